# Optimizing an MI355X kernel written in HIP

```python
import math
import jax, jax.numpy as jnp
from jax import lax
import numpy as np

D_MODEL = 1024
BATCH = 4
SEQ = 8192
DEPTH = 2

D_MIX = D_MODEL
HEAD_DIM = 64
M_WIDTH = D_MIX // 2
M_HEAD_DIM = 128
M_HEADS = M_WIDTH // M_HEAD_DIM
M_CHUNK = 64
CONV_W = 4
B_WIDTH = D_MIX // 4
B_HEADS = B_WIDTH // HEAD_DIM
MOBA_BLOCK = 256
MOBA_TOPK = 3
N_WIDTH = D_MIX // 4
N_HEADS = N_WIDTH // HEAD_DIM
CMP_LEN = 32
CMP_STRIDE = 16
CMP_HIDDEN = 128
SEL_BLOCK = 64
SEL_TOPK = 16
WINDOW = 512
Q_BLOCK = 64
D_FF = 4 * D_MODEL
ROPE_THETA = 500000.0
ROT_DIM = HEAD_DIM // 4
NORM_EPS = 1e-6
NEG = -1e30
BIG = 1e9

SPLITS = ((M_WIDTH,) * 4 + (M_HEADS, M_HEADS)
          + (B_WIDTH,) * 3
          + (N_WIDTH,) + (HEAD_DIM,) * 6
          + (3 * N_HEADS,))
D_IN = sum(SPLITS)
SPLIT_POINTS = tuple(int(v) for v in np.cumsum(SPLITS)[:-1])

kernel_name = "hybrid_mlstm_moba_nsa_block"


def rmsnorm(x, g):
    xf = x.astype(jnp.float32)
    y = xf * lax.rsqrt(jnp.mean(xf * xf, axis=-1, keepdims=True) + NORM_EPS)
    return (y * g.astype(jnp.float32)).astype(x.dtype)


def partial_rope(x):
    S = x.shape[-2]
    half = ROT_DIM // 2
    inv_freq = jnp.exp(-math.log(ROPE_THETA) * jnp.arange(half, dtype=jnp.float32) * (2.0 / ROT_DIM))
    ang = jnp.arange(S, dtype=jnp.float32)[:, None] * inv_freq[None, :]
    cos, sin = jnp.cos(ang), jnp.sin(ang)
    x1, x2, rest = x[..., :half], x[..., half:ROT_DIM], x[..., ROT_DIM:]
    return jnp.concatenate([x1 * cos - x2 * sin, x2 * cos + x1 * sin, rest], axis=-1)


def causal_conv(x, w):
    S = x.shape[1]
    xp = jnp.pad(x, ((0, 0), (CONV_W - 1, 0), (0, 0)))
    return sum(xp[:, j:j + S] * w[j] for j in range(CONV_W))


def masked_softmax(s, mask):
    p = jax.nn.softmax(jnp.where(mask, s, NEG), axis=-1)
    return jnp.where(mask, p, 0.0)


def mlstm(q, k, v, o_pre, i_pre, f_pre, norm_g):
    B, S, _ = q.shape
    NC, L, H, D = S // M_CHUNK, M_CHUNK, M_HEADS, M_HEAD_DIM

    def to_chunks(t):
        return t.reshape(B, NC, L, H, D).transpose(1, 0, 3, 2, 4)

    qc, kc, vc = to_chunks(q), to_chunks(k) * (D ** -0.5), to_chunks(v)
    lf = jax.nn.log_sigmoid(f_pre).reshape(B, NC, L, H).transpose(1, 0, 3, 2)
    li = i_pre.reshape(B, NC, L, H).transpose(1, 0, 3, 2)
    causal = jnp.tril(jnp.ones((L, L), dtype=bool))

    def step(carry, xs):
        C, n, m = carry
        qt, kt, vt, lft, lit = xs
        b = jnp.cumsum(lft, axis=-1)
        dmat = jnp.where(causal, b[..., :, None] - b[..., None, :] + lit[..., None, :], -jnp.inf)
        inter = b + m[..., None]
        m_t = jnp.maximum(inter, jnp.max(dmat, axis=-1))
        w_intra = jnp.exp(dmat - m_t[..., None])
        w_prev = jnp.exp(inter - m_t)
        s = jnp.einsum('bhtd,bhsd->bhts', qt, kt) * w_intra
        num = jnp.einsum('bhts,bhse->bhte', s, vt) + w_prev[..., None] * jnp.einsum('bhtd,bhde->bhte', qt, C)
        den = jnp.sum(s, axis=-1) + w_prev * jnp.einsum('bhtd,bhd->bht', qt, n)
        h = num / jnp.maximum(jnp.abs(den), jnp.exp(-m_t))[..., None]
        b_last = b[..., -1]
        g = b_last[..., None] - b + lit
        m_new = jnp.maximum(b_last + m, jnp.max(g, axis=-1))
        a = jnp.exp(b_last + m - m_new)
        w_s = jnp.exp(g - m_new[..., None])
        C = a[..., None, None] * C + jnp.einsum('bhs,bhsd,bhse->bhde', w_s, kt, vt)
        n = a[..., None] * n + jnp.einsum('bhs,bhsd->bhd', w_s, kt)
        return (C, n, m_new), h

    init = (jnp.zeros((B, H, D, D), jnp.float32), jnp.zeros((B, H, D), jnp.float32),
            jnp.zeros((B, H), jnp.float32))
    _, h = lax.scan(step, init, (qc, kc, vc, lf, li))
    h = h.transpose(1, 0, 3, 2, 4).reshape(B, S, H, D)
    h = rmsnorm(h, norm_g.reshape(H, D)).reshape(B, S, M_WIDTH)
    return jax.nn.sigmoid(o_pre) * h


def moba(q, k, v, q_g, k_g):
    B, S, _ = q.shape
    H, D, BS = B_HEADS, HEAD_DIM, MOBA_BLOCK
    heads = lambda t: t.reshape(B, S, H, D).transpose(0, 2, 1, 3)
    q = partial_rope(rmsnorm(heads(q), q_g))
    k = partial_rope(rmsnorm(heads(k), k_g))
    v = heads(v)
    NB = -(-S // BS)
    pad = NB * BS - S
    kp = jnp.pad(k, ((0, 0), (0, 0), (0, pad), (0, 0)))
    vp = jnp.pad(v, ((0, 0), (0, 0), (0, pad), (0, 0)))
    kb = kp.reshape(B, H, NB, BS, D)
    vb = vp.reshape(B, H, NB, BS, D)
    kmean = jnp.mean(kb, axis=3)
    topk = min(MOBA_TOPK, NB)
    scale = D ** -0.5
    gather = jax.vmap(jax.vmap(lambda blocks, idx: blocks[idx]))

    def block(j):
        t0 = j * Q_BLOCK
        tq = t0 + jnp.arange(Q_BLOCK)
        qj = lax.dynamic_slice_in_dim(q, t0, Q_BLOCK, axis=2)
        own = t0 // BS
        gs = jnp.einsum('bhqd,bhnd->bhqn', qj, kmean)
        gs = jnp.where(jnp.arange(NB) < own, gs, NEG)
        _, idx = lax.top_k(gs, topk)
        gk, gv = gather(kb, idx), gather(vb, idx)
        s_sel = jnp.einsum('bhqd,bhqrkd->bhqrk', qj, gk) * scale
        s_sel = jnp.where((jnp.arange(topk) < own)[:, None], s_sel, NEG).reshape(B, H, Q_BLOCK, topk * BS)
        ko = lax.dynamic_slice_in_dim(kp, own * BS, BS, axis=2)
        vo = lax.dynamic_slice_in_dim(vp, own * BS, BS, axis=2)
        s_own = jnp.einsum('bhqd,bhkd->bhqk', qj, ko) * scale
        s_own = jnp.where(own * BS + jnp.arange(BS)[None, :] <= tq[:, None], s_own, NEG)
        p = jax.nn.softmax(jnp.concatenate([s_sel, s_own], axis=-1), axis=-1)
        p_sel = p[..., :topk * BS].reshape(B, H, Q_BLOCK, topk, BS)
        p_own = p[..., topk * BS:]
        return (jnp.einsum('bhqrk,bhqrkd->bhqd', p_sel, gv)
                + jnp.einsum('bhqk,bhkd->bhqd', p_own, vo))

    out = lax.map(block, jnp.arange(S // Q_BLOCK))
    return out.transpose(1, 0, 3, 2, 4).reshape(B, S, B_WIDTH)


def nsa(q, kc, vc, ks, vs, kw, vw, g_pre, q_g, k_g, pe, w1, w2):
    B, S, _ = q.shape
    H, D = N_HEADS, HEAD_DIM
    scale = D ** -0.5
    q = rmsnorm(q.reshape(B, S, H, D), q_g).transpose(0, 2, 1, 3)
    qr = partial_rope(q)
    ks = partial_rope(rmsnorm(ks, k_g[1]))
    kw = partial_rope(rmsnorm(kw, k_g[2]))

    n_sub = CMP_LEN // CMP_STRIDE
    Nc = S // CMP_STRIDE - n_sub + 1

    def compress(t, pe_, w1_, w2_):
        c = t.reshape(B, S // CMP_STRIDE, CMP_STRIDE, D)
        blocks = jnp.concatenate([c[:, r:Nc + r] for r in range(n_sub)], axis=2) + pe_
        hid = jax.nn.silu(blocks.reshape(B, Nc, CMP_LEN * D) @ w1_)
        return hid @ w2_

    Kc = rmsnorm(compress(kc, pe[0], w1[0], w2[0]), k_g[0])
    Vc = compress(vc, pe[1], w1[1], w2[1])
    c_end = jnp.arange(Nc) * CMP_STRIDE + CMP_LEN - 1

    Nsel = S // SEL_BLOCK
    c_start = np.arange(Nc) * CMP_STRIDE
    s_start = np.arange(Nsel) * SEL_BLOCK
    overlap = jnp.asarray(((c_start[:, None] < s_start[None, :] + SEL_BLOCK)
                           & (c_start[:, None] + CMP_LEN > s_start[None, :])).astype(np.float32))
    ksb = ks.reshape(B, Nsel, SEL_BLOCK, D)
    vsb = vs.reshape(B, Nsel, SEL_BLOCK, D)
    ksel = min(SEL_TOPK, Nsel)
    gather_b = jax.vmap(lambda blocks, idx: blocks[idx])
    kw_pad = jnp.pad(kw, ((0, 0), (WINDOW, 0), (0, 0)))
    vw_pad = jnp.pad(vw, ((0, 0), (WINDOW, 0), (0, 0)))
    gates = jax.nn.sigmoid(g_pre).reshape(B, S, 3, H)

    def block(j):
        t0 = j * Q_BLOCK
        tq = t0 + jnp.arange(Q_BLOCK)
        qj = lax.dynamic_slice_in_dim(q, t0, Q_BLOCK, axis=2)
        qrj = lax.dynamic_slice_in_dim(qr, t0, Q_BLOCK, axis=2)
        s_c = jnp.einsum('bhqd,bcd->bhqc', qj, Kc) * scale
        p_c = masked_softmax(s_c, c_end[None, :] <= tq[:, None])
        o_c = jnp.einsum('bhqc,bcd->bhqd', p_c, Vc)
        imp = jnp.einsum('bhqc,cn->bqn', p_c, overlap)
        blk_q = tq // SEL_BLOCK
        jn = jnp.arange(Nsel)
        causal_blk = jn[None, :] <= blk_q[:, None]
        forced = causal_blk & ((jn[None, :] == 0) | (jn[None, :] >= blk_q[:, None] - 1))
        imp = jnp.where(forced, BIG, jnp.where(causal_blk, imp, NEG))
        _, sidx = lax.top_k(imp, ksel)
        gk, gv = gather_b(ksb, sidx), gather_b(vsb, sidx)
        pos = sidx[..., None] * SEL_BLOCK + jnp.arange(SEL_BLOCK)
        mask_s = (pos <= tq[None, :, None, None])[:, None]
        s_s = jnp.where(mask_s, jnp.einsum('bhqd,bqrkd->bhqrk', qrj, gk) * scale, NEG)
        p_s = jax.nn.softmax(s_s.reshape(B, H, Q_BLOCK, ksel * SEL_BLOCK), axis=-1)
        o_s = jnp.einsum('bhqrk,bqrkd->bhqd', p_s.reshape(B, H, Q_BLOCK, ksel, SEL_BLOCK), gv)
        kwj = lax.dynamic_slice_in_dim(kw_pad, t0, WINDOW + Q_BLOCK, axis=1)
        vwj = lax.dynamic_slice_in_dim(vw_pad, t0, WINDOW + Q_BLOCK, axis=1)
        posw = t0 - WINDOW + jnp.arange(WINDOW + Q_BLOCK)
        mask_w = ((posw[None, :] <= tq[:, None]) & (posw[None, :] > tq[:, None] - WINDOW)
                  & (posw[None, :] >= 0))
        s_w = jnp.where(mask_w, jnp.einsum('bhqd,bkd->bhqk', qrj, kwj) * scale, NEG)
        o_w = jnp.einsum('bhqk,bkd->bhqd', jax.nn.softmax(s_w, axis=-1), vwj)
        gj = lax.dynamic_slice_in_dim(gates, t0, Q_BLOCK, axis=1).transpose(0, 2, 3, 1)[..., None]
        return gj[:, 0] * o_c + gj[:, 1] * o_s + gj[:, 2] * o_w

    out = lax.map(block, jnp.arange(S // Q_BLOCK))
    return out.transpose(1, 0, 3, 2, 4).reshape(B, S, N_WIDTH)


def setup_inputs(seed: int = 0) -> dict:
    key = jax.random.key(seed)
    ks = jax.random.split(key, 20)
    nrm = lambda k, shape, s: jax.random.normal(k, shape, jnp.float32) * s
    L = DEPTH
    b_i = nrm(ks[2], (L, M_HEADS), 0.1)
    b_f = jnp.linspace(3.0, 6.0, M_HEADS, dtype=jnp.float32)[None, :] + nrm(ks[3], (L, M_HEADS), 0.1)
    return {
        "x": nrm(ks[0], (BATCH, SEQ, D_MODEL), 1.0),
        "w_in": nrm(ks[1], (L, D_MODEL, D_IN), D_MODEL ** -0.5),
        "b_if": jnp.concatenate([b_i, b_f], axis=-1),
        "conv_qk": nrm(ks[4], (L, CONV_W, 2 * M_WIDTH), CONV_W ** -0.5),
        "m_norm": 1.0 + nrm(ks[5], (L, M_WIDTH), 0.02),
        "moba_qk_norm": 1.0 + nrm(ks[6], (L, 2, HEAD_DIM), 0.02),
        "nsa_q_norm": 1.0 + nrm(ks[7], (L, HEAD_DIM), 0.02),
        "nsa_k_norm": 1.0 + nrm(ks[8], (L, 3, HEAD_DIM), 0.02),
        "cmp_pe": nrm(ks[9], (L, 2, CMP_LEN, HEAD_DIM), 0.02),
        "cmp_w1": nrm(ks[10], (L, 2, CMP_LEN * HEAD_DIM, CMP_HIDDEN), (CMP_LEN * HEAD_DIM) ** -0.5),
        "cmp_w2": nrm(ks[11], (L, 2, CMP_HIDDEN, HEAD_DIM), CMP_HIDDEN ** -0.5),
        "w_out": nrm(ks[12], (L, D_MIX, D_MODEL), D_MIX ** -0.5),
        "norm_mix": 1.0 + nrm(ks[13], (L, D_MODEL), 0.02),
        "norm_ffn": 1.0 + nrm(ks[14], (L, D_MODEL), 0.02),
        "w_ff1": nrm(ks[15], (L, D_MODEL, D_FF), D_MODEL ** -0.5),
        "w_ff2": nrm(ks[16], (L, D_FF, D_MODEL), D_FF ** -0.5),
    }


def reference(x, w_in, b_if, conv_qk, m_norm, moba_qk_norm, nsa_q_norm, nsa_k_norm,
              cmp_pe, cmp_w1, cmp_w2, w_out, norm_mix, norm_ffn, w_ff1, w_ff2):
    for l in range(DEPTH):
        h = rmsnorm(x, norm_mix[l])
        proj = jnp.einsum('bsd,de->bse', h, w_in[l]).astype(jnp.float32)
        (m_q, m_k, m_v, m_o, m_i, m_f, b_q, b_k, b_v,
         n_q, n_kc, n_vc, n_ks, n_vs, n_kw, n_vw, n_g) = jnp.split(proj, SPLIT_POINTS, axis=-1)
        qk = jax.nn.silu(causal_conv(jnp.concatenate([m_q, m_k], axis=-1), conv_qk[l]))
        gif = jnp.concatenate([m_i, m_f], axis=-1) + b_if[l]
        y_m = mlstm(qk[..., :M_WIDTH], qk[..., M_WIDTH:], m_v, m_o,
                    gif[..., :M_HEADS], gif[..., M_HEADS:], m_norm[l])
        y_b = moba(b_q, b_k, b_v, moba_qk_norm[l, 0], moba_qk_norm[l, 1])
        y_n = nsa(n_q, n_kc, n_vc, n_ks, n_vs, n_kw, n_vw, n_g, nsa_q_norm[l], nsa_k_norm[l],
                  cmp_pe[l], cmp_w1[l], cmp_w2[l])
        mix = jnp.concatenate([y_m, y_b, y_n], axis=-1).astype(x.dtype)
        x = x + jnp.einsum('bse,ed->bsd', mix, w_out[l])
        h = rmsnorm(x, norm_ffn[l])
        u = jnp.square(jax.nn.relu(jnp.einsum('bsd,df->bsf', h, w_ff1[l])))
        x = x + jnp.einsum('bsf,fd->bsd', u, w_ff2[l])
    return x
```

```cpp
#include <hip/hip_runtime.h>
#include <cstdio>
#include <cstdint>
namespace pg8 {
#define PG8_LAS __attribute__((address_space(3)))
typedef unsigned short bf16_t;
typedef short bf16x8 __attribute__((ext_vector_type(8)));
typedef float f32x4 __attribute__((ext_vector_type(4)));
typedef unsigned u32x4 __attribute__((ext_vector_type(4)));
constexpr int BM = 256, BK = 64, HALF = 128, HTB = HALF * BK * 2  , STAGE_BYTES = 8 * HTB, NXCD = 8, WGM = 8;

__host__ __device__ __forceinline__ int lds_byte(int r, int c) { const int st = (r >> 4) * 2 + (c >> 5), rr = r & 15, cc = c & 31, ob = rr * 64 + cc * 2; return st * 1024 + (ob ^ (((ob >> 9) & 1) << 5)); }
__host__ __device__ __forceinline__ void stage_rc(int b, int& R, int& C) { const int st = b / 1024, sb = b % 1024, swz = sb ^ (((sb >> 9) & 1) << 5); R = (st >> 1) * 16 + swz / 64; C = (st & 1) * 32 + (swz % 64) / 2; }
__host__ __device__ __forceinline__ int perm32(int rho) { const int n = rho >> 4, i = rho & 15; return 8 * (i >> 2) + 4 * n + (i & 3); }

struct Unit { int pm, pn; };
struct Gemm { const bf16_t* A; const bf16_t* Bt; int M, N, K; };

struct StaticOrder {
    int nM, nN, nwg, G, c;
    __host__ __device__ void init(int M, int N, int G_, int c_) { nM = M / BM; nN = N / BM; nwg = nM * nN; G = G_; c = c_; }
    __host__ __device__ bool next(int i, Unit& u) const {
        const long L = (long)i * G + c; if (L >= nwg) return false;
        int wgid = (int)L; { const int q = nwg / NXCD, r = nwg % NXCD, xcd = wgid % NXCD, off = wgid / NXCD; wgid = (xcd < r ? xcd * (q + 1) : r * (q + 1) + (xcd - r) * q) + off; }
        const int nig = WGM * nN, gid = wgid / nig, fm = gid * WGM, gsz = (nM - fm) < WGM ? (nM - fm) : WGM;
        u.pm = fm + ((wgid % nig) % gsz); u.pn = (wgid % nig) / gsz; return true;
    }
    __device__ __forceinline__ void a_ready(const Unit&) const {}
    __device__ __forceinline__ void done(const Unit&) const {}
};

__device__ __forceinline__ unsigned f2bf_u(float f) { unsigned u = __builtin_bit_cast(unsigned, f); return (u + 0x7fffu + ((u >> 16) & 1u)) >> 16; }
__device__ __forceinline__ unsigned pk2bf(float lo, float hi) { return f2bf_u(lo) | (f2bf_u(hi) << 16); }

struct EpiProj {
    static constexpr bool PERM = true, AFTER_DRAIN = false;
    bf16_t* O; int ldc; float* gates; int gate0;
    __device__ __forceinline__ void operator()(const f32x4 (&acc)[2][2][4][2], const Unit& u, int wr, int wc, int fr, int fq) const {
        const int row0 = u.pm * BM + wr * 64 + fr; const int col0 = u.pn * BM + wc * 32 + 8 * fq;
#pragma unroll
        for (int ai = 0; ai < 2; ++ai)
#pragma unroll
            for (int m = 0; m < 4; ++m) { const int row = row0 + ai * HALF + m * 16; bf16_t* rowp = O + (size_t)row * ldc + col0;
#pragma unroll
                for (int bj = 0; bj < 2; ++bj) { const f32x4 v0 = acc[ai][bj][m][0], v1 = acc[ai][bj][m][1];
                    u32x4 w; w.x = pk2bf(v0[0], v0[1]); w.y = pk2bf(v0[2], v0[3]); w.z = pk2bf(v1[0], v1[1]); w.w = pk2bf(v1[2], v1[3]);
                    *(u32x4*)(rowp + bj * HALF) = w;
                    const int c = col0 + bj * HALF - gate0;
                    if (c >= 0 && c < 32) { float* g = gates + (size_t)row * 32 + c; *(f32x4*)g = v0; *(f32x4*)(g + 4) = v1; } } }
    }
};
struct EpiRelu2 {
    static constexpr bool PERM = true, AFTER_DRAIN = false;
    bf16_t* O; int ldc;
    __device__ __forceinline__ void operator()(const f32x4 (&acc)[2][2][4][2], const Unit& u, int wr, int wc, int fr, int fq) const {
        const int row0 = u.pm * BM + wr * 64 + fr; const int col0 = u.pn * BM + wc * 32 + 8 * fq;
#pragma unroll
        for (int ai = 0; ai < 2; ++ai)
#pragma unroll
            for (int m = 0; m < 4; ++m) { const int row = row0 + ai * HALF + m * 16; bf16_t* rowp = O + (size_t)row * ldc + col0;
#pragma unroll
                for (int bj = 0; bj < 2; ++bj) { f32x4 v0 = acc[ai][bj][m][0], v1 = acc[ai][bj][m][1];
#pragma unroll
                    for (int e = 0; e < 4; ++e) { float a = v0[e] > 0.f ? v0[e] : 0.f; v0[e] = a * a; float b = v1[e] > 0.f ? v1[e] : 0.f; v1[e] = b * b; }
                    u32x4 w; w.x = pk2bf(v0[0], v0[1]); w.y = pk2bf(v0[2], v0[3]); w.z = pk2bf(v1[0], v1[1]); w.w = pk2bf(v1[2], v1[3]);
                    *(u32x4*)(rowp + bj * HALF) = w; } }
    }
};
struct EpiResid {
    static constexpr bool PERM = false, AFTER_DRAIN = false;
    const float* base; float* out; int ldc;
    __device__ __forceinline__ void operator()(const f32x4 (&acc)[2][2][4][2], const Unit& u, int wr, int wc, int fr, int fq) const {
        const int row0 = u.pm * BM + wr * 64 + fr; const int col0 = u.pn * BM + wc * 32 + 4 * fq;
#pragma unroll
        for (int ai = 0; ai < 2; ++ai)
#pragma unroll
            for (int m = 0; m < 4; ++m) { const size_t off = (size_t)(row0 + ai * HALF + m * 16) * ldc + col0;
#pragma unroll
                for (int bj = 0; bj < 2; ++bj)
#pragma unroll
                    for (int n = 0; n < 2; ++n) { const size_t o = off + bj * HALF + n * 16; const f32x4 b = *(const f32x4*)(base + o); *(f32x4*)(out + o) = b + acc[ai][bj][m][n]; } }
    }
};
template <class Epi, class Sched, bool ALIGN_EPI = false, bool SP2 = false>
__device__ __forceinline__ void gemm_phase(PG8_LAS unsigned char* lds, const Gemm g, const Sched& S, const Epi& E) {
    const int tid = threadIdx.x, wid = __builtin_amdgcn_readfirstlane(tid >> 6), lane = tid & 63, wr = wid >> 2, wc = wid & 3, fr = lane & 15, fq = lane >> 4;
    const int K = g.K, nt = K / BK;
    unsigned voffA[2], voffB[2];
#pragma unroll
    for (int i = 0; i < 2; ++i) { int R, C; stage_rc(tid * 16 + i * 8192, R, C); const int Rb = Epi::PERM ? ((R & ~31) + perm32(R & 31)) : R;
        voffA[i] = (unsigned)(R * K + C) * 2u; voffB[i] = (unsigned)(Rb * K + C) * 2u; }
    const size_t kstep = (size_t)(BK * 2);
    const size_t hstep = (size_t)HALF * K * 2;
    const size_t tstep = 2 * hstep;
    const unsigned ldsw = (unsigned)wid * 1024u;
    const int aoff = lds_byte(wr * 64 + fr, fq * 8), boff = lds_byte(wc * 32 + fr, fq * 8);
#define PG8_SA(b, h) (((b) * 2 + (h)) * HTB)
#define PG8_SB(b, h) ((4 + (b) * 2 + (h)) * HTB)
#define PG8_STAGE(bufoff, gbase, voff) do { _Pragma("unroll") for (int _i = 0; _i < 2; ++_i) \
        __builtin_amdgcn_global_load_lds((const unsigned*)((const char*)(gbase) + (voff)[_i]), (PG8_LAS unsigned*)(lds + (bufoff) + ldsw + _i * 8192), 16, 0, 0); } while (0)
#define PG8_LDA(dst, b, h) do { _Pragma("unroll") for (int m = 0; m < 4; ++m) _Pragma("unroll") for (int k = 0; k < 2; ++k) dst[m][k] = *(const PG8_LAS bf16x8*)(lds + PG8_SA(b, h) + aoff + m * 2048 + k * 1024); } while (0)
#define PG8_LDB(dst, b, h) do { _Pragma("unroll") for (int n = 0; n < 2; ++n) _Pragma("unroll") for (int k = 0; k < 2; ++k) dst[n][k] = *(const PG8_LAS bf16x8*)(lds + PG8_SB(b, h) + boff + n * 2048 + k * 1024); } while (0)
#define PG8_MMA(ai, bj, At, Bt) do { __builtin_amdgcn_s_setprio(1); _Pragma("unroll") for (int m = 0; m < 4; ++m) _Pragma("unroll") for (int n = 0; n < 2; ++n) _Pragma("unroll") for (int k = 0; k < 2; ++k) \
        acc[ai][bj][m][n] = __builtin_amdgcn_mfma_f32_16x16x32_bf16(Bt[n][k], At[m][k], acc[ai][bj][m][n], 0, 0, 0); __builtin_amdgcn_s_setprio(0); } while (0)
#define PG8_WAIT_V(n) asm volatile("s_waitcnt vmcnt(" #n ")" ::: "memory")
#define PG8_WAIT_L(n) asm volatile("s_waitcnt lgkmcnt(" #n ")" ::: "memory")
#define PG8_BAR __builtin_amdgcn_s_barrier()
#define PG8_SCHED __builtin_amdgcn_sched_barrier(0)
    Unit cur, nxt; int ui = 0;
    if (!S.next(0, cur)) return;
    f32x4 acc[2][2][4][2];
#pragma unroll
    for (int a = 0; a < 2; ++a)
#pragma unroll
        for (int b = 0; b < 2; ++b)
#pragma unroll
            for (int m = 0; m < 4; ++m)
#pragma unroll
                for (int n = 0; n < 2; ++n) acc[a][b][m][n] = (f32x4){0.f, 0.f, 0.f, 0.f};
    bf16x8 At[4][2], B0[2][2], B1[2][2];
    const char* cA = (const char*)g.A + (size_t)cur.pm * tstep; const char* cB = (const char*)g.Bt + (size_t)cur.pn * tstep;
    S.a_ready(cur);
    if constexpr (SP2) {
        PG8_STAGE(PG8_SB(0, 0), cB, voffB); PG8_STAGE(PG8_SB(0, 1), cB + hstep, voffB); PG8_STAGE(PG8_SA(0, 0), cA, voffA); PG8_STAGE(PG8_SA(0, 1), cA + hstep, voffA);
        if (wr == 1) PG8_BAR;
        PG8_WAIT_V(2); PG8_BAR;
        PG8_STAGE(PG8_SB(1, 0), cB + kstep, voffB); PG8_STAGE(PG8_SA(1, 0), cA + kstep, voffA); PG8_STAGE(PG8_SB(1, 1), cB + hstep + kstep, voffB);
        PG8_WAIT_V(6); PG8_BAR;
    } else {
        PG8_STAGE(PG8_SB(0, 0), cB, voffB); PG8_STAGE(PG8_SA(0, 0), cA, voffA); PG8_STAGE(PG8_SB(0, 1), cB + hstep, voffB); PG8_STAGE(PG8_SA(0, 1), cA + hstep, voffA);
        if (wr == 1) PG8_BAR;
        PG8_WAIT_V(4); PG8_BAR;
        PG8_STAGE(PG8_SB(1, 0), cB + kstep, voffB); PG8_STAGE(PG8_SA(1, 0), cA + kstep, voffA); PG8_STAGE(PG8_SB(1, 1), cB + hstep + kstep, voffB);
        PG8_WAIT_V(6); PG8_BAR;
    }
    for (;;) {
        const bool has_next = S.next(ui + 1, nxt);
        const char* nA = has_next ? (const char*)g.A + (size_t)nxt.pm * tstep : cA; const char* nB = has_next ? (const char*)g.Bt + (size_t)nxt.pn * tstep : cB;
        for (int t = 0; t < nt; t += 2) {
            const bool last = (t == nt - 2);
            const char* a1 = cA + (size_t)(t + 1) * kstep;
            const char* a2 = last ? nA : cA + (size_t)(t + 2) * kstep; const char* b2 = last ? nB : cB + (size_t)(t + 2) * kstep;
            const char* a3 = a2 + kstep; const char* b3 = b2 + kstep;
            if (last && has_next) S.a_ready(nxt);
            if constexpr (SP2) {
            PG8_LDB(B0, 0, 0); PG8_LDB(B1, 0, 1); PG8_SCHED; PG8_LDA(At, 0, 0); PG8_STAGE(PG8_SA(1, 1), a1 + hstep, voffA);
            PG8_WAIT_V(8); PG8_WAIT_L(0); PG8_BAR; PG8_MMA(0, 0, At, B0); PG8_MMA(0, 1, At, B1); PG8_BAR; PG8_SCHED;
            PG8_LDA(At, 0, 1); PG8_STAGE(PG8_SB(0, 0), b2, voffB); PG8_STAGE(PG8_SB(0, 1), b2 + hstep, voffB); PG8_STAGE(PG8_SA(0, 0), a2, voffA);
            PG8_WAIT_V(8); PG8_WAIT_L(0); PG8_BAR; PG8_MMA(1, 0, At, B0); PG8_MMA(1, 1, At, B1); PG8_BAR; PG8_SCHED;
            PG8_LDB(B0, 1, 0); PG8_LDB(B1, 1, 1); PG8_SCHED; PG8_LDA(At, 1, 0); PG8_STAGE(PG8_SA(0, 1), a2 + hstep, voffA);
            PG8_WAIT_V(8); PG8_WAIT_L(0); PG8_BAR; PG8_MMA(0, 0, At, B0); PG8_MMA(0, 1, At, B1); PG8_BAR; PG8_SCHED;
            PG8_LDA(At, 1, 1); PG8_STAGE(PG8_SB(1, 0), b3, voffB); PG8_STAGE(PG8_SB(1, 1), b3 + hstep, voffB); PG8_STAGE(PG8_SA(1, 0), a3, voffA);
            PG8_WAIT_V(8); PG8_WAIT_L(0); PG8_BAR; PG8_MMA(1, 0, At, B0); PG8_MMA(1, 1, At, B1); PG8_BAR; PG8_SCHED;
            } else {
            PG8_LDB(B0, 0, 0); PG8_SCHED; PG8_LDA(At, 0, 0); PG8_STAGE(PG8_SA(1, 1), a1 + hstep, voffA);
            PG8_WAIT_L(8); PG8_BAR; PG8_WAIT_L(0); PG8_MMA(0, 0, At, B0); PG8_BAR; PG8_SCHED;
            PG8_LDB(B1, 0, 1); PG8_STAGE(PG8_SB(0, 0), b2, voffB);
            PG8_BAR; PG8_WAIT_L(0); PG8_MMA(0, 1, At, B1); PG8_BAR;
            PG8_LDA(At, 0, 1); PG8_STAGE(PG8_SA(0, 0), a2, voffA);
            PG8_BAR; PG8_WAIT_L(0); PG8_MMA(1, 0, At, B0); PG8_BAR; PG8_SCHED;
            PG8_STAGE(PG8_SB(0, 1), b2 + hstep, voffB);
            PG8_WAIT_V(6); PG8_BAR; PG8_MMA(1, 1, At, B1); PG8_BAR;
            PG8_LDB(B0, 1, 0); PG8_SCHED; PG8_LDA(At, 1, 0); PG8_STAGE(PG8_SA(0, 1), a2 + hstep, voffA);
            PG8_WAIT_L(8); PG8_BAR; PG8_WAIT_L(0); PG8_MMA(0, 0, At, B0); PG8_BAR; PG8_SCHED;
            PG8_LDB(B1, 1, 1); PG8_STAGE(PG8_SB(1, 0), b3, voffB);
            PG8_BAR; PG8_WAIT_L(0); PG8_MMA(0, 1, At, B1); PG8_BAR;
            PG8_LDA(At, 1, 1); PG8_STAGE(PG8_SA(1, 0), a3, voffA);
            PG8_BAR; PG8_WAIT_L(0); PG8_MMA(1, 0, At, B0); PG8_BAR; PG8_SCHED;
            PG8_STAGE(PG8_SB(1, 1), b3 + hstep, voffB);
            PG8_WAIT_V(6); PG8_BAR; PG8_MMA(1, 1, At, B1); PG8_BAR;
            }
        }
        if constexpr (ALIGN_EPI) { if (wr == 0) PG8_BAR; }
        if constexpr (!Epi::AFTER_DRAIN) { E(acc, cur, wr, wc, fr, fq); S.done(cur); }
        if (!has_next) break;
#pragma unroll
        for (int a = 0; a < 2; ++a)
#pragma unroll
            for (int b = 0; b < 2; ++b)
#pragma unroll
                for (int m = 0; m < 4; ++m)
#pragma unroll
                    for (int n = 0; n < 2; ++n) acc[a][b][m][n] = (f32x4){0.f, 0.f, 0.f, 0.f};
        cur = nxt; cA = nA; cB = nB; ++ui;
        if constexpr (ALIGN_EPI) { if (wr == 1) PG8_BAR; }
    }
    PG8_WAIT_V(0);
    if constexpr (!ALIGN_EPI) { if (wr == 0) PG8_BAR; }
    PG8_BAR;
    if constexpr (Epi::AFTER_DRAIN) { E.fused(acc, cur, wr, wc, fr, fq, lds, wid, lane); S.done(cur); }
#undef PG8_SA
#undef PG8_SB
#undef PG8_STAGE
#undef PG8_LDA
#undef PG8_LDB
#undef PG8_MMA
#undef PG8_WAIT_V
#undef PG8_WAIT_L
#undef PG8_BAR
#undef PG8_SCHED
}
}

typedef unsigned short bf16;
constexpr int NB = 4, SEQ = 8192, T = NB * SEQ, DM = 1024, DFF = 4096, DEPTH = 2;
constexpr int DIN = 3476, DINP = 3584;
constexpr int C_MQ = 0, C_MK = 512, C_MV = 1024, C_MO = 1536, C_BQ = 2048, C_BK = 2304, C_BV = 2560, C_NQ = 2816,
              C_NKC = 3072, C_NVC = 3136, C_NKS = 3200, C_NVS = 3264, C_NKW = 3328, C_NVW = 3392, C_GATE = 3456;
constexpr int NCMP = 511;
constexpr float EPS = 1e-6f;

__device__ __forceinline__ float bf2f(bf16 v) { return __builtin_bit_cast(float, (unsigned)v << 16); }
__device__ __forceinline__ bf16 f2bf(float f) { return (bf16)pg8::f2bf_u(f); }
__device__ __forceinline__ float wave_sum(float v) {
#pragma unroll
    for (int o = 1; o < 64; o <<= 1) v += __shfl_xor(v, o);
    return v;
}
__device__ __forceinline__ float wave_max(float v) {
#pragma unroll
    for (int o = 1; o < 64; o <<= 1) v = fmaxf(v, __shfl_xor(v, o));
    return v;
}
__device__ __forceinline__ float sigmoidf_(float x) { return 1.f / (1.f + __expf(-x)); }
__device__ __forceinline__ float log_sigmoidf_(float x) { return fminf(x, 0.f) - log1pf(__expf(-fabsf(x))); }


__device__ __forceinline__ float dot64(const bf16* __restrict__ kp, const float* q) {
    const uint4* k4 = (const uint4*)kp; float a = 0.f;
#pragma unroll
    for (int j = 0; j < 8; ++j) { const uint4 w = k4[j]; const unsigned ww[4] = {w.x, w.y, w.z, w.w};
#pragma unroll
        for (int e = 0; e < 4; ++e) { a = fmaf(q[8 * j + 2 * e], __builtin_bit_cast(float, ww[e] << 16), a); a = fmaf(q[8 * j + 2 * e + 1], __builtin_bit_cast(float, ww[e] & 0xffff0000u), a); } }
    return a;
}
__device__ __forceinline__ void dot64x4(const bf16* __restrict__ kp, const float (*q)[64], float (&a)[4]) {
    const uint4* k4 = (const uint4*)kp; a[0] = a[1] = a[2] = a[3] = 0.f;
#pragma unroll
    for (int j = 0; j < 8; ++j) { const uint4 w = k4[j]; const unsigned ww[4] = {w.x, w.y, w.z, w.w};
#pragma unroll
        for (int e = 0; e < 4; ++e) { const float k0 = __builtin_bit_cast(float, ww[e] << 16), k1 = __builtin_bit_cast(float, ww[e] & 0xffff0000u);
#pragma unroll
            for (int h = 0; h < 4; ++h) { a[h] = fmaf(q[h][8 * j + 2 * e], k0, a[h]); a[h] = fmaf(q[h][8 * j + 2 * e + 1], k1, a[h]); } } }
}

__host__ __device__ __forceinline__ int win_src(int n) {
    if (n < 2048) return n;
    if (n < 3456) return n + 8;
    if (n < 3464) return n - 3456 + 2048;
    if (n < 3476) return n;
    return -1;
}

__global__ void __launch_bounds__(256) k_convert_w(const float* __restrict__ W, int K, int N, int NP, bf16* __restrict__ WT, int mode) {
    __shared__ float tile[64][65];
    const int n0 = blockIdx.x * 64, k0 = blockIdx.y * 64, c = threadIdx.x & 63, r = threadIdx.x >> 6;
    const int src = mode ? win_src(n0 + c) : (n0 + c);
#pragma unroll 4
    for (int i = 0; i < 16; ++i) { const int k = r + 4 * i; tile[k][c] = (src >= 0) ? W[(size_t)(k0 + k) * N + src] : 0.f; }
    __syncthreads();
#pragma unroll 4
    for (int i = 0; i < 16; ++i) { const int n = r + 4 * i; WT[(size_t)(n0 + n) * K + k0 + c] = f2bf(tile[c][n]); }
}
__global__ void k_rope_tab(float* tab) {
    const int i = blockIdx.x * blockDim.x + threadIdx.x; if (i >= SEQ * 8) return;
    const int pos = i >> 3, f = i & 7;
    const float inv = expf(-logf(500000.0f) * (float)f * (2.0f / 16.0f));
    const float ang = (float)pos * inv;
    tab[pos * 16 + f] = cosf(ang); tab[pos * 16 + 8 + f] = sinf(ang);
}
__global__ void __launch_bounds__(256) k_rmsnorm(const float* __restrict__ x, const float* __restrict__ g, bf16* __restrict__ H) {
    const int lane = threadIdx.x & 63, row = blockIdx.x * 4 + (threadIdx.x >> 6);
    const float4* xr = (const float4*)(x + (size_t)row * DM) + lane;
    float4 v[4]; float s = 0.f;
#pragma unroll
    for (int j = 0; j < 4; ++j) { v[j] = xr[64 * j]; s += v[j].x * v[j].x + v[j].y * v[j].y + v[j].z * v[j].z + v[j].w * v[j].w; }
    const float rstd = rsqrtf(wave_sum(s) * (1.f / DM) + EPS);
    uint2* o = (uint2*)(H + (size_t)row * DM) + lane;
#pragma unroll
    for (int j = 0; j < 4; ++j) { const float4 gg = ((const float4*)g)[lane + 64 * j];
        uint2 w; w.x = pg8::pk2bf(v[j].x * rstd * gg.x, v[j].y * rstd * gg.y); w.y = pg8::pk2bf(v[j].z * rstd * gg.z, v[j].w * rstd * gg.w); o[64 * j] = w; }
}

__global__ void __launch_bounds__(256) k_prep(bf16* __restrict__ P, const float* __restrict__ tab, const float* __restrict__ moba_g  ,
                                              const float* __restrict__ nsa_qg  , const float* __restrict__ nsa_kg  , float* __restrict__ kmean  ) {
    __shared__ float red[4][64];
    const int lane = threadIdx.x & 63, wid = threadIdx.x >> 6, tb = blockIdx.x, kind = blockIdx.y;
    int col; const float* g; bool rope;
    if (kind < 4) { col = C_BQ + kind * 64; g = moba_g; rope = true; }
    else if (kind < 8) { col = C_BK + (kind - 4) * 64; g = moba_g + 64; rope = true; }
    else if (kind < 12) { col = C_NQ + (kind - 8) * 64; g = nsa_qg; rope = false; }
    else if (kind == 12) { col = C_NKS; g = nsa_kg + 64; rope = true; }
    else { col = C_NKW; g = nsa_kg + 128; rope = true; }
    const float gd = g[lane];
    float ksum = 0.f;
    for (int i = 0; i < 64; ++i) {
        const int row = tb * 256 + wid * 64 + i, pos = row & (SEQ - 1);
        bf16* p = P + (size_t)row * DINP + col + lane;
        const float x = bf2f(*p);
        const float ss = wave_sum(x * x);
        float y = x * rsqrtf(ss * (1.f / 64.f) + EPS) * gd;
        if (rope) {
            const float other = __shfl_xor(y, 8);
            if (lane < 16) { const int f = lane & 7; const float c = tab[pos * 16 + f], s = tab[pos * 16 + 8 + f];
                y = (lane < 8) ? (y * c - other * s) : (y * c + other * s); }
        }
        *p = f2bf(y);
        ksum += y;
    }
    if (kind >= 4 && kind < 8) {
        red[wid][lane] = ksum; __syncthreads();
        if (wid == 0) { const float s = red[0][lane] + red[1][lane] + red[2][lane] + red[3][lane];
            const int b = tb >> 5, n = tb & 31; kmean[(((size_t)b * 4 + (kind - 4)) * 32 + n) * 64 + lane] = s * (1.f / 256.f); }
    }
}

__global__ void __launch_bounds__(128) k_compress(const bf16* __restrict__ P, const float* __restrict__ pe  , const float* __restrict__ w1  ,
                                                  const float* __restrict__ w2  , const float* __restrict__ kg0  , float* __restrict__ KVc  ) {
    __shared__ float in[2048]; __shared__ float hid[128]; __shared__ float outv[64];
    const int i = blockIdx.x, b = blockIdx.y, kv = blockIdx.z, tid = threadIdx.x;
    const int col = kv ? C_NVC : C_NKC;
    for (int e = tid; e < 2048; e += 128) { const int p = e >> 6, d = e & 63; in[e] = bf2f(P[(size_t)(b * SEQ + 16 * i + p) * DINP + col + d]) + pe[(kv * 32 + p) * 64 + d]; }
    __syncthreads();
    const float* w = w1 + (size_t)kv * 2048 * 128 + tid;
    float a = 0.f;
#pragma unroll 8
    for (int k = 0; k < 2048; ++k) a = fmaf(in[k], w[(size_t)k * 128], a);
    hid[tid] = a / (1.f + __expf(-a));
    __syncthreads();
    if (tid < 64) { const float* ww = w2 + (size_t)kv * 128 * 64 + tid; float o = 0.f;
#pragma unroll 8
        for (int j = 0; j < 128; ++j) o = fmaf(hid[j], ww[j * 64], o);
        if (kv == 0) { const float ss = wave_sum(o * o); o = o * rsqrtf(ss * (1.f / 64.f) + EPS) * kg0[tid]; }
        KVc[(((size_t)kv * NB + b) * 512 + i) * 64 + tid] = o; }
}

__device__ __forceinline__ float conv_silu(const bf16* __restrict__ P, const float* __restrict__ cw  , int rowbase, int t, int c) {
    float a = 0.f;
#pragma unroll
    for (int j = 0; j < 4; ++j) { const int tt = t - 3 + j; if (tt >= 0) a = fmaf(cw[j * 1024 + c], bf2f(P[(size_t)(rowbase + tt) * DINP + c]), a); }
    return a / (1.f + __expf(-a));
}
__global__ void __launch_bounds__(256) k_mlstm_local(const bf16* __restrict__ P, const float* __restrict__ G, const float* __restrict__ cw, const float* __restrict__ bif  ,
                                                     float* __restrict__ Cst  , float* __restrict__ nst  , float* __restrict__ dec  ) {
    __shared__ bf16 ks[64][128]; __shared__ bf16 vs[64][128]; __shared__ float wS[64]; __shared__ float lf[64];
    const int tid = threadIdx.x, u = blockIdx.x, c = u & 127, h = (u >> 7) & 3, b = u >> 9;
    const int rowbase = b * SEQ, t0 = c * 64;
    for (int e = tid; e < 64 * 128; e += 256) { const int s = e >> 7, d = e & 127;
        ks[s][d] = f2bf(conv_silu(P, cw, rowbase, t0 + s, 512 + h * 128 + d) * 0.08838834764831845f);
        vs[s][d] = P[(size_t)(rowbase + t0 + s) * DINP + C_MV + h * 128 + d]; }
    if (tid < 64) lf[tid] = log_sigmoidf_(G[(size_t)(rowbase + t0 + tid) * 32 + 4 + h] + bif[4 + h]);
    __syncthreads();
    if (tid == 0) { float acc = 0.f;
        for (int s = 0; s < 64; ++s) { acc += lf[s]; lf[s] = acc; }
        dec[u] = __expf(acc); }
    __syncthreads();
    if (tid < 64) wS[tid] = __expf(lf[63] - lf[tid] + G[(size_t)(rowbase + t0 + tid) * 32 + h] + bif[h]);
    __syncthreads();
    const int d = tid >> 1, e0 = (tid & 1) * 64;
    float acc[64];
#pragma unroll
    for (int e = 0; e < 64; ++e) acc[e] = 0.f;
    float an = 0.f;
    for (int s = 0; s < 64; ++s) { const float kw = wS[s] * bf2f(ks[s][d]); an += kw;
#pragma unroll
        for (int e = 0; e < 64; ++e) acc[e] = fmaf(kw, bf2f(vs[s][e0 + e]), acc[e]); }
    float* o = Cst + ((size_t)u * 128 + d) * 128 + e0;
#pragma unroll
    for (int e = 0; e < 64; ++e) o[e] = acc[e];
    if ((tid & 1) == 0) nst[(size_t)u * 128 + d] = an;
}
__global__ void __launch_bounds__(256) k_mlstm_scan(float* __restrict__ Cst, float* __restrict__ nst, const float* __restrict__ dec) {
    const int bh = blockIdx.x / 65, part = blockIdx.x % 65, tid = threadIdx.x;
    float* base; int stride;
    if (part < 64) { base = Cst + (size_t)bh * 128 * 16384 + part * 256 + tid; stride = 16384; }
    else { if (tid >= 128) return; base = nst + (size_t)bh * 128 * 128 + tid; stride = 128; }
    float C = 0.f;
    for (int c = 0; c < 128; ++c) { const float dC = base[(size_t)c * stride]; base[(size_t)c * stride] = C; C = dec[bh * 128 + c] * C + dC; }
}
__global__ void __launch_bounds__(256) k_mlstm_out(const bf16* __restrict__ P, const float* __restrict__ G, const float* __restrict__ cw, const float* __restrict__ bif,
                                                   const float* __restrict__ Cst, const float* __restrict__ nst, const float* __restrict__ mnorm  , bf16* __restrict__ MIX) {
    __shared__ bf16 qs[64][128]; __shared__ float ksS[64 * 64];   __shared__ bf16 vs[64][128];
    __shared__ float bb[64]; __shared__ float li[64];
    bf16 (*ks)[128] = (bf16 (*)[128])ksS;
    const int tid = threadIdx.x, u = blockIdx.x, c = u & 127, h = (u >> 7) & 3, b = u >> 9;
    const int rowbase = b * SEQ, t0 = c * 64;
    for (int e = tid; e < 64 * 128; e += 256) { const int s = e >> 7, d = e & 127;
        qs[s][d] = f2bf(conv_silu(P, cw, rowbase, t0 + s, h * 128 + d));
        ks[s][d] = f2bf(conv_silu(P, cw, rowbase, t0 + s, 512 + h * 128 + d) * 0.08838834764831845f);
        vs[s][d] = P[(size_t)(rowbase + t0 + s) * DINP + C_MV + h * 128 + d]; }
    if (tid < 64) { bb[tid] = log_sigmoidf_(G[(size_t)(rowbase + t0 + tid) * 32 + 4 + h] + bif[4 + h]); li[tid] = G[(size_t)(rowbase + t0 + tid) * 32 + h] + bif[h]; }
    __syncthreads();
    if (tid == 0) { float acc = 0.f; for (int s = 0; s < 64; ++s) { acc += bb[s]; bb[s] = acc; } }
    __syncthreads();
    const int t = tid >> 2, part = tid & 3;
    float sreg[16];
    {
        const int s0 = part * 16;
#pragma unroll
        for (int j = 0; j < 16; ++j) { const int s = s0 + j; float a = 0.f;
            if (s <= t) { for (int d = 0; d < 128; ++d) a = fmaf(bf2f(qs[t][d]), bf2f(ks[s][d]), a); a *= __expf(bb[t] - bb[s] + li[s]); }
            sreg[j] = a; }
    }
    __syncthreads();
    float* S = ksS;
#pragma unroll
    for (int j = 0; j < 16; ++j) S[t * 64 + part * 16 + j] = sreg[j];
    __syncthreads();
    const float Ft = __expf(bb[t]);
    float den = 0.f;
    for (int s = 0; s <= t; ++s) den += S[t * 64 + s];
    { const float* np = nst + (size_t)u * 128; float a = 0.f; for (int d = 0; d < 128; ++d) a = fmaf(bf2f(qs[t][d]), np[d], a); den += Ft * a; }
    const int e0 = part * 32;
    float acc[32];
#pragma unroll
    for (int e = 0; e < 32; ++e) acc[e] = 0.f;
    { const float* Cp = Cst + (size_t)u * 16384 + e0;
      for (int d = 0; d < 128; ++d) { const float qd = bf2f(qs[t][d]);
#pragma unroll
          for (int e = 0; e < 32; ++e) acc[e] = fmaf(qd, Cp[d * 128 + e], acc[e]); } }
#pragma unroll
    for (int e = 0; e < 32; ++e) acc[e] *= Ft;
    for (int s = 0; s <= t; ++s) { const float w = S[t * 64 + s];
#pragma unroll
        for (int e = 0; e < 32; ++e) acc[e] = fmaf(w, bf2f(vs[s][e0 + e]), acc[e]); }
    const float inv = 1.f / fmaxf(fabsf(den), 1.f);
    float ss = 0.f;
#pragma unroll
    for (int e = 0; e < 32; ++e) { acc[e] *= inv; ss += acc[e] * acc[e]; }
    ss += __shfl_xor(ss, 1); ss += __shfl_xor(ss, 2);
    const float rstd = rsqrtf(ss * (1.f / 128.f) + EPS);
    const size_t row = (size_t)(rowbase + t0 + t);
#pragma unroll
    for (int e = 0; e < 32; ++e) { const int cc = h * 128 + e0 + e;
        const float o = sigmoidf_(bf2f(P[row * DINP + C_MO + cc]));
        MIX[row * DM + cc] = f2bf(acc[e] * rstd * mnorm[cc] * o); }
}

__global__ void __launch_bounds__(256) k_moba(const bf16* __restrict__ P, const float* __restrict__ kmean, bf16* __restrict__ MIX) {
    __shared__ float qsh[4][64];
    const int lane = threadIdx.x & 63, wid = threadIdx.x >> 6, gw = blockIdx.x * 4 + wid;
    const int bh = gw >> 13, tq = gw & (SEQ - 1), b = bh >> 2, h = bh & 3, own = tq >> 8;
    const size_t row = (size_t)b * SEQ + tq;
    qsh[wid][lane] = bf2f(P[row * DINP + C_BQ + h * 64 + lane]);
    __builtin_amdgcn_s_waitcnt(0); __builtin_amdgcn_wave_barrier();
    const float* q = qsh[wid];
    float gs = -3.0e38f;
    if (lane < 32) { if (lane < own) { const float* km = kmean + (((size_t)b * 4 + h) * 32 + lane) * 64; float a = 0.f; for (int d = 0; d < 64; ++d) a = fmaf(q[d], km[d], a); gs = a; } else gs = -1e30f; }
    int blk[4]; bool val[4];
#pragma unroll
    for (int r = 0; r < 3; ++r) { const float m = wave_max(gs); const unsigned long long bal = __ballot(gs == m); const int idx = __ffsll((long long)bal) - 1;
        blk[r] = idx; val[r] = (r < own); if (lane == idx) gs = -3.0e38f; }
    blk[3] = own; val[3] = true;
    float s[4][4]; float mx = -1e30f;
#pragma unroll
    for (int g = 0; g < 4; ++g)
#pragma unroll
        for (int i = 0; i < 4; ++i) { float a = -1e30f;
            if (val[g]) { const int pos = blk[g] * 256 + i * 64 + lane;
                if (g < 3 || pos <= tq) { const bf16* kp = P + ((size_t)b * SEQ + pos) * DINP + C_BK + h * 64; a = dot64(kp, q) * 0.125f; } }
            s[g][i] = a; mx = fmaxf(mx, a); }
    mx = wave_max(mx);
    float l = 0.f;
#pragma unroll
    for (int g = 0; g < 4; ++g)
#pragma unroll
        for (int i = 0; i < 4; ++i) { const float p = (s[g][i] > -1e29f) ? __expf(s[g][i] - mx) : 0.f; s[g][i] = p; l += p; }
    l = wave_sum(l);
    float o = 0.f;
#pragma unroll
    for (int g = 0; g < 4; ++g) { if (!val[g]) continue;
#pragma unroll
        for (int i = 0; i < 4; ++i) { const bf16* vp = P + ((size_t)b * SEQ + blk[g] * 256 + i * 64) * DINP + C_BV + h * 64 + lane;
            for (int src = 0; src < 64; ++src) { const float p = __shfl(s[g][i], src); o = fmaf(p, bf2f(vp[(size_t)src * DINP]), o); } } }
    MIX[row * DM + 512 + h * 64 + lane] = f2bf(o / l);
}

__global__ void __launch_bounds__(256) k_nsa(const bf16* __restrict__ P, const float* __restrict__ G, const float* __restrict__ tab, const float* __restrict__ KVc, bf16* __restrict__ MIX) {
    __shared__ float qn_s[4][4][64]; __shared__ float qr_s[4][4][64]; __shared__ float ps_s[4][516];
    const int lane = threadIdx.x & 63, wid = threadIdx.x >> 6, gw = blockIdx.x * 4 + wid;
    const int b = gw >> 13, tq = gw & (SEQ - 1), blkq = tq >> 6;
    const size_t row = (size_t)b * SEQ + tq;
#pragma unroll
    for (int h = 0; h < 4; ++h) { const float x = bf2f(P[row * DINP + C_NQ + h * 64 + lane]); qn_s[wid][h][lane] = x;
        float y = x; const float other = __shfl_xor(x, 8);
        if (lane < 16) { const int f = lane & 7; const float c = tab[tq * 16 + f], s = tab[tq * 16 + 8 + f]; y = (lane < 8) ? (x * c - other * s) : (x * c + other * s); }
        qr_s[wid][h][lane] = y; }
    __builtin_amdgcn_s_waitcnt(0); __builtin_amdgcn_wave_barrier();
    const float (*qn)[64] = qn_s[wid]; const float (*qr)[64] = qr_s[wid]; float* ps = ps_s[wid];
    const float* Kc = KVc + (size_t)b * 512 * 64; const float* Vc = KVc + ((size_t)NB + b) * 512 * 64;
    float out[4] = {0.f, 0.f, 0.f, 0.f};
    float gate[3][4];
#pragma unroll
    for (int br = 0; br < 3; ++br)
#pragma unroll
        for (int h = 0; h < 4; ++h) gate[br][h] = sigmoidf_(G[row * 32 + 8 + br * 4 + h]);
    const int ncv = (tq >= 31) ? ((tq - 31) >> 4) + 1 : 0;
    {
        float sc[8][4]; float mx[4] = {-1e30f, -1e30f, -1e30f, -1e30f};
#pragma unroll
        for (int i = 0; i < 8; ++i) { const int c = i * 64 + lane;
            float a[4] = {-1e30f, -1e30f, -1e30f, -1e30f};
            if (c < ncv) { const float* kp = Kc + (size_t)c * 64; a[0] = a[1] = a[2] = a[3] = 0.f;
                for (int d = 0; d < 64; ++d) { const float kd = kp[d]; a[0] = fmaf(qn[0][d], kd, a[0]); a[1] = fmaf(qn[1][d], kd, a[1]); a[2] = fmaf(qn[2][d], kd, a[2]); a[3] = fmaf(qn[3][d], kd, a[3]); }
#pragma unroll
                for (int h = 0; h < 4; ++h) a[h] *= 0.125f; }
#pragma unroll
            for (int h = 0; h < 4; ++h) { sc[i][h] = a[h]; mx[h] = fmaxf(mx[h], a[h]); } }
        float l[4];
#pragma unroll
        for (int h = 0; h < 4; ++h) { mx[h] = wave_max(mx[h]); l[h] = 0.f; }
#pragma unroll
        for (int i = 0; i < 8; ++i) { const int c = i * 64 + lane;
#pragma unroll
            for (int h = 0; h < 4; ++h) { const float p = (c < ncv) ? __expf(sc[i][h] - mx[h]) : 0.f; sc[i][h] = p; l[h] += p; } }
#pragma unroll
        for (int h = 0; h < 4; ++h) { l[h] = wave_sum(l[h]); l[h] = (l[h] > 0.f) ? 1.f / l[h] : 0.f; }
#pragma unroll
        for (int i = 0; i < 8; ++i) { float su = 0.f;
#pragma unroll
            for (int h = 0; h < 4; ++h) { sc[i][h] *= l[h]; su += sc[i][h]; }
            ps[i * 64 + lane] = su; }
        if (lane < 4) ps[512 + lane] = 0.f;
        float oc[4] = {0.f, 0.f, 0.f, 0.f};
#pragma unroll
        for (int i = 0; i < 8; ++i) { if (i * 64 >= ncv) break; const int nn = min(64, ncv - i * 64);
            for (int src = 0; src < nn; ++src) { const float v = Vc[(size_t)(i * 64 + src) * 64 + lane];
                oc[0] = fmaf(__shfl(sc[i][0], src), v, oc[0]); oc[1] = fmaf(__shfl(sc[i][1], src), v, oc[1]);
                oc[2] = fmaf(__shfl(sc[i][2], src), v, oc[2]); oc[3] = fmaf(__shfl(sc[i][3], src), v, oc[3]); } }
#pragma unroll
        for (int h = 0; h < 4; ++h) out[h] = gate[0][h] * oc[h];
    }
    __builtin_amdgcn_s_waitcnt(0); __builtin_amdgcn_wave_barrier();
    int sidx[16];
    {
        float v0, v1;
        { const int n = lane; float im = 0.f;
#pragma unroll
          for (int j = -1; j < 4; ++j) { const int c = 4 * n + j; if (c >= 0 && c < NCMP) im += ps[c]; }
          const bool causal = n <= blkq, forced = causal && (n == 0 || n >= blkq - 1);
          v0 = forced ? 1e9f : (causal ? im : -1e30f); }
        { const int n = lane + 64; float im = 0.f;
#pragma unroll
          for (int j = -1; j < 4; ++j) { const int c = 4 * n + j; if (c >= 0 && c < NCMP) im += ps[c]; }
          const bool causal = n <= blkq, forced = causal && (n == 0 || n >= blkq - 1);
          v1 = forced ? 1e9f : (causal ? im : -1e30f); }
#pragma unroll
        for (int k = 0; k < 16; ++k) { const float m = wave_max(fmaxf(v0, v1));
            const unsigned long long b0 = __ballot(v0 == m); int idx;
            if (b0) { idx = __ffsll((long long)b0) - 1; if (lane == idx) v0 = -3.0e38f; }
            else { const unsigned long long b1 = __ballot(v1 == m); idx = __ffsll((long long)b1) - 1; if (lane == idx) v1 = -3.0e38f; idx += 64; }
            sidx[k] = idx; }
    }
    {
        float sc[16][4]; float mx[4] = {-1e30f, -1e30f, -1e30f, -1e30f};
#pragma unroll
        for (int k = 0; k < 16; ++k) { const int n = sidx[k], pos = n * 64 + lane;
            float a[4] = {-1e30f, -1e30f, -1e30f, -1e30f};
            if (n <= blkq && pos <= tq) { const bf16* kp = P + ((size_t)b * SEQ + pos) * DINP + C_NKS; dot64x4(kp, qr, a);
#pragma unroll
                for (int h = 0; h < 4; ++h) a[h] *= 0.125f; }
#pragma unroll
            for (int h = 0; h < 4; ++h) { sc[k][h] = a[h]; mx[h] = fmaxf(mx[h], a[h]); } }
        float l[4];
#pragma unroll
        for (int h = 0; h < 4; ++h) { mx[h] = wave_max(mx[h]); l[h] = 0.f; }
#pragma unroll
        for (int k = 0; k < 16; ++k)
#pragma unroll
            for (int h = 0; h < 4; ++h) { const float p = (sc[k][h] > -1e29f) ? __expf(sc[k][h] - mx[h]) : 0.f; sc[k][h] = p; l[h] += p; }
#pragma unroll
        for (int h = 0; h < 4; ++h) l[h] = 1.f / wave_sum(l[h]);
        float os[4] = {0.f, 0.f, 0.f, 0.f};
#pragma unroll
        for (int k = 0; k < 16; ++k) { const int n = sidx[k]; if (n > blkq) continue;
            const bf16* vp = P + ((size_t)b * SEQ + n * 64) * DINP + C_NVS + lane;
            for (int src = 0; src < 64; ++src) { const float v = bf2f(vp[(size_t)src * DINP]);
                os[0] = fmaf(__shfl(sc[k][0], src), v, os[0]); os[1] = fmaf(__shfl(sc[k][1], src), v, os[1]);
                os[2] = fmaf(__shfl(sc[k][2], src), v, os[2]); os[3] = fmaf(__shfl(sc[k][3], src), v, os[3]); } }
#pragma unroll
        for (int h = 0; h < 4; ++h) out[h] += gate[1][h] * os[h] * l[h];
    }
    {
        float sc[8][4]; float mx[4] = {-1e30f, -1e30f, -1e30f, -1e30f};
#pragma unroll
        for (int i = 0; i < 8; ++i) { const int pos = tq - 511 + i * 64 + lane;
            float a[4] = {-1e30f, -1e30f, -1e30f, -1e30f};
            if (pos >= 0) { const bf16* kp = P + ((size_t)b * SEQ + pos) * DINP + C_NKW; dot64x4(kp, qr, a);
#pragma unroll
                for (int h = 0; h < 4; ++h) a[h] *= 0.125f; }
#pragma unroll
            for (int h = 0; h < 4; ++h) { sc[i][h] = a[h]; mx[h] = fmaxf(mx[h], a[h]); } }
        float l[4];
#pragma unroll
        for (int h = 0; h < 4; ++h) { mx[h] = wave_max(mx[h]); l[h] = 0.f; }
#pragma unroll
        for (int i = 0; i < 8; ++i)
#pragma unroll
            for (int h = 0; h < 4; ++h) { const float p = (sc[i][h] > -1e29f) ? __expf(sc[i][h] - mx[h]) : 0.f; sc[i][h] = p; l[h] += p; }
#pragma unroll
        for (int h = 0; h < 4; ++h) l[h] = 1.f / wave_sum(l[h]);
        float ow[4] = {0.f, 0.f, 0.f, 0.f};
#pragma unroll
        for (int i = 0; i < 8; ++i) { const int p0 = tq - 511 + i * 64; if (p0 + 63 < 0) continue;
            const int s0 = p0 < 0 ? -p0 : 0;
            for (int src = s0; src < 64; ++src) { const float v = bf2f(P[((size_t)b * SEQ + p0 + src) * DINP + C_NVW + lane]);
                ow[0] = fmaf(__shfl(sc[i][0], src), v, ow[0]); ow[1] = fmaf(__shfl(sc[i][1], src), v, ow[1]);
                ow[2] = fmaf(__shfl(sc[i][2], src), v, ow[2]); ow[3] = fmaf(__shfl(sc[i][3], src), v, ow[3]); } }
#pragma unroll
        for (int h = 0; h < 4; ++h) out[h] += gate[2][h] * ow[h] * l[h];
    }
#pragma unroll
    for (int h = 0; h < 4; ++h) MIX[row * DM + 768 + h * 64 + lane] = f2bf(out[h]);
}

__global__ void __launch_bounds__(512, 2) k_gemm_proj(const bf16* A, const bf16* Bt, bf16* O, float* gates) {
    extern __shared__ __attribute__((aligned(16))) unsigned char lds[];
    pg8::Gemm g{A, Bt, T, DINP, DM}; pg8::StaticOrder S; S.init(T, DINP, gridDim.x, blockIdx.x);
    pg8::EpiProj E{O, DINP, gates, C_GATE};
    pg8::gemm_phase<pg8::EpiProj, pg8::StaticOrder, true, true>((PG8_LAS unsigned char*)lds, g, S, E);
}
__global__ void __launch_bounds__(512, 2) k_gemm_up(const bf16* A, const bf16* Bt, bf16* O) {
    extern __shared__ __attribute__((aligned(16))) unsigned char lds[];
    pg8::Gemm g{A, Bt, T, DFF, DM}; pg8::StaticOrder S; S.init(T, DFF, gridDim.x, blockIdx.x);
    pg8::EpiRelu2 E{O, DFF};
    pg8::gemm_phase<pg8::EpiRelu2, pg8::StaticOrder, true, true>((PG8_LAS unsigned char*)lds, g, S, E);
}
__global__ void __launch_bounds__(512, 2) k_gemm_resid(const bf16* A, const bf16* Bt, int K, const float* base, float* out) {
    extern __shared__ __attribute__((aligned(16))) unsigned char lds[];
    pg8::Gemm g{A, Bt, T, DM, K}; pg8::StaticOrder S; S.init(T, DM, gridDim.x, blockIdx.x);
    pg8::EpiResid E{base, out, DM};
    pg8::gemm_phase<pg8::EpiResid, pg8::StaticOrder, true, true>((PG8_LAS unsigned char*)lds, g, S, E);
}

constexpr size_t MiB = 1u << 20;
constexpr size_t W_LAYER = (size_t)(DINP + DM + DFF) * DM + (size_t)DM * DFF;
constexpr size_t WS_W = 0;
constexpr size_t WS_HM = 52 * MiB;
constexpr size_t WS_G = 116 * MiB;
constexpr size_t WS_SMALL = 120 * MiB;
constexpr size_t WS_TAB = WS_SMALL, WS_KMEAN = WS_SMALL + 512 * 1024, WS_KVC = WS_SMALL + 1 * MiB, WS_NST = WS_SMALL + 2 * MiB, WS_DEC = WS_SMALL + 3 * MiB;
constexpr size_t WS_P = 124 * MiB;
constexpr size_t WS_C = 348 * MiB;
constexpr size_t WS_U = WS_P;
constexpr size_t WS_END = 476 * MiB;
static_assert(W_LAYER * 2 * DEPTH <= 52 * MiB, "weights");
static_assert((size_t)T * DINP * 2 == 224 * MiB && (size_t)T * DFF * 2 == 256 * MiB, "sizes");

extern "C" void kernel_launch(void* const* d_in, const int* in_sizes, int n_in, void* d_out, int out_size, void* d_ws, size_t ws_size, hipStream_t stream) {
    static int ok = 0;
    if (ok == 0) {
        ok = 1;
        if (n_in != 16 || in_sizes[0] != T * DM || out_size != T * DM || ws_size < WS_END) { fprintf(stderr, "kernel_launch: unexpected shapes / workspace %zu < %zu\n", ws_size, (size_t)WS_END); ok = -1; }
        if (hipFuncSetAttribute((const void*)k_gemm_proj, hipFuncAttributeMaxDynamicSharedMemorySize, 131072) != hipSuccess) ok = -1;
        if (hipFuncSetAttribute((const void*)k_gemm_up, hipFuncAttributeMaxDynamicSharedMemorySize, 131072) != hipSuccess) ok = -1;
        if (hipFuncSetAttribute((const void*)k_gemm_resid, hipFuncAttributeMaxDynamicSharedMemorySize, 131072) != hipSuccess) ok = -1;
    }
    if (ok < 0) return;
    const float* x = (const float*)d_in[0]; const float* w_in = (const float*)d_in[1]; const float* b_if = (const float*)d_in[2]; const float* conv_qk = (const float*)d_in[3];
    const float* m_norm = (const float*)d_in[4]; const float* moba_qk = (const float*)d_in[5]; const float* nsa_qn = (const float*)d_in[6]; const float* nsa_kn = (const float*)d_in[7];
    const float* cmp_pe = (const float*)d_in[8]; const float* cmp_w1 = (const float*)d_in[9]; const float* cmp_w2 = (const float*)d_in[10]; const float* w_out = (const float*)d_in[11];
    const float* norm_mix = (const float*)d_in[12]; const float* norm_ffn = (const float*)d_in[13]; const float* w_ff1 = (const float*)d_in[14]; const float* w_ff2 = (const float*)d_in[15];
    unsigned char* ws = (unsigned char*)d_ws; float* out = (float*)d_out;
    bf16* Wb = (bf16*)(ws + WS_W); bf16* HM = (bf16*)(ws + WS_HM); float* G = (float*)(ws + WS_G); float* tab = (float*)(ws + WS_TAB); float* kmean = (float*)(ws + WS_KMEAN);
    float* KVc = (float*)(ws + WS_KVC); float* nst = (float*)(ws + WS_NST); float* dec = (float*)(ws + WS_DEC); bf16* P = (bf16*)(ws + WS_P); float* Cst = (float*)(ws + WS_C); bf16* U = (bf16*)(ws + WS_U);
    for (int l = 0; l < DEPTH; ++l) {
        bf16* WinT = Wb + l * W_LAYER; bf16* WoT = WinT + (size_t)DINP * DM; bf16* W1T = WoT + (size_t)DM * DM; bf16* W2T = W1T + (size_t)DFF * DM;
        k_convert_w<<<dim3(DINP / 64, DM / 64), 256, 0, stream>>>(w_in + (size_t)l * DM * DIN, DM, DIN, DINP, WinT, 1);
        k_convert_w<<<dim3(DM / 64, DM / 64), 256, 0, stream>>>(w_out + (size_t)l * DM * DM, DM, DM, DM, WoT, 0);
        k_convert_w<<<dim3(DFF / 64, DM / 64), 256, 0, stream>>>(w_ff1 + (size_t)l * DM * DFF, DM, DFF, DFF, W1T, 0);
        k_convert_w<<<dim3(DM / 64, DFF / 64), 256, 0, stream>>>(w_ff2 + (size_t)l * DFF * DM, DFF, DM, DM, W2T, 0);
    }
    k_rope_tab<<<SEQ * 8 / 256, 256, 0, stream>>>(tab);
    for (int l = 0; l < DEPTH; ++l) {
        const bf16* WinT = Wb + l * W_LAYER; const bf16* WoT = WinT + (size_t)DINP * DM; const bf16* W1T = WoT + (size_t)DM * DM; const bf16* W2T = W1T + (size_t)DFF * DM;
        const float* xin = l == 0 ? x : out;
        k_rmsnorm<<<T / 4, 256, 0, stream>>>(xin, norm_mix + l * DM, HM);
        k_gemm_proj<<<256, 512, 131072, stream>>>(HM, WinT, P, G);
        k_prep<<<dim3(T / 256, 14), 256, 0, stream>>>(P, tab, moba_qk + l * 128, nsa_qn + l * 64, nsa_kn + l * 192, kmean);
        k_compress<<<dim3(NCMP, NB, 2), 128, 0, stream>>>(P, cmp_pe + (size_t)l * 2 * 32 * 64, cmp_w1 + (size_t)l * 2 * 2048 * 128, cmp_w2 + (size_t)l * 2 * 128 * 64, nsa_kn + l * 192, KVc);
        k_mlstm_local<<<2048, 256, 0, stream>>>(P, G, conv_qk + (size_t)l * 4 * 1024, b_if + l * 8, Cst, nst, dec);
        k_mlstm_scan<<<16 * 65, 256, 0, stream>>>(Cst, nst, dec);
        k_mlstm_out<<<2048, 256, 0, stream>>>(P, G, conv_qk + (size_t)l * 4 * 1024, b_if + l * 8, Cst, nst, m_norm + l * 512, HM);
        k_moba<<<NB * 4 * SEQ / 4, 256, 0, stream>>>(P, kmean, HM);
        k_nsa<<<NB * SEQ / 4, 256, 0, stream>>>(P, G, tab, KVc, HM);
        k_gemm_resid<<<256, 512, 131072, stream>>>(HM, WoT, DM, xin, out);
        k_rmsnorm<<<T / 4, 256, 0, stream>>>(out, norm_ffn + l * DM, HM);
        k_gemm_up<<<256, 512, 131072, stream>>>(HM, W1T, U);
        k_gemm_resid<<<256, 512, 131072, stream>>>(U, W2T, DFF, out, out);
    }
}
```

```cpp
#include <hip/hip_runtime.h>
#include <hip/hip_cooperative_groups.h>
#include <cstdio>
#include <cstdint>
namespace cg = cooperative_groups;
namespace pg8 {
#define PG8_LAS __attribute__((address_space(3)))
typedef unsigned short bf16_t;
typedef short bf16x8 __attribute__((ext_vector_type(8)));
typedef float f32x4 __attribute__((ext_vector_type(4)));
typedef unsigned u32x4 __attribute__((ext_vector_type(4)));
constexpr int BM = 256, BK = 64, HALF = 128, HTB = HALF * BK * 2  , STAGE_BYTES = 8 * HTB, NXCD = 8, WGM = 8;

__host__ __device__ __forceinline__ int lds_byte(int r, int c) { const int st = (r >> 4) * 2 + (c >> 5), rr = r & 15, cc = c & 31, ob = rr * 64 + cc * 2; return st * 1024 + (ob ^ (((ob >> 9) & 1) << 5)); }
__host__ __device__ __forceinline__ void stage_rc(int b, int& R, int& C) { const int st = b / 1024, sb = b % 1024, swz = sb ^ (((sb >> 9) & 1) << 5); R = (st >> 1) * 16 + swz / 64; C = (st & 1) * 32 + (swz % 64) / 2; }
__host__ __device__ __forceinline__ int perm32(int rho) { const int n = rho >> 4, i = rho & 15; return 8 * (i >> 2) + 4 * n + (i & 3); }

struct Unit { int pm, pn; };
struct Gemm { const bf16_t* A; const bf16_t* Bt; int M, N, K; };

struct StaticOrder {
    int nM, nN, nwg, G, c;
    __host__ __device__ void init(int M, int N, int G_, int c_) { nM = M / BM; nN = N / BM; nwg = nM * nN; G = G_; c = c_; }
    __host__ __device__ bool next(int i, Unit& u) const {
        const long L = (long)i * G + c; if (L >= nwg) return false;
        int wgid = (int)L; { const int q = nwg / NXCD, r = nwg % NXCD, xcd = wgid % NXCD, off = wgid / NXCD; wgid = (xcd < r ? xcd * (q + 1) : r * (q + 1) + (xcd - r) * q) + off; }
        const int nig = WGM * nN, gid = wgid / nig, fm = gid * WGM, gsz = (nM - fm) < WGM ? (nM - fm) : WGM;
        u.pm = fm + ((wgid % nig) % gsz); u.pn = (wgid % nig) / gsz; return true;
    }
    __device__ __forceinline__ void a_ready(const Unit&) const {}
    __device__ __forceinline__ void done(const Unit&) const {}
};

__device__ __forceinline__ unsigned f2bf_u(float f) { unsigned u = __builtin_bit_cast(unsigned, f); return (u + 0x7fffu + ((u >> 16) & 1u)) >> 16; }
__device__ __forceinline__ unsigned pk2bf(float lo, float hi) { return f2bf_u(lo) | (f2bf_u(hi) << 16); }

struct EpiProj {
    static constexpr bool PERM = true, AFTER_DRAIN = false;
    bf16_t* O; int ldc; float* gates; int gate0;
    __device__ __forceinline__ void operator()(const f32x4 (&acc)[2][2][4][2], const Unit& u, int wr, int wc, int fr, int fq) const {
        const int row0 = u.pm * BM + wr * 64 + fr; const int col0 = u.pn * BM + wc * 32 + 8 * fq;
#pragma unroll
        for (int ai = 0; ai < 2; ++ai)
#pragma unroll
            for (int m = 0; m < 4; ++m) { const int row = row0 + ai * HALF + m * 16; bf16_t* rowp = O + (size_t)row * ldc + col0;
#pragma unroll
                for (int bj = 0; bj < 2; ++bj) { const f32x4 v0 = acc[ai][bj][m][0], v1 = acc[ai][bj][m][1];
                    u32x4 w; w.x = pk2bf(v0[0], v0[1]); w.y = pk2bf(v0[2], v0[3]); w.z = pk2bf(v1[0], v1[1]); w.w = pk2bf(v1[2], v1[3]);
                    *(u32x4*)(rowp + bj * HALF) = w;
                    const int c = col0 + bj * HALF - gate0;
                    if (c >= 0 && c < 32) { float* g = gates + (size_t)row * 32 + c; *(f32x4*)g = v0; *(f32x4*)(g + 4) = v1; } } }
    }
};
struct EpiRelu2 {
    static constexpr bool PERM = true, AFTER_DRAIN = false;
    bf16_t* O; int ldc;
    __device__ __forceinline__ void operator()(const f32x4 (&acc)[2][2][4][2], const Unit& u, int wr, int wc, int fr, int fq) const {
        const int row0 = u.pm * BM + wr * 64 + fr; const int col0 = u.pn * BM + wc * 32 + 8 * fq;
#pragma unroll
        for (int ai = 0; ai < 2; ++ai)
#pragma unroll
            for (int m = 0; m < 4; ++m) { const int row = row0 + ai * HALF + m * 16; bf16_t* rowp = O + (size_t)row * ldc + col0;
#pragma unroll
                for (int bj = 0; bj < 2; ++bj) { f32x4 v0 = acc[ai][bj][m][0], v1 = acc[ai][bj][m][1];
#pragma unroll
                    for (int e = 0; e < 4; ++e) { float a = v0[e] > 0.f ? v0[e] : 0.f; v0[e] = a * a; float b = v1[e] > 0.f ? v1[e] : 0.f; v1[e] = b * b; }
                    u32x4 w; w.x = pk2bf(v0[0], v0[1]); w.y = pk2bf(v0[2], v0[3]); w.z = pk2bf(v1[0], v1[1]); w.w = pk2bf(v1[2], v1[3]);
                    *(u32x4*)(rowp + bj * HALF) = w; } }
    }
};
struct EpiResid {
    static constexpr bool PERM = false, AFTER_DRAIN = false;
    const float* base; float* out; int ldc;
    __device__ __forceinline__ void operator()(const f32x4 (&acc)[2][2][4][2], const Unit& u, int wr, int wc, int fr, int fq) const {
        const int row0 = u.pm * BM + wr * 64 + fr; const int col0 = u.pn * BM + wc * 32 + 4 * fq;
#pragma unroll
        for (int ai = 0; ai < 2; ++ai)
#pragma unroll
            for (int m = 0; m < 4; ++m) { const size_t off = (size_t)(row0 + ai * HALF + m * 16) * ldc + col0;
#pragma unroll
                for (int bj = 0; bj < 2; ++bj)
#pragma unroll
                    for (int n = 0; n < 2; ++n) { const size_t o = off + bj * HALF + n * 16; const f32x4 b = *(const f32x4*)(base + o); *(f32x4*)(out + o) = b + acc[ai][bj][m][n]; } }
    }
};

struct EpiAny {
    static constexpr bool AFTER_DRAIN = false;
    int kind; bool perm;
    bf16_t* O; int ldc; float* gates; int gate0; const float* base; float* out;
    __device__ __forceinline__ void operator()(const f32x4 (&acc)[2][2][4][2], const Unit& u, int wr, int wc, int fr, int fq) const {
        if (kind == 0) { EpiProj e{O, ldc, gates, gate0}; e(acc, u, wr, wc, fr, fq); }
        else if (kind == 1) { EpiRelu2 e{O, ldc}; e(acc, u, wr, wc, fr, fq); }
        else { EpiResid e{base, out, ldc}; e(acc, u, wr, wc, fr, fq); }
    }
};
template <class Epi, class Sched, bool ALIGN_EPI = false, bool SP2 = false>
__device__ __forceinline__ void gemm_phase(PG8_LAS unsigned char* lds, const Gemm g, const Sched& S, const Epi& E, const int tid) {
    const int wid = __builtin_amdgcn_readfirstlane(tid >> 6), lane = tid & 63, wr = wid >> 2, wc = wid & 3, fr = lane & 15, fq = lane >> 4;
    const int K = g.K, nt = K / BK;
    unsigned voffA[2], voffB[2];
#pragma unroll
    for (int i = 0; i < 2; ++i) { int R, C; stage_rc(tid * 16 + i * 8192, R, C); const int Rb = E.perm ? ((R & ~31) + perm32(R & 31)) : R;
        voffA[i] = (unsigned)(R * K + C) * 2u; voffB[i] = (unsigned)(Rb * K + C) * 2u; }
    const size_t kstep = (size_t)(BK * 2);
    const size_t hstep = (size_t)HALF * K * 2;
    const size_t tstep = 2 * hstep;
    const unsigned ldsw = (unsigned)wid * 1024u;
    const int aoff = lds_byte(wr * 64 + fr, fq * 8), boff = lds_byte(wc * 32 + fr, fq * 8);
#define PG8_SA(b, h) (((b) * 2 + (h)) * HTB)
#define PG8_SB(b, h) ((4 + (b) * 2 + (h)) * HTB)
#define PG8_STAGE(bufoff, gbase, voff) do { _Pragma("unroll") for (int _i = 0; _i < 2; ++_i) \
        __builtin_amdgcn_global_load_lds((const unsigned*)((const char*)(gbase) + (voff)[_i]), (PG8_LAS unsigned*)(lds + (bufoff) + ldsw + _i * 8192), 16, 0, 0); } while (0)
#define PG8_LDA(dst, b, h) do { _Pragma("unroll") for (int m = 0; m < 4; ++m) _Pragma("unroll") for (int k = 0; k < 2; ++k) dst[m][k] = *(const PG8_LAS bf16x8*)(lds + PG8_SA(b, h) + aoff + m * 2048 + k * 1024); } while (0)
#define PG8_LDB(dst, b, h) do { _Pragma("unroll") for (int n = 0; n < 2; ++n) _Pragma("unroll") for (int k = 0; k < 2; ++k) dst[n][k] = *(const PG8_LAS bf16x8*)(lds + PG8_SB(b, h) + boff + n * 2048 + k * 1024); } while (0)
#define PG8_MMA(ai, bj, At, Bt) do { __builtin_amdgcn_s_setprio(1); _Pragma("unroll") for (int m = 0; m < 4; ++m) _Pragma("unroll") for (int n = 0; n < 2; ++n) _Pragma("unroll") for (int k = 0; k < 2; ++k) \
        acc[ai][bj][m][n] = __builtin_amdgcn_mfma_f32_16x16x32_bf16(Bt[n][k], At[m][k], acc[ai][bj][m][n], 0, 0, 0); __builtin_amdgcn_s_setprio(0); } while (0)
#define PG8_WAIT_V(n) asm volatile("s_waitcnt vmcnt(" #n ")" ::: "memory")
#define PG8_WAIT_L(n) asm volatile("s_waitcnt lgkmcnt(" #n ")" ::: "memory")
#define PG8_BAR __builtin_amdgcn_s_barrier()
#define PG8_SCHED __builtin_amdgcn_sched_barrier(0)
    Unit cur, nxt; int ui = 0;
    if (!S.next(0, cur)) return;
    f32x4 acc[2][2][4][2];
#pragma unroll
    for (int a = 0; a < 2; ++a)
#pragma unroll
        for (int b = 0; b < 2; ++b)
#pragma unroll
            for (int m = 0; m < 4; ++m)
#pragma unroll
                for (int n = 0; n < 2; ++n) acc[a][b][m][n] = (f32x4){0.f, 0.f, 0.f, 0.f};
    bf16x8 At[4][2], B0[2][2], B1[2][2];
    const char* cA = (const char*)g.A + (size_t)cur.pm * tstep; const char* cB = (const char*)g.Bt + (size_t)cur.pn * tstep;
    S.a_ready(cur);
    if constexpr (SP2) {
        PG8_STAGE(PG8_SB(0, 0), cB, voffB); PG8_STAGE(PG8_SB(0, 1), cB + hstep, voffB); PG8_STAGE(PG8_SA(0, 0), cA, voffA); PG8_STAGE(PG8_SA(0, 1), cA + hstep, voffA);
        if (wr == 1) PG8_BAR;
        PG8_WAIT_V(2); PG8_BAR;
        PG8_STAGE(PG8_SB(1, 0), cB + kstep, voffB); PG8_STAGE(PG8_SA(1, 0), cA + kstep, voffA); PG8_STAGE(PG8_SB(1, 1), cB + hstep + kstep, voffB);
        PG8_WAIT_V(6); PG8_BAR;
    } else {
        PG8_STAGE(PG8_SB(0, 0), cB, voffB); PG8_STAGE(PG8_SA(0, 0), cA, voffA); PG8_STAGE(PG8_SB(0, 1), cB + hstep, voffB); PG8_STAGE(PG8_SA(0, 1), cA + hstep, voffA);
        if (wr == 1) PG8_BAR;
        PG8_WAIT_V(4); PG8_BAR;
        PG8_STAGE(PG8_SB(1, 0), cB + kstep, voffB); PG8_STAGE(PG8_SA(1, 0), cA + kstep, voffA); PG8_STAGE(PG8_SB(1, 1), cB + hstep + kstep, voffB);
        PG8_WAIT_V(6); PG8_BAR;
    }
    for (;;) {
        const bool has_next = S.next(ui + 1, nxt);
        const char* nA = has_next ? (const char*)g.A + (size_t)nxt.pm * tstep : cA; const char* nB = has_next ? (const char*)g.Bt + (size_t)nxt.pn * tstep : cB;
        for (int t = 0; t < nt; t += 2) {
            const bool last = (t == nt - 2);
            const char* a1 = cA + (size_t)(t + 1) * kstep;
            const char* a2 = last ? nA : cA + (size_t)(t + 2) * kstep; const char* b2 = last ? nB : cB + (size_t)(t + 2) * kstep;
            const char* a3 = a2 + kstep; const char* b3 = b2 + kstep;
            if (last && has_next) S.a_ready(nxt);
            if constexpr (SP2) {
            PG8_LDB(B0, 0, 0); PG8_LDB(B1, 0, 1); PG8_SCHED; PG8_LDA(At, 0, 0); PG8_STAGE(PG8_SA(1, 1), a1 + hstep, voffA);
            PG8_WAIT_V(8); PG8_WAIT_L(0); PG8_BAR; PG8_MMA(0, 0, At, B0); PG8_MMA(0, 1, At, B1); PG8_BAR; PG8_SCHED;
            PG8_LDA(At, 0, 1); PG8_STAGE(PG8_SB(0, 0), b2, voffB); PG8_STAGE(PG8_SB(0, 1), b2 + hstep, voffB); PG8_STAGE(PG8_SA(0, 0), a2, voffA);
            PG8_WAIT_V(8); PG8_WAIT_L(0); PG8_BAR; PG8_MMA(1, 0, At, B0); PG8_MMA(1, 1, At, B1); PG8_BAR; PG8_SCHED;
            PG8_LDB(B0, 1, 0); PG8_LDB(B1, 1, 1); PG8_SCHED; PG8_LDA(At, 1, 0); PG8_STAGE(PG8_SA(0, 1), a2 + hstep, voffA);
            PG8_WAIT_V(8); PG8_WAIT_L(0); PG8_BAR; PG8_MMA(0, 0, At, B0); PG8_MMA(0, 1, At, B1); PG8_BAR; PG8_SCHED;
            PG8_LDA(At, 1, 1); PG8_STAGE(PG8_SB(1, 0), b3, voffB); PG8_STAGE(PG8_SB(1, 1), b3 + hstep, voffB); PG8_STAGE(PG8_SA(1, 0), a3, voffA);
            PG8_WAIT_V(8); PG8_WAIT_L(0); PG8_BAR; PG8_MMA(1, 0, At, B0); PG8_MMA(1, 1, At, B1); PG8_BAR; PG8_SCHED;
            } else {
            PG8_LDB(B0, 0, 0); PG8_SCHED; PG8_LDA(At, 0, 0); PG8_STAGE(PG8_SA(1, 1), a1 + hstep, voffA);
            PG8_WAIT_L(8); PG8_BAR; PG8_WAIT_L(0); PG8_MMA(0, 0, At, B0); PG8_BAR; PG8_SCHED;
            PG8_LDB(B1, 0, 1); PG8_STAGE(PG8_SB(0, 0), b2, voffB);
            PG8_BAR; PG8_WAIT_L(0); PG8_MMA(0, 1, At, B1); PG8_BAR;
            PG8_LDA(At, 0, 1); PG8_STAGE(PG8_SA(0, 0), a2, voffA);
            PG8_BAR; PG8_WAIT_L(0); PG8_MMA(1, 0, At, B0); PG8_BAR; PG8_SCHED;
            PG8_STAGE(PG8_SB(0, 1), b2 + hstep, voffB);
            PG8_WAIT_V(6); PG8_BAR; PG8_MMA(1, 1, At, B1); PG8_BAR;
            PG8_LDB(B0, 1, 0); PG8_SCHED; PG8_LDA(At, 1, 0); PG8_STAGE(PG8_SA(0, 1), a2 + hstep, voffA);
            PG8_WAIT_L(8); PG8_BAR; PG8_WAIT_L(0); PG8_MMA(0, 0, At, B0); PG8_BAR; PG8_SCHED;
            PG8_LDB(B1, 1, 1); PG8_STAGE(PG8_SB(1, 0), b3, voffB);
            PG8_BAR; PG8_WAIT_L(0); PG8_MMA(0, 1, At, B1); PG8_BAR;
            PG8_LDA(At, 1, 1); PG8_STAGE(PG8_SA(1, 0), a3, voffA);
            PG8_BAR; PG8_WAIT_L(0); PG8_MMA(1, 0, At, B0); PG8_BAR; PG8_SCHED;
            PG8_STAGE(PG8_SB(1, 1), b3 + hstep, voffB);
            PG8_WAIT_V(6); PG8_BAR; PG8_MMA(1, 1, At, B1); PG8_BAR;
            }
        }
        if constexpr (ALIGN_EPI) { if (wr == 0) PG8_BAR; }
        if constexpr (!Epi::AFTER_DRAIN) { E(acc, cur, wr, wc, fr, fq); S.done(cur); }
        if (!has_next) break;
#pragma unroll
        for (int a = 0; a < 2; ++a)
#pragma unroll
            for (int b = 0; b < 2; ++b)
#pragma unroll
                for (int m = 0; m < 4; ++m)
#pragma unroll
                    for (int n = 0; n < 2; ++n) acc[a][b][m][n] = (f32x4){0.f, 0.f, 0.f, 0.f};
        cur = nxt; cA = nA; cB = nB; ++ui;
        if constexpr (ALIGN_EPI) { if (wr == 1) PG8_BAR; }
    }
    PG8_WAIT_V(0);
    if constexpr (!ALIGN_EPI) { if (wr == 0) PG8_BAR; }
    PG8_BAR;
    if constexpr (Epi::AFTER_DRAIN) { E.fused(acc, cur, wr, wc, fr, fq, lds, wid, lane); S.done(cur); }
#undef PG8_SA
#undef PG8_SB
#undef PG8_STAGE
#undef PG8_LDA
#undef PG8_LDB
#undef PG8_MMA
#undef PG8_WAIT_V
#undef PG8_WAIT_L
#undef PG8_BAR
#undef PG8_SCHED
}
}

typedef unsigned short bf16;
constexpr int NB = 4, SEQ = 8192, T = NB * SEQ, DM = 1024, DFF = 4096, DEPTH = 2;
constexpr int DIN = 3476, DINP = 3584;
constexpr int C_MQ = 0, C_MK = 512, C_MV = 1024, C_MO = 1536, C_BQ = 2048, C_BK = 2304, C_BV = 2560, C_NQ = 2816,
              C_NKC = 3072, C_NVC = 3136, C_NKS = 3200, C_NVS = 3264, C_NKW = 3328, C_NVW = 3392, C_GATE = 3456;
constexpr int NCMP = 511;
constexpr float EPS = 1e-6f;

__device__ __forceinline__ float bf2f(bf16 v) { return __builtin_bit_cast(float, (unsigned)v << 16); }
__device__ __forceinline__ bf16 f2bf(float f) { return (bf16)pg8::f2bf_u(f); }
__device__ __forceinline__ float wave_sum(float v) {
#pragma unroll
    for (int o = 1; o < 64; o <<= 1) v += __shfl_xor(v, o);
    return v;
}
__device__ __forceinline__ float wave_max(float v) {
#pragma unroll
    for (int o = 1; o < 64; o <<= 1) v = fmaxf(v, __shfl_xor(v, o));
    return v;
}
__device__ __forceinline__ float rcpf_(float x) { return __builtin_amdgcn_rcpf(x); }
__device__ __forceinline__ float sigmoidf_(float x) { return rcpf_(1.f + __expf(-x)); }
__device__ __forceinline__ float log_sigmoidf_(float x) { return fminf(x, 0.f) - __logf(1.f + __expf(-fabsf(x))); }
__device__ __forceinline__ void rope_cs(int pos, int f, float& c, float& s) {
    const float invf = f == 0 ? 1.0f : f == 1 ? 0.193922758102417f : f == 2 ? 0.03760603442788124f : f == 3 ? 0.007292666472494602f : f == 4 ? 0.0014142136787995696f
                     : f == 5 ? 0.00027424818836152554f : f == 6 ? 5.318298644851893e-05f : 1.031338433676865e-05f;
    const float ang = (float)pos * invf;
    const float k = rintf(ang * 0.15915493667125702f);
    float r = fmaf(-k, 6.2831854820251465f, ang); r = fmaf(-k, -1.7484555314695172e-07f, r);
    c = __cosf(r); s = __sinf(r);
}


__device__ __forceinline__ float dot64(const bf16* __restrict__ kp, const float* q) {
    const uint4* k4 = (const uint4*)kp; float a = 0.f;
#pragma unroll
    for (int j = 0; j < 8; ++j) { const uint4 w = k4[j]; const unsigned ww[4] = {w.x, w.y, w.z, w.w};
#pragma unroll
        for (int e = 0; e < 4; ++e) { a = fmaf(q[8 * j + 2 * e], __builtin_bit_cast(float, ww[e] << 16), a); a = fmaf(q[8 * j + 2 * e + 1], __builtin_bit_cast(float, ww[e] & 0xffff0000u), a); } }
    return a;
}
__device__ __forceinline__ void dot64x4(const bf16* __restrict__ kp, const float (*q)[64], float (&a)[4]) {
    const uint4* k4 = (const uint4*)kp; a[0] = a[1] = a[2] = a[3] = 0.f;
#pragma unroll
    for (int j = 0; j < 8; ++j) { const uint4 w = k4[j]; const unsigned ww[4] = {w.x, w.y, w.z, w.w};
#pragma unroll
        for (int e = 0; e < 4; ++e) { const float k0 = __builtin_bit_cast(float, ww[e] << 16), k1 = __builtin_bit_cast(float, ww[e] & 0xffff0000u);
#pragma unroll
            for (int h = 0; h < 4; ++h) { a[h] = fmaf(q[h][8 * j + 2 * e], k0, a[h]); a[h] = fmaf(q[h][8 * j + 2 * e + 1], k1, a[h]); } } }
}

__host__ __device__ __forceinline__ int win_src(int n) {
    if (n < 2048) return n;
    if (n < 3456) return n + 8;
    if (n < 3464) return n - 3456 + 2048;
    if (n < 3476) return n;
    return -1;
}


__device__ __forceinline__ void ph_convert_w(const float* __restrict__ W, int K, int N, int NP, bf16* __restrict__ WT, int mode, int item, bool act, int t, float* tile  ) {
    const int nbx = NP / 64; const int n0 = (item % nbx) * 64, k0 = (item / nbx) * 64, c = t & 63, r = t >> 6;
    if (act) { const int src = mode ? win_src(n0 + c) : (n0 + c);
#pragma unroll 4
        for (int i = 0; i < 16; ++i) { const int k = r + 4 * i; tile[k * 65 + c] = (src >= 0) ? W[(size_t)(k0 + k) * N + src] : 0.f; } }
    __syncthreads();
    if (act) {
#pragma unroll 4
        for (int i = 0; i < 16; ++i) { const int n = r + 4 * i; WT[(size_t)(n0 + n) * K + k0 + c] = f2bf(tile[c * 65 + n]); } }
    __syncthreads();
}
__device__ __forceinline__ void ph_rmsnorm_row(const float* __restrict__ x, const float* __restrict__ g, bf16* __restrict__ H, int row, int lane) {
    const float4* xr = (const float4*)(x + (size_t)row * DM) + lane;
    float4 v[4]; float s = 0.f;
#pragma unroll
    for (int j = 0; j < 4; ++j) { v[j] = xr[64 * j]; s += v[j].x * v[j].x + v[j].y * v[j].y + v[j].z * v[j].z + v[j].w * v[j].w; }
    const float rstd = rsqrtf(wave_sum(s) * (1.f / DM) + EPS);
    uint2* o = (uint2*)(H + (size_t)row * DM) + lane;
#pragma unroll
    for (int j = 0; j < 4; ++j) { const float4 gg = ((const float4*)g)[lane + 64 * j];
        uint2 w; w.x = pg8::pk2bf(v[j].x * rstd * gg.x, v[j].y * rstd * gg.y); w.y = pg8::pk2bf(v[j].z * rstd * gg.z, v[j].w * rstd * gg.w); o[64 * j] = w; }
}
__device__ __forceinline__ void ph_prep(bf16* __restrict__ P, const float* __restrict__ tab, const float* __restrict__ moba_g, const float* __restrict__ nsa_qg, const float* __restrict__ nsa_kg,
                                        float* __restrict__ kmean, int item, bool act, int t, float* red  ) {
    const int lane = t & 63, wid = t >> 6, tb = item % 128, kind = item / 128;
    float ksum = 0.f;
    if (act) {
        int col; const float* g; bool rope;
        if (kind < 4) { col = C_BQ + kind * 64; g = moba_g; rope = true; }
        else if (kind < 8) { col = C_BK + (kind - 4) * 64; g = moba_g + 64; rope = true; }
        else if (kind < 12) { col = C_NQ + (kind - 8) * 64; g = nsa_qg; rope = false; }
        else if (kind == 12) { col = C_NKS; g = nsa_kg + 64; rope = true; }
        else { col = C_NKW; g = nsa_kg + 128; rope = true; }
        const float gd = g[lane];
        for (int i = 0; i < 64; ++i) {
            const int row = tb * 256 + wid * 64 + i, pos = row & (SEQ - 1);
            bf16* p = P + (size_t)row * DINP + col + lane;
            const float x = bf2f(*p);
            const float ss = wave_sum(x * x);
            float y = x * rsqrtf(ss * (1.f / 64.f) + EPS) * gd;
            if (rope) {
                const float other = __shfl_xor(y, 8);
                if (lane < 16) { const int f = lane & 7; const float c = tab[pos * 16 + f], s = tab[pos * 16 + 8 + f];
                    y = (lane < 8) ? (y * c - other * s) : (y * c + other * s); }
            }
            *p = f2bf(y);
            ksum += y;
        }
        red[wid * 64 + lane] = ksum;
    }
    __syncthreads();
    if (act && kind >= 4 && kind < 8 && wid == 0) { const float s = red[lane] + red[64 + lane] + red[128 + lane] + red[192 + lane];
        const int b = tb >> 5, n = tb & 31; kmean[(((size_t)b * 4 + (kind - 4)) * 32 + n) * 64 + lane] = s * (1.f / 256.f); }
    __syncthreads();
}
__device__ __forceinline__ void ph_compress(const bf16* __restrict__ P, const float* __restrict__ pe, const float* __restrict__ w1, const float* __restrict__ w2, const float* __restrict__ kg0,
                                            float* __restrict__ KVc, int item, bool act, int t, float* sm  ) {
    float* in = sm; float* hid = sm + 2048;
    const int i = item % NCMP, b = (item / NCMP) & 3, kv = item / (NCMP * 4);
    const int col = kv ? C_NVC : C_NKC;
    if (act) for (int e = t; e < 2048; e += 256) { const int p = e >> 6, d = e & 63; in[e] = bf2f(P[(size_t)(b * SEQ + 16 * i + p) * DINP + col + d]) + pe[(kv * 32 + p) * 64 + d]; }
    __syncthreads();
    if (act && t < 128) { const float* w = w1 + (size_t)kv * 2048 * 128 + t; float a = 0.f;
#pragma unroll 8
        for (int k = 0; k < 2048; ++k) a = fmaf(in[k], w[(size_t)k * 128], a);
        hid[t] = a * rcpf_(1.f + __expf(-a)); }
    __syncthreads();
    if (act && t < 64) { const float* ww = w2 + (size_t)kv * 128 * 64 + t; float o = 0.f;
#pragma unroll 8
        for (int j = 0; j < 128; ++j) o = fmaf(hid[j], ww[j * 64], o);
        if (kv == 0) { const float ss = wave_sum(o * o); o = o * rsqrtf(ss * (1.f / 64.f) + EPS) * kg0[t]; }
        KVc[(((size_t)kv * NB + b) * 512 + i) * 64 + t] = o; }
    __syncthreads();
}
__device__ __forceinline__ float conv_silu(const bf16* __restrict__ P, const float* __restrict__ cw  , int rowbase, int t, int c) {
    float a = 0.f;
#pragma unroll
    for (int j = 0; j < 4; ++j) { const int tt = t - 3 + j; if (tt >= 0) a = fmaf(cw[j * 1024 + c], bf2f(P[(size_t)(rowbase + tt) * DINP + c]), a); }
    return a * rcpf_(1.f + __expf(-a));
}
__device__ __forceinline__ void ph_mlstm_local(const bf16* __restrict__ P, const float* __restrict__ G, const float* __restrict__ cw, const float* __restrict__ bif,
                                               float* __restrict__ Cst, float* __restrict__ nst, float* __restrict__ dec, int u, bool act, int tid, unsigned char* sm) {
    bf16 (*ks)[128] = (bf16 (*)[128])sm; bf16 (*vs)[128] = (bf16 (*)[128])(sm + 16384); float* wS = (float*)(sm + 32768); float* lf = wS + 64;
    const int c = u & 127, h = (u >> 7) & 3, b = u >> 9;
    const int rowbase = b * SEQ, t0 = c * 64;
    if (act) {
        for (int e = tid; e < 64 * 128; e += 256) { const int s = e >> 7, d = e & 127;
            ks[s][d] = f2bf(conv_silu(P, cw, rowbase, t0 + s, 512 + h * 128 + d) * 0.08838834764831845f);
            vs[s][d] = P[(size_t)(rowbase + t0 + s) * DINP + C_MV + h * 128 + d]; }
        if (tid < 64) lf[tid] = log_sigmoidf_(G[(size_t)(rowbase + t0 + tid) * 32 + 4 + h] + bif[4 + h]);
    }
    __syncthreads();
    if (act && tid == 0) { float acc = 0.f;
        for (int s = 0; s < 64; ++s) { acc += lf[s]; lf[s] = acc; }
        dec[u] = __expf(acc); }
    __syncthreads();
    if (act && tid < 64) wS[tid] = __expf(lf[63] - lf[tid] + G[(size_t)(rowbase + t0 + tid) * 32 + h] + bif[h]);
    __syncthreads();
    if (act) {
        const int d = tid >> 1, e0 = (tid & 1) * 64;
        float acc[64];
#pragma unroll
        for (int e = 0; e < 64; ++e) acc[e] = 0.f;
        float an = 0.f;
        for (int s = 0; s < 64; ++s) { const float kw = wS[s] * bf2f(ks[s][d]); an += kw;
#pragma unroll
            for (int e = 0; e < 64; ++e) acc[e] = fmaf(kw, bf2f(vs[s][e0 + e]), acc[e]); }
        float* o = Cst + ((size_t)u * 128 + d) * 128 + e0;
#pragma unroll
        for (int e = 0; e < 64; ++e) o[e] = acc[e];
        if ((tid & 1) == 0) nst[(size_t)u * 128 + d] = an;
    }
    __syncthreads();
}
__device__ __forceinline__ void ph_mlstm_scan(float* __restrict__ Cst, float* __restrict__ nst, const float* __restrict__ dec, int item, int tid) {
    const int bh = item / 65, part = item % 65;
    float* base; int stride;
    if (part < 64) { base = Cst + (size_t)bh * 128 * 16384 + part * 256 + tid; stride = 16384; }
    else { if (tid >= 128) return; base = nst + (size_t)bh * 128 * 128 + tid; stride = 128; }
    float C = 0.f;
    for (int c = 0; c < 128; ++c) { const float dC = base[(size_t)c * stride]; base[(size_t)c * stride] = C; C = dec[bh * 128 + c] * C + dC; }
}
__device__ __forceinline__ void ph_mlstm_out(const bf16* __restrict__ P, const float* __restrict__ G, const float* __restrict__ cw, const float* __restrict__ bif,
                                             const float* __restrict__ Cst, const float* __restrict__ nst, const float* __restrict__ mnorm, bf16* __restrict__ MIX, int u, bool act, int tid, unsigned char* sm) {
    bf16 (*qs)[128] = (bf16 (*)[128])sm; float* ksS = (float*)(sm + 16384); bf16 (*ks)[128] = (bf16 (*)[128])ksS; bf16 (*vs)[128] = (bf16 (*)[128])(sm + 32768);
    float* bb = (float*)(sm + 49152); float* li = bb + 64;
    const int c = u & 127, h = (u >> 7) & 3, b = u >> 9;
    const int rowbase = b * SEQ, t0 = c * 64;
    if (act) {
        for (int e = tid; e < 64 * 128; e += 256) { const int s = e >> 7, d = e & 127;
            qs[s][d] = f2bf(conv_silu(P, cw, rowbase, t0 + s, h * 128 + d));
            ks[s][d] = f2bf(conv_silu(P, cw, rowbase, t0 + s, 512 + h * 128 + d) * 0.08838834764831845f);
            vs[s][d] = P[(size_t)(rowbase + t0 + s) * DINP + C_MV + h * 128 + d]; }
        if (tid < 64) { bb[tid] = log_sigmoidf_(G[(size_t)(rowbase + t0 + tid) * 32 + 4 + h] + bif[4 + h]); li[tid] = G[(size_t)(rowbase + t0 + tid) * 32 + h] + bif[h]; }
    }
    __syncthreads();
    if (act && tid == 0) { float acc = 0.f; for (int s = 0; s < 64; ++s) { acc += bb[s]; bb[s] = acc; } }
    __syncthreads();
    const int t = tid >> 2, part = tid & 3;
    float sreg[16];
    if (act) {
        const int s0 = part * 16;
#pragma unroll
        for (int j = 0; j < 16; ++j) { const int s = s0 + j; float a = 0.f;
            if (s <= t) { for (int d = 0; d < 128; ++d) a = fmaf(bf2f(qs[t][d]), bf2f(ks[s][d]), a); a *= __expf(bb[t] - bb[s] + li[s]); }
            sreg[j] = a; }
    }
    __syncthreads();
    float* S = ksS;
    if (act) {
#pragma unroll
        for (int j = 0; j < 16; ++j) S[t * 64 + part * 16 + j] = sreg[j];
    }
    __syncthreads();
    if (act) {
        const float Ft = __expf(bb[t]);
        float den = 0.f;
        for (int s = 0; s <= t; ++s) den += S[t * 64 + s];
        { const float* np = nst + (size_t)u * 128; float a = 0.f; for (int d = 0; d < 128; ++d) a = fmaf(bf2f(qs[t][d]), np[d], a); den += Ft * a; }
        const int e0 = part * 32;
        float acc[32];
#pragma unroll
        for (int e = 0; e < 32; ++e) acc[e] = 0.f;
        { const float* Cp = Cst + (size_t)u * 16384 + e0;
          for (int d = 0; d < 128; ++d) { const float qd = bf2f(qs[t][d]);
#pragma unroll
              for (int e = 0; e < 32; ++e) acc[e] = fmaf(qd, Cp[d * 128 + e], acc[e]); } }
#pragma unroll
        for (int e = 0; e < 32; ++e) acc[e] *= Ft;
        for (int s = 0; s <= t; ++s) { const float w = S[t * 64 + s];
#pragma unroll
            for (int e = 0; e < 32; ++e) acc[e] = fmaf(w, bf2f(vs[s][e0 + e]), acc[e]); }
        const float inv = rcpf_(fmaxf(fabsf(den), 1.f));
        float ss = 0.f;
#pragma unroll
        for (int e = 0; e < 32; ++e) { acc[e] *= inv; ss += acc[e] * acc[e]; }
        ss += __shfl_xor(ss, 1); ss += __shfl_xor(ss, 2);
        const float rstd = rsqrtf(ss * (1.f / 128.f) + EPS);
        const size_t row = (size_t)(rowbase + t0 + t);
#pragma unroll
        for (int e = 0; e < 32; ++e) { const int cc = h * 128 + e0 + e;
            const float o = sigmoidf_(bf2f(P[row * DINP + C_MO + cc]));
            MIX[row * DM + cc] = f2bf(acc[e] * rstd * mnorm[cc] * o); }
    }
    __syncthreads();
}

__device__ __forceinline__ void ph_moba(const bf16* __restrict__ P, const float* __restrict__ kmean, bf16* __restrict__ MIX, int gw, int lane, float* q) {
    const int bh = gw >> 13, tq = gw & (SEQ - 1), b = bh >> 2, h = bh & 3, own = tq >> 8;
    const size_t row = (size_t)b * SEQ + tq;
    __builtin_amdgcn_s_waitcnt(0); __builtin_amdgcn_wave_barrier();
    q[lane] = bf2f(P[row * DINP + C_BQ + h * 64 + lane]);
    __builtin_amdgcn_s_waitcnt(0); __builtin_amdgcn_wave_barrier();
    float gs = -3.0e38f;
    if (lane < 32) { if (lane < own) { const float* km = kmean + (((size_t)b * 4 + h) * 32 + lane) * 64; float a = 0.f; for (int d = 0; d < 64; ++d) a = fmaf(q[d], km[d], a); gs = a; } else gs = -1e30f; }
    int blk[4]; bool val[4];
#pragma unroll
    for (int r = 0; r < 3; ++r) { const float m = wave_max(gs); const unsigned long long bal = __ballot(gs == m); const int idx = __ffsll((long long)bal) - 1;
        blk[r] = idx; val[r] = (r < own); if (lane == idx) gs = -3.0e38f; }
    blk[3] = own; val[3] = true;
    float s[4][4]; float mx = -1e30f;
#pragma unroll
    for (int g = 0; g < 4; ++g)
#pragma unroll
        for (int i = 0; i < 4; ++i) { float a = -1e30f;
            if (val[g]) { const int pos = blk[g] * 256 + i * 64 + lane;
                if (g < 3 || pos <= tq) { const bf16* kp = P + ((size_t)b * SEQ + pos) * DINP + C_BK + h * 64; a = dot64(kp, q) * 0.125f; } }
            s[g][i] = a; mx = fmaxf(mx, a); }
    mx = wave_max(mx);
    float l = 0.f;
#pragma unroll
    for (int g = 0; g < 4; ++g)
#pragma unroll
        for (int i = 0; i < 4; ++i) { const float p = (s[g][i] > -1e29f) ? __expf(s[g][i] - mx) : 0.f; s[g][i] = p; l += p; }
    l = wave_sum(l);
    float o = 0.f;
#pragma unroll
    for (int g = 0; g < 4; ++g) { if (!val[g]) continue;
#pragma unroll
        for (int i = 0; i < 4; ++i) { const bf16* vp = P + ((size_t)b * SEQ + blk[g] * 256 + i * 64) * DINP + C_BV + h * 64 + lane;
            for (int src = 0; src < 64; ++src) { const float p = __shfl(s[g][i], src); o = fmaf(p, bf2f(vp[(size_t)src * DINP]), o); } } }
    MIX[row * DM + 512 + h * 64 + lane] = f2bf(o * rcpf_(l));
}

__device__ __forceinline__ void ph_nsa(const bf16* __restrict__ P, const float* __restrict__ G, const float* __restrict__ tab, const float* __restrict__ KVc, bf16* __restrict__ MIX, int gw, int lane, float* sm) {
    float (*qn)[64] = (float (*)[64])sm; float (*qr)[64] = (float (*)[64])(sm + 256); float* ps = sm + 512;
    const int b = gw >> 13, tq = gw & (SEQ - 1), blkq = tq >> 6;
    const size_t row = (size_t)b * SEQ + tq;
    __builtin_amdgcn_s_waitcnt(0); __builtin_amdgcn_wave_barrier();
#pragma unroll
    for (int h = 0; h < 4; ++h) { const float x = bf2f(P[row * DINP + C_NQ + h * 64 + lane]); qn[h][lane] = x;
        float y = x; const float other = __shfl_xor(x, 8);
        if (lane < 16) { const int f = lane & 7; const float c = tab[tq * 16 + f], s = tab[tq * 16 + 8 + f]; y = (lane < 8) ? (x * c - other * s) : (x * c + other * s); }
        qr[h][lane] = y; }
    __builtin_amdgcn_s_waitcnt(0); __builtin_amdgcn_wave_barrier();
    const float* Kc = KVc + (size_t)b * 512 * 64; const float* Vc = KVc + ((size_t)NB + b) * 512 * 64;
    float out[4] = {0.f, 0.f, 0.f, 0.f};
    float gate[3][4];
#pragma unroll
    for (int br = 0; br < 3; ++br)
#pragma unroll
        for (int h = 0; h < 4; ++h) gate[br][h] = sigmoidf_(G[row * 32 + 8 + br * 4 + h]);
    const int ncv = (tq >= 31) ? ((tq - 31) >> 4) + 1 : 0;
    {
        float sc[8][4]; float mx[4] = {-1e30f, -1e30f, -1e30f, -1e30f};
#pragma unroll
        for (int i = 0; i < 8; ++i) { const int c = i * 64 + lane;
            float a[4] = {-1e30f, -1e30f, -1e30f, -1e30f};
            if (c < ncv) { const float* kp = Kc + (size_t)c * 64; a[0] = a[1] = a[2] = a[3] = 0.f;
                for (int d = 0; d < 64; ++d) { const float kd = kp[d]; a[0] = fmaf(qn[0][d], kd, a[0]); a[1] = fmaf(qn[1][d], kd, a[1]); a[2] = fmaf(qn[2][d], kd, a[2]); a[3] = fmaf(qn[3][d], kd, a[3]); }
#pragma unroll
                for (int h = 0; h < 4; ++h) a[h] *= 0.125f; }
#pragma unroll
            for (int h = 0; h < 4; ++h) { sc[i][h] = a[h]; mx[h] = fmaxf(mx[h], a[h]); } }
        float l[4];
#pragma unroll
        for (int h = 0; h < 4; ++h) { mx[h] = wave_max(mx[h]); l[h] = 0.f; }
#pragma unroll
        for (int i = 0; i < 8; ++i) { const int c = i * 64 + lane;
#pragma unroll
            for (int h = 0; h < 4; ++h) { const float p = (c < ncv) ? __expf(sc[i][h] - mx[h]) : 0.f; sc[i][h] = p; l[h] += p; } }
#pragma unroll
        for (int h = 0; h < 4; ++h) { l[h] = wave_sum(l[h]); l[h] = (l[h] > 0.f) ? rcpf_(l[h]) : 0.f; }
#pragma unroll
        for (int i = 0; i < 8; ++i) { float su = 0.f;
#pragma unroll
            for (int h = 0; h < 4; ++h) { sc[i][h] *= l[h]; su += sc[i][h]; }
            ps[i * 64 + lane] = su; }
        if (lane < 4) ps[512 + lane] = 0.f;
        float oc[4] = {0.f, 0.f, 0.f, 0.f};
#pragma unroll
        for (int i = 0; i < 8; ++i) { if (i * 64 >= ncv) break; const int nn = min(64, ncv - i * 64);
            for (int src = 0; src < nn; ++src) { const float v = Vc[(size_t)(i * 64 + src) * 64 + lane];
                oc[0] = fmaf(__shfl(sc[i][0], src), v, oc[0]); oc[1] = fmaf(__shfl(sc[i][1], src), v, oc[1]);
                oc[2] = fmaf(__shfl(sc[i][2], src), v, oc[2]); oc[3] = fmaf(__shfl(sc[i][3], src), v, oc[3]); } }
#pragma unroll
        for (int h = 0; h < 4; ++h) out[h] = gate[0][h] * oc[h];
    }
    __builtin_amdgcn_s_waitcnt(0); __builtin_amdgcn_wave_barrier();
    int sidx[16];
    {
        float v0, v1;
        { const int n = lane; float im = 0.f;
#pragma unroll
          for (int j = -1; j < 4; ++j) { const int c = 4 * n + j; if (c >= 0 && c < NCMP) im += ps[c]; }
          const bool causal = n <= blkq, forced = causal && (n == 0 || n >= blkq - 1);
          v0 = forced ? 1e9f : (causal ? im : -1e30f); }
        { const int n = lane + 64; float im = 0.f;
#pragma unroll
          for (int j = -1; j < 4; ++j) { const int c = 4 * n + j; if (c >= 0 && c < NCMP) im += ps[c]; }
          const bool causal = n <= blkq, forced = causal && (n == 0 || n >= blkq - 1);
          v1 = forced ? 1e9f : (causal ? im : -1e30f); }
#pragma unroll
        for (int k = 0; k < 16; ++k) { const float m = wave_max(fmaxf(v0, v1));
            const unsigned long long b0 = __ballot(v0 == m); int idx;
            if (b0) { idx = __ffsll((long long)b0) - 1; if (lane == idx) v0 = -3.0e38f; }
            else { const unsigned long long b1 = __ballot(v1 == m); idx = __ffsll((long long)b1) - 1; if (lane == idx) v1 = -3.0e38f; idx += 64; }
            sidx[k] = idx; }
    }
    {
        float sc[16][4]; float mx[4] = {-1e30f, -1e30f, -1e30f, -1e30f};
#pragma unroll
        for (int k = 0; k < 16; ++k) { const int n = sidx[k], pos = n * 64 + lane;
            float a[4] = {-1e30f, -1e30f, -1e30f, -1e30f};
            if (n <= blkq && pos <= tq) { const bf16* kp = P + ((size_t)b * SEQ + pos) * DINP + C_NKS; dot64x4(kp, qr, a);
#pragma unroll
                for (int h = 0; h < 4; ++h) a[h] *= 0.125f; }
#pragma unroll
            for (int h = 0; h < 4; ++h) { sc[k][h] = a[h]; mx[h] = fmaxf(mx[h], a[h]); } }
        float l[4];
#pragma unroll
        for (int h = 0; h < 4; ++h) { mx[h] = wave_max(mx[h]); l[h] = 0.f; }
#pragma unroll
        for (int k = 0; k < 16; ++k)
#pragma unroll
            for (int h = 0; h < 4; ++h) { const float p = (sc[k][h] > -1e29f) ? __expf(sc[k][h] - mx[h]) : 0.f; sc[k][h] = p; l[h] += p; }
#pragma unroll
        for (int h = 0; h < 4; ++h) l[h] = rcpf_(wave_sum(l[h]));
        float os[4] = {0.f, 0.f, 0.f, 0.f};
#pragma unroll
        for (int k = 0; k < 16; ++k) { const int n = sidx[k]; if (n > blkq) continue;
            const bf16* vp = P + ((size_t)b * SEQ + n * 64) * DINP + C_NVS + lane;
            for (int src = 0; src < 64; ++src) { const float v = bf2f(vp[(size_t)src * DINP]);
                os[0] = fmaf(__shfl(sc[k][0], src), v, os[0]); os[1] = fmaf(__shfl(sc[k][1], src), v, os[1]);
                os[2] = fmaf(__shfl(sc[k][2], src), v, os[2]); os[3] = fmaf(__shfl(sc[k][3], src), v, os[3]); } }
#pragma unroll
        for (int h = 0; h < 4; ++h) out[h] += gate[1][h] * os[h] * l[h];
    }
    {
        float sc[8][4]; float mx[4] = {-1e30f, -1e30f, -1e30f, -1e30f};
#pragma unroll
        for (int i = 0; i < 8; ++i) { const int pos = tq - 511 + i * 64 + lane;
            float a[4] = {-1e30f, -1e30f, -1e30f, -1e30f};
            if (pos >= 0) { const bf16* kp = P + ((size_t)b * SEQ + pos) * DINP + C_NKW; dot64x4(kp, qr, a);
#pragma unroll
                for (int h = 0; h < 4; ++h) a[h] *= 0.125f; }
#pragma unroll
            for (int h = 0; h < 4; ++h) { sc[i][h] = a[h]; mx[h] = fmaxf(mx[h], a[h]); } }
        float l[4];
#pragma unroll
        for (int h = 0; h < 4; ++h) { mx[h] = wave_max(mx[h]); l[h] = 0.f; }
#pragma unroll
        for (int i = 0; i < 8; ++i)
#pragma unroll
            for (int h = 0; h < 4; ++h) { const float p = (sc[i][h] > -1e29f) ? __expf(sc[i][h] - mx[h]) : 0.f; sc[i][h] = p; l[h] += p; }
#pragma unroll
        for (int h = 0; h < 4; ++h) l[h] = rcpf_(wave_sum(l[h]));
        float ow[4] = {0.f, 0.f, 0.f, 0.f};
#pragma unroll
        for (int i = 0; i < 8; ++i) { const int p0 = tq - 511 + i * 64; if (p0 + 63 < 0) continue;
            const int s0 = p0 < 0 ? -p0 : 0;
            for (int src = s0; src < 64; ++src) { const float v = bf2f(P[((size_t)b * SEQ + p0 + src) * DINP + C_NVW + lane]);
                ow[0] = fmaf(__shfl(sc[i][0], src), v, ow[0]); ow[1] = fmaf(__shfl(sc[i][1], src), v, ow[1]);
                ow[2] = fmaf(__shfl(sc[i][2], src), v, ow[2]); ow[3] = fmaf(__shfl(sc[i][3], src), v, ow[3]); } }
#pragma unroll
        for (int h = 0; h < 4; ++h) out[h] += gate[2][h] * ow[h] * l[h];
    }
#pragma unroll
    for (int h = 0; h < 4; ++h) MIX[row * DM + 768 + h * 64 + lane] = f2bf(out[h]);
}

constexpr size_t MiB = 1u << 20;
constexpr size_t W_LAYER = (size_t)(DINP + DM + DFF) * DM + (size_t)DM * DFF;
constexpr size_t WS_W = 0;
constexpr size_t WS_HM = 52 * MiB;
constexpr size_t WS_G = 116 * MiB;
constexpr size_t WS_SMALL = 120 * MiB;
constexpr size_t WS_TAB = WS_SMALL, WS_KMEAN = WS_SMALL + 512 * 1024, WS_KVC = WS_SMALL + 1 * MiB, WS_NST = WS_SMALL + 2 * MiB, WS_DEC = WS_SMALL + 3 * MiB;
constexpr size_t WS_P = 124 * MiB;
constexpr size_t WS_C = 348 * MiB;
constexpr size_t WS_U = WS_P;
constexpr size_t WS_END = 476 * MiB;
static_assert(W_LAYER * 2 * DEPTH <= 52 * MiB, "weights");
static_assert((size_t)T * DINP * 2 == 224 * MiB && (size_t)T * DFF * 2 == 256 * MiB, "sizes");

struct Params { const float* in[16]; float* out; unsigned char* ws; };
constexpr int LDS_BYTES = 147456;

__global__ void __launch_bounds__(512, 2) hybrid_fwd(Params prm) {
    extern __shared__ __attribute__((aligned(16))) unsigned char lds[];
    cg::grid_group grid = cg::this_grid();
    constexpr int NPH = 1 + DEPTH * 9 - 1;
    for (int ph = 0; ph < NPH; ++ph) {
        int tid = threadIdx.x; asm volatile("" : "+v"(tid));
        const int G = gridDim.x, bid = blockIdx.x, half = tid >> 8, t256 = tid & 255, lane = tid & 63, wid = __builtin_amdgcn_readfirstlane(tid >> 6);
        unsigned char* smh = lds + half * 65536;
        unsigned char* ws = prm.ws; float* out = prm.out; asm volatile("" : "+s"(ws), "+s"(out));
        size_t zz = 0; asm volatile("" : "+s"(zz));
#define IN(k) (prm.in[k] + zz)
        bf16* Wb = (bf16*)(ws + WS_W); bf16* HM = (bf16*)(ws + WS_HM); float* Gt = (float*)(ws + WS_G); float* tab = (float*)(ws + WS_TAB); float* kmean = (float*)(ws + WS_KMEAN);
        float* KVc = (float*)(ws + WS_KVC); float* nst = (float*)(ws + WS_NST); float* dec = (float*)(ws + WS_DEC); bf16* P = (bf16*)(ws + WS_P); float* Cst = (float*)(ws + WS_C); bf16* U = (bf16*)(ws + WS_U);
        const int vb = bid * 2 + half, NVB = G * 2;
        const int gwv = bid * 8 + wid, NGW = G * 8;
        const int l = ph == 0 ? 0 : (ph - 1) / 9, j = ph == 0 ? -1 : (ph - 1) % 9;
        const float* x = IN(0);
        const float* xin = l == 0 ? x : out;
        const bf16* WinT = Wb + l * W_LAYER; const bf16* WoT = WinT + (size_t)DINP * DM; const bf16* W1T = WoT + (size_t)DM * DM; const bf16* W2T = W1T + (size_t)DFF * DM;
        if (ph == 0) {
            const float* w_in = IN(1); const float* w_out = IN(11); const float* w_ff1 = IN(14); const float* w_ff2 = IN(15);
            for (int ll = 0; ll < DEPTH; ++ll) {
                bf16* WinT_ = Wb + ll * W_LAYER; bf16* WoT_ = WinT_ + (size_t)DINP * DM; bf16* W1T_ = WoT_ + (size_t)DM * DM; bf16* W2T_ = W1T_ + (size_t)DFF * DM;
                for (int mt = 0; mt < 4; ++mt) {
                    const float* W; int K, N, NP, mode; bf16* WT;
                    if (mt == 0) { W = w_in + (size_t)ll * DM * DIN; K = DM; N = DIN; NP = DINP; WT = WinT_; mode = 1; }
                    else if (mt == 1) { W = w_out + (size_t)ll * DM * DM; K = DM; N = DM; NP = DM; WT = WoT_; mode = 0; }
                    else if (mt == 2) { W = w_ff1 + (size_t)ll * DM * DFF; K = DM; N = DFF; NP = DFF; WT = W1T_; mode = 0; }
                    else { W = w_ff2 + (size_t)ll * DFF * DM; K = DFF; N = DM; NP = DM; WT = W2T_; mode = 0; }
                    const int nit = (NP / 64) * (K / 64);
                    for (int it0 = 0; it0 < nit; it0 += NVB) { const int it = it0 + vb; ph_convert_w(W, K, N, NP, WT, mode, it, it < nit, t256, (float*)smh); }
                }
            }
            for (int i = bid * 512 + tid; i < SEQ * 8; i += G * 512) { const int pos = i >> 3, f = i & 7;
                float c_, s_; rope_cs(pos, f, c_, s_);
                tab[pos * 16 + f] = c_; tab[pos * 16 + 8 + f] = s_; }
            for (int row = gwv; row < T; row += NGW) ph_rmsnorm_row(x, IN(12), HM, row, lane);
        } else if (j == 0 || j == 4 || j == 6 || j == 7) {
            pg8::Gemm g; pg8::EpiAny E; int N;
            if (j == 0) { g = pg8::Gemm{HM, WinT, T, DINP, DM}; N = DINP; E = pg8::EpiAny{0, true, P, DINP, Gt, C_GATE, nullptr, nullptr}; }
            else if (j == 4) { g = pg8::Gemm{HM, WoT, T, DM, DM}; N = DM; E = pg8::EpiAny{2, false, nullptr, DM, nullptr, 0, xin, out}; }
            else if (j == 6) { g = pg8::Gemm{HM, W1T, T, DFF, DM}; N = DFF; E = pg8::EpiAny{1, true, U, DFF, nullptr, 0, nullptr, nullptr}; }
            else { g = pg8::Gemm{U, W2T, T, DM, DFF}; N = DM; E = pg8::EpiAny{2, false, nullptr, DM, nullptr, 0, out, out}; }
            pg8::StaticOrder S; S.init(T, N, G, bid);
            pg8::gemm_phase<pg8::EpiAny, pg8::StaticOrder, true, true>((PG8_LAS unsigned char*)lds, g, S, E, tid);
        } else if (j == 1) {
            const float* cw = IN(3) + (size_t)l * 4 * 1024; const float* bif = IN(2) + l * 8;
            for (int it0 = 0; it0 < 128 * 14; it0 += NVB) { const int it = it0 + vb; ph_prep(P, tab, IN(5) + l * 128, IN(6) + l * 64, IN(7) + l * 192, kmean, it, it < 128 * 14, t256, (float*)smh); }
            for (int it0 = 0; it0 < NCMP * 8; it0 += NVB) { const int it = it0 + vb;
                ph_compress(P, IN(8) + (size_t)l * 2 * 32 * 64, IN(9) + (size_t)l * 2 * 2048 * 128, IN(10) + (size_t)l * 2 * 128 * 64, IN(7) + l * 192, KVc, it, it < NCMP * 8, t256, (float*)smh); }
            for (int it0 = 0; it0 < 2048; it0 += NVB) { const int it = it0 + vb; ph_mlstm_local(P, Gt, cw, bif, Cst, nst, dec, it, it < 2048, t256, smh); }
        } else if (j == 2) {
            for (int it = vb; it < 16 * 65; it += NVB) ph_mlstm_scan(Cst, nst, dec, it, t256);
            for (int gw = gwv; gw < NB * 4 * SEQ; gw += NGW) ph_moba(P, kmean, HM, gw, lane, (float*)(lds + wid * 4352));
            for (int gw = gwv; gw < NB * SEQ; gw += NGW) ph_nsa(P, Gt, tab, KVc, HM, gw, lane, (float*)(lds + wid * 4352));
        } else if (j == 3) {
            const float* cw = IN(3) + (size_t)l * 4 * 1024; const float* bif = IN(2) + l * 8;
            for (int it0 = 0; it0 < 2048; it0 += NVB) { const int it = it0 + vb; ph_mlstm_out(P, Gt, cw, bif, Cst, nst, IN(4) + l * 512, HM, it, it < 2048, t256, smh); }
        } else if (j == 5) {
            for (int row = gwv; row < T; row += NGW) ph_rmsnorm_row(out, IN(13) + l * DM, HM, row, lane);
        } else {
            for (int row = gwv; row < T; row += NGW) ph_rmsnorm_row(out, IN(12) + (l + 1) * DM, HM, row, lane);
        }
        if (ph + 1 < NPH) grid.sync();
    }
#undef IN
}

extern "C" void kernel_launch(void* const* d_in, const int* in_sizes, int n_in, void* d_out, int out_size, void* d_ws, size_t ws_size, hipStream_t stream) {
    static int grid = 0;
    if (grid == 0) {
        if (n_in != 16 || in_sizes[0] != T * DM || out_size != T * DM || ws_size < WS_END) { fprintf(stderr, "kernel_launch: unexpected shapes / workspace %zu < %zu\n", ws_size, (size_t)WS_END); grid = -1; return; }
        int dev = 0, cus = 0, per_cu = 0;
        if (hipGetDevice(&dev) != hipSuccess || hipDeviceGetAttribute(&cus, hipDeviceAttributeMultiprocessorCount, dev) != hipSuccess) { grid = -1; return; }
        if (hipFuncSetAttribute((const void*)hybrid_fwd, hipFuncAttributeMaxDynamicSharedMemorySize, LDS_BYTES) != hipSuccess) { fprintf(stderr, "kernel_launch: hipFuncSetAttribute failed\n"); grid = -1; return; }
        if (hipOccupancyMaxActiveBlocksPerMultiprocessor(&per_cu, (const void*)hybrid_fwd, 512, LDS_BYTES) != hipSuccess || per_cu < 1) { fprintf(stderr, "kernel_launch: occupancy query failed (%d)\n", per_cu); grid = -1; return; }
        grid = cus * per_cu;
        fprintf(stderr, "kernel_launch: grid %d (%d CUs x %d)\n", grid, cus, per_cu);
    }
    if (grid < 0) return;
    Params p{};
    for (int i = 0; i < 16; ++i) p.in[i] = (const float*)d_in[i];
    p.out = (float*)d_out; p.ws = (unsigned char*)d_ws;
    void* args[] = {&p};
    hipError_t e = hipLaunchCooperativeKernel((const void*)hybrid_fwd, dim3(grid), dim3(512), args, LDS_BYTES, stream);
    if (e != hipSuccess) fprintf(stderr, "kernel_launch: cooperative launch failed: %s (grid %d)\n", hipGetErrorString(e), grid);
}
```

```cpp
#include <hip/hip_runtime.h>
#include <hip/hip_cooperative_groups.h>
#include <cstdio>
#include <cstdint>
namespace cg = cooperative_groups;
namespace pg8 {
#define PG8_LAS __attribute__((address_space(3)))
typedef unsigned short bf16_t;
typedef short bf16x8 __attribute__((ext_vector_type(8)));
typedef float f32x4 __attribute__((ext_vector_type(4)));
typedef unsigned u32x4 __attribute__((ext_vector_type(4)));
constexpr int BM = 256, BK = 64, HALF = 128, HTB = HALF * BK * 2  , STAGE_BYTES = 8 * HTB, NXCD = 8, WGM = 8;

__host__ __device__ __forceinline__ int lds_byte(int r, int c) { const int st = (r >> 4) * 2 + (c >> 5), rr = r & 15, cc = c & 31, ob = rr * 64 + cc * 2; return st * 1024 + (ob ^ (((ob >> 9) & 1) << 5)); }
__host__ __device__ __forceinline__ void stage_rc(int b, int& R, int& C) { const int st = b / 1024, sb = b % 1024, swz = sb ^ (((sb >> 9) & 1) << 5); R = (st >> 1) * 16 + swz / 64; C = (st & 1) * 32 + (swz % 64) / 2; }
__host__ __device__ __forceinline__ int perm32(int rho) { const int n = rho >> 4, i = rho & 15; return 8 * (i >> 2) + 4 * n + (i & 3); }

struct Unit { int pm, pn; };
struct Gemm { const bf16_t* A; const bf16_t* Bt; int M, N, K; };

struct StaticOrder {
    int nM, nN, nwg, G, c;
    __host__ __device__ void init(int M, int N, int G_, int c_) { nM = M / BM; nN = N / BM; nwg = nM * nN; G = G_; c = c_; }
    __host__ __device__ bool next(int i, Unit& u) const {
        const long L = (long)i * G + c; if (L >= nwg) return false;
        int wgid = (int)L; { const int q = nwg / NXCD, r = nwg % NXCD, xcd = wgid % NXCD, off = wgid / NXCD; wgid = (xcd < r ? xcd * (q + 1) : r * (q + 1) + (xcd - r) * q) + off; }
        const int nig = WGM * nN, gid = wgid / nig, fm = gid * WGM, gsz = (nM - fm) < WGM ? (nM - fm) : WGM;
        u.pm = fm + ((wgid % nig) % gsz); u.pn = (wgid % nig) / gsz; return true;
    }
    __device__ __forceinline__ void a_ready(const Unit&) const {}
    __device__ __forceinline__ void done(const Unit&) const {}
};

__device__ __forceinline__ unsigned f2bf_u(float f) { unsigned u = __builtin_bit_cast(unsigned, f); return (u + 0x7fffu + ((u >> 16) & 1u)) >> 16; }
__device__ __forceinline__ unsigned pk2bf(float lo, float hi) { return f2bf_u(lo) | (f2bf_u(hi) << 16); }

struct EpiProj {
    static constexpr bool PERM = true, AFTER_DRAIN = false;
    bf16_t* O; int ldc; float* gates; int gate0;
    __device__ __forceinline__ void operator()(const f32x4 (&acc)[2][2][4][2], const Unit& u, int wr, int wc, int fr, int fq) const {
        const int row0 = u.pm * BM + wr * 64 + fr; const int col0 = u.pn * BM + wc * 32 + 8 * fq;
#pragma unroll
        for (int ai = 0; ai < 2; ++ai)
#pragma unroll
            for (int m = 0; m < 4; ++m) { const int row = row0 + ai * HALF + m * 16; bf16_t* rowp = O + (size_t)row * ldc + col0;
#pragma unroll
                for (int bj = 0; bj < 2; ++bj) { const f32x4 v0 = acc[ai][bj][m][0], v1 = acc[ai][bj][m][1];
                    u32x4 w; w.x = pk2bf(v0[0], v0[1]); w.y = pk2bf(v0[2], v0[3]); w.z = pk2bf(v1[0], v1[1]); w.w = pk2bf(v1[2], v1[3]);
                    *(u32x4*)(rowp + bj * HALF) = w;
                    const int c = col0 + bj * HALF - gate0;
                    if (c >= 0 && c < 32) { float* g = gates + (size_t)row * 32 + c; *(f32x4*)g = v0; *(f32x4*)(g + 4) = v1; } } }
    }
};
struct EpiRelu2 {
    static constexpr bool PERM = true, AFTER_DRAIN = false;
    bf16_t* O; int ldc;
    __device__ __forceinline__ void operator()(const f32x4 (&acc)[2][2][4][2], const Unit& u, int wr, int wc, int fr, int fq) const {
        const int row0 = u.pm * BM + wr * 64 + fr; const int col0 = u.pn * BM + wc * 32 + 8 * fq;
#pragma unroll
        for (int ai = 0; ai < 2; ++ai)
#pragma unroll
            for (int m = 0; m < 4; ++m) { const int row = row0 + ai * HALF + m * 16; bf16_t* rowp = O + (size_t)row * ldc + col0;
#pragma unroll
                for (int bj = 0; bj < 2; ++bj) { f32x4 v0 = acc[ai][bj][m][0], v1 = acc[ai][bj][m][1];
#pragma unroll
                    for (int e = 0; e < 4; ++e) { float a = v0[e] > 0.f ? v0[e] : 0.f; v0[e] = a * a; float b = v1[e] > 0.f ? v1[e] : 0.f; v1[e] = b * b; }
                    u32x4 w; w.x = pk2bf(v0[0], v0[1]); w.y = pk2bf(v0[2], v0[3]); w.z = pk2bf(v1[0], v1[1]); w.w = pk2bf(v1[2], v1[3]);
                    *(u32x4*)(rowp + bj * HALF) = w; } }
    }
};
struct EpiResid {
    static constexpr bool PERM = false, AFTER_DRAIN = false;
    const float* base; float* out; int ldc;
    __device__ __forceinline__ void operator()(const f32x4 (&acc)[2][2][4][2], const Unit& u, int wr, int wc, int fr, int fq) const {
        const int row0 = u.pm * BM + wr * 64 + fr; const int col0 = u.pn * BM + wc * 32 + 4 * fq;
#pragma unroll
        for (int ai = 0; ai < 2; ++ai)
#pragma unroll
            for (int m = 0; m < 4; ++m) { const size_t off = (size_t)(row0 + ai * HALF + m * 16) * ldc + col0;
#pragma unroll
                for (int bj = 0; bj < 2; ++bj)
#pragma unroll
                    for (int n = 0; n < 2; ++n) { const size_t o = off + bj * HALF + n * 16; const f32x4 b = *(const f32x4*)(base + o); *(f32x4*)(out + o) = b + acc[ai][bj][m][n]; } }
    }
};

struct EpiAny {
    static constexpr bool AFTER_DRAIN = false;
    int kind; bool perm;
    bf16_t* O; int ldc; float* gates; int gate0; const float* base; float* out;
    __device__ __forceinline__ void operator()(const f32x4 (&acc)[2][2][4][2], const Unit& u, int wr, int wc, int fr, int fq) const {
        if (kind == 0) { EpiProj e{O, ldc, gates, gate0}; e(acc, u, wr, wc, fr, fq); }
        else if (kind == 1) { EpiRelu2 e{O, ldc}; e(acc, u, wr, wc, fr, fq); }
        else { EpiResid e{base, out, ldc}; e(acc, u, wr, wc, fr, fq); }
    }
};
template <class Epi, class Sched, bool ALIGN_EPI = false, bool SP2 = false>
__device__ __forceinline__ void gemm_phase(PG8_LAS unsigned char* lds, const Gemm g, const Sched& S, const Epi& E, const int tid) {
    const int wid = __builtin_amdgcn_readfirstlane(tid >> 6), lane = tid & 63, wr = wid >> 2, wc = wid & 3, fr = lane & 15, fq = lane >> 4;
    const int K = g.K, nt = K / BK;
    unsigned voffA[2], voffB[2];
#pragma unroll
    for (int i = 0; i < 2; ++i) { int R, C; stage_rc(tid * 16 + i * 8192, R, C); const int Rb = E.perm ? ((R & ~31) + perm32(R & 31)) : R;
        voffA[i] = (unsigned)(R * K + C) * 2u; voffB[i] = (unsigned)(Rb * K + C) * 2u; }
    const size_t kstep = (size_t)(BK * 2);
    const size_t hstep = (size_t)HALF * K * 2;
    const size_t tstep = 2 * hstep;
    const unsigned ldsw = (unsigned)wid * 1024u;
    const int aoff = lds_byte(wr * 64 + fr, fq * 8), boff = lds_byte(wc * 32 + fr, fq * 8);
#define PG8_SA(b, h) (((b) * 2 + (h)) * HTB)
#define PG8_SB(b, h) ((4 + (b) * 2 + (h)) * HTB)
#define PG8_STAGE(bufoff, gbase, voff) do { _Pragma("unroll") for (int _i = 0; _i < 2; ++_i) \
        __builtin_amdgcn_global_load_lds((const unsigned*)((const char*)(gbase) + (voff)[_i]), (PG8_LAS unsigned*)(lds + (bufoff) + ldsw + _i * 8192), 16, 0, 0); } while (0)
#define PG8_LDA(dst, b, h) do { _Pragma("unroll") for (int m = 0; m < 4; ++m) _Pragma("unroll") for (int k = 0; k < 2; ++k) dst[m][k] = *(const PG8_LAS bf16x8*)(lds + PG8_SA(b, h) + aoff + m * 2048 + k * 1024); } while (0)
#define PG8_LDB(dst, b, h) do { _Pragma("unroll") for (int n = 0; n < 2; ++n) _Pragma("unroll") for (int k = 0; k < 2; ++k) dst[n][k] = *(const PG8_LAS bf16x8*)(lds + PG8_SB(b, h) + boff + n * 2048 + k * 1024); } while (0)
#define PG8_MMA(ai, bj, At, Bt) do { __builtin_amdgcn_s_setprio(1); _Pragma("unroll") for (int m = 0; m < 4; ++m) _Pragma("unroll") for (int n = 0; n < 2; ++n) _Pragma("unroll") for (int k = 0; k < 2; ++k) \
        acc[ai][bj][m][n] = __builtin_amdgcn_mfma_f32_16x16x32_bf16(Bt[n][k], At[m][k], acc[ai][bj][m][n], 0, 0, 0); __builtin_amdgcn_s_setprio(0); } while (0)
#define PG8_WAIT_V(n) asm volatile("s_waitcnt vmcnt(" #n ")" ::: "memory")
#define PG8_WAIT_L(n) asm volatile("s_waitcnt lgkmcnt(" #n ")" ::: "memory")
#define PG8_BAR __builtin_amdgcn_s_barrier()
#define PG8_SCHED __builtin_amdgcn_sched_barrier(0)
    Unit cur, nxt; int ui = 0;
    if (!S.next(0, cur)) return;
    f32x4 acc[2][2][4][2];
#pragma unroll
    for (int a = 0; a < 2; ++a)
#pragma unroll
        for (int b = 0; b < 2; ++b)
#pragma unroll
            for (int m = 0; m < 4; ++m)
#pragma unroll
                for (int n = 0; n < 2; ++n) acc[a][b][m][n] = (f32x4){0.f, 0.f, 0.f, 0.f};
    bf16x8 At[4][2], B0[2][2], B1[2][2];
    const char* cA = (const char*)g.A + (size_t)cur.pm * tstep; const char* cB = (const char*)g.Bt + (size_t)cur.pn * tstep;
    S.a_ready(cur);
    if constexpr (SP2) {
        PG8_STAGE(PG8_SB(0, 0), cB, voffB); PG8_STAGE(PG8_SB(0, 1), cB + hstep, voffB); PG8_STAGE(PG8_SA(0, 0), cA, voffA); PG8_STAGE(PG8_SA(0, 1), cA + hstep, voffA);
        if (wr == 1) PG8_BAR;
        PG8_WAIT_V(2); PG8_BAR;
        PG8_STAGE(PG8_SB(1, 0), cB + kstep, voffB); PG8_STAGE(PG8_SA(1, 0), cA + kstep, voffA); PG8_STAGE(PG8_SB(1, 1), cB + hstep + kstep, voffB);
        PG8_WAIT_V(6); PG8_BAR;
    } else {
        PG8_STAGE(PG8_SB(0, 0), cB, voffB); PG8_STAGE(PG8_SA(0, 0), cA, voffA); PG8_STAGE(PG8_SB(0, 1), cB + hstep, voffB); PG8_STAGE(PG8_SA(0, 1), cA + hstep, voffA);
        if (wr == 1) PG8_BAR;
        PG8_WAIT_V(4); PG8_BAR;
        PG8_STAGE(PG8_SB(1, 0), cB + kstep, voffB); PG8_STAGE(PG8_SA(1, 0), cA + kstep, voffA); PG8_STAGE(PG8_SB(1, 1), cB + hstep + kstep, voffB);
        PG8_WAIT_V(6); PG8_BAR;
    }
    for (;;) {
        const bool has_next = S.next(ui + 1, nxt);
        const char* nA = has_next ? (const char*)g.A + (size_t)nxt.pm * tstep : cA; const char* nB = has_next ? (const char*)g.Bt + (size_t)nxt.pn * tstep : cB;
        for (int t = 0; t < nt; t += 2) {
            const bool last = (t == nt - 2);
            const char* a1 = cA + (size_t)(t + 1) * kstep;
            const char* a2 = last ? nA : cA + (size_t)(t + 2) * kstep; const char* b2 = last ? nB : cB + (size_t)(t + 2) * kstep;
            const char* a3 = a2 + kstep; const char* b3 = b2 + kstep;
            if (last && has_next) S.a_ready(nxt);
            if constexpr (SP2) {
            PG8_LDB(B0, 0, 0); PG8_LDB(B1, 0, 1); PG8_SCHED; PG8_LDA(At, 0, 0); PG8_STAGE(PG8_SA(1, 1), a1 + hstep, voffA);
            PG8_WAIT_V(8); PG8_WAIT_L(0); PG8_BAR; PG8_MMA(0, 0, At, B0); PG8_MMA(0, 1, At, B1); PG8_BAR; PG8_SCHED;
            PG8_LDA(At, 0, 1); PG8_STAGE(PG8_SB(0, 0), b2, voffB); PG8_STAGE(PG8_SB(0, 1), b2 + hstep, voffB); PG8_STAGE(PG8_SA(0, 0), a2, voffA);
            PG8_WAIT_V(8); PG8_WAIT_L(0); PG8_BAR; PG8_MMA(1, 0, At, B0); PG8_MMA(1, 1, At, B1); PG8_BAR; PG8_SCHED;
            PG8_LDB(B0, 1, 0); PG8_LDB(B1, 1, 1); PG8_SCHED; PG8_LDA(At, 1, 0); PG8_STAGE(PG8_SA(0, 1), a2 + hstep, voffA);
            PG8_WAIT_V(8); PG8_WAIT_L(0); PG8_BAR; PG8_MMA(0, 0, At, B0); PG8_MMA(0, 1, At, B1); PG8_BAR; PG8_SCHED;
            PG8_LDA(At, 1, 1); PG8_STAGE(PG8_SB(1, 0), b3, voffB); PG8_STAGE(PG8_SB(1, 1), b3 + hstep, voffB); PG8_STAGE(PG8_SA(1, 0), a3, voffA);
            PG8_WAIT_V(8); PG8_WAIT_L(0); PG8_BAR; PG8_MMA(1, 0, At, B0); PG8_MMA(1, 1, At, B1); PG8_BAR; PG8_SCHED;
            } else {
            PG8_LDB(B0, 0, 0); PG8_SCHED; PG8_LDA(At, 0, 0); PG8_STAGE(PG8_SA(1, 1), a1 + hstep, voffA);
            PG8_WAIT_L(8); PG8_BAR; PG8_WAIT_L(0); PG8_MMA(0, 0, At, B0); PG8_BAR; PG8_SCHED;
            PG8_LDB(B1, 0, 1); PG8_STAGE(PG8_SB(0, 0), b2, voffB);
            PG8_BAR; PG8_WAIT_L(0); PG8_MMA(0, 1, At, B1); PG8_BAR;
            PG8_LDA(At, 0, 1); PG8_STAGE(PG8_SA(0, 0), a2, voffA);
            PG8_BAR; PG8_WAIT_L(0); PG8_MMA(1, 0, At, B0); PG8_BAR; PG8_SCHED;
            PG8_STAGE(PG8_SB(0, 1), b2 + hstep, voffB);
            PG8_WAIT_V(6); PG8_BAR; PG8_MMA(1, 1, At, B1); PG8_BAR;
            PG8_LDB(B0, 1, 0); PG8_SCHED; PG8_LDA(At, 1, 0); PG8_STAGE(PG8_SA(0, 1), a2 + hstep, voffA);
            PG8_WAIT_L(8); PG8_BAR; PG8_WAIT_L(0); PG8_MMA(0, 0, At, B0); PG8_BAR; PG8_SCHED;
            PG8_LDB(B1, 1, 1); PG8_STAGE(PG8_SB(1, 0), b3, voffB);
            PG8_BAR; PG8_WAIT_L(0); PG8_MMA(0, 1, At, B1); PG8_BAR;
            PG8_LDA(At, 1, 1); PG8_STAGE(PG8_SA(1, 0), a3, voffA);
            PG8_BAR; PG8_WAIT_L(0); PG8_MMA(1, 0, At, B0); PG8_BAR; PG8_SCHED;
            PG8_STAGE(PG8_SB(1, 1), b3 + hstep, voffB);
            PG8_WAIT_V(6); PG8_BAR; PG8_MMA(1, 1, At, B1); PG8_BAR;
            }
        }
        if constexpr (ALIGN_EPI) { if (wr == 0) PG8_BAR; }
        if constexpr (!Epi::AFTER_DRAIN) { E(acc, cur, wr, wc, fr, fq); S.done(cur); }
        if (!has_next) break;
#pragma unroll
        for (int a = 0; a < 2; ++a)
#pragma unroll
            for (int b = 0; b < 2; ++b)
#pragma unroll
                for (int m = 0; m < 4; ++m)
#pragma unroll
                    for (int n = 0; n < 2; ++n) acc[a][b][m][n] = (f32x4){0.f, 0.f, 0.f, 0.f};
        cur = nxt; cA = nA; cB = nB; ++ui;
        if constexpr (ALIGN_EPI) { if (wr == 1) PG8_BAR; }
    }
    PG8_WAIT_V(0);
    if constexpr (!ALIGN_EPI) { if (wr == 0) PG8_BAR; }
    PG8_BAR;
    if constexpr (Epi::AFTER_DRAIN) { E.fused(acc, cur, wr, wc, fr, fq, lds, wid, lane); S.done(cur); }
#undef PG8_SA
#undef PG8_SB
#undef PG8_STAGE
#undef PG8_LDA
#undef PG8_LDB
#undef PG8_MMA
#undef PG8_WAIT_V
#undef PG8_WAIT_L
#undef PG8_BAR
#undef PG8_SCHED
}
}

typedef unsigned short bf16;
constexpr int NB = 4, SEQ = 8192, T = NB * SEQ, DM = 1024, DFF = 4096, DEPTH = 2;
constexpr int DIN = 3476, DINP = 3584;
constexpr int C_MQ = 0, C_MK = 512, C_MV = 1024, C_MO = 1536, C_BQ = 2048, C_BK = 2304, C_BV = 2560, C_NQ = 2816,
              C_NKC = 3072, C_NVC = 3136, C_NKS = 3200, C_NVS = 3264, C_NKW = 3328, C_NVW = 3392, C_GATE = 3456;
constexpr int NCMP = 511;
constexpr float EPS = 1e-6f;

__device__ __forceinline__ float bf2f(bf16 v) { return __builtin_bit_cast(float, (unsigned)v << 16); }
__device__ __forceinline__ bf16 f2bf(float f) { return (bf16)pg8::f2bf_u(f); }
template <int MASK> __device__ __forceinline__ float shx(float v) {
    if constexpr (MASK == 32) { auto rr = __builtin_amdgcn_permlane32_swap(__float_as_uint(v), __float_as_uint(v), false, false);
        return __uint_as_float(__builtin_amdgcn_mbcnt_lo(~0u, 0u) == 32u ? rr[0] : rr[1]); }
    else return __uint_as_float((unsigned)__builtin_amdgcn_ds_swizzle((int)__float_as_uint(v), 0x1F | (MASK << 10)));
}
template <int MASK> __device__ __forceinline__ unsigned shxu(unsigned v) { return __float_as_uint(shx<MASK>(__uint_as_float(v))); }
__device__ __forceinline__ float wave_sum(float v) {
    v += shx<1>(v); v += shx<2>(v); v += shx<4>(v); v += shx<8>(v); v += shx<16>(v);
    auto rr = __builtin_amdgcn_permlane32_swap(__float_as_uint(v), __float_as_uint(v), false, false); return __uint_as_float(rr[0]) + __uint_as_float(rr[1]);
}
__device__ __forceinline__ float wave_max(float v) {
    v = fmaxf(v, shx<1>(v)); v = fmaxf(v, shx<2>(v)); v = fmaxf(v, shx<4>(v)); v = fmaxf(v, shx<8>(v)); v = fmaxf(v, shx<16>(v));
    auto rr = __builtin_amdgcn_permlane32_swap(__float_as_uint(v), __float_as_uint(v), false, false); return fmaxf(__uint_as_float(rr[0]), __uint_as_float(rr[1]));
}
__device__ __forceinline__ float rcpf_(float x) { return __builtin_amdgcn_rcpf(x); }
__device__ __forceinline__ float sigmoidf_(float x) { return rcpf_(1.f + __expf(-x)); }
__device__ __forceinline__ float log_sigmoidf_(float x) { return fminf(x, 0.f) - __logf(1.f + __expf(-fabsf(x))); }
__device__ __forceinline__ void rope_cs(int pos, int f, float& c, float& s) {
    const float invf = f == 0 ? 1.0f : f == 1 ? 0.193922758102417f : f == 2 ? 0.03760603442788124f : f == 3 ? 0.007292666472494602f : f == 4 ? 0.0014142136787995696f
                     : f == 5 ? 0.00027424818836152554f : f == 6 ? 5.318298644851893e-05f : 1.031338433676865e-05f;
    const float ang = (float)pos * invf;
    const float k = rintf(ang * 0.15915493667125702f);
    float r = fmaf(-k, 6.2831854820251465f, ang); r = fmaf(-k, -1.7484555314695172e-07f, r);
    c = __cosf(r); s = __sinf(r);
}


__device__ __forceinline__ float dot64(const bf16* __restrict__ kp, const float* q) {
    const uint4* k4 = (const uint4*)kp; float a = 0.f;
#pragma unroll
    for (int j = 0; j < 8; ++j) { const uint4 w = k4[j]; const unsigned ww[4] = {w.x, w.y, w.z, w.w};
#pragma unroll
        for (int e = 0; e < 4; ++e) { a = fmaf(q[8 * j + 2 * e], __builtin_bit_cast(float, ww[e] << 16), a); a = fmaf(q[8 * j + 2 * e + 1], __builtin_bit_cast(float, ww[e] & 0xffff0000u), a); } }
    return a;
}
__device__ __forceinline__ void dot64x4(const bf16* __restrict__ kp, const float (*q)[64], float (&a)[4]) {
    const uint4* k4 = (const uint4*)kp; a[0] = a[1] = a[2] = a[3] = 0.f;
#pragma unroll
    for (int j = 0; j < 8; ++j) { const uint4 w = k4[j]; const unsigned ww[4] = {w.x, w.y, w.z, w.w};
#pragma unroll
        for (int e = 0; e < 4; ++e) { const float k0 = __builtin_bit_cast(float, ww[e] << 16), k1 = __builtin_bit_cast(float, ww[e] & 0xffff0000u);
#pragma unroll
            for (int h = 0; h < 4; ++h) { a[h] = fmaf(q[h][8 * j + 2 * e], k0, a[h]); a[h] = fmaf(q[h][8 * j + 2 * e + 1], k1, a[h]); } } }
}

__host__ __device__ __forceinline__ int win_src(int n) {
    if (n < 2048) return n;
    if (n < 3456) return n + 8;
    if (n < 3464) return n - 3456 + 2048;
    if (n < 3476) return n;
    return -1;
}


__device__ __forceinline__ void ph_convert_w(const float* __restrict__ W, int K, int N, int NP, bf16* __restrict__ WT, int mode, int item, bool act, int t, float* tile  ) {
    const int nbx = NP / 64; const int n0 = (item % nbx) * 64, k0 = (item / nbx) * 64, c = t & 63, r = t >> 6;
    if (act) { const int src = mode ? win_src(n0 + c) : (n0 + c);
#pragma unroll 4
        for (int i = 0; i < 16; ++i) { const int k = r + 4 * i; tile[k * 65 + c] = (src >= 0) ? W[(size_t)(k0 + k) * N + src] : 0.f; } }
    __syncthreads();
    if (act) {
#pragma unroll 4
        for (int i = 0; i < 16; ++i) { const int n = r + 4 * i; WT[(size_t)(n0 + n) * K + k0 + c] = f2bf(tile[c * 65 + n]); } }
    __syncthreads();
}
__device__ __forceinline__ void ph_rmsnorm_row(const float* __restrict__ x, const float* __restrict__ g, bf16* __restrict__ H, int row, int lane) {
    const float4* xr = (const float4*)(x + (size_t)row * DM) + lane;
    float4 v[4]; float s = 0.f;
#pragma unroll
    for (int j = 0; j < 4; ++j) { v[j] = xr[64 * j]; s += v[j].x * v[j].x + v[j].y * v[j].y + v[j].z * v[j].z + v[j].w * v[j].w; }
    const float rstd = rsqrtf(wave_sum(s) * (1.f / DM) + EPS);
    uint2* o = (uint2*)(H + (size_t)row * DM) + lane;
#pragma unroll
    for (int j = 0; j < 4; ++j) { const float4 gg = ((const float4*)g)[lane + 64 * j];
        uint2 w; w.x = pg8::pk2bf(v[j].x * rstd * gg.x, v[j].y * rstd * gg.y); w.y = pg8::pk2bf(v[j].z * rstd * gg.z, v[j].w * rstd * gg.w); o[64 * j] = w; }
}
__device__ __forceinline__ void ph_prep(bf16* __restrict__ P, const float* __restrict__ tab, const float* __restrict__ moba_g, const float* __restrict__ nsa_qg, const float* __restrict__ nsa_kg,
                                        float* __restrict__ kmean, int item, bool act, int t, float* red  ) {
    const int lane = t & 63, wid = t >> 6, tb = item % 128, kind = item / 128;
    float ksum = 0.f;
    if (act) {
        int col; const float* g; bool rope;
        if (kind < 4) { col = C_BQ + kind * 64; g = moba_g; rope = true; }
        else if (kind < 8) { col = C_BK + (kind - 4) * 64; g = moba_g + 64; rope = true; }
        else if (kind < 12) { col = C_NQ + (kind - 8) * 64; g = nsa_qg; rope = false; }
        else if (kind == 12) { col = C_NKS; g = nsa_kg + 64; rope = true; }
        else { col = C_NKW; g = nsa_kg + 128; rope = true; }
        const float gd = g[lane];
        for (int i = 0; i < 64; ++i) {
            const int row = tb * 256 + wid * 64 + i, pos = row & (SEQ - 1);
            bf16* p = P + (size_t)row * DINP + col + lane;
            const float x = bf2f(*p);
            const float ss = wave_sum(x * x);
            float y = x * rsqrtf(ss * (1.f / 64.f) + EPS) * gd;
            if (rope) {
                const float other = shx<8>(y);
                if (lane < 16) { const int f = lane & 7; const float c = tab[pos * 16 + f], s = tab[pos * 16 + 8 + f];
                    y = (lane < 8) ? (y * c - other * s) : (y * c + other * s); }
            }
            *p = f2bf(y);
            ksum += y;
        }
        red[wid * 64 + lane] = ksum;
    }
    __syncthreads();
    if (act && kind >= 4 && kind < 8 && wid == 0) { const float s = red[lane] + red[64 + lane] + red[128 + lane] + red[192 + lane];
        const int b = tb >> 5, n = tb & 31; kmean[(((size_t)b * 4 + (kind - 4)) * 32 + n) * 64 + lane] = s * (1.f / 256.f); }
    __syncthreads();
}
__device__ __forceinline__ void ph_compress(const bf16* __restrict__ P, const float* __restrict__ pe, const float* __restrict__ w1, const float* __restrict__ w2, const float* __restrict__ kg0,
                                            float* __restrict__ KVc, bf16* __restrict__ KVcb, int item, bool act, int t, float* sm  ) {
    float* in = sm; float* hid = sm + 2048;
    const int i = item % NCMP, b = (item / NCMP) & 3, kv = item / (NCMP * 4);
    const int col = kv ? C_NVC : C_NKC;
    if (act) for (int e = t; e < 2048; e += 256) { const int p = e >> 6, d = e & 63; in[e] = bf2f(P[(size_t)(b * SEQ + 16 * i + p) * DINP + col + d]) + pe[(kv * 32 + p) * 64 + d]; }
    __syncthreads();
    if (act && t < 128) { const float* w = w1 + (size_t)kv * 2048 * 128 + t; float a = 0.f;
#pragma unroll 8
        for (int k = 0; k < 2048; ++k) a = fmaf(in[k], w[(size_t)k * 128], a);
        hid[t] = a * rcpf_(1.f + __expf(-a)); }
    __syncthreads();
    if (act && t < 64) { const float* ww = w2 + (size_t)kv * 128 * 64 + t; float o = 0.f;
#pragma unroll 8
        for (int j = 0; j < 128; ++j) o = fmaf(hid[j], ww[j * 64], o);
        if (kv == 0) { const float ss = wave_sum(o * o); o = o * rsqrtf(ss * (1.f / 64.f) + EPS) * kg0[t]; }
        KVc[(((size_t)kv * NB + b) * 512 + i) * 64 + t] = o; KVcb[(((size_t)kv * NB + b) * 512 + i) * 64 + t] = f2bf(o);
        if (i == NCMP - 1) KVcb[(((size_t)kv * NB + b) * 512 + NCMP) * 64 + t] = 0; }
    __syncthreads();
}
__device__ __forceinline__ float conv_silu(const bf16* __restrict__ P, const float* __restrict__ cw  , int rowbase, int t, int c) {
    float a = 0.f;
#pragma unroll
    for (int j = 0; j < 4; ++j) { const int tt = t - 3 + j; if (tt >= 0) a = fmaf(cw[j * 1024 + c], bf2f(P[(size_t)(rowbase + tt) * DINP + c]), a); }
    return a * rcpf_(1.f + __expf(-a));
}
__device__ __forceinline__ void ph_mlstm_local(const bf16* __restrict__ P, const float* __restrict__ G, const float* __restrict__ cw, const float* __restrict__ bif,
                                               float* __restrict__ Cst, float* __restrict__ nst, float* __restrict__ dec, int u, bool act, int tid, unsigned char* sm) {
    bf16 (*ks)[128] = (bf16 (*)[128])sm; bf16 (*vs)[128] = (bf16 (*)[128])(sm + 16384); float* wS = (float*)(sm + 32768); float* lf = wS + 64;
    const int c = u & 127, h = (u >> 7) & 3, b = u >> 9;
    const int rowbase = b * SEQ, t0 = c * 64;
    if (act) {
        for (int e = tid; e < 64 * 128; e += 256) { const int s = e >> 7, d = e & 127;
            ks[s][d] = f2bf(conv_silu(P, cw, rowbase, t0 + s, 512 + h * 128 + d) * 0.08838834764831845f);
            vs[s][d] = P[(size_t)(rowbase + t0 + s) * DINP + C_MV + h * 128 + d]; }
        if (tid < 64) lf[tid] = log_sigmoidf_(G[(size_t)(rowbase + t0 + tid) * 32 + 4 + h] + bif[4 + h]);
    }
    __syncthreads();
    if (act && tid == 0) { float acc = 0.f;
        for (int s = 0; s < 64; ++s) { acc += lf[s]; lf[s] = acc; }
        dec[u] = __expf(acc); }
    __syncthreads();
    if (act && tid < 64) wS[tid] = __expf(lf[63] - lf[tid] + G[(size_t)(rowbase + t0 + tid) * 32 + h] + bif[h]);
    __syncthreads();
    if (act) {
        const int d = tid >> 1, e0 = (tid & 1) * 64;
        float acc[64];
#pragma unroll
        for (int e = 0; e < 64; ++e) acc[e] = 0.f;
        float an = 0.f;
        for (int s = 0; s < 64; ++s) { const float kw = wS[s] * bf2f(ks[s][d]); an += kw;
#pragma unroll
            for (int e = 0; e < 64; ++e) acc[e] = fmaf(kw, bf2f(vs[s][e0 + e]), acc[e]); }
        float* o = Cst + ((size_t)u * 128 + d) * 128 + e0;
#pragma unroll
        for (int e = 0; e < 64; ++e) o[e] = acc[e];
        if ((tid & 1) == 0) nst[(size_t)u * 128 + d] = an;
    }
    __syncthreads();
}
__device__ __forceinline__ void ph_mlstm_scan(float* __restrict__ Cst, float* __restrict__ nst, const float* __restrict__ dec, int item, int tid) {
    const int bh = item / 65, part = item % 65;
    float* base; int stride;
    if (part < 64) { base = Cst + (size_t)bh * 128 * 16384 + part * 256 + tid; stride = 16384; }
    else { if (tid >= 128) return; base = nst + (size_t)bh * 128 * 128 + tid; stride = 128; }
    float C = 0.f;
    for (int c = 0; c < 128; ++c) { const float dC = base[(size_t)c * stride]; base[(size_t)c * stride] = C; C = dec[bh * 128 + c] * C + dC; }
}
__device__ __forceinline__ void ph_mlstm_out(const bf16* __restrict__ P, const float* __restrict__ G, const float* __restrict__ cw, const float* __restrict__ bif,
                                             const float* __restrict__ Cst, const float* __restrict__ nst, const float* __restrict__ mnorm, bf16* __restrict__ MIX, int u, bool act, int tid, unsigned char* sm) {
    bf16 (*qs)[128] = (bf16 (*)[128])sm; float* ksS = (float*)(sm + 16384); bf16 (*ks)[128] = (bf16 (*)[128])ksS; bf16 (*vs)[128] = (bf16 (*)[128])(sm + 32768);
    float* bb = (float*)(sm + 49152); float* li = bb + 64;
    const int c = u & 127, h = (u >> 7) & 3, b = u >> 9;
    const int rowbase = b * SEQ, t0 = c * 64;
    if (act) {
        for (int e = tid; e < 64 * 128; e += 256) { const int s = e >> 7, d = e & 127;
            qs[s][d] = f2bf(conv_silu(P, cw, rowbase, t0 + s, h * 128 + d));
            ks[s][d] = f2bf(conv_silu(P, cw, rowbase, t0 + s, 512 + h * 128 + d) * 0.08838834764831845f);
            vs[s][d] = P[(size_t)(rowbase + t0 + s) * DINP + C_MV + h * 128 + d]; }
        if (tid < 64) { bb[tid] = log_sigmoidf_(G[(size_t)(rowbase + t0 + tid) * 32 + 4 + h] + bif[4 + h]); li[tid] = G[(size_t)(rowbase + t0 + tid) * 32 + h] + bif[h]; }
    }
    __syncthreads();
    if (act && tid == 0) { float acc = 0.f; for (int s = 0; s < 64; ++s) { acc += bb[s]; bb[s] = acc; } }
    __syncthreads();
    const int t = tid >> 2, part = tid & 3;
    float sreg[16];
    if (act) {
        const int s0 = part * 16;
#pragma unroll
        for (int j = 0; j < 16; ++j) { const int s = s0 + j; float a = 0.f;
            if (s <= t) { for (int d = 0; d < 128; ++d) a = fmaf(bf2f(qs[t][d]), bf2f(ks[s][d]), a); a *= __expf(bb[t] - bb[s] + li[s]); }
            sreg[j] = a; }
    }
    __syncthreads();
    float* S = ksS;
    if (act) {
#pragma unroll
        for (int j = 0; j < 16; ++j) S[t * 64 + part * 16 + j] = sreg[j];
    }
    __syncthreads();
    if (act) {
        const float Ft = __expf(bb[t]);
        float den = 0.f;
        for (int s = 0; s <= t; ++s) den += S[t * 64 + s];
        { const float* np = nst + (size_t)u * 128; float a = 0.f; for (int d = 0; d < 128; ++d) a = fmaf(bf2f(qs[t][d]), np[d], a); den += Ft * a; }
        const int e0 = part * 32;
        float acc[32];
#pragma unroll
        for (int e = 0; e < 32; ++e) acc[e] = 0.f;
        { const float* Cp = Cst + (size_t)u * 16384 + e0;
          for (int d = 0; d < 128; ++d) { const float qd = bf2f(qs[t][d]);
#pragma unroll
              for (int e = 0; e < 32; ++e) acc[e] = fmaf(qd, Cp[d * 128 + e], acc[e]); } }
#pragma unroll
        for (int e = 0; e < 32; ++e) acc[e] *= Ft;
        for (int s = 0; s <= t; ++s) { const float w = S[t * 64 + s];
#pragma unroll
            for (int e = 0; e < 32; ++e) acc[e] = fmaf(w, bf2f(vs[s][e0 + e]), acc[e]); }
        const float inv = rcpf_(fmaxf(fabsf(den), 1.f));
        float ss = 0.f;
#pragma unroll
        for (int e = 0; e < 32; ++e) { acc[e] *= inv; ss += acc[e] * acc[e]; }
        ss += shx<1>(ss); ss += shx<2>(ss);
        const float rstd = rsqrtf(ss * (1.f / 128.f) + EPS);
        const size_t row = (size_t)(rowbase + t0 + t);
#pragma unroll
        for (int e = 0; e < 32; ++e) { const int cc = h * 128 + e0 + e;
            const float o = sigmoidf_(bf2f(P[row * DINP + C_MO + cc]));
            MIX[row * DM + cc] = f2bf(acc[e] * rstd * mnorm[cc] * o); }
    }
    __syncthreads();
}

__device__ __forceinline__ void ph_moba(const bf16* __restrict__ P, const float* __restrict__ kmean, bf16* __restrict__ MIX, int gw, int lane, float* q) {
    const int bh = gw >> 13, tq = gw & (SEQ - 1), b = bh >> 2, h = bh & 3, own = tq >> 8;
    const size_t row = (size_t)b * SEQ + tq;
    __builtin_amdgcn_s_waitcnt(0); __builtin_amdgcn_wave_barrier();
    q[lane] = bf2f(P[row * DINP + C_BQ + h * 64 + lane]);
    __builtin_amdgcn_s_waitcnt(0); __builtin_amdgcn_wave_barrier();
    float gs = -3.0e38f;
    if (lane < 32) { if (lane < own) { const float* km = kmean + (((size_t)b * 4 + h) * 32 + lane) * 64; float a = 0.f; for (int d = 0; d < 64; ++d) a = fmaf(q[d], km[d], a); gs = a; } else gs = -1e30f; }
    int blk[4]; bool val[4];
#pragma unroll
    for (int r = 0; r < 3; ++r) { const float m = wave_max(gs); const unsigned long long bal = __ballot(gs == m); const int idx = __ffsll((long long)bal) - 1;
        blk[r] = idx; val[r] = (r < own); if (lane == idx) gs = -3.0e38f; }
    blk[3] = own; val[3] = true;
    float s[4][4]; float mx = -1e30f;
#pragma unroll
    for (int g = 0; g < 4; ++g)
#pragma unroll
        for (int i = 0; i < 4; ++i) { float a = -1e30f;
            if (val[g]) { const int pos = blk[g] * 256 + i * 64 + lane;
                if (g < 3 || pos <= tq) { const bf16* kp = P + ((size_t)b * SEQ + pos) * DINP + C_BK + h * 64; a = dot64(kp, q) * 0.125f; } }
            s[g][i] = a; mx = fmaxf(mx, a); }
    mx = wave_max(mx);
    float l = 0.f;
#pragma unroll
    for (int g = 0; g < 4; ++g)
#pragma unroll
        for (int i = 0; i < 4; ++i) { const float p = (s[g][i] > -1e29f) ? __expf(s[g][i] - mx) : 0.f; s[g][i] = p; l += p; }
    l = wave_sum(l);
    float o = 0.f;
#pragma unroll
    for (int g = 0; g < 4; ++g) { if (!val[g]) continue;
#pragma unroll
        for (int i = 0; i < 4; ++i) { const bf16* vp = P + ((size_t)b * SEQ + blk[g] * 256 + i * 64) * DINP + C_BV + h * 64 + lane;
            for (int src = 0; src < 64; ++src) { const float p = __shfl(s[g][i], src); o = fmaf(p, bf2f(vp[(size_t)src * DINP]), o); } } }
    MIX[row * DM + 512 + h * 64 + lane] = f2bf(o * rcpf_(l));
}

__device__ __forceinline__ void ph_nsa(const bf16* __restrict__ P, const float* __restrict__ G, const float* __restrict__ tab, const float* __restrict__ KVc, bf16* __restrict__ MIX, int gw, int lane, float* sm) {
    float (*qn)[64] = (float (*)[64])sm; float (*qr)[64] = (float (*)[64])(sm + 256); float* ps = sm + 512;
    const int b = gw >> 13, tq = gw & (SEQ - 1), blkq = tq >> 6;
    const size_t row = (size_t)b * SEQ + tq;
    __builtin_amdgcn_s_waitcnt(0); __builtin_amdgcn_wave_barrier();
#pragma unroll
    for (int h = 0; h < 4; ++h) { const float x = bf2f(P[row * DINP + C_NQ + h * 64 + lane]); qn[h][lane] = x;
        float y = x; const float other = shx<8>(x);
        if (lane < 16) { const int f = lane & 7; const float c = tab[tq * 16 + f], s = tab[tq * 16 + 8 + f]; y = (lane < 8) ? (x * c - other * s) : (x * c + other * s); }
        qr[h][lane] = y; }
    __builtin_amdgcn_s_waitcnt(0); __builtin_amdgcn_wave_barrier();
    const float* Kc = KVc + (size_t)b * 512 * 64; const float* Vc = KVc + ((size_t)NB + b) * 512 * 64;
    float out[4] = {0.f, 0.f, 0.f, 0.f};
    float gate[3][4];
#pragma unroll
    for (int br = 0; br < 3; ++br)
#pragma unroll
        for (int h = 0; h < 4; ++h) gate[br][h] = sigmoidf_(G[row * 32 + 8 + br * 4 + h]);
    const int ncv = (tq >= 31) ? ((tq - 31) >> 4) + 1 : 0;
    {
        float sc[8][4]; float mx[4] = {-1e30f, -1e30f, -1e30f, -1e30f};
#pragma unroll
        for (int i = 0; i < 8; ++i) { const int c = i * 64 + lane;
            float a[4] = {-1e30f, -1e30f, -1e30f, -1e30f};
            if (c < ncv) { const float* kp = Kc + (size_t)c * 64; a[0] = a[1] = a[2] = a[3] = 0.f;
                for (int d = 0; d < 64; ++d) { const float kd = kp[d]; a[0] = fmaf(qn[0][d], kd, a[0]); a[1] = fmaf(qn[1][d], kd, a[1]); a[2] = fmaf(qn[2][d], kd, a[2]); a[3] = fmaf(qn[3][d], kd, a[3]); }
#pragma unroll
                for (int h = 0; h < 4; ++h) a[h] *= 0.125f; }
#pragma unroll
            for (int h = 0; h < 4; ++h) { sc[i][h] = a[h]; mx[h] = fmaxf(mx[h], a[h]); } }
        float l[4];
#pragma unroll
        for (int h = 0; h < 4; ++h) { mx[h] = wave_max(mx[h]); l[h] = 0.f; }
#pragma unroll
        for (int i = 0; i < 8; ++i) { const int c = i * 64 + lane;
#pragma unroll
            for (int h = 0; h < 4; ++h) { const float p = (c < ncv) ? __expf(sc[i][h] - mx[h]) : 0.f; sc[i][h] = p; l[h] += p; } }
#pragma unroll
        for (int h = 0; h < 4; ++h) { l[h] = wave_sum(l[h]); l[h] = (l[h] > 0.f) ? rcpf_(l[h]) : 0.f; }
#pragma unroll
        for (int i = 0; i < 8; ++i) { float su = 0.f;
#pragma unroll
            for (int h = 0; h < 4; ++h) { sc[i][h] *= l[h]; su += sc[i][h]; }
            ps[i * 64 + lane] = su; }
        if (lane < 4) ps[512 + lane] = 0.f;
        float oc[4] = {0.f, 0.f, 0.f, 0.f};
#pragma unroll
        for (int i = 0; i < 8; ++i) { if (i * 64 >= ncv) break; const int nn = min(64, ncv - i * 64);
            for (int src = 0; src < nn; ++src) { const float v = Vc[(size_t)(i * 64 + src) * 64 + lane];
                oc[0] = fmaf(__shfl(sc[i][0], src), v, oc[0]); oc[1] = fmaf(__shfl(sc[i][1], src), v, oc[1]);
                oc[2] = fmaf(__shfl(sc[i][2], src), v, oc[2]); oc[3] = fmaf(__shfl(sc[i][3], src), v, oc[3]); } }
#pragma unroll
        for (int h = 0; h < 4; ++h) out[h] = gate[0][h] * oc[h];
    }
    __builtin_amdgcn_s_waitcnt(0); __builtin_amdgcn_wave_barrier();
    int sidx[16];
    {
        float v0, v1;
        { const int n = lane; float im = 0.f;
#pragma unroll
          for (int j = -1; j < 4; ++j) { const int c = 4 * n + j; if (c >= 0 && c < NCMP) im += ps[c]; }
          const bool causal = n <= blkq, forced = causal && (n == 0 || n >= blkq - 1);
          v0 = forced ? 1e9f : (causal ? im : -1e30f); }
        { const int n = lane + 64; float im = 0.f;
#pragma unroll
          for (int j = -1; j < 4; ++j) { const int c = 4 * n + j; if (c >= 0 && c < NCMP) im += ps[c]; }
          const bool causal = n <= blkq, forced = causal && (n == 0 || n >= blkq - 1);
          v1 = forced ? 1e9f : (causal ? im : -1e30f); }
#pragma unroll
        for (int k = 0; k < 16; ++k) { const float m = wave_max(fmaxf(v0, v1));
            const unsigned long long b0 = __ballot(v0 == m); int idx;
            if (b0) { idx = __ffsll((long long)b0) - 1; if (lane == idx) v0 = -3.0e38f; }
            else { const unsigned long long b1 = __ballot(v1 == m); idx = __ffsll((long long)b1) - 1; if (lane == idx) v1 = -3.0e38f; idx += 64; }
            sidx[k] = idx; }
    }
    {
        float sc[16][4]; float mx[4] = {-1e30f, -1e30f, -1e30f, -1e30f};
#pragma unroll
        for (int k = 0; k < 16; ++k) { const int n = sidx[k], pos = n * 64 + lane;
            float a[4] = {-1e30f, -1e30f, -1e30f, -1e30f};
            if (n <= blkq && pos <= tq) { const bf16* kp = P + ((size_t)b * SEQ + pos) * DINP + C_NKS; dot64x4(kp, qr, a);
#pragma unroll
                for (int h = 0; h < 4; ++h) a[h] *= 0.125f; }
#pragma unroll
            for (int h = 0; h < 4; ++h) { sc[k][h] = a[h]; mx[h] = fmaxf(mx[h], a[h]); } }
        float l[4];
#pragma unroll
        for (int h = 0; h < 4; ++h) { mx[h] = wave_max(mx[h]); l[h] = 0.f; }
#pragma unroll
        for (int k = 0; k < 16; ++k)
#pragma unroll
            for (int h = 0; h < 4; ++h) { const float p = (sc[k][h] > -1e29f) ? __expf(sc[k][h] - mx[h]) : 0.f; sc[k][h] = p; l[h] += p; }
#pragma unroll
        for (int h = 0; h < 4; ++h) l[h] = rcpf_(wave_sum(l[h]));
        float os[4] = {0.f, 0.f, 0.f, 0.f};
#pragma unroll
        for (int k = 0; k < 16; ++k) { const int n = sidx[k]; if (n > blkq) continue;
            const bf16* vp = P + ((size_t)b * SEQ + n * 64) * DINP + C_NVS + lane;
            for (int src = 0; src < 64; ++src) { const float v = bf2f(vp[(size_t)src * DINP]);
                os[0] = fmaf(__shfl(sc[k][0], src), v, os[0]); os[1] = fmaf(__shfl(sc[k][1], src), v, os[1]);
                os[2] = fmaf(__shfl(sc[k][2], src), v, os[2]); os[3] = fmaf(__shfl(sc[k][3], src), v, os[3]); } }
#pragma unroll
        for (int h = 0; h < 4; ++h) out[h] += gate[1][h] * os[h] * l[h];
    }
    {
        float sc[8][4]; float mx[4] = {-1e30f, -1e30f, -1e30f, -1e30f};
#pragma unroll
        for (int i = 0; i < 8; ++i) { const int pos = tq - 511 + i * 64 + lane;
            float a[4] = {-1e30f, -1e30f, -1e30f, -1e30f};
            if (pos >= 0) { const bf16* kp = P + ((size_t)b * SEQ + pos) * DINP + C_NKW; dot64x4(kp, qr, a);
#pragma unroll
                for (int h = 0; h < 4; ++h) a[h] *= 0.125f; }
#pragma unroll
            for (int h = 0; h < 4; ++h) { sc[i][h] = a[h]; mx[h] = fmaxf(mx[h], a[h]); } }
        float l[4];
#pragma unroll
        for (int h = 0; h < 4; ++h) { mx[h] = wave_max(mx[h]); l[h] = 0.f; }
#pragma unroll
        for (int i = 0; i < 8; ++i)
#pragma unroll
            for (int h = 0; h < 4; ++h) { const float p = (sc[i][h] > -1e29f) ? __expf(sc[i][h] - mx[h]) : 0.f; sc[i][h] = p; l[h] += p; }
#pragma unroll
        for (int h = 0; h < 4; ++h) l[h] = rcpf_(wave_sum(l[h]));
        float ow[4] = {0.f, 0.f, 0.f, 0.f};
#pragma unroll
        for (int i = 0; i < 8; ++i) { const int p0 = tq - 511 + i * 64; if (p0 + 63 < 0) continue;
            const int s0 = p0 < 0 ? -p0 : 0;
            for (int src = s0; src < 64; ++src) { const float v = bf2f(P[((size_t)b * SEQ + p0 + src) * DINP + C_NVW + lane]);
                ow[0] = fmaf(__shfl(sc[i][0], src), v, ow[0]); ow[1] = fmaf(__shfl(sc[i][1], src), v, ow[1]);
                ow[2] = fmaf(__shfl(sc[i][2], src), v, ow[2]); ow[3] = fmaf(__shfl(sc[i][3], src), v, ow[3]); } }
#pragma unroll
        for (int h = 0; h < 4; ++h) out[h] += gate[2][h] * ow[h] * l[h];
    }
#pragma unroll
    for (int h = 0; h < 4; ++h) MIX[row * DM + 768 + h * 64 + lane] = f2bf(out[h]);
}


#define LAS __attribute__((address_space(3)))
typedef short bf16x8 __attribute__((ext_vector_type(8)));
typedef float f32x16 __attribute__((ext_vector_type(16)));
typedef short s16x4 __attribute__((ext_vector_type(4)));
typedef unsigned u32x4v __attribute__((ext_vector_type(4)));
typedef float f32x2_t __attribute__((ext_vector_type(2)));
typedef __bf16 bf16x2_t __attribute__((ext_vector_type(2)));
constexpr int KROW = 144, VROW = 192;
constexpr int KBUF = 64 * KROW, VBUF = 64 * VROW, STG = KBUF + VBUF;
constexpr float SCL2 = 0.125f * 1.4426950408889634f;
constexpr float NEGBIG = -1e30f;

__device__ __forceinline__ unsigned cvtpk(float lo, float hi) { f32x2_t v = {lo, hi}; bf16x2_t b = __builtin_convertvector(v, bf16x2_t); return __builtin_bit_cast(unsigned, b); }
__device__ __forceinline__ int crow(int r, int hi) { return (r & 3) + 8 * (r >> 2) + 4 * hi; }
__device__ __forceinline__ s16x4 lds_tr(LAS const unsigned char* p) { return __builtin_bit_cast(s16x4, __builtin_amdgcn_ds_read_tr16_b64_v4i16((LAS s16x4*)p)); }

struct TileSrc { const bf16* k; const bf16* v; int stride; };
__device__ __forceinline__ void tile_load(u32x4v& kr, u32x4v& vr, const TileSrc& s, int t) {
    const int key = t >> 3, ch = t & 7;
    kr = *(const u32x4v*)(s.k + (size_t)key * s.stride + ch * 8); vr = *(const u32x4v*)(s.v + (size_t)key * s.stride + ch * 8);
}
__device__ __forceinline__ void tile_store(LAS unsigned char* buf, const u32x4v& kr, const u32x4v& vr, int t) {
    const int key = t >> 3, ch = t & 7;
    *(LAS u32x4v*)(buf + key * KROW + ch * 16) = kr; *(LAS u32x4v*)(buf + KBUF + key * VROW + ch * 16) = vr;
}
__device__ __forceinline__ void qk_tile(f32x16& p0, f32x16& p1, LAS const unsigned char* kb, const bf16x8 (&qf)[4], int r32, int hi) {
#pragma unroll
    for (int r = 0; r < 16; ++r) { p0[r] = 0.f; p1[r] = 0.f; }
    LAS const unsigned char* a = kb + r32 * KROW + hi * 16;
#pragma unroll
    for (int ks = 0; ks < 4; ++ks) {
        const bf16x8 a0 = *(LAS const bf16x8*)(a + ks * 32), a1 = *(LAS const bf16x8*)(a + 32 * KROW + ks * 32);
        p0 = __builtin_amdgcn_mfma_f32_32x32x16_bf16(a0, qf[ks], p0, 0, 0, 0);
        p1 = __builtin_amdgcn_mfma_f32_32x32x16_bf16(a1, qf[ks], p1, 0, 0, 0);
    }
}
__device__ __forceinline__ void pv_tile(f32x16& o0, f32x16& o1, LAS const unsigned char* vb, const f32x16& p0, const f32x16& p1, int lane) {
    const int g = lane >> 4, i = lane & 15, hi = lane >> 5;
    LAS const unsigned char* base = vb + (4 * hi + (i >> 2)) * VROW + (16 * (g & 1) + 4 * (i & 3)) * 2;
#pragma unroll
    for (int s = 0; s < 4; ++s) {
        unsigned w[4];
#pragma unroll
        for (int e = 0; e < 4; ++e) { const int r = 8 * (s & 1) + 2 * e; w[e] = (s < 2) ? cvtpk(p0[r], p0[r + 1]) : cvtpk(p1[r], p1[r + 1]); }
        const u32x4v wv = {w[0], w[1], w[2], w[3]};
        const bf16x8 pf = __builtin_bit_cast(bf16x8, wv);
#pragma unroll
        for (int mb = 0; mb < 2; ++mb) {
            const s16x4 lo = lds_tr(base + s * 16 * VROW + mb * 64), hi4 = lds_tr(base + s * 16 * VROW + 8 * VROW + mb * 64);
            const bf16x8 vt = {lo[0], lo[1], lo[2], lo[3], hi4[0], hi4[1], hi4[2], hi4[3]};
            if (mb == 0) o0 = __builtin_amdgcn_mfma_f32_32x32x16_bf16(vt, pf, o0, 0, 0, 0);
            else o1 = __builtin_amdgcn_mfma_f32_32x32x16_bf16(vt, pf, o1, 0, 0, 0);
        }
    }
}
__device__ __forceinline__ void softmax_tile(f32x16& p0, f32x16& p1, f32x16& o0, f32x16& o1, float& m, float& l) {
    float tm = fmaxf(p0[0], p1[0]);
#pragma unroll
    for (int r = 1; r < 16; ++r) tm = fmaxf(tm, fmaxf(p0[r], p1[r]));
    tm = fmaxf(tm, shx<32>(tm));
    const float mn = fmaxf(m, tm), alpha = __builtin_amdgcn_exp2f(m - mn);
    m = mn;
    float s = 0.f;
#pragma unroll
    for (int r = 0; r < 16; ++r) { p0[r] = __builtin_amdgcn_exp2f(p0[r] - mn); p1[r] = __builtin_amdgcn_exp2f(p1[r] - mn); s += p0[r] + p1[r]; }
    l = l * alpha + s;
#pragma unroll
    for (int r = 0; r < 16; ++r) { o0[r] *= alpha; o1[r] *= alpha; }
}

constexpr int MOBA_KM_OFF = 2 * STG, MOBA_TL_OFF = MOBA_KM_OFF + 32 * 64 * 4, MOBA_UW_OFF = MOBA_TL_OFF + 132 * 4;
__device__ __forceinline__ void moba_unit(const bf16* __restrict__ P, const float* __restrict__ kmean, bf16* __restrict__ MIX, int b, int h, int qb, int tid, LAS unsigned char* lds) {
    const int lane = tid & 63, wid = __builtin_amdgcn_readfirstlane(tid >> 6), r32 = lane & 31, hi = lane >> 5;
    LAS float* km = (LAS float*)(lds + MOBA_KM_OFF); LAS int* tl = (LAS int*)(lds + MOBA_TL_OFF); LAS unsigned* uw = (LAS unsigned*)(lds + MOBA_UW_OFF);
    const int own = qb, tq = qb * 256 + wid * 32 + r32;
    const size_t rowq = (size_t)b * SEQ + tq;
    const bf16* Pb = P + (size_t)b * SEQ * DINP;
    u32x4v kr, vr;
    { TileSrc s{Pb + (size_t)(own * 256) * DINP + C_BK + h * 64, Pb + (size_t)(own * 256) * DINP + C_BV + h * 64, DINP}; tile_load(kr, vr, s, tid); }
    bf16x8 qf[4];
#pragma unroll
    for (int ks = 0; ks < 4; ++ks) qf[ks] = *(const bf16x8*)(P + rowq * DINP + C_BQ + h * 64 + ks * 16 + hi * 8);
    for (int e = tid; e < own * 64; e += 512) km[e] = kmean[(((size_t)b * 4 + h) * 32) * 64 + e];
    __syncthreads();
    unsigned mask = 0u;
    {
        float qv[32];
#pragma unroll
        for (int ks = 0; ks < 4; ++ks)
#pragma unroll
            for (int j = 0; j < 8; ++j) qv[ks * 8 + j] = bf2f((bf16)qf[ks][j]);
        float b0 = -3e38f, b1 = -3e38f, b2 = -3e38f; int i0 = -1, i1 = -1, i2 = -1;
        for (int n = 0; n < own; ++n) {
            LAS const float* kp = km + n * 64 + hi * 8; float a = 0.f;
#pragma unroll
            for (int ks = 0; ks < 4; ++ks)
#pragma unroll
                for (int j = 0; j < 8; ++j) a = fmaf(qv[ks * 8 + j], kp[ks * 16 + j], a);
            a += shx<32>(a);
            if (a > b0) { b2 = b1; i2 = i1; b1 = b0; i1 = i0; b0 = a; i0 = n; }
            else if (a > b1) { b2 = b1; i2 = i1; b1 = a; i1 = n; }
            else if (a > b2) { b2 = a; i2 = n; }
        }
        if (i0 >= 0) mask |= 1u << i0; if (i1 >= 0) mask |= 1u << i1; if (i2 >= 0) mask |= 1u << i2;
    }
    { unsigned um = mask;
      um |= shxu<1>(um); um |= shxu<2>(um); um |= shxu<4>(um); um |= shxu<8>(um); um |= shxu<16>(um); um |= shxu<32>(um);
      if (lane == 0) uw[wid] = um; }
    tile_store(lds, kr, vr, tid);
    __syncthreads();
    if (tid == 0) { unsigned um = 0u; for (int w = 0; w < 8; ++w) um |= uw[w];
        int cnt = 0; for (int s = 0; s < 4; ++s) tl[cnt++] = own * 4 + s;
        for (int n = 0; n < own; ++n) if ((um >> n) & 1u) for (int s = 0; s < 4; ++s) tl[cnt++] = n * 4 + s;
        tl[131] = cnt; }
    __syncthreads();
    const int nt = tl[131];
    f32x16 o0, o1;
#pragma unroll
    for (int r = 0; r < 16; ++r) { o0[r] = 0.f; o1[r] = 0.f; }
    float m = NEGBIG, l = 0.f;
    for (int i = 0; i < nt; ++i) {
        const int tile = tl[i];
        if (i + 1 < nt) { const int nx = tl[i + 1]; TileSrc s{Pb + (size_t)(nx * 64) * DINP + C_BK + h * 64, Pb + (size_t)(nx * 64) * DINP + C_BV + h * 64, DINP}; tile_load(kr, vr, s, tid); }
        LAS const unsigned char* buf = lds + (i & 1) * STG;
        f32x16 p0, p1;
        qk_tile(p0, p1, buf, qf, r32, hi);
        const int blk = tile >> 2, kbase = tile * 64;
        if (blk == own) {
#pragma unroll
            for (int r = 0; r < 16; ++r) { const int k0 = kbase + crow(r, hi); p0[r] = (k0 <= tq) ? p0[r] * SCL2 : NEGBIG; p1[r] = (k0 + 32 <= tq) ? p1[r] * SCL2 : NEGBIG; }
        } else {
            const bool sel = (mask >> blk) & 1u;
#pragma unroll
            for (int r = 0; r < 16; ++r) { p0[r] = sel ? p0[r] * SCL2 : NEGBIG; p1[r] = sel ? p1[r] * SCL2 : NEGBIG; }
        }
        softmax_tile(p0, p1, o0, o1, m, l);
        pv_tile(o0, o1, buf + KBUF, p0, p1, lane);
        if (i + 1 < nt) tile_store(lds + ((i + 1) & 1) * STG, kr, vr, tid);
        __syncthreads();
    }
    l += shx<32>(l);
    const float inv = rcpf_(l);
    bf16* op = MIX + rowq * DM + 512 + h * 64 + 4 * hi;
#pragma unroll
    for (int g = 0; g < 4; ++g) {
        uint2 w0, w1;
        w0.x = cvtpk(o0[4 * g] * inv, o0[4 * g + 1] * inv); w0.y = cvtpk(o0[4 * g + 2] * inv, o0[4 * g + 3] * inv);
        w1.x = cvtpk(o1[4 * g] * inv, o1[4 * g + 1] * inv); w1.y = cvtpk(o1[4 * g + 2] * inv, o1[4 * g + 3] * inv);
        *(uint2*)(op + 8 * g) = w0; *(uint2*)(op + 32 + 8 * g) = w1;
    }
}

constexpr int NSA_S4_OFF = 2 * STG, NSA_L4_OFF = NSA_S4_OFF + 8 * 8 * 128 * 4, NSA_SM_OFF = NSA_L4_OFF + 8 * 8 * 128 * 4;
struct NsaCtx { const bf16* Pb; const bf16* Kcb; const bf16* Vcb; int b, jq, tid, lane, wid, r32, hi, tq; unsigned mk0, mk1, mk2, mk3; };

template <int MODE>
__device__ __forceinline__ void nsa_tiles(const NsaCtx& c, LAS unsigned char* lds, const bf16x8 (&qf)[4], int nt, f32x16& o0, f32x16& o1, float& m, float& l, float pre) {
    const int tid = c.tid, lane = c.lane, r32 = c.r32, hi = c.hi, tq = c.tq, jq = c.jq;
    const int nw = (jq < 8 ? jq : 8) + 1;
    auto tile_of = [&](int i) -> int { return MODE < 2 ? i : (i == 0 ? jq : (MODE == 2 ? i - 1 : jq - nw + i)); };
    auto src_of = [&](int t) -> TileSrc {
        if (MODE < 2) return TileSrc{c.Kcb + (size_t)t * 64 * 64, c.Vcb + (size_t)t * 64 * 64, 64};
        if (MODE == 2) return TileSrc{c.Pb + (size_t)t * 64 * DINP + C_NKS, c.Pb + (size_t)t * 64 * DINP + C_NVS, DINP};
        return TileSrc{c.Pb + (size_t)t * 64 * DINP + C_NKW, c.Pb + (size_t)t * 64 * DINP + C_NVW, DINP};
    };
    u32x4v kr, vr;
    { const TileSrc s = src_of(tile_of(0)); tile_load(kr, vr, s, tid); }
    tile_store(lds, kr, vr, tid);
    __syncthreads();
    const int ncv = (tq >= 31) ? ((tq - 31) >> 4) + 1 : 0;
    for (int i = 0; i < nt; ++i) {
        const int tile = tile_of(i);
        if (i + 1 < nt) { const TileSrc s = src_of(tile_of(i + 1)); tile_load(kr, vr, s, tid); }
        LAS const unsigned char* buf = lds + (i & 1) * STG;
        const int kbase = tile * 64;
        bool rowsel = true;
        if (MODE == 2 && tile != jq) { const unsigned w = (tile >> 5) == 0 ? c.mk0 : (tile >> 5) == 1 ? c.mk1 : (tile >> 5) == 2 ? c.mk2 : c.mk3; rowsel = (w >> (tile & 31)) & 1u; }
        if (MODE != 2 || __any(rowsel)) {
            f32x16 p0, p1;
            qk_tile(p0, p1, buf, qf, r32, hi);
            if (MODE < 2) {
#pragma unroll
                for (int r = 0; r < 16; ++r) { const int k0 = kbase + crow(r, hi); p0[r] = (k0 < ncv) ? p0[r] * SCL2 : NEGBIG; p1[r] = (k0 + 32 < ncv) ? p1[r] * SCL2 : NEGBIG; }
            } else if (MODE == 2) {
                if (tile == jq) {
#pragma unroll
                    for (int r = 0; r < 16; ++r) { const int k0 = kbase + crow(r, hi); p0[r] = (k0 <= tq) ? p0[r] * SCL2 : NEGBIG; p1[r] = (k0 + 32 <= tq) ? p1[r] * SCL2 : NEGBIG; }
                } else {
#pragma unroll
                    for (int r = 0; r < 16; ++r) { p0[r] = rowsel ? p0[r] * SCL2 : NEGBIG; p1[r] = rowsel ? p1[r] * SCL2 : NEGBIG; }
                }
            } else {
#pragma unroll
                for (int r = 0; r < 16; ++r) { const int k0 = kbase + crow(r, hi);
                    p0[r] = (k0 <= tq && k0 + 511 >= tq) ? p0[r] * SCL2 : NEGBIG; p1[r] = (k0 + 32 <= tq && k0 + 32 + 511 >= tq) ? p1[r] * SCL2 : NEGBIG; }
            }
            if (MODE == 0) {
                float tm = fmaxf(p0[0], p1[0]);
#pragma unroll
                for (int r = 1; r < 16; ++r) tm = fmaxf(tm, fmaxf(p0[r], p1[r]));
                tm = fmaxf(tm, shx<32>(tm));
                const float mn = fmaxf(m, tm); float s = 0.f;
#pragma unroll
                for (int r = 0; r < 16; ++r) { s += (p0[r] > -1e29f ? __builtin_amdgcn_exp2f(p0[r] - mn) : 0.f) + (p1[r] > -1e29f ? __builtin_amdgcn_exp2f(p1[r] - mn) : 0.f); }
                l = l * __builtin_amdgcn_exp2f(m - mn) + s; m = mn;
            } else if (MODE == 1) {
#pragma unroll
                for (int r = 0; r < 16; ++r) { p0[r] = (p0[r] > -1e29f) ? __builtin_amdgcn_exp2f(p0[r] - m) * pre : 0.f; p1[r] = (p1[r] > -1e29f) ? __builtin_amdgcn_exp2f(p1[r] - m) * pre : 0.f; }
                pv_tile(o0, o1, buf + KBUF, p0, p1, lane);
                LAS float* S4 = (LAS float*)(lds + NSA_S4_OFF) + (c.wid * 8 + (r32 & 7)) * 128; LAS float* L4 = (LAS float*)(lds + NSA_L4_OFF) + (c.wid * 8 + (r32 & 7)) * 128;
#pragma unroll
                for (int mbk = 0; mbk < 2; ++mbk)
#pragma unroll
                    for (int g = 0; g < 4; ++g) {
                        float s4 = mbk ? (p1[4 * g] + p1[4 * g + 1]) + (p1[4 * g + 2] + p1[4 * g + 3]) : (p0[4 * g] + p0[4 * g + 1]) + (p0[4 * g + 2] + p0[4 * g + 3]);
                        float la = mbk ? p1[4 * g + 3] : p0[4 * g + 3];
                        s4 += shx<8>(s4); s4 += shx<16>(s4); la += shx<8>(la); la += shx<16>(la);
                        const int gi = tile * 16 + 8 * mbk + 2 * g + hi;
                        if (r32 < 8) { S4[gi] = s4; L4[gi] = la; }
                    }
            } else {
                softmax_tile(p0, p1, o0, o1, m, l);
                pv_tile(o0, o1, buf + KBUF, p0, p1, lane);
            }
        }
        if (i + 1 < nt) tile_store(lds + ((i + 1) & 1) * STG, kr, vr, tid);
        __syncthreads();
    }
}

__device__ __forceinline__ void nsa_unit(const bf16* __restrict__ P, const float* __restrict__ G, const float* __restrict__ tab, const bf16* __restrict__ KVcb, bf16* __restrict__ MIX,
                                         int b, int jq, int tid, LAS unsigned char* lds) {
    NsaCtx c; c.b = b; c.jq = jq; c.tid = tid; c.lane = tid & 63; c.wid = __builtin_amdgcn_readfirstlane(tid >> 6); c.r32 = c.lane & 31; c.hi = c.lane >> 5;
    const int qi = c.r32 & 7, hh = c.r32 >> 3, hi = c.hi, lane = c.lane;
    c.tq = jq * 64 + c.wid * 8 + qi;
    c.Pb = P + (size_t)b * SEQ * DINP; c.Kcb = KVcb + (size_t)b * 512 * 64; c.Vcb = KVcb + ((size_t)NB + b) * 512 * 64;
    c.mk0 = c.mk1 = c.mk2 = c.mk3 = 0u;
    const size_t rowq = (size_t)b * SEQ + c.tq;
    bf16x8 qn[4], qr[4];
#pragma unroll
    for (int ks = 0; ks < 4; ++ks) { qn[ks] = *(const bf16x8*)(P + rowq * DINP + C_NQ + hh * 64 + ks * 16 + hi * 8); qr[ks] = qn[ks]; }
    {
        unsigned w[4];
#pragma unroll
        for (int e = 0; e < 4; ++e) {
            float y[2];
#pragma unroll
            for (int k = 0; k < 2; ++k) { const int j = 2 * e + k; const float x = bf2f((bf16)qn[0][j]); const float other = shx<32>(x);
                const float cs = tab[c.tq * 16 + j], sn = tab[c.tq * 16 + 8 + j]; y[k] = hi ? (x * cs + other * sn) : (x * cs - other * sn); }
            w[e] = cvtpk(y[0], y[1]);
        }
        const u32x4v wv = {w[0], w[1], w[2], w[3]}; qr[0] = __builtin_bit_cast(bf16x8, wv);
    }
    const float g0 = sigmoidf_(G[rowq * 32 + 8 + hh]), g1 = sigmoidf_(G[rowq * 32 + 12 + hh]), g2 = sigmoidf_(G[rowq * 32 + 16 + hh]);
    f32x16 a0, a1;
    {
        const int ncvmax = min(4 * jq + 3, NCMP), nct = (ncvmax + 63) >> 6;
        f32x16 o0, o1;
#pragma unroll
        for (int r = 0; r < 16; ++r) { o0[r] = 0.f; o1[r] = 0.f; }
        float m = NEGBIG, l = 0.f;
        nsa_tiles<0>(c, lds, qn, nct, o0, o1, m, l, 0.f);
        l += shx<32>(l);
        const float pre = (l > 0.f) ? rcpf_(l) : 0.f;
        nsa_tiles<1>(c, lds, qn, nct, o0, o1, m, l, pre);
#pragma unroll
        for (int r = 0; r < 16; ++r) { a0[r] = g0 * o0[r]; a1[r] = g0 * o1[r]; }
    }
    {
        LAS unsigned* sm = (LAS unsigned*)(lds + NSA_SM_OFF);
        for (int q = 0; q < 8; ++q) {
            LAS const float* S4 = (LAS const float*)(lds + NSA_S4_OFF) + (c.wid * 8 + q) * 128; LAS const float* L4 = (LAS const float*)(lds + NSA_L4_OFF) + (c.wid * 8 + q) * 128;
            float v0, v1;
            { const int n = lane; const bool causal = n <= jq, forced = causal && (n == 0 || n >= jq - 1);
              float im = 0.f; if (causal) { im = S4[n]; if (n > 0) im += L4[n - 1]; }
              v0 = forced ? 1e9f : (causal ? im : -1e30f); }
            { const int n = lane + 64; const bool causal = n <= jq, forced = causal && (n >= jq - 1);
              float im = 0.f; if (causal) { im = S4[n] + L4[n - 1]; }
              v1 = forced ? 1e9f : (causal ? im : -1e30f); }
            unsigned long long sel0 = 0ull, sel1 = 0ull;
            for (int k = 0; k < 16; ++k) { const float mx = wave_max(fmaxf(v0, v1));
                const unsigned long long b0 = __ballot(v0 == mx);
                if (b0) { const int idx = __ffsll((long long)b0) - 1; sel0 |= 1ull << idx; if (lane == idx) v0 = -3.0e38f; }
                else { const unsigned long long b1 = __ballot(v1 == mx); const int idx = __ffsll((long long)b1) - 1; sel1 |= 1ull << idx; if (lane == idx) v1 = -3.0e38f; } }
            if (lane == 0) { sm[(c.wid * 8 + q) * 4 + 0] = (unsigned)sel0; sm[(c.wid * 8 + q) * 4 + 1] = (unsigned)(sel0 >> 32); sm[(c.wid * 8 + q) * 4 + 2] = (unsigned)sel1; sm[(c.wid * 8 + q) * 4 + 3] = (unsigned)(sel1 >> 32); }
        }
        __builtin_amdgcn_s_waitcnt(0xc07f); __builtin_amdgcn_wave_barrier();
        c.mk0 = sm[(c.wid * 8 + qi) * 4 + 0]; c.mk1 = sm[(c.wid * 8 + qi) * 4 + 1]; c.mk2 = sm[(c.wid * 8 + qi) * 4 + 2]; c.mk3 = sm[(c.wid * 8 + qi) * 4 + 3];
    }
    {
        f32x16 o0, o1;
#pragma unroll
        for (int r = 0; r < 16; ++r) { o0[r] = 0.f; o1[r] = 0.f; }
        float m = NEGBIG, l = 0.f;
        nsa_tiles<2>(c, lds, qr, jq + 1, o0, o1, m, l, 0.f);
        l += shx<32>(l);
        const float sc = g1 * rcpf_(l);
#pragma unroll
        for (int r = 0; r < 16; ++r) { a0[r] = fmaf(sc, o0[r], a0[r]); a1[r] = fmaf(sc, o1[r], a1[r]); }
    }
    {
        f32x16 o0, o1;
#pragma unroll
        for (int r = 0; r < 16; ++r) { o0[r] = 0.f; o1[r] = 0.f; }
        float m = NEGBIG, l = 0.f;
        nsa_tiles<3>(c, lds, qr, (jq < 8 ? jq : 8) + 1, o0, o1, m, l, 0.f);
        l += shx<32>(l);
        const float sc = g2 * rcpf_(l);
#pragma unroll
        for (int r = 0; r < 16; ++r) { a0[r] = fmaf(sc, o0[r], a0[r]); a1[r] = fmaf(sc, o1[r], a1[r]); }
    }
    bf16* op = MIX + rowq * DM + 768 + hh * 64 + 4 * hi;
#pragma unroll
    for (int g = 0; g < 4; ++g) {
        uint2 w0, w1;
        w0.x = cvtpk(a0[4 * g], a0[4 * g + 1]); w0.y = cvtpk(a0[4 * g + 2], a0[4 * g + 3]);
        w1.x = cvtpk(a1[4 * g], a1[4 * g + 1]); w1.y = cvtpk(a1[4 * g + 2], a1[4 * g + 3]);
        *(uint2*)(op + 8 * g) = w0; *(uint2*)(op + 32 + 8 * g) = w1;
    }
}

constexpr size_t MiB = 1u << 20;
constexpr size_t W_LAYER = (size_t)(DINP + DM + DFF) * DM + (size_t)DM * DFF;
constexpr size_t WS_W = 0;
constexpr size_t WS_HM = 52 * MiB;
constexpr size_t WS_G = 116 * MiB;
constexpr size_t WS_SMALL = 120 * MiB;
constexpr size_t WS_TAB = WS_SMALL, WS_KMEAN = WS_SMALL + 512 * 1024, WS_KVC = WS_SMALL + 1 * MiB, WS_NST = WS_SMALL + 2 * MiB, WS_DEC = WS_SMALL + 3 * MiB, WS_KVCB = WS_SMALL + 3 * MiB + 512 * 1024;
constexpr size_t WS_P = 124 * MiB;
constexpr size_t WS_C = 348 * MiB;
constexpr size_t WS_U = WS_P;
constexpr size_t WS_END = 476 * MiB;
static_assert(W_LAYER * 2 * DEPTH <= 52 * MiB, "weights");
static_assert((size_t)T * DINP * 2 == 224 * MiB && (size_t)T * DFF * 2 == 256 * MiB, "sizes");

struct Params { const float* in[16]; float* out; unsigned char* ws; };
constexpr int LDS_BYTES = 147456;

__global__ void __launch_bounds__(512, 2) hybrid_fwd(Params prm) {
    extern __shared__ __attribute__((aligned(16))) unsigned char lds[];
    cg::grid_group grid = cg::this_grid();
    constexpr int NPH = 1 + DEPTH * 9 - 1;
    for (int ph = 0; ph < NPH; ++ph) {
        int tid = threadIdx.x; asm volatile("" : "+v"(tid));
        const int G = gridDim.x, bid = blockIdx.x, half = tid >> 8, t256 = tid & 255, lane = tid & 63, wid = __builtin_amdgcn_readfirstlane(tid >> 6);
        unsigned char* smh = lds + half * 65536;
        unsigned char* ws = prm.ws; float* out = prm.out; asm volatile("" : "+s"(ws), "+s"(out));
        size_t zz = 0; asm volatile("" : "+s"(zz));
#define IN(k) (prm.in[k] + zz)
        bf16* Wb = (bf16*)(ws + WS_W); bf16* HM = (bf16*)(ws + WS_HM); float* Gt = (float*)(ws + WS_G); float* tab = (float*)(ws + WS_TAB); float* kmean = (float*)(ws + WS_KMEAN);
        float* KVc = (float*)(ws + WS_KVC); float* nst = (float*)(ws + WS_NST); float* dec = (float*)(ws + WS_DEC); bf16* KVcb = (bf16*)(ws + WS_KVCB); bf16* P = (bf16*)(ws + WS_P); float* Cst = (float*)(ws + WS_C); bf16* U = (bf16*)(ws + WS_U);
        const int vb = bid * 2 + half, NVB = G * 2;
        const int gwv = bid * 8 + wid, NGW = G * 8;
        const int l = ph == 0 ? 0 : (ph - 1) / 9, j = ph == 0 ? -1 : (ph - 1) % 9;
        const float* x = IN(0);
        const float* xin = l == 0 ? x : out;
        const bf16* WinT = Wb + l * W_LAYER; const bf16* WoT = WinT + (size_t)DINP * DM; const bf16* W1T = WoT + (size_t)DM * DM; const bf16* W2T = W1T + (size_t)DFF * DM;
        if (ph == 0) {
            const float* w_in = IN(1); const float* w_out = IN(11); const float* w_ff1 = IN(14); const float* w_ff2 = IN(15);
            for (int ll = 0; ll < DEPTH; ++ll) {
                bf16* WinT_ = Wb + ll * W_LAYER; bf16* WoT_ = WinT_ + (size_t)DINP * DM; bf16* W1T_ = WoT_ + (size_t)DM * DM; bf16* W2T_ = W1T_ + (size_t)DFF * DM;
                for (int mt = 0; mt < 4; ++mt) {
                    const float* W; int K, N, NP, mode; bf16* WT;
                    if (mt == 0) { W = w_in + (size_t)ll * DM * DIN; K = DM; N = DIN; NP = DINP; WT = WinT_; mode = 1; }
                    else if (mt == 1) { W = w_out + (size_t)ll * DM * DM; K = DM; N = DM; NP = DM; WT = WoT_; mode = 0; }
                    else if (mt == 2) { W = w_ff1 + (size_t)ll * DM * DFF; K = DM; N = DFF; NP = DFF; WT = W1T_; mode = 0; }
                    else { W = w_ff2 + (size_t)ll * DFF * DM; K = DFF; N = DM; NP = DM; WT = W2T_; mode = 0; }
                    const int nit = (NP / 64) * (K / 64);
                    for (int it0 = 0; it0 < nit; it0 += NVB) { const int it = it0 + vb; ph_convert_w(W, K, N, NP, WT, mode, it, it < nit, t256, (float*)smh); }
                }
            }
            for (int i = bid * 512 + tid; i < SEQ * 8; i += G * 512) { const int pos = i >> 3, f = i & 7;
                float c_, s_; rope_cs(pos, f, c_, s_);
                tab[pos * 16 + f] = c_; tab[pos * 16 + 8 + f] = s_; }
            for (int row = gwv; row < T; row += NGW) ph_rmsnorm_row(x, IN(12), HM, row, lane);
        } else if (j == 0 || j == 4 || j == 6 || j == 7) {
            pg8::Gemm g; pg8::EpiAny E; int N;
            if (j == 0) { g = pg8::Gemm{HM, WinT, T, DINP, DM}; N = DINP; E = pg8::EpiAny{0, true, P, DINP, Gt, C_GATE, nullptr, nullptr}; }
            else if (j == 4) { g = pg8::Gemm{HM, WoT, T, DM, DM}; N = DM; E = pg8::EpiAny{2, false, nullptr, DM, nullptr, 0, xin, out}; }
            else if (j == 6) { g = pg8::Gemm{HM, W1T, T, DFF, DM}; N = DFF; E = pg8::EpiAny{1, true, U, DFF, nullptr, 0, nullptr, nullptr}; }
            else { g = pg8::Gemm{U, W2T, T, DM, DFF}; N = DM; E = pg8::EpiAny{2, false, nullptr, DM, nullptr, 0, out, out}; }
            pg8::StaticOrder S; S.init(T, N, G, bid);
            pg8::gemm_phase<pg8::EpiAny, pg8::StaticOrder, true, true>((PG8_LAS unsigned char*)lds, g, S, E, tid);
        } else if (j == 1) {
            const float* cw = IN(3) + (size_t)l * 4 * 1024; const float* bif = IN(2) + l * 8;
            for (int it0 = 0; it0 < 128 * 14; it0 += NVB) { const int it = it0 + vb; ph_prep(P, tab, IN(5) + l * 128, IN(6) + l * 64, IN(7) + l * 192, kmean, it, it < 128 * 14, t256, (float*)smh); }
            for (int it0 = 0; it0 < NCMP * 8; it0 += NVB) { const int it = it0 + vb;
                ph_compress(P, IN(8) + (size_t)l * 2 * 32 * 64, IN(9) + (size_t)l * 2 * 2048 * 128, IN(10) + (size_t)l * 2 * 128 * 64, IN(7) + l * 192, KVc, KVcb, it, it < NCMP * 8, t256, (float*)smh); }
            for (int it0 = 0; it0 < 2048; it0 += NVB) { const int it = it0 + vb; ph_mlstm_local(P, Gt, cw, bif, Cst, nst, dec, it, it < 2048, t256, smh); }
        } else if (j == 2) {
            for (int it = vb; it < 16 * 65; it += NVB) ph_mlstm_scan(Cst, nst, dec, it, t256);
            for (int pu = bid; pu < 256; pu += G) { const int bh = pu >> 4, s = pu & 15;
                moba_unit(P, kmean, HM, bh >> 2, bh & 3, 31 - s, tid, (LAS unsigned char*)lds); moba_unit(P, kmean, HM, bh >> 2, bh & 3, s, tid, (LAS unsigned char*)lds); }
            for (int pu = bid; pu < 256; pu += G) { const int b_ = pu >> 6, s = pu & 63;
                nsa_unit(P, Gt, tab, KVcb, HM, b_, 127 - s, tid, (LAS unsigned char*)lds); nsa_unit(P, Gt, tab, KVcb, HM, b_, s, tid, (LAS unsigned char*)lds); }
        } else if (j == 3) {
            const float* cw = IN(3) + (size_t)l * 4 * 1024; const float* bif = IN(2) + l * 8;
            for (int it0 = 0; it0 < 2048; it0 += NVB) { const int it = it0 + vb; ph_mlstm_out(P, Gt, cw, bif, Cst, nst, IN(4) + l * 512, HM, it, it < 2048, t256, smh); }
        } else if (j == 5) {
            for (int row = gwv; row < T; row += NGW) ph_rmsnorm_row(out, IN(13) + l * DM, HM, row, lane);
        } else {
            for (int row = gwv; row < T; row += NGW) ph_rmsnorm_row(out, IN(12) + (l + 1) * DM, HM, row, lane);
        }
        if (ph + 1 < NPH) grid.sync();
    }
#undef IN
}

extern "C" void kernel_launch(void* const* d_in, const int* in_sizes, int n_in, void* d_out, int out_size, void* d_ws, size_t ws_size, hipStream_t stream) {
    static int grid = 0;
    if (grid == 0) {
        if (n_in != 16 || in_sizes[0] != T * DM || out_size != T * DM || ws_size < WS_END) { fprintf(stderr, "kernel_launch: unexpected shapes / workspace %zu < %zu\n", ws_size, (size_t)WS_END); grid = -1; return; }
        int dev = 0, cus = 0, per_cu = 0;
        if (hipGetDevice(&dev) != hipSuccess || hipDeviceGetAttribute(&cus, hipDeviceAttributeMultiprocessorCount, dev) != hipSuccess) { grid = -1; return; }
        if (hipFuncSetAttribute((const void*)hybrid_fwd, hipFuncAttributeMaxDynamicSharedMemorySize, LDS_BYTES) != hipSuccess) { fprintf(stderr, "kernel_launch: hipFuncSetAttribute failed\n"); grid = -1; return; }
        if (hipOccupancyMaxActiveBlocksPerMultiprocessor(&per_cu, (const void*)hybrid_fwd, 512, LDS_BYTES) != hipSuccess || per_cu < 1) { fprintf(stderr, "kernel_launch: occupancy query failed (%d)\n", per_cu); grid = -1; return; }
        grid = cus * per_cu;
        fprintf(stderr, "kernel_launch: grid %d (%d CUs x %d)\n", grid, cus, per_cu);
    }
    if (grid < 0) return;
    Params p{};
    for (int i = 0; i < 16; ++i) p.in[i] = (const float*)d_in[i];
    p.out = (float*)d_out; p.ws = (unsigned char*)d_ws;
    void* args[] = {&p};
    hipError_t e = hipLaunchCooperativeKernel((const void*)hybrid_fwd, dim3(grid), dim3(512), args, LDS_BYTES, stream);
    if (e != hipSuccess) fprintf(stderr, "kernel_launch: cooperative launch failed: %s (grid %d)\n", hipGetErrorString(e), grid);
}
```

```cpp
#include <hip/hip_runtime.h>
#include <hip/hip_cooperative_groups.h>
#include <cstdio>
#include <cstdint>
namespace cg = cooperative_groups;
namespace pg8 {
#define PG8_LAS __attribute__((address_space(3)))
typedef unsigned short bf16_t;
typedef short bf16x8 __attribute__((ext_vector_type(8)));
typedef float f32x4 __attribute__((ext_vector_type(4)));
typedef unsigned u32x4 __attribute__((ext_vector_type(4)));
constexpr int BM = 256, BK = 64, HALF = 128, HTB = HALF * BK * 2  , STAGE_BYTES = 8 * HTB, NXCD = 8, WGM = 8;

__host__ __device__ __forceinline__ int lds_byte(int r, int c) { const int st = (r >> 4) * 2 + (c >> 5), rr = r & 15, cc = c & 31, ob = rr * 64 + cc * 2; return st * 1024 + (ob ^ (((ob >> 9) & 1) << 5)); }
__host__ __device__ __forceinline__ void stage_rc(int b, int& R, int& C) { const int st = b / 1024, sb = b % 1024, swz = sb ^ (((sb >> 9) & 1) << 5); R = (st >> 1) * 16 + swz / 64; C = (st & 1) * 32 + (swz % 64) / 2; }
__host__ __device__ __forceinline__ int perm32(int rho) { const int n = rho >> 4, i = rho & 15; return 8 * (i >> 2) + 4 * n + (i & 3); }

struct Unit { int pm, pn; };
struct Gemm { const bf16_t* A; const bf16_t* Bt; int M, N, K; };

struct StaticOrder {
    int nM, nN, nwg, G, c;
    __host__ __device__ void init(int M, int N, int G_, int c_) { nM = M / BM; nN = N / BM; nwg = nM * nN; G = G_; c = c_; }
    __host__ __device__ bool next(int i, Unit& u) const {
        const long L = (long)i * G + c; if (L >= nwg) return false;
        int wgid = (int)L; { const int q = nwg / NXCD, r = nwg % NXCD, xcd = wgid % NXCD, off = wgid / NXCD; wgid = (xcd < r ? xcd * (q + 1) : r * (q + 1) + (xcd - r) * q) + off; }
        const int nig = WGM * nN, gid = wgid / nig, fm = gid * WGM, gsz = (nM - fm) < WGM ? (nM - fm) : WGM;
        u.pm = fm + ((wgid % nig) % gsz); u.pn = (wgid % nig) / gsz; return true;
    }
    __device__ __forceinline__ void a_ready(const Unit&) const {}
    __device__ __forceinline__ void done(const Unit&) const {}
};

__device__ __forceinline__ unsigned f2bf_u(float f) { unsigned u = __builtin_bit_cast(unsigned, f); return (u + 0x7fffu + ((u >> 16) & 1u)) >> 16; }
__device__ __forceinline__ unsigned pk2bf(float lo, float hi) { return f2bf_u(lo) | (f2bf_u(hi) << 16); }

struct EpiProj {
    static constexpr bool PERM = true, AFTER_DRAIN = false;
    bf16_t* O; int ldc; float* gates; int gate0;
    __device__ __forceinline__ void operator()(const f32x4 (&acc)[2][2][4][2], const Unit& u, int wr, int wc, int fr, int fq) const {
        const int row0 = u.pm * BM + wr * 64 + fr; const int col0 = u.pn * BM + wc * 32 + 8 * fq;
#pragma unroll
        for (int ai = 0; ai < 2; ++ai)
#pragma unroll
            for (int m = 0; m < 4; ++m) { const int row = row0 + ai * HALF + m * 16; bf16_t* rowp = O + (size_t)row * ldc + col0;
#pragma unroll
                for (int bj = 0; bj < 2; ++bj) { const f32x4 v0 = acc[ai][bj][m][0], v1 = acc[ai][bj][m][1];
                    u32x4 w; w.x = pk2bf(v0[0], v0[1]); w.y = pk2bf(v0[2], v0[3]); w.z = pk2bf(v1[0], v1[1]); w.w = pk2bf(v1[2], v1[3]);
                    *(u32x4*)(rowp + bj * HALF) = w;
                    const int c = col0 + bj * HALF - gate0;
                    if (c >= 0 && c < 32) { float* g = gates + (size_t)row * 32 + c; *(f32x4*)g = v0; *(f32x4*)(g + 4) = v1; } } }
    }
};
struct EpiRelu2 {
    static constexpr bool PERM = true, AFTER_DRAIN = false;
    bf16_t* O; int ldc;
    __device__ __forceinline__ void operator()(const f32x4 (&acc)[2][2][4][2], const Unit& u, int wr, int wc, int fr, int fq) const {
        const int row0 = u.pm * BM + wr * 64 + fr; const int col0 = u.pn * BM + wc * 32 + 8 * fq;
#pragma unroll
        for (int ai = 0; ai < 2; ++ai)
#pragma unroll
            for (int m = 0; m < 4; ++m) { const int row = row0 + ai * HALF + m * 16; bf16_t* rowp = O + (size_t)row * ldc + col0;
#pragma unroll
                for (int bj = 0; bj < 2; ++bj) { f32x4 v0 = acc[ai][bj][m][0], v1 = acc[ai][bj][m][1];
#pragma unroll
                    for (int e = 0; e < 4; ++e) { float a = v0[e] > 0.f ? v0[e] : 0.f; v0[e] = a * a; float b = v1[e] > 0.f ? v1[e] : 0.f; v1[e] = b * b; }
                    u32x4 w; w.x = pk2bf(v0[0], v0[1]); w.y = pk2bf(v0[2], v0[3]); w.z = pk2bf(v1[0], v1[1]); w.w = pk2bf(v1[2], v1[3]);
                    *(u32x4*)(rowp + bj * HALF) = w; } }
    }
};
struct EpiResid {
    static constexpr bool PERM = false, AFTER_DRAIN = false;
    const float* base; float* out; int ldc;
    __device__ __forceinline__ void operator()(const f32x4 (&acc)[2][2][4][2], const Unit& u, int wr, int wc, int fr, int fq) const {
        const int row0 = u.pm * BM + wr * 64 + fr; const int col0 = u.pn * BM + wc * 32 + 4 * fq;
#pragma unroll
        for (int ai = 0; ai < 2; ++ai)
#pragma unroll
            for (int m = 0; m < 4; ++m) { const size_t off = (size_t)(row0 + ai * HALF + m * 16) * ldc + col0;
#pragma unroll
                for (int bj = 0; bj < 2; ++bj)
#pragma unroll
                    for (int n = 0; n < 2; ++n) { const size_t o = off + bj * HALF + n * 16; const f32x4 b = *(const f32x4*)(base + o); *(f32x4*)(out + o) = b + acc[ai][bj][m][n]; } }
    }
};

struct EpiAny {
    static constexpr bool AFTER_DRAIN = false;
    int kind; bool perm;
    bf16_t* O; int ldc; float* gates; int gate0; const float* base; float* out;
    __device__ __forceinline__ void operator()(const f32x4 (&acc)[2][2][4][2], const Unit& u, int wr, int wc, int fr, int fq) const {
        if (kind == 0) { EpiProj e{O, ldc, gates, gate0}; e(acc, u, wr, wc, fr, fq); }
        else if (kind == 1) { EpiRelu2 e{O, ldc}; e(acc, u, wr, wc, fr, fq); }
        else { EpiResid e{base, out, ldc}; e(acc, u, wr, wc, fr, fq); }
    }
};
template <class Epi, class Sched, bool ALIGN_EPI = false, bool SP2 = false>
__device__ __forceinline__ void gemm_phase(PG8_LAS unsigned char* lds, const Gemm g, const Sched& S, const Epi& E, const int tid) {
    const int wid = __builtin_amdgcn_readfirstlane(tid >> 6), lane = tid & 63, wr = wid >> 2, wc = wid & 3, fr = lane & 15, fq = lane >> 4;
    const int K = g.K, nt = K / BK;
    unsigned voffA[2], voffB[2];
#pragma unroll
    for (int i = 0; i < 2; ++i) { int R, C; stage_rc(tid * 16 + i * 8192, R, C); const int Rb = E.perm ? ((R & ~31) + perm32(R & 31)) : R;
        voffA[i] = (unsigned)(R * K + C) * 2u; voffB[i] = (unsigned)(Rb * K + C) * 2u; }
    const size_t kstep = (size_t)(BK * 2);
    const size_t hstep = (size_t)HALF * K * 2;
    const size_t tstep = 2 * hstep;
    const unsigned ldsw = (unsigned)wid * 1024u;
    const int aoff = lds_byte(wr * 64 + fr, fq * 8), boff = lds_byte(wc * 32 + fr, fq * 8);
#define PG8_SA(b, h) (((b) * 2 + (h)) * HTB)
#define PG8_SB(b, h) ((4 + (b) * 2 + (h)) * HTB)
#define PG8_STAGE(bufoff, gbase, voff) do { _Pragma("unroll") for (int _i = 0; _i < 2; ++_i) \
        __builtin_amdgcn_global_load_lds((const unsigned*)((const char*)(gbase) + (voff)[_i]), (PG8_LAS unsigned*)(lds + (bufoff) + ldsw + _i * 8192), 16, 0, 0); } while (0)
#define PG8_LDA(dst, b, h) do { _Pragma("unroll") for (int m = 0; m < 4; ++m) _Pragma("unroll") for (int k = 0; k < 2; ++k) dst[m][k] = *(const PG8_LAS bf16x8*)(lds + PG8_SA(b, h) + aoff + m * 2048 + k * 1024); } while (0)
#define PG8_LDB(dst, b, h) do { _Pragma("unroll") for (int n = 0; n < 2; ++n) _Pragma("unroll") for (int k = 0; k < 2; ++k) dst[n][k] = *(const PG8_LAS bf16x8*)(lds + PG8_SB(b, h) + boff + n * 2048 + k * 1024); } while (0)
#define PG8_MMA(ai, bj, At, Bt) do { __builtin_amdgcn_s_setprio(1); _Pragma("unroll") for (int m = 0; m < 4; ++m) _Pragma("unroll") for (int n = 0; n < 2; ++n) _Pragma("unroll") for (int k = 0; k < 2; ++k) \
        acc[ai][bj][m][n] = __builtin_amdgcn_mfma_f32_16x16x32_bf16(Bt[n][k], At[m][k], acc[ai][bj][m][n], 0, 0, 0); __builtin_amdgcn_s_setprio(0); } while (0)
#define PG8_WAIT_V(n) asm volatile("s_waitcnt vmcnt(" #n ")" ::: "memory")
#define PG8_WAIT_L(n) asm volatile("s_waitcnt lgkmcnt(" #n ")" ::: "memory")
#define PG8_BAR __builtin_amdgcn_s_barrier()
#define PG8_SCHED __builtin_amdgcn_sched_barrier(0)
    Unit cur, nxt; int ui = 0;
    if (!S.next(0, cur)) return;
    f32x4 acc[2][2][4][2];
#pragma unroll
    for (int a = 0; a < 2; ++a)
#pragma unroll
        for (int b = 0; b < 2; ++b)
#pragma unroll
            for (int m = 0; m < 4; ++m)
#pragma unroll
                for (int n = 0; n < 2; ++n) acc[a][b][m][n] = (f32x4){0.f, 0.f, 0.f, 0.f};
    bf16x8 At[4][2], B0[2][2], B1[2][2];
    const char* cA = (const char*)g.A + (size_t)cur.pm * tstep; const char* cB = (const char*)g.Bt + (size_t)cur.pn * tstep;
    S.a_ready(cur);
    if constexpr (SP2) {
        PG8_STAGE(PG8_SB(0, 0), cB, voffB); PG8_STAGE(PG8_SB(0, 1), cB + hstep, voffB); PG8_STAGE(PG8_SA(0, 0), cA, voffA); PG8_STAGE(PG8_SA(0, 1), cA + hstep, voffA);
        if (wr == 1) PG8_BAR;
        PG8_WAIT_V(2); PG8_BAR;
        PG8_STAGE(PG8_SB(1, 0), cB + kstep, voffB); PG8_STAGE(PG8_SA(1, 0), cA + kstep, voffA); PG8_STAGE(PG8_SB(1, 1), cB + hstep + kstep, voffB);
        PG8_WAIT_V(6); PG8_BAR;
    } else {
        PG8_STAGE(PG8_SB(0, 0), cB, voffB); PG8_STAGE(PG8_SA(0, 0), cA, voffA); PG8_STAGE(PG8_SB(0, 1), cB + hstep, voffB); PG8_STAGE(PG8_SA(0, 1), cA + hstep, voffA);
        if (wr == 1) PG8_BAR;
        PG8_WAIT_V(4); PG8_BAR;
        PG8_STAGE(PG8_SB(1, 0), cB + kstep, voffB); PG8_STAGE(PG8_SA(1, 0), cA + kstep, voffA); PG8_STAGE(PG8_SB(1, 1), cB + hstep + kstep, voffB);
        PG8_WAIT_V(6); PG8_BAR;
    }
    for (;;) {
        const bool has_next = S.next(ui + 1, nxt);
        const char* nA = has_next ? (const char*)g.A + (size_t)nxt.pm * tstep : cA; const char* nB = has_next ? (const char*)g.Bt + (size_t)nxt.pn * tstep : cB;
        for (int t = 0; t < nt; t += 2) {
            const bool last = (t == nt - 2);
            const char* a1 = cA + (size_t)(t + 1) * kstep;
            const char* a2 = last ? nA : cA + (size_t)(t + 2) * kstep; const char* b2 = last ? nB : cB + (size_t)(t + 2) * kstep;
            const char* a3 = a2 + kstep; const char* b3 = b2 + kstep;
            if (last && has_next) S.a_ready(nxt);
            if constexpr (SP2) {
            PG8_LDB(B0, 0, 0); PG8_LDB(B1, 0, 1); PG8_SCHED; PG8_LDA(At, 0, 0); PG8_STAGE(PG8_SA(1, 1), a1 + hstep, voffA);
            PG8_WAIT_V(8); PG8_WAIT_L(0); PG8_BAR; PG8_MMA(0, 0, At, B0); PG8_MMA(0, 1, At, B1); PG8_BAR; PG8_SCHED;
            PG8_LDA(At, 0, 1); PG8_STAGE(PG8_SB(0, 0), b2, voffB); PG8_STAGE(PG8_SB(0, 1), b2 + hstep, voffB); PG8_STAGE(PG8_SA(0, 0), a2, voffA);
            PG8_WAIT_V(8); PG8_WAIT_L(0); PG8_BAR; PG8_MMA(1, 0, At, B0); PG8_MMA(1, 1, At, B1); PG8_BAR; PG8_SCHED;
            PG8_LDB(B0, 1, 0); PG8_LDB(B1, 1, 1); PG8_SCHED; PG8_LDA(At, 1, 0); PG8_STAGE(PG8_SA(0, 1), a2 + hstep, voffA);
            PG8_WAIT_V(8); PG8_WAIT_L(0); PG8_BAR; PG8_MMA(0, 0, At, B0); PG8_MMA(0, 1, At, B1); PG8_BAR; PG8_SCHED;
            PG8_LDA(At, 1, 1); PG8_STAGE(PG8_SB(1, 0), b3, voffB); PG8_STAGE(PG8_SB(1, 1), b3 + hstep, voffB); PG8_STAGE(PG8_SA(1, 0), a3, voffA);
            PG8_WAIT_V(8); PG8_WAIT_L(0); PG8_BAR; PG8_MMA(1, 0, At, B0); PG8_MMA(1, 1, At, B1); PG8_BAR; PG8_SCHED;
            } else {
            PG8_LDB(B0, 0, 0); PG8_SCHED; PG8_LDA(At, 0, 0); PG8_STAGE(PG8_SA(1, 1), a1 + hstep, voffA);
            PG8_WAIT_L(8); PG8_BAR; PG8_WAIT_L(0); PG8_MMA(0, 0, At, B0); PG8_BAR; PG8_SCHED;
            PG8_LDB(B1, 0, 1); PG8_STAGE(PG8_SB(0, 0), b2, voffB);
            PG8_BAR; PG8_WAIT_L(0); PG8_MMA(0, 1, At, B1); PG8_BAR;
            PG8_LDA(At, 0, 1); PG8_STAGE(PG8_SA(0, 0), a2, voffA);
            PG8_BAR; PG8_WAIT_L(0); PG8_MMA(1, 0, At, B0); PG8_BAR; PG8_SCHED;
            PG8_STAGE(PG8_SB(0, 1), b2 + hstep, voffB);
            PG8_WAIT_V(6); PG8_BAR; PG8_MMA(1, 1, At, B1); PG8_BAR;
            PG8_LDB(B0, 1, 0); PG8_SCHED; PG8_LDA(At, 1, 0); PG8_STAGE(PG8_SA(0, 1), a2 + hstep, voffA);
            PG8_WAIT_L(8); PG8_BAR; PG8_WAIT_L(0); PG8_MMA(0, 0, At, B0); PG8_BAR; PG8_SCHED;
            PG8_LDB(B1, 1, 1); PG8_STAGE(PG8_SB(1, 0), b3, voffB);
            PG8_BAR; PG8_WAIT_L(0); PG8_MMA(0, 1, At, B1); PG8_BAR;
            PG8_LDA(At, 1, 1); PG8_STAGE(PG8_SA(1, 0), a3, voffA);
            PG8_BAR; PG8_WAIT_L(0); PG8_MMA(1, 0, At, B0); PG8_BAR; PG8_SCHED;
            PG8_STAGE(PG8_SB(1, 1), b3 + hstep, voffB);
            PG8_WAIT_V(6); PG8_BAR; PG8_MMA(1, 1, At, B1); PG8_BAR;
            }
        }
        if constexpr (ALIGN_EPI) { if (wr == 0) PG8_BAR; }
        if constexpr (!Epi::AFTER_DRAIN) { E(acc, cur, wr, wc, fr, fq); S.done(cur); }
        if (!has_next) break;
#pragma unroll
        for (int a = 0; a < 2; ++a)
#pragma unroll
            for (int b = 0; b < 2; ++b)
#pragma unroll
                for (int m = 0; m < 4; ++m)
#pragma unroll
                    for (int n = 0; n < 2; ++n) acc[a][b][m][n] = (f32x4){0.f, 0.f, 0.f, 0.f};
        cur = nxt; cA = nA; cB = nB; ++ui;
        if constexpr (ALIGN_EPI) { if (wr == 1) PG8_BAR; }
    }
    PG8_WAIT_V(0);
    if constexpr (!ALIGN_EPI) { if (wr == 0) PG8_BAR; }
    PG8_BAR;
    if constexpr (Epi::AFTER_DRAIN) { E.fused(acc, cur, wr, wc, fr, fq, lds, wid, lane); S.done(cur); }
#undef PG8_SA
#undef PG8_SB
#undef PG8_STAGE
#undef PG8_LDA
#undef PG8_LDB
#undef PG8_MMA
#undef PG8_WAIT_V
#undef PG8_WAIT_L
#undef PG8_BAR
#undef PG8_SCHED
}
}

typedef unsigned short bf16;
constexpr int NB = 4, SEQ = 8192, T = NB * SEQ, DM = 1024, DFF = 4096, DEPTH = 2;
constexpr int DIN = 3476, DINP = 3584;
constexpr int C_MQ = 0, C_MK = 512, C_MV = 1024, C_MO = 1536, C_BQ = 2048, C_BK = 2304, C_BV = 2560, C_NQ = 2816,
              C_NKC = 3072, C_NVC = 3136, C_NKS = 3200, C_NVS = 3264, C_NKW = 3328, C_NVW = 3392, C_GATE = 3456;
constexpr int NCMP = 511;
constexpr float EPS = 1e-6f;

__device__ __forceinline__ float bf2f(bf16 v) { return __builtin_bit_cast(float, (unsigned)v << 16); }
__device__ __forceinline__ bf16 f2bf(float f) { return (bf16)pg8::f2bf_u(f); }
template <int MASK> __device__ __forceinline__ float shx(float v) {
    if constexpr (MASK == 32) { auto rr = __builtin_amdgcn_permlane32_swap(__float_as_uint(v), __float_as_uint(v), false, false);
        return __uint_as_float(__builtin_amdgcn_mbcnt_lo(~0u, 0u) == 32u ? rr[0] : rr[1]); }
    else return __uint_as_float((unsigned)__builtin_amdgcn_ds_swizzle((int)__float_as_uint(v), 0x1F | (MASK << 10)));
}
template <int MASK> __device__ __forceinline__ unsigned shxu(unsigned v) { return __float_as_uint(shx<MASK>(__uint_as_float(v))); }
__device__ __forceinline__ float wave_sum(float v) {
    v += shx<1>(v); v += shx<2>(v); v += shx<4>(v); v += shx<8>(v); v += shx<16>(v);
    auto rr = __builtin_amdgcn_permlane32_swap(__float_as_uint(v), __float_as_uint(v), false, false); return __uint_as_float(rr[0]) + __uint_as_float(rr[1]);
}
__device__ __forceinline__ float wave_max(float v) {
    v = fmaxf(v, shx<1>(v)); v = fmaxf(v, shx<2>(v)); v = fmaxf(v, shx<4>(v)); v = fmaxf(v, shx<8>(v)); v = fmaxf(v, shx<16>(v));
    auto rr = __builtin_amdgcn_permlane32_swap(__float_as_uint(v), __float_as_uint(v), false, false); return fmaxf(__uint_as_float(rr[0]), __uint_as_float(rr[1]));
}
__device__ __forceinline__ float rcpf_(float x) { return __builtin_amdgcn_rcpf(x); }
__device__ __forceinline__ float sigmoidf_(float x) { return rcpf_(1.f + __expf(-x)); }
__device__ __forceinline__ float log_sigmoidf_(float x) { return fminf(x, 0.f) - __logf(1.f + __expf(-fabsf(x))); }
__device__ __forceinline__ void rope_cs(int pos, int f, float& c, float& s) {
    const float invf = f == 0 ? 1.0f : f == 1 ? 0.193922758102417f : f == 2 ? 0.03760603442788124f : f == 3 ? 0.007292666472494602f : f == 4 ? 0.0014142136787995696f
                     : f == 5 ? 0.00027424818836152554f : f == 6 ? 5.318298644851893e-05f : 1.031338433676865e-05f;
    const float ang = (float)pos * invf;
    const float k = rintf(ang * 0.15915493667125702f);
    float r = fmaf(-k, 6.2831854820251465f, ang); r = fmaf(-k, -1.7484555314695172e-07f, r);
    c = __cosf(r); s = __sinf(r);
}


__device__ __forceinline__ float dot64(const bf16* __restrict__ kp, const float* q) {
    const uint4* k4 = (const uint4*)kp; float a = 0.f;
#pragma unroll
    for (int j = 0; j < 8; ++j) { const uint4 w = k4[j]; const unsigned ww[4] = {w.x, w.y, w.z, w.w};
#pragma unroll
        for (int e = 0; e < 4; ++e) { a = fmaf(q[8 * j + 2 * e], __builtin_bit_cast(float, ww[e] << 16), a); a = fmaf(q[8 * j + 2 * e + 1], __builtin_bit_cast(float, ww[e] & 0xffff0000u), a); } }
    return a;
}
__device__ __forceinline__ void dot64x4(const bf16* __restrict__ kp, const float (*q)[64], float (&a)[4]) {
    const uint4* k4 = (const uint4*)kp; a[0] = a[1] = a[2] = a[3] = 0.f;
#pragma unroll
    for (int j = 0; j < 8; ++j) { const uint4 w = k4[j]; const unsigned ww[4] = {w.x, w.y, w.z, w.w};
#pragma unroll
        for (int e = 0; e < 4; ++e) { const float k0 = __builtin_bit_cast(float, ww[e] << 16), k1 = __builtin_bit_cast(float, ww[e] & 0xffff0000u);
#pragma unroll
            for (int h = 0; h < 4; ++h) { a[h] = fmaf(q[h][8 * j + 2 * e], k0, a[h]); a[h] = fmaf(q[h][8 * j + 2 * e + 1], k1, a[h]); } } }
}

__host__ __device__ __forceinline__ int win_src(int n) {
    if (n < 2048) return n;
    if (n < 3456) return n + 8;
    if (n < 3464) return n - 3456 + 2048;
    if (n < 3476) return n;
    return -1;
}


__device__ __forceinline__ void ph_convert_w(const float* __restrict__ W, int K, int N, int NP, bf16* __restrict__ WT, int mode, int item, bool act, int t, float* tile  ) {
    const int nbx = NP / 64; const int n0 = (item % nbx) * 64, k0 = (item / nbx) * 64, c = t & 63, r = t >> 6;
    if (act) { const int src = mode ? win_src(n0 + c) : (n0 + c);
#pragma unroll 4
        for (int i = 0; i < 16; ++i) { const int k = r + 4 * i; tile[k * 65 + c] = (src >= 0) ? W[(size_t)(k0 + k) * N + src] : 0.f; } }
    __syncthreads();
    if (act) {
#pragma unroll 4
        for (int i = 0; i < 16; ++i) { const int n = r + 4 * i; WT[(size_t)(n0 + n) * K + k0 + c] = f2bf(tile[c * 65 + n]); } }
    __syncthreads();
}
__device__ __forceinline__ void ph_rmsnorm_row(const float* __restrict__ x, const float* __restrict__ g, bf16* __restrict__ H, int row, int lane) {
    const float4* xr = (const float4*)(x + (size_t)row * DM) + lane;
    float4 v[4]; float s = 0.f;
#pragma unroll
    for (int j = 0; j < 4; ++j) { v[j] = xr[64 * j]; s += v[j].x * v[j].x + v[j].y * v[j].y + v[j].z * v[j].z + v[j].w * v[j].w; }
    const float rstd = rsqrtf(wave_sum(s) * (1.f / DM) + EPS);
    uint2* o = (uint2*)(H + (size_t)row * DM) + lane;
#pragma unroll
    for (int j = 0; j < 4; ++j) { const float4 gg = ((const float4*)g)[lane + 64 * j];
        uint2 w; w.x = pg8::pk2bf(v[j].x * rstd * gg.x, v[j].y * rstd * gg.y); w.y = pg8::pk2bf(v[j].z * rstd * gg.z, v[j].w * rstd * gg.w); o[64 * j] = w; }
}
__device__ __forceinline__ void ph_prep(bf16* __restrict__ P, const float* __restrict__ tab, const float* __restrict__ moba_g, const float* __restrict__ nsa_qg, const float* __restrict__ nsa_kg,
                                        float* __restrict__ kmean, int item, bool act, int t, float* red  ) {
    const int lane = t & 63, wid = t >> 6, tb = item % 128, kind = item / 128;
    float ksum = 0.f;
    if (act) {
        int col; const float* g; bool rope;
        if (kind < 4) { col = C_BQ + kind * 64; g = moba_g; rope = true; }
        else if (kind < 8) { col = C_BK + (kind - 4) * 64; g = moba_g + 64; rope = true; }
        else if (kind < 12) { col = C_NQ + (kind - 8) * 64; g = nsa_qg; rope = false; }
        else if (kind == 12) { col = C_NKS; g = nsa_kg + 64; rope = true; }
        else { col = C_NKW; g = nsa_kg + 128; rope = true; }
        const float gd = g[lane];
        for (int i = 0; i < 64; ++i) {
            const int row = tb * 256 + wid * 64 + i, pos = row & (SEQ - 1);
            bf16* p = P + (size_t)row * DINP + col + lane;
            const float x = bf2f(*p);
            const float ss = wave_sum(x * x);
            float y = x * rsqrtf(ss * (1.f / 64.f) + EPS) * gd;
            if (rope) {
                const float other = shx<8>(y);
                if (lane < 16) { const int f = lane & 7; const float c = tab[pos * 16 + f], s = tab[pos * 16 + 8 + f];
                    y = (lane < 8) ? (y * c - other * s) : (y * c + other * s); }
            }
            *p = f2bf(y);
            ksum += y;
        }
        red[wid * 64 + lane] = ksum;
    }
    __syncthreads();
    if (act && kind >= 4 && kind < 8 && wid == 0) { const float s = red[lane] + red[64 + lane] + red[128 + lane] + red[192 + lane];
        const int b = tb >> 5, n = tb & 31; kmean[(((size_t)b * 4 + (kind - 4)) * 32 + n) * 64 + lane] = s * (1.f / 256.f); }
    __syncthreads();
}
__device__ __forceinline__ void ph_compress(const bf16* __restrict__ P, const float* __restrict__ pe, const float* __restrict__ w1, const float* __restrict__ w2, const float* __restrict__ kg0,
                                            float* __restrict__ KVc, bf16* __restrict__ KVcb, int item, bool act, int t, float* sm  ) {
    float* in = sm; float* hid = sm + 2048;
    const int i = item % NCMP, b = (item / NCMP) & 3, kv = item / (NCMP * 4);
    const int col = kv ? C_NVC : C_NKC;
    if (act) for (int e = t; e < 2048; e += 256) { const int p = e >> 6, d = e & 63; in[e] = bf2f(P[(size_t)(b * SEQ + 16 * i + p) * DINP + col + d]) + pe[(kv * 32 + p) * 64 + d]; }
    __syncthreads();
    if (act && t < 128) { const float* w = w1 + (size_t)kv * 2048 * 128 + t; float a = 0.f;
#pragma unroll 8
        for (int k = 0; k < 2048; ++k) a = fmaf(in[k], w[(size_t)k * 128], a);
        hid[t] = a * rcpf_(1.f + __expf(-a)); }
    __syncthreads();
    if (act && t < 64) { const float* ww = w2 + (size_t)kv * 128 * 64 + t; float o = 0.f;
#pragma unroll 8
        for (int j = 0; j < 128; ++j) o = fmaf(hid[j], ww[j * 64], o);
        if (kv == 0) { const float ss = wave_sum(o * o); o = o * rsqrtf(ss * (1.f / 64.f) + EPS) * kg0[t]; }
        KVc[(((size_t)kv * NB + b) * 512 + i) * 64 + t] = o; KVcb[(((size_t)kv * NB + b) * 512 + i) * 64 + t] = f2bf(o);
        if (i == NCMP - 1) KVcb[(((size_t)kv * NB + b) * 512 + NCMP) * 64 + t] = 0; }
    __syncthreads();
}
__device__ __forceinline__ float conv_silu(const bf16* __restrict__ P, const float* __restrict__ cw  , int rowbase, int t, int c) {
    float a = 0.f;
#pragma unroll
    for (int j = 0; j < 4; ++j) { const int tt = t - 3 + j; if (tt >= 0) a = fmaf(cw[j * 1024 + c], bf2f(P[(size_t)(rowbase + tt) * DINP + c]), a); }
    return a * rcpf_(1.f + __expf(-a));
}
__device__ __forceinline__ void ph_mlstm_local(const bf16* __restrict__ P, const float* __restrict__ G, const float* __restrict__ cw, const float* __restrict__ bif,
                                               float* __restrict__ Cst, float* __restrict__ nst, float* __restrict__ dec, int u, bool act, int tid, unsigned char* sm) {
    bf16 (*ks)[128] = (bf16 (*)[128])sm; bf16 (*vs)[128] = (bf16 (*)[128])(sm + 16384); float* wS = (float*)(sm + 32768); float* lf = wS + 64;
    const int c = u & 127, h = (u >> 7) & 3, b = u >> 9;
    const int rowbase = b * SEQ, t0 = c * 64;
    if (act) {
        for (int e = tid; e < 64 * 128; e += 256) { const int s = e >> 7, d = e & 127;
            ks[s][d] = f2bf(conv_silu(P, cw, rowbase, t0 + s, 512 + h * 128 + d) * 0.08838834764831845f);
            vs[s][d] = P[(size_t)(rowbase + t0 + s) * DINP + C_MV + h * 128 + d]; }
        if (tid < 64) lf[tid] = log_sigmoidf_(G[(size_t)(rowbase + t0 + tid) * 32 + 4 + h] + bif[4 + h]);
    }
    __syncthreads();
    if (act && tid == 0) { float acc = 0.f;
        for (int s = 0; s < 64; ++s) { acc += lf[s]; lf[s] = acc; }
        dec[u] = __expf(acc); }
    __syncthreads();
    if (act && tid < 64) wS[tid] = __expf(lf[63] - lf[tid] + G[(size_t)(rowbase + t0 + tid) * 32 + h] + bif[h]);
    __syncthreads();
    if (act) {
        const int d = tid >> 1, e0 = (tid & 1) * 64;
        float acc[64];
#pragma unroll
        for (int e = 0; e < 64; ++e) acc[e] = 0.f;
        float an = 0.f;
        for (int s = 0; s < 64; ++s) { const float kw = wS[s] * bf2f(ks[s][d]); an += kw;
#pragma unroll
            for (int e = 0; e < 64; ++e) acc[e] = fmaf(kw, bf2f(vs[s][e0 + e]), acc[e]); }
        float* o = Cst + ((size_t)u * 128 + d) * 128 + e0;
#pragma unroll
        for (int e = 0; e < 64; ++e) o[e] = acc[e];
        if ((tid & 1) == 0) nst[(size_t)u * 128 + d] = an;
    }
    __syncthreads();
}
__device__ __forceinline__ void ph_mlstm_scan(float* __restrict__ Cst, float* __restrict__ nst, const float* __restrict__ dec, int item, int tid) {
    const int bh = item / 65, part = item % 65;
    float* base; int stride;
    if (part < 64) { base = Cst + (size_t)bh * 128 * 16384 + part * 256 + tid; stride = 16384; }
    else { if (tid >= 128) return; base = nst + (size_t)bh * 128 * 128 + tid; stride = 128; }
    float C = 0.f;
    for (int c = 0; c < 128; ++c) { const float dC = base[(size_t)c * stride]; base[(size_t)c * stride] = C; C = dec[bh * 128 + c] * C + dC; }
}
__device__ __forceinline__ void ph_mlstm_out(const bf16* __restrict__ P, const float* __restrict__ G, const float* __restrict__ cw, const float* __restrict__ bif,
                                             const float* __restrict__ Cst, const float* __restrict__ nst, const float* __restrict__ mnorm, bf16* __restrict__ MIX, int u, bool act, int tid, unsigned char* sm) {
    bf16 (*qs)[128] = (bf16 (*)[128])sm; float* ksS = (float*)(sm + 16384); bf16 (*ks)[128] = (bf16 (*)[128])ksS; bf16 (*vs)[128] = (bf16 (*)[128])(sm + 32768);
    float* bb = (float*)(sm + 49152); float* li = bb + 64;
    const int c = u & 127, h = (u >> 7) & 3, b = u >> 9;
    const int rowbase = b * SEQ, t0 = c * 64;
    if (act) {
        for (int e = tid; e < 64 * 128; e += 256) { const int s = e >> 7, d = e & 127;
            qs[s][d] = f2bf(conv_silu(P, cw, rowbase, t0 + s, h * 128 + d));
            ks[s][d] = f2bf(conv_silu(P, cw, rowbase, t0 + s, 512 + h * 128 + d) * 0.08838834764831845f);
            vs[s][d] = P[(size_t)(rowbase + t0 + s) * DINP + C_MV + h * 128 + d]; }
        if (tid < 64) { bb[tid] = log_sigmoidf_(G[(size_t)(rowbase + t0 + tid) * 32 + 4 + h] + bif[4 + h]); li[tid] = G[(size_t)(rowbase + t0 + tid) * 32 + h] + bif[h]; }
    }
    __syncthreads();
    if (act && tid == 0) { float acc = 0.f; for (int s = 0; s < 64; ++s) { acc += bb[s]; bb[s] = acc; } }
    __syncthreads();
    const int t = tid >> 2, part = tid & 3;
    float sreg[16];
    if (act) {
        const int s0 = part * 16;
#pragma unroll
        for (int j = 0; j < 16; ++j) { const int s = s0 + j; float a = 0.f;
            if (s <= t) { for (int d = 0; d < 128; ++d) a = fmaf(bf2f(qs[t][d]), bf2f(ks[s][d]), a); a *= __expf(bb[t] - bb[s] + li[s]); }
            sreg[j] = a; }
    }
    __syncthreads();
    float* S = ksS;
    if (act) {
#pragma unroll
        for (int j = 0; j < 16; ++j) S[t * 64 + part * 16 + j] = sreg[j];
    }
    __syncthreads();
    if (act) {
        const float Ft = __expf(bb[t]);
        float den = 0.f;
        for (int s = 0; s <= t; ++s) den += S[t * 64 + s];
        { const float* np = nst + (size_t)u * 128; float a = 0.f; for (int d = 0; d < 128; ++d) a = fmaf(bf2f(qs[t][d]), np[d], a); den += Ft * a; }
        const int e0 = part * 32;
        float acc[32];
#pragma unroll
        for (int e = 0; e < 32; ++e) acc[e] = 0.f;
        { const float* Cp = Cst + (size_t)u * 16384 + e0;
          for (int d = 0; d < 128; ++d) { const float qd = bf2f(qs[t][d]);
#pragma unroll
              for (int e = 0; e < 32; ++e) acc[e] = fmaf(qd, Cp[d * 128 + e], acc[e]); } }
#pragma unroll
        for (int e = 0; e < 32; ++e) acc[e] *= Ft;
        for (int s = 0; s <= t; ++s) { const float w = S[t * 64 + s];
#pragma unroll
            for (int e = 0; e < 32; ++e) acc[e] = fmaf(w, bf2f(vs[s][e0 + e]), acc[e]); }
        const float inv = rcpf_(fmaxf(fabsf(den), 1.f));
        float ss = 0.f;
#pragma unroll
        for (int e = 0; e < 32; ++e) { acc[e] *= inv; ss += acc[e] * acc[e]; }
        ss += shx<1>(ss); ss += shx<2>(ss);
        const float rstd = rsqrtf(ss * (1.f / 128.f) + EPS);
        const size_t row = (size_t)(rowbase + t0 + t);
#pragma unroll
        for (int e = 0; e < 32; ++e) { const int cc = h * 128 + e0 + e;
            const float o = sigmoidf_(bf2f(P[row * DINP + C_MO + cc]));
            MIX[row * DM + cc] = f2bf(acc[e] * rstd * mnorm[cc] * o); }
    }
    __syncthreads();
}

__device__ __forceinline__ void ph_moba(const bf16* __restrict__ P, const float* __restrict__ kmean, bf16* __restrict__ MIX, int gw, int lane, float* q) {
    const int bh = gw >> 13, tq = gw & (SEQ - 1), b = bh >> 2, h = bh & 3, own = tq >> 8;
    const size_t row = (size_t)b * SEQ + tq;
    __builtin_amdgcn_s_waitcnt(0); __builtin_amdgcn_wave_barrier();
    q[lane] = bf2f(P[row * DINP + C_BQ + h * 64 + lane]);
    __builtin_amdgcn_s_waitcnt(0); __builtin_amdgcn_wave_barrier();
    float gs = -3.0e38f;
    if (lane < 32) { if (lane < own) { const float* km = kmean + (((size_t)b * 4 + h) * 32 + lane) * 64; float a = 0.f; for (int d = 0; d < 64; ++d) a = fmaf(q[d], km[d], a); gs = a; } else gs = -1e30f; }
    int blk[4]; bool val[4];
#pragma unroll
    for (int r = 0; r < 3; ++r) { const float m = wave_max(gs); const unsigned long long bal = __ballot(gs == m); const int idx = __ffsll((long long)bal) - 1;
        blk[r] = idx; val[r] = (r < own); if (lane == idx) gs = -3.0e38f; }
    blk[3] = own; val[3] = true;
    float s[4][4]; float mx = -1e30f;
#pragma unroll
    for (int g = 0; g < 4; ++g)
#pragma unroll
        for (int i = 0; i < 4; ++i) { float a = -1e30f;
            if (val[g]) { const int pos = blk[g] * 256 + i * 64 + lane;
                if (g < 3 || pos <= tq) { const bf16* kp = P + ((size_t)b * SEQ + pos) * DINP + C_BK + h * 64; a = dot64(kp, q) * 0.125f; } }
            s[g][i] = a; mx = fmaxf(mx, a); }
    mx = wave_max(mx);
    float l = 0.f;
#pragma unroll
    for (int g = 0; g < 4; ++g)
#pragma unroll
        for (int i = 0; i < 4; ++i) { const float p = (s[g][i] > -1e29f) ? __expf(s[g][i] - mx) : 0.f; s[g][i] = p; l += p; }
    l = wave_sum(l);
    float o = 0.f;
#pragma unroll
    for (int g = 0; g < 4; ++g) { if (!val[g]) continue;
#pragma unroll
        for (int i = 0; i < 4; ++i) { const bf16* vp = P + ((size_t)b * SEQ + blk[g] * 256 + i * 64) * DINP + C_BV + h * 64 + lane;
            for (int src = 0; src < 64; ++src) { const float p = __shfl(s[g][i], src); o = fmaf(p, bf2f(vp[(size_t)src * DINP]), o); } } }
    MIX[row * DM + 512 + h * 64 + lane] = f2bf(o * rcpf_(l));
}

__device__ __forceinline__ void ph_nsa(const bf16* __restrict__ P, const float* __restrict__ G, const float* __restrict__ tab, const float* __restrict__ KVc, bf16* __restrict__ MIX, int gw, int lane, float* sm) {
    float (*qn)[64] = (float (*)[64])sm; float (*qr)[64] = (float (*)[64])(sm + 256); float* ps = sm + 512;
    const int b = gw >> 13, tq = gw & (SEQ - 1), blkq = tq >> 6;
    const size_t row = (size_t)b * SEQ + tq;
    __builtin_amdgcn_s_waitcnt(0); __builtin_amdgcn_wave_barrier();
#pragma unroll
    for (int h = 0; h < 4; ++h) { const float x = bf2f(P[row * DINP + C_NQ + h * 64 + lane]); qn[h][lane] = x;
        float y = x; const float other = shx<8>(x);
        if (lane < 16) { const int f = lane & 7; const float c = tab[tq * 16 + f], s = tab[tq * 16 + 8 + f]; y = (lane < 8) ? (x * c - other * s) : (x * c + other * s); }
        qr[h][lane] = y; }
    __builtin_amdgcn_s_waitcnt(0); __builtin_amdgcn_wave_barrier();
    const float* Kc = KVc + (size_t)b * 512 * 64; const float* Vc = KVc + ((size_t)NB + b) * 512 * 64;
    float out[4] = {0.f, 0.f, 0.f, 0.f};
    float gate[3][4];
#pragma unroll
    for (int br = 0; br < 3; ++br)
#pragma unroll
        for (int h = 0; h < 4; ++h) gate[br][h] = sigmoidf_(G[row * 32 + 8 + br * 4 + h]);
    const int ncv = (tq >= 31) ? ((tq - 31) >> 4) + 1 : 0;
    {
        float sc[8][4]; float mx[4] = {-1e30f, -1e30f, -1e30f, -1e30f};
#pragma unroll
        for (int i = 0; i < 8; ++i) { const int c = i * 64 + lane;
            float a[4] = {-1e30f, -1e30f, -1e30f, -1e30f};
            if (c < ncv) { const float* kp = Kc + (size_t)c * 64; a[0] = a[1] = a[2] = a[3] = 0.f;
                for (int d = 0; d < 64; ++d) { const float kd = kp[d]; a[0] = fmaf(qn[0][d], kd, a[0]); a[1] = fmaf(qn[1][d], kd, a[1]); a[2] = fmaf(qn[2][d], kd, a[2]); a[3] = fmaf(qn[3][d], kd, a[3]); }
#pragma unroll
                for (int h = 0; h < 4; ++h) a[h] *= 0.125f; }
#pragma unroll
            for (int h = 0; h < 4; ++h) { sc[i][h] = a[h]; mx[h] = fmaxf(mx[h], a[h]); } }
        float l[4];
#pragma unroll
        for (int h = 0; h < 4; ++h) { mx[h] = wave_max(mx[h]); l[h] = 0.f; }
#pragma unroll
        for (int i = 0; i < 8; ++i) { const int c = i * 64 + lane;
#pragma unroll
            for (int h = 0; h < 4; ++h) { const float p = (c < ncv) ? __expf(sc[i][h] - mx[h]) : 0.f; sc[i][h] = p; l[h] += p; } }
#pragma unroll
        for (int h = 0; h < 4; ++h) { l[h] = wave_sum(l[h]); l[h] = (l[h] > 0.f) ? rcpf_(l[h]) : 0.f; }
#pragma unroll
        for (int i = 0; i < 8; ++i) { float su = 0.f;
#pragma unroll
            for (int h = 0; h < 4; ++h) { sc[i][h] *= l[h]; su += sc[i][h]; }
            ps[i * 64 + lane] = su; }
        if (lane < 4) ps[512 + lane] = 0.f;
        float oc[4] = {0.f, 0.f, 0.f, 0.f};
#pragma unroll
        for (int i = 0; i < 8; ++i) { if (i * 64 >= ncv) break; const int nn = min(64, ncv - i * 64);
            for (int src = 0; src < nn; ++src) { const float v = Vc[(size_t)(i * 64 + src) * 64 + lane];
                oc[0] = fmaf(__shfl(sc[i][0], src), v, oc[0]); oc[1] = fmaf(__shfl(sc[i][1], src), v, oc[1]);
                oc[2] = fmaf(__shfl(sc[i][2], src), v, oc[2]); oc[3] = fmaf(__shfl(sc[i][3], src), v, oc[3]); } }
#pragma unroll
        for (int h = 0; h < 4; ++h) out[h] = gate[0][h] * oc[h];
    }
    __builtin_amdgcn_s_waitcnt(0); __builtin_amdgcn_wave_barrier();
    int sidx[16];
    {
        float v0, v1;
        { const int n = lane; float im = 0.f;
#pragma unroll
          for (int j = -1; j < 4; ++j) { const int c = 4 * n + j; if (c >= 0 && c < NCMP) im += ps[c]; }
          const bool causal = n <= blkq, forced = causal && (n == 0 || n >= blkq - 1);
          v0 = forced ? 1e9f : (causal ? im : -1e30f); }
        { const int n = lane + 64; float im = 0.f;
#pragma unroll
          for (int j = -1; j < 4; ++j) { const int c = 4 * n + j; if (c >= 0 && c < NCMP) im += ps[c]; }
          const bool causal = n <= blkq, forced = causal && (n == 0 || n >= blkq - 1);
          v1 = forced ? 1e9f : (causal ? im : -1e30f); }
#pragma unroll
        for (int k = 0; k < 16; ++k) { const float m = wave_max(fmaxf(v0, v1));
            const unsigned long long b0 = __ballot(v0 == m); int idx;
            if (b0) { idx = __ffsll((long long)b0) - 1; if (lane == idx) v0 = -3.0e38f; }
            else { const unsigned long long b1 = __ballot(v1 == m); idx = __ffsll((long long)b1) - 1; if (lane == idx) v1 = -3.0e38f; idx += 64; }
            sidx[k] = idx; }
    }
    {
        float sc[16][4]; float mx[4] = {-1e30f, -1e30f, -1e30f, -1e30f};
#pragma unroll
        for (int k = 0; k < 16; ++k) { const int n = sidx[k], pos = n * 64 + lane;
            float a[4] = {-1e30f, -1e30f, -1e30f, -1e30f};
            if (n <= blkq && pos <= tq) { const bf16* kp = P + ((size_t)b * SEQ + pos) * DINP + C_NKS; dot64x4(kp, qr, a);
#pragma unroll
                for (int h = 0; h < 4; ++h) a[h] *= 0.125f; }
#pragma unroll
            for (int h = 0; h < 4; ++h) { sc[k][h] = a[h]; mx[h] = fmaxf(mx[h], a[h]); } }
        float l[4];
#pragma unroll
        for (int h = 0; h < 4; ++h) { mx[h] = wave_max(mx[h]); l[h] = 0.f; }
#pragma unroll
        for (int k = 0; k < 16; ++k)
#pragma unroll
            for (int h = 0; h < 4; ++h) { const float p = (sc[k][h] > -1e29f) ? __expf(sc[k][h] - mx[h]) : 0.f; sc[k][h] = p; l[h] += p; }
#pragma unroll
        for (int h = 0; h < 4; ++h) l[h] = rcpf_(wave_sum(l[h]));
        float os[4] = {0.f, 0.f, 0.f, 0.f};
#pragma unroll
        for (int k = 0; k < 16; ++k) { const int n = sidx[k]; if (n > blkq) continue;
            const bf16* vp = P + ((size_t)b * SEQ + n * 64) * DINP + C_NVS + lane;
            for (int src = 0; src < 64; ++src) { const float v = bf2f(vp[(size_t)src * DINP]);
                os[0] = fmaf(__shfl(sc[k][0], src), v, os[0]); os[1] = fmaf(__shfl(sc[k][1], src), v, os[1]);
                os[2] = fmaf(__shfl(sc[k][2], src), v, os[2]); os[3] = fmaf(__shfl(sc[k][3], src), v, os[3]); } }
#pragma unroll
        for (int h = 0; h < 4; ++h) out[h] += gate[1][h] * os[h] * l[h];
    }
    {
        float sc[8][4]; float mx[4] = {-1e30f, -1e30f, -1e30f, -1e30f};
#pragma unroll
        for (int i = 0; i < 8; ++i) { const int pos = tq - 511 + i * 64 + lane;
            float a[4] = {-1e30f, -1e30f, -1e30f, -1e30f};
            if (pos >= 0) { const bf16* kp = P + ((size_t)b * SEQ + pos) * DINP + C_NKW; dot64x4(kp, qr, a);
#pragma unroll
                for (int h = 0; h < 4; ++h) a[h] *= 0.125f; }
#pragma unroll
            for (int h = 0; h < 4; ++h) { sc[i][h] = a[h]; mx[h] = fmaxf(mx[h], a[h]); } }
        float l[4];
#pragma unroll
        for (int h = 0; h < 4; ++h) { mx[h] = wave_max(mx[h]); l[h] = 0.f; }
#pragma unroll
        for (int i = 0; i < 8; ++i)
#pragma unroll
            for (int h = 0; h < 4; ++h) { const float p = (sc[i][h] > -1e29f) ? __expf(sc[i][h] - mx[h]) : 0.f; sc[i][h] = p; l[h] += p; }
#pragma unroll
        for (int h = 0; h < 4; ++h) l[h] = rcpf_(wave_sum(l[h]));
        float ow[4] = {0.f, 0.f, 0.f, 0.f};
#pragma unroll
        for (int i = 0; i < 8; ++i) { const int p0 = tq - 511 + i * 64; if (p0 + 63 < 0) continue;
            const int s0 = p0 < 0 ? -p0 : 0;
            for (int src = s0; src < 64; ++src) { const float v = bf2f(P[((size_t)b * SEQ + p0 + src) * DINP + C_NVW + lane]);
                ow[0] = fmaf(__shfl(sc[i][0], src), v, ow[0]); ow[1] = fmaf(__shfl(sc[i][1], src), v, ow[1]);
                ow[2] = fmaf(__shfl(sc[i][2], src), v, ow[2]); ow[3] = fmaf(__shfl(sc[i][3], src), v, ow[3]); } }
#pragma unroll
        for (int h = 0; h < 4; ++h) out[h] += gate[2][h] * ow[h] * l[h];
    }
#pragma unroll
    for (int h = 0; h < 4; ++h) MIX[row * DM + 768 + h * 64 + lane] = f2bf(out[h]);
}


#define LAS __attribute__((address_space(3)))
typedef short bf16x8 __attribute__((ext_vector_type(8)));
typedef float f32x16 __attribute__((ext_vector_type(16)));
typedef short s16x4 __attribute__((ext_vector_type(4)));
typedef unsigned u32x4v __attribute__((ext_vector_type(4)));
typedef float f32x2_t __attribute__((ext_vector_type(2)));
typedef __bf16 bf16x2_t __attribute__((ext_vector_type(2)));
constexpr int KROW = 144, VROW = 192;
constexpr int KBUF = 64 * KROW, VBUF = 64 * VROW, STG = KBUF + VBUF;
constexpr float SCL2 = 0.125f * 1.4426950408889634f;
constexpr float NEGBIG = -1e30f;

__device__ __forceinline__ unsigned cvtpk(float lo, float hi) { f32x2_t v = {lo, hi}; bf16x2_t b = __builtin_convertvector(v, bf16x2_t); return __builtin_bit_cast(unsigned, b); }
__device__ __forceinline__ int crow(int r, int hi) { return (r & 3) + 8 * (r >> 2) + 4 * hi; }
__device__ __forceinline__ s16x4 lds_tr(LAS const unsigned char* p) { return __builtin_bit_cast(s16x4, __builtin_amdgcn_ds_read_tr16_b64_v4i16((LAS s16x4*)p)); }

struct TileSrc { const bf16* k; const bf16* v; int stride; };
__device__ __forceinline__ void tile_load(u32x4v& kr, u32x4v& vr, const TileSrc& s, int t) {
    const int key = t >> 3, ch = t & 7;
    kr = *(const u32x4v*)(s.k + (size_t)key * s.stride + ch * 8); vr = *(const u32x4v*)(s.v + (size_t)key * s.stride + ch * 8);
}
__device__ __forceinline__ void tile_store(LAS unsigned char* buf, const u32x4v& kr, const u32x4v& vr, int t) {
    const int key = t >> 3, ch = t & 7;
    *(LAS u32x4v*)(buf + key * KROW + ch * 16) = kr; *(LAS u32x4v*)(buf + KBUF + key * VROW + ch * 16) = vr;
}
__device__ __forceinline__ void qk_tile(f32x16& p0, f32x16& p1, LAS const unsigned char* kb, const bf16x8 (&qf)[4], int r32, int hi) {
#pragma unroll
    for (int r = 0; r < 16; ++r) { p0[r] = 0.f; p1[r] = 0.f; }
    LAS const unsigned char* a = kb + r32 * KROW + hi * 16;
#pragma unroll
    for (int ks = 0; ks < 4; ++ks) {
        const bf16x8 a0 = *(LAS const bf16x8*)(a + ks * 32), a1 = *(LAS const bf16x8*)(a + 32 * KROW + ks * 32);
        p0 = __builtin_amdgcn_mfma_f32_32x32x16_bf16(a0, qf[ks], p0, 0, 0, 0);
        p1 = __builtin_amdgcn_mfma_f32_32x32x16_bf16(a1, qf[ks], p1, 0, 0, 0);
    }
}
__device__ __forceinline__ void pv_tile(f32x16& o0, f32x16& o1, LAS const unsigned char* vb, const f32x16& p0, const f32x16& p1, int lane) {
    const int g = lane >> 4, i = lane & 15, hi = lane >> 5;
    LAS const unsigned char* base = vb + (4 * hi + (i >> 2)) * VROW + (16 * (g & 1) + 4 * (i & 3)) * 2;
#pragma unroll
    for (int s = 0; s < 4; ++s) {
        unsigned w[4];
#pragma unroll
        for (int e = 0; e < 4; ++e) { const int r = 8 * (s & 1) + 2 * e; w[e] = (s < 2) ? cvtpk(p0[r], p0[r + 1]) : cvtpk(p1[r], p1[r + 1]); }
        const u32x4v wv = {w[0], w[1], w[2], w[3]};
        const bf16x8 pf = __builtin_bit_cast(bf16x8, wv);
#pragma unroll
        for (int mb = 0; mb < 2; ++mb) {
            const s16x4 lo = lds_tr(base + s * 16 * VROW + mb * 64), hi4 = lds_tr(base + s * 16 * VROW + 8 * VROW + mb * 64);
            const bf16x8 vt = {lo[0], lo[1], lo[2], lo[3], hi4[0], hi4[1], hi4[2], hi4[3]};
            if (mb == 0) o0 = __builtin_amdgcn_mfma_f32_32x32x16_bf16(vt, pf, o0, 0, 0, 0);
            else o1 = __builtin_amdgcn_mfma_f32_32x32x16_bf16(vt, pf, o1, 0, 0, 0);
        }
    }
}
__device__ __forceinline__ void softmax_tile(f32x16& p0, f32x16& p1, f32x16& o0, f32x16& o1, float& m, float& l) {
    float tm = fmaxf(p0[0], p1[0]);
#pragma unroll
    for (int r = 1; r < 16; ++r) tm = fmaxf(tm, fmaxf(p0[r], p1[r]));
    tm = fmaxf(tm, shx<32>(tm));
    const float mn = fmaxf(m, tm), alpha = __builtin_amdgcn_exp2f(m - mn);
    m = mn;
    float s = 0.f;
#pragma unroll
    for (int r = 0; r < 16; ++r) { p0[r] = __builtin_amdgcn_exp2f(p0[r] - mn); p1[r] = __builtin_amdgcn_exp2f(p1[r] - mn); s += p0[r] + p1[r]; }
    l = l * alpha + s;
#pragma unroll
    for (int r = 0; r < 16; ++r) { o0[r] *= alpha; o1[r] *= alpha; }
}

constexpr int MOBA_KM_OFF = 2 * STG, MOBA_TL_OFF = MOBA_KM_OFF + 32 * 64 * 4, MOBA_UW_OFF = MOBA_TL_OFF + 132 * 4;
__device__ __forceinline__ void moba_unit(const bf16* __restrict__ P, const float* __restrict__ kmean, bf16* __restrict__ MIX, int b, int h, int qb, int tid, LAS unsigned char* lds) {
    const int lane = tid & 63, wid = __builtin_amdgcn_readfirstlane(tid >> 6), r32 = lane & 31, hi = lane >> 5;
    LAS float* km = (LAS float*)(lds + MOBA_KM_OFF); LAS int* tl = (LAS int*)(lds + MOBA_TL_OFF); LAS unsigned* uw = (LAS unsigned*)(lds + MOBA_UW_OFF);
    const int own = qb, tq = qb * 256 + wid * 32 + r32;
    const size_t rowq = (size_t)b * SEQ + tq;
    const bf16* Pb = P + (size_t)b * SEQ * DINP;
    u32x4v kr, vr;
    { TileSrc s{Pb + (size_t)(own * 256) * DINP + C_BK + h * 64, Pb + (size_t)(own * 256) * DINP + C_BV + h * 64, DINP}; tile_load(kr, vr, s, tid); }
    bf16x8 qf[4];
#pragma unroll
    for (int ks = 0; ks < 4; ++ks) qf[ks] = *(const bf16x8*)(P + rowq * DINP + C_BQ + h * 64 + ks * 16 + hi * 8);
    for (int e = tid; e < own * 64; e += 512) km[e] = kmean[(((size_t)b * 4 + h) * 32) * 64 + e];
    __syncthreads();
    unsigned mask = 0u;
    {
        float qv[32];
#pragma unroll
        for (int ks = 0; ks < 4; ++ks)
#pragma unroll
            for (int j = 0; j < 8; ++j) qv[ks * 8 + j] = bf2f((bf16)qf[ks][j]);
        float b0 = -3e38f, b1 = -3e38f, b2 = -3e38f; int i0 = -1, i1 = -1, i2 = -1;
        for (int n = 0; n < own; ++n) {
            LAS const float* kp = km + n * 64 + hi * 8; float a = 0.f;
#pragma unroll
            for (int ks = 0; ks < 4; ++ks)
#pragma unroll
                for (int j = 0; j < 8; ++j) a = fmaf(qv[ks * 8 + j], kp[ks * 16 + j], a);
            a += shx<32>(a);
            if (a > b0) { b2 = b1; i2 = i1; b1 = b0; i1 = i0; b0 = a; i0 = n; }
            else if (a > b1) { b2 = b1; i2 = i1; b1 = a; i1 = n; }
            else if (a > b2) { b2 = a; i2 = n; }
        }
        if (i0 >= 0) mask |= 1u << i0; if (i1 >= 0) mask |= 1u << i1; if (i2 >= 0) mask |= 1u << i2;
    }
    { unsigned um = mask;
      um |= shxu<1>(um); um |= shxu<2>(um); um |= shxu<4>(um); um |= shxu<8>(um); um |= shxu<16>(um); um |= shxu<32>(um);
      if (lane == 0) uw[wid] = um; }
    tile_store(lds, kr, vr, tid);
    __syncthreads();
    if (tid == 0) { unsigned um = 0u; for (int w = 0; w < 8; ++w) um |= uw[w];
        int cnt = 0; for (int s = 0; s < 4; ++s) tl[cnt++] = own * 4 + s;
        for (int n = 0; n < own; ++n) if ((um >> n) & 1u) for (int s = 0; s < 4; ++s) tl[cnt++] = n * 4 + s;
        tl[131] = cnt; }
    __syncthreads();
    const int nt = tl[131];
    f32x16 o0, o1;
#pragma unroll
    for (int r = 0; r < 16; ++r) { o0[r] = 0.f; o1[r] = 0.f; }
    float m = NEGBIG, l = 0.f;
    for (int i = 0; i < nt; ++i) {
        const int tile = tl[i];
        if (i + 1 < nt) { const int nx = tl[i + 1]; TileSrc s{Pb + (size_t)(nx * 64) * DINP + C_BK + h * 64, Pb + (size_t)(nx * 64) * DINP + C_BV + h * 64, DINP}; tile_load(kr, vr, s, tid); }
        LAS const unsigned char* buf = lds + (i & 1) * STG;
        f32x16 p0, p1;
        qk_tile(p0, p1, buf, qf, r32, hi);
        const int blk = tile >> 2, kbase = tile * 64;
        if (blk == own) {
#pragma unroll
            for (int r = 0; r < 16; ++r) { const int k0 = kbase + crow(r, hi); p0[r] = (k0 <= tq) ? p0[r] * SCL2 : NEGBIG; p1[r] = (k0 + 32 <= tq) ? p1[r] * SCL2 : NEGBIG; }
        } else {
            const bool sel = (mask >> blk) & 1u;
#pragma unroll
            for (int r = 0; r < 16; ++r) { p0[r] = sel ? p0[r] * SCL2 : NEGBIG; p1[r] = sel ? p1[r] * SCL2 : NEGBIG; }
        }
        softmax_tile(p0, p1, o0, o1, m, l);
        pv_tile(o0, o1, buf + KBUF, p0, p1, lane);
        if (i + 1 < nt) tile_store(lds + ((i + 1) & 1) * STG, kr, vr, tid);
        __syncthreads();
    }
    l += shx<32>(l);
    const float inv = rcpf_(l);
    bf16* op = MIX + rowq * DM + 512 + h * 64 + 4 * hi;
#pragma unroll
    for (int g = 0; g < 4; ++g) {
        uint2 w0, w1;
        w0.x = cvtpk(o0[4 * g] * inv, o0[4 * g + 1] * inv); w0.y = cvtpk(o0[4 * g + 2] * inv, o0[4 * g + 3] * inv);
        w1.x = cvtpk(o1[4 * g] * inv, o1[4 * g + 1] * inv); w1.y = cvtpk(o1[4 * g + 2] * inv, o1[4 * g + 3] * inv);
        *(uint2*)(op + 8 * g) = w0; *(uint2*)(op + 32 + 8 * g) = w1;
    }
}

constexpr int NSA_S4_OFF = 2 * STG, NSA_L4_OFF = NSA_S4_OFF + 8 * 8 * 128 * 4, NSA_SM_OFF = NSA_L4_OFF + 8 * 8 * 128 * 4;
struct NsaCtx { const bf16* Pb; const bf16* Kcb; const bf16* Vcb; int b, jq, tid, lane, wid, r32, hi, tq; unsigned mk0, mk1, mk2, mk3; };

template <int MODE>
__device__ __forceinline__ void nsa_tiles(const NsaCtx& c, LAS unsigned char* lds, const bf16x8 (&qf)[4], int nt, f32x16& o0, f32x16& o1, float& m, float& l, float pre) {
    const int tid = c.tid, lane = c.lane, r32 = c.r32, hi = c.hi, tq = c.tq, jq = c.jq;
    const int nw = (jq < 8 ? jq : 8) + 1;
    auto tile_of = [&](int i) -> int { return MODE < 2 ? i : (i == 0 ? jq : (MODE == 2 ? i - 1 : jq - nw + i)); };
    auto src_of = [&](int t) -> TileSrc {
        if (MODE < 2) return TileSrc{c.Kcb + (size_t)t * 64 * 64, c.Vcb + (size_t)t * 64 * 64, 64};
        if (MODE == 2) return TileSrc{c.Pb + (size_t)t * 64 * DINP + C_NKS, c.Pb + (size_t)t * 64 * DINP + C_NVS, DINP};
        return TileSrc{c.Pb + (size_t)t * 64 * DINP + C_NKW, c.Pb + (size_t)t * 64 * DINP + C_NVW, DINP};
    };
    u32x4v kr, vr;
    { const TileSrc s = src_of(tile_of(0)); tile_load(kr, vr, s, tid); }
    tile_store(lds, kr, vr, tid);
    __syncthreads();
    const int ncv = (tq >= 31) ? ((tq - 31) >> 4) + 1 : 0;
    for (int i = 0; i < nt; ++i) {
        const int tile = tile_of(i);
        if (i + 1 < nt) { const TileSrc s = src_of(tile_of(i + 1)); tile_load(kr, vr, s, tid); }
        LAS const unsigned char* buf = lds + (i & 1) * STG;
        const int kbase = tile * 64;
        bool rowsel = true;
        if (MODE == 2 && tile != jq) { const unsigned w = (tile >> 5) == 0 ? c.mk0 : (tile >> 5) == 1 ? c.mk1 : (tile >> 5) == 2 ? c.mk2 : c.mk3; rowsel = (w >> (tile & 31)) & 1u; }
        if (MODE != 2 || __any(rowsel)) {
            f32x16 p0, p1;
            qk_tile(p0, p1, buf, qf, r32, hi);
            if (MODE < 2) {
#pragma unroll
                for (int r = 0; r < 16; ++r) { const int k0 = kbase + crow(r, hi); p0[r] = (k0 < ncv) ? p0[r] * SCL2 : NEGBIG; p1[r] = (k0 + 32 < ncv) ? p1[r] * SCL2 : NEGBIG; }
            } else if (MODE == 2) {
                if (tile == jq) {
#pragma unroll
                    for (int r = 0; r < 16; ++r) { const int k0 = kbase + crow(r, hi); p0[r] = (k0 <= tq) ? p0[r] * SCL2 : NEGBIG; p1[r] = (k0 + 32 <= tq) ? p1[r] * SCL2 : NEGBIG; }
                } else {
#pragma unroll
                    for (int r = 0; r < 16; ++r) { p0[r] = rowsel ? p0[r] * SCL2 : NEGBIG; p1[r] = rowsel ? p1[r] * SCL2 : NEGBIG; }
                }
            } else {
#pragma unroll
                for (int r = 0; r < 16; ++r) { const int k0 = kbase + crow(r, hi);
                    p0[r] = (k0 <= tq && k0 + 511 >= tq) ? p0[r] * SCL2 : NEGBIG; p1[r] = (k0 + 32 <= tq && k0 + 32 + 511 >= tq) ? p1[r] * SCL2 : NEGBIG; }
            }
            if (MODE == 0) {
                float tm = fmaxf(p0[0], p1[0]);
#pragma unroll
                for (int r = 1; r < 16; ++r) tm = fmaxf(tm, fmaxf(p0[r], p1[r]));
                tm = fmaxf(tm, shx<32>(tm));
                const float mn = fmaxf(m, tm); float s = 0.f;
#pragma unroll
                for (int r = 0; r < 16; ++r) { s += (p0[r] > -1e29f ? __builtin_amdgcn_exp2f(p0[r] - mn) : 0.f) + (p1[r] > -1e29f ? __builtin_amdgcn_exp2f(p1[r] - mn) : 0.f); }
                l = l * __builtin_amdgcn_exp2f(m - mn) + s; m = mn;
            } else if (MODE == 1) {
#pragma unroll
                for (int r = 0; r < 16; ++r) { p0[r] = (p0[r] > -1e29f) ? __builtin_amdgcn_exp2f(p0[r] - m) * pre : 0.f; p1[r] = (p1[r] > -1e29f) ? __builtin_amdgcn_exp2f(p1[r] - m) * pre : 0.f; }
                pv_tile(o0, o1, buf + KBUF, p0, p1, lane);
                LAS float* S4 = (LAS float*)(lds + NSA_S4_OFF) + (c.wid * 8 + (r32 & 7)) * 128; LAS float* L4 = (LAS float*)(lds + NSA_L4_OFF) + (c.wid * 8 + (r32 & 7)) * 128;
#pragma unroll
                for (int mbk = 0; mbk < 2; ++mbk)
#pragma unroll
                    for (int g = 0; g < 4; ++g) {
                        float s4 = mbk ? (p1[4 * g] + p1[4 * g + 1]) + (p1[4 * g + 2] + p1[4 * g + 3]) : (p0[4 * g] + p0[4 * g + 1]) + (p0[4 * g + 2] + p0[4 * g + 3]);
                        float la = mbk ? p1[4 * g + 3] : p0[4 * g + 3];
                        s4 += shx<8>(s4); s4 += shx<16>(s4); la += shx<8>(la); la += shx<16>(la);
                        const int gi = tile * 16 + 8 * mbk + 2 * g + hi;
                        if (r32 < 8) { S4[gi] = s4; L4[gi] = la; }
                    }
            } else {
                softmax_tile(p0, p1, o0, o1, m, l);
                pv_tile(o0, o1, buf + KBUF, p0, p1, lane);
            }
        }
        if (i + 1 < nt) tile_store(lds + ((i + 1) & 1) * STG, kr, vr, tid);
        __syncthreads();
    }
}

__device__ __forceinline__ void nsa_unit(const bf16* __restrict__ P, const float* __restrict__ G, const float* __restrict__ tab, const bf16* __restrict__ KVcb, bf16* __restrict__ MIX,
                                         int b, int jq, int tid, LAS unsigned char* lds) {
    NsaCtx c; c.b = b; c.jq = jq; c.tid = tid; c.lane = tid & 63; c.wid = __builtin_amdgcn_readfirstlane(tid >> 6); c.r32 = c.lane & 31; c.hi = c.lane >> 5;
    const int qi = c.r32 & 7, hh = c.r32 >> 3, hi = c.hi, lane = c.lane;
    c.tq = jq * 64 + c.wid * 8 + qi;
    c.Pb = P + (size_t)b * SEQ * DINP; c.Kcb = KVcb + (size_t)b * 512 * 64; c.Vcb = KVcb + ((size_t)NB + b) * 512 * 64;
    c.mk0 = c.mk1 = c.mk2 = c.mk3 = 0u;
    const size_t rowq = (size_t)b * SEQ + c.tq;
    bf16x8 qn[4], qr[4];
#pragma unroll
    for (int ks = 0; ks < 4; ++ks) { qn[ks] = *(const bf16x8*)(P + rowq * DINP + C_NQ + hh * 64 + ks * 16 + hi * 8); qr[ks] = qn[ks]; }
    {
        unsigned w[4];
#pragma unroll
        for (int e = 0; e < 4; ++e) {
            float y[2];
#pragma unroll
            for (int k = 0; k < 2; ++k) { const int j = 2 * e + k; const float x = bf2f((bf16)qn[0][j]); const float other = shx<32>(x);
                const float cs = tab[c.tq * 16 + j], sn = tab[c.tq * 16 + 8 + j]; y[k] = hi ? (x * cs + other * sn) : (x * cs - other * sn); }
            w[e] = cvtpk(y[0], y[1]);
        }
        const u32x4v wv = {w[0], w[1], w[2], w[3]}; qr[0] = __builtin_bit_cast(bf16x8, wv);
    }
    const float g0 = sigmoidf_(G[rowq * 32 + 8 + hh]), g1 = sigmoidf_(G[rowq * 32 + 12 + hh]), g2 = sigmoidf_(G[rowq * 32 + 16 + hh]);
    f32x16 a0, a1;
    {
        const int ncvmax = min(4 * jq + 3, NCMP), nct = (ncvmax + 63) >> 6;
        f32x16 o0, o1;
#pragma unroll
        for (int r = 0; r < 16; ++r) { o0[r] = 0.f; o1[r] = 0.f; }
        float m = NEGBIG, l = 0.f;
        nsa_tiles<0>(c, lds, qn, nct, o0, o1, m, l, 0.f);
        l += shx<32>(l);
        const float pre = (l > 0.f) ? rcpf_(l) : 0.f;
        nsa_tiles<1>(c, lds, qn, nct, o0, o1, m, l, pre);
#pragma unroll
        for (int r = 0; r < 16; ++r) { a0[r] = g0 * o0[r]; a1[r] = g0 * o1[r]; }
    }
    {
        LAS unsigned* sm = (LAS unsigned*)(lds + NSA_SM_OFF);
        for (int q = 0; q < 8; ++q) {
            LAS const float* S4 = (LAS const float*)(lds + NSA_S4_OFF) + (c.wid * 8 + q) * 128; LAS const float* L4 = (LAS const float*)(lds + NSA_L4_OFF) + (c.wid * 8 + q) * 128;
            float v0, v1;
            { const int n = lane; const bool causal = n <= jq, forced = causal && (n == 0 || n >= jq - 1);
              float im = 0.f; if (causal) { im = S4[n]; if (n > 0) im += L4[n - 1]; }
              v0 = forced ? 1e9f : (causal ? im : -1e30f); }
            { const int n = lane + 64; const bool causal = n <= jq, forced = causal && (n >= jq - 1);
              float im = 0.f; if (causal) { im = S4[n] + L4[n - 1]; }
              v1 = forced ? 1e9f : (causal ? im : -1e30f); }
            unsigned long long sel0 = 0ull, sel1 = 0ull;
            for (int k = 0; k < 16; ++k) { const float mx = wave_max(fmaxf(v0, v1));
                const unsigned long long b0 = __ballot(v0 == mx);
                if (b0) { const int idx = __ffsll((long long)b0) - 1; sel0 |= 1ull << idx; if (lane == idx) v0 = -3.0e38f; }
                else { const unsigned long long b1 = __ballot(v1 == mx); const int idx = __ffsll((long long)b1) - 1; sel1 |= 1ull << idx; if (lane == idx) v1 = -3.0e38f; } }
            if (lane == 0) { sm[(c.wid * 8 + q) * 4 + 0] = (unsigned)sel0; sm[(c.wid * 8 + q) * 4 + 1] = (unsigned)(sel0 >> 32); sm[(c.wid * 8 + q) * 4 + 2] = (unsigned)sel1; sm[(c.wid * 8 + q) * 4 + 3] = (unsigned)(sel1 >> 32); }
        }
        __builtin_amdgcn_s_waitcnt(0xc07f); __builtin_amdgcn_wave_barrier();
        c.mk0 = sm[(c.wid * 8 + qi) * 4 + 0]; c.mk1 = sm[(c.wid * 8 + qi) * 4 + 1]; c.mk2 = sm[(c.wid * 8 + qi) * 4 + 2]; c.mk3 = sm[(c.wid * 8 + qi) * 4 + 3];
    }
    {
        f32x16 o0, o1;
#pragma unroll
        for (int r = 0; r < 16; ++r) { o0[r] = 0.f; o1[r] = 0.f; }
        float m = NEGBIG, l = 0.f;
        nsa_tiles<2>(c, lds, qr, jq + 1, o0, o1, m, l, 0.f);
        l += shx<32>(l);
        const float sc = g1 * rcpf_(l);
#pragma unroll
        for (int r = 0; r < 16; ++r) { a0[r] = fmaf(sc, o0[r], a0[r]); a1[r] = fmaf(sc, o1[r], a1[r]); }
    }
    {
        f32x16 o0, o1;
#pragma unroll
        for (int r = 0; r < 16; ++r) { o0[r] = 0.f; o1[r] = 0.f; }
        float m = NEGBIG, l = 0.f;
        nsa_tiles<3>(c, lds, qr, (jq < 8 ? jq : 8) + 1, o0, o1, m, l, 0.f);
        l += shx<32>(l);
        const float sc = g2 * rcpf_(l);
#pragma unroll
        for (int r = 0; r < 16; ++r) { a0[r] = fmaf(sc, o0[r], a0[r]); a1[r] = fmaf(sc, o1[r], a1[r]); }
    }
    bf16* op = MIX + rowq * DM + 768 + hh * 64 + 4 * hi;
#pragma unroll
    for (int g = 0; g < 4; ++g) {
        uint2 w0, w1;
        w0.x = cvtpk(a0[4 * g], a0[4 * g + 1]); w0.y = cvtpk(a0[4 * g + 2], a0[4 * g + 3]);
        w1.x = cvtpk(a1[4 * g], a1[4 * g + 1]); w1.y = cvtpk(a1[4 * g + 2], a1[4 * g + 3]);
        *(uint2*)(op + 8 * g) = w0; *(uint2*)(op + 32 + 8 * g) = w1;
    }
}


constexpr int MQ_PITCH = 272, MV_PITCH = 320;
constexpr int ML_CW_OFF = 0;
constexpr int ML_G_OFF = 4096;
constexpr int ML_Q_OFF = 8192;
constexpr int ML_K_OFF = ML_Q_OFF + 64 * MQ_PITCH;
constexpr int ML_V_OFF = ML_K_OFF + 64 * MV_PITCH;
constexpr int ML_END = ML_V_OFF + 64 * MV_PITCH;
static_assert(ML_END <= 131072, "mlstm LDS");
constexpr float KSCALE = 0.08838834764831845f;

__device__ __forceinline__ void conv8(float (&y)[8], const bf16* __restrict__ Pb, int t, int col0, LAS const float* cwp) {
#pragma unroll
    for (int e = 0; e < 8; ++e) y[e] = 0.f;
#pragma unroll
    for (int j = 0; j < 4; ++j) { const int tt = t - 3 + j;
        if (tt >= 0) { const u32x4v w = *(const u32x4v*)(Pb + (size_t)tt * DINP + col0);
#pragma unroll
            for (int e = 0; e < 4; ++e) { y[2 * e] = fmaf(cwp[j * 256 + 2 * e], __builtin_bit_cast(float, w[e] << 16), y[2 * e]); y[2 * e + 1] = fmaf(cwp[j * 256 + 2 * e + 1], __builtin_bit_cast(float, w[e] & 0xffff0000u), y[2 * e + 1]); } } }
#pragma unroll
    for (int e = 0; e < 8; ++e) y[e] = y[e] * rcpf_(1.f + __expf(-y[e]));
}
__device__ __forceinline__ void mlstm_gates(const float* __restrict__ G, const float* __restrict__ bif, int row0, int h, int tid, LAS float* gs) {
    if (tid < 64) { gs[tid] = log_sigmoidf_(G[(size_t)(row0 + tid) * 32 + 4 + h] + bif[4 + h]); gs[128 + tid] = G[(size_t)(row0 + tid) * 32 + h] + bif[h]; }
    __syncthreads();
    if (tid < 64) { float a = 0.f; for (int s = 0; s <= tid; ++s) a += gs[s]; gs[64 + tid] = a; }
    __syncthreads();
}

__device__ __forceinline__ void mlstm_m1(const bf16* __restrict__ P, const float* __restrict__ G, const float* __restrict__ cw, const float* __restrict__ bif,
                                         bf16* __restrict__ CT, float* __restrict__ nst, float* __restrict__ dec, int u, int tid, LAS unsigned char* lds) {
    const int lane = tid & 63, wid = __builtin_amdgcn_readfirstlane(tid >> 6), hi = lane >> 5;
    const int c = u & 127, h = (u >> 7) & 3, b = u >> 9, t0 = c * 64;
    const bf16* Pb = P + (size_t)b * SEQ * DINP;
    LAS float* cwl = (LAS float*)(lds + ML_CW_OFF); LAS float* gs = (LAS float*)(lds + ML_G_OFF);
    for (int e = tid; e < 4 * 128; e += 512) { const int j = e >> 7, d = e & 127; cwl[j * 256 + 128 + d] = cw[j * 1024 + 512 + h * 128 + d]; }
    mlstm_gates(G, bif, b * SEQ + t0, h, tid, gs);
    if (tid < 64) gs[192 + tid] = __expf(gs[64 + 63] - gs[64 + tid] + gs[128 + tid]);
    if (tid == 0) dec[u] = __expf(gs[64 + 63]);
    __syncthreads();
#pragma unroll
    for (int pass = 0; pass < 2; ++pass) {
        const int s = tid >> 3, ch = (tid & 7) + 8 * pass;
        float y[8]; conv8(y, Pb, t0 + s, C_MK + h * 128 + ch * 8, cwl + 128 + ch * 8);
        const float ws = gs[192 + s] * KSCALE;
        u32x4v w; w[0] = cvtpk(y[0] * ws, y[1] * ws); w[1] = cvtpk(y[2] * ws, y[3] * ws); w[2] = cvtpk(y[4] * ws, y[5] * ws); w[3] = cvtpk(y[6] * ws, y[7] * ws);
        *(LAS u32x4v*)(lds + ML_K_OFF + s * MV_PITCH + ch * 16) = w;
        *(LAS u32x4v*)(lds + ML_V_OFF + s * MV_PITCH + ch * 16) = *(const u32x4v*)(Pb + (size_t)(t0 + s) * DINP + C_MV + h * 128 + ch * 8);
    }
    __syncthreads();
    const int g = lane >> 4, i = lane & 15;
    const int mb = wid >> 1, nb0 = 2 * (wid & 1);
    f32x16 acc0, acc1;
#pragma unroll
    for (int r = 0; r < 16; ++r) { acc0[r] = 0.f; acc1[r] = 0.f; }
    LAS const unsigned char* trb = lds + (4 * hi + (i >> 2)) * MV_PITCH + (16 * (g & 1) + 4 * (i & 3)) * 2;
#pragma unroll
    for (int ks = 0; ks < 4; ++ks) {
        const s16x4 alo = lds_tr(trb + ML_K_OFF + ks * 16 * MV_PITCH + mb * 64), ahi = lds_tr(trb + ML_K_OFF + ks * 16 * MV_PITCH + 8 * MV_PITCH + mb * 64);
        const bf16x8 af = {alo[0], alo[1], alo[2], alo[3], ahi[0], ahi[1], ahi[2], ahi[3]};
        const s16x4 b0lo = lds_tr(trb + ML_V_OFF + ks * 16 * MV_PITCH + nb0 * 64), b0hi = lds_tr(trb + ML_V_OFF + ks * 16 * MV_PITCH + 8 * MV_PITCH + nb0 * 64);
        const s16x4 b1lo = lds_tr(trb + ML_V_OFF + ks * 16 * MV_PITCH + (nb0 + 1) * 64), b1hi = lds_tr(trb + ML_V_OFF + ks * 16 * MV_PITCH + 8 * MV_PITCH + (nb0 + 1) * 64);
        const bf16x8 bf0 = {b0lo[0], b0lo[1], b0lo[2], b0lo[3], b0hi[0], b0hi[1], b0hi[2], b0hi[3]}, bf1 = {b1lo[0], b1lo[1], b1lo[2], b1lo[3], b1hi[0], b1hi[1], b1hi[2], b1hi[3]};
        acc0 = __builtin_amdgcn_mfma_f32_32x32x16_bf16(af, bf0, acc0, 0, 0, 0);
        acc1 = __builtin_amdgcn_mfma_f32_32x32x16_bf16(af, bf1, acc1, 0, 0, 0);
    }
    bf16* ct = CT + (size_t)u * 16384;
#pragma unroll
    for (int gq = 0; gq < 4; ++gq) { const int d0 = 32 * mb + 8 * gq + 4 * hi;
        uint2 w0, w1; w0.x = cvtpk(acc0[4 * gq], acc0[4 * gq + 1]); w0.y = cvtpk(acc0[4 * gq + 2], acc0[4 * gq + 3]); w1.x = cvtpk(acc1[4 * gq], acc1[4 * gq + 1]); w1.y = cvtpk(acc1[4 * gq + 2], acc1[4 * gq + 3]);
        *(uint2*)(ct + (size_t)(32 * nb0 + (lane & 31)) * 128 + d0) = w0; *(uint2*)(ct + (size_t)(32 * (nb0 + 1) + (lane & 31)) * 128 + d0) = w1; }
    if (tid < 128) { float a = 0.f; for (int s = 0; s < 64; ++s) a += bf2f(*(LAS const bf16*)(lds + ML_K_OFF + s * MV_PITCH + tid * 2)); nst[(size_t)u * 128 + tid] = a; }
    __syncthreads();
}

__device__ __forceinline__ void mlstm_scan(bf16* __restrict__ CT, float* __restrict__ nst, const float* __restrict__ dec, int item, int tid) {
    const int bh = item / 9, part = item % 9;
    if (part < 8) {
        bf16* base = CT + (size_t)bh * 128 * 16384 + (part * 512 + tid) * 4;
        float C[4] = {0.f, 0.f, 0.f, 0.f};
        for (int c0 = 0; c0 < 128; c0 += 16) {
            uint2 w[16];
#pragma unroll
            for (int k = 0; k < 16; ++k) w[k] = *(const uint2*)(base + (size_t)(c0 + k) * 16384);
#pragma unroll
            for (int k = 0; k < 16; ++k) { const float a = dec[bh * 128 + c0 + k];
                uint2 o; o.x = cvtpk(C[0], C[1]); o.y = cvtpk(C[2], C[3]); *(uint2*)(base + (size_t)(c0 + k) * 16384) = o;
                C[0] = fmaf(a, C[0], __builtin_bit_cast(float, w[k].x << 16)); C[1] = fmaf(a, C[1], __builtin_bit_cast(float, w[k].x & 0xffff0000u));
                C[2] = fmaf(a, C[2], __builtin_bit_cast(float, w[k].y << 16)); C[3] = fmaf(a, C[3], __builtin_bit_cast(float, w[k].y & 0xffff0000u)); }
        }
    } else if (tid < 128) {
        float* base = nst + (size_t)bh * 128 * 128 + tid; float C = 0.f;
        for (int c = 0; c < 128; ++c) { const float dC = base[(size_t)c * 128]; base[(size_t)c * 128] = C; C = dec[bh * 128 + c] * C + dC; }
    }
}

__device__ __forceinline__ void mlstm_m3(const bf16* __restrict__ P, const float* __restrict__ G, const float* __restrict__ cw, const float* __restrict__ bif,
                                         const bf16* __restrict__ CT, const float* __restrict__ nst, const float* __restrict__ mnorm, bf16* __restrict__ MIX, int u, int tid, LAS unsigned char* lds) {
    const int lane = tid & 63, wid = __builtin_amdgcn_readfirstlane(tid >> 6), hi = lane >> 5, r32 = lane & 31;
    const int c = u & 127, h = (u >> 7) & 3, b = u >> 9, t0 = c * 64;
    const bf16* Pb = P + (size_t)b * SEQ * DINP;
    LAS float* cwl = (LAS float*)(lds + ML_CW_OFF); LAS float* gs = (LAS float*)(lds + ML_G_OFF);
    for (int e = tid; e < 4 * 256; e += 512) { const int j = e >> 8, d = e & 255; cwl[j * 256 + d] = cw[j * 1024 + (d < 128 ? h * 128 + d : 512 + h * 128 + d - 128)]; }
    if (tid >= 128 && tid < 256) gs[256 + tid - 128] = nst[(size_t)u * 128 + tid - 128];
    mlstm_gates(G, bif, b * SEQ + t0, h, tid, gs);
#pragma unroll
    for (int pass = 0; pass < 2; ++pass) {
        const int s = tid >> 3, ch = (tid & 7) + 8 * pass;
        float y[8]; u32x4v w;
        conv8(y, Pb, t0 + s, C_MQ + h * 128 + ch * 8, cwl + ch * 8);
        w[0] = cvtpk(y[0], y[1]); w[1] = cvtpk(y[2], y[3]); w[2] = cvtpk(y[4], y[5]); w[3] = cvtpk(y[6], y[7]);
        *(LAS u32x4v*)(lds + ML_Q_OFF + s * MQ_PITCH + ch * 16) = w;
        conv8(y, Pb, t0 + s, C_MK + h * 128 + ch * 8, cwl + 128 + ch * 8);
        w[0] = cvtpk(y[0] * KSCALE, y[1] * KSCALE); w[1] = cvtpk(y[2] * KSCALE, y[3] * KSCALE); w[2] = cvtpk(y[4] * KSCALE, y[5] * KSCALE); w[3] = cvtpk(y[6] * KSCALE, y[7] * KSCALE);
        *(LAS u32x4v*)(lds + ML_K_OFF + s * MQ_PITCH + ch * 16) = w;
        *(LAS u32x4v*)(lds + ML_V_OFF + s * MV_PITCH + ch * 16) = *(const u32x4v*)(Pb + (size_t)(t0 + s) * DINP + C_MV + h * 128 + ch * 8);
    }
    __syncthreads();
    const int tb = wid & 1, eb = wid >> 1, t = 32 * tb + r32;
    bf16x8 qf[8];
#pragma unroll
    for (int ks = 0; ks < 8; ++ks) qf[ks] = *(LAS const bf16x8*)(lds + ML_Q_OFF + t * MQ_PITCH + ks * 32 + hi * 16);
    f32x16 ni;
#pragma unroll
    for (int r = 0; r < 16; ++r) ni[r] = 0.f;
    { const bf16* ctp = CT + (size_t)u * 16384 + (size_t)(32 * eb + r32) * 128 + hi * 8;
      bf16x8 cf[8];
#pragma unroll
      for (int ks = 0; ks < 8; ++ks) cf[ks] = *(const bf16x8*)(ctp + ks * 16);
#pragma unroll
      for (int ks = 0; ks < 8; ++ks) ni = __builtin_amdgcn_mfma_f32_32x32x16_bf16(cf[ks], qf[ks], ni, 0, 0, 0); }
    f32x16 p0, p1;
#pragma unroll
    for (int r = 0; r < 16; ++r) { p0[r] = 0.f; p1[r] = 0.f; }
    { LAS const unsigned char* ka = lds + ML_K_OFF + r32 * MQ_PITCH + hi * 16;
#pragma unroll
      for (int ks = 0; ks < 8; ++ks) { const bf16x8 a0 = *(LAS const bf16x8*)(ka + ks * 32); p0 = __builtin_amdgcn_mfma_f32_32x32x16_bf16(a0, qf[ks], p0, 0, 0, 0); }
      if (tb == 1) {
#pragma unroll
          for (int ks = 0; ks < 8; ++ks) { const bf16x8 a1 = *(LAS const bf16x8*)(ka + 32 * MQ_PITCH + ks * 32); p1 = __builtin_amdgcn_mfma_f32_32x32x16_bf16(a1, qf[ks], p1, 0, 0, 0); } } }
    const float bt = gs[64 + t], Ft = __expf(bt);
    float dsum = 0.f;
#pragma unroll
    for (int r = 0; r < 16; ++r) { const int s0 = crow(r, hi);
        { const float w = (s0 <= t) ? __expf(bt - gs[64 + s0] + gs[128 + s0]) : 0.f; p0[r] *= w; dsum += p0[r]; }
        { const int s1 = s0 + 32; const float w = (s1 <= t) ? __expf(bt - gs[64 + s1] + gs[128 + s1]) : 0.f; p1[r] *= w; dsum += p1[r]; } }
    float qn = 0.f;
#pragma unroll
    for (int ks = 0; ks < 8; ++ks)
#pragma unroll
        for (int j = 0; j < 8; ++j) qn = fmaf(bf2f((bf16)qf[ks][j]), gs[256 + ks * 16 + hi * 8 + j], qn);
    dsum += shx<32>(dsum); qn += shx<32>(qn);
    const float den = dsum + Ft * qn, inv = rcpf_(fmaxf(fabsf(den), 1.f));
    f32x16 na;
#pragma unroll
    for (int r = 0; r < 16; ++r) na[r] = 0.f;
    { const int g = lane >> 4, i = lane & 15;
      LAS const unsigned char* trb = lds + ML_V_OFF + (4 * hi + (i >> 2)) * MV_PITCH + (16 * (g & 1) + 4 * (i & 3)) * 2 + eb * 64;
#pragma unroll
      for (int ss = 0; ss < 4; ++ss) { if (ss >= 2 && tb == 0) break;
          unsigned w[4];
#pragma unroll
          for (int e = 0; e < 4; ++e) { const int r = 8 * (ss & 1) + 2 * e; w[e] = (ss < 2) ? cvtpk(p0[r], p0[r + 1]) : cvtpk(p1[r], p1[r + 1]); }
          const u32x4v wv = {w[0], w[1], w[2], w[3]}; const bf16x8 pf = __builtin_bit_cast(bf16x8, wv);
          const s16x4 lo = lds_tr(trb + ss * 16 * MV_PITCH), hi4 = lds_tr(trb + ss * 16 * MV_PITCH + 8 * MV_PITCH);
          const bf16x8 vt = {lo[0], lo[1], lo[2], lo[3], hi4[0], hi4[1], hi4[2], hi4[3]};
          na = __builtin_amdgcn_mfma_f32_32x32x16_bf16(vt, pf, na, 0, 0, 0); } }
    float ssq = 0.f;
#pragma unroll
    for (int r = 0; r < 16; ++r) { na[r] = (na[r] + Ft * ni[r]) * inv; ssq += na[r] * na[r]; }
    ssq += shx<32>(ssq);
    if (hi == 0) gs[384 + eb * 64 + t] = ssq;
    __syncthreads();
    const float rstd = rsqrtf((gs[384 + t] + gs[384 + 64 + t] + gs[384 + 128 + t] + gs[384 + 192 + t]) * (1.f / 128.f) + EPS);
    const size_t row = (size_t)b * SEQ + t0 + t;
#pragma unroll
    for (int gq = 0; gq < 4; ++gq) { const int cc = h * 128 + 32 * eb + 8 * gq + 4 * hi;
        const uint2 ow = *(const uint2*)(P + row * DINP + C_MO + cc); const float4 mn = *(const float4*)(mnorm + cc);
        const float o0 = sigmoidf_(__builtin_bit_cast(float, ow.x << 16)), o1 = sigmoidf_(__builtin_bit_cast(float, ow.x & 0xffff0000u)), o2 = sigmoidf_(__builtin_bit_cast(float, ow.y << 16)), o3 = sigmoidf_(__builtin_bit_cast(float, ow.y & 0xffff0000u));
        uint2 w; w.x = cvtpk(na[4 * gq] * rstd * mn.x * o0, na[4 * gq + 1] * rstd * mn.y * o1); w.y = cvtpk(na[4 * gq + 2] * rstd * mn.z * o2, na[4 * gq + 3] * rstd * mn.w * o3);
        *(uint2*)(MIX + row * DM + cc) = w; }
    __syncthreads();
}


__device__ __forceinline__ void compress_item(const bf16* __restrict__ P, const bf16* __restrict__ w1t  , const float* __restrict__ c1  , const float* __restrict__ w2  ,
                                              const float* __restrict__ kg0, bf16* __restrict__ KVcb, int item, int tid, LAS unsigned char* lds) {
    const int lane = tid & 63, wid = __builtin_amdgcn_readfirstlane(tid >> 6), hi = lane >> 5, r32 = lane & 31;
    const int kv = item >> 5, b = (item >> 3) & 3, i0 = (item & 7) * 64;
    const int rb = wid & 1, cb = wid >> 1;
    const int irow = min(i0 + 32 * rb + r32, NCMP - 1);
    const bf16* xa = P + ((size_t)b * SEQ + 16 * irow) * DINP + (kv ? C_NVC : C_NKC) + hi * 8;
    const bf16* wb = w1t + ((size_t)kv * 128 + 32 * cb + r32) * 2048 + hi * 8;
    f32x16 acc;
#pragma unroll
    for (int r = 0; r < 16; ++r) acc[r] = 0.f;
    for (int p0 = 0; p0 < 32; p0 += 4) {
        bf16x8 af[16], bfr[16];
#pragma unroll
        for (int q = 0; q < 16; ++q) { const int p = p0 + (q >> 2), dq = q & 3;
            af[q] = *(const bf16x8*)(xa + (size_t)p * DINP + dq * 16); bfr[q] = *(const bf16x8*)(wb + p * 64 + dq * 16); }
#pragma unroll
        for (int q = 0; q < 16; ++q) acc = __builtin_amdgcn_mfma_f32_32x32x16_bf16(af[q], bfr[q], acc, 0, 0, 0);
    }
    LAS float* hid = (LAS float*)lds;
    { const float cj = c1[kv * 128 + 32 * cb + r32];
#pragma unroll
      for (int r = 0; r < 16; ++r) { const float a = acc[r] + cj; hid[(32 * rb + crow(r, hi)) * 132 + 32 * cb + r32] = a * rcpf_(1.f + __expf(-a)); } }
    __syncthreads();
    {
        const int il = tid >> 3, d0 = (tid & 7) * 8;
        float o[8];
#pragma unroll
        for (int e = 0; e < 8; ++e) o[e] = 0.f;
        const float* wp = w2 + (size_t)kv * 128 * 64 + d0;
        for (int j = 0; j < 128; ++j) { const float hv = hid[il * 132 + j]; const float4 wa = *(const float4*)(wp + j * 64), wb4 = *(const float4*)(wp + j * 64 + 4);
            o[0] = fmaf(hv, wa.x, o[0]); o[1] = fmaf(hv, wa.y, o[1]); o[2] = fmaf(hv, wa.z, o[2]); o[3] = fmaf(hv, wa.w, o[3]);
            o[4] = fmaf(hv, wb4.x, o[4]); o[5] = fmaf(hv, wb4.y, o[5]); o[6] = fmaf(hv, wb4.z, o[6]); o[7] = fmaf(hv, wb4.w, o[7]); }
        if (kv == 0) { float ss = 0.f;
#pragma unroll
            for (int e = 0; e < 8; ++e) ss += o[e] * o[e];
            ss += shx<1>(ss); ss += shx<2>(ss); ss += shx<4>(ss);
            const float rstd = rsqrtf(ss * (1.f / 64.f) + EPS);
#pragma unroll
            for (int e = 0; e < 8; ++e) o[e] *= rstd * kg0[d0 + e]; }
        const int i = i0 + il;
        if (i >= NCMP) {
#pragma unroll
            for (int e = 0; e < 8; ++e) o[e] = 0.f; }
        u32x4v w; w[0] = cvtpk(o[0], o[1]); w[1] = cvtpk(o[2], o[3]); w[2] = cvtpk(o[4], o[5]); w[3] = cvtpk(o[6], o[7]);
        *(u32x4v*)(KVcb + (((size_t)kv * NB + b) * 512 + i) * 64 + d0) = w;
    }
    __syncthreads();
}
__device__ __forceinline__ void cmp_c1_item(const float* __restrict__ pe, const float* __restrict__ w1, float* __restrict__ c1, int item, int tid, LAS unsigned char* lds) {
    const int lk = item >> 4, j0 = (item & 15) * 8, jj = tid & 7, kk = tid >> 3;
    const float* pp = pe + (size_t)lk * 2048; const float* ww = w1 + (size_t)lk * 2048 * 128 + j0 + jj;
    float a = 0.f;
    for (int k = kk; k < 2048; k += 64) a = fmaf(pp[k], ww[(size_t)k * 128], a);
    LAS float* red = (LAS float*)lds;
    red[tid] = a;
    __syncthreads();
    if (tid < 8) { float s = 0.f; for (int q = 0; q < 64; ++q) s += red[q * 8 + tid]; c1[lk * 128 + j0 + tid] = s; }
    __syncthreads();
}

constexpr size_t MiB = 1u << 20;
constexpr size_t W_LAYER = (size_t)(DINP + DM + DFF) * DM + (size_t)DM * DFF;
constexpr size_t WS_W = 0;
constexpr size_t WS_HM = 52 * MiB;
constexpr size_t WS_G = 116 * MiB;
constexpr size_t WS_SMALL = 120 * MiB;
constexpr size_t WS_TAB = WS_SMALL, WS_KMEAN = WS_SMALL + 512 * 1024, WS_KVC = WS_SMALL + 1 * MiB, WS_NST = WS_SMALL + 2 * MiB, WS_DEC = WS_SMALL + 3 * MiB, WS_KVCB = WS_SMALL + 3 * MiB + 512 * 1024;
constexpr size_t WS_W1T = 50 * MiB, WS_C1 = WS_SMALL + 3 * MiB + 16 * 1024;
constexpr size_t WS_P = 124 * MiB;
constexpr size_t WS_C = 348 * MiB;
constexpr size_t WS_U = WS_P;
constexpr size_t WS_END = 476 * MiB;
static_assert(W_LAYER * 2 * DEPTH <= 50 * MiB && WS_W1T + (size_t)DEPTH * 2 * 128 * 2048 * 2 <= 52 * MiB, "weights");
static_assert((size_t)T * DINP * 2 == 224 * MiB && (size_t)T * DFF * 2 == 256 * MiB, "sizes");

struct Params { const float* in[16]; float* out; unsigned char* ws; };
constexpr int LDS_BYTES = 147456;

__global__ void __launch_bounds__(512, 2) hybrid_fwd(Params prm) {
    extern __shared__ __attribute__((aligned(16))) unsigned char lds[];
    cg::grid_group grid = cg::this_grid();
    constexpr int NPH = 1 + DEPTH * 9 - 1;
    for (int ph = 0; ph < NPH; ++ph) {
        int tid = threadIdx.x; asm volatile("" : "+v"(tid));
        const int G = gridDim.x, bid = blockIdx.x, half = tid >> 8, t256 = tid & 255, lane = tid & 63, wid = __builtin_amdgcn_readfirstlane(tid >> 6);
        unsigned char* smh = lds + half * 65536;
        unsigned char* ws = prm.ws; float* out = prm.out; asm volatile("" : "+s"(ws), "+s"(out));
        size_t zz = 0; asm volatile("" : "+s"(zz));
#define IN(k) (prm.in[k] + zz)
        bf16* Wb = (bf16*)(ws + WS_W); bf16* HM = (bf16*)(ws + WS_HM); float* Gt = (float*)(ws + WS_G); float* tab = (float*)(ws + WS_TAB); float* kmean = (float*)(ws + WS_KMEAN);
        float* KVc = (float*)(ws + WS_KVC); float* nst = (float*)(ws + WS_NST); float* dec = (float*)(ws + WS_DEC); bf16* KVcb = (bf16*)(ws + WS_KVCB); bf16* W1t = (bf16*)(ws + WS_W1T); float* C1 = (float*)(ws + WS_C1); bf16* P = (bf16*)(ws + WS_P); bf16* CT = (bf16*)(ws + WS_C); bf16* U = (bf16*)(ws + WS_U);
        const int vb = bid * 2 + half, NVB = G * 2;
        const int gwv = bid * 8 + wid, NGW = G * 8;
        const int l = ph == 0 ? 0 : (ph - 1) / 9, j = ph == 0 ? -1 : (ph - 1) % 9;
        const float* x = IN(0);
        const float* xin = l == 0 ? x : out;
        const bf16* WinT = Wb + l * W_LAYER; const bf16* WoT = WinT + (size_t)DINP * DM; const bf16* W1T = WoT + (size_t)DM * DM; const bf16* W2T = W1T + (size_t)DFF * DM;
        if (ph == 0) {
            const float* w_in = IN(1); const float* w_out = IN(11); const float* w_ff1 = IN(14); const float* w_ff2 = IN(15);
            for (int ll = 0; ll < DEPTH; ++ll) {
                bf16* WinT_ = Wb + ll * W_LAYER; bf16* WoT_ = WinT_ + (size_t)DINP * DM; bf16* W1T_ = WoT_ + (size_t)DM * DM; bf16* W2T_ = W1T_ + (size_t)DFF * DM;
                for (int mt = 0; mt < 4; ++mt) {
                    const float* W; int K, N, NP, mode; bf16* WT;
                    if (mt == 0) { W = w_in + (size_t)ll * DM * DIN; K = DM; N = DIN; NP = DINP; WT = WinT_; mode = 1; }
                    else if (mt == 1) { W = w_out + (size_t)ll * DM * DM; K = DM; N = DM; NP = DM; WT = WoT_; mode = 0; }
                    else if (mt == 2) { W = w_ff1 + (size_t)ll * DM * DFF; K = DM; N = DFF; NP = DFF; WT = W1T_; mode = 0; }
                    else { W = w_ff2 + (size_t)ll * DFF * DM; K = DFF; N = DM; NP = DM; WT = W2T_; mode = 0; }
                    const int nit = (NP / 64) * (K / 64);
                    for (int it0 = 0; it0 < nit; it0 += NVB) { const int it = it0 + vb; ph_convert_w(W, K, N, NP, WT, mode, it, it < nit, t256, (float*)smh); }
                }
            }
            for (int lk = 0; lk < DEPTH * 2; ++lk) {
                const int nit = 2 * 32;
                for (int it0 = 0; it0 < nit; it0 += NVB) { const int it = it0 + vb; ph_convert_w(IN(9) + (size_t)lk * 2048 * 128, 2048, 128, 128, W1t + (size_t)lk * 128 * 2048, 0, it, it < nit, t256, (float*)smh); }
            }
            for (int it = bid; it < 64; it += G) cmp_c1_item(IN(8), IN(9), C1, it, tid, (LAS unsigned char*)lds);
            for (int i = bid * 512 + tid; i < SEQ * 8; i += G * 512) { const int pos = i >> 3, f = i & 7;
                float c_, s_; rope_cs(pos, f, c_, s_);
                tab[pos * 16 + f] = c_; tab[pos * 16 + 8 + f] = s_; }
            for (int row = gwv; row < T; row += NGW) ph_rmsnorm_row(x, IN(12), HM, row, lane);
        } else if (j == 0 || j == 4 || j == 6 || j == 7) {
            pg8::Gemm g; pg8::EpiAny E; int N;
            if (j == 0) { g = pg8::Gemm{HM, WinT, T, DINP, DM}; N = DINP; E = pg8::EpiAny{0, true, P, DINP, Gt, C_GATE, nullptr, nullptr}; }
            else if (j == 4) { g = pg8::Gemm{HM, WoT, T, DM, DM}; N = DM; E = pg8::EpiAny{2, false, nullptr, DM, nullptr, 0, xin, out}; }
            else if (j == 6) { g = pg8::Gemm{HM, W1T, T, DFF, DM}; N = DFF; E = pg8::EpiAny{1, true, U, DFF, nullptr, 0, nullptr, nullptr}; }
            else { g = pg8::Gemm{U, W2T, T, DM, DFF}; N = DM; E = pg8::EpiAny{2, false, nullptr, DM, nullptr, 0, out, out}; }
            pg8::StaticOrder S; S.init(T, N, G, bid);
            pg8::gemm_phase<pg8::EpiAny, pg8::StaticOrder, true, true>((PG8_LAS unsigned char*)lds, g, S, E, tid);
        } else if (j == 1) {
            const float* cw = IN(3) + (size_t)l * 4 * 1024; const float* bif = IN(2) + l * 8;
            for (int it0 = 0; it0 < 128 * 14; it0 += NVB) { const int it = it0 + vb; ph_prep(P, tab, IN(5) + l * 128, IN(6) + l * 64, IN(7) + l * 192, kmean, it, it < 128 * 14, t256, (float*)smh); }
            for (int it = bid; it < 64; it += G) compress_item(P, W1t + (size_t)l * 2 * 128 * 2048, C1 + l * 256, IN(10) + (size_t)l * 2 * 128 * 64, IN(7) + l * 192, KVcb, it, tid, (LAS unsigned char*)lds);
            for (int u = bid; u < 2048; u += G) mlstm_m1(P, Gt, cw, bif, CT, nst, dec, u, tid, (LAS unsigned char*)lds);
        } else if (j == 2) {
            for (int it = bid; it < 16 * 9; it += G) mlstm_scan(CT, nst, dec, it, tid);
            for (int pu = bid; pu < 256; pu += G) { const int bh = pu >> 4, s = pu & 15;
                moba_unit(P, kmean, HM, bh >> 2, bh & 3, 31 - s, tid, (LAS unsigned char*)lds); moba_unit(P, kmean, HM, bh >> 2, bh & 3, s, tid, (LAS unsigned char*)lds); }
            for (int pu = bid; pu < 256; pu += G) { const int b_ = pu >> 6, s = pu & 63;
                nsa_unit(P, Gt, tab, KVcb, HM, b_, 127 - s, tid, (LAS unsigned char*)lds); nsa_unit(P, Gt, tab, KVcb, HM, b_, s, tid, (LAS unsigned char*)lds); }
        } else if (j == 3) {
            const float* cw = IN(3) + (size_t)l * 4 * 1024; const float* bif = IN(2) + l * 8;
            for (int u = bid; u < 2048; u += G) mlstm_m3(P, Gt, cw, bif, CT, nst, IN(4) + l * 512, HM, u, tid, (LAS unsigned char*)lds);
        } else if (j == 5) {
            for (int row = gwv; row < T; row += NGW) ph_rmsnorm_row(out, IN(13) + l * DM, HM, row, lane);
        } else {
            for (int row = gwv; row < T; row += NGW) ph_rmsnorm_row(out, IN(12) + (l + 1) * DM, HM, row, lane);
        }
        if (ph + 1 < NPH) grid.sync();
    }
#undef IN
}

extern "C" void kernel_launch(void* const* d_in, const int* in_sizes, int n_in, void* d_out, int out_size, void* d_ws, size_t ws_size, hipStream_t stream) {
    static int grid = 0;
    if (grid == 0) {
        if (n_in != 16 || in_sizes[0] != T * DM || out_size != T * DM || ws_size < WS_END) { fprintf(stderr, "kernel_launch: unexpected shapes / workspace %zu < %zu\n", ws_size, (size_t)WS_END); grid = -1; return; }
        int dev = 0, cus = 0, per_cu = 0;
        if (hipGetDevice(&dev) != hipSuccess || hipDeviceGetAttribute(&cus, hipDeviceAttributeMultiprocessorCount, dev) != hipSuccess) { grid = -1; return; }
        if (hipFuncSetAttribute((const void*)hybrid_fwd, hipFuncAttributeMaxDynamicSharedMemorySize, LDS_BYTES) != hipSuccess) { fprintf(stderr, "kernel_launch: hipFuncSetAttribute failed\n"); grid = -1; return; }
        if (hipOccupancyMaxActiveBlocksPerMultiprocessor(&per_cu, (const void*)hybrid_fwd, 512, LDS_BYTES) != hipSuccess || per_cu < 1) { fprintf(stderr, "kernel_launch: occupancy query failed (%d)\n", per_cu); grid = -1; return; }
        grid = cus * per_cu;
        fprintf(stderr, "kernel_launch: grid %d (%d CUs x %d)\n", grid, cus, per_cu);
    }
    if (grid < 0) return;
    Params p{};
    for (int i = 0; i < 16; ++i) p.in[i] = (const float*)d_in[i];
    p.out = (float*)d_out; p.ws = (unsigned char*)d_ws;
    void* args[] = {&p};
    hipError_t e = hipLaunchCooperativeKernel((const void*)hybrid_fwd, dim3(grid), dim3(512), args, LDS_BYTES, stream);
    if (e != hipSuccess) fprintf(stderr, "kernel_launch: cooperative launch failed: %s (grid %d)\n", hipGetErrorString(e), grid);
}
```

```cpp
#include <hip/hip_runtime.h>
#include <hip/hip_cooperative_groups.h>
#include <cstdio>
#include <cstdint>
namespace cg = cooperative_groups;
namespace pg8 {
#define PG8_LAS __attribute__((address_space(3)))
typedef unsigned short bf16_t;
typedef short bf16x8 __attribute__((ext_vector_type(8)));
typedef float f32x4 __attribute__((ext_vector_type(4)));
typedef unsigned u32x4 __attribute__((ext_vector_type(4)));
constexpr int BM = 256, BK = 64, HALF = 128, HTB = HALF * BK * 2  , STAGE_BYTES = 8 * HTB, NXCD = 8, WGM = 8;

__host__ __device__ __forceinline__ int lds_byte(int r, int c) { const int st = (r >> 4) * 2 + (c >> 5), rr = r & 15, cc = c & 31, ob = rr * 64 + cc * 2; return st * 1024 + (ob ^ (((ob >> 9) & 1) << 5)); }
__host__ __device__ __forceinline__ void stage_rc(int b, int& R, int& C) { const int st = b / 1024, sb = b % 1024, swz = sb ^ (((sb >> 9) & 1) << 5); R = (st >> 1) * 16 + swz / 64; C = (st & 1) * 32 + (swz % 64) / 2; }
__host__ __device__ __forceinline__ int perm32(int rho) { const int n = rho >> 4, i = rho & 15; return 8 * (i >> 2) + 4 * n + (i & 3); }

struct Unit { int pm, pn; };
struct Gemm { const bf16_t* A; const bf16_t* Bt; int M, N, K; };

struct StaticOrder {
    int nM, nN, nwg, G, c;
    __host__ __device__ void init(int M, int N, int G_, int c_) { nM = M / BM; nN = N / BM; nwg = nM * nN; G = G_; c = c_; }
    __host__ __device__ bool next(int i, Unit& u) const {
        const long L = (long)i * G + c; if (L >= nwg) return false;
        int wgid = (int)L; { const int q = nwg / NXCD, r = nwg % NXCD, xcd = wgid % NXCD, off = wgid / NXCD; wgid = (xcd < r ? xcd * (q + 1) : r * (q + 1) + (xcd - r) * q) + off; }
        const int nig = WGM * nN, gid = wgid / nig, fm = gid * WGM, gsz = (nM - fm) < WGM ? (nM - fm) : WGM;
        u.pm = fm + ((wgid % nig) % gsz); u.pn = (wgid % nig) / gsz; return true;
    }
    __device__ __forceinline__ void a_ready(const Unit&) const {}
    __device__ __forceinline__ void done(const Unit&) const {}
};

__device__ __forceinline__ unsigned f2bf_u(float f) { unsigned u = __builtin_bit_cast(unsigned, f); return (u + 0x7fffu + ((u >> 16) & 1u)) >> 16; }
__device__ __forceinline__ unsigned pk2bf(float lo, float hi) { return f2bf_u(lo) | (f2bf_u(hi) << 16); }

struct EpiProj {
    static constexpr bool PERM = true, AFTER_DRAIN = false;
    bf16_t* O; int ldc; float* gates; int gate0;
    __device__ __forceinline__ void operator()(const f32x4 (&acc)[2][2][4][2], const Unit& u, int wr, int wc, int fr, int fq) const {
        const int row0 = u.pm * BM + wr * 64 + fr; const int col0 = u.pn * BM + wc * 32 + 8 * fq;
#pragma unroll
        for (int ai = 0; ai < 2; ++ai)
#pragma unroll
            for (int m = 0; m < 4; ++m) { const int row = row0 + ai * HALF + m * 16; bf16_t* rowp = O + (size_t)row * ldc + col0;
#pragma unroll
                for (int bj = 0; bj < 2; ++bj) { const f32x4 v0 = acc[ai][bj][m][0], v1 = acc[ai][bj][m][1];
                    u32x4 w; w.x = pk2bf(v0[0], v0[1]); w.y = pk2bf(v0[2], v0[3]); w.z = pk2bf(v1[0], v1[1]); w.w = pk2bf(v1[2], v1[3]);
                    *(u32x4*)(rowp + bj * HALF) = w;
                    const int c = col0 + bj * HALF - gate0;
                    if (c >= 0 && c < 32) { float* g = gates + (size_t)row * 32 + c; *(f32x4*)g = v0; *(f32x4*)(g + 4) = v1; } } }
    }
};
struct EpiRelu2 {
    static constexpr bool PERM = true, AFTER_DRAIN = false;
    bf16_t* O; int ldc;
    __device__ __forceinline__ void operator()(const f32x4 (&acc)[2][2][4][2], const Unit& u, int wr, int wc, int fr, int fq) const {
        const int row0 = u.pm * BM + wr * 64 + fr; const int col0 = u.pn * BM + wc * 32 + 8 * fq;
#pragma unroll
        for (int ai = 0; ai < 2; ++ai)
#pragma unroll
            for (int m = 0; m < 4; ++m) { const int row = row0 + ai * HALF + m * 16; bf16_t* rowp = O + (size_t)row * ldc + col0;
#pragma unroll
                for (int bj = 0; bj < 2; ++bj) { f32x4 v0 = acc[ai][bj][m][0], v1 = acc[ai][bj][m][1];
#pragma unroll
                    for (int e = 0; e < 4; ++e) { float a = v0[e] > 0.f ? v0[e] : 0.f; v0[e] = a * a; float b = v1[e] > 0.f ? v1[e] : 0.f; v1[e] = b * b; }
                    u32x4 w; w.x = pk2bf(v0[0], v0[1]); w.y = pk2bf(v0[2], v0[3]); w.z = pk2bf(v1[0], v1[1]); w.w = pk2bf(v1[2], v1[3]);
                    *(u32x4*)(rowp + bj * HALF) = w; } }
    }
};
struct EpiResid {
    static constexpr bool PERM = false, AFTER_DRAIN = false;
    const float* base; float* out; int ldc;
    __device__ __forceinline__ void operator()(const f32x4 (&acc)[2][2][4][2], const Unit& u, int wr, int wc, int fr, int fq) const {
        const int row0 = u.pm * BM + wr * 64 + fr; const int col0 = u.pn * BM + wc * 32 + 4 * fq;
#pragma unroll
        for (int ai = 0; ai < 2; ++ai)
#pragma unroll
            for (int m = 0; m < 4; ++m) { const size_t off = (size_t)(row0 + ai * HALF + m * 16) * ldc + col0;
#pragma unroll
                for (int bj = 0; bj < 2; ++bj)
#pragma unroll
                    for (int n = 0; n < 2; ++n) { const size_t o = off + bj * HALF + n * 16; const f32x4 b = *(const f32x4*)(base + o); *(f32x4*)(out + o) = b + acc[ai][bj][m][n]; } }
    }
};

struct EpiAny {
    static constexpr bool AFTER_DRAIN = false;
    int kind; bool perm;
    bf16_t* O; int ldc; float* gates; int gate0; const float* base; float* out;
    __device__ __forceinline__ void operator()(const f32x4 (&acc)[2][2][4][2], const Unit& u, int wr, int wc, int fr, int fq) const {
        if (kind == 0) { EpiProj e{O, ldc, gates, gate0}; e(acc, u, wr, wc, fr, fq); }
        else if (kind == 1) { EpiRelu2 e{O, ldc}; e(acc, u, wr, wc, fr, fq); }
        else { EpiResid e{base, out, ldc}; e(acc, u, wr, wc, fr, fq); }
    }
};
template <class Epi, class Sched, bool ALIGN_EPI = false, bool SP2 = false>
__device__ __forceinline__ void gemm_phase(PG8_LAS unsigned char* lds, const Gemm g, const Sched& S, const Epi& E, const int tid) {
    const int wid = __builtin_amdgcn_readfirstlane(tid >> 6), lane = tid & 63, wr = wid >> 2, wc = wid & 3, fr = lane & 15, fq = lane >> 4;
    const int K = g.K, nt = K / BK;
    unsigned voffA[2], voffB[2];
#pragma unroll
    for (int i = 0; i < 2; ++i) { int R, C; stage_rc(tid * 16 + i * 8192, R, C); const int Rb = E.perm ? ((R & ~31) + perm32(R & 31)) : R;
        voffA[i] = (unsigned)(R * K + C) * 2u; voffB[i] = (unsigned)(Rb * K + C) * 2u; }
    const size_t kstep = (size_t)(BK * 2);
    const size_t hstep = (size_t)HALF * K * 2;
    const size_t tstep = 2 * hstep;
    const unsigned ldsw = (unsigned)wid * 1024u;
    const int aoff = lds_byte(wr * 64 + fr, fq * 8), boff = lds_byte(wc * 32 + fr, fq * 8);
#define PG8_SA(b, h) (((b) * 2 + (h)) * HTB)
#define PG8_SB(b, h) ((4 + (b) * 2 + (h)) * HTB)
#define PG8_STAGE(bufoff, gbase, voff) do { _Pragma("unroll") for (int _i = 0; _i < 2; ++_i) \
        __builtin_amdgcn_global_load_lds((const unsigned*)((const char*)(gbase) + (voff)[_i]), (PG8_LAS unsigned*)(lds + (bufoff) + ldsw + _i * 8192), 16, 0, 0); } while (0)
#define PG8_LDA(dst, b, h) do { _Pragma("unroll") for (int m = 0; m < 4; ++m) _Pragma("unroll") for (int k = 0; k < 2; ++k) dst[m][k] = *(const PG8_LAS bf16x8*)(lds + PG8_SA(b, h) + aoff + m * 2048 + k * 1024); } while (0)
#define PG8_LDB(dst, b, h) do { _Pragma("unroll") for (int n = 0; n < 2; ++n) _Pragma("unroll") for (int k = 0; k < 2; ++k) dst[n][k] = *(const PG8_LAS bf16x8*)(lds + PG8_SB(b, h) + boff + n * 2048 + k * 1024); } while (0)
#define PG8_MMA(ai, bj, At, Bt) do { __builtin_amdgcn_s_setprio(1); _Pragma("unroll") for (int m = 0; m < 4; ++m) _Pragma("unroll") for (int n = 0; n < 2; ++n) _Pragma("unroll") for (int k = 0; k < 2; ++k) \
        acc[ai][bj][m][n] = __builtin_amdgcn_mfma_f32_16x16x32_bf16(Bt[n][k], At[m][k], acc[ai][bj][m][n], 0, 0, 0); __builtin_amdgcn_s_setprio(0); } while (0)
#define PG8_WAIT_V(n) asm volatile("s_waitcnt vmcnt(" #n ")" ::: "memory")
#define PG8_WAIT_L(n) asm volatile("s_waitcnt lgkmcnt(" #n ")" ::: "memory")
#define PG8_BAR __builtin_amdgcn_s_barrier()
#define PG8_SCHED __builtin_amdgcn_sched_barrier(0)
    Unit cur, nxt; int ui = 0;
    if (!S.next(0, cur)) return;
    f32x4 acc[2][2][4][2];
#pragma unroll
    for (int a = 0; a < 2; ++a)
#pragma unroll
        for (int b = 0; b < 2; ++b)
#pragma unroll
            for (int m = 0; m < 4; ++m)
#pragma unroll
                for (int n = 0; n < 2; ++n) acc[a][b][m][n] = (f32x4){0.f, 0.f, 0.f, 0.f};
    bf16x8 At[4][2], B0[2][2], B1[2][2];
    const char* cA = (const char*)g.A + (size_t)cur.pm * tstep; const char* cB = (const char*)g.Bt + (size_t)cur.pn * tstep;
    S.a_ready(cur);
    if constexpr (SP2) {
        PG8_STAGE(PG8_SB(0, 0), cB, voffB); PG8_STAGE(PG8_SB(0, 1), cB + hstep, voffB); PG8_STAGE(PG8_SA(0, 0), cA, voffA); PG8_STAGE(PG8_SA(0, 1), cA + hstep, voffA);
        if (wr == 1) PG8_BAR;
        PG8_WAIT_V(2); PG8_BAR;
        PG8_STAGE(PG8_SB(1, 0), cB + kstep, voffB); PG8_STAGE(PG8_SA(1, 0), cA + kstep, voffA); PG8_STAGE(PG8_SB(1, 1), cB + hstep + kstep, voffB);
        PG8_WAIT_V(6); PG8_BAR;
    } else {
        PG8_STAGE(PG8_SB(0, 0), cB, voffB); PG8_STAGE(PG8_SA(0, 0), cA, voffA); PG8_STAGE(PG8_SB(0, 1), cB + hstep, voffB); PG8_STAGE(PG8_SA(0, 1), cA + hstep, voffA);
        if (wr == 1) PG8_BAR;
        PG8_WAIT_V(4); PG8_BAR;
        PG8_STAGE(PG8_SB(1, 0), cB + kstep, voffB); PG8_STAGE(PG8_SA(1, 0), cA + kstep, voffA); PG8_STAGE(PG8_SB(1, 1), cB + hstep + kstep, voffB);
        PG8_WAIT_V(6); PG8_BAR;
    }
    for (;;) {
        const bool has_next = S.next(ui + 1, nxt);
        const char* nA = has_next ? (const char*)g.A + (size_t)nxt.pm * tstep : cA; const char* nB = has_next ? (const char*)g.Bt + (size_t)nxt.pn * tstep : cB;
        for (int t = 0; t < nt; t += 2) {
            const bool last = (t == nt - 2);
            const char* a1 = cA + (size_t)(t + 1) * kstep;
            const char* a2 = last ? nA : cA + (size_t)(t + 2) * kstep; const char* b2 = last ? nB : cB + (size_t)(t + 2) * kstep;
            const char* a3 = a2 + kstep; const char* b3 = b2 + kstep;
            if (last && has_next) S.a_ready(nxt);
            if constexpr (SP2) {
            PG8_LDB(B0, 0, 0); PG8_LDB(B1, 0, 1); PG8_SCHED; PG8_LDA(At, 0, 0); PG8_STAGE(PG8_SA(1, 1), a1 + hstep, voffA);
            PG8_WAIT_V(8); PG8_WAIT_L(0); PG8_BAR; PG8_MMA(0, 0, At, B0); PG8_MMA(0, 1, At, B1); PG8_BAR; PG8_SCHED;
            PG8_LDA(At, 0, 1); PG8_STAGE(PG8_SB(0, 0), b2, voffB); PG8_STAGE(PG8_SB(0, 1), b2 + hstep, voffB); PG8_STAGE(PG8_SA(0, 0), a2, voffA);
            PG8_WAIT_V(8); PG8_WAIT_L(0); PG8_BAR; PG8_MMA(1, 0, At, B0); PG8_MMA(1, 1, At, B1); PG8_BAR; PG8_SCHED;
            PG8_LDB(B0, 1, 0); PG8_LDB(B1, 1, 1); PG8_SCHED; PG8_LDA(At, 1, 0); PG8_STAGE(PG8_SA(0, 1), a2 + hstep, voffA);
            PG8_WAIT_V(8); PG8_WAIT_L(0); PG8_BAR; PG8_MMA(0, 0, At, B0); PG8_MMA(0, 1, At, B1); PG8_BAR; PG8_SCHED;
            PG8_LDA(At, 1, 1); PG8_STAGE(PG8_SB(1, 0), b3, voffB); PG8_STAGE(PG8_SB(1, 1), b3 + hstep, voffB); PG8_STAGE(PG8_SA(1, 0), a3, voffA);
            PG8_WAIT_V(8); PG8_WAIT_L(0); PG8_BAR; PG8_MMA(1, 0, At, B0); PG8_MMA(1, 1, At, B1); PG8_BAR; PG8_SCHED;
            } else {
            PG8_LDB(B0, 0, 0); PG8_SCHED; PG8_LDA(At, 0, 0); PG8_STAGE(PG8_SA(1, 1), a1 + hstep, voffA);
            PG8_WAIT_L(8); PG8_BAR; PG8_WAIT_L(0); PG8_MMA(0, 0, At, B0); PG8_BAR; PG8_SCHED;
            PG8_LDB(B1, 0, 1); PG8_STAGE(PG8_SB(0, 0), b2, voffB);
            PG8_BAR; PG8_WAIT_L(0); PG8_MMA(0, 1, At, B1); PG8_BAR;
            PG8_LDA(At, 0, 1); PG8_STAGE(PG8_SA(0, 0), a2, voffA);
            PG8_BAR; PG8_WAIT_L(0); PG8_MMA(1, 0, At, B0); PG8_BAR; PG8_SCHED;
            PG8_STAGE(PG8_SB(0, 1), b2 + hstep, voffB);
            PG8_WAIT_V(6); PG8_BAR; PG8_MMA(1, 1, At, B1); PG8_BAR;
            PG8_LDB(B0, 1, 0); PG8_SCHED; PG8_LDA(At, 1, 0); PG8_STAGE(PG8_SA(0, 1), a2 + hstep, voffA);
            PG8_WAIT_L(8); PG8_BAR; PG8_WAIT_L(0); PG8_MMA(0, 0, At, B0); PG8_BAR; PG8_SCHED;
            PG8_LDB(B1, 1, 1); PG8_STAGE(PG8_SB(1, 0), b3, voffB);
            PG8_BAR; PG8_WAIT_L(0); PG8_MMA(0, 1, At, B1); PG8_BAR;
            PG8_LDA(At, 1, 1); PG8_STAGE(PG8_SA(1, 0), a3, voffA);
            PG8_BAR; PG8_WAIT_L(0); PG8_MMA(1, 0, At, B0); PG8_BAR; PG8_SCHED;
            PG8_STAGE(PG8_SB(1, 1), b3 + hstep, voffB);
            PG8_WAIT_V(6); PG8_BAR; PG8_MMA(1, 1, At, B1); PG8_BAR;
            }
        }
        if constexpr (ALIGN_EPI) { if (wr == 0) PG8_BAR; }
        if constexpr (!Epi::AFTER_DRAIN) { E(acc, cur, wr, wc, fr, fq); S.done(cur); }
        if (!has_next) break;
#pragma unroll
        for (int a = 0; a < 2; ++a)
#pragma unroll
            for (int b = 0; b < 2; ++b)
#pragma unroll
                for (int m = 0; m < 4; ++m)
#pragma unroll
                    for (int n = 0; n < 2; ++n) acc[a][b][m][n] = (f32x4){0.f, 0.f, 0.f, 0.f};
        cur = nxt; cA = nA; cB = nB; ++ui;
        if constexpr (ALIGN_EPI) { if (wr == 1) PG8_BAR; }
    }
    PG8_WAIT_V(0);
    if constexpr (!ALIGN_EPI) { if (wr == 0) PG8_BAR; }
    PG8_BAR;
    if constexpr (Epi::AFTER_DRAIN) { E.fused(acc, cur, wr, wc, fr, fq, lds, wid, lane); S.done(cur); }
#undef PG8_SA
#undef PG8_SB
#undef PG8_STAGE
#undef PG8_LDA
#undef PG8_LDB
#undef PG8_MMA
#undef PG8_WAIT_V
#undef PG8_WAIT_L
#undef PG8_BAR
#undef PG8_SCHED
}
}

typedef unsigned short bf16;
constexpr int NB = 4, SEQ = 8192, T = NB * SEQ, DM = 1024, DFF = 4096, DEPTH = 2;
constexpr int DIN = 3476, DINP = 3584;
constexpr int C_MQ = 0, C_MK = 512, C_MV = 1024, C_MO = 1536, C_BQ = 2048, C_BK = 2304, C_BV = 2560, C_NQ = 2816,
              C_NKC = 3072, C_NVC = 3136, C_NKS = 3200, C_NVS = 3264, C_NKW = 3328, C_NVW = 3392, C_GATE = 3456;
constexpr int NCMP = 511;
constexpr float EPS = 1e-6f;

__device__ __forceinline__ float bf2f(bf16 v) { return __builtin_bit_cast(float, (unsigned)v << 16); }
__device__ __forceinline__ bf16 f2bf(float f) { return (bf16)pg8::f2bf_u(f); }
template <int MASK> __device__ __forceinline__ float shx(float v) {
    if constexpr (MASK == 32) { auto rr = __builtin_amdgcn_permlane32_swap(__float_as_uint(v), __float_as_uint(v), false, false);
        return __uint_as_float(__builtin_amdgcn_mbcnt_lo(~0u, 0u) == 32u ? rr[0] : rr[1]); }
    else return __uint_as_float((unsigned)__builtin_amdgcn_ds_swizzle((int)__float_as_uint(v), 0x1F | (MASK << 10)));
}
template <int MASK> __device__ __forceinline__ unsigned shxu(unsigned v) { return __float_as_uint(shx<MASK>(__uint_as_float(v))); }
__device__ __forceinline__ float wave_sum(float v) {
    v += shx<1>(v); v += shx<2>(v); v += shx<4>(v); v += shx<8>(v); v += shx<16>(v);
    auto rr = __builtin_amdgcn_permlane32_swap(__float_as_uint(v), __float_as_uint(v), false, false); return __uint_as_float(rr[0]) + __uint_as_float(rr[1]);
}
__device__ __forceinline__ float wave_max(float v) {
    v = fmaxf(v, shx<1>(v)); v = fmaxf(v, shx<2>(v)); v = fmaxf(v, shx<4>(v)); v = fmaxf(v, shx<8>(v)); v = fmaxf(v, shx<16>(v));
    auto rr = __builtin_amdgcn_permlane32_swap(__float_as_uint(v), __float_as_uint(v), false, false); return fmaxf(__uint_as_float(rr[0]), __uint_as_float(rr[1]));
}
__device__ __forceinline__ float rcpf_(float x) { return __builtin_amdgcn_rcpf(x); }
__device__ __forceinline__ float sigmoidf_(float x) { return rcpf_(1.f + __expf(-x)); }
__device__ __forceinline__ float log_sigmoidf_(float x) { return fminf(x, 0.f) - __logf(1.f + __expf(-fabsf(x))); }
__device__ __forceinline__ void rope_cs(int pos, int f, float& c, float& s) {
    const float invf = f == 0 ? 1.0f : f == 1 ? 0.193922758102417f : f == 2 ? 0.03760603442788124f : f == 3 ? 0.007292666472494602f : f == 4 ? 0.0014142136787995696f
                     : f == 5 ? 0.00027424818836152554f : f == 6 ? 5.318298644851893e-05f : 1.031338433676865e-05f;
    const float ang = (float)pos * invf;
    const float k = rintf(ang * 0.15915493667125702f);
    float r = fmaf(-k, 6.2831854820251465f, ang); r = fmaf(-k, -1.7484555314695172e-07f, r);
    c = __cosf(r); s = __sinf(r);
}


__device__ __forceinline__ float dot64(const bf16* __restrict__ kp, const float* q) {
    const uint4* k4 = (const uint4*)kp; float a = 0.f;
#pragma unroll
    for (int j = 0; j < 8; ++j) { const uint4 w = k4[j]; const unsigned ww[4] = {w.x, w.y, w.z, w.w};
#pragma unroll
        for (int e = 0; e < 4; ++e) { a = fmaf(q[8 * j + 2 * e], __builtin_bit_cast(float, ww[e] << 16), a); a = fmaf(q[8 * j + 2 * e + 1], __builtin_bit_cast(float, ww[e] & 0xffff0000u), a); } }
    return a;
}
__device__ __forceinline__ void dot64x4(const bf16* __restrict__ kp, const float (*q)[64], float (&a)[4]) {
    const uint4* k4 = (const uint4*)kp; a[0] = a[1] = a[2] = a[3] = 0.f;
#pragma unroll
    for (int j = 0; j < 8; ++j) { const uint4 w = k4[j]; const unsigned ww[4] = {w.x, w.y, w.z, w.w};
#pragma unroll
        for (int e = 0; e < 4; ++e) { const float k0 = __builtin_bit_cast(float, ww[e] << 16), k1 = __builtin_bit_cast(float, ww[e] & 0xffff0000u);
#pragma unroll
            for (int h = 0; h < 4; ++h) { a[h] = fmaf(q[h][8 * j + 2 * e], k0, a[h]); a[h] = fmaf(q[h][8 * j + 2 * e + 1], k1, a[h]); } } }
}

__host__ __device__ __forceinline__ int win_src(int n) {
    if (n < 2048) return n;
    if (n < 3456) return n + 8;
    if (n < 3464) return n - 3456 + 2048;
    if (n < 3476) return n;
    return -1;
}


__device__ __forceinline__ void ph_convert_w(const float* __restrict__ W, int K, int N, int NP, bf16* __restrict__ WT, int mode, int item, bool act, int t, float* tile  ) {
    const int nbx = NP / 64; const int n0 = (item % nbx) * 64, k0 = (item / nbx) * 64, c = t & 63, r = t >> 6;
    if (act) { const int src = mode ? win_src(n0 + c) : (n0 + c);
#pragma unroll 4
        for (int i = 0; i < 16; ++i) { const int k = r + 4 * i; tile[k * 65 + c] = (src >= 0) ? W[(size_t)(k0 + k) * N + src] : 0.f; } }
    __syncthreads();
    if (act) {
#pragma unroll 4
        for (int i = 0; i < 16; ++i) { const int n = r + 4 * i; WT[(size_t)(n0 + n) * K + k0 + c] = f2bf(tile[c * 65 + n]); } }
    __syncthreads();
}
__device__ __forceinline__ void ph_rmsnorm_row(const float* __restrict__ x, const float* __restrict__ g, bf16* __restrict__ H, int row, int lane) {
    const float4* xr = (const float4*)(x + (size_t)row * DM) + lane;
    float4 v[4]; float s = 0.f;
#pragma unroll
    for (int j = 0; j < 4; ++j) { v[j] = xr[64 * j]; s += v[j].x * v[j].x + v[j].y * v[j].y + v[j].z * v[j].z + v[j].w * v[j].w; }
    const float rstd = rsqrtf(wave_sum(s) * (1.f / DM) + EPS);
    uint2* o = (uint2*)(H + (size_t)row * DM) + lane;
#pragma unroll
    for (int j = 0; j < 4; ++j) { const float4 gg = ((const float4*)g)[lane + 64 * j];
        uint2 w; w.x = pg8::pk2bf(v[j].x * rstd * gg.x, v[j].y * rstd * gg.y); w.y = pg8::pk2bf(v[j].z * rstd * gg.z, v[j].w * rstd * gg.w); o[64 * j] = w; }
}
typedef unsigned u32x4p __attribute__((ext_vector_type(4)));
__device__ __forceinline__ void ph_prep(bf16* __restrict__ P, const float* __restrict__ tab, const float* __restrict__ moba_g, const float* __restrict__ nsa_qg, const float* __restrict__ nsa_kg,
                                        float* __restrict__ kmean, int item, bool act, int t, float* red  ) {
    const int lane = t & 63, wid = t >> 6, tb = item % 128, kind = item / 128, rg = lane >> 3, dch = lane & 7;
    if (act) {
        int col; const float* g; bool rope;
        if (kind < 4) { col = C_BQ + kind * 64; g = moba_g; rope = true; }
        else if (kind < 8) { col = C_BK + (kind - 4) * 64; g = moba_g + 64; rope = true; }
        else if (kind < 12) { col = C_NQ + (kind - 8) * 64; g = nsa_qg; rope = false; }
        else if (kind == 12) { col = C_NKS; g = nsa_kg + 64; rope = true; }
        else { col = C_NKW; g = nsa_kg + 128; rope = true; }
        float gd[8];
#pragma unroll
        for (int e = 0; e < 8; ++e) gd[e] = g[dch * 8 + e];
        const int row0 = tb * 256 + wid * 64 + rg;
        u32x4p raw[8];
#pragma unroll
        for (int it = 0; it < 8; ++it) raw[it] = *(const u32x4p*)(P + (size_t)(row0 + it * 8) * DINP + col + dch * 8);
        float ks[8];
#pragma unroll
        for (int e = 0; e < 8; ++e) ks[e] = 0.f;
#pragma unroll
        for (int it = 0; it < 8; ++it) {
            const int row = row0 + it * 8, pos = row & (SEQ - 1);
            float y[8]; float ss = 0.f;
#pragma unroll
            for (int e = 0; e < 4; ++e) { y[2 * e] = __builtin_bit_cast(float, raw[it][e] << 16); y[2 * e + 1] = __builtin_bit_cast(float, raw[it][e] & 0xffff0000u); ss += y[2 * e] * y[2 * e] + y[2 * e + 1] * y[2 * e + 1]; }
            ss += shx<1>(ss); ss += shx<2>(ss); ss += shx<4>(ss);
            const float rstd = rsqrtf(ss * (1.f / 64.f) + EPS);
#pragma unroll
            for (int e = 0; e < 8; ++e) y[e] *= rstd * gd[e];
            if (rope) {
                float o[8];
#pragma unroll
                for (int e = 0; e < 8; ++e) o[e] = shx<1>(y[e]);
                if (dch < 2) { const float4 c0 = *(const float4*)(tab + pos * 16), c1 = *(const float4*)(tab + pos * 16 + 4), s0 = *(const float4*)(tab + pos * 16 + 8), s1 = *(const float4*)(tab + pos * 16 + 12);
                    const float cs[8] = {c0.x, c0.y, c0.z, c0.w, c1.x, c1.y, c1.z, c1.w}, sn[8] = {s0.x, s0.y, s0.z, s0.w, s1.x, s1.y, s1.z, s1.w};
#pragma unroll
                    for (int e = 0; e < 8; ++e) y[e] = dch ? (y[e] * cs[e] + o[e] * sn[e]) : (y[e] * cs[e] - o[e] * sn[e]); }
            }
            u32x4p w; w[0] = pg8::pk2bf(y[0], y[1]); w[1] = pg8::pk2bf(y[2], y[3]); w[2] = pg8::pk2bf(y[4], y[5]); w[3] = pg8::pk2bf(y[6], y[7]);
            *(u32x4p*)(P + (size_t)row * DINP + col + dch * 8) = w;
#pragma unroll
            for (int e = 0; e < 8; ++e) ks[e] += y[e];
        }
        if (kind >= 4 && kind < 8) {
#pragma unroll
            for (int e = 0; e < 8; ++e) { ks[e] += shx<8>(ks[e]); ks[e] += shx<16>(ks[e]); ks[e] += shx<32>(ks[e]); }
            if (rg == 0) {
#pragma unroll
                for (int e = 0; e < 8; ++e) red[wid * 64 + dch * 8 + e] = ks[e]; }
        }
    }
    __syncthreads();
    if (act && kind >= 4 && kind < 8 && wid == 0) { const float s = red[lane] + red[64 + lane] + red[128 + lane] + red[192 + lane];
        const int b = tb >> 5, n = tb & 31; kmean[(((size_t)b * 4 + (kind - 4)) * 32 + n) * 64 + lane] = s * (1.f / 256.f); }
    __syncthreads();
}
__device__ __forceinline__ void ph_compress(const bf16* __restrict__ P, const float* __restrict__ pe, const float* __restrict__ w1, const float* __restrict__ w2, const float* __restrict__ kg0,
                                            float* __restrict__ KVc, bf16* __restrict__ KVcb, int item, bool act, int t, float* sm  ) {
    float* in = sm; float* hid = sm + 2048;
    const int i = item % NCMP, b = (item / NCMP) & 3, kv = item / (NCMP * 4);
    const int col = kv ? C_NVC : C_NKC;
    if (act) for (int e = t; e < 2048; e += 256) { const int p = e >> 6, d = e & 63; in[e] = bf2f(P[(size_t)(b * SEQ + 16 * i + p) * DINP + col + d]) + pe[(kv * 32 + p) * 64 + d]; }
    __syncthreads();
    if (act && t < 128) { const float* w = w1 + (size_t)kv * 2048 * 128 + t; float a = 0.f;
#pragma unroll 8
        for (int k = 0; k < 2048; ++k) a = fmaf(in[k], w[(size_t)k * 128], a);
        hid[t] = a * rcpf_(1.f + __expf(-a)); }
    __syncthreads();
    if (act && t < 64) { const float* ww = w2 + (size_t)kv * 128 * 64 + t; float o = 0.f;
#pragma unroll 8
        for (int j = 0; j < 128; ++j) o = fmaf(hid[j], ww[j * 64], o);
        if (kv == 0) { const float ss = wave_sum(o * o); o = o * rsqrtf(ss * (1.f / 64.f) + EPS) * kg0[t]; }
        KVc[(((size_t)kv * NB + b) * 512 + i) * 64 + t] = o; KVcb[(((size_t)kv * NB + b) * 512 + i) * 64 + t] = f2bf(o);
        if (i == NCMP - 1) KVcb[(((size_t)kv * NB + b) * 512 + NCMP) * 64 + t] = 0; }
    __syncthreads();
}
__device__ __forceinline__ float conv_silu(const bf16* __restrict__ P, const float* __restrict__ cw  , int rowbase, int t, int c) {
    float a = 0.f;
#pragma unroll
    for (int j = 0; j < 4; ++j) { const int tt = t - 3 + j; if (tt >= 0) a = fmaf(cw[j * 1024 + c], bf2f(P[(size_t)(rowbase + tt) * DINP + c]), a); }
    return a * rcpf_(1.f + __expf(-a));
}
__device__ __forceinline__ void ph_mlstm_local(const bf16* __restrict__ P, const float* __restrict__ G, const float* __restrict__ cw, const float* __restrict__ bif,
                                               float* __restrict__ Cst, float* __restrict__ nst, float* __restrict__ dec, int u, bool act, int tid, unsigned char* sm) {
    bf16 (*ks)[128] = (bf16 (*)[128])sm; bf16 (*vs)[128] = (bf16 (*)[128])(sm + 16384); float* wS = (float*)(sm + 32768); float* lf = wS + 64;
    const int c = u & 127, h = (u >> 7) & 3, b = u >> 9;
    const int rowbase = b * SEQ, t0 = c * 64;
    if (act) {
        for (int e = tid; e < 64 * 128; e += 256) { const int s = e >> 7, d = e & 127;
            ks[s][d] = f2bf(conv_silu(P, cw, rowbase, t0 + s, 512 + h * 128 + d) * 0.08838834764831845f);
            vs[s][d] = P[(size_t)(rowbase + t0 + s) * DINP + C_MV + h * 128 + d]; }
        if (tid < 64) lf[tid] = log_sigmoidf_(G[(size_t)(rowbase + t0 + tid) * 32 + 4 + h] + bif[4 + h]);
    }
    __syncthreads();
    if (act && tid == 0) { float acc = 0.f;
        for (int s = 0; s < 64; ++s) { acc += lf[s]; lf[s] = acc; }
        dec[u] = __expf(acc); }
    __syncthreads();
    if (act && tid < 64) wS[tid] = __expf(lf[63] - lf[tid] + G[(size_t)(rowbase + t0 + tid) * 32 + h] + bif[h]);
    __syncthreads();
    if (act) {
        const int d = tid >> 1, e0 = (tid & 1) * 64;
        float acc[64];
#pragma unroll
        for (int e = 0; e < 64; ++e) acc[e] = 0.f;
        float an = 0.f;
        for (int s = 0; s < 64; ++s) { const float kw = wS[s] * bf2f(ks[s][d]); an += kw;
#pragma unroll
            for (int e = 0; e < 64; ++e) acc[e] = fmaf(kw, bf2f(vs[s][e0 + e]), acc[e]); }
        float* o = Cst + ((size_t)u * 128 + d) * 128 + e0;
#pragma unroll
        for (int e = 0; e < 64; ++e) o[e] = acc[e];
        if ((tid & 1) == 0) nst[(size_t)u * 128 + d] = an;
    }
    __syncthreads();
}
__device__ __forceinline__ void ph_mlstm_scan(float* __restrict__ Cst, float* __restrict__ nst, const float* __restrict__ dec, int item, int tid) {
    const int bh = item / 65, part = item % 65;
    float* base; int stride;
    if (part < 64) { base = Cst + (size_t)bh * 128 * 16384 + part * 256 + tid; stride = 16384; }
    else { if (tid >= 128) return; base = nst + (size_t)bh * 128 * 128 + tid; stride = 128; }
    float C = 0.f;
    for (int c = 0; c < 128; ++c) { const float dC = base[(size_t)c * stride]; base[(size_t)c * stride] = C; C = dec[bh * 128 + c] * C + dC; }
}
__device__ __forceinline__ void ph_mlstm_out(const bf16* __restrict__ P, const float* __restrict__ G, const float* __restrict__ cw, const float* __restrict__ bif,
                                             const float* __restrict__ Cst, const float* __restrict__ nst, const float* __restrict__ mnorm, bf16* __restrict__ MIX, int u, bool act, int tid, unsigned char* sm) {
    bf16 (*qs)[128] = (bf16 (*)[128])sm; float* ksS = (float*)(sm + 16384); bf16 (*ks)[128] = (bf16 (*)[128])ksS; bf16 (*vs)[128] = (bf16 (*)[128])(sm + 32768);
    float* bb = (float*)(sm + 49152); float* li = bb + 64;
    const int c = u & 127, h = (u >> 7) & 3, b = u >> 9;
    const int rowbase = b * SEQ, t0 = c * 64;
    if (act) {
        for (int e = tid; e < 64 * 128; e += 256) { const int s = e >> 7, d = e & 127;
            qs[s][d] = f2bf(conv_silu(P, cw, rowbase, t0 + s, h * 128 + d));
            ks[s][d] = f2bf(conv_silu(P, cw, rowbase, t0 + s, 512 + h * 128 + d) * 0.08838834764831845f);
            vs[s][d] = P[(size_t)(rowbase + t0 + s) * DINP + C_MV + h * 128 + d]; }
        if (tid < 64) { bb[tid] = log_sigmoidf_(G[(size_t)(rowbase + t0 + tid) * 32 + 4 + h] + bif[4 + h]); li[tid] = G[(size_t)(rowbase + t0 + tid) * 32 + h] + bif[h]; }
    }
    __syncthreads();
    if (act && tid == 0) { float acc = 0.f; for (int s = 0; s < 64; ++s) { acc += bb[s]; bb[s] = acc; } }
    __syncthreads();
    const int t = tid >> 2, part = tid & 3;
    float sreg[16];
    if (act) {
        const int s0 = part * 16;
#pragma unroll
        for (int j = 0; j < 16; ++j) { const int s = s0 + j; float a = 0.f;
            if (s <= t) { for (int d = 0; d < 128; ++d) a = fmaf(bf2f(qs[t][d]), bf2f(ks[s][d]), a); a *= __expf(bb[t] - bb[s] + li[s]); }
            sreg[j] = a; }
    }
    __syncthreads();
    float* S = ksS;
    if (act) {
#pragma unroll
        for (int j = 0; j < 16; ++j) S[t * 64 + part * 16 + j] = sreg[j];
    }
    __syncthreads();
    if (act) {
        const float Ft = __expf(bb[t]);
        float den = 0.f;
        for (int s = 0; s <= t; ++s) den += S[t * 64 + s];
        { const float* np = nst + (size_t)u * 128; float a = 0.f; for (int d = 0; d < 128; ++d) a = fmaf(bf2f(qs[t][d]), np[d], a); den += Ft * a; }
        const int e0 = part * 32;
        float acc[32];
#pragma unroll
        for (int e = 0; e < 32; ++e) acc[e] = 0.f;
        { const float* Cp = Cst + (size_t)u * 16384 + e0;
          for (int d = 0; d < 128; ++d) { const float qd = bf2f(qs[t][d]);
#pragma unroll
              for (int e = 0; e < 32; ++e) acc[e] = fmaf(qd, Cp[d * 128 + e], acc[e]); } }
#pragma unroll
        for (int e = 0; e < 32; ++e) acc[e] *= Ft;
        for (int s = 0; s <= t; ++s) { const float w = S[t * 64 + s];
#pragma unroll
            for (int e = 0; e < 32; ++e) acc[e] = fmaf(w, bf2f(vs[s][e0 + e]), acc[e]); }
        const float inv = rcpf_(fmaxf(fabsf(den), 1.f));
        float ss = 0.f;
#pragma unroll
        for (int e = 0; e < 32; ++e) { acc[e] *= inv; ss += acc[e] * acc[e]; }
        ss += shx<1>(ss); ss += shx<2>(ss);
        const float rstd = rsqrtf(ss * (1.f / 128.f) + EPS);
        const size_t row = (size_t)(rowbase + t0 + t);
#pragma unroll
        for (int e = 0; e < 32; ++e) { const int cc = h * 128 + e0 + e;
            const float o = sigmoidf_(bf2f(P[row * DINP + C_MO + cc]));
            MIX[row * DM + cc] = f2bf(acc[e] * rstd * mnorm[cc] * o); }
    }
    __syncthreads();
}

__device__ __forceinline__ void ph_moba(const bf16* __restrict__ P, const float* __restrict__ kmean, bf16* __restrict__ MIX, int gw, int lane, float* q) {
    const int bh = gw >> 13, tq = gw & (SEQ - 1), b = bh >> 2, h = bh & 3, own = tq >> 8;
    const size_t row = (size_t)b * SEQ + tq;
    __builtin_amdgcn_s_waitcnt(0); __builtin_amdgcn_wave_barrier();
    q[lane] = bf2f(P[row * DINP + C_BQ + h * 64 + lane]);
    __builtin_amdgcn_s_waitcnt(0); __builtin_amdgcn_wave_barrier();
    float gs = -3.0e38f;
    if (lane < 32) { if (lane < own) { const float* km = kmean + (((size_t)b * 4 + h) * 32 + lane) * 64; float a = 0.f; for (int d = 0; d < 64; ++d) a = fmaf(q[d], km[d], a); gs = a; } else gs = -1e30f; }
    int blk[4]; bool val[4];
#pragma unroll
    for (int r = 0; r < 3; ++r) { const float m = wave_max(gs); const unsigned long long bal = __ballot(gs == m); const int idx = __ffsll((long long)bal) - 1;
        blk[r] = idx; val[r] = (r < own); if (lane == idx) gs = -3.0e38f; }
    blk[3] = own; val[3] = true;
    float s[4][4]; float mx = -1e30f;
#pragma unroll
    for (int g = 0; g < 4; ++g)
#pragma unroll
        for (int i = 0; i < 4; ++i) { float a = -1e30f;
            if (val[g]) { const int pos = blk[g] * 256 + i * 64 + lane;
                if (g < 3 || pos <= tq) { const bf16* kp = P + ((size_t)b * SEQ + pos) * DINP + C_BK + h * 64; a = dot64(kp, q) * 0.125f; } }
            s[g][i] = a; mx = fmaxf(mx, a); }
    mx = wave_max(mx);
    float l = 0.f;
#pragma unroll
    for (int g = 0; g < 4; ++g)
#pragma unroll
        for (int i = 0; i < 4; ++i) { const float p = (s[g][i] > -1e29f) ? __expf(s[g][i] - mx) : 0.f; s[g][i] = p; l += p; }
    l = wave_sum(l);
    float o = 0.f;
#pragma unroll
    for (int g = 0; g < 4; ++g) { if (!val[g]) continue;
#pragma unroll
        for (int i = 0; i < 4; ++i) { const bf16* vp = P + ((size_t)b * SEQ + blk[g] * 256 + i * 64) * DINP + C_BV + h * 64 + lane;
            for (int src = 0; src < 64; ++src) { const float p = __shfl(s[g][i], src); o = fmaf(p, bf2f(vp[(size_t)src * DINP]), o); } } }
    MIX[row * DM + 512 + h * 64 + lane] = f2bf(o * rcpf_(l));
}

__device__ __forceinline__ void ph_nsa(const bf16* __restrict__ P, const float* __restrict__ G, const float* __restrict__ tab, const float* __restrict__ KVc, bf16* __restrict__ MIX, int gw, int lane, float* sm) {
    float (*qn)[64] = (float (*)[64])sm; float (*qr)[64] = (float (*)[64])(sm + 256); float* ps = sm + 512;
    const int b = gw >> 13, tq = gw & (SEQ - 1), blkq = tq >> 6;
    const size_t row = (size_t)b * SEQ + tq;
    __builtin_amdgcn_s_waitcnt(0); __builtin_amdgcn_wave_barrier();
#pragma unroll
    for (int h = 0; h < 4; ++h) { const float x = bf2f(P[row * DINP + C_NQ + h * 64 + lane]); qn[h][lane] = x;
        float y = x; const float other = shx<8>(x);
        if (lane < 16) { const int f = lane & 7; const float c = tab[tq * 16 + f], s = tab[tq * 16 + 8 + f]; y = (lane < 8) ? (x * c - other * s) : (x * c + other * s); }
        qr[h][lane] = y; }
    __builtin_amdgcn_s_waitcnt(0); __builtin_amdgcn_wave_barrier();
    const float* Kc = KVc + (size_t)b * 512 * 64; const float* Vc = KVc + ((size_t)NB + b) * 512 * 64;
    float out[4] = {0.f, 0.f, 0.f, 0.f};
    float gate[3][4];
#pragma unroll
    for (int br = 0; br < 3; ++br)
#pragma unroll
        for (int h = 0; h < 4; ++h) gate[br][h] = sigmoidf_(G[row * 32 + 8 + br * 4 + h]);
    const int ncv = (tq >= 31) ? ((tq - 31) >> 4) + 1 : 0;
    {
        float sc[8][4]; float mx[4] = {-1e30f, -1e30f, -1e30f, -1e30f};
#pragma unroll
        for (int i = 0; i < 8; ++i) { const int c = i * 64 + lane;
            float a[4] = {-1e30f, -1e30f, -1e30f, -1e30f};
            if (c < ncv) { const float* kp = Kc + (size_t)c * 64; a[0] = a[1] = a[2] = a[3] = 0.f;
                for (int d = 0; d < 64; ++d) { const float kd = kp[d]; a[0] = fmaf(qn[0][d], kd, a[0]); a[1] = fmaf(qn[1][d], kd, a[1]); a[2] = fmaf(qn[2][d], kd, a[2]); a[3] = fmaf(qn[3][d], kd, a[3]); }
#pragma unroll
                for (int h = 0; h < 4; ++h) a[h] *= 0.125f; }
#pragma unroll
            for (int h = 0; h < 4; ++h) { sc[i][h] = a[h]; mx[h] = fmaxf(mx[h], a[h]); } }
        float l[4];
#pragma unroll
        for (int h = 0; h < 4; ++h) { mx[h] = wave_max(mx[h]); l[h] = 0.f; }
#pragma unroll
        for (int i = 0; i < 8; ++i) { const int c = i * 64 + lane;
#pragma unroll
            for (int h = 0; h < 4; ++h) { const float p = (c < ncv) ? __expf(sc[i][h] - mx[h]) : 0.f; sc[i][h] = p; l[h] += p; } }
#pragma unroll
        for (int h = 0; h < 4; ++h) { l[h] = wave_sum(l[h]); l[h] = (l[h] > 0.f) ? rcpf_(l[h]) : 0.f; }
#pragma unroll
        for (int i = 0; i < 8; ++i) { float su = 0.f;
#pragma unroll
            for (int h = 0; h < 4; ++h) { sc[i][h] *= l[h]; su += sc[i][h]; }
            ps[i * 64 + lane] = su; }
        if (lane < 4) ps[512 + lane] = 0.f;
        float oc[4] = {0.f, 0.f, 0.f, 0.f};
#pragma unroll
        for (int i = 0; i < 8; ++i) { if (i * 64 >= ncv) break; const int nn = min(64, ncv - i * 64);
            for (int src = 0; src < nn; ++src) { const float v = Vc[(size_t)(i * 64 + src) * 64 + lane];
                oc[0] = fmaf(__shfl(sc[i][0], src), v, oc[0]); oc[1] = fmaf(__shfl(sc[i][1], src), v, oc[1]);
                oc[2] = fmaf(__shfl(sc[i][2], src), v, oc[2]); oc[3] = fmaf(__shfl(sc[i][3], src), v, oc[3]); } }
#pragma unroll
        for (int h = 0; h < 4; ++h) out[h] = gate[0][h] * oc[h];
    }
    __builtin_amdgcn_s_waitcnt(0); __builtin_amdgcn_wave_barrier();
    int sidx[16];
    {
        float v0, v1;
        { const int n = lane; float im = 0.f;
#pragma unroll
          for (int j = -1; j < 4; ++j) { const int c = 4 * n + j; if (c >= 0 && c < NCMP) im += ps[c]; }
          const bool causal = n <= blkq, forced = causal && (n == 0 || n >= blkq - 1);
          v0 = forced ? 1e9f : (causal ? im : -1e30f); }
        { const int n = lane + 64; float im = 0.f;
#pragma unroll
          for (int j = -1; j < 4; ++j) { const int c = 4 * n + j; if (c >= 0 && c < NCMP) im += ps[c]; }
          const bool causal = n <= blkq, forced = causal && (n == 0 || n >= blkq - 1);
          v1 = forced ? 1e9f : (causal ? im : -1e30f); }
#pragma unroll
        for (int k = 0; k < 16; ++k) { const float m = wave_max(fmaxf(v0, v1));
            const unsigned long long b0 = __ballot(v0 == m); int idx;
            if (b0) { idx = __ffsll((long long)b0) - 1; if (lane == idx) v0 = -3.0e38f; }
            else { const unsigned long long b1 = __ballot(v1 == m); idx = __ffsll((long long)b1) - 1; if (lane == idx) v1 = -3.0e38f; idx += 64; }
            sidx[k] = idx; }
    }
    {
        float sc[16][4]; float mx[4] = {-1e30f, -1e30f, -1e30f, -1e30f};
#pragma unroll
        for (int k = 0; k < 16; ++k) { const int n = sidx[k], pos = n * 64 + lane;
            float a[4] = {-1e30f, -1e30f, -1e30f, -1e30f};
            if (n <= blkq && pos <= tq) { const bf16* kp = P + ((size_t)b * SEQ + pos) * DINP + C_NKS; dot64x4(kp, qr, a);
#pragma unroll
                for (int h = 0; h < 4; ++h) a[h] *= 0.125f; }
#pragma unroll
            for (int h = 0; h < 4; ++h) { sc[k][h] = a[h]; mx[h] = fmaxf(mx[h], a[h]); } }
        float l[4];
#pragma unroll
        for (int h = 0; h < 4; ++h) { mx[h] = wave_max(mx[h]); l[h] = 0.f; }
#pragma unroll
        for (int k = 0; k < 16; ++k)
#pragma unroll
            for (int h = 0; h < 4; ++h) { const float p = (sc[k][h] > -1e29f) ? __expf(sc[k][h] - mx[h]) : 0.f; sc[k][h] = p; l[h] += p; }
#pragma unroll
        for (int h = 0; h < 4; ++h) l[h] = rcpf_(wave_sum(l[h]));
        float os[4] = {0.f, 0.f, 0.f, 0.f};
#pragma unroll
        for (int k = 0; k < 16; ++k) { const int n = sidx[k]; if (n > blkq) continue;
            const bf16* vp = P + ((size_t)b * SEQ + n * 64) * DINP + C_NVS + lane;
            for (int src = 0; src < 64; ++src) { const float v = bf2f(vp[(size_t)src * DINP]);
                os[0] = fmaf(__shfl(sc[k][0], src), v, os[0]); os[1] = fmaf(__shfl(sc[k][1], src), v, os[1]);
                os[2] = fmaf(__shfl(sc[k][2], src), v, os[2]); os[3] = fmaf(__shfl(sc[k][3], src), v, os[3]); } }
#pragma unroll
        for (int h = 0; h < 4; ++h) out[h] += gate[1][h] * os[h] * l[h];
    }
    {
        float sc[8][4]; float mx[4] = {-1e30f, -1e30f, -1e30f, -1e30f};
#pragma unroll
        for (int i = 0; i < 8; ++i) { const int pos = tq - 511 + i * 64 + lane;
            float a[4] = {-1e30f, -1e30f, -1e30f, -1e30f};
            if (pos >= 0) { const bf16* kp = P + ((size_t)b * SEQ + pos) * DINP + C_NKW; dot64x4(kp, qr, a);
#pragma unroll
                for (int h = 0; h < 4; ++h) a[h] *= 0.125f; }
#pragma unroll
            for (int h = 0; h < 4; ++h) { sc[i][h] = a[h]; mx[h] = fmaxf(mx[h], a[h]); } }
        float l[4];
#pragma unroll
        for (int h = 0; h < 4; ++h) { mx[h] = wave_max(mx[h]); l[h] = 0.f; }
#pragma unroll
        for (int i = 0; i < 8; ++i)
#pragma unroll
            for (int h = 0; h < 4; ++h) { const float p = (sc[i][h] > -1e29f) ? __expf(sc[i][h] - mx[h]) : 0.f; sc[i][h] = p; l[h] += p; }
#pragma unroll
        for (int h = 0; h < 4; ++h) l[h] = rcpf_(wave_sum(l[h]));
        float ow[4] = {0.f, 0.f, 0.f, 0.f};
#pragma unroll
        for (int i = 0; i < 8; ++i) { const int p0 = tq - 511 + i * 64; if (p0 + 63 < 0) continue;
            const int s0 = p0 < 0 ? -p0 : 0;
            for (int src = s0; src < 64; ++src) { const float v = bf2f(P[((size_t)b * SEQ + p0 + src) * DINP + C_NVW + lane]);
                ow[0] = fmaf(__shfl(sc[i][0], src), v, ow[0]); ow[1] = fmaf(__shfl(sc[i][1], src), v, ow[1]);
                ow[2] = fmaf(__shfl(sc[i][2], src), v, ow[2]); ow[3] = fmaf(__shfl(sc[i][3], src), v, ow[3]); } }
#pragma unroll
        for (int h = 0; h < 4; ++h) out[h] += gate[2][h] * ow[h] * l[h];
    }
#pragma unroll
    for (int h = 0; h < 4; ++h) MIX[row * DM + 768 + h * 64 + lane] = f2bf(out[h]);
}


#define LAS __attribute__((address_space(3)))
typedef short bf16x8 __attribute__((ext_vector_type(8)));
typedef float f32x16 __attribute__((ext_vector_type(16)));
typedef short s16x4 __attribute__((ext_vector_type(4)));
typedef unsigned u32x4v __attribute__((ext_vector_type(4)));
typedef float f32x2_t __attribute__((ext_vector_type(2)));
typedef __bf16 bf16x2_t __attribute__((ext_vector_type(2)));
constexpr int KROW = 144, VROW = 192;
constexpr int KBUF = 64 * KROW, VBUF = 64 * VROW, STG = KBUF + VBUF;
constexpr float SCL2 = 0.125f * 1.4426950408889634f;
constexpr float NEGBIG = -1e30f;

__device__ __forceinline__ unsigned cvtpk(float lo, float hi) { f32x2_t v = {lo, hi}; bf16x2_t b = __builtin_convertvector(v, bf16x2_t); return __builtin_bit_cast(unsigned, b); }
__device__ __forceinline__ int crow(int r, int hi) { return (r & 3) + 8 * (r >> 2) + 4 * hi; }
__device__ __forceinline__ s16x4 lds_tr(LAS const unsigned char* p) { return __builtin_bit_cast(s16x4, __builtin_amdgcn_ds_read_tr16_b64_v4i16((LAS s16x4*)p)); }

struct TileSrc { const bf16* k; const bf16* v; int stride; };
__device__ __forceinline__ void tile_load(u32x4v& kr, u32x4v& vr, const TileSrc& s, int t) {
    const int key = t >> 3, ch = t & 7;
    kr = *(const u32x4v*)(s.k + (size_t)key * s.stride + ch * 8); vr = *(const u32x4v*)(s.v + (size_t)key * s.stride + ch * 8);
}
__device__ __forceinline__ void tile_store(LAS unsigned char* buf, const u32x4v& kr, const u32x4v& vr, int t) {
    const int key = t >> 3, ch = t & 7;
    *(LAS u32x4v*)(buf + key * KROW + ch * 16) = kr; *(LAS u32x4v*)(buf + KBUF + key * VROW + ch * 16) = vr;
}
__device__ __forceinline__ void qk_tile(f32x16& p0, f32x16& p1, LAS const unsigned char* kb, const bf16x8 (&qf)[4], int r32, int hi) {
#pragma unroll
    for (int r = 0; r < 16; ++r) { p0[r] = 0.f; p1[r] = 0.f; }
    LAS const unsigned char* a = kb + r32 * KROW + hi * 16;
#pragma unroll
    for (int ks = 0; ks < 4; ++ks) {
        const bf16x8 a0 = *(LAS const bf16x8*)(a + ks * 32), a1 = *(LAS const bf16x8*)(a + 32 * KROW + ks * 32);
        p0 = __builtin_amdgcn_mfma_f32_32x32x16_bf16(a0, qf[ks], p0, 0, 0, 0);
        p1 = __builtin_amdgcn_mfma_f32_32x32x16_bf16(a1, qf[ks], p1, 0, 0, 0);
    }
}
__device__ __forceinline__ void pv_tile(f32x16& o0, f32x16& o1, LAS const unsigned char* vb, const f32x16& p0, const f32x16& p1, int lane) {
    const int g = lane >> 4, i = lane & 15, hi = lane >> 5;
    LAS const unsigned char* base = vb + (4 * hi + (i >> 2)) * VROW + (16 * (g & 1) + 4 * (i & 3)) * 2;
#pragma unroll
    for (int s = 0; s < 4; ++s) {
        unsigned w[4];
#pragma unroll
        for (int e = 0; e < 4; ++e) { const int r = 8 * (s & 1) + 2 * e; w[e] = (s < 2) ? cvtpk(p0[r], p0[r + 1]) : cvtpk(p1[r], p1[r + 1]); }
        const u32x4v wv = {w[0], w[1], w[2], w[3]};
        const bf16x8 pf = __builtin_bit_cast(bf16x8, wv);
#pragma unroll
        for (int mb = 0; mb < 2; ++mb) {
            const s16x4 lo = lds_tr(base + s * 16 * VROW + mb * 64), hi4 = lds_tr(base + s * 16 * VROW + 8 * VROW + mb * 64);
            const bf16x8 vt = {lo[0], lo[1], lo[2], lo[3], hi4[0], hi4[1], hi4[2], hi4[3]};
            if (mb == 0) o0 = __builtin_amdgcn_mfma_f32_32x32x16_bf16(vt, pf, o0, 0, 0, 0);
            else o1 = __builtin_amdgcn_mfma_f32_32x32x16_bf16(vt, pf, o1, 0, 0, 0);
        }
    }
}
__device__ __forceinline__ void softmax_tile(f32x16& p0, f32x16& p1, f32x16& o0, f32x16& o1, float& m, float& l) {
    float tm = fmaxf(p0[0], p1[0]);
#pragma unroll
    for (int r = 1; r < 16; ++r) tm = fmaxf(tm, fmaxf(p0[r], p1[r]));
    tm = fmaxf(tm, shx<32>(tm));
    const float mn = fmaxf(m, tm), alpha = __builtin_amdgcn_exp2f(m - mn);
    m = mn;
    float s = 0.f;
#pragma unroll
    for (int r = 0; r < 16; ++r) { p0[r] = __builtin_amdgcn_exp2f(p0[r] - mn); p1[r] = __builtin_amdgcn_exp2f(p1[r] - mn); s += p0[r] + p1[r]; }
    l = l * alpha + s;
#pragma unroll
    for (int r = 0; r < 16; ++r) { o0[r] *= alpha; o1[r] *= alpha; }
}

constexpr int MOBA_KM_OFF = 2 * STG, MOBA_TL_OFF = MOBA_KM_OFF + 32 * 64 * 4, MOBA_UW_OFF = MOBA_TL_OFF + 132 * 4;
__device__ __forceinline__ void moba_unit(const bf16* __restrict__ P, const float* __restrict__ kmean, bf16* __restrict__ MIX, int b, int h, int qb, int tid, LAS unsigned char* lds) {
    const int lane = tid & 63, wid = __builtin_amdgcn_readfirstlane(tid >> 6), r32 = lane & 31, hi = lane >> 5;
    LAS float* km = (LAS float*)(lds + MOBA_KM_OFF); LAS int* tl = (LAS int*)(lds + MOBA_TL_OFF); LAS unsigned* uw = (LAS unsigned*)(lds + MOBA_UW_OFF);
    const int own = qb, tq = qb * 256 + wid * 32 + r32;
    const size_t rowq = (size_t)b * SEQ + tq;
    const bf16* Pb = P + (size_t)b * SEQ * DINP;
    u32x4v kr, vr;
    { TileSrc s{Pb + (size_t)(own * 256) * DINP + C_BK + h * 64, Pb + (size_t)(own * 256) * DINP + C_BV + h * 64, DINP}; tile_load(kr, vr, s, tid); }
    bf16x8 qf[4];
#pragma unroll
    for (int ks = 0; ks < 4; ++ks) qf[ks] = *(const bf16x8*)(P + rowq * DINP + C_BQ + h * 64 + ks * 16 + hi * 8);
    for (int e = tid; e < own * 64; e += 512) km[e] = kmean[(((size_t)b * 4 + h) * 32) * 64 + e];
    __syncthreads();
    unsigned mask = 0u;
    {
        float qv[32];
#pragma unroll
        for (int ks = 0; ks < 4; ++ks)
#pragma unroll
            for (int j = 0; j < 8; ++j) qv[ks * 8 + j] = bf2f((bf16)qf[ks][j]);
        float b0 = -3e38f, b1 = -3e38f, b2 = -3e38f; int i0 = -1, i1 = -1, i2 = -1;
        for (int n = 0; n < own; ++n) {
            LAS const float* kp = km + n * 64 + hi * 8; float a = 0.f;
#pragma unroll
            for (int ks = 0; ks < 4; ++ks)
#pragma unroll
                for (int j = 0; j < 8; ++j) a = fmaf(qv[ks * 8 + j], kp[ks * 16 + j], a);
            a += shx<32>(a);
            if (a > b0) { b2 = b1; i2 = i1; b1 = b0; i1 = i0; b0 = a; i0 = n; }
            else if (a > b1) { b2 = b1; i2 = i1; b1 = a; i1 = n; }
            else if (a > b2) { b2 = a; i2 = n; }
        }
        if (i0 >= 0) mask |= 1u << i0; if (i1 >= 0) mask |= 1u << i1; if (i2 >= 0) mask |= 1u << i2;
    }
    { unsigned um = mask;
      um |= shxu<1>(um); um |= shxu<2>(um); um |= shxu<4>(um); um |= shxu<8>(um); um |= shxu<16>(um); um |= shxu<32>(um);
      if (lane == 0) uw[wid] = um; }
    tile_store(lds, kr, vr, tid);
    __syncthreads();
    if (tid == 0) { unsigned um = 0u; for (int w = 0; w < 8; ++w) um |= uw[w];
        int cnt = 0; for (int s = 0; s < 4; ++s) tl[cnt++] = own * 4 + s;
        for (int n = 0; n < own; ++n) if ((um >> n) & 1u) for (int s = 0; s < 4; ++s) tl[cnt++] = n * 4 + s;
        tl[131] = cnt; }
    __syncthreads();
    const int nt = tl[131];
    f32x16 o0, o1;
#pragma unroll
    for (int r = 0; r < 16; ++r) { o0[r] = 0.f; o1[r] = 0.f; }
    float m = NEGBIG, l = 0.f;
    for (int i = 0; i < nt; ++i) {
        const int tile = tl[i];
        if (i + 1 < nt) { const int nx = tl[i + 1]; TileSrc s{Pb + (size_t)(nx * 64) * DINP + C_BK + h * 64, Pb + (size_t)(nx * 64) * DINP + C_BV + h * 64, DINP}; tile_load(kr, vr, s, tid); }
        LAS const unsigned char* buf = lds + (i & 1) * STG;
        f32x16 p0, p1;
        qk_tile(p0, p1, buf, qf, r32, hi);
        const int blk = tile >> 2, kbase = tile * 64;
        if (blk == own) {
#pragma unroll
            for (int r = 0; r < 16; ++r) { const int k0 = kbase + crow(r, hi); p0[r] = (k0 <= tq) ? p0[r] * SCL2 : NEGBIG; p1[r] = (k0 + 32 <= tq) ? p1[r] * SCL2 : NEGBIG; }
        } else {
            const bool sel = (mask >> blk) & 1u;
#pragma unroll
            for (int r = 0; r < 16; ++r) { p0[r] = sel ? p0[r] * SCL2 : NEGBIG; p1[r] = sel ? p1[r] * SCL2 : NEGBIG; }
        }
        softmax_tile(p0, p1, o0, o1, m, l);
        pv_tile(o0, o1, buf + KBUF, p0, p1, lane);
        if (i + 1 < nt) tile_store(lds + ((i + 1) & 1) * STG, kr, vr, tid);
        __syncthreads();
    }
    l += shx<32>(l);
    const float inv = rcpf_(l);
    bf16* op = MIX + rowq * DM + 512 + h * 64 + 4 * hi;
#pragma unroll
    for (int g = 0; g < 4; ++g) {
        uint2 w0, w1;
        w0.x = cvtpk(o0[4 * g] * inv, o0[4 * g + 1] * inv); w0.y = cvtpk(o0[4 * g + 2] * inv, o0[4 * g + 3] * inv);
        w1.x = cvtpk(o1[4 * g] * inv, o1[4 * g + 1] * inv); w1.y = cvtpk(o1[4 * g + 2] * inv, o1[4 * g + 3] * inv);
        *(uint2*)(op + 8 * g) = w0; *(uint2*)(op + 32 + 8 * g) = w1;
    }
}

constexpr int NSA_S4_OFF = 2 * STG, NSA_L4_OFF = NSA_S4_OFF + 8 * 8 * 128 * 4, NSA_SM_OFF = NSA_L4_OFF + 8 * 8 * 128 * 4;
struct NsaCtx { const bf16* Pb; const bf16* Kcb; const bf16* Vcb; int b, jq, tid, lane, wid, r32, hi, tq; unsigned mk0, mk1, mk2, mk3; };

template <int MODE>
__device__ __forceinline__ void nsa_tiles(const NsaCtx& c, LAS unsigned char* lds, const bf16x8 (&qf)[4], int nt, f32x16& o0, f32x16& o1, float& m, float& l, float pre) {
    const int tid = c.tid, lane = c.lane, r32 = c.r32, hi = c.hi, tq = c.tq, jq = c.jq;
    const int nw = (jq < 8 ? jq : 8) + 1;
    auto tile_of = [&](int i) -> int { return MODE < 2 ? i : (i == 0 ? jq : (MODE == 2 ? i - 1 : jq - nw + i)); };
    auto src_of = [&](int t) -> TileSrc {
        if (MODE < 2) return TileSrc{c.Kcb + (size_t)t * 64 * 64, c.Vcb + (size_t)t * 64 * 64, 64};
        if (MODE == 2) return TileSrc{c.Pb + (size_t)t * 64 * DINP + C_NKS, c.Pb + (size_t)t * 64 * DINP + C_NVS, DINP};
        return TileSrc{c.Pb + (size_t)t * 64 * DINP + C_NKW, c.Pb + (size_t)t * 64 * DINP + C_NVW, DINP};
    };
    u32x4v kr, vr;
    { const TileSrc s = src_of(tile_of(0)); tile_load(kr, vr, s, tid); }
    tile_store(lds, kr, vr, tid);
    __syncthreads();
    const int ncv = (tq >= 31) ? ((tq - 31) >> 4) + 1 : 0;
    for (int i = 0; i < nt; ++i) {
        const int tile = tile_of(i);
        if (i + 1 < nt) { const TileSrc s = src_of(tile_of(i + 1)); tile_load(kr, vr, s, tid); }
        LAS const unsigned char* buf = lds + (i & 1) * STG;
        const int kbase = tile * 64;
        bool rowsel = true;
        if (MODE == 2 && tile != jq) { const unsigned w = (tile >> 5) == 0 ? c.mk0 : (tile >> 5) == 1 ? c.mk1 : (tile >> 5) == 2 ? c.mk2 : c.mk3; rowsel = (w >> (tile & 31)) & 1u; }
        if (MODE != 2 || __any(rowsel)) {
            f32x16 p0, p1;
            qk_tile(p0, p1, buf, qf, r32, hi);
            if (MODE < 2) {
#pragma unroll
                for (int r = 0; r < 16; ++r) { const int k0 = kbase + crow(r, hi); p0[r] = (k0 < ncv) ? p0[r] * SCL2 : NEGBIG; p1[r] = (k0 + 32 < ncv) ? p1[r] * SCL2 : NEGBIG; }
            } else if (MODE == 2) {
                if (tile == jq) {
#pragma unroll
                    for (int r = 0; r < 16; ++r) { const int k0 = kbase + crow(r, hi); p0[r] = (k0 <= tq) ? p0[r] * SCL2 : NEGBIG; p1[r] = (k0 + 32 <= tq) ? p1[r] * SCL2 : NEGBIG; }
                } else {
#pragma unroll
                    for (int r = 0; r < 16; ++r) { p0[r] = rowsel ? p0[r] * SCL2 : NEGBIG; p1[r] = rowsel ? p1[r] * SCL2 : NEGBIG; }
                }
            } else {
#pragma unroll
                for (int r = 0; r < 16; ++r) { const int k0 = kbase + crow(r, hi);
                    p0[r] = (k0 <= tq && k0 + 511 >= tq) ? p0[r] * SCL2 : NEGBIG; p1[r] = (k0 + 32 <= tq && k0 + 32 + 511 >= tq) ? p1[r] * SCL2 : NEGBIG; }
            }
            if (MODE == 0) {
                float tm = fmaxf(p0[0], p1[0]);
#pragma unroll
                for (int r = 1; r < 16; ++r) tm = fmaxf(tm, fmaxf(p0[r], p1[r]));
                tm = fmaxf(tm, shx<32>(tm));
                const float mn = fmaxf(m, tm); float s = 0.f;
#pragma unroll
                for (int r = 0; r < 16; ++r) { s += (p0[r] > -1e29f ? __builtin_amdgcn_exp2f(p0[r] - mn) : 0.f) + (p1[r] > -1e29f ? __builtin_amdgcn_exp2f(p1[r] - mn) : 0.f); }
                l = l * __builtin_amdgcn_exp2f(m - mn) + s; m = mn;
            } else if (MODE == 1) {
#pragma unroll
                for (int r = 0; r < 16; ++r) { p0[r] = (p0[r] > -1e29f) ? __builtin_amdgcn_exp2f(p0[r] - m) * pre : 0.f; p1[r] = (p1[r] > -1e29f) ? __builtin_amdgcn_exp2f(p1[r] - m) * pre : 0.f; }
                pv_tile(o0, o1, buf + KBUF, p0, p1, lane);
                LAS float* S4 = (LAS float*)(lds + NSA_S4_OFF) + (c.wid * 8 + (r32 & 7)) * 128; LAS float* L4 = (LAS float*)(lds + NSA_L4_OFF) + (c.wid * 8 + (r32 & 7)) * 128;
#pragma unroll
                for (int mbk = 0; mbk < 2; ++mbk)
#pragma unroll
                    for (int g = 0; g < 4; ++g) {
                        float s4 = mbk ? (p1[4 * g] + p1[4 * g + 1]) + (p1[4 * g + 2] + p1[4 * g + 3]) : (p0[4 * g] + p0[4 * g + 1]) + (p0[4 * g + 2] + p0[4 * g + 3]);
                        float la = mbk ? p1[4 * g + 3] : p0[4 * g + 3];
                        s4 += shx<8>(s4); s4 += shx<16>(s4); la += shx<8>(la); la += shx<16>(la);
                        const int gi = tile * 16 + 8 * mbk + 2 * g + hi;
                        if (r32 < 8) { S4[gi] = s4; L4[gi] = la; }
                    }
            } else {
                softmax_tile(p0, p1, o0, o1, m, l);
                pv_tile(o0, o1, buf + KBUF, p0, p1, lane);
            }
        }
        if (i + 1 < nt) tile_store(lds + ((i + 1) & 1) * STG, kr, vr, tid);
        __syncthreads();
    }
}

__device__ __forceinline__ void nsa_unit(const bf16* __restrict__ P, const float* __restrict__ G, const float* __restrict__ tab, const bf16* __restrict__ KVcb, bf16* __restrict__ MIX,
                                         int b, int jq, int tid, LAS unsigned char* lds) {
    NsaCtx c; c.b = b; c.jq = jq; c.tid = tid; c.lane = tid & 63; c.wid = __builtin_amdgcn_readfirstlane(tid >> 6); c.r32 = c.lane & 31; c.hi = c.lane >> 5;
    const int qi = c.r32 & 7, hh = c.r32 >> 3, hi = c.hi, lane = c.lane;
    c.tq = jq * 64 + c.wid * 8 + qi;
    c.Pb = P + (size_t)b * SEQ * DINP; c.Kcb = KVcb + (size_t)b * 512 * 64; c.Vcb = KVcb + ((size_t)NB + b) * 512 * 64;
    c.mk0 = c.mk1 = c.mk2 = c.mk3 = 0u;
    const size_t rowq = (size_t)b * SEQ + c.tq;
    bf16x8 qn[4], qr[4];
#pragma unroll
    for (int ks = 0; ks < 4; ++ks) { qn[ks] = *(const bf16x8*)(P + rowq * DINP + C_NQ + hh * 64 + ks * 16 + hi * 8); qr[ks] = qn[ks]; }
    {
        unsigned w[4];
#pragma unroll
        for (int e = 0; e < 4; ++e) {
            float y[2];
#pragma unroll
            for (int k = 0; k < 2; ++k) { const int j = 2 * e + k; const float x = bf2f((bf16)qn[0][j]); const float other = shx<32>(x);
                const float cs = tab[c.tq * 16 + j], sn = tab[c.tq * 16 + 8 + j]; y[k] = hi ? (x * cs + other * sn) : (x * cs - other * sn); }
            w[e] = cvtpk(y[0], y[1]);
        }
        const u32x4v wv = {w[0], w[1], w[2], w[3]}; qr[0] = __builtin_bit_cast(bf16x8, wv);
    }
    const float g0 = sigmoidf_(G[rowq * 32 + 8 + hh]), g1 = sigmoidf_(G[rowq * 32 + 12 + hh]), g2 = sigmoidf_(G[rowq * 32 + 16 + hh]);
    f32x16 a0, a1;
    {
        const int ncvmax = min(4 * jq + 3, NCMP), nct = (ncvmax + 63) >> 6;
        f32x16 o0, o1;
#pragma unroll
        for (int r = 0; r < 16; ++r) { o0[r] = 0.f; o1[r] = 0.f; }
        float m = NEGBIG, l = 0.f;
        nsa_tiles<0>(c, lds, qn, nct, o0, o1, m, l, 0.f);
        l += shx<32>(l);
        const float pre = (l > 0.f) ? rcpf_(l) : 0.f;
        nsa_tiles<1>(c, lds, qn, nct, o0, o1, m, l, pre);
#pragma unroll
        for (int r = 0; r < 16; ++r) { a0[r] = g0 * o0[r]; a1[r] = g0 * o1[r]; }
    }
    {
        LAS unsigned* sm = (LAS unsigned*)(lds + NSA_SM_OFF);
        for (int q = 0; q < 8; ++q) {
            LAS const float* S4 = (LAS const float*)(lds + NSA_S4_OFF) + (c.wid * 8 + q) * 128; LAS const float* L4 = (LAS const float*)(lds + NSA_L4_OFF) + (c.wid * 8 + q) * 128;
            float v0, v1;
            { const int n = lane; const bool causal = n <= jq, forced = causal && (n == 0 || n >= jq - 1);
              float im = 0.f; if (causal) { im = S4[n]; if (n > 0) im += L4[n - 1]; }
              v0 = forced ? 1e9f : (causal ? im : -1e30f); }
            { const int n = lane + 64; const bool causal = n <= jq, forced = causal && (n >= jq - 1);
              float im = 0.f; if (causal) { im = S4[n] + L4[n - 1]; }
              v1 = forced ? 1e9f : (causal ? im : -1e30f); }
            unsigned long long sel0 = 0ull, sel1 = 0ull;
            for (int k = 0; k < 16; ++k) { const float mx = wave_max(fmaxf(v0, v1));
                const unsigned long long b0 = __ballot(v0 == mx);
                if (b0) { const int idx = __ffsll((long long)b0) - 1; sel0 |= 1ull << idx; if (lane == idx) v0 = -3.0e38f; }
                else { const unsigned long long b1 = __ballot(v1 == mx); const int idx = __ffsll((long long)b1) - 1; sel1 |= 1ull << idx; if (lane == idx) v1 = -3.0e38f; } }
            if (lane == 0) { sm[(c.wid * 8 + q) * 4 + 0] = (unsigned)sel0; sm[(c.wid * 8 + q) * 4 + 1] = (unsigned)(sel0 >> 32); sm[(c.wid * 8 + q) * 4 + 2] = (unsigned)sel1; sm[(c.wid * 8 + q) * 4 + 3] = (unsigned)(sel1 >> 32); }
        }
        __builtin_amdgcn_s_waitcnt(0xc07f); __builtin_amdgcn_wave_barrier();
        c.mk0 = sm[(c.wid * 8 + qi) * 4 + 0]; c.mk1 = sm[(c.wid * 8 + qi) * 4 + 1]; c.mk2 = sm[(c.wid * 8 + qi) * 4 + 2]; c.mk3 = sm[(c.wid * 8 + qi) * 4 + 3];
    }
    {
        f32x16 o0, o1;
#pragma unroll
        for (int r = 0; r < 16; ++r) { o0[r] = 0.f; o1[r] = 0.f; }
        float m = NEGBIG, l = 0.f;
        nsa_tiles<2>(c, lds, qr, jq + 1, o0, o1, m, l, 0.f);
        l += shx<32>(l);
        const float sc = g1 * rcpf_(l);
#pragma unroll
        for (int r = 0; r < 16; ++r) { a0[r] = fmaf(sc, o0[r], a0[r]); a1[r] = fmaf(sc, o1[r], a1[r]); }
    }
    {
        f32x16 o0, o1;
#pragma unroll
        for (int r = 0; r < 16; ++r) { o0[r] = 0.f; o1[r] = 0.f; }
        float m = NEGBIG, l = 0.f;
        nsa_tiles<3>(c, lds, qr, (jq < 8 ? jq : 8) + 1, o0, o1, m, l, 0.f);
        l += shx<32>(l);
        const float sc = g2 * rcpf_(l);
#pragma unroll
        for (int r = 0; r < 16; ++r) { a0[r] = fmaf(sc, o0[r], a0[r]); a1[r] = fmaf(sc, o1[r], a1[r]); }
    }
    bf16* op = MIX + rowq * DM + 768 + hh * 64 + 4 * hi;
#pragma unroll
    for (int g = 0; g < 4; ++g) {
        uint2 w0, w1;
        w0.x = cvtpk(a0[4 * g], a0[4 * g + 1]); w0.y = cvtpk(a0[4 * g + 2], a0[4 * g + 3]);
        w1.x = cvtpk(a1[4 * g], a1[4 * g + 1]); w1.y = cvtpk(a1[4 * g + 2], a1[4 * g + 3]);
        *(uint2*)(op + 8 * g) = w0; *(uint2*)(op + 32 + 8 * g) = w1;
    }
}


constexpr int MQ_PITCH = 272, MV_PITCH = 320;
constexpr int ML_G_OFF = 0;
constexpr int ML_Q_OFF = 4096;
constexpr int ML_K_OFF = ML_Q_OFF + 64 * MQ_PITCH;
constexpr int ML_V_OFF = ML_K_OFF + 64 * MV_PITCH;
constexpr int ML_END = ML_V_OFF + 64 * MV_PITCH;
static_assert(ML_END <= 131072, "mlstm LDS");
constexpr float KSCALE = 0.08838834764831845f;

__device__ __forceinline__ void qk2_rows(const bf16* __restrict__ P, const float* __restrict__ cw, bf16* __restrict__ QK2, int bid, int G, int tid) {
    const int ch = tid & 127, c0 = ch * 8;
    float tp[4][8];
#pragma unroll
    for (int j = 0; j < 4; ++j) { const float4 a = *(const float4*)(cw + j * 1024 + c0), b4 = *(const float4*)(cw + j * 1024 + c0 + 4);
        tp[j][0] = a.x; tp[j][1] = a.y; tp[j][2] = a.z; tp[j][3] = a.w; tp[j][4] = b4.x; tp[j][5] = b4.y; tp[j][6] = b4.z; tp[j][7] = b4.w; }
    const float sc = (c0 >= 512) ? KSCALE : 1.f;
    for (int row0 = bid * 4 + (tid >> 7); row0 < T; row0 += G * 16) {
        u32x4v w[4][4];
#pragma unroll
        for (int q = 0; q < 4; ++q) { const int row = row0 + q * G * 4, t = row & (SEQ - 1);
#pragma unroll
            for (int j = 0; j < 4; ++j) { w[q][j] = u32x4v{0u, 0u, 0u, 0u}; if (row < T && t - 3 + j >= 0) w[q][j] = *(const u32x4v*)(P + (size_t)(row - 3 + j) * DINP + c0); } }
#pragma unroll
        for (int q = 0; q < 4; ++q) { const int row = row0 + q * G * 4;
            float y[8];
#pragma unroll
            for (int e = 0; e < 8; ++e) y[e] = 0.f;
#pragma unroll
            for (int j = 0; j < 4; ++j)
#pragma unroll
                for (int e = 0; e < 4; ++e) { y[2 * e] = fmaf(tp[j][2 * e], __builtin_bit_cast(float, w[q][j][e] << 16), y[2 * e]); y[2 * e + 1] = fmaf(tp[j][2 * e + 1], __builtin_bit_cast(float, w[q][j][e] & 0xffff0000u), y[2 * e + 1]); }
#pragma unroll
            for (int e = 0; e < 8; ++e) y[e] = y[e] * rcpf_(1.f + __expf(-y[e])) * sc;
            u32x4v o; o[0] = cvtpk(y[0], y[1]); o[1] = cvtpk(y[2], y[3]); o[2] = cvtpk(y[4], y[5]); o[3] = cvtpk(y[6], y[7]);
            if (row < T) *(u32x4v*)(QK2 + (size_t)row * 1024 + c0) = o; }
    }
}

struct MlRaw { u32x4v q[2], k[2], v[2]; float gf, gi; };
template <bool WITH_Q> __device__ __forceinline__ void ml_load(MlRaw& r, const bf16* __restrict__ P, const bf16* __restrict__ QK2, const float* __restrict__ G, const float* __restrict__ bif, int u, int tid) {
    const int c = u & 127, h = (u >> 7) & 3, b = u >> 9, row0 = b * SEQ + c * 64, s = tid >> 3;
#pragma unroll
    for (int pass = 0; pass < 2; ++pass) { const int ch = (tid & 7) + 8 * pass;
        if (WITH_Q) r.q[pass] = *(const u32x4v*)(QK2 + (size_t)(row0 + s) * 1024 + h * 128 + ch * 8);
        r.k[pass] = *(const u32x4v*)(QK2 + (size_t)(row0 + s) * 1024 + 512 + h * 128 + ch * 8);
        r.v[pass] = *(const u32x4v*)(P + (size_t)(row0 + s) * DINP + C_MV + h * 128 + ch * 8); }
    if (tid < 64) { r.gf = G[(size_t)(row0 + tid) * 32 + 4 + h] + bif[4 + h]; r.gi = G[(size_t)(row0 + tid) * 32 + h] + bif[h]; }
}
__device__ __forceinline__ void mlstm_gates(const MlRaw& r, int tid, LAS float* gs) {
    if (tid < 64) { gs[tid] = log_sigmoidf_(r.gf); gs[128 + tid] = r.gi; }
    __syncthreads();
    if (tid < 64) { float a = 0.f; for (int s = 0; s <= tid; ++s) a += gs[s]; gs[64 + tid] = a; }
    __syncthreads();
}

__device__ __forceinline__ void mlstm_m1_phase(const bf16* __restrict__ P, const bf16* __restrict__ QK2, const float* __restrict__ G, const float* __restrict__ bif,
                                               bf16* __restrict__ CT, float* __restrict__ nst, float* __restrict__ dec, int bid, int Gd, int tid, LAS unsigned char* lds) {
    const int lane = tid & 63, wid = __builtin_amdgcn_readfirstlane(tid >> 6), hi = lane >> 5;
    LAS float* gs = (LAS float*)(lds + ML_G_OFF);
    MlRaw raw;
    if (bid < 2048) ml_load<false>(raw, P, QK2, G, bif, bid, tid);
    for (int u = bid; u < 2048; u += Gd) {
        mlstm_gates(raw, tid, gs);
        if (tid == 0) dec[u] = __expf(gs[64 + 63]);
        {
            const int s = tid >> 3; const float ws = __expf(gs[64 + 63] - gs[64 + s] + gs[128 + s]);
#pragma unroll
            for (int pass = 0; pass < 2; ++pass) { const int ch = (tid & 7) + 8 * pass; u32x4v w;
#pragma unroll
                for (int e = 0; e < 4; ++e) w[e] = cvtpk(__builtin_bit_cast(float, raw.k[pass][e] << 16) * ws, __builtin_bit_cast(float, raw.k[pass][e] & 0xffff0000u) * ws);
                *(LAS u32x4v*)(lds + ML_K_OFF + s * MV_PITCH + ch * 16) = w;
                *(LAS u32x4v*)(lds + ML_V_OFF + s * MV_PITCH + ch * 16) = raw.v[pass]; }
        }
        if (u + Gd < 2048) ml_load<false>(raw, P, QK2, G, bif, u + Gd, tid);
        __syncthreads();
        const int g = lane >> 4, i = lane & 15;
        const int mb = wid >> 1, nb0 = 2 * (wid & 1);
        f32x16 acc0, acc1;
#pragma unroll
        for (int r = 0; r < 16; ++r) { acc0[r] = 0.f; acc1[r] = 0.f; }
        LAS const unsigned char* trb = lds + (4 * hi + (i >> 2)) * MV_PITCH + (16 * (g & 1) + 4 * (i & 3)) * 2;
#pragma unroll
        for (int ks = 0; ks < 4; ++ks) {
            const s16x4 alo = lds_tr(trb + ML_K_OFF + ks * 16 * MV_PITCH + mb * 64), ahi = lds_tr(trb + ML_K_OFF + ks * 16 * MV_PITCH + 8 * MV_PITCH + mb * 64);
            const bf16x8 af = {alo[0], alo[1], alo[2], alo[3], ahi[0], ahi[1], ahi[2], ahi[3]};
            const s16x4 b0lo = lds_tr(trb + ML_V_OFF + ks * 16 * MV_PITCH + nb0 * 64), b0hi = lds_tr(trb + ML_V_OFF + ks * 16 * MV_PITCH + 8 * MV_PITCH + nb0 * 64);
            const s16x4 b1lo = lds_tr(trb + ML_V_OFF + ks * 16 * MV_PITCH + (nb0 + 1) * 64), b1hi = lds_tr(trb + ML_V_OFF + ks * 16 * MV_PITCH + 8 * MV_PITCH + (nb0 + 1) * 64);
            const bf16x8 bf0 = {b0lo[0], b0lo[1], b0lo[2], b0lo[3], b0hi[0], b0hi[1], b0hi[2], b0hi[3]}, bf1 = {b1lo[0], b1lo[1], b1lo[2], b1lo[3], b1hi[0], b1hi[1], b1hi[2], b1hi[3]};
            acc0 = __builtin_amdgcn_mfma_f32_32x32x16_bf16(af, bf0, acc0, 0, 0, 0);
            acc1 = __builtin_amdgcn_mfma_f32_32x32x16_bf16(af, bf1, acc1, 0, 0, 0);
        }
        bf16* ct = CT + (size_t)u * 16384;
#pragma unroll
        for (int gq = 0; gq < 4; ++gq) { const int d0 = 32 * mb + 8 * gq + 4 * hi;
            uint2 w0, w1; w0.x = cvtpk(acc0[4 * gq], acc0[4 * gq + 1]); w0.y = cvtpk(acc0[4 * gq + 2], acc0[4 * gq + 3]); w1.x = cvtpk(acc1[4 * gq], acc1[4 * gq + 1]); w1.y = cvtpk(acc1[4 * gq + 2], acc1[4 * gq + 3]);
            *(uint2*)(ct + (size_t)(32 * nb0 + (lane & 31)) * 128 + d0) = w0; *(uint2*)(ct + (size_t)(32 * (nb0 + 1) + (lane & 31)) * 128 + d0) = w1; }
        if (tid < 128) { float a = 0.f; for (int s = 0; s < 64; ++s) a += bf2f(*(LAS const bf16*)(lds + ML_K_OFF + s * MV_PITCH + tid * 2)); nst[(size_t)u * 128 + tid] = a; }
        __syncthreads();
    }
}
__device__ __forceinline__ void mlstm_scan(bf16* __restrict__ CT, float* __restrict__ nst, const float* __restrict__ dec, int item, int tid) {
    const int bh = item / 9, part = item % 9;
    if (part < 8) {
        bf16* base = CT + (size_t)bh * 128 * 16384 + (part * 512 + tid) * 4;
        float C[4] = {0.f, 0.f, 0.f, 0.f};
        for (int c0 = 0; c0 < 128; c0 += 16) {
            uint2 w[16];
#pragma unroll
            for (int k = 0; k < 16; ++k) w[k] = *(const uint2*)(base + (size_t)(c0 + k) * 16384);
#pragma unroll
            for (int k = 0; k < 16; ++k) { const float a = dec[bh * 128 + c0 + k];
                uint2 o; o.x = cvtpk(C[0], C[1]); o.y = cvtpk(C[2], C[3]); *(uint2*)(base + (size_t)(c0 + k) * 16384) = o;
                C[0] = fmaf(a, C[0], __builtin_bit_cast(float, w[k].x << 16)); C[1] = fmaf(a, C[1], __builtin_bit_cast(float, w[k].x & 0xffff0000u));
                C[2] = fmaf(a, C[2], __builtin_bit_cast(float, w[k].y << 16)); C[3] = fmaf(a, C[3], __builtin_bit_cast(float, w[k].y & 0xffff0000u)); }
        }
    } else if (tid < 128) {
        float* base = nst + (size_t)bh * 128 * 128 + tid; float C = 0.f;
        for (int c = 0; c < 128; ++c) { const float dC = base[(size_t)c * 128]; base[(size_t)c * 128] = C; C = dec[bh * 128 + c] * C + dC; }
    }
}

__device__ __forceinline__ void mlstm_m3_phase(const bf16* __restrict__ P, const bf16* __restrict__ QK2, const float* __restrict__ G, const float* __restrict__ bif,
                                               const bf16* __restrict__ CT, const float* __restrict__ nst, const float* __restrict__ mnorm, bf16* __restrict__ MIX, int bid, int Gd, int tid, LAS unsigned char* lds) {
    const int lane = tid & 63, wid = __builtin_amdgcn_readfirstlane(tid >> 6), hi = lane >> 5, r32 = lane & 31;
    LAS float* gs = (LAS float*)(lds + ML_G_OFF);
    MlRaw raw;
    if (bid < 2048) ml_load<true>(raw, P, QK2, G, bif, bid, tid);
    for (int u = bid; u < 2048; u += Gd) {
    const int c = u & 127, h = (u >> 7) & 3, b = u >> 9, t0 = c * 64;
    if (tid >= 128 && tid < 256) gs[256 + tid - 128] = nst[(size_t)u * 128 + tid - 128];
    mlstm_gates(raw, tid, gs);
    {
        const int s = tid >> 3;
#pragma unroll
        for (int pass = 0; pass < 2; ++pass) { const int ch = (tid & 7) + 8 * pass;
            *(LAS u32x4v*)(lds + ML_Q_OFF + s * MQ_PITCH + ch * 16) = raw.q[pass];
            *(LAS u32x4v*)(lds + ML_K_OFF + s * MQ_PITCH + ch * 16) = raw.k[pass];
            *(LAS u32x4v*)(lds + ML_V_OFF + s * MV_PITCH + ch * 16) = raw.v[pass]; }
    }
    if (u + Gd < 2048) ml_load<true>(raw, P, QK2, G, bif, u + Gd, tid);
    __syncthreads();
    const int tb = wid & 1, eb = wid >> 1, t = 32 * tb + r32;
    bf16x8 qf[8];
#pragma unroll
    for (int ks = 0; ks < 8; ++ks) qf[ks] = *(LAS const bf16x8*)(lds + ML_Q_OFF + t * MQ_PITCH + ks * 32 + hi * 16);
    f32x16 ni;
#pragma unroll
    for (int r = 0; r < 16; ++r) ni[r] = 0.f;
    { const bf16* ctp = CT + (size_t)u * 16384 + (size_t)(32 * eb + r32) * 128 + hi * 8;
      bf16x8 cf[8];
#pragma unroll
      for (int ks = 0; ks < 8; ++ks) cf[ks] = *(const bf16x8*)(ctp + ks * 16);
#pragma unroll
      for (int ks = 0; ks < 8; ++ks) ni = __builtin_amdgcn_mfma_f32_32x32x16_bf16(cf[ks], qf[ks], ni, 0, 0, 0); }
    f32x16 p0, p1;
#pragma unroll
    for (int r = 0; r < 16; ++r) { p0[r] = 0.f; p1[r] = 0.f; }
    { LAS const unsigned char* ka = lds + ML_K_OFF + r32 * MQ_PITCH + hi * 16;
#pragma unroll
      for (int ks = 0; ks < 8; ++ks) { const bf16x8 a0 = *(LAS const bf16x8*)(ka + ks * 32); p0 = __builtin_amdgcn_mfma_f32_32x32x16_bf16(a0, qf[ks], p0, 0, 0, 0); }
      if (tb == 1) {
#pragma unroll
          for (int ks = 0; ks < 8; ++ks) { const bf16x8 a1 = *(LAS const bf16x8*)(ka + 32 * MQ_PITCH + ks * 32); p1 = __builtin_amdgcn_mfma_f32_32x32x16_bf16(a1, qf[ks], p1, 0, 0, 0); } } }
    const float bt = gs[64 + t], Ft = __expf(bt);
    float dsum = 0.f;
#pragma unroll
    for (int r = 0; r < 16; ++r) { const int s0 = crow(r, hi);
        { const float w = (s0 <= t) ? __expf(bt - gs[64 + s0] + gs[128 + s0]) : 0.f; p0[r] *= w; dsum += p0[r]; }
        { const int s1 = s0 + 32; const float w = (s1 <= t) ? __expf(bt - gs[64 + s1] + gs[128 + s1]) : 0.f; p1[r] *= w; dsum += p1[r]; } }
    float qn = 0.f;
#pragma unroll
    for (int ks = 0; ks < 8; ++ks)
#pragma unroll
        for (int j = 0; j < 8; ++j) qn = fmaf(bf2f((bf16)qf[ks][j]), gs[256 + ks * 16 + hi * 8 + j], qn);
    dsum += shx<32>(dsum); qn += shx<32>(qn);
    const float den = dsum + Ft * qn, inv = rcpf_(fmaxf(fabsf(den), 1.f));
    f32x16 na;
#pragma unroll
    for (int r = 0; r < 16; ++r) na[r] = 0.f;
    { const int g = lane >> 4, i = lane & 15;
      LAS const unsigned char* trb = lds + ML_V_OFF + (4 * hi + (i >> 2)) * MV_PITCH + (16 * (g & 1) + 4 * (i & 3)) * 2 + eb * 64;
#pragma unroll
      for (int ss = 0; ss < 4; ++ss) { if (ss >= 2 && tb == 0) break;
          unsigned w[4];
#pragma unroll
          for (int e = 0; e < 4; ++e) { const int r = 8 * (ss & 1) + 2 * e; w[e] = (ss < 2) ? cvtpk(p0[r], p0[r + 1]) : cvtpk(p1[r], p1[r + 1]); }
          const u32x4v wv = {w[0], w[1], w[2], w[3]}; const bf16x8 pf = __builtin_bit_cast(bf16x8, wv);
          const s16x4 lo = lds_tr(trb + ss * 16 * MV_PITCH), hi4 = lds_tr(trb + ss * 16 * MV_PITCH + 8 * MV_PITCH);
          const bf16x8 vt = {lo[0], lo[1], lo[2], lo[3], hi4[0], hi4[1], hi4[2], hi4[3]};
          na = __builtin_amdgcn_mfma_f32_32x32x16_bf16(vt, pf, na, 0, 0, 0); } }
    float ssq = 0.f;
#pragma unroll
    for (int r = 0; r < 16; ++r) { na[r] = (na[r] + Ft * ni[r]) * inv; ssq += na[r] * na[r]; }
    ssq += shx<32>(ssq);
    if (hi == 0) gs[384 + eb * 64 + t] = ssq;
    __syncthreads();
    const float rstd = rsqrtf((gs[384 + t] + gs[384 + 64 + t] + gs[384 + 128 + t] + gs[384 + 192 + t]) * (1.f / 128.f) + EPS);
    const size_t row = (size_t)b * SEQ + t0 + t;
#pragma unroll
    for (int gq = 0; gq < 4; ++gq) { const int cc = h * 128 + 32 * eb + 8 * gq + 4 * hi;
        const uint2 ow = *(const uint2*)(P + row * DINP + C_MO + cc); const float4 mn = *(const float4*)(mnorm + cc);
        const float o0 = sigmoidf_(__builtin_bit_cast(float, ow.x << 16)), o1 = sigmoidf_(__builtin_bit_cast(float, ow.x & 0xffff0000u)), o2 = sigmoidf_(__builtin_bit_cast(float, ow.y << 16)), o3 = sigmoidf_(__builtin_bit_cast(float, ow.y & 0xffff0000u));
        uint2 w; w.x = cvtpk(na[4 * gq] * rstd * mn.x * o0, na[4 * gq + 1] * rstd * mn.y * o1); w.y = cvtpk(na[4 * gq + 2] * rstd * mn.z * o2, na[4 * gq + 3] * rstd * mn.w * o3);
        *(uint2*)(MIX + row * DM + cc) = w; }
    __syncthreads();
    }
}


typedef float f32x4v __attribute__((ext_vector_type(4)));
__device__ __forceinline__ void compress_item(const bf16* __restrict__ P, const bf16* __restrict__ w1t  , const float* __restrict__ c1  , const float* __restrict__ w2  ,
                                              const float* __restrict__ kg0, bf16* __restrict__ KVcb, int item, int tid, LAS unsigned char* lds) {
    const int lane = tid & 63, wid = __builtin_amdgcn_readfirstlane(tid >> 6), hi = lane >> 5, r32 = lane & 31;
    const int kv = item >> 5, b = (item >> 3) & 3, i0 = (item & 7) * 64;
    const int rb = wid & 1, cb = wid >> 1;
    const int irow = min(i0 + 32 * rb + r32, NCMP - 1);
    const bf16* xa = P + ((size_t)b * SEQ + 16 * irow) * DINP + (kv ? C_NVC : C_NKC) + hi * 8;
    const bf16* wb = w1t + ((size_t)kv * 128 + 32 * cb + r32) * 2048 + hi * 8;
    f32x16 acc;
#pragma unroll
    for (int r = 0; r < 16; ++r) acc[r] = 0.f;
    for (int p0 = 0; p0 < 32; p0 += 4) {
        bf16x8 af[16], bfr[16];
#pragma unroll
        for (int q = 0; q < 16; ++q) { const int p = p0 + (q >> 2), dq = q & 3;
            af[q] = *(const bf16x8*)(xa + (size_t)p * DINP + dq * 16); bfr[q] = *(const bf16x8*)(wb + p * 64 + dq * 16); }
#pragma unroll
        for (int q = 0; q < 16; ++q) acc = __builtin_amdgcn_mfma_f32_32x32x16_bf16(af[q], bfr[q], acc, 0, 0, 0);
    }
    LAS float* hid = (LAS float*)lds;
    { LAS f32x4v* w2s = (LAS f32x4v*)(lds + 64 * 132 * 4); const f32x4v* w2g = (const f32x4v*)(w2 + (size_t)kv * 128 * 64);
#pragma unroll
      for (int q = 0; q < 4; ++q) w2s[tid + 512 * q] = w2g[tid + 512 * q]; }
    { const float cj = c1[kv * 128 + 32 * cb + r32];
#pragma unroll
      for (int r = 0; r < 16; ++r) { const float a = acc[r] + cj; hid[(32 * rb + crow(r, hi)) * 132 + 32 * cb + r32] = a * rcpf_(1.f + __expf(-a)); } }
    __syncthreads();
    {
        const int il = tid >> 3, d0 = (tid & 7) * 8;
        float o[8];
#pragma unroll
        for (int e = 0; e < 8; ++e) o[e] = 0.f;
        LAS const float* wp = (LAS const float*)(lds + 64 * 132 * 4) + d0;
#pragma unroll 8
        for (int j = 0; j < 128; ++j) { const float hv = hid[il * 132 + j]; const f32x4v wa = *(LAS const f32x4v*)(wp + j * 64), wb4 = *(LAS const f32x4v*)(wp + j * 64 + 4);
            o[0] = fmaf(hv, wa[0], o[0]); o[1] = fmaf(hv, wa[1], o[1]); o[2] = fmaf(hv, wa[2], o[2]); o[3] = fmaf(hv, wa[3], o[3]);
            o[4] = fmaf(hv, wb4[0], o[4]); o[5] = fmaf(hv, wb4[1], o[5]); o[6] = fmaf(hv, wb4[2], o[6]); o[7] = fmaf(hv, wb4[3], o[7]); }
        if (kv == 0) { float ss = 0.f;
#pragma unroll
            for (int e = 0; e < 8; ++e) ss += o[e] * o[e];
            ss += shx<1>(ss); ss += shx<2>(ss); ss += shx<4>(ss);
            const float rstd = rsqrtf(ss * (1.f / 64.f) + EPS);
#pragma unroll
            for (int e = 0; e < 8; ++e) o[e] *= rstd * kg0[d0 + e]; }
        const int i = i0 + il;
        if (i >= NCMP) {
#pragma unroll
            for (int e = 0; e < 8; ++e) o[e] = 0.f; }
        u32x4v w; w[0] = cvtpk(o[0], o[1]); w[1] = cvtpk(o[2], o[3]); w[2] = cvtpk(o[4], o[5]); w[3] = cvtpk(o[6], o[7]);
        *(u32x4v*)(KVcb + (((size_t)kv * NB + b) * 512 + i) * 64 + d0) = w;
    }
    __syncthreads();
}
__device__ __forceinline__ void cmp_c1_item(const float* __restrict__ pe, const float* __restrict__ w1, float* __restrict__ c1, int item, int tid, LAS unsigned char* lds) {
    const int lk = item >> 4, j0 = (item & 15) * 8, jj = tid & 7, kk = tid >> 3;
    const float* pp = pe + (size_t)lk * 2048; const float* ww = w1 + (size_t)lk * 2048 * 128 + j0 + jj;
    float a = 0.f;
#pragma unroll 8
    for (int k = kk; k < 2048; k += 64) a = fmaf(pp[k], ww[(size_t)k * 128], a);
    LAS float* red = (LAS float*)lds;
    red[tid] = a;
    __syncthreads();
    if (tid < 8) { float s = 0.f; for (int q = 0; q < 64; ++q) s += red[q * 8 + tid]; c1[lk * 128 + j0 + tid] = s; }
    __syncthreads();
}

#define XB_TMO      128
#define XB_XCNT(j)  (256  + 64 * (j))
#define XB_XSUB(j)  (1280 + 64 * (j))
#define XB_XGEN(j)  (2304 + 64 * (j))
#define XB_TOP      3328
#define XB_TOPGEN   3392
#define XCD_BAR_WORDS 3456
#define XB_SPIN_CAP (1u << 22)

__device__ __forceinline__ unsigned xb_ld(unsigned* p)              { return __hip_atomic_load(p, __ATOMIC_RELAXED, __HIP_MEMORY_SCOPE_AGENT); }
__device__ __forceinline__ unsigned xb_add(unsigned* p, unsigned v) { return __hip_atomic_fetch_add(p, v, __ATOMIC_RELAXED, __HIP_MEMORY_SCOPE_AGENT); }
__device__ __forceinline__ unsigned xb_xcc_id() { return (unsigned)__builtin_amdgcn_s_getreg((3 << 11) | 20) & 0xFu; }
#define XB_SPIN(cond, bar) do { unsigned _sp = 0; while (cond) { __builtin_amdgcn_s_sleep(1); \
    if ((++_sp & 255u) == 0u) { if (xb_ld(&(bar)[XB_TMO])) break; if (_sp > XB_SPIN_CAP) { atomicAdd(&(bar)[XB_TMO], 1u); break; } } } } while (0)

struct XcdBarrier {
    unsigned* bar; unsigned x;
    volatile LAS unsigned* st;
};

__device__ __forceinline__ XcdBarrier xcd_barrier_post(unsigned* bar, volatile LAS unsigned* st) {
    XcdBarrier b; b.bar = bar; b.x = xb_xcc_id(); b.st = st;
    if (threadIdx.x == 0) (void)xb_add(&bar[XB_XCNT(b.x)], 1u);
    return b;
}
__device__ __forceinline__ void xcd_barrier_complete(unsigned* bar, unsigned x, unsigned& nloc, unsigned& nx) {
    const unsigned G = gridDim.x * gridDim.y * gridDim.z;
    unsigned sum, cnt, mine, sp = 0u;
    for (;;) {
        sum = 0u; cnt = 0u; mine = 0u;
#pragma unroll
        for (unsigned j = 0; j < 16; ++j) { const unsigned c = xb_ld(&bar[XB_XCNT(j)]); sum += c; cnt += (c > 0u) ? 1u : 0u; mine = (j == x) ? c : mine; }
        if (sum == G) break;
        __builtin_amdgcn_s_sleep(1);
        if ((++sp & 255u) == 0u) { if (xb_ld(&bar[XB_TMO])) break; if (sp > XB_SPIN_CAP) { atomicAdd(&bar[XB_TMO], 1u); break; } }
    }
    nloc = mine > 0u ? mine : 1u; nx = cnt > 0u ? cnt : 1u;
}

__device__ __forceinline__ void xcd_barrier(const XcdBarrier& b) {
    asm volatile("s_waitcnt vmcnt(0)" ::: "memory");
    __syncthreads();
    if (threadIdx.x == 0) {
        unsigned* bar = b.bar;
        __builtin_amdgcn_s_waitcnt(0);
        unsigned nloc = b.st[0], nx = b.st[1];
        if (nloc == 0u) { xcd_barrier_complete(bar, b.x, nloc, nx); b.st[0] = nloc; b.st[1] = nx; }
        const unsigned old = xb_add(&bar[XB_XSUB(b.x)], 1u);
        const unsigned gen = old / nloc;
        if (old + 1u == (gen + 1u) * nloc) {
            __builtin_amdgcn_fence(__ATOMIC_RELEASE, "agent");
            asm volatile("s_waitcnt vmcnt(0)" ::: "memory");
            const unsigned og = xb_add(&bar[XB_TOP], 1u);
            const unsigned tg = og / nx;
            if (og + 1u == (tg + 1u) * nx) xb_add(&bar[XB_TOPGEN], 1u);
            else XB_SPIN(xb_ld(&bar[XB_TOPGEN]) == tg, bar);
            __builtin_amdgcn_fence(__ATOMIC_ACQUIRE, "agent");
            xb_add(&bar[XB_XGEN(b.x)], 1u);
            asm volatile("s_waitcnt vmcnt(0)" ::: "memory");
        } else {
            XB_SPIN(xb_ld(&bar[XB_XGEN(b.x)]) == gen, bar);
            __builtin_amdgcn_fence(__ATOMIC_ACQUIRE, "agent");
            asm volatile("s_waitcnt vmcnt(0)" ::: "memory");
        }
    }
    __syncthreads();
}


constexpr size_t MiB = 1u << 20;
constexpr size_t W_LAYER = (size_t)(DINP + DM + DFF) * DM + (size_t)DM * DFF;
constexpr size_t WS_W = 0;
constexpr size_t WS_HM = 52 * MiB;
constexpr size_t WS_G = 116 * MiB;
constexpr size_t WS_SMALL = 120 * MiB;
constexpr size_t WS_TAB = WS_SMALL, WS_KMEAN = WS_SMALL + 512 * 1024, WS_KVC = WS_SMALL + 1 * MiB, WS_NST = WS_SMALL + 2 * MiB, WS_DEC = WS_SMALL + 3 * MiB, WS_KVCB = WS_SMALL + 3 * MiB + 512 * 1024;
constexpr size_t WS_BAR = WS_SMALL + 3 * MiB + 64 * 1024;
constexpr size_t WS_W1T = 50 * MiB, WS_C1 = WS_SMALL + 3 * MiB + 16 * 1024;
constexpr size_t WS_P = 124 * MiB;
constexpr size_t WS_C = 348 * MiB;
constexpr size_t WS_U = WS_P;
constexpr size_t WS_END = 476 * MiB;
static_assert(W_LAYER * 2 * DEPTH <= 50 * MiB && WS_W1T + (size_t)DEPTH * 2 * 128 * 2048 * 2 <= 52 * MiB, "weights");
static_assert((size_t)T * DINP * 2 == 224 * MiB && (size_t)T * DFF * 2 == 256 * MiB, "sizes");

#ifndef DUP_M1
#define DUP_M1 1
#endif
#ifndef DUP_MOBA
#define DUP_MOBA 1
#endif
#ifndef DUP_NSA
#define DUP_NSA 1
#endif
#ifndef DUP_M3
#define DUP_M3 1
#endif
#ifndef DUP_CMP
#define DUP_CMP 1
#endif
struct Params { const float* in[16]; float* out; unsigned char* ws; };
constexpr int LDS_BYTES = 147456;

__global__ void __launch_bounds__(512, 2) hybrid_fwd(Params prm) {
    extern __shared__ __attribute__((aligned(16))) unsigned char lds[];
    cg::grid_group grid = cg::this_grid();
    constexpr int NPH = 1 + DEPTH * 10 - 1;
    volatile LAS unsigned* xst = (volatile LAS unsigned*)((LAS unsigned char*)lds + 131072 + 1024);
    if (threadIdx.x < 2) xst[threadIdx.x] = 0u;
    __syncthreads();
    const XcdBarrier xbar = xcd_barrier_post((unsigned*)(prm.ws + WS_BAR), xst);
    for (int ph = 0; ph < NPH; ++ph) {
        int tid = threadIdx.x; asm volatile("" : "+v"(tid));
        const int G = gridDim.x, bid = blockIdx.x, half = tid >> 8, t256 = tid & 255, lane = tid & 63, wid = __builtin_amdgcn_readfirstlane(tid >> 6);
        unsigned char* smh = lds + half * 65536;
        unsigned char* ws = prm.ws; float* out = prm.out; asm volatile("" : "+s"(ws), "+s"(out));
        size_t zz = 0; asm volatile("" : "+s"(zz));
#define IN(k) (prm.in[k] + zz)
        bf16* Wb = (bf16*)(ws + WS_W); bf16* HM = (bf16*)(ws + WS_HM); float* Gt = (float*)(ws + WS_G); float* tab = (float*)(ws + WS_TAB); float* kmean = (float*)(ws + WS_KMEAN);
        float* KVc = (float*)(ws + WS_KVC); float* nst = (float*)(ws + WS_NST); float* dec = (float*)(ws + WS_DEC); bf16* KVcb = (bf16*)(ws + WS_KVCB); bf16* W1t = (bf16*)(ws + WS_W1T); float* C1 = (float*)(ws + WS_C1); bf16* P = (bf16*)(ws + WS_P); bf16* CT = (bf16*)(ws + WS_C); bf16* QK2 = (bf16*)(ws + WS_C + 64 * MiB); bf16* U = (bf16*)(ws + WS_U);
        const int vb = bid * 2 + half, NVB = G * 2;
        const int gwv = bid * 8 + wid, NGW = G * 8;
        const int l = ph == 0 ? 0 : (ph - 1) / 10, j = ph == 0 ? -1 : (ph - 1) % 10;
        const float* x = IN(0);
        const float* xin = l == 0 ? x : out;
        const bf16* WinT = Wb + l * W_LAYER; const bf16* WoT = WinT + (size_t)DINP * DM; const bf16* W1T = WoT + (size_t)DM * DM; const bf16* W2T = W1T + (size_t)DFF * DM;
        if (ph == 0) {
            const float* w_in = IN(1); const float* w_out = IN(11); const float* w_ff1 = IN(14); const float* w_ff2 = IN(15);
            for (int ll = 0; ll < DEPTH; ++ll) {
                bf16* WinT_ = Wb + ll * W_LAYER; bf16* WoT_ = WinT_ + (size_t)DINP * DM; bf16* W1T_ = WoT_ + (size_t)DM * DM; bf16* W2T_ = W1T_ + (size_t)DFF * DM;
                for (int mt = 0; mt < 4; ++mt) {
                    const float* W; int K, N, NP, mode; bf16* WT;
                    if (mt == 0) { W = w_in + (size_t)ll * DM * DIN; K = DM; N = DIN; NP = DINP; WT = WinT_; mode = 1; }
                    else if (mt == 1) { W = w_out + (size_t)ll * DM * DM; K = DM; N = DM; NP = DM; WT = WoT_; mode = 0; }
                    else if (mt == 2) { W = w_ff1 + (size_t)ll * DM * DFF; K = DM; N = DFF; NP = DFF; WT = W1T_; mode = 0; }
                    else { W = w_ff2 + (size_t)ll * DFF * DM; K = DFF; N = DM; NP = DM; WT = W2T_; mode = 0; }
                    const int nit = (NP / 64) * (K / 64);
                    for (int it0 = 0; it0 < nit; it0 += NVB) { const int it = it0 + vb; ph_convert_w(W, K, N, NP, WT, mode, it, it < nit, t256, (float*)smh); }
                }
            }
            for (int lk = 0; lk < DEPTH * 2; ++lk) {
                const int nit = 2 * 32;
                for (int it0 = 0; it0 < nit; it0 += NVB) { const int it = it0 + vb; ph_convert_w(IN(9) + (size_t)lk * 2048 * 128, 2048, 128, 128, W1t + (size_t)lk * 128 * 2048, 0, it, it < nit, t256, (float*)smh); }
            }
            for (int it = bid; it < 64; it += G) cmp_c1_item(IN(8), IN(9), C1, it, tid, (LAS unsigned char*)lds);
            for (int i = bid * 512 + tid; i < SEQ * 8; i += G * 512) { const int pos = i >> 3, f = i & 7;
                float c_, s_; rope_cs(pos, f, c_, s_);
                tab[pos * 16 + f] = c_; tab[pos * 16 + 8 + f] = s_; }
            for (int row = gwv; row < T; row += NGW) ph_rmsnorm_row(x, IN(12), HM, row, lane);
        } else if (j == 0 || j == 5 || j == 7 || j == 8) {
            pg8::Gemm g; pg8::EpiAny E; int N;
            if (j == 0) { g = pg8::Gemm{HM, WinT, T, DINP, DM}; N = DINP; E = pg8::EpiAny{0, true, P, DINP, Gt, C_GATE, nullptr, nullptr}; }
            else if (j == 5) { g = pg8::Gemm{HM, WoT, T, DM, DM}; N = DM; E = pg8::EpiAny{2, false, nullptr, DM, nullptr, 0, xin, out}; }
            else if (j == 7) { g = pg8::Gemm{HM, W1T, T, DFF, DM}; N = DFF; E = pg8::EpiAny{1, true, U, DFF, nullptr, 0, nullptr, nullptr}; }
            else { g = pg8::Gemm{U, W2T, T, DM, DFF}; N = DM; E = pg8::EpiAny{2, false, nullptr, DM, nullptr, 0, out, out}; }
            pg8::StaticOrder S; S.init(T, N, G, bid);
            pg8::gemm_phase<pg8::EpiAny, pg8::StaticOrder, true, true>((PG8_LAS unsigned char*)lds, g, S, E, tid);
        } else if (j == 1) {
            for (int rep = 0; rep < DUP_CMP; ++rep) for (int it = bid; it < 64; it += G) compress_item(P, W1t + (size_t)l * 2 * 128 * 2048, C1 + l * 256, IN(10) + (size_t)l * 2 * 128 * 64, IN(7) + l * 192, KVcb, it, tid, (LAS unsigned char*)lds);
            for (int it0 = 0; it0 < 128 * 14; it0 += NVB) { const int it = it0 + vb; ph_prep(P, tab, IN(5) + l * 128, IN(6) + l * 64, IN(7) + l * 192, kmean, it, it < 128 * 14, t256, (float*)smh); }
            qk2_rows(P, IN(3) + (size_t)l * 4 * 1024, QK2, bid, G, tid);
        } else if (j == 2) {
            for (int rep = 0; rep < DUP_M1; ++rep) mlstm_m1_phase(P, QK2, Gt, IN(2) + l * 8, CT, nst, dec, bid, G, tid, (LAS unsigned char*)lds);
            for (int rep = 0; rep < DUP_MOBA; ++rep) for (int pu = bid; pu < 256; pu += G) { const int bh = pu >> 4, s = pu & 15;
                moba_unit(P, kmean, HM, bh >> 2, bh & 3, 31 - s, tid, (LAS unsigned char*)lds); moba_unit(P, kmean, HM, bh >> 2, bh & 3, s, tid, (LAS unsigned char*)lds); }
        } else if (j == 3) {
            for (int it = bid; it < 16 * 9; it += G) mlstm_scan(CT, nst, dec, it, tid);
            for (int rep = 0; rep < DUP_NSA; ++rep) for (int pu = bid; pu < 256; pu += G) { const int b_ = pu >> 6, s = pu & 63;
                nsa_unit(P, Gt, tab, KVcb, HM, b_, 127 - s, tid, (LAS unsigned char*)lds); nsa_unit(P, Gt, tab, KVcb, HM, b_, s, tid, (LAS unsigned char*)lds); }
        } else if (j == 4) {
            for (int rep = 0; rep < DUP_M3; ++rep) mlstm_m3_phase(P, QK2, Gt, IN(2) + l * 8, CT, nst, IN(4) + l * 512, HM, bid, G, tid, (LAS unsigned char*)lds);
        } else if (j == 6) {
            for (int row = gwv; row < T; row += NGW) ph_rmsnorm_row(out, IN(13) + l * DM, HM, row, lane);
        } else {
            for (int row = gwv; row < T; row += NGW) ph_rmsnorm_row(out, IN(12) + (l + 1) * DM, HM, row, lane);
        }
        if (ph + 1 < NPH) { if (ph == 0) grid.sync(); else xcd_barrier(xbar); }
    }
#undef IN
}

extern "C" void kernel_launch(void* const* d_in, const int* in_sizes, int n_in, void* d_out, int out_size, void* d_ws, size_t ws_size, hipStream_t stream) {
    static int grid = 0;
    if (grid == 0) {
        if (n_in != 16 || in_sizes[0] != T * DM || out_size != T * DM || ws_size < WS_END) { fprintf(stderr, "kernel_launch: unexpected shapes / workspace %zu < %zu\n", ws_size, (size_t)WS_END); grid = -1; return; }
        int dev = 0, cus = 0, per_cu = 0;
        if (hipGetDevice(&dev) != hipSuccess || hipDeviceGetAttribute(&cus, hipDeviceAttributeMultiprocessorCount, dev) != hipSuccess) { grid = -1; return; }
        if (hipFuncSetAttribute((const void*)hybrid_fwd, hipFuncAttributeMaxDynamicSharedMemorySize, LDS_BYTES) != hipSuccess) { fprintf(stderr, "kernel_launch: hipFuncSetAttribute failed\n"); grid = -1; return; }
        if (hipOccupancyMaxActiveBlocksPerMultiprocessor(&per_cu, (const void*)hybrid_fwd, 512, LDS_BYTES) != hipSuccess || per_cu < 1) { fprintf(stderr, "kernel_launch: occupancy query failed (%d)\n", per_cu); grid = -1; return; }
        grid = cus * per_cu;
        fprintf(stderr, "kernel_launch: grid %d (%d CUs x %d)\n", grid, cus, per_cu);
    }
    if (grid < 0) return;
    if (hipMemsetAsync((char*)d_ws + WS_BAR, 0, XCD_BAR_WORDS * 4, stream) != hipSuccess) { fprintf(stderr, "kernel_launch: memset failed\n"); return; }
    Params p{};
    for (int i = 0; i < 16; ++i) p.in[i] = (const float*)d_in[i];
    p.out = (float*)d_out; p.ws = (unsigned char*)d_ws;
    void* args[] = {&p};
    hipError_t e = hipLaunchCooperativeKernel((const void*)hybrid_fwd, dim3(grid), dim3(512), args, LDS_BYTES, stream);
    if (e != hipSuccess) fprintf(stderr, "kernel_launch: cooperative launch failed: %s (grid %d)\n", hipGetErrorString(e), grid);
}
```

```cpp
#include <hip/hip_runtime.h>
#include <hip/hip_cooperative_groups.h>
#include <cstdio>
#include <cstdint>
namespace cg = cooperative_groups;
namespace pg8 {
#define PG8_LAS __attribute__((address_space(3)))
typedef unsigned short bf16_t;
typedef short bf16x8 __attribute__((ext_vector_type(8)));
typedef float f32x4 __attribute__((ext_vector_type(4)));
typedef unsigned u32x4 __attribute__((ext_vector_type(4)));
constexpr int BM = 256, BK = 64, HALF = 128, HTB = HALF * BK * 2  , STAGE_BYTES = 8 * HTB, NXCD = 8, WGM = 8;

__host__ __device__ __forceinline__ int lds_byte(int r, int c) { const int st = (r >> 4) * 2 + (c >> 5), rr = r & 15, cc = c & 31, ob = rr * 64 + cc * 2; return st * 1024 + (ob ^ (((ob >> 9) & 1) << 5)); }
__host__ __device__ __forceinline__ void stage_rc(int b, int& R, int& C) { const int st = b / 1024, sb = b % 1024, swz = sb ^ (((sb >> 9) & 1) << 5); R = (st >> 1) * 16 + swz / 64; C = (st & 1) * 32 + (swz % 64) / 2; }
__host__ __device__ __forceinline__ int perm32(int rho) { const int n = rho >> 4, i = rho & 15; return 8 * (i >> 2) + 4 * n + (i & 3); }

struct Unit { int pm, pn; };
struct Gemm { const bf16_t* A; const bf16_t* Bt; int M, N, K; };

struct StaticOrder {
    int nM, nN, nwg, G, c;
    __host__ __device__ void init(int M, int N, int G_, int c_) { nM = M / BM; nN = N / BM; nwg = nM * nN; G = G_; c = c_; }
    __host__ __device__ bool next(int i, Unit& u) const {
        const long L = (long)i * G + c; if (L >= nwg) return false;
        int wgid = (int)L; { const int q = nwg / NXCD, r = nwg % NXCD, xcd = wgid % NXCD, off = wgid / NXCD; wgid = (xcd < r ? xcd * (q + 1) : r * (q + 1) + (xcd - r) * q) + off; }
        const int nig = WGM * nN, gid = wgid / nig, fm = gid * WGM, gsz = (nM - fm) < WGM ? (nM - fm) : WGM;
        u.pm = fm + ((wgid % nig) % gsz); u.pn = (wgid % nig) / gsz; return true;
    }
    __device__ __forceinline__ void a_ready(const Unit&) const {}
    __device__ __forceinline__ void done(const Unit&) const {}
};

__device__ __forceinline__ unsigned f2bf_u(float f) { unsigned u = __builtin_bit_cast(unsigned, f); return (u + 0x7fffu + ((u >> 16) & 1u)) >> 16; }
__device__ __forceinline__ unsigned pk2bf(float lo, float hi) { return f2bf_u(lo) | (f2bf_u(hi) << 16); }

__device__ __forceinline__ unsigned cvtpk_bf16(float lo, float hi) { typedef float f2_ __attribute__((ext_vector_type(2))); typedef __bf16 b2_ __attribute__((ext_vector_type(2)));
    f2_ v = {lo, hi}; b2_ b = __builtin_convertvector(v, b2_); return __builtin_bit_cast(unsigned, b); }
__device__ __forceinline__ float swz_xor16(float v) { return __uint_as_float((unsigned)__builtin_amdgcn_ds_swizzle((int)__float_as_uint(v), 0x1F | (16 << 10))); }
__device__ __forceinline__ float half_sum(float v) { auto rr = __builtin_amdgcn_permlane32_swap(__float_as_uint(v), __float_as_uint(v), false, false); return __uint_as_float(rr[0]) + __uint_as_float(rr[1]); }
__device__ __forceinline__ float row_rstd(const unsigned long long* ssq, int row) { return __builtin_amdgcn_rsqf((float)ssq[row] * (1.0f / (1048576.0f * 1024.0f)) + 1e-6f); }

struct EpiProj {
    static constexpr bool PERM = true, AFTER_DRAIN = false;
    bf16_t* O; int ldc; float* gates; int gate0; const unsigned long long* ssp;
    __device__ __forceinline__ void operator()(const f32x4 (&acc)[2][2][4][2], const Unit& u, int wr, int wc, int fr, int fq) const {
        const int row0 = u.pm * BM + wr * 64 + fr; const int col0 = u.pn * BM + wc * 32 + 8 * fq;
        float rsv[2][4];
#pragma unroll
        for (int ai = 0; ai < 2; ++ai)
#pragma unroll
            for (int m = 0; m < 4; ++m) rsv[ai][m] = row_rstd(ssp, row0 + ai * HALF + m * 16);
#pragma unroll
        for (int ai = 0; ai < 2; ++ai)
#pragma unroll
            for (int m = 0; m < 4; ++m) { const int row = row0 + ai * HALF + m * 16; bf16_t* rowp = O + (size_t)row * ldc + col0; const float rs = rsv[ai][m];
#pragma unroll
                for (int bj = 0; bj < 2; ++bj) { const f32x4 v0 = acc[ai][bj][m][0] * rs, v1 = acc[ai][bj][m][1] * rs;
                    u32x4 w; w.x = cvtpk_bf16(v0[0], v0[1]); w.y = cvtpk_bf16(v0[2], v0[3]); w.z = cvtpk_bf16(v1[0], v1[1]); w.w = cvtpk_bf16(v1[2], v1[3]);
                    *(u32x4*)(rowp + bj * HALF) = w;
                    const int c = col0 + bj * HALF - gate0;
                    if (c >= 0 && c < 32) { float* g = gates + (size_t)row * 32 + c; *(f32x4*)g = v0; *(f32x4*)(g + 4) = v1; } } }
    }
};
struct EpiRelu2 {
    static constexpr bool PERM = true, AFTER_DRAIN = false;
    bf16_t* O; int ldc; const unsigned long long* ssp;
    __device__ __forceinline__ void operator()(const f32x4 (&acc)[2][2][4][2], const Unit& u, int wr, int wc, int fr, int fq) const {
        const int row0 = u.pm * BM + wr * 64 + fr; const int col0 = u.pn * BM + wc * 32 + 8 * fq;
        float rsv[2][4];
#pragma unroll
        for (int ai = 0; ai < 2; ++ai)
#pragma unroll
            for (int m = 0; m < 4; ++m) rsv[ai][m] = row_rstd(ssp, row0 + ai * HALF + m * 16);
#pragma unroll
        for (int ai = 0; ai < 2; ++ai)
#pragma unroll
            for (int m = 0; m < 4; ++m) { const int row = row0 + ai * HALF + m * 16; bf16_t* rowp = O + (size_t)row * ldc + col0; const float rs = rsv[ai][m];
#pragma unroll
                for (int bj = 0; bj < 2; ++bj) { f32x4 v0 = acc[ai][bj][m][0] * rs, v1 = acc[ai][bj][m][1] * rs;
#pragma unroll
                    for (int e = 0; e < 4; ++e) { float a = v0[e] > 0.f ? v0[e] : 0.f; v0[e] = a * a; float b = v1[e] > 0.f ? v1[e] : 0.f; v1[e] = b * b; }
                    u32x4 w; w.x = cvtpk_bf16(v0[0], v0[1]); w.y = cvtpk_bf16(v0[2], v0[3]); w.z = cvtpk_bf16(v1[0], v1[1]); w.w = cvtpk_bf16(v1[2], v1[3]);
                    *(u32x4*)(rowp + bj * HALF) = w; } }
    }
};
struct EpiResid {
    static constexpr bool PERM = false, AFTER_DRAIN = false;
    const float* base; float* out; int ldc; bf16_t* xb; unsigned long long* ssp;
    __device__ __forceinline__ void operator()(const f32x4 (&acc)[2][2][4][2], const Unit& u, int wr, int wc, int fr, int fq) const {
        const int row0 = u.pm * BM + wr * 64 + fr; const int col0 = u.pn * BM + wc * 32 + 4 * fq;
#pragma unroll
        for (int ai = 0; ai < 2; ++ai)
#pragma unroll
            for (int m = 0; m < 4; ++m) { const int row = row0 + ai * HALF + m * 16; const size_t off = (size_t)row * ldc + col0; float ss = 0.f;
#pragma unroll
                for (int bj = 0; bj < 2; ++bj)
#pragma unroll
                    for (int n = 0; n < 2; ++n) { const size_t o = off + bj * HALF + n * 16; const f32x4 b = *(const f32x4*)(base + o); const f32x4 v = b + acc[ai][bj][m][n]; *(f32x4*)(out + o) = v;
                        if (xb) { ss += (v[0] * v[0] + v[1] * v[1]) + (v[2] * v[2] + v[3] * v[3]); typedef unsigned u32x2_ __attribute__((ext_vector_type(2)));
                            u32x2_ w; w.x = cvtpk_bf16(v[0], v[1]); w.y = cvtpk_bf16(v[2], v[3]); *(u32x2_*)(xb + o) = w; } }
                if (xb) { ss += swz_xor16(ss); ss = half_sum(ss); if (fq == 0) atomicAdd(ssp + row, (unsigned long long)(ss * 1048576.0f + 0.5f)); } }
    }
};

struct EpiAny {
    static constexpr bool AFTER_DRAIN = false;
    int kind; bool perm;
    bf16_t* O; int ldc; float* gates; int gate0; const float* base; float* out; bf16_t* xb; unsigned long long* ssp;
    __device__ __forceinline__ void operator()(const f32x4 (&acc)[2][2][4][2], const Unit& u, int wr, int wc, int fr, int fq) const {
        if (kind == 0) { EpiProj e{O, ldc, gates, gate0, ssp}; e(acc, u, wr, wc, fr, fq); }
        else if (kind == 1) { EpiRelu2 e{O, ldc, ssp}; e(acc, u, wr, wc, fr, fq); }
        else { EpiResid e{base, out, ldc, xb, ssp}; e(acc, u, wr, wc, fr, fq); }
    }
};
template <class Epi, class Sched, bool ALIGN_EPI = false, bool SP2 = false>
__device__ __forceinline__ void gemm_phase(PG8_LAS unsigned char* lds, const Gemm g, const Sched& S, const Epi& E, const int tid) {
    const int wid = __builtin_amdgcn_readfirstlane(tid >> 6), lane = tid & 63, wr = wid >> 2, wc = wid & 3, fr = lane & 15, fq = lane >> 4;
    const int K = g.K, nt = K / BK;
    unsigned voffA[2], voffB[2];
#pragma unroll
    for (int i = 0; i < 2; ++i) { int R, C; stage_rc(tid * 16 + i * 8192, R, C); const int Rb = E.perm ? ((R & ~31) + perm32(R & 31)) : R;
        voffA[i] = (unsigned)(R * K + C) * 2u; voffB[i] = (unsigned)(Rb * K + C) * 2u; }
    const size_t kstep = (size_t)(BK * 2);
    const size_t hstep = (size_t)HALF * K * 2;
    const size_t tstep = 2 * hstep;
    const unsigned ldsw = (unsigned)wid * 1024u;
    const int aoff = lds_byte(wr * 64 + fr, fq * 8), boff = lds_byte(wc * 32 + fr, fq * 8);
#define PG8_SA(b, h) (((b) * 2 + (h)) * HTB)
#define PG8_SB(b, h) ((4 + (b) * 2 + (h)) * HTB)
#define PG8_STAGE(bufoff, gbase, voff) do { _Pragma("unroll") for (int _i = 0; _i < 2; ++_i) \
        __builtin_amdgcn_global_load_lds((const unsigned*)((const char*)(gbase) + (voff)[_i]), (PG8_LAS unsigned*)(lds + (bufoff) + ldsw + _i * 8192), 16, 0, 0); } while (0)
#define PG8_LDA(dst, b, h) do { _Pragma("unroll") for (int m = 0; m < 4; ++m) _Pragma("unroll") for (int k = 0; k < 2; ++k) dst[m][k] = *(const PG8_LAS bf16x8*)(lds + PG8_SA(b, h) + aoff + m * 2048 + k * 1024); } while (0)
#define PG8_LDB(dst, b, h) do { _Pragma("unroll") for (int n = 0; n < 2; ++n) _Pragma("unroll") for (int k = 0; k < 2; ++k) dst[n][k] = *(const PG8_LAS bf16x8*)(lds + PG8_SB(b, h) + boff + n * 2048 + k * 1024); } while (0)
#define PG8_MMA(ai, bj, At, Bt) do { __builtin_amdgcn_s_setprio(1); _Pragma("unroll") for (int m = 0; m < 4; ++m) _Pragma("unroll") for (int n = 0; n < 2; ++n) _Pragma("unroll") for (int k = 0; k < 2; ++k) \
        acc[ai][bj][m][n] = __builtin_amdgcn_mfma_f32_16x16x32_bf16(Bt[n][k], At[m][k], acc[ai][bj][m][n], 0, 0, 0); __builtin_amdgcn_s_setprio(0); } while (0)
#define PG8_WAIT_V(n) asm volatile("s_waitcnt vmcnt(" #n ")" ::: "memory")
#define PG8_WAIT_L(n) asm volatile("s_waitcnt lgkmcnt(" #n ")" ::: "memory")
#define PG8_BAR __builtin_amdgcn_s_barrier()
#define PG8_SCHED __builtin_amdgcn_sched_barrier(0)
    Unit cur, nxt; int ui = 0;
    if (!S.next(0, cur)) return;
    f32x4 acc[2][2][4][2];
#pragma unroll
    for (int a = 0; a < 2; ++a)
#pragma unroll
        for (int b = 0; b < 2; ++b)
#pragma unroll
            for (int m = 0; m < 4; ++m)
#pragma unroll
                for (int n = 0; n < 2; ++n) acc[a][b][m][n] = (f32x4){0.f, 0.f, 0.f, 0.f};
    bf16x8 At[4][2], B0[2][2], B1[2][2];
    const char* cA = (const char*)g.A + (size_t)cur.pm * tstep; const char* cB = (const char*)g.Bt + (size_t)cur.pn * tstep;
    S.a_ready(cur);
    if constexpr (SP2) {
        PG8_STAGE(PG8_SB(0, 0), cB, voffB); PG8_STAGE(PG8_SB(0, 1), cB + hstep, voffB); PG8_STAGE(PG8_SA(0, 0), cA, voffA); PG8_STAGE(PG8_SA(0, 1), cA + hstep, voffA);
        if (wr == 1) PG8_BAR;
        PG8_WAIT_V(2); PG8_BAR;
        PG8_STAGE(PG8_SB(1, 0), cB + kstep, voffB); PG8_STAGE(PG8_SA(1, 0), cA + kstep, voffA); PG8_STAGE(PG8_SB(1, 1), cB + hstep + kstep, voffB);
        PG8_WAIT_V(6); PG8_BAR;
    } else {
        PG8_STAGE(PG8_SB(0, 0), cB, voffB); PG8_STAGE(PG8_SA(0, 0), cA, voffA); PG8_STAGE(PG8_SB(0, 1), cB + hstep, voffB); PG8_STAGE(PG8_SA(0, 1), cA + hstep, voffA);
        if (wr == 1) PG8_BAR;
        PG8_WAIT_V(4); PG8_BAR;
        PG8_STAGE(PG8_SB(1, 0), cB + kstep, voffB); PG8_STAGE(PG8_SA(1, 0), cA + kstep, voffA); PG8_STAGE(PG8_SB(1, 1), cB + hstep + kstep, voffB);
        PG8_WAIT_V(6); PG8_BAR;
    }
    for (;;) {
        const bool has_next = S.next(ui + 1, nxt);
        const char* nA = has_next ? (const char*)g.A + (size_t)nxt.pm * tstep : cA; const char* nB = has_next ? (const char*)g.Bt + (size_t)nxt.pn * tstep : cB;
        for (int t = 0; t < nt; t += 2) {
            const bool last = (t == nt - 2);
            const char* a1 = cA + (size_t)(t + 1) * kstep;
            const char* a2 = last ? nA : cA + (size_t)(t + 2) * kstep; const char* b2 = last ? nB : cB + (size_t)(t + 2) * kstep;
            const char* a3 = a2 + kstep; const char* b3 = b2 + kstep;
            if (last && has_next) S.a_ready(nxt);
            if constexpr (SP2) {
            PG8_LDB(B0, 0, 0); PG8_LDB(B1, 0, 1); PG8_SCHED; PG8_LDA(At, 0, 0); PG8_STAGE(PG8_SA(1, 1), a1 + hstep, voffA);
            PG8_WAIT_V(8); PG8_WAIT_L(0); PG8_BAR; PG8_MMA(0, 0, At, B0); PG8_MMA(0, 1, At, B1); PG8_BAR; PG8_SCHED;
            PG8_LDA(At, 0, 1); PG8_STAGE(PG8_SB(0, 0), b2, voffB); PG8_STAGE(PG8_SB(0, 1), b2 + hstep, voffB); PG8_STAGE(PG8_SA(0, 0), a2, voffA);
            PG8_WAIT_V(8); PG8_WAIT_L(0); PG8_BAR; PG8_MMA(1, 0, At, B0); PG8_MMA(1, 1, At, B1); PG8_BAR; PG8_SCHED;
            PG8_LDB(B0, 1, 0); PG8_LDB(B1, 1, 1); PG8_SCHED; PG8_LDA(At, 1, 0); PG8_STAGE(PG8_SA(0, 1), a2 + hstep, voffA);
            PG8_WAIT_V(8); PG8_WAIT_L(0); PG8_BAR; PG8_MMA(0, 0, At, B0); PG8_MMA(0, 1, At, B1); PG8_BAR; PG8_SCHED;
            PG8_LDA(At, 1, 1); PG8_STAGE(PG8_SB(1, 0), b3, voffB); PG8_STAGE(PG8_SB(1, 1), b3 + hstep, voffB); PG8_STAGE(PG8_SA(1, 0), a3, voffA);
            PG8_WAIT_V(8); PG8_WAIT_L(0); PG8_BAR; PG8_MMA(1, 0, At, B0); PG8_MMA(1, 1, At, B1); PG8_BAR; PG8_SCHED;
            } else {
            PG8_LDB(B0, 0, 0); PG8_SCHED; PG8_LDA(At, 0, 0); PG8_STAGE(PG8_SA(1, 1), a1 + hstep, voffA);
            PG8_WAIT_L(8); PG8_BAR; PG8_WAIT_L(0); PG8_MMA(0, 0, At, B0); PG8_BAR; PG8_SCHED;
            PG8_LDB(B1, 0, 1); PG8_STAGE(PG8_SB(0, 0), b2, voffB);
            PG8_BAR; PG8_WAIT_L(0); PG8_MMA(0, 1, At, B1); PG8_BAR;
            PG8_LDA(At, 0, 1); PG8_STAGE(PG8_SA(0, 0), a2, voffA);
            PG8_BAR; PG8_WAIT_L(0); PG8_MMA(1, 0, At, B0); PG8_BAR; PG8_SCHED;
            PG8_STAGE(PG8_SB(0, 1), b2 + hstep, voffB);
            PG8_WAIT_V(6); PG8_BAR; PG8_MMA(1, 1, At, B1); PG8_BAR;
            PG8_LDB(B0, 1, 0); PG8_SCHED; PG8_LDA(At, 1, 0); PG8_STAGE(PG8_SA(0, 1), a2 + hstep, voffA);
            PG8_WAIT_L(8); PG8_BAR; PG8_WAIT_L(0); PG8_MMA(0, 0, At, B0); PG8_BAR; PG8_SCHED;
            PG8_LDB(B1, 1, 1); PG8_STAGE(PG8_SB(1, 0), b3, voffB);
            PG8_BAR; PG8_WAIT_L(0); PG8_MMA(0, 1, At, B1); PG8_BAR;
            PG8_LDA(At, 1, 1); PG8_STAGE(PG8_SA(1, 0), a3, voffA);
            PG8_BAR; PG8_WAIT_L(0); PG8_MMA(1, 0, At, B0); PG8_BAR; PG8_SCHED;
            PG8_STAGE(PG8_SB(1, 1), b3 + hstep, voffB);
            PG8_WAIT_V(6); PG8_BAR; PG8_MMA(1, 1, At, B1); PG8_BAR;
            }
        }
        if constexpr (ALIGN_EPI) { if (wr == 0) PG8_BAR; }
        if constexpr (!Epi::AFTER_DRAIN) { E(acc, cur, wr, wc, fr, fq); S.done(cur); }
        if (!has_next) break;
#pragma unroll
        for (int a = 0; a < 2; ++a)
#pragma unroll
            for (int b = 0; b < 2; ++b)
#pragma unroll
                for (int m = 0; m < 4; ++m)
#pragma unroll
                    for (int n = 0; n < 2; ++n) acc[a][b][m][n] = (f32x4){0.f, 0.f, 0.f, 0.f};
        cur = nxt; cA = nA; cB = nB; ++ui;
        if constexpr (ALIGN_EPI) { if (wr == 1) PG8_BAR; }
    }
    PG8_WAIT_V(0);
    if constexpr (!ALIGN_EPI) { if (wr == 0) PG8_BAR; }
    PG8_BAR;
    if constexpr (Epi::AFTER_DRAIN) { E.fused(acc, cur, wr, wc, fr, fq, lds, wid, lane); S.done(cur); }
#undef PG8_SA
#undef PG8_SB
#undef PG8_STAGE
#undef PG8_LDA
#undef PG8_LDB
#undef PG8_MMA
#undef PG8_WAIT_V
#undef PG8_WAIT_L
#undef PG8_BAR
#undef PG8_SCHED
}
}

typedef unsigned short bf16;
constexpr int NB = 4, SEQ = 8192, T = NB * SEQ, DM = 1024, DFF = 4096, DEPTH = 2;
constexpr int DIN = 3476, DINP = 3584;
constexpr int C_MQ = 0, C_MK = 512, C_MV = 1024, C_MO = 1536, C_BQ = 2048, C_BK = 2304, C_BV = 2560, C_NQ = 2816,
              C_NKC = 3072, C_NVC = 3136, C_NKS = 3200, C_NVS = 3264, C_NKW = 3328, C_NVW = 3392, C_GATE = 3456;
constexpr int NCMP = 511;
constexpr float EPS = 1e-6f;

__device__ __forceinline__ float bf2f(bf16 v) { return __builtin_bit_cast(float, (unsigned)v << 16); }
__device__ __forceinline__ bf16 f2bf(float f) { return (bf16)pg8::f2bf_u(f); }
template <int MASK> __device__ __forceinline__ float shx(float v) {
    if constexpr (MASK == 32) { auto rr = __builtin_amdgcn_permlane32_swap(__float_as_uint(v), __float_as_uint(v), false, false);
        return __uint_as_float(__builtin_amdgcn_mbcnt_lo(~0u, 0u) == 32u ? rr[0] : rr[1]); }
    else return __uint_as_float((unsigned)__builtin_amdgcn_ds_swizzle((int)__float_as_uint(v), 0x1F | (MASK << 10)));
}
template <int MASK> __device__ __forceinline__ unsigned shxu(unsigned v) { return __float_as_uint(shx<MASK>(__uint_as_float(v))); }
__device__ __forceinline__ float wave_sum(float v) {
    v += shx<1>(v); v += shx<2>(v); v += shx<4>(v); v += shx<8>(v); v += shx<16>(v);
    auto rr = __builtin_amdgcn_permlane32_swap(__float_as_uint(v), __float_as_uint(v), false, false); return __uint_as_float(rr[0]) + __uint_as_float(rr[1]);
}
__device__ __forceinline__ float wave_max(float v) {
    v = fmaxf(v, shx<1>(v)); v = fmaxf(v, shx<2>(v)); v = fmaxf(v, shx<4>(v)); v = fmaxf(v, shx<8>(v)); v = fmaxf(v, shx<16>(v));
    auto rr = __builtin_amdgcn_permlane32_swap(__float_as_uint(v), __float_as_uint(v), false, false); return fmaxf(__uint_as_float(rr[0]), __uint_as_float(rr[1]));
}
__device__ __forceinline__ float zf_() { float z = 0.f; asm volatile("" : "+v"(z)); return z; }
__device__ __forceinline__ float rcpf_(float x) { return __builtin_amdgcn_rcpf(x); }
__device__ __forceinline__ float sigmoidf_(float x) { return rcpf_(1.f + __expf(-x)); }
__device__ __forceinline__ float log_sigmoidf_(float x) { return fminf(x, 0.f) - __logf(1.f + __expf(-fabsf(x))); }
__device__ __forceinline__ void rope_cs(int pos, int f, float& c, float& s) {
    const float invf = f == 0 ? 1.0f : f == 1 ? 0.193922758102417f : f == 2 ? 0.03760603442788124f : f == 3 ? 0.007292666472494602f : f == 4 ? 0.0014142136787995696f
                     : f == 5 ? 0.00027424818836152554f : f == 6 ? 5.318298644851893e-05f : 1.031338433676865e-05f;
    const float ang = (float)pos * invf;
    const float k = rintf(ang * 0.15915493667125702f);
    float r = fmaf(-k, 6.2831854820251465f, ang); r = fmaf(-k, -1.7484555314695172e-07f, r);
    c = __cosf(r); s = __sinf(r);
}


__device__ __forceinline__ float dot64(const bf16* __restrict__ kp, const float* q) {
    const uint4* k4 = (const uint4*)kp; float a = 0.f;
#pragma unroll
    for (int j = 0; j < 8; ++j) { const uint4 w = k4[j]; const unsigned ww[4] = {w.x, w.y, w.z, w.w};
#pragma unroll
        for (int e = 0; e < 4; ++e) { a = fmaf(q[8 * j + 2 * e], __builtin_bit_cast(float, ww[e] << 16), a); a = fmaf(q[8 * j + 2 * e + 1], __builtin_bit_cast(float, ww[e] & 0xffff0000u), a); } }
    return a;
}
__device__ __forceinline__ void dot64x4(const bf16* __restrict__ kp, const float (*q)[64], float (&a)[4]) {
    const uint4* k4 = (const uint4*)kp; a[0] = a[1] = a[2] = a[3] = 0.f;
#pragma unroll
    for (int j = 0; j < 8; ++j) { const uint4 w = k4[j]; const unsigned ww[4] = {w.x, w.y, w.z, w.w};
#pragma unroll
        for (int e = 0; e < 4; ++e) { const float k0 = __builtin_bit_cast(float, ww[e] << 16), k1 = __builtin_bit_cast(float, ww[e] & 0xffff0000u);
#pragma unroll
            for (int h = 0; h < 4; ++h) { a[h] = fmaf(q[h][8 * j + 2 * e], k0, a[h]); a[h] = fmaf(q[h][8 * j + 2 * e + 1], k1, a[h]); } } }
}

__host__ __device__ __forceinline__ int win_src(int n) {
    if (n < 2048) return n;
    if (n < 3456) return n + 8;
    if (n < 3464) return n - 3456 + 2048;
    if (n < 3476) return n;
    return -1;
}


__device__ __forceinline__ void ph_convert_w(const float* __restrict__ W, int K, int N, int NP, bf16* __restrict__ WT, int mode, int item, bool act, int t, float* tile  , const float* __restrict__ gk = nullptr) {
    const int nbx = NP / 64; const int n0 = (item % nbx) * 64, k0 = (item / nbx) * 64, c = t & 63, r = t >> 6;
    if (act) { const int src = mode ? win_src(n0 + c) : (n0 + c);
#pragma unroll
        for (int i = 0; i < 16; ++i) { const int k = r + 4 * i; tile[k * 65 + c] = (src >= 0) ? W[(size_t)(k0 + k) * N + src] * (gk ? gk[k0 + k] : 1.f) : 0.f; } }
    __syncthreads();
    if (act) {
#pragma unroll 4
        for (int i = 0; i < 16; ++i) { const int n = r + 4 * i; WT[(size_t)(n0 + n) * K + k0 + c] = f2bf(tile[c * 65 + n]); } }
    __syncthreads();
}
__device__ __forceinline__ void ph_rmsnorm_row(const float* __restrict__ x, const float* __restrict__ g, bf16* __restrict__ H, int row, int lane) {
    const float4* xr = (const float4*)(x + (size_t)row * DM) + lane;
    float4 v[4]; float s = 0.f;
#pragma unroll
    for (int j = 0; j < 4; ++j) { v[j] = xr[64 * j]; s += v[j].x * v[j].x + v[j].y * v[j].y + v[j].z * v[j].z + v[j].w * v[j].w; }
    const float rstd = rsqrtf(wave_sum(s) * (1.f / DM) + EPS);
    uint2* o = (uint2*)(H + (size_t)row * DM) + lane;
#pragma unroll
    for (int j = 0; j < 4; ++j) { const float4 gg = ((const float4*)g)[lane + 64 * j];
        uint2 w; w.x = pg8::pk2bf(v[j].x * rstd * gg.x, v[j].y * rstd * gg.y); w.y = pg8::pk2bf(v[j].z * rstd * gg.z, v[j].w * rstd * gg.w); o[64 * j] = w; }
}
typedef unsigned u32x4p __attribute__((ext_vector_type(4)));
__device__ __forceinline__ void ph_x_row(const float* __restrict__ x, bf16* __restrict__ XB, unsigned long long* __restrict__ ssq, int row, int lane) {
    const float4* xr = (const float4*)(x + (size_t)row * DM) + lane;
    float4 v[4]; float s = 0.f;
#pragma unroll
    for (int j = 0; j < 4; ++j) { v[j] = xr[64 * j]; s += v[j].x * v[j].x + v[j].y * v[j].y + v[j].z * v[j].z + v[j].w * v[j].w; }
    s = wave_sum(s);
    uint2* o = (uint2*)(XB + (size_t)row * DM) + lane;
#pragma unroll
    for (int j = 0; j < 4; ++j) { uint2 w; w.x = pg8::cvtpk_bf16(v[j].x, v[j].y); w.y = pg8::cvtpk_bf16(v[j].z, v[j].w); o[64 * j] = w; }
    if (lane == 0) ssq[row] = (unsigned long long)(s * 1048576.0f + 0.5f);
}
__device__ __forceinline__ void ph_prep(bf16* __restrict__ P, const float* __restrict__ tab, const float* __restrict__ moba_g, const float* __restrict__ nsa_qg, const float* __restrict__ nsa_kg,
                                        float* __restrict__ kmean, int item, bool act, int t, float* red  ) {
    const int lane = t & 63, wid = t >> 6, tb = item % 128, kind = item / 128, rg = lane >> 3, dch = lane & 7;
    if (act) {
        int col; const float* g; bool rope;
        if (kind < 4) { col = C_BQ + kind * 64; g = moba_g; rope = true; }
        else if (kind < 8) { col = C_BK + (kind - 4) * 64; g = moba_g + 64; rope = true; }
        else if (kind < 12) { col = C_NQ + (kind - 8) * 64; g = nsa_qg; rope = false; }
        else if (kind == 12) { col = C_NKS; g = nsa_kg + 64; rope = true; }
        else { col = C_NKW; g = nsa_kg + 128; rope = true; }
        float gd[8];
#pragma unroll
        for (int e = 0; e < 8; ++e) gd[e] = g[dch * 8 + e];
        const int row0 = tb * 256 + wid * 64 + rg;
        u32x4p raw[8];
#pragma unroll
        for (int it = 0; it < 8; ++it) raw[it] = *(const u32x4p*)(P + (size_t)(row0 + it * 8) * DINP + col + dch * 8);
        float ks[8];
#pragma unroll
        for (int e = 0; e < 8; ++e) ks[e] = 0.f;
#pragma unroll
        for (int it = 0; it < 8; ++it) {
            const int row = row0 + it * 8, pos = row & (SEQ - 1);
            float y[8]; float ss = 0.f;
#pragma unroll
            for (int e = 0; e < 4; ++e) { y[2 * e] = __builtin_bit_cast(float, raw[it][e] << 16); y[2 * e + 1] = __builtin_bit_cast(float, raw[it][e] & 0xffff0000u); ss += y[2 * e] * y[2 * e] + y[2 * e + 1] * y[2 * e + 1]; }
            ss += shx<1>(ss); ss += shx<2>(ss); ss += shx<4>(ss);
            const float rstd = rsqrtf(ss * (1.f / 64.f) + EPS);
#pragma unroll
            for (int e = 0; e < 8; ++e) y[e] *= rstd * gd[e];
            if (rope) {
                float o[8];
#pragma unroll
                for (int e = 0; e < 8; ++e) o[e] = shx<1>(y[e]);
                if (dch < 2) { const float4 c0 = *(const float4*)(tab + pos * 16), c1 = *(const float4*)(tab + pos * 16 + 4), s0 = *(const float4*)(tab + pos * 16 + 8), s1 = *(const float4*)(tab + pos * 16 + 12);
                    const float cs[8] = {c0.x, c0.y, c0.z, c0.w, c1.x, c1.y, c1.z, c1.w}, sn[8] = {s0.x, s0.y, s0.z, s0.w, s1.x, s1.y, s1.z, s1.w};
#pragma unroll
                    for (int e = 0; e < 8; ++e) y[e] = dch ? (y[e] * cs[e] + o[e] * sn[e]) : (y[e] * cs[e] - o[e] * sn[e]); }
            }
            u32x4p w; w[0] = pg8::pk2bf(y[0], y[1]); w[1] = pg8::pk2bf(y[2], y[3]); w[2] = pg8::pk2bf(y[4], y[5]); w[3] = pg8::pk2bf(y[6], y[7]);
            *(u32x4p*)(P + (size_t)row * DINP + col + dch * 8) = w;
#pragma unroll
            for (int e = 0; e < 8; ++e) ks[e] += y[e];
        }
        if (kind >= 4 && kind < 8) {
#pragma unroll
            for (int e = 0; e < 8; ++e) { ks[e] += shx<8>(ks[e]); ks[e] += shx<16>(ks[e]); ks[e] += shx<32>(ks[e]); }
            if (rg == 0) {
#pragma unroll
                for (int e = 0; e < 8; ++e) red[wid * 64 + dch * 8 + e] = ks[e]; }
        }
    }
    __syncthreads();
    if (act && kind >= 4 && kind < 8 && wid == 0) { const float s = red[lane] + red[64 + lane] + red[128 + lane] + red[192 + lane];
        const int b = tb >> 5, n = tb & 31; kmean[(((size_t)b * 4 + (kind - 4)) * 32 + n) * 64 + lane] = s * (1.f / 256.f); }
    __syncthreads();
}
__device__ __forceinline__ void ph_compress(const bf16* __restrict__ P, const float* __restrict__ pe, const float* __restrict__ w1, const float* __restrict__ w2, const float* __restrict__ kg0,
                                            float* __restrict__ KVc, bf16* __restrict__ KVcb, int item, bool act, int t, float* sm  ) {
    float* in = sm; float* hid = sm + 2048;
    const int i = item % NCMP, b = (item / NCMP) & 3, kv = item / (NCMP * 4);
    const int col = kv ? C_NVC : C_NKC;
    if (act) for (int e = t; e < 2048; e += 256) { const int p = e >> 6, d = e & 63; in[e] = bf2f(P[(size_t)(b * SEQ + 16 * i + p) * DINP + col + d]) + pe[(kv * 32 + p) * 64 + d]; }
    __syncthreads();
    if (act && t < 128) { const float* w = w1 + (size_t)kv * 2048 * 128 + t; float a = 0.f;
#pragma unroll 8
        for (int k = 0; k < 2048; ++k) a = fmaf(in[k], w[(size_t)k * 128], a);
        hid[t] = a * rcpf_(1.f + __expf(-a)); }
    __syncthreads();
    if (act && t < 64) { const float* ww = w2 + (size_t)kv * 128 * 64 + t; float o = 0.f;
#pragma unroll 8
        for (int j = 0; j < 128; ++j) o = fmaf(hid[j], ww[j * 64], o);
        if (kv == 0) { const float ss = wave_sum(o * o); o = o * rsqrtf(ss * (1.f / 64.f) + EPS) * kg0[t]; }
        KVc[(((size_t)kv * NB + b) * 512 + i) * 64 + t] = o; KVcb[(((size_t)kv * NB + b) * 512 + i) * 64 + t] = f2bf(o);
        if (i == NCMP - 1) KVcb[(((size_t)kv * NB + b) * 512 + NCMP) * 64 + t] = 0; }
    __syncthreads();
}
__device__ __forceinline__ float conv_silu(const bf16* __restrict__ P, const float* __restrict__ cw  , int rowbase, int t, int c) {
    float a = 0.f;
#pragma unroll
    for (int j = 0; j < 4; ++j) { const int tt = t - 3 + j; if (tt >= 0) a = fmaf(cw[j * 1024 + c], bf2f(P[(size_t)(rowbase + tt) * DINP + c]), a); }
    return a * rcpf_(1.f + __expf(-a));
}
__device__ __forceinline__ void ph_mlstm_local(const bf16* __restrict__ P, const float* __restrict__ G, const float* __restrict__ cw, const float* __restrict__ bif,
                                               float* __restrict__ Cst, float* __restrict__ nst, float* __restrict__ dec, int u, bool act, int tid, unsigned char* sm) {
    bf16 (*ks)[128] = (bf16 (*)[128])sm; bf16 (*vs)[128] = (bf16 (*)[128])(sm + 16384); float* wS = (float*)(sm + 32768); float* lf = wS + 64;
    const int c = u & 127, h = (u >> 7) & 3, b = u >> 9;
    const int rowbase = b * SEQ, t0 = c * 64;
    if (act) {
        for (int e = tid; e < 64 * 128; e += 256) { const int s = e >> 7, d = e & 127;
            ks[s][d] = f2bf(conv_silu(P, cw, rowbase, t0 + s, 512 + h * 128 + d) * 0.08838834764831845f);
            vs[s][d] = P[(size_t)(rowbase + t0 + s) * DINP + C_MV + h * 128 + d]; }
        if (tid < 64) lf[tid] = log_sigmoidf_(G[(size_t)(rowbase + t0 + tid) * 32 + 4 + h] + bif[4 + h]);
    }
    __syncthreads();
    if (act && tid == 0) { float acc = 0.f;
        for (int s = 0; s < 64; ++s) { acc += lf[s]; lf[s] = acc; }
        dec[u] = __expf(acc); }
    __syncthreads();
    if (act && tid < 64) wS[tid] = __expf(lf[63] - lf[tid] + G[(size_t)(rowbase + t0 + tid) * 32 + h] + bif[h]);
    __syncthreads();
    if (act) {
        const int d = tid >> 1, e0 = (tid & 1) * 64;
        float acc[64];
#pragma unroll
        for (int e = 0; e < 64; ++e) acc[e] = 0.f;
        float an = 0.f;
        for (int s = 0; s < 64; ++s) { const float kw = wS[s] * bf2f(ks[s][d]); an += kw;
#pragma unroll
            for (int e = 0; e < 64; ++e) acc[e] = fmaf(kw, bf2f(vs[s][e0 + e]), acc[e]); }
        float* o = Cst + ((size_t)u * 128 + d) * 128 + e0;
#pragma unroll
        for (int e = 0; e < 64; ++e) o[e] = acc[e];
        if ((tid & 1) == 0) nst[(size_t)u * 128 + d] = an;
    }
    __syncthreads();
}
__device__ __forceinline__ void ph_mlstm_scan(float* __restrict__ Cst, float* __restrict__ nst, const float* __restrict__ dec, int item, int tid) {
    const int bh = item / 65, part = item % 65;
    float* base; int stride;
    if (part < 64) { base = Cst + (size_t)bh * 128 * 16384 + part * 256 + tid; stride = 16384; }
    else { if (tid >= 128) return; base = nst + (size_t)bh * 128 * 128 + tid; stride = 128; }
    float C = 0.f;
    for (int c = 0; c < 128; ++c) { const float dC = base[(size_t)c * stride]; base[(size_t)c * stride] = C; C = dec[bh * 128 + c] * C + dC; }
}
__device__ __forceinline__ void ph_mlstm_out(const bf16* __restrict__ P, const float* __restrict__ G, const float* __restrict__ cw, const float* __restrict__ bif,
                                             const float* __restrict__ Cst, const float* __restrict__ nst, const float* __restrict__ mnorm, bf16* __restrict__ MIX, int u, bool act, int tid, unsigned char* sm) {
    bf16 (*qs)[128] = (bf16 (*)[128])sm; float* ksS = (float*)(sm + 16384); bf16 (*ks)[128] = (bf16 (*)[128])ksS; bf16 (*vs)[128] = (bf16 (*)[128])(sm + 32768);
    float* bb = (float*)(sm + 49152); float* li = bb + 64;
    const int c = u & 127, h = (u >> 7) & 3, b = u >> 9;
    const int rowbase = b * SEQ, t0 = c * 64;
    if (act) {
        for (int e = tid; e < 64 * 128; e += 256) { const int s = e >> 7, d = e & 127;
            qs[s][d] = f2bf(conv_silu(P, cw, rowbase, t0 + s, h * 128 + d));
            ks[s][d] = f2bf(conv_silu(P, cw, rowbase, t0 + s, 512 + h * 128 + d) * 0.08838834764831845f);
            vs[s][d] = P[(size_t)(rowbase + t0 + s) * DINP + C_MV + h * 128 + d]; }
        if (tid < 64) { bb[tid] = log_sigmoidf_(G[(size_t)(rowbase + t0 + tid) * 32 + 4 + h] + bif[4 + h]); li[tid] = G[(size_t)(rowbase + t0 + tid) * 32 + h] + bif[h]; }
    }
    __syncthreads();
    if (act && tid == 0) { float acc = 0.f; for (int s = 0; s < 64; ++s) { acc += bb[s]; bb[s] = acc; } }
    __syncthreads();
    const int t = tid >> 2, part = tid & 3;
    float sreg[16];
    if (act) {
        const int s0 = part * 16;
#pragma unroll
        for (int j = 0; j < 16; ++j) { const int s = s0 + j; float a = 0.f;
            if (s <= t) { for (int d = 0; d < 128; ++d) a = fmaf(bf2f(qs[t][d]), bf2f(ks[s][d]), a); a *= __expf(bb[t] - bb[s] + li[s]); }
            sreg[j] = a; }
    }
    __syncthreads();
    float* S = ksS;
    if (act) {
#pragma unroll
        for (int j = 0; j < 16; ++j) S[t * 64 + part * 16 + j] = sreg[j];
    }
    __syncthreads();
    if (act) {
        const float Ft = __expf(bb[t]);
        float den = 0.f;
        for (int s = 0; s <= t; ++s) den += S[t * 64 + s];
        { const float* np = nst + (size_t)u * 128; float a = 0.f; for (int d = 0; d < 128; ++d) a = fmaf(bf2f(qs[t][d]), np[d], a); den += Ft * a; }
        const int e0 = part * 32;
        float acc[32];
#pragma unroll
        for (int e = 0; e < 32; ++e) acc[e] = 0.f;
        { const float* Cp = Cst + (size_t)u * 16384 + e0;
          for (int d = 0; d < 128; ++d) { const float qd = bf2f(qs[t][d]);
#pragma unroll
              for (int e = 0; e < 32; ++e) acc[e] = fmaf(qd, Cp[d * 128 + e], acc[e]); } }
#pragma unroll
        for (int e = 0; e < 32; ++e) acc[e] *= Ft;
        for (int s = 0; s <= t; ++s) { const float w = S[t * 64 + s];
#pragma unroll
            for (int e = 0; e < 32; ++e) acc[e] = fmaf(w, bf2f(vs[s][e0 + e]), acc[e]); }
        const float inv = rcpf_(fmaxf(fabsf(den), 1.f));
        float ss = 0.f;
#pragma unroll
        for (int e = 0; e < 32; ++e) { acc[e] *= inv; ss += acc[e] * acc[e]; }
        ss += shx<1>(ss); ss += shx<2>(ss);
        const float rstd = rsqrtf(ss * (1.f / 128.f) + EPS);
        const size_t row = (size_t)(rowbase + t0 + t);
#pragma unroll
        for (int e = 0; e < 32; ++e) { const int cc = h * 128 + e0 + e;
            const float o = sigmoidf_(bf2f(P[row * DINP + C_MO + cc]));
            MIX[row * DM + cc] = f2bf(acc[e] * rstd * mnorm[cc] * o); }
    }
    __syncthreads();
}

__device__ __forceinline__ void ph_moba(const bf16* __restrict__ P, const float* __restrict__ kmean, bf16* __restrict__ MIX, int gw, int lane, float* q) {
    const int bh = gw >> 13, tq = gw & (SEQ - 1), b = bh >> 2, h = bh & 3, own = tq >> 8;
    const size_t row = (size_t)b * SEQ + tq;
    __builtin_amdgcn_s_waitcnt(0); __builtin_amdgcn_wave_barrier();
    q[lane] = bf2f(P[row * DINP + C_BQ + h * 64 + lane]);
    __builtin_amdgcn_s_waitcnt(0); __builtin_amdgcn_wave_barrier();
    float gs = -3.0e38f;
    if (lane < 32) { if (lane < own) { const float* km = kmean + (((size_t)b * 4 + h) * 32 + lane) * 64; float a = 0.f; for (int d = 0; d < 64; ++d) a = fmaf(q[d], km[d], a); gs = a; } else gs = -1e30f; }
    int blk[4]; bool val[4];
#pragma unroll
    for (int r = 0; r < 3; ++r) { const float m = wave_max(gs); const unsigned long long bal = __ballot(gs == m); const int idx = __ffsll((long long)bal) - 1;
        blk[r] = idx; val[r] = (r < own); if (lane == idx) gs = -3.0e38f; }
    blk[3] = own; val[3] = true;
    float s[4][4]; float mx = -1e30f;
#pragma unroll
    for (int g = 0; g < 4; ++g)
#pragma unroll
        for (int i = 0; i < 4; ++i) { float a = -1e30f;
            if (val[g]) { const int pos = blk[g] * 256 + i * 64 + lane;
                if (g < 3 || pos <= tq) { const bf16* kp = P + ((size_t)b * SEQ + pos) * DINP + C_BK + h * 64; a = dot64(kp, q) * 0.125f; } }
            s[g][i] = a; mx = fmaxf(mx, a); }
    mx = wave_max(mx);
    float l = 0.f;
#pragma unroll
    for (int g = 0; g < 4; ++g)
#pragma unroll
        for (int i = 0; i < 4; ++i) { const float p = (s[g][i] > -1e29f) ? __expf(s[g][i] - mx) : 0.f; s[g][i] = p; l += p; }
    l = wave_sum(l);
    float o = 0.f;
#pragma unroll
    for (int g = 0; g < 4; ++g) { if (!val[g]) continue;
#pragma unroll
        for (int i = 0; i < 4; ++i) { const bf16* vp = P + ((size_t)b * SEQ + blk[g] * 256 + i * 64) * DINP + C_BV + h * 64 + lane;
            for (int src = 0; src < 64; ++src) { const float p = __shfl(s[g][i], src); o = fmaf(p, bf2f(vp[(size_t)src * DINP]), o); } } }
    MIX[row * DM + 512 + h * 64 + lane] = f2bf(o * rcpf_(l));
}

__device__ __forceinline__ void ph_nsa(const bf16* __restrict__ P, const float* __restrict__ G, const float* __restrict__ tab, const float* __restrict__ KVc, bf16* __restrict__ MIX, int gw, int lane, float* sm) {
    float (*qn)[64] = (float (*)[64])sm; float (*qr)[64] = (float (*)[64])(sm + 256); float* ps = sm + 512;
    const int b = gw >> 13, tq = gw & (SEQ - 1), blkq = tq >> 6;
    const size_t row = (size_t)b * SEQ + tq;
    __builtin_amdgcn_s_waitcnt(0); __builtin_amdgcn_wave_barrier();
#pragma unroll
    for (int h = 0; h < 4; ++h) { const float x = bf2f(P[row * DINP + C_NQ + h * 64 + lane]); qn[h][lane] = x;
        float y = x; const float other = shx<8>(x);
        if (lane < 16) { const int f = lane & 7; const float c = tab[tq * 16 + f], s = tab[tq * 16 + 8 + f]; y = (lane < 8) ? (x * c - other * s) : (x * c + other * s); }
        qr[h][lane] = y; }
    __builtin_amdgcn_s_waitcnt(0); __builtin_amdgcn_wave_barrier();
    const float* Kc = KVc + (size_t)b * 512 * 64; const float* Vc = KVc + ((size_t)NB + b) * 512 * 64;
    float out[4] = {0.f, 0.f, 0.f, 0.f};
    float gate[3][4];
#pragma unroll
    for (int br = 0; br < 3; ++br)
#pragma unroll
        for (int h = 0; h < 4; ++h) gate[br][h] = sigmoidf_(G[row * 32 + 8 + br * 4 + h]);
    const int ncv = (tq >= 31) ? ((tq - 31) >> 4) + 1 : 0;
    {
        float sc[8][4]; float mx[4] = {-1e30f, -1e30f, -1e30f, -1e30f};
#pragma unroll
        for (int i = 0; i < 8; ++i) { const int c = i * 64 + lane;
            float a[4] = {-1e30f, -1e30f, -1e30f, -1e30f};
            if (c < ncv) { const float* kp = Kc + (size_t)c * 64; a[0] = a[1] = a[2] = a[3] = 0.f;
                for (int d = 0; d < 64; ++d) { const float kd = kp[d]; a[0] = fmaf(qn[0][d], kd, a[0]); a[1] = fmaf(qn[1][d], kd, a[1]); a[2] = fmaf(qn[2][d], kd, a[2]); a[3] = fmaf(qn[3][d], kd, a[3]); }
#pragma unroll
                for (int h = 0; h < 4; ++h) a[h] *= 0.125f; }
#pragma unroll
            for (int h = 0; h < 4; ++h) { sc[i][h] = a[h]; mx[h] = fmaxf(mx[h], a[h]); } }
        float l[4];
#pragma unroll
        for (int h = 0; h < 4; ++h) { mx[h] = wave_max(mx[h]); l[h] = 0.f; }
#pragma unroll
        for (int i = 0; i < 8; ++i) { const int c = i * 64 + lane;
#pragma unroll
            for (int h = 0; h < 4; ++h) { const float p = (c < ncv) ? __expf(sc[i][h] - mx[h]) : 0.f; sc[i][h] = p; l[h] += p; } }
#pragma unroll
        for (int h = 0; h < 4; ++h) { l[h] = wave_sum(l[h]); l[h] = (l[h] > 0.f) ? rcpf_(l[h]) : 0.f; }
#pragma unroll
        for (int i = 0; i < 8; ++i) { float su = 0.f;
#pragma unroll
            for (int h = 0; h < 4; ++h) { sc[i][h] *= l[h]; su += sc[i][h]; }
            ps[i * 64 + lane] = su; }
        if (lane < 4) ps[512 + lane] = 0.f;
        float oc[4] = {0.f, 0.f, 0.f, 0.f};
#pragma unroll
        for (int i = 0; i < 8; ++i) { if (i * 64 >= ncv) break; const int nn = min(64, ncv - i * 64);
            for (int src = 0; src < nn; ++src) { const float v = Vc[(size_t)(i * 64 + src) * 64 + lane];
                oc[0] = fmaf(__shfl(sc[i][0], src), v, oc[0]); oc[1] = fmaf(__shfl(sc[i][1], src), v, oc[1]);
                oc[2] = fmaf(__shfl(sc[i][2], src), v, oc[2]); oc[3] = fmaf(__shfl(sc[i][3], src), v, oc[3]); } }
#pragma unroll
        for (int h = 0; h < 4; ++h) out[h] = gate[0][h] * oc[h];
    }
    __builtin_amdgcn_s_waitcnt(0); __builtin_amdgcn_wave_barrier();
    int sidx[16];
    {
        float v0, v1;
        { const int n = lane; float im = 0.f;
#pragma unroll
          for (int j = -1; j < 4; ++j) { const int c = 4 * n + j; if (c >= 0 && c < NCMP) im += ps[c]; }
          const bool causal = n <= blkq, forced = causal && (n == 0 || n >= blkq - 1);
          v0 = forced ? 1e9f : (causal ? im : -1e30f); }
        { const int n = lane + 64; float im = 0.f;
#pragma unroll
          for (int j = -1; j < 4; ++j) { const int c = 4 * n + j; if (c >= 0 && c < NCMP) im += ps[c]; }
          const bool causal = n <= blkq, forced = causal && (n == 0 || n >= blkq - 1);
          v1 = forced ? 1e9f : (causal ? im : -1e30f); }
#pragma unroll
        for (int k = 0; k < 16; ++k) { const float m = wave_max(fmaxf(v0, v1));
            const unsigned long long b0 = __ballot(v0 == m); int idx;
            if (b0) { idx = __ffsll((long long)b0) - 1; if (lane == idx) v0 = -3.0e38f; }
            else { const unsigned long long b1 = __ballot(v1 == m); idx = __ffsll((long long)b1) - 1; if (lane == idx) v1 = -3.0e38f; idx += 64; }
            sidx[k] = idx; }
    }
    {
        float sc[16][4]; float mx[4] = {-1e30f, -1e30f, -1e30f, -1e30f};
#pragma unroll
        for (int k = 0; k < 16; ++k) { const int n = sidx[k], pos = n * 64 + lane;
            float a[4] = {-1e30f, -1e30f, -1e30f, -1e30f};
            if (n <= blkq && pos <= tq) { const bf16* kp = P + ((size_t)b * SEQ + pos) * DINP + C_NKS; dot64x4(kp, qr, a);
#pragma unroll
                for (int h = 0; h < 4; ++h) a[h] *= 0.125f; }
#pragma unroll
            for (int h = 0; h < 4; ++h) { sc[k][h] = a[h]; mx[h] = fmaxf(mx[h], a[h]); } }
        float l[4];
#pragma unroll
        for (int h = 0; h < 4; ++h) { mx[h] = wave_max(mx[h]); l[h] = 0.f; }
#pragma unroll
        for (int k = 0; k < 16; ++k)
#pragma unroll
            for (int h = 0; h < 4; ++h) { const float p = (sc[k][h] > -1e29f) ? __expf(sc[k][h] - mx[h]) : 0.f; sc[k][h] = p; l[h] += p; }
#pragma unroll
        for (int h = 0; h < 4; ++h) l[h] = rcpf_(wave_sum(l[h]));
        float os[4] = {0.f, 0.f, 0.f, 0.f};
#pragma unroll
        for (int k = 0; k < 16; ++k) { const int n = sidx[k]; if (n > blkq) continue;
            const bf16* vp = P + ((size_t)b * SEQ + n * 64) * DINP + C_NVS + lane;
            for (int src = 0; src < 64; ++src) { const float v = bf2f(vp[(size_t)src * DINP]);
                os[0] = fmaf(__shfl(sc[k][0], src), v, os[0]); os[1] = fmaf(__shfl(sc[k][1], src), v, os[1]);
                os[2] = fmaf(__shfl(sc[k][2], src), v, os[2]); os[3] = fmaf(__shfl(sc[k][3], src), v, os[3]); } }
#pragma unroll
        for (int h = 0; h < 4; ++h) out[h] += gate[1][h] * os[h] * l[h];
    }
    {
        float sc[8][4]; float mx[4] = {-1e30f, -1e30f, -1e30f, -1e30f};
#pragma unroll
        for (int i = 0; i < 8; ++i) { const int pos = tq - 511 + i * 64 + lane;
            float a[4] = {-1e30f, -1e30f, -1e30f, -1e30f};
            if (pos >= 0) { const bf16* kp = P + ((size_t)b * SEQ + pos) * DINP + C_NKW; dot64x4(kp, qr, a);
#pragma unroll
                for (int h = 0; h < 4; ++h) a[h] *= 0.125f; }
#pragma unroll
            for (int h = 0; h < 4; ++h) { sc[i][h] = a[h]; mx[h] = fmaxf(mx[h], a[h]); } }
        float l[4];
#pragma unroll
        for (int h = 0; h < 4; ++h) { mx[h] = wave_max(mx[h]); l[h] = 0.f; }
#pragma unroll
        for (int i = 0; i < 8; ++i)
#pragma unroll
            for (int h = 0; h < 4; ++h) { const float p = (sc[i][h] > -1e29f) ? __expf(sc[i][h] - mx[h]) : 0.f; sc[i][h] = p; l[h] += p; }
#pragma unroll
        for (int h = 0; h < 4; ++h) l[h] = rcpf_(wave_sum(l[h]));
        float ow[4] = {0.f, 0.f, 0.f, 0.f};
#pragma unroll
        for (int i = 0; i < 8; ++i) { const int p0 = tq - 511 + i * 64; if (p0 + 63 < 0) continue;
            const int s0 = p0 < 0 ? -p0 : 0;
            for (int src = s0; src < 64; ++src) { const float v = bf2f(P[((size_t)b * SEQ + p0 + src) * DINP + C_NVW + lane]);
                ow[0] = fmaf(__shfl(sc[i][0], src), v, ow[0]); ow[1] = fmaf(__shfl(sc[i][1], src), v, ow[1]);
                ow[2] = fmaf(__shfl(sc[i][2], src), v, ow[2]); ow[3] = fmaf(__shfl(sc[i][3], src), v, ow[3]); } }
#pragma unroll
        for (int h = 0; h < 4; ++h) out[h] += gate[2][h] * ow[h] * l[h];
    }
#pragma unroll
    for (int h = 0; h < 4; ++h) MIX[row * DM + 768 + h * 64 + lane] = f2bf(out[h]);
}


#define LAS __attribute__((address_space(3)))
typedef short bf16x8 __attribute__((ext_vector_type(8)));
typedef float f32x16 __attribute__((ext_vector_type(16)));
typedef short s16x4 __attribute__((ext_vector_type(4)));
typedef unsigned u32x4v __attribute__((ext_vector_type(4)));
typedef float f32x2_t __attribute__((ext_vector_type(2)));
typedef __bf16 bf16x2_t __attribute__((ext_vector_type(2)));
constexpr int KROW = 144, VROW = 192;
constexpr int KBUF = 64 * KROW, VBUF = 64 * VROW, STG = KBUF + VBUF;
constexpr float SCL2 = 0.125f * 1.4426950408889634f;
constexpr float NEGBIG = -1e30f;

__device__ __forceinline__ unsigned cvtpk(float lo, float hi) { f32x2_t v = {lo, hi}; bf16x2_t b = __builtin_convertvector(v, bf16x2_t); return __builtin_bit_cast(unsigned, b); }
__device__ __forceinline__ int crow(int r, int hi) { return (r & 3) + 8 * (r >> 2) + 4 * hi; }
__device__ __forceinline__ s16x4 lds_tr(LAS const unsigned char* p) { return __builtin_bit_cast(s16x4, __builtin_amdgcn_ds_read_tr16_b64_v4i16((LAS s16x4*)p)); }

__device__ __forceinline__ bf16x8 scale_frag(bf16x8 v, float s) {
    const u32x4v w = __builtin_bit_cast(u32x4v, v); u32x4v o;
#pragma unroll
    for (int e = 0; e < 4; ++e) o[e] = cvtpk(__builtin_bit_cast(float, w[e] << 16) * s, __builtin_bit_cast(float, w[e] & 0xffff0000u) * s);
    return __builtin_bit_cast(bf16x8, o);
}
struct TileSrc { const bf16* k; const bf16* v; int stride; };
__device__ __forceinline__ void tile_load(u32x4v& kr, u32x4v& vr, const TileSrc& s, int t) {
    const int key = t >> 3, ch = t & 7;
    kr = *(const u32x4v*)(s.k + (size_t)key * s.stride + ch * 8); vr = *(const u32x4v*)(s.v + (size_t)key * s.stride + ch * 8);
}
__device__ __forceinline__ void tile_store(LAS unsigned char* buf, const u32x4v& kr, const u32x4v& vr, int t) {
    const int key = t >> 3, ch = t & 7;
    *(LAS u32x4v*)(buf + key * KROW + ch * 16) = kr; *(LAS u32x4v*)(buf + KBUF + key * VROW + ch * 16) = vr;
}
__device__ __forceinline__ void qk_tile(f32x16& p0, f32x16& p1, LAS const unsigned char* kb, const bf16x8 (&qf)[4], int r32, int hi, float cinit) {
    float ci = cinit; asm volatile("" : "+v"(ci));
#pragma unroll
    for (int r = 0; r < 16; ++r) { p0[r] = ci; p1[r] = ci; }
    LAS const unsigned char* a = kb + r32 * KROW + hi * 16;
#pragma unroll
    for (int ks = 0; ks < 4; ++ks) {
        const bf16x8 a0 = *(LAS const bf16x8*)(a + ks * 32), a1 = *(LAS const bf16x8*)(a + 32 * KROW + ks * 32);
        p0 = __builtin_amdgcn_mfma_f32_32x32x16_bf16(a0, qf[ks], p0, 0, 0, 0);
        p1 = __builtin_amdgcn_mfma_f32_32x32x16_bf16(a1, qf[ks], p1, 0, 0, 0);
    }
}
__device__ __forceinline__ void pv_tile(f32x16& o0, f32x16& o1, LAS const unsigned char* vb, const f32x16& p0, const f32x16& p1, int lane) {
    const int g = lane >> 4, i = lane & 15, hi = lane >> 5;
    LAS const unsigned char* base = vb + (4 * hi + (i >> 2)) * VROW + (16 * (g & 1) + 4 * (i & 3)) * 2;
#pragma unroll
    for (int s = 0; s < 4; ++s) {
        unsigned w[4];
#pragma unroll
        for (int e = 0; e < 4; ++e) { const int r = 8 * (s & 1) + 2 * e; w[e] = (s < 2) ? cvtpk(p0[r], p0[r + 1]) : cvtpk(p1[r], p1[r + 1]); }
        const u32x4v wv = {w[0], w[1], w[2], w[3]};
        const bf16x8 pf = __builtin_bit_cast(bf16x8, wv);
#pragma unroll
        for (int mb = 0; mb < 2; ++mb) {
            const s16x4 lo = lds_tr(base + s * 16 * VROW + mb * 64), hi4 = lds_tr(base + s * 16 * VROW + 8 * VROW + mb * 64);
            const bf16x8 vt = {lo[0], lo[1], lo[2], lo[3], hi4[0], hi4[1], hi4[2], hi4[3]};
            if (mb == 0) o0 = __builtin_amdgcn_mfma_f32_32x32x16_bf16(vt, pf, o0, 0, 0, 0);
            else o1 = __builtin_amdgcn_mfma_f32_32x32x16_bf16(vt, pf, o1, 0, 0, 0);
        }
    }
}
constexpr float SM_THR = 8.0f;
__device__ __forceinline__ void softmax_tile(f32x16& p0, f32x16& p1, f32x16& o0, f32x16& o1, float& mref, float& l, bool first) {
    float a = __builtin_fmaxf(__builtin_fmaxf(p0[0], p0[1]), p1[0]), b = __builtin_fmaxf(__builtin_fmaxf(p0[2], p0[3]), p1[1]);
    a = __builtin_fmaxf(__builtin_fmaxf(a, p1[2]), p1[3]);
#pragma unroll
    for (int r = 4; r < 16; r += 4) { a = __builtin_fmaxf(__builtin_fmaxf(a, p0[r]), p0[r + 1]); b = __builtin_fmaxf(__builtin_fmaxf(b, p0[r + 2]), p0[r + 3]);
        a = __builtin_fmaxf(__builtin_fmaxf(a, p1[r]), p1[r + 1]); b = __builtin_fmaxf(__builtin_fmaxf(b, p1[r + 2]), p1[r + 3]); }
    float rm = __builtin_fmaxf(a, b);
    { auto rr = __builtin_amdgcn_permlane32_swap(__float_as_uint(rm), __float_as_uint(rm), false, false); rm = __builtin_fmaxf(__uint_as_float(rr[0]), __uint_as_float(rr[1])); }
    if (first || __any(rm > SM_THR)) {
        const float dl = first ? rm : __builtin_fmaxf(rm, 0.f);
        mref += dl;
        const float f = __builtin_amdgcn_exp2f(-dl);
        l *= f;
#pragma unroll
        for (int r = 0; r < 16; ++r) { p0[r] -= dl; p1[r] -= dl; o0[r] *= f; o1[r] *= f; }
    }
    float s0 = 0.f, s1 = 0.f;
#pragma unroll
    for (int r = 0; r < 16; ++r) { p0[r] = __builtin_amdgcn_exp2f(p0[r]); p1[r] = __builtin_amdgcn_exp2f(p1[r]); s0 += p0[r]; s1 += p1[r]; }
    l += s0 + s1;
}

constexpr int MOBA_KM_OFF = 2 * STG, MOBA_TL_OFF = MOBA_KM_OFF + 32 * 64 * 4, MOBA_UW_OFF = MOBA_TL_OFF + 132 * 4;
__device__ __forceinline__ void moba_unit(const bf16* __restrict__ P, const float* __restrict__ kmean, bf16* __restrict__ MIX, int b, int h, int qb, int tid, LAS unsigned char* lds) {
    const int lane = tid & 63, wid = __builtin_amdgcn_readfirstlane(tid >> 6), r32 = lane & 31, hi = lane >> 5;
    LAS float* km = (LAS float*)(lds + MOBA_KM_OFF); LAS int* tl = (LAS int*)(lds + MOBA_TL_OFF); LAS unsigned* uw = (LAS unsigned*)(lds + MOBA_UW_OFF);
    const int own = qb, tq = qb * 256 + wid * 32 + r32;
    const size_t rowq = (size_t)b * SEQ + tq;
    const bf16* Pb = P + (size_t)b * SEQ * DINP;
    u32x4v kr, vr;
    { TileSrc s{Pb + (size_t)(own * 256) * DINP + C_BK + h * 64, Pb + (size_t)(own * 256) * DINP + C_BV + h * 64, DINP}; tile_load(kr, vr, s, tid); }
    bf16x8 qf[4];
#pragma unroll
    for (int ks = 0; ks < 4; ++ks) qf[ks] = *(const bf16x8*)(P + rowq * DINP + C_BQ + h * 64 + ks * 16 + hi * 8);
    for (int e = tid; e < own * 64; e += 512) km[e] = kmean[(((size_t)b * 4 + h) * 32) * 64 + e];
    __syncthreads();
    unsigned mask = 0u;
    {
        float qv[32];
#pragma unroll
        for (int ks = 0; ks < 4; ++ks)
#pragma unroll
            for (int j = 0; j < 8; ++j) qv[ks * 8 + j] = bf2f((bf16)qf[ks][j]);
        float b0 = -3e38f, b1 = -3e38f, b2 = -3e38f; int i0 = -1, i1 = -1, i2 = -1;
        for (int n = 0; n < own; ++n) {
            LAS const float* kp = km + n * 64 + hi * 8; float a = 0.f;
#pragma unroll
            for (int ks = 0; ks < 4; ++ks)
#pragma unroll
                for (int j = 0; j < 8; ++j) a = fmaf(qv[ks * 8 + j], kp[ks * 16 + j], a);
            a += shx<32>(a);
            if (a > b0) { b2 = b1; i2 = i1; b1 = b0; i1 = i0; b0 = a; i0 = n; }
            else if (a > b1) { b2 = b1; i2 = i1; b1 = a; i1 = n; }
            else if (a > b2) { b2 = a; i2 = n; }
        }
        if (i0 >= 0) mask |= 1u << i0; if (i1 >= 0) mask |= 1u << i1; if (i2 >= 0) mask |= 1u << i2;
    }
    { unsigned um = mask;
      um |= shxu<1>(um); um |= shxu<2>(um); um |= shxu<4>(um); um |= shxu<8>(um); um |= shxu<16>(um); um |= shxu<32>(um);
      if (lane == 0) uw[wid] = um; }
    tile_store(lds, kr, vr, tid);
    __syncthreads();
    if (tid == 0) { unsigned um = 0u; for (int w = 0; w < 8; ++w) um |= uw[w];
        int cnt = 0; for (int s = 0; s < 4; ++s) tl[cnt++] = own * 4 + s;
        for (int n = 0; n < own; ++n) if ((um >> n) & 1u) for (int s = 0; s < 4; ++s) tl[cnt++] = n * 4 + s;
        tl[131] = cnt; }
    __syncthreads();
    const int nt = tl[131];
#pragma unroll
    for (int ks = 0; ks < 4; ++ks) qf[ks] = scale_frag(qf[ks], SCL2);
    f32x16 o0, o1;
#pragma unroll
    for (int r = 0; r < 16; ++r) { o0[r] = zf_(); o1[r] = o0[r]; }
    float mref = 0.f, l = 0.f;
    for (int i = 0; i < nt; ++i) {
        const int tile = tl[i];
        if (i + 1 < nt) { const int nx = tl[i + 1]; TileSrc s{Pb + (size_t)(nx * 64) * DINP + C_BK + h * 64, Pb + (size_t)(nx * 64) * DINP + C_BV + h * 64, DINP}; tile_load(kr, vr, s, tid); }
        LAS const unsigned char* buf = lds + (i & 1) * STG;
        const int blk = tile >> 2, kbase = tile * 64;
        const bool sel = (blk == own) || ((mask >> blk) & 1u);
        if (__any(sel)) {
            f32x16 p0, p1;
            qk_tile(p0, p1, buf, qf, r32, hi, sel ? -mref : NEGBIG);
            if (blk == own) {
#pragma unroll
                for (int r = 0; r < 16; ++r) { const int k0 = kbase + crow(r, hi); p0[r] = (k0 <= tq) ? p0[r] : NEGBIG; p1[r] = (k0 + 32 <= tq) ? p1[r] : NEGBIG; }
            }
            softmax_tile(p0, p1, o0, o1, mref, l, i == 0);
            pv_tile(o0, o1, buf + KBUF, p0, p1, lane);
        }
        if (i + 1 < nt) tile_store(lds + ((i + 1) & 1) * STG, kr, vr, tid);
        __syncthreads();
    }
    l += shx<32>(l);
    const float inv = rcpf_(l);
    bf16* op = MIX + rowq * DM + 512 + h * 64 + 4 * hi;
#pragma unroll
    for (int g = 0; g < 4; ++g) {
        uint2 w0, w1;
        w0.x = cvtpk(o0[4 * g] * inv, o0[4 * g + 1] * inv); w0.y = cvtpk(o0[4 * g + 2] * inv, o0[4 * g + 3] * inv);
        w1.x = cvtpk(o1[4 * g] * inv, o1[4 * g + 1] * inv); w1.y = cvtpk(o1[4 * g + 2] * inv, o1[4 * g + 3] * inv);
        *(uint2*)(op + 8 * g) = w0; *(uint2*)(op + 32 + 8 * g) = w1;
    }
}

constexpr int NSA_S4_OFF = 2 * STG, NSA_L4_OFF = NSA_S4_OFF + 8 * 8 * 128 * 4, NSA_SM_OFF = NSA_L4_OFF + 8 * 8 * 128 * 4;
struct NsaCtx { const bf16* Pb; const bf16* Kcb; const bf16* Vcb; int b, jq, tid, lane, wid, r32, hi, tq; unsigned mk0, mk1, mk2, mk3; };

template <int MODE>
__device__ __forceinline__ void nsa_tiles(const NsaCtx& c, LAS unsigned char* lds, const bf16x8 (&qf)[4], int nt, f32x16& o0, f32x16& o1, float& m, float& l, float pre) {
    const int tid = c.tid, lane = c.lane, r32 = c.r32, hi = c.hi, tq = c.tq, jq = c.jq;
    const int nw = (jq < 8 ? jq : 8) + 1;
    auto tile_of = [&](int i) -> int { return MODE < 2 ? i : (i == 0 ? jq : (MODE == 2 ? i - 1 : jq - nw + i)); };
    auto src_of = [&](int t) -> TileSrc {
        if (MODE < 2) return TileSrc{c.Kcb + (size_t)t * 64 * 64, c.Vcb + (size_t)t * 64 * 64, 64};
        if (MODE == 2) return TileSrc{c.Pb + (size_t)t * 64 * DINP + C_NKS, c.Pb + (size_t)t * 64 * DINP + C_NVS, DINP};
        return TileSrc{c.Pb + (size_t)t * 64 * DINP + C_NKW, c.Pb + (size_t)t * 64 * DINP + C_NVW, DINP};
    };
    u32x4v kr, vr;
    { const TileSrc s = src_of(tile_of(0)); tile_load(kr, vr, s, tid); }
    tile_store(lds, kr, vr, tid);
    __syncthreads();
    const int ncv = (tq >= 31) ? ((tq - 31) >> 4) + 1 : 0;
    for (int i = 0; i < nt; ++i) {
        const int tile = tile_of(i);
        if (i + 1 < nt) { const TileSrc s = src_of(tile_of(i + 1)); tile_load(kr, vr, s, tid); }
        LAS const unsigned char* buf = lds + (i & 1) * STG;
        const int kbase = tile * 64;
        bool rowsel = true;
        if (MODE == 2 && tile != jq) { const unsigned w = (tile >> 5) == 0 ? c.mk0 : (tile >> 5) == 1 ? c.mk1 : (tile >> 5) == 2 ? c.mk2 : c.mk3; rowsel = (w >> (tile & 31)) & 1u; }
        if (MODE != 2 || __any(rowsel)) {
            f32x16 p0, p1;
            qk_tile(p0, p1, buf, qf, r32, hi, MODE < 2 ? 0.f : (rowsel ? -m : NEGBIG));
            if (MODE < 2) {
#pragma unroll
                for (int r = 0; r < 16; ++r) { const int k0 = kbase + crow(r, hi); p0[r] = (k0 < ncv) ? p0[r] : NEGBIG; p1[r] = (k0 + 32 < ncv) ? p1[r] : NEGBIG; }
            } else if (MODE == 2) {
                if (tile == jq) {
#pragma unroll
                    for (int r = 0; r < 16; ++r) { const int k0 = kbase + crow(r, hi); p0[r] = (k0 <= tq) ? p0[r] : NEGBIG; p1[r] = (k0 + 32 <= tq) ? p1[r] : NEGBIG; }
                }
            } else if (tile == jq || tile + 8 == jq) {
#pragma unroll
                for (int r = 0; r < 16; ++r) { const int k0 = kbase + crow(r, hi);
                    p0[r] = (k0 <= tq && k0 + 511 >= tq) ? p0[r] : NEGBIG; p1[r] = (k0 + 32 <= tq && k0 + 32 + 511 >= tq) ? p1[r] : NEGBIG; }
            }
            if (MODE == 0) {
                float tm = fmaxf(p0[0], p1[0]);
#pragma unroll
                for (int r = 1; r < 16; ++r) tm = fmaxf(tm, fmaxf(p0[r], p1[r]));
                tm = fmaxf(tm, shx<32>(tm));
                const float mn = fmaxf(m, tm); float s = 0.f;
#pragma unroll
                for (int r = 0; r < 16; ++r) { s += (p0[r] > -1e29f ? __builtin_amdgcn_exp2f(p0[r] - mn) : 0.f) + (p1[r] > -1e29f ? __builtin_amdgcn_exp2f(p1[r] - mn) : 0.f); }
                l = l * __builtin_amdgcn_exp2f(m - mn) + s; m = mn;
            } else if (MODE == 1) {
#pragma unroll
                for (int r = 0; r < 16; ++r) { p0[r] = (p0[r] > -1e29f) ? __builtin_amdgcn_exp2f(p0[r] - m) * pre : 0.f; p1[r] = (p1[r] > -1e29f) ? __builtin_amdgcn_exp2f(p1[r] - m) * pre : 0.f; }
                pv_tile(o0, o1, buf + KBUF, p0, p1, lane);
                LAS float* S4 = (LAS float*)(lds + NSA_S4_OFF) + (c.wid * 8 + (r32 & 7)) * 128; LAS float* L4 = (LAS float*)(lds + NSA_L4_OFF) + (c.wid * 8 + (r32 & 7)) * 128;
#pragma unroll
                for (int mbk = 0; mbk < 2; ++mbk)
#pragma unroll
                    for (int g = 0; g < 4; ++g) {
                        float s4 = mbk ? (p1[4 * g] + p1[4 * g + 1]) + (p1[4 * g + 2] + p1[4 * g + 3]) : (p0[4 * g] + p0[4 * g + 1]) + (p0[4 * g + 2] + p0[4 * g + 3]);
                        float la = mbk ? p1[4 * g + 3] : p0[4 * g + 3];
                        s4 += shx<8>(s4); s4 += shx<16>(s4); la += shx<8>(la); la += shx<16>(la);
                        const int gi = tile * 16 + 8 * mbk + 2 * g + hi;
                        if (r32 < 8) { S4[gi] = s4; L4[gi] = la; }
                    }
            } else {
                softmax_tile(p0, p1, o0, o1, m, l, i == 0);
                pv_tile(o0, o1, buf + KBUF, p0, p1, lane);
            }
        }
        if (i + 1 < nt) tile_store(lds + ((i + 1) & 1) * STG, kr, vr, tid);
        __syncthreads();
    }
}

__device__ __forceinline__ void nsa_unit(const bf16* __restrict__ P, const float* __restrict__ G, const float* __restrict__ tab, const bf16* __restrict__ KVcb, bf16* __restrict__ MIX,
                                         int b, int jq, int tid, LAS unsigned char* lds) {
    NsaCtx c; c.b = b; c.jq = jq; c.tid = tid; c.lane = tid & 63; c.wid = __builtin_amdgcn_readfirstlane(tid >> 6); c.r32 = c.lane & 31; c.hi = c.lane >> 5;
    const int qi = c.r32 & 7, hh = c.r32 >> 3, hi = c.hi, lane = c.lane;
    c.tq = jq * 64 + c.wid * 8 + qi;
    c.Pb = P + (size_t)b * SEQ * DINP; c.Kcb = KVcb + (size_t)b * 512 * 64; c.Vcb = KVcb + ((size_t)NB + b) * 512 * 64;
    c.mk0 = c.mk1 = c.mk2 = c.mk3 = 0u;
    const size_t rowq = (size_t)b * SEQ + c.tq;
    bf16x8 qf[4];
#pragma unroll
    for (int ks = 0; ks < 4; ++ks) qf[ks] = scale_frag(*(const bf16x8*)(P + rowq * DINP + C_NQ + hh * 64 + ks * 16 + hi * 8), SCL2);
    const float g0 = sigmoidf_(G[rowq * 32 + 8 + hh]), g1 = sigmoidf_(G[rowq * 32 + 12 + hh]), g2 = sigmoidf_(G[rowq * 32 + 16 + hh]);
    f32x16 a0, a1;
    {
        const int ncvmax = min(4 * jq + 3, NCMP), nct = (ncvmax + 63) >> 6;
        f32x16 o0, o1;
#pragma unroll
        for (int r = 0; r < 16; ++r) { o0[r] = zf_(); o1[r] = o0[r]; }
        float m = NEGBIG, l = 0.f;
        nsa_tiles<0>(c, lds, qf, nct, o0, o1, m, l, 0.f);
        l += shx<32>(l);
        const float pre = (l > 0.f) ? rcpf_(l) : 0.f;
        nsa_tiles<1>(c, lds, qf, nct, o0, o1, m, l, pre);
#pragma unroll
        for (int r = 0; r < 16; ++r) { a0[r] = g0 * o0[r]; a1[r] = g0 * o1[r]; }
    }
    {
        LAS unsigned* sm = (LAS unsigned*)(lds + NSA_SM_OFF);
        for (int q = 0; q < 8; ++q) {
            LAS const float* S4 = (LAS const float*)(lds + NSA_S4_OFF) + (c.wid * 8 + q) * 128; LAS const float* L4 = (LAS const float*)(lds + NSA_L4_OFF) + (c.wid * 8 + q) * 128;
            float v0, v1;
            { const int n = lane; const bool causal = n <= jq, forced = causal && (n == 0 || n >= jq - 1);
              float im = 0.f; if (causal) { im = S4[n]; if (n > 0) im += L4[n - 1]; }
              v0 = forced ? 1e9f : (causal ? im : -1e30f); }
            { const int n = lane + 64; const bool causal = n <= jq, forced = causal && (n >= jq - 1);
              float im = 0.f; if (causal) { im = S4[n] + L4[n - 1]; }
              v1 = forced ? 1e9f : (causal ? im : -1e30f); }
            unsigned long long sel0 = 0ull, sel1 = 0ull;
            for (int k = 0; k < 16; ++k) { const float mx = wave_max(fmaxf(v0, v1));
                const unsigned long long b0 = __ballot(v0 == mx);
                if (b0) { const int idx = __ffsll((long long)b0) - 1; sel0 |= 1ull << idx; if (lane == idx) v0 = -3.0e38f; }
                else { const unsigned long long b1 = __ballot(v1 == mx); const int idx = __ffsll((long long)b1) - 1; sel1 |= 1ull << idx; if (lane == idx) v1 = -3.0e38f; } }
            if (lane == 0) { sm[(c.wid * 8 + q) * 4 + 0] = (unsigned)sel0; sm[(c.wid * 8 + q) * 4 + 1] = (unsigned)(sel0 >> 32); sm[(c.wid * 8 + q) * 4 + 2] = (unsigned)sel1; sm[(c.wid * 8 + q) * 4 + 3] = (unsigned)(sel1 >> 32); }
        }
        __builtin_amdgcn_s_waitcnt(0xc07f); __builtin_amdgcn_wave_barrier();
        c.mk0 = sm[(c.wid * 8 + qi) * 4 + 0]; c.mk1 = sm[(c.wid * 8 + qi) * 4 + 1]; c.mk2 = sm[(c.wid * 8 + qi) * 4 + 2]; c.mk3 = sm[(c.wid * 8 + qi) * 4 + 3];
    }
    LAS float* stash = (LAS float*)(lds + NSA_S4_OFF) + c.wid * 1024 + lane;
    LAS float* stash2 = (LAS float*)(lds + NSA_L4_OFF) + c.wid * 1024 + lane;
#pragma unroll
    for (int r = 0; r < 16; ++r) { stash[r * 64] = a0[r]; stash2[r * 64] = a1[r]; }
    {
        const u32x4v qw = __builtin_bit_cast(u32x4v, qf[0]); u32x4v w;
#pragma unroll
        for (int e = 0; e < 4; ++e) {
            float y[2];
#pragma unroll
            for (int k = 0; k < 2; ++k) { const int j = 2 * e + k; const float x = k ? __builtin_bit_cast(float, qw[e] & 0xffff0000u) : __builtin_bit_cast(float, qw[e] << 16); const float other = shx<32>(x);
                const float cs = tab[c.tq * 16 + j], sn = tab[c.tq * 16 + 8 + j]; y[k] = hi ? (x * cs + other * sn) : (x * cs - other * sn); }
            w[e] = cvtpk(y[0], y[1]);
        }
        qf[0] = __builtin_bit_cast(bf16x8, w);
    }
    {
        f32x16 o0, o1;
#pragma unroll
        for (int r = 0; r < 16; ++r) { o0[r] = zf_(); o1[r] = o0[r]; }
        float m = 0.f, l = 0.f;
        nsa_tiles<2>(c, lds, qf, jq + 1, o0, o1, m, l, 0.f);
        l += shx<32>(l);
        const float sc = g1 * rcpf_(l);
#pragma unroll
        for (int r = 0; r < 16; ++r) { stash[r * 64] = fmaf(sc, o0[r], stash[r * 64]); stash2[r * 64] = fmaf(sc, o1[r], stash2[r * 64]); }
    }
    {
        f32x16 o0, o1;
#pragma unroll
        for (int r = 0; r < 16; ++r) { o0[r] = zf_(); o1[r] = o0[r]; }
        float m = 0.f, l = 0.f;
        nsa_tiles<3>(c, lds, qf, (jq < 8 ? jq : 8) + 1, o0, o1, m, l, 0.f);
        l += shx<32>(l);
        const float sc = g2 * rcpf_(l);
#pragma unroll
        for (int r = 0; r < 16; ++r) { a0[r] = fmaf(sc, o0[r], stash[r * 64]); a1[r] = fmaf(sc, o1[r], stash2[r * 64]); }
    }
    bf16* op = MIX + rowq * DM + 768 + hh * 64 + 4 * hi;
#pragma unroll
    for (int g = 0; g < 4; ++g) {
        uint2 w0, w1;
        w0.x = cvtpk(a0[4 * g], a0[4 * g + 1]); w0.y = cvtpk(a0[4 * g + 2], a0[4 * g + 3]);
        w1.x = cvtpk(a1[4 * g], a1[4 * g + 1]); w1.y = cvtpk(a1[4 * g + 2], a1[4 * g + 3]);
        *(uint2*)(op + 8 * g) = w0; *(uint2*)(op + 32 + 8 * g) = w1;
    }
}


constexpr int MQ_PITCH = 272, MV_PITCH = 320;
constexpr int ML_G_OFF = 0;
constexpr int ML_Q_OFF = 4096;
constexpr int ML_K_OFF = ML_Q_OFF + 64 * MQ_PITCH;
constexpr int ML_V_OFF = ML_K_OFF + 64 * MV_PITCH;
constexpr int ML_END = ML_V_OFF + 64 * MV_PITCH;
static_assert(ML_END <= 131072, "mlstm LDS");
constexpr float KSCALE = 0.08838834764831845f;

__device__ __forceinline__ void qk2_rows(const bf16* __restrict__ P, const float* __restrict__ cw, bf16* __restrict__ QK2, int bid, int G, int tid) {
    const int ch = tid & 127, c0 = ch * 8;
    float tp[4][8];
#pragma unroll
    for (int j = 0; j < 4; ++j) { const float4 a = *(const float4*)(cw + j * 1024 + c0), b4 = *(const float4*)(cw + j * 1024 + c0 + 4);
        tp[j][0] = a.x; tp[j][1] = a.y; tp[j][2] = a.z; tp[j][3] = a.w; tp[j][4] = b4.x; tp[j][5] = b4.y; tp[j][6] = b4.z; tp[j][7] = b4.w; }
    const float sc = (c0 >= 512) ? KSCALE : 1.f;
    for (int row0 = bid * 4 + (tid >> 7); row0 < T; row0 += G * 16) {
        u32x4v w[4][4];
#pragma unroll
        for (int q = 0; q < 4; ++q) { const int row = row0 + q * G * 4, t = row & (SEQ - 1);
#pragma unroll
            for (int j = 0; j < 4; ++j) { w[q][j] = u32x4v{0u, 0u, 0u, 0u}; if (row < T && t - 3 + j >= 0) w[q][j] = *(const u32x4v*)(P + (size_t)(row - 3 + j) * DINP + c0); } }
#pragma unroll
        for (int q = 0; q < 4; ++q) { const int row = row0 + q * G * 4;
            float y[8];
#pragma unroll
            for (int e = 0; e < 8; ++e) y[e] = 0.f;
#pragma unroll
            for (int j = 0; j < 4; ++j)
#pragma unroll
                for (int e = 0; e < 4; ++e) { y[2 * e] = fmaf(tp[j][2 * e], __builtin_bit_cast(float, w[q][j][e] << 16), y[2 * e]); y[2 * e + 1] = fmaf(tp[j][2 * e + 1], __builtin_bit_cast(float, w[q][j][e] & 0xffff0000u), y[2 * e + 1]); }
#pragma unroll
            for (int e = 0; e < 8; ++e) y[e] = y[e] * rcpf_(1.f + __expf(-y[e])) * sc;
            u32x4v o; o[0] = cvtpk(y[0], y[1]); o[1] = cvtpk(y[2], y[3]); o[2] = cvtpk(y[4], y[5]); o[3] = cvtpk(y[6], y[7]);
            if (row < T) *(u32x4v*)(QK2 + (size_t)row * 1024 + c0) = o; }
    }
}

struct MlRaw { u32x4v q[2], k[2], v[2]; float gf, gi; };
template <bool WITH_Q> __device__ __forceinline__ void ml_load(MlRaw& r, const bf16* __restrict__ P, const bf16* __restrict__ QK2, const float* __restrict__ G, const float* __restrict__ bif, int u, int tid) {
    const int c = u & 127, h = (u >> 7) & 3, b = u >> 9, row0 = b * SEQ + c * 64, s = tid >> 3;
#pragma unroll
    for (int pass = 0; pass < 2; ++pass) { const int ch = (tid & 7) + 8 * pass;
        if (WITH_Q) r.q[pass] = *(const u32x4v*)(QK2 + (size_t)(row0 + s) * 1024 + h * 128 + ch * 8);
        r.k[pass] = *(const u32x4v*)(QK2 + (size_t)(row0 + s) * 1024 + 512 + h * 128 + ch * 8);
        r.v[pass] = *(const u32x4v*)(P + (size_t)(row0 + s) * DINP + C_MV + h * 128 + ch * 8); }
    if (tid < 64) { r.gf = G[(size_t)(row0 + tid) * 32 + 4 + h] + bif[4 + h]; r.gi = G[(size_t)(row0 + tid) * 32 + h] + bif[h]; }
}
__device__ __forceinline__ void mlstm_gates(const MlRaw& r, int tid, LAS float* gs) {
    if (tid < 64) { gs[tid] = log_sigmoidf_(r.gf); gs[128 + tid] = r.gi; }
    __syncthreads();
    if (tid < 64) { float a = 0.f; for (int s = 0; s <= tid; ++s) a += gs[s]; gs[64 + tid] = a; }
    __syncthreads();
}

__device__ __forceinline__ void mlstm_m1_phase(const bf16* __restrict__ P, const bf16* __restrict__ QK2, const float* __restrict__ G, const float* __restrict__ bif,
                                               bf16* __restrict__ CT, float* __restrict__ nst, float* __restrict__ dec, int bid, int Gd, int tid, LAS unsigned char* lds) {
    const int lane = tid & 63, wid = __builtin_amdgcn_readfirstlane(tid >> 6), hi = lane >> 5;
    LAS float* gs = (LAS float*)(lds + ML_G_OFF);
    MlRaw raw;
    if (bid < 2048) ml_load<false>(raw, P, QK2, G, bif, bid, tid);
    for (int u = bid; u < 2048; u += Gd) {
        mlstm_gates(raw, tid, gs);
        if (tid == 0) dec[u] = __expf(gs[64 + 63]);
        {
            const int s = tid >> 3; const float ws = __expf(gs[64 + 63] - gs[64 + s] + gs[128 + s]);
#pragma unroll
            for (int pass = 0; pass < 2; ++pass) { const int ch = (tid & 7) + 8 * pass; u32x4v w;
#pragma unroll
                for (int e = 0; e < 4; ++e) w[e] = cvtpk(__builtin_bit_cast(float, raw.k[pass][e] << 16) * ws, __builtin_bit_cast(float, raw.k[pass][e] & 0xffff0000u) * ws);
                *(LAS u32x4v*)(lds + ML_K_OFF + s * MV_PITCH + ch * 16) = w;
                *(LAS u32x4v*)(lds + ML_V_OFF + s * MV_PITCH + ch * 16) = raw.v[pass]; }
        }
        if (u + Gd < 2048) ml_load<false>(raw, P, QK2, G, bif, u + Gd, tid);
        __syncthreads();
        const int g = lane >> 4, i = lane & 15;
        const int mb = wid >> 1, nb0 = 2 * (wid & 1);
        f32x16 acc0, acc1;
#pragma unroll
        for (int r = 0; r < 16; ++r) { acc0[r] = zf_(); acc1[r] = acc0[r]; }
        LAS const unsigned char* trb = lds + (4 * hi + (i >> 2)) * MV_PITCH + (16 * (g & 1) + 4 * (i & 3)) * 2;
#pragma unroll
        for (int ks = 0; ks < 4; ++ks) {
            const s16x4 alo = lds_tr(trb + ML_K_OFF + ks * 16 * MV_PITCH + mb * 64), ahi = lds_tr(trb + ML_K_OFF + ks * 16 * MV_PITCH + 8 * MV_PITCH + mb * 64);
            const bf16x8 af = {alo[0], alo[1], alo[2], alo[3], ahi[0], ahi[1], ahi[2], ahi[3]};
            const s16x4 b0lo = lds_tr(trb + ML_V_OFF + ks * 16 * MV_PITCH + nb0 * 64), b0hi = lds_tr(trb + ML_V_OFF + ks * 16 * MV_PITCH + 8 * MV_PITCH + nb0 * 64);
            const s16x4 b1lo = lds_tr(trb + ML_V_OFF + ks * 16 * MV_PITCH + (nb0 + 1) * 64), b1hi = lds_tr(trb + ML_V_OFF + ks * 16 * MV_PITCH + 8 * MV_PITCH + (nb0 + 1) * 64);
            const bf16x8 bf0 = {b0lo[0], b0lo[1], b0lo[2], b0lo[3], b0hi[0], b0hi[1], b0hi[2], b0hi[3]}, bf1 = {b1lo[0], b1lo[1], b1lo[2], b1lo[3], b1hi[0], b1hi[1], b1hi[2], b1hi[3]};
            acc0 = __builtin_amdgcn_mfma_f32_32x32x16_bf16(af, bf0, acc0, 0, 0, 0);
            acc1 = __builtin_amdgcn_mfma_f32_32x32x16_bf16(af, bf1, acc1, 0, 0, 0);
        }
        bf16* ct = CT + (size_t)u * 16384;
#pragma unroll
        for (int gq = 0; gq < 4; ++gq) { const int d0 = 32 * mb + 8 * gq + 4 * hi;
            uint2 w0, w1; w0.x = cvtpk(acc0[4 * gq], acc0[4 * gq + 1]); w0.y = cvtpk(acc0[4 * gq + 2], acc0[4 * gq + 3]); w1.x = cvtpk(acc1[4 * gq], acc1[4 * gq + 1]); w1.y = cvtpk(acc1[4 * gq + 2], acc1[4 * gq + 3]);
            *(uint2*)(ct + (size_t)(32 * nb0 + (lane & 31)) * 128 + d0) = w0; *(uint2*)(ct + (size_t)(32 * (nb0 + 1) + (lane & 31)) * 128 + d0) = w1; }
        if (tid < 128) { float a = 0.f; for (int s = 0; s < 64; ++s) a += bf2f(*(LAS const bf16*)(lds + ML_K_OFF + s * MV_PITCH + tid * 2)); nst[(size_t)u * 128 + tid] = a; }
        __syncthreads();
    }
}
__device__ __forceinline__ void mlstm_scan(bf16* __restrict__ CT, float* __restrict__ nst, const float* __restrict__ dec, int item, int tid) {
    const int bh = item / 9, part = item % 9;
    if (part < 8) {
        bf16* base = CT + (size_t)bh * 128 * 16384 + (part * 512 + tid) * 4;
        float C[4] = {0.f, 0.f, 0.f, 0.f};
        for (int c0 = 0; c0 < 128; c0 += 16) {
            uint2 w[16];
#pragma unroll
            for (int k = 0; k < 16; ++k) w[k] = *(const uint2*)(base + (size_t)(c0 + k) * 16384);
#pragma unroll
            for (int k = 0; k < 16; ++k) { const float a = dec[bh * 128 + c0 + k];
                uint2 o; o.x = cvtpk(C[0], C[1]); o.y = cvtpk(C[2], C[3]); *(uint2*)(base + (size_t)(c0 + k) * 16384) = o;
                C[0] = fmaf(a, C[0], __builtin_bit_cast(float, w[k].x << 16)); C[1] = fmaf(a, C[1], __builtin_bit_cast(float, w[k].x & 0xffff0000u));
                C[2] = fmaf(a, C[2], __builtin_bit_cast(float, w[k].y << 16)); C[3] = fmaf(a, C[3], __builtin_bit_cast(float, w[k].y & 0xffff0000u)); }
        }
    } else if (tid < 128) {
        float* base = nst + (size_t)bh * 128 * 128 + tid; float C = 0.f;
        for (int c = 0; c < 128; ++c) { const float dC = base[(size_t)c * 128]; base[(size_t)c * 128] = C; C = dec[bh * 128 + c] * C + dC; }
    }
}

__device__ __forceinline__ void mlstm_m3_phase(const bf16* __restrict__ P, const bf16* __restrict__ QK2, const float* __restrict__ G, const float* __restrict__ bif,
                                               const bf16* __restrict__ CT, const float* __restrict__ nst, const float* __restrict__ mnorm, bf16* __restrict__ MIX, int bid, int Gd, int tid, LAS unsigned char* lds) {
    const int lane = tid & 63, wid = __builtin_amdgcn_readfirstlane(tid >> 6), hi = lane >> 5, r32 = lane & 31;
    LAS float* gs = (LAS float*)(lds + ML_G_OFF);
    MlRaw raw;
    if (bid < 2048) ml_load<true>(raw, P, QK2, G, bif, bid, tid);
    for (int u = bid; u < 2048; u += Gd) {
    const int c = u & 127, h = (u >> 7) & 3, b = u >> 9, t0 = c * 64;
    if (tid >= 128 && tid < 256) gs[256 + tid - 128] = nst[(size_t)u * 128 + tid - 128];
    mlstm_gates(raw, tid, gs);
    {
        const int s = tid >> 3;
#pragma unroll
        for (int pass = 0; pass < 2; ++pass) { const int ch = (tid & 7) + 8 * pass;
            *(LAS u32x4v*)(lds + ML_Q_OFF + s * MQ_PITCH + ch * 16) = raw.q[pass];
            *(LAS u32x4v*)(lds + ML_K_OFF + s * MQ_PITCH + ch * 16) = raw.k[pass];
            *(LAS u32x4v*)(lds + ML_V_OFF + s * MV_PITCH + ch * 16) = raw.v[pass]; }
    }
    if (u + Gd < 2048) ml_load<true>(raw, P, QK2, G, bif, u + Gd, tid);
    __syncthreads();
    const int tb = wid & 1, eb = wid >> 1, t = 32 * tb + r32;
    bf16x8 qf[8];
#pragma unroll
    for (int ks = 0; ks < 8; ++ks) qf[ks] = *(LAS const bf16x8*)(lds + ML_Q_OFF + t * MQ_PITCH + ks * 32 + hi * 16);
    f32x16 ni;
#pragma unroll
    for (int r = 0; r < 16; ++r) ni[r] = zf_();
    { const bf16* ctp = CT + (size_t)u * 16384 + (size_t)(32 * eb + r32) * 128 + hi * 8;
      bf16x8 cf[8];
#pragma unroll
      for (int ks = 0; ks < 8; ++ks) cf[ks] = *(const bf16x8*)(ctp + ks * 16);
#pragma unroll
      for (int ks = 0; ks < 8; ++ks) ni = __builtin_amdgcn_mfma_f32_32x32x16_bf16(cf[ks], qf[ks], ni, 0, 0, 0); }
    f32x16 p0, p1;
#pragma unroll
    for (int r = 0; r < 16; ++r) { p0[r] = zf_(); p1[r] = p0[r]; }
    { LAS const unsigned char* ka = lds + ML_K_OFF + r32 * MQ_PITCH + hi * 16;
#pragma unroll
      for (int ks = 0; ks < 8; ++ks) { const bf16x8 a0 = *(LAS const bf16x8*)(ka + ks * 32); p0 = __builtin_amdgcn_mfma_f32_32x32x16_bf16(a0, qf[ks], p0, 0, 0, 0); }
      if (tb == 1) {
#pragma unroll
          for (int ks = 0; ks < 8; ++ks) { const bf16x8 a1 = *(LAS const bf16x8*)(ka + 32 * MQ_PITCH + ks * 32); p1 = __builtin_amdgcn_mfma_f32_32x32x16_bf16(a1, qf[ks], p1, 0, 0, 0); } } }
    const float bt = gs[64 + t], Ft = __expf(bt);
    float dsum = 0.f;
#pragma unroll
    for (int r = 0; r < 16; ++r) { const int s0 = crow(r, hi);
        { const float w = (s0 <= t) ? __expf(bt - gs[64 + s0] + gs[128 + s0]) : 0.f; p0[r] *= w; dsum += p0[r]; }
        { const int s1 = s0 + 32; const float w = (s1 <= t) ? __expf(bt - gs[64 + s1] + gs[128 + s1]) : 0.f; p1[r] *= w; dsum += p1[r]; } }
    float qn = 0.f;
#pragma unroll
    for (int ks = 0; ks < 8; ++ks)
#pragma unroll
        for (int j = 0; j < 8; ++j) qn = fmaf(bf2f((bf16)qf[ks][j]), gs[256 + ks * 16 + hi * 8 + j], qn);
    dsum += shx<32>(dsum); qn += shx<32>(qn);
    const float den = dsum + Ft * qn, inv = rcpf_(fmaxf(fabsf(den), 1.f));
    f32x16 na;
#pragma unroll
    for (int r = 0; r < 16; ++r) na[r] = zf_();
    { const int g = lane >> 4, i = lane & 15;
      LAS const unsigned char* trb = lds + ML_V_OFF + (4 * hi + (i >> 2)) * MV_PITCH + (16 * (g & 1) + 4 * (i & 3)) * 2 + eb * 64;
#pragma unroll
      for (int ss = 0; ss < 4; ++ss) { if (ss >= 2 && tb == 0) break;
          unsigned w[4];
#pragma unroll
          for (int e = 0; e < 4; ++e) { const int r = 8 * (ss & 1) + 2 * e; w[e] = (ss < 2) ? cvtpk(p0[r], p0[r + 1]) : cvtpk(p1[r], p1[r + 1]); }
          const u32x4v wv = {w[0], w[1], w[2], w[3]}; const bf16x8 pf = __builtin_bit_cast(bf16x8, wv);
          const s16x4 lo = lds_tr(trb + ss * 16 * MV_PITCH), hi4 = lds_tr(trb + ss * 16 * MV_PITCH + 8 * MV_PITCH);
          const bf16x8 vt = {lo[0], lo[1], lo[2], lo[3], hi4[0], hi4[1], hi4[2], hi4[3]};
          na = __builtin_amdgcn_mfma_f32_32x32x16_bf16(vt, pf, na, 0, 0, 0); } }
    float ssq = 0.f;
#pragma unroll
    for (int r = 0; r < 16; ++r) { na[r] = (na[r] + Ft * ni[r]) * inv; ssq += na[r] * na[r]; }
    ssq += shx<32>(ssq);
    if (hi == 0) gs[384 + eb * 64 + t] = ssq;
    __syncthreads();
    const float rstd = rsqrtf((gs[384 + t] + gs[384 + 64 + t] + gs[384 + 128 + t] + gs[384 + 192 + t]) * (1.f / 128.f) + EPS);
    const size_t row = (size_t)b * SEQ + t0 + t;
#pragma unroll
    for (int gq = 0; gq < 4; ++gq) { const int cc = h * 128 + 32 * eb + 8 * gq + 4 * hi;
        const uint2 ow = *(const uint2*)(P + row * DINP + C_MO + cc); const float4 mn = *(const float4*)(mnorm + cc);
        const float o0 = sigmoidf_(__builtin_bit_cast(float, ow.x << 16)), o1 = sigmoidf_(__builtin_bit_cast(float, ow.x & 0xffff0000u)), o2 = sigmoidf_(__builtin_bit_cast(float, ow.y << 16)), o3 = sigmoidf_(__builtin_bit_cast(float, ow.y & 0xffff0000u));
        uint2 w; w.x = cvtpk(na[4 * gq] * rstd * mn.x * o0, na[4 * gq + 1] * rstd * mn.y * o1); w.y = cvtpk(na[4 * gq + 2] * rstd * mn.z * o2, na[4 * gq + 3] * rstd * mn.w * o3);
        *(uint2*)(MIX + row * DM + cc) = w; }
    __syncthreads();
    }
}


typedef float f32x4v __attribute__((ext_vector_type(4)));
__device__ __forceinline__ void compress_item(const bf16* __restrict__ P, const bf16* __restrict__ w1t  , const float* __restrict__ c1  , const float* __restrict__ w2  ,
                                              const float* __restrict__ kg0, bf16* __restrict__ KVcb, int item, int tid, LAS unsigned char* lds) {
    const int lane = tid & 63, wid = __builtin_amdgcn_readfirstlane(tid >> 6), hi = lane >> 5, r32 = lane & 31;
    const int kv = item >> 5, b = (item >> 3) & 3, i0 = (item & 7) * 64;
    const int rb = wid & 1, cb = wid >> 1;
    const int irow = min(i0 + 32 * rb + r32, NCMP - 1);
    const bf16* xa = P + ((size_t)b * SEQ + 16 * irow) * DINP + (kv ? C_NVC : C_NKC) + hi * 8;
    const bf16* wb = w1t + ((size_t)kv * 128 + 32 * cb + r32) * 2048 + hi * 8;
    f32x16 acc;
#pragma unroll
    for (int r = 0; r < 16; ++r) acc[r] = zf_();
    for (int p0 = 0; p0 < 32; p0 += 4) {
        bf16x8 af[16], bfr[16];
#pragma unroll
        for (int q = 0; q < 16; ++q) { const int p = p0 + (q >> 2), dq = q & 3;
            af[q] = *(const bf16x8*)(xa + (size_t)p * DINP + dq * 16); bfr[q] = *(const bf16x8*)(wb + p * 64 + dq * 16); }
#pragma unroll
        for (int q = 0; q < 16; ++q) acc = __builtin_amdgcn_mfma_f32_32x32x16_bf16(af[q], bfr[q], acc, 0, 0, 0);
    }
    LAS float* hid = (LAS float*)lds;
    { LAS f32x4v* w2s = (LAS f32x4v*)(lds + 64 * 132 * 4); const f32x4v* w2g = (const f32x4v*)(w2 + (size_t)kv * 128 * 64);
#pragma unroll
      for (int q = 0; q < 4; ++q) w2s[tid + 512 * q] = w2g[tid + 512 * q]; }
    { const float cj = c1[kv * 128 + 32 * cb + r32];
#pragma unroll
      for (int r = 0; r < 16; ++r) { const float a = acc[r] + cj; hid[(32 * rb + crow(r, hi)) * 132 + 32 * cb + r32] = a * rcpf_(1.f + __expf(-a)); } }
    __syncthreads();
    {
        const int il = tid >> 3, d0 = (tid & 7) * 8;
        float o[8];
#pragma unroll
        for (int e = 0; e < 8; ++e) o[e] = 0.f;
        LAS const float* wp = (LAS const float*)(lds + 64 * 132 * 4) + d0;
#pragma unroll 8
        for (int j = 0; j < 128; ++j) { const float hv = hid[il * 132 + j]; const f32x4v wa = *(LAS const f32x4v*)(wp + j * 64), wb4 = *(LAS const f32x4v*)(wp + j * 64 + 4);
            o[0] = fmaf(hv, wa[0], o[0]); o[1] = fmaf(hv, wa[1], o[1]); o[2] = fmaf(hv, wa[2], o[2]); o[3] = fmaf(hv, wa[3], o[3]);
            o[4] = fmaf(hv, wb4[0], o[4]); o[5] = fmaf(hv, wb4[1], o[5]); o[6] = fmaf(hv, wb4[2], o[6]); o[7] = fmaf(hv, wb4[3], o[7]); }
        if (kv == 0) { float ss = 0.f;
#pragma unroll
            for (int e = 0; e < 8; ++e) ss += o[e] * o[e];
            ss += shx<1>(ss); ss += shx<2>(ss); ss += shx<4>(ss);
            const float rstd = rsqrtf(ss * (1.f / 64.f) + EPS);
#pragma unroll
            for (int e = 0; e < 8; ++e) o[e] *= rstd * kg0[d0 + e]; }
        const int i = i0 + il;
        if (i >= NCMP) {
#pragma unroll
            for (int e = 0; e < 8; ++e) o[e] = 0.f; }
        u32x4v w; w[0] = cvtpk(o[0], o[1]); w[1] = cvtpk(o[2], o[3]); w[2] = cvtpk(o[4], o[5]); w[3] = cvtpk(o[6], o[7]);
        *(u32x4v*)(KVcb + (((size_t)kv * NB + b) * 512 + i) * 64 + d0) = w;
    }
    __syncthreads();
}
__device__ __forceinline__ void cmp_c1_item(const float* __restrict__ pe, const float* __restrict__ w1, float* __restrict__ c1, int item, int tid, LAS unsigned char* lds) {
    const int lk = item >> 4, j0 = (item & 15) * 8, jj = tid & 7, kk = tid >> 3;
    const float* pp = pe + (size_t)lk * 2048; const float* ww = w1 + (size_t)lk * 2048 * 128 + j0 + jj;
    float a = 0.f;
#pragma unroll 8
    for (int k = kk; k < 2048; k += 64) a = fmaf(pp[k], ww[(size_t)k * 128], a);
    LAS float* red = (LAS float*)lds;
    red[tid] = a;
    __syncthreads();
    if (tid < 8) { float s = 0.f; for (int q = 0; q < 64; ++q) s += red[q * 8 + tid]; c1[lk * 128 + j0 + tid] = s; }
    __syncthreads();
}

#define XB_TMO      128
#define XB_XCNT(j)  (256  + 64 * (j))
#define XB_XSUB(j)  (1280 + 64 * (j))
#define XB_XGEN(j)  (2304 + 64 * (j))
#define XB_TOP      3328
#define XB_TOPGEN   3392
#define XCD_BAR_WORDS 3456
#define XB_SPIN_CAP (1u << 22)

__device__ __forceinline__ unsigned xb_ld(unsigned* p)              { return __hip_atomic_load(p, __ATOMIC_RELAXED, __HIP_MEMORY_SCOPE_AGENT); }
__device__ __forceinline__ unsigned xb_add(unsigned* p, unsigned v) { return __hip_atomic_fetch_add(p, v, __ATOMIC_RELAXED, __HIP_MEMORY_SCOPE_AGENT); }
__device__ __forceinline__ unsigned xb_xcc_id() { return (unsigned)__builtin_amdgcn_s_getreg((3 << 11) | 20) & 0xFu; }
#define XB_SPIN(cond, bar) do { unsigned _sp = 0; while (cond) { __builtin_amdgcn_s_sleep(1); \
    if ((++_sp & 255u) == 0u) { if (xb_ld(&(bar)[XB_TMO])) break; if (_sp > XB_SPIN_CAP) { atomicAdd(&(bar)[XB_TMO], 1u); break; } } } } while (0)

struct XcdBarrier {
    unsigned* bar; unsigned x;
    volatile LAS unsigned* st;
};

__device__ __forceinline__ XcdBarrier xcd_barrier_post(unsigned* bar, volatile LAS unsigned* st) {
    XcdBarrier b; b.bar = bar; b.x = xb_xcc_id(); b.st = st;
    if (threadIdx.x == 0) (void)xb_add(&bar[XB_XCNT(b.x)], 1u);
    return b;
}
__device__ __forceinline__ void xcd_barrier_complete(unsigned* bar, unsigned x, unsigned& nloc, unsigned& nx) {
    const unsigned G = gridDim.x * gridDim.y * gridDim.z;
    unsigned sum, cnt, mine, sp = 0u;
    for (;;) {
        sum = 0u; cnt = 0u; mine = 0u;
#pragma unroll
        for (unsigned j = 0; j < 16; ++j) { const unsigned c = xb_ld(&bar[XB_XCNT(j)]); sum += c; cnt += (c > 0u) ? 1u : 0u; mine = (j == x) ? c : mine; }
        if (sum == G) break;
        __builtin_amdgcn_s_sleep(1);
        if ((++sp & 255u) == 0u) { if (xb_ld(&bar[XB_TMO])) break; if (sp > XB_SPIN_CAP) { atomicAdd(&bar[XB_TMO], 1u); break; } }
    }
    nloc = mine > 0u ? mine : 1u; nx = cnt > 0u ? cnt : 1u;
}

__device__ __forceinline__ void xcd_barrier(const XcdBarrier& b) {
    asm volatile("s_waitcnt vmcnt(0)" ::: "memory");
    __syncthreads();
    if (threadIdx.x == 0) {
        unsigned* bar = b.bar;
        __builtin_amdgcn_s_waitcnt(0);
        unsigned nloc = b.st[0], nx = b.st[1];
        if (nloc == 0u) { xcd_barrier_complete(bar, b.x, nloc, nx); b.st[0] = nloc; b.st[1] = nx; }
        const unsigned old = xb_add(&bar[XB_XSUB(b.x)], 1u);
        const unsigned gen = old / nloc;
        if (old + 1u == (gen + 1u) * nloc) {
            __builtin_amdgcn_fence(__ATOMIC_RELEASE, "agent");
            asm volatile("s_waitcnt vmcnt(0)" ::: "memory");
            const unsigned og = xb_add(&bar[XB_TOP], 1u);
            const unsigned tg = og / nx;
            if (og + 1u == (tg + 1u) * nx) xb_add(&bar[XB_TOPGEN], 1u);
            else XB_SPIN(xb_ld(&bar[XB_TOPGEN]) == tg, bar);
            __builtin_amdgcn_fence(__ATOMIC_ACQUIRE, "agent");
            xb_add(&bar[XB_XGEN(b.x)], 1u);
            asm volatile("s_waitcnt vmcnt(0)" ::: "memory");
        } else {
            XB_SPIN(xb_ld(&bar[XB_XGEN(b.x)]) == gen, bar);
            __builtin_amdgcn_fence(__ATOMIC_ACQUIRE, "agent");
            asm volatile("s_waitcnt vmcnt(0)" ::: "memory");
        }
    }
    __syncthreads();
}


constexpr size_t MiB = 1u << 20;
constexpr size_t W_LAYER = (size_t)(DINP + DM + DFF) * DM + (size_t)DM * DFF;
constexpr size_t WS_W = 0;
constexpr size_t WS_HM = 52 * MiB;
constexpr size_t WS_G = 116 * MiB;
constexpr size_t WS_SMALL = 120 * MiB;
constexpr size_t WS_TAB = WS_SMALL, WS_KMEAN = WS_SMALL + 512 * 1024, WS_KVC = WS_SMALL + 1 * MiB, WS_NST = WS_SMALL + 2 * MiB, WS_DEC = WS_SMALL + 3 * MiB, WS_KVCB = WS_SMALL + 3 * MiB + 512 * 1024;
constexpr size_t WS_SSP = 476 * MiB;
constexpr size_t WS_BAR = WS_SMALL + 3 * MiB + 64 * 1024;
constexpr size_t WS_W1T = 50 * MiB, WS_C1 = WS_SMALL + 3 * MiB + 16 * 1024;
constexpr size_t WS_P = 124 * MiB;
constexpr size_t WS_C = 348 * MiB;
constexpr size_t WS_U = WS_P;
constexpr size_t WS_END = 478 * MiB;
static_assert(W_LAYER * 2 * DEPTH <= 50 * MiB && WS_W1T + (size_t)DEPTH * 2 * 128 * 2048 * 2 <= 52 * MiB, "weights");
static_assert((size_t)T * DINP * 2 == 224 * MiB && (size_t)T * DFF * 2 == 256 * MiB, "sizes");

#ifndef DUP_GEMM
#define DUP_GEMM 1
#endif
#ifndef DUP_M1
#define DUP_M1 1
#endif
#ifndef DUP_MOBA
#define DUP_MOBA 1
#endif
#ifndef DUP_NSA
#define DUP_NSA 1
#endif
#ifndef DUP_M3
#define DUP_M3 1
#endif
#ifndef DUP_CMP
#define DUP_CMP 1
#endif
struct Params { const float* in[16]; float* out; unsigned char* ws; };
static_assert(sizeof(Params) == 18 * 8, "kernarg layout: in[k] at 8k, out at 128, ws at 136");
constexpr int LDS_BYTES = 147456;

__global__ void __launch_bounds__(512, 2) hybrid_fwd(Params prm) {
    extern __shared__ __attribute__((aligned(16))) unsigned char lds[];
    cg::grid_group grid = cg::this_grid();
    constexpr int NPH = 1 + DEPTH * 8;
    volatile LAS unsigned* xst = (volatile LAS unsigned*)((LAS unsigned char*)lds + 131072 + 1024);
    if (threadIdx.x < 2) xst[threadIdx.x] = 0u;
    __syncthreads();
    (void)xcd_barrier_post((unsigned*)(prm.ws + WS_BAR), xst);
    for (int ph = 0; ph < NPH; ++ph) {
        int tid = threadIdx.x; asm volatile("" : "+v"(tid));
        int G = gridDim.x, bid = blockIdx.x; asm volatile("" : "+s"(G), "+s"(bid));
        const int half = tid >> 8, t256 = tid & 255, lane = tid & 63, wid = __builtin_amdgcn_readfirstlane(tid >> 6);
        unsigned char* smh = lds + half * 65536;
        const __attribute__((address_space(4))) unsigned char* ka = (const __attribute__((address_space(4))) unsigned char*)__builtin_amdgcn_kernarg_segment_ptr(); asm volatile("" : "+s"(ka));
#define KARG(T_, off) (*(T_ const __attribute__((address_space(4)))*)(ka + (off)))
#define IN(k) KARG(const float*, 8 * (k))
        unsigned char* ws = KARG(unsigned char*, 8 * 17); float* out = KARG(float*, 8 * 16);
        bf16* Wb = (bf16*)(ws + WS_W); bf16* HM = (bf16*)(ws + WS_HM); float* Gt = (float*)(ws + WS_G); float* tab = (float*)(ws + WS_TAB); float* kmean = (float*)(ws + WS_KMEAN);
        float* KVc = (float*)(ws + WS_KVC); float* nst = (float*)(ws + WS_NST); float* dec = (float*)(ws + WS_DEC); bf16* KVcb = (bf16*)(ws + WS_KVCB); bf16* W1t = (bf16*)(ws + WS_W1T); float* C1 = (float*)(ws + WS_C1); bf16* P = (bf16*)(ws + WS_P); bf16* CT = (bf16*)(ws + WS_C); bf16* QK2 = (bf16*)(ws + WS_C + 64 * MiB); bf16* XB = QK2  ; unsigned long long* SSA = (unsigned long long*)(ws + WS_SSP); unsigned long long* SSB = SSA + T;     bf16* U = (bf16*)(ws + WS_U);
        const int vb = bid * 2 + half, NVB = G * 2;
        const int gwv = bid * 8 + wid, NGW = G * 8;
        const int l = ph == 0 ? 0 : (ph - 1) / 8, j = ph == 0 ? -1 : (ph - 1) % 8;
        const float* x = IN(0);
        const float* xin = l == 0 ? x : out;
        const bf16* WinT = Wb + l * W_LAYER; const bf16* WoT = WinT + (size_t)DINP * DM; const bf16* W1T = WoT + (size_t)DM * DM; const bf16* W2T = W1T + (size_t)DFF * DM;
        if (ph == 0) {
            const float* w_in = IN(1); const float* w_out = IN(11); const float* w_ff1 = IN(14); const float* w_ff2 = IN(15);
            for (int ll = 0; ll < DEPTH; ++ll) {
                bf16* WinT_ = Wb + ll * W_LAYER; bf16* WoT_ = WinT_ + (size_t)DINP * DM; bf16* W1T_ = WoT_ + (size_t)DM * DM; bf16* W2T_ = W1T_ + (size_t)DFF * DM;
                for (int mt = 0; mt < 4; ++mt) {
                    const float* W; int K, N, NP, mode; bf16* WT;
                    const float* gk = nullptr;
                    if (mt == 0) { W = w_in + (size_t)ll * DM * DIN; K = DM; N = DIN; NP = DINP; WT = WinT_; mode = 1; gk = IN(12) + ll * DM; }
                    else if (mt == 1) { W = w_out + (size_t)ll * DM * DM; K = DM; N = DM; NP = DM; WT = WoT_; mode = 0; }
                    else if (mt == 2) { W = w_ff1 + (size_t)ll * DM * DFF; K = DM; N = DFF; NP = DFF; WT = W1T_; mode = 0; gk = IN(13) + ll * DM; }
                    else { W = w_ff2 + (size_t)ll * DFF * DM; K = DFF; N = DM; NP = DM; WT = W2T_; mode = 0; }
                    const int nit = (NP / 64) * (K / 64);
                    for (int it0 = 0; it0 < nit; it0 += NVB) { const int it = it0 + vb; ph_convert_w(W, K, N, NP, WT, mode, it, it < nit, t256, (float*)smh, gk); }
                }
            }
            for (int lk = 0; lk < DEPTH * 2; ++lk) {
                const int nit = 2 * 32;
                for (int it0 = 0; it0 < nit; it0 += NVB) { const int it = it0 + vb; ph_convert_w(IN(9) + (size_t)lk * 2048 * 128, 2048, 128, 128, W1t + (size_t)lk * 128 * 2048, 0, it, it < nit, t256, (float*)smh); }
            }
            for (int it = bid; it < 64; it += G) cmp_c1_item(IN(8), IN(9), C1, it, tid, (LAS unsigned char*)lds);
            for (int i = bid * 512 + tid; i < SEQ * 8; i += G * 512) { const int pos = i >> 3, f = i & 7;
                float c_, s_; rope_cs(pos, f, c_, s_);
                tab[pos * 16 + f] = c_; tab[pos * 16 + 8 + f] = s_; }
            for (int row = gwv; row < T; row += NGW) ph_x_row(x, XB, SSA, row, lane);
        } else if (j == 0 || j >= 5) {
            pg8::Gemm g; pg8::EpiAny E; int N; const bool last = (l + 1 == DEPTH);
            if (j == 0) { g = pg8::Gemm{XB, WinT, T, DINP, DM}; N = DINP; E = pg8::EpiAny{0, true, P, DINP, Gt, C_GATE, nullptr, nullptr, nullptr, SSA}; }
            else if (j == 5) { g = pg8::Gemm{HM, WoT, T, DM, DM}; N = DM; E = pg8::EpiAny{2, false, nullptr, DM, nullptr, 0, xin, out, XB, SSB}; }
            else if (j == 6) { g = pg8::Gemm{XB, W1T, T, DFF, DM}; N = DFF; E = pg8::EpiAny{1, true, U, DFF, nullptr, 0, nullptr, nullptr, nullptr, SSB}; }
            else { g = pg8::Gemm{U, W2T, T, DM, DFF}; N = DM; E = pg8::EpiAny{2, false, nullptr, DM, nullptr, 0, out, out, last ? nullptr : XB, SSA}; }
            pg8::StaticOrder S; S.init(T, N, G, bid);
            for (int rep = 0; rep < ((j == 0 || j == 6) ? DUP_GEMM : 1); ++rep) pg8::gemm_phase<pg8::EpiAny, pg8::StaticOrder, true, true>((PG8_LAS unsigned char*)lds, g, S, E, tid);
        } else if (j == 1) {
            for (int rep = 0; rep < DUP_CMP; ++rep) for (int it = bid; it < 64; it += G) compress_item(P, W1t + (size_t)l * 2 * 128 * 2048, C1 + l * 256, IN(10) + (size_t)l * 2 * 128 * 64, IN(7) + l * 192, KVcb, it, tid, (LAS unsigned char*)lds);
            for (int it0 = 0; it0 < 128 * 14; it0 += NVB) { const int it = it0 + vb; ph_prep(P, tab, IN(5) + l * 128, IN(6) + l * 64, IN(7) + l * 192, kmean, it, it < 128 * 14, t256, (float*)smh); }
            qk2_rows(P, IN(3) + (size_t)l * 4 * 1024, QK2, bid, G, tid);
            for (int i = bid * 512 + tid; i < 2 * T; i += G * 512) SSA[i] = 0ull;
        } else if (j == 2) {
            for (int rep = 0; rep < DUP_M1; ++rep) mlstm_m1_phase(P, QK2, Gt, IN(2) + l * 8, CT, nst, dec, bid, G, tid, (LAS unsigned char*)lds);
            for (int rep = 0; rep < DUP_MOBA; ++rep) for (int pu = bid; pu < 256; pu += G) { const int bh = pu >> 4, s = pu & 15;
                moba_unit(P, kmean, HM, bh >> 2, bh & 3, 31 - s, tid, (LAS unsigned char*)lds); moba_unit(P, kmean, HM, bh >> 2, bh & 3, s, tid, (LAS unsigned char*)lds); }
        } else if (j == 3) {
            for (int it = bid; it < 16 * 9; it += G) mlstm_scan(CT, nst, dec, it, tid);
            for (int rep = 0; rep < DUP_NSA; ++rep) for (int pu = bid; pu < 256; pu += G) { const int b_ = pu >> 6, s = pu & 63;
                nsa_unit(P, Gt, tab, KVcb, HM, b_, 127 - s, tid, (LAS unsigned char*)lds); nsa_unit(P, Gt, tab, KVcb, HM, b_, s, tid, (LAS unsigned char*)lds); }
        } else {
            for (int rep = 0; rep < DUP_M3; ++rep) mlstm_m3_phase(P, QK2, Gt, IN(2) + l * 8, CT, nst, IN(4) + l * 512, HM, bid, G, tid, (LAS unsigned char*)lds);
        }
        if (ph + 1 < NPH) { if (ph == 0) grid.sync(); else { XcdBarrier xbar; xbar.bar = (unsigned*)(ws + WS_BAR); xbar.x = xb_xcc_id(); xbar.st = xst; xcd_barrier(xbar); } }
    }
#undef IN
#undef KARG
}

extern "C" void kernel_launch(void* const* d_in, const int* in_sizes, int n_in, void* d_out, int out_size, void* d_ws, size_t ws_size, hipStream_t stream) {
    static int grid = 0;
    if (grid == 0) {
        if (n_in != 16 || in_sizes[0] != T * DM || out_size != T * DM || ws_size < WS_END) { fprintf(stderr, "kernel_launch: unexpected shapes / workspace %zu < %zu\n", ws_size, (size_t)WS_END); grid = -1; return; }
        int dev = 0, cus = 0, per_cu = 0;
        if (hipGetDevice(&dev) != hipSuccess || hipDeviceGetAttribute(&cus, hipDeviceAttributeMultiprocessorCount, dev) != hipSuccess) { grid = -1; return; }
        if (hipFuncSetAttribute((const void*)hybrid_fwd, hipFuncAttributeMaxDynamicSharedMemorySize, LDS_BYTES) != hipSuccess) { fprintf(stderr, "kernel_launch: hipFuncSetAttribute failed\n"); grid = -1; return; }
        if (hipOccupancyMaxActiveBlocksPerMultiprocessor(&per_cu, (const void*)hybrid_fwd, 512, LDS_BYTES) != hipSuccess || per_cu < 1) { fprintf(stderr, "kernel_launch: occupancy query failed (%d)\n", per_cu); grid = -1; return; }
        grid = cus * per_cu;
        fprintf(stderr, "kernel_launch: grid %d (%d CUs x %d)\n", grid, cus, per_cu);
    }
    if (grid < 0) return;
    if (hipMemsetAsync((char*)d_ws + WS_BAR, 0, XCD_BAR_WORDS * 4, stream) != hipSuccess) { fprintf(stderr, "kernel_launch: memset failed\n"); return; }
    Params p{};
    for (int i = 0; i < 16; ++i) p.in[i] = (const float*)d_in[i];
    p.out = (float*)d_out; p.ws = (unsigned char*)d_ws;
    void* args[] = {&p};
    hipError_t e = hipLaunchCooperativeKernel((const void*)hybrid_fwd, dim3(grid), dim3(512), args, LDS_BYTES, stream);
    if (e != hipSuccess) fprintf(stderr, "kernel_launch: cooperative launch failed: %s (grid %d)\n", hipGetErrorString(e), grid);
}
```

```cpp
#include <hip/hip_runtime.h>
#include <hip/hip_cooperative_groups.h>
#include <cstdio>
#include <cstdint>
namespace cg = cooperative_groups;
namespace pg8 {
#define PG8_LAS __attribute__((address_space(3)))
typedef unsigned short bf16_t;
typedef short bf16x8 __attribute__((ext_vector_type(8)));
typedef float f32x4 __attribute__((ext_vector_type(4)));
typedef unsigned u32x4 __attribute__((ext_vector_type(4)));
constexpr int BM = 256, BK = 64, HALF = 128, HTB = HALF * BK * 2  , STAGE_BYTES = 8 * HTB, NXCD = 8, WGM = 8;

__host__ __device__ __forceinline__ int lds_byte(int r, int c) { const int st = (r >> 4) * 2 + (c >> 5), rr = r & 15, cc = c & 31, ob = rr * 64 + cc * 2; return st * 1024 + (ob ^ (((ob >> 9) & 1) << 5)); }
__host__ __device__ __forceinline__ void stage_rc(int b, int& R, int& C) { const int st = b / 1024, sb = b % 1024, swz = sb ^ (((sb >> 9) & 1) << 5); R = (st >> 1) * 16 + swz / 64; C = (st & 1) * 32 + (swz % 64) / 2; }
__host__ __device__ __forceinline__ int perm32(int rho) { const int n = rho >> 4, i = rho & 15; return 8 * (i >> 2) + 4 * n + (i & 3); }

struct Unit { int pm, pn; };
struct Gemm { const bf16_t* A; const bf16_t* Bt; int M, N, K; };

struct StaticOrder {
    int nM, nN, nwg, G, c;
    __host__ __device__ void init(int M, int N, int G_, int c_) { nM = M / BM; nN = N / BM; nwg = nM * nN; G = G_; c = c_; }
    __host__ __device__ bool next(int i, Unit& u) const {
        const long L = (long)i * G + c; if (L >= nwg) return false;
        int wgid = (int)L; { const int q = nwg / NXCD, r = nwg % NXCD, xcd = wgid % NXCD, off = wgid / NXCD; wgid = (xcd < r ? xcd * (q + 1) : r * (q + 1) + (xcd - r) * q) + off; }
        const int nig = WGM * nN, gid = wgid / nig, fm = gid * WGM, gsz = (nM - fm) < WGM ? (nM - fm) : WGM;
        u.pm = fm + ((wgid % nig) % gsz); u.pn = (wgid % nig) / gsz; return true;
    }
    __device__ __forceinline__ void a_ready(const Unit&) const {}
    __device__ __forceinline__ void done(const Unit&) const {}
};

__device__ __forceinline__ unsigned f2bf_u(float f) { unsigned u = __builtin_bit_cast(unsigned, f); return (u + 0x7fffu + ((u >> 16) & 1u)) >> 16; }
__device__ __forceinline__ unsigned pk2bf(float lo, float hi) { return f2bf_u(lo) | (f2bf_u(hi) << 16); }

__device__ __forceinline__ unsigned cvtpk_bf16(float lo, float hi) { typedef float f2_ __attribute__((ext_vector_type(2))); typedef __bf16 b2_ __attribute__((ext_vector_type(2)));
    f2_ v = {lo, hi}; b2_ b = __builtin_convertvector(v, b2_); return __builtin_bit_cast(unsigned, b); }
__device__ __forceinline__ float swz_xor16(float v) { return __uint_as_float((unsigned)__builtin_amdgcn_ds_swizzle((int)__float_as_uint(v), 0x1F | (16 << 10))); }
__device__ __forceinline__ float half_sum(float v) { auto rr = __builtin_amdgcn_permlane32_swap(__float_as_uint(v), __float_as_uint(v), false, false); return __uint_as_float(rr[0]) + __uint_as_float(rr[1]); }
__device__ __forceinline__ float row_rstd(const unsigned long long* ssq, int row) { return __builtin_amdgcn_rsqf((float)ssq[row] * (1.0f / (1048576.0f * 1024.0f)) + 1e-6f); }

struct EpiProj {
    static constexpr bool PERM = true, AFTER_DRAIN = false;
    bf16_t* O; int ldc; float* gates; int gate0; const unsigned long long* ssp;
    __device__ __forceinline__ void operator()(const f32x4 (&acc)[2][2][4][2], const Unit& u, int wr, int wc, int fr, int fq) const {
        const int row0 = u.pm * BM + wr * 64 + fr; const int col0 = u.pn * BM + wc * 32 + 8 * fq;
        float rsv[2][4];
#pragma unroll
        for (int ai = 0; ai < 2; ++ai)
#pragma unroll
            for (int m = 0; m < 4; ++m) rsv[ai][m] = row_rstd(ssp, row0 + ai * HALF + m * 16);
#pragma unroll
        for (int ai = 0; ai < 2; ++ai)
#pragma unroll
            for (int m = 0; m < 4; ++m) { const int row = row0 + ai * HALF + m * 16; bf16_t* rowp = O + (size_t)row * ldc + col0; const float rs = rsv[ai][m];
#pragma unroll
                for (int bj = 0; bj < 2; ++bj) { const f32x4 v0 = acc[ai][bj][m][0] * rs, v1 = acc[ai][bj][m][1] * rs;
                    u32x4 w; w.x = cvtpk_bf16(v0[0], v0[1]); w.y = cvtpk_bf16(v0[2], v0[3]); w.z = cvtpk_bf16(v1[0], v1[1]); w.w = cvtpk_bf16(v1[2], v1[3]);
                    *(u32x4*)(rowp + bj * HALF) = w;
                    const int c = col0 + bj * HALF - gate0;
                    if (c >= 0 && c < 32) { float* g = gates + (size_t)row * 32 + c; *(f32x4*)g = v0; *(f32x4*)(g + 4) = v1; } } }
    }
};
struct EpiRelu2 {
    static constexpr bool PERM = true, AFTER_DRAIN = false;
    bf16_t* O; int ldc; const unsigned long long* ssp;
    __device__ __forceinline__ void operator()(const f32x4 (&acc)[2][2][4][2], const Unit& u, int wr, int wc, int fr, int fq) const {
        const int row0 = u.pm * BM + wr * 64 + fr; const int col0 = u.pn * BM + wc * 32 + 8 * fq;
        float rsv[2][4];
#pragma unroll
        for (int ai = 0; ai < 2; ++ai)
#pragma unroll
            for (int m = 0; m < 4; ++m) rsv[ai][m] = row_rstd(ssp, row0 + ai * HALF + m * 16);
#pragma unroll
        for (int ai = 0; ai < 2; ++ai)
#pragma unroll
            for (int m = 0; m < 4; ++m) { const int row = row0 + ai * HALF + m * 16; bf16_t* rowp = O + (size_t)row * ldc + col0; const float rs = rsv[ai][m];
#pragma unroll
                for (int bj = 0; bj < 2; ++bj) { f32x4 v0 = acc[ai][bj][m][0] * rs, v1 = acc[ai][bj][m][1] * rs;
#pragma unroll
                    for (int e = 0; e < 4; ++e) { float a = v0[e] > 0.f ? v0[e] : 0.f; v0[e] = a * a; float b = v1[e] > 0.f ? v1[e] : 0.f; v1[e] = b * b; }
                    u32x4 w; w.x = cvtpk_bf16(v0[0], v0[1]); w.y = cvtpk_bf16(v0[2], v0[3]); w.z = cvtpk_bf16(v1[0], v1[1]); w.w = cvtpk_bf16(v1[2], v1[3]);
                    *(u32x4*)(rowp + bj * HALF) = w; } }
    }
};
struct EpiResid {
    static constexpr bool PERM = false, AFTER_DRAIN = false;
    const float* base; float* out; int ldc; bf16_t* xb; unsigned long long* ssp;
    __device__ __forceinline__ void operator()(const f32x4 (&acc)[2][2][4][2], const Unit& u, int wr, int wc, int fr, int fq) const {
        const int row0 = u.pm * BM + wr * 64 + fr; const int col0 = u.pn * BM + wc * 32 + 4 * fq;
#pragma unroll
        for (int ai = 0; ai < 2; ++ai)
#pragma unroll
            for (int m = 0; m < 4; ++m) { const int row = row0 + ai * HALF + m * 16; const size_t off = (size_t)row * ldc + col0; float ss = 0.f;
#pragma unroll
                for (int bj = 0; bj < 2; ++bj)
#pragma unroll
                    for (int n = 0; n < 2; ++n) { const size_t o = off + bj * HALF + n * 16; const f32x4 b = *(const f32x4*)(base + o); const f32x4 v = b + acc[ai][bj][m][n]; *(f32x4*)(out + o) = v;
                        if (xb) { ss += (v[0] * v[0] + v[1] * v[1]) + (v[2] * v[2] + v[3] * v[3]); typedef unsigned u32x2_ __attribute__((ext_vector_type(2)));
                            u32x2_ w; w.x = cvtpk_bf16(v[0], v[1]); w.y = cvtpk_bf16(v[2], v[3]); *(u32x2_*)(xb + o) = w; } }
                if (xb) { ss += swz_xor16(ss); ss = half_sum(ss); if (fq == 0) atomicAdd(ssp + row, (unsigned long long)(ss * 1048576.0f + 0.5f)); } }
    }
};

struct EpiAny {
    static constexpr bool AFTER_DRAIN = false;
    int kind; bool perm;
    bf16_t* O; int ldc; float* gates; int gate0; const float* base; float* out; bf16_t* xb; unsigned long long* ssp;
    __device__ __forceinline__ void operator()(const f32x4 (&acc)[2][2][4][2], const Unit& u, int wr, int wc, int fr, int fq) const {
        if (kind == 0) { EpiProj e{O, ldc, gates, gate0, ssp}; e(acc, u, wr, wc, fr, fq); }
        else if (kind == 1) { EpiRelu2 e{O, ldc, ssp}; e(acc, u, wr, wc, fr, fq); }
        else { EpiResid e{base, out, ldc, xb, ssp}; e(acc, u, wr, wc, fr, fq); }
    }
};
template <class Epi, class Sched, bool ALIGN_EPI = false, bool SP2 = false>
__device__ __forceinline__ void gemm_phase(PG8_LAS unsigned char* lds, const Gemm g, const Sched& S, const Epi& E, const int tid) {
    const int wid = __builtin_amdgcn_readfirstlane(tid >> 6), lane = tid & 63, wr = wid >> 2, wc = wid & 3, fr = lane & 15, fq = lane >> 4;
    const int K = g.K, nt = K / BK;
    unsigned voffA[2], voffB[2];
#pragma unroll
    for (int i = 0; i < 2; ++i) { int R, C; stage_rc(tid * 16 + i * 8192, R, C); const int Rb = E.perm ? ((R & ~31) + perm32(R & 31)) : R;
        voffA[i] = (unsigned)(R * K + C) * 2u; voffB[i] = (unsigned)(Rb * K + C) * 2u; }
    const size_t kstep = (size_t)(BK * 2);
    const size_t hstep = (size_t)HALF * K * 2;
    const size_t tstep = 2 * hstep;
    const unsigned ldsw = (unsigned)wid * 1024u;
    const int aoff = lds_byte(wr * 64 + fr, fq * 8), boff = lds_byte(wc * 32 + fr, fq * 8);
#define PG8_SA(b, h) (((b) * 2 + (h)) * HTB)
#define PG8_SB(b, h) ((4 + (b) * 2 + (h)) * HTB)
#define PG8_STAGE(bufoff, gbase, voff) do { _Pragma("unroll") for (int _i = 0; _i < 2; ++_i) \
        __builtin_amdgcn_global_load_lds((const unsigned*)((const char*)(gbase) + (voff)[_i]), (PG8_LAS unsigned*)(lds + (bufoff) + ldsw + _i * 8192), 16, 0, 0); } while (0)
#define PG8_LDA(dst, b, h) do { _Pragma("unroll") for (int m = 0; m < 4; ++m) _Pragma("unroll") for (int k = 0; k < 2; ++k) dst[m][k] = *(const PG8_LAS bf16x8*)(lds + PG8_SA(b, h) + aoff + m * 2048 + k * 1024); } while (0)
#define PG8_LDB(dst, b, h) do { _Pragma("unroll") for (int n = 0; n < 2; ++n) _Pragma("unroll") for (int k = 0; k < 2; ++k) dst[n][k] = *(const PG8_LAS bf16x8*)(lds + PG8_SB(b, h) + boff + n * 2048 + k * 1024); } while (0)
#define PG8_MMA(ai, bj, At, Bt) do { __builtin_amdgcn_s_setprio(1); _Pragma("unroll") for (int m = 0; m < 4; ++m) _Pragma("unroll") for (int n = 0; n < 2; ++n) _Pragma("unroll") for (int k = 0; k < 2; ++k) \
        acc[ai][bj][m][n] = __builtin_amdgcn_mfma_f32_16x16x32_bf16(Bt[n][k], At[m][k], acc[ai][bj][m][n], 0, 0, 0); __builtin_amdgcn_s_setprio(0); } while (0)
#define PG8_WAIT_V(n) asm volatile("s_waitcnt vmcnt(" #n ")" ::: "memory")
#define PG8_WAIT_L(n) asm volatile("s_waitcnt lgkmcnt(" #n ")" ::: "memory")
#define PG8_BAR __builtin_amdgcn_s_barrier()
#define PG8_SCHED __builtin_amdgcn_sched_barrier(0)
    Unit cur, nxt; int ui = 0;
    if (!S.next(0, cur)) return;
    f32x4 acc[2][2][4][2];
#pragma unroll
    for (int a = 0; a < 2; ++a)
#pragma unroll
        for (int b = 0; b < 2; ++b)
#pragma unroll
            for (int m = 0; m < 4; ++m)
#pragma unroll
                for (int n = 0; n < 2; ++n) acc[a][b][m][n] = (f32x4){0.f, 0.f, 0.f, 0.f};
    bf16x8 At[4][2], B0[2][2], B1[2][2];
    const char* cA = (const char*)g.A + (size_t)cur.pm * tstep; const char* cB = (const char*)g.Bt + (size_t)cur.pn * tstep;
    S.a_ready(cur);
    if constexpr (SP2) {
        PG8_STAGE(PG8_SB(0, 0), cB, voffB); PG8_STAGE(PG8_SB(0, 1), cB + hstep, voffB); PG8_STAGE(PG8_SA(0, 0), cA, voffA); PG8_STAGE(PG8_SA(0, 1), cA + hstep, voffA);
        if (wr == 1) PG8_BAR;
        PG8_WAIT_V(2); PG8_BAR;
        PG8_STAGE(PG8_SB(1, 0), cB + kstep, voffB); PG8_STAGE(PG8_SA(1, 0), cA + kstep, voffA); PG8_STAGE(PG8_SB(1, 1), cB + hstep + kstep, voffB);
        PG8_WAIT_V(6); PG8_BAR;
    } else {
        PG8_STAGE(PG8_SB(0, 0), cB, voffB); PG8_STAGE(PG8_SA(0, 0), cA, voffA); PG8_STAGE(PG8_SB(0, 1), cB + hstep, voffB); PG8_STAGE(PG8_SA(0, 1), cA + hstep, voffA);
        if (wr == 1) PG8_BAR;
        PG8_WAIT_V(4); PG8_BAR;
        PG8_STAGE(PG8_SB(1, 0), cB + kstep, voffB); PG8_STAGE(PG8_SA(1, 0), cA + kstep, voffA); PG8_STAGE(PG8_SB(1, 1), cB + hstep + kstep, voffB);
        PG8_WAIT_V(6); PG8_BAR;
    }
    for (;;) {
        const bool has_next = S.next(ui + 1, nxt);
        const char* nA = has_next ? (const char*)g.A + (size_t)nxt.pm * tstep : cA; const char* nB = has_next ? (const char*)g.Bt + (size_t)nxt.pn * tstep : cB;
        for (int t = 0; t < nt; t += 2) {
            const bool last = (t == nt - 2);
            const char* a1 = cA + (size_t)(t + 1) * kstep;
            const char* a2 = last ? nA : cA + (size_t)(t + 2) * kstep; const char* b2 = last ? nB : cB + (size_t)(t + 2) * kstep;
            const char* a3 = a2 + kstep; const char* b3 = b2 + kstep;
            if (last && has_next) S.a_ready(nxt);
            if constexpr (SP2) {
            PG8_LDB(B0, 0, 0); PG8_LDB(B1, 0, 1); PG8_SCHED; PG8_LDA(At, 0, 0); PG8_STAGE(PG8_SA(1, 1), a1 + hstep, voffA);
            PG8_WAIT_V(8); PG8_WAIT_L(0); PG8_BAR; PG8_MMA(0, 0, At, B0); PG8_MMA(0, 1, At, B1); PG8_BAR; PG8_SCHED;
            PG8_LDA(At, 0, 1); PG8_STAGE(PG8_SB(0, 0), b2, voffB); PG8_STAGE(PG8_SB(0, 1), b2 + hstep, voffB); PG8_STAGE(PG8_SA(0, 0), a2, voffA);
            PG8_WAIT_V(8); PG8_WAIT_L(0); PG8_BAR; PG8_MMA(1, 0, At, B0); PG8_MMA(1, 1, At, B1); PG8_BAR; PG8_SCHED;
            PG8_LDB(B0, 1, 0); PG8_LDB(B1, 1, 1); PG8_SCHED; PG8_LDA(At, 1, 0); PG8_STAGE(PG8_SA(0, 1), a2 + hstep, voffA);
            PG8_WAIT_V(8); PG8_WAIT_L(0); PG8_BAR; PG8_MMA(0, 0, At, B0); PG8_MMA(0, 1, At, B1); PG8_BAR; PG8_SCHED;
            PG8_LDA(At, 1, 1); PG8_STAGE(PG8_SB(1, 0), b3, voffB); PG8_STAGE(PG8_SB(1, 1), b3 + hstep, voffB); PG8_STAGE(PG8_SA(1, 0), a3, voffA);
            PG8_WAIT_V(8); PG8_WAIT_L(0); PG8_BAR; PG8_MMA(1, 0, At, B0); PG8_MMA(1, 1, At, B1); PG8_BAR; PG8_SCHED;
            } else {
            PG8_LDB(B0, 0, 0); PG8_SCHED; PG8_LDA(At, 0, 0); PG8_STAGE(PG8_SA(1, 1), a1 + hstep, voffA);
            PG8_WAIT_L(8); PG8_BAR; PG8_WAIT_L(0); PG8_MMA(0, 0, At, B0); PG8_BAR; PG8_SCHED;
            PG8_LDB(B1, 0, 1); PG8_STAGE(PG8_SB(0, 0), b2, voffB);
            PG8_BAR; PG8_WAIT_L(0); PG8_MMA(0, 1, At, B1); PG8_BAR;
            PG8_LDA(At, 0, 1); PG8_STAGE(PG8_SA(0, 0), a2, voffA);
            PG8_BAR; PG8_WAIT_L(0); PG8_MMA(1, 0, At, B0); PG8_BAR; PG8_SCHED;
            PG8_STAGE(PG8_SB(0, 1), b2 + hstep, voffB);
            PG8_WAIT_V(6); PG8_BAR; PG8_MMA(1, 1, At, B1); PG8_BAR;
            PG8_LDB(B0, 1, 0); PG8_SCHED; PG8_LDA(At, 1, 0); PG8_STAGE(PG8_SA(0, 1), a2 + hstep, voffA);
            PG8_WAIT_L(8); PG8_BAR; PG8_WAIT_L(0); PG8_MMA(0, 0, At, B0); PG8_BAR; PG8_SCHED;
            PG8_LDB(B1, 1, 1); PG8_STAGE(PG8_SB(1, 0), b3, voffB);
            PG8_BAR; PG8_WAIT_L(0); PG8_MMA(0, 1, At, B1); PG8_BAR;
            PG8_LDA(At, 1, 1); PG8_STAGE(PG8_SA(1, 0), a3, voffA);
            PG8_BAR; PG8_WAIT_L(0); PG8_MMA(1, 0, At, B0); PG8_BAR; PG8_SCHED;
            PG8_STAGE(PG8_SB(1, 1), b3 + hstep, voffB);
            PG8_WAIT_V(6); PG8_BAR; PG8_MMA(1, 1, At, B1); PG8_BAR;
            }
        }
        if constexpr (ALIGN_EPI) { if (wr == 0) PG8_BAR; }
        if constexpr (!Epi::AFTER_DRAIN) { E(acc, cur, wr, wc, fr, fq); S.done(cur); }
        if (!has_next) break;
#pragma unroll
        for (int a = 0; a < 2; ++a)
#pragma unroll
            for (int b = 0; b < 2; ++b)
#pragma unroll
                for (int m = 0; m < 4; ++m)
#pragma unroll
                    for (int n = 0; n < 2; ++n) acc[a][b][m][n] = (f32x4){0.f, 0.f, 0.f, 0.f};
        cur = nxt; cA = nA; cB = nB; ++ui;
        if constexpr (ALIGN_EPI) { if (wr == 1) PG8_BAR; }
    }
    PG8_WAIT_V(0);
    if constexpr (!ALIGN_EPI) { if (wr == 0) PG8_BAR; }
    PG8_BAR;
    if constexpr (Epi::AFTER_DRAIN) { E.fused(acc, cur, wr, wc, fr, fq, lds, wid, lane); S.done(cur); }
#undef PG8_SA
#undef PG8_SB
#undef PG8_STAGE
#undef PG8_LDA
#undef PG8_LDB
#undef PG8_MMA
#undef PG8_WAIT_V
#undef PG8_WAIT_L
#undef PG8_BAR
#undef PG8_SCHED
}
}

typedef unsigned short bf16;
constexpr int NB = 4, SEQ = 8192, T = NB * SEQ, DM = 1024, DFF = 4096, DEPTH = 2;
constexpr int DIN = 3476, DINP = 3584;
constexpr int C_MQ = 0, C_MK = 512, C_MV = 1024, C_MO = 1536, C_BQ = 2048, C_BK = 2304, C_BV = 2560, C_NQ = 2816,
              C_NKC = 3072, C_NVC = 3136, C_NKS = 3200, C_NVS = 3264, C_NKW = 3328, C_NVW = 3392, C_GATE = 3456;
constexpr int NCMP = 511;
constexpr float EPS = 1e-6f;

__device__ __forceinline__ float bf2f(bf16 v) { return __builtin_bit_cast(float, (unsigned)v << 16); }
__device__ __forceinline__ bf16 f2bf(float f) { return (bf16)pg8::f2bf_u(f); }
template <int MASK> __device__ __forceinline__ float shx(float v) {
    if constexpr (MASK == 32) { auto rr = __builtin_amdgcn_permlane32_swap(__float_as_uint(v), __float_as_uint(v), false, false);
        return __uint_as_float(__builtin_amdgcn_mbcnt_lo(~0u, 0u) == 32u ? rr[0] : rr[1]); }
    else return __uint_as_float((unsigned)__builtin_amdgcn_ds_swizzle((int)__float_as_uint(v), 0x1F | (MASK << 10)));
}
template <int MASK> __device__ __forceinline__ unsigned shxu(unsigned v) { return __float_as_uint(shx<MASK>(__uint_as_float(v))); }
__device__ __forceinline__ float wave_sum(float v) {
    v += shx<1>(v); v += shx<2>(v); v += shx<4>(v); v += shx<8>(v); v += shx<16>(v);
    auto rr = __builtin_amdgcn_permlane32_swap(__float_as_uint(v), __float_as_uint(v), false, false); return __uint_as_float(rr[0]) + __uint_as_float(rr[1]);
}
__device__ __forceinline__ float wave_max(float v) {
    v = fmaxf(v, shx<1>(v)); v = fmaxf(v, shx<2>(v)); v = fmaxf(v, shx<4>(v)); v = fmaxf(v, shx<8>(v)); v = fmaxf(v, shx<16>(v));
    auto rr = __builtin_amdgcn_permlane32_swap(__float_as_uint(v), __float_as_uint(v), false, false); return fmaxf(__uint_as_float(rr[0]), __uint_as_float(rr[1]));
}
__device__ __forceinline__ float zf_() { float z = 0.f; asm volatile("" : "+v"(z)); return z; }
__device__ __forceinline__ float rcpf_(float x) { return __builtin_amdgcn_rcpf(x); }
__device__ __forceinline__ float sigmoidf_(float x) { return rcpf_(1.f + __expf(-x)); }
__device__ __forceinline__ float log_sigmoidf_(float x) { return fminf(x, 0.f) - __logf(1.f + __expf(-fabsf(x))); }
__device__ __forceinline__ void rope_cs(int pos, int f, float& c, float& s) {
    const float invf = f == 0 ? 1.0f : f == 1 ? 0.193922758102417f : f == 2 ? 0.03760603442788124f : f == 3 ? 0.007292666472494602f : f == 4 ? 0.0014142136787995696f
                     : f == 5 ? 0.00027424818836152554f : f == 6 ? 5.318298644851893e-05f : 1.031338433676865e-05f;
    const float ang = (float)pos * invf;
    const float k = rintf(ang * 0.15915493667125702f);
    float r = fmaf(-k, 6.2831854820251465f, ang); r = fmaf(-k, -1.7484555314695172e-07f, r);
    c = __cosf(r); s = __sinf(r);
}


__device__ __forceinline__ float dot64(const bf16* __restrict__ kp, const float* q) {
    const uint4* k4 = (const uint4*)kp; float a = 0.f;
#pragma unroll
    for (int j = 0; j < 8; ++j) { const uint4 w = k4[j]; const unsigned ww[4] = {w.x, w.y, w.z, w.w};
#pragma unroll
        for (int e = 0; e < 4; ++e) { a = fmaf(q[8 * j + 2 * e], __builtin_bit_cast(float, ww[e] << 16), a); a = fmaf(q[8 * j + 2 * e + 1], __builtin_bit_cast(float, ww[e] & 0xffff0000u), a); } }
    return a;
}
__device__ __forceinline__ void dot64x4(const bf16* __restrict__ kp, const float (*q)[64], float (&a)[4]) {
    const uint4* k4 = (const uint4*)kp; a[0] = a[1] = a[2] = a[3] = 0.f;
#pragma unroll
    for (int j = 0; j < 8; ++j) { const uint4 w = k4[j]; const unsigned ww[4] = {w.x, w.y, w.z, w.w};
#pragma unroll
        for (int e = 0; e < 4; ++e) { const float k0 = __builtin_bit_cast(float, ww[e] << 16), k1 = __builtin_bit_cast(float, ww[e] & 0xffff0000u);
#pragma unroll
            for (int h = 0; h < 4; ++h) { a[h] = fmaf(q[h][8 * j + 2 * e], k0, a[h]); a[h] = fmaf(q[h][8 * j + 2 * e + 1], k1, a[h]); } } }
}

__host__ __device__ __forceinline__ int win_src(int n) {
    if (n < 2048) return n;
    if (n < 3456) return n + 8;
    if (n < 3464) return n - 3456 + 2048;
    if (n < 3476) return n;
    return -1;
}


__device__ __forceinline__ void ph_convert_w(const float* __restrict__ W, int K, int N, int NP, bf16* __restrict__ WT, int mode, int item, bool act, int t, float* tile  , const float* __restrict__ gk = nullptr) {
    const int nbx = NP / 64; const int n0 = (item % nbx) * 64, k0 = (item / nbx) * 64, c = t & 63, r = t >> 6;
    if (act) { const int src = mode ? win_src(n0 + c) : (n0 + c);
#pragma unroll
        for (int i = 0; i < 16; ++i) { const int k = r + 4 * i; tile[k * 65 + c] = (src >= 0) ? W[(size_t)(k0 + k) * N + src] * (gk ? gk[k0 + k] : 1.f) : 0.f; } }
    __syncthreads();
    if (act) {
#pragma unroll 4
        for (int i = 0; i < 16; ++i) { const int n = r + 4 * i; WT[(size_t)(n0 + n) * K + k0 + c] = f2bf(tile[c * 65 + n]); } }
    __syncthreads();
}
__device__ __forceinline__ void ph_rmsnorm_row(const float* __restrict__ x, const float* __restrict__ g, bf16* __restrict__ H, int row, int lane) {
    const float4* xr = (const float4*)(x + (size_t)row * DM) + lane;
    float4 v[4]; float s = 0.f;
#pragma unroll
    for (int j = 0; j < 4; ++j) { v[j] = xr[64 * j]; s += v[j].x * v[j].x + v[j].y * v[j].y + v[j].z * v[j].z + v[j].w * v[j].w; }
    const float rstd = rsqrtf(wave_sum(s) * (1.f / DM) + EPS);
    uint2* o = (uint2*)(H + (size_t)row * DM) + lane;
#pragma unroll
    for (int j = 0; j < 4; ++j) { const float4 gg = ((const float4*)g)[lane + 64 * j];
        uint2 w; w.x = pg8::pk2bf(v[j].x * rstd * gg.x, v[j].y * rstd * gg.y); w.y = pg8::pk2bf(v[j].z * rstd * gg.z, v[j].w * rstd * gg.w); o[64 * j] = w; }
}
typedef unsigned u32x4p __attribute__((ext_vector_type(4)));
__device__ __forceinline__ void ph_x_row(const float* __restrict__ x, bf16* __restrict__ XB, unsigned long long* __restrict__ ssq, int row, int lane) {
    const float4* xr = (const float4*)(x + (size_t)row * DM) + lane;
    float4 v[4]; float s = 0.f;
#pragma unroll
    for (int j = 0; j < 4; ++j) { v[j] = xr[64 * j]; s += v[j].x * v[j].x + v[j].y * v[j].y + v[j].z * v[j].z + v[j].w * v[j].w; }
    s = wave_sum(s);
    uint2* o = (uint2*)(XB + (size_t)row * DM) + lane;
#pragma unroll
    for (int j = 0; j < 4; ++j) { uint2 w; w.x = pg8::cvtpk_bf16(v[j].x, v[j].y); w.y = pg8::cvtpk_bf16(v[j].z, v[j].w); o[64 * j] = w; }
    if (lane == 0) ssq[row] = (unsigned long long)(s * 1048576.0f + 0.5f);
}
__device__ __forceinline__ void ph_prep(bf16* __restrict__ P, const float* __restrict__ tab, const float* __restrict__ moba_g, const float* __restrict__ nsa_qg, const float* __restrict__ nsa_kg,
                                        float* __restrict__ kmean, int item, bool act, int t, float* red  ) {
    const int lane = t & 63, wid = t >> 6, tb = item % 128, kind = item / 128, rg = lane >> 3, dch = lane & 7;
    if (act) {
        int col; const float* g; bool rope;
        if (kind < 4) { col = C_BQ + kind * 64; g = moba_g; rope = true; }
        else if (kind < 8) { col = C_BK + (kind - 4) * 64; g = moba_g + 64; rope = true; }
        else if (kind < 12) { col = C_NQ + (kind - 8) * 64; g = nsa_qg; rope = false; }
        else if (kind == 12) { col = C_NKS; g = nsa_kg + 64; rope = true; }
        else { col = C_NKW; g = nsa_kg + 128; rope = true; }
        float gd[8];
#pragma unroll
        for (int e = 0; e < 8; ++e) gd[e] = g[dch * 8 + e];
        const int row0 = tb * 256 + wid * 64 + rg;
        u32x4p raw[8];
#pragma unroll
        for (int it = 0; it < 8; ++it) raw[it] = *(const u32x4p*)(P + (size_t)(row0 + it * 8) * DINP + col + dch * 8);
        float ks[8];
#pragma unroll
        for (int e = 0; e < 8; ++e) ks[e] = 0.f;
#pragma unroll
        for (int it = 0; it < 8; ++it) {
            const int row = row0 + it * 8, pos = row & (SEQ - 1);
            float y[8]; float ss = 0.f;
#pragma unroll
            for (int e = 0; e < 4; ++e) { y[2 * e] = __builtin_bit_cast(float, raw[it][e] << 16); y[2 * e + 1] = __builtin_bit_cast(float, raw[it][e] & 0xffff0000u); ss += y[2 * e] * y[2 * e] + y[2 * e + 1] * y[2 * e + 1]; }
            ss += shx<1>(ss); ss += shx<2>(ss); ss += shx<4>(ss);
            const float rstd = rsqrtf(ss * (1.f / 64.f) + EPS);
#pragma unroll
            for (int e = 0; e < 8; ++e) y[e] *= rstd * gd[e];
            if (rope) {
                float o[8];
#pragma unroll
                for (int e = 0; e < 8; ++e) o[e] = shx<1>(y[e]);
                if (dch < 2) { const float4 c0 = *(const float4*)(tab + pos * 16), c1 = *(const float4*)(tab + pos * 16 + 4), s0 = *(const float4*)(tab + pos * 16 + 8), s1 = *(const float4*)(tab + pos * 16 + 12);
                    const float cs[8] = {c0.x, c0.y, c0.z, c0.w, c1.x, c1.y, c1.z, c1.w}, sn[8] = {s0.x, s0.y, s0.z, s0.w, s1.x, s1.y, s1.z, s1.w};
#pragma unroll
                    for (int e = 0; e < 8; ++e) y[e] = dch ? (y[e] * cs[e] + o[e] * sn[e]) : (y[e] * cs[e] - o[e] * sn[e]); }
            }
            u32x4p w; w[0] = pg8::pk2bf(y[0], y[1]); w[1] = pg8::pk2bf(y[2], y[3]); w[2] = pg8::pk2bf(y[4], y[5]); w[3] = pg8::pk2bf(y[6], y[7]);
            *(u32x4p*)(P + (size_t)row * DINP + col + dch * 8) = w;
#pragma unroll
            for (int e = 0; e < 8; ++e) ks[e] += y[e];
        }
        if (kind >= 4 && kind < 8) {
#pragma unroll
            for (int e = 0; e < 8; ++e) { ks[e] += shx<8>(ks[e]); ks[e] += shx<16>(ks[e]); ks[e] += shx<32>(ks[e]); }
            if (rg == 0) {
#pragma unroll
                for (int e = 0; e < 8; ++e) red[wid * 64 + dch * 8 + e] = ks[e]; }
        }
    }
    __syncthreads();
    if (act && kind >= 4 && kind < 8 && wid == 0) { const float s = red[lane] + red[64 + lane] + red[128 + lane] + red[192 + lane];
        const int b = tb >> 5, n = tb & 31; kmean[(((size_t)b * 4 + (kind - 4)) * 32 + n) * 64 + lane] = s * (1.f / 256.f); }
    __syncthreads();
}
__device__ __forceinline__ void ph_compress(const bf16* __restrict__ P, const float* __restrict__ pe, const float* __restrict__ w1, const float* __restrict__ w2, const float* __restrict__ kg0,
                                            float* __restrict__ KVc, bf16* __restrict__ KVcb, int item, bool act, int t, float* sm  ) {
    float* in = sm; float* hid = sm + 2048;
    const int i = item % NCMP, b = (item / NCMP) & 3, kv = item / (NCMP * 4);
    const int col = kv ? C_NVC : C_NKC;
    if (act) for (int e = t; e < 2048; e += 256) { const int p = e >> 6, d = e & 63; in[e] = bf2f(P[(size_t)(b * SEQ + 16 * i + p) * DINP + col + d]) + pe[(kv * 32 + p) * 64 + d]; }
    __syncthreads();
    if (act && t < 128) { const float* w = w1 + (size_t)kv * 2048 * 128 + t; float a = 0.f;
#pragma unroll 8
        for (int k = 0; k < 2048; ++k) a = fmaf(in[k], w[(size_t)k * 128], a);
        hid[t] = a * rcpf_(1.f + __expf(-a)); }
    __syncthreads();
    if (act && t < 64) { const float* ww = w2 + (size_t)kv * 128 * 64 + t; float o = 0.f;
#pragma unroll 8
        for (int j = 0; j < 128; ++j) o = fmaf(hid[j], ww[j * 64], o);
        if (kv == 0) { const float ss = wave_sum(o * o); o = o * rsqrtf(ss * (1.f / 64.f) + EPS) * kg0[t]; }
        KVc[(((size_t)kv * NB + b) * 512 + i) * 64 + t] = o; KVcb[(((size_t)kv * NB + b) * 512 + i) * 64 + t] = f2bf(o);
        if (i == NCMP - 1) KVcb[(((size_t)kv * NB + b) * 512 + NCMP) * 64 + t] = 0; }
    __syncthreads();
}
__device__ __forceinline__ float conv_silu(const bf16* __restrict__ P, const float* __restrict__ cw  , int rowbase, int t, int c) {
    float a = 0.f;
#pragma unroll
    for (int j = 0; j < 4; ++j) { const int tt = t - 3 + j; if (tt >= 0) a = fmaf(cw[j * 1024 + c], bf2f(P[(size_t)(rowbase + tt) * DINP + c]), a); }
    return a * rcpf_(1.f + __expf(-a));
}
__device__ __forceinline__ void ph_mlstm_local(const bf16* __restrict__ P, const float* __restrict__ G, const float* __restrict__ cw, const float* __restrict__ bif,
                                               float* __restrict__ Cst, float* __restrict__ nst, float* __restrict__ dec, int u, bool act, int tid, unsigned char* sm) {
    bf16 (*ks)[128] = (bf16 (*)[128])sm; bf16 (*vs)[128] = (bf16 (*)[128])(sm + 16384); float* wS = (float*)(sm + 32768); float* lf = wS + 64;
    const int c = u & 127, h = (u >> 7) & 3, b = u >> 9;
    const int rowbase = b * SEQ, t0 = c * 64;
    if (act) {
        for (int e = tid; e < 64 * 128; e += 256) { const int s = e >> 7, d = e & 127;
            ks[s][d] = f2bf(conv_silu(P, cw, rowbase, t0 + s, 512 + h * 128 + d) * 0.08838834764831845f);
            vs[s][d] = P[(size_t)(rowbase + t0 + s) * DINP + C_MV + h * 128 + d]; }
        if (tid < 64) lf[tid] = log_sigmoidf_(G[(size_t)(rowbase + t0 + tid) * 32 + 4 + h] + bif[4 + h]);
    }
    __syncthreads();
    if (act && tid == 0) { float acc = 0.f;
        for (int s = 0; s < 64; ++s) { acc += lf[s]; lf[s] = acc; }
        dec[u] = __expf(acc); }
    __syncthreads();
    if (act && tid < 64) wS[tid] = __expf(lf[63] - lf[tid] + G[(size_t)(rowbase + t0 + tid) * 32 + h] + bif[h]);
    __syncthreads();
    if (act) {
        const int d = tid >> 1, e0 = (tid & 1) * 64;
        float acc[64];
#pragma unroll
        for (int e = 0; e < 64; ++e) acc[e] = 0.f;
        float an = 0.f;
        for (int s = 0; s < 64; ++s) { const float kw = wS[s] * bf2f(ks[s][d]); an += kw;
#pragma unroll
            for (int e = 0; e < 64; ++e) acc[e] = fmaf(kw, bf2f(vs[s][e0 + e]), acc[e]); }
        float* o = Cst + ((size_t)u * 128 + d) * 128 + e0;
#pragma unroll
        for (int e = 0; e < 64; ++e) o[e] = acc[e];
        if ((tid & 1) == 0) nst[(size_t)u * 128 + d] = an;
    }
    __syncthreads();
}
__device__ __forceinline__ void ph_mlstm_scan(float* __restrict__ Cst, float* __restrict__ nst, const float* __restrict__ dec, int item, int tid) {
    const int bh = item / 65, part = item % 65;
    float* base; int stride;
    if (part < 64) { base = Cst + (size_t)bh * 128 * 16384 + part * 256 + tid; stride = 16384; }
    else { if (tid >= 128) return; base = nst + (size_t)bh * 128 * 128 + tid; stride = 128; }
    float C = 0.f;
    for (int c = 0; c < 128; ++c) { const float dC = base[(size_t)c * stride]; base[(size_t)c * stride] = C; C = dec[bh * 128 + c] * C + dC; }
}
__device__ __forceinline__ void ph_mlstm_out(const bf16* __restrict__ P, const float* __restrict__ G, const float* __restrict__ cw, const float* __restrict__ bif,
                                             const float* __restrict__ Cst, const float* __restrict__ nst, const float* __restrict__ mnorm, bf16* __restrict__ MIX, int u, bool act, int tid, unsigned char* sm) {
    bf16 (*qs)[128] = (bf16 (*)[128])sm; float* ksS = (float*)(sm + 16384); bf16 (*ks)[128] = (bf16 (*)[128])ksS; bf16 (*vs)[128] = (bf16 (*)[128])(sm + 32768);
    float* bb = (float*)(sm + 49152); float* li = bb + 64;
    const int c = u & 127, h = (u >> 7) & 3, b = u >> 9;
    const int rowbase = b * SEQ, t0 = c * 64;
    if (act) {
        for (int e = tid; e < 64 * 128; e += 256) { const int s = e >> 7, d = e & 127;
            qs[s][d] = f2bf(conv_silu(P, cw, rowbase, t0 + s, h * 128 + d));
            ks[s][d] = f2bf(conv_silu(P, cw, rowbase, t0 + s, 512 + h * 128 + d) * 0.08838834764831845f);
            vs[s][d] = P[(size_t)(rowbase + t0 + s) * DINP + C_MV + h * 128 + d]; }
        if (tid < 64) { bb[tid] = log_sigmoidf_(G[(size_t)(rowbase + t0 + tid) * 32 + 4 + h] + bif[4 + h]); li[tid] = G[(size_t)(rowbase + t0 + tid) * 32 + h] + bif[h]; }
    }
    __syncthreads();
    if (act && tid == 0) { float acc = 0.f; for (int s = 0; s < 64; ++s) { acc += bb[s]; bb[s] = acc; } }
    __syncthreads();
    const int t = tid >> 2, part = tid & 3;
    float sreg[16];
    if (act) {
        const int s0 = part * 16;
#pragma unroll
        for (int j = 0; j < 16; ++j) { const int s = s0 + j; float a = 0.f;
            if (s <= t) { for (int d = 0; d < 128; ++d) a = fmaf(bf2f(qs[t][d]), bf2f(ks[s][d]), a); a *= __expf(bb[t] - bb[s] + li[s]); }
            sreg[j] = a; }
    }
    __syncthreads();
    float* S = ksS;
    if (act) {
#pragma unroll
        for (int j = 0; j < 16; ++j) S[t * 64 + part * 16 + j] = sreg[j];
    }
    __syncthreads();
    if (act) {
        const float Ft = __expf(bb[t]);
        float den = 0.f;
        for (int s = 0; s <= t; ++s) den += S[t * 64 + s];
        { const float* np = nst + (size_t)u * 128; float a = 0.f; for (int d = 0; d < 128; ++d) a = fmaf(bf2f(qs[t][d]), np[d], a); den += Ft * a; }
        const int e0 = part * 32;
        float acc[32];
#pragma unroll
        for (int e = 0; e < 32; ++e) acc[e] = 0.f;
        { const float* Cp = Cst + (size_t)u * 16384 + e0;
          for (int d = 0; d < 128; ++d) { const float qd = bf2f(qs[t][d]);
#pragma unroll
              for (int e = 0; e < 32; ++e) acc[e] = fmaf(qd, Cp[d * 128 + e], acc[e]); } }
#pragma unroll
        for (int e = 0; e < 32; ++e) acc[e] *= Ft;
        for (int s = 0; s <= t; ++s) { const float w = S[t * 64 + s];
#pragma unroll
            for (int e = 0; e < 32; ++e) acc[e] = fmaf(w, bf2f(vs[s][e0 + e]), acc[e]); }
        const float inv = rcpf_(fmaxf(fabsf(den), 1.f));
        float ss = 0.f;
#pragma unroll
        for (int e = 0; e < 32; ++e) { acc[e] *= inv; ss += acc[e] * acc[e]; }
        ss += shx<1>(ss); ss += shx<2>(ss);
        const float rstd = rsqrtf(ss * (1.f / 128.f) + EPS);
        const size_t row = (size_t)(rowbase + t0 + t);
#pragma unroll
        for (int e = 0; e < 32; ++e) { const int cc = h * 128 + e0 + e;
            const float o = sigmoidf_(bf2f(P[row * DINP + C_MO + cc]));
            MIX[row * DM + cc] = f2bf(acc[e] * rstd * mnorm[cc] * o); }
    }
    __syncthreads();
}

__device__ __forceinline__ void ph_moba(const bf16* __restrict__ P, const float* __restrict__ kmean, bf16* __restrict__ MIX, int gw, int lane, float* q) {
    const int bh = gw >> 13, tq = gw & (SEQ - 1), b = bh >> 2, h = bh & 3, own = tq >> 8;
    const size_t row = (size_t)b * SEQ + tq;
    __builtin_amdgcn_s_waitcnt(0); __builtin_amdgcn_wave_barrier();
    q[lane] = bf2f(P[row * DINP + C_BQ + h * 64 + lane]);
    __builtin_amdgcn_s_waitcnt(0); __builtin_amdgcn_wave_barrier();
    float gs = -3.0e38f;
    if (lane < 32) { if (lane < own) { const float* km = kmean + (((size_t)b * 4 + h) * 32 + lane) * 64; float a = 0.f; for (int d = 0; d < 64; ++d) a = fmaf(q[d], km[d], a); gs = a; } else gs = -1e30f; }
    int blk[4]; bool val[4];
#pragma unroll
    for (int r = 0; r < 3; ++r) { const float m = wave_max(gs); const unsigned long long bal = __ballot(gs == m); const int idx = __ffsll((long long)bal) - 1;
        blk[r] = idx; val[r] = (r < own); if (lane == idx) gs = -3.0e38f; }
    blk[3] = own; val[3] = true;
    float s[4][4]; float mx = -1e30f;
#pragma unroll
    for (int g = 0; g < 4; ++g)
#pragma unroll
        for (int i = 0; i < 4; ++i) { float a = -1e30f;
            if (val[g]) { const int pos = blk[g] * 256 + i * 64 + lane;
                if (g < 3 || pos <= tq) { const bf16* kp = P + ((size_t)b * SEQ + pos) * DINP + C_BK + h * 64; a = dot64(kp, q) * 0.125f; } }
            s[g][i] = a; mx = fmaxf(mx, a); }
    mx = wave_max(mx);
    float l = 0.f;
#pragma unroll
    for (int g = 0; g < 4; ++g)
#pragma unroll
        for (int i = 0; i < 4; ++i) { const float p = (s[g][i] > -1e29f) ? __expf(s[g][i] - mx) : 0.f; s[g][i] = p; l += p; }
    l = wave_sum(l);
    float o = 0.f;
#pragma unroll
    for (int g = 0; g < 4; ++g) { if (!val[g]) continue;
#pragma unroll
        for (int i = 0; i < 4; ++i) { const bf16* vp = P + ((size_t)b * SEQ + blk[g] * 256 + i * 64) * DINP + C_BV + h * 64 + lane;
            for (int src = 0; src < 64; ++src) { const float p = __shfl(s[g][i], src); o = fmaf(p, bf2f(vp[(size_t)src * DINP]), o); } } }
    MIX[row * DM + 512 + h * 64 + lane] = f2bf(o * rcpf_(l));
}

__device__ __forceinline__ void ph_nsa(const bf16* __restrict__ P, const float* __restrict__ G, const float* __restrict__ tab, const float* __restrict__ KVc, bf16* __restrict__ MIX, int gw, int lane, float* sm) {
    float (*qn)[64] = (float (*)[64])sm; float (*qr)[64] = (float (*)[64])(sm + 256); float* ps = sm + 512;
    const int b = gw >> 13, tq = gw & (SEQ - 1), blkq = tq >> 6;
    const size_t row = (size_t)b * SEQ + tq;
    __builtin_amdgcn_s_waitcnt(0); __builtin_amdgcn_wave_barrier();
#pragma unroll
    for (int h = 0; h < 4; ++h) { const float x = bf2f(P[row * DINP + C_NQ + h * 64 + lane]); qn[h][lane] = x;
        float y = x; const float other = shx<8>(x);
        if (lane < 16) { const int f = lane & 7; const float c = tab[tq * 16 + f], s = tab[tq * 16 + 8 + f]; y = (lane < 8) ? (x * c - other * s) : (x * c + other * s); }
        qr[h][lane] = y; }
    __builtin_amdgcn_s_waitcnt(0); __builtin_amdgcn_wave_barrier();
    const float* Kc = KVc + (size_t)b * 512 * 64; const float* Vc = KVc + ((size_t)NB + b) * 512 * 64;
    float out[4] = {0.f, 0.f, 0.f, 0.f};
    float gate[3][4];
#pragma unroll
    for (int br = 0; br < 3; ++br)
#pragma unroll
        for (int h = 0; h < 4; ++h) gate[br][h] = sigmoidf_(G[row * 32 + 8 + br * 4 + h]);
    const int ncv = (tq >= 31) ? ((tq - 31) >> 4) + 1 : 0;
    {
        float sc[8][4]; float mx[4] = {-1e30f, -1e30f, -1e30f, -1e30f};
#pragma unroll
        for (int i = 0; i < 8; ++i) { const int c = i * 64 + lane;
            float a[4] = {-1e30f, -1e30f, -1e30f, -1e30f};
            if (c < ncv) { const float* kp = Kc + (size_t)c * 64; a[0] = a[1] = a[2] = a[3] = 0.f;
                for (int d = 0; d < 64; ++d) { const float kd = kp[d]; a[0] = fmaf(qn[0][d], kd, a[0]); a[1] = fmaf(qn[1][d], kd, a[1]); a[2] = fmaf(qn[2][d], kd, a[2]); a[3] = fmaf(qn[3][d], kd, a[3]); }
#pragma unroll
                for (int h = 0; h < 4; ++h) a[h] *= 0.125f; }
#pragma unroll
            for (int h = 0; h < 4; ++h) { sc[i][h] = a[h]; mx[h] = fmaxf(mx[h], a[h]); } }
        float l[4];
#pragma unroll
        for (int h = 0; h < 4; ++h) { mx[h] = wave_max(mx[h]); l[h] = 0.f; }
#pragma unroll
        for (int i = 0; i < 8; ++i) { const int c = i * 64 + lane;
#pragma unroll
            for (int h = 0; h < 4; ++h) { const float p = (c < ncv) ? __expf(sc[i][h] - mx[h]) : 0.f; sc[i][h] = p; l[h] += p; } }
#pragma unroll
        for (int h = 0; h < 4; ++h) { l[h] = wave_sum(l[h]); l[h] = (l[h] > 0.f) ? rcpf_(l[h]) : 0.f; }
#pragma unroll
        for (int i = 0; i < 8; ++i) { float su = 0.f;
#pragma unroll
            for (int h = 0; h < 4; ++h) { sc[i][h] *= l[h]; su += sc[i][h]; }
            ps[i * 64 + lane] = su; }
        if (lane < 4) ps[512 + lane] = 0.f;
        float oc[4] = {0.f, 0.f, 0.f, 0.f};
#pragma unroll
        for (int i = 0; i < 8; ++i) { if (i * 64 >= ncv) break; const int nn = min(64, ncv - i * 64);
            for (int src = 0; src < nn; ++src) { const float v = Vc[(size_t)(i * 64 + src) * 64 + lane];
                oc[0] = fmaf(__shfl(sc[i][0], src), v, oc[0]); oc[1] = fmaf(__shfl(sc[i][1], src), v, oc[1]);
                oc[2] = fmaf(__shfl(sc[i][2], src), v, oc[2]); oc[3] = fmaf(__shfl(sc[i][3], src), v, oc[3]); } }
#pragma unroll
        for (int h = 0; h < 4; ++h) out[h] = gate[0][h] * oc[h];
    }
    __builtin_amdgcn_s_waitcnt(0); __builtin_amdgcn_wave_barrier();
    int sidx[16];
    {
        float v0, v1;
        { const int n = lane; float im = 0.f;
#pragma unroll
          for (int j = -1; j < 4; ++j) { const int c = 4 * n + j; if (c >= 0 && c < NCMP) im += ps[c]; }
          const bool causal = n <= blkq, forced = causal && (n == 0 || n >= blkq - 1);
          v0 = forced ? 1e9f : (causal ? im : -1e30f); }
        { const int n = lane + 64; float im = 0.f;
#pragma unroll
          for (int j = -1; j < 4; ++j) { const int c = 4 * n + j; if (c >= 0 && c < NCMP) im += ps[c]; }
          const bool causal = n <= blkq, forced = causal && (n == 0 || n >= blkq - 1);
          v1 = forced ? 1e9f : (causal ? im : -1e30f); }
#pragma unroll
        for (int k = 0; k < 16; ++k) { const float m = wave_max(fmaxf(v0, v1));
            const unsigned long long b0 = __ballot(v0 == m); int idx;
            if (b0) { idx = __ffsll((long long)b0) - 1; if (lane == idx) v0 = -3.0e38f; }
            else { const unsigned long long b1 = __ballot(v1 == m); idx = __ffsll((long long)b1) - 1; if (lane == idx) v1 = -3.0e38f; idx += 64; }
            sidx[k] = idx; }
    }
    {
        float sc[16][4]; float mx[4] = {-1e30f, -1e30f, -1e30f, -1e30f};
#pragma unroll
        for (int k = 0; k < 16; ++k) { const int n = sidx[k], pos = n * 64 + lane;
            float a[4] = {-1e30f, -1e30f, -1e30f, -1e30f};
            if (n <= blkq && pos <= tq) { const bf16* kp = P + ((size_t)b * SEQ + pos) * DINP + C_NKS; dot64x4(kp, qr, a);
#pragma unroll
                for (int h = 0; h < 4; ++h) a[h] *= 0.125f; }
#pragma unroll
            for (int h = 0; h < 4; ++h) { sc[k][h] = a[h]; mx[h] = fmaxf(mx[h], a[h]); } }
        float l[4];
#pragma unroll
        for (int h = 0; h < 4; ++h) { mx[h] = wave_max(mx[h]); l[h] = 0.f; }
#pragma unroll
        for (int k = 0; k < 16; ++k)
#pragma unroll
            for (int h = 0; h < 4; ++h) { const float p = (sc[k][h] > -1e29f) ? __expf(sc[k][h] - mx[h]) : 0.f; sc[k][h] = p; l[h] += p; }
#pragma unroll
        for (int h = 0; h < 4; ++h) l[h] = rcpf_(wave_sum(l[h]));
        float os[4] = {0.f, 0.f, 0.f, 0.f};
#pragma unroll
        for (int k = 0; k < 16; ++k) { const int n = sidx[k]; if (n > blkq) continue;
            const bf16* vp = P + ((size_t)b * SEQ + n * 64) * DINP + C_NVS + lane;
            for (int src = 0; src < 64; ++src) { const float v = bf2f(vp[(size_t)src * DINP]);
                os[0] = fmaf(__shfl(sc[k][0], src), v, os[0]); os[1] = fmaf(__shfl(sc[k][1], src), v, os[1]);
                os[2] = fmaf(__shfl(sc[k][2], src), v, os[2]); os[3] = fmaf(__shfl(sc[k][3], src), v, os[3]); } }
#pragma unroll
        for (int h = 0; h < 4; ++h) out[h] += gate[1][h] * os[h] * l[h];
    }
    {
        float sc[8][4]; float mx[4] = {-1e30f, -1e30f, -1e30f, -1e30f};
#pragma unroll
        for (int i = 0; i < 8; ++i) { const int pos = tq - 511 + i * 64 + lane;
            float a[4] = {-1e30f, -1e30f, -1e30f, -1e30f};
            if (pos >= 0) { const bf16* kp = P + ((size_t)b * SEQ + pos) * DINP + C_NKW; dot64x4(kp, qr, a);
#pragma unroll
                for (int h = 0; h < 4; ++h) a[h] *= 0.125f; }
#pragma unroll
            for (int h = 0; h < 4; ++h) { sc[i][h] = a[h]; mx[h] = fmaxf(mx[h], a[h]); } }
        float l[4];
#pragma unroll
        for (int h = 0; h < 4; ++h) { mx[h] = wave_max(mx[h]); l[h] = 0.f; }
#pragma unroll
        for (int i = 0; i < 8; ++i)
#pragma unroll
            for (int h = 0; h < 4; ++h) { const float p = (sc[i][h] > -1e29f) ? __expf(sc[i][h] - mx[h]) : 0.f; sc[i][h] = p; l[h] += p; }
#pragma unroll
        for (int h = 0; h < 4; ++h) l[h] = rcpf_(wave_sum(l[h]));
        float ow[4] = {0.f, 0.f, 0.f, 0.f};
#pragma unroll
        for (int i = 0; i < 8; ++i) { const int p0 = tq - 511 + i * 64; if (p0 + 63 < 0) continue;
            const int s0 = p0 < 0 ? -p0 : 0;
            for (int src = s0; src < 64; ++src) { const float v = bf2f(P[((size_t)b * SEQ + p0 + src) * DINP + C_NVW + lane]);
                ow[0] = fmaf(__shfl(sc[i][0], src), v, ow[0]); ow[1] = fmaf(__shfl(sc[i][1], src), v, ow[1]);
                ow[2] = fmaf(__shfl(sc[i][2], src), v, ow[2]); ow[3] = fmaf(__shfl(sc[i][3], src), v, ow[3]); } }
#pragma unroll
        for (int h = 0; h < 4; ++h) out[h] += gate[2][h] * ow[h] * l[h];
    }
#pragma unroll
    for (int h = 0; h < 4; ++h) MIX[row * DM + 768 + h * 64 + lane] = f2bf(out[h]);
}


#define LAS __attribute__((address_space(3)))
typedef short bf16x8 __attribute__((ext_vector_type(8)));
typedef float f32x16 __attribute__((ext_vector_type(16)));
typedef short s16x4 __attribute__((ext_vector_type(4)));
typedef unsigned u32x4v __attribute__((ext_vector_type(4)));
typedef float f32x2_t __attribute__((ext_vector_type(2)));
typedef __bf16 bf16x2_t __attribute__((ext_vector_type(2)));
constexpr int KROW = 144, VROW = 192;
constexpr int KBUF = 64 * KROW, VBUF = 64 * VROW, STG = KBUF + VBUF;
constexpr float SCL2 = 0.125f * 1.4426950408889634f;
constexpr float NEGBIG = -1e30f;

__device__ __forceinline__ unsigned cvtpk(float lo, float hi) { f32x2_t v = {lo, hi}; bf16x2_t b = __builtin_convertvector(v, bf16x2_t); return __builtin_bit_cast(unsigned, b); }
__device__ __forceinline__ int crow(int r, int hi) { return (r & 3) + 8 * (r >> 2) + 4 * hi; }
__device__ __forceinline__ s16x4 lds_tr(LAS const unsigned char* p) { return __builtin_bit_cast(s16x4, __builtin_amdgcn_ds_read_tr16_b64_v4i16((LAS s16x4*)p)); }

__device__ __forceinline__ bf16x8 scale_frag(bf16x8 v, float s) {
    const u32x4v w = __builtin_bit_cast(u32x4v, v); u32x4v o;
#pragma unroll
    for (int e = 0; e < 4; ++e) o[e] = cvtpk(__builtin_bit_cast(float, w[e] << 16) * s, __builtin_bit_cast(float, w[e] & 0xffff0000u) * s);
    return __builtin_bit_cast(bf16x8, o);
}
struct TileSrc { const bf16* k; const bf16* v; int stride; };
__device__ __forceinline__ void tile_load(u32x4v& kr, u32x4v& vr, const TileSrc& s, int t) {
    const int key = t >> 3, ch = t & 7;
    kr = *(const u32x4v*)(s.k + (size_t)key * s.stride + ch * 8); vr = *(const u32x4v*)(s.v + (size_t)key * s.stride + ch * 8);
}
__device__ __forceinline__ void tile_store(LAS unsigned char* buf, const u32x4v& kr, const u32x4v& vr, int t) {
    const int key = t >> 3, ch = t & 7;
    *(LAS u32x4v*)(buf + key * KROW + ch * 16) = kr; *(LAS u32x4v*)(buf + KBUF + key * VROW + ch * 16) = vr;
}
__device__ __forceinline__ void qk_tile(f32x16& p0, f32x16& p1, LAS const unsigned char* kb, const bf16x8 (&qf)[4], int r32, int hi, float cinit) {
    float ci = cinit; asm volatile("" : "+v"(ci));
#pragma unroll
    for (int r = 0; r < 16; ++r) { p0[r] = ci; p1[r] = ci; }
    LAS const unsigned char* a = kb + r32 * KROW + hi * 16;
#pragma unroll
    for (int ks = 0; ks < 4; ++ks) {
        const bf16x8 a0 = *(LAS const bf16x8*)(a + ks * 32), a1 = *(LAS const bf16x8*)(a + 32 * KROW + ks * 32);
        p0 = __builtin_amdgcn_mfma_f32_32x32x16_bf16(a0, qf[ks], p0, 0, 0, 0);
        p1 = __builtin_amdgcn_mfma_f32_32x32x16_bf16(a1, qf[ks], p1, 0, 0, 0);
    }
}
__device__ __forceinline__ void pv_tile(f32x16& o0, f32x16& o1, LAS const unsigned char* vb, const f32x16& p0, const f32x16& p1, int lane) {
    const int g = lane >> 4, i = lane & 15, hi = lane >> 5;
    LAS const unsigned char* base = vb + (4 * hi + (i >> 2)) * VROW + (16 * (g & 1) + 4 * (i & 3)) * 2;
#pragma unroll
    for (int s = 0; s < 4; ++s) {
        unsigned w[4];
#pragma unroll
        for (int e = 0; e < 4; ++e) { const int r = 8 * (s & 1) + 2 * e; w[e] = (s < 2) ? cvtpk(p0[r], p0[r + 1]) : cvtpk(p1[r], p1[r + 1]); }
        const u32x4v wv = {w[0], w[1], w[2], w[3]};
        const bf16x8 pf = __builtin_bit_cast(bf16x8, wv);
#pragma unroll
        for (int mb = 0; mb < 2; ++mb) {
            const s16x4 lo = lds_tr(base + s * 16 * VROW + mb * 64), hi4 = lds_tr(base + s * 16 * VROW + 8 * VROW + mb * 64);
            const bf16x8 vt = {lo[0], lo[1], lo[2], lo[3], hi4[0], hi4[1], hi4[2], hi4[3]};
            if (mb == 0) o0 = __builtin_amdgcn_mfma_f32_32x32x16_bf16(vt, pf, o0, 0, 0, 0);
            else o1 = __builtin_amdgcn_mfma_f32_32x32x16_bf16(vt, pf, o1, 0, 0, 0);
        }
    }
}
constexpr float SM_THR = 8.0f;
__device__ __forceinline__ void softmax_tile(f32x16& p0, f32x16& p1, f32x16& o0, f32x16& o1, float& mref, float& l, bool first) {
    float a = __builtin_fmaxf(__builtin_fmaxf(p0[0], p0[1]), p1[0]), b = __builtin_fmaxf(__builtin_fmaxf(p0[2], p0[3]), p1[1]);
    a = __builtin_fmaxf(__builtin_fmaxf(a, p1[2]), p1[3]);
#pragma unroll
    for (int r = 4; r < 16; r += 4) { a = __builtin_fmaxf(__builtin_fmaxf(a, p0[r]), p0[r + 1]); b = __builtin_fmaxf(__builtin_fmaxf(b, p0[r + 2]), p0[r + 3]);
        a = __builtin_fmaxf(__builtin_fmaxf(a, p1[r]), p1[r + 1]); b = __builtin_fmaxf(__builtin_fmaxf(b, p1[r + 2]), p1[r + 3]); }
    float rm = __builtin_fmaxf(a, b);
    { auto rr = __builtin_amdgcn_permlane32_swap(__float_as_uint(rm), __float_as_uint(rm), false, false); rm = __builtin_fmaxf(__uint_as_float(rr[0]), __uint_as_float(rr[1])); }
    if (first || __any(rm > SM_THR)) {
        const float dl = first ? rm : __builtin_fmaxf(rm, 0.f);
        mref += dl;
        const float f = __builtin_amdgcn_exp2f(-dl);
        l *= f;
#pragma unroll
        for (int r = 0; r < 16; ++r) { p0[r] -= dl; p1[r] -= dl; o0[r] *= f; o1[r] *= f; }
    }
    float s0 = 0.f, s1 = 0.f;
#pragma unroll
    for (int r = 0; r < 16; ++r) { p0[r] = __builtin_amdgcn_exp2f(p0[r]); p1[r] = __builtin_amdgcn_exp2f(p1[r]); s0 += p0[r]; s1 += p1[r]; }
    l += s0 + s1;
}


constexpr int PV_OFF = 2 * KBUF, PIPE_BYTES = 2 * KBUF + 2 * VBUF;
__device__ __forceinline__ void k_store(LAS unsigned char* lds, int slot, const u32x4v& kr, int t) { *(LAS u32x4v*)(lds + slot * KBUF + (t >> 3) * KROW + (t & 7) * 16) = kr; }
__device__ __forceinline__ void v_store(LAS unsigned char* lds, int voff, const u32x4v& vr, int t) { *(LAS u32x4v*)(lds + PV_OFF + voff + (t >> 3) * VROW + (t & 7) * 16) = vr; }
__device__ __forceinline__ u32x4v kv_load(const bf16* base, int stride, int t) { return *(const u32x4v*)(base + (size_t)(t >> 3) * stride + (t & 7) * 8); }
__device__ __forceinline__ void pv_frag(f32x16& o0, f32x16& o1, LAS const unsigned char* vb, const bf16x8 (&pf)[4], int lane) {
    const int g = lane >> 4, i = lane & 15, hi = lane >> 5;
    LAS const unsigned char* base = vb + (4 * hi + (i >> 2)) * VROW + (16 * (g & 1) + 4 * (i & 3)) * 2;
#pragma unroll
    for (int s = 0; s < 4; ++s)
#pragma unroll
        for (int mb = 0; mb < 2; ++mb) {
            const s16x4 lo = lds_tr(base + s * 16 * VROW + mb * 64), hi4 = lds_tr(base + s * 16 * VROW + 8 * VROW + mb * 64);
            const bf16x8 vt = {lo[0], lo[1], lo[2], lo[3], hi4[0], hi4[1], hi4[2], hi4[3]};
            if (mb == 0) o0 = __builtin_amdgcn_mfma_f32_32x32x16_bf16(vt, pf[s], o0, 0, 0, 0);
            else o1 = __builtin_amdgcn_mfma_f32_32x32x16_bf16(vt, pf[s], o1, 0, 0, 0);
        }
}
__device__ __forceinline__ void exp_pack(f32x16& p0, f32x16& p1, float& l, bf16x8 (&pf)[4]) {
    float s0 = 0.f, s1 = 0.f;
#pragma unroll
    for (int r = 0; r < 16; ++r) { p0[r] = __builtin_amdgcn_exp2f(p0[r]); p1[r] = __builtin_amdgcn_exp2f(p1[r]); s0 += p0[r]; s1 += p1[r]; }
    l += s0 + s1;
#pragma unroll
    for (int s = 0; s < 4; ++s) { u32x4v w;
#pragma unroll
        for (int e = 0; e < 4; ++e) { const int r = 8 * (s & 1) + 2 * e; w[e] = (s < 2) ? cvtpk(p0[r], p0[r + 1]) : cvtpk(p1[r], p1[r + 1]); }
        pf[s] = __builtin_bit_cast(bf16x8, w); }
}
template <class Pol>
__device__ __forceinline__ void attn_step_gen(const Pol& pol, int t, bool doqk, LAS unsigned char* lds, const bf16x8 (&qf)[4], float negm, f32x16& pc0, f32x16& pc1,
                                              f32x16& o0, f32x16& o1, float& l, int tid, int lane, int r32, int hi) {
    const int nt = pol.nt;
    u32x4v kr, vr;
    const bool ldk = (t + 2 < nt), ldv = (t + 1 < nt);
    if (ldk) kr = kv_load(pol.kptr(t + 2), pol.stride, tid);
    if (ldv) vr = kv_load(pol.vptr(t + 1), pol.stride, tid);
    f32x16 pn0, pn1; bf16x8 pf[4];
    if (doqk) { qk_tile(pn0, pn1, lds + ((t + 1) & 1) * KBUF, qf, r32, hi, pol.rowsel(t + 1) ? negm : NEGBIG); pol.mask(t + 1, pn0, pn1); }
    exp_pack(pc0, pc1, l, pf);
    pv_frag(o0, o1, lds + PV_OFF + (t & 1) * VBUF, pf, lane);
    if (ldk) k_store(lds, t & 1, kr, tid);
    if (ldv) v_store(lds, ((t + 1) & 1) * VBUF, vr, tid);
    __syncthreads();
    if (doqk) { pc0 = pn0; pc1 = pn1; }
}
template <class Pol>
__device__ __forceinline__ void attn_step_fast(const Pol& pol, int t, LAS unsigned char* lds, const bf16x8 (&qf)[4], float negm, f32x16& pc0, f32x16& pc1, f32x16& pn0, f32x16& pn1,
                                               f32x16& o0, f32x16& o1, float& l, u32x4v& kld, u32x4v& vld, const u32x4v& kst, const u32x4v& vst,
                                               int tid, int lane, int r32, int hi) {
    const int nt = pol.nt, tk = (t + 3 < nt) ? t + 3 : nt - 1, tv = (t + 2 < nt) ? t + 2 : nt - 1;
    kld = kv_load(pol.kptr(tk), pol.stride, tid); vld = kv_load(pol.vptr(tv), pol.stride, tid);
    bf16x8 pf[4];
    qk_tile(pn0, pn1, lds + ((t + 1) & 1) * KBUF, qf, r32, hi, pol.rowsel(t + 1) ? negm : NEGBIG);
    exp_pack(pc0, pc1, l, pf);
    pv_frag(o0, o1, lds + PV_OFF + (t & 1) * VBUF, pf, lane);
    k_store(lds, t & 1, kst, tid);
    v_store(lds, ((t + 1) & 1) * VBUF, vst, tid);
    __syncthreads();
}
template <class Pol>
__device__ __forceinline__ void attn_pipe(const Pol& pol, LAS unsigned char* lds, const bf16x8 (&qf)[4], float negm, f32x16& o0, f32x16& o1, float& l, int tid) {
    const int lane = tid & 63, r32 = lane & 31, hi = lane >> 5, nt = pol.nt;
    {
        const u32x4v k0 = kv_load(pol.kptr(0), pol.stride, tid), v0 = kv_load(pol.vptr(0), pol.stride, tid);
        u32x4v k1 = k0; if (nt > 1) k1 = kv_load(pol.kptr(1), pol.stride, tid);
        k_store(lds, 0, k0, tid); v_store(lds, 0, v0, tid); if (nt > 1) k_store(lds, 1, k1, tid);
    }
    __syncthreads();
    f32x16 pc0, pc1;
    qk_tile(pc0, pc1, lds, qf, r32, hi, pol.rowsel(0) ? negm : NEGBIG); pol.mask(0, pc0, pc1);
    int t = 0;
    for (; t < nt - 1 && t + 1 < pol.nmask; ++t)
        attn_step_gen(pol, t, true, lds, qf, negm, pc0, pc1, o0, o1, l, tid, lane, r32, hi);
    if (t < nt - 1) {
        const int tk0 = (t + 2 < nt) ? t + 2 : nt - 1;
        u32x4v ka = kv_load(pol.kptr(tk0), pol.stride, tid), va = kv_load(pol.vptr(t + 1), pol.stride, tid), kb, vb;
        f32x16 pd0, pd1;
        for (; t + 1 < nt - 1; t += 2) {
            attn_step_fast(pol, t, lds, qf, negm, pc0, pc1, pd0, pd1, o0, o1, l, kb, vb, ka, va, tid, lane, r32, hi);
            attn_step_fast(pol, t + 1, lds, qf, negm, pd0, pd1, pc0, pc1, o0, o1, l, ka, va, kb, vb, tid, lane, r32, hi);
        }
        if (t < nt - 1) {
            attn_step_fast(pol, t, lds, qf, negm, pc0, pc1, pd0, pd1, o0, o1, l, kb, vb, ka, va, tid, lane, r32, hi);
            pc0 = pd0; pc1 = pd1; ++t;
        }
    }
    attn_step_gen(pol, nt - 1, false, lds, qf, negm, pc0, pc1, o0, o1, l, tid, lane, r32, hi);
}
__device__ __forceinline__ float row_negm(const bf16x8 (&qf)[4], float kmax) {
    float ss = 0.f;
#pragma unroll
    for (int ks = 0; ks < 4; ++ks) { const u32x4v w = __builtin_bit_cast(u32x4v, qf[ks]);
#pragma unroll
        for (int e = 0; e < 4; ++e) { const float a = __builtin_bit_cast(float, w[e] << 16), b = __builtin_bit_cast(float, w[e] & 0xffff0000u); ss += a * a + b * b; } }
    ss += shx<32>(ss);
    return -(__builtin_sqrtf(ss) * kmax);
}
__device__ __forceinline__ float gain_kmax(const float* g, int lane) { return wave_max(fabsf(g[lane])) * (8.0f * 1.02f); }

constexpr int MOBA_KM_OFF = PIPE_BYTES, MOBA_TL_OFF = MOBA_KM_OFF + 32 * 64 * 4, MOBA_UW_OFF = MOBA_TL_OFF + 132 * 4;
struct MobaPol {
    int nt, nmask, stride, own, tq, hi; unsigned selbits; const bf16* Pk; const bf16* Pv; LAS const int* tl;
    __device__ __forceinline__ const bf16* kptr(int i) const { return Pk + (size_t)tl[i] * 64 * DINP; }
    __device__ __forceinline__ const bf16* vptr(int i) const { return Pv + (size_t)tl[i] * 64 * DINP; }
    __device__ __forceinline__ bool rowsel(int i) const { const int blk = tl[i] >> 2; return blk == own || ((selbits >> blk) & 1u); }
    __device__ __forceinline__ void mask_(int i, f32x16& p0, f32x16& p1) const {
        const int tile = tl[i];
        if ((tile >> 2) == own) { const int kbase = tile * 64;
#pragma unroll
            for (int r = 0; r < 16; ++r) { const int k0 = kbase + crow(r, hi); p0[r] = (k0 <= tq) ? p0[r] : NEGBIG; p1[r] = (k0 + 32 <= tq) ? p1[r] : NEGBIG; } }
    }
    __device__ __forceinline__ void mask(int i, f32x16& p0, f32x16& p1) const { mask_(i, p0, p1); }
};
__device__ __forceinline__ void moba_unit(const bf16* __restrict__ P, const float* __restrict__ kmean, const float* __restrict__ kgain, bf16* __restrict__ MIX, int b, int h, int qb, int tid, LAS unsigned char* lds) {
    asm volatile("" : "+v"(tid));
    const int lane = tid & 63, wid = __builtin_amdgcn_readfirstlane(tid >> 6), r32 = lane & 31, hi = lane >> 5;
    LAS float* km = (LAS float*)(lds + MOBA_KM_OFF); LAS int* tl = (LAS int*)(lds + MOBA_TL_OFF); LAS unsigned* uw = (LAS unsigned*)(lds + MOBA_UW_OFF);
    const int own = qb, tq = qb * 256 + wid * 32 + r32;
    const size_t rowq = (size_t)b * SEQ + tq;
    const bf16* Pb = P + (size_t)b * SEQ * DINP;
    bf16x8 qf[4];
#pragma unroll
    for (int ks = 0; ks < 4; ++ks) qf[ks] = *(const bf16x8*)(P + rowq * DINP + C_BQ + h * 64 + ks * 16 + hi * 8);
    const float kmax = gain_kmax(kgain, lane);
    for (int e = tid; e < own * 64; e += 512) km[e] = kmean[(((size_t)b * 4 + h) * 32) * 64 + e];
    __syncthreads();
    unsigned mask = 0u;
    {
        float qv[32];
#pragma unroll
        for (int ks = 0; ks < 4; ++ks)
#pragma unroll
            for (int j = 0; j < 8; ++j) qv[ks * 8 + j] = bf2f((bf16)qf[ks][j]);
        float b0 = -3e38f, b1 = -3e38f, b2 = -3e38f; int i0 = -1, i1 = -1, i2 = -1;
        for (int n = 0; n < own; ++n) {
            LAS const float* kp = km + n * 64 + hi * 8; float a = 0.f;
#pragma unroll
            for (int ks = 0; ks < 4; ++ks)
#pragma unroll
                for (int j = 0; j < 8; ++j) a = fmaf(qv[ks * 8 + j], kp[ks * 16 + j], a);
            a += shx<32>(a);
            if (a > b0) { b2 = b1; i2 = i1; b1 = b0; i1 = i0; b0 = a; i0 = n; }
            else if (a > b1) { b2 = b1; i2 = i1; b1 = a; i1 = n; }
            else if (a > b2) { b2 = a; i2 = n; }
        }
        if (i0 >= 0) mask |= 1u << i0; if (i1 >= 0) mask |= 1u << i1; if (i2 >= 0) mask |= 1u << i2;
    }
    { unsigned um = mask;
      um |= shxu<1>(um); um |= shxu<2>(um); um |= shxu<4>(um); um |= shxu<8>(um); um |= shxu<16>(um); um |= shxu<32>(um);
      if (lane == 0) uw[wid] = um; }
    __syncthreads();
    if (tid == 0) { unsigned um = 0u; for (int w = 0; w < 8; ++w) um |= uw[w];
        int cnt = 0; for (int s = 0; s < 4; ++s) tl[cnt++] = own * 4 + s;
        for (int n = 0; n < own; ++n) if ((um >> n) & 1u) for (int s = 0; s < 4; ++s) tl[cnt++] = n * 4 + s;
        tl[131] = cnt; }
    __syncthreads();
#pragma unroll
    for (int ks = 0; ks < 4; ++ks) qf[ks] = scale_frag(qf[ks], SCL2);
    f32x16 o0, o1;
#pragma unroll
    for (int r = 0; r < 16; ++r) { o0[r] = zf_(); o1[r] = o0[r]; }
    float l = 0.f;
    MobaPol pol; pol.nt = tl[131]; pol.nmask = 4; pol.stride = DINP; pol.own = own; pol.tq = tq; pol.hi = hi; pol.selbits = mask; pol.Pk = Pb + C_BK + h * 64; pol.Pv = Pb + C_BV + h * 64; pol.tl = tl;
    attn_pipe(pol, lds, qf, row_negm(qf, kmax), o0, o1, l, tid);
    l += shx<32>(l);
    const float inv = rcpf_(l);
    bf16* op = MIX + rowq * DM + 512 + h * 64 + 4 * hi;
#pragma unroll
    for (int g = 0; g < 4; ++g) {
        uint2 w0, w1;
        w0.x = cvtpk(o0[4 * g] * inv, o0[4 * g + 1] * inv); w0.y = cvtpk(o0[4 * g + 2] * inv, o0[4 * g + 3] * inv);
        w1.x = cvtpk(o1[4 * g] * inv, o1[4 * g + 1] * inv); w1.y = cvtpk(o1[4 * g + 2] * inv, o1[4 * g + 3] * inv);
        *(uint2*)(op + 8 * g) = w0; *(uint2*)(op + 32 + 8 * g) = w1;
    }
}

constexpr int NSA_S4_OFF = PIPE_BYTES, NSA_L4_OFF = NSA_S4_OFF + 8 * 8 * 128 * 4, NSA_SM_OFF = NSA_L4_OFF + 8 * 8 * 128 * 4;
struct NsaCtx { const bf16* Pb; const bf16* Kcb; const bf16* Vcb; int b, jq, tid, lane, wid, r32, hi, tq; unsigned mk0, mk1, mk2, mk3; };

template <int MODE>
__device__ __forceinline__ void nsa_tiles(const NsaCtx& c, LAS unsigned char* lds, const bf16x8 (&qf)[4], int nt, f32x16& o0, f32x16& o1, float& m, float& l, float pre) {
    const int tid = c.tid, lane = c.lane, r32 = c.r32, hi = c.hi, tq = c.tq, jq = c.jq;
    const int nw = (jq < 8 ? jq : 8) + 1;
    auto tile_of = [&](int i) -> int { return MODE < 2 ? i : (i == 0 ? jq : (MODE == 2 ? i - 1 : jq - nw + i)); };
    auto src_of = [&](int t) -> TileSrc {
        if (MODE < 2) return TileSrc{c.Kcb + (size_t)t * 64 * 64, c.Vcb + (size_t)t * 64 * 64, 64};
        if (MODE == 2) return TileSrc{c.Pb + (size_t)t * 64 * DINP + C_NKS, c.Pb + (size_t)t * 64 * DINP + C_NVS, DINP};
        return TileSrc{c.Pb + (size_t)t * 64 * DINP + C_NKW, c.Pb + (size_t)t * 64 * DINP + C_NVW, DINP};
    };
    u32x4v kr, vr;
    { const TileSrc s = src_of(tile_of(0)); tile_load(kr, vr, s, tid); }
    tile_store(lds, kr, vr, tid);
    __syncthreads();
    const int ncv = (tq >= 31) ? ((tq - 31) >> 4) + 1 : 0;
    for (int i = 0; i < nt; ++i) {
        const int tile = tile_of(i);
        if (i + 1 < nt) { const TileSrc s = src_of(tile_of(i + 1)); tile_load(kr, vr, s, tid); }
        LAS const unsigned char* buf = lds + (i & 1) * STG;
        const int kbase = tile * 64;
        bool rowsel = true;
        if (MODE == 2 && tile != jq) { const unsigned w = (tile >> 5) == 0 ? c.mk0 : (tile >> 5) == 1 ? c.mk1 : (tile >> 5) == 2 ? c.mk2 : c.mk3; rowsel = (w >> (tile & 31)) & 1u; }
        if (MODE != 2 || __any(rowsel)) {
            f32x16 p0, p1;
            qk_tile(p0, p1, buf, qf, r32, hi, MODE < 2 ? 0.f : (rowsel ? -m : NEGBIG));
            if (MODE < 2) {
#pragma unroll
                for (int r = 0; r < 16; ++r) { const int k0 = kbase + crow(r, hi); p0[r] = (k0 < ncv) ? p0[r] : NEGBIG; p1[r] = (k0 + 32 < ncv) ? p1[r] : NEGBIG; }
            } else if (MODE == 2) {
                if (tile == jq) {
#pragma unroll
                    for (int r = 0; r < 16; ++r) { const int k0 = kbase + crow(r, hi); p0[r] = (k0 <= tq) ? p0[r] : NEGBIG; p1[r] = (k0 + 32 <= tq) ? p1[r] : NEGBIG; }
                }
            } else if (tile == jq || tile + 8 == jq) {
#pragma unroll
                for (int r = 0; r < 16; ++r) { const int k0 = kbase + crow(r, hi);
                    p0[r] = (k0 <= tq && k0 + 511 >= tq) ? p0[r] : NEGBIG; p1[r] = (k0 + 32 <= tq && k0 + 32 + 511 >= tq) ? p1[r] : NEGBIG; }
            }
            if (MODE == 0) {
                float tm = fmaxf(p0[0], p1[0]);
#pragma unroll
                for (int r = 1; r < 16; ++r) tm = fmaxf(tm, fmaxf(p0[r], p1[r]));
                tm = fmaxf(tm, shx<32>(tm));
                const float mn = fmaxf(m, tm); float s = 0.f;
#pragma unroll
                for (int r = 0; r < 16; ++r) { s += (p0[r] > -1e29f ? __builtin_amdgcn_exp2f(p0[r] - mn) : 0.f) + (p1[r] > -1e29f ? __builtin_amdgcn_exp2f(p1[r] - mn) : 0.f); }
                l = l * __builtin_amdgcn_exp2f(m - mn) + s; m = mn;
            } else if (MODE == 1) {
#pragma unroll
                for (int r = 0; r < 16; ++r) { p0[r] = (p0[r] > -1e29f) ? __builtin_amdgcn_exp2f(p0[r] - m) * pre : 0.f; p1[r] = (p1[r] > -1e29f) ? __builtin_amdgcn_exp2f(p1[r] - m) * pre : 0.f; }
                pv_tile(o0, o1, buf + KBUF, p0, p1, lane);
                LAS float* S4 = (LAS float*)(lds + NSA_S4_OFF) + (c.wid * 8 + (r32 & 7)) * 128; LAS float* L4 = (LAS float*)(lds + NSA_L4_OFF) + (c.wid * 8 + (r32 & 7)) * 128;
#pragma unroll
                for (int mbk = 0; mbk < 2; ++mbk)
#pragma unroll
                    for (int g = 0; g < 4; ++g) {
                        float s4 = mbk ? (p1[4 * g] + p1[4 * g + 1]) + (p1[4 * g + 2] + p1[4 * g + 3]) : (p0[4 * g] + p0[4 * g + 1]) + (p0[4 * g + 2] + p0[4 * g + 3]);
                        float la = mbk ? p1[4 * g + 3] : p0[4 * g + 3];
                        s4 += shx<8>(s4); s4 += shx<16>(s4); la += shx<8>(la); la += shx<16>(la);
                        const int gi = tile * 16 + 8 * mbk + 2 * g + hi;
                        if (r32 < 8) { S4[gi] = s4; L4[gi] = la; }
                    }
            } else {
                softmax_tile(p0, p1, o0, o1, m, l, i == 0);
                pv_tile(o0, o1, buf + KBUF, p0, p1, lane);
            }
        }
        if (i + 1 < nt) tile_store(lds + ((i + 1) & 1) * STG, kr, vr, tid);
        __syncthreads();
    }
}

struct NsaSelPol {
    int nt, nmask, stride, jq, tq, hi; unsigned long long mlo, mhi; const bf16* Pk; const bf16* Pv;
    __device__ __forceinline__ int tile_of(int i) const { return i == 0 ? jq : i - 1; }
    __device__ __forceinline__ const bf16* kptr(int i) const { return Pk + (size_t)tile_of(i) * 64 * DINP; }
    __device__ __forceinline__ const bf16* vptr(int i) const { return Pv + (size_t)tile_of(i) * 64 * DINP; }
    __device__ __forceinline__ bool rowsel(int i) const { if (i == 0) return true; const int tile = i - 1; const unsigned long long w = tile < 64 ? mlo : mhi; return (w >> (tile & 63)) & 1ull; }
    __device__ __forceinline__ void mask(int i, f32x16& p0, f32x16& p1) const {
        if (i == 0) { const int kbase = jq * 64;
#pragma unroll
            for (int r = 0; r < 16; ++r) { const int k0 = kbase + crow(r, hi); p0[r] = (k0 <= tq) ? p0[r] : NEGBIG; p1[r] = (k0 + 32 <= tq) ? p1[r] : NEGBIG; } }
    }
};
struct NsaWinPol {
    int nt, nmask, stride, jq, tq, hi; const bf16* Pk; const bf16* Pv;
    __device__ __forceinline__ int tile_of(int i) const { return i == 0 ? jq : jq - nt + i; }
    __device__ __forceinline__ const bf16* kptr(int i) const { return Pk + (size_t)tile_of(i) * 64 * DINP; }
    __device__ __forceinline__ const bf16* vptr(int i) const { return Pv + (size_t)tile_of(i) * 64 * DINP; }
    __device__ __forceinline__ bool rowsel(int) const { return true; }
    __device__ __forceinline__ void mask(int i, f32x16& p0, f32x16& p1) const {
        const int tile = tile_of(i);
        if (tile == jq || tile + 8 == jq) { const int kbase = tile * 64;
#pragma unroll
            for (int r = 0; r < 16; ++r) { const int k0 = kbase + crow(r, hi);
                p0[r] = (k0 <= tq && k0 + 511 >= tq) ? p0[r] : NEGBIG; p1[r] = (k0 + 32 <= tq && k0 + 32 + 511 >= tq) ? p1[r] : NEGBIG; } }
    }
};
__device__ __forceinline__ void nsa_unit(const bf16* __restrict__ P, const float* __restrict__ G, const float* __restrict__ tab, const bf16* __restrict__ KVcb, const float* __restrict__ kgain  , bf16* __restrict__ MIX,
                                         int b, int jq, int tid, LAS unsigned char* lds) {
    asm volatile("" : "+v"(tid));
    NsaCtx c; c.b = b; c.jq = jq; c.tid = tid; c.lane = tid & 63; c.wid = __builtin_amdgcn_readfirstlane(tid >> 6); c.r32 = c.lane & 31; c.hi = c.lane >> 5;
    const int qi = c.r32 & 7, hh = c.r32 >> 3, hi = c.hi, lane = c.lane;
    c.tq = jq * 64 + c.wid * 8 + qi;
    c.Pb = P + (size_t)b * SEQ * DINP; c.Kcb = KVcb + (size_t)b * 512 * 64; c.Vcb = KVcb + ((size_t)NB + b) * 512 * 64;
    c.mk0 = c.mk1 = c.mk2 = c.mk3 = 0u;
    const size_t rowq = (size_t)b * SEQ + c.tq;
    bf16x8 qf[4];
#pragma unroll
    for (int ks = 0; ks < 4; ++ks) qf[ks] = scale_frag(*(const bf16x8*)(P + rowq * DINP + C_NQ + hh * 64 + ks * 16 + hi * 8), SCL2);
    const float g0 = sigmoidf_(G[rowq * 32 + 8 + hh]);
    { LAS float* gl = (LAS float*)(lds + NSA_SM_OFF + 1024); gl[tid] = sigmoidf_(G[rowq * 32 + 12 + hh]); gl[512 + tid] = sigmoidf_(G[rowq * 32 + 16 + hh]); }
    f32x16 a0, a1;
    {
        const int ncvmax = min(4 * jq + 3, NCMP), nct = (ncvmax + 63) >> 6;
        f32x16 o0, o1;
#pragma unroll
        for (int r = 0; r < 16; ++r) { o0[r] = zf_(); o1[r] = o0[r]; }
        float m = NEGBIG, l = 0.f;
        nsa_tiles<0>(c, lds, qf, nct, o0, o1, m, l, 0.f);
        l += shx<32>(l);
        const float pre = (l > 0.f) ? rcpf_(l) : 0.f;
        nsa_tiles<1>(c, lds, qf, nct, o0, o1, m, l, pre);
#pragma unroll
        for (int r = 0; r < 16; ++r) { a0[r] = g0 * o0[r]; a1[r] = g0 * o1[r]; }
    }
    {
        LAS unsigned* sm = (LAS unsigned*)(lds + NSA_SM_OFF);
        for (int q = 0; q < 8; ++q) {
            LAS const float* S4 = (LAS const float*)(lds + NSA_S4_OFF) + (c.wid * 8 + q) * 128; LAS const float* L4 = (LAS const float*)(lds + NSA_L4_OFF) + (c.wid * 8 + q) * 128;
            float v0, v1;
            { const int n = lane; const bool causal = n <= jq, forced = causal && (n == 0 || n >= jq - 1);
              float im = 0.f; if (causal) { im = S4[n]; if (n > 0) im += L4[n - 1]; }
              v0 = forced ? 1e9f : (causal ? im : -1e30f); }
            { const int n = lane + 64; const bool causal = n <= jq, forced = causal && (n >= jq - 1);
              float im = 0.f; if (causal) { im = S4[n] + L4[n - 1]; }
              v1 = forced ? 1e9f : (causal ? im : -1e30f); }
            unsigned long long sel0 = 0ull, sel1 = 0ull;
            for (int k = 0; k < 16; ++k) { const float mx = wave_max(fmaxf(v0, v1));
                const unsigned long long b0 = __ballot(v0 == mx);
                if (b0) { const int idx = __ffsll((long long)b0) - 1; sel0 |= 1ull << idx; if (lane == idx) v0 = -3.0e38f; }
                else { const unsigned long long b1 = __ballot(v1 == mx); const int idx = __ffsll((long long)b1) - 1; sel1 |= 1ull << idx; if (lane == idx) v1 = -3.0e38f; } }
            if (lane == 0) { sm[(c.wid * 8 + q) * 4 + 0] = (unsigned)sel0; sm[(c.wid * 8 + q) * 4 + 1] = (unsigned)(sel0 >> 32); sm[(c.wid * 8 + q) * 4 + 2] = (unsigned)sel1; sm[(c.wid * 8 + q) * 4 + 3] = (unsigned)(sel1 >> 32); }
        }
        __builtin_amdgcn_s_waitcnt(0xc07f); __builtin_amdgcn_wave_barrier();
        c.mk0 = sm[(c.wid * 8 + qi) * 4 + 0]; c.mk1 = sm[(c.wid * 8 + qi) * 4 + 1]; c.mk2 = sm[(c.wid * 8 + qi) * 4 + 2]; c.mk3 = sm[(c.wid * 8 + qi) * 4 + 3];
    }
    LAS float* stash = (LAS float*)(lds + NSA_S4_OFF) + c.wid * 1024 + lane;
    LAS float* stash2 = (LAS float*)(lds + NSA_L4_OFF) + c.wid * 1024 + lane;
#pragma unroll
    for (int r = 0; r < 16; ++r) { stash[r * 64] = a0[r]; stash2[r * 64] = a1[r]; }
    {
        const u32x4v qw = __builtin_bit_cast(u32x4v, qf[0]); u32x4v w;
#pragma unroll
        for (int e = 0; e < 4; ++e) {
            float y[2];
#pragma unroll
            for (int k = 0; k < 2; ++k) { const int j = 2 * e + k; const float x = k ? __builtin_bit_cast(float, qw[e] & 0xffff0000u) : __builtin_bit_cast(float, qw[e] << 16); const float other = shx<32>(x);
                const float cs = tab[c.tq * 16 + j], sn = tab[c.tq * 16 + 8 + j]; y[k] = hi ? (x * cs + other * sn) : (x * cs - other * sn); }
            w[e] = cvtpk(y[0], y[1]);
        }
        qf[0] = __builtin_bit_cast(bf16x8, w);
    }
    {
        f32x16 o0, o1;
#pragma unroll
        for (int r = 0; r < 16; ++r) { o0[r] = zf_(); o1[r] = o0[r]; }
        float l = 0.f;
        NsaSelPol pol; pol.nt = jq + 1; pol.nmask = 1; pol.stride = DINP; pol.jq = jq; pol.tq = c.tq; pol.hi = hi; pol.mlo = (unsigned long long)c.mk0 | ((unsigned long long)c.mk1 << 32); pol.mhi = (unsigned long long)c.mk2 | ((unsigned long long)c.mk3 << 32); pol.Pk = c.Pb + C_NKS; pol.Pv = c.Pb + C_NVS;
        attn_pipe(pol, lds, qf, row_negm(qf, gain_kmax(kgain + 64, lane)), o0, o1, l, tid);
        l += shx<32>(l);
        int t2 = tid; asm volatile("" : "+v"(t2));
        const float sc = ((LAS const float*)(lds + NSA_SM_OFF + 1024))[t2] * rcpf_(l);
        LAS float* st1 = (LAS float*)(lds + NSA_S4_OFF) + (t2 >> 6) * 1024 + (t2 & 63); LAS float* st2 = (LAS float*)(lds + NSA_L4_OFF) + (t2 >> 6) * 1024 + (t2 & 63);
#pragma unroll
        for (int r = 0; r < 16; ++r) { st1[r * 64] = fmaf(sc, o0[r], st1[r * 64]); st2[r * 64] = fmaf(sc, o1[r], st2[r * 64]); }
    }
    {
        f32x16 o0, o1;
#pragma unroll
        for (int r = 0; r < 16; ++r) { o0[r] = zf_(); o1[r] = o0[r]; }
        float l = 0.f;
        NsaWinPol pol; pol.nt = (jq < 8 ? jq : 8) + 1; pol.nmask = 2; pol.stride = DINP; pol.jq = jq; pol.tq = c.tq; pol.hi = hi; pol.Pk = c.Pb + C_NKW; pol.Pv = c.Pb + C_NVW;
        attn_pipe(pol, lds, qf, row_negm(qf, gain_kmax(kgain + 128, lane)), o0, o1, l, tid);
        l += shx<32>(l);
        int t2 = tid; asm volatile("" : "+v"(t2));
        const float sc = ((LAS const float*)(lds + NSA_SM_OFF + 1024))[512 + t2] * rcpf_(l);
        LAS const float* st1 = (LAS const float*)(lds + NSA_S4_OFF) + (t2 >> 6) * 1024 + (t2 & 63); LAS const float* st2 = (LAS const float*)(lds + NSA_L4_OFF) + (t2 >> 6) * 1024 + (t2 & 63);
#pragma unroll
        for (int r = 0; r < 16; ++r) { a0[r] = fmaf(sc, o0[r], st1[r * 64]); a1[r] = fmaf(sc, o1[r], st2[r * 64]); }
    }
    int t3 = tid; asm volatile("" : "+v"(t3));
    const int ln3 = t3 & 63, r3 = ln3 & 31;
    bf16* op = MIX + ((size_t)b * SEQ + jq * 64 + (t3 >> 6) * 8 + (r3 & 7)) * DM + 768 + (r3 >> 3) * 64 + 4 * (ln3 >> 5);
#pragma unroll
    for (int g = 0; g < 4; ++g) {
        uint2 w0, w1;
        w0.x = cvtpk(a0[4 * g], a0[4 * g + 1]); w0.y = cvtpk(a0[4 * g + 2], a0[4 * g + 3]);
        w1.x = cvtpk(a1[4 * g], a1[4 * g + 1]); w1.y = cvtpk(a1[4 * g + 2], a1[4 * g + 3]);
        *(uint2*)(op + 8 * g) = w0; *(uint2*)(op + 32 + 8 * g) = w1;
    }
}


constexpr int MQ_PITCH = 272, MV_PITCH = 320;
constexpr int ML_G_OFF = 0;
constexpr int ML_Q_OFF = 4096;
constexpr int ML_K_OFF = ML_Q_OFF + 64 * MQ_PITCH;
constexpr int ML_V_OFF = ML_K_OFF + 64 * MV_PITCH;
constexpr int ML_END = ML_V_OFF + 64 * MV_PITCH;
static_assert(ML_END <= 131072, "mlstm LDS");
constexpr float KSCALE = 0.08838834764831845f;

__device__ __forceinline__ void qk2_rows(const bf16* __restrict__ P, const float* __restrict__ cw, bf16* __restrict__ QK2, int bid, int G, int tid) {
    asm volatile("" : "+v"(tid));
    const int ch = tid & 127, c0 = ch * 8;
    float tp[4][8];
#pragma unroll
    for (int j = 0; j < 4; ++j) { const float4 a = *(const float4*)(cw + j * 1024 + c0), b4 = *(const float4*)(cw + j * 1024 + c0 + 4);
        tp[j][0] = a.x; tp[j][1] = a.y; tp[j][2] = a.z; tp[j][3] = a.w; tp[j][4] = b4.x; tp[j][5] = b4.y; tp[j][6] = b4.z; tp[j][7] = b4.w; }
    const float sc = (c0 >= 512) ? KSCALE : 1.f;
    for (int row0 = bid * 4 + (tid >> 7); row0 < T; row0 += G * 16) {
        u32x4v w[4][4];
#pragma unroll
        for (int q = 0; q < 4; ++q) { const int row = row0 + q * G * 4, t = row & (SEQ - 1);
#pragma unroll
            for (int j = 0; j < 4; ++j) { w[q][j] = u32x4v{0u, 0u, 0u, 0u}; if (row < T && t - 3 + j >= 0) w[q][j] = *(const u32x4v*)(P + (size_t)(row - 3 + j) * DINP + c0); } }
#pragma unroll
        for (int q = 0; q < 4; ++q) { const int row = row0 + q * G * 4;
            float y[8];
#pragma unroll
            for (int e = 0; e < 8; ++e) y[e] = 0.f;
#pragma unroll
            for (int j = 0; j < 4; ++j)
#pragma unroll
                for (int e = 0; e < 4; ++e) { y[2 * e] = fmaf(tp[j][2 * e], __builtin_bit_cast(float, w[q][j][e] << 16), y[2 * e]); y[2 * e + 1] = fmaf(tp[j][2 * e + 1], __builtin_bit_cast(float, w[q][j][e] & 0xffff0000u), y[2 * e + 1]); }
#pragma unroll
            for (int e = 0; e < 8; ++e) y[e] = y[e] * rcpf_(1.f + __expf(-y[e])) * sc;
            u32x4v o; o[0] = cvtpk(y[0], y[1]); o[1] = cvtpk(y[2], y[3]); o[2] = cvtpk(y[4], y[5]); o[3] = cvtpk(y[6], y[7]);
            if (row < T) *(u32x4v*)(QK2 + (size_t)row * 1024 + c0) = o; }
    }
}

struct MlRaw { u32x4v q[2], k[2], v[2]; float gf, gi; };
template <bool WITH_Q> __device__ __forceinline__ void ml_load(MlRaw& r, const bf16* __restrict__ P, const bf16* __restrict__ QK2, const float* __restrict__ G, const float* __restrict__ bif, int u, int tid) {
    const int c = u & 127, h = (u >> 7) & 3, b = u >> 9, row0 = b * SEQ + c * 64, s = tid >> 3;
#pragma unroll
    for (int pass = 0; pass < 2; ++pass) { const int ch = (tid & 7) + 8 * pass;
        if (WITH_Q) r.q[pass] = *(const u32x4v*)(QK2 + (size_t)(row0 + s) * 1024 + h * 128 + ch * 8);
        r.k[pass] = *(const u32x4v*)(QK2 + (size_t)(row0 + s) * 1024 + 512 + h * 128 + ch * 8);
        r.v[pass] = *(const u32x4v*)(P + (size_t)(row0 + s) * DINP + C_MV + h * 128 + ch * 8); }
    if (tid < 64) { r.gf = G[(size_t)(row0 + tid) * 32 + 4 + h] + bif[4 + h]; r.gi = G[(size_t)(row0 + tid) * 32 + h] + bif[h]; }
}
__device__ __forceinline__ void mlstm_gates(const MlRaw& r, int tid, LAS float* gs) {
    if (tid < 64) { gs[tid] = log_sigmoidf_(r.gf); gs[128 + tid] = r.gi; }
    __syncthreads();
    if (tid < 64) { float a = 0.f; for (int s = 0; s <= tid; ++s) a += gs[s]; gs[64 + tid] = a; }
    __syncthreads();
}

__device__ __forceinline__ void mlstm_m1_phase(const bf16* __restrict__ P, const bf16* __restrict__ QK2, const float* __restrict__ G, const float* __restrict__ bif,
                                               bf16* __restrict__ CT, float* __restrict__ nst, float* __restrict__ dec, int bid, int Gd, int tid, LAS unsigned char* lds) {
    asm volatile("" : "+v"(tid));
    const int lane = tid & 63, wid = __builtin_amdgcn_readfirstlane(tid >> 6), hi = lane >> 5;
    LAS float* gs = (LAS float*)(lds + ML_G_OFF);
    MlRaw raw;
    if (bid < 2048) ml_load<false>(raw, P, QK2, G, bif, bid, tid);
    for (int u = bid; u < 2048; u += Gd) {
        mlstm_gates(raw, tid, gs);
        if (tid == 0) dec[u] = __expf(gs[64 + 63]);
        {
            const int s = tid >> 3; const float ws = __expf(gs[64 + 63] - gs[64 + s] + gs[128 + s]);
#pragma unroll
            for (int pass = 0; pass < 2; ++pass) { const int ch = (tid & 7) + 8 * pass; u32x4v w;
#pragma unroll
                for (int e = 0; e < 4; ++e) w[e] = cvtpk(__builtin_bit_cast(float, raw.k[pass][e] << 16) * ws, __builtin_bit_cast(float, raw.k[pass][e] & 0xffff0000u) * ws);
                *(LAS u32x4v*)(lds + ML_K_OFF + s * MV_PITCH + ch * 16) = w;
                *(LAS u32x4v*)(lds + ML_V_OFF + s * MV_PITCH + ch * 16) = raw.v[pass]; }
        }
        if (u + Gd < 2048) ml_load<false>(raw, P, QK2, G, bif, u + Gd, tid);
        __syncthreads();
        const int g = lane >> 4, i = lane & 15;
        const int mb = wid >> 1, nb0 = 2 * (wid & 1);
        f32x16 acc0, acc1;
#pragma unroll
        for (int r = 0; r < 16; ++r) { acc0[r] = zf_(); acc1[r] = acc0[r]; }
        LAS const unsigned char* trb = lds + (4 * hi + (i >> 2)) * MV_PITCH + (16 * (g & 1) + 4 * (i & 3)) * 2;
#pragma unroll
        for (int ks = 0; ks < 4; ++ks) {
            const s16x4 alo = lds_tr(trb + ML_K_OFF + ks * 16 * MV_PITCH + mb * 64), ahi = lds_tr(trb + ML_K_OFF + ks * 16 * MV_PITCH + 8 * MV_PITCH + mb * 64);
            const bf16x8 af = {alo[0], alo[1], alo[2], alo[3], ahi[0], ahi[1], ahi[2], ahi[3]};
            const s16x4 b0lo = lds_tr(trb + ML_V_OFF + ks * 16 * MV_PITCH + nb0 * 64), b0hi = lds_tr(trb + ML_V_OFF + ks * 16 * MV_PITCH + 8 * MV_PITCH + nb0 * 64);
            const s16x4 b1lo = lds_tr(trb + ML_V_OFF + ks * 16 * MV_PITCH + (nb0 + 1) * 64), b1hi = lds_tr(trb + ML_V_OFF + ks * 16 * MV_PITCH + 8 * MV_PITCH + (nb0 + 1) * 64);
            const bf16x8 bf0 = {b0lo[0], b0lo[1], b0lo[2], b0lo[3], b0hi[0], b0hi[1], b0hi[2], b0hi[3]}, bf1 = {b1lo[0], b1lo[1], b1lo[2], b1lo[3], b1hi[0], b1hi[1], b1hi[2], b1hi[3]};
            acc0 = __builtin_amdgcn_mfma_f32_32x32x16_bf16(af, bf0, acc0, 0, 0, 0);
            acc1 = __builtin_amdgcn_mfma_f32_32x32x16_bf16(af, bf1, acc1, 0, 0, 0);
        }
        bf16* ct = CT + (size_t)u * 16384;
#pragma unroll
        for (int gq = 0; gq < 4; ++gq) { const int d0 = 32 * mb + 8 * gq + 4 * hi;
            uint2 w0, w1; w0.x = cvtpk(acc0[4 * gq], acc0[4 * gq + 1]); w0.y = cvtpk(acc0[4 * gq + 2], acc0[4 * gq + 3]); w1.x = cvtpk(acc1[4 * gq], acc1[4 * gq + 1]); w1.y = cvtpk(acc1[4 * gq + 2], acc1[4 * gq + 3]);
            *(uint2*)(ct + (size_t)(32 * nb0 + (lane & 31)) * 128 + d0) = w0; *(uint2*)(ct + (size_t)(32 * (nb0 + 1) + (lane & 31)) * 128 + d0) = w1; }
        if (tid < 128) { float a = 0.f; for (int s = 0; s < 64; ++s) a += bf2f(*(LAS const bf16*)(lds + ML_K_OFF + s * MV_PITCH + tid * 2)); nst[(size_t)u * 128 + tid] = a; }
        __syncthreads();
    }
}
__device__ __forceinline__ void mlstm_scan(bf16* __restrict__ CT, float* __restrict__ nst, const float* __restrict__ dec, int item, int tid) {
    asm volatile("" : "+v"(tid));
    const int bh = item / 9, part = item % 9;
    if (part < 8) {
        bf16* base = CT + (size_t)bh * 128 * 16384 + (part * 512 + tid) * 4;
        float C[4] = {0.f, 0.f, 0.f, 0.f};
        for (int c0 = 0; c0 < 128; c0 += 16) {
            uint2 w[16];
#pragma unroll
            for (int k = 0; k < 16; ++k) w[k] = *(const uint2*)(base + (size_t)(c0 + k) * 16384);
#pragma unroll
            for (int k = 0; k < 16; ++k) { const float a = dec[bh * 128 + c0 + k];
                uint2 o; o.x = cvtpk(C[0], C[1]); o.y = cvtpk(C[2], C[3]); *(uint2*)(base + (size_t)(c0 + k) * 16384) = o;
                C[0] = fmaf(a, C[0], __builtin_bit_cast(float, w[k].x << 16)); C[1] = fmaf(a, C[1], __builtin_bit_cast(float, w[k].x & 0xffff0000u));
                C[2] = fmaf(a, C[2], __builtin_bit_cast(float, w[k].y << 16)); C[3] = fmaf(a, C[3], __builtin_bit_cast(float, w[k].y & 0xffff0000u)); }
        }
    } else if (tid < 128) {
        float* base = nst + (size_t)bh * 128 * 128 + tid; float C = 0.f;
        for (int c = 0; c < 128; ++c) { const float dC = base[(size_t)c * 128]; base[(size_t)c * 128] = C; C = dec[bh * 128 + c] * C + dC; }
    }
}

__device__ __forceinline__ void mlstm_m3_phase(const bf16* __restrict__ P, const bf16* __restrict__ QK2, const float* __restrict__ G, const float* __restrict__ bif,
                                               const bf16* __restrict__ CT, const float* __restrict__ nst, const float* __restrict__ mnorm, bf16* __restrict__ MIX, int bid, int Gd, int tid, LAS unsigned char* lds) {
    asm volatile("" : "+v"(tid));
    const int lane = tid & 63, wid = __builtin_amdgcn_readfirstlane(tid >> 6), hi = lane >> 5, r32 = lane & 31;
    LAS float* gs = (LAS float*)(lds + ML_G_OFF);
    MlRaw raw;
    if (bid < 2048) ml_load<true>(raw, P, QK2, G, bif, bid, tid);
    for (int u = bid; u < 2048; u += Gd) {
    const int c = u & 127, h = (u >> 7) & 3, b = u >> 9, t0 = c * 64;
    if (tid >= 128 && tid < 256) gs[256 + tid - 128] = nst[(size_t)u * 128 + tid - 128];
    mlstm_gates(raw, tid, gs);
    {
        const int s = tid >> 3;
#pragma unroll
        for (int pass = 0; pass < 2; ++pass) { const int ch = (tid & 7) + 8 * pass;
            *(LAS u32x4v*)(lds + ML_Q_OFF + s * MQ_PITCH + ch * 16) = raw.q[pass];
            *(LAS u32x4v*)(lds + ML_K_OFF + s * MQ_PITCH + ch * 16) = raw.k[pass];
            *(LAS u32x4v*)(lds + ML_V_OFF + s * MV_PITCH + ch * 16) = raw.v[pass]; }
    }
    if (u + Gd < 2048) ml_load<true>(raw, P, QK2, G, bif, u + Gd, tid);
    __syncthreads();
    const int tb = wid & 1, eb = wid >> 1, t = 32 * tb + r32;
    bf16x8 qf[8];
#pragma unroll
    for (int ks = 0; ks < 8; ++ks) qf[ks] = *(LAS const bf16x8*)(lds + ML_Q_OFF + t * MQ_PITCH + ks * 32 + hi * 16);
    f32x16 ni;
#pragma unroll
    for (int r = 0; r < 16; ++r) ni[r] = zf_();
    { const bf16* ctp = CT + (size_t)u * 16384 + (size_t)(32 * eb + r32) * 128 + hi * 8;
      bf16x8 cf[8];
#pragma unroll
      for (int ks = 0; ks < 8; ++ks) cf[ks] = *(const bf16x8*)(ctp + ks * 16);
#pragma unroll
      for (int ks = 0; ks < 8; ++ks) ni = __builtin_amdgcn_mfma_f32_32x32x16_bf16(cf[ks], qf[ks], ni, 0, 0, 0); }
    f32x16 p0, p1;
#pragma unroll
    for (int r = 0; r < 16; ++r) { p0[r] = zf_(); p1[r] = p0[r]; }
    { LAS const unsigned char* ka = lds + ML_K_OFF + r32 * MQ_PITCH + hi * 16;
#pragma unroll
      for (int ks = 0; ks < 8; ++ks) { const bf16x8 a0 = *(LAS const bf16x8*)(ka + ks * 32); p0 = __builtin_amdgcn_mfma_f32_32x32x16_bf16(a0, qf[ks], p0, 0, 0, 0); }
      if (tb == 1) {
#pragma unroll
          for (int ks = 0; ks < 8; ++ks) { const bf16x8 a1 = *(LAS const bf16x8*)(ka + 32 * MQ_PITCH + ks * 32); p1 = __builtin_amdgcn_mfma_f32_32x32x16_bf16(a1, qf[ks], p1, 0, 0, 0); } } }
    const float bt = gs[64 + t], Ft = __expf(bt);
    float dsum = 0.f;
#pragma unroll
    for (int r = 0; r < 16; ++r) { const int s0 = crow(r, hi);
        { const float w = (s0 <= t) ? __expf(bt - gs[64 + s0] + gs[128 + s0]) : 0.f; p0[r] *= w; dsum += p0[r]; }
        { const int s1 = s0 + 32; const float w = (s1 <= t) ? __expf(bt - gs[64 + s1] + gs[128 + s1]) : 0.f; p1[r] *= w; dsum += p1[r]; } }
    float qn = 0.f;
#pragma unroll
    for (int ks = 0; ks < 8; ++ks)
#pragma unroll
        for (int j = 0; j < 8; ++j) qn = fmaf(bf2f((bf16)qf[ks][j]), gs[256 + ks * 16 + hi * 8 + j], qn);
    dsum += shx<32>(dsum); qn += shx<32>(qn);
    const float den = dsum + Ft * qn, inv = rcpf_(fmaxf(fabsf(den), 1.f));
    f32x16 na;
#pragma unroll
    for (int r = 0; r < 16; ++r) na[r] = zf_();
    { const int g = lane >> 4, i = lane & 15;
      LAS const unsigned char* trb = lds + ML_V_OFF + (4 * hi + (i >> 2)) * MV_PITCH + (16 * (g & 1) + 4 * (i & 3)) * 2 + eb * 64;
#pragma unroll
      for (int ss = 0; ss < 4; ++ss) { if (ss >= 2 && tb == 0) break;
          unsigned w[4];
#pragma unroll
          for (int e = 0; e < 4; ++e) { const int r = 8 * (ss & 1) + 2 * e; w[e] = (ss < 2) ? cvtpk(p0[r], p0[r + 1]) : cvtpk(p1[r], p1[r + 1]); }
          const u32x4v wv = {w[0], w[1], w[2], w[3]}; const bf16x8 pf = __builtin_bit_cast(bf16x8, wv);
          const s16x4 lo = lds_tr(trb + ss * 16 * MV_PITCH), hi4 = lds_tr(trb + ss * 16 * MV_PITCH + 8 * MV_PITCH);
          const bf16x8 vt = {lo[0], lo[1], lo[2], lo[3], hi4[0], hi4[1], hi4[2], hi4[3]};
          na = __builtin_amdgcn_mfma_f32_32x32x16_bf16(vt, pf, na, 0, 0, 0); } }
    float ssq = 0.f;
#pragma unroll
    for (int r = 0; r < 16; ++r) { na[r] = (na[r] + Ft * ni[r]) * inv; ssq += na[r] * na[r]; }
    ssq += shx<32>(ssq);
    if (hi == 0) gs[384 + eb * 64 + t] = ssq;
    __syncthreads();
    const float rstd = rsqrtf((gs[384 + t] + gs[384 + 64 + t] + gs[384 + 128 + t] + gs[384 + 192 + t]) * (1.f / 128.f) + EPS);
    const size_t row = (size_t)b * SEQ + t0 + t;
#pragma unroll
    for (int gq = 0; gq < 4; ++gq) { const int cc = h * 128 + 32 * eb + 8 * gq + 4 * hi;
        const uint2 ow = *(const uint2*)(P + row * DINP + C_MO + cc); const float4 mn = *(const float4*)(mnorm + cc);
        const float o0 = sigmoidf_(__builtin_bit_cast(float, ow.x << 16)), o1 = sigmoidf_(__builtin_bit_cast(float, ow.x & 0xffff0000u)), o2 = sigmoidf_(__builtin_bit_cast(float, ow.y << 16)), o3 = sigmoidf_(__builtin_bit_cast(float, ow.y & 0xffff0000u));
        uint2 w; w.x = cvtpk(na[4 * gq] * rstd * mn.x * o0, na[4 * gq + 1] * rstd * mn.y * o1); w.y = cvtpk(na[4 * gq + 2] * rstd * mn.z * o2, na[4 * gq + 3] * rstd * mn.w * o3);
        *(uint2*)(MIX + row * DM + cc) = w; }
    __syncthreads();
    }
}


typedef float f32x4v __attribute__((ext_vector_type(4)));
__device__ __forceinline__ void compress_item(const bf16* __restrict__ P, const bf16* __restrict__ w1t  , const float* __restrict__ c1  , const float* __restrict__ w2  ,
                                              const float* __restrict__ kg0, bf16* __restrict__ KVcb, int item, int tid, LAS unsigned char* lds) {
    asm volatile("" : "+v"(tid));
    const int lane = tid & 63, wid = __builtin_amdgcn_readfirstlane(tid >> 6), hi = lane >> 5, r32 = lane & 31;
    const int kv = item >> 5, b = (item >> 3) & 3, i0 = (item & 7) * 64;
    const int rb = wid & 1, cb = wid >> 1;
    const int irow = min(i0 + 32 * rb + r32, NCMP - 1);
    const bf16* xa = P + ((size_t)b * SEQ + 16 * irow) * DINP + (kv ? C_NVC : C_NKC) + hi * 8;
    const bf16* wb = w1t + ((size_t)kv * 128 + 32 * cb + r32) * 2048 + hi * 8;
    f32x16 acc;
#pragma unroll
    for (int r = 0; r < 16; ++r) acc[r] = zf_();
    for (int p0 = 0; p0 < 32; p0 += 4) {
        bf16x8 af[16], bfr[16];
#pragma unroll
        for (int q = 0; q < 16; ++q) { const int p = p0 + (q >> 2), dq = q & 3;
            af[q] = *(const bf16x8*)(xa + (size_t)p * DINP + dq * 16); bfr[q] = *(const bf16x8*)(wb + p * 64 + dq * 16); }
#pragma unroll
        for (int q = 0; q < 16; ++q) acc = __builtin_amdgcn_mfma_f32_32x32x16_bf16(af[q], bfr[q], acc, 0, 0, 0);
    }
    LAS float* hid = (LAS float*)lds;
    { LAS f32x4v* w2s = (LAS f32x4v*)(lds + 64 * 132 * 4); const f32x4v* w2g = (const f32x4v*)(w2 + (size_t)kv * 128 * 64);
#pragma unroll
      for (int q = 0; q < 4; ++q) w2s[tid + 512 * q] = w2g[tid + 512 * q]; }
    { const float cj = c1[kv * 128 + 32 * cb + r32];
#pragma unroll
      for (int r = 0; r < 16; ++r) { const float a = acc[r] + cj; hid[(32 * rb + crow(r, hi)) * 132 + 32 * cb + r32] = a * rcpf_(1.f + __expf(-a)); } }
    __syncthreads();
    {
        const int il = tid >> 3, d0 = (tid & 7) * 8;
        float o[8];
#pragma unroll
        for (int e = 0; e < 8; ++e) o[e] = 0.f;
        LAS const float* wp = (LAS const float*)(lds + 64 * 132 * 4) + d0;
#pragma unroll 8
        for (int j = 0; j < 128; ++j) { const float hv = hid[il * 132 + j]; const f32x4v wa = *(LAS const f32x4v*)(wp + j * 64), wb4 = *(LAS const f32x4v*)(wp + j * 64 + 4);
            o[0] = fmaf(hv, wa[0], o[0]); o[1] = fmaf(hv, wa[1], o[1]); o[2] = fmaf(hv, wa[2], o[2]); o[3] = fmaf(hv, wa[3], o[3]);
            o[4] = fmaf(hv, wb4[0], o[4]); o[5] = fmaf(hv, wb4[1], o[5]); o[6] = fmaf(hv, wb4[2], o[6]); o[7] = fmaf(hv, wb4[3], o[7]); }
        if (kv == 0) { float ss = 0.f;
#pragma unroll
            for (int e = 0; e < 8; ++e) ss += o[e] * o[e];
            ss += shx<1>(ss); ss += shx<2>(ss); ss += shx<4>(ss);
            const float rstd = rsqrtf(ss * (1.f / 64.f) + EPS);
#pragma unroll
            for (int e = 0; e < 8; ++e) o[e] *= rstd * kg0[d0 + e]; }
        const int i = i0 + il;
        if (i >= NCMP) {
#pragma unroll
            for (int e = 0; e < 8; ++e) o[e] = 0.f; }
        u32x4v w; w[0] = cvtpk(o[0], o[1]); w[1] = cvtpk(o[2], o[3]); w[2] = cvtpk(o[4], o[5]); w[3] = cvtpk(o[6], o[7]);
        *(u32x4v*)(KVcb + (((size_t)kv * NB + b) * 512 + i) * 64 + d0) = w;
    }
    __syncthreads();
}
__device__ __forceinline__ void cmp_c1_item(const float* __restrict__ pe, const float* __restrict__ w1, float* __restrict__ c1, int item, int tid, LAS unsigned char* lds) {
    const int lk = item >> 4, j0 = (item & 15) * 8, jj = tid & 7, kk = tid >> 3;
    const float* pp = pe + (size_t)lk * 2048; const float* ww = w1 + (size_t)lk * 2048 * 128 + j0 + jj;
    float a = 0.f;
#pragma unroll 8
    for (int k = kk; k < 2048; k += 64) a = fmaf(pp[k], ww[(size_t)k * 128], a);
    LAS float* red = (LAS float*)lds;
    red[tid] = a;
    __syncthreads();
    if (tid < 8) { float s = 0.f; for (int q = 0; q < 64; ++q) s += red[q * 8 + tid]; c1[lk * 128 + j0 + tid] = s; }
    __syncthreads();
}

#define XB_TMO      128
#define XB_XCNT(j)  (256  + 64 * (j))
#define XB_XSUB(j)  (1280 + 64 * (j))
#define XB_XGEN(j)  (2304 + 64 * (j))
#define XB_TOP      3328
#define XB_TOPGEN   3392
#define XCD_BAR_WORDS 3456
#define XB_SPIN_CAP (1u << 22)

__device__ __forceinline__ unsigned xb_ld(unsigned* p)              { return __hip_atomic_load(p, __ATOMIC_RELAXED, __HIP_MEMORY_SCOPE_AGENT); }
__device__ __forceinline__ unsigned xb_add(unsigned* p, unsigned v) { return __hip_atomic_fetch_add(p, v, __ATOMIC_RELAXED, __HIP_MEMORY_SCOPE_AGENT); }
__device__ __forceinline__ unsigned xb_xcc_id() { return (unsigned)__builtin_amdgcn_s_getreg((3 << 11) | 20) & 0xFu; }
#define XB_SPIN(cond, bar) do { unsigned _sp = 0; while (cond) { __builtin_amdgcn_s_sleep(1); \
    if ((++_sp & 255u) == 0u) { if (xb_ld(&(bar)[XB_TMO])) break; if (_sp > XB_SPIN_CAP) { atomicAdd(&(bar)[XB_TMO], 1u); break; } } } } while (0)

struct XcdBarrier {
    unsigned* bar; unsigned x;
    volatile LAS unsigned* st;
};

__device__ __forceinline__ XcdBarrier xcd_barrier_post(unsigned* bar, volatile LAS unsigned* st) {
    XcdBarrier b; b.bar = bar; b.x = xb_xcc_id(); b.st = st;
    if (threadIdx.x == 0) (void)xb_add(&bar[XB_XCNT(b.x)], 1u);
    return b;
}
__device__ __forceinline__ void xcd_barrier_complete(unsigned* bar, unsigned x, unsigned& nloc, unsigned& nx) {
    const unsigned G = gridDim.x * gridDim.y * gridDim.z;
    unsigned sum, cnt, mine, sp = 0u;
    for (;;) {
        sum = 0u; cnt = 0u; mine = 0u;
#pragma unroll
        for (unsigned j = 0; j < 16; ++j) { const unsigned c = xb_ld(&bar[XB_XCNT(j)]); sum += c; cnt += (c > 0u) ? 1u : 0u; mine = (j == x) ? c : mine; }
        if (sum == G) break;
        __builtin_amdgcn_s_sleep(1);
        if ((++sp & 255u) == 0u) { if (xb_ld(&bar[XB_TMO])) break; if (sp > XB_SPIN_CAP) { atomicAdd(&bar[XB_TMO], 1u); break; } }
    }
    nloc = mine > 0u ? mine : 1u; nx = cnt > 0u ? cnt : 1u;
}

__device__ __forceinline__ void xcd_barrier(const XcdBarrier& b) {
    asm volatile("s_waitcnt vmcnt(0)" ::: "memory");
    __syncthreads();
    if (threadIdx.x == 0) {
        unsigned* bar = b.bar;
        __builtin_amdgcn_s_waitcnt(0);
        unsigned nloc = b.st[0], nx = b.st[1];
        if (nloc == 0u) { xcd_barrier_complete(bar, b.x, nloc, nx); b.st[0] = nloc; b.st[1] = nx; }
        const unsigned old = xb_add(&bar[XB_XSUB(b.x)], 1u);
        const unsigned gen = old / nloc;
        if (old + 1u == (gen + 1u) * nloc) {
            __builtin_amdgcn_fence(__ATOMIC_RELEASE, "agent");
            asm volatile("s_waitcnt vmcnt(0)" ::: "memory");
            const unsigned og = xb_add(&bar[XB_TOP], 1u);
            const unsigned tg = og / nx;
            if (og + 1u == (tg + 1u) * nx) xb_add(&bar[XB_TOPGEN], 1u);
            else XB_SPIN(xb_ld(&bar[XB_TOPGEN]) == tg, bar);
            __builtin_amdgcn_fence(__ATOMIC_ACQUIRE, "agent");
            xb_add(&bar[XB_XGEN(b.x)], 1u);
            asm volatile("s_waitcnt vmcnt(0)" ::: "memory");
        } else {
            XB_SPIN(xb_ld(&bar[XB_XGEN(b.x)]) == gen, bar);
            __builtin_amdgcn_fence(__ATOMIC_ACQUIRE, "agent");
            asm volatile("s_waitcnt vmcnt(0)" ::: "memory");
        }
    }
    __syncthreads();
}


constexpr size_t MiB = 1u << 20;
constexpr size_t W_LAYER = (size_t)(DINP + DM + DFF) * DM + (size_t)DM * DFF;
constexpr size_t WS_W = 0;
constexpr size_t WS_HM = 52 * MiB;
constexpr size_t WS_G = 116 * MiB;
constexpr size_t WS_SMALL = 120 * MiB;
constexpr size_t WS_TAB = WS_SMALL, WS_KMEAN = WS_SMALL + 512 * 1024, WS_KVC = WS_SMALL + 1 * MiB, WS_NST = WS_SMALL + 2 * MiB, WS_DEC = WS_SMALL + 3 * MiB, WS_KVCB = WS_SMALL + 3 * MiB + 512 * 1024;
constexpr size_t WS_SSP = 476 * MiB;
constexpr size_t WS_BAR = WS_SMALL + 3 * MiB + 64 * 1024;
constexpr size_t WS_W1T = 50 * MiB, WS_C1 = WS_SMALL + 3 * MiB + 16 * 1024;
constexpr size_t WS_P = 124 * MiB;
constexpr size_t WS_C = 348 * MiB;
constexpr size_t WS_U = WS_P;
constexpr size_t WS_END = 478 * MiB;
static_assert(W_LAYER * 2 * DEPTH <= 50 * MiB && WS_W1T + (size_t)DEPTH * 2 * 128 * 2048 * 2 <= 52 * MiB, "weights");
static_assert((size_t)T * DINP * 2 == 224 * MiB && (size_t)T * DFF * 2 == 256 * MiB, "sizes");

#ifndef DUP_PRO
#define DUP_PRO 1
#endif
#ifndef DUP_QK2
#define DUP_QK2 1
#endif
#ifndef DUP_GEMM
#define DUP_GEMM 1
#endif
#ifndef DUP_M1
#define DUP_M1 1
#endif
#ifndef DUP_MOBA
#define DUP_MOBA 1
#endif
#ifndef DUP_NSA
#define DUP_NSA 1
#endif
#ifndef DUP_M3
#define DUP_M3 1
#endif
#ifndef DUP_CMP
#define DUP_CMP 1
#endif
struct Params { const float* in[16]; float* out; unsigned char* ws; };
static_assert(sizeof(Params) == 18 * 8, "kernarg layout: in[k] at 8k, out at 128, ws at 136");
constexpr int LDS_BYTES = 147456;

__global__ void __launch_bounds__(512, 2) hybrid_fwd(Params prm) {
    extern __shared__ __attribute__((aligned(16))) unsigned char lds[];
    cg::grid_group grid = cg::this_grid();
    constexpr int NPH = 1 + DEPTH * 8;
    volatile LAS unsigned* xst = (volatile LAS unsigned*)((LAS unsigned char*)lds + 131072 + 1024);
    if (threadIdx.x < 2) xst[threadIdx.x] = 0u;
    __syncthreads();
    (void)xcd_barrier_post((unsigned*)(prm.ws + WS_BAR), xst);
    for (int ph = 0; ph < NPH; ++ph) {
        int tid = threadIdx.x; asm volatile("" : "+v"(tid));
        int G = gridDim.x, bid = blockIdx.x; asm volatile("" : "+s"(G), "+s"(bid));
#define PH_LOCALS const int half = tid >> 8, t256 = tid & 255, lane = tid & 63, wid = __builtin_amdgcn_readfirstlane(tid >> 6); unsigned char* smh = lds + half * 65536; \
        const int vb = bid * 2 + half, NVB = G * 2, gwv = bid * 8 + wid, NGW = G * 8; (void)lane; (void)smh; (void)vb; (void)NVB; (void)gwv; (void)NGW; (void)t256;
        const __attribute__((address_space(4))) unsigned char* ka = (const __attribute__((address_space(4))) unsigned char*)__builtin_amdgcn_kernarg_segment_ptr(); asm volatile("" : "+s"(ka));
#define KARG(T_, off) (*(T_ const __attribute__((address_space(4)))*)(ka + (off)))
#define IN(k) KARG(const float*, 8 * (k))
        unsigned char* ws = KARG(unsigned char*, 8 * 17); float* out = KARG(float*, 8 * 16);
        bf16* Wb = (bf16*)(ws + WS_W); bf16* HM = (bf16*)(ws + WS_HM); float* Gt = (float*)(ws + WS_G); float* tab = (float*)(ws + WS_TAB); float* kmean = (float*)(ws + WS_KMEAN);
        float* KVc = (float*)(ws + WS_KVC); float* nst = (float*)(ws + WS_NST); float* dec = (float*)(ws + WS_DEC); bf16* KVcb = (bf16*)(ws + WS_KVCB); bf16* W1t = (bf16*)(ws + WS_W1T); float* C1 = (float*)(ws + WS_C1); bf16* P = (bf16*)(ws + WS_P); bf16* CT = (bf16*)(ws + WS_C); bf16* QK2 = (bf16*)(ws + WS_C + 64 * MiB); bf16* XB = QK2  ; unsigned long long* SSA = (unsigned long long*)(ws + WS_SSP); unsigned long long* SSB = SSA + T;     bf16* U = (bf16*)(ws + WS_U);
        const int l = ph == 0 ? 0 : (ph - 1) / 8, j = ph == 0 ? -1 : (ph - 1) % 8;
        const float* x = IN(0);
        const float* xin = l == 0 ? x : out;
        const bf16* WinT = Wb + l * W_LAYER; const bf16* WoT = WinT + (size_t)DINP * DM; const bf16* W1T = WoT + (size_t)DM * DM; const bf16* W2T = W1T + (size_t)DFF * DM;
        if (ph == 0) {
            PH_LOCALS
            const float* w_in = IN(1); const float* w_out = IN(11); const float* w_ff1 = IN(14); const float* w_ff2 = IN(15);
            for (int rep = 0; rep < DUP_PRO; ++rep) {
            for (int ll = 0; ll < DEPTH; ++ll) {
                bf16* WinT_ = Wb + ll * W_LAYER; bf16* WoT_ = WinT_ + (size_t)DINP * DM; bf16* W1T_ = WoT_ + (size_t)DM * DM; bf16* W2T_ = W1T_ + (size_t)DFF * DM;
                for (int mt = 0; mt < 4; ++mt) {
                    const float* W; int K, N, NP, mode; bf16* WT;
                    const float* gk = nullptr;
                    if (mt == 0) { W = w_in + (size_t)ll * DM * DIN; K = DM; N = DIN; NP = DINP; WT = WinT_; mode = 1; gk = IN(12) + ll * DM; }
                    else if (mt == 1) { W = w_out + (size_t)ll * DM * DM; K = DM; N = DM; NP = DM; WT = WoT_; mode = 0; }
                    else if (mt == 2) { W = w_ff1 + (size_t)ll * DM * DFF; K = DM; N = DFF; NP = DFF; WT = W1T_; mode = 0; gk = IN(13) + ll * DM; }
                    else { W = w_ff2 + (size_t)ll * DFF * DM; K = DFF; N = DM; NP = DM; WT = W2T_; mode = 0; }
                    const int nit = (NP / 64) * (K / 64);
                    for (int it0 = 0; it0 < nit; it0 += NVB) { const int it = it0 + vb; ph_convert_w(W, K, N, NP, WT, mode, it, it < nit, t256, (float*)smh, gk); }
                }
            }
            for (int lk = 0; lk < DEPTH * 2; ++lk) {
                const int nit = 2 * 32;
                for (int it0 = 0; it0 < nit; it0 += NVB) { const int it = it0 + vb; ph_convert_w(IN(9) + (size_t)lk * 2048 * 128, 2048, 128, 128, W1t + (size_t)lk * 128 * 2048, 0, it, it < nit, t256, (float*)smh); }
            }
            for (int it = bid; it < 64; it += G) cmp_c1_item(IN(8), IN(9), C1, it, tid, (LAS unsigned char*)lds);
            for (int i = bid * 512 + tid; i < SEQ * 8; i += G * 512) { const int pos = i >> 3, f = i & 7;
                float c_, s_; rope_cs(pos, f, c_, s_);
                tab[pos * 16 + f] = c_; tab[pos * 16 + 8 + f] = s_; }
            for (int row = gwv; row < T; row += NGW) ph_x_row(x, XB, SSA, row, lane);
            }
        } else if (j == 0 || j >= 5) {
            pg8::Gemm g; pg8::EpiAny E; int N; const bool last = (l + 1 == DEPTH);
            if (j == 0) { g = pg8::Gemm{XB, WinT, T, DINP, DM}; N = DINP; E = pg8::EpiAny{0, true, P, DINP, Gt, C_GATE, nullptr, nullptr, nullptr, SSA}; }
            else if (j == 5) { g = pg8::Gemm{HM, WoT, T, DM, DM}; N = DM; E = pg8::EpiAny{2, false, nullptr, DM, nullptr, 0, xin, out, XB, SSB}; }
            else if (j == 6) { g = pg8::Gemm{XB, W1T, T, DFF, DM}; N = DFF; E = pg8::EpiAny{1, true, U, DFF, nullptr, 0, nullptr, nullptr, nullptr, SSB}; }
            else { g = pg8::Gemm{U, W2T, T, DM, DFF}; N = DM; E = pg8::EpiAny{2, false, nullptr, DM, nullptr, 0, out, out, last ? nullptr : XB, SSA}; }
            pg8::StaticOrder S; S.init(T, N, G, bid);
            for (int rep = 0; rep < ((j == 0 || j == 6) ? DUP_GEMM : 1); ++rep) pg8::gemm_phase<pg8::EpiAny, pg8::StaticOrder, true, true>((PG8_LAS unsigned char*)lds, g, S, E, tid);
        } else if (j == 1) {
            PH_LOCALS
            for (int rep = 0; rep < DUP_CMP; ++rep) for (int it = bid; it < 64; it += G) compress_item(P, W1t + (size_t)l * 2 * 128 * 2048, C1 + l * 256, IN(10) + (size_t)l * 2 * 128 * 64, IN(7) + l * 192, KVcb, it, tid, (LAS unsigned char*)lds);
            for (int it0 = 0; it0 < 128 * 14; it0 += NVB) { const int it = it0 + vb; ph_prep(P, tab, IN(5) + l * 128, IN(6) + l * 64, IN(7) + l * 192, kmean, it, it < 128 * 14, t256, (float*)smh); }
            for (int rep = 0; rep < DUP_QK2; ++rep) qk2_rows(P, IN(3) + (size_t)l * 4 * 1024, QK2, bid, G, tid);
            { unsigned long long z64 = 0ull; asm volatile("" : "+v"(z64)); for (int i = bid * 512 + tid; i < 2 * T; i += G * 512) SSA[i] = z64; }
        } else if (j == 2) {
            for (int rep = 0; rep < DUP_M1; ++rep) mlstm_m1_phase(P, QK2, Gt, IN(2) + l * 8, CT, nst, dec, bid, G, tid, (LAS unsigned char*)lds);
            for (int rep = 0; rep < DUP_MOBA; ++rep) for (int pu = bid; pu < 256; pu += G) { const int bh = pu >> 4, s = pu & 15;
                moba_unit(P, kmean, IN(5) + l * 128 + 64, HM, bh >> 2, bh & 3, 31 - s, tid, (LAS unsigned char*)lds); moba_unit(P, kmean, IN(5) + l * 128 + 64, HM, bh >> 2, bh & 3, s, tid, (LAS unsigned char*)lds); }
        } else if (j == 3) {
            for (int it = bid; it < 16 * 9; it += G) mlstm_scan(CT, nst, dec, it, tid);
            for (int rep = 0; rep < DUP_NSA; ++rep) for (int pu = bid; pu < 256; pu += G) { const int b_ = pu >> 6, s = pu & 63;
                nsa_unit(P, Gt, tab, KVcb, IN(7) + l * 192, HM, b_, 127 - s, tid, (LAS unsigned char*)lds); nsa_unit(P, Gt, tab, KVcb, IN(7) + l * 192, HM, b_, s, tid, (LAS unsigned char*)lds); }
        } else {
            for (int rep = 0; rep < DUP_M3; ++rep) mlstm_m3_phase(P, QK2, Gt, IN(2) + l * 8, CT, nst, IN(4) + l * 512, HM, bid, G, tid, (LAS unsigned char*)lds);
        }
        if (ph + 1 < NPH) { if (ph == 0) grid.sync(); else { XcdBarrier xbar; xbar.bar = (unsigned*)(ws + WS_BAR); xbar.x = xb_xcc_id(); xbar.st = xst; xcd_barrier(xbar); } }
    }
#undef IN
#undef KARG
#undef PH_LOCALS
}

extern "C" void kernel_launch(void* const* d_in, const int* in_sizes, int n_in, void* d_out, int out_size, void* d_ws, size_t ws_size, hipStream_t stream) {
    static int grid = 0;
    if (grid == 0) {
        if (n_in != 16 || in_sizes[0] != T * DM || out_size != T * DM || ws_size < WS_END) { fprintf(stderr, "kernel_launch: unexpected shapes / workspace %zu < %zu\n", ws_size, (size_t)WS_END); grid = -1; return; }
        int dev = 0, cus = 0, per_cu = 0;
        if (hipGetDevice(&dev) != hipSuccess || hipDeviceGetAttribute(&cus, hipDeviceAttributeMultiprocessorCount, dev) != hipSuccess) { grid = -1; return; }
        if (hipFuncSetAttribute((const void*)hybrid_fwd, hipFuncAttributeMaxDynamicSharedMemorySize, LDS_BYTES) != hipSuccess) { fprintf(stderr, "kernel_launch: hipFuncSetAttribute failed\n"); grid = -1; return; }
        if (hipOccupancyMaxActiveBlocksPerMultiprocessor(&per_cu, (const void*)hybrid_fwd, 512, LDS_BYTES) != hipSuccess || per_cu < 1) { fprintf(stderr, "kernel_launch: occupancy query failed (%d)\n", per_cu); grid = -1; return; }
        grid = cus * per_cu;
        fprintf(stderr, "kernel_launch: grid %d (%d CUs x %d)\n", grid, cus, per_cu);
    }
    if (grid < 0) return;
    if (hipMemsetAsync((char*)d_ws + WS_BAR, 0, XCD_BAR_WORDS * 4, stream) != hipSuccess) { fprintf(stderr, "kernel_launch: memset failed\n"); return; }
    Params p{};
    for (int i = 0; i < 16; ++i) p.in[i] = (const float*)d_in[i];
    p.out = (float*)d_out; p.ws = (unsigned char*)d_ws;
    void* args[] = {&p};
    hipError_t e = hipLaunchCooperativeKernel((const void*)hybrid_fwd, dim3(grid), dim3(512), args, LDS_BYTES, stream);
    if (e != hipSuccess) fprintf(stderr, "kernel_launch: cooperative launch failed: %s (grid %d)\n", hipGetErrorString(e), grid);
}
```

```cpp
#include <hip/hip_runtime.h>
#include <hip/hip_cooperative_groups.h>
#include <cstdio>
#include <cstdint>
namespace cg = cooperative_groups;
namespace pg8 {
#define PG8_LAS __attribute__((address_space(3)))
typedef unsigned short bf16_t;
typedef short bf16x8 __attribute__((ext_vector_type(8)));
typedef float f32x4 __attribute__((ext_vector_type(4)));
typedef unsigned u32x4 __attribute__((ext_vector_type(4)));
constexpr int BM = 256, BK = 64, HALF = 128, HTB = HALF * BK * 2  , STAGE_BYTES = 8 * HTB, NXCD = 8, WGM = 8;

__host__ __device__ __forceinline__ int lds_byte(int r, int c) { const int st = (r >> 4) * 2 + (c >> 5), rr = r & 15, cc = c & 31, ob = rr * 64 + cc * 2; return st * 1024 + (ob ^ (((ob >> 9) & 1) << 5)); }
__host__ __device__ __forceinline__ void stage_rc(int b, int& R, int& C) { const int st = b / 1024, sb = b % 1024, swz = sb ^ (((sb >> 9) & 1) << 5); R = (st >> 1) * 16 + swz / 64; C = (st & 1) * 32 + (swz % 64) / 2; }
__host__ __device__ __forceinline__ int perm32(int rho) { const int n = rho >> 4, i = rho & 15; return 8 * (i >> 2) + 4 * n + (i & 3); }

struct Unit { int pm, pn; };
struct Gemm { const bf16_t* A; const bf16_t* Bt; int M, N, K; };

struct StaticOrder {
    int nM, nN, nwg, G, c;
    __host__ __device__ void init(int M, int N, int G_, int c_) { nM = M / BM; nN = N / BM; nwg = nM * nN; G = G_; c = c_; }
    __host__ __device__ bool next(int i, Unit& u) const {
        const long L = (long)i * G + c; if (L >= nwg) return false;
        int wgid = (int)L; { const int q = nwg / NXCD, r = nwg % NXCD, xcd = wgid % NXCD, off = wgid / NXCD; wgid = (xcd < r ? xcd * (q + 1) : r * (q + 1) + (xcd - r) * q) + off; }
        const int nig = WGM * nN, gid = wgid / nig, fm = gid * WGM, gsz = (nM - fm) < WGM ? (nM - fm) : WGM;
        u.pm = fm + ((wgid % nig) % gsz); u.pn = (wgid % nig) / gsz; return true;
    }
    __device__ __forceinline__ void a_ready(const Unit&) const {}
    __device__ __forceinline__ void done(const Unit&) const {}
};

__device__ __forceinline__ unsigned f2bf_u(float f) { unsigned u = __builtin_bit_cast(unsigned, f); return (u + 0x7fffu + ((u >> 16) & 1u)) >> 16; }
__device__ __forceinline__ unsigned pk2bf(float lo, float hi) { return f2bf_u(lo) | (f2bf_u(hi) << 16); }

__device__ __forceinline__ unsigned cvtpk_bf16(float lo, float hi) { typedef float f2_ __attribute__((ext_vector_type(2))); typedef __bf16 b2_ __attribute__((ext_vector_type(2)));
    f2_ v = {lo, hi}; b2_ b = __builtin_convertvector(v, b2_); return __builtin_bit_cast(unsigned, b); }
__device__ __forceinline__ float swz_xor16(float v) { return __uint_as_float((unsigned)__builtin_amdgcn_ds_swizzle((int)__float_as_uint(v), 0x1F | (16 << 10))); }
__device__ __forceinline__ float half_sum(float v) { auto rr = __builtin_amdgcn_permlane32_swap(__float_as_uint(v), __float_as_uint(v), false, false); return __uint_as_float(rr[0]) + __uint_as_float(rr[1]); }
__device__ __forceinline__ float row_rstd(const unsigned long long* ssq, int row) { return __builtin_amdgcn_rsqf((float)ssq[row] * (1.0f / (1048576.0f * 1024.0f)) + 1e-6f); }

struct EpiProj {
    static constexpr bool PERM = true, AFTER_DRAIN = false;
    bf16_t* O; int ldc; float* gates; int gate0; const unsigned long long* ssp;
    __device__ __forceinline__ void operator()(const f32x4 (&acc)[2][2][4][2], const Unit& u, int wr, int wc, int fr, int fq) const {
        const int row0 = u.pm * BM + wr * 64 + fr; const int col0 = u.pn * BM + wc * 32 + 8 * fq;
        float rsv[2][4];
#pragma unroll
        for (int ai = 0; ai < 2; ++ai)
#pragma unroll
            for (int m = 0; m < 4; ++m) rsv[ai][m] = row_rstd(ssp, row0 + ai * HALF + m * 16);
#pragma unroll
        for (int ai = 0; ai < 2; ++ai)
#pragma unroll
            for (int m = 0; m < 4; ++m) { const int row = row0 + ai * HALF + m * 16; bf16_t* rowp = O + (size_t)row * ldc + col0; const float rs = rsv[ai][m];
#pragma unroll
                for (int bj = 0; bj < 2; ++bj) { const f32x4 v0 = acc[ai][bj][m][0] * rs, v1 = acc[ai][bj][m][1] * rs;
                    u32x4 w; w.x = cvtpk_bf16(v0[0], v0[1]); w.y = cvtpk_bf16(v0[2], v0[3]); w.z = cvtpk_bf16(v1[0], v1[1]); w.w = cvtpk_bf16(v1[2], v1[3]);
                    *(u32x4*)(rowp + bj * HALF) = w;
                    const int c = col0 + bj * HALF - gate0;
                    if (c >= 0 && c < 32) { float* g = gates + (size_t)row * 32 + c; *(f32x4*)g = v0; *(f32x4*)(g + 4) = v1; } } }
    }
};
struct EpiRelu2 {
    static constexpr bool PERM = true, AFTER_DRAIN = false;
    bf16_t* O; int ldc; const unsigned long long* ssp;
    __device__ __forceinline__ void operator()(const f32x4 (&acc)[2][2][4][2], const Unit& u, int wr, int wc, int fr, int fq) const {
        const int row0 = u.pm * BM + wr * 64 + fr; const int col0 = u.pn * BM + wc * 32 + 8 * fq;
        float rsv[2][4];
#pragma unroll
        for (int ai = 0; ai < 2; ++ai)
#pragma unroll
            for (int m = 0; m < 4; ++m) rsv[ai][m] = row_rstd(ssp, row0 + ai * HALF + m * 16);
#pragma unroll
        for (int ai = 0; ai < 2; ++ai)
#pragma unroll
            for (int m = 0; m < 4; ++m) { const int row = row0 + ai * HALF + m * 16; bf16_t* rowp = O + (size_t)row * ldc + col0; const float rs = rsv[ai][m];
#pragma unroll
                for (int bj = 0; bj < 2; ++bj) { f32x4 v0 = acc[ai][bj][m][0] * rs, v1 = acc[ai][bj][m][1] * rs;
#pragma unroll
                    for (int e = 0; e < 4; ++e) { float a = v0[e] > 0.f ? v0[e] : 0.f; v0[e] = a * a; float b = v1[e] > 0.f ? v1[e] : 0.f; v1[e] = b * b; }
                    u32x4 w; w.x = cvtpk_bf16(v0[0], v0[1]); w.y = cvtpk_bf16(v0[2], v0[3]); w.z = cvtpk_bf16(v1[0], v1[1]); w.w = cvtpk_bf16(v1[2], v1[3]);
                    *(u32x4*)(rowp + bj * HALF) = w; } }
    }
};
struct EpiResid {
    static constexpr bool PERM = false, AFTER_DRAIN = false;
    const float* base; float* out; int ldc; bf16_t* xb; unsigned long long* ssp;
    __device__ __forceinline__ void operator()(const f32x4 (&acc)[2][2][4][2], const Unit& u, int wr, int wc, int fr, int fq) const {
        const int row0 = u.pm * BM + wr * 64 + fr; const int col0 = u.pn * BM + wc * 32 + 4 * fq;
#pragma unroll
        for (int ai = 0; ai < 2; ++ai)
#pragma unroll
            for (int m = 0; m < 4; ++m) { const int row = row0 + ai * HALF + m * 16; const size_t off = (size_t)row * ldc + col0; float ss = 0.f;
#pragma unroll
                for (int bj = 0; bj < 2; ++bj)
#pragma unroll
                    for (int n = 0; n < 2; ++n) { const size_t o = off + bj * HALF + n * 16; const f32x4 b = *(const f32x4*)(base + o); const f32x4 v = b + acc[ai][bj][m][n]; *(f32x4*)(out + o) = v;
                        if (xb) { ss += (v[0] * v[0] + v[1] * v[1]) + (v[2] * v[2] + v[3] * v[3]); typedef unsigned u32x2_ __attribute__((ext_vector_type(2)));
                            u32x2_ w; w.x = cvtpk_bf16(v[0], v[1]); w.y = cvtpk_bf16(v[2], v[3]); *(u32x2_*)(xb + o) = w; } }
                if (xb) { ss += swz_xor16(ss); ss = half_sum(ss); if (fq == 0) atomicAdd(ssp + row, (unsigned long long)(ss * 1048576.0f + 0.5f)); } }
    }
};

struct EpiAny {
    static constexpr bool AFTER_DRAIN = false;
    int kind; bool perm;
    bf16_t* O; int ldc; float* gates; int gate0; const float* base; float* out; bf16_t* xb; unsigned long long* ssp;
    __device__ __forceinline__ void operator()(const f32x4 (&acc)[2][2][4][2], const Unit& u, int wr, int wc, int fr, int fq) const {
        if (kind == 0) { EpiProj e{O, ldc, gates, gate0, ssp}; e(acc, u, wr, wc, fr, fq); }
        else if (kind == 1) { EpiRelu2 e{O, ldc, ssp}; e(acc, u, wr, wc, fr, fq); }
        else { EpiResid e{base, out, ldc, xb, ssp}; e(acc, u, wr, wc, fr, fq); }
    }
};
template <class Epi, class Sched, bool ALIGN_EPI = false, bool SP2 = false>
__device__ __forceinline__ void gemm_phase(PG8_LAS unsigned char* lds, const Gemm g, const Sched& S, const Epi& E, const int tid) {
    const int wid = __builtin_amdgcn_readfirstlane(tid >> 6), lane = tid & 63, wr = wid >> 2, wc = wid & 3, fr = lane & 15, fq = lane >> 4;
    const int K = g.K, nt = K / BK;
    unsigned voffA[2], voffB[2];
#pragma unroll
    for (int i = 0; i < 2; ++i) { int R, C; stage_rc(tid * 16 + i * 8192, R, C); const int Rb = E.perm ? ((R & ~31) + perm32(R & 31)) : R;
        voffA[i] = (unsigned)(R * K + C) * 2u; voffB[i] = (unsigned)(Rb * K + C) * 2u; }
    const size_t kstep = (size_t)(BK * 2);
    const size_t hstep = (size_t)HALF * K * 2;
    const size_t tstep = 2 * hstep;
    const unsigned ldsw = (unsigned)wid * 1024u;
    const int aoff = lds_byte(wr * 64 + fr, fq * 8), boff = lds_byte(wc * 32 + fr, fq * 8);
#define PG8_SA(b, h) (((b) * 2 + (h)) * HTB)
#define PG8_SB(b, h) ((4 + (b) * 2 + (h)) * HTB)
#define PG8_STAGE(bufoff, gbase, voff) do { _Pragma("unroll") for (int _i = 0; _i < 2; ++_i) \
        __builtin_amdgcn_global_load_lds((const unsigned*)((const char*)(gbase) + (voff)[_i]), (PG8_LAS unsigned*)(lds + (bufoff) + ldsw + _i * 8192), 16, 0, 0); } while (0)
#define PG8_LDA(dst, b, h) do { _Pragma("unroll") for (int m = 0; m < 4; ++m) _Pragma("unroll") for (int k = 0; k < 2; ++k) dst[m][k] = *(const PG8_LAS bf16x8*)(lds + PG8_SA(b, h) + aoff + m * 2048 + k * 1024); } while (0)
#define PG8_LDB(dst, b, h) do { _Pragma("unroll") for (int n = 0; n < 2; ++n) _Pragma("unroll") for (int k = 0; k < 2; ++k) dst[n][k] = *(const PG8_LAS bf16x8*)(lds + PG8_SB(b, h) + boff + n * 2048 + k * 1024); } while (0)
#define PG8_MMA(ai, bj, At, Bt) do { __builtin_amdgcn_s_setprio(1); _Pragma("unroll") for (int m = 0; m < 4; ++m) _Pragma("unroll") for (int n = 0; n < 2; ++n) _Pragma("unroll") for (int k = 0; k < 2; ++k) \
        acc[ai][bj][m][n] = __builtin_amdgcn_mfma_f32_16x16x32_bf16(Bt[n][k], At[m][k], acc[ai][bj][m][n], 0, 0, 0); __builtin_amdgcn_s_setprio(0); } while (0)
#define PG8_WAIT_V(n) asm volatile("s_waitcnt vmcnt(" #n ")" ::: "memory")
#define PG8_WAIT_L(n) asm volatile("s_waitcnt lgkmcnt(" #n ")" ::: "memory")
#define PG8_BAR __builtin_amdgcn_s_barrier()
#define PG8_SCHED __builtin_amdgcn_sched_barrier(0)
    Unit cur, nxt; int ui = 0;
    if (!S.next(0, cur)) return;
    f32x4 acc[2][2][4][2];
#pragma unroll
    for (int a = 0; a < 2; ++a)
#pragma unroll
        for (int b = 0; b < 2; ++b)
#pragma unroll
            for (int m = 0; m < 4; ++m)
#pragma unroll
                for (int n = 0; n < 2; ++n) acc[a][b][m][n] = (f32x4){0.f, 0.f, 0.f, 0.f};
    bf16x8 At[4][2], B0[2][2], B1[2][2];
    const char* cA = (const char*)g.A + (size_t)cur.pm * tstep; const char* cB = (const char*)g.Bt + (size_t)cur.pn * tstep;
    S.a_ready(cur);
    if constexpr (SP2) {
        PG8_STAGE(PG8_SB(0, 0), cB, voffB); PG8_STAGE(PG8_SB(0, 1), cB + hstep, voffB); PG8_STAGE(PG8_SA(0, 0), cA, voffA); PG8_STAGE(PG8_SA(0, 1), cA + hstep, voffA);
        if (wr == 1) PG8_BAR;
        PG8_WAIT_V(2); PG8_BAR;
        PG8_STAGE(PG8_SB(1, 0), cB + kstep, voffB); PG8_STAGE(PG8_SA(1, 0), cA + kstep, voffA); PG8_STAGE(PG8_SB(1, 1), cB + hstep + kstep, voffB);
        PG8_WAIT_V(6); PG8_BAR;
    } else {
        PG8_STAGE(PG8_SB(0, 0), cB, voffB); PG8_STAGE(PG8_SA(0, 0), cA, voffA); PG8_STAGE(PG8_SB(0, 1), cB + hstep, voffB); PG8_STAGE(PG8_SA(0, 1), cA + hstep, voffA);
        if (wr == 1) PG8_BAR;
        PG8_WAIT_V(4); PG8_BAR;
        PG8_STAGE(PG8_SB(1, 0), cB + kstep, voffB); PG8_STAGE(PG8_SA(1, 0), cA + kstep, voffA); PG8_STAGE(PG8_SB(1, 1), cB + hstep + kstep, voffB);
        PG8_WAIT_V(6); PG8_BAR;
    }
    for (;;) {
        const bool has_next = S.next(ui + 1, nxt);
        const char* nA = has_next ? (const char*)g.A + (size_t)nxt.pm * tstep : cA; const char* nB = has_next ? (const char*)g.Bt + (size_t)nxt.pn * tstep : cB;
        for (int t = 0; t < nt; t += 2) {
            const bool last = (t == nt - 2);
            const char* a1 = cA + (size_t)(t + 1) * kstep;
            const char* a2 = last ? nA : cA + (size_t)(t + 2) * kstep; const char* b2 = last ? nB : cB + (size_t)(t + 2) * kstep;
            const char* a3 = a2 + kstep; const char* b3 = b2 + kstep;
            if (last && has_next) S.a_ready(nxt);
            if constexpr (SP2) {
            PG8_LDB(B0, 0, 0); PG8_LDB(B1, 0, 1); PG8_SCHED; PG8_LDA(At, 0, 0); PG8_STAGE(PG8_SA(1, 1), a1 + hstep, voffA);
            PG8_WAIT_V(8); PG8_WAIT_L(0); PG8_BAR; PG8_MMA(0, 0, At, B0); PG8_MMA(0, 1, At, B1); PG8_BAR; PG8_SCHED;
            PG8_LDA(At, 0, 1); PG8_STAGE(PG8_SB(0, 0), b2, voffB); PG8_STAGE(PG8_SB(0, 1), b2 + hstep, voffB); PG8_STAGE(PG8_SA(0, 0), a2, voffA);
            PG8_WAIT_V(8); PG8_WAIT_L(0); PG8_BAR; PG8_MMA(1, 0, At, B0); PG8_MMA(1, 1, At, B1); PG8_BAR; PG8_SCHED;
            PG8_LDB(B0, 1, 0); PG8_LDB(B1, 1, 1); PG8_SCHED; PG8_LDA(At, 1, 0); PG8_STAGE(PG8_SA(0, 1), a2 + hstep, voffA);
            PG8_WAIT_V(8); PG8_WAIT_L(0); PG8_BAR; PG8_MMA(0, 0, At, B0); PG8_MMA(0, 1, At, B1); PG8_BAR; PG8_SCHED;
            PG8_LDA(At, 1, 1); PG8_STAGE(PG8_SB(1, 0), b3, voffB); PG8_STAGE(PG8_SB(1, 1), b3 + hstep, voffB); PG8_STAGE(PG8_SA(1, 0), a3, voffA);
            PG8_WAIT_V(8); PG8_WAIT_L(0); PG8_BAR; PG8_MMA(1, 0, At, B0); PG8_MMA(1, 1, At, B1); PG8_BAR; PG8_SCHED;
            } else {
            PG8_LDB(B0, 0, 0); PG8_SCHED; PG8_LDA(At, 0, 0); PG8_STAGE(PG8_SA(1, 1), a1 + hstep, voffA);
            PG8_WAIT_L(8); PG8_BAR; PG8_WAIT_L(0); PG8_MMA(0, 0, At, B0); PG8_BAR; PG8_SCHED;
            PG8_LDB(B1, 0, 1); PG8_STAGE(PG8_SB(0, 0), b2, voffB);
            PG8_BAR; PG8_WAIT_L(0); PG8_MMA(0, 1, At, B1); PG8_BAR;
            PG8_LDA(At, 0, 1); PG8_STAGE(PG8_SA(0, 0), a2, voffA);
            PG8_BAR; PG8_WAIT_L(0); PG8_MMA(1, 0, At, B0); PG8_BAR; PG8_SCHED;
            PG8_STAGE(PG8_SB(0, 1), b2 + hstep, voffB);
            PG8_WAIT_V(6); PG8_BAR; PG8_MMA(1, 1, At, B1); PG8_BAR;
            PG8_LDB(B0, 1, 0); PG8_SCHED; PG8_LDA(At, 1, 0); PG8_STAGE(PG8_SA(0, 1), a2 + hstep, voffA);
            PG8_WAIT_L(8); PG8_BAR; PG8_WAIT_L(0); PG8_MMA(0, 0, At, B0); PG8_BAR; PG8_SCHED;
            PG8_LDB(B1, 1, 1); PG8_STAGE(PG8_SB(1, 0), b3, voffB);
            PG8_BAR; PG8_WAIT_L(0); PG8_MMA(0, 1, At, B1); PG8_BAR;
            PG8_LDA(At, 1, 1); PG8_STAGE(PG8_SA(1, 0), a3, voffA);
            PG8_BAR; PG8_WAIT_L(0); PG8_MMA(1, 0, At, B0); PG8_BAR; PG8_SCHED;
            PG8_STAGE(PG8_SB(1, 1), b3 + hstep, voffB);
            PG8_WAIT_V(6); PG8_BAR; PG8_MMA(1, 1, At, B1); PG8_BAR;
            }
        }
        if constexpr (ALIGN_EPI) { if (wr == 0) PG8_BAR; }
        if constexpr (!Epi::AFTER_DRAIN) { E(acc, cur, wr, wc, fr, fq); S.done(cur); }
        if (!has_next) break;
#pragma unroll
        for (int a = 0; a < 2; ++a)
#pragma unroll
            for (int b = 0; b < 2; ++b)
#pragma unroll
                for (int m = 0; m < 4; ++m)
#pragma unroll
                    for (int n = 0; n < 2; ++n) acc[a][b][m][n] = (f32x4){0.f, 0.f, 0.f, 0.f};
        cur = nxt; cA = nA; cB = nB; ++ui;
        if constexpr (ALIGN_EPI) { if (wr == 1) PG8_BAR; }
    }
    PG8_WAIT_V(0);
    if constexpr (!ALIGN_EPI) { if (wr == 0) PG8_BAR; }
    PG8_BAR;
    if constexpr (Epi::AFTER_DRAIN) { E.fused(acc, cur, wr, wc, fr, fq, lds, wid, lane); S.done(cur); }
#undef PG8_SA
#undef PG8_SB
#undef PG8_STAGE
#undef PG8_LDA
#undef PG8_LDB
#undef PG8_MMA
#undef PG8_WAIT_V
#undef PG8_WAIT_L
#undef PG8_BAR
#undef PG8_SCHED
}
}

typedef unsigned short bf16;
constexpr int NB = 4, SEQ = 8192, T = NB * SEQ, DM = 1024, DFF = 4096, DEPTH = 2;
constexpr int DIN = 3476, DINP = 3584;
constexpr int C_MQ = 0, C_MK = 512, C_MV = 1024, C_MO = 1536, C_BQ = 2048, C_BK = 2304, C_BV = 2560, C_NQ = 2816,
              C_NKC = 3072, C_NVC = 3136, C_NKS = 3200, C_NVS = 3264, C_NKW = 3328, C_NVW = 3392, C_GATE = 3456;
constexpr int NCMP = 511;
constexpr float EPS = 1e-6f;

__device__ __forceinline__ float bf2f(bf16 v) { return __builtin_bit_cast(float, (unsigned)v << 16); }
__device__ __forceinline__ bf16 f2bf(float f) { return (bf16)pg8::f2bf_u(f); }
template <int MASK> __device__ __forceinline__ float shx(float v) {
    if constexpr (MASK == 32) { auto rr = __builtin_amdgcn_permlane32_swap(__float_as_uint(v), __float_as_uint(v), false, false);
        return __uint_as_float(__builtin_amdgcn_mbcnt_lo(~0u, 0u) == 32u ? rr[0] : rr[1]); }
    else return __uint_as_float((unsigned)__builtin_amdgcn_ds_swizzle((int)__float_as_uint(v), 0x1F | (MASK << 10)));
}
__device__ __forceinline__ float xchg32(float v, int hi) { auto rr = __builtin_amdgcn_permlane32_swap(__float_as_uint(v), __float_as_uint(v), false, false); return __uint_as_float(hi ? rr[0] : rr[1]); }
__device__ __forceinline__ float hsum32(float v) { auto rr = __builtin_amdgcn_permlane32_swap(__float_as_uint(v), __float_as_uint(v), false, false); return __uint_as_float(rr[0]) + __uint_as_float(rr[1]); }
__device__ __forceinline__ float hmax32(float v) { auto rr = __builtin_amdgcn_permlane32_swap(__float_as_uint(v), __float_as_uint(v), false, false); return fmaxf(__uint_as_float(rr[0]), __uint_as_float(rr[1])); }
template <int MASK> __device__ __forceinline__ unsigned shxu(unsigned v) { return __float_as_uint(shx<MASK>(__uint_as_float(v))); }
__device__ __forceinline__ float wave_sum(float v) {
    v += shx<1>(v); v += shx<2>(v); v += shx<4>(v); v += shx<8>(v); v += shx<16>(v);
    auto rr = __builtin_amdgcn_permlane32_swap(__float_as_uint(v), __float_as_uint(v), false, false); return __uint_as_float(rr[0]) + __uint_as_float(rr[1]);
}
__device__ __forceinline__ float wave_max(float v) {
    v = fmaxf(v, shx<1>(v)); v = fmaxf(v, shx<2>(v)); v = fmaxf(v, shx<4>(v)); v = fmaxf(v, shx<8>(v)); v = fmaxf(v, shx<16>(v));
    auto rr = __builtin_amdgcn_permlane32_swap(__float_as_uint(v), __float_as_uint(v), false, false); return fmaxf(__uint_as_float(rr[0]), __uint_as_float(rr[1]));
}
__device__ __forceinline__ float sgprf(float c) { asm volatile("" : "+s"(c)); return c; }
#define nbg (sgprf(-1e30f))
__device__ __forceinline__ int mk_tid(int wave_s) { int t; asm volatile("v_mbcnt_lo_u32_b32 %0, -1, 0\n\tv_mbcnt_hi_u32_b32 %0, -1, %0" : "=v"(t)); return t + wave_s * 64; }
__device__ __forceinline__ float zf_() { float z = 0.f; asm volatile("" : "+v"(z)); return z; }
__device__ __forceinline__ float rcpf_(float x) { return __builtin_amdgcn_rcpf(x); }
__device__ __forceinline__ float sigmoidf_(float x) { return rcpf_(1.f + __expf(-x)); }
__device__ __forceinline__ float log_sigmoidf_(float x) { return fminf(x, 0.f) - __logf(1.f + __expf(-fabsf(x))); }
__device__ __forceinline__ void rope_cs(int pos, int f, float& c, float& s) {
    const float invf = f == 0 ? 1.0f : f == 1 ? 0.193922758102417f : f == 2 ? 0.03760603442788124f : f == 3 ? 0.007292666472494602f : f == 4 ? 0.0014142136787995696f
                     : f == 5 ? 0.00027424818836152554f : f == 6 ? 5.318298644851893e-05f : 1.031338433676865e-05f;
    const float ang = (float)pos * invf;
    const float k = rintf(ang * 0.15915493667125702f);
    float r = fmaf(-k, 6.2831854820251465f, ang); r = fmaf(-k, -1.7484555314695172e-07f, r);
    c = __cosf(r); s = __sinf(r);
}


__device__ __forceinline__ float dot64(const bf16* __restrict__ kp, const float* q) {
    const uint4* k4 = (const uint4*)kp; float a = 0.f;
#pragma unroll
    for (int j = 0; j < 8; ++j) { const uint4 w = k4[j]; const unsigned ww[4] = {w.x, w.y, w.z, w.w};
#pragma unroll
        for (int e = 0; e < 4; ++e) { a = fmaf(q[8 * j + 2 * e], __builtin_bit_cast(float, ww[e] << 16), a); a = fmaf(q[8 * j + 2 * e + 1], __builtin_bit_cast(float, ww[e] & 0xffff0000u), a); } }
    return a;
}
__device__ __forceinline__ void dot64x4(const bf16* __restrict__ kp, const float (*q)[64], float (&a)[4]) {
    const uint4* k4 = (const uint4*)kp; a[0] = a[1] = a[2] = a[3] = 0.f;
#pragma unroll
    for (int j = 0; j < 8; ++j) { const uint4 w = k4[j]; const unsigned ww[4] = {w.x, w.y, w.z, w.w};
#pragma unroll
        for (int e = 0; e < 4; ++e) { const float k0 = __builtin_bit_cast(float, ww[e] << 16), k1 = __builtin_bit_cast(float, ww[e] & 0xffff0000u);
#pragma unroll
            for (int h = 0; h < 4; ++h) { a[h] = fmaf(q[h][8 * j + 2 * e], k0, a[h]); a[h] = fmaf(q[h][8 * j + 2 * e + 1], k1, a[h]); } } }
}

__host__ __device__ __forceinline__ int win_src(int n) {
    if (n < 2048) return n;
    if (n < 3456) return n + 8;
    if (n < 3464) return n - 3456 + 2048;
    if (n < 3476) return n;
    return -1;
}


typedef unsigned u32x4p __attribute__((ext_vector_type(4)));
__device__ __forceinline__ void ph_convert_w(const float* __restrict__ W, int K, int N, int NP, bf16* __restrict__ WT, int mode, int item, bool act, int t, float* tile  , const float* __restrict__ gk = nullptr) {
    const int nbx = NP / 64; const int n0 = (item % nbx) * 64, k0 = (item / nbx) * 64, c = t & 63, r = t >> 6;
    if (act) { const int src = mode ? win_src(n0 + c) : (n0 + c);
#pragma unroll
        for (int i = 0; i < 16; ++i) { const int k = r + 4 * i; tile[k * 65 + c] = (src >= 0) ? W[(size_t)(k0 + k) * N + src] * (gk ? gk[k0 + k] : 1.f) : 0.f; } }
    __syncthreads();
    if (act) { const int n = t >> 2, kc = (t & 3) * 16;
        u32x4p w0, w1;
#pragma unroll
        for (int e = 0; e < 4; ++e) { w0[e] = pg8::cvtpk_bf16(tile[(kc + 2 * e) * 65 + n], tile[(kc + 2 * e + 1) * 65 + n]); w1[e] = pg8::cvtpk_bf16(tile[(kc + 8 + 2 * e) * 65 + n], tile[(kc + 8 + 2 * e + 1) * 65 + n]); }
        u32x4p* dst = (u32x4p*)(WT + (size_t)(n0 + n) * K + k0 + kc); dst[0] = w0; dst[1] = w1; }
    __syncthreads();
}
__device__ __forceinline__ void ph_rmsnorm_row(const float* __restrict__ x, const float* __restrict__ g, bf16* __restrict__ H, int row, int lane) {
    const float4* xr = (const float4*)(x + (size_t)row * DM) + lane;
    float4 v[4]; float s = 0.f;
#pragma unroll
    for (int j = 0; j < 4; ++j) { v[j] = xr[64 * j]; s += v[j].x * v[j].x + v[j].y * v[j].y + v[j].z * v[j].z + v[j].w * v[j].w; }
    const float rstd = rsqrtf(wave_sum(s) * (1.f / DM) + EPS);
    uint2* o = (uint2*)(H + (size_t)row * DM) + lane;
#pragma unroll
    for (int j = 0; j < 4; ++j) { const float4 gg = ((const float4*)g)[lane + 64 * j];
        uint2 w; w.x = pg8::pk2bf(v[j].x * rstd * gg.x, v[j].y * rstd * gg.y); w.y = pg8::pk2bf(v[j].z * rstd * gg.z, v[j].w * rstd * gg.w); o[64 * j] = w; }
}
__device__ __forceinline__ void ph_x_row(const float* __restrict__ x, bf16* __restrict__ XB, unsigned long long* __restrict__ ssq, int row, int lane) {
    const float4* xr = (const float4*)(x + (size_t)row * DM) + lane;
    float4 v[4]; float s = 0.f;
#pragma unroll
    for (int j = 0; j < 4; ++j) { v[j] = xr[64 * j]; s += v[j].x * v[j].x + v[j].y * v[j].y + v[j].z * v[j].z + v[j].w * v[j].w; }
    s = wave_sum(s);
    uint2* o = (uint2*)(XB + (size_t)row * DM) + lane;
#pragma unroll
    for (int j = 0; j < 4; ++j) { uint2 w; w.x = pg8::cvtpk_bf16(v[j].x, v[j].y); w.y = pg8::cvtpk_bf16(v[j].z, v[j].w); o[64 * j] = w; }
    if (lane == 0) ssq[row] = (unsigned long long)(s * 1048576.0f + 0.5f);
}
__device__ __forceinline__ void ph_prep(bf16* __restrict__ P, const float* __restrict__ tab, const float* __restrict__ moba_g, const float* __restrict__ nsa_qg, const float* __restrict__ nsa_kg,
                                        float* __restrict__ kmean, int item, bool act, int t, float* red  ) {
    const int lane = t & 63, wid = t >> 6, tb = item % 128, kind = item / 128, rg = lane >> 3, dch = lane & 7;
    if (act) {
        int col; const float* g; bool rope;
        if (kind < 4) { col = C_BQ + kind * 64; g = moba_g; rope = true; }
        else if (kind < 8) { col = C_BK + (kind - 4) * 64; g = moba_g + 64; rope = true; }
        else if (kind < 12) { col = C_NQ + (kind - 8) * 64; g = nsa_qg; rope = false; }
        else if (kind == 12) { col = C_NKS; g = nsa_kg + 64; rope = true; }
        else { col = C_NKW; g = nsa_kg + 128; rope = true; }
        float gd[8];
#pragma unroll
        for (int e = 0; e < 8; ++e) gd[e] = g[dch * 8 + e];
        const int row0 = tb * 256 + wid * 64 + rg;
        u32x4p raw[8];
#pragma unroll
        for (int it = 0; it < 8; ++it) raw[it] = *(const u32x4p*)(P + (size_t)(row0 + it * 8) * DINP + col + dch * 8);
        float ks[8];
#pragma unroll
        for (int e = 0; e < 8; ++e) ks[e] = 0.f;
#pragma unroll
        for (int it = 0; it < 8; ++it) {
            const int row = row0 + it * 8, pos = row & (SEQ - 1);
            float y[8]; float ss = 0.f;
#pragma unroll
            for (int e = 0; e < 4; ++e) { y[2 * e] = __builtin_bit_cast(float, raw[it][e] << 16); y[2 * e + 1] = __builtin_bit_cast(float, raw[it][e] & 0xffff0000u); ss += y[2 * e] * y[2 * e] + y[2 * e + 1] * y[2 * e + 1]; }
            ss += shx<1>(ss); ss += shx<2>(ss); ss += shx<4>(ss);
            const float rstd = rsqrtf(ss * (1.f / 64.f) + EPS);
#pragma unroll
            for (int e = 0; e < 8; ++e) y[e] *= rstd * gd[e];
            if (rope) {
                float o[8];
#pragma unroll
                for (int e = 0; e < 8; ++e) o[e] = shx<1>(y[e]);
                if (dch < 2) { const float4 c0 = *(const float4*)(tab + pos * 16), c1 = *(const float4*)(tab + pos * 16 + 4), s0 = *(const float4*)(tab + pos * 16 + 8), s1 = *(const float4*)(tab + pos * 16 + 12);
                    const float cs[8] = {c0.x, c0.y, c0.z, c0.w, c1.x, c1.y, c1.z, c1.w}, sn[8] = {s0.x, s0.y, s0.z, s0.w, s1.x, s1.y, s1.z, s1.w};
#pragma unroll
                    for (int e = 0; e < 8; ++e) y[e] = dch ? (y[e] * cs[e] + o[e] * sn[e]) : (y[e] * cs[e] - o[e] * sn[e]); }
            }
            u32x4p w; w[0] = pg8::pk2bf(y[0], y[1]); w[1] = pg8::pk2bf(y[2], y[3]); w[2] = pg8::pk2bf(y[4], y[5]); w[3] = pg8::pk2bf(y[6], y[7]);
            *(u32x4p*)(P + (size_t)row * DINP + col + dch * 8) = w;
#pragma unroll
            for (int e = 0; e < 8; ++e) ks[e] += y[e];
        }
        if (kind >= 4 && kind < 8) {
#pragma unroll
            for (int e = 0; e < 8; ++e) { ks[e] += shx<8>(ks[e]); ks[e] += shx<16>(ks[e]); ks[e] += shx<32>(ks[e]); }
            if (rg == 0) {
#pragma unroll
                for (int e = 0; e < 8; ++e) red[wid * 64 + dch * 8 + e] = ks[e]; }
        }
    }
    __syncthreads();
    if (act && kind >= 4 && kind < 8 && wid == 0) { const float s = red[lane] + red[64 + lane] + red[128 + lane] + red[192 + lane];
        const int b = tb >> 5, n = tb & 31; kmean[(((size_t)b * 4 + (kind - 4)) * 32 + n) * 64 + lane] = s * (1.f / 256.f); }
    __syncthreads();
}
__device__ __forceinline__ void ph_compress(const bf16* __restrict__ P, const float* __restrict__ pe, const float* __restrict__ w1, const float* __restrict__ w2, const float* __restrict__ kg0,
                                            float* __restrict__ KVc, bf16* __restrict__ KVcb, int item, bool act, int t, float* sm  ) {
    float* in = sm; float* hid = sm + 2048;
    const int i = item % NCMP, b = (item / NCMP) & 3, kv = item / (NCMP * 4);
    const int col = kv ? C_NVC : C_NKC;
    if (act) for (int e = t; e < 2048; e += 256) { const int p = e >> 6, d = e & 63; in[e] = bf2f(P[(size_t)(b * SEQ + 16 * i + p) * DINP + col + d]) + pe[(kv * 32 + p) * 64 + d]; }
    __syncthreads();
    if (act && t < 128) { const float* w = w1 + (size_t)kv * 2048 * 128 + t; float a = 0.f;
#pragma unroll 8
        for (int k = 0; k < 2048; ++k) a = fmaf(in[k], w[(size_t)k * 128], a);
        hid[t] = a * rcpf_(1.f + __expf(-a)); }
    __syncthreads();
    if (act && t < 64) { const float* ww = w2 + (size_t)kv * 128 * 64 + t; float o = 0.f;
#pragma unroll 8
        for (int j = 0; j < 128; ++j) o = fmaf(hid[j], ww[j * 64], o);
        if (kv == 0) { const float ss = wave_sum(o * o); o = o * rsqrtf(ss * (1.f / 64.f) + EPS) * kg0[t]; }
        KVc[(((size_t)kv * NB + b) * 512 + i) * 64 + t] = o; KVcb[(((size_t)kv * NB + b) * 512 + i) * 64 + t] = f2bf(o);
        if (i == NCMP - 1) KVcb[(((size_t)kv * NB + b) * 512 + NCMP) * 64 + t] = 0; }
    __syncthreads();
}
__device__ __forceinline__ float conv_silu(const bf16* __restrict__ P, const float* __restrict__ cw  , int rowbase, int t, int c) {
    float a = 0.f;
#pragma unroll
    for (int j = 0; j < 4; ++j) { const int tt = t - 3 + j; if (tt >= 0) a = fmaf(cw[j * 1024 + c], bf2f(P[(size_t)(rowbase + tt) * DINP + c]), a); }
    return a * rcpf_(1.f + __expf(-a));
}
__device__ __forceinline__ void ph_mlstm_local(const bf16* __restrict__ P, const float* __restrict__ G, const float* __restrict__ cw, const float* __restrict__ bif,
                                               float* __restrict__ Cst, float* __restrict__ nst, float* __restrict__ dec, int u, bool act, int tid, unsigned char* sm) {
    bf16 (*ks)[128] = (bf16 (*)[128])sm; bf16 (*vs)[128] = (bf16 (*)[128])(sm + 16384); float* wS = (float*)(sm + 32768); float* lf = wS + 64;
    const int c = u & 127, h = (u >> 7) & 3, b = u >> 9;
    const int rowbase = b * SEQ, t0 = c * 64;
    if (act) {
        for (int e = tid; e < 64 * 128; e += 256) { const int s = e >> 7, d = e & 127;
            ks[s][d] = f2bf(conv_silu(P, cw, rowbase, t0 + s, 512 + h * 128 + d) * 0.08838834764831845f);
            vs[s][d] = P[(size_t)(rowbase + t0 + s) * DINP + C_MV + h * 128 + d]; }
        if (tid < 64) lf[tid] = log_sigmoidf_(G[(size_t)(rowbase + t0 + tid) * 32 + 4 + h] + bif[4 + h]);
    }
    __syncthreads();
    if (act && tid == 0) { float acc = 0.f;
        for (int s = 0; s < 64; ++s) { acc += lf[s]; lf[s] = acc; }
        dec[u] = __expf(acc); }
    __syncthreads();
    if (act && tid < 64) wS[tid] = __expf(lf[63] - lf[tid] + G[(size_t)(rowbase + t0 + tid) * 32 + h] + bif[h]);
    __syncthreads();
    if (act) {
        const int d = tid >> 1, e0 = (tid & 1) * 64;
        float acc[64];
#pragma unroll
        for (int e = 0; e < 64; ++e) acc[e] = 0.f;
        float an = 0.f;
        for (int s = 0; s < 64; ++s) { const float kw = wS[s] * bf2f(ks[s][d]); an += kw;
#pragma unroll
            for (int e = 0; e < 64; ++e) acc[e] = fmaf(kw, bf2f(vs[s][e0 + e]), acc[e]); }
        float* o = Cst + ((size_t)u * 128 + d) * 128 + e0;
#pragma unroll
        for (int e = 0; e < 64; ++e) o[e] = acc[e];
        if ((tid & 1) == 0) nst[(size_t)u * 128 + d] = an;
    }
    __syncthreads();
}
__device__ __forceinline__ void ph_mlstm_scan(float* __restrict__ Cst, float* __restrict__ nst, const float* __restrict__ dec, int item, int tid) {
    const int bh = item / 65, part = item % 65;
    float* base; int stride;
    if (part < 64) { base = Cst + (size_t)bh * 128 * 16384 + part * 256 + tid; stride = 16384; }
    else { if (tid >= 128) return; base = nst + (size_t)bh * 128 * 128 + tid; stride = 128; }
    float C = 0.f;
    for (int c = 0; c < 128; ++c) { const float dC = base[(size_t)c * stride]; base[(size_t)c * stride] = C; C = dec[bh * 128 + c] * C + dC; }
}
__device__ __forceinline__ void ph_mlstm_out(const bf16* __restrict__ P, const float* __restrict__ G, const float* __restrict__ cw, const float* __restrict__ bif,
                                             const float* __restrict__ Cst, const float* __restrict__ nst, const float* __restrict__ mnorm, bf16* __restrict__ MIX, int u, bool act, int tid, unsigned char* sm) {
    bf16 (*qs)[128] = (bf16 (*)[128])sm; float* ksS = (float*)(sm + 16384); bf16 (*ks)[128] = (bf16 (*)[128])ksS; bf16 (*vs)[128] = (bf16 (*)[128])(sm + 32768);
    float* bb = (float*)(sm + 49152); float* li = bb + 64;
    const int c = u & 127, h = (u >> 7) & 3, b = u >> 9;
    const int rowbase = b * SEQ, t0 = c * 64;
    if (act) {
        for (int e = tid; e < 64 * 128; e += 256) { const int s = e >> 7, d = e & 127;
            qs[s][d] = f2bf(conv_silu(P, cw, rowbase, t0 + s, h * 128 + d));
            ks[s][d] = f2bf(conv_silu(P, cw, rowbase, t0 + s, 512 + h * 128 + d) * 0.08838834764831845f);
            vs[s][d] = P[(size_t)(rowbase + t0 + s) * DINP + C_MV + h * 128 + d]; }
        if (tid < 64) { bb[tid] = log_sigmoidf_(G[(size_t)(rowbase + t0 + tid) * 32 + 4 + h] + bif[4 + h]); li[tid] = G[(size_t)(rowbase + t0 + tid) * 32 + h] + bif[h]; }
    }
    __syncthreads();
    if (act && tid == 0) { float acc = 0.f; for (int s = 0; s < 64; ++s) { acc += bb[s]; bb[s] = acc; } }
    __syncthreads();
    const int t = tid >> 2, part = tid & 3;
    float sreg[16];
    if (act) {
        const int s0 = part * 16;
#pragma unroll
        for (int j = 0; j < 16; ++j) { const int s = s0 + j; float a = 0.f;
            if (s <= t) { for (int d = 0; d < 128; ++d) a = fmaf(bf2f(qs[t][d]), bf2f(ks[s][d]), a); a *= __expf(bb[t] - bb[s] + li[s]); }
            sreg[j] = a; }
    }
    __syncthreads();
    float* S = ksS;
    if (act) {
#pragma unroll
        for (int j = 0; j < 16; ++j) S[t * 64 + part * 16 + j] = sreg[j];
    }
    __syncthreads();
    if (act) {
        const float Ft = __expf(bb[t]);
        float den = 0.f;
        for (int s = 0; s <= t; ++s) den += S[t * 64 + s];
        { const float* np = nst + (size_t)u * 128; float a = 0.f; for (int d = 0; d < 128; ++d) a = fmaf(bf2f(qs[t][d]), np[d], a); den += Ft * a; }
        const int e0 = part * 32;
        float acc[32];
#pragma unroll
        for (int e = 0; e < 32; ++e) acc[e] = 0.f;
        { const float* Cp = Cst + (size_t)u * 16384 + e0;
          for (int d = 0; d < 128; ++d) { const float qd = bf2f(qs[t][d]);
#pragma unroll
              for (int e = 0; e < 32; ++e) acc[e] = fmaf(qd, Cp[d * 128 + e], acc[e]); } }
#pragma unroll
        for (int e = 0; e < 32; ++e) acc[e] *= Ft;
        for (int s = 0; s <= t; ++s) { const float w = S[t * 64 + s];
#pragma unroll
            for (int e = 0; e < 32; ++e) acc[e] = fmaf(w, bf2f(vs[s][e0 + e]), acc[e]); }
        const float inv = rcpf_(fmaxf(fabsf(den), 1.f));
        float ss = 0.f;
#pragma unroll
        for (int e = 0; e < 32; ++e) { acc[e] *= inv; ss += acc[e] * acc[e]; }
        ss += shx<1>(ss); ss += shx<2>(ss);
        const float rstd = rsqrtf(ss * (1.f / 128.f) + EPS);
        const size_t row = (size_t)(rowbase + t0 + t);
#pragma unroll
        for (int e = 0; e < 32; ++e) { const int cc = h * 128 + e0 + e;
            const float o = sigmoidf_(bf2f(P[row * DINP + C_MO + cc]));
            MIX[row * DM + cc] = f2bf(acc[e] * rstd * mnorm[cc] * o); }
    }
    __syncthreads();
}

__device__ __forceinline__ void ph_moba(const bf16* __restrict__ P, const float* __restrict__ kmean, bf16* __restrict__ MIX, int gw, int lane, float* q) {
    const int bh = gw >> 13, tq = gw & (SEQ - 1), b = bh >> 2, h = bh & 3, own = tq >> 8;
    const size_t row = (size_t)b * SEQ + tq;
    __builtin_amdgcn_s_waitcnt(0); __builtin_amdgcn_wave_barrier();
    q[lane] = bf2f(P[row * DINP + C_BQ + h * 64 + lane]);
    __builtin_amdgcn_s_waitcnt(0); __builtin_amdgcn_wave_barrier();
    float gs = -3.0e38f;
    if (lane < 32) { if (lane < own) { const float* km = kmean + (((size_t)b * 4 + h) * 32 + lane) * 64; float a = 0.f; for (int d = 0; d < 64; ++d) a = fmaf(q[d], km[d], a); gs = a; } else gs = -1e30f; }
    int blk[4]; bool val[4];
#pragma unroll
    for (int r = 0; r < 3; ++r) { const float m = wave_max(gs); const unsigned long long bal = __ballot(gs == m); const int idx = __ffsll((long long)bal) - 1;
        blk[r] = idx; val[r] = (r < own); if (lane == idx) gs = -3.0e38f; }
    blk[3] = own; val[3] = true;
    float s[4][4]; float mx = -1e30f;
#pragma unroll
    for (int g = 0; g < 4; ++g)
#pragma unroll
        for (int i = 0; i < 4; ++i) { float a = -1e30f;
            if (val[g]) { const int pos = blk[g] * 256 + i * 64 + lane;
                if (g < 3 || pos <= tq) { const bf16* kp = P + ((size_t)b * SEQ + pos) * DINP + C_BK + h * 64; a = dot64(kp, q) * 0.125f; } }
            s[g][i] = a; mx = fmaxf(mx, a); }
    mx = wave_max(mx);
    float l = 0.f;
#pragma unroll
    for (int g = 0; g < 4; ++g)
#pragma unroll
        for (int i = 0; i < 4; ++i) { const float p = (s[g][i] > -1e29f) ? __expf(s[g][i] - mx) : 0.f; s[g][i] = p; l += p; }
    l = wave_sum(l);
    float o = 0.f;
#pragma unroll
    for (int g = 0; g < 4; ++g) { if (!val[g]) continue;
#pragma unroll
        for (int i = 0; i < 4; ++i) { const bf16* vp = P + ((size_t)b * SEQ + blk[g] * 256 + i * 64) * DINP + C_BV + h * 64 + lane;
            for (int src = 0; src < 64; ++src) { const float p = __shfl(s[g][i], src); o = fmaf(p, bf2f(vp[(size_t)src * DINP]), o); } } }
    MIX[row * DM + 512 + h * 64 + lane] = f2bf(o * rcpf_(l));
}

__device__ __forceinline__ void ph_nsa(const bf16* __restrict__ P, const float* __restrict__ G, const float* __restrict__ tab, const float* __restrict__ KVc, bf16* __restrict__ MIX, int gw, int lane, float* sm) {
    float (*qn)[64] = (float (*)[64])sm; float (*qr)[64] = (float (*)[64])(sm + 256); float* ps = sm + 512;
    const int b = gw >> 13, tq = gw & (SEQ - 1), blkq = tq >> 6;
    const size_t row = (size_t)b * SEQ + tq;
    __builtin_amdgcn_s_waitcnt(0); __builtin_amdgcn_wave_barrier();
#pragma unroll
    for (int h = 0; h < 4; ++h) { const float x = bf2f(P[row * DINP + C_NQ + h * 64 + lane]); qn[h][lane] = x;
        float y = x; const float other = shx<8>(x);
        if (lane < 16) { const int f = lane & 7; const float c = tab[tq * 16 + f], s = tab[tq * 16 + 8 + f]; y = (lane < 8) ? (x * c - other * s) : (x * c + other * s); }
        qr[h][lane] = y; }
    __builtin_amdgcn_s_waitcnt(0); __builtin_amdgcn_wave_barrier();
    const float* Kc = KVc + (size_t)b * 512 * 64; const float* Vc = KVc + ((size_t)NB + b) * 512 * 64;
    float out[4] = {0.f, 0.f, 0.f, 0.f};
    float gate[3][4];
#pragma unroll
    for (int br = 0; br < 3; ++br)
#pragma unroll
        for (int h = 0; h < 4; ++h) gate[br][h] = sigmoidf_(G[row * 32 + 8 + br * 4 + h]);
    const int ncv = (tq >= 31) ? ((tq - 31) >> 4) + 1 : 0;
    {
        float sc[8][4]; float mx[4] = {-1e30f, -1e30f, -1e30f, -1e30f};
#pragma unroll
        for (int i = 0; i < 8; ++i) { const int c = i * 64 + lane;
            float a[4] = {-1e30f, -1e30f, -1e30f, -1e30f};
            if (c < ncv) { const float* kp = Kc + (size_t)c * 64; a[0] = a[1] = a[2] = a[3] = 0.f;
                for (int d = 0; d < 64; ++d) { const float kd = kp[d]; a[0] = fmaf(qn[0][d], kd, a[0]); a[1] = fmaf(qn[1][d], kd, a[1]); a[2] = fmaf(qn[2][d], kd, a[2]); a[3] = fmaf(qn[3][d], kd, a[3]); }
#pragma unroll
                for (int h = 0; h < 4; ++h) a[h] *= 0.125f; }
#pragma unroll
            for (int h = 0; h < 4; ++h) { sc[i][h] = a[h]; mx[h] = fmaxf(mx[h], a[h]); } }
        float l[4];
#pragma unroll
        for (int h = 0; h < 4; ++h) { mx[h] = wave_max(mx[h]); l[h] = 0.f; }
#pragma unroll
        for (int i = 0; i < 8; ++i) { const int c = i * 64 + lane;
#pragma unroll
            for (int h = 0; h < 4; ++h) { const float p = (c < ncv) ? __expf(sc[i][h] - mx[h]) : 0.f; sc[i][h] = p; l[h] += p; } }
#pragma unroll
        for (int h = 0; h < 4; ++h) { l[h] = wave_sum(l[h]); l[h] = (l[h] > 0.f) ? rcpf_(l[h]) : 0.f; }
#pragma unroll
        for (int i = 0; i < 8; ++i) { float su = 0.f;
#pragma unroll
            for (int h = 0; h < 4; ++h) { sc[i][h] *= l[h]; su += sc[i][h]; }
            ps[i * 64 + lane] = su; }
        if (lane < 4) ps[512 + lane] = 0.f;
        float oc[4] = {0.f, 0.f, 0.f, 0.f};
#pragma unroll
        for (int i = 0; i < 8; ++i) { if (i * 64 >= ncv) break; const int nn = min(64, ncv - i * 64);
            for (int src = 0; src < nn; ++src) { const float v = Vc[(size_t)(i * 64 + src) * 64 + lane];
                oc[0] = fmaf(__shfl(sc[i][0], src), v, oc[0]); oc[1] = fmaf(__shfl(sc[i][1], src), v, oc[1]);
                oc[2] = fmaf(__shfl(sc[i][2], src), v, oc[2]); oc[3] = fmaf(__shfl(sc[i][3], src), v, oc[3]); } }
#pragma unroll
        for (int h = 0; h < 4; ++h) out[h] = gate[0][h] * oc[h];
    }
    __builtin_amdgcn_s_waitcnt(0); __builtin_amdgcn_wave_barrier();
    int sidx[16];
    {
        float v0, v1;
        { const int n = lane; float im = 0.f;
#pragma unroll
          for (int j = -1; j < 4; ++j) { const int c = 4 * n + j; if (c >= 0 && c < NCMP) im += ps[c]; }
          const bool causal = n <= blkq, forced = causal && (n == 0 || n >= blkq - 1);
          v0 = forced ? 1e9f : (causal ? im : -1e30f); }
        { const int n = lane + 64; float im = 0.f;
#pragma unroll
          for (int j = -1; j < 4; ++j) { const int c = 4 * n + j; if (c >= 0 && c < NCMP) im += ps[c]; }
          const bool causal = n <= blkq, forced = causal && (n == 0 || n >= blkq - 1);
          v1 = forced ? 1e9f : (causal ? im : -1e30f); }
#pragma unroll
        for (int k = 0; k < 16; ++k) { const float m = wave_max(fmaxf(v0, v1));
            const unsigned long long b0 = __ballot(v0 == m); int idx;
            if (b0) { idx = __ffsll((long long)b0) - 1; if (lane == idx) v0 = -3.0e38f; }
            else { const unsigned long long b1 = __ballot(v1 == m); idx = __ffsll((long long)b1) - 1; if (lane == idx) v1 = -3.0e38f; idx += 64; }
            sidx[k] = idx; }
    }
    {
        float sc[16][4]; float mx[4] = {-1e30f, -1e30f, -1e30f, -1e30f};
#pragma unroll
        for (int k = 0; k < 16; ++k) { const int n = sidx[k], pos = n * 64 + lane;
            float a[4] = {-1e30f, -1e30f, -1e30f, -1e30f};
            if (n <= blkq && pos <= tq) { const bf16* kp = P + ((size_t)b * SEQ + pos) * DINP + C_NKS; dot64x4(kp, qr, a);
#pragma unroll
                for (int h = 0; h < 4; ++h) a[h] *= 0.125f; }
#pragma unroll
            for (int h = 0; h < 4; ++h) { sc[k][h] = a[h]; mx[h] = fmaxf(mx[h], a[h]); } }
        float l[4];
#pragma unroll
        for (int h = 0; h < 4; ++h) { mx[h] = wave_max(mx[h]); l[h] = 0.f; }
#pragma unroll
        for (int k = 0; k < 16; ++k)
#pragma unroll
            for (int h = 0; h < 4; ++h) { const float p = (sc[k][h] > -1e29f) ? __expf(sc[k][h] - mx[h]) : 0.f; sc[k][h] = p; l[h] += p; }
#pragma unroll
        for (int h = 0; h < 4; ++h) l[h] = rcpf_(wave_sum(l[h]));
        float os[4] = {0.f, 0.f, 0.f, 0.f};
#pragma unroll
        for (int k = 0; k < 16; ++k) { const int n = sidx[k]; if (n > blkq) continue;
            const bf16* vp = P + ((size_t)b * SEQ + n * 64) * DINP + C_NVS + lane;
            for (int src = 0; src < 64; ++src) { const float v = bf2f(vp[(size_t)src * DINP]);
                os[0] = fmaf(__shfl(sc[k][0], src), v, os[0]); os[1] = fmaf(__shfl(sc[k][1], src), v, os[1]);
                os[2] = fmaf(__shfl(sc[k][2], src), v, os[2]); os[3] = fmaf(__shfl(sc[k][3], src), v, os[3]); } }
#pragma unroll
        for (int h = 0; h < 4; ++h) out[h] += gate[1][h] * os[h] * l[h];
    }
    {
        float sc[8][4]; float mx[4] = {-1e30f, -1e30f, -1e30f, -1e30f};
#pragma unroll
        for (int i = 0; i < 8; ++i) { const int pos = tq - 511 + i * 64 + lane;
            float a[4] = {-1e30f, -1e30f, -1e30f, -1e30f};
            if (pos >= 0) { const bf16* kp = P + ((size_t)b * SEQ + pos) * DINP + C_NKW; dot64x4(kp, qr, a);
#pragma unroll
                for (int h = 0; h < 4; ++h) a[h] *= 0.125f; }
#pragma unroll
            for (int h = 0; h < 4; ++h) { sc[i][h] = a[h]; mx[h] = fmaxf(mx[h], a[h]); } }
        float l[4];
#pragma unroll
        for (int h = 0; h < 4; ++h) { mx[h] = wave_max(mx[h]); l[h] = 0.f; }
#pragma unroll
        for (int i = 0; i < 8; ++i)
#pragma unroll
            for (int h = 0; h < 4; ++h) { const float p = (sc[i][h] > -1e29f) ? __expf(sc[i][h] - mx[h]) : 0.f; sc[i][h] = p; l[h] += p; }
#pragma unroll
        for (int h = 0; h < 4; ++h) l[h] = rcpf_(wave_sum(l[h]));
        float ow[4] = {0.f, 0.f, 0.f, 0.f};
#pragma unroll
        for (int i = 0; i < 8; ++i) { const int p0 = tq - 511 + i * 64; if (p0 + 63 < 0) continue;
            const int s0 = p0 < 0 ? -p0 : 0;
            for (int src = s0; src < 64; ++src) { const float v = bf2f(P[((size_t)b * SEQ + p0 + src) * DINP + C_NVW + lane]);
                ow[0] = fmaf(__shfl(sc[i][0], src), v, ow[0]); ow[1] = fmaf(__shfl(sc[i][1], src), v, ow[1]);
                ow[2] = fmaf(__shfl(sc[i][2], src), v, ow[2]); ow[3] = fmaf(__shfl(sc[i][3], src), v, ow[3]); } }
#pragma unroll
        for (int h = 0; h < 4; ++h) out[h] += gate[2][h] * ow[h] * l[h];
    }
#pragma unroll
    for (int h = 0; h < 4; ++h) MIX[row * DM + 768 + h * 64 + lane] = f2bf(out[h]);
}


#define LAS __attribute__((address_space(3)))
typedef short bf16x8 __attribute__((ext_vector_type(8)));
typedef float f32x16 __attribute__((ext_vector_type(16)));
typedef short s16x4 __attribute__((ext_vector_type(4)));
typedef unsigned u32x4v __attribute__((ext_vector_type(4)));
typedef float f32x2_t __attribute__((ext_vector_type(2)));
typedef __bf16 bf16x2_t __attribute__((ext_vector_type(2)));
constexpr int KROW = 144, VROW = 192;
constexpr int KBUF = 64 * KROW, VBUF = 64 * VROW, STG = KBUF + VBUF;
constexpr float SCL2 = 0.125f * 1.4426950408889634f;
constexpr float NEGBIG = -1e30f;

__device__ __forceinline__ unsigned cvtpk(float lo, float hi) { f32x2_t v = {lo, hi}; bf16x2_t b = __builtin_convertvector(v, bf16x2_t); return __builtin_bit_cast(unsigned, b); }
__device__ __forceinline__ int crow(int r, int hi) { return (r & 3) + 8 * (r >> 2) + 4 * hi; }
__device__ __forceinline__ s16x4 lds_tr(LAS const unsigned char* p) { return __builtin_bit_cast(s16x4, __builtin_amdgcn_ds_read_tr16_b64_v4i16((LAS s16x4*)p)); }

__device__ __forceinline__ bf16x8 scale_frag(bf16x8 v, float s) {
    const u32x4v w = __builtin_bit_cast(u32x4v, v); u32x4v o;
#pragma unroll
    for (int e = 0; e < 4; ++e) o[e] = cvtpk(__builtin_bit_cast(float, w[e] << 16) * s, __builtin_bit_cast(float, w[e] & 0xffff0000u) * s);
    return __builtin_bit_cast(bf16x8, o);
}
struct TileSrc { const bf16* k; const bf16* v; int stride; };
__device__ __forceinline__ void tile_load(u32x4v& kr, u32x4v& vr, const TileSrc& s, int t) {
    const int key = t >> 3, ch = t & 7;
    kr = *(const u32x4v*)(s.k + (size_t)key * s.stride + ch * 8); vr = *(const u32x4v*)(s.v + (size_t)key * s.stride + ch * 8);
}
__device__ __forceinline__ void tile_store(LAS unsigned char* buf, const u32x4v& kr, const u32x4v& vr, int t) {
    const int key = t >> 3, ch = t & 7;
    *(LAS u32x4v*)(buf + key * KROW + ch * 16) = kr; *(LAS u32x4v*)(buf + KBUF + key * VROW + ch * 16) = vr;
}
__device__ __forceinline__ void qk_tile(f32x16& p0, f32x16& p1, LAS const unsigned char* kb, const bf16x8 (&qf)[4], int r32, int hi, float cinit) {
    float ci = cinit; asm volatile("" : "+v"(ci));
#pragma unroll
    for (int r = 0; r < 16; ++r) { p0[r] = ci; p1[r] = ci; }
    LAS const unsigned char* a = kb + r32 * KROW + hi * 16;
#pragma unroll
    for (int ks = 0; ks < 4; ++ks) {
        const bf16x8 a0 = *(LAS const bf16x8*)(a + ks * 32), a1 = *(LAS const bf16x8*)(a + 32 * KROW + ks * 32);
        p0 = __builtin_amdgcn_mfma_f32_32x32x16_bf16(a0, qf[ks], p0, 0, 0, 0);
        p1 = __builtin_amdgcn_mfma_f32_32x32x16_bf16(a1, qf[ks], p1, 0, 0, 0);
    }
}
__device__ __forceinline__ void pv_tile(f32x16& o0, f32x16& o1, LAS const unsigned char* vb, const f32x16& p0, const f32x16& p1, int lane) {
    const int g = lane >> 4, i = lane & 15, hi = lane >> 5;
    LAS const unsigned char* base = vb + (4 * hi + (i >> 2)) * VROW + (16 * (g & 1) + 4 * (i & 3)) * 2;
#pragma unroll
    for (int s = 0; s < 4; ++s) {
        unsigned w[4];
#pragma unroll
        for (int e = 0; e < 4; ++e) { const int r = 8 * (s & 1) + 2 * e; w[e] = (s < 2) ? cvtpk(p0[r], p0[r + 1]) : cvtpk(p1[r], p1[r + 1]); }
        const u32x4v wv = {w[0], w[1], w[2], w[3]};
        const bf16x8 pf = __builtin_bit_cast(bf16x8, wv);
#pragma unroll
        for (int mb = 0; mb < 2; ++mb) {
            const s16x4 lo = lds_tr(base + s * 16 * VROW + mb * 64), hi4 = lds_tr(base + s * 16 * VROW + 8 * VROW + mb * 64);
            const bf16x8 vt = {lo[0], lo[1], lo[2], lo[3], hi4[0], hi4[1], hi4[2], hi4[3]};
            if (mb == 0) o0 = __builtin_amdgcn_mfma_f32_32x32x16_bf16(vt, pf, o0, 0, 0, 0);
            else o1 = __builtin_amdgcn_mfma_f32_32x32x16_bf16(vt, pf, o1, 0, 0, 0);
        }
    }
}
constexpr float SM_THR = 8.0f;
__device__ __forceinline__ void softmax_tile(f32x16& p0, f32x16& p1, f32x16& o0, f32x16& o1, float& mref, float& l, bool first) {
    float a = __builtin_fmaxf(__builtin_fmaxf(p0[0], p0[1]), p1[0]), b = __builtin_fmaxf(__builtin_fmaxf(p0[2], p0[3]), p1[1]);
    a = __builtin_fmaxf(__builtin_fmaxf(a, p1[2]), p1[3]);
#pragma unroll
    for (int r = 4; r < 16; r += 4) { a = __builtin_fmaxf(__builtin_fmaxf(a, p0[r]), p0[r + 1]); b = __builtin_fmaxf(__builtin_fmaxf(b, p0[r + 2]), p0[r + 3]);
        a = __builtin_fmaxf(__builtin_fmaxf(a, p1[r]), p1[r + 1]); b = __builtin_fmaxf(__builtin_fmaxf(b, p1[r + 2]), p1[r + 3]); }
    float rm = __builtin_fmaxf(a, b);
    { auto rr = __builtin_amdgcn_permlane32_swap(__float_as_uint(rm), __float_as_uint(rm), false, false); rm = __builtin_fmaxf(__uint_as_float(rr[0]), __uint_as_float(rr[1])); }
    if (first || __any(rm > SM_THR)) {
        const float dl = first ? rm : __builtin_fmaxf(rm, 0.f);
        mref += dl;
        const float f = __builtin_amdgcn_exp2f(-dl);
        l *= f;
#pragma unroll
        for (int r = 0; r < 16; ++r) { p0[r] -= dl; p1[r] -= dl; o0[r] *= f; o1[r] *= f; }
    }
    float s0 = 0.f, s1 = 0.f;
#pragma unroll
    for (int r = 0; r < 16; ++r) { p0[r] = __builtin_amdgcn_exp2f(p0[r]); p1[r] = __builtin_amdgcn_exp2f(p1[r]); s0 += p0[r]; s1 += p1[r]; }
    l += s0 + s1;
}


constexpr int PV_OFF = 2 * KBUF, PIPE_BYTES = 2 * KBUF + 2 * VBUF;
__device__ __forceinline__ void k_store(LAS unsigned char* lds, int slot, const u32x4v& kr, int t) { *(LAS u32x4v*)(lds + slot * KBUF + (t >> 3) * KROW + (t & 7) * 16) = kr; }
__device__ __forceinline__ void v_store(LAS unsigned char* lds, int voff, const u32x4v& vr, int t) { *(LAS u32x4v*)(lds + PV_OFF + voff + (t >> 3) * VROW + (t & 7) * 16) = vr; }
__device__ __forceinline__ u32x4v kv_load(const bf16* base, int stride, int t) { return *(const u32x4v*)(base + (size_t)(t >> 3) * stride + (t & 7) * 8); }
__device__ __forceinline__ void pv_frag(f32x16& o0, f32x16& o1, LAS const unsigned char* vb, const bf16x8 (&pf)[4], int lane) {
    const int g = lane >> 4, i = lane & 15, hi = lane >> 5;
    LAS const unsigned char* base = vb + (4 * hi + (i >> 2)) * VROW + (16 * (g & 1) + 4 * (i & 3)) * 2;
#pragma unroll
    for (int s = 0; s < 4; ++s)
#pragma unroll
        for (int mb = 0; mb < 2; ++mb) {
            const s16x4 lo = lds_tr(base + s * 16 * VROW + mb * 64), hi4 = lds_tr(base + s * 16 * VROW + 8 * VROW + mb * 64);
            const bf16x8 vt = {lo[0], lo[1], lo[2], lo[3], hi4[0], hi4[1], hi4[2], hi4[3]};
            if (mb == 0) o0 = __builtin_amdgcn_mfma_f32_32x32x16_bf16(vt, pf[s], o0, 0, 0, 0);
            else o1 = __builtin_amdgcn_mfma_f32_32x32x16_bf16(vt, pf[s], o1, 0, 0, 0);
        }
}
__device__ __forceinline__ void exp_pack(f32x16& p0, f32x16& p1, float& l, bf16x8 (&pf)[4]) {
    float s0 = 0.f, s1 = 0.f;
#pragma unroll
    for (int r = 0; r < 16; ++r) { p0[r] = __builtin_amdgcn_exp2f(p0[r]); p1[r] = __builtin_amdgcn_exp2f(p1[r]); s0 += p0[r]; s1 += p1[r]; }
    l += s0 + s1;
#pragma unroll
    for (int s = 0; s < 4; ++s) { u32x4v w;
#pragma unroll
        for (int e = 0; e < 4; ++e) { const int r = 8 * (s & 1) + 2 * e; w[e] = (s < 2) ? cvtpk(p0[r], p0[r + 1]) : cvtpk(p1[r], p1[r + 1]); }
        pf[s] = __builtin_bit_cast(bf16x8, w); }
}
template <class Pol>
__device__ __forceinline__ void attn_step_gen(const Pol& pol, int t, bool doqk, LAS unsigned char* lds, const bf16x8 (&qf)[4], float negm, f32x16& pc0, f32x16& pc1,
                                              f32x16& o0, f32x16& o1, float& l, int tid, int lane, int r32, int hi) {
    const int nt = pol.nt;
    u32x4v kr, vr;
    const bool ldk = (t + 2 < nt), ldv = (t + 1 < nt);
    if (ldk) kr = kv_load(pol.kptr(t + 2), pol.stride, tid);
    if (ldv) vr = kv_load(pol.vptr(t + 1), pol.stride, tid);
    f32x16 pn0, pn1; bf16x8 pf[4];
    if (doqk) { qk_tile(pn0, pn1, lds + ((t + 1) & 1) * KBUF, qf, r32, hi, pol.rowsel(t + 1) ? negm : NEGBIG); pol.mask(t + 1, pn0, pn1); }
    exp_pack(pc0, pc1, l, pf);
    pv_frag(o0, o1, lds + PV_OFF + (t & 1) * VBUF, pf, lane);
    if (ldk) k_store(lds, t & 1, kr, tid);
    if (ldv) v_store(lds, ((t + 1) & 1) * VBUF, vr, tid);
    __syncthreads();
    if (doqk) { pc0 = pn0; pc1 = pn1; }
}
template <class Pol>
__device__ __forceinline__ void attn_step_fast(const Pol& pol, int t, LAS unsigned char* lds, const bf16x8 (&qf)[4], float negm, f32x16& pc0, f32x16& pc1, f32x16& pn0, f32x16& pn1,
                                               f32x16& o0, f32x16& o1, float& l, u32x4v& kld, u32x4v& vld, const u32x4v& kst, const u32x4v& vst,
                                               int tid, int lane, int r32, int hi) {
    const int nt = pol.nt, tk = (t + 3 < nt) ? t + 3 : nt - 1, tv = (t + 2 < nt) ? t + 2 : nt - 1;
    kld = kv_load(pol.kptr(tk), pol.stride, tid); vld = kv_load(pol.vptr(tv), pol.stride, tid);
    bf16x8 pf[4];
    qk_tile(pn0, pn1, lds + ((t + 1) & 1) * KBUF, qf, r32, hi, pol.rowsel(t + 1) ? negm : NEGBIG);
    exp_pack(pc0, pc1, l, pf);
    pv_frag(o0, o1, lds + PV_OFF + (t & 1) * VBUF, pf, lane);
    k_store(lds, t & 1, kst, tid);
    v_store(lds, ((t + 1) & 1) * VBUF, vst, tid);
    __syncthreads();
}
template <class Pol>
__device__ __forceinline__ void attn_pipe(const Pol& pol, LAS unsigned char* lds, const bf16x8 (&qf)[4], float negm, f32x16& o0, f32x16& o1, float& l, int tid) {
    const int lane = tid & 63, r32 = lane & 31, hi = lane >> 5, nt = pol.nt;
    {
        const u32x4v k0 = kv_load(pol.kptr(0), pol.stride, tid), v0 = kv_load(pol.vptr(0), pol.stride, tid);
        u32x4v k1 = k0; if (nt > 1) k1 = kv_load(pol.kptr(1), pol.stride, tid);
        k_store(lds, 0, k0, tid); v_store(lds, 0, v0, tid); if (nt > 1) k_store(lds, 1, k1, tid);
    }
    __syncthreads();
    f32x16 pc0, pc1;
    qk_tile(pc0, pc1, lds, qf, r32, hi, pol.rowsel(0) ? negm : NEGBIG); pol.mask(0, pc0, pc1);
    int t = 0;
    for (; t < nt - 1 && t + 1 < pol.nmask; ++t)
        attn_step_gen(pol, t, true, lds, qf, negm, pc0, pc1, o0, o1, l, tid, lane, r32, hi);
    if (t < nt - 1) {
        const int tk0 = (t + 2 < nt) ? t + 2 : nt - 1;
        u32x4v ka = kv_load(pol.kptr(tk0), pol.stride, tid), va = kv_load(pol.vptr(t + 1), pol.stride, tid), kb, vb;
        f32x16 pd0, pd1;
        for (; t + 1 < nt - 1; t += 2) {
            attn_step_fast(pol, t, lds, qf, negm, pc0, pc1, pd0, pd1, o0, o1, l, kb, vb, ka, va, tid, lane, r32, hi);
            attn_step_fast(pol, t + 1, lds, qf, negm, pd0, pd1, pc0, pc1, o0, o1, l, ka, va, kb, vb, tid, lane, r32, hi);
        }
        if (t < nt - 1) {
            attn_step_fast(pol, t, lds, qf, negm, pc0, pc1, pd0, pd1, o0, o1, l, kb, vb, ka, va, tid, lane, r32, hi);
            pc0 = pd0; pc1 = pd1; ++t;
        }
    }
    attn_step_gen(pol, nt - 1, false, lds, qf, negm, pc0, pc1, o0, o1, l, tid, lane, r32, hi);
}
__device__ __forceinline__ float row_negm(const bf16x8 (&qf)[4], float kmax) {
    float ss = 0.f;
#pragma unroll
    for (int ks = 0; ks < 4; ++ks) { const u32x4v w = __builtin_bit_cast(u32x4v, qf[ks]);
#pragma unroll
        for (int e = 0; e < 4; ++e) { const float a = __builtin_bit_cast(float, w[e] << 16), b = __builtin_bit_cast(float, w[e] & 0xffff0000u); ss += a * a + b * b; } }
    ss += shx<32>(ss);
    return -(__builtin_sqrtf(ss) * kmax);
}
__device__ __forceinline__ float gain_kmax(const float* g, int lane) { return wave_max(fabsf(g[lane])) * (8.0f * 1.02f); }

constexpr int MOBA_KM_OFF = PIPE_BYTES, MOBA_TL_OFF = MOBA_KM_OFF + 32 * 64 * 4, MOBA_UW_OFF = MOBA_TL_OFF + 132 * 4;
struct MobaPol {
    int nt, nmask, stride, own, tq, hi; unsigned selbits; const bf16* Pk; const bf16* Pv; LAS const int* tl;
    __device__ __forceinline__ const bf16* kptr(int i) const { return Pk + (size_t)tl[i] * 64 * DINP; }
    __device__ __forceinline__ const bf16* vptr(int i) const { return Pv + (size_t)tl[i] * 64 * DINP; }
    __device__ __forceinline__ bool rowsel(int i) const { const int blk = tl[i] >> 2; return blk == own || ((selbits >> blk) & 1u); }
    __device__ __forceinline__ void mask_(int i, f32x16& p0, f32x16& p1) const {
        const int tile = tl[i];
        if ((tile >> 2) == own) { const int kbase = tile * 64;
#pragma unroll
            for (int r = 0; r < 16; ++r) { const int k0 = kbase + crow(r, hi); p0[r] = (k0 <= tq) ? p0[r] : NEGBIG; p1[r] = (k0 + 32 <= tq) ? p1[r] : NEGBIG; } }
    }
    __device__ __forceinline__ void mask(int i, f32x16& p0, f32x16& p1) const { mask_(i, p0, p1); }
};
__device__ __forceinline__ void moba_unit(const bf16* __restrict__ P, const float* __restrict__ kmean, const float* __restrict__ kgain, bf16* __restrict__ MIX, int b, int h, int qb, int tid, LAS unsigned char* lds) {
    asm volatile("" : "+v"(tid));
    const int lane = tid & 63, wid = __builtin_amdgcn_readfirstlane(tid >> 6), r32 = lane & 31, hi = lane >> 5;
    LAS float* km = (LAS float*)(lds + MOBA_KM_OFF); LAS int* tl = (LAS int*)(lds + MOBA_TL_OFF); LAS unsigned* uw = (LAS unsigned*)(lds + MOBA_UW_OFF);
    const int own = qb, tq = qb * 256 + wid * 32 + r32;
    const size_t rowq = (size_t)b * SEQ + tq;
    const bf16* Pb = P + (size_t)b * SEQ * DINP;
    bf16x8 qf[4];
#pragma unroll
    for (int ks = 0; ks < 4; ++ks) qf[ks] = *(const bf16x8*)(P + rowq * DINP + C_BQ + h * 64 + ks * 16 + hi * 8);
    const float kmax = gain_kmax(kgain, lane);
    for (int e = tid; e < own * 64; e += 512) km[e] = kmean[(((size_t)b * 4 + h) * 32) * 64 + e];
    __syncthreads();
    unsigned mask = 0u;
    {
        float qv[32];
#pragma unroll
        for (int ks = 0; ks < 4; ++ks)
#pragma unroll
            for (int j = 0; j < 8; ++j) qv[ks * 8 + j] = bf2f((bf16)qf[ks][j]);
        float b0 = -3e38f, b1 = -3e38f, b2 = -3e38f; int i0 = -1, i1 = -1, i2 = -1;
        for (int n = 0; n < own; ++n) {
            LAS const float* kp = km + n * 64 + hi * 8; float a = 0.f;
#pragma unroll
            for (int ks = 0; ks < 4; ++ks)
#pragma unroll
                for (int j = 0; j < 8; ++j) a = fmaf(qv[ks * 8 + j], kp[ks * 16 + j], a);
            a += shx<32>(a);
            if (a > b0) { b2 = b1; i2 = i1; b1 = b0; i1 = i0; b0 = a; i0 = n; }
            else if (a > b1) { b2 = b1; i2 = i1; b1 = a; i1 = n; }
            else if (a > b2) { b2 = a; i2 = n; }
        }
        if (i0 >= 0) mask |= 1u << i0; if (i1 >= 0) mask |= 1u << i1; if (i2 >= 0) mask |= 1u << i2;
    }
    { unsigned um = mask;
      um |= shxu<1>(um); um |= shxu<2>(um); um |= shxu<4>(um); um |= shxu<8>(um); um |= shxu<16>(um); um |= shxu<32>(um);
      if (lane == 0) uw[wid] = um; }
    __syncthreads();
    if (tid == 0) { unsigned um = 0u; for (int w = 0; w < 8; ++w) um |= uw[w];
        int cnt = 0; for (int s = 0; s < 4; ++s) tl[cnt++] = own * 4 + s;
        for (int n = 0; n < own; ++n) if ((um >> n) & 1u) for (int s = 0; s < 4; ++s) tl[cnt++] = n * 4 + s;
        tl[131] = cnt; }
    __syncthreads();
#pragma unroll
    for (int ks = 0; ks < 4; ++ks) qf[ks] = scale_frag(qf[ks], SCL2);
    f32x16 o0, o1;
#pragma unroll
    for (int r = 0; r < 16; ++r) { o0[r] = zf_(); o1[r] = o0[r]; }
    float l = 0.f;
    MobaPol pol; pol.nt = tl[131]; pol.nmask = 4; pol.stride = DINP; pol.own = own; pol.tq = tq; pol.hi = hi; pol.selbits = mask; pol.Pk = Pb + C_BK + h * 64; pol.Pv = Pb + C_BV + h * 64; pol.tl = tl;
    attn_pipe(pol, lds, qf, row_negm(qf, kmax), o0, o1, l, tid);
    l += shx<32>(l);
    const float inv = rcpf_(l);
    bf16* op = MIX + rowq * DM + 512 + h * 64 + 4 * hi;
#pragma unroll
    for (int g = 0; g < 4; ++g) {
        uint2 w0, w1;
        w0.x = cvtpk(o0[4 * g] * inv, o0[4 * g + 1] * inv); w0.y = cvtpk(o0[4 * g + 2] * inv, o0[4 * g + 3] * inv);
        w1.x = cvtpk(o1[4 * g] * inv, o1[4 * g + 1] * inv); w1.y = cvtpk(o1[4 * g + 2] * inv, o1[4 * g + 3] * inv);
        *(uint2*)(op + 8 * g) = w0; *(uint2*)(op + 32 + 8 * g) = w1;
    }
}

constexpr int NSA_S4_OFF = PIPE_BYTES, NSA_L4_OFF = NSA_S4_OFF + 8 * 8 * 128 * 4, NSA_SM_OFF = NSA_L4_OFF + 8 * 8 * 128 * 4;
struct NsaCtx { const bf16* Pb; const bf16* Kcb; const bf16* Vcb; int b, jq, tid, lane, wid, r32, hi, tq; unsigned mk0, mk1, mk2, mk3; };

template <int MODE>
__device__ __forceinline__ void nsa_tiles(const NsaCtx& c, LAS unsigned char* lds, const bf16x8 (&qf)[4], int nt, f32x16& o0, f32x16& o1, float& m, float& l, float pre) {
    const int tid = c.tid, lane = c.lane, r32 = c.r32, hi = c.hi, tq = c.tq, jq = c.jq;
    const int nw = (jq < 8 ? jq : 8) + 1;
    auto tile_of = [&](int i) -> int { return MODE < 2 ? i : (i == 0 ? jq : (MODE == 2 ? i - 1 : jq - nw + i)); };
    auto src_of = [&](int t) -> TileSrc {
        if (MODE < 2) return TileSrc{c.Kcb + (size_t)t * 64 * 64, c.Vcb + (size_t)t * 64 * 64, 64};
        if (MODE == 2) return TileSrc{c.Pb + (size_t)t * 64 * DINP + C_NKS, c.Pb + (size_t)t * 64 * DINP + C_NVS, DINP};
        return TileSrc{c.Pb + (size_t)t * 64 * DINP + C_NKW, c.Pb + (size_t)t * 64 * DINP + C_NVW, DINP};
    };
    u32x4v kr, vr;
    { const TileSrc s = src_of(tile_of(0)); tile_load(kr, vr, s, tid); }
    tile_store(lds, kr, vr, tid);
    __syncthreads();
    const int ncv = (tq >= 31) ? ((tq - 31) >> 4) + 1 : 0;
    for (int i = 0; i < nt; ++i) {
        const int tile = tile_of(i);
        if (i + 1 < nt) { const TileSrc s = src_of(tile_of(i + 1)); tile_load(kr, vr, s, tid); }
        LAS const unsigned char* buf = lds + (i & 1) * STG;
        const int kbase = tile * 64;
        bool rowsel = true;
        if (MODE == 2 && tile != jq) { const unsigned w = (tile >> 5) == 0 ? c.mk0 : (tile >> 5) == 1 ? c.mk1 : (tile >> 5) == 2 ? c.mk2 : c.mk3; rowsel = (w >> (tile & 31)) & 1u; }
        if (MODE != 2 || __any(rowsel)) {
            f32x16 p0, p1;
            qk_tile(p0, p1, buf, qf, r32, hi, MODE < 2 ? 0.f : (rowsel ? -m : NEGBIG));
            if (MODE < 2) {
#pragma unroll
                for (int r = 0; r < 16; ++r) { const int k0 = kbase + crow(r, hi); p0[r] = (k0 < ncv) ? p0[r] : NEGBIG; p1[r] = (k0 + 32 < ncv) ? p1[r] : NEGBIG; }
            } else if (MODE == 2) {
                if (tile == jq) {
#pragma unroll
                    for (int r = 0; r < 16; ++r) { const int k0 = kbase + crow(r, hi); p0[r] = (k0 <= tq) ? p0[r] : NEGBIG; p1[r] = (k0 + 32 <= tq) ? p1[r] : NEGBIG; }
                }
            } else if (tile == jq || tile + 8 == jq) {
#pragma unroll
                for (int r = 0; r < 16; ++r) { const int k0 = kbase + crow(r, hi);
                    p0[r] = (k0 <= tq && k0 + 511 >= tq) ? p0[r] : NEGBIG; p1[r] = (k0 + 32 <= tq && k0 + 32 + 511 >= tq) ? p1[r] : NEGBIG; }
            }
            if (MODE == 0) {
                float tm = fmaxf(p0[0], p1[0]);
#pragma unroll
                for (int r = 1; r < 16; ++r) tm = fmaxf(tm, fmaxf(p0[r], p1[r]));
                tm = fmaxf(tm, shx<32>(tm));
                const float mn = fmaxf(m, tm); float s = 0.f;
#pragma unroll
                for (int r = 0; r < 16; ++r) { s += (p0[r] > -1e29f ? __builtin_amdgcn_exp2f(p0[r] - mn) : 0.f) + (p1[r] > -1e29f ? __builtin_amdgcn_exp2f(p1[r] - mn) : 0.f); }
                l = l * __builtin_amdgcn_exp2f(m - mn) + s; m = mn;
            } else if (MODE == 1) {
#pragma unroll
                for (int r = 0; r < 16; ++r) { p0[r] = (p0[r] > -1e29f) ? __builtin_amdgcn_exp2f(p0[r] - m) * pre : 0.f; p1[r] = (p1[r] > -1e29f) ? __builtin_amdgcn_exp2f(p1[r] - m) * pre : 0.f; }
                pv_tile(o0, o1, buf + KBUF, p0, p1, lane);
                LAS float* S4 = (LAS float*)(lds + NSA_S4_OFF) + (c.wid * 8 + (r32 & 7)) * 128; LAS float* L4 = (LAS float*)(lds + NSA_L4_OFF) + (c.wid * 8 + (r32 & 7)) * 128;
#pragma unroll
                for (int mbk = 0; mbk < 2; ++mbk)
#pragma unroll
                    for (int g = 0; g < 4; ++g) {
                        float s4 = mbk ? (p1[4 * g] + p1[4 * g + 1]) + (p1[4 * g + 2] + p1[4 * g + 3]) : (p0[4 * g] + p0[4 * g + 1]) + (p0[4 * g + 2] + p0[4 * g + 3]);
                        float la = mbk ? p1[4 * g + 3] : p0[4 * g + 3];
                        s4 += shx<8>(s4); s4 += shx<16>(s4); la += shx<8>(la); la += shx<16>(la);
                        const int gi = tile * 16 + 8 * mbk + 2 * g + hi;
                        if (r32 < 8) { S4[gi] = s4; L4[gi] = la; }
                    }
            } else {
                softmax_tile(p0, p1, o0, o1, m, l, i == 0);
                pv_tile(o0, o1, buf + KBUF, p0, p1, lane);
            }
        }
        if (i + 1 < nt) tile_store(lds + ((i + 1) & 1) * STG, kr, vr, tid);
        __syncthreads();
    }
}

struct NsaSelPol {
    int nt, nmask, stride, jq, tq, hi; unsigned long long mlo, mhi; const bf16* Pk; const bf16* Pv;
    __device__ __forceinline__ int tile_of(int i) const { return i == 0 ? jq : i - 1; }
    __device__ __forceinline__ const bf16* kptr(int i) const { return Pk + (size_t)tile_of(i) * 64 * DINP; }
    __device__ __forceinline__ const bf16* vptr(int i) const { return Pv + (size_t)tile_of(i) * 64 * DINP; }
    __device__ __forceinline__ bool rowsel(int i) const { if (i == 0) return true; const int tile = i - 1; const unsigned long long w = tile < 64 ? mlo : mhi; return (w >> (tile & 63)) & 1ull; }
    __device__ __forceinline__ void mask(int i, f32x16& p0, f32x16& p1) const {
        if (i == 0) { const int kbase = jq * 64;
#pragma unroll
            for (int r = 0; r < 16; ++r) { const int k0 = kbase + crow(r, hi); p0[r] = (k0 <= tq) ? p0[r] : NEGBIG; p1[r] = (k0 + 32 <= tq) ? p1[r] : NEGBIG; } }
    }
};
struct NsaWinPol {
    int nt, nmask, stride, jq, tq, hi; const bf16* Pk; const bf16* Pv;
    __device__ __forceinline__ int tile_of(int i) const { return i == 0 ? jq : jq - nt + i; }
    __device__ __forceinline__ const bf16* kptr(int i) const { return Pk + (size_t)tile_of(i) * 64 * DINP; }
    __device__ __forceinline__ const bf16* vptr(int i) const { return Pv + (size_t)tile_of(i) * 64 * DINP; }
    __device__ __forceinline__ bool rowsel(int) const { return true; }
    __device__ __forceinline__ void mask(int i, f32x16& p0, f32x16& p1) const {
        const int tile = tile_of(i);
        if (tile == jq || tile + 8 == jq) { const int kbase = tile * 64;
#pragma unroll
            for (int r = 0; r < 16; ++r) { const int k0 = kbase + crow(r, hi);
                p0[r] = (k0 <= tq && k0 + 511 >= tq) ? p0[r] : NEGBIG; p1[r] = (k0 + 32 <= tq && k0 + 32 + 511 >= tq) ? p1[r] : NEGBIG; } }
    }
};
__device__ __forceinline__ void nsa_unit(const bf16* __restrict__ P, const float* __restrict__ G, const float* __restrict__ tab, const bf16* __restrict__ KVcb, const float* __restrict__ kgain  , bf16* __restrict__ MIX,
                                         int b, int jq, int tid, LAS unsigned char* lds) {
    asm volatile("" : "+v"(tid));
    NsaCtx c; c.b = b; c.jq = jq; c.tid = tid; c.lane = tid & 63; c.wid = __builtin_amdgcn_readfirstlane(tid >> 6); c.r32 = c.lane & 31; c.hi = c.lane >> 5;
    const int qi = c.r32 & 7, hh = c.r32 >> 3, hi = c.hi, lane = c.lane;
    c.tq = jq * 64 + c.wid * 8 + qi;
    c.Pb = P + (size_t)b * SEQ * DINP; c.Kcb = KVcb + (size_t)b * 512 * 64; c.Vcb = KVcb + ((size_t)NB + b) * 512 * 64;
    c.mk0 = c.mk1 = c.mk2 = c.mk3 = 0u;
    const size_t rowq = (size_t)b * SEQ + c.tq;
    bf16x8 qf[4];
#pragma unroll
    for (int ks = 0; ks < 4; ++ks) qf[ks] = scale_frag(*(const bf16x8*)(P + rowq * DINP + C_NQ + hh * 64 + ks * 16 + hi * 8), SCL2);
    const float g0 = sigmoidf_(G[rowq * 32 + 8 + hh]);
    { LAS float* gl = (LAS float*)(lds + NSA_SM_OFF + 1024); gl[tid] = sigmoidf_(G[rowq * 32 + 12 + hh]); gl[512 + tid] = sigmoidf_(G[rowq * 32 + 16 + hh]); }
    f32x16 a0, a1;
    {
        const int ncvmax = min(4 * jq + 3, NCMP), nct = (ncvmax + 63) >> 6;
        f32x16 o0, o1;
#pragma unroll
        for (int r = 0; r < 16; ++r) { o0[r] = zf_(); o1[r] = o0[r]; }
        float m = NEGBIG, l = 0.f;
        nsa_tiles<0>(c, lds, qf, nct, o0, o1, m, l, 0.f);
        l += shx<32>(l);
        const float pre = (l > 0.f) ? rcpf_(l) : 0.f;
        nsa_tiles<1>(c, lds, qf, nct, o0, o1, m, l, pre);
#pragma unroll
        for (int r = 0; r < 16; ++r) { a0[r] = g0 * o0[r]; a1[r] = g0 * o1[r]; }
    }
    {
        LAS unsigned* sm = (LAS unsigned*)(lds + NSA_SM_OFF);
        for (int q = 0; q < 8; ++q) {
            LAS const float* S4 = (LAS const float*)(lds + NSA_S4_OFF) + (c.wid * 8 + q) * 128; LAS const float* L4 = (LAS const float*)(lds + NSA_L4_OFF) + (c.wid * 8 + q) * 128;
            float v0, v1;
            { const int n = lane; const bool causal = n <= jq, forced = causal && (n == 0 || n >= jq - 1);
              float im = 0.f; if (causal) { im = S4[n]; if (n > 0) im += L4[n - 1]; }
              v0 = forced ? 1e9f : (causal ? im : -1e30f); }
            { const int n = lane + 64; const bool causal = n <= jq, forced = causal && (n >= jq - 1);
              float im = 0.f; if (causal) { im = S4[n] + L4[n - 1]; }
              v1 = forced ? 1e9f : (causal ? im : -1e30f); }
            unsigned long long sel0 = 0ull, sel1 = 0ull;
            for (int k = 0; k < 16; ++k) { const float mx = wave_max(fmaxf(v0, v1));
                const unsigned long long b0 = __ballot(v0 == mx);
                if (b0) { const int idx = __ffsll((long long)b0) - 1; sel0 |= 1ull << idx; if (lane == idx) v0 = -3.0e38f; }
                else { const unsigned long long b1 = __ballot(v1 == mx); const int idx = __ffsll((long long)b1) - 1; sel1 |= 1ull << idx; if (lane == idx) v1 = -3.0e38f; } }
            if (lane == 0) { sm[(c.wid * 8 + q) * 4 + 0] = (unsigned)sel0; sm[(c.wid * 8 + q) * 4 + 1] = (unsigned)(sel0 >> 32); sm[(c.wid * 8 + q) * 4 + 2] = (unsigned)sel1; sm[(c.wid * 8 + q) * 4 + 3] = (unsigned)(sel1 >> 32); }
        }
        __builtin_amdgcn_s_waitcnt(0xc07f); __builtin_amdgcn_wave_barrier();
        c.mk0 = sm[(c.wid * 8 + qi) * 4 + 0]; c.mk1 = sm[(c.wid * 8 + qi) * 4 + 1]; c.mk2 = sm[(c.wid * 8 + qi) * 4 + 2]; c.mk3 = sm[(c.wid * 8 + qi) * 4 + 3];
    }
    LAS float* stash = (LAS float*)(lds + NSA_S4_OFF) + c.wid * 1024 + lane;
    LAS float* stash2 = (LAS float*)(lds + NSA_L4_OFF) + c.wid * 1024 + lane;
#pragma unroll
    for (int r = 0; r < 16; ++r) { stash[r * 64] = a0[r]; stash2[r * 64] = a1[r]; }
    {
        const u32x4v qw = __builtin_bit_cast(u32x4v, qf[0]); u32x4v w;
#pragma unroll
        for (int e = 0; e < 4; ++e) {
            float y[2];
#pragma unroll
            for (int k = 0; k < 2; ++k) { const int j = 2 * e + k; const float x = k ? __builtin_bit_cast(float, qw[e] & 0xffff0000u) : __builtin_bit_cast(float, qw[e] << 16); const float other = shx<32>(x);
                const float cs = tab[c.tq * 16 + j], sn = tab[c.tq * 16 + 8 + j]; y[k] = hi ? (x * cs + other * sn) : (x * cs - other * sn); }
            w[e] = cvtpk(y[0], y[1]);
        }
        qf[0] = __builtin_bit_cast(bf16x8, w);
    }
    {
        f32x16 o0, o1;
#pragma unroll
        for (int r = 0; r < 16; ++r) { o0[r] = zf_(); o1[r] = o0[r]; }
        float l = 0.f;
        NsaSelPol pol; pol.nt = jq + 1; pol.nmask = 1; pol.stride = DINP; pol.jq = jq; pol.tq = c.tq; pol.hi = hi; pol.mlo = (unsigned long long)c.mk0 | ((unsigned long long)c.mk1 << 32); pol.mhi = (unsigned long long)c.mk2 | ((unsigned long long)c.mk3 << 32); pol.Pk = c.Pb + C_NKS; pol.Pv = c.Pb + C_NVS;
        attn_pipe(pol, lds, qf, row_negm(qf, gain_kmax(kgain + 64, lane)), o0, o1, l, tid);
        l += shx<32>(l);
        int t2 = tid; asm volatile("" : "+v"(t2));
        const float sc = ((LAS const float*)(lds + NSA_SM_OFF + 1024))[t2] * rcpf_(l);
        LAS float* st1 = (LAS float*)(lds + NSA_S4_OFF) + (t2 >> 6) * 1024 + (t2 & 63); LAS float* st2 = (LAS float*)(lds + NSA_L4_OFF) + (t2 >> 6) * 1024 + (t2 & 63);
#pragma unroll
        for (int r = 0; r < 16; ++r) { st1[r * 64] = fmaf(sc, o0[r], st1[r * 64]); st2[r * 64] = fmaf(sc, o1[r], st2[r * 64]); }
    }
    {
        f32x16 o0, o1;
#pragma unroll
        for (int r = 0; r < 16; ++r) { o0[r] = zf_(); o1[r] = o0[r]; }
        float l = 0.f;
        NsaWinPol pol; pol.nt = (jq < 8 ? jq : 8) + 1; pol.nmask = 2; pol.stride = DINP; pol.jq = jq; pol.tq = c.tq; pol.hi = hi; pol.Pk = c.Pb + C_NKW; pol.Pv = c.Pb + C_NVW;
        attn_pipe(pol, lds, qf, row_negm(qf, gain_kmax(kgain + 128, lane)), o0, o1, l, tid);
        l += shx<32>(l);
        int t2 = tid; asm volatile("" : "+v"(t2));
        const float sc = ((LAS const float*)(lds + NSA_SM_OFF + 1024))[512 + t2] * rcpf_(l);
        LAS const float* st1 = (LAS const float*)(lds + NSA_S4_OFF) + (t2 >> 6) * 1024 + (t2 & 63); LAS const float* st2 = (LAS const float*)(lds + NSA_L4_OFF) + (t2 >> 6) * 1024 + (t2 & 63);
#pragma unroll
        for (int r = 0; r < 16; ++r) { a0[r] = fmaf(sc, o0[r], st1[r * 64]); a1[r] = fmaf(sc, o1[r], st2[r * 64]); }
    }
    int t3 = tid; asm volatile("" : "+v"(t3));
    const int ln3 = t3 & 63, r3 = ln3 & 31;
    bf16* op = MIX + ((size_t)b * SEQ + jq * 64 + (t3 >> 6) * 8 + (r3 & 7)) * DM + 768 + (r3 >> 3) * 64 + 4 * (ln3 >> 5);
#pragma unroll
    for (int g = 0; g < 4; ++g) {
        uint2 w0, w1;
        w0.x = cvtpk(a0[4 * g], a0[4 * g + 1]); w0.y = cvtpk(a0[4 * g + 2], a0[4 * g + 3]);
        w1.x = cvtpk(a1[4 * g], a1[4 * g + 1]); w1.y = cvtpk(a1[4 * g + 2], a1[4 * g + 3]);
        *(uint2*)(op + 8 * g) = w0; *(uint2*)(op + 32 + 8 * g) = w1;
    }
}


constexpr int MQ_PITCH = 272, MV_PITCH = 320;
constexpr int ML_G_OFF = 0;
constexpr int ML_Q_OFF = 4096;
constexpr int ML_K_OFF = ML_Q_OFF + 64 * MQ_PITCH;
constexpr int ML_V_OFF = ML_K_OFF + 64 * MV_PITCH;
constexpr int ML_END = ML_V_OFF + 64 * MV_PITCH;
static_assert(ML_END <= 131072, "mlstm LDS");
constexpr float KSCALE = 0.08838834764831845f;

__device__ __forceinline__ void qk2_rows(const bf16* __restrict__ P, const float* __restrict__ cw, bf16* __restrict__ QK2, int bid, int G, int tid) {
    asm volatile("" : "+v"(tid));
    const int ch = tid & 127, c0 = ch * 8;
    float tp[4][8];
#pragma unroll
    for (int j = 0; j < 4; ++j) { const float4 a = *(const float4*)(cw + j * 1024 + c0), b4 = *(const float4*)(cw + j * 1024 + c0 + 4);
        tp[j][0] = a.x; tp[j][1] = a.y; tp[j][2] = a.z; tp[j][3] = a.w; tp[j][4] = b4.x; tp[j][5] = b4.y; tp[j][6] = b4.z; tp[j][7] = b4.w; }
    const float sc = (c0 >= 512) ? KSCALE : 1.f;
    for (int row0 = bid * 4 + (tid >> 7); row0 < T; row0 += G * 16) {
        u32x4v w[4][4];
#pragma unroll
        for (int q = 0; q < 4; ++q) { const int row = row0 + q * G * 4, t = row & (SEQ - 1);
#pragma unroll
            for (int j = 0; j < 4; ++j) { w[q][j] = u32x4v{0u, 0u, 0u, 0u}; if (row < T && t - 3 + j >= 0) w[q][j] = *(const u32x4v*)(P + (size_t)(row - 3 + j) * DINP + c0); } }
#pragma unroll
        for (int q = 0; q < 4; ++q) { const int row = row0 + q * G * 4;
            float y[8];
#pragma unroll
            for (int e = 0; e < 8; ++e) y[e] = 0.f;
#pragma unroll
            for (int j = 0; j < 4; ++j)
#pragma unroll
                for (int e = 0; e < 4; ++e) { y[2 * e] = fmaf(tp[j][2 * e], __builtin_bit_cast(float, w[q][j][e] << 16), y[2 * e]); y[2 * e + 1] = fmaf(tp[j][2 * e + 1], __builtin_bit_cast(float, w[q][j][e] & 0xffff0000u), y[2 * e + 1]); }
#pragma unroll
            for (int e = 0; e < 8; ++e) y[e] = y[e] * rcpf_(1.f + __expf(-y[e])) * sc;
            u32x4v o; o[0] = cvtpk(y[0], y[1]); o[1] = cvtpk(y[2], y[3]); o[2] = cvtpk(y[4], y[5]); o[3] = cvtpk(y[6], y[7]);
            if (row < T) *(u32x4v*)(QK2 + (size_t)row * 1024 + c0) = o; }
    }
}

struct MlRaw { u32x4v q[2], k[2], v[2]; float gf, gi; };
template <bool WITH_Q> __device__ __forceinline__ void ml_load(MlRaw& r, const bf16* __restrict__ P, const bf16* __restrict__ QK2, const float* __restrict__ G, const float* __restrict__ bif, int u, int tid) {
    const int c = u & 127, h = (u >> 7) & 3, b = u >> 9, row0 = b * SEQ + c * 64, s = tid >> 3;
#pragma unroll
    for (int pass = 0; pass < 2; ++pass) { const int ch = (tid & 7) + 8 * pass;
        if (WITH_Q) r.q[pass] = *(const u32x4v*)(QK2 + (size_t)(row0 + s) * 1024 + h * 128 + ch * 8);
        r.k[pass] = *(const u32x4v*)(QK2 + (size_t)(row0 + s) * 1024 + 512 + h * 128 + ch * 8);
        r.v[pass] = *(const u32x4v*)(P + (size_t)(row0 + s) * DINP + C_MV + h * 128 + ch * 8); }
    if (tid < 64) { r.gf = G[(size_t)(row0 + tid) * 32 + 4 + h] + bif[4 + h]; r.gi = G[(size_t)(row0 + tid) * 32 + h] + bif[h]; }
}
__device__ __forceinline__ void mlstm_gates(const MlRaw& r, int tid, LAS float* gs) {
    if (tid < 64) { gs[tid] = log_sigmoidf_(r.gf); gs[128 + tid] = r.gi; }
    __syncthreads();
    if (tid < 64) { float a = 0.f; for (int s = 0; s <= tid; ++s) a += gs[s]; gs[64 + tid] = a; }
    __syncthreads();
}

__device__ __forceinline__ void mlstm_m1_phase(const bf16* __restrict__ P, const bf16* __restrict__ QK2, const float* __restrict__ G, const float* __restrict__ bif,
                                               bf16* __restrict__ CT, float* __restrict__ nst, float* __restrict__ dec, int bid, int Gd, int tid, LAS unsigned char* lds) {
    asm volatile("" : "+v"(tid));
    const int lane = tid & 63, wid = __builtin_amdgcn_readfirstlane(tid >> 6), hi = lane >> 5;
    LAS float* gs = (LAS float*)(lds + ML_G_OFF);
    MlRaw raw;
    if (bid < 2048) ml_load<false>(raw, P, QK2, G, bif, bid, tid);
    for (int u = bid; u < 2048; u += Gd) {
        mlstm_gates(raw, tid, gs);
        if (tid == 0) dec[u] = __expf(gs[64 + 63]);
        {
            const int s = tid >> 3; const float ws = __expf(gs[64 + 63] - gs[64 + s] + gs[128 + s]);
#pragma unroll
            for (int pass = 0; pass < 2; ++pass) { const int ch = (tid & 7) + 8 * pass; u32x4v w;
#pragma unroll
                for (int e = 0; e < 4; ++e) w[e] = cvtpk(__builtin_bit_cast(float, raw.k[pass][e] << 16) * ws, __builtin_bit_cast(float, raw.k[pass][e] & 0xffff0000u) * ws);
                *(LAS u32x4v*)(lds + ML_K_OFF + s * MV_PITCH + ch * 16) = w;
                *(LAS u32x4v*)(lds + ML_V_OFF + s * MV_PITCH + ch * 16) = raw.v[pass]; }
        }
        if (u + Gd < 2048) ml_load<false>(raw, P, QK2, G, bif, u + Gd, tid);
        __syncthreads();
        const int g = lane >> 4, i = lane & 15;
        const int mb = wid >> 1, nb0 = 2 * (wid & 1);
        f32x16 acc0, acc1;
#pragma unroll
        for (int r = 0; r < 16; ++r) { acc0[r] = zf_(); acc1[r] = acc0[r]; }
        LAS const unsigned char* trb = lds + (4 * hi + (i >> 2)) * MV_PITCH + (16 * (g & 1) + 4 * (i & 3)) * 2;
#pragma unroll
        for (int ks = 0; ks < 4; ++ks) {
            const s16x4 alo = lds_tr(trb + ML_K_OFF + ks * 16 * MV_PITCH + mb * 64), ahi = lds_tr(trb + ML_K_OFF + ks * 16 * MV_PITCH + 8 * MV_PITCH + mb * 64);
            const bf16x8 af = {alo[0], alo[1], alo[2], alo[3], ahi[0], ahi[1], ahi[2], ahi[3]};
            const s16x4 b0lo = lds_tr(trb + ML_V_OFF + ks * 16 * MV_PITCH + nb0 * 64), b0hi = lds_tr(trb + ML_V_OFF + ks * 16 * MV_PITCH + 8 * MV_PITCH + nb0 * 64);
            const s16x4 b1lo = lds_tr(trb + ML_V_OFF + ks * 16 * MV_PITCH + (nb0 + 1) * 64), b1hi = lds_tr(trb + ML_V_OFF + ks * 16 * MV_PITCH + 8 * MV_PITCH + (nb0 + 1) * 64);
            const bf16x8 bf0 = {b0lo[0], b0lo[1], b0lo[2], b0lo[3], b0hi[0], b0hi[1], b0hi[2], b0hi[3]}, bf1 = {b1lo[0], b1lo[1], b1lo[2], b1lo[3], b1hi[0], b1hi[1], b1hi[2], b1hi[3]};
            acc0 = __builtin_amdgcn_mfma_f32_32x32x16_bf16(af, bf0, acc0, 0, 0, 0);
            acc1 = __builtin_amdgcn_mfma_f32_32x32x16_bf16(af, bf1, acc1, 0, 0, 0);
        }
        bf16* ct = CT + (size_t)u * 16384;
#pragma unroll
        for (int gq = 0; gq < 4; ++gq) { const int d0 = 32 * mb + 8 * gq + 4 * hi;
            uint2 w0, w1; w0.x = cvtpk(acc0[4 * gq], acc0[4 * gq + 1]); w0.y = cvtpk(acc0[4 * gq + 2], acc0[4 * gq + 3]); w1.x = cvtpk(acc1[4 * gq], acc1[4 * gq + 1]); w1.y = cvtpk(acc1[4 * gq + 2], acc1[4 * gq + 3]);
            *(uint2*)(ct + (size_t)(32 * nb0 + (lane & 31)) * 128 + d0) = w0; *(uint2*)(ct + (size_t)(32 * (nb0 + 1) + (lane & 31)) * 128 + d0) = w1; }
        if (tid < 128) { float a = 0.f; for (int s = 0; s < 64; ++s) a += bf2f(*(LAS const bf16*)(lds + ML_K_OFF + s * MV_PITCH + tid * 2)); nst[(size_t)u * 128 + tid] = a; }
        __syncthreads();
    }
}
__device__ __forceinline__ void mlstm_scan(bf16* __restrict__ CT, float* __restrict__ nst, const float* __restrict__ dec, int item, int tid) {
    asm volatile("" : "+v"(tid));
    const int bh = item / 9, part = item % 9;
    if (part < 8) {
        bf16* base = CT + (size_t)bh * 128 * 16384 + (part * 512 + tid) * 4;
        float C[4] = {0.f, 0.f, 0.f, 0.f};
        for (int c0 = 0; c0 < 128; c0 += 16) {
            uint2 w[16];
#pragma unroll
            for (int k = 0; k < 16; ++k) w[k] = *(const uint2*)(base + (size_t)(c0 + k) * 16384);
#pragma unroll
            for (int k = 0; k < 16; ++k) { const float a = dec[bh * 128 + c0 + k];
                uint2 o; o.x = cvtpk(C[0], C[1]); o.y = cvtpk(C[2], C[3]); *(uint2*)(base + (size_t)(c0 + k) * 16384) = o;
                C[0] = fmaf(a, C[0], __builtin_bit_cast(float, w[k].x << 16)); C[1] = fmaf(a, C[1], __builtin_bit_cast(float, w[k].x & 0xffff0000u));
                C[2] = fmaf(a, C[2], __builtin_bit_cast(float, w[k].y << 16)); C[3] = fmaf(a, C[3], __builtin_bit_cast(float, w[k].y & 0xffff0000u)); }
        }
    } else if (tid < 128) {
        float* base = nst + (size_t)bh * 128 * 128 + tid; float C = 0.f;
        for (int c = 0; c < 128; ++c) { const float dC = base[(size_t)c * 128]; base[(size_t)c * 128] = C; C = dec[bh * 128 + c] * C + dC; }
    }
}

__device__ __forceinline__ void mlstm_m3_phase(const bf16* __restrict__ P, const bf16* __restrict__ QK2, const float* __restrict__ G, const float* __restrict__ bif,
                                               const bf16* __restrict__ CT, const float* __restrict__ nst, const float* __restrict__ mnorm, bf16* __restrict__ MIX, int bid, int Gd, int tid, LAS unsigned char* lds) {
    asm volatile("" : "+v"(tid));
    const int lane = tid & 63, wid = __builtin_amdgcn_readfirstlane(tid >> 6), hi = lane >> 5, r32 = lane & 31;
    LAS float* gs = (LAS float*)(lds + ML_G_OFF);
    MlRaw raw;
    if (bid < 2048) ml_load<true>(raw, P, QK2, G, bif, bid, tid);
    for (int u = bid; u < 2048; u += Gd) {
    const int c = u & 127, h = (u >> 7) & 3, b = u >> 9, t0 = c * 64;
    const int tb = wid & 1, eb = wid >> 1, t = 32 * tb + r32;
    bf16x8 cf[8]; uint2 opre[4]; float npv = 0.f;
    { const bf16* ctp = CT + (size_t)u * 16384 + (size_t)(32 * eb + r32) * 128 + hi * 8;
#pragma unroll
      for (int ks = 0; ks < 8; ++ks) cf[ks] = *(const bf16x8*)(ctp + ks * 16);
      const size_t row_ = (size_t)b * SEQ + t0 + t;
#pragma unroll
      for (int gq = 0; gq < 4; ++gq) opre[gq] = *(const uint2*)(P + row_ * DINP + C_MO + h * 128 + 32 * eb + 8 * gq + 4 * hi);
      if (tid >= 128 && tid < 256) npv = nst[(size_t)u * 128 + tid - 128]; }
    if (tid >= 128 && tid < 256) gs[256 + tid - 128] = npv;
    mlstm_gates(raw, tid, gs);
    {
        const int s = tid >> 3;
#pragma unroll
        for (int pass = 0; pass < 2; ++pass) { const int ch = (tid & 7) + 8 * pass;
            *(LAS u32x4v*)(lds + ML_Q_OFF + s * MQ_PITCH + ch * 16) = raw.q[pass];
            *(LAS u32x4v*)(lds + ML_K_OFF + s * MQ_PITCH + ch * 16) = raw.k[pass];
            *(LAS u32x4v*)(lds + ML_V_OFF + s * MV_PITCH + ch * 16) = raw.v[pass]; }
    }
    if (u + Gd < 2048) ml_load<true>(raw, P, QK2, G, bif, u + Gd, tid);
    __syncthreads();
    bf16x8 qf[8];
#pragma unroll
    for (int ks = 0; ks < 8; ++ks) qf[ks] = *(LAS const bf16x8*)(lds + ML_Q_OFF + t * MQ_PITCH + ks * 32 + hi * 16);
    f32x16 ni;
#pragma unroll
    for (int r = 0; r < 16; ++r) ni[r] = zf_();
#pragma unroll
    for (int ks = 0; ks < 8; ++ks) ni = __builtin_amdgcn_mfma_f32_32x32x16_bf16(cf[ks], qf[ks], ni, 0, 0, 0);
    f32x16 p0, p1;
#pragma unroll
    for (int r = 0; r < 16; ++r) { p0[r] = zf_(); p1[r] = p0[r]; }
    { LAS const unsigned char* ka = lds + ML_K_OFF + r32 * MQ_PITCH + hi * 16;
#pragma unroll
      for (int ks = 0; ks < 8; ++ks) { const bf16x8 a0 = *(LAS const bf16x8*)(ka + ks * 32); p0 = __builtin_amdgcn_mfma_f32_32x32x16_bf16(a0, qf[ks], p0, 0, 0, 0); }
      if (tb == 1) {
#pragma unroll
          for (int ks = 0; ks < 8; ++ks) { const bf16x8 a1 = *(LAS const bf16x8*)(ka + 32 * MQ_PITCH + ks * 32); p1 = __builtin_amdgcn_mfma_f32_32x32x16_bf16(a1, qf[ks], p1, 0, 0, 0); } } }
    const float bt = gs[64 + t], Ft = __expf(bt);
    float dsum = 0.f;
#pragma unroll
    for (int r = 0; r < 16; ++r) { const int s0 = crow(r, hi);
        { const float w = (s0 <= t) ? __expf(bt - gs[64 + s0] + gs[128 + s0]) : 0.f; p0[r] *= w; dsum += p0[r]; }
        { const int s1 = s0 + 32; const float w = (s1 <= t) ? __expf(bt - gs[64 + s1] + gs[128 + s1]) : 0.f; p1[r] *= w; dsum += p1[r]; } }
    float qn = 0.f;
#pragma unroll
    for (int ks = 0; ks < 8; ++ks)
#pragma unroll
        for (int j = 0; j < 8; ++j) qn = fmaf(bf2f((bf16)qf[ks][j]), gs[256 + ks * 16 + hi * 8 + j], qn);
    dsum += shx<32>(dsum); qn += shx<32>(qn);
    const float den = dsum + Ft * qn, inv = rcpf_(fmaxf(fabsf(den), 1.f));
    f32x16 na;
#pragma unroll
    for (int r = 0; r < 16; ++r) na[r] = zf_();
    { const int g = lane >> 4, i = lane & 15;
      LAS const unsigned char* trb = lds + ML_V_OFF + (4 * hi + (i >> 2)) * MV_PITCH + (16 * (g & 1) + 4 * (i & 3)) * 2 + eb * 64;
#pragma unroll
      for (int ss = 0; ss < 4; ++ss) { if (ss >= 2 && tb == 0) break;
          unsigned w[4];
#pragma unroll
          for (int e = 0; e < 4; ++e) { const int r = 8 * (ss & 1) + 2 * e; w[e] = (ss < 2) ? cvtpk(p0[r], p0[r + 1]) : cvtpk(p1[r], p1[r + 1]); }
          const u32x4v wv = {w[0], w[1], w[2], w[3]}; const bf16x8 pf = __builtin_bit_cast(bf16x8, wv);
          const s16x4 lo = lds_tr(trb + ss * 16 * MV_PITCH), hi4 = lds_tr(trb + ss * 16 * MV_PITCH + 8 * MV_PITCH);
          const bf16x8 vt = {lo[0], lo[1], lo[2], lo[3], hi4[0], hi4[1], hi4[2], hi4[3]};
          na = __builtin_amdgcn_mfma_f32_32x32x16_bf16(vt, pf, na, 0, 0, 0); } }
    float ssq = 0.f;
#pragma unroll
    for (int r = 0; r < 16; ++r) { na[r] = (na[r] + Ft * ni[r]) * inv; ssq += na[r] * na[r]; }
    ssq += shx<32>(ssq);
    if (hi == 0) gs[384 + eb * 64 + t] = ssq;
    __syncthreads();
    const float rstd = rsqrtf((gs[384 + t] + gs[384 + 64 + t] + gs[384 + 128 + t] + gs[384 + 192 + t]) * (1.f / 128.f) + EPS);
    const size_t row = (size_t)b * SEQ + t0 + t;
#pragma unroll
    for (int gq = 0; gq < 4; ++gq) { const int cc = h * 128 + 32 * eb + 8 * gq + 4 * hi;
        const uint2 ow = opre[gq]; const float4 mn = *(const float4*)(mnorm + cc);
        const float o0 = sigmoidf_(__builtin_bit_cast(float, ow.x << 16)), o1 = sigmoidf_(__builtin_bit_cast(float, ow.x & 0xffff0000u)), o2 = sigmoidf_(__builtin_bit_cast(float, ow.y << 16)), o3 = sigmoidf_(__builtin_bit_cast(float, ow.y & 0xffff0000u));
        uint2 w; w.x = cvtpk(na[4 * gq] * rstd * mn.x * o0, na[4 * gq + 1] * rstd * mn.y * o1); w.y = cvtpk(na[4 * gq + 2] * rstd * mn.z * o2, na[4 * gq + 3] * rstd * mn.w * o3);
        *(uint2*)(MIX + row * DM + cc) = w; }
    __syncthreads();
    }
}


typedef float f32x4v __attribute__((ext_vector_type(4)));
__device__ __forceinline__ void compress_item(const bf16* __restrict__ P, const bf16* __restrict__ w1t  , const float* __restrict__ c1  , const float* __restrict__ w2  ,
                                              const float* __restrict__ kg0, bf16* __restrict__ KVcb, int item, int tid, LAS unsigned char* lds) {
    asm volatile("" : "+v"(tid));
    const int lane = tid & 63, wid = __builtin_amdgcn_readfirstlane(tid >> 6), hi = lane >> 5, r32 = lane & 31;
    const int kv = item >> 6, b = (item >> 4) & 3, i0 = (item & 15) * 32;
    const int cb = wid & 3, kh = wid >> 2;
    const int irow = min(i0 + r32, NCMP - 1);
    const bf16* xa = P + ((size_t)b * SEQ + 16 * irow + 16 * kh) * DINP + (kv ? C_NVC : C_NKC) + hi * 8;
    const bf16* wb = w1t + ((size_t)kv * 128 + 32 * cb + r32) * 2048 + kh * 1024 + hi * 8;
    f32x16 acc;
#pragma unroll
    for (int r = 0; r < 16; ++r) acc[r] = zf_();
    for (int p0 = 0; p0 < 16; p0 += 4) {
        bf16x8 af[16], bfr[16];
#pragma unroll
        for (int q = 0; q < 16; ++q) { const int p = p0 + (q >> 2), dq = q & 3;
            af[q] = *(const bf16x8*)(xa + (size_t)p * DINP + dq * 16); bfr[q] = *(const bf16x8*)(wb + p * 64 + dq * 16); }
#pragma unroll
        for (int q = 0; q < 16; ++q) acc = __builtin_amdgcn_mfma_f32_32x32x16_bf16(af[q], bfr[q], acc, 0, 0, 0);
    }
    LAS float* hid = (LAS float*)lds + kh * 32 * 132;
    { LAS f32x4v* w2s = (LAS f32x4v*)(lds + 2 * 32 * 132 * 4); const f32x4v* w2g = (const f32x4v*)(w2 + (size_t)kv * 128 * 64);
#pragma unroll
      for (int q = 0; q < 4; ++q) w2s[tid + 512 * q] = w2g[tid + 512 * q]; }
#pragma unroll
    for (int r = 0; r < 16; ++r) hid[crow(r, hi) * 132 + 32 * cb + r32] = acc[r];
    __syncthreads();
    {
        const int il = tid >> 4, d0 = (tid & 15) * 4;
        float o[4] = {0.f, 0.f, 0.f, 0.f};
        LAS const float* ha = (LAS const float*)lds + il * 132; LAS const float* hb = ha + 32 * 132;
        LAS const float* wp = (LAS const float*)(lds + 2 * 32 * 132 * 4) + d0;
        const float* cj = c1 + kv * 128;
#pragma unroll 8
        for (int j = 0; j < 128; ++j) { const float a = ha[j] + hb[j] + cj[j]; const float hv = a * rcpf_(1.f + __expf(-a)); const f32x4v wa = *(LAS const f32x4v*)(wp + j * 64);
            o[0] = fmaf(hv, wa[0], o[0]); o[1] = fmaf(hv, wa[1], o[1]); o[2] = fmaf(hv, wa[2], o[2]); o[3] = fmaf(hv, wa[3], o[3]); }
        if (kv == 0) { float ss = o[0] * o[0] + o[1] * o[1] + o[2] * o[2] + o[3] * o[3];
            ss += shx<1>(ss); ss += shx<2>(ss); ss += shx<4>(ss); ss += shx<8>(ss);
            const float rstd = rsqrtf(ss * (1.f / 64.f) + EPS);
#pragma unroll
            for (int e = 0; e < 4; ++e) o[e] *= rstd * kg0[d0 + e]; }
        const int i = i0 + il;
        if (i >= NCMP) { o[0] = o[1] = o[2] = o[3] = 0.f; }
        uint2 w; w.x = cvtpk(o[0], o[1]); w.y = cvtpk(o[2], o[3]);
        *(uint2*)(KVcb + (((size_t)kv * NB + b) * 512 + i) * 64 + d0) = w;
    }
    __syncthreads();
}
__device__ __forceinline__ void cmp_c1_item(const float* __restrict__ pe, const float* __restrict__ w1, float* __restrict__ c1, int item, int tid, LAS unsigned char* lds) {
    const int lk = item >> 4, j0 = (item & 15) * 8, jj = tid & 7, kk = tid >> 3;
    const float* pp = pe + (size_t)lk * 2048; const float* ww = w1 + (size_t)lk * 2048 * 128 + j0 + jj;
    float a = 0.f;
#pragma unroll 8
    for (int k = kk; k < 2048; k += 64) a = fmaf(pp[k], ww[(size_t)k * 128], a);
    LAS float* red = (LAS float*)lds;
    red[tid] = a;
    __syncthreads();
    if (tid < 8) { float s = 0.f; for (int q = 0; q < 64; ++q) s += red[q * 8 + tid]; c1[lk * 128 + j0 + tid] = s; }
    __syncthreads();
}

#define XB_TMO      128
#define XB_XCNT(j)  (256  + 64 * (j))
#define XB_XSUB(j)  (1280 + 64 * (j))
#define XB_XGEN(j)  (2304 + 64 * (j))
#define XB_TOP      3328
#define XB_TOPGEN   3392
#define XCD_BAR_WORDS 3456
#define XB_SPIN_CAP (1u << 22)

__device__ __forceinline__ unsigned xb_ld(unsigned* p)              { return __hip_atomic_load(p, __ATOMIC_RELAXED, __HIP_MEMORY_SCOPE_AGENT); }
__device__ __forceinline__ unsigned xb_add(unsigned* p, unsigned v) { return __hip_atomic_fetch_add(p, v, __ATOMIC_RELAXED, __HIP_MEMORY_SCOPE_AGENT); }
__device__ __forceinline__ unsigned xb_xcc_id() { return (unsigned)__builtin_amdgcn_s_getreg((3 << 11) | 20) & 0xFu; }
#define XB_SPIN(cond, bar) do { unsigned _sp = 0; while (cond) { __builtin_amdgcn_s_sleep(1); \
    if ((++_sp & 255u) == 0u) { if (xb_ld(&(bar)[XB_TMO])) break; if (_sp > XB_SPIN_CAP) { atomicAdd(&(bar)[XB_TMO], 1u); break; } } } } while (0)

struct XcdBarrier {
    unsigned* bar; unsigned x;
    volatile LAS unsigned* st;
};

__device__ __forceinline__ XcdBarrier xcd_barrier_post(unsigned* bar, volatile LAS unsigned* st) {
    XcdBarrier b; b.bar = bar; b.x = xb_xcc_id(); b.st = st;
    if (threadIdx.x == 0) (void)xb_add(&bar[XB_XCNT(b.x)], 1u);
    return b;
}
__device__ __forceinline__ void xcd_barrier_complete(unsigned* bar, unsigned x, unsigned& nloc, unsigned& nx) {
    const unsigned G = gridDim.x * gridDim.y * gridDim.z;
    unsigned sum, cnt, mine, sp = 0u;
    for (;;) {
        sum = 0u; cnt = 0u; mine = 0u;
#pragma unroll
        for (unsigned j = 0; j < 16; ++j) { const unsigned c = xb_ld(&bar[XB_XCNT(j)]); sum += c; cnt += (c > 0u) ? 1u : 0u; mine = (j == x) ? c : mine; }
        if (sum == G) break;
        __builtin_amdgcn_s_sleep(1);
        if ((++sp & 255u) == 0u) { if (xb_ld(&bar[XB_TMO])) break; if (sp > XB_SPIN_CAP) { atomicAdd(&bar[XB_TMO], 1u); break; } }
    }
    nloc = mine > 0u ? mine : 1u; nx = cnt > 0u ? cnt : 1u;
}

__device__ __forceinline__ void xcd_barrier(const XcdBarrier& b) {
    asm volatile("s_waitcnt vmcnt(0)" ::: "memory");
    __syncthreads();
    if (threadIdx.x == 0) {
        unsigned* bar = b.bar;
        __builtin_amdgcn_s_waitcnt(0);
        unsigned nloc = b.st[0], nx = b.st[1];
        if (nloc == 0u) { xcd_barrier_complete(bar, b.x, nloc, nx); b.st[0] = nloc; b.st[1] = nx; }
        const unsigned old = xb_add(&bar[XB_XSUB(b.x)], 1u);
        const unsigned gen = old / nloc;
        if (old + 1u == (gen + 1u) * nloc) {
            __builtin_amdgcn_fence(__ATOMIC_RELEASE, "agent");
            asm volatile("s_waitcnt vmcnt(0)" ::: "memory");
            const unsigned og = xb_add(&bar[XB_TOP], 1u);
            const unsigned tg = og / nx;
            if (og + 1u == (tg + 1u) * nx) xb_add(&bar[XB_TOPGEN], 1u);
            else XB_SPIN(xb_ld(&bar[XB_TOPGEN]) == tg, bar);
            __builtin_amdgcn_fence(__ATOMIC_ACQUIRE, "agent");
            xb_add(&bar[XB_XGEN(b.x)], 1u);
            asm volatile("s_waitcnt vmcnt(0)" ::: "memory");
        } else {
            XB_SPIN(xb_ld(&bar[XB_XGEN(b.x)]) == gen, bar);
            __builtin_amdgcn_fence(__ATOMIC_ACQUIRE, "agent");
            asm volatile("s_waitcnt vmcnt(0)" ::: "memory");
        }
    }
    __syncthreads();
}


constexpr size_t MiB = 1u << 20;
constexpr size_t W_LAYER = (size_t)(DINP + DM + DFF) * DM + (size_t)DM * DFF;
constexpr size_t WS_W = 0;
constexpr size_t WS_HM = 52 * MiB;
constexpr size_t WS_G = 116 * MiB;
constexpr size_t WS_SMALL = 120 * MiB;
constexpr size_t WS_TAB = WS_SMALL, WS_KMEAN = WS_SMALL + 512 * 1024, WS_KVC = WS_SMALL + 1 * MiB, WS_NST = WS_SMALL + 2 * MiB, WS_DEC = WS_SMALL + 3 * MiB, WS_KVCB = WS_SMALL + 3 * MiB + 512 * 1024;
constexpr size_t WS_SSP = 476 * MiB;
constexpr size_t WS_BAR = WS_SMALL + 3 * MiB + 64 * 1024;
constexpr size_t WS_W1T = 50 * MiB, WS_C1 = WS_SMALL + 3 * MiB + 16 * 1024;
constexpr size_t WS_P = 124 * MiB;
constexpr size_t WS_C = 348 * MiB;
constexpr size_t WS_U = WS_P;
constexpr size_t WS_END = 478 * MiB;
static_assert(W_LAYER * 2 * DEPTH <= 50 * MiB && WS_W1T + (size_t)DEPTH * 2 * 128 * 2048 * 2 <= 52 * MiB, "weights");
static_assert((size_t)T * DINP * 2 == 224 * MiB && (size_t)T * DFF * 2 == 256 * MiB, "sizes");

#ifndef DUP_PRO
#define DUP_PRO 1
#endif
#ifndef DUP_QK2
#define DUP_QK2 1
#endif
#ifndef DUP_GEMM
#define DUP_GEMM 1
#endif
#ifndef DUP_M1
#define DUP_M1 1
#endif
#ifndef DUP_MOBA
#define DUP_MOBA 1
#endif
#ifndef DUP_NSA
#define DUP_NSA 1
#endif
#ifndef DUP_M3
#define DUP_M3 1
#endif
#ifndef DUP_CMP
#define DUP_CMP 1
#endif
struct Params { const float* in[16]; float* out; unsigned char* ws; };
static_assert(sizeof(Params) == 18 * 8, "kernarg layout: in[k] at 8k, out at 128, ws at 136");
constexpr int LDS_BYTES = 147456;

__global__ void __launch_bounds__(512, 2) hybrid_fwd(Params prm) {
    extern __shared__ __attribute__((aligned(16))) unsigned char lds[];
    cg::grid_group grid = cg::this_grid();
    constexpr int NPH = 1 + DEPTH * 8;
    volatile LAS unsigned* xst = (volatile LAS unsigned*)((LAS unsigned char*)lds + 131072 + 1024);
    if (threadIdx.x < 2) xst[threadIdx.x] = 0u;
    __syncthreads();
    (void)xcd_barrier_post((unsigned*)(prm.ws + WS_BAR), xst);
    for (int ph = 0; ph < NPH; ++ph) {
        int tid = threadIdx.x; asm volatile("" : "+v"(tid));
        int G = gridDim.x, bid = blockIdx.x; asm volatile("" : "+s"(G), "+s"(bid));
#define PH_LOCALS const int half = tid >> 8, t256 = tid & 255, lane = tid & 63, wid = __builtin_amdgcn_readfirstlane(tid >> 6); unsigned char* smh = lds + half * 65536; \
        const int vb = bid * 2 + half, NVB = G * 2, gwv = bid * 8 + wid, NGW = G * 8; (void)lane; (void)smh; (void)vb; (void)NVB; (void)gwv; (void)NGW; (void)t256;
        const __attribute__((address_space(4))) unsigned char* ka = (const __attribute__((address_space(4))) unsigned char*)__builtin_amdgcn_kernarg_segment_ptr(); asm volatile("" : "+s"(ka));
#define KARG(T_, off) (*(T_ const __attribute__((address_space(4)))*)(ka + (off)))
#define IN(k) KARG(const float*, 8 * (k))
        unsigned char* ws = KARG(unsigned char*, 8 * 17); float* out = KARG(float*, 8 * 16);
        bf16* Wb = (bf16*)(ws + WS_W); bf16* HM = (bf16*)(ws + WS_HM); float* Gt = (float*)(ws + WS_G); float* tab = (float*)(ws + WS_TAB); float* kmean = (float*)(ws + WS_KMEAN);
        float* KVc = (float*)(ws + WS_KVC); float* nst = (float*)(ws + WS_NST); float* dec = (float*)(ws + WS_DEC); bf16* KVcb = (bf16*)(ws + WS_KVCB); bf16* W1t = (bf16*)(ws + WS_W1T); float* C1 = (float*)(ws + WS_C1); bf16* P = (bf16*)(ws + WS_P); bf16* CT = (bf16*)(ws + WS_C); bf16* QK2 = (bf16*)(ws + WS_C + 64 * MiB); bf16* XB = QK2  ; unsigned long long* SSA = (unsigned long long*)(ws + WS_SSP); unsigned long long* SSB = SSA + T;     bf16* U = (bf16*)(ws + WS_U);
        const int l = ph == 0 ? 0 : (ph - 1) / 8, j = ph == 0 ? -1 : (ph - 1) % 8;
        const float* x = IN(0);
        const float* xin = l == 0 ? x : out;
        const bf16* WinT = Wb + l * W_LAYER; const bf16* WoT = WinT + (size_t)DINP * DM; const bf16* W1T = WoT + (size_t)DM * DM; const bf16* W2T = W1T + (size_t)DFF * DM;
        if (ph == 0) {
            PH_LOCALS
            const float* w_in = IN(1); const float* w_out = IN(11); const float* w_ff1 = IN(14); const float* w_ff2 = IN(15);
            for (int rep = 0; rep < DUP_PRO; ++rep) {
            for (int ll = 0; ll < DEPTH; ++ll) {
                bf16* WinT_ = Wb + ll * W_LAYER; bf16* WoT_ = WinT_ + (size_t)DINP * DM; bf16* W1T_ = WoT_ + (size_t)DM * DM; bf16* W2T_ = W1T_ + (size_t)DFF * DM;
                for (int mt = 0; mt < 4; ++mt) {
                    const float* W; int K, N, NP, mode; bf16* WT;
                    const float* gk = nullptr;
                    if (mt == 0) { W = w_in + (size_t)ll * DM * DIN; K = DM; N = DIN; NP = DINP; WT = WinT_; mode = 1; gk = IN(12) + ll * DM; }
                    else if (mt == 1) { W = w_out + (size_t)ll * DM * DM; K = DM; N = DM; NP = DM; WT = WoT_; mode = 0; }
                    else if (mt == 2) { W = w_ff1 + (size_t)ll * DM * DFF; K = DM; N = DFF; NP = DFF; WT = W1T_; mode = 0; gk = IN(13) + ll * DM; }
                    else { W = w_ff2 + (size_t)ll * DFF * DM; K = DFF; N = DM; NP = DM; WT = W2T_; mode = 0; }
                    const int nit = (NP / 64) * (K / 64);
                    for (int it0 = 0; it0 < nit; it0 += NVB) { const int it = it0 + vb; ph_convert_w(W, K, N, NP, WT, mode, it, it < nit, t256, (float*)smh, gk); }
                }
            }
            for (int lk = 0; lk < DEPTH * 2; ++lk) {
                const int nit = 2 * 32;
                for (int it0 = 0; it0 < nit; it0 += NVB) { const int it = it0 + vb; ph_convert_w(IN(9) + (size_t)lk * 2048 * 128, 2048, 128, 128, W1t + (size_t)lk * 128 * 2048, 0, it, it < nit, t256, (float*)smh); }
            }
            for (int it = bid; it < 64; it += G) cmp_c1_item(IN(8), IN(9), C1, it, tid, (LAS unsigned char*)lds);
            for (int i = bid * 512 + tid; i < SEQ * 8; i += G * 512) { const int pos = i >> 3, f = i & 7;
                float c_, s_; rope_cs(pos, f, c_, s_);
                tab[pos * 16 + f] = c_; tab[pos * 16 + 8 + f] = s_; }
            for (int row = gwv; row < T; row += 2 * NGW) { ph_x_row(x, XB, SSA, row, lane); if (row + NGW < T) ph_x_row(x, XB, SSA, row + NGW, lane); }
            }
        } else if (j == 0 || j >= 5) {
            pg8::Gemm g; pg8::EpiAny E; int N; const bool last = (l + 1 == DEPTH);
            if (j == 0) { g = pg8::Gemm{XB, WinT, T, DINP, DM}; N = DINP; E = pg8::EpiAny{0, true, P, DINP, Gt, C_GATE, nullptr, nullptr, nullptr, SSA}; }
            else if (j == 5) { g = pg8::Gemm{HM, WoT, T, DM, DM}; N = DM; E = pg8::EpiAny{2, false, nullptr, DM, nullptr, 0, xin, out, XB, SSB}; }
            else if (j == 6) { g = pg8::Gemm{XB, W1T, T, DFF, DM}; N = DFF; E = pg8::EpiAny{1, true, U, DFF, nullptr, 0, nullptr, nullptr, nullptr, SSB}; }
            else { g = pg8::Gemm{U, W2T, T, DM, DFF}; N = DM; E = pg8::EpiAny{2, false, nullptr, DM, nullptr, 0, out, out, last ? nullptr : XB, SSA}; }
            pg8::StaticOrder S; S.init(T, N, G, bid);
            for (int rep = 0; rep < ((j == 0 || j == 6) ? DUP_GEMM : 1); ++rep) pg8::gemm_phase<pg8::EpiAny, pg8::StaticOrder, true, true>((PG8_LAS unsigned char*)lds, g, S, E, tid);
        } else if (j == 1) {
            PH_LOCALS
            for (int rep = 0; rep < DUP_CMP; ++rep) for (int it = bid; it < 128; it += G) compress_item(P, W1t + (size_t)l * 2 * 128 * 2048, C1 + l * 256, IN(10) + (size_t)l * 2 * 128 * 64, IN(7) + l * 192, KVcb, it, tid, (LAS unsigned char*)lds);
            for (int it0 = 0; it0 < 128 * 14; it0 += NVB) { const int it = it0 + vb; ph_prep(P, tab, IN(5) + l * 128, IN(6) + l * 64, IN(7) + l * 192, kmean, it, it < 128 * 14, t256, (float*)smh); }
            for (int rep = 0; rep < DUP_QK2; ++rep) qk2_rows(P, IN(3) + (size_t)l * 4 * 1024, QK2, bid, G, tid);
            { unsigned long long z64 = 0ull; asm volatile("" : "+v"(z64)); for (int i = bid * 512 + tid; i < 2 * T; i += G * 512) SSA[i] = z64; }
        } else if (j == 2) {
            for (int rep = 0; rep < DUP_M1; ++rep) mlstm_m1_phase(P, QK2, Gt, IN(2) + l * 8, CT, nst, dec, bid, G, tid, (LAS unsigned char*)lds);
            for (int rep = 0; rep < DUP_MOBA; ++rep) for (int pu = bid; pu < 256; pu += G) { const int bh = pu >> 4, s = pu & 15;
                moba_unit(P, kmean, IN(5) + l * 128 + 64, HM, bh >> 2, bh & 3, 31 - s, tid, (LAS unsigned char*)lds); moba_unit(P, kmean, IN(5) + l * 128 + 64, HM, bh >> 2, bh & 3, s, tid, (LAS unsigned char*)lds); }
        } else if (j == 3) {
            for (int it = bid; it < 16 * 9; it += G) mlstm_scan(CT, nst, dec, it, tid);
            for (int rep = 0; rep < DUP_NSA; ++rep) for (int pu = bid; pu < 256; pu += G) { const int b_ = pu >> 6, s = pu & 63;
                nsa_unit(P, Gt, tab, KVcb, IN(7) + l * 192, HM, b_, 127 - s, tid, (LAS unsigned char*)lds); nsa_unit(P, Gt, tab, KVcb, IN(7) + l * 192, HM, b_, s, tid, (LAS unsigned char*)lds); }
        } else {
            for (int rep = 0; rep < DUP_M3; ++rep) mlstm_m3_phase(P, QK2, Gt, IN(2) + l * 8, CT, nst, IN(4) + l * 512, HM, bid, G, tid, (LAS unsigned char*)lds);
        }
        if (ph + 1 < NPH) { if (ph == 0) grid.sync(); else { XcdBarrier xbar; xbar.bar = (unsigned*)(ws + WS_BAR); xbar.x = xb_xcc_id(); xbar.st = xst; xcd_barrier(xbar); } }
    }
#undef IN
#undef KARG
#undef PH_LOCALS
}

extern "C" void kernel_launch(void* const* d_in, const int* in_sizes, int n_in, void* d_out, int out_size, void* d_ws, size_t ws_size, hipStream_t stream) {
    static int grid = 0;
    if (grid == 0) {
        if (n_in != 16 || in_sizes[0] != T * DM || out_size != T * DM || ws_size < WS_END) { fprintf(stderr, "kernel_launch: unexpected shapes / workspace %zu < %zu\n", ws_size, (size_t)WS_END); grid = -1; return; }
        int dev = 0, cus = 0, per_cu = 0;
        if (hipGetDevice(&dev) != hipSuccess || hipDeviceGetAttribute(&cus, hipDeviceAttributeMultiprocessorCount, dev) != hipSuccess) { grid = -1; return; }
        if (hipFuncSetAttribute((const void*)hybrid_fwd, hipFuncAttributeMaxDynamicSharedMemorySize, LDS_BYTES) != hipSuccess) { fprintf(stderr, "kernel_launch: hipFuncSetAttribute failed\n"); grid = -1; return; }
        if (hipOccupancyMaxActiveBlocksPerMultiprocessor(&per_cu, (const void*)hybrid_fwd, 512, LDS_BYTES) != hipSuccess || per_cu < 1) { fprintf(stderr, "kernel_launch: occupancy query failed (%d)\n", per_cu); grid = -1; return; }
        grid = cus * per_cu;
        fprintf(stderr, "kernel_launch: grid %d (%d CUs x %d)\n", grid, cus, per_cu);
    }
    if (grid < 0) return;
    if (hipMemsetAsync((char*)d_ws + WS_BAR, 0, XCD_BAR_WORDS * 4, stream) != hipSuccess) { fprintf(stderr, "kernel_launch: memset failed\n"); return; }
    Params p{};
    for (int i = 0; i < 16; ++i) p.in[i] = (const float*)d_in[i];
    p.out = (float*)d_out; p.ws = (unsigned char*)d_ws;
    void* args[] = {&p};
    hipError_t e = hipLaunchCooperativeKernel((const void*)hybrid_fwd, dim3(grid), dim3(512), args, LDS_BYTES, stream);
    if (e != hipSuccess) fprintf(stderr, "kernel_launch: cooperative launch failed: %s (grid %d)\n", hipGetErrorString(e), grid);
}
```

```cpp
#include <hip/hip_runtime.h>
#include <hip/hip_cooperative_groups.h>
#include <cstdio>
#include <cstdint>
namespace cg = cooperative_groups;
namespace pg8 {
#define PG8_LAS __attribute__((address_space(3)))
typedef unsigned short bf16_t;
typedef short bf16x8 __attribute__((ext_vector_type(8)));
typedef float f32x4 __attribute__((ext_vector_type(4)));
typedef unsigned u32x4 __attribute__((ext_vector_type(4)));
constexpr int BM = 256, BK = 64, HALF = 128, HTB = HALF * BK * 2  , STAGE_BYTES = 8 * HTB, NXCD = 8, WGM = 8;

__host__ __device__ __forceinline__ int lds_byte(int r, int c) { const int st = (r >> 4) * 2 + (c >> 5), rr = r & 15, cc = c & 31, ob = rr * 64 + cc * 2; return st * 1024 + (ob ^ (((ob >> 9) & 1) << 5)); }
__host__ __device__ __forceinline__ void stage_rc(int b, int& R, int& C) { const int st = b / 1024, sb = b % 1024, swz = sb ^ (((sb >> 9) & 1) << 5); R = (st >> 1) * 16 + swz / 64; C = (st & 1) * 32 + (swz % 64) / 2; }
__host__ __device__ __forceinline__ int perm32(int rho) { const int n = rho >> 4, i = rho & 15; return 8 * (i >> 2) + 4 * n + (i & 3); }

struct Unit { int pm, pn; };
struct Gemm { const bf16_t* A; const bf16_t* Bt; int M, N, K; };

struct StaticOrder {
    int nM, nN, nwg, G, c;
    __host__ __device__ void init(int M, int N, int G_, int c_) { nM = M / BM; nN = N / BM; nwg = nM * nN; G = G_; c = c_; }
    __host__ __device__ bool next(int i, Unit& u) const {
        const long L = (long)i * G + c; if (L >= nwg) return false;
        int wgid = (int)L; { const int q = nwg / NXCD, r = nwg % NXCD, xcd = wgid % NXCD, off = wgid / NXCD; wgid = (xcd < r ? xcd * (q + 1) : r * (q + 1) + (xcd - r) * q) + off; }
        const int nig = WGM * nN, gid = wgid / nig, fm = gid * WGM, gsz = (nM - fm) < WGM ? (nM - fm) : WGM;
        u.pm = fm + ((wgid % nig) % gsz); u.pn = (wgid % nig) / gsz; return true;
    }
    __device__ __forceinline__ void a_ready(const Unit&) const {}
    __device__ __forceinline__ void done(const Unit&) const {}
};

__device__ __forceinline__ unsigned f2bf_u(float f) { unsigned u = __builtin_bit_cast(unsigned, f); return (u + 0x7fffu + ((u >> 16) & 1u)) >> 16; }
__device__ __forceinline__ unsigned pk2bf(float lo, float hi) { return f2bf_u(lo) | (f2bf_u(hi) << 16); }

__device__ __forceinline__ unsigned cvtpk_bf16(float lo, float hi) { typedef float f2_ __attribute__((ext_vector_type(2))); typedef __bf16 b2_ __attribute__((ext_vector_type(2)));
    f2_ v = {lo, hi}; b2_ b = __builtin_convertvector(v, b2_); return __builtin_bit_cast(unsigned, b); }
__device__ __forceinline__ float swz_xor16(float v) { return __uint_as_float((unsigned)__builtin_amdgcn_ds_swizzle((int)__float_as_uint(v), 0x1F | (16 << 10))); }
__device__ __forceinline__ float half_sum(float v) { auto rr = __builtin_amdgcn_permlane32_swap(__float_as_uint(v), __float_as_uint(v), false, false); return __uint_as_float(rr[0]) + __uint_as_float(rr[1]); }
__device__ __forceinline__ float row_rstd(const unsigned long long* ssq, int row) { return __builtin_amdgcn_rsqf((float)ssq[row] * (1.0f / (1048576.0f * 1024.0f)) + 1e-6f); }

struct EpiProj {
    static constexpr bool PERM = true, AFTER_DRAIN = false;
    bf16_t* O; int ldc; float* gates; int gate0; const unsigned long long* ssp;
    __device__ __forceinline__ void operator()(const f32x4 (&acc)[2][2][4][2], const Unit& u, int wr, int wc, int fr, int fq) const {
        const int row0 = u.pm * BM + wr * 64 + fr; const int col0 = u.pn * BM + wc * 32 + 8 * fq;
        float rsv[2][4];
#pragma unroll
        for (int ai = 0; ai < 2; ++ai)
#pragma unroll
            for (int m = 0; m < 4; ++m) rsv[ai][m] = row_rstd(ssp, row0 + ai * HALF + m * 16);
#pragma unroll
        for (int ai = 0; ai < 2; ++ai)
#pragma unroll
            for (int m = 0; m < 4; ++m) { const int row = row0 + ai * HALF + m * 16; bf16_t* rowp = O + (size_t)row * ldc + col0; const float rs = rsv[ai][m];
#pragma unroll
                for (int bj = 0; bj < 2; ++bj) { const f32x4 v0 = acc[ai][bj][m][0] * rs, v1 = acc[ai][bj][m][1] * rs;
                    u32x4 w; w.x = cvtpk_bf16(v0[0], v0[1]); w.y = cvtpk_bf16(v0[2], v0[3]); w.z = cvtpk_bf16(v1[0], v1[1]); w.w = cvtpk_bf16(v1[2], v1[3]);
                    *(u32x4*)(rowp + bj * HALF) = w;
                    const int c = col0 + bj * HALF - gate0;
                    if (c >= 0 && c < 32) { float* g = gates + (size_t)row * 32 + c; *(f32x4*)g = v0; *(f32x4*)(g + 4) = v1; } } }
    }
};
struct EpiRelu2 {
    static constexpr bool PERM = true, AFTER_DRAIN = false;
    bf16_t* O; int ldc; const unsigned long long* ssp;
    __device__ __forceinline__ void operator()(const f32x4 (&acc)[2][2][4][2], const Unit& u, int wr, int wc, int fr, int fq) const {
        const int row0 = u.pm * BM + wr * 64 + fr; const int col0 = u.pn * BM + wc * 32 + 8 * fq;
        float rsv[2][4];
#pragma unroll
        for (int ai = 0; ai < 2; ++ai)
#pragma unroll
            for (int m = 0; m < 4; ++m) rsv[ai][m] = row_rstd(ssp, row0 + ai * HALF + m * 16);
#pragma unroll
        for (int ai = 0; ai < 2; ++ai)
#pragma unroll
            for (int m = 0; m < 4; ++m) { const int row = row0 + ai * HALF + m * 16; bf16_t* rowp = O + (size_t)row * ldc + col0; const float rs = rsv[ai][m];
#pragma unroll
                for (int bj = 0; bj < 2; ++bj) { f32x4 v0 = acc[ai][bj][m][0] * rs, v1 = acc[ai][bj][m][1] * rs;
#pragma unroll
                    for (int e = 0; e < 4; ++e) { float a = v0[e] > 0.f ? v0[e] : 0.f; v0[e] = a * a; float b = v1[e] > 0.f ? v1[e] : 0.f; v1[e] = b * b; }
                    u32x4 w; w.x = cvtpk_bf16(v0[0], v0[1]); w.y = cvtpk_bf16(v0[2], v0[3]); w.z = cvtpk_bf16(v1[0], v1[1]); w.w = cvtpk_bf16(v1[2], v1[3]);
                    *(u32x4*)(rowp + bj * HALF) = w; } }
    }
};
struct EpiResid {
    static constexpr bool PERM = false, AFTER_DRAIN = false;
    const float* base; float* out; int ldc; bf16_t* xb; unsigned long long* ssp;
    __device__ __forceinline__ void operator()(const f32x4 (&acc)[2][2][4][2], const Unit& u, int wr, int wc, int fr, int fq) const {
        const int row0 = u.pm * BM + wr * 64 + fr; const int col0 = u.pn * BM + wc * 32 + 4 * fq;
#pragma unroll
        for (int ai = 0; ai < 2; ++ai)
#pragma unroll
            for (int m = 0; m < 4; ++m) { const int row = row0 + ai * HALF + m * 16; const size_t off = (size_t)row * ldc + col0; float ss = 0.f;
#pragma unroll
                for (int bj = 0; bj < 2; ++bj)
#pragma unroll
                    for (int n = 0; n < 2; ++n) { const size_t o = off + bj * HALF + n * 16; const f32x4 b = *(const f32x4*)(base + o); const f32x4 v = b + acc[ai][bj][m][n]; *(f32x4*)(out + o) = v;
                        if (xb) { ss += (v[0] * v[0] + v[1] * v[1]) + (v[2] * v[2] + v[3] * v[3]); typedef unsigned u32x2_ __attribute__((ext_vector_type(2)));
                            u32x2_ w; w.x = cvtpk_bf16(v[0], v[1]); w.y = cvtpk_bf16(v[2], v[3]); *(u32x2_*)(xb + o) = w; } }
                if (xb) { ss += swz_xor16(ss); ss = half_sum(ss); if (fq == 0) atomicAdd(ssp + row, (unsigned long long)(ss * 1048576.0f + 0.5f)); } }
    }
};

struct EpiAny {
    static constexpr bool AFTER_DRAIN = false;
    int kind; bool perm;
    bf16_t* O; int ldc; float* gates; int gate0; const float* base; float* out; bf16_t* xb; unsigned long long* ssp;
    __device__ __forceinline__ void operator()(const f32x4 (&acc)[2][2][4][2], const Unit& u, int wr, int wc, int fr, int fq) const {
        if (kind == 0) { EpiProj e{O, ldc, gates, gate0, ssp}; e(acc, u, wr, wc, fr, fq); }
        else if (kind == 1) { EpiRelu2 e{O, ldc, ssp}; e(acc, u, wr, wc, fr, fq); }
        else { EpiResid e{base, out, ldc, xb, ssp}; e(acc, u, wr, wc, fr, fq); }
    }
};
template <class Epi, class Sched, bool ALIGN_EPI = false, bool SP2 = false>
__device__ __forceinline__ void gemm_phase(PG8_LAS unsigned char* lds, const Gemm g, const Sched& S, const Epi& E, const int tid) {
    const int wid = __builtin_amdgcn_readfirstlane(tid >> 6), lane = tid & 63, wr = wid >> 2, wc = wid & 3, fr = lane & 15, fq = lane >> 4;
    const int K = g.K, nt = K / BK;
    unsigned voffA[2], voffB[2];
#pragma unroll
    for (int i = 0; i < 2; ++i) { int R, C; stage_rc(tid * 16 + i * 8192, R, C); const int Rb = E.perm ? ((R & ~31) + perm32(R & 31)) : R;
        voffA[i] = (unsigned)(R * K + C) * 2u; voffB[i] = (unsigned)(Rb * K + C) * 2u; }
    const size_t kstep = (size_t)(BK * 2);
    const size_t hstep = (size_t)HALF * K * 2;
    const size_t tstep = 2 * hstep;
    const unsigned ldsw = (unsigned)wid * 1024u;
    const int aoff = lds_byte(wr * 64 + fr, fq * 8), boff = lds_byte(wc * 32 + fr, fq * 8);
#define PG8_SA(b, h) (((b) * 2 + (h)) * HTB)
#define PG8_SB(b, h) ((4 + (b) * 2 + (h)) * HTB)
#define PG8_STAGE(bufoff, gbase, voff) do { _Pragma("unroll") for (int _i = 0; _i < 2; ++_i) \
        __builtin_amdgcn_global_load_lds((const unsigned*)((const char*)(gbase) + (voff)[_i]), (PG8_LAS unsigned*)(lds + (bufoff) + ldsw + _i * 8192), 16, 0, 0); } while (0)
#define PG8_LDA(dst, b, h) do { _Pragma("unroll") for (int m = 0; m < 4; ++m) _Pragma("unroll") for (int k = 0; k < 2; ++k) dst[m][k] = *(const PG8_LAS bf16x8*)(lds + PG8_SA(b, h) + aoff + m * 2048 + k * 1024); } while (0)
#define PG8_LDB(dst, b, h) do { _Pragma("unroll") for (int n = 0; n < 2; ++n) _Pragma("unroll") for (int k = 0; k < 2; ++k) dst[n][k] = *(const PG8_LAS bf16x8*)(lds + PG8_SB(b, h) + boff + n * 2048 + k * 1024); } while (0)
#define PG8_MMA(ai, bj, At, Bt) do { __builtin_amdgcn_s_setprio(1); _Pragma("unroll") for (int m = 0; m < 4; ++m) _Pragma("unroll") for (int n = 0; n < 2; ++n) _Pragma("unroll") for (int k = 0; k < 2; ++k) \
        acc[ai][bj][m][n] = __builtin_amdgcn_mfma_f32_16x16x32_bf16(Bt[n][k], At[m][k], acc[ai][bj][m][n], 0, 0, 0); __builtin_amdgcn_s_setprio(0); } while (0)
#define PG8_WAIT_V(n) asm volatile("s_waitcnt vmcnt(" #n ")" ::: "memory")
#define PG8_WAIT_L(n) asm volatile("s_waitcnt lgkmcnt(" #n ")" ::: "memory")
#define PG8_BAR __builtin_amdgcn_s_barrier()
#define PG8_SCHED __builtin_amdgcn_sched_barrier(0)
    Unit cur, nxt; int ui = 0;
    if (!S.next(0, cur)) return;
    f32x4 acc[2][2][4][2];
#pragma unroll
    for (int a = 0; a < 2; ++a)
#pragma unroll
        for (int b = 0; b < 2; ++b)
#pragma unroll
            for (int m = 0; m < 4; ++m)
#pragma unroll
                for (int n = 0; n < 2; ++n) acc[a][b][m][n] = (f32x4){0.f, 0.f, 0.f, 0.f};
    bf16x8 At[4][2], B0[2][2], B1[2][2];
    const char* cA = (const char*)g.A + (size_t)cur.pm * tstep; const char* cB = (const char*)g.Bt + (size_t)cur.pn * tstep;
    S.a_ready(cur);
    if constexpr (SP2) {
        PG8_STAGE(PG8_SB(0, 0), cB, voffB); PG8_STAGE(PG8_SB(0, 1), cB + hstep, voffB); PG8_STAGE(PG8_SA(0, 0), cA, voffA); PG8_STAGE(PG8_SA(0, 1), cA + hstep, voffA);
        if (wr == 1) PG8_BAR;
        PG8_WAIT_V(2); PG8_BAR;
        PG8_STAGE(PG8_SB(1, 0), cB + kstep, voffB); PG8_STAGE(PG8_SA(1, 0), cA + kstep, voffA); PG8_STAGE(PG8_SB(1, 1), cB + hstep + kstep, voffB);
        PG8_WAIT_V(6); PG8_BAR;
    } else {
        PG8_STAGE(PG8_SB(0, 0), cB, voffB); PG8_STAGE(PG8_SA(0, 0), cA, voffA); PG8_STAGE(PG8_SB(0, 1), cB + hstep, voffB); PG8_STAGE(PG8_SA(0, 1), cA + hstep, voffA);
        if (wr == 1) PG8_BAR;
        PG8_WAIT_V(4); PG8_BAR;
        PG8_STAGE(PG8_SB(1, 0), cB + kstep, voffB); PG8_STAGE(PG8_SA(1, 0), cA + kstep, voffA); PG8_STAGE(PG8_SB(1, 1), cB + hstep + kstep, voffB);
        PG8_WAIT_V(6); PG8_BAR;
    }
    for (;;) {
        const bool has_next = S.next(ui + 1, nxt);
        const char* nA = has_next ? (const char*)g.A + (size_t)nxt.pm * tstep : cA; const char* nB = has_next ? (const char*)g.Bt + (size_t)nxt.pn * tstep : cB;
        for (int t = 0; t < nt; t += 2) {
            const bool last = (t == nt - 2);
            const char* a1 = cA + (size_t)(t + 1) * kstep;
            const char* a2 = last ? nA : cA + (size_t)(t + 2) * kstep; const char* b2 = last ? nB : cB + (size_t)(t + 2) * kstep;
            const char* a3 = a2 + kstep; const char* b3 = b2 + kstep;
            if (last && has_next) S.a_ready(nxt);
            if constexpr (SP2) {
            PG8_LDB(B0, 0, 0); PG8_LDB(B1, 0, 1); PG8_SCHED; PG8_LDA(At, 0, 0); PG8_STAGE(PG8_SA(1, 1), a1 + hstep, voffA);
            PG8_WAIT_V(8); PG8_WAIT_L(0); PG8_BAR; PG8_MMA(0, 0, At, B0); PG8_MMA(0, 1, At, B1); PG8_BAR; PG8_SCHED;
            PG8_LDA(At, 0, 1); PG8_STAGE(PG8_SB(0, 0), b2, voffB); PG8_STAGE(PG8_SB(0, 1), b2 + hstep, voffB); PG8_STAGE(PG8_SA(0, 0), a2, voffA);
            PG8_WAIT_V(8); PG8_WAIT_L(0); PG8_BAR; PG8_MMA(1, 0, At, B0); PG8_MMA(1, 1, At, B1); PG8_BAR; PG8_SCHED;
            PG8_LDB(B0, 1, 0); PG8_LDB(B1, 1, 1); PG8_SCHED; PG8_LDA(At, 1, 0); PG8_STAGE(PG8_SA(0, 1), a2 + hstep, voffA);
            PG8_WAIT_V(8); PG8_WAIT_L(0); PG8_BAR; PG8_MMA(0, 0, At, B0); PG8_MMA(0, 1, At, B1); PG8_BAR; PG8_SCHED;
            PG8_LDA(At, 1, 1); PG8_STAGE(PG8_SB(1, 0), b3, voffB); PG8_STAGE(PG8_SB(1, 1), b3 + hstep, voffB); PG8_STAGE(PG8_SA(1, 0), a3, voffA);
            PG8_WAIT_V(8); PG8_WAIT_L(0); PG8_BAR; PG8_MMA(1, 0, At, B0); PG8_MMA(1, 1, At, B1); PG8_BAR; PG8_SCHED;
            } else {
            PG8_LDB(B0, 0, 0); PG8_SCHED; PG8_LDA(At, 0, 0); PG8_STAGE(PG8_SA(1, 1), a1 + hstep, voffA);
            PG8_WAIT_L(8); PG8_BAR; PG8_WAIT_L(0); PG8_MMA(0, 0, At, B0); PG8_BAR; PG8_SCHED;
            PG8_LDB(B1, 0, 1); PG8_STAGE(PG8_SB(0, 0), b2, voffB);
            PG8_BAR; PG8_WAIT_L(0); PG8_MMA(0, 1, At, B1); PG8_BAR;
            PG8_LDA(At, 0, 1); PG8_STAGE(PG8_SA(0, 0), a2, voffA);
            PG8_BAR; PG8_WAIT_L(0); PG8_MMA(1, 0, At, B0); PG8_BAR; PG8_SCHED;
            PG8_STAGE(PG8_SB(0, 1), b2 + hstep, voffB);
            PG8_WAIT_V(6); PG8_BAR; PG8_MMA(1, 1, At, B1); PG8_BAR;
            PG8_LDB(B0, 1, 0); PG8_SCHED; PG8_LDA(At, 1, 0); PG8_STAGE(PG8_SA(0, 1), a2 + hstep, voffA);
            PG8_WAIT_L(8); PG8_BAR; PG8_WAIT_L(0); PG8_MMA(0, 0, At, B0); PG8_BAR; PG8_SCHED;
            PG8_LDB(B1, 1, 1); PG8_STAGE(PG8_SB(1, 0), b3, voffB);
            PG8_BAR; PG8_WAIT_L(0); PG8_MMA(0, 1, At, B1); PG8_BAR;
            PG8_LDA(At, 1, 1); PG8_STAGE(PG8_SA(1, 0), a3, voffA);
            PG8_BAR; PG8_WAIT_L(0); PG8_MMA(1, 0, At, B0); PG8_BAR; PG8_SCHED;
            PG8_STAGE(PG8_SB(1, 1), b3 + hstep, voffB);
            PG8_WAIT_V(6); PG8_BAR; PG8_MMA(1, 1, At, B1); PG8_BAR;
            }
        }
        if constexpr (ALIGN_EPI) { if (wr == 0) PG8_BAR; }
        if constexpr (!Epi::AFTER_DRAIN) { E(acc, cur, wr, wc, fr, fq); S.done(cur); }
        if (!has_next) break;
#pragma unroll
        for (int a = 0; a < 2; ++a)
#pragma unroll
            for (int b = 0; b < 2; ++b)
#pragma unroll
                for (int m = 0; m < 4; ++m)
#pragma unroll
                    for (int n = 0; n < 2; ++n) acc[a][b][m][n] = (f32x4){0.f, 0.f, 0.f, 0.f};
        cur = nxt; cA = nA; cB = nB; ++ui;
        if constexpr (ALIGN_EPI) { if (wr == 1) PG8_BAR; }
    }
    PG8_WAIT_V(0);
    if constexpr (!ALIGN_EPI) { if (wr == 0) PG8_BAR; }
    PG8_BAR;
    if constexpr (Epi::AFTER_DRAIN) { E.fused(acc, cur, wr, wc, fr, fq, lds, wid, lane); S.done(cur); }
#undef PG8_SA
#undef PG8_SB
#undef PG8_STAGE
#undef PG8_LDA
#undef PG8_LDB
#undef PG8_MMA
#undef PG8_WAIT_V
#undef PG8_WAIT_L
#undef PG8_BAR
#undef PG8_SCHED
}
}

typedef unsigned short bf16;
constexpr int NB = 4, SEQ = 8192, T = NB * SEQ, DM = 1024, DFF = 4096, DEPTH = 2;
constexpr int DIN = 3476, DINP = 3584;
constexpr int C_MQ = 0, C_MK = 512, C_MV = 1024, C_MO = 1536, C_BQ = 2048, C_BK = 2304, C_BV = 2560, C_NQ = 2816,
              C_NKC = 3072, C_NVC = 3136, C_NKS = 3200, C_NVS = 3264, C_NKW = 3328, C_NVW = 3392, C_GATE = 3456;
constexpr int NCMP = 511;
constexpr float EPS = 1e-6f;

__device__ __forceinline__ float bf2f(bf16 v) { return __builtin_bit_cast(float, (unsigned)v << 16); }
__device__ __forceinline__ bf16 f2bf(float f) { return (bf16)pg8::f2bf_u(f); }
template <int MASK> __device__ __forceinline__ float shx(float v) {
    if constexpr (MASK == 32) { auto rr = __builtin_amdgcn_permlane32_swap(__float_as_uint(v), __float_as_uint(v), false, false);
        return __uint_as_float(__builtin_amdgcn_mbcnt_lo(~0u, 0u) == 32u ? rr[0] : rr[1]); }
    else return __uint_as_float((unsigned)__builtin_amdgcn_ds_swizzle((int)__float_as_uint(v), 0x1F | (MASK << 10)));
}
__device__ __forceinline__ float xchg32(float v, int hi) { auto rr = __builtin_amdgcn_permlane32_swap(__float_as_uint(v), __float_as_uint(v), false, false); return __uint_as_float(hi ? rr[0] : rr[1]); }
__device__ __forceinline__ float hsum32(float v) { auto rr = __builtin_amdgcn_permlane32_swap(__float_as_uint(v), __float_as_uint(v), false, false); return __uint_as_float(rr[0]) + __uint_as_float(rr[1]); }
__device__ __forceinline__ float hmax32(float v) { auto rr = __builtin_amdgcn_permlane32_swap(__float_as_uint(v), __float_as_uint(v), false, false); return fmaxf(__uint_as_float(rr[0]), __uint_as_float(rr[1])); }
template <int MASK> __device__ __forceinline__ unsigned shxu(unsigned v) { return __float_as_uint(shx<MASK>(__uint_as_float(v))); }
__device__ __forceinline__ float wave_sum(float v) {
    v += shx<1>(v); v += shx<2>(v); v += shx<4>(v); v += shx<8>(v); v += shx<16>(v);
    auto rr = __builtin_amdgcn_permlane32_swap(__float_as_uint(v), __float_as_uint(v), false, false); return __uint_as_float(rr[0]) + __uint_as_float(rr[1]);
}
__device__ __forceinline__ float wave_max(float v) {
    v = fmaxf(v, shx<1>(v)); v = fmaxf(v, shx<2>(v)); v = fmaxf(v, shx<4>(v)); v = fmaxf(v, shx<8>(v)); v = fmaxf(v, shx<16>(v));
    auto rr = __builtin_amdgcn_permlane32_swap(__float_as_uint(v), __float_as_uint(v), false, false); return fmaxf(__uint_as_float(rr[0]), __uint_as_float(rr[1]));
}
__device__ __forceinline__ float sgprf(float c) { asm volatile("" : "+s"(c)); return c; }
#define nbg (sgprf(-1e30f))
__device__ __forceinline__ int mk_tid(int wave_s) { int t; asm volatile("v_mbcnt_lo_u32_b32 %0, -1, 0\n\tv_mbcnt_hi_u32_b32 %0, -1, %0" : "=v"(t)); return t + wave_s * 64; }
__device__ __forceinline__ float zf_() { float z = 0.f; asm volatile("" : "+v"(z)); return z; }
__device__ __forceinline__ float rcpf_(float x) { return __builtin_amdgcn_rcpf(x); }
__device__ __forceinline__ float sigmoidf_(float x) { return rcpf_(1.f + __expf(-x)); }
__device__ __forceinline__ float log_sigmoidf_(float x) { return fminf(x, 0.f) - __logf(1.f + __expf(-fabsf(x))); }
__device__ __forceinline__ void rope_cs(int pos, int f, float& c, float& s) {
    const float invf = f == 0 ? 1.0f : f == 1 ? 0.193922758102417f : f == 2 ? 0.03760603442788124f : f == 3 ? 0.007292666472494602f : f == 4 ? 0.0014142136787995696f
                     : f == 5 ? 0.00027424818836152554f : f == 6 ? 5.318298644851893e-05f : 1.031338433676865e-05f;
    const float ang = (float)pos * invf;
    const float k = rintf(ang * 0.15915493667125702f);
    float r = fmaf(-k, 6.2831854820251465f, ang); r = fmaf(-k, -1.7484555314695172e-07f, r);
    c = __cosf(r); s = __sinf(r);
}


__device__ __forceinline__ float dot64(const bf16* __restrict__ kp, const float* q) {
    const uint4* k4 = (const uint4*)kp; float a = 0.f;
#pragma unroll
    for (int j = 0; j < 8; ++j) { const uint4 w = k4[j]; const unsigned ww[4] = {w.x, w.y, w.z, w.w};
#pragma unroll
        for (int e = 0; e < 4; ++e) { a = fmaf(q[8 * j + 2 * e], __builtin_bit_cast(float, ww[e] << 16), a); a = fmaf(q[8 * j + 2 * e + 1], __builtin_bit_cast(float, ww[e] & 0xffff0000u), a); } }
    return a;
}
__device__ __forceinline__ void dot64x4(const bf16* __restrict__ kp, const float (*q)[64], float (&a)[4]) {
    const uint4* k4 = (const uint4*)kp; a[0] = a[1] = a[2] = a[3] = 0.f;
#pragma unroll
    for (int j = 0; j < 8; ++j) { const uint4 w = k4[j]; const unsigned ww[4] = {w.x, w.y, w.z, w.w};
#pragma unroll
        for (int e = 0; e < 4; ++e) { const float k0 = __builtin_bit_cast(float, ww[e] << 16), k1 = __builtin_bit_cast(float, ww[e] & 0xffff0000u);
#pragma unroll
            for (int h = 0; h < 4; ++h) { a[h] = fmaf(q[h][8 * j + 2 * e], k0, a[h]); a[h] = fmaf(q[h][8 * j + 2 * e + 1], k1, a[h]); } } }
}

__host__ __device__ __forceinline__ int win_src(int n) {
    if (n < 2048) return n;
    if (n < 3456) return n + 8;
    if (n < 3464) return n - 3456 + 2048;
    if (n < 3476) return n;
    return -1;
}


typedef unsigned u32x4p __attribute__((ext_vector_type(4)));
__device__ __forceinline__ void ph_convert_w(const float* __restrict__ W, int K, int N, int NP, bf16* __restrict__ WT, int mode, int item, bool act, int t, float* tile  , const float* __restrict__ gk = nullptr) {
    const int nbx = NP / 64; const int n0 = (item % nbx) * 64, k0 = (item / nbx) * 64, c = t & 63, r = t >> 6;
    if (act) { const int src = mode ? win_src(n0 + c) : (n0 + c);
#pragma unroll
        for (int i = 0; i < 16; ++i) { const int k = r + 4 * i; tile[k * 65 + c] = (src >= 0) ? W[(size_t)(k0 + k) * N + src] * (gk ? gk[k0 + k] : 1.f) : 0.f; } }
    __syncthreads();
    if (act) { const int n = t >> 2, kc = (t & 3) * 16;
        u32x4p w0, w1;
#pragma unroll
        for (int e = 0; e < 4; ++e) { w0[e] = pg8::cvtpk_bf16(tile[(kc + 2 * e) * 65 + n], tile[(kc + 2 * e + 1) * 65 + n]); w1[e] = pg8::cvtpk_bf16(tile[(kc + 8 + 2 * e) * 65 + n], tile[(kc + 8 + 2 * e + 1) * 65 + n]); }
        u32x4p* dst = (u32x4p*)(WT + (size_t)(n0 + n) * K + k0 + kc); dst[0] = w0; dst[1] = w1; }
    __syncthreads();
}
__device__ __forceinline__ void ph_rmsnorm_row(const float* __restrict__ x, const float* __restrict__ g, bf16* __restrict__ H, int row, int lane) {
    const float4* xr = (const float4*)(x + (size_t)row * DM) + lane;
    float4 v[4]; float s = 0.f;
#pragma unroll
    for (int j = 0; j < 4; ++j) { v[j] = xr[64 * j]; s += v[j].x * v[j].x + v[j].y * v[j].y + v[j].z * v[j].z + v[j].w * v[j].w; }
    const float rstd = rsqrtf(wave_sum(s) * (1.f / DM) + EPS);
    uint2* o = (uint2*)(H + (size_t)row * DM) + lane;
#pragma unroll
    for (int j = 0; j < 4; ++j) { const float4 gg = ((const float4*)g)[lane + 64 * j];
        uint2 w; w.x = pg8::pk2bf(v[j].x * rstd * gg.x, v[j].y * rstd * gg.y); w.y = pg8::pk2bf(v[j].z * rstd * gg.z, v[j].w * rstd * gg.w); o[64 * j] = w; }
}
__device__ __forceinline__ void ph_x_row(const float* __restrict__ x, bf16* __restrict__ XB, unsigned long long* __restrict__ ssq, int row, int lane) {
    const float4* xr = (const float4*)(x + (size_t)row * DM) + lane;
    float4 v[4]; float s = 0.f;
#pragma unroll
    for (int j = 0; j < 4; ++j) { v[j] = xr[64 * j]; s += v[j].x * v[j].x + v[j].y * v[j].y + v[j].z * v[j].z + v[j].w * v[j].w; }
    s = wave_sum(s);
    uint2* o = (uint2*)(XB + (size_t)row * DM) + lane;
#pragma unroll
    for (int j = 0; j < 4; ++j) { uint2 w; w.x = pg8::cvtpk_bf16(v[j].x, v[j].y); w.y = pg8::cvtpk_bf16(v[j].z, v[j].w); o[64 * j] = w; }
    if (lane == 0) ssq[row] = (unsigned long long)(s * 1048576.0f + 0.5f);
}
__device__ __forceinline__ void ph_prep(bf16* __restrict__ P, const float* __restrict__ tab, const float* __restrict__ moba_g, const float* __restrict__ nsa_qg, const float* __restrict__ nsa_kg,
                                        float* __restrict__ kmean, int item, bool act, int t, float* red  ) {
    const int lane = t & 63, wid = t >> 6, tb = item % 128, kind = item / 128, rg = lane >> 3, dch = lane & 7;
    if (act) {
        int col; const float* g; bool rope;
        if (kind < 4) { col = C_BQ + kind * 64; g = moba_g; rope = true; }
        else if (kind < 8) { col = C_BK + (kind - 4) * 64; g = moba_g + 64; rope = true; }
        else if (kind < 12) { col = C_NQ + (kind - 8) * 64; g = nsa_qg; rope = false; }
        else if (kind == 12) { col = C_NKS; g = nsa_kg + 64; rope = true; }
        else { col = C_NKW; g = nsa_kg + 128; rope = true; }
        float gd[8];
#pragma unroll
        for (int e = 0; e < 8; ++e) gd[e] = g[dch * 8 + e];
        const int row0 = tb * 256 + wid * 64 + rg;
        u32x4p raw[8];
#pragma unroll
        for (int it = 0; it < 8; ++it) raw[it] = *(const u32x4p*)(P + (size_t)(row0 + it * 8) * DINP + col + dch * 8);
        float ks[8];
#pragma unroll
        for (int e = 0; e < 8; ++e) ks[e] = 0.f;
#pragma unroll
        for (int it = 0; it < 8; ++it) {
            const int row = row0 + it * 8, pos = row & (SEQ - 1);
            float y[8]; float ss = 0.f;
#pragma unroll
            for (int e = 0; e < 4; ++e) { y[2 * e] = __builtin_bit_cast(float, raw[it][e] << 16); y[2 * e + 1] = __builtin_bit_cast(float, raw[it][e] & 0xffff0000u); ss += y[2 * e] * y[2 * e] + y[2 * e + 1] * y[2 * e + 1]; }
            ss += shx<1>(ss); ss += shx<2>(ss); ss += shx<4>(ss);
            const float rstd = rsqrtf(ss * (1.f / 64.f) + EPS);
#pragma unroll
            for (int e = 0; e < 8; ++e) y[e] *= rstd * gd[e];
            if (rope) {
                float o[8];
#pragma unroll
                for (int e = 0; e < 8; ++e) o[e] = shx<1>(y[e]);
                if (dch < 2) { const float4 c0 = *(const float4*)(tab + pos * 16), c1 = *(const float4*)(tab + pos * 16 + 4), s0 = *(const float4*)(tab + pos * 16 + 8), s1 = *(const float4*)(tab + pos * 16 + 12);
                    const float cs[8] = {c0.x, c0.y, c0.z, c0.w, c1.x, c1.y, c1.z, c1.w}, sn[8] = {s0.x, s0.y, s0.z, s0.w, s1.x, s1.y, s1.z, s1.w};
#pragma unroll
                    for (int e = 0; e < 8; ++e) y[e] = dch ? (y[e] * cs[e] + o[e] * sn[e]) : (y[e] * cs[e] - o[e] * sn[e]); }
            }
            u32x4p w; w[0] = pg8::pk2bf(y[0], y[1]); w[1] = pg8::pk2bf(y[2], y[3]); w[2] = pg8::pk2bf(y[4], y[5]); w[3] = pg8::pk2bf(y[6], y[7]);
            *(u32x4p*)(P + (size_t)row * DINP + col + dch * 8) = w;
#pragma unroll
            for (int e = 0; e < 8; ++e) ks[e] += y[e];
        }
        if (kind >= 4 && kind < 8) {
#pragma unroll
            for (int e = 0; e < 8; ++e) { ks[e] += shx<8>(ks[e]); ks[e] += shx<16>(ks[e]); ks[e] += shx<32>(ks[e]); }
            if (rg == 0) {
#pragma unroll
                for (int e = 0; e < 8; ++e) red[wid * 64 + dch * 8 + e] = ks[e]; }
        }
    }
    __syncthreads();
    if (act && kind >= 4 && kind < 8 && wid == 0) { const float s = red[lane] + red[64 + lane] + red[128 + lane] + red[192 + lane];
        const int b = tb >> 5, n = tb & 31; kmean[(((size_t)b * 4 + (kind - 4)) * 32 + n) * 64 + lane] = s * (1.f / 256.f); }
    __syncthreads();
}
__device__ __forceinline__ void ph_compress(const bf16* __restrict__ P, const float* __restrict__ pe, const float* __restrict__ w1, const float* __restrict__ w2, const float* __restrict__ kg0,
                                            float* __restrict__ KVc, bf16* __restrict__ KVcb, int item, bool act, int t, float* sm  ) {
    float* in = sm; float* hid = sm + 2048;
    const int i = item % NCMP, b = (item / NCMP) & 3, kv = item / (NCMP * 4);
    const int col = kv ? C_NVC : C_NKC;
    if (act) for (int e = t; e < 2048; e += 256) { const int p = e >> 6, d = e & 63; in[e] = bf2f(P[(size_t)(b * SEQ + 16 * i + p) * DINP + col + d]) + pe[(kv * 32 + p) * 64 + d]; }
    __syncthreads();
    if (act && t < 128) { const float* w = w1 + (size_t)kv * 2048 * 128 + t; float a = 0.f;
#pragma unroll 8
        for (int k = 0; k < 2048; ++k) a = fmaf(in[k], w[(size_t)k * 128], a);
        hid[t] = a * rcpf_(1.f + __expf(-a)); }
    __syncthreads();
    if (act && t < 64) { const float* ww = w2 + (size_t)kv * 128 * 64 + t; float o = 0.f;
#pragma unroll 8
        for (int j = 0; j < 128; ++j) o = fmaf(hid[j], ww[j * 64], o);
        if (kv == 0) { const float ss = wave_sum(o * o); o = o * rsqrtf(ss * (1.f / 64.f) + EPS) * kg0[t]; }
        KVc[(((size_t)kv * NB + b) * 512 + i) * 64 + t] = o; KVcb[(((size_t)kv * NB + b) * 512 + i) * 64 + t] = f2bf(o);
        if (i == NCMP - 1) KVcb[(((size_t)kv * NB + b) * 512 + NCMP) * 64 + t] = 0; }
    __syncthreads();
}
__device__ __forceinline__ float conv_silu(const bf16* __restrict__ P, const float* __restrict__ cw  , int rowbase, int t, int c) {
    float a = 0.f;
#pragma unroll
    for (int j = 0; j < 4; ++j) { const int tt = t - 3 + j; if (tt >= 0) a = fmaf(cw[j * 1024 + c], bf2f(P[(size_t)(rowbase + tt) * DINP + c]), a); }
    return a * rcpf_(1.f + __expf(-a));
}
__device__ __forceinline__ void ph_mlstm_local(const bf16* __restrict__ P, const float* __restrict__ G, const float* __restrict__ cw, const float* __restrict__ bif,
                                               float* __restrict__ Cst, float* __restrict__ nst, float* __restrict__ dec, int u, bool act, int tid, unsigned char* sm) {
    bf16 (*ks)[128] = (bf16 (*)[128])sm; bf16 (*vs)[128] = (bf16 (*)[128])(sm + 16384); float* wS = (float*)(sm + 32768); float* lf = wS + 64;
    const int c = u & 127, h = (u >> 7) & 3, b = u >> 9;
    const int rowbase = b * SEQ, t0 = c * 64;
    if (act) {
        for (int e = tid; e < 64 * 128; e += 256) { const int s = e >> 7, d = e & 127;
            ks[s][d] = f2bf(conv_silu(P, cw, rowbase, t0 + s, 512 + h * 128 + d) * 0.08838834764831845f);
            vs[s][d] = P[(size_t)(rowbase + t0 + s) * DINP + C_MV + h * 128 + d]; }
        if (tid < 64) lf[tid] = log_sigmoidf_(G[(size_t)(rowbase + t0 + tid) * 32 + 4 + h] + bif[4 + h]);
    }
    __syncthreads();
    if (act && tid == 0) { float acc = 0.f;
        for (int s = 0; s < 64; ++s) { acc += lf[s]; lf[s] = acc; }
        dec[u] = __expf(acc); }
    __syncthreads();
    if (act && tid < 64) wS[tid] = __expf(lf[63] - lf[tid] + G[(size_t)(rowbase + t0 + tid) * 32 + h] + bif[h]);
    __syncthreads();
    if (act) {
        const int d = tid >> 1, e0 = (tid & 1) * 64;
        float acc[64];
#pragma unroll
        for (int e = 0; e < 64; ++e) acc[e] = 0.f;
        float an = 0.f;
        for (int s = 0; s < 64; ++s) { const float kw = wS[s] * bf2f(ks[s][d]); an += kw;
#pragma unroll
            for (int e = 0; e < 64; ++e) acc[e] = fmaf(kw, bf2f(vs[s][e0 + e]), acc[e]); }
        float* o = Cst + ((size_t)u * 128 + d) * 128 + e0;
#pragma unroll
        for (int e = 0; e < 64; ++e) o[e] = acc[e];
        if ((tid & 1) == 0) nst[(size_t)u * 128 + d] = an;
    }
    __syncthreads();
}
__device__ __forceinline__ void ph_mlstm_scan(float* __restrict__ Cst, float* __restrict__ nst, const float* __restrict__ dec, int item, int tid) {
    const int bh = item / 65, part = item % 65;
    float* base; int stride;
    if (part < 64) { base = Cst + (size_t)bh * 128 * 16384 + part * 256 + tid; stride = 16384; }
    else { if (tid >= 128) return; base = nst + (size_t)bh * 128 * 128 + tid; stride = 128; }
    float C = 0.f;
    for (int c = 0; c < 128; ++c) { const float dC = base[(size_t)c * stride]; base[(size_t)c * stride] = C; C = dec[bh * 128 + c] * C + dC; }
}
__device__ __forceinline__ void ph_mlstm_out(const bf16* __restrict__ P, const float* __restrict__ G, const float* __restrict__ cw, const float* __restrict__ bif,
                                             const float* __restrict__ Cst, const float* __restrict__ nst, const float* __restrict__ mnorm, bf16* __restrict__ MIX, int u, bool act, int tid, unsigned char* sm) {
    bf16 (*qs)[128] = (bf16 (*)[128])sm; float* ksS = (float*)(sm + 16384); bf16 (*ks)[128] = (bf16 (*)[128])ksS; bf16 (*vs)[128] = (bf16 (*)[128])(sm + 32768);
    float* bb = (float*)(sm + 49152); float* li = bb + 64;
    const int c = u & 127, h = (u >> 7) & 3, b = u >> 9;
    const int rowbase = b * SEQ, t0 = c * 64;
    if (act) {
        for (int e = tid; e < 64 * 128; e += 256) { const int s = e >> 7, d = e & 127;
            qs[s][d] = f2bf(conv_silu(P, cw, rowbase, t0 + s, h * 128 + d));
            ks[s][d] = f2bf(conv_silu(P, cw, rowbase, t0 + s, 512 + h * 128 + d) * 0.08838834764831845f);
            vs[s][d] = P[(size_t)(rowbase + t0 + s) * DINP + C_MV + h * 128 + d]; }
        if (tid < 64) { bb[tid] = log_sigmoidf_(G[(size_t)(rowbase + t0 + tid) * 32 + 4 + h] + bif[4 + h]); li[tid] = G[(size_t)(rowbase + t0 + tid) * 32 + h] + bif[h]; }
    }
    __syncthreads();
    if (act && tid == 0) { float acc = 0.f; for (int s = 0; s < 64; ++s) { acc += bb[s]; bb[s] = acc; } }
    __syncthreads();
    const int t = tid >> 2, part = tid & 3;
    float sreg[16];
    if (act) {
        const int s0 = part * 16;
#pragma unroll
        for (int j = 0; j < 16; ++j) { const int s = s0 + j; float a = 0.f;
            if (s <= t) { for (int d = 0; d < 128; ++d) a = fmaf(bf2f(qs[t][d]), bf2f(ks[s][d]), a); a *= __expf(bb[t] - bb[s] + li[s]); }
            sreg[j] = a; }
    }
    __syncthreads();
    float* S = ksS;
    if (act) {
#pragma unroll
        for (int j = 0; j < 16; ++j) S[t * 64 + part * 16 + j] = sreg[j];
    }
    __syncthreads();
    if (act) {
        const float Ft = __expf(bb[t]);
        float den = 0.f;
        for (int s = 0; s <= t; ++s) den += S[t * 64 + s];
        { const float* np = nst + (size_t)u * 128; float a = 0.f; for (int d = 0; d < 128; ++d) a = fmaf(bf2f(qs[t][d]), np[d], a); den += Ft * a; }
        const int e0 = part * 32;
        float acc[32];
#pragma unroll
        for (int e = 0; e < 32; ++e) acc[e] = 0.f;
        { const float* Cp = Cst + (size_t)u * 16384 + e0;
          for (int d = 0; d < 128; ++d) { const float qd = bf2f(qs[t][d]);
#pragma unroll
              for (int e = 0; e < 32; ++e) acc[e] = fmaf(qd, Cp[d * 128 + e], acc[e]); } }
#pragma unroll
        for (int e = 0; e < 32; ++e) acc[e] *= Ft;
        for (int s = 0; s <= t; ++s) { const float w = S[t * 64 + s];
#pragma unroll
            for (int e = 0; e < 32; ++e) acc[e] = fmaf(w, bf2f(vs[s][e0 + e]), acc[e]); }
        const float inv = rcpf_(fmaxf(fabsf(den), 1.f));
        float ss = 0.f;
#pragma unroll
        for (int e = 0; e < 32; ++e) { acc[e] *= inv; ss += acc[e] * acc[e]; }
        ss += shx<1>(ss); ss += shx<2>(ss);
        const float rstd = rsqrtf(ss * (1.f / 128.f) + EPS);
        const size_t row = (size_t)(rowbase + t0 + t);
#pragma unroll
        for (int e = 0; e < 32; ++e) { const int cc = h * 128 + e0 + e;
            const float o = sigmoidf_(bf2f(P[row * DINP + C_MO + cc]));
            MIX[row * DM + cc] = f2bf(acc[e] * rstd * mnorm[cc] * o); }
    }
    __syncthreads();
}

__device__ __forceinline__ void ph_moba(const bf16* __restrict__ P, const float* __restrict__ kmean, bf16* __restrict__ MIX, int gw, int lane, float* q) {
    const int bh = gw >> 13, tq = gw & (SEQ - 1), b = bh >> 2, h = bh & 3, own = tq >> 8;
    const size_t row = (size_t)b * SEQ + tq;
    __builtin_amdgcn_s_waitcnt(0); __builtin_amdgcn_wave_barrier();
    q[lane] = bf2f(P[row * DINP + C_BQ + h * 64 + lane]);
    __builtin_amdgcn_s_waitcnt(0); __builtin_amdgcn_wave_barrier();
    float gs = -3.0e38f;
    if (lane < 32) { if (lane < own) { const float* km = kmean + (((size_t)b * 4 + h) * 32 + lane) * 64; float a = 0.f; for (int d = 0; d < 64; ++d) a = fmaf(q[d], km[d], a); gs = a; } else gs = -1e30f; }
    int blk[4]; bool val[4];
#pragma unroll
    for (int r = 0; r < 3; ++r) { const float m = wave_max(gs); const unsigned long long bal = __ballot(gs == m); const int idx = __ffsll((long long)bal) - 1;
        blk[r] = idx; val[r] = (r < own); if (lane == idx) gs = -3.0e38f; }
    blk[3] = own; val[3] = true;
    float s[4][4]; float mx = -1e30f;
#pragma unroll
    for (int g = 0; g < 4; ++g)
#pragma unroll
        for (int i = 0; i < 4; ++i) { float a = -1e30f;
            if (val[g]) { const int pos = blk[g] * 256 + i * 64 + lane;
                if (g < 3 || pos <= tq) { const bf16* kp = P + ((size_t)b * SEQ + pos) * DINP + C_BK + h * 64; a = dot64(kp, q) * 0.125f; } }
            s[g][i] = a; mx = fmaxf(mx, a); }
    mx = wave_max(mx);
    float l = 0.f;
#pragma unroll
    for (int g = 0; g < 4; ++g)
#pragma unroll
        for (int i = 0; i < 4; ++i) { const float p = (s[g][i] > -1e29f) ? __expf(s[g][i] - mx) : 0.f; s[g][i] = p; l += p; }
    l = wave_sum(l);
    float o = 0.f;
#pragma unroll
    for (int g = 0; g < 4; ++g) { if (!val[g]) continue;
#pragma unroll
        for (int i = 0; i < 4; ++i) { const bf16* vp = P + ((size_t)b * SEQ + blk[g] * 256 + i * 64) * DINP + C_BV + h * 64 + lane;
            for (int src = 0; src < 64; ++src) { const float p = __shfl(s[g][i], src); o = fmaf(p, bf2f(vp[(size_t)src * DINP]), o); } } }
    MIX[row * DM + 512 + h * 64 + lane] = f2bf(o * rcpf_(l));
}

__device__ __forceinline__ void ph_nsa(const bf16* __restrict__ P, const float* __restrict__ G, const float* __restrict__ tab, const float* __restrict__ KVc, bf16* __restrict__ MIX, int gw, int lane, float* sm) {
    float (*qn)[64] = (float (*)[64])sm; float (*qr)[64] = (float (*)[64])(sm + 256); float* ps = sm + 512;
    const int b = gw >> 13, tq = gw & (SEQ - 1), blkq = tq >> 6;
    const size_t row = (size_t)b * SEQ + tq;
    __builtin_amdgcn_s_waitcnt(0); __builtin_amdgcn_wave_barrier();
#pragma unroll
    for (int h = 0; h < 4; ++h) { const float x = bf2f(P[row * DINP + C_NQ + h * 64 + lane]); qn[h][lane] = x;
        float y = x; const float other = shx<8>(x);
        if (lane < 16) { const int f = lane & 7; const float c = tab[tq * 16 + f], s = tab[tq * 16 + 8 + f]; y = (lane < 8) ? (x * c - other * s) : (x * c + other * s); }
        qr[h][lane] = y; }
    __builtin_amdgcn_s_waitcnt(0); __builtin_amdgcn_wave_barrier();
    const float* Kc = KVc + (size_t)b * 512 * 64; const float* Vc = KVc + ((size_t)NB + b) * 512 * 64;
    float out[4] = {0.f, 0.f, 0.f, 0.f};
    float gate[3][4];
#pragma unroll
    for (int br = 0; br < 3; ++br)
#pragma unroll
        for (int h = 0; h < 4; ++h) gate[br][h] = sigmoidf_(G[row * 32 + 8 + br * 4 + h]);
    const int ncv = (tq >= 31) ? ((tq - 31) >> 4) + 1 : 0;
    {
        float sc[8][4]; float mx[4] = {-1e30f, -1e30f, -1e30f, -1e30f};
#pragma unroll
        for (int i = 0; i < 8; ++i) { const int c = i * 64 + lane;
            float a[4] = {-1e30f, -1e30f, -1e30f, -1e30f};
            if (c < ncv) { const float* kp = Kc + (size_t)c * 64; a[0] = a[1] = a[2] = a[3] = 0.f;
                for (int d = 0; d < 64; ++d) { const float kd = kp[d]; a[0] = fmaf(qn[0][d], kd, a[0]); a[1] = fmaf(qn[1][d], kd, a[1]); a[2] = fmaf(qn[2][d], kd, a[2]); a[3] = fmaf(qn[3][d], kd, a[3]); }
#pragma unroll
                for (int h = 0; h < 4; ++h) a[h] *= 0.125f; }
#pragma unroll
            for (int h = 0; h < 4; ++h) { sc[i][h] = a[h]; mx[h] = fmaxf(mx[h], a[h]); } }
        float l[4];
#pragma unroll
        for (int h = 0; h < 4; ++h) { mx[h] = wave_max(mx[h]); l[h] = 0.f; }
#pragma unroll
        for (int i = 0; i < 8; ++i) { const int c = i * 64 + lane;
#pragma unroll
            for (int h = 0; h < 4; ++h) { const float p = (c < ncv) ? __expf(sc[i][h] - mx[h]) : 0.f; sc[i][h] = p; l[h] += p; } }
#pragma unroll
        for (int h = 0; h < 4; ++h) { l[h] = wave_sum(l[h]); l[h] = (l[h] > 0.f) ? rcpf_(l[h]) : 0.f; }
#pragma unroll
        for (int i = 0; i < 8; ++i) { float su = 0.f;
#pragma unroll
            for (int h = 0; h < 4; ++h) { sc[i][h] *= l[h]; su += sc[i][h]; }
            ps[i * 64 + lane] = su; }
        if (lane < 4) ps[512 + lane] = 0.f;
        float oc[4] = {0.f, 0.f, 0.f, 0.f};
#pragma unroll
        for (int i = 0; i < 8; ++i) { if (i * 64 >= ncv) break; const int nn = min(64, ncv - i * 64);
            for (int src = 0; src < nn; ++src) { const float v = Vc[(size_t)(i * 64 + src) * 64 + lane];
                oc[0] = fmaf(__shfl(sc[i][0], src), v, oc[0]); oc[1] = fmaf(__shfl(sc[i][1], src), v, oc[1]);
                oc[2] = fmaf(__shfl(sc[i][2], src), v, oc[2]); oc[3] = fmaf(__shfl(sc[i][3], src), v, oc[3]); } }
#pragma unroll
        for (int h = 0; h < 4; ++h) out[h] = gate[0][h] * oc[h];
    }
    __builtin_amdgcn_s_waitcnt(0); __builtin_amdgcn_wave_barrier();
    int sidx[16];
    {
        float v0, v1;
        { const int n = lane; float im = 0.f;
#pragma unroll
          for (int j = -1; j < 4; ++j) { const int c = 4 * n + j; if (c >= 0 && c < NCMP) im += ps[c]; }
          const bool causal = n <= blkq, forced = causal && (n == 0 || n >= blkq - 1);
          v0 = forced ? 1e9f : (causal ? im : -1e30f); }
        { const int n = lane + 64; float im = 0.f;
#pragma unroll
          for (int j = -1; j < 4; ++j) { const int c = 4 * n + j; if (c >= 0 && c < NCMP) im += ps[c]; }
          const bool causal = n <= blkq, forced = causal && (n == 0 || n >= blkq - 1);
          v1 = forced ? 1e9f : (causal ? im : -1e30f); }
#pragma unroll
        for (int k = 0; k < 16; ++k) { const float m = wave_max(fmaxf(v0, v1));
            const unsigned long long b0 = __ballot(v0 == m); int idx;
            if (b0) { idx = __ffsll((long long)b0) - 1; if (lane == idx) v0 = -3.0e38f; }
            else { const unsigned long long b1 = __ballot(v1 == m); idx = __ffsll((long long)b1) - 1; if (lane == idx) v1 = -3.0e38f; idx += 64; }
            sidx[k] = idx; }
    }
    {
        float sc[16][4]; float mx[4] = {-1e30f, -1e30f, -1e30f, -1e30f};
#pragma unroll
        for (int k = 0; k < 16; ++k) { const int n = sidx[k], pos = n * 64 + lane;
            float a[4] = {-1e30f, -1e30f, -1e30f, -1e30f};
            if (n <= blkq && pos <= tq) { const bf16* kp = P + ((size_t)b * SEQ + pos) * DINP + C_NKS; dot64x4(kp, qr, a);
#pragma unroll
                for (int h = 0; h < 4; ++h) a[h] *= 0.125f; }
#pragma unroll
            for (int h = 0; h < 4; ++h) { sc[k][h] = a[h]; mx[h] = fmaxf(mx[h], a[h]); } }
        float l[4];
#pragma unroll
        for (int h = 0; h < 4; ++h) { mx[h] = wave_max(mx[h]); l[h] = 0.f; }
#pragma unroll
        for (int k = 0; k < 16; ++k)
#pragma unroll
            for (int h = 0; h < 4; ++h) { const float p = (sc[k][h] > -1e29f) ? __expf(sc[k][h] - mx[h]) : 0.f; sc[k][h] = p; l[h] += p; }
#pragma unroll
        for (int h = 0; h < 4; ++h) l[h] = rcpf_(wave_sum(l[h]));
        float os[4] = {0.f, 0.f, 0.f, 0.f};
#pragma unroll
        for (int k = 0; k < 16; ++k) { const int n = sidx[k]; if (n > blkq) continue;
            const bf16* vp = P + ((size_t)b * SEQ + n * 64) * DINP + C_NVS + lane;
            for (int src = 0; src < 64; ++src) { const float v = bf2f(vp[(size_t)src * DINP]);
                os[0] = fmaf(__shfl(sc[k][0], src), v, os[0]); os[1] = fmaf(__shfl(sc[k][1], src), v, os[1]);
                os[2] = fmaf(__shfl(sc[k][2], src), v, os[2]); os[3] = fmaf(__shfl(sc[k][3], src), v, os[3]); } }
#pragma unroll
        for (int h = 0; h < 4; ++h) out[h] += gate[1][h] * os[h] * l[h];
    }
    {
        float sc[8][4]; float mx[4] = {-1e30f, -1e30f, -1e30f, -1e30f};
#pragma unroll
        for (int i = 0; i < 8; ++i) { const int pos = tq - 511 + i * 64 + lane;
            float a[4] = {-1e30f, -1e30f, -1e30f, -1e30f};
            if (pos >= 0) { const bf16* kp = P + ((size_t)b * SEQ + pos) * DINP + C_NKW; dot64x4(kp, qr, a);
#pragma unroll
                for (int h = 0; h < 4; ++h) a[h] *= 0.125f; }
#pragma unroll
            for (int h = 0; h < 4; ++h) { sc[i][h] = a[h]; mx[h] = fmaxf(mx[h], a[h]); } }
        float l[4];
#pragma unroll
        for (int h = 0; h < 4; ++h) { mx[h] = wave_max(mx[h]); l[h] = 0.f; }
#pragma unroll
        for (int i = 0; i < 8; ++i)
#pragma unroll
            for (int h = 0; h < 4; ++h) { const float p = (sc[i][h] > -1e29f) ? __expf(sc[i][h] - mx[h]) : 0.f; sc[i][h] = p; l[h] += p; }
#pragma unroll
        for (int h = 0; h < 4; ++h) l[h] = rcpf_(wave_sum(l[h]));
        float ow[4] = {0.f, 0.f, 0.f, 0.f};
#pragma unroll
        for (int i = 0; i < 8; ++i) { const int p0 = tq - 511 + i * 64; if (p0 + 63 < 0) continue;
            const int s0 = p0 < 0 ? -p0 : 0;
            for (int src = s0; src < 64; ++src) { const float v = bf2f(P[((size_t)b * SEQ + p0 + src) * DINP + C_NVW + lane]);
                ow[0] = fmaf(__shfl(sc[i][0], src), v, ow[0]); ow[1] = fmaf(__shfl(sc[i][1], src), v, ow[1]);
                ow[2] = fmaf(__shfl(sc[i][2], src), v, ow[2]); ow[3] = fmaf(__shfl(sc[i][3], src), v, ow[3]); } }
#pragma unroll
        for (int h = 0; h < 4; ++h) out[h] += gate[2][h] * ow[h] * l[h];
    }
#pragma unroll
    for (int h = 0; h < 4; ++h) MIX[row * DM + 768 + h * 64 + lane] = f2bf(out[h]);
}


#define LAS __attribute__((address_space(3)))
typedef short bf16x8 __attribute__((ext_vector_type(8)));
typedef float f32x16 __attribute__((ext_vector_type(16)));
typedef short s16x4 __attribute__((ext_vector_type(4)));
typedef unsigned u32x4v __attribute__((ext_vector_type(4)));
typedef float f32x2_t __attribute__((ext_vector_type(2)));
typedef __bf16 bf16x2_t __attribute__((ext_vector_type(2)));
constexpr int KROW = 144, VROW = 192;
constexpr int KBUF = 64 * KROW, VBUF = 64 * VROW, STG = KBUF + VBUF;
constexpr float SCL2 = 0.125f * 1.4426950408889634f;
constexpr float NEGBIG = -1e30f;

__device__ __forceinline__ unsigned cvtpk(float lo, float hi) { f32x2_t v = {lo, hi}; bf16x2_t b = __builtin_convertvector(v, bf16x2_t); return __builtin_bit_cast(unsigned, b); }
__device__ __forceinline__ int crow(int r, int hi) { return (r & 3) + 8 * (r >> 2) + 4 * hi; }
__device__ __forceinline__ s16x4 lds_tr(LAS const unsigned char* p) { return __builtin_bit_cast(s16x4, __builtin_amdgcn_ds_read_tr16_b64_v4i16((LAS s16x4*)p)); }

__device__ __forceinline__ bf16x8 scale_frag(bf16x8 v, float s) {
    const u32x4v w = __builtin_bit_cast(u32x4v, v); u32x4v o;
#pragma unroll
    for (int e = 0; e < 4; ++e) o[e] = cvtpk(__builtin_bit_cast(float, w[e] << 16) * s, __builtin_bit_cast(float, w[e] & 0xffff0000u) * s);
    return __builtin_bit_cast(bf16x8, o);
}
struct TileSrc { const bf16* k; const bf16* v; int stride; };
__device__ __forceinline__ void tile_load(u32x4v& kr, u32x4v& vr, const TileSrc& s, int t) {
    const int key = t >> 3, ch = t & 7;
    kr = *(const u32x4v*)(s.k + (size_t)key * s.stride + ch * 8); vr = *(const u32x4v*)(s.v + (size_t)key * s.stride + ch * 8);
}
__device__ __forceinline__ void tile_store(LAS unsigned char* buf, const u32x4v& kr, const u32x4v& vr, int t) {
    const int key = t >> 3, ch = t & 7;
    *(LAS u32x4v*)(buf + key * KROW + ch * 16) = kr; *(LAS u32x4v*)(buf + KBUF + key * VROW + ch * 16) = vr;
}
__device__ __forceinline__ void qk_tile(f32x16& p0, f32x16& p1, LAS const unsigned char* kb, const bf16x8 (&qf)[4], int r32, int hi, float cinit) {
    float ci = cinit; asm volatile("" : "+v"(ci));
#pragma unroll
    for (int r = 0; r < 16; ++r) { p0[r] = ci; p1[r] = ci; }
    LAS const unsigned char* a = kb + r32 * KROW + hi * 16;
#pragma unroll
    for (int ks = 0; ks < 4; ++ks) {
        const bf16x8 a0 = *(LAS const bf16x8*)(a + ks * 32), a1 = *(LAS const bf16x8*)(a + 32 * KROW + ks * 32);
        p0 = __builtin_amdgcn_mfma_f32_32x32x16_bf16(a0, qf[ks], p0, 0, 0, 0);
        p1 = __builtin_amdgcn_mfma_f32_32x32x16_bf16(a1, qf[ks], p1, 0, 0, 0);
    }
}
__device__ __forceinline__ void pv_tile(f32x16& o0, f32x16& o1, LAS const unsigned char* vb, const f32x16& p0, const f32x16& p1, int lane) {
    const int g = lane >> 4, i = lane & 15, hi = lane >> 5;
    LAS const unsigned char* base = vb + (4 * hi + (i >> 2)) * VROW + (16 * (g & 1) + 4 * (i & 3)) * 2;
#pragma unroll
    for (int s = 0; s < 4; ++s) {
        unsigned w[4];
#pragma unroll
        for (int e = 0; e < 4; ++e) { const int r = 8 * (s & 1) + 2 * e; w[e] = (s < 2) ? cvtpk(p0[r], p0[r + 1]) : cvtpk(p1[r], p1[r + 1]); }
        const u32x4v wv = {w[0], w[1], w[2], w[3]};
        const bf16x8 pf = __builtin_bit_cast(bf16x8, wv);
#pragma unroll
        for (int mb = 0; mb < 2; ++mb) {
            const s16x4 lo = lds_tr(base + s * 16 * VROW + mb * 64), hi4 = lds_tr(base + s * 16 * VROW + 8 * VROW + mb * 64);
            const bf16x8 vt = {lo[0], lo[1], lo[2], lo[3], hi4[0], hi4[1], hi4[2], hi4[3]};
            if (mb == 0) o0 = __builtin_amdgcn_mfma_f32_32x32x16_bf16(vt, pf, o0, 0, 0, 0);
            else o1 = __builtin_amdgcn_mfma_f32_32x32x16_bf16(vt, pf, o1, 0, 0, 0);
        }
    }
}
constexpr float SM_THR = 8.0f;
__device__ __forceinline__ void softmax_tile(f32x16& p0, f32x16& p1, f32x16& o0, f32x16& o1, float& mref, float& l, bool first) {
    float a = __builtin_fmaxf(__builtin_fmaxf(p0[0], p0[1]), p1[0]), b = __builtin_fmaxf(__builtin_fmaxf(p0[2], p0[3]), p1[1]);
    a = __builtin_fmaxf(__builtin_fmaxf(a, p1[2]), p1[3]);
#pragma unroll
    for (int r = 4; r < 16; r += 4) { a = __builtin_fmaxf(__builtin_fmaxf(a, p0[r]), p0[r + 1]); b = __builtin_fmaxf(__builtin_fmaxf(b, p0[r + 2]), p0[r + 3]);
        a = __builtin_fmaxf(__builtin_fmaxf(a, p1[r]), p1[r + 1]); b = __builtin_fmaxf(__builtin_fmaxf(b, p1[r + 2]), p1[r + 3]); }
    float rm = __builtin_fmaxf(a, b);
    { auto rr = __builtin_amdgcn_permlane32_swap(__float_as_uint(rm), __float_as_uint(rm), false, false); rm = __builtin_fmaxf(__uint_as_float(rr[0]), __uint_as_float(rr[1])); }
    if (first || __any(rm > SM_THR)) {
        const float dl = first ? rm : __builtin_fmaxf(rm, 0.f);
        mref += dl;
        const float f = __builtin_amdgcn_exp2f(-dl);
        l *= f;
#pragma unroll
        for (int r = 0; r < 16; ++r) { p0[r] -= dl; p1[r] -= dl; o0[r] *= f; o1[r] *= f; }
    }
    float s0 = 0.f, s1 = 0.f;
#pragma unroll
    for (int r = 0; r < 16; ++r) { p0[r] = __builtin_amdgcn_exp2f(p0[r]); p1[r] = __builtin_amdgcn_exp2f(p1[r]); s0 += p0[r]; s1 += p1[r]; }
    l += s0 + s1;
}


constexpr int PV_OFF = 2 * KBUF, PIPE_BYTES = 2 * KBUF + 2 * VBUF;
__device__ __forceinline__ void k_store(LAS unsigned char* lds, int slot, const u32x4v& kr, int t) { *(LAS u32x4v*)(lds + slot * KBUF + (t >> 3) * KROW + (t & 7) * 16) = kr; }
__device__ __forceinline__ void v_store(LAS unsigned char* lds, int voff, const u32x4v& vr, int t) { *(LAS u32x4v*)(lds + PV_OFF + voff + (t >> 3) * VROW + (t & 7) * 16) = vr; }
__device__ __forceinline__ u32x4v kv_load(const bf16* base, int stride, int t) { return *(const u32x4v*)(base + (size_t)(t >> 3) * stride + (t & 7) * 8); }
__device__ __forceinline__ void pv_frag(f32x16& o0, f32x16& o1, LAS const unsigned char* vb, const bf16x8 (&pf)[4], int lane) {
    const int g = lane >> 4, i = lane & 15, hi = lane >> 5;
    LAS const unsigned char* base = vb + (4 * hi + (i >> 2)) * VROW + (16 * (g & 1) + 4 * (i & 3)) * 2;
#pragma unroll
    for (int s = 0; s < 4; ++s)
#pragma unroll
        for (int mb = 0; mb < 2; ++mb) {
            const s16x4 lo = lds_tr(base + s * 16 * VROW + mb * 64), hi4 = lds_tr(base + s * 16 * VROW + 8 * VROW + mb * 64);
            const bf16x8 vt = {lo[0], lo[1], lo[2], lo[3], hi4[0], hi4[1], hi4[2], hi4[3]};
            if (mb == 0) o0 = __builtin_amdgcn_mfma_f32_32x32x16_bf16(vt, pf[s], o0, 0, 0, 0);
            else o1 = __builtin_amdgcn_mfma_f32_32x32x16_bf16(vt, pf[s], o1, 0, 0, 0);
        }
}
__device__ __forceinline__ void exp_pack(f32x16& p0, f32x16& p1, float& l, bf16x8 (&pf)[4]) {
    float s0 = 0.f, s1 = 0.f;
#pragma unroll
    for (int r = 0; r < 16; ++r) { p0[r] = __builtin_amdgcn_exp2f(p0[r]); p1[r] = __builtin_amdgcn_exp2f(p1[r]); s0 += p0[r]; s1 += p1[r]; }
    l += s0 + s1;
#pragma unroll
    for (int s = 0; s < 4; ++s) { u32x4v w;
#pragma unroll
        for (int e = 0; e < 4; ++e) { const int r = 8 * (s & 1) + 2 * e; w[e] = (s < 2) ? cvtpk(p0[r], p0[r + 1]) : cvtpk(p1[r], p1[r + 1]); }
        pf[s] = __builtin_bit_cast(bf16x8, w); }
}
template <class Pol>
__device__ __forceinline__ void attn_step_gen(const Pol& pol, int t, bool doqk, LAS unsigned char* lds, const bf16x8 (&qf)[4], float negm, f32x16& pc0, f32x16& pc1,
                                              f32x16& o0, f32x16& o1, float& l, int tid, int lane, int r32, int hi) {
    const int nt = pol.nt;
    u32x4v kr, vr;
    const bool ldk = (t + 2 < nt), ldv = (t + 1 < nt);
    if (ldk) kr = kv_load(pol.kptr(t + 2), pol.stride, tid);
    if (ldv) vr = kv_load(pol.vptr(t + 1), pol.stride, tid);
    f32x16 pn0, pn1; bf16x8 pf[4];
    if (doqk) { qk_tile(pn0, pn1, lds + ((t + 1) & 1) * KBUF, qf, r32, hi, pol.rowsel(t + 1) ? negm : NEGBIG); pol.mask(t + 1, pn0, pn1); }
    exp_pack(pc0, pc1, l, pf);
    pv_frag(o0, o1, lds + PV_OFF + (t & 1) * VBUF, pf, lane);
    if (ldk) k_store(lds, t & 1, kr, tid);
    if (ldv) v_store(lds, ((t + 1) & 1) * VBUF, vr, tid);
    __syncthreads();
    if (doqk) { pc0 = pn0; pc1 = pn1; }
}
template <class Pol>
__device__ __forceinline__ void attn_step_fast(const Pol& pol, int t, LAS unsigned char* lds, const bf16x8 (&qf)[4], float negm, f32x16& pc0, f32x16& pc1, f32x16& pn0, f32x16& pn1,
                                               f32x16& o0, f32x16& o1, float& l, u32x4v& kld, u32x4v& vld, const u32x4v& kst, const u32x4v& vst,
                                               int tid, int lane, int r32, int hi) {
    const int nt = pol.nt, tk = (t + 3 < nt) ? t + 3 : nt - 1, tv = (t + 2 < nt) ? t + 2 : nt - 1;
    kld = kv_load(pol.kptr(tk), pol.stride, tid); vld = kv_load(pol.vptr(tv), pol.stride, tid);
    bf16x8 pf[4];
    qk_tile(pn0, pn1, lds + ((t + 1) & 1) * KBUF, qf, r32, hi, pol.rowsel(t + 1) ? negm : NEGBIG);
    exp_pack(pc0, pc1, l, pf);
    pv_frag(o0, o1, lds + PV_OFF + (t & 1) * VBUF, pf, lane);
    k_store(lds, t & 1, kst, tid);
    v_store(lds, ((t + 1) & 1) * VBUF, vst, tid);
    __syncthreads();
}
template <class Pol>
__device__ __forceinline__ void attn_pipe(const Pol& pol, LAS unsigned char* lds, const bf16x8 (&qf)[4], float negm, f32x16& o0, f32x16& o1, float& l, int tid) {
    const int lane = tid & 63, r32 = lane & 31, hi = lane >> 5, nt = pol.nt;
    {
        const u32x4v k0 = kv_load(pol.kptr(0), pol.stride, tid), v0 = kv_load(pol.vptr(0), pol.stride, tid);
        u32x4v k1 = k0; if (nt > 1) k1 = kv_load(pol.kptr(1), pol.stride, tid);
        k_store(lds, 0, k0, tid); v_store(lds, 0, v0, tid); if (nt > 1) k_store(lds, 1, k1, tid);
    }
    __syncthreads();
    f32x16 pc0, pc1;
    qk_tile(pc0, pc1, lds, qf, r32, hi, pol.rowsel(0) ? negm : NEGBIG); pol.mask(0, pc0, pc1);
    int t = 0;
    for (; t < nt - 1 && t + 1 < pol.nmask; ++t)
        attn_step_gen(pol, t, true, lds, qf, negm, pc0, pc1, o0, o1, l, tid, lane, r32, hi);
    if (t < nt - 1) {
        const int tk0 = (t + 2 < nt) ? t + 2 : nt - 1;
        u32x4v ka = kv_load(pol.kptr(tk0), pol.stride, tid), va = kv_load(pol.vptr(t + 1), pol.stride, tid), kb, vb;
        f32x16 pd0, pd1;
        for (; t + 1 < nt - 1; t += 2) {
            attn_step_fast(pol, t, lds, qf, negm, pc0, pc1, pd0, pd1, o0, o1, l, kb, vb, ka, va, tid, lane, r32, hi);
            attn_step_fast(pol, t + 1, lds, qf, negm, pd0, pd1, pc0, pc1, o0, o1, l, ka, va, kb, vb, tid, lane, r32, hi);
        }
        if (t < nt - 1) {
            attn_step_fast(pol, t, lds, qf, negm, pc0, pc1, pd0, pd1, o0, o1, l, kb, vb, ka, va, tid, lane, r32, hi);
            pc0 = pd0; pc1 = pd1; ++t;
        }
    }
    attn_step_gen(pol, nt - 1, false, lds, qf, negm, pc0, pc1, o0, o1, l, tid, lane, r32, hi);
}
__device__ __forceinline__ float row_negm(const bf16x8 (&qf)[4], float kmax) {
    float ss = 0.f;
#pragma unroll
    for (int ks = 0; ks < 4; ++ks) { const u32x4v w = __builtin_bit_cast(u32x4v, qf[ks]);
#pragma unroll
        for (int e = 0; e < 4; ++e) { const float a = __builtin_bit_cast(float, w[e] << 16), b = __builtin_bit_cast(float, w[e] & 0xffff0000u); ss += a * a + b * b; } }
    ss += shx<32>(ss);
    return -(__builtin_sqrtf(ss) * kmax);
}
__device__ __forceinline__ float gain_kmax(const float* g, int lane) { return wave_max(fabsf(g[lane])) * (8.0f * 1.02f); }

constexpr int MOBA_KM_OFF = PIPE_BYTES, MOBA_TL_OFF = MOBA_KM_OFF + 32 * 64 * 4, MOBA_UW_OFF = MOBA_TL_OFF + 132 * 4;
struct MobaPol {
    int nt, nmask, stride, own, tq, hi; unsigned selbits; const bf16* Pk; const bf16* Pv; LAS const int* tl;
    __device__ __forceinline__ const bf16* kptr(int i) const { return Pk + (size_t)tl[i] * 64 * DINP; }
    __device__ __forceinline__ const bf16* vptr(int i) const { return Pv + (size_t)tl[i] * 64 * DINP; }
    __device__ __forceinline__ bool rowsel(int i) const { const int blk = tl[i] >> 2; return blk == own || ((selbits >> blk) & 1u); }
    __device__ __forceinline__ void mask_(int i, f32x16& p0, f32x16& p1) const {
        const int tile = tl[i];
        if ((tile >> 2) == own) { const int kbase = tile * 64;
#pragma unroll
            for (int r = 0; r < 16; ++r) { const int k0 = kbase + crow(r, hi); p0[r] = (k0 <= tq) ? p0[r] : NEGBIG; p1[r] = (k0 + 32 <= tq) ? p1[r] : NEGBIG; } }
    }
    __device__ __forceinline__ void mask(int i, f32x16& p0, f32x16& p1) const { mask_(i, p0, p1); }
};
__device__ __forceinline__ void moba_unit(const bf16* __restrict__ P, const float* __restrict__ kmean, const float* __restrict__ kgain, bf16* __restrict__ MIX, int b, int h, int qb, int tid, LAS unsigned char* lds) {
    asm volatile("" : "+v"(tid));
    const int lane = tid & 63, wid = __builtin_amdgcn_readfirstlane(tid >> 6), r32 = lane & 31, hi = lane >> 5;
    LAS float* km = (LAS float*)(lds + MOBA_KM_OFF); LAS int* tl = (LAS int*)(lds + MOBA_TL_OFF); LAS unsigned* uw = (LAS unsigned*)(lds + MOBA_UW_OFF);
    const int own = qb, tq = qb * 256 + wid * 32 + r32;
    const size_t rowq = (size_t)b * SEQ + tq;
    const bf16* Pb = P + (size_t)b * SEQ * DINP;
    bf16x8 qf[4];
#pragma unroll
    for (int ks = 0; ks < 4; ++ks) qf[ks] = *(const bf16x8*)(P + rowq * DINP + C_BQ + h * 64 + ks * 16 + hi * 8);
    const float kmax = gain_kmax(kgain, lane);
    for (int e = tid; e < own * 64; e += 512) km[e] = kmean[(((size_t)b * 4 + h) * 32) * 64 + e];
    __syncthreads();
    unsigned mask = 0u;
    {
        float qv[32];
#pragma unroll
        for (int ks = 0; ks < 4; ++ks)
#pragma unroll
            for (int j = 0; j < 8; ++j) qv[ks * 8 + j] = bf2f((bf16)qf[ks][j]);
        float b0 = -3e38f, b1 = -3e38f, b2 = -3e38f; int i0 = -1, i1 = -1, i2 = -1;
        for (int n = 0; n < own; ++n) {
            LAS const float* kp = km + n * 64 + hi * 8; float a = 0.f;
#pragma unroll
            for (int ks = 0; ks < 4; ++ks)
#pragma unroll
                for (int j = 0; j < 8; ++j) a = fmaf(qv[ks * 8 + j], kp[ks * 16 + j], a);
            a += shx<32>(a);
            if (a > b0) { b2 = b1; i2 = i1; b1 = b0; i1 = i0; b0 = a; i0 = n; }
            else if (a > b1) { b2 = b1; i2 = i1; b1 = a; i1 = n; }
            else if (a > b2) { b2 = a; i2 = n; }
        }
        if (i0 >= 0) mask |= 1u << i0; if (i1 >= 0) mask |= 1u << i1; if (i2 >= 0) mask |= 1u << i2;
    }
    { unsigned um = mask;
      um |= shxu<1>(um); um |= shxu<2>(um); um |= shxu<4>(um); um |= shxu<8>(um); um |= shxu<16>(um); um |= shxu<32>(um);
      if (lane == 0) uw[wid] = um; }
    __syncthreads();
    if (tid == 0) { unsigned um = 0u; for (int w = 0; w < 8; ++w) um |= uw[w];
        int cnt = 0; for (int s = 0; s < 4; ++s) tl[cnt++] = own * 4 + s;
        for (int n = 0; n < own; ++n) if ((um >> n) & 1u) for (int s = 0; s < 4; ++s) tl[cnt++] = n * 4 + s;
        tl[131] = cnt; }
    __syncthreads();
#pragma unroll
    for (int ks = 0; ks < 4; ++ks) qf[ks] = scale_frag(qf[ks], SCL2);
    f32x16 o0, o1;
#pragma unroll
    for (int r = 0; r < 16; ++r) { o0[r] = zf_(); o1[r] = o0[r]; }
    float l = 0.f;
    MobaPol pol; pol.nt = tl[131]; pol.nmask = 4; pol.stride = DINP; pol.own = own; pol.tq = tq; pol.hi = hi; pol.selbits = mask; pol.Pk = Pb + C_BK + h * 64; pol.Pv = Pb + C_BV + h * 64; pol.tl = tl;
    attn_pipe(pol, lds, qf, row_negm(qf, kmax), o0, o1, l, tid);
    l += shx<32>(l);
    const float inv = rcpf_(l);
    bf16* op = MIX + rowq * DM + 512 + h * 64 + 4 * hi;
#pragma unroll
    for (int g = 0; g < 4; ++g) {
        uint2 w0, w1;
        w0.x = cvtpk(o0[4 * g] * inv, o0[4 * g + 1] * inv); w0.y = cvtpk(o0[4 * g + 2] * inv, o0[4 * g + 3] * inv);
        w1.x = cvtpk(o1[4 * g] * inv, o1[4 * g + 1] * inv); w1.y = cvtpk(o1[4 * g + 2] * inv, o1[4 * g + 3] * inv);
        *(uint2*)(op + 8 * g) = w0; *(uint2*)(op + 32 + 8 * g) = w1;
    }
}

constexpr int NSA_S4_OFF = PIPE_BYTES, NSA_L4_OFF = NSA_S4_OFF + 8 * 8 * 128 * 4, NSA_SM_OFF = NSA_L4_OFF + 8 * 8 * 128 * 4;
struct NsaCtx { const bf16* Pb; const bf16* Kcb; const bf16* Vcb; int b, jq, tid, lane, wid, r32, hi, tq; unsigned mk0, mk1, mk2, mk3; };

template <int MODE>
__device__ __forceinline__ void nsa_tiles(const NsaCtx& c, LAS unsigned char* lds, const bf16x8 (&qf)[4], int nt, f32x16& o0, f32x16& o1, float& m, float& l, float pre) {
    const int tid = c.tid, lane = c.lane, r32 = c.r32, hi = c.hi, tq = c.tq, jq = c.jq;
    const int nw = (jq < 8 ? jq : 8) + 1;
    auto tile_of = [&](int i) -> int { return MODE < 2 ? i : (i == 0 ? jq : (MODE == 2 ? i - 1 : jq - nw + i)); };
    auto src_of = [&](int t) -> TileSrc {
        if (MODE < 2) return TileSrc{c.Kcb + (size_t)t * 64 * 64, c.Vcb + (size_t)t * 64 * 64, 64};
        if (MODE == 2) return TileSrc{c.Pb + (size_t)t * 64 * DINP + C_NKS, c.Pb + (size_t)t * 64 * DINP + C_NVS, DINP};
        return TileSrc{c.Pb + (size_t)t * 64 * DINP + C_NKW, c.Pb + (size_t)t * 64 * DINP + C_NVW, DINP};
    };
    u32x4v kr, vr;
    { const TileSrc s = src_of(tile_of(0)); tile_load(kr, vr, s, tid); }
    tile_store(lds, kr, vr, tid);
    __syncthreads();
    const int ncv = (tq >= 31) ? ((tq - 31) >> 4) + 1 : 0;
    for (int i = 0; i < nt; ++i) {
        const int tile = tile_of(i);
        if (i + 1 < nt) { const TileSrc s = src_of(tile_of(i + 1)); tile_load(kr, vr, s, tid); }
        LAS const unsigned char* buf = lds + (i & 1) * STG;
        const int kbase = tile * 64;
        bool rowsel = true;
        if (MODE == 2 && tile != jq) { const unsigned w = (tile >> 5) == 0 ? c.mk0 : (tile >> 5) == 1 ? c.mk1 : (tile >> 5) == 2 ? c.mk2 : c.mk3; rowsel = (w >> (tile & 31)) & 1u; }
        if (MODE != 2 || __any(rowsel)) {
            f32x16 p0, p1;
            qk_tile(p0, p1, buf, qf, r32, hi, MODE < 2 ? 0.f : (rowsel ? -m : NEGBIG));
            if (MODE < 2) {
#pragma unroll
                for (int r = 0; r < 16; ++r) { const int k0 = kbase + crow(r, hi); p0[r] = (k0 < ncv) ? p0[r] : NEGBIG; p1[r] = (k0 + 32 < ncv) ? p1[r] : NEGBIG; }
            } else if (MODE == 2) {
                if (tile == jq) {
#pragma unroll
                    for (int r = 0; r < 16; ++r) { const int k0 = kbase + crow(r, hi); p0[r] = (k0 <= tq) ? p0[r] : NEGBIG; p1[r] = (k0 + 32 <= tq) ? p1[r] : NEGBIG; }
                }
            } else if (tile == jq || tile + 8 == jq) {
#pragma unroll
                for (int r = 0; r < 16; ++r) { const int k0 = kbase + crow(r, hi);
                    p0[r] = (k0 <= tq && k0 + 511 >= tq) ? p0[r] : NEGBIG; p1[r] = (k0 + 32 <= tq && k0 + 32 + 511 >= tq) ? p1[r] : NEGBIG; }
            }
            if (MODE == 0) {
                float tm = fmaxf(p0[0], p1[0]);
#pragma unroll
                for (int r = 1; r < 16; ++r) tm = fmaxf(tm, fmaxf(p0[r], p1[r]));
                tm = fmaxf(tm, shx<32>(tm));
                const float mn = fmaxf(m, tm); float s = 0.f;
#pragma unroll
                for (int r = 0; r < 16; ++r) { s += (p0[r] > -1e29f ? __builtin_amdgcn_exp2f(p0[r] - mn) : 0.f) + (p1[r] > -1e29f ? __builtin_amdgcn_exp2f(p1[r] - mn) : 0.f); }
                l = l * __builtin_amdgcn_exp2f(m - mn) + s; m = mn;
            } else if (MODE == 1) {
#pragma unroll
                for (int r = 0; r < 16; ++r) { p0[r] = (p0[r] > -1e29f) ? __builtin_amdgcn_exp2f(p0[r] - m) * pre : 0.f; p1[r] = (p1[r] > -1e29f) ? __builtin_amdgcn_exp2f(p1[r] - m) * pre : 0.f; }
                pv_tile(o0, o1, buf + KBUF, p0, p1, lane);
                LAS float* S4 = (LAS float*)(lds + NSA_S4_OFF) + (c.wid * 8 + (r32 & 7)) * 128; LAS float* L4 = (LAS float*)(lds + NSA_L4_OFF) + (c.wid * 8 + (r32 & 7)) * 128;
#pragma unroll
                for (int mbk = 0; mbk < 2; ++mbk)
#pragma unroll
                    for (int g = 0; g < 4; ++g) {
                        float s4 = mbk ? (p1[4 * g] + p1[4 * g + 1]) + (p1[4 * g + 2] + p1[4 * g + 3]) : (p0[4 * g] + p0[4 * g + 1]) + (p0[4 * g + 2] + p0[4 * g + 3]);
                        float la = mbk ? p1[4 * g + 3] : p0[4 * g + 3];
                        s4 += shx<8>(s4); s4 += shx<16>(s4); la += shx<8>(la); la += shx<16>(la);
                        const int gi = tile * 16 + 8 * mbk + 2 * g + hi;
                        if (r32 < 8) { S4[gi] = s4; L4[gi] = la; }
                    }
            } else {
                softmax_tile(p0, p1, o0, o1, m, l, i == 0);
                pv_tile(o0, o1, buf + KBUF, p0, p1, lane);
            }
        }
        if (i + 1 < nt) tile_store(lds + ((i + 1) & 1) * STG, kr, vr, tid);
        __syncthreads();
    }
}

struct NsaSelPol {
    int nt, nmask, stride, jq, tq, hi; unsigned long long mlo, mhi; const bf16* Pk; const bf16* Pv;
    __device__ __forceinline__ int tile_of(int i) const { return i == 0 ? jq : i - 1; }
    __device__ __forceinline__ const bf16* kptr(int i) const { return Pk + (size_t)tile_of(i) * 64 * DINP; }
    __device__ __forceinline__ const bf16* vptr(int i) const { return Pv + (size_t)tile_of(i) * 64 * DINP; }
    __device__ __forceinline__ bool rowsel(int i) const { if (i == 0) return true; const int tile = i - 1; const unsigned long long w = tile < 64 ? mlo : mhi; return (w >> (tile & 63)) & 1ull; }
    __device__ __forceinline__ void mask(int i, f32x16& p0, f32x16& p1) const {
        if (i == 0) { const int kbase = jq * 64;
#pragma unroll
            for (int r = 0; r < 16; ++r) { const int k0 = kbase + crow(r, hi); p0[r] = (k0 <= tq) ? p0[r] : NEGBIG; p1[r] = (k0 + 32 <= tq) ? p1[r] : NEGBIG; } }
    }
};
struct NsaWinPol {
    int nt, nmask, stride, jq, tq, hi; const bf16* Pk; const bf16* Pv;
    __device__ __forceinline__ int tile_of(int i) const { return i == 0 ? jq : jq - nt + i; }
    __device__ __forceinline__ const bf16* kptr(int i) const { return Pk + (size_t)tile_of(i) * 64 * DINP; }
    __device__ __forceinline__ const bf16* vptr(int i) const { return Pv + (size_t)tile_of(i) * 64 * DINP; }
    __device__ __forceinline__ bool rowsel(int) const { return true; }
    __device__ __forceinline__ void mask(int i, f32x16& p0, f32x16& p1) const {
        const int tile = tile_of(i);
        if (tile == jq || tile + 8 == jq) { const int kbase = tile * 64;
#pragma unroll
            for (int r = 0; r < 16; ++r) { const int k0 = kbase + crow(r, hi);
                p0[r] = (k0 <= tq && k0 + 511 >= tq) ? p0[r] : NEGBIG; p1[r] = (k0 + 32 <= tq && k0 + 32 + 511 >= tq) ? p1[r] : NEGBIG; } }
    }
};
__device__ __forceinline__ void nsa_unit(const bf16* __restrict__ P, const float* __restrict__ G, const float* __restrict__ tab, const bf16* __restrict__ KVcb, const float* __restrict__ kgain  , bf16* __restrict__ MIX,
                                         int b, int jq, int tid, LAS unsigned char* lds) {
    asm volatile("" : "+v"(tid));
    NsaCtx c; c.b = b; c.jq = jq; c.tid = tid; c.lane = tid & 63; c.wid = __builtin_amdgcn_readfirstlane(tid >> 6); c.r32 = c.lane & 31; c.hi = c.lane >> 5;
    const int qi = c.r32 & 7, hh = c.r32 >> 3, hi = c.hi, lane = c.lane;
    c.tq = jq * 64 + c.wid * 8 + qi;
    c.Pb = P + (size_t)b * SEQ * DINP; c.Kcb = KVcb + (size_t)b * 512 * 64; c.Vcb = KVcb + ((size_t)NB + b) * 512 * 64;
    c.mk0 = c.mk1 = c.mk2 = c.mk3 = 0u;
    const size_t rowq = (size_t)b * SEQ + c.tq;
    bf16x8 qf[4];
#pragma unroll
    for (int ks = 0; ks < 4; ++ks) qf[ks] = scale_frag(*(const bf16x8*)(P + rowq * DINP + C_NQ + hh * 64 + ks * 16 + hi * 8), SCL2);
    const float g0 = sigmoidf_(G[rowq * 32 + 8 + hh]);
    { LAS float* gl = (LAS float*)(lds + NSA_SM_OFF + 1024); gl[tid] = sigmoidf_(G[rowq * 32 + 12 + hh]); gl[512 + tid] = sigmoidf_(G[rowq * 32 + 16 + hh]); }
    f32x16 a0, a1;
    {
        const int ncvmax = min(4 * jq + 3, NCMP), nct = (ncvmax + 63) >> 6;
        f32x16 o0, o1;
#pragma unroll
        for (int r = 0; r < 16; ++r) { o0[r] = zf_(); o1[r] = o0[r]; }
        float m = NEGBIG, l = 0.f;
        nsa_tiles<0>(c, lds, qf, nct, o0, o1, m, l, 0.f);
        l += shx<32>(l);
        const float pre = (l > 0.f) ? rcpf_(l) : 0.f;
        nsa_tiles<1>(c, lds, qf, nct, o0, o1, m, l, pre);
#pragma unroll
        for (int r = 0; r < 16; ++r) { a0[r] = g0 * o0[r]; a1[r] = g0 * o1[r]; }
    }
    {
        LAS unsigned* sm = (LAS unsigned*)(lds + NSA_SM_OFF);
        for (int q = 0; q < 8; ++q) {
            LAS const float* S4 = (LAS const float*)(lds + NSA_S4_OFF) + (c.wid * 8 + q) * 128; LAS const float* L4 = (LAS const float*)(lds + NSA_L4_OFF) + (c.wid * 8 + q) * 128;
            float v0, v1;
            { const int n = lane; const bool causal = n <= jq, forced = causal && (n == 0 || n >= jq - 1);
              float im = 0.f; if (causal) { im = S4[n]; if (n > 0) im += L4[n - 1]; }
              v0 = forced ? 1e9f : (causal ? im : -1e30f); }
            { const int n = lane + 64; const bool causal = n <= jq, forced = causal && (n >= jq - 1);
              float im = 0.f; if (causal) { im = S4[n] + L4[n - 1]; }
              v1 = forced ? 1e9f : (causal ? im : -1e30f); }
            const unsigned b0_ = __float_as_uint(v0), b1_ = __float_as_uint(v1);
            const unsigned u0 = b0_ ^ ((b0_ >> 31) ? 0xFFFFFFFFu : 0x80000000u), u1 = b1_ ^ ((b1_ >> 31) ? 0xFFFFFFFFu : 0x80000000u);
            unsigned T = 0u;
#pragma unroll
            for (int bit = 31; bit >= 0; --bit) { const unsigned cand = T | (1u << bit);
                const int cn = __popcll(__ballot(u0 >= cand)) + __popcll(__ballot(u1 >= cand));
                if (cn >= 16) T = cand; }
            const unsigned long long g0b = __ballot(u0 > T), g1b = __ballot(u1 > T), e0b = __ballot(u0 == T), e1b = __ballot(u1 == T);
            const int rem = 16 - (__popcll(g0b) + __popcll(g1b));
            const unsigned long long ltm = (1ull << lane) - 1ull;
            const unsigned long long sel0 = g0b | __ballot(u0 == T && __popcll(e0b & ltm) < rem);
            const unsigned long long sel1 = g1b | __ballot(u1 == T && __popcll(e0b) + __popcll(e1b & ltm) < rem);
            if (lane == 0) { sm[(c.wid * 8 + q) * 4 + 0] = (unsigned)sel0; sm[(c.wid * 8 + q) * 4 + 1] = (unsigned)(sel0 >> 32); sm[(c.wid * 8 + q) * 4 + 2] = (unsigned)sel1; sm[(c.wid * 8 + q) * 4 + 3] = (unsigned)(sel1 >> 32); }
        }
        __builtin_amdgcn_s_waitcnt(0xc07f); __builtin_amdgcn_wave_barrier();
        c.mk0 = sm[(c.wid * 8 + qi) * 4 + 0]; c.mk1 = sm[(c.wid * 8 + qi) * 4 + 1]; c.mk2 = sm[(c.wid * 8 + qi) * 4 + 2]; c.mk3 = sm[(c.wid * 8 + qi) * 4 + 3];
    }
    LAS float* stash = (LAS float*)(lds + NSA_S4_OFF) + c.wid * 1024 + lane;
    LAS float* stash2 = (LAS float*)(lds + NSA_L4_OFF) + c.wid * 1024 + lane;
#pragma unroll
    for (int r = 0; r < 16; ++r) { stash[r * 64] = a0[r]; stash2[r * 64] = a1[r]; }
    {
        const u32x4v qw = __builtin_bit_cast(u32x4v, qf[0]); u32x4v w;
#pragma unroll
        for (int e = 0; e < 4; ++e) {
            float y[2];
#pragma unroll
            for (int k = 0; k < 2; ++k) { const int j = 2 * e + k; const float x = k ? __builtin_bit_cast(float, qw[e] & 0xffff0000u) : __builtin_bit_cast(float, qw[e] << 16); const float other = shx<32>(x);
                const float cs = tab[c.tq * 16 + j], sn = tab[c.tq * 16 + 8 + j]; y[k] = hi ? (x * cs + other * sn) : (x * cs - other * sn); }
            w[e] = cvtpk(y[0], y[1]);
        }
        qf[0] = __builtin_bit_cast(bf16x8, w);
    }
    {
        f32x16 o0, o1;
#pragma unroll
        for (int r = 0; r < 16; ++r) { o0[r] = zf_(); o1[r] = o0[r]; }
        float l = 0.f;
        NsaSelPol pol; pol.nt = jq + 1; pol.nmask = 1; pol.stride = DINP; pol.jq = jq; pol.tq = c.tq; pol.hi = hi; pol.mlo = (unsigned long long)c.mk0 | ((unsigned long long)c.mk1 << 32); pol.mhi = (unsigned long long)c.mk2 | ((unsigned long long)c.mk3 << 32); pol.Pk = c.Pb + C_NKS; pol.Pv = c.Pb + C_NVS;
        attn_pipe(pol, lds, qf, row_negm(qf, gain_kmax(kgain + 64, lane)), o0, o1, l, tid);
        l += shx<32>(l);
        int t2 = tid; asm volatile("" : "+v"(t2));
        const float sc = ((LAS const float*)(lds + NSA_SM_OFF + 1024))[t2] * rcpf_(l);
        LAS float* st1 = (LAS float*)(lds + NSA_S4_OFF) + (t2 >> 6) * 1024 + (t2 & 63); LAS float* st2 = (LAS float*)(lds + NSA_L4_OFF) + (t2 >> 6) * 1024 + (t2 & 63);
#pragma unroll
        for (int r = 0; r < 16; ++r) { st1[r * 64] = fmaf(sc, o0[r], st1[r * 64]); st2[r * 64] = fmaf(sc, o1[r], st2[r * 64]); }
    }
    {
        f32x16 o0, o1;
#pragma unroll
        for (int r = 0; r < 16; ++r) { o0[r] = zf_(); o1[r] = o0[r]; }
        float l = 0.f;
        NsaWinPol pol; pol.nt = (jq < 8 ? jq : 8) + 1; pol.nmask = 2; pol.stride = DINP; pol.jq = jq; pol.tq = c.tq; pol.hi = hi; pol.Pk = c.Pb + C_NKW; pol.Pv = c.Pb + C_NVW;
        attn_pipe(pol, lds, qf, row_negm(qf, gain_kmax(kgain + 128, lane)), o0, o1, l, tid);
        l += shx<32>(l);
        int t2 = tid; asm volatile("" : "+v"(t2));
        const float sc = ((LAS const float*)(lds + NSA_SM_OFF + 1024))[512 + t2] * rcpf_(l);
        LAS const float* st1 = (LAS const float*)(lds + NSA_S4_OFF) + (t2 >> 6) * 1024 + (t2 & 63); LAS const float* st2 = (LAS const float*)(lds + NSA_L4_OFF) + (t2 >> 6) * 1024 + (t2 & 63);
#pragma unroll
        for (int r = 0; r < 16; ++r) { a0[r] = fmaf(sc, o0[r], st1[r * 64]); a1[r] = fmaf(sc, o1[r], st2[r * 64]); }
    }
    int t3 = tid; asm volatile("" : "+v"(t3));
    const int ln3 = t3 & 63, r3 = ln3 & 31;
    bf16* op = MIX + ((size_t)b * SEQ + jq * 64 + (t3 >> 6) * 8 + (r3 & 7)) * DM + 768 + (r3 >> 3) * 64 + 4 * (ln3 >> 5);
#pragma unroll
    for (int g = 0; g < 4; ++g) {
        uint2 w0, w1;
        w0.x = cvtpk(a0[4 * g], a0[4 * g + 1]); w0.y = cvtpk(a0[4 * g + 2], a0[4 * g + 3]);
        w1.x = cvtpk(a1[4 * g], a1[4 * g + 1]); w1.y = cvtpk(a1[4 * g + 2], a1[4 * g + 3]);
        *(uint2*)(op + 8 * g) = w0; *(uint2*)(op + 32 + 8 * g) = w1;
    }
}


constexpr int MQ_PITCH = 272, MV_PITCH = 320;
constexpr int ML_G_OFF = 0;
constexpr int ML_Q_OFF = 4096;
constexpr int ML_K_OFF = ML_Q_OFF + 64 * MQ_PITCH;
constexpr int ML_V_OFF = ML_K_OFF + 64 * MV_PITCH;
constexpr int ML_END = ML_V_OFF + 64 * MV_PITCH;
static_assert(ML_END <= 131072, "mlstm LDS");
constexpr float KSCALE = 0.08838834764831845f;

__device__ __forceinline__ void qk2_rows(const bf16* __restrict__ P, const float* __restrict__ cw, bf16* __restrict__ QK2, int bid, int G, int tid) {
    asm volatile("" : "+v"(tid));
    const int ch = tid & 127, c0 = ch * 8;
    float tp[4][8];
#pragma unroll
    for (int j = 0; j < 4; ++j) { const float4 a = *(const float4*)(cw + j * 1024 + c0), b4 = *(const float4*)(cw + j * 1024 + c0 + 4);
        tp[j][0] = a.x; tp[j][1] = a.y; tp[j][2] = a.z; tp[j][3] = a.w; tp[j][4] = b4.x; tp[j][5] = b4.y; tp[j][6] = b4.z; tp[j][7] = b4.w; }
    const float sc = (c0 >= 512) ? KSCALE : 1.f;
    for (int row0 = bid * 4 + (tid >> 7); row0 < T; row0 += G * 16) {
        u32x4v w[4][4];
#pragma unroll
        for (int q = 0; q < 4; ++q) { const int row = row0 + q * G * 4, t = row & (SEQ - 1);
#pragma unroll
            for (int j = 0; j < 4; ++j) { w[q][j] = u32x4v{0u, 0u, 0u, 0u}; if (row < T && t - 3 + j >= 0) w[q][j] = *(const u32x4v*)(P + (size_t)(row - 3 + j) * DINP + c0); } }
#pragma unroll
        for (int q = 0; q < 4; ++q) { const int row = row0 + q * G * 4;
            float y[8];
#pragma unroll
            for (int e = 0; e < 8; ++e) y[e] = 0.f;
#pragma unroll
            for (int j = 0; j < 4; ++j)
#pragma unroll
                for (int e = 0; e < 4; ++e) { y[2 * e] = fmaf(tp[j][2 * e], __builtin_bit_cast(float, w[q][j][e] << 16), y[2 * e]); y[2 * e + 1] = fmaf(tp[j][2 * e + 1], __builtin_bit_cast(float, w[q][j][e] & 0xffff0000u), y[2 * e + 1]); }
#pragma unroll
            for (int e = 0; e < 8; ++e) y[e] = y[e] * rcpf_(1.f + __expf(-y[e])) * sc;
            u32x4v o; o[0] = cvtpk(y[0], y[1]); o[1] = cvtpk(y[2], y[3]); o[2] = cvtpk(y[4], y[5]); o[3] = cvtpk(y[6], y[7]);
            if (row < T) *(u32x4v*)(QK2 + (size_t)row * 1024 + c0) = o; }
    }
}

struct MlRaw { u32x4v q[2], k[2], v[2]; float gf, gi; };
template <bool WITH_Q> __device__ __forceinline__ void ml_load(MlRaw& r, const bf16* __restrict__ P, const bf16* __restrict__ QK2, const float* __restrict__ G, const float* __restrict__ bif, int u, int tid) {
    const int c = u & 127, h = (u >> 7) & 3, b = u >> 9, row0 = b * SEQ + c * 64, s = tid >> 3;
#pragma unroll
    for (int pass = 0; pass < 2; ++pass) { const int ch = (tid & 7) + 8 * pass;
        if (WITH_Q) r.q[pass] = *(const u32x4v*)(QK2 + (size_t)(row0 + s) * 1024 + h * 128 + ch * 8);
        r.k[pass] = *(const u32x4v*)(QK2 + (size_t)(row0 + s) * 1024 + 512 + h * 128 + ch * 8);
        r.v[pass] = *(const u32x4v*)(P + (size_t)(row0 + s) * DINP + C_MV + h * 128 + ch * 8); }
    if (tid < 64) { r.gf = G[(size_t)(row0 + tid) * 32 + 4 + h] + bif[4 + h]; r.gi = G[(size_t)(row0 + tid) * 32 + h] + bif[h]; }
}
__device__ __forceinline__ void mlstm_gates(const MlRaw& r, int tid, LAS float* gs) {
    if (tid < 64) { gs[tid] = log_sigmoidf_(r.gf); gs[128 + tid] = r.gi; }
    __syncthreads();
    if (tid < 64) { float a = 0.f; for (int s = 0; s <= tid; ++s) a += gs[s]; gs[64 + tid] = a; }
    __syncthreads();
}

__device__ __forceinline__ void mlstm_m1_phase(const bf16* __restrict__ P, const bf16* __restrict__ QK2, const float* __restrict__ G, const float* __restrict__ bif,
                                               bf16* __restrict__ CT, float* __restrict__ nst, float* __restrict__ dec, int bid, int Gd, int tid, LAS unsigned char* lds) {
    asm volatile("" : "+v"(tid));
    const int lane = tid & 63, wid = __builtin_amdgcn_readfirstlane(tid >> 6), hi = lane >> 5;
    LAS float* gs = (LAS float*)(lds + ML_G_OFF);
    MlRaw raw;
    if (bid < 2048) ml_load<false>(raw, P, QK2, G, bif, bid, tid);
    for (int u = bid; u < 2048; u += Gd) {
        mlstm_gates(raw, tid, gs);
        if (tid == 0) dec[u] = __expf(gs[64 + 63]);
        {
            const int s = tid >> 3; const float ws = __expf(gs[64 + 63] - gs[64 + s] + gs[128 + s]);
#pragma unroll
            for (int pass = 0; pass < 2; ++pass) { const int ch = (tid & 7) + 8 * pass; u32x4v w;
#pragma unroll
                for (int e = 0; e < 4; ++e) w[e] = cvtpk(__builtin_bit_cast(float, raw.k[pass][e] << 16) * ws, __builtin_bit_cast(float, raw.k[pass][e] & 0xffff0000u) * ws);
                *(LAS u32x4v*)(lds + ML_K_OFF + s * MV_PITCH + ch * 16) = w;
                *(LAS u32x4v*)(lds + ML_V_OFF + s * MV_PITCH + ch * 16) = raw.v[pass]; }
        }
        if (u + Gd < 2048) ml_load<false>(raw, P, QK2, G, bif, u + Gd, tid);
        __syncthreads();
        const int g = lane >> 4, i = lane & 15;
        const int mb = wid >> 1, nb0 = 2 * (wid & 1);
        f32x16 acc0, acc1;
#pragma unroll
        for (int r = 0; r < 16; ++r) { acc0[r] = zf_(); acc1[r] = acc0[r]; }
        LAS const unsigned char* trb = lds + (4 * hi + (i >> 2)) * MV_PITCH + (16 * (g & 1) + 4 * (i & 3)) * 2;
#pragma unroll
        for (int ks = 0; ks < 4; ++ks) {
            const s16x4 alo = lds_tr(trb + ML_K_OFF + ks * 16 * MV_PITCH + mb * 64), ahi = lds_tr(trb + ML_K_OFF + ks * 16 * MV_PITCH + 8 * MV_PITCH + mb * 64);
            const bf16x8 af = {alo[0], alo[1], alo[2], alo[3], ahi[0], ahi[1], ahi[2], ahi[3]};
            const s16x4 b0lo = lds_tr(trb + ML_V_OFF + ks * 16 * MV_PITCH + nb0 * 64), b0hi = lds_tr(trb + ML_V_OFF + ks * 16 * MV_PITCH + 8 * MV_PITCH + nb0 * 64);
            const s16x4 b1lo = lds_tr(trb + ML_V_OFF + ks * 16 * MV_PITCH + (nb0 + 1) * 64), b1hi = lds_tr(trb + ML_V_OFF + ks * 16 * MV_PITCH + 8 * MV_PITCH + (nb0 + 1) * 64);
            const bf16x8 bf0 = {b0lo[0], b0lo[1], b0lo[2], b0lo[3], b0hi[0], b0hi[1], b0hi[2], b0hi[3]}, bf1 = {b1lo[0], b1lo[1], b1lo[2], b1lo[3], b1hi[0], b1hi[1], b1hi[2], b1hi[3]};
            acc0 = __builtin_amdgcn_mfma_f32_32x32x16_bf16(af, bf0, acc0, 0, 0, 0);
            acc1 = __builtin_amdgcn_mfma_f32_32x32x16_bf16(af, bf1, acc1, 0, 0, 0);
        }
        bf16* ct = CT + (size_t)u * 16384;
#pragma unroll
        for (int gq = 0; gq < 4; ++gq) { const int d0 = 32 * mb + 8 * gq + 4 * hi;
            uint2 w0, w1; w0.x = cvtpk(acc0[4 * gq], acc0[4 * gq + 1]); w0.y = cvtpk(acc0[4 * gq + 2], acc0[4 * gq + 3]); w1.x = cvtpk(acc1[4 * gq], acc1[4 * gq + 1]); w1.y = cvtpk(acc1[4 * gq + 2], acc1[4 * gq + 3]);
            *(uint2*)(ct + (size_t)(32 * nb0 + (lane & 31)) * 128 + d0) = w0; *(uint2*)(ct + (size_t)(32 * (nb0 + 1) + (lane & 31)) * 128 + d0) = w1; }
        if (tid < 128) { float a = 0.f; for (int s = 0; s < 64; ++s) a += bf2f(*(LAS const bf16*)(lds + ML_K_OFF + s * MV_PITCH + tid * 2)); nst[(size_t)u * 128 + tid] = a; }
        __syncthreads();
    }
}
__device__ __forceinline__ void mlstm_scan(bf16* __restrict__ CT, float* __restrict__ nst, const float* __restrict__ dec, int item, int tid) {
    asm volatile("" : "+v"(tid));
    const int bh = item / 9, part = item % 9;
    if (part < 8) {
        bf16* base = CT + (size_t)bh * 128 * 16384 + (part * 512 + tid) * 4;
        float C[4] = {0.f, 0.f, 0.f, 0.f};
        for (int c0 = 0; c0 < 128; c0 += 16) {
            uint2 w[16];
#pragma unroll
            for (int k = 0; k < 16; ++k) w[k] = *(const uint2*)(base + (size_t)(c0 + k) * 16384);
#pragma unroll
            for (int k = 0; k < 16; ++k) { const float a = dec[bh * 128 + c0 + k];
                uint2 o; o.x = cvtpk(C[0], C[1]); o.y = cvtpk(C[2], C[3]); *(uint2*)(base + (size_t)(c0 + k) * 16384) = o;
                C[0] = fmaf(a, C[0], __builtin_bit_cast(float, w[k].x << 16)); C[1] = fmaf(a, C[1], __builtin_bit_cast(float, w[k].x & 0xffff0000u));
                C[2] = fmaf(a, C[2], __builtin_bit_cast(float, w[k].y << 16)); C[3] = fmaf(a, C[3], __builtin_bit_cast(float, w[k].y & 0xffff0000u)); }
        }
    } else if (tid < 128) {
        float* base = nst + (size_t)bh * 128 * 128 + tid; float C = 0.f;
        for (int c = 0; c < 128; ++c) { const float dC = base[(size_t)c * 128]; base[(size_t)c * 128] = C; C = dec[bh * 128 + c] * C + dC; }
    }
}

__device__ __forceinline__ void mlstm_m3_phase(const bf16* __restrict__ P, const bf16* __restrict__ QK2, const float* __restrict__ G, const float* __restrict__ bif,
                                               const bf16* __restrict__ CT, const float* __restrict__ nst, const float* __restrict__ mnorm, bf16* __restrict__ MIX, int bid, int Gd, int tid, LAS unsigned char* lds) {
    asm volatile("" : "+v"(tid));
    const int lane = tid & 63, wid = __builtin_amdgcn_readfirstlane(tid >> 6), hi = lane >> 5, r32 = lane & 31;
    LAS float* gs = (LAS float*)(lds + ML_G_OFF);
    MlRaw raw;
    if (bid < 2048) ml_load<true>(raw, P, QK2, G, bif, bid, tid);
    for (int u = bid; u < 2048; u += Gd) {
    const int c = u & 127, h = (u >> 7) & 3, b = u >> 9, t0 = c * 64;
    const int tb = wid & 1, eb = wid >> 1, t = 32 * tb + r32;
    bf16x8 cf[8]; uint2 opre[4]; float npv = 0.f;
    { const bf16* ctp = CT + (size_t)u * 16384 + (size_t)(32 * eb + r32) * 128 + hi * 8;
#pragma unroll
      for (int ks = 0; ks < 8; ++ks) cf[ks] = *(const bf16x8*)(ctp + ks * 16);
      const size_t row_ = (size_t)b * SEQ + t0 + t;
#pragma unroll
      for (int gq = 0; gq < 4; ++gq) opre[gq] = *(const uint2*)(P + row_ * DINP + C_MO + h * 128 + 32 * eb + 8 * gq + 4 * hi);
      if (tid >= 128 && tid < 256) npv = nst[(size_t)u * 128 + tid - 128]; }
    if (tid >= 128 && tid < 256) gs[256 + tid - 128] = npv;
    mlstm_gates(raw, tid, gs);
    {
        const int s = tid >> 3;
#pragma unroll
        for (int pass = 0; pass < 2; ++pass) { const int ch = (tid & 7) + 8 * pass;
            *(LAS u32x4v*)(lds + ML_Q_OFF + s * MQ_PITCH + ch * 16) = raw.q[pass];
            *(LAS u32x4v*)(lds + ML_K_OFF + s * MQ_PITCH + ch * 16) = raw.k[pass];
            *(LAS u32x4v*)(lds + ML_V_OFF + s * MV_PITCH + ch * 16) = raw.v[pass]; }
    }
    if (u + Gd < 2048) ml_load<true>(raw, P, QK2, G, bif, u + Gd, tid);
    __syncthreads();
    bf16x8 qf[8];
#pragma unroll
    for (int ks = 0; ks < 8; ++ks) qf[ks] = *(LAS const bf16x8*)(lds + ML_Q_OFF + t * MQ_PITCH + ks * 32 + hi * 16);
    f32x16 ni;
#pragma unroll
    for (int r = 0; r < 16; ++r) ni[r] = zf_();
#pragma unroll
    for (int ks = 0; ks < 8; ++ks) ni = __builtin_amdgcn_mfma_f32_32x32x16_bf16(cf[ks], qf[ks], ni, 0, 0, 0);
    f32x16 p0, p1;
#pragma unroll
    for (int r = 0; r < 16; ++r) { p0[r] = zf_(); p1[r] = p0[r]; }
    { LAS const unsigned char* ka = lds + ML_K_OFF + r32 * MQ_PITCH + hi * 16;
#pragma unroll
      for (int ks = 0; ks < 8; ++ks) { const bf16x8 a0 = *(LAS const bf16x8*)(ka + ks * 32); p0 = __builtin_amdgcn_mfma_f32_32x32x16_bf16(a0, qf[ks], p0, 0, 0, 0); }
      if (tb == 1) {
#pragma unroll
          for (int ks = 0; ks < 8; ++ks) { const bf16x8 a1 = *(LAS const bf16x8*)(ka + 32 * MQ_PITCH + ks * 32); p1 = __builtin_amdgcn_mfma_f32_32x32x16_bf16(a1, qf[ks], p1, 0, 0, 0); } } }
    const float bt = gs[64 + t], Ft = __expf(bt);
    float dsum = 0.f;
#pragma unroll
    for (int r = 0; r < 16; ++r) { const int s0 = crow(r, hi);
        { const float w = (s0 <= t) ? __expf(bt - gs[64 + s0] + gs[128 + s0]) : 0.f; p0[r] *= w; dsum += p0[r]; }
        { const int s1 = s0 + 32; const float w = (s1 <= t) ? __expf(bt - gs[64 + s1] + gs[128 + s1]) : 0.f; p1[r] *= w; dsum += p1[r]; } }
    float qn = 0.f;
#pragma unroll
    for (int ks = 0; ks < 8; ++ks)
#pragma unroll
        for (int j = 0; j < 8; ++j) qn = fmaf(bf2f((bf16)qf[ks][j]), gs[256 + ks * 16 + hi * 8 + j], qn);
    dsum += shx<32>(dsum); qn += shx<32>(qn);
    const float den = dsum + Ft * qn, inv = rcpf_(fmaxf(fabsf(den), 1.f));
    f32x16 na;
#pragma unroll
    for (int r = 0; r < 16; ++r) na[r] = zf_();
    { const int g = lane >> 4, i = lane & 15;
      LAS const unsigned char* trb = lds + ML_V_OFF + (4 * hi + (i >> 2)) * MV_PITCH + (16 * (g & 1) + 4 * (i & 3)) * 2 + eb * 64;
#pragma unroll
      for (int ss = 0; ss < 4; ++ss) { if (ss >= 2 && tb == 0) break;
          unsigned w[4];
#pragma unroll
          for (int e = 0; e < 4; ++e) { const int r = 8 * (ss & 1) + 2 * e; w[e] = (ss < 2) ? cvtpk(p0[r], p0[r + 1]) : cvtpk(p1[r], p1[r + 1]); }
          const u32x4v wv = {w[0], w[1], w[2], w[3]}; const bf16x8 pf = __builtin_bit_cast(bf16x8, wv);
          const s16x4 lo = lds_tr(trb + ss * 16 * MV_PITCH), hi4 = lds_tr(trb + ss * 16 * MV_PITCH + 8 * MV_PITCH);
          const bf16x8 vt = {lo[0], lo[1], lo[2], lo[3], hi4[0], hi4[1], hi4[2], hi4[3]};
          na = __builtin_amdgcn_mfma_f32_32x32x16_bf16(vt, pf, na, 0, 0, 0); } }
    float ssq = 0.f;
#pragma unroll
    for (int r = 0; r < 16; ++r) { na[r] = (na[r] + Ft * ni[r]) * inv; ssq += na[r] * na[r]; }
    ssq += shx<32>(ssq);
    if (hi == 0) gs[384 + eb * 64 + t] = ssq;
    __syncthreads();
    const float rstd = rsqrtf((gs[384 + t] + gs[384 + 64 + t] + gs[384 + 128 + t] + gs[384 + 192 + t]) * (1.f / 128.f) + EPS);
    const size_t row = (size_t)b * SEQ + t0 + t;
#pragma unroll
    for (int gq = 0; gq < 4; ++gq) { const int cc = h * 128 + 32 * eb + 8 * gq + 4 * hi;
        const uint2 ow = opre[gq]; const float4 mn = *(const float4*)(mnorm + cc);
        const float o0 = sigmoidf_(__builtin_bit_cast(float, ow.x << 16)), o1 = sigmoidf_(__builtin_bit_cast(float, ow.x & 0xffff0000u)), o2 = sigmoidf_(__builtin_bit_cast(float, ow.y << 16)), o3 = sigmoidf_(__builtin_bit_cast(float, ow.y & 0xffff0000u));
        uint2 w; w.x = cvtpk(na[4 * gq] * rstd * mn.x * o0, na[4 * gq + 1] * rstd * mn.y * o1); w.y = cvtpk(na[4 * gq + 2] * rstd * mn.z * o2, na[4 * gq + 3] * rstd * mn.w * o3);
        *(uint2*)(MIX + row * DM + cc) = w; }
    __syncthreads();
    }
}


typedef float f32x4v __attribute__((ext_vector_type(4)));
__device__ __forceinline__ void compress_item(const bf16* __restrict__ P, const bf16* __restrict__ w1t  , const float* __restrict__ c1  , const float* __restrict__ w2  ,
                                              const float* __restrict__ kg0, bf16* __restrict__ KVcb, int item, int tid, LAS unsigned char* lds) {
    asm volatile("" : "+v"(tid));
    const int lane = tid & 63, wid = __builtin_amdgcn_readfirstlane(tid >> 6), hi = lane >> 5, r32 = lane & 31;
    const int kv = item >> 6, b = (item >> 4) & 3, i0 = (item & 15) * 32;
    const int cb = wid & 3, kh = wid >> 2;
    const int irow = min(i0 + r32, NCMP - 1);
    const bf16* xa = P + ((size_t)b * SEQ + 16 * irow + 16 * kh) * DINP + (kv ? C_NVC : C_NKC) + hi * 8;
    const bf16* wb = w1t + ((size_t)kv * 128 + 32 * cb + r32) * 2048 + kh * 1024 + hi * 8;
    f32x16 acc;
#pragma unroll
    for (int r = 0; r < 16; ++r) acc[r] = zf_();
    for (int p0 = 0; p0 < 16; p0 += 4) {
        bf16x8 af[16], bfr[16];
#pragma unroll
        for (int q = 0; q < 16; ++q) { const int p = p0 + (q >> 2), dq = q & 3;
            af[q] = *(const bf16x8*)(xa + (size_t)p * DINP + dq * 16); bfr[q] = *(const bf16x8*)(wb + p * 64 + dq * 16); }
#pragma unroll
        for (int q = 0; q < 16; ++q) acc = __builtin_amdgcn_mfma_f32_32x32x16_bf16(af[q], bfr[q], acc, 0, 0, 0);
    }
    LAS float* hid = (LAS float*)lds + kh * 32 * 132;
    { LAS f32x4v* w2s = (LAS f32x4v*)(lds + 2 * 32 * 132 * 4); const f32x4v* w2g = (const f32x4v*)(w2 + (size_t)kv * 128 * 64);
#pragma unroll
      for (int q = 0; q < 4; ++q) w2s[tid + 512 * q] = w2g[tid + 512 * q]; }
#pragma unroll
    for (int r = 0; r < 16; ++r) hid[crow(r, hi) * 132 + 32 * cb + r32] = acc[r];
    __syncthreads();
    {
        const int il = tid >> 4, d0 = (tid & 15) * 4;
        float o[4] = {0.f, 0.f, 0.f, 0.f};
        LAS const float* ha = (LAS const float*)lds + il * 132; LAS const float* hb = ha + 32 * 132;
        LAS const float* wp = (LAS const float*)(lds + 2 * 32 * 132 * 4) + d0;
        const float* cj = c1 + kv * 128;
#pragma unroll 8
        for (int j = 0; j < 128; ++j) { const float a = ha[j] + hb[j] + cj[j]; const float hv = a * rcpf_(1.f + __expf(-a)); const f32x4v wa = *(LAS const f32x4v*)(wp + j * 64);
            o[0] = fmaf(hv, wa[0], o[0]); o[1] = fmaf(hv, wa[1], o[1]); o[2] = fmaf(hv, wa[2], o[2]); o[3] = fmaf(hv, wa[3], o[3]); }
        if (kv == 0) { float ss = o[0] * o[0] + o[1] * o[1] + o[2] * o[2] + o[3] * o[3];
            ss += shx<1>(ss); ss += shx<2>(ss); ss += shx<4>(ss); ss += shx<8>(ss);
            const float rstd = rsqrtf(ss * (1.f / 64.f) + EPS);
#pragma unroll
            for (int e = 0; e < 4; ++e) o[e] *= rstd * kg0[d0 + e]; }
        const int i = i0 + il;
        if (i >= NCMP) { o[0] = o[1] = o[2] = o[3] = 0.f; }
        uint2 w; w.x = cvtpk(o[0], o[1]); w.y = cvtpk(o[2], o[3]);
        *(uint2*)(KVcb + (((size_t)kv * NB + b) * 512 + i) * 64 + d0) = w;
    }
    __syncthreads();
}
__device__ __forceinline__ void cmp_c1_item(const float* __restrict__ pe, const float* __restrict__ w1, float* __restrict__ c1, int item, int tid, LAS unsigned char* lds) {
    const int lk = item >> 4, j0 = (item & 15) * 8, jj = tid & 7, kk = tid >> 3;
    const float* pp = pe + (size_t)lk * 2048; const float* ww = w1 + (size_t)lk * 2048 * 128 + j0 + jj;
    float a = 0.f;
#pragma unroll 8
    for (int k = kk; k < 2048; k += 64) a = fmaf(pp[k], ww[(size_t)k * 128], a);
    LAS float* red = (LAS float*)lds;
    red[tid] = a;
    __syncthreads();
    if (tid < 8) { float s = 0.f; for (int q = 0; q < 64; ++q) s += red[q * 8 + tid]; c1[lk * 128 + j0 + tid] = s; }
    __syncthreads();
}

#define XB_TMO      128
#define XB_XCNT(j)  (256  + 64 * (j))
#define XB_XSUB(j)  (1280 + 64 * (j))
#define XB_XGEN(j)  (2304 + 64 * (j))
#define XB_TOP      3328
#define XB_TOPGEN   3392
#define XCD_BAR_WORDS 3456
#define XB_SPIN_CAP (1u << 22)

__device__ __forceinline__ unsigned xb_ld(unsigned* p)              { return __hip_atomic_load(p, __ATOMIC_RELAXED, __HIP_MEMORY_SCOPE_AGENT); }
__device__ __forceinline__ unsigned xb_add(unsigned* p, unsigned v) { return __hip_atomic_fetch_add(p, v, __ATOMIC_RELAXED, __HIP_MEMORY_SCOPE_AGENT); }
__device__ __forceinline__ unsigned xb_xcc_id() { return (unsigned)__builtin_amdgcn_s_getreg((3 << 11) | 20) & 0xFu; }
#define XB_SPIN(cond, bar) do { unsigned _sp = 0; while (cond) { __builtin_amdgcn_s_sleep(1); \
    if ((++_sp & 255u) == 0u) { if (xb_ld(&(bar)[XB_TMO])) break; if (_sp > XB_SPIN_CAP) { atomicAdd(&(bar)[XB_TMO], 1u); break; } } } } while (0)

struct XcdBarrier {
    unsigned* bar; unsigned x;
    volatile LAS unsigned* st;
};

__device__ __forceinline__ XcdBarrier xcd_barrier_post(unsigned* bar, volatile LAS unsigned* st) {
    XcdBarrier b; b.bar = bar; b.x = xb_xcc_id(); b.st = st;
    if (threadIdx.x == 0) (void)xb_add(&bar[XB_XCNT(b.x)], 1u);
    return b;
}
__device__ __forceinline__ void xcd_barrier_complete(unsigned* bar, unsigned x, unsigned& nloc, unsigned& nx) {
    const unsigned G = gridDim.x * gridDim.y * gridDim.z;
    unsigned sum, cnt, mine, sp = 0u;
    for (;;) {
        sum = 0u; cnt = 0u; mine = 0u;
#pragma unroll
        for (unsigned j = 0; j < 16; ++j) { const unsigned c = xb_ld(&bar[XB_XCNT(j)]); sum += c; cnt += (c > 0u) ? 1u : 0u; mine = (j == x) ? c : mine; }
        if (sum == G) break;
        __builtin_amdgcn_s_sleep(1);
        if ((++sp & 255u) == 0u) { if (xb_ld(&bar[XB_TMO])) break; if (sp > XB_SPIN_CAP) { atomicAdd(&bar[XB_TMO], 1u); break; } }
    }
    nloc = mine > 0u ? mine : 1u; nx = cnt > 0u ? cnt : 1u;
}

__device__ __forceinline__ void xcd_barrier(const XcdBarrier& b) {
    asm volatile("s_waitcnt vmcnt(0)" ::: "memory");
    __syncthreads();
    if (threadIdx.x == 0) {
        unsigned* bar = b.bar;
        __builtin_amdgcn_s_waitcnt(0);
        unsigned nloc = b.st[0], nx = b.st[1];
        if (nloc == 0u) { xcd_barrier_complete(bar, b.x, nloc, nx); b.st[0] = nloc; b.st[1] = nx; }
        const unsigned old = xb_add(&bar[XB_XSUB(b.x)], 1u);
        const unsigned gen = old / nloc;
        if (old + 1u == (gen + 1u) * nloc) {
            __builtin_amdgcn_fence(__ATOMIC_RELEASE, "agent");
            asm volatile("s_waitcnt vmcnt(0)" ::: "memory");
            const unsigned og = xb_add(&bar[XB_TOP], 1u);
            const unsigned tg = og / nx;
            if (og + 1u == (tg + 1u) * nx) xb_add(&bar[XB_TOPGEN], 1u);
            else XB_SPIN(xb_ld(&bar[XB_TOPGEN]) == tg, bar);
            __builtin_amdgcn_fence(__ATOMIC_ACQUIRE, "agent");
            xb_add(&bar[XB_XGEN(b.x)], 1u);
            asm volatile("s_waitcnt vmcnt(0)" ::: "memory");
        } else {
            XB_SPIN(xb_ld(&bar[XB_XGEN(b.x)]) == gen, bar);
            __builtin_amdgcn_fence(__ATOMIC_ACQUIRE, "agent");
            asm volatile("s_waitcnt vmcnt(0)" ::: "memory");
        }
    }
    __syncthreads();
}


constexpr size_t MiB = 1u << 20;
constexpr size_t W_LAYER = (size_t)(DINP + DM + DFF) * DM + (size_t)DM * DFF;
constexpr size_t WS_W = 0;
constexpr size_t WS_HM = 52 * MiB;
constexpr size_t WS_G = 116 * MiB;
constexpr size_t WS_SMALL = 120 * MiB;
constexpr size_t WS_TAB = WS_SMALL, WS_KMEAN = WS_SMALL + 512 * 1024, WS_KVC = WS_SMALL + 1 * MiB, WS_NST = WS_SMALL + 2 * MiB, WS_DEC = WS_SMALL + 3 * MiB, WS_KVCB = WS_SMALL + 3 * MiB + 512 * 1024;
constexpr size_t WS_SSP = 476 * MiB;
constexpr size_t WS_BAR = WS_SMALL + 3 * MiB + 64 * 1024;
constexpr size_t WS_W1T = 50 * MiB, WS_C1 = WS_SMALL + 3 * MiB + 16 * 1024;
constexpr size_t WS_P = 124 * MiB;
constexpr size_t WS_C = 348 * MiB;
constexpr size_t WS_U = WS_P;
constexpr size_t WS_END = 478 * MiB;
static_assert(W_LAYER * 2 * DEPTH <= 50 * MiB && WS_W1T + (size_t)DEPTH * 2 * 128 * 2048 * 2 <= 52 * MiB, "weights");
static_assert((size_t)T * DINP * 2 == 224 * MiB && (size_t)T * DFF * 2 == 256 * MiB, "sizes");

#ifndef DUP_PRO
#define DUP_PRO 1
#endif
#ifndef DUP_QK2
#define DUP_QK2 1
#endif
#ifndef DUP_GEMM
#define DUP_GEMM 1
#endif
#ifndef DUP_M1
#define DUP_M1 1
#endif
#ifndef DUP_MOBA
#define DUP_MOBA 1
#endif
#ifndef DUP_NSA
#define DUP_NSA 1
#endif
#ifndef DUP_M3
#define DUP_M3 1
#endif
#ifndef DUP_CMP
#define DUP_CMP 1
#endif
struct Params { const float* in[16]; float* out; unsigned char* ws; };
static_assert(sizeof(Params) == 18 * 8, "kernarg layout: in[k] at 8k, out at 128, ws at 136");
constexpr int LDS_BYTES = 147456;

__global__ void __launch_bounds__(512, 2) hybrid_fwd(Params prm) {
    extern __shared__ __attribute__((aligned(16))) unsigned char lds[];
    cg::grid_group grid = cg::this_grid();
    constexpr int NPH = 1 + DEPTH * 8;
    volatile LAS unsigned* xst = (volatile LAS unsigned*)((LAS unsigned char*)lds + 131072 + 1024);
    if (threadIdx.x < 2) xst[threadIdx.x] = 0u;
    __syncthreads();
    (void)xcd_barrier_post((unsigned*)(prm.ws + WS_BAR), xst);
    for (int ph = 0; ph < NPH; ++ph) {
        int tid = threadIdx.x; asm volatile("" : "+v"(tid));
        int G = gridDim.x, bid = blockIdx.x; asm volatile("" : "+s"(G), "+s"(bid));
#define PH_LOCALS const int half = tid >> 8, t256 = tid & 255, lane = tid & 63, wid = __builtin_amdgcn_readfirstlane(tid >> 6); unsigned char* smh = lds + half * 65536; \
        const int vb = bid * 2 + half, NVB = G * 2, gwv = bid * 8 + wid, NGW = G * 8; (void)lane; (void)smh; (void)vb; (void)NVB; (void)gwv; (void)NGW; (void)t256;
        const __attribute__((address_space(4))) unsigned char* ka = (const __attribute__((address_space(4))) unsigned char*)__builtin_amdgcn_kernarg_segment_ptr(); asm volatile("" : "+s"(ka));
#define KARG(T_, off) (*(T_ const __attribute__((address_space(4)))*)(ka + (off)))
#define IN(k) KARG(const float*, 8 * (k))
        unsigned char* ws = KARG(unsigned char*, 8 * 17); float* out = KARG(float*, 8 * 16);
        bf16* Wb = (bf16*)(ws + WS_W); bf16* HM = (bf16*)(ws + WS_HM); float* Gt = (float*)(ws + WS_G); float* tab = (float*)(ws + WS_TAB); float* kmean = (float*)(ws + WS_KMEAN);
        float* KVc = (float*)(ws + WS_KVC); float* nst = (float*)(ws + WS_NST); float* dec = (float*)(ws + WS_DEC); bf16* KVcb = (bf16*)(ws + WS_KVCB); bf16* W1t = (bf16*)(ws + WS_W1T); float* C1 = (float*)(ws + WS_C1); bf16* P = (bf16*)(ws + WS_P); bf16* CT = (bf16*)(ws + WS_C); bf16* QK2 = (bf16*)(ws + WS_C + 64 * MiB); bf16* XB = QK2  ; unsigned long long* SSA = (unsigned long long*)(ws + WS_SSP); unsigned long long* SSB = SSA + T;     bf16* U = (bf16*)(ws + WS_U);
        const int l = ph == 0 ? 0 : (ph - 1) / 8, j = ph == 0 ? -1 : (ph - 1) % 8;
        const float* x = IN(0);
        const float* xin = l == 0 ? x : out;
        const bf16* WinT = Wb + l * W_LAYER; const bf16* WoT = WinT + (size_t)DINP * DM; const bf16* W1T = WoT + (size_t)DM * DM; const bf16* W2T = W1T + (size_t)DFF * DM;
        if (ph == 0) {
            PH_LOCALS
            const float* w_in = IN(1); const float* w_out = IN(11); const float* w_ff1 = IN(14); const float* w_ff2 = IN(15);
            for (int rep = 0; rep < DUP_PRO; ++rep) {
            for (int ll = 0; ll < DEPTH; ++ll) {
                bf16* WinT_ = Wb + ll * W_LAYER; bf16* WoT_ = WinT_ + (size_t)DINP * DM; bf16* W1T_ = WoT_ + (size_t)DM * DM; bf16* W2T_ = W1T_ + (size_t)DFF * DM;
                for (int mt = 0; mt < 4; ++mt) {
                    const float* W; int K, N, NP, mode; bf16* WT;
                    const float* gk = nullptr;
                    if (mt == 0) { W = w_in + (size_t)ll * DM * DIN; K = DM; N = DIN; NP = DINP; WT = WinT_; mode = 1; gk = IN(12) + ll * DM; }
                    else if (mt == 1) { W = w_out + (size_t)ll * DM * DM; K = DM; N = DM; NP = DM; WT = WoT_; mode = 0; }
                    else if (mt == 2) { W = w_ff1 + (size_t)ll * DM * DFF; K = DM; N = DFF; NP = DFF; WT = W1T_; mode = 0; gk = IN(13) + ll * DM; }
                    else { W = w_ff2 + (size_t)ll * DFF * DM; K = DFF; N = DM; NP = DM; WT = W2T_; mode = 0; }
                    const int nit = (NP / 64) * (K / 64);
                    for (int it0 = 0; it0 < nit; it0 += NVB) { const int it = it0 + vb; ph_convert_w(W, K, N, NP, WT, mode, it, it < nit, t256, (float*)smh, gk); }
                }
            }
            for (int lk = 0; lk < DEPTH * 2; ++lk) {
                const int nit = 2 * 32;
                for (int it0 = 0; it0 < nit; it0 += NVB) { const int it = it0 + vb; ph_convert_w(IN(9) + (size_t)lk * 2048 * 128, 2048, 128, 128, W1t + (size_t)lk * 128 * 2048, 0, it, it < nit, t256, (float*)smh); }
            }
            for (int it = bid; it < 64; it += G) cmp_c1_item(IN(8), IN(9), C1, it, tid, (LAS unsigned char*)lds);
            for (int i = bid * 512 + tid; i < SEQ * 8; i += G * 512) { const int pos = i >> 3, f = i & 7;
                float c_, s_; rope_cs(pos, f, c_, s_);
                tab[pos * 16 + f] = c_; tab[pos * 16 + 8 + f] = s_; }
            for (int row = gwv; row < T; row += 2 * NGW) { ph_x_row(x, XB, SSA, row, lane); if (row + NGW < T) ph_x_row(x, XB, SSA, row + NGW, lane); }
            }
        } else if (j == 0 || j >= 5) {
            pg8::Gemm g; pg8::EpiAny E; int N; const bool last = (l + 1 == DEPTH);
            if (j == 0) { g = pg8::Gemm{XB, WinT, T, DINP, DM}; N = DINP; E = pg8::EpiAny{0, true, P, DINP, Gt, C_GATE, nullptr, nullptr, nullptr, SSA}; }
            else if (j == 5) { g = pg8::Gemm{HM, WoT, T, DM, DM}; N = DM; E = pg8::EpiAny{2, false, nullptr, DM, nullptr, 0, xin, out, XB, SSB}; }
            else if (j == 6) { g = pg8::Gemm{XB, W1T, T, DFF, DM}; N = DFF; E = pg8::EpiAny{1, true, U, DFF, nullptr, 0, nullptr, nullptr, nullptr, SSB}; }
            else { g = pg8::Gemm{U, W2T, T, DM, DFF}; N = DM; E = pg8::EpiAny{2, false, nullptr, DM, nullptr, 0, out, out, last ? nullptr : XB, SSA}; }
            pg8::StaticOrder S; S.init(T, N, G, bid);
            for (int rep = 0; rep < ((j == 0 || j == 6) ? DUP_GEMM : 1); ++rep) pg8::gemm_phase<pg8::EpiAny, pg8::StaticOrder, true, true>((PG8_LAS unsigned char*)lds, g, S, E, tid);
        } else if (j == 1) {
            PH_LOCALS
            for (int rep = 0; rep < DUP_CMP; ++rep) for (int it = bid; it < 128; it += G) compress_item(P, W1t + (size_t)l * 2 * 128 * 2048, C1 + l * 256, IN(10) + (size_t)l * 2 * 128 * 64, IN(7) + l * 192, KVcb, it, tid, (LAS unsigned char*)lds);
            for (int it0 = 0; it0 < 128 * 14; it0 += NVB) { const int it = it0 + vb; ph_prep(P, tab, IN(5) + l * 128, IN(6) + l * 64, IN(7) + l * 192, kmean, it, it < 128 * 14, t256, (float*)smh); }
            for (int rep = 0; rep < DUP_QK2; ++rep) qk2_rows(P, IN(3) + (size_t)l * 4 * 1024, QK2, bid, G, tid);
            { unsigned long long z64 = 0ull; asm volatile("" : "+v"(z64)); for (int i = bid * 512 + tid; i < 2 * T; i += G * 512) SSA[i] = z64; }
        } else if (j == 2) {
            for (int rep = 0; rep < DUP_M1; ++rep) mlstm_m1_phase(P, QK2, Gt, IN(2) + l * 8, CT, nst, dec, bid, G, tid, (LAS unsigned char*)lds);
            for (int rep = 0; rep < DUP_MOBA; ++rep) for (int pu = bid; pu < 256; pu += G) { const int bh = pu >> 4, s = pu & 15;
                moba_unit(P, kmean, IN(5) + l * 128 + 64, HM, bh >> 2, bh & 3, 31 - s, tid, (LAS unsigned char*)lds); moba_unit(P, kmean, IN(5) + l * 128 + 64, HM, bh >> 2, bh & 3, s, tid, (LAS unsigned char*)lds); }
        } else if (j == 3) {
            for (int it = bid; it < 16 * 9; it += G) mlstm_scan(CT, nst, dec, it, tid);
            for (int rep = 0; rep < DUP_NSA; ++rep) for (int pu = bid; pu < 256; pu += G) { const int b_ = pu >> 6, s = pu & 63;
                nsa_unit(P, Gt, tab, KVcb, IN(7) + l * 192, HM, b_, 127 - s, tid, (LAS unsigned char*)lds); nsa_unit(P, Gt, tab, KVcb, IN(7) + l * 192, HM, b_, s, tid, (LAS unsigned char*)lds); }
        } else {
            for (int rep = 0; rep < DUP_M3; ++rep) mlstm_m3_phase(P, QK2, Gt, IN(2) + l * 8, CT, nst, IN(4) + l * 512, HM, bid, G, tid, (LAS unsigned char*)lds);
        }
        if (ph + 1 < NPH) { if (ph == 0) grid.sync(); else { XcdBarrier xbar; xbar.bar = (unsigned*)(ws + WS_BAR); xbar.x = xb_xcc_id(); xbar.st = xst; xcd_barrier(xbar); } }
    }
#undef IN
#undef KARG
#undef PH_LOCALS
}

extern "C" void kernel_launch(void* const* d_in, const int* in_sizes, int n_in, void* d_out, int out_size, void* d_ws, size_t ws_size, hipStream_t stream) {
    static int grid = 0;
    if (grid == 0) {
        if (n_in != 16 || in_sizes[0] != T * DM || out_size != T * DM || ws_size < WS_END) { fprintf(stderr, "kernel_launch: unexpected shapes / workspace %zu < %zu\n", ws_size, (size_t)WS_END); grid = -1; return; }
        int dev = 0, cus = 0, per_cu = 0;
        if (hipGetDevice(&dev) != hipSuccess || hipDeviceGetAttribute(&cus, hipDeviceAttributeMultiprocessorCount, dev) != hipSuccess) { grid = -1; return; }
        if (hipFuncSetAttribute((const void*)hybrid_fwd, hipFuncAttributeMaxDynamicSharedMemorySize, LDS_BYTES) != hipSuccess) { fprintf(stderr, "kernel_launch: hipFuncSetAttribute failed\n"); grid = -1; return; }
        if (hipOccupancyMaxActiveBlocksPerMultiprocessor(&per_cu, (const void*)hybrid_fwd, 512, LDS_BYTES) != hipSuccess || per_cu < 1) { fprintf(stderr, "kernel_launch: occupancy query failed (%d)\n", per_cu); grid = -1; return; }
        grid = cus * per_cu;
        fprintf(stderr, "kernel_launch: grid %d (%d CUs x %d)\n", grid, cus, per_cu);
    }
    if (grid < 0) return;
    if (hipMemsetAsync((char*)d_ws + WS_BAR, 0, XCD_BAR_WORDS * 4, stream) != hipSuccess) { fprintf(stderr, "kernel_launch: memset failed\n"); return; }
    Params p{};
    for (int i = 0; i < 16; ++i) p.in[i] = (const float*)d_in[i];
    p.out = (float*)d_out; p.ws = (unsigned char*)d_ws;
    void* args[] = {&p};
    hipError_t e = hipLaunchCooperativeKernel((const void*)hybrid_fwd, dim3(grid), dim3(512), args, LDS_BYTES, stream);
    if (e != hipSuccess) fprintf(stderr, "kernel_launch: cooperative launch failed: %s (grid %d)\n", hipGetErrorString(e), grid);
}
```

```cpp
#include <hip/hip_runtime.h>
#include <hip/hip_cooperative_groups.h>
#include <cstdio>
#include <cstdint>
namespace cg = cooperative_groups;
namespace pg8 {
#define PG8_LAS __attribute__((address_space(3)))
typedef unsigned short bf16_t;
typedef short bf16x8 __attribute__((ext_vector_type(8)));
typedef float f32x4 __attribute__((ext_vector_type(4)));
typedef unsigned u32x4 __attribute__((ext_vector_type(4)));
constexpr int BM = 256, BK = 64, HALF = 128, HTB = HALF * BK * 2  , STAGE_BYTES = 8 * HTB, NXCD = 8, WGM = 8;

__host__ __device__ __forceinline__ int lds_byte(int r, int c) { const int st = (r >> 4) * 2 + (c >> 5), rr = r & 15, cc = c & 31, ob = rr * 64 + cc * 2; return st * 1024 + (ob ^ (((ob >> 9) & 1) << 5)); }
__host__ __device__ __forceinline__ void stage_rc(int b, int& R, int& C) { const int st = b / 1024, sb = b % 1024, swz = sb ^ (((sb >> 9) & 1) << 5); R = (st >> 1) * 16 + swz / 64; C = (st & 1) * 32 + (swz % 64) / 2; }
__host__ __device__ __forceinline__ int perm32(int rho) { const int n = rho >> 4, i = rho & 15; return 8 * (i >> 2) + 4 * n + (i & 3); }

struct Unit { int pm, pn; };
struct Gemm { const bf16_t* A; const bf16_t* Bt; int M, N, K; };

struct StaticOrder {
    int nM, nN, nwg, G, c;
    __host__ __device__ void init(int M, int N, int G_, int c_) { nM = M / BM; nN = N / BM; nwg = nM * nN; G = G_; c = c_; }
    __host__ __device__ bool next(int i, Unit& u) const {
        const long L = (long)i * G + c; if (L >= nwg) return false;
        int wgid = (int)L; { const int q = nwg / NXCD, r = nwg % NXCD, xcd = wgid % NXCD, off = wgid / NXCD; wgid = (xcd < r ? xcd * (q + 1) : r * (q + 1) + (xcd - r) * q) + off; }
        const int nig = WGM * nN, gid = wgid / nig, fm = gid * WGM, gsz = (nM - fm) < WGM ? (nM - fm) : WGM;
        u.pm = fm + ((wgid % nig) % gsz); u.pn = (wgid % nig) / gsz; return true;
    }
    __device__ __forceinline__ void a_ready(const Unit&) const {}
    __device__ __forceinline__ void done(const Unit&) const {}
};

__device__ __forceinline__ unsigned f2bf_u(float f) { unsigned u = __builtin_bit_cast(unsigned, f); return (u + 0x7fffu + ((u >> 16) & 1u)) >> 16; }
__device__ __forceinline__ unsigned pk2bf(float lo, float hi) { return f2bf_u(lo) | (f2bf_u(hi) << 16); }

__device__ __forceinline__ unsigned cvtpk_bf16(float lo, float hi) { typedef float f2_ __attribute__((ext_vector_type(2))); typedef __bf16 b2_ __attribute__((ext_vector_type(2)));
    f2_ v = {lo, hi}; b2_ b = __builtin_convertvector(v, b2_); return __builtin_bit_cast(unsigned, b); }
__device__ __forceinline__ float swz_xor16(float v) { return __uint_as_float((unsigned)__builtin_amdgcn_ds_swizzle((int)__float_as_uint(v), 0x1F | (16 << 10))); }
__device__ __forceinline__ float half_sum(float v) { auto rr = __builtin_amdgcn_permlane32_swap(__float_as_uint(v), __float_as_uint(v), false, false); return __uint_as_float(rr[0]) + __uint_as_float(rr[1]); }
__device__ __forceinline__ float row_rstd(const unsigned long long* ssq, int row) { return __builtin_amdgcn_rsqf((float)ssq[row] * (1.0f / (1048576.0f * 1024.0f)) + 1e-6f); }

struct EpiProj {
    static constexpr bool PERM = true, AFTER_DRAIN = false;
    bf16_t* O; int ldc; float* gates; int gate0; const unsigned long long* ssp;
    __device__ __forceinline__ void operator()(const f32x4 (&acc)[2][2][4][2], const Unit& u, int wr, int wc, int fr, int fq) const {
        const int row0 = u.pm * BM + wr * 64 + fr; const int col0 = u.pn * BM + wc * 32 + 8 * fq;
        float rsv[2][4];
#pragma unroll
        for (int ai = 0; ai < 2; ++ai)
#pragma unroll
            for (int m = 0; m < 4; ++m) rsv[ai][m] = row_rstd(ssp, row0 + ai * HALF + m * 16);
#pragma unroll
        for (int ai = 0; ai < 2; ++ai)
#pragma unroll
            for (int m = 0; m < 4; ++m) { const int row = row0 + ai * HALF + m * 16; bf16_t* rowp = O + (size_t)row * ldc + col0; const float rs = rsv[ai][m];
#pragma unroll
                for (int bj = 0; bj < 2; ++bj) { const f32x4 v0 = acc[ai][bj][m][0] * rs, v1 = acc[ai][bj][m][1] * rs;
                    u32x4 w; w.x = cvtpk_bf16(v0[0], v0[1]); w.y = cvtpk_bf16(v0[2], v0[3]); w.z = cvtpk_bf16(v1[0], v1[1]); w.w = cvtpk_bf16(v1[2], v1[3]);
                    *(u32x4*)(rowp + bj * HALF) = w;
                    const int c = col0 + bj * HALF - gate0;
                    if (c >= 0 && c < 32) { float* g = gates + (size_t)row * 32 + c; *(f32x4*)g = v0; *(f32x4*)(g + 4) = v1; } } }
    }
};
struct EpiRelu2 {
    static constexpr bool PERM = true, AFTER_DRAIN = false;
    bf16_t* O; int ldc; const unsigned long long* ssp;
    __device__ __forceinline__ void operator()(const f32x4 (&acc)[2][2][4][2], const Unit& u, int wr, int wc, int fr, int fq) const {
        const int row0 = u.pm * BM + wr * 64 + fr; const int col0 = u.pn * BM + wc * 32 + 8 * fq;
        float rsv[2][4];
#pragma unroll
        for (int ai = 0; ai < 2; ++ai)
#pragma unroll
            for (int m = 0; m < 4; ++m) rsv[ai][m] = row_rstd(ssp, row0 + ai * HALF + m * 16);
#pragma unroll
        for (int ai = 0; ai < 2; ++ai)
#pragma unroll
            for (int m = 0; m < 4; ++m) { const int row = row0 + ai * HALF + m * 16; bf16_t* rowp = O + (size_t)row * ldc + col0; const float rs = rsv[ai][m];
#pragma unroll
                for (int bj = 0; bj < 2; ++bj) { f32x4 v0 = acc[ai][bj][m][0] * rs, v1 = acc[ai][bj][m][1] * rs;
#pragma unroll
                    for (int e = 0; e < 4; ++e) { float a = v0[e] > 0.f ? v0[e] : 0.f; v0[e] = a * a; float b = v1[e] > 0.f ? v1[e] : 0.f; v1[e] = b * b; }
                    u32x4 w; w.x = cvtpk_bf16(v0[0], v0[1]); w.y = cvtpk_bf16(v0[2], v0[3]); w.z = cvtpk_bf16(v1[0], v1[1]); w.w = cvtpk_bf16(v1[2], v1[3]);
                    *(u32x4*)(rowp + bj * HALF) = w; } }
    }
};
struct EpiResid {
    static constexpr bool PERM = false, AFTER_DRAIN = false;
    const float* base; float* out; int ldc; bf16_t* xb; unsigned long long* ssp;
    __device__ __forceinline__ void operator()(const f32x4 (&acc)[2][2][4][2], const Unit& u, int wr, int wc, int fr, int fq) const {
        const int row0 = u.pm * BM + wr * 64 + fr; const int col0 = u.pn * BM + wc * 32 + 4 * fq;
#pragma unroll
        for (int ai = 0; ai < 2; ++ai)
#pragma unroll
            for (int m = 0; m < 4; ++m) { const int row = row0 + ai * HALF + m * 16; const size_t off = (size_t)row * ldc + col0; float ss = 0.f;
#pragma unroll
                for (int bj = 0; bj < 2; ++bj)
#pragma unroll
                    for (int n = 0; n < 2; ++n) { const size_t o = off + bj * HALF + n * 16; const f32x4 b = *(const f32x4*)(base + o); const f32x4 v = b + acc[ai][bj][m][n]; *(f32x4*)(out + o) = v;
                        if (xb) { ss += (v[0] * v[0] + v[1] * v[1]) + (v[2] * v[2] + v[3] * v[3]); typedef unsigned u32x2_ __attribute__((ext_vector_type(2)));
                            u32x2_ w; w.x = cvtpk_bf16(v[0], v[1]); w.y = cvtpk_bf16(v[2], v[3]); *(u32x2_*)(xb + o) = w; } }
                if (xb) { ss += swz_xor16(ss); ss = half_sum(ss); if (fq == 0) atomicAdd(ssp + row, (unsigned long long)(ss * 1048576.0f + 0.5f)); } }
    }
};

struct EpiAny {
    static constexpr bool AFTER_DRAIN = false;
    int kind; bool perm;
    bf16_t* O; int ldc; float* gates; int gate0; const float* base; float* out; bf16_t* xb; unsigned long long* ssp;
    __device__ __forceinline__ void operator()(const f32x4 (&acc)[2][2][4][2], const Unit& u, int wr, int wc, int fr, int fq) const {
        if (kind == 0) { EpiProj e{O, ldc, gates, gate0, ssp}; e(acc, u, wr, wc, fr, fq); }
        else if (kind == 1) { EpiRelu2 e{O, ldc, ssp}; e(acc, u, wr, wc, fr, fq); }
        else { EpiResid e{base, out, ldc, xb, ssp}; e(acc, u, wr, wc, fr, fq); }
    }
};
template <class Epi, class Sched, bool ALIGN_EPI = false, bool SP2 = false>
__device__ __forceinline__ void gemm_phase(PG8_LAS unsigned char* lds, const Gemm g, const Sched& S, const Epi& E, const int tid) {
    const int wid = __builtin_amdgcn_readfirstlane(tid >> 6), lane = tid & 63, wr = wid >> 2, wc = wid & 3, fr = lane & 15, fq = lane >> 4;
    const int K = g.K, nt = K / BK;
    unsigned voffA[2], voffB[2];
#pragma unroll
    for (int i = 0; i < 2; ++i) { int R, C; stage_rc(tid * 16 + i * 8192, R, C); const int Rb = E.perm ? ((R & ~31) + perm32(R & 31)) : R;
        voffA[i] = (unsigned)(R * K + C) * 2u; voffB[i] = (unsigned)(Rb * K + C) * 2u; }
    const size_t kstep = (size_t)(BK * 2);
    const size_t hstep = (size_t)HALF * K * 2;
    const size_t tstep = 2 * hstep;
    const unsigned ldsw = (unsigned)wid * 1024u;
    const int aoff = lds_byte(wr * 64 + fr, fq * 8), boff = lds_byte(wc * 32 + fr, fq * 8);
#define PG8_SA(b, h) (((b) * 2 + (h)) * HTB)
#define PG8_SB(b, h) ((4 + (b) * 2 + (h)) * HTB)
#define PG8_STAGE(bufoff, gbase, voff) do { _Pragma("unroll") for (int _i = 0; _i < 2; ++_i) \
        __builtin_amdgcn_global_load_lds((const unsigned*)((const char*)(gbase) + (voff)[_i]), (PG8_LAS unsigned*)(lds + (bufoff) + ldsw + _i * 8192), 16, 0, 0); } while (0)
#define PG8_LDA(dst, b, h) do { _Pragma("unroll") for (int m = 0; m < 4; ++m) _Pragma("unroll") for (int k = 0; k < 2; ++k) dst[m][k] = *(const PG8_LAS bf16x8*)(lds + PG8_SA(b, h) + aoff + m * 2048 + k * 1024); } while (0)
#define PG8_LDB(dst, b, h) do { _Pragma("unroll") for (int n = 0; n < 2; ++n) _Pragma("unroll") for (int k = 0; k < 2; ++k) dst[n][k] = *(const PG8_LAS bf16x8*)(lds + PG8_SB(b, h) + boff + n * 2048 + k * 1024); } while (0)
#define PG8_MMA(ai, bj, At, Bt) do { __builtin_amdgcn_s_setprio(1); _Pragma("unroll") for (int m = 0; m < 4; ++m) _Pragma("unroll") for (int n = 0; n < 2; ++n) _Pragma("unroll") for (int k = 0; k < 2; ++k) \
        acc[ai][bj][m][n] = __builtin_amdgcn_mfma_f32_16x16x32_bf16(Bt[n][k], At[m][k], acc[ai][bj][m][n], 0, 0, 0); __builtin_amdgcn_s_setprio(0); } while (0)
#define PG8_WAIT_V(n) asm volatile("s_waitcnt vmcnt(" #n ")" ::: "memory")
#define PG8_WAIT_L(n) asm volatile("s_waitcnt lgkmcnt(" #n ")" ::: "memory")
#define PG8_BAR __builtin_amdgcn_s_barrier()
#define PG8_SCHED __builtin_amdgcn_sched_barrier(0)
    Unit cur, nxt; int ui = 0;
    if (!S.next(0, cur)) return;
    f32x4 acc[2][2][4][2];
#pragma unroll
    for (int a = 0; a < 2; ++a)
#pragma unroll
        for (int b = 0; b < 2; ++b)
#pragma unroll
            for (int m = 0; m < 4; ++m)
#pragma unroll
                for (int n = 0; n < 2; ++n) acc[a][b][m][n] = (f32x4){0.f, 0.f, 0.f, 0.f};
    bf16x8 At[4][2], B0[2][2], B1[2][2];
    const char* cA = (const char*)g.A + (size_t)cur.pm * tstep; const char* cB = (const char*)g.Bt + (size_t)cur.pn * tstep;
    S.a_ready(cur);
    if constexpr (SP2) {
        PG8_STAGE(PG8_SB(0, 0), cB, voffB); PG8_STAGE(PG8_SB(0, 1), cB + hstep, voffB); PG8_STAGE(PG8_SA(0, 0), cA, voffA); PG8_STAGE(PG8_SA(0, 1), cA + hstep, voffA);
        if (wr == 1) PG8_BAR;
        PG8_WAIT_V(2); PG8_BAR;
        PG8_STAGE(PG8_SB(1, 0), cB + kstep, voffB); PG8_STAGE(PG8_SA(1, 0), cA + kstep, voffA); PG8_STAGE(PG8_SB(1, 1), cB + hstep + kstep, voffB);
        PG8_WAIT_V(6); PG8_BAR;
    } else {
        PG8_STAGE(PG8_SB(0, 0), cB, voffB); PG8_STAGE(PG8_SA(0, 0), cA, voffA); PG8_STAGE(PG8_SB(0, 1), cB + hstep, voffB); PG8_STAGE(PG8_SA(0, 1), cA + hstep, voffA);
        if (wr == 1) PG8_BAR;
        PG8_WAIT_V(4); PG8_BAR;
        PG8_STAGE(PG8_SB(1, 0), cB + kstep, voffB); PG8_STAGE(PG8_SA(1, 0), cA + kstep, voffA); PG8_STAGE(PG8_SB(1, 1), cB + hstep + kstep, voffB);
        PG8_WAIT_V(6); PG8_BAR;
    }
    for (;;) {
        const bool has_next = S.next(ui + 1, nxt);
        const char* nA = has_next ? (const char*)g.A + (size_t)nxt.pm * tstep : cA; const char* nB = has_next ? (const char*)g.Bt + (size_t)nxt.pn * tstep : cB;
        for (int t = 0; t < nt; t += 2) {
            const bool last = (t == nt - 2);
            const char* a1 = cA + (size_t)(t + 1) * kstep;
            const char* a2 = last ? nA : cA + (size_t)(t + 2) * kstep; const char* b2 = last ? nB : cB + (size_t)(t + 2) * kstep;
            const char* a3 = a2 + kstep; const char* b3 = b2 + kstep;
            if (last && has_next) S.a_ready(nxt);
            if constexpr (SP2) {
            PG8_LDB(B0, 0, 0); PG8_LDB(B1, 0, 1); PG8_SCHED; PG8_LDA(At, 0, 0); PG8_STAGE(PG8_SA(1, 1), a1 + hstep, voffA);
            PG8_WAIT_V(8); PG8_WAIT_L(0); PG8_BAR; PG8_MMA(0, 0, At, B0); PG8_MMA(0, 1, At, B1); PG8_BAR; PG8_SCHED;
            PG8_LDA(At, 0, 1); PG8_STAGE(PG8_SB(0, 0), b2, voffB); PG8_STAGE(PG8_SB(0, 1), b2 + hstep, voffB); PG8_STAGE(PG8_SA(0, 0), a2, voffA);
            PG8_WAIT_V(8); PG8_WAIT_L(0); PG8_BAR; PG8_MMA(1, 0, At, B0); PG8_MMA(1, 1, At, B1); PG8_BAR; PG8_SCHED;
            PG8_LDB(B0, 1, 0); PG8_LDB(B1, 1, 1); PG8_SCHED; PG8_LDA(At, 1, 0); PG8_STAGE(PG8_SA(0, 1), a2 + hstep, voffA);
            PG8_WAIT_V(8); PG8_WAIT_L(0); PG8_BAR; PG8_MMA(0, 0, At, B0); PG8_MMA(0, 1, At, B1); PG8_BAR; PG8_SCHED;
            PG8_LDA(At, 1, 1); PG8_STAGE(PG8_SB(1, 0), b3, voffB); PG8_STAGE(PG8_SB(1, 1), b3 + hstep, voffB); PG8_STAGE(PG8_SA(1, 0), a3, voffA);
            PG8_WAIT_V(8); PG8_WAIT_L(0); PG8_BAR; PG8_MMA(1, 0, At, B0); PG8_MMA(1, 1, At, B1); PG8_BAR; PG8_SCHED;
            } else {
            PG8_LDB(B0, 0, 0); PG8_SCHED; PG8_LDA(At, 0, 0); PG8_STAGE(PG8_SA(1, 1), a1 + hstep, voffA);
            PG8_WAIT_L(8); PG8_BAR; PG8_WAIT_L(0); PG8_MMA(0, 0, At, B0); PG8_BAR; PG8_SCHED;
            PG8_LDB(B1, 0, 1); PG8_STAGE(PG8_SB(0, 0), b2, voffB);
            PG8_BAR; PG8_WAIT_L(0); PG8_MMA(0, 1, At, B1); PG8_BAR;
            PG8_LDA(At, 0, 1); PG8_STAGE(PG8_SA(0, 0), a2, voffA);
            PG8_BAR; PG8_WAIT_L(0); PG8_MMA(1, 0, At, B0); PG8_BAR; PG8_SCHED;
            PG8_STAGE(PG8_SB(0, 1), b2 + hstep, voffB);
            PG8_WAIT_V(6); PG8_BAR; PG8_MMA(1, 1, At, B1); PG8_BAR;
            PG8_LDB(B0, 1, 0); PG8_SCHED; PG8_LDA(At, 1, 0); PG8_STAGE(PG8_SA(0, 1), a2 + hstep, voffA);
            PG8_WAIT_L(8); PG8_BAR; PG8_WAIT_L(0); PG8_MMA(0, 0, At, B0); PG8_BAR; PG8_SCHED;
            PG8_LDB(B1, 1, 1); PG8_STAGE(PG8_SB(1, 0), b3, voffB);
            PG8_BAR; PG8_WAIT_L(0); PG8_MMA(0, 1, At, B1); PG8_BAR;
            PG8_LDA(At, 1, 1); PG8_STAGE(PG8_SA(1, 0), a3, voffA);
            PG8_BAR; PG8_WAIT_L(0); PG8_MMA(1, 0, At, B0); PG8_BAR; PG8_SCHED;
            PG8_STAGE(PG8_SB(1, 1), b3 + hstep, voffB);
            PG8_WAIT_V(6); PG8_BAR; PG8_MMA(1, 1, At, B1); PG8_BAR;
            }
        }
        if constexpr (ALIGN_EPI) { if (wr == 0) PG8_BAR; }
        if constexpr (!Epi::AFTER_DRAIN) { E(acc, cur, wr, wc, fr, fq); S.done(cur); }
        if (!has_next) break;
#pragma unroll
        for (int a = 0; a < 2; ++a)
#pragma unroll
            for (int b = 0; b < 2; ++b)
#pragma unroll
                for (int m = 0; m < 4; ++m)
#pragma unroll
                    for (int n = 0; n < 2; ++n) acc[a][b][m][n] = (f32x4){0.f, 0.f, 0.f, 0.f};
        cur = nxt; cA = nA; cB = nB; ++ui;
        if constexpr (ALIGN_EPI) { if (wr == 1) PG8_BAR; }
    }
    PG8_WAIT_V(0);
    if constexpr (!ALIGN_EPI) { if (wr == 0) PG8_BAR; }
    PG8_BAR;
    if constexpr (Epi::AFTER_DRAIN) { E.fused(acc, cur, wr, wc, fr, fq, lds, wid, lane); S.done(cur); }
#undef PG8_SA
#undef PG8_SB
#undef PG8_STAGE
#undef PG8_LDA
#undef PG8_LDB
#undef PG8_MMA
#undef PG8_WAIT_V
#undef PG8_WAIT_L
#undef PG8_BAR
#undef PG8_SCHED
}
}

typedef unsigned short bf16;
constexpr int NB = 4, SEQ = 8192, T = NB * SEQ, DM = 1024, DFF = 4096, DEPTH = 2;
constexpr int DIN = 3476, DINP = 3584;
constexpr int C_MQ = 0, C_MK = 512, C_MV = 1024, C_MO = 1536, C_BQ = 2048, C_BK = 2304, C_BV = 2560, C_NQ = 2816,
              C_NKC = 3072, C_NVC = 3136, C_NKS = 3200, C_NVS = 3264, C_NKW = 3328, C_NVW = 3392, C_GATE = 3456;
constexpr int NCMP = 511;
constexpr float EPS = 1e-6f;

__device__ __forceinline__ float bf2f(bf16 v) { return __builtin_bit_cast(float, (unsigned)v << 16); }
__device__ __forceinline__ bf16 f2bf(float f) { return (bf16)pg8::f2bf_u(f); }
template <int MASK> __device__ __forceinline__ float shx(float v) {
    if constexpr (MASK == 32) { auto rr = __builtin_amdgcn_permlane32_swap(__float_as_uint(v), __float_as_uint(v), false, false);
        return __uint_as_float(__builtin_amdgcn_mbcnt_lo(~0u, 0u) == 32u ? rr[0] : rr[1]); }
    else return __uint_as_float((unsigned)__builtin_amdgcn_ds_swizzle((int)__float_as_uint(v), 0x1F | (MASK << 10)));
}
__device__ __forceinline__ float xchg32(float v, int hi) { auto rr = __builtin_amdgcn_permlane32_swap(__float_as_uint(v), __float_as_uint(v), false, false); return __uint_as_float(hi ? rr[0] : rr[1]); }
__device__ __forceinline__ float hsum32(float v) { auto rr = __builtin_amdgcn_permlane32_swap(__float_as_uint(v), __float_as_uint(v), false, false); return __uint_as_float(rr[0]) + __uint_as_float(rr[1]); }
__device__ __forceinline__ float hmax32(float v) { auto rr = __builtin_amdgcn_permlane32_swap(__float_as_uint(v), __float_as_uint(v), false, false); return fmaxf(__uint_as_float(rr[0]), __uint_as_float(rr[1])); }
template <int MASK> __device__ __forceinline__ unsigned shxu(unsigned v) { return __float_as_uint(shx<MASK>(__uint_as_float(v))); }
__device__ __forceinline__ float wave_sum(float v) {
    v += shx<1>(v); v += shx<2>(v); v += shx<4>(v); v += shx<8>(v); v += shx<16>(v);
    auto rr = __builtin_amdgcn_permlane32_swap(__float_as_uint(v), __float_as_uint(v), false, false); return __uint_as_float(rr[0]) + __uint_as_float(rr[1]);
}
__device__ __forceinline__ float wave_max(float v) {
    v = fmaxf(v, shx<1>(v)); v = fmaxf(v, shx<2>(v)); v = fmaxf(v, shx<4>(v)); v = fmaxf(v, shx<8>(v)); v = fmaxf(v, shx<16>(v));
    auto rr = __builtin_amdgcn_permlane32_swap(__float_as_uint(v), __float_as_uint(v), false, false); return fmaxf(__uint_as_float(rr[0]), __uint_as_float(rr[1]));
}
__device__ __forceinline__ float sgprf(float c) { asm volatile("" : "+s"(c)); return c; }
#define nbg (sgprf(-1e30f))
__device__ __forceinline__ int mk_tid(int wave_s) { int t; asm volatile("v_mbcnt_lo_u32_b32 %0, -1, 0\n\tv_mbcnt_hi_u32_b32 %0, -1, %0" : "=v"(t)); return t + wave_s * 64; }
__device__ __forceinline__ float zf_() { float z = 0.f; asm volatile("" : "+v"(z)); return z; }
__device__ __forceinline__ float rcpf_(float x) { return __builtin_amdgcn_rcpf(x); }
__device__ __forceinline__ float sigmoidf_(float x) { return rcpf_(1.f + __expf(-x)); }
__device__ __forceinline__ float log_sigmoidf_(float x) { return fminf(x, 0.f) - __logf(1.f + __expf(-fabsf(x))); }
__device__ __forceinline__ void rope_cs(int pos, int f, float& c, float& s) {
    const float invf = f == 0 ? 1.0f : f == 1 ? 0.193922758102417f : f == 2 ? 0.03760603442788124f : f == 3 ? 0.007292666472494602f : f == 4 ? 0.0014142136787995696f
                     : f == 5 ? 0.00027424818836152554f : f == 6 ? 5.318298644851893e-05f : 1.031338433676865e-05f;
    const float ang = (float)pos * invf;
    const float k = rintf(ang * 0.15915493667125702f);
    float r = fmaf(-k, 6.2831854820251465f, ang); r = fmaf(-k, -1.7484555314695172e-07f, r);
    c = __cosf(r); s = __sinf(r);
}


__device__ __forceinline__ float dot64(const bf16* __restrict__ kp, const float* q) {
    const uint4* k4 = (const uint4*)kp; float a = 0.f;
#pragma unroll
    for (int j = 0; j < 8; ++j) { const uint4 w = k4[j]; const unsigned ww[4] = {w.x, w.y, w.z, w.w};
#pragma unroll
        for (int e = 0; e < 4; ++e) { a = fmaf(q[8 * j + 2 * e], __builtin_bit_cast(float, ww[e] << 16), a); a = fmaf(q[8 * j + 2 * e + 1], __builtin_bit_cast(float, ww[e] & 0xffff0000u), a); } }
    return a;
}
__device__ __forceinline__ void dot64x4(const bf16* __restrict__ kp, const float (*q)[64], float (&a)[4]) {
    const uint4* k4 = (const uint4*)kp; a[0] = a[1] = a[2] = a[3] = 0.f;
#pragma unroll
    for (int j = 0; j < 8; ++j) { const uint4 w = k4[j]; const unsigned ww[4] = {w.x, w.y, w.z, w.w};
#pragma unroll
        for (int e = 0; e < 4; ++e) { const float k0 = __builtin_bit_cast(float, ww[e] << 16), k1 = __builtin_bit_cast(float, ww[e] & 0xffff0000u);
#pragma unroll
            for (int h = 0; h < 4; ++h) { a[h] = fmaf(q[h][8 * j + 2 * e], k0, a[h]); a[h] = fmaf(q[h][8 * j + 2 * e + 1], k1, a[h]); } } }
}

__host__ __device__ __forceinline__ int win_src(int n) {
    if (n < 2048) return n;
    if (n < 3456) return n + 8;
    if (n < 3464) return n - 3456 + 2048;
    if (n < 3476) return n;
    return -1;
}


typedef unsigned u32x4p __attribute__((ext_vector_type(4)));
__device__ __forceinline__ void ph_convert_w(const float* __restrict__ W, int K, int N, int NP, bf16* __restrict__ WT, int mode, int item, bool act, int t, float* tile  , const float* __restrict__ gk = nullptr) {
    const int nbx = NP / 64; const int n0 = (item % nbx) * 64, k0 = (item / nbx) * 64, c = t & 63, r = t >> 6;
    if (act) { const int src = mode ? win_src(n0 + c) : (n0 + c);
#pragma unroll
        for (int i = 0; i < 16; ++i) { const int k = r + 4 * i; tile[k * 65 + c] = (src >= 0) ? W[(size_t)(k0 + k) * N + src] * (gk ? gk[k0 + k] : 1.f) : 0.f; } }
    __syncthreads();
    if (act) { const int n = t >> 2, kc = (t & 3) * 16;
        u32x4p w0, w1;
#pragma unroll
        for (int e = 0; e < 4; ++e) { w0[e] = pg8::cvtpk_bf16(tile[(kc + 2 * e) * 65 + n], tile[(kc + 2 * e + 1) * 65 + n]); w1[e] = pg8::cvtpk_bf16(tile[(kc + 8 + 2 * e) * 65 + n], tile[(kc + 8 + 2 * e + 1) * 65 + n]); }
        u32x4p* dst = (u32x4p*)(WT + (size_t)(n0 + n) * K + k0 + kc); dst[0] = w0; dst[1] = w1; }
    __syncthreads();
}
__device__ __forceinline__ void ph_rmsnorm_row(const float* __restrict__ x, const float* __restrict__ g, bf16* __restrict__ H, int row, int lane) {
    const float4* xr = (const float4*)(x + (size_t)row * DM) + lane;
    float4 v[4]; float s = 0.f;
#pragma unroll
    for (int j = 0; j < 4; ++j) { v[j] = xr[64 * j]; s += v[j].x * v[j].x + v[j].y * v[j].y + v[j].z * v[j].z + v[j].w * v[j].w; }
    const float rstd = rsqrtf(wave_sum(s) * (1.f / DM) + EPS);
    uint2* o = (uint2*)(H + (size_t)row * DM) + lane;
#pragma unroll
    for (int j = 0; j < 4; ++j) { const float4 gg = ((const float4*)g)[lane + 64 * j];
        uint2 w; w.x = pg8::pk2bf(v[j].x * rstd * gg.x, v[j].y * rstd * gg.y); w.y = pg8::pk2bf(v[j].z * rstd * gg.z, v[j].w * rstd * gg.w); o[64 * j] = w; }
}
__device__ __forceinline__ void ph_x_row(const float* __restrict__ x, bf16* __restrict__ XB, unsigned long long* __restrict__ ssq, int row, int lane) {
    const float4* xr = (const float4*)(x + (size_t)row * DM) + lane;
    float4 v[4]; float s = 0.f;
#pragma unroll
    for (int j = 0; j < 4; ++j) { v[j] = xr[64 * j]; s += v[j].x * v[j].x + v[j].y * v[j].y + v[j].z * v[j].z + v[j].w * v[j].w; }
    s = wave_sum(s);
    uint2* o = (uint2*)(XB + (size_t)row * DM) + lane;
#pragma unroll
    for (int j = 0; j < 4; ++j) { uint2 w; w.x = pg8::cvtpk_bf16(v[j].x, v[j].y); w.y = pg8::cvtpk_bf16(v[j].z, v[j].w); o[64 * j] = w; }
    if (lane == 0) ssq[row] = (unsigned long long)(s * 1048576.0f + 0.5f);
}
__device__ __forceinline__ void ph_prep(bf16* __restrict__ P, const float* __restrict__ tab, const float* __restrict__ moba_g, const float* __restrict__ nsa_qg, const float* __restrict__ nsa_kg,
                                        float* __restrict__ kmean, int item, bool act, int t, float* red  ) {
    const int lane = t & 63, wid = t >> 6, tb = item % 128, kind = item / 128, rg = lane >> 3, dch = lane & 7;
    if (act) {
        int col; const float* g; bool rope;
        if (kind < 4) { col = C_BQ + kind * 64; g = moba_g; rope = true; }
        else if (kind < 8) { col = C_BK + (kind - 4) * 64; g = moba_g + 64; rope = true; }
        else if (kind < 12) { col = C_NQ + (kind - 8) * 64; g = nsa_qg; rope = false; }
        else if (kind == 12) { col = C_NKS; g = nsa_kg + 64; rope = true; }
        else { col = C_NKW; g = nsa_kg + 128; rope = true; }
        float gd[8];
#pragma unroll
        for (int e = 0; e < 8; ++e) gd[e] = g[dch * 8 + e];
        const int row0 = tb * 256 + wid * 64 + rg;
        u32x4p raw[8];
#pragma unroll
        for (int it = 0; it < 8; ++it) raw[it] = *(const u32x4p*)(P + (size_t)(row0 + it * 8) * DINP + col + dch * 8);
        float ks[8];
#pragma unroll
        for (int e = 0; e < 8; ++e) ks[e] = 0.f;
#pragma unroll
        for (int it = 0; it < 8; ++it) {
            const int row = row0 + it * 8, pos = row & (SEQ - 1);
            float y[8]; float ss = 0.f;
#pragma unroll
            for (int e = 0; e < 4; ++e) { y[2 * e] = __builtin_bit_cast(float, raw[it][e] << 16); y[2 * e + 1] = __builtin_bit_cast(float, raw[it][e] & 0xffff0000u); ss += y[2 * e] * y[2 * e] + y[2 * e + 1] * y[2 * e + 1]; }
            ss += shx<1>(ss); ss += shx<2>(ss); ss += shx<4>(ss);
            const float rstd = rsqrtf(ss * (1.f / 64.f) + EPS);
#pragma unroll
            for (int e = 0; e < 8; ++e) y[e] *= rstd * gd[e];
            if (rope) {
                float o[8];
#pragma unroll
                for (int e = 0; e < 8; ++e) o[e] = shx<1>(y[e]);
                if (dch < 2) { const float4 c0 = *(const float4*)(tab + pos * 16), c1 = *(const float4*)(tab + pos * 16 + 4), s0 = *(const float4*)(tab + pos * 16 + 8), s1 = *(const float4*)(tab + pos * 16 + 12);
                    const float cs[8] = {c0.x, c0.y, c0.z, c0.w, c1.x, c1.y, c1.z, c1.w}, sn[8] = {s0.x, s0.y, s0.z, s0.w, s1.x, s1.y, s1.z, s1.w};
#pragma unroll
                    for (int e = 0; e < 8; ++e) y[e] = dch ? (y[e] * cs[e] + o[e] * sn[e]) : (y[e] * cs[e] - o[e] * sn[e]); }
            }
            u32x4p w; w[0] = pg8::pk2bf(y[0], y[1]); w[1] = pg8::pk2bf(y[2], y[3]); w[2] = pg8::pk2bf(y[4], y[5]); w[3] = pg8::pk2bf(y[6], y[7]);
            *(u32x4p*)(P + (size_t)row * DINP + col + dch * 8) = w;
#pragma unroll
            for (int e = 0; e < 8; ++e) ks[e] += y[e];
        }
        if (kind >= 4 && kind < 8) {
#pragma unroll
            for (int e = 0; e < 8; ++e) { ks[e] += shx<8>(ks[e]); ks[e] += shx<16>(ks[e]); ks[e] += shx<32>(ks[e]); }
            if (rg == 0) {
#pragma unroll
                for (int e = 0; e < 8; ++e) red[wid * 64 + dch * 8 + e] = ks[e]; }
        }
    }
    __syncthreads();
    if (act && kind >= 4 && kind < 8 && wid == 0) { const float s = red[lane] + red[64 + lane] + red[128 + lane] + red[192 + lane];
        const int b = tb >> 5, n = tb & 31; kmean[(((size_t)b * 4 + (kind - 4)) * 32 + n) * 64 + lane] = s * (1.f / 256.f); }
    __syncthreads();
}
__device__ __forceinline__ void ph_compress(const bf16* __restrict__ P, const float* __restrict__ pe, const float* __restrict__ w1, const float* __restrict__ w2, const float* __restrict__ kg0,
                                            float* __restrict__ KVc, bf16* __restrict__ KVcb, int item, bool act, int t, float* sm  ) {
    float* in = sm; float* hid = sm + 2048;
    const int i = item % NCMP, b = (item / NCMP) & 3, kv = item / (NCMP * 4);
    const int col = kv ? C_NVC : C_NKC;
    if (act) for (int e = t; e < 2048; e += 256) { const int p = e >> 6, d = e & 63; in[e] = bf2f(P[(size_t)(b * SEQ + 16 * i + p) * DINP + col + d]) + pe[(kv * 32 + p) * 64 + d]; }
    __syncthreads();
    if (act && t < 128) { const float* w = w1 + (size_t)kv * 2048 * 128 + t; float a = 0.f;
#pragma unroll 8
        for (int k = 0; k < 2048; ++k) a = fmaf(in[k], w[(size_t)k * 128], a);
        hid[t] = a * rcpf_(1.f + __expf(-a)); }
    __syncthreads();
    if (act && t < 64) { const float* ww = w2 + (size_t)kv * 128 * 64 + t; float o = 0.f;
#pragma unroll 8
        for (int j = 0; j < 128; ++j) o = fmaf(hid[j], ww[j * 64], o);
        if (kv == 0) { const float ss = wave_sum(o * o); o = o * rsqrtf(ss * (1.f / 64.f) + EPS) * kg0[t]; }
        KVc[(((size_t)kv * NB + b) * 512 + i) * 64 + t] = o; KVcb[(((size_t)kv * NB + b) * 512 + i) * 64 + t] = f2bf(o);
        if (i == NCMP - 1) KVcb[(((size_t)kv * NB + b) * 512 + NCMP) * 64 + t] = 0; }
    __syncthreads();
}
__device__ __forceinline__ float conv_silu(const bf16* __restrict__ P, const float* __restrict__ cw  , int rowbase, int t, int c) {
    float a = 0.f;
#pragma unroll
    for (int j = 0; j < 4; ++j) { const int tt = t - 3 + j; if (tt >= 0) a = fmaf(cw[j * 1024 + c], bf2f(P[(size_t)(rowbase + tt) * DINP + c]), a); }
    return a * rcpf_(1.f + __expf(-a));
}
__device__ __forceinline__ void ph_mlstm_local(const bf16* __restrict__ P, const float* __restrict__ G, const float* __restrict__ cw, const float* __restrict__ bif,
                                               float* __restrict__ Cst, float* __restrict__ nst, float* __restrict__ dec, int u, bool act, int tid, unsigned char* sm) {
    bf16 (*ks)[128] = (bf16 (*)[128])sm; bf16 (*vs)[128] = (bf16 (*)[128])(sm + 16384); float* wS = (float*)(sm + 32768); float* lf = wS + 64;
    const int c = u & 127, h = (u >> 7) & 3, b = u >> 9;
    const int rowbase = b * SEQ, t0 = c * 64;
    if (act) {
        for (int e = tid; e < 64 * 128; e += 256) { const int s = e >> 7, d = e & 127;
            ks[s][d] = f2bf(conv_silu(P, cw, rowbase, t0 + s, 512 + h * 128 + d) * 0.08838834764831845f);
            vs[s][d] = P[(size_t)(rowbase + t0 + s) * DINP + C_MV + h * 128 + d]; }
        if (tid < 64) lf[tid] = log_sigmoidf_(G[(size_t)(rowbase + t0 + tid) * 32 + 4 + h] + bif[4 + h]);
    }
    __syncthreads();
    if (act && tid == 0) { float acc = 0.f;
        for (int s = 0; s < 64; ++s) { acc += lf[s]; lf[s] = acc; }
        dec[u] = __expf(acc); }
    __syncthreads();
    if (act && tid < 64) wS[tid] = __expf(lf[63] - lf[tid] + G[(size_t)(rowbase + t0 + tid) * 32 + h] + bif[h]);
    __syncthreads();
    if (act) {
        const int d = tid >> 1, e0 = (tid & 1) * 64;
        float acc[64];
#pragma unroll
        for (int e = 0; e < 64; ++e) acc[e] = 0.f;
        float an = 0.f;
        for (int s = 0; s < 64; ++s) { const float kw = wS[s] * bf2f(ks[s][d]); an += kw;
#pragma unroll
            for (int e = 0; e < 64; ++e) acc[e] = fmaf(kw, bf2f(vs[s][e0 + e]), acc[e]); }
        float* o = Cst + ((size_t)u * 128 + d) * 128 + e0;
#pragma unroll
        for (int e = 0; e < 64; ++e) o[e] = acc[e];
        if ((tid & 1) == 0) nst[(size_t)u * 128 + d] = an;
    }
    __syncthreads();
}
__device__ __forceinline__ void ph_mlstm_scan(float* __restrict__ Cst, float* __restrict__ nst, const float* __restrict__ dec, int item, int tid) {
    const int bh = item / 65, part = item % 65;
    float* base; int stride;
    if (part < 64) { base = Cst + (size_t)bh * 128 * 16384 + part * 256 + tid; stride = 16384; }
    else { if (tid >= 128) return; base = nst + (size_t)bh * 128 * 128 + tid; stride = 128; }
    float C = 0.f;
    for (int c = 0; c < 128; ++c) { const float dC = base[(size_t)c * stride]; base[(size_t)c * stride] = C; C = dec[bh * 128 + c] * C + dC; }
}
__device__ __forceinline__ void ph_mlstm_out(const bf16* __restrict__ P, const float* __restrict__ G, const float* __restrict__ cw, const float* __restrict__ bif,
                                             const float* __restrict__ Cst, const float* __restrict__ nst, const float* __restrict__ mnorm, bf16* __restrict__ MIX, int u, bool act, int tid, unsigned char* sm) {
    bf16 (*qs)[128] = (bf16 (*)[128])sm; float* ksS = (float*)(sm + 16384); bf16 (*ks)[128] = (bf16 (*)[128])ksS; bf16 (*vs)[128] = (bf16 (*)[128])(sm + 32768);
    float* bb = (float*)(sm + 49152); float* li = bb + 64;
    const int c = u & 127, h = (u >> 7) & 3, b = u >> 9;
    const int rowbase = b * SEQ, t0 = c * 64;
    if (act) {
        for (int e = tid; e < 64 * 128; e += 256) { const int s = e >> 7, d = e & 127;
            qs[s][d] = f2bf(conv_silu(P, cw, rowbase, t0 + s, h * 128 + d));
            ks[s][d] = f2bf(conv_silu(P, cw, rowbase, t0 + s, 512 + h * 128 + d) * 0.08838834764831845f);
            vs[s][d] = P[(size_t)(rowbase + t0 + s) * DINP + C_MV + h * 128 + d]; }
        if (tid < 64) { bb[tid] = log_sigmoidf_(G[(size_t)(rowbase + t0 + tid) * 32 + 4 + h] + bif[4 + h]); li[tid] = G[(size_t)(rowbase + t0 + tid) * 32 + h] + bif[h]; }
    }
    __syncthreads();
    if (act && tid == 0) { float acc = 0.f; for (int s = 0; s < 64; ++s) { acc += bb[s]; bb[s] = acc; } }
    __syncthreads();
    const int t = tid >> 2, part = tid & 3;
    float sreg[16];
    if (act) {
        const int s0 = part * 16;
#pragma unroll
        for (int j = 0; j < 16; ++j) { const int s = s0 + j; float a = 0.f;
            if (s <= t) { for (int d = 0; d < 128; ++d) a = fmaf(bf2f(qs[t][d]), bf2f(ks[s][d]), a); a *= __expf(bb[t] - bb[s] + li[s]); }
            sreg[j] = a; }
    }
    __syncthreads();
    float* S = ksS;
    if (act) {
#pragma unroll
        for (int j = 0; j < 16; ++j) S[t * 64 + part * 16 + j] = sreg[j];
    }
    __syncthreads();
    if (act) {
        const float Ft = __expf(bb[t]);
        float den = 0.f;
        for (int s = 0; s <= t; ++s) den += S[t * 64 + s];
        { const float* np = nst + (size_t)u * 128; float a = 0.f; for (int d = 0; d < 128; ++d) a = fmaf(bf2f(qs[t][d]), np[d], a); den += Ft * a; }
        const int e0 = part * 32;
        float acc[32];
#pragma unroll
        for (int e = 0; e < 32; ++e) acc[e] = 0.f;
        { const float* Cp = Cst + (size_t)u * 16384 + e0;
          for (int d = 0; d < 128; ++d) { const float qd = bf2f(qs[t][d]);
#pragma unroll
              for (int e = 0; e < 32; ++e) acc[e] = fmaf(qd, Cp[d * 128 + e], acc[e]); } }
#pragma unroll
        for (int e = 0; e < 32; ++e) acc[e] *= Ft;
        for (int s = 0; s <= t; ++s) { const float w = S[t * 64 + s];
#pragma unroll
            for (int e = 0; e < 32; ++e) acc[e] = fmaf(w, bf2f(vs[s][e0 + e]), acc[e]); }
        const float inv = rcpf_(fmaxf(fabsf(den), 1.f));
        float ss = 0.f;
#pragma unroll
        for (int e = 0; e < 32; ++e) { acc[e] *= inv; ss += acc[e] * acc[e]; }
        ss += shx<1>(ss); ss += shx<2>(ss);
        const float rstd = rsqrtf(ss * (1.f / 128.f) + EPS);
        const size_t row = (size_t)(rowbase + t0 + t);
#pragma unroll
        for (int e = 0; e < 32; ++e) { const int cc = h * 128 + e0 + e;
            const float o = sigmoidf_(bf2f(P[row * DINP + C_MO + cc]));
            MIX[row * DM + cc] = f2bf(acc[e] * rstd * mnorm[cc] * o); }
    }
    __syncthreads();
}

__device__ __forceinline__ void ph_moba(const bf16* __restrict__ P, const float* __restrict__ kmean, bf16* __restrict__ MIX, int gw, int lane, float* q) {
    const int bh = gw >> 13, tq = gw & (SEQ - 1), b = bh >> 2, h = bh & 3, own = tq >> 8;
    const size_t row = (size_t)b * SEQ + tq;
    __builtin_amdgcn_s_waitcnt(0); __builtin_amdgcn_wave_barrier();
    q[lane] = bf2f(P[row * DINP + C_BQ + h * 64 + lane]);
    __builtin_amdgcn_s_waitcnt(0); __builtin_amdgcn_wave_barrier();
    float gs = -3.0e38f;
    if (lane < 32) { if (lane < own) { const float* km = kmean + (((size_t)b * 4 + h) * 32 + lane) * 64; float a = 0.f; for (int d = 0; d < 64; ++d) a = fmaf(q[d], km[d], a); gs = a; } else gs = -1e30f; }
    int blk[4]; bool val[4];
#pragma unroll
    for (int r = 0; r < 3; ++r) { const float m = wave_max(gs); const unsigned long long bal = __ballot(gs == m); const int idx = __ffsll((long long)bal) - 1;
        blk[r] = idx; val[r] = (r < own); if (lane == idx) gs = -3.0e38f; }
    blk[3] = own; val[3] = true;
    float s[4][4]; float mx = -1e30f;
#pragma unroll
    for (int g = 0; g < 4; ++g)
#pragma unroll
        for (int i = 0; i < 4; ++i) { float a = -1e30f;
            if (val[g]) { const int pos = blk[g] * 256 + i * 64 + lane;
                if (g < 3 || pos <= tq) { const bf16* kp = P + ((size_t)b * SEQ + pos) * DINP + C_BK + h * 64; a = dot64(kp, q) * 0.125f; } }
            s[g][i] = a; mx = fmaxf(mx, a); }
    mx = wave_max(mx);
    float l = 0.f;
#pragma unroll
    for (int g = 0; g < 4; ++g)
#pragma unroll
        for (int i = 0; i < 4; ++i) { const float p = (s[g][i] > -1e29f) ? __expf(s[g][i] - mx) : 0.f; s[g][i] = p; l += p; }
    l = wave_sum(l);
    float o = 0.f;
#pragma unroll
    for (int g = 0; g < 4; ++g) { if (!val[g]) continue;
#pragma unroll
        for (int i = 0; i < 4; ++i) { const bf16* vp = P + ((size_t)b * SEQ + blk[g] * 256 + i * 64) * DINP + C_BV + h * 64 + lane;
            for (int src = 0; src < 64; ++src) { const float p = __shfl(s[g][i], src); o = fmaf(p, bf2f(vp[(size_t)src * DINP]), o); } } }
    MIX[row * DM + 512 + h * 64 + lane] = f2bf(o * rcpf_(l));
}

__device__ __forceinline__ void ph_nsa(const bf16* __restrict__ P, const float* __restrict__ G, const float* __restrict__ tab, const float* __restrict__ KVc, bf16* __restrict__ MIX, int gw, int lane, float* sm) {
    float (*qn)[64] = (float (*)[64])sm; float (*qr)[64] = (float (*)[64])(sm + 256); float* ps = sm + 512;
    const int b = gw >> 13, tq = gw & (SEQ - 1), blkq = tq >> 6;
    const size_t row = (size_t)b * SEQ + tq;
    __builtin_amdgcn_s_waitcnt(0); __builtin_amdgcn_wave_barrier();
#pragma unroll
    for (int h = 0; h < 4; ++h) { const float x = bf2f(P[row * DINP + C_NQ + h * 64 + lane]); qn[h][lane] = x;
        float y = x; const float other = shx<8>(x);
        if (lane < 16) { const int f = lane & 7; const float c = tab[tq * 16 + f], s = tab[tq * 16 + 8 + f]; y = (lane < 8) ? (x * c - other * s) : (x * c + other * s); }
        qr[h][lane] = y; }
    __builtin_amdgcn_s_waitcnt(0); __builtin_amdgcn_wave_barrier();
    const float* Kc = KVc + (size_t)b * 512 * 64; const float* Vc = KVc + ((size_t)NB + b) * 512 * 64;
    float out[4] = {0.f, 0.f, 0.f, 0.f};
    float gate[3][4];
#pragma unroll
    for (int br = 0; br < 3; ++br)
#pragma unroll
        for (int h = 0; h < 4; ++h) gate[br][h] = sigmoidf_(G[row * 32 + 8 + br * 4 + h]);
    const int ncv = (tq >= 31) ? ((tq - 31) >> 4) + 1 : 0;
    {
        float sc[8][4]; float mx[4] = {-1e30f, -1e30f, -1e30f, -1e30f};
#pragma unroll
        for (int i = 0; i < 8; ++i) { const int c = i * 64 + lane;
            float a[4] = {-1e30f, -1e30f, -1e30f, -1e30f};
            if (c < ncv) { const float* kp = Kc + (size_t)c * 64; a[0] = a[1] = a[2] = a[3] = 0.f;
                for (int d = 0; d < 64; ++d) { const float kd = kp[d]; a[0] = fmaf(qn[0][d], kd, a[0]); a[1] = fmaf(qn[1][d], kd, a[1]); a[2] = fmaf(qn[2][d], kd, a[2]); a[3] = fmaf(qn[3][d], kd, a[3]); }
#pragma unroll
                for (int h = 0; h < 4; ++h) a[h] *= 0.125f; }
#pragma unroll
            for (int h = 0; h < 4; ++h) { sc[i][h] = a[h]; mx[h] = fmaxf(mx[h], a[h]); } }
        float l[4];
#pragma unroll
        for (int h = 0; h < 4; ++h) { mx[h] = wave_max(mx[h]); l[h] = 0.f; }
#pragma unroll
        for (int i = 0; i < 8; ++i) { const int c = i * 64 + lane;
#pragma unroll
            for (int h = 0; h < 4; ++h) { const float p = (c < ncv) ? __expf(sc[i][h] - mx[h]) : 0.f; sc[i][h] = p; l[h] += p; } }
#pragma unroll
        for (int h = 0; h < 4; ++h) { l[h] = wave_sum(l[h]); l[h] = (l[h] > 0.f) ? rcpf_(l[h]) : 0.f; }
#pragma unroll
        for (int i = 0; i < 8; ++i) { float su = 0.f;
#pragma unroll
            for (int h = 0; h < 4; ++h) { sc[i][h] *= l[h]; su += sc[i][h]; }
            ps[i * 64 + lane] = su; }
        if (lane < 4) ps[512 + lane] = 0.f;
        float oc[4] = {0.f, 0.f, 0.f, 0.f};
#pragma unroll
        for (int i = 0; i < 8; ++i) { if (i * 64 >= ncv) break; const int nn = min(64, ncv - i * 64);
            for (int src = 0; src < nn; ++src) { const float v = Vc[(size_t)(i * 64 + src) * 64 + lane];
                oc[0] = fmaf(__shfl(sc[i][0], src), v, oc[0]); oc[1] = fmaf(__shfl(sc[i][1], src), v, oc[1]);
                oc[2] = fmaf(__shfl(sc[i][2], src), v, oc[2]); oc[3] = fmaf(__shfl(sc[i][3], src), v, oc[3]); } }
#pragma unroll
        for (int h = 0; h < 4; ++h) out[h] = gate[0][h] * oc[h];
    }
    __builtin_amdgcn_s_waitcnt(0); __builtin_amdgcn_wave_barrier();
    int sidx[16];
    {
        float v0, v1;
        { const int n = lane; float im = 0.f;
#pragma unroll
          for (int j = -1; j < 4; ++j) { const int c = 4 * n + j; if (c >= 0 && c < NCMP) im += ps[c]; }
          const bool causal = n <= blkq, forced = causal && (n == 0 || n >= blkq - 1);
          v0 = forced ? 1e9f : (causal ? im : -1e30f); }
        { const int n = lane + 64; float im = 0.f;
#pragma unroll
          for (int j = -1; j < 4; ++j) { const int c = 4 * n + j; if (c >= 0 && c < NCMP) im += ps[c]; }
          const bool causal = n <= blkq, forced = causal && (n == 0 || n >= blkq - 1);
          v1 = forced ? 1e9f : (causal ? im : -1e30f); }
#pragma unroll
        for (int k = 0; k < 16; ++k) { const float m = wave_max(fmaxf(v0, v1));
            const unsigned long long b0 = __ballot(v0 == m); int idx;
            if (b0) { idx = __ffsll((long long)b0) - 1; if (lane == idx) v0 = -3.0e38f; }
            else { const unsigned long long b1 = __ballot(v1 == m); idx = __ffsll((long long)b1) - 1; if (lane == idx) v1 = -3.0e38f; idx += 64; }
            sidx[k] = idx; }
    }
    {
        float sc[16][4]; float mx[4] = {-1e30f, -1e30f, -1e30f, -1e30f};
#pragma unroll
        for (int k = 0; k < 16; ++k) { const int n = sidx[k], pos = n * 64 + lane;
            float a[4] = {-1e30f, -1e30f, -1e30f, -1e30f};
            if (n <= blkq && pos <= tq) { const bf16* kp = P + ((size_t)b * SEQ + pos) * DINP + C_NKS; dot64x4(kp, qr, a);
#pragma unroll
                for (int h = 0; h < 4; ++h) a[h] *= 0.125f; }
#pragma unroll
            for (int h = 0; h < 4; ++h) { sc[k][h] = a[h]; mx[h] = fmaxf(mx[h], a[h]); } }
        float l[4];
#pragma unroll
        for (int h = 0; h < 4; ++h) { mx[h] = wave_max(mx[h]); l[h] = 0.f; }
#pragma unroll
        for (int k = 0; k < 16; ++k)
#pragma unroll
            for (int h = 0; h < 4; ++h) { const float p = (sc[k][h] > -1e29f) ? __expf(sc[k][h] - mx[h]) : 0.f; sc[k][h] = p; l[h] += p; }
#pragma unroll
        for (int h = 0; h < 4; ++h) l[h] = rcpf_(wave_sum(l[h]));
        float os[4] = {0.f, 0.f, 0.f, 0.f};
#pragma unroll
        for (int k = 0; k < 16; ++k) { const int n = sidx[k]; if (n > blkq) continue;
            const bf16* vp = P + ((size_t)b * SEQ + n * 64) * DINP + C_NVS + lane;
            for (int src = 0; src < 64; ++src) { const float v = bf2f(vp[(size_t)src * DINP]);
                os[0] = fmaf(__shfl(sc[k][0], src), v, os[0]); os[1] = fmaf(__shfl(sc[k][1], src), v, os[1]);
                os[2] = fmaf(__shfl(sc[k][2], src), v, os[2]); os[3] = fmaf(__shfl(sc[k][3], src), v, os[3]); } }
#pragma unroll
        for (int h = 0; h < 4; ++h) out[h] += gate[1][h] * os[h] * l[h];
    }
    {
        float sc[8][4]; float mx[4] = {-1e30f, -1e30f, -1e30f, -1e30f};
#pragma unroll
        for (int i = 0; i < 8; ++i) { const int pos = tq - 511 + i * 64 + lane;
            float a[4] = {-1e30f, -1e30f, -1e30f, -1e30f};
            if (pos >= 0) { const bf16* kp = P + ((size_t)b * SEQ + pos) * DINP + C_NKW; dot64x4(kp, qr, a);
#pragma unroll
                for (int h = 0; h < 4; ++h) a[h] *= 0.125f; }
#pragma unroll
            for (int h = 0; h < 4; ++h) { sc[i][h] = a[h]; mx[h] = fmaxf(mx[h], a[h]); } }
        float l[4];
#pragma unroll
        for (int h = 0; h < 4; ++h) { mx[h] = wave_max(mx[h]); l[h] = 0.f; }
#pragma unroll
        for (int i = 0; i < 8; ++i)
#pragma unroll
            for (int h = 0; h < 4; ++h) { const float p = (sc[i][h] > -1e29f) ? __expf(sc[i][h] - mx[h]) : 0.f; sc[i][h] = p; l[h] += p; }
#pragma unroll
        for (int h = 0; h < 4; ++h) l[h] = rcpf_(wave_sum(l[h]));
        float ow[4] = {0.f, 0.f, 0.f, 0.f};
#pragma unroll
        for (int i = 0; i < 8; ++i) { const int p0 = tq - 511 + i * 64; if (p0 + 63 < 0) continue;
            const int s0 = p0 < 0 ? -p0 : 0;
            for (int src = s0; src < 64; ++src) { const float v = bf2f(P[((size_t)b * SEQ + p0 + src) * DINP + C_NVW + lane]);
                ow[0] = fmaf(__shfl(sc[i][0], src), v, ow[0]); ow[1] = fmaf(__shfl(sc[i][1], src), v, ow[1]);
                ow[2] = fmaf(__shfl(sc[i][2], src), v, ow[2]); ow[3] = fmaf(__shfl(sc[i][3], src), v, ow[3]); } }
#pragma unroll
        for (int h = 0; h < 4; ++h) out[h] += gate[2][h] * ow[h] * l[h];
    }
#pragma unroll
    for (int h = 0; h < 4; ++h) MIX[row * DM + 768 + h * 64 + lane] = f2bf(out[h]);
}


#define LAS __attribute__((address_space(3)))
typedef short bf16x8 __attribute__((ext_vector_type(8)));
typedef float f32x16 __attribute__((ext_vector_type(16)));
typedef short s16x4 __attribute__((ext_vector_type(4)));
typedef unsigned u32x4v __attribute__((ext_vector_type(4)));
typedef float f32x2_t __attribute__((ext_vector_type(2)));
typedef __bf16 bf16x2_t __attribute__((ext_vector_type(2)));
constexpr int KROW = 144, VROW = 192;
constexpr int KBUF = 64 * KROW, VBUF = 64 * VROW, STG = KBUF + VBUF;
constexpr float SCL2 = 0.125f * 1.4426950408889634f;
constexpr float NEGBIG = -1e30f;

__device__ __forceinline__ unsigned cvtpk(float lo, float hi) { f32x2_t v = {lo, hi}; bf16x2_t b = __builtin_convertvector(v, bf16x2_t); return __builtin_bit_cast(unsigned, b); }
__device__ __forceinline__ int crow(int r, int hi) { return (r & 3) + 8 * (r >> 2) + 4 * hi; }
__device__ __forceinline__ s16x4 lds_tr(LAS const unsigned char* p) { return __builtin_bit_cast(s16x4, __builtin_amdgcn_ds_read_tr16_b64_v4i16((LAS s16x4*)p)); }

__device__ __forceinline__ bf16x8 scale_frag(bf16x8 v, float s) {
    const u32x4v w = __builtin_bit_cast(u32x4v, v); u32x4v o;
#pragma unroll
    for (int e = 0; e < 4; ++e) o[e] = cvtpk(__builtin_bit_cast(float, w[e] << 16) * s, __builtin_bit_cast(float, w[e] & 0xffff0000u) * s);
    return __builtin_bit_cast(bf16x8, o);
}
struct TileSrc { const bf16* k; const bf16* v; int stride; };
__device__ __forceinline__ void tile_load(u32x4v& kr, u32x4v& vr, const TileSrc& s, int t) {
    const int key = t >> 3, ch = t & 7;
    kr = *(const u32x4v*)(s.k + (size_t)key * s.stride + ch * 8); vr = *(const u32x4v*)(s.v + (size_t)key * s.stride + ch * 8);
}
__device__ __forceinline__ void tile_store(LAS unsigned char* buf, const u32x4v& kr, const u32x4v& vr, int t) {
    const int key = t >> 3, ch = t & 7;
    *(LAS u32x4v*)(buf + key * KROW + ch * 16) = kr; *(LAS u32x4v*)(buf + KBUF + key * VROW + ch * 16) = vr;
}
__device__ __forceinline__ void qk_tile(f32x16& p0, f32x16& p1, LAS const unsigned char* kb, const bf16x8 (&qf)[4], int r32, int hi, float cinit) {
    float ci = cinit; asm volatile("" : "+v"(ci));
#pragma unroll
    for (int r = 0; r < 16; ++r) { p0[r] = ci; p1[r] = ci; }
    LAS const unsigned char* a = kb + r32 * KROW + hi * 16;
#pragma unroll
    for (int ks = 0; ks < 4; ++ks) {
        const bf16x8 a0 = *(LAS const bf16x8*)(a + ks * 32), a1 = *(LAS const bf16x8*)(a + 32 * KROW + ks * 32);
        p0 = __builtin_amdgcn_mfma_f32_32x32x16_bf16(a0, qf[ks], p0, 0, 0, 0);
        p1 = __builtin_amdgcn_mfma_f32_32x32x16_bf16(a1, qf[ks], p1, 0, 0, 0);
    }
}
__device__ __forceinline__ void pv_tile(f32x16& o0, f32x16& o1, LAS const unsigned char* vb, const f32x16& p0, const f32x16& p1, int lane) {
    const int g = lane >> 4, i = lane & 15, hi = lane >> 5;
    LAS const unsigned char* base = vb + (4 * hi + (i >> 2)) * VROW + (16 * (g & 1) + 4 * (i & 3)) * 2;
#pragma unroll
    for (int s = 0; s < 4; ++s) {
        unsigned w[4];
#pragma unroll
        for (int e = 0; e < 4; ++e) { const int r = 8 * (s & 1) + 2 * e; w[e] = (s < 2) ? cvtpk(p0[r], p0[r + 1]) : cvtpk(p1[r], p1[r + 1]); }
        const u32x4v wv = {w[0], w[1], w[2], w[3]};
        const bf16x8 pf = __builtin_bit_cast(bf16x8, wv);
#pragma unroll
        for (int mb = 0; mb < 2; ++mb) {
            const s16x4 lo = lds_tr(base + s * 16 * VROW + mb * 64), hi4 = lds_tr(base + s * 16 * VROW + 8 * VROW + mb * 64);
            const bf16x8 vt = {lo[0], lo[1], lo[2], lo[3], hi4[0], hi4[1], hi4[2], hi4[3]};
            if (mb == 0) o0 = __builtin_amdgcn_mfma_f32_32x32x16_bf16(vt, pf, o0, 0, 0, 0);
            else o1 = __builtin_amdgcn_mfma_f32_32x32x16_bf16(vt, pf, o1, 0, 0, 0);
        }
    }
}
constexpr float SM_THR = 8.0f;
__device__ __forceinline__ void softmax_tile(f32x16& p0, f32x16& p1, f32x16& o0, f32x16& o1, float& mref, float& l, bool first) {
    float a = __builtin_fmaxf(__builtin_fmaxf(p0[0], p0[1]), p1[0]), b = __builtin_fmaxf(__builtin_fmaxf(p0[2], p0[3]), p1[1]);
    a = __builtin_fmaxf(__builtin_fmaxf(a, p1[2]), p1[3]);
#pragma unroll
    for (int r = 4; r < 16; r += 4) { a = __builtin_fmaxf(__builtin_fmaxf(a, p0[r]), p0[r + 1]); b = __builtin_fmaxf(__builtin_fmaxf(b, p0[r + 2]), p0[r + 3]);
        a = __builtin_fmaxf(__builtin_fmaxf(a, p1[r]), p1[r + 1]); b = __builtin_fmaxf(__builtin_fmaxf(b, p1[r + 2]), p1[r + 3]); }
    float rm = __builtin_fmaxf(a, b);
    { auto rr = __builtin_amdgcn_permlane32_swap(__float_as_uint(rm), __float_as_uint(rm), false, false); rm = __builtin_fmaxf(__uint_as_float(rr[0]), __uint_as_float(rr[1])); }
    if (first || __any(rm > SM_THR)) {
        const float dl = first ? rm : __builtin_fmaxf(rm, 0.f);
        mref += dl;
        const float f = __builtin_amdgcn_exp2f(-dl);
        l *= f;
#pragma unroll
        for (int r = 0; r < 16; ++r) { p0[r] -= dl; p1[r] -= dl; o0[r] *= f; o1[r] *= f; }
    }
    float s0 = 0.f, s1 = 0.f;
#pragma unroll
    for (int r = 0; r < 16; ++r) { p0[r] = __builtin_amdgcn_exp2f(p0[r]); p1[r] = __builtin_amdgcn_exp2f(p1[r]); s0 += p0[r]; s1 += p1[r]; }
    l += s0 + s1;
}


constexpr int PV_OFF = 2 * KBUF, PIPE_BYTES = 2 * KBUF + 2 * VBUF;
__device__ __forceinline__ void k_store(LAS unsigned char* lds, int slot, const u32x4v& kr, int t) { *(LAS u32x4v*)(lds + slot * KBUF + (t >> 3) * KROW + (t & 7) * 16) = kr; }
__device__ __forceinline__ void v_store(LAS unsigned char* lds, int voff, const u32x4v& vr, int t) { *(LAS u32x4v*)(lds + PV_OFF + voff + (t >> 3) * VROW + (t & 7) * 16) = vr; }
__device__ __forceinline__ u32x4v kv_load(const bf16* base, int stride, int t) { return *(const u32x4v*)(base + (size_t)(t >> 3) * stride + (t & 7) * 8); }
__device__ __forceinline__ void pv_frag(f32x16& o0, f32x16& o1, LAS const unsigned char* vb, const bf16x8 (&pf)[4], int lane) {
    const int g = lane >> 4, i = lane & 15, hi = lane >> 5;
    LAS const unsigned char* base = vb + (4 * hi + (i >> 2)) * VROW + (16 * (g & 1) + 4 * (i & 3)) * 2;
#pragma unroll
    for (int s = 0; s < 4; ++s)
#pragma unroll
        for (int mb = 0; mb < 2; ++mb) {
            const s16x4 lo = lds_tr(base + s * 16 * VROW + mb * 64), hi4 = lds_tr(base + s * 16 * VROW + 8 * VROW + mb * 64);
            const bf16x8 vt = {lo[0], lo[1], lo[2], lo[3], hi4[0], hi4[1], hi4[2], hi4[3]};
            if (mb == 0) o0 = __builtin_amdgcn_mfma_f32_32x32x16_bf16(vt, pf[s], o0, 0, 0, 0);
            else o1 = __builtin_amdgcn_mfma_f32_32x32x16_bf16(vt, pf[s], o1, 0, 0, 0);
        }
}
__device__ __forceinline__ void exp_pack(f32x16& p0, f32x16& p1, float& l, bf16x8 (&pf)[4]) {
    float s0 = 0.f, s1 = 0.f;
#pragma unroll
    for (int r = 0; r < 16; ++r) { p0[r] = __builtin_amdgcn_exp2f(p0[r]); p1[r] = __builtin_amdgcn_exp2f(p1[r]); s0 += p0[r]; s1 += p1[r]; }
    l += s0 + s1;
#pragma unroll
    for (int s = 0; s < 4; ++s) { u32x4v w;
#pragma unroll
        for (int e = 0; e < 4; ++e) { const int r = 8 * (s & 1) + 2 * e; w[e] = (s < 2) ? cvtpk(p0[r], p0[r + 1]) : cvtpk(p1[r], p1[r + 1]); }
        pf[s] = __builtin_bit_cast(bf16x8, w); }
}
template <class Pol>
__device__ __forceinline__ void attn_step_gen(const Pol& pol, int t, bool doqk, LAS unsigned char* lds, const bf16x8 (&qf)[4], float negm, f32x16& pc0, f32x16& pc1,
                                              f32x16& o0, f32x16& o1, float& l, int tid, int lane, int r32, int hi) {
    const int nt = pol.nt;
    u32x4v kr, vr;
    const bool ldk = (t + 2 < nt), ldv = (t + 1 < nt);
    if (ldk) kr = kv_load(pol.kptr(t + 2), pol.stride, tid);
    if (ldv) vr = kv_load(pol.vptr(t + 1), pol.stride, tid);
    f32x16 pn0, pn1; bf16x8 pf[4];
    if (doqk) { qk_tile(pn0, pn1, lds + ((t + 1) & 1) * KBUF, qf, r32, hi, pol.rowsel(t + 1) ? negm : NEGBIG); pol.mask(t + 1, pn0, pn1); }
    exp_pack(pc0, pc1, l, pf);
    pv_frag(o0, o1, lds + PV_OFF + (t & 1) * VBUF, pf, lane);
    if (ldk) k_store(lds, t & 1, kr, tid);
    if (ldv) v_store(lds, ((t + 1) & 1) * VBUF, vr, tid);
    __syncthreads();
    if (doqk) { pc0 = pn0; pc1 = pn1; }
}
template <class Pol>
__device__ __forceinline__ void attn_step_fast(const Pol& pol, int t, LAS unsigned char* lds, const bf16x8 (&qf)[4], float negm, f32x16& pc0, f32x16& pc1, f32x16& pn0, f32x16& pn1,
                                               f32x16& o0, f32x16& o1, float& l, u32x4v& kld, u32x4v& vld, const u32x4v& kst, const u32x4v& vst,
                                               int tid, int lane, int r32, int hi) {
    const int nt = pol.nt, tk = (t + 3 < nt) ? t + 3 : nt - 1, tv = (t + 2 < nt) ? t + 2 : nt - 1;
    kld = kv_load(pol.kptr(tk), pol.stride, tid); vld = kv_load(pol.vptr(tv), pol.stride, tid);
    bf16x8 pf[4];
    qk_tile(pn0, pn1, lds + ((t + 1) & 1) * KBUF, qf, r32, hi, pol.rowsel(t + 1) ? negm : NEGBIG);
    exp_pack(pc0, pc1, l, pf);
    pv_frag(o0, o1, lds + PV_OFF + (t & 1) * VBUF, pf, lane);
    k_store(lds, t & 1, kst, tid);
    v_store(lds, ((t + 1) & 1) * VBUF, vst, tid);
    __syncthreads();
}
template <class Pol>
__device__ __forceinline__ void attn_pipe(const Pol& pol, LAS unsigned char* lds, const bf16x8 (&qf)[4], float negm, f32x16& o0, f32x16& o1, float& l, int tid) {
    const int lane = tid & 63, r32 = lane & 31, hi = lane >> 5, nt = pol.nt;
    {
        const u32x4v k0 = kv_load(pol.kptr(0), pol.stride, tid), v0 = kv_load(pol.vptr(0), pol.stride, tid);
        u32x4v k1 = k0; if (nt > 1) k1 = kv_load(pol.kptr(1), pol.stride, tid);
        k_store(lds, 0, k0, tid); v_store(lds, 0, v0, tid); if (nt > 1) k_store(lds, 1, k1, tid);
    }
    __syncthreads();
    f32x16 pc0, pc1;
    qk_tile(pc0, pc1, lds, qf, r32, hi, pol.rowsel(0) ? negm : NEGBIG); pol.mask(0, pc0, pc1);
    int t = 0;
    for (; t < nt - 1 && t + 1 < pol.nmask; ++t)
        attn_step_gen(pol, t, true, lds, qf, negm, pc0, pc1, o0, o1, l, tid, lane, r32, hi);
    if (t < nt - 1) {
        const int tk0 = (t + 2 < nt) ? t + 2 : nt - 1;
        u32x4v ka = kv_load(pol.kptr(tk0), pol.stride, tid), va = kv_load(pol.vptr(t + 1), pol.stride, tid), kb, vb;
        f32x16 pd0, pd1;
        for (; t + 1 < nt - 1; t += 2) {
            attn_step_fast(pol, t, lds, qf, negm, pc0, pc1, pd0, pd1, o0, o1, l, kb, vb, ka, va, tid, lane, r32, hi);
            attn_step_fast(pol, t + 1, lds, qf, negm, pd0, pd1, pc0, pc1, o0, o1, l, ka, va, kb, vb, tid, lane, r32, hi);
        }
        if (t < nt - 1) {
            attn_step_fast(pol, t, lds, qf, negm, pc0, pc1, pd0, pd1, o0, o1, l, kb, vb, ka, va, tid, lane, r32, hi);
            pc0 = pd0; pc1 = pd1; ++t;
        }
    }
    attn_step_gen(pol, nt - 1, false, lds, qf, negm, pc0, pc1, o0, o1, l, tid, lane, r32, hi);
}
__device__ __forceinline__ float row_negm(const bf16x8 (&qf)[4], float kmax) {
    float ss = 0.f;
#pragma unroll
    for (int ks = 0; ks < 4; ++ks) { const u32x4v w = __builtin_bit_cast(u32x4v, qf[ks]);
#pragma unroll
        for (int e = 0; e < 4; ++e) { const float a = __builtin_bit_cast(float, w[e] << 16), b = __builtin_bit_cast(float, w[e] & 0xffff0000u); ss += a * a + b * b; } }
    ss += shx<32>(ss);
    return -(__builtin_sqrtf(ss) * kmax);
}
__device__ __forceinline__ float gain_kmax(const float* g, int lane) { return wave_max(fabsf(g[lane])) * (8.0f * 1.02f); }


constexpr int MK_KM_OFF = 0, MK_MSK_OFF = 8192, MK_CNT_OFF = MK_MSK_OFF + 1024, MK_END = MK_CNT_OFF + 512;
__device__ __forceinline__ void moba_gate_item(const bf16* __restrict__ P, const float* __restrict__ kmean, unsigned* __restrict__ SELB, int* __restrict__ CNTQ, unsigned char* __restrict__ LISTG,
                                               int b, int h, int qb, int tid, LAS unsigned char* lds) {
    asm volatile("" : "+v"(tid));
    const int lane = tid & 63, wid = __builtin_amdgcn_readfirstlane(tid >> 6), r32 = lane & 31, hi = lane >> 5, bh = b * 4 + h;
    LAS float* km = (LAS float*)(lds + MK_KM_OFF); LAS unsigned* msk = (LAS unsigned*)(lds + MK_MSK_OFF); LAS int* cnts = (LAS int*)(lds + MK_CNT_OFF);
    const int own = qb;
    const size_t rowq = (size_t)b * SEQ + qb * 256 + wid * 32 + r32;
    bf16x8 qg[4];
#pragma unroll
    for (int ks = 0; ks < 4; ++ks) qg[ks] = *(const bf16x8*)(P + rowq * DINP + C_BQ + h * 64 + ks * 16 + hi * 8);
    for (int e = tid; e < own * 64; e += 512) km[e] = kmean[((size_t)bh * 32) * 64 + e];
    __syncthreads();
    {
        unsigned mask = 0u; float qv[32];
#pragma unroll
        for (int ks = 0; ks < 4; ++ks)
#pragma unroll
            for (int j = 0; j < 8; ++j) qv[ks * 8 + j] = bf2f((bf16)qg[ks][j]);
        float b0 = -3e38f, b1 = -3e38f, b2 = -3e38f; int i0 = -1, i1 = -1, i2 = -1;
        for (int n = 0; n < own; ++n) {
            LAS const float* kp = km + n * 64 + hi * 8; float a = 0.f;
#pragma unroll
            for (int ks = 0; ks < 4; ++ks)
#pragma unroll
                for (int j = 0; j < 8; ++j) a = fmaf(qv[ks * 8 + j], kp[ks * 16 + j], a);
            a += shx<32>(a);
            if (a > b0) { b2 = b1; i2 = i1; b1 = b0; i1 = i0; b0 = a; i0 = n; }
            else if (a > b1) { b2 = b1; i2 = i1; b1 = a; i1 = n; }
            else if (a > b2) { b2 = a; i2 = n; }
        }
        if (i0 >= 0) mask |= 1u << i0; if (i1 >= 0) mask |= 1u << i1; if (i2 >= 0) mask |= 1u << i2;
        if (hi == 0) { msk[wid * 32 + r32] = mask; SELB[(size_t)bh * SEQ + qb * 256 + wid * 32 + r32] = mask; }
    }
    __syncthreads();
    unsigned mym = 0u;
    if (wid < 4) { mym = msk[wid * 64 + lane];
        for (int n = 0; n < own; ++n) { const unsigned long long bal = __ballot((mym >> n) & 1u); if (lane == 0) cnts[n * 4 + wid] = __popcll(bal); } }
    __syncthreads();
    if (wid < 4) {
        unsigned char* lg = LISTG + ((size_t)bh * 32 + qb) * 32 * 256;
        for (int n = 0; n < own; ++n) { const unsigned long long bal = __ballot((mym >> n) & 1u);
            int off = 0; for (int w = 0; w < wid; ++w) off += cnts[n * 4 + w];
            if ((mym >> n) & 1u) lg[n * 256 + off + __popcll(bal & ((1ull << lane) - 1ull))] = (unsigned char)(wid * 64 + lane); }
    } else if (wid == 4) {
        if (lane < 32) CNTQ[((size_t)bh * 32 + qb) * 32 + lane] = (lane < own) ? (cnts[lane * 4] + cnts[lane * 4 + 1] + cnts[lane * 4 + 2] + cnts[lane * 4 + 3]) : 0;
    }
    __syncthreads();
}
__device__ __forceinline__ unsigned char* moba_part(bf16* P, size_t token, int h, int slot) { return (unsigned char*)(P + token * DINP) + h * 512 + slot * 136; }
constexpr int MK_TAB_OFF = 4 * STG;
__device__ __forceinline__ void moba_kv_chunk(bf16* __restrict__ P, const unsigned* __restrict__ SELB, const int* __restrict__ CNTQ, const unsigned char* __restrict__ LISTG, float kmax,
                                              int bh, int n, int c, int tid, LAS unsigned char* lds) {
    asm volatile("" : "+v"(tid));
    const int lane = tid & 63, wid = __builtin_amdgcn_readfirstlane(tid >> 6), r32 = lane & 31, hi = lane >> 5, b = bh >> 2, h = bh & 3;
    bf16* Pb = P + (size_t)b * SEQ * DINP;
    LAS int* tab = (LAS int*)(lds + MK_TAB_OFF);
    {
        const bf16* ksrc = Pb + (size_t)(n * 256) * DINP + C_BK + h * 64; const bf16* vsrc = Pb + (size_t)(n * 256) * DINP + C_BV + h * 64;
        u32x4v kr[4], vr[4];
#pragma unroll
        for (int s = 0; s < 4; ++s) { kr[s] = kv_load(ksrc + (size_t)s * 64 * DINP, DINP, tid); vr[s] = kv_load(vsrc + (size_t)s * 64 * DINP, DINP, tid); }
        if (tid < 32) { const int cq = (tid > n) ? CNTQ[((size_t)bh * 32 + tid) * 32 + n] : 0; tab[tid] = (cq + 31) >> 5; tab[32 + tid] = cq; }
#pragma unroll
        for (int s = 0; s < 4; ++s) { *(LAS u32x4v*)(lds + s * STG + (tid >> 3) * KROW + (tid & 7) * 16) = kr[s]; *(LAS u32x4v*)(lds + s * STG + KBUF + (tid >> 3) * VROW + (tid & 7) * 16) = vr[s]; }
    }
    __syncthreads();
    if (tid < 16) { const int ord = 16 * c + tid; int qb = -1, j = 0, acc = 0;
        for (int q = n + 1; q < 32; ++q) { const int t = tab[q]; if (qb < 0 && ord < acc + t) { qb = q; j = ord - acc; } acc += t; }
        tab[64 + tid] = qb < 0 ? -1 : ((qb << 8) | j); }
    __syncthreads();
    for (int r = 0; r < 2; ++r) {
        const int ord = 16 * c + 8 * r + wid;
        const int code = tab[64 + 8 * r + wid];
        if (code < 0) continue;
        const int qb = code >> 8, j = code & 255; (void)ord;
        const int cnt = tab[32 + qb], idx = j * 32 + r32; const bool valid = idx < cnt;
        const int row = LISTG[(((size_t)bh * 32 + qb) * 32 + n) * 256 + (valid ? idx : cnt - 1)];
        const size_t token = (size_t)b * SEQ + qb * 256 + row;
        bf16x8 qf[4];
#pragma unroll
        for (int ks = 0; ks < 4; ++ks) qf[ks] = scale_frag(*(const bf16x8*)(P + token * DINP + C_BQ + h * 64 + ks * 16 + hi * 8), SCL2);
        const unsigned mrow = SELB[(size_t)bh * SEQ + qb * 256 + row];
        const float negm = row_negm(qf, kmax);
        f32x16 o0, o1; float l = 0.f;
#pragma unroll
        for (int q = 0; q < 16; ++q) { o0[q] = zf_(); o1[q] = o0[q]; }
#pragma unroll
        for (int s = 0; s < 4; ++s) { f32x16 p0, p1; bf16x8 pf[4];
            qk_tile(p0, p1, lds + s * STG, qf, r32, hi, negm);
            exp_pack(p0, p1, l, pf);
            pv_frag(o0, o1, lds + s * STG + KBUF, pf, lane); }
        l += shx<32>(l);
        if (valid) { unsigned char* pp = moba_part(P, token, h, __popc(mrow & ((1u << n) - 1u)));
#pragma unroll
            for (int g = 0; g < 4; ++g) { uint2 w0, w1;
                w0.x = cvtpk(o0[4 * g], o0[4 * g + 1]); w0.y = cvtpk(o0[4 * g + 2], o0[4 * g + 3]); w1.x = cvtpk(o1[4 * g], o1[4 * g + 1]); w1.y = cvtpk(o1[4 * g + 2], o1[4 * g + 3]);
                *(uint2*)(pp + (8 * g + 4 * hi) * 2) = w0; *(uint2*)(pp + (32 + 8 * g + 4 * hi) * 2) = w1; }
            if (hi == 0) *(float*)(pp + 128) = l; }
    }
    __syncthreads();
}
struct MobaOwnPol {
    int nt, nmask, stride, own, tq, hi; const bf16* Pk; const bf16* Pv;
    __device__ __forceinline__ const bf16* kptr(int i) const { return Pk + (size_t)(own * 4 + i) * 64 * DINP; }
    __device__ __forceinline__ const bf16* vptr(int i) const { return Pv + (size_t)(own * 4 + i) * 64 * DINP; }
    __device__ __forceinline__ bool rowsel(int) const { return true; }
    __device__ __forceinline__ void mask(int i, f32x16& p0, f32x16& p1) const { const int kbase = (own * 4 + i) * 64;
#pragma unroll
        for (int r = 0; r < 16; ++r) { const int k0 = kbase + crow(r, hi); p0[r] = (k0 <= tq) ? p0[r] : nbg; p1[r] = (k0 + 32 <= tq) ? p1[r] : nbg; } }
};
__device__ __forceinline__ void moba_merge_unit(bf16* __restrict__ P, const unsigned* __restrict__ SELB, float kmax, bf16* __restrict__ MIX, int b, int h, int qb, int tid, LAS unsigned char* lds) {
    asm volatile("" : "+v"(tid));
    const int lane = tid & 63, wid = __builtin_amdgcn_readfirstlane(tid >> 6), r32 = lane & 31, hi = lane >> 5, bh = b * 4 + h;
    const int tq = qb * 256 + wid * 32 + r32;
    const size_t rowq = (size_t)b * SEQ + tq;
    const bf16* Pb = P + (size_t)b * SEQ * DINP;
    bf16x8 qf[4];
#pragma unroll
    for (int ks = 0; ks < 4; ++ks) qf[ks] = scale_frag(*(const bf16x8*)(P + rowq * DINP + C_BQ + h * 64 + ks * 16 + hi * 8), SCL2);
    f32x16 o0, o1;
#pragma unroll
    for (int r = 0; r < 16; ++r) { o0[r] = zf_(); o1[r] = o0[r]; }
    float l = 0.f;
    { MobaOwnPol pol; pol.nt = 4; pol.nmask = 4; pol.stride = DINP; pol.own = qb; pol.tq = tq; pol.hi = hi; pol.Pk = Pb + C_BK + h * 64; pol.Pv = Pb + C_BV + h * 64;
      attn_pipe(pol, lds, qf, row_negm(qf, kmax), o0, o1, l, tid); }
    l += shx<32>(l);
    int t2 = tid; asm volatile("" : "+v"(t2));
    const int l2 = t2 & 63, r2 = l2 & 31, h2 = l2 >> 5, w2 = t2 >> 6;
    const size_t token = (size_t)b * SEQ + qb * 256 + w2 * 32 + r2;
    const int ns = __popc(SELB[(size_t)bh * SEQ + qb * 256 + w2 * 32 + r2]);
    for (int s = 0; s < 3; ++s) { if (!__any(s < ns)) break;
        if (s < ns) { const unsigned char* pp = moba_part(P, token, h, s);
#pragma unroll
            for (int g = 0; g < 4; ++g) { const uint2 w0 = *(const uint2*)(pp + (8 * g + 4 * h2) * 2), w1 = *(const uint2*)(pp + (32 + 8 * g + 4 * h2) * 2);
                o0[4 * g] += __builtin_bit_cast(float, w0.x << 16); o0[4 * g + 1] += __builtin_bit_cast(float, w0.x & 0xffff0000u); o0[4 * g + 2] += __builtin_bit_cast(float, w0.y << 16); o0[4 * g + 3] += __builtin_bit_cast(float, w0.y & 0xffff0000u);
                o1[4 * g] += __builtin_bit_cast(float, w1.x << 16); o1[4 * g + 1] += __builtin_bit_cast(float, w1.x & 0xffff0000u); o1[4 * g + 2] += __builtin_bit_cast(float, w1.y << 16); o1[4 * g + 3] += __builtin_bit_cast(float, w1.y & 0xffff0000u); }
            l += *(const float*)(pp + 128); } }
    const float inv = rcpf_(l);
    bf16* op = MIX + token * DM + 512 + h * 64 + 4 * h2;
#pragma unroll
    for (int g = 0; g < 4; ++g) {
        uint2 w0, w1;
        w0.x = cvtpk(o0[4 * g] * inv, o0[4 * g + 1] * inv); w0.y = cvtpk(o0[4 * g + 2] * inv, o0[4 * g + 3] * inv);
        w1.x = cvtpk(o1[4 * g] * inv, o1[4 * g + 1] * inv); w1.y = cvtpk(o1[4 * g + 2] * inv, o1[4 * g + 3] * inv);
        *(uint2*)(op + 8 * g) = w0; *(uint2*)(op + 32 + 8 * g) = w1;
    }
}
constexpr int MK_ENUM_OFF = 4 * STG + 512;
__device__ __forceinline__ void moba_kv_phase(bf16* __restrict__ P, const unsigned* __restrict__ SELB, const int* __restrict__ CNTQ, const unsigned char* __restrict__ LISTG, const float* __restrict__ kgain,
                                              int bid, int G, int tid, LAS unsigned char* lds) {
    asm volatile("" : "+v"(tid));
    LAS int* nch = (LAS int*)(lds + MK_ENUM_OFF);
    const float kmax = gain_kmax(kgain, tid & 63);
    { const int bh = tid >> 5, n = tid & 31; int T = 0;
      for (int q = n + 1; q < 32; ++q) T += (CNTQ[((size_t)bh * 32 + q) * 32 + n] + 31) >> 5;
      nch[tid] = (T + 15) >> 4; }
    __syncthreads();
    if (tid < 64) {
        int v[8], s = 0;
#pragma unroll
        for (int k = 0; k < 8; ++k) { s += nch[tid * 8 + k]; v[k] = s; }
        int incl = s;
#pragma unroll
        for (int o = 1; o < 64; o <<= 1) { const int t = __shfl_up(incl, o); if (tid >= o) incl += t; }
        const int base = incl - s;
#pragma unroll
        for (int k = 0; k < 8; ++k) nch[tid * 8 + k] = v[k] + base; }
    __syncthreads();
    const int total = nch[511];
    for (int cid = bid; cid < total; cid += G) {
        int lo = 0, hi_ = 511; while (lo < hi_) { const int mid = (lo + hi_) >> 1; if (nch[mid] > cid) hi_ = mid; else lo = mid + 1; }
        const int pair = lo, c = cid - (pair ? nch[pair - 1] : 0);
        moba_kv_chunk(P, SELB, CNTQ, LISTG, kmax, pair >> 5, pair & 31, c, tid, lds);
    }
    __syncthreads();
}

constexpr int NSA_S4_OFF = PIPE_BYTES, NSA_L4_OFF = NSA_S4_OFF + 8 * 8 * 128 * 4, NSA_SM_OFF = NSA_L4_OFF + 8 * 8 * 128 * 4;
struct NsaCtx { const bf16* Pb; const bf16* Kcb; const bf16* Vcb; int b, jq, tid, lane, wid, r32, hi, tq; unsigned mk0, mk1, mk2, mk3; };

template <int MODE>
__device__ __forceinline__ void nsa_tiles(const NsaCtx& c, LAS unsigned char* lds, const bf16x8 (&qf)[4], int nt, f32x16& o0, f32x16& o1, float& m, float& l, float pre) {
    const int tid = c.tid, lane = c.lane, r32 = c.r32, hi = c.hi, tq = c.tq, jq = c.jq;
    const int nw = (jq < 8 ? jq : 8) + 1;
    auto tile_of = [&](int i) -> int { return MODE < 2 ? i : (i == 0 ? jq : (MODE == 2 ? i - 1 : jq - nw + i)); };
    auto src_of = [&](int t) -> TileSrc {
        if (MODE < 2) return TileSrc{c.Kcb + (size_t)t * 64 * 64, c.Vcb + (size_t)t * 64 * 64, 64};
        if (MODE == 2) return TileSrc{c.Pb + (size_t)t * 64 * DINP + C_NKS, c.Pb + (size_t)t * 64 * DINP + C_NVS, DINP};
        return TileSrc{c.Pb + (size_t)t * 64 * DINP + C_NKW, c.Pb + (size_t)t * 64 * DINP + C_NVW, DINP};
    };
    u32x4v kr, vr;
    { const TileSrc s = src_of(tile_of(0)); tile_load(kr, vr, s, tid); }
    tile_store(lds, kr, vr, tid);
    __syncthreads();
    const int ncv = (tq >= 31) ? ((tq - 31) >> 4) + 1 : 0;
    for (int i = 0; i < nt; ++i) {
        const int tile = tile_of(i);
        if (i + 1 < nt) { const TileSrc s = src_of(tile_of(i + 1)); tile_load(kr, vr, s, tid); }
        LAS const unsigned char* buf = lds + (i & 1) * STG;
        const int kbase = tile * 64;
        bool rowsel = true;
        if (MODE == 2 && tile != jq) { const unsigned w = (tile >> 5) == 0 ? c.mk0 : (tile >> 5) == 1 ? c.mk1 : (tile >> 5) == 2 ? c.mk2 : c.mk3; rowsel = (w >> (tile & 31)) & 1u; }
        if (MODE != 2 || __any(rowsel)) {
            f32x16 p0, p1;
            qk_tile(p0, p1, buf, qf, r32, hi, MODE < 2 ? 0.f : (rowsel ? -m : NEGBIG));
            if (MODE < 2) {
#pragma unroll
                for (int r = 0; r < 16; ++r) { const int k0 = kbase + crow(r, hi); p0[r] = (k0 < ncv) ? p0[r] : NEGBIG; p1[r] = (k0 + 32 < ncv) ? p1[r] : NEGBIG; }
            } else if (MODE == 2) {
                if (tile == jq) {
#pragma unroll
                    for (int r = 0; r < 16; ++r) { const int k0 = kbase + crow(r, hi); p0[r] = (k0 <= tq) ? p0[r] : NEGBIG; p1[r] = (k0 + 32 <= tq) ? p1[r] : NEGBIG; }
                }
            } else if (tile == jq || tile + 8 == jq) {
#pragma unroll
                for (int r = 0; r < 16; ++r) { const int k0 = kbase + crow(r, hi);
                    p0[r] = (k0 <= tq && k0 + 511 >= tq) ? p0[r] : NEGBIG; p1[r] = (k0 + 32 <= tq && k0 + 32 + 511 >= tq) ? p1[r] : NEGBIG; }
            }
            if (MODE == 0) {
                float tm = fmaxf(p0[0], p1[0]);
#pragma unroll
                for (int r = 1; r < 16; ++r) tm = fmaxf(tm, fmaxf(p0[r], p1[r]));
                tm = fmaxf(tm, shx<32>(tm));
                const float mn = fmaxf(m, tm); float s = 0.f;
#pragma unroll
                for (int r = 0; r < 16; ++r) { s += (p0[r] > -1e29f ? __builtin_amdgcn_exp2f(p0[r] - mn) : 0.f) + (p1[r] > -1e29f ? __builtin_amdgcn_exp2f(p1[r] - mn) : 0.f); }
                l = l * __builtin_amdgcn_exp2f(m - mn) + s; m = mn;
            } else if (MODE == 1) {
#pragma unroll
                for (int r = 0; r < 16; ++r) { p0[r] = (p0[r] > -1e29f) ? __builtin_amdgcn_exp2f(p0[r] - m) * pre : 0.f; p1[r] = (p1[r] > -1e29f) ? __builtin_amdgcn_exp2f(p1[r] - m) * pre : 0.f; }
                pv_tile(o0, o1, buf + KBUF, p0, p1, lane);
                LAS float* S4 = (LAS float*)(lds + NSA_S4_OFF) + (c.wid * 8 + (r32 & 7)) * 128; LAS float* L4 = (LAS float*)(lds + NSA_L4_OFF) + (c.wid * 8 + (r32 & 7)) * 128;
#pragma unroll
                for (int mbk = 0; mbk < 2; ++mbk)
#pragma unroll
                    for (int g = 0; g < 4; ++g) {
                        float s4 = mbk ? (p1[4 * g] + p1[4 * g + 1]) + (p1[4 * g + 2] + p1[4 * g + 3]) : (p0[4 * g] + p0[4 * g + 1]) + (p0[4 * g + 2] + p0[4 * g + 3]);
                        float la = mbk ? p1[4 * g + 3] : p0[4 * g + 3];
                        s4 += shx<8>(s4); s4 += shx<16>(s4); la += shx<8>(la); la += shx<16>(la);
                        const int gi = tile * 16 + 8 * mbk + 2 * g + hi;
                        if (r32 < 8) { S4[gi] = s4; L4[gi] = la; }
                    }
            } else {
                softmax_tile(p0, p1, o0, o1, m, l, i == 0);
                pv_tile(o0, o1, buf + KBUF, p0, p1, lane);
            }
        }
        if (i + 1 < nt) tile_store(lds + ((i + 1) & 1) * STG, kr, vr, tid);
        __syncthreads();
    }
}

struct NsaSelPol {
    int nt, nmask, stride, jq, tq, hi; unsigned long long mlo, mhi; const bf16* Pk; const bf16* Pv;
    __device__ __forceinline__ int tile_of(int i) const { return i == 0 ? jq : i - 1; }
    __device__ __forceinline__ const bf16* kptr(int i) const { return Pk + (size_t)tile_of(i) * 64 * DINP; }
    __device__ __forceinline__ const bf16* vptr(int i) const { return Pv + (size_t)tile_of(i) * 64 * DINP; }
    __device__ __forceinline__ bool rowsel(int i) const { if (i == 0) return true; const int tile = i - 1; const unsigned long long w = tile < 64 ? mlo : mhi; return (w >> (tile & 63)) & 1ull; }
    __device__ __forceinline__ void mask(int i, f32x16& p0, f32x16& p1) const {
        if (i == 0) { const int kbase = jq * 64;
#pragma unroll
            for (int r = 0; r < 16; ++r) { const int k0 = kbase + crow(r, hi); p0[r] = (k0 <= tq) ? p0[r] : NEGBIG; p1[r] = (k0 + 32 <= tq) ? p1[r] : NEGBIG; } }
    }
};
struct NsaWinPol {
    int nt, nmask, stride, jq, tq, hi; const bf16* Pk; const bf16* Pv;
    __device__ __forceinline__ int tile_of(int i) const { return i == 0 ? jq : jq - nt + i; }
    __device__ __forceinline__ const bf16* kptr(int i) const { return Pk + (size_t)tile_of(i) * 64 * DINP; }
    __device__ __forceinline__ const bf16* vptr(int i) const { return Pv + (size_t)tile_of(i) * 64 * DINP; }
    __device__ __forceinline__ bool rowsel(int) const { return true; }
    __device__ __forceinline__ void mask(int i, f32x16& p0, f32x16& p1) const {
        const int tile = tile_of(i);
        if (tile == jq || tile + 8 == jq) { const int kbase = tile * 64;
#pragma unroll
            for (int r = 0; r < 16; ++r) { const int k0 = kbase + crow(r, hi);
                p0[r] = (k0 <= tq && k0 + 511 >= tq) ? p0[r] : NEGBIG; p1[r] = (k0 + 32 <= tq && k0 + 32 + 511 >= tq) ? p1[r] : NEGBIG; } }
    }
};
__device__ __forceinline__ void nsa_unit(const bf16* __restrict__ P, const float* __restrict__ G, const float* __restrict__ tab, const bf16* __restrict__ KVcb, const float* __restrict__ kgain  , bf16* __restrict__ MIX,
                                         int b, int jq, int tid, LAS unsigned char* lds) {
    asm volatile("" : "+v"(tid));
    NsaCtx c; c.b = b; c.jq = jq; c.tid = tid; c.lane = tid & 63; c.wid = __builtin_amdgcn_readfirstlane(tid >> 6); c.r32 = c.lane & 31; c.hi = c.lane >> 5;
    const int qi = c.r32 & 7, hh = c.r32 >> 3, hi = c.hi, lane = c.lane;
    c.tq = jq * 64 + c.wid * 8 + qi;
    c.Pb = P + (size_t)b * SEQ * DINP; c.Kcb = KVcb + (size_t)b * 512 * 64; c.Vcb = KVcb + ((size_t)NB + b) * 512 * 64;
    c.mk0 = c.mk1 = c.mk2 = c.mk3 = 0u;
    const size_t rowq = (size_t)b * SEQ + c.tq;
    bf16x8 qf[4];
#pragma unroll
    for (int ks = 0; ks < 4; ++ks) qf[ks] = scale_frag(*(const bf16x8*)(P + rowq * DINP + C_NQ + hh * 64 + ks * 16 + hi * 8), SCL2);
    const float g0 = sigmoidf_(G[rowq * 32 + 8 + hh]);
    { LAS float* gl = (LAS float*)(lds + NSA_SM_OFF + 1024); gl[tid] = sigmoidf_(G[rowq * 32 + 12 + hh]); gl[512 + tid] = sigmoidf_(G[rowq * 32 + 16 + hh]); }
    f32x16 a0, a1;
    {
        const int ncvmax = min(4 * jq + 3, NCMP), nct = (ncvmax + 63) >> 6;
        f32x16 o0, o1;
#pragma unroll
        for (int r = 0; r < 16; ++r) { o0[r] = zf_(); o1[r] = o0[r]; }
        float m = NEGBIG, l = 0.f;
        nsa_tiles<0>(c, lds, qf, nct, o0, o1, m, l, 0.f);
        l += shx<32>(l);
        const float pre = (l > 0.f) ? rcpf_(l) : 0.f;
        nsa_tiles<1>(c, lds, qf, nct, o0, o1, m, l, pre);
#pragma unroll
        for (int r = 0; r < 16; ++r) { a0[r] = g0 * o0[r]; a1[r] = g0 * o1[r]; }
    }
    {
        LAS unsigned* sm = (LAS unsigned*)(lds + NSA_SM_OFF);
        for (int q = 0; q < 8; ++q) {
            LAS const float* S4 = (LAS const float*)(lds + NSA_S4_OFF) + (c.wid * 8 + q) * 128; LAS const float* L4 = (LAS const float*)(lds + NSA_L4_OFF) + (c.wid * 8 + q) * 128;
            float v0, v1;
            { const int n = lane; const bool causal = n <= jq, forced = causal && (n == 0 || n >= jq - 1);
              float im = 0.f; if (causal) { im = S4[n]; if (n > 0) im += L4[n - 1]; }
              v0 = forced ? 1e9f : (causal ? im : -1e30f); }
            { const int n = lane + 64; const bool causal = n <= jq, forced = causal && (n >= jq - 1);
              float im = 0.f; if (causal) { im = S4[n] + L4[n - 1]; }
              v1 = forced ? 1e9f : (causal ? im : -1e30f); }
            const unsigned b0_ = __float_as_uint(v0), b1_ = __float_as_uint(v1);
            const unsigned u0 = b0_ ^ ((b0_ >> 31) ? 0xFFFFFFFFu : 0x80000000u), u1 = b1_ ^ ((b1_ >> 31) ? 0xFFFFFFFFu : 0x80000000u);
            unsigned T = 0u;
#pragma unroll
            for (int bit = 31; bit >= 0; --bit) { const unsigned cand = T | (1u << bit);
                const int cn = __popcll(__ballot(u0 >= cand)) + __popcll(__ballot(u1 >= cand));
                if (cn >= 16) T = cand; }
            const unsigned long long g0b = __ballot(u0 > T), g1b = __ballot(u1 > T), e0b = __ballot(u0 == T), e1b = __ballot(u1 == T);
            const int rem = 16 - (__popcll(g0b) + __popcll(g1b));
            const unsigned long long ltm = (1ull << lane) - 1ull;
            const unsigned long long sel0 = g0b | __ballot(u0 == T && __popcll(e0b & ltm) < rem);
            const unsigned long long sel1 = g1b | __ballot(u1 == T && __popcll(e0b) + __popcll(e1b & ltm) < rem);
            if (lane == 0) { sm[(c.wid * 8 + q) * 4 + 0] = (unsigned)sel0; sm[(c.wid * 8 + q) * 4 + 1] = (unsigned)(sel0 >> 32); sm[(c.wid * 8 + q) * 4 + 2] = (unsigned)sel1; sm[(c.wid * 8 + q) * 4 + 3] = (unsigned)(sel1 >> 32); }
        }
        __builtin_amdgcn_s_waitcnt(0xc07f); __builtin_amdgcn_wave_barrier();
        c.mk0 = sm[(c.wid * 8 + qi) * 4 + 0]; c.mk1 = sm[(c.wid * 8 + qi) * 4 + 1]; c.mk2 = sm[(c.wid * 8 + qi) * 4 + 2]; c.mk3 = sm[(c.wid * 8 + qi) * 4 + 3];
    }
    LAS float* stash = (LAS float*)(lds + NSA_S4_OFF) + c.wid * 1024 + lane;
    LAS float* stash2 = (LAS float*)(lds + NSA_L4_OFF) + c.wid * 1024 + lane;
#pragma unroll
    for (int r = 0; r < 16; ++r) { stash[r * 64] = a0[r]; stash2[r * 64] = a1[r]; }
    {
        const u32x4v qw = __builtin_bit_cast(u32x4v, qf[0]); u32x4v w;
#pragma unroll
        for (int e = 0; e < 4; ++e) {
            float y[2];
#pragma unroll
            for (int k = 0; k < 2; ++k) { const int j = 2 * e + k; const float x = k ? __builtin_bit_cast(float, qw[e] & 0xffff0000u) : __builtin_bit_cast(float, qw[e] << 16); const float other = shx<32>(x);
                const float cs = tab[c.tq * 16 + j], sn = tab[c.tq * 16 + 8 + j]; y[k] = hi ? (x * cs + other * sn) : (x * cs - other * sn); }
            w[e] = cvtpk(y[0], y[1]);
        }
        qf[0] = __builtin_bit_cast(bf16x8, w);
    }
    {
        f32x16 o0, o1;
#pragma unroll
        for (int r = 0; r < 16; ++r) { o0[r] = zf_(); o1[r] = o0[r]; }
        float l = 0.f;
        NsaSelPol pol; pol.nt = jq + 1; pol.nmask = 1; pol.stride = DINP; pol.jq = jq; pol.tq = c.tq; pol.hi = hi; pol.mlo = (unsigned long long)c.mk0 | ((unsigned long long)c.mk1 << 32); pol.mhi = (unsigned long long)c.mk2 | ((unsigned long long)c.mk3 << 32); pol.Pk = c.Pb + C_NKS; pol.Pv = c.Pb + C_NVS;
        attn_pipe(pol, lds, qf, row_negm(qf, gain_kmax(kgain + 64, lane)), o0, o1, l, tid);
        l += shx<32>(l);
        int t2 = tid; asm volatile("" : "+v"(t2));
        const float sc = ((LAS const float*)(lds + NSA_SM_OFF + 1024))[t2] * rcpf_(l);
        LAS float* st1 = (LAS float*)(lds + NSA_S4_OFF) + (t2 >> 6) * 1024 + (t2 & 63); LAS float* st2 = (LAS float*)(lds + NSA_L4_OFF) + (t2 >> 6) * 1024 + (t2 & 63);
#pragma unroll
        for (int r = 0; r < 16; ++r) { st1[r * 64] = fmaf(sc, o0[r], st1[r * 64]); st2[r * 64] = fmaf(sc, o1[r], st2[r * 64]); }
    }
    {
        f32x16 o0, o1;
#pragma unroll
        for (int r = 0; r < 16; ++r) { o0[r] = zf_(); o1[r] = o0[r]; }
        float l = 0.f;
        NsaWinPol pol; pol.nt = (jq < 8 ? jq : 8) + 1; pol.nmask = 2; pol.stride = DINP; pol.jq = jq; pol.tq = c.tq; pol.hi = hi; pol.Pk = c.Pb + C_NKW; pol.Pv = c.Pb + C_NVW;
        attn_pipe(pol, lds, qf, row_negm(qf, gain_kmax(kgain + 128, lane)), o0, o1, l, tid);
        l += shx<32>(l);
        int t2 = tid; asm volatile("" : "+v"(t2));
        const float sc = ((LAS const float*)(lds + NSA_SM_OFF + 1024))[512 + t2] * rcpf_(l);
        LAS const float* st1 = (LAS const float*)(lds + NSA_S4_OFF) + (t2 >> 6) * 1024 + (t2 & 63); LAS const float* st2 = (LAS const float*)(lds + NSA_L4_OFF) + (t2 >> 6) * 1024 + (t2 & 63);
#pragma unroll
        for (int r = 0; r < 16; ++r) { a0[r] = fmaf(sc, o0[r], st1[r * 64]); a1[r] = fmaf(sc, o1[r], st2[r * 64]); }
    }
    int t3 = tid; asm volatile("" : "+v"(t3));
    const int ln3 = t3 & 63, r3 = ln3 & 31;
    bf16* op = MIX + ((size_t)b * SEQ + jq * 64 + (t3 >> 6) * 8 + (r3 & 7)) * DM + 768 + (r3 >> 3) * 64 + 4 * (ln3 >> 5);
#pragma unroll
    for (int g = 0; g < 4; ++g) {
        uint2 w0, w1;
        w0.x = cvtpk(a0[4 * g], a0[4 * g + 1]); w0.y = cvtpk(a0[4 * g + 2], a0[4 * g + 3]);
        w1.x = cvtpk(a1[4 * g], a1[4 * g + 1]); w1.y = cvtpk(a1[4 * g + 2], a1[4 * g + 3]);
        *(uint2*)(op + 8 * g) = w0; *(uint2*)(op + 32 + 8 * g) = w1;
    }
}


constexpr int MQ_PITCH = 272, MV_PITCH = 320;
constexpr int ML_G_OFF = 0;
constexpr int ML_Q_OFF = 4096;
constexpr int ML_K_OFF = ML_Q_OFF + 64 * MQ_PITCH;
constexpr int ML_V_OFF = ML_K_OFF + 64 * MV_PITCH;
constexpr int ML_END = ML_V_OFF + 64 * MV_PITCH;
static_assert(ML_END <= 131072, "mlstm LDS");
constexpr float KSCALE = 0.08838834764831845f;

__device__ __forceinline__ void qk2_rows(const bf16* __restrict__ P, const float* __restrict__ cw, bf16* __restrict__ QK2, int bid, int G, int tid) {
    asm volatile("" : "+v"(tid));
    const int ch = tid & 127, c0 = ch * 8;
    float tp[4][8];
#pragma unroll
    for (int j = 0; j < 4; ++j) { const float4 a = *(const float4*)(cw + j * 1024 + c0), b4 = *(const float4*)(cw + j * 1024 + c0 + 4);
        tp[j][0] = a.x; tp[j][1] = a.y; tp[j][2] = a.z; tp[j][3] = a.w; tp[j][4] = b4.x; tp[j][5] = b4.y; tp[j][6] = b4.z; tp[j][7] = b4.w; }
    const float sc = (c0 >= 512) ? KSCALE : 1.f;
    for (int row0 = bid * 4 + (tid >> 7); row0 < T; row0 += G * 16) {
        u32x4v w[4][4];
#pragma unroll
        for (int q = 0; q < 4; ++q) { const int row = row0 + q * G * 4, t = row & (SEQ - 1);
#pragma unroll
            for (int j = 0; j < 4; ++j) { w[q][j] = u32x4v{0u, 0u, 0u, 0u}; if (row < T && t - 3 + j >= 0) w[q][j] = *(const u32x4v*)(P + (size_t)(row - 3 + j) * DINP + c0); } }
#pragma unroll
        for (int q = 0; q < 4; ++q) { const int row = row0 + q * G * 4;
            float y[8];
#pragma unroll
            for (int e = 0; e < 8; ++e) y[e] = 0.f;
#pragma unroll
            for (int j = 0; j < 4; ++j)
#pragma unroll
                for (int e = 0; e < 4; ++e) { y[2 * e] = fmaf(tp[j][2 * e], __builtin_bit_cast(float, w[q][j][e] << 16), y[2 * e]); y[2 * e + 1] = fmaf(tp[j][2 * e + 1], __builtin_bit_cast(float, w[q][j][e] & 0xffff0000u), y[2 * e + 1]); }
#pragma unroll
            for (int e = 0; e < 8; ++e) y[e] = y[e] * rcpf_(1.f + __expf(-y[e])) * sc;
            u32x4v o; o[0] = cvtpk(y[0], y[1]); o[1] = cvtpk(y[2], y[3]); o[2] = cvtpk(y[4], y[5]); o[3] = cvtpk(y[6], y[7]);
            if (row < T) *(u32x4v*)(QK2 + (size_t)row * 1024 + c0) = o; }
    }
}

struct MlRaw { u32x4v q[2], k[2], v[2]; float gf, gi; };
template <bool WITH_Q> __device__ __forceinline__ void ml_load(MlRaw& r, const bf16* __restrict__ P, const bf16* __restrict__ QK2, const float* __restrict__ G, const float* __restrict__ bif, int u, int tid) {
    const int c = u & 127, h = (u >> 7) & 3, b = u >> 9, row0 = b * SEQ + c * 64, s = tid >> 3;
#pragma unroll
    for (int pass = 0; pass < 2; ++pass) { const int ch = (tid & 7) + 8 * pass;
        if (WITH_Q) r.q[pass] = *(const u32x4v*)(QK2 + (size_t)(row0 + s) * 1024 + h * 128 + ch * 8);
        r.k[pass] = *(const u32x4v*)(QK2 + (size_t)(row0 + s) * 1024 + 512 + h * 128 + ch * 8);
        r.v[pass] = *(const u32x4v*)(P + (size_t)(row0 + s) * DINP + C_MV + h * 128 + ch * 8); }
    if (tid < 64) { r.gf = G[(size_t)(row0 + tid) * 32 + 4 + h] + bif[4 + h]; r.gi = G[(size_t)(row0 + tid) * 32 + h] + bif[h]; }
}
__device__ __forceinline__ void mlstm_gates(const MlRaw& r, int tid, LAS float* gs) {
    if (tid < 64) { gs[tid] = log_sigmoidf_(r.gf); gs[128 + tid] = r.gi; }
    __syncthreads();
    if (tid < 64) { float a = 0.f; for (int s = 0; s <= tid; ++s) a += gs[s]; gs[64 + tid] = a; }
    __syncthreads();
}

__device__ __forceinline__ void mlstm_m1_phase(const bf16* __restrict__ P, const bf16* __restrict__ QK2, const float* __restrict__ G, const float* __restrict__ bif,
                                               bf16* __restrict__ CT, float* __restrict__ nst, float* __restrict__ dec, int bid, int Gd, int tid, LAS unsigned char* lds) {
    asm volatile("" : "+v"(tid));
    const int lane = tid & 63, wid = __builtin_amdgcn_readfirstlane(tid >> 6), hi = lane >> 5;
    LAS float* gs = (LAS float*)(lds + ML_G_OFF);
    MlRaw raw;
    if (bid < 2048) ml_load<false>(raw, P, QK2, G, bif, bid, tid);
    for (int u = bid; u < 2048; u += Gd) {
        mlstm_gates(raw, tid, gs);
        if (tid == 0) dec[u] = __expf(gs[64 + 63]);
        {
            const int s = tid >> 3; const float ws = __expf(gs[64 + 63] - gs[64 + s] + gs[128 + s]);
#pragma unroll
            for (int pass = 0; pass < 2; ++pass) { const int ch = (tid & 7) + 8 * pass; u32x4v w;
#pragma unroll
                for (int e = 0; e < 4; ++e) w[e] = cvtpk(__builtin_bit_cast(float, raw.k[pass][e] << 16) * ws, __builtin_bit_cast(float, raw.k[pass][e] & 0xffff0000u) * ws);
                *(LAS u32x4v*)(lds + ML_K_OFF + s * MV_PITCH + ch * 16) = w;
                *(LAS u32x4v*)(lds + ML_V_OFF + s * MV_PITCH + ch * 16) = raw.v[pass]; }
        }
        if (u + Gd < 2048) ml_load<false>(raw, P, QK2, G, bif, u + Gd, tid);
        __syncthreads();
        const int g = lane >> 4, i = lane & 15;
        const int mb = wid >> 1, nb0 = 2 * (wid & 1);
        f32x16 acc0, acc1;
#pragma unroll
        for (int r = 0; r < 16; ++r) { acc0[r] = zf_(); acc1[r] = acc0[r]; }
        LAS const unsigned char* trb = lds + (4 * hi + (i >> 2)) * MV_PITCH + (16 * (g & 1) + 4 * (i & 3)) * 2;
#pragma unroll
        for (int ks = 0; ks < 4; ++ks) {
            const s16x4 alo = lds_tr(trb + ML_K_OFF + ks * 16 * MV_PITCH + mb * 64), ahi = lds_tr(trb + ML_K_OFF + ks * 16 * MV_PITCH + 8 * MV_PITCH + mb * 64);
            const bf16x8 af = {alo[0], alo[1], alo[2], alo[3], ahi[0], ahi[1], ahi[2], ahi[3]};
            const s16x4 b0lo = lds_tr(trb + ML_V_OFF + ks * 16 * MV_PITCH + nb0 * 64), b0hi = lds_tr(trb + ML_V_OFF + ks * 16 * MV_PITCH + 8 * MV_PITCH + nb0 * 64);
            const s16x4 b1lo = lds_tr(trb + ML_V_OFF + ks * 16 * MV_PITCH + (nb0 + 1) * 64), b1hi = lds_tr(trb + ML_V_OFF + ks * 16 * MV_PITCH + 8 * MV_PITCH + (nb0 + 1) * 64);
            const bf16x8 bf0 = {b0lo[0], b0lo[1], b0lo[2], b0lo[3], b0hi[0], b0hi[1], b0hi[2], b0hi[3]}, bf1 = {b1lo[0], b1lo[1], b1lo[2], b1lo[3], b1hi[0], b1hi[1], b1hi[2], b1hi[3]};
            acc0 = __builtin_amdgcn_mfma_f32_32x32x16_bf16(af, bf0, acc0, 0, 0, 0);
            acc1 = __builtin_amdgcn_mfma_f32_32x32x16_bf16(af, bf1, acc1, 0, 0, 0);
        }
        bf16* ct = CT + (size_t)u * 16384;
#pragma unroll
        for (int gq = 0; gq < 4; ++gq) { const int d0 = 32 * mb + 8 * gq + 4 * hi;
            uint2 w0, w1; w0.x = cvtpk(acc0[4 * gq], acc0[4 * gq + 1]); w0.y = cvtpk(acc0[4 * gq + 2], acc0[4 * gq + 3]); w1.x = cvtpk(acc1[4 * gq], acc1[4 * gq + 1]); w1.y = cvtpk(acc1[4 * gq + 2], acc1[4 * gq + 3]);
            *(uint2*)(ct + (size_t)(32 * nb0 + (lane & 31)) * 128 + d0) = w0; *(uint2*)(ct + (size_t)(32 * (nb0 + 1) + (lane & 31)) * 128 + d0) = w1; }
        if (tid < 128) { float a = 0.f; for (int s = 0; s < 64; ++s) a += bf2f(*(LAS const bf16*)(lds + ML_K_OFF + s * MV_PITCH + tid * 2)); nst[(size_t)u * 128 + tid] = a; }
        __syncthreads();
    }
}
__device__ __forceinline__ void mlstm_scan(bf16* __restrict__ CT, float* __restrict__ nst, const float* __restrict__ dec, int item, int tid) {
    asm volatile("" : "+v"(tid));
    const int bh = item / 9, part = item % 9;
    if (part < 8) {
        bf16* base = CT + (size_t)bh * 128 * 16384 + (part * 512 + tid) * 4;
        float C[4]; C[0] = zf_(); C[1] = C[0]; C[2] = C[0]; C[3] = C[0];
        for (int c0 = 0; c0 < 128; c0 += 16) {
            uint2 w[16];
#pragma unroll
            for (int k = 0; k < 16; ++k) w[k] = *(const uint2*)(base + (size_t)(c0 + k) * 16384);
#pragma unroll
            for (int k = 0; k < 16; ++k) { const float a = dec[bh * 128 + c0 + k];
                uint2 o; o.x = cvtpk(C[0], C[1]); o.y = cvtpk(C[2], C[3]); *(uint2*)(base + (size_t)(c0 + k) * 16384) = o;
                C[0] = fmaf(a, C[0], __builtin_bit_cast(float, w[k].x << 16)); C[1] = fmaf(a, C[1], __builtin_bit_cast(float, w[k].x & 0xffff0000u));
                C[2] = fmaf(a, C[2], __builtin_bit_cast(float, w[k].y << 16)); C[3] = fmaf(a, C[3], __builtin_bit_cast(float, w[k].y & 0xffff0000u)); }
        }
    } else if (tid < 128) {
        float* base = nst + (size_t)bh * 128 * 128 + tid; float C = 0.f;
        for (int c = 0; c < 128; ++c) { const float dC = base[(size_t)c * 128]; base[(size_t)c * 128] = C; C = dec[bh * 128 + c] * C + dC; }
    }
}

__device__ __forceinline__ void mlstm_m3_phase(const bf16* __restrict__ P, const bf16* __restrict__ QK2, const float* __restrict__ G, const float* __restrict__ bif,
                                               const bf16* __restrict__ CT, const float* __restrict__ nst, const float* __restrict__ mnorm, bf16* __restrict__ MIX, int bid, int Gd, int tid, LAS unsigned char* lds) {
    asm volatile("" : "+v"(tid));
    const int lane = tid & 63, wid = __builtin_amdgcn_readfirstlane(tid >> 6), hi = lane >> 5, r32 = lane & 31;
    LAS float* gs = (LAS float*)(lds + ML_G_OFF);
    MlRaw raw;
    if (bid < 2048) ml_load<true>(raw, P, QK2, G, bif, bid, tid);
    for (int u = bid; u < 2048; u += Gd) {
    const int c = u & 127, h = (u >> 7) & 3, b = u >> 9, t0 = c * 64;
    const int tb = wid & 1, eb = wid >> 1, t = 32 * tb + r32;
    bf16x8 cf[8]; uint2 opre[4]; float npv = 0.f;
    { const bf16* ctp = CT + (size_t)u * 16384 + (size_t)(32 * eb + r32) * 128 + hi * 8;
#pragma unroll
      for (int ks = 0; ks < 8; ++ks) cf[ks] = *(const bf16x8*)(ctp + ks * 16);
      const size_t row_ = (size_t)b * SEQ + t0 + t;
#pragma unroll
      for (int gq = 0; gq < 4; ++gq) opre[gq] = *(const uint2*)(P + row_ * DINP + C_MO + h * 128 + 32 * eb + 8 * gq + 4 * hi);
      if (tid >= 128 && tid < 256) npv = nst[(size_t)u * 128 + tid - 128]; }
    if (tid >= 128 && tid < 256) gs[256 + tid - 128] = npv;
    mlstm_gates(raw, tid, gs);
    {
        const int s = tid >> 3;
#pragma unroll
        for (int pass = 0; pass < 2; ++pass) { const int ch = (tid & 7) + 8 * pass;
            *(LAS u32x4v*)(lds + ML_Q_OFF + s * MQ_PITCH + ch * 16) = raw.q[pass];
            *(LAS u32x4v*)(lds + ML_K_OFF + s * MQ_PITCH + ch * 16) = raw.k[pass];
            *(LAS u32x4v*)(lds + ML_V_OFF + s * MV_PITCH + ch * 16) = raw.v[pass]; }
    }
    if (u + Gd < 2048) ml_load<true>(raw, P, QK2, G, bif, u + Gd, tid);
    __syncthreads();
    bf16x8 qf[8];
#pragma unroll
    for (int ks = 0; ks < 8; ++ks) qf[ks] = *(LAS const bf16x8*)(lds + ML_Q_OFF + t * MQ_PITCH + ks * 32 + hi * 16);
    f32x16 ni;
#pragma unroll
    for (int r = 0; r < 16; ++r) ni[r] = zf_();
#pragma unroll
    for (int ks = 0; ks < 8; ++ks) ni = __builtin_amdgcn_mfma_f32_32x32x16_bf16(cf[ks], qf[ks], ni, 0, 0, 0);
    f32x16 p0, p1;
#pragma unroll
    for (int r = 0; r < 16; ++r) { p0[r] = zf_(); p1[r] = p0[r]; }
    { LAS const unsigned char* ka = lds + ML_K_OFF + r32 * MQ_PITCH + hi * 16;
#pragma unroll
      for (int ks = 0; ks < 8; ++ks) { const bf16x8 a0 = *(LAS const bf16x8*)(ka + ks * 32); p0 = __builtin_amdgcn_mfma_f32_32x32x16_bf16(a0, qf[ks], p0, 0, 0, 0); }
      if (tb == 1) {
#pragma unroll
          for (int ks = 0; ks < 8; ++ks) { const bf16x8 a1 = *(LAS const bf16x8*)(ka + 32 * MQ_PITCH + ks * 32); p1 = __builtin_amdgcn_mfma_f32_32x32x16_bf16(a1, qf[ks], p1, 0, 0, 0); } } }
    const float bt = gs[64 + t], Ft = __expf(bt);
    float dsum = 0.f;
#pragma unroll
    for (int r = 0; r < 16; ++r) { const int s0 = crow(r, hi);
        { const float w = (s0 <= t) ? __expf(bt - gs[64 + s0] + gs[128 + s0]) : 0.f; p0[r] *= w; dsum += p0[r]; }
        { const int s1 = s0 + 32; const float w = (s1 <= t) ? __expf(bt - gs[64 + s1] + gs[128 + s1]) : 0.f; p1[r] *= w; dsum += p1[r]; } }
    float qn = 0.f;
#pragma unroll
    for (int ks = 0; ks < 8; ++ks)
#pragma unroll
        for (int j = 0; j < 8; ++j) qn = fmaf(bf2f((bf16)qf[ks][j]), gs[256 + ks * 16 + hi * 8 + j], qn);
    dsum += shx<32>(dsum); qn += shx<32>(qn);
    const float den = dsum + Ft * qn, inv = rcpf_(fmaxf(fabsf(den), 1.f));
    f32x16 na;
#pragma unroll
    for (int r = 0; r < 16; ++r) na[r] = zf_();
    { const int g = lane >> 4, i = lane & 15;
      LAS const unsigned char* trb = lds + ML_V_OFF + (4 * hi + (i >> 2)) * MV_PITCH + (16 * (g & 1) + 4 * (i & 3)) * 2 + eb * 64;
#pragma unroll
      for (int ss = 0; ss < 4; ++ss) { if (ss >= 2 && tb == 0) break;
          unsigned w[4];
#pragma unroll
          for (int e = 0; e < 4; ++e) { const int r = 8 * (ss & 1) + 2 * e; w[e] = (ss < 2) ? cvtpk(p0[r], p0[r + 1]) : cvtpk(p1[r], p1[r + 1]); }
          const u32x4v wv = {w[0], w[1], w[2], w[3]}; const bf16x8 pf = __builtin_bit_cast(bf16x8, wv);
          const s16x4 lo = lds_tr(trb + ss * 16 * MV_PITCH), hi4 = lds_tr(trb + ss * 16 * MV_PITCH + 8 * MV_PITCH);
          const bf16x8 vt = {lo[0], lo[1], lo[2], lo[3], hi4[0], hi4[1], hi4[2], hi4[3]};
          na = __builtin_amdgcn_mfma_f32_32x32x16_bf16(vt, pf, na, 0, 0, 0); } }
    float ssq = 0.f;
#pragma unroll
    for (int r = 0; r < 16; ++r) { na[r] = (na[r] + Ft * ni[r]) * inv; ssq += na[r] * na[r]; }
    ssq += shx<32>(ssq);
    if (hi == 0) gs[384 + eb * 64 + t] = ssq;
    __syncthreads();
    const float rstd = rsqrtf((gs[384 + t] + gs[384 + 64 + t] + gs[384 + 128 + t] + gs[384 + 192 + t]) * (1.f / 128.f) + EPS);
    const size_t row = (size_t)b * SEQ + t0 + t;
#pragma unroll
    for (int gq = 0; gq < 4; ++gq) { const int cc = h * 128 + 32 * eb + 8 * gq + 4 * hi;
        const uint2 ow = opre[gq]; const float4 mn = *(const float4*)(mnorm + cc);
        const float o0 = sigmoidf_(__builtin_bit_cast(float, ow.x << 16)), o1 = sigmoidf_(__builtin_bit_cast(float, ow.x & 0xffff0000u)), o2 = sigmoidf_(__builtin_bit_cast(float, ow.y << 16)), o3 = sigmoidf_(__builtin_bit_cast(float, ow.y & 0xffff0000u));
        uint2 w; w.x = cvtpk(na[4 * gq] * rstd * mn.x * o0, na[4 * gq + 1] * rstd * mn.y * o1); w.y = cvtpk(na[4 * gq + 2] * rstd * mn.z * o2, na[4 * gq + 3] * rstd * mn.w * o3);
        *(uint2*)(MIX + row * DM + cc) = w; }
    __syncthreads();
    }
}


typedef float f32x4v __attribute__((ext_vector_type(4)));
__device__ __forceinline__ void compress_item(const bf16* __restrict__ P, const bf16* __restrict__ w1t  , const float* __restrict__ c1  , const float* __restrict__ w2  ,
                                              const float* __restrict__ kg0, bf16* __restrict__ KVcb, int item, int tid, LAS unsigned char* lds) {
    asm volatile("" : "+v"(tid));
    const int lane = tid & 63, wid = __builtin_amdgcn_readfirstlane(tid >> 6), hi = lane >> 5, r32 = lane & 31;
    const int kv = item >> 6, b = (item >> 4) & 3, i0 = (item & 15) * 32;
    const int cb = wid & 3, kh = wid >> 2;
    const int irow = min(i0 + r32, NCMP - 1);
    const bf16* xa = P + ((size_t)b * SEQ + 16 * irow + 16 * kh) * DINP + (kv ? C_NVC : C_NKC) + hi * 8;
    const bf16* wb = w1t + ((size_t)kv * 128 + 32 * cb + r32) * 2048 + kh * 1024 + hi * 8;
    f32x16 acc;
#pragma unroll
    for (int r = 0; r < 16; ++r) acc[r] = zf_();
    for (int p0 = 0; p0 < 16; p0 += 4) {
        bf16x8 af[16], bfr[16];
#pragma unroll
        for (int q = 0; q < 16; ++q) { const int p = p0 + (q >> 2), dq = q & 3;
            af[q] = *(const bf16x8*)(xa + (size_t)p * DINP + dq * 16); bfr[q] = *(const bf16x8*)(wb + p * 64 + dq * 16); }
#pragma unroll
        for (int q = 0; q < 16; ++q) acc = __builtin_amdgcn_mfma_f32_32x32x16_bf16(af[q], bfr[q], acc, 0, 0, 0);
    }
    LAS float* hid = (LAS float*)lds + kh * 32 * 132;
    { LAS f32x4v* w2s = (LAS f32x4v*)(lds + 2 * 32 * 132 * 4); const f32x4v* w2g = (const f32x4v*)(w2 + (size_t)kv * 128 * 64);
#pragma unroll
      for (int q = 0; q < 4; ++q) w2s[tid + 512 * q] = w2g[tid + 512 * q]; }
#pragma unroll
    for (int r = 0; r < 16; ++r) hid[crow(r, hi) * 132 + 32 * cb + r32] = acc[r];
    __syncthreads();
    {
        const int il = tid >> 4, d0 = (tid & 15) * 4;
        float o[4] = {0.f, 0.f, 0.f, 0.f};
        LAS const float* ha = (LAS const float*)lds + il * 132; LAS const float* hb = ha + 32 * 132;
        LAS const float* wp = (LAS const float*)(lds + 2 * 32 * 132 * 4) + d0;
        const float* cj = c1 + kv * 128;
#pragma unroll 8
        for (int j = 0; j < 128; ++j) { const float a = ha[j] + hb[j] + cj[j]; const float hv = a * rcpf_(1.f + __expf(-a)); const f32x4v wa = *(LAS const f32x4v*)(wp + j * 64);
            o[0] = fmaf(hv, wa[0], o[0]); o[1] = fmaf(hv, wa[1], o[1]); o[2] = fmaf(hv, wa[2], o[2]); o[3] = fmaf(hv, wa[3], o[3]); }
        if (kv == 0) { float ss = o[0] * o[0] + o[1] * o[1] + o[2] * o[2] + o[3] * o[3];
            ss += shx<1>(ss); ss += shx<2>(ss); ss += shx<4>(ss); ss += shx<8>(ss);
            const float rstd = rsqrtf(ss * (1.f / 64.f) + EPS);
#pragma unroll
            for (int e = 0; e < 4; ++e) o[e] *= rstd * kg0[d0 + e]; }
        const int i = i0 + il;
        if (i >= NCMP) { o[0] = zf_(); o[1] = o[0]; o[2] = o[0]; o[3] = o[0]; }
        uint2 w; w.x = cvtpk(o[0], o[1]); w.y = cvtpk(o[2], o[3]);
        *(uint2*)(KVcb + (((size_t)kv * NB + b) * 512 + i) * 64 + d0) = w;
    }
    __syncthreads();
}
__device__ __forceinline__ void cmp_c1_item(const float* __restrict__ pe, const float* __restrict__ w1, float* __restrict__ c1, int item, int tid, LAS unsigned char* lds) {
    const int lk = item >> 4, j0 = (item & 15) * 8, jj = tid & 7, kk = tid >> 3;
    const float* pp = pe + (size_t)lk * 2048; const float* ww = w1 + (size_t)lk * 2048 * 128 + j0 + jj;
    float a = 0.f;
#pragma unroll 8
    for (int k = kk; k < 2048; k += 64) a = fmaf(pp[k], ww[(size_t)k * 128], a);
    LAS float* red = (LAS float*)lds;
    red[tid] = a;
    __syncthreads();
    if (tid < 8) { float s = 0.f; for (int q = 0; q < 64; ++q) s += red[q * 8 + tid]; c1[lk * 128 + j0 + tid] = s; }
    __syncthreads();
}

#define XB_TMO      128
#define XB_XCNT(j)  (256  + 64 * (j))
#define XB_XSUB(j)  (1280 + 64 * (j))
#define XB_XGEN(j)  (2304 + 64 * (j))
#define XB_TOP      3328
#define XB_TOPGEN   3392
#define XCD_BAR_WORDS 3456
#define XB_SPIN_CAP (1u << 22)

__device__ __forceinline__ unsigned xb_ld(unsigned* p)              { return __hip_atomic_load(p, __ATOMIC_RELAXED, __HIP_MEMORY_SCOPE_AGENT); }
__device__ __forceinline__ unsigned xb_add(unsigned* p, unsigned v) { return __hip_atomic_fetch_add(p, v, __ATOMIC_RELAXED, __HIP_MEMORY_SCOPE_AGENT); }
__device__ __forceinline__ unsigned xb_xcc_id() { return (unsigned)__builtin_amdgcn_s_getreg((3 << 11) | 20) & 0xFu; }
#define XB_SPIN(cond, bar) do { unsigned _sp = 0; while (cond) { __builtin_amdgcn_s_sleep(1); \
    if ((++_sp & 255u) == 0u) { if (xb_ld(&(bar)[XB_TMO])) break; if (_sp > XB_SPIN_CAP) { atomicAdd(&(bar)[XB_TMO], 1u); break; } } } } while (0)

struct XcdBarrier {
    unsigned* bar; unsigned x;
    volatile LAS unsigned* st;
};

__device__ __forceinline__ XcdBarrier xcd_barrier_post(unsigned* bar, volatile LAS unsigned* st) {
    XcdBarrier b; b.bar = bar; b.x = xb_xcc_id(); b.st = st;
    if (threadIdx.x == 0) (void)xb_add(&bar[XB_XCNT(b.x)], 1u);
    return b;
}
__device__ __forceinline__ void xcd_barrier_complete(unsigned* bar, unsigned x, unsigned& nloc, unsigned& nx) {
    const unsigned G = gridDim.x * gridDim.y * gridDim.z;
    unsigned sum, cnt, mine, sp = 0u;
    for (;;) {
        sum = 0u; cnt = 0u; mine = 0u;
#pragma unroll
        for (unsigned j = 0; j < 16; ++j) { const unsigned c = xb_ld(&bar[XB_XCNT(j)]); sum += c; cnt += (c > 0u) ? 1u : 0u; mine = (j == x) ? c : mine; }
        if (sum == G) break;
        __builtin_amdgcn_s_sleep(1);
        if ((++sp & 255u) == 0u) { if (xb_ld(&bar[XB_TMO])) break; if (sp > XB_SPIN_CAP) { atomicAdd(&bar[XB_TMO], 1u); break; } }
    }
    nloc = mine > 0u ? mine : 1u; nx = cnt > 0u ? cnt : 1u;
}

__device__ __forceinline__ void xcd_barrier(const XcdBarrier& b) {
    asm volatile("s_waitcnt vmcnt(0)" ::: "memory");
    __syncthreads();
    if (threadIdx.x == 0) {
        unsigned* bar = b.bar;
        __builtin_amdgcn_s_waitcnt(0);
        unsigned nloc = b.st[0], nx = b.st[1];
        if (nloc == 0u) { xcd_barrier_complete(bar, b.x, nloc, nx); b.st[0] = nloc; b.st[1] = nx; }
        const unsigned old = xb_add(&bar[XB_XSUB(b.x)], 1u);
        const unsigned gen = old / nloc;
        if (old + 1u == (gen + 1u) * nloc) {
            __builtin_amdgcn_fence(__ATOMIC_RELEASE, "agent");
            asm volatile("s_waitcnt vmcnt(0)" ::: "memory");
            const unsigned og = xb_add(&bar[XB_TOP], 1u);
            const unsigned tg = og / nx;
            if (og + 1u == (tg + 1u) * nx) xb_add(&bar[XB_TOPGEN], 1u);
            else XB_SPIN(xb_ld(&bar[XB_TOPGEN]) == tg, bar);
            __builtin_amdgcn_fence(__ATOMIC_ACQUIRE, "agent");
            xb_add(&bar[XB_XGEN(b.x)], 1u);
            asm volatile("s_waitcnt vmcnt(0)" ::: "memory");
        } else {
            XB_SPIN(xb_ld(&bar[XB_XGEN(b.x)]) == gen, bar);
            __builtin_amdgcn_fence(__ATOMIC_ACQUIRE, "agent");
            asm volatile("s_waitcnt vmcnt(0)" ::: "memory");
        }
    }
    __syncthreads();
}


constexpr int M2_G_OFF = 0, M2_STG_OFF = 4096, M2_KIMG = 64 * MQ_PITCH, M2_VIMG = 64 * MV_PITCH, M2_STG = M2_KIMG + M2_VIMG;
static_assert(M2_STG_OFF + 2 * M2_STG <= 131072, "mlstm256 LDS");
__device__ __forceinline__ void ml256_gates(const float* __restrict__ G, const float* __restrict__ bif, int row0, int h, int tid, LAS float* gs) {
    if (tid < 256) { gs[tid] = log_sigmoidf_(G[(size_t)(row0 + tid) * 32 + 4 + h] + bif[4 + h]); gs[512 + tid] = G[(size_t)(row0 + tid) * 32 + h] + bif[h]; }
    __syncthreads();
    if (tid < 256) { float a = 0.f;
#pragma unroll 8
        for (int s = 0; s <= tid; ++s) a += gs[s];
        gs[256 + tid] = a; }
    __syncthreads();
}
struct Ml2Raw { u32x4v k[2], v[2]; };
__device__ __forceinline__ void ml2_load(Ml2Raw& r, const bf16* __restrict__ P, const bf16* __restrict__ QK2, int row0, int h, int tid) {
    const int s = tid >> 3;
#pragma unroll
    for (int pass = 0; pass < 2; ++pass) { const int ch = (tid & 7) + 8 * pass;
        r.k[pass] = *(const u32x4v*)(QK2 + (size_t)(row0 + s) * 1024 + 512 + h * 128 + ch * 8);
        r.v[pass] = *(const u32x4v*)(P + (size_t)(row0 + s) * DINP + C_MV + h * 128 + ch * 8); }
}
__device__ __forceinline__ void ml256_m1_phase(const bf16* __restrict__ P, const bf16* __restrict__ QK2, const float* __restrict__ G, const float* __restrict__ bif,
                                               bf16* __restrict__ CT, float* __restrict__ nst, float* __restrict__ dec, int bid, int Gd, int tid, LAS unsigned char* lds) {
    asm volatile("" : "+v"(tid));
    const int lane = tid & 63, wid = __builtin_amdgcn_readfirstlane(tid >> 6), hi = lane >> 5;
    LAS float* gs = (LAS float*)(lds + M2_G_OFF);
    for (int u = bid; u < 512; u += Gd) {
        const int sc = u & 31, h = (u >> 5) & 3, b = u >> 7, row0 = b * SEQ + sc * 256;
        Ml2Raw raw; ml2_load(raw, P, QK2, row0, h, tid);
        ml256_gates(G, bif, row0, h, tid, gs);
        if (tid == 0) dec[u] = __expf(gs[256 + 255]);
        const int g = lane >> 4, i = lane & 15;
        const int mb = wid >> 1, nb0 = 2 * (wid & 1);
        f32x16 acc0, acc1;
#pragma unroll
        for (int r = 0; r < 16; ++r) { acc0[r] = zf_(); acc1[r] = acc0[r]; }
        float an = 0.f;
        for (int st = 0; st < 4; ++st) {
            LAS unsigned char* stg = lds + M2_STG_OFF + (st & 1) * (2 * M2_VIMG);
            { const int s = tid >> 3; const float ws = __expf(gs[256 + 255] - gs[256 + st * 64 + s] + gs[512 + st * 64 + s]);
#pragma unroll
              for (int pass = 0; pass < 2; ++pass) { const int ch = (tid & 7) + 8 * pass; u32x4v w;
#pragma unroll
                  for (int e = 0; e < 4; ++e) w[e] = cvtpk(__builtin_bit_cast(float, raw.k[pass][e] << 16) * ws, __builtin_bit_cast(float, raw.k[pass][e] & 0xffff0000u) * ws);
                  *(LAS u32x4v*)(stg + s * MV_PITCH + ch * 16) = w;
                  *(LAS u32x4v*)(stg + M2_VIMG + s * MV_PITCH + ch * 16) = raw.v[pass]; } }
            if (st + 1 < 4) ml2_load(raw, P, QK2, row0 + (st + 1) * 64, h, tid);
            __syncthreads();
            LAS const unsigned char* trb = stg + (4 * hi + (i >> 2)) * MV_PITCH + (16 * (g & 1) + 4 * (i & 3)) * 2;
#pragma unroll
            for (int ks = 0; ks < 4; ++ks) {
                const s16x4 alo = lds_tr(trb + ks * 16 * MV_PITCH + mb * 64), ahi = lds_tr(trb + ks * 16 * MV_PITCH + 8 * MV_PITCH + mb * 64);
                const bf16x8 af = {alo[0], alo[1], alo[2], alo[3], ahi[0], ahi[1], ahi[2], ahi[3]};
                const s16x4 b0lo = lds_tr(trb + M2_VIMG + ks * 16 * MV_PITCH + nb0 * 64), b0hi = lds_tr(trb + M2_VIMG + ks * 16 * MV_PITCH + 8 * MV_PITCH + nb0 * 64);
                const s16x4 b1lo = lds_tr(trb + M2_VIMG + ks * 16 * MV_PITCH + (nb0 + 1) * 64), b1hi = lds_tr(trb + M2_VIMG + ks * 16 * MV_PITCH + 8 * MV_PITCH + (nb0 + 1) * 64);
                const bf16x8 bf0 = {b0lo[0], b0lo[1], b0lo[2], b0lo[3], b0hi[0], b0hi[1], b0hi[2], b0hi[3]}, bf1 = {b1lo[0], b1lo[1], b1lo[2], b1lo[3], b1hi[0], b1hi[1], b1hi[2], b1hi[3]};
                acc0 = __builtin_amdgcn_mfma_f32_32x32x16_bf16(af, bf0, acc0, 0, 0, 0);
                acc1 = __builtin_amdgcn_mfma_f32_32x32x16_bf16(af, bf1, acc1, 0, 0, 0);
            }
            if (tid < 128) { for (int s = 0; s < 64; ++s) an += bf2f(*(LAS const bf16*)(stg + s * MV_PITCH + tid * 2)); }
        }
        bf16* ct = CT + (size_t)u * 16384;
#pragma unroll
        for (int gq = 0; gq < 4; ++gq) { const int d0 = 32 * mb + 8 * gq + 4 * hi;
            uint2 w0, w1; w0.x = cvtpk(acc0[4 * gq], acc0[4 * gq + 1]); w0.y = cvtpk(acc0[4 * gq + 2], acc0[4 * gq + 3]); w1.x = cvtpk(acc1[4 * gq], acc1[4 * gq + 1]); w1.y = cvtpk(acc1[4 * gq + 2], acc1[4 * gq + 3]);
            *(uint2*)(ct + (size_t)(32 * nb0 + (lane & 31)) * 128 + d0) = w0; *(uint2*)(ct + (size_t)(32 * (nb0 + 1) + (lane & 31)) * 128 + d0) = w1; }
        if (tid < 128) nst[(size_t)u * 128 + tid] = an;
        __syncthreads();
    }
}
__device__ __forceinline__ void ml256_scan(bf16* __restrict__ CT, float* __restrict__ nst, const float* __restrict__ dec, int item, int tid) {
    asm volatile("" : "+v"(tid));
    const int bh = item / 9, part = item % 9;
    if (part < 8) {
        bf16* base = CT + (size_t)bh * 32 * 16384 + (part * 512 + tid) * 4;
        float C[4]; C[0] = zf_(); C[1] = C[0]; C[2] = C[0]; C[3] = C[0];
        for (int c0 = 0; c0 < 32; c0 += 16) {
            uint2 w[16];
#pragma unroll
            for (int k = 0; k < 16; ++k) w[k] = *(const uint2*)(base + (size_t)(c0 + k) * 16384);
#pragma unroll
            for (int k = 0; k < 16; ++k) { const float a = dec[bh * 32 + c0 + k];
                uint2 o; o.x = cvtpk(C[0], C[1]); o.y = cvtpk(C[2], C[3]); *(uint2*)(base + (size_t)(c0 + k) * 16384) = o;
                C[0] = fmaf(a, C[0], __builtin_bit_cast(float, w[k].x << 16)); C[1] = fmaf(a, C[1], __builtin_bit_cast(float, w[k].x & 0xffff0000u));
                C[2] = fmaf(a, C[2], __builtin_bit_cast(float, w[k].y << 16)); C[3] = fmaf(a, C[3], __builtin_bit_cast(float, w[k].y & 0xffff0000u)); }
        }
    } else if (tid < 128) {
        float* base = nst + (size_t)bh * 32 * 128 + tid; float C = 0.f;
        for (int c = 0; c < 32; ++c) { const float dC = base[(size_t)c * 128]; base[(size_t)c * 128] = C; C = dec[bh * 32 + c] * C + dC; }
    }
}
__device__ __forceinline__ void ml256_m3_phase(const bf16* __restrict__ P, const bf16* __restrict__ QK2, const float* __restrict__ G, const float* __restrict__ bif,
                                               const bf16* __restrict__ CT, const float* __restrict__ nst, const float* __restrict__ mnorm, bf16* __restrict__ MIX, int bid, int Gd, int tid, LAS unsigned char* lds) {
    asm volatile("" : "+v"(tid));
    const int lane = tid & 63, wid = __builtin_amdgcn_readfirstlane(tid >> 6), hi = lane >> 5, r32 = lane & 31;
    LAS float* gs = (LAS float*)(lds + M2_G_OFF);
    for (int u = bid; u < 512; u += Gd) {
        const int sc = u & 31, h = (u >> 5) & 3, b = u >> 7, row0 = b * SEQ + sc * 256;
        const int t = 32 * wid + r32; const size_t rowt = (size_t)row0 + t;
        auto stage_load = [&](int kt, u32x4v (&kk)[2], u32x4v (&vv)[2]) { const int s = tid >> 3;
#pragma unroll
            for (int pass = 0; pass < 2; ++pass) { const int ch = (tid & 7) + 8 * pass;
                kk[pass] = *(const u32x4v*)(QK2 + (size_t)(row0 + kt * 64 + s) * 1024 + 512 + h * 128 + ch * 8);
                vv[pass] = *(const u32x4v*)(P + (size_t)(row0 + kt * 64 + s) * DINP + C_MV + h * 128 + ch * 8); } };
        auto stage_store = [&](int kt, const u32x4v (&kk)[2], const u32x4v (&vv)[2]) { LAS unsigned char* stg = lds + M2_STG_OFF + (kt & 1) * M2_STG; const int s = tid >> 3;
#pragma unroll
            for (int pass = 0; pass < 2; ++pass) { const int ch = (tid & 7) + 8 * pass;
                *(LAS u32x4v*)(stg + s * MQ_PITCH + ch * 16) = kk[pass]; *(LAS u32x4v*)(stg + M2_KIMG + s * MV_PITCH + ch * 16) = vv[pass]; } };
        u32x4v kk[2], vv[2]; stage_load(0, kk, vv);
        bf16x8 qf[8];
#pragma unroll
        for (int ks = 0; ks < 8; ++ks) qf[ks] = *(const bf16x8*)(QK2 + rowt * 1024 + h * 128 + ks * 16 + hi * 8);
        if (tid >= 256 && tid < 384) gs[768 + tid - 256] = nst[(size_t)u * 128 + tid - 256];
        ml256_gates(G, bif, row0, h, tid, gs);
        stage_store(0, kk, vv);
        __syncthreads();
        f32x16 N0, N1, N2, N3;
#pragma unroll
        for (int r = 0; r < 16; ++r) { N0[r] = zf_(); N1[r] = N0[r]; N2[r] = N0[r]; N3[r] = N0[r]; }
        const float bt = gs[256 + t], Ft = __expf(bt);
        float dsum = 0.f;
        const int ktmax = wid >> 1;
        for (int kt = 0; kt < 4; ++kt) {
            if (kt + 1 < 4) stage_load(kt + 1, kk, vv);
            if (kt <= ktmax) {
                LAS const unsigned char* stg = lds + M2_STG_OFF + (kt & 1) * M2_STG;
                f32x16 p0, p1;
#pragma unroll
                for (int r = 0; r < 16; ++r) { p0[r] = zf_(); p1[r] = p0[r]; }
                LAS const unsigned char* ka = stg + r32 * MQ_PITCH + hi * 16;
#pragma unroll
                for (int ks = 0; ks < 8; ++ks) { const bf16x8 a0 = *(LAS const bf16x8*)(ka + ks * 32), a1 = *(LAS const bf16x8*)(ka + 32 * MQ_PITCH + ks * 32);
                    p0 = __builtin_amdgcn_mfma_f32_32x32x16_bf16(a0, qf[ks], p0, 0, 0, 0); p1 = __builtin_amdgcn_mfma_f32_32x32x16_bf16(a1, qf[ks], p1, 0, 0, 0); }
#pragma unroll
                for (int r = 0; r < 16; ++r) { const int s0 = kt * 64 + crow(r, hi), s1 = s0 + 32;
                    { const float w = (s0 <= t) ? __expf(bt - gs[256 + s0] + gs[512 + s0]) : 0.f; p0[r] *= w; dsum += p0[r]; }
                    { const float w = (s1 <= t) ? __expf(bt - gs[256 + s1] + gs[512 + s1]) : 0.f; p1[r] *= w; dsum += p1[r]; } }
                bf16x8 pf[4];
#pragma unroll
                for (int s = 0; s < 4; ++s) { u32x4v w;
#pragma unroll
                    for (int e = 0; e < 4; ++e) { const int r = 8 * (s & 1) + 2 * e; w[e] = (s < 2) ? cvtpk(p0[r], p0[r + 1]) : cvtpk(p1[r], p1[r + 1]); }
                    pf[s] = __builtin_bit_cast(bf16x8, w); }
                const int g = lane >> 4, i = lane & 15;
                LAS const unsigned char* trb = stg + M2_KIMG + (4 * hi + (i >> 2)) * MV_PITCH + (16 * (g & 1) + 4 * (i & 3)) * 2;
#pragma unroll
                for (int s = 0; s < 4; ++s) {
#pragma unroll
                    for (int eb = 0; eb < 4; ++eb) {
                        const s16x4 lo = lds_tr(trb + s * 16 * MV_PITCH + eb * 64), hi4 = lds_tr(trb + s * 16 * MV_PITCH + 8 * MV_PITCH + eb * 64);
                        const bf16x8 vt = {lo[0], lo[1], lo[2], lo[3], hi4[0], hi4[1], hi4[2], hi4[3]};
                        if (eb == 0) N0 = __builtin_amdgcn_mfma_f32_32x32x16_bf16(vt, pf[s], N0, 0, 0, 0);
                        else if (eb == 1) N1 = __builtin_amdgcn_mfma_f32_32x32x16_bf16(vt, pf[s], N1, 0, 0, 0);
                        else if (eb == 2) N2 = __builtin_amdgcn_mfma_f32_32x32x16_bf16(vt, pf[s], N2, 0, 0, 0);
                        else N3 = __builtin_amdgcn_mfma_f32_32x32x16_bf16(vt, pf[s], N3, 0, 0, 0);
                    } }
            }
            if (kt + 1 < 4) stage_store(kt + 1, kk, vv);
            __syncthreads();
        }
        float qn = 0.f;
#pragma unroll
        for (int ks = 0; ks < 8; ++ks)
#pragma unroll
            for (int j = 0; j < 8; ++j) qn = fmaf(bf2f((bf16)qf[ks][j]), gs[768 + ks * 16 + hi * 8 + j], qn);
        dsum += shx<32>(dsum); qn += shx<32>(qn);
        const float den = dsum + Ft * qn, inv = rcpf_(fmaxf(fabsf(den), 1.f));
        float ssq = 0.f;
#pragma unroll
        for (int eb = 0; eb < 4; ++eb) {
            const bf16* ctp = CT + (size_t)u * 16384 + (size_t)(32 * eb + r32) * 128 + hi * 8;
            bf16x8 cf[8];
#pragma unroll
            for (int ks = 0; ks < 8; ++ks) cf[ks] = *(const bf16x8*)(ctp + ks * 16);
            f32x16 ni;
#pragma unroll
            for (int r = 0; r < 16; ++r) ni[r] = zf_();
#pragma unroll
            for (int ks = 0; ks < 8; ++ks) ni = __builtin_amdgcn_mfma_f32_32x32x16_bf16(cf[ks], qf[ks], ni, 0, 0, 0);
            f32x16& Nx = eb == 0 ? N0 : eb == 1 ? N1 : eb == 2 ? N2 : N3;
#pragma unroll
            for (int r = 0; r < 16; ++r) { Nx[r] = (Nx[r] + Ft * ni[r]) * inv; ssq += Nx[r] * Nx[r]; }
        }
        ssq += shx<32>(ssq);
        const float rstd = rsqrtf(ssq * (1.f / 128.f) + EPS);
#pragma unroll
        for (int eb = 0; eb < 4; ++eb) { const f32x16& Nx = eb == 0 ? N0 : eb == 1 ? N1 : eb == 2 ? N2 : N3;
#pragma unroll
            for (int gq = 0; gq < 4; ++gq) { const int cc = h * 128 + 32 * eb + 8 * gq + 4 * hi;
                const uint2 ow = *(const uint2*)(P + rowt * DINP + C_MO + cc); const float4 mn = *(const float4*)(mnorm + cc);
                const float o0 = sigmoidf_(__builtin_bit_cast(float, ow.x << 16)), o1 = sigmoidf_(__builtin_bit_cast(float, ow.x & 0xffff0000u)), o2 = sigmoidf_(__builtin_bit_cast(float, ow.y << 16)), o3 = sigmoidf_(__builtin_bit_cast(float, ow.y & 0xffff0000u));
                uint2 w; w.x = cvtpk(Nx[4 * gq] * rstd * mn.x * o0, Nx[4 * gq + 1] * rstd * mn.y * o1); w.y = cvtpk(Nx[4 * gq + 2] * rstd * mn.z * o2, Nx[4 * gq + 3] * rstd * mn.w * o3);
                *(uint2*)(MIX + rowt * DM + cc) = w; } }
        __syncthreads();
    }
}

constexpr size_t MiB = 1u << 20;
constexpr size_t W_LAYER = (size_t)(DINP + DM + DFF) * DM + (size_t)DM * DFF;
constexpr size_t WS_W = 0;
constexpr size_t WS_HM = 52 * MiB;
constexpr size_t WS_G = 116 * MiB;
constexpr size_t WS_SMALL = 120 * MiB;
constexpr size_t WS_TAB = WS_SMALL, WS_KMEAN = WS_SMALL + 512 * 1024, WS_KVC = WS_SMALL + 1 * MiB, WS_NST = WS_SMALL + 2 * MiB, WS_DEC = WS_SMALL + 3 * MiB, WS_KVCB = WS_SMALL + 3 * MiB + 512 * 1024;
constexpr size_t WS_SSP = 476 * MiB;
constexpr size_t WS_BAR = WS_SMALL + 3 * MiB + 64 * 1024;
constexpr size_t WS_W1T = 50 * MiB, WS_C1 = WS_SMALL + 3 * MiB + 16 * 1024;
constexpr size_t WS_P = 124 * MiB;
constexpr size_t WS_C = 348 * MiB;
constexpr size_t WS_U = WS_P;
constexpr size_t WS_SELB = 478 * MiB, WS_CNTQ = WS_SELB + 512 * 1024, WS_LISTG = WS_CNTQ + 64 * 1024;
constexpr size_t WS_END = 484 * MiB;
static_assert(W_LAYER * 2 * DEPTH <= 50 * MiB && WS_W1T + (size_t)DEPTH * 2 * 128 * 2048 * 2 <= 52 * MiB, "weights");
static_assert((size_t)T * DINP * 2 == 224 * MiB && (size_t)T * DFF * 2 == 256 * MiB, "sizes");

#ifndef DUP_PRO
#define DUP_PRO 1
#endif
#ifndef DUP_QK2
#define DUP_QK2 1
#endif
#ifndef DUP_GEMM
#define DUP_GEMM 1
#endif
#ifndef DUP_M1
#define DUP_M1 1
#endif
#ifndef DUP_MOBA
#define DUP_MOBA 1
#endif
#ifndef DUP_NSA
#define DUP_NSA 1
#endif
#ifndef DUP_M3
#define DUP_M3 1
#endif
#ifndef DUP_CMP
#define DUP_CMP 1
#endif
struct Params { const float* in[16]; float* out; unsigned char* ws; };
static_assert(sizeof(Params) == 18 * 8, "kernarg layout: in[k] at 8k, out at 128, ws at 136");
constexpr int LDS_BYTES = 147456;

__global__ void __launch_bounds__(512, 2) hybrid_fwd(Params prm) {
    extern __shared__ __attribute__((aligned(16))) unsigned char lds[];
    cg::grid_group grid = cg::this_grid();
    constexpr int NPH = 1 + DEPTH * 8;
    volatile LAS unsigned* xst = (volatile LAS unsigned*)((LAS unsigned char*)lds + 131072 + 1024);
    if (threadIdx.x < 2) xst[threadIdx.x] = 0u;
    __syncthreads();
    (void)xcd_barrier_post((unsigned*)(prm.ws + WS_BAR), xst);
    for (int ph = 0; ph < NPH; ++ph) {
        int tid = threadIdx.x; asm volatile("" : "+v"(tid));
        int G = gridDim.x, bid = blockIdx.x; asm volatile("" : "+s"(G), "+s"(bid));
#define PH_LOCALS const int half = tid >> 8, t256 = tid & 255, lane = tid & 63, wid = __builtin_amdgcn_readfirstlane(tid >> 6); unsigned char* smh = lds + half * 65536; \
        const int vb = bid * 2 + half, NVB = G * 2, gwv = bid * 8 + wid, NGW = G * 8; (void)lane; (void)smh; (void)vb; (void)NVB; (void)gwv; (void)NGW; (void)t256;
        const __attribute__((address_space(4))) unsigned char* ka = (const __attribute__((address_space(4))) unsigned char*)__builtin_amdgcn_kernarg_segment_ptr(); asm volatile("" : "+s"(ka));
#define KARG(T_, off) (*(T_ const __attribute__((address_space(4)))*)(ka + (off)))
#define IN(k) KARG(const float*, 8 * (k))
        unsigned char* ws = KARG(unsigned char*, 8 * 17); float* out = KARG(float*, 8 * 16);
        bf16* Wb = (bf16*)(ws + WS_W); bf16* HM = (bf16*)(ws + WS_HM); float* Gt = (float*)(ws + WS_G); float* tab = (float*)(ws + WS_TAB); float* kmean = (float*)(ws + WS_KMEAN);
        float* KVc = (float*)(ws + WS_KVC); float* nst = (float*)(ws + WS_NST); float* dec = (float*)(ws + WS_DEC); bf16* KVcb = (bf16*)(ws + WS_KVCB); bf16* W1t = (bf16*)(ws + WS_W1T); float* C1 = (float*)(ws + WS_C1); bf16* P = (bf16*)(ws + WS_P); bf16* CT = (bf16*)(ws + WS_C); unsigned* SELB = (unsigned*)(ws + WS_SELB); int* CNTQ = (int*)(ws + WS_CNTQ); unsigned char* LISTG = ws + WS_LISTG; bf16* QK2 = (bf16*)(ws + WS_C + 64 * MiB); bf16* XB = QK2  ; unsigned long long* SSA = (unsigned long long*)(ws + WS_SSP); unsigned long long* SSB = SSA + T;     bf16* U = (bf16*)(ws + WS_U);
        const int l = ph == 0 ? 0 : (ph - 1) / 8, j = ph == 0 ? -1 : (ph - 1) % 8;
        const float* x = IN(0);
        const float* xin = l == 0 ? x : out;
        const bf16* WinT = Wb + l * W_LAYER; const bf16* WoT = WinT + (size_t)DINP * DM; const bf16* W1T = WoT + (size_t)DM * DM; const bf16* W2T = W1T + (size_t)DFF * DM;
        if (ph == 0) {
            PH_LOCALS
            const float* w_in = IN(1); const float* w_out = IN(11); const float* w_ff1 = IN(14); const float* w_ff2 = IN(15);
            for (int rep = 0; rep < DUP_PRO; ++rep) {
            for (int ll = 0; ll < DEPTH; ++ll) {
                bf16* WinT_ = Wb + ll * W_LAYER; bf16* WoT_ = WinT_ + (size_t)DINP * DM; bf16* W1T_ = WoT_ + (size_t)DM * DM; bf16* W2T_ = W1T_ + (size_t)DFF * DM;
                for (int mt = 0; mt < 4; ++mt) {
                    const float* W; int K, N, NP, mode; bf16* WT;
                    const float* gk = nullptr;
                    if (mt == 0) { W = w_in + (size_t)ll * DM * DIN; K = DM; N = DIN; NP = DINP; WT = WinT_; mode = 1; gk = IN(12) + ll * DM; }
                    else if (mt == 1) { W = w_out + (size_t)ll * DM * DM; K = DM; N = DM; NP = DM; WT = WoT_; mode = 0; }
                    else if (mt == 2) { W = w_ff1 + (size_t)ll * DM * DFF; K = DM; N = DFF; NP = DFF; WT = W1T_; mode = 0; gk = IN(13) + ll * DM; }
                    else { W = w_ff2 + (size_t)ll * DFF * DM; K = DFF; N = DM; NP = DM; WT = W2T_; mode = 0; }
                    const int nit = (NP / 64) * (K / 64);
                    for (int it0 = 0; it0 < nit; it0 += NVB) { const int it = it0 + vb; ph_convert_w(W, K, N, NP, WT, mode, it, it < nit, t256, (float*)smh, gk); }
                }
            }
            for (int lk = 0; lk < DEPTH * 2; ++lk) {
                const int nit = 2 * 32;
                for (int it0 = 0; it0 < nit; it0 += NVB) { const int it = it0 + vb; ph_convert_w(IN(9) + (size_t)lk * 2048 * 128, 2048, 128, 128, W1t + (size_t)lk * 128 * 2048, 0, it, it < nit, t256, (float*)smh); }
            }
            for (int it = bid; it < 64; it += G) cmp_c1_item(IN(8), IN(9), C1, it, tid, (LAS unsigned char*)lds);
            for (int i = bid * 512 + tid; i < SEQ * 8; i += G * 512) { const int pos = i >> 3, f = i & 7;
                float c_, s_; rope_cs(pos, f, c_, s_);
                tab[pos * 16 + f] = c_; tab[pos * 16 + 8 + f] = s_; }
            for (int row = gwv; row < T; row += 2 * NGW) { ph_x_row(x, XB, SSA, row, lane); if (row + NGW < T) ph_x_row(x, XB, SSA, row + NGW, lane); }
            }
        } else if (j == 0 || j >= 5) {
            pg8::Gemm g; pg8::EpiAny E; int N; const bool last = (l + 1 == DEPTH);
            if (j == 0) { g = pg8::Gemm{XB, WinT, T, DINP, DM}; N = DINP; E = pg8::EpiAny{0, true, P, DINP, Gt, C_GATE, nullptr, nullptr, nullptr, SSA}; }
            else if (j == 5) { g = pg8::Gemm{HM, WoT, T, DM, DM}; N = DM; E = pg8::EpiAny{2, false, nullptr, DM, nullptr, 0, xin, out, XB, SSB}; }
            else if (j == 6) { g = pg8::Gemm{XB, W1T, T, DFF, DM}; N = DFF; E = pg8::EpiAny{1, true, U, DFF, nullptr, 0, nullptr, nullptr, nullptr, SSB}; }
            else { g = pg8::Gemm{U, W2T, T, DM, DFF}; N = DM; E = pg8::EpiAny{2, false, nullptr, DM, nullptr, 0, out, out, last ? nullptr : XB, SSA}; }
            pg8::StaticOrder S; S.init(T, N, G, bid);
            for (int rep = 0; rep < ((j == 0 || j == 6) ? DUP_GEMM : 1); ++rep) pg8::gemm_phase<pg8::EpiAny, pg8::StaticOrder, true, true>((PG8_LAS unsigned char*)lds, g, S, E, tid);
        } else if (j == 1) {
            PH_LOCALS
            for (int rep = 0; rep < DUP_CMP; ++rep) for (int it = bid; it < 128; it += G) compress_item(P, W1t + (size_t)l * 2 * 128 * 2048, C1 + l * 256, IN(10) + (size_t)l * 2 * 128 * 64, IN(7) + l * 192, KVcb, it, tid, (LAS unsigned char*)lds);
            for (int it0 = 0; it0 < 128 * 14; it0 += NVB) { const int it = it0 + vb; ph_prep(P, tab, IN(5) + l * 128, IN(6) + l * 64, IN(7) + l * 192, kmean, it, it < 128 * 14, t256, (float*)smh); }
            for (int rep = 0; rep < DUP_QK2; ++rep) qk2_rows(P, IN(3) + (size_t)l * 4 * 1024, QK2, bid, G, tid);
            { unsigned long long z64 = 0ull; asm volatile("" : "+v"(z64)); for (int i = bid * 512 + tid; i < 2 * T; i += G * 512) SSA[i] = z64; }
        } else if (j == 2) {
            for (int rep = 0; rep < DUP_M1; ++rep) ml256_m1_phase(P, QK2, Gt, IN(2) + l * 8, CT, nst, dec, bid, G, tid, (LAS unsigned char*)lds);
            for (int u = bid; u < 512; u += G) moba_gate_item(P, kmean, SELB, CNTQ, LISTG, u >> 7, (u >> 5) & 3, u & 31, tid, (LAS unsigned char*)lds);
        } else if (j == 3) {
            for (int it = bid; it < 16 * 9; it += G) ml256_scan(CT, nst, dec, it, tid);
            for (int rep = 0; rep < DUP_MOBA; ++rep) moba_kv_phase(P, SELB, CNTQ, LISTG, IN(5) + l * 128 + 64, bid, G, tid, (LAS unsigned char*)lds);
            for (int rep = 0; rep < DUP_NSA; ++rep) for (int pu = bid; pu < 256; pu += G) { const int b_ = pu >> 6, s = pu & 63;
                nsa_unit(P, Gt, tab, KVcb, IN(7) + l * 192, HM, b_, 127 - s, tid, (LAS unsigned char*)lds); nsa_unit(P, Gt, tab, KVcb, IN(7) + l * 192, HM, b_, s, tid, (LAS unsigned char*)lds); }
        } else {
            { const float kmx = gain_kmax(IN(5) + l * 128 + 64, tid & 63);
              for (int pu = bid; pu < 256; pu += G) { const int bh = pu >> 4, s = pu & 15;
                  moba_merge_unit(P, SELB, kmx, HM, bh >> 2, bh & 3, 31 - s, tid, (LAS unsigned char*)lds); moba_merge_unit(P, SELB, kmx, HM, bh >> 2, bh & 3, s, tid, (LAS unsigned char*)lds); } }
            for (int rep = 0; rep < DUP_M3; ++rep) ml256_m3_phase(P, QK2, Gt, IN(2) + l * 8, CT, nst, IN(4) + l * 512, HM, bid, G, tid, (LAS unsigned char*)lds);
        }
        if (ph + 1 < NPH) { if (ph == 0) grid.sync(); else { XcdBarrier xbar; xbar.bar = (unsigned*)(ws + WS_BAR); xbar.x = xb_xcc_id(); xbar.st = xst; xcd_barrier(xbar); } }
    }
#undef IN
#undef KARG
#undef PH_LOCALS
}

extern "C" void kernel_launch(void* const* d_in, const int* in_sizes, int n_in, void* d_out, int out_size, void* d_ws, size_t ws_size, hipStream_t stream) {
    static int grid = 0;
    if (grid == 0) {
        if (n_in != 16 || in_sizes[0] != T * DM || out_size != T * DM || ws_size < WS_END) { fprintf(stderr, "kernel_launch: unexpected shapes / workspace %zu < %zu\n", ws_size, (size_t)WS_END); grid = -1; return; }
        int dev = 0, cus = 0, per_cu = 0;
        if (hipGetDevice(&dev) != hipSuccess || hipDeviceGetAttribute(&cus, hipDeviceAttributeMultiprocessorCount, dev) != hipSuccess) { grid = -1; return; }
        if (hipFuncSetAttribute((const void*)hybrid_fwd, hipFuncAttributeMaxDynamicSharedMemorySize, LDS_BYTES) != hipSuccess) { fprintf(stderr, "kernel_launch: hipFuncSetAttribute failed\n"); grid = -1; return; }
        if (hipOccupancyMaxActiveBlocksPerMultiprocessor(&per_cu, (const void*)hybrid_fwd, 512, LDS_BYTES) != hipSuccess || per_cu < 1) { fprintf(stderr, "kernel_launch: occupancy query failed (%d)\n", per_cu); grid = -1; return; }
        grid = cus * per_cu;
        fprintf(stderr, "kernel_launch: grid %d (%d CUs x %d)\n", grid, cus, per_cu);
    }
    if (grid < 0) return;
    if (hipMemsetAsync((char*)d_ws + WS_BAR, 0, XCD_BAR_WORDS * 4, stream) != hipSuccess) { fprintf(stderr, "kernel_launch: memset failed\n"); return; }
    Params p{};
    for (int i = 0; i < 16; ++i) p.in[i] = (const float*)d_in[i];
    p.out = (float*)d_out; p.ws = (unsigned char*)d_ws;
    void* args[] = {&p};
    hipError_t e = hipLaunchCooperativeKernel((const void*)hybrid_fwd, dim3(grid), dim3(512), args, LDS_BYTES, stream);
    if (e != hipSuccess) fprintf(stderr, "kernel_launch: cooperative launch failed: %s (grid %d)\n", hipGetErrorString(e), grid);
}
```

```cpp
#include <hip/hip_runtime.h>
#include <hip/hip_cooperative_groups.h>
#include <cstdio>
#include <cstdint>
namespace cg = cooperative_groups;
namespace pg8 {
#define PG8_LAS __attribute__((address_space(3)))
typedef unsigned short bf16_t;
typedef short bf16x8 __attribute__((ext_vector_type(8)));
typedef float f32x4 __attribute__((ext_vector_type(4)));
typedef unsigned u32x4 __attribute__((ext_vector_type(4)));
constexpr int BM = 256, BK = 64, HALF = 128, HTB = HALF * BK * 2  , STAGE_BYTES = 8 * HTB, NXCD = 8, WGM = 8;

__host__ __device__ __forceinline__ int lds_byte(int r, int c) { const int st = (r >> 4) * 2 + (c >> 5), rr = r & 15, cc = c & 31, ob = rr * 64 + cc * 2; return st * 1024 + (ob ^ (((ob >> 9) & 1) << 5)); }
__host__ __device__ __forceinline__ void stage_rc(int b, int& R, int& C) { const int st = b / 1024, sb = b % 1024, swz = sb ^ (((sb >> 9) & 1) << 5); R = (st >> 1) * 16 + swz / 64; C = (st & 1) * 32 + (swz % 64) / 2; }
__host__ __device__ __forceinline__ int perm32(int rho) { const int n = rho >> 4, i = rho & 15; return 8 * (i >> 2) + 4 * n + (i & 3); }

struct Unit { int pm, pn; };
struct Gemm { const bf16_t* A; const bf16_t* Bt; int M, N, K; };

struct StaticOrder {
    int nM, nN, nwg, G, c;
    __host__ __device__ void init(int M, int N, int G_, int c_) { nM = M / BM; nN = N / BM; nwg = nM * nN; G = G_; c = c_; }
    __host__ __device__ bool next(int i, Unit& u) const {
        const long L = (long)i * G + c; if (L >= nwg) return false;
        int wgid = (int)L; { const int q = nwg / NXCD, r = nwg % NXCD, xcd = wgid % NXCD, off = wgid / NXCD; wgid = (xcd < r ? xcd * (q + 1) : r * (q + 1) + (xcd - r) * q) + off; }
        const int nig = WGM * nN, gid = wgid / nig, fm = gid * WGM, gsz = (nM - fm) < WGM ? (nM - fm) : WGM;
        u.pm = fm + ((wgid % nig) % gsz); u.pn = (wgid % nig) / gsz; return true;
    }
    __device__ __forceinline__ void a_ready(const Unit&) const {}
    __device__ __forceinline__ void done(const Unit&) const {}
};

__device__ __forceinline__ unsigned f2bf_u(float f) { unsigned u = __builtin_bit_cast(unsigned, f); return (u + 0x7fffu + ((u >> 16) & 1u)) >> 16; }
__device__ __forceinline__ unsigned pk2bf(float lo, float hi) { return f2bf_u(lo) | (f2bf_u(hi) << 16); }

__device__ __forceinline__ unsigned cvtpk_bf16(float lo, float hi) { typedef float f2_ __attribute__((ext_vector_type(2))); typedef __bf16 b2_ __attribute__((ext_vector_type(2)));
    f2_ v = {lo, hi}; b2_ b = __builtin_convertvector(v, b2_); return __builtin_bit_cast(unsigned, b); }
__device__ __forceinline__ float swz_xor16(float v) { return __uint_as_float((unsigned)__builtin_amdgcn_ds_swizzle((int)__float_as_uint(v), 0x1F | (16 << 10))); }
__device__ __forceinline__ float half_sum(float v) { auto rr = __builtin_amdgcn_permlane32_swap(__float_as_uint(v), __float_as_uint(v), false, false); return __uint_as_float(rr[0]) + __uint_as_float(rr[1]); }
__device__ __forceinline__ float row_rstd(const unsigned long long* ssq, int row) { return __builtin_amdgcn_rsqf((float)ssq[row] * (1.0f / (1048576.0f * 1024.0f)) + 1e-6f); }

struct EpiProj {
    static constexpr bool PERM = true, AFTER_DRAIN = false;
    bf16_t* O; int ldc; float* gates; int gate0; const unsigned long long* ssp;
    __device__ __forceinline__ void operator()(const f32x4 (&acc)[2][2][4][2], const Unit& u, int wr, int wc, int fr, int fq) const {
        const int row0 = u.pm * BM + wr * 64 + fr; const int col0 = u.pn * BM + wc * 32 + 8 * fq;
        float rsv[2][4];
#pragma unroll
        for (int ai = 0; ai < 2; ++ai)
#pragma unroll
            for (int m = 0; m < 4; ++m) rsv[ai][m] = row_rstd(ssp, row0 + ai * HALF + m * 16);
#pragma unroll
        for (int ai = 0; ai < 2; ++ai)
#pragma unroll
            for (int m = 0; m < 4; ++m) { const int row = row0 + ai * HALF + m * 16; bf16_t* rowp = O + (size_t)row * ldc + col0; const float rs = rsv[ai][m];
#pragma unroll
                for (int bj = 0; bj < 2; ++bj) { const f32x4 v0 = acc[ai][bj][m][0] * rs, v1 = acc[ai][bj][m][1] * rs;
                    u32x4 w; w.x = cvtpk_bf16(v0[0], v0[1]); w.y = cvtpk_bf16(v0[2], v0[3]); w.z = cvtpk_bf16(v1[0], v1[1]); w.w = cvtpk_bf16(v1[2], v1[3]);
                    *(u32x4*)(rowp + bj * HALF) = w;
                    const int c = col0 + bj * HALF - gate0;
                    if (c >= 0 && c < 32) { float* g = gates + (size_t)row * 32 + c; *(f32x4*)g = v0; *(f32x4*)(g + 4) = v1; } } }
    }
};
struct EpiRelu2 {
    static constexpr bool PERM = true, AFTER_DRAIN = false;
    bf16_t* O; int ldc; const unsigned long long* ssp;
    __device__ __forceinline__ void operator()(const f32x4 (&acc)[2][2][4][2], const Unit& u, int wr, int wc, int fr, int fq) const {
        const int row0 = u.pm * BM + wr * 64 + fr; const int col0 = u.pn * BM + wc * 32 + 8 * fq;
        float rsv[2][4];
#pragma unroll
        for (int ai = 0; ai < 2; ++ai)
#pragma unroll
            for (int m = 0; m < 4; ++m) rsv[ai][m] = row_rstd(ssp, row0 + ai * HALF + m * 16);
#pragma unroll
        for (int ai = 0; ai < 2; ++ai)
#pragma unroll
            for (int m = 0; m < 4; ++m) { const int row = row0 + ai * HALF + m * 16; bf16_t* rowp = O + (size_t)row * ldc + col0; const float rs = rsv[ai][m];
#pragma unroll
                for (int bj = 0; bj < 2; ++bj) { f32x4 v0 = acc[ai][bj][m][0] * rs, v1 = acc[ai][bj][m][1] * rs;
#pragma unroll
                    for (int e = 0; e < 4; ++e) { float a = v0[e] > 0.f ? v0[e] : 0.f; v0[e] = a * a; float b = v1[e] > 0.f ? v1[e] : 0.f; v1[e] = b * b; }
                    u32x4 w; w.x = cvtpk_bf16(v0[0], v0[1]); w.y = cvtpk_bf16(v0[2], v0[3]); w.z = cvtpk_bf16(v1[0], v1[1]); w.w = cvtpk_bf16(v1[2], v1[3]);
                    *(u32x4*)(rowp + bj * HALF) = w; } }
    }
};
struct EpiResid {
    static constexpr bool PERM = true, AFTER_DRAIN = false;
    float* out; int ldc; bf16_t* xb; unsigned long long* ssp;
    __device__ __forceinline__ void operator()(const f32x4 (&acc)[2][2][4][2], const Unit& u, int wr, int wc, int fr, int fq) const {
        const int row0 = u.pm * BM + wr * 64 + fr; const int col0 = u.pn * BM + wc * 32 + 8 * fq;
#pragma unroll
        for (int ai = 0; ai < 2; ++ai)
#pragma unroll
            for (int m = 0; m < 4; ++m) { const int row = row0 + ai * HALF + m * 16; const size_t off = (size_t)row * ldc + col0; float ss = 0.f;
#pragma unroll
                for (int bj = 0; bj < 2; ++bj) { const size_t o = off + bj * HALF; const u32x4 b = *(const u32x4*)(xb + o);
                    f32x4 v0, v1;
                    v0[0] = __uint_as_float(b.x << 16) + acc[ai][bj][m][0][0]; v0[1] = __uint_as_float(b.x & 0xffff0000u) + acc[ai][bj][m][0][1];
                    v0[2] = __uint_as_float(b.y << 16) + acc[ai][bj][m][0][2]; v0[3] = __uint_as_float(b.y & 0xffff0000u) + acc[ai][bj][m][0][3];
                    v1[0] = __uint_as_float(b.z << 16) + acc[ai][bj][m][1][0]; v1[1] = __uint_as_float(b.z & 0xffff0000u) + acc[ai][bj][m][1][1];
                    v1[2] = __uint_as_float(b.w << 16) + acc[ai][bj][m][1][2]; v1[3] = __uint_as_float(b.w & 0xffff0000u) + acc[ai][bj][m][1][3];
                    if (out) { *(f32x4*)(out + o) = v0; *(f32x4*)(out + o + 4) = v1; }
                    else { ss += ((v0[0] * v0[0] + v0[1] * v0[1]) + (v0[2] * v0[2] + v0[3] * v0[3])) + ((v1[0] * v1[0] + v1[1] * v1[1]) + (v1[2] * v1[2] + v1[3] * v1[3]));
                        u32x4 w; w.x = cvtpk_bf16(v0[0], v0[1]); w.y = cvtpk_bf16(v0[2], v0[3]); w.z = cvtpk_bf16(v1[0], v1[1]); w.w = cvtpk_bf16(v1[2], v1[3]); *(u32x4*)(xb + o) = w; } }
                if (!out) { ss += swz_xor16(ss); ss = half_sum(ss); if (fq == 0) atomicAdd(ssp + row, (unsigned long long)(ss * 1048576.0f + 0.5f)); } }
    }
};

struct EpiAny {
    static constexpr bool AFTER_DRAIN = false;
    int kind; bool perm;
    bf16_t* O; int ldc; float* gates; int gate0; const float* base; float* out; bf16_t* xb; unsigned long long* ssp;
    __device__ __forceinline__ void operator()(const f32x4 (&acc)[2][2][4][2], const Unit& u, int wr, int wc, int fr, int fq) const {
        if (kind == 0) { EpiProj e{O, ldc, gates, gate0, ssp}; e(acc, u, wr, wc, fr, fq); }
        else if (kind == 1) { EpiRelu2 e{O, ldc, ssp}; e(acc, u, wr, wc, fr, fq); }
        else { EpiResid e{out, ldc, xb, ssp}; e(acc, u, wr, wc, fr, fq); }
    }
};
template <class Epi, class Sched, bool ALIGN_EPI = false, bool SP2 = false>
__device__ __forceinline__ void gemm_phase(PG8_LAS unsigned char* lds, const Gemm g, const Sched& S, const Epi& E, const int tid) {
    const int wid = __builtin_amdgcn_readfirstlane(tid >> 6), lane = tid & 63, wr = wid >> 2, wc = wid & 3, fr = lane & 15, fq = lane >> 4;
    const int K = g.K, nt = K / BK;
    unsigned voffA[2], voffB[2];
#pragma unroll
    for (int i = 0; i < 2; ++i) { int R, C; stage_rc(tid * 16 + i * 8192, R, C); const int Rb = E.perm ? ((R & ~31) + perm32(R & 31)) : R;
        voffA[i] = (unsigned)(R * K + C) * 2u; voffB[i] = (unsigned)(Rb * K + C) * 2u; }
    const size_t kstep = (size_t)(BK * 2);
    const size_t hstep = (size_t)HALF * K * 2;
    const size_t tstep = 2 * hstep;
    const unsigned ldsw = (unsigned)wid * 1024u;
    const int aoff = lds_byte(wr * 64 + fr, fq * 8), boff = lds_byte(wc * 32 + fr, fq * 8);
#define PG8_SA(b, h) (((b) * 2 + (h)) * HTB)
#define PG8_SB(b, h) ((4 + (b) * 2 + (h)) * HTB)
#define PG8_STAGE(bufoff, gbase, voff) do { _Pragma("unroll") for (int _i = 0; _i < 2; ++_i) \
        __builtin_amdgcn_global_load_lds((const unsigned*)((const char*)(gbase) + (voff)[_i]), (PG8_LAS unsigned*)(lds + (bufoff) + ldsw + _i * 8192), 16, 0, 0); } while (0)
#define PG8_LDA(dst, b, h) do { _Pragma("unroll") for (int m = 0; m < 4; ++m) _Pragma("unroll") for (int k = 0; k < 2; ++k) dst[m][k] = *(const PG8_LAS bf16x8*)(lds + PG8_SA(b, h) + aoff + m * 2048 + k * 1024); } while (0)
#define PG8_LDB(dst, b, h) do { _Pragma("unroll") for (int n = 0; n < 2; ++n) _Pragma("unroll") for (int k = 0; k < 2; ++k) dst[n][k] = *(const PG8_LAS bf16x8*)(lds + PG8_SB(b, h) + boff + n * 2048 + k * 1024); } while (0)
#define PG8_MMA(ai, bj, At, Bt) do { __builtin_amdgcn_s_setprio(1); _Pragma("unroll") for (int m = 0; m < 4; ++m) _Pragma("unroll") for (int n = 0; n < 2; ++n) _Pragma("unroll") for (int k = 0; k < 2; ++k) \
        acc[ai][bj][m][n] = __builtin_amdgcn_mfma_f32_16x16x32_bf16(Bt[n][k], At[m][k], acc[ai][bj][m][n], 0, 0, 0); __builtin_amdgcn_s_setprio(0); } while (0)
#define PG8_WAIT_V(n) asm volatile("s_waitcnt vmcnt(" #n ")" ::: "memory")
#define PG8_WAIT_L(n) asm volatile("s_waitcnt lgkmcnt(" #n ")" ::: "memory")
#define PG8_BAR __builtin_amdgcn_s_barrier()
#define PG8_SCHED __builtin_amdgcn_sched_barrier(0)
    Unit cur, nxt; int ui = 0;
    if (!S.next(0, cur)) return;
    f32x4 acc[2][2][4][2];
#pragma unroll
    for (int a = 0; a < 2; ++a)
#pragma unroll
        for (int b = 0; b < 2; ++b)
#pragma unroll
            for (int m = 0; m < 4; ++m)
#pragma unroll
                for (int n = 0; n < 2; ++n) acc[a][b][m][n] = (f32x4){0.f, 0.f, 0.f, 0.f};
    bf16x8 At[4][2], B0[2][2], B1[2][2];
    const char* cA = (const char*)g.A + (size_t)cur.pm * tstep; const char* cB = (const char*)g.Bt + (size_t)cur.pn * tstep;
    S.a_ready(cur);
    if constexpr (SP2) {
        PG8_STAGE(PG8_SB(0, 0), cB, voffB); PG8_STAGE(PG8_SB(0, 1), cB + hstep, voffB); PG8_STAGE(PG8_SA(0, 0), cA, voffA); PG8_STAGE(PG8_SA(0, 1), cA + hstep, voffA);
        if (wr == 1) PG8_BAR;
        PG8_WAIT_V(2); PG8_BAR;
        PG8_STAGE(PG8_SB(1, 0), cB + kstep, voffB); PG8_STAGE(PG8_SA(1, 0), cA + kstep, voffA); PG8_STAGE(PG8_SB(1, 1), cB + hstep + kstep, voffB);
        PG8_WAIT_V(6); PG8_BAR;
    } else {
        PG8_STAGE(PG8_SB(0, 0), cB, voffB); PG8_STAGE(PG8_SA(0, 0), cA, voffA); PG8_STAGE(PG8_SB(0, 1), cB + hstep, voffB); PG8_STAGE(PG8_SA(0, 1), cA + hstep, voffA);
        if (wr == 1) PG8_BAR;
        PG8_WAIT_V(4); PG8_BAR;
        PG8_STAGE(PG8_SB(1, 0), cB + kstep, voffB); PG8_STAGE(PG8_SA(1, 0), cA + kstep, voffA); PG8_STAGE(PG8_SB(1, 1), cB + hstep + kstep, voffB);
        PG8_WAIT_V(6); PG8_BAR;
    }
    for (;;) {
        const bool has_next = S.next(ui + 1, nxt);
        const char* nA = has_next ? (const char*)g.A + (size_t)nxt.pm * tstep : cA; const char* nB = has_next ? (const char*)g.Bt + (size_t)nxt.pn * tstep : cB;
        for (int t = 0; t < nt; t += 2) {
            const bool last = (t == nt - 2);
            const char* a1 = cA + (size_t)(t + 1) * kstep;
            const char* a2 = last ? nA : cA + (size_t)(t + 2) * kstep; const char* b2 = last ? nB : cB + (size_t)(t + 2) * kstep;
            const char* a3 = a2 + kstep; const char* b3 = b2 + kstep;
            if (last && has_next) S.a_ready(nxt);
            if constexpr (SP2) {
            PG8_LDB(B0, 0, 0); PG8_LDB(B1, 0, 1); PG8_SCHED; PG8_LDA(At, 0, 0); PG8_STAGE(PG8_SA(1, 1), a1 + hstep, voffA);
            PG8_WAIT_V(8); PG8_WAIT_L(0); PG8_BAR; PG8_MMA(0, 0, At, B0); PG8_MMA(0, 1, At, B1); PG8_BAR; PG8_SCHED;
            PG8_LDA(At, 0, 1); PG8_STAGE(PG8_SB(0, 0), b2, voffB); PG8_STAGE(PG8_SB(0, 1), b2 + hstep, voffB); PG8_STAGE(PG8_SA(0, 0), a2, voffA);
            PG8_WAIT_V(8); PG8_WAIT_L(0); PG8_BAR; PG8_MMA(1, 0, At, B0); PG8_MMA(1, 1, At, B1); PG8_BAR; PG8_SCHED;
            PG8_LDB(B0, 1, 0); PG8_LDB(B1, 1, 1); PG8_SCHED; PG8_LDA(At, 1, 0); PG8_STAGE(PG8_SA(0, 1), a2 + hstep, voffA);
            PG8_WAIT_V(8); PG8_WAIT_L(0); PG8_BAR; PG8_MMA(0, 0, At, B0); PG8_MMA(0, 1, At, B1); PG8_BAR; PG8_SCHED;
            PG8_LDA(At, 1, 1); PG8_STAGE(PG8_SB(1, 0), b3, voffB); PG8_STAGE(PG8_SB(1, 1), b3 + hstep, voffB); PG8_STAGE(PG8_SA(1, 0), a3, voffA);
            PG8_WAIT_V(8); PG8_WAIT_L(0); PG8_BAR; PG8_MMA(1, 0, At, B0); PG8_MMA(1, 1, At, B1); PG8_BAR; PG8_SCHED;
            } else {
            PG8_LDB(B0, 0, 0); PG8_SCHED; PG8_LDA(At, 0, 0); PG8_STAGE(PG8_SA(1, 1), a1 + hstep, voffA);
            PG8_WAIT_L(8); PG8_BAR; PG8_WAIT_L(0); PG8_MMA(0, 0, At, B0); PG8_BAR; PG8_SCHED;
            PG8_LDB(B1, 0, 1); PG8_STAGE(PG8_SB(0, 0), b2, voffB);
            PG8_BAR; PG8_WAIT_L(0); PG8_MMA(0, 1, At, B1); PG8_BAR;
            PG8_LDA(At, 0, 1); PG8_STAGE(PG8_SA(0, 0), a2, voffA);
            PG8_BAR; PG8_WAIT_L(0); PG8_MMA(1, 0, At, B0); PG8_BAR; PG8_SCHED;
            PG8_STAGE(PG8_SB(0, 1), b2 + hstep, voffB);
            PG8_WAIT_V(6); PG8_BAR; PG8_MMA(1, 1, At, B1); PG8_BAR;
            PG8_LDB(B0, 1, 0); PG8_SCHED; PG8_LDA(At, 1, 0); PG8_STAGE(PG8_SA(0, 1), a2 + hstep, voffA);
            PG8_WAIT_L(8); PG8_BAR; PG8_WAIT_L(0); PG8_MMA(0, 0, At, B0); PG8_BAR; PG8_SCHED;
            PG8_LDB(B1, 1, 1); PG8_STAGE(PG8_SB(1, 0), b3, voffB);
            PG8_BAR; PG8_WAIT_L(0); PG8_MMA(0, 1, At, B1); PG8_BAR;
            PG8_LDA(At, 1, 1); PG8_STAGE(PG8_SA(1, 0), a3, voffA);
            PG8_BAR; PG8_WAIT_L(0); PG8_MMA(1, 0, At, B0); PG8_BAR; PG8_SCHED;
            PG8_STAGE(PG8_SB(1, 1), b3 + hstep, voffB);
            PG8_WAIT_V(6); PG8_BAR; PG8_MMA(1, 1, At, B1); PG8_BAR;
            }
        }
        if constexpr (ALIGN_EPI) { if (wr == 0) PG8_BAR; }
        if constexpr (!Epi::AFTER_DRAIN) { E(acc, cur, wr, wc, fr, fq); S.done(cur); }
        if (!has_next) break;
#pragma unroll
        for (int a = 0; a < 2; ++a)
#pragma unroll
            for (int b = 0; b < 2; ++b)
#pragma unroll
                for (int m = 0; m < 4; ++m)
#pragma unroll
                    for (int n = 0; n < 2; ++n) acc[a][b][m][n] = (f32x4){0.f, 0.f, 0.f, 0.f};
        cur = nxt; cA = nA; cB = nB; ++ui;
        if constexpr (ALIGN_EPI) { if (wr == 1) PG8_BAR; }
    }
    PG8_WAIT_V(0);
    if constexpr (!ALIGN_EPI) { if (wr == 0) PG8_BAR; }
    PG8_BAR;
    if constexpr (Epi::AFTER_DRAIN) { E.fused(acc, cur, wr, wc, fr, fq, lds, wid, lane); S.done(cur); }
#undef PG8_SA
#undef PG8_SB
#undef PG8_STAGE
#undef PG8_LDA
#undef PG8_LDB
#undef PG8_MMA
#undef PG8_WAIT_V
#undef PG8_WAIT_L
#undef PG8_BAR
#undef PG8_SCHED
}
}

typedef unsigned short bf16;
constexpr int NB = 4, SEQ = 8192, T = NB * SEQ, DM = 1024, DFF = 4096, DEPTH = 2;
constexpr int DIN = 3476, DINP = 3584;
constexpr int C_MQ = 0, C_MK = 512, C_MV = 1024, C_MO = 1536, C_BQ = 2048, C_BK = 2304, C_BV = 2560, C_NQ = 2816,
              C_NKC = 3072, C_NVC = 3136, C_NKS = 3200, C_NVS = 3264, C_NKW = 3328, C_NVW = 3392, C_GATE = 3456;
constexpr int NCMP = 511;
constexpr float EPS = 1e-6f;

__device__ __forceinline__ float bf2f(bf16 v) { return __builtin_bit_cast(float, (unsigned)v << 16); }
__device__ __forceinline__ bf16 f2bf(float f) { return (bf16)pg8::f2bf_u(f); }
template <int MASK> __device__ __forceinline__ float shx(float v) {
    if constexpr (MASK == 32) { auto rr = __builtin_amdgcn_permlane32_swap(__float_as_uint(v), __float_as_uint(v), false, false);
        return __uint_as_float(__builtin_amdgcn_mbcnt_lo(~0u, 0u) == 32u ? rr[0] : rr[1]); }
    else return __uint_as_float((unsigned)__builtin_amdgcn_ds_swizzle((int)__float_as_uint(v), 0x1F | (MASK << 10)));
}
__device__ __forceinline__ float xchg32(float v, int hi) { auto rr = __builtin_amdgcn_permlane32_swap(__float_as_uint(v), __float_as_uint(v), false, false); return __uint_as_float(hi ? rr[0] : rr[1]); }
__device__ __forceinline__ float hsum32(float v) { auto rr = __builtin_amdgcn_permlane32_swap(__float_as_uint(v), __float_as_uint(v), false, false); return __uint_as_float(rr[0]) + __uint_as_float(rr[1]); }
__device__ __forceinline__ float hmax32(float v) { auto rr = __builtin_amdgcn_permlane32_swap(__float_as_uint(v), __float_as_uint(v), false, false); return fmaxf(__uint_as_float(rr[0]), __uint_as_float(rr[1])); }
template <int MASK> __device__ __forceinline__ unsigned shxu(unsigned v) { return __float_as_uint(shx<MASK>(__uint_as_float(v))); }
__device__ __forceinline__ float wave_sum(float v) {
    v += shx<1>(v); v += shx<2>(v); v += shx<4>(v); v += shx<8>(v); v += shx<16>(v);
    auto rr = __builtin_amdgcn_permlane32_swap(__float_as_uint(v), __float_as_uint(v), false, false); return __uint_as_float(rr[0]) + __uint_as_float(rr[1]);
}
__device__ __forceinline__ float wave_max(float v) {
    v = fmaxf(v, shx<1>(v)); v = fmaxf(v, shx<2>(v)); v = fmaxf(v, shx<4>(v)); v = fmaxf(v, shx<8>(v)); v = fmaxf(v, shx<16>(v));
    auto rr = __builtin_amdgcn_permlane32_swap(__float_as_uint(v), __float_as_uint(v), false, false); return fmaxf(__uint_as_float(rr[0]), __uint_as_float(rr[1]));
}
__device__ __forceinline__ float sgprf(float c) { asm volatile("" : "+s"(c)); return c; }
#define nbg (sgprf(-1e30f))
__device__ __forceinline__ int mk_tid(int wave_s) { int t; asm volatile("v_mbcnt_lo_u32_b32 %0, -1, 0\n\tv_mbcnt_hi_u32_b32 %0, -1, %0" : "=v"(t)); return t + wave_s * 64; }
__device__ __forceinline__ float zf_() { float z = 0.f; asm volatile("" : "+v"(z)); return z; }
__device__ __forceinline__ float rcpf_(float x) { return __builtin_amdgcn_rcpf(x); }
__device__ __forceinline__ float sigmoidf_(float x) { return rcpf_(1.f + __expf(-x)); }
__device__ __forceinline__ float log_sigmoidf_(float x) { return fminf(x, 0.f) - __logf(1.f + __expf(-fabsf(x))); }
__device__ __forceinline__ void rope_cs(int pos, int f, float& c, float& s) {
    const float invf = f == 0 ? 1.0f : f == 1 ? 0.193922758102417f : f == 2 ? 0.03760603442788124f : f == 3 ? 0.007292666472494602f : f == 4 ? 0.0014142136787995696f
                     : f == 5 ? 0.00027424818836152554f : f == 6 ? 5.318298644851893e-05f : 1.031338433676865e-05f;
    const float ang = (float)pos * invf;
    const float k = rintf(ang * 0.15915493667125702f);
    float r = fmaf(-k, 6.2831854820251465f, ang); r = fmaf(-k, -1.7484555314695172e-07f, r);
    c = __cosf(r); s = __sinf(r);
}


__device__ __forceinline__ float dot64(const bf16* __restrict__ kp, const float* q) {
    const uint4* k4 = (const uint4*)kp; float a = 0.f;
#pragma unroll
    for (int j = 0; j < 8; ++j) { const uint4 w = k4[j]; const unsigned ww[4] = {w.x, w.y, w.z, w.w};
#pragma unroll
        for (int e = 0; e < 4; ++e) { a = fmaf(q[8 * j + 2 * e], __builtin_bit_cast(float, ww[e] << 16), a); a = fmaf(q[8 * j + 2 * e + 1], __builtin_bit_cast(float, ww[e] & 0xffff0000u), a); } }
    return a;
}
__device__ __forceinline__ void dot64x4(const bf16* __restrict__ kp, const float (*q)[64], float (&a)[4]) {
    const uint4* k4 = (const uint4*)kp; a[0] = a[1] = a[2] = a[3] = 0.f;
#pragma unroll
    for (int j = 0; j < 8; ++j) { const uint4 w = k4[j]; const unsigned ww[4] = {w.x, w.y, w.z, w.w};
#pragma unroll
        for (int e = 0; e < 4; ++e) { const float k0 = __builtin_bit_cast(float, ww[e] << 16), k1 = __builtin_bit_cast(float, ww[e] & 0xffff0000u);
#pragma unroll
            for (int h = 0; h < 4; ++h) { a[h] = fmaf(q[h][8 * j + 2 * e], k0, a[h]); a[h] = fmaf(q[h][8 * j + 2 * e + 1], k1, a[h]); } } }
}

__host__ __device__ __forceinline__ int win_src(int n) {
    if (n < 2048) return n;
    if (n < 3456) return n + 8;
    if (n < 3464) return n - 3456 + 2048;
    if (n < 3476) return n;
    return -1;
}


typedef unsigned u32x4p __attribute__((ext_vector_type(4)));
__device__ __forceinline__ void cw_load(float (&v)[16], const float* __restrict__ W, int N, int NP, int mode, int item, int t, const float* __restrict__ gk) {
    const int nbx = NP / 64; const int n0 = (item % nbx) * 64, k0 = (item / nbx) * 64, c = t & 63, r = t >> 6;
    const int src = mode ? win_src(n0 + c) : (n0 + c);
#pragma unroll
    for (int i = 0; i < 16; ++i) { const int k = r + 4 * i; v[i] = (src >= 0) ? W[(size_t)(k0 + k) * N + src] * (gk ? gk[k0 + k] : 1.f) : 0.f; }
}
__device__ __forceinline__ void ph_convert_mat(const float* __restrict__ W, int K, int N, int NP, bf16* __restrict__ WT, int mode, int vb, int NVB, int t, float* tile, const float* __restrict__ gk = nullptr) {
    const int nit = (NP / 64) * (K / 64), nbx = NP / 64, c = t & 63, r = t >> 6;
    float v[16];
    if (vb < nit) cw_load(v, W, N, NP, mode, vb, t, gk);
    for (int it0 = 0; it0 < nit; it0 += NVB) { const int it = it0 + vb; const bool act = it < nit;
        if (act) {
#pragma unroll
            for (int i = 0; i < 16; ++i) tile[(r + 4 * i) * 65 + c] = v[i]; }
        if (it + NVB < nit) cw_load(v, W, N, NP, mode, it + NVB, t, gk);
        __syncthreads();
        if (act) { const int n0 = (it % nbx) * 64, k0 = (it / nbx) * 64, n = t >> 2, kc = (t & 3) * 16;
            u32x4p w0, w1;
#pragma unroll
            for (int e = 0; e < 4; ++e) { w0[e] = pg8::cvtpk_bf16(tile[(kc + 2 * e) * 65 + n], tile[(kc + 2 * e + 1) * 65 + n]); w1[e] = pg8::cvtpk_bf16(tile[(kc + 8 + 2 * e) * 65 + n], tile[(kc + 8 + 2 * e + 1) * 65 + n]); }
            u32x4p* dst = (u32x4p*)(WT + (size_t)(n0 + n) * K + k0 + kc); dst[0] = w0; dst[1] = w1; }
        __syncthreads();
    }
}
__device__ __forceinline__ void ph_x_row(const float* __restrict__ x, bf16* __restrict__ XB, unsigned long long* __restrict__ ssq, int row, int lane) {
    const float4* xr = (const float4*)(x + (size_t)row * DM) + lane;
    float4 v[4]; float s = 0.f;
#pragma unroll
    for (int j = 0; j < 4; ++j) { v[j] = xr[64 * j]; s += v[j].x * v[j].x + v[j].y * v[j].y + v[j].z * v[j].z + v[j].w * v[j].w; }
    s = wave_sum(s);
    uint2* o = (uint2*)(XB + (size_t)row * DM) + lane;
#pragma unroll
    for (int j = 0; j < 4; ++j) { uint2 w; w.x = pg8::cvtpk_bf16(v[j].x, v[j].y); w.y = pg8::cvtpk_bf16(v[j].z, v[j].w); o[64 * j] = w; }
    if (lane == 0) ssq[row] = (unsigned long long)(s * 1048576.0f + 0.5f);
}
__device__ __forceinline__ void ph_prep(bf16* __restrict__ P, const float* __restrict__ tab, const float* __restrict__ moba_g, const float* __restrict__ nsa_qg, const float* __restrict__ nsa_kg,
                                        float* __restrict__ kmean, int item, bool act, int t, float* red  ) {
    const int lane = t & 63, wid = t >> 6, tb = item % 128, kind = item / 128, rg = lane >> 3, dch = lane & 7;
    if (act) {
        int col; const float* g; bool rope;
        if (kind < 4) { col = C_BQ + kind * 64; g = moba_g; rope = true; }
        else if (kind < 8) { col = C_BK + (kind - 4) * 64; g = moba_g + 64; rope = true; }
        else if (kind < 12) { col = C_NQ + (kind - 8) * 64; g = nsa_qg; rope = false; }
        else if (kind == 12) { col = C_NKS; g = nsa_kg + 64; rope = true; }
        else { col = C_NKW; g = nsa_kg + 128; rope = true; }
        float gd[8];
#pragma unroll
        for (int e = 0; e < 8; ++e) gd[e] = g[dch * 8 + e];
        const int row0 = tb * 256 + wid * 64 + rg;
        u32x4p raw[8];
#pragma unroll
        for (int it = 0; it < 8; ++it) raw[it] = *(const u32x4p*)(P + (size_t)(row0 + it * 8) * DINP + col + dch * 8);
        float ks[8];
#pragma unroll
        for (int e = 0; e < 8; ++e) ks[e] = 0.f;
#pragma unroll
        for (int it = 0; it < 8; ++it) {
            const int row = row0 + it * 8, pos = row & (SEQ - 1);
            float y[8]; float ss = 0.f;
#pragma unroll
            for (int e = 0; e < 4; ++e) { y[2 * e] = __builtin_bit_cast(float, raw[it][e] << 16); y[2 * e + 1] = __builtin_bit_cast(float, raw[it][e] & 0xffff0000u); ss += y[2 * e] * y[2 * e] + y[2 * e + 1] * y[2 * e + 1]; }
            ss += shx<1>(ss); ss += shx<2>(ss); ss += shx<4>(ss);
            const float rstd = rsqrtf(ss * (1.f / 64.f) + EPS);
#pragma unroll
            for (int e = 0; e < 8; ++e) y[e] *= rstd * gd[e];
            if (rope) {
                float o[8];
#pragma unroll
                for (int e = 0; e < 8; ++e) o[e] = shx<1>(y[e]);
                if (dch < 2) { const float4 c0 = *(const float4*)(tab + pos * 16), c1 = *(const float4*)(tab + pos * 16 + 4), s0 = *(const float4*)(tab + pos * 16 + 8), s1 = *(const float4*)(tab + pos * 16 + 12);
                    const float cs[8] = {c0.x, c0.y, c0.z, c0.w, c1.x, c1.y, c1.z, c1.w}, sn[8] = {s0.x, s0.y, s0.z, s0.w, s1.x, s1.y, s1.z, s1.w};
#pragma unroll
                    for (int e = 0; e < 8; ++e) y[e] = dch ? (y[e] * cs[e] + o[e] * sn[e]) : (y[e] * cs[e] - o[e] * sn[e]); }
            }
            u32x4p w; w[0] = pg8::pk2bf(y[0], y[1]); w[1] = pg8::pk2bf(y[2], y[3]); w[2] = pg8::pk2bf(y[4], y[5]); w[3] = pg8::pk2bf(y[6], y[7]);
            *(u32x4p*)(P + (size_t)row * DINP + col + dch * 8) = w;
#pragma unroll
            for (int e = 0; e < 8; ++e) ks[e] += y[e];
        }
        if (kind >= 4 && kind < 8) {
#pragma unroll
            for (int e = 0; e < 8; ++e) { ks[e] += shx<8>(ks[e]); ks[e] += shx<16>(ks[e]); ks[e] += shx<32>(ks[e]); }
            if (rg == 0) {
#pragma unroll
                for (int e = 0; e < 8; ++e) red[wid * 64 + dch * 8 + e] = ks[e]; }
        }
    }
    __syncthreads();
    if (act && kind >= 4 && kind < 8 && wid == 0) { const float s = red[lane] + red[64 + lane] + red[128 + lane] + red[192 + lane];
        const int b = tb >> 5, n = tb & 31; kmean[(((size_t)b * 4 + (kind - 4)) * 32 + n) * 64 + lane] = s * (1.f / 256.f); }
    __syncthreads();
}
__device__ __forceinline__ void ph_compress(const bf16* __restrict__ P, const float* __restrict__ pe, const float* __restrict__ w1, const float* __restrict__ w2, const float* __restrict__ kg0,
                                            float* __restrict__ KVc, bf16* __restrict__ KVcb, int item, bool act, int t, float* sm  ) {
    float* in = sm; float* hid = sm + 2048;
    const int i = item % NCMP, b = (item / NCMP) & 3, kv = item / (NCMP * 4);
    const int col = kv ? C_NVC : C_NKC;
    if (act) for (int e = t; e < 2048; e += 256) { const int p = e >> 6, d = e & 63; in[e] = bf2f(P[(size_t)(b * SEQ + 16 * i + p) * DINP + col + d]) + pe[(kv * 32 + p) * 64 + d]; }
    __syncthreads();
    if (act && t < 128) { const float* w = w1 + (size_t)kv * 2048 * 128 + t; float a = 0.f;
#pragma unroll 8
        for (int k = 0; k < 2048; ++k) a = fmaf(in[k], w[(size_t)k * 128], a);
        hid[t] = a * rcpf_(1.f + __expf(-a)); }
    __syncthreads();
    if (act && t < 64) { const float* ww = w2 + (size_t)kv * 128 * 64 + t; float o = 0.f;
#pragma unroll 8
        for (int j = 0; j < 128; ++j) o = fmaf(hid[j], ww[j * 64], o);
        if (kv == 0) { const float ss = wave_sum(o * o); o = o * rsqrtf(ss * (1.f / 64.f) + EPS) * kg0[t]; }
        KVc[(((size_t)kv * NB + b) * 512 + i) * 64 + t] = o; KVcb[(((size_t)kv * NB + b) * 512 + i) * 64 + t] = f2bf(o);
        if (i == NCMP - 1) KVcb[(((size_t)kv * NB + b) * 512 + NCMP) * 64 + t] = 0; }
    __syncthreads();
}
__device__ __forceinline__ float conv_silu(const bf16* __restrict__ P, const float* __restrict__ cw  , int rowbase, int t, int c) {
    float a = 0.f;
#pragma unroll
    for (int j = 0; j < 4; ++j) { const int tt = t - 3 + j; if (tt >= 0) a = fmaf(cw[j * 1024 + c], bf2f(P[(size_t)(rowbase + tt) * DINP + c]), a); }
    return a * rcpf_(1.f + __expf(-a));
}
__device__ __forceinline__ void ph_mlstm_local(const bf16* __restrict__ P, const float* __restrict__ G, const float* __restrict__ cw, const float* __restrict__ bif,
                                               float* __restrict__ Cst, float* __restrict__ nst, float* __restrict__ dec, int u, bool act, int tid, unsigned char* sm) {
    bf16 (*ks)[128] = (bf16 (*)[128])sm; bf16 (*vs)[128] = (bf16 (*)[128])(sm + 16384); float* wS = (float*)(sm + 32768); float* lf = wS + 64;
    const int c = u & 127, h = (u >> 7) & 3, b = u >> 9;
    const int rowbase = b * SEQ, t0 = c * 64;
    if (act) {
        for (int e = tid; e < 64 * 128; e += 256) { const int s = e >> 7, d = e & 127;
            ks[s][d] = f2bf(conv_silu(P, cw, rowbase, t0 + s, 512 + h * 128 + d) * 0.08838834764831845f);
            vs[s][d] = P[(size_t)(rowbase + t0 + s) * DINP + C_MV + h * 128 + d]; }
        if (tid < 64) lf[tid] = log_sigmoidf_(G[(size_t)(rowbase + t0 + tid) * 32 + 4 + h] + bif[4 + h]);
    }
    __syncthreads();
    if (act && tid == 0) { float acc = 0.f;
        for (int s = 0; s < 64; ++s) { acc += lf[s]; lf[s] = acc; }
        dec[u] = __expf(acc); }
    __syncthreads();
    if (act && tid < 64) wS[tid] = __expf(lf[63] - lf[tid] + G[(size_t)(rowbase + t0 + tid) * 32 + h] + bif[h]);
    __syncthreads();
    if (act) {
        const int d = tid >> 1, e0 = (tid & 1) * 64;
        float acc[64];
#pragma unroll
        for (int e = 0; e < 64; ++e) acc[e] = 0.f;
        float an = 0.f;
        for (int s = 0; s < 64; ++s) { const float kw = wS[s] * bf2f(ks[s][d]); an += kw;
#pragma unroll
            for (int e = 0; e < 64; ++e) acc[e] = fmaf(kw, bf2f(vs[s][e0 + e]), acc[e]); }
        float* o = Cst + ((size_t)u * 128 + d) * 128 + e0;
#pragma unroll
        for (int e = 0; e < 64; ++e) o[e] = acc[e];
        if ((tid & 1) == 0) nst[(size_t)u * 128 + d] = an;
    }
    __syncthreads();
}
__device__ __forceinline__ void ph_mlstm_scan(float* __restrict__ Cst, float* __restrict__ nst, const float* __restrict__ dec, int item, int tid) {
    const int bh = item / 65, part = item % 65;
    float* base; int stride;
    if (part < 64) { base = Cst + (size_t)bh * 128 * 16384 + part * 256 + tid; stride = 16384; }
    else { if (tid >= 128) return; base = nst + (size_t)bh * 128 * 128 + tid; stride = 128; }
    float C = 0.f;
    for (int c = 0; c < 128; ++c) { const float dC = base[(size_t)c * stride]; base[(size_t)c * stride] = C; C = dec[bh * 128 + c] * C + dC; }
}
__device__ __forceinline__ void ph_mlstm_out(const bf16* __restrict__ P, const float* __restrict__ G, const float* __restrict__ cw, const float* __restrict__ bif,
                                             const float* __restrict__ Cst, const float* __restrict__ nst, const float* __restrict__ mnorm, bf16* __restrict__ MIX, int u, bool act, int tid, unsigned char* sm) {
    bf16 (*qs)[128] = (bf16 (*)[128])sm; float* ksS = (float*)(sm + 16384); bf16 (*ks)[128] = (bf16 (*)[128])ksS; bf16 (*vs)[128] = (bf16 (*)[128])(sm + 32768);
    float* bb = (float*)(sm + 49152); float* li = bb + 64;
    const int c = u & 127, h = (u >> 7) & 3, b = u >> 9;
    const int rowbase = b * SEQ, t0 = c * 64;
    if (act) {
        for (int e = tid; e < 64 * 128; e += 256) { const int s = e >> 7, d = e & 127;
            qs[s][d] = f2bf(conv_silu(P, cw, rowbase, t0 + s, h * 128 + d));
            ks[s][d] = f2bf(conv_silu(P, cw, rowbase, t0 + s, 512 + h * 128 + d) * 0.08838834764831845f);
            vs[s][d] = P[(size_t)(rowbase + t0 + s) * DINP + C_MV + h * 128 + d]; }
        if (tid < 64) { bb[tid] = log_sigmoidf_(G[(size_t)(rowbase + t0 + tid) * 32 + 4 + h] + bif[4 + h]); li[tid] = G[(size_t)(rowbase + t0 + tid) * 32 + h] + bif[h]; }
    }
    __syncthreads();
    if (act && tid == 0) { float acc = 0.f; for (int s = 0; s < 64; ++s) { acc += bb[s]; bb[s] = acc; } }
    __syncthreads();
    const int t = tid >> 2, part = tid & 3;
    float sreg[16];
    if (act) {
        const int s0 = part * 16;
#pragma unroll
        for (int j = 0; j < 16; ++j) { const int s = s0 + j; float a = 0.f;
            if (s <= t) { for (int d = 0; d < 128; ++d) a = fmaf(bf2f(qs[t][d]), bf2f(ks[s][d]), a); a *= __expf(bb[t] - bb[s] + li[s]); }
            sreg[j] = a; }
    }
    __syncthreads();
    float* S = ksS;
    if (act) {
#pragma unroll
        for (int j = 0; j < 16; ++j) S[t * 64 + part * 16 + j] = sreg[j];
    }
    __syncthreads();
    if (act) {
        const float Ft = __expf(bb[t]);
        float den = 0.f;
        for (int s = 0; s <= t; ++s) den += S[t * 64 + s];
        { const float* np = nst + (size_t)u * 128; float a = 0.f; for (int d = 0; d < 128; ++d) a = fmaf(bf2f(qs[t][d]), np[d], a); den += Ft * a; }
        const int e0 = part * 32;
        float acc[32];
#pragma unroll
        for (int e = 0; e < 32; ++e) acc[e] = 0.f;
        { const float* Cp = Cst + (size_t)u * 16384 + e0;
          for (int d = 0; d < 128; ++d) { const float qd = bf2f(qs[t][d]);
#pragma unroll
              for (int e = 0; e < 32; ++e) acc[e] = fmaf(qd, Cp[d * 128 + e], acc[e]); } }
#pragma unroll
        for (int e = 0; e < 32; ++e) acc[e] *= Ft;
        for (int s = 0; s <= t; ++s) { const float w = S[t * 64 + s];
#pragma unroll
            for (int e = 0; e < 32; ++e) acc[e] = fmaf(w, bf2f(vs[s][e0 + e]), acc[e]); }
        const float inv = rcpf_(fmaxf(fabsf(den), 1.f));
        float ss = 0.f;
#pragma unroll
        for (int e = 0; e < 32; ++e) { acc[e] *= inv; ss += acc[e] * acc[e]; }
        ss += shx<1>(ss); ss += shx<2>(ss);
        const float rstd = rsqrtf(ss * (1.f / 128.f) + EPS);
        const size_t row = (size_t)(rowbase + t0 + t);
#pragma unroll
        for (int e = 0; e < 32; ++e) { const int cc = h * 128 + e0 + e;
            const float o = sigmoidf_(bf2f(P[row * DINP + C_MO + cc]));
            MIX[row * DM + cc] = f2bf(acc[e] * rstd * mnorm[cc] * o); }
    }
    __syncthreads();
}

__device__ __forceinline__ void ph_moba(const bf16* __restrict__ P, const float* __restrict__ kmean, bf16* __restrict__ MIX, int gw, int lane, float* q) {
    const int bh = gw >> 13, tq = gw & (SEQ - 1), b = bh >> 2, h = bh & 3, own = tq >> 8;
    const size_t row = (size_t)b * SEQ + tq;
    __builtin_amdgcn_s_waitcnt(0); __builtin_amdgcn_wave_barrier();
    q[lane] = bf2f(P[row * DINP + C_BQ + h * 64 + lane]);
    __builtin_amdgcn_s_waitcnt(0); __builtin_amdgcn_wave_barrier();
    float gs = -3.0e38f;
    if (lane < 32) { if (lane < own) { const float* km = kmean + (((size_t)b * 4 + h) * 32 + lane) * 64; float a = 0.f; for (int d = 0; d < 64; ++d) a = fmaf(q[d], km[d], a); gs = a; } else gs = -1e30f; }
    int blk[4]; bool val[4];
#pragma unroll
    for (int r = 0; r < 3; ++r) { const float m = wave_max(gs); const unsigned long long bal = __ballot(gs == m); const int idx = __ffsll((long long)bal) - 1;
        blk[r] = idx; val[r] = (r < own); if (lane == idx) gs = -3.0e38f; }
    blk[3] = own; val[3] = true;
    float s[4][4]; float mx = -1e30f;
#pragma unroll
    for (int g = 0; g < 4; ++g)
#pragma unroll
        for (int i = 0; i < 4; ++i) { float a = -1e30f;
            if (val[g]) { const int pos = blk[g] * 256 + i * 64 + lane;
                if (g < 3 || pos <= tq) { const bf16* kp = P + ((size_t)b * SEQ + pos) * DINP + C_BK + h * 64; a = dot64(kp, q) * 0.125f; } }
            s[g][i] = a; mx = fmaxf(mx, a); }
    mx = wave_max(mx);
    float l = 0.f;
#pragma unroll
    for (int g = 0; g < 4; ++g)
#pragma unroll
        for (int i = 0; i < 4; ++i) { const float p = (s[g][i] > -1e29f) ? __expf(s[g][i] - mx) : 0.f; s[g][i] = p; l += p; }
    l = wave_sum(l);
    float o = 0.f;
#pragma unroll
    for (int g = 0; g < 4; ++g) { if (!val[g]) continue;
#pragma unroll
        for (int i = 0; i < 4; ++i) { const bf16* vp = P + ((size_t)b * SEQ + blk[g] * 256 + i * 64) * DINP + C_BV + h * 64 + lane;
            for (int src = 0; src < 64; ++src) { const float p = __shfl(s[g][i], src); o = fmaf(p, bf2f(vp[(size_t)src * DINP]), o); } } }
    MIX[row * DM + 512 + h * 64 + lane] = f2bf(o * rcpf_(l));
}

__device__ __forceinline__ void ph_nsa(const bf16* __restrict__ P, const float* __restrict__ G, const float* __restrict__ tab, const float* __restrict__ KVc, bf16* __restrict__ MIX, int gw, int lane, float* sm) {
    float (*qn)[64] = (float (*)[64])sm; float (*qr)[64] = (float (*)[64])(sm + 256); float* ps = sm + 512;
    const int b = gw >> 13, tq = gw & (SEQ - 1), blkq = tq >> 6;
    const size_t row = (size_t)b * SEQ + tq;
    __builtin_amdgcn_s_waitcnt(0); __builtin_amdgcn_wave_barrier();
#pragma unroll
    for (int h = 0; h < 4; ++h) { const float x = bf2f(P[row * DINP + C_NQ + h * 64 + lane]); qn[h][lane] = x;
        float y = x; const float other = shx<8>(x);
        if (lane < 16) { const int f = lane & 7; const float c = tab[tq * 16 + f], s = tab[tq * 16 + 8 + f]; y = (lane < 8) ? (x * c - other * s) : (x * c + other * s); }
        qr[h][lane] = y; }
    __builtin_amdgcn_s_waitcnt(0); __builtin_amdgcn_wave_barrier();
    const float* Kc = KVc + (size_t)b * 512 * 64; const float* Vc = KVc + ((size_t)NB + b) * 512 * 64;
    float out[4] = {0.f, 0.f, 0.f, 0.f};
    float gate[3][4];
#pragma unroll
    for (int br = 0; br < 3; ++br)
#pragma unroll
        for (int h = 0; h < 4; ++h) gate[br][h] = sigmoidf_(G[row * 32 + 8 + br * 4 + h]);
    const int ncv = (tq >= 31) ? ((tq - 31) >> 4) + 1 : 0;
    {
        float sc[8][4]; float mx[4] = {-1e30f, -1e30f, -1e30f, -1e30f};
#pragma unroll
        for (int i = 0; i < 8; ++i) { const int c = i * 64 + lane;
            float a[4] = {-1e30f, -1e30f, -1e30f, -1e30f};
            if (c < ncv) { const float* kp = Kc + (size_t)c * 64; a[0] = a[1] = a[2] = a[3] = 0.f;
                for (int d = 0; d < 64; ++d) { const float kd = kp[d]; a[0] = fmaf(qn[0][d], kd, a[0]); a[1] = fmaf(qn[1][d], kd, a[1]); a[2] = fmaf(qn[2][d], kd, a[2]); a[3] = fmaf(qn[3][d], kd, a[3]); }
#pragma unroll
                for (int h = 0; h < 4; ++h) a[h] *= 0.125f; }
#pragma unroll
            for (int h = 0; h < 4; ++h) { sc[i][h] = a[h]; mx[h] = fmaxf(mx[h], a[h]); } }
        float l[4];
#pragma unroll
        for (int h = 0; h < 4; ++h) { mx[h] = wave_max(mx[h]); l[h] = 0.f; }
#pragma unroll
        for (int i = 0; i < 8; ++i) { const int c = i * 64 + lane;
#pragma unroll
            for (int h = 0; h < 4; ++h) { const float p = (c < ncv) ? __expf(sc[i][h] - mx[h]) : 0.f; sc[i][h] = p; l[h] += p; } }
#pragma unroll
        for (int h = 0; h < 4; ++h) { l[h] = wave_sum(l[h]); l[h] = (l[h] > 0.f) ? rcpf_(l[h]) : 0.f; }
#pragma unroll
        for (int i = 0; i < 8; ++i) { float su = 0.f;
#pragma unroll
            for (int h = 0; h < 4; ++h) { sc[i][h] *= l[h]; su += sc[i][h]; }
            ps[i * 64 + lane] = su; }
        if (lane < 4) ps[512 + lane] = 0.f;
        float oc[4] = {0.f, 0.f, 0.f, 0.f};
#pragma unroll
        for (int i = 0; i < 8; ++i) { if (i * 64 >= ncv) break; const int nn = min(64, ncv - i * 64);
            for (int src = 0; src < nn; ++src) { const float v = Vc[(size_t)(i * 64 + src) * 64 + lane];
                oc[0] = fmaf(__shfl(sc[i][0], src), v, oc[0]); oc[1] = fmaf(__shfl(sc[i][1], src), v, oc[1]);
                oc[2] = fmaf(__shfl(sc[i][2], src), v, oc[2]); oc[3] = fmaf(__shfl(sc[i][3], src), v, oc[3]); } }
#pragma unroll
        for (int h = 0; h < 4; ++h) out[h] = gate[0][h] * oc[h];
    }
    __builtin_amdgcn_s_waitcnt(0); __builtin_amdgcn_wave_barrier();
    int sidx[16];
    {
        float v0, v1;
        { const int n = lane; float im = 0.f;
#pragma unroll
          for (int j = -1; j < 4; ++j) { const int c = 4 * n + j; if (c >= 0 && c < NCMP) im += ps[c]; }
          const bool causal = n <= blkq, forced = causal && (n == 0 || n >= blkq - 1);
          v0 = forced ? 1e9f : (causal ? im : -1e30f); }
        { const int n = lane + 64; float im = 0.f;
#pragma unroll
          for (int j = -1; j < 4; ++j) { const int c = 4 * n + j; if (c >= 0 && c < NCMP) im += ps[c]; }
          const bool causal = n <= blkq, forced = causal && (n == 0 || n >= blkq - 1);
          v1 = forced ? 1e9f : (causal ? im : -1e30f); }
#pragma unroll
        for (int k = 0; k < 16; ++k) { const float m = wave_max(fmaxf(v0, v1));
            const unsigned long long b0 = __ballot(v0 == m); int idx;
            if (b0) { idx = __ffsll((long long)b0) - 1; if (lane == idx) v0 = -3.0e38f; }
            else { const unsigned long long b1 = __ballot(v1 == m); idx = __ffsll((long long)b1) - 1; if (lane == idx) v1 = -3.0e38f; idx += 64; }
            sidx[k] = idx; }
    }
    {
        float sc[16][4]; float mx[4] = {-1e30f, -1e30f, -1e30f, -1e30f};
#pragma unroll
        for (int k = 0; k < 16; ++k) { const int n = sidx[k], pos = n * 64 + lane;
            float a[4] = {-1e30f, -1e30f, -1e30f, -1e30f};
            if (n <= blkq && pos <= tq) { const bf16* kp = P + ((size_t)b * SEQ + pos) * DINP + C_NKS; dot64x4(kp, qr, a);
#pragma unroll
                for (int h = 0; h < 4; ++h) a[h] *= 0.125f; }
#pragma unroll
            for (int h = 0; h < 4; ++h) { sc[k][h] = a[h]; mx[h] = fmaxf(mx[h], a[h]); } }
        float l[4];
#pragma unroll
        for (int h = 0; h < 4; ++h) { mx[h] = wave_max(mx[h]); l[h] = 0.f; }
#pragma unroll
        for (int k = 0; k < 16; ++k)
#pragma unroll
            for (int h = 0; h < 4; ++h) { const float p = (sc[k][h] > -1e29f) ? __expf(sc[k][h] - mx[h]) : 0.f; sc[k][h] = p; l[h] += p; }
#pragma unroll
        for (int h = 0; h < 4; ++h) l[h] = rcpf_(wave_sum(l[h]));
        float os[4] = {0.f, 0.f, 0.f, 0.f};
#pragma unroll
        for (int k = 0; k < 16; ++k) { const int n = sidx[k]; if (n > blkq) continue;
            const bf16* vp = P + ((size_t)b * SEQ + n * 64) * DINP + C_NVS + lane;
            for (int src = 0; src < 64; ++src) { const float v = bf2f(vp[(size_t)src * DINP]);
                os[0] = fmaf(__shfl(sc[k][0], src), v, os[0]); os[1] = fmaf(__shfl(sc[k][1], src), v, os[1]);
                os[2] = fmaf(__shfl(sc[k][2], src), v, os[2]); os[3] = fmaf(__shfl(sc[k][3], src), v, os[3]); } }
#pragma unroll
        for (int h = 0; h < 4; ++h) out[h] += gate[1][h] * os[h] * l[h];
    }
    {
        float sc[8][4]; float mx[4] = {-1e30f, -1e30f, -1e30f, -1e30f};
#pragma unroll
        for (int i = 0; i < 8; ++i) { const int pos = tq - 511 + i * 64 + lane;
            float a[4] = {-1e30f, -1e30f, -1e30f, -1e30f};
            if (pos >= 0) { const bf16* kp = P + ((size_t)b * SEQ + pos) * DINP + C_NKW; dot64x4(kp, qr, a);
#pragma unroll
                for (int h = 0; h < 4; ++h) a[h] *= 0.125f; }
#pragma unroll
            for (int h = 0; h < 4; ++h) { sc[i][h] = a[h]; mx[h] = fmaxf(mx[h], a[h]); } }
        float l[4];
#pragma unroll
        for (int h = 0; h < 4; ++h) { mx[h] = wave_max(mx[h]); l[h] = 0.f; }
#pragma unroll
        for (int i = 0; i < 8; ++i)
#pragma unroll
            for (int h = 0; h < 4; ++h) { const float p = (sc[i][h] > -1e29f) ? __expf(sc[i][h] - mx[h]) : 0.f; sc[i][h] = p; l[h] += p; }
#pragma unroll
        for (int h = 0; h < 4; ++h) l[h] = rcpf_(wave_sum(l[h]));
        float ow[4] = {0.f, 0.f, 0.f, 0.f};
#pragma unroll
        for (int i = 0; i < 8; ++i) { const int p0 = tq - 511 + i * 64; if (p0 + 63 < 0) continue;
            const int s0 = p0 < 0 ? -p0 : 0;
            for (int src = s0; src < 64; ++src) { const float v = bf2f(P[((size_t)b * SEQ + p0 + src) * DINP + C_NVW + lane]);
                ow[0] = fmaf(__shfl(sc[i][0], src), v, ow[0]); ow[1] = fmaf(__shfl(sc[i][1], src), v, ow[1]);
                ow[2] = fmaf(__shfl(sc[i][2], src), v, ow[2]); ow[3] = fmaf(__shfl(sc[i][3], src), v, ow[3]); } }
#pragma unroll
        for (int h = 0; h < 4; ++h) out[h] += gate[2][h] * ow[h] * l[h];
    }
#pragma unroll
    for (int h = 0; h < 4; ++h) MIX[row * DM + 768 + h * 64 + lane] = f2bf(out[h]);
}


#define LAS __attribute__((address_space(3)))
typedef short bf16x8 __attribute__((ext_vector_type(8)));
typedef float f32x16 __attribute__((ext_vector_type(16)));
typedef short s16x4 __attribute__((ext_vector_type(4)));
typedef unsigned u32x4v __attribute__((ext_vector_type(4)));
typedef float f32x2_t __attribute__((ext_vector_type(2)));
typedef __bf16 bf16x2_t __attribute__((ext_vector_type(2)));
constexpr int KROW = 144, VROW = 192;
constexpr int KBUF = 64 * KROW, VBUF = 64 * VROW, STG = KBUF + VBUF;
constexpr float SCL2 = 0.125f * 1.4426950408889634f;
constexpr float NEGBIG = -1e30f;

__device__ __forceinline__ unsigned cvtpk(float lo, float hi) { f32x2_t v = {lo, hi}; bf16x2_t b = __builtin_convertvector(v, bf16x2_t); return __builtin_bit_cast(unsigned, b); }
__device__ __forceinline__ int crow(int r, int hi) { return (r & 3) + 8 * (r >> 2) + 4 * hi; }
__device__ __forceinline__ s16x4 lds_tr(LAS const unsigned char* p) { return __builtin_bit_cast(s16x4, __builtin_amdgcn_ds_read_tr16_b64_v4i16((LAS s16x4*)p)); }

__device__ __forceinline__ bf16x8 scale_frag(bf16x8 v, float s) {
    const u32x4v w = __builtin_bit_cast(u32x4v, v); u32x4v o;
#pragma unroll
    for (int e = 0; e < 4; ++e) o[e] = cvtpk(__builtin_bit_cast(float, w[e] << 16) * s, __builtin_bit_cast(float, w[e] & 0xffff0000u) * s);
    return __builtin_bit_cast(bf16x8, o);
}
struct TileSrc { const bf16* k; const bf16* v; int stride; };
__device__ __forceinline__ void tile_load(u32x4v& kr, u32x4v& vr, const TileSrc& s, int t) {
    const int key = t >> 3, ch = t & 7;
    kr = *(const u32x4v*)(s.k + (size_t)key * s.stride + ch * 8); vr = *(const u32x4v*)(s.v + (size_t)key * s.stride + ch * 8);
}
__device__ __forceinline__ void tile_store(LAS unsigned char* buf, const u32x4v& kr, const u32x4v& vr, int t) {
    const int key = t >> 3, ch = t & 7;
    *(LAS u32x4v*)(buf + key * KROW + ch * 16) = kr; *(LAS u32x4v*)(buf + KBUF + key * VROW + ch * 16) = vr;
}
__device__ __forceinline__ void qk_tile(f32x16& p0, f32x16& p1, LAS const unsigned char* kb, const bf16x8 (&qf)[4], int r32, int hi, float cinit) {
    float ci = cinit; asm volatile("" : "+v"(ci));
#pragma unroll
    for (int r = 0; r < 16; ++r) { p0[r] = ci; p1[r] = ci; }
    LAS const unsigned char* a = kb + r32 * KROW + hi * 16;
#pragma unroll
    for (int ks = 0; ks < 4; ++ks) {
        const bf16x8 a0 = *(LAS const bf16x8*)(a + ks * 32), a1 = *(LAS const bf16x8*)(a + 32 * KROW + ks * 32);
        p0 = __builtin_amdgcn_mfma_f32_32x32x16_bf16(a0, qf[ks], p0, 0, 0, 0);
        p1 = __builtin_amdgcn_mfma_f32_32x32x16_bf16(a1, qf[ks], p1, 0, 0, 0);
    }
}
__device__ __forceinline__ void pv_tile(f32x16& o0, f32x16& o1, LAS const unsigned char* vb, const f32x16& p0, const f32x16& p1, int lane) {
    const int g = lane >> 4, i = lane & 15, hi = lane >> 5;
    LAS const unsigned char* base = vb + (4 * hi + (i >> 2)) * VROW + (16 * (g & 1) + 4 * (i & 3)) * 2;
#pragma unroll
    for (int s = 0; s < 4; ++s) {
        unsigned w[4];
#pragma unroll
        for (int e = 0; e < 4; ++e) { const int r = 8 * (s & 1) + 2 * e; w[e] = (s < 2) ? cvtpk(p0[r], p0[r + 1]) : cvtpk(p1[r], p1[r + 1]); }
        const u32x4v wv = {w[0], w[1], w[2], w[3]};
        const bf16x8 pf = __builtin_bit_cast(bf16x8, wv);
#pragma unroll
        for (int mb = 0; mb < 2; ++mb) {
            const s16x4 lo = lds_tr(base + s * 16 * VROW + mb * 64), hi4 = lds_tr(base + s * 16 * VROW + 8 * VROW + mb * 64);
            const bf16x8 vt = {lo[0], lo[1], lo[2], lo[3], hi4[0], hi4[1], hi4[2], hi4[3]};
            if (mb == 0) o0 = __builtin_amdgcn_mfma_f32_32x32x16_bf16(vt, pf, o0, 0, 0, 0);
            else o1 = __builtin_amdgcn_mfma_f32_32x32x16_bf16(vt, pf, o1, 0, 0, 0);
        }
    }
}
constexpr float SM_THR = 8.0f;
__device__ __forceinline__ void softmax_tile(f32x16& p0, f32x16& p1, f32x16& o0, f32x16& o1, float& mref, float& l, bool first) {
    float a = __builtin_fmaxf(__builtin_fmaxf(p0[0], p0[1]), p1[0]), b = __builtin_fmaxf(__builtin_fmaxf(p0[2], p0[3]), p1[1]);
    a = __builtin_fmaxf(__builtin_fmaxf(a, p1[2]), p1[3]);
#pragma unroll
    for (int r = 4; r < 16; r += 4) { a = __builtin_fmaxf(__builtin_fmaxf(a, p0[r]), p0[r + 1]); b = __builtin_fmaxf(__builtin_fmaxf(b, p0[r + 2]), p0[r + 3]);
        a = __builtin_fmaxf(__builtin_fmaxf(a, p1[r]), p1[r + 1]); b = __builtin_fmaxf(__builtin_fmaxf(b, p1[r + 2]), p1[r + 3]); }
    float rm = __builtin_fmaxf(a, b);
    { auto rr = __builtin_amdgcn_permlane32_swap(__float_as_uint(rm), __float_as_uint(rm), false, false); rm = __builtin_fmaxf(__uint_as_float(rr[0]), __uint_as_float(rr[1])); }
    if (first || __any(rm > SM_THR)) {
        const float dl = first ? rm : __builtin_fmaxf(rm, 0.f);
        mref += dl;
        const float f = __builtin_amdgcn_exp2f(-dl);
        l *= f;
#pragma unroll
        for (int r = 0; r < 16; ++r) { p0[r] -= dl; p1[r] -= dl; o0[r] *= f; o1[r] *= f; }
    }
    float s0 = 0.f, s1 = 0.f;
#pragma unroll
    for (int r = 0; r < 16; ++r) { p0[r] = __builtin_amdgcn_exp2f(p0[r]); p1[r] = __builtin_amdgcn_exp2f(p1[r]); s0 += p0[r]; s1 += p1[r]; }
    l += s0 + s1;
}


constexpr int PV_OFF = 2 * KBUF, PIPE_BYTES = 2 * KBUF + 2 * VBUF;
__device__ __forceinline__ void k_store(LAS unsigned char* lds, int slot, const u32x4v& kr, int t) { *(LAS u32x4v*)(lds + slot * KBUF + (t >> 3) * KROW + (t & 7) * 16) = kr; }
__device__ __forceinline__ void v_store(LAS unsigned char* lds, int voff, const u32x4v& vr, int t) { *(LAS u32x4v*)(lds + PV_OFF + voff + (t >> 3) * VROW + (t & 7) * 16) = vr; }
__device__ __forceinline__ u32x4v kv_load(const bf16* base, int stride, int t) { return *(const u32x4v*)(base + (size_t)(t >> 3) * stride + (t & 7) * 8); }
__device__ __forceinline__ void pv_frag(f32x16& o0, f32x16& o1, LAS const unsigned char* vb, const bf16x8 (&pf)[4], int lane) {
    const int g = lane >> 4, i = lane & 15, hi = lane >> 5;
    LAS const unsigned char* base = vb + (4 * hi + (i >> 2)) * VROW + (16 * (g & 1) + 4 * (i & 3)) * 2;
#pragma unroll
    for (int s = 0; s < 4; ++s)
#pragma unroll
        for (int mb = 0; mb < 2; ++mb) {
            const s16x4 lo = lds_tr(base + s * 16 * VROW + mb * 64), hi4 = lds_tr(base + s * 16 * VROW + 8 * VROW + mb * 64);
            const bf16x8 vt = {lo[0], lo[1], lo[2], lo[3], hi4[0], hi4[1], hi4[2], hi4[3]};
            if (mb == 0) o0 = __builtin_amdgcn_mfma_f32_32x32x16_bf16(vt, pf[s], o0, 0, 0, 0);
            else o1 = __builtin_amdgcn_mfma_f32_32x32x16_bf16(vt, pf[s], o1, 0, 0, 0);
        }
}
__device__ __forceinline__ void exp_pack(f32x16& p0, f32x16& p1, float& l, bf16x8 (&pf)[4]) {
    float s0 = 0.f, s1 = 0.f;
#pragma unroll
    for (int r = 0; r < 16; ++r) { p0[r] = __builtin_amdgcn_exp2f(p0[r]); p1[r] = __builtin_amdgcn_exp2f(p1[r]); s0 += p0[r]; s1 += p1[r]; }
    l += s0 + s1;
#pragma unroll
    for (int s = 0; s < 4; ++s) { u32x4v w;
#pragma unroll
        for (int e = 0; e < 4; ++e) { const int r = 8 * (s & 1) + 2 * e; w[e] = (s < 2) ? cvtpk(p0[r], p0[r + 1]) : cvtpk(p1[r], p1[r + 1]); }
        pf[s] = __builtin_bit_cast(bf16x8, w); }
}
template <class Pol>
__device__ __forceinline__ void attn_step_gen(const Pol& pol, int t, bool doqk, LAS unsigned char* lds, const bf16x8 (&qf)[4], float negm, f32x16& pc0, f32x16& pc1,
                                              f32x16& o0, f32x16& o1, float& l, int tid, int lane, int r32, int hi) {
    const int nt = pol.nt;
    u32x4v kr, vr;
    const bool ldk = (t + 2 < nt), ldv = (t + 1 < nt);
    if (ldk) kr = kv_load(pol.kptr(t + 2), pol.stride, tid);
    if (ldv) vr = kv_load(pol.vptr(t + 1), pol.stride, tid);
    f32x16 pn0, pn1; bf16x8 pf[4];
    if (doqk) { qk_tile(pn0, pn1, lds + ((t + 1) & 1) * KBUF, qf, r32, hi, pol.rowsel(t + 1) ? negm : NEGBIG); pol.mask(t + 1, pn0, pn1); }
    exp_pack(pc0, pc1, l, pf);
    pv_frag(o0, o1, lds + PV_OFF + (t & 1) * VBUF, pf, lane);
    if (ldk) k_store(lds, t & 1, kr, tid);
    if (ldv) v_store(lds, ((t + 1) & 1) * VBUF, vr, tid);
    __syncthreads();
    if (doqk) { pc0 = pn0; pc1 = pn1; }
}
template <class Pol>
__device__ __forceinline__ void attn_step_fast(const Pol& pol, int t, LAS unsigned char* lds, const bf16x8 (&qf)[4], float negm, f32x16& pc0, f32x16& pc1, f32x16& pn0, f32x16& pn1,
                                               f32x16& o0, f32x16& o1, float& l, u32x4v& kld, u32x4v& vld, const u32x4v& kst, const u32x4v& vst,
                                               int tid, int lane, int r32, int hi) {
    const int nt = pol.nt, tk = (t + 3 < nt) ? t + 3 : nt - 1, tv = (t + 2 < nt) ? t + 2 : nt - 1;
    kld = kv_load(pol.kptr(tk), pol.stride, tid); vld = kv_load(pol.vptr(tv), pol.stride, tid);
    bf16x8 pf[4];
    qk_tile(pn0, pn1, lds + ((t + 1) & 1) * KBUF, qf, r32, hi, pol.rowsel(t + 1) ? negm : NEGBIG);
    exp_pack(pc0, pc1, l, pf);
    pv_frag(o0, o1, lds + PV_OFF + (t & 1) * VBUF, pf, lane);
    k_store(lds, t & 1, kst, tid);
    v_store(lds, ((t + 1) & 1) * VBUF, vst, tid);
    __syncthreads();
}
template <class Pol>
__device__ __forceinline__ void attn_pipe(const Pol& pol, LAS unsigned char* lds, const bf16x8 (&qf)[4], float negm, f32x16& o0, f32x16& o1, float& l, int tid) {
    const int lane = tid & 63, r32 = lane & 31, hi = lane >> 5, nt = pol.nt;
    {
        const u32x4v k0 = kv_load(pol.kptr(0), pol.stride, tid), v0 = kv_load(pol.vptr(0), pol.stride, tid);
        u32x4v k1 = k0; if (nt > 1) k1 = kv_load(pol.kptr(1), pol.stride, tid);
        k_store(lds, 0, k0, tid); v_store(lds, 0, v0, tid); if (nt > 1) k_store(lds, 1, k1, tid);
    }
    __syncthreads();
    f32x16 pc0, pc1;
    qk_tile(pc0, pc1, lds, qf, r32, hi, pol.rowsel(0) ? negm : NEGBIG); pol.mask(0, pc0, pc1);
    int t = 0;
    for (; t < nt - 1 && t + 1 < pol.nmask; ++t)
        attn_step_gen(pol, t, true, lds, qf, negm, pc0, pc1, o0, o1, l, tid, lane, r32, hi);
    if (t < nt - 1) {
        const int tk0 = (t + 2 < nt) ? t + 2 : nt - 1;
        u32x4v ka = kv_load(pol.kptr(tk0), pol.stride, tid), va = kv_load(pol.vptr(t + 1), pol.stride, tid), kb, vb;
        f32x16 pd0, pd1;
        for (; t + 1 < nt - 1; t += 2) {
            attn_step_fast(pol, t, lds, qf, negm, pc0, pc1, pd0, pd1, o0, o1, l, kb, vb, ka, va, tid, lane, r32, hi);
            attn_step_fast(pol, t + 1, lds, qf, negm, pd0, pd1, pc0, pc1, o0, o1, l, ka, va, kb, vb, tid, lane, r32, hi);
        }
        if (t < nt - 1) {
            attn_step_fast(pol, t, lds, qf, negm, pc0, pc1, pd0, pd1, o0, o1, l, kb, vb, ka, va, tid, lane, r32, hi);
            pc0 = pd0; pc1 = pd1; ++t;
        }
    }
    attn_step_gen(pol, nt - 1, false, lds, qf, negm, pc0, pc1, o0, o1, l, tid, lane, r32, hi);
}
__device__ __forceinline__ float row_negm(const bf16x8 (&qf)[4], float kmax) {
    float ss = 0.f;
#pragma unroll
    for (int ks = 0; ks < 4; ++ks) { const u32x4v w = __builtin_bit_cast(u32x4v, qf[ks]);
#pragma unroll
        for (int e = 0; e < 4; ++e) { const float a = __builtin_bit_cast(float, w[e] << 16), b = __builtin_bit_cast(float, w[e] & 0xffff0000u); ss += a * a + b * b; } }
    ss += shx<32>(ss);
    return -(__builtin_sqrtf(ss) * kmax);
}
__device__ __forceinline__ float gain_kmax(const float* g, int lane) { return wave_max(fabsf(g[lane])) * (8.0f * 1.02f); }


constexpr int MK_KM_OFF = 0, MK_MSK_OFF = 8192, MK_CNT_OFF = MK_MSK_OFF + 1024, MK_END = MK_CNT_OFF + 512;
__device__ __forceinline__ void moba_gate_item(const bf16* __restrict__ P, const float* __restrict__ kmean, unsigned* __restrict__ SELB, int* __restrict__ CNTQ, unsigned char* __restrict__ LISTG,
                                               int b, int h, int qb, int tid, LAS unsigned char* lds) {
    asm volatile("" : "+v"(tid));
    const int lane = tid & 63, wid = __builtin_amdgcn_readfirstlane(tid >> 6), r32 = lane & 31, hi = lane >> 5, bh = b * 4 + h;
    LAS float* km = (LAS float*)(lds + MK_KM_OFF); LAS unsigned* msk = (LAS unsigned*)(lds + MK_MSK_OFF); LAS int* cnts = (LAS int*)(lds + MK_CNT_OFF);
    const int own = qb;
    const size_t rowq = (size_t)b * SEQ + qb * 256 + wid * 32 + r32;
    bf16x8 qg[4];
#pragma unroll
    for (int ks = 0; ks < 4; ++ks) qg[ks] = *(const bf16x8*)(P + rowq * DINP + C_BQ + h * 64 + ks * 16 + hi * 8);
    for (int e = tid; e < own * 64; e += 512) km[e] = kmean[((size_t)bh * 32) * 64 + e];
    __syncthreads();
    {
        unsigned mask = 0u; float qv[32];
#pragma unroll
        for (int ks = 0; ks < 4; ++ks)
#pragma unroll
            for (int j = 0; j < 8; ++j) qv[ks * 8 + j] = bf2f((bf16)qg[ks][j]);
        float b0 = -3e38f, b1 = -3e38f, b2 = -3e38f; int i0 = -1, i1 = -1, i2 = -1;
        for (int n = 0; n < own; ++n) {
            LAS const float* kp = km + n * 64 + hi * 8; float a = 0.f;
#pragma unroll
            for (int ks = 0; ks < 4; ++ks)
#pragma unroll
                for (int j = 0; j < 8; ++j) a = fmaf(qv[ks * 8 + j], kp[ks * 16 + j], a);
            a += shx<32>(a);
            if (a > b0) { b2 = b1; i2 = i1; b1 = b0; i1 = i0; b0 = a; i0 = n; }
            else if (a > b1) { b2 = b1; i2 = i1; b1 = a; i1 = n; }
            else if (a > b2) { b2 = a; i2 = n; }
        }
        if (i0 >= 0) mask |= 1u << i0; if (i1 >= 0) mask |= 1u << i1; if (i2 >= 0) mask |= 1u << i2;
        if (hi == 0) { msk[wid * 32 + r32] = mask; SELB[(size_t)bh * SEQ + qb * 256 + wid * 32 + r32] = mask; }
    }
    __syncthreads();
    unsigned mym = 0u;
    if (wid < 4) { mym = msk[wid * 64 + lane];
        for (int n = 0; n < own; ++n) { const unsigned long long bal = __ballot((mym >> n) & 1u); if (lane == 0) cnts[n * 4 + wid] = __popcll(bal); } }
    __syncthreads();
    if (wid < 4) {
        unsigned char* lg = LISTG + ((size_t)bh * 32 + qb) * 32 * 256;
        for (int n = 0; n < own; ++n) { const unsigned long long bal = __ballot((mym >> n) & 1u);
            int off = 0; for (int w = 0; w < wid; ++w) off += cnts[n * 4 + w];
            if ((mym >> n) & 1u) lg[n * 256 + off + __popcll(bal & ((1ull << lane) - 1ull))] = (unsigned char)(wid * 64 + lane); }
    } else if (wid == 4) {
        if (lane < 32) CNTQ[((size_t)bh * 32 + qb) * 32 + lane] = (lane < own) ? (cnts[lane * 4] + cnts[lane * 4 + 1] + cnts[lane * 4 + 2] + cnts[lane * 4 + 3]) : 0;
    }
    __syncthreads();
}
__device__ __forceinline__ unsigned char* moba_part(bf16* P, size_t token, int h, int slot) { return (unsigned char*)(P + token * DINP) + h * 512 + slot * 136; }
constexpr int MK_TAB_OFF = 4 * STG;
__device__ __forceinline__ void moba_kv_chunk(bf16* __restrict__ P, const unsigned* __restrict__ SELB, const int* __restrict__ CNTQ, const unsigned char* __restrict__ LISTG, float kmax,
                                              int bh, int n, int c, int tid, LAS unsigned char* lds) {
    asm volatile("" : "+v"(tid));
    const int lane = tid & 63, wid = __builtin_amdgcn_readfirstlane(tid >> 6), r32 = lane & 31, hi = lane >> 5, b = bh >> 2, h = bh & 3;
    bf16* Pb = P + (size_t)b * SEQ * DINP;
    LAS int* tab = (LAS int*)(lds + MK_TAB_OFF);
    {
        const bf16* ksrc = Pb + (size_t)(n * 256) * DINP + C_BK + h * 64; const bf16* vsrc = Pb + (size_t)(n * 256) * DINP + C_BV + h * 64;
        u32x4v kr[4], vr[4];
#pragma unroll
        for (int s = 0; s < 4; ++s) { kr[s] = kv_load(ksrc + (size_t)s * 64 * DINP, DINP, tid); vr[s] = kv_load(vsrc + (size_t)s * 64 * DINP, DINP, tid); }
        if (tid < 32) { const int cq = (tid > n) ? CNTQ[((size_t)bh * 32 + tid) * 32 + n] : 0; tab[tid] = (cq + 31) >> 5; tab[32 + tid] = cq; }
#pragma unroll
        for (int s = 0; s < 4; ++s) { *(LAS u32x4v*)(lds + s * STG + (tid >> 3) * KROW + (tid & 7) * 16) = kr[s]; *(LAS u32x4v*)(lds + s * STG + KBUF + (tid >> 3) * VROW + (tid & 7) * 16) = vr[s]; }
    }
    __syncthreads();
    if (tid < 16) { const int ord = 16 * c + tid; int qb = -1, j = 0, acc = 0;
        for (int q = n + 1; q < 32; ++q) { const int t = tab[q]; if (qb < 0 && ord < acc + t) { qb = q; j = ord - acc; } acc += t; }
        tab[64 + tid] = qb < 0 ? -1 : ((qb << 8) | j); }
    __syncthreads();
    for (int r = 0; r < 2; ++r) {
        const int ord = 16 * c + 8 * r + wid;
        const int code = tab[64 + 8 * r + wid];
        if (code < 0) continue;
        const int qb = code >> 8, j = code & 255; (void)ord;
        const int cnt = tab[32 + qb], idx = j * 32 + r32; const bool valid = idx < cnt;
        const int row = LISTG[(((size_t)bh * 32 + qb) * 32 + n) * 256 + (valid ? idx : cnt - 1)];
        const size_t token = (size_t)b * SEQ + qb * 256 + row;
        bf16x8 qf[4];
#pragma unroll
        for (int ks = 0; ks < 4; ++ks) qf[ks] = scale_frag(*(const bf16x8*)(P + token * DINP + C_BQ + h * 64 + ks * 16 + hi * 8), SCL2);
        const unsigned mrow = SELB[(size_t)bh * SEQ + qb * 256 + row];
        const float negm = row_negm(qf, kmax);
        f32x16 o0, o1; float l = 0.f;
#pragma unroll
        for (int q = 0; q < 16; ++q) { o0[q] = zf_(); o1[q] = o0[q]; }
#pragma unroll
        for (int s = 0; s < 4; ++s) { f32x16 p0, p1; bf16x8 pf[4];
            qk_tile(p0, p1, lds + s * STG, qf, r32, hi, negm);
            exp_pack(p0, p1, l, pf);
            pv_frag(o0, o1, lds + s * STG + KBUF, pf, lane); }
        l += shx<32>(l);
        if (valid) { unsigned char* pp = moba_part(P, token, h, __popc(mrow & ((1u << n) - 1u)));
#pragma unroll
            for (int g = 0; g < 4; ++g) { uint2 w0, w1;
                w0.x = cvtpk(o0[4 * g], o0[4 * g + 1]); w0.y = cvtpk(o0[4 * g + 2], o0[4 * g + 3]); w1.x = cvtpk(o1[4 * g], o1[4 * g + 1]); w1.y = cvtpk(o1[4 * g + 2], o1[4 * g + 3]);
                *(uint2*)(pp + (8 * g + 4 * hi) * 2) = w0; *(uint2*)(pp + (32 + 8 * g + 4 * hi) * 2) = w1; }
            if (hi == 0) *(float*)(pp + 128) = l; }
    }
    __syncthreads();
}
struct MobaOwnPol {
    int nt, nmask, stride, own, tq, hi; const bf16* Pk; const bf16* Pv;
    __device__ __forceinline__ const bf16* kptr(int i) const { return Pk + (size_t)(own * 4 + i) * 64 * DINP; }
    __device__ __forceinline__ const bf16* vptr(int i) const { return Pv + (size_t)(own * 4 + i) * 64 * DINP; }
    __device__ __forceinline__ bool rowsel(int) const { return true; }
    __device__ __forceinline__ void mask(int i, f32x16& p0, f32x16& p1) const { const int kbase = (own * 4 + i) * 64;
#pragma unroll
        for (int r = 0; r < 16; ++r) { const int k0 = kbase + crow(r, hi); p0[r] = (k0 <= tq) ? p0[r] : nbg; p1[r] = (k0 + 32 <= tq) ? p1[r] : nbg; } }
};
__device__ __forceinline__ void moba_merge_unit(bf16* __restrict__ P, const unsigned* __restrict__ SELB, float kmax, bf16* __restrict__ MIX, int b, int h, int qb, int tid, LAS unsigned char* lds) {
    asm volatile("" : "+v"(tid));
    const int lane = tid & 63, wid = __builtin_amdgcn_readfirstlane(tid >> 6), r32 = lane & 31, hi = lane >> 5, bh = b * 4 + h;
    const int tq = qb * 256 + wid * 32 + r32;
    const size_t rowq = (size_t)b * SEQ + tq;
    const bf16* Pb = P + (size_t)b * SEQ * DINP;
    bf16x8 qf[4];
#pragma unroll
    for (int ks = 0; ks < 4; ++ks) qf[ks] = scale_frag(*(const bf16x8*)(P + rowq * DINP + C_BQ + h * 64 + ks * 16 + hi * 8), SCL2);
    f32x16 o0, o1;
#pragma unroll
    for (int r = 0; r < 16; ++r) { o0[r] = zf_(); o1[r] = o0[r]; }
    float l = 0.f;
    { MobaOwnPol pol; pol.nt = 4; pol.nmask = 4; pol.stride = DINP; pol.own = qb; pol.tq = tq; pol.hi = hi; pol.Pk = Pb + C_BK + h * 64; pol.Pv = Pb + C_BV + h * 64;
      attn_pipe(pol, lds, qf, row_negm(qf, kmax), o0, o1, l, tid); }
    l += shx<32>(l);
    int t2 = tid; asm volatile("" : "+v"(t2));
    const int l2 = t2 & 63, r2 = l2 & 31, h2 = l2 >> 5, w2 = t2 >> 6;
    const size_t token = (size_t)b * SEQ + qb * 256 + w2 * 32 + r2;
    const int ns = __popc(SELB[(size_t)bh * SEQ + qb * 256 + w2 * 32 + r2]);
    for (int s = 0; s < 3; ++s) { if (!__any(s < ns)) break;
        if (s < ns) { const unsigned char* pp = moba_part(P, token, h, s);
#pragma unroll
            for (int g = 0; g < 4; ++g) { const uint2 w0 = *(const uint2*)(pp + (8 * g + 4 * h2) * 2), w1 = *(const uint2*)(pp + (32 + 8 * g + 4 * h2) * 2);
                o0[4 * g] += __builtin_bit_cast(float, w0.x << 16); o0[4 * g + 1] += __builtin_bit_cast(float, w0.x & 0xffff0000u); o0[4 * g + 2] += __builtin_bit_cast(float, w0.y << 16); o0[4 * g + 3] += __builtin_bit_cast(float, w0.y & 0xffff0000u);
                o1[4 * g] += __builtin_bit_cast(float, w1.x << 16); o1[4 * g + 1] += __builtin_bit_cast(float, w1.x & 0xffff0000u); o1[4 * g + 2] += __builtin_bit_cast(float, w1.y << 16); o1[4 * g + 3] += __builtin_bit_cast(float, w1.y & 0xffff0000u); }
            l += *(const float*)(pp + 128); } }
    const float inv = rcpf_(l);
    bf16* op = MIX + token * DM + 512 + h * 64 + 4 * h2;
#pragma unroll
    for (int g = 0; g < 4; ++g) {
        uint2 w0, w1;
        w0.x = cvtpk(o0[4 * g] * inv, o0[4 * g + 1] * inv); w0.y = cvtpk(o0[4 * g + 2] * inv, o0[4 * g + 3] * inv);
        w1.x = cvtpk(o1[4 * g] * inv, o1[4 * g + 1] * inv); w1.y = cvtpk(o1[4 * g + 2] * inv, o1[4 * g + 3] * inv);
        *(uint2*)(op + 8 * g) = w0; *(uint2*)(op + 32 + 8 * g) = w1;
    }
}
constexpr int MK_ENUM_OFF = 4 * STG + 512;
__device__ __forceinline__ void moba_kv_phase(bf16* __restrict__ P, const unsigned* __restrict__ SELB, const int* __restrict__ CNTQ, const unsigned char* __restrict__ LISTG, const float* __restrict__ kgain,
                                              int bid, int G, int tid, LAS unsigned char* lds) {
    asm volatile("" : "+v"(tid));
    LAS int* nch = (LAS int*)(lds + MK_ENUM_OFF);
    const float kmax = gain_kmax(kgain, tid & 63);
    { const int bh = tid >> 5, n = tid & 31; int T = 0;
      for (int q = n + 1; q < 32; ++q) T += (CNTQ[((size_t)bh * 32 + q) * 32 + n] + 31) >> 5;
      nch[tid] = (T + 15) >> 4; }
    __syncthreads();
    if (tid < 64) {
        int v[8], s = 0;
#pragma unroll
        for (int k = 0; k < 8; ++k) { s += nch[tid * 8 + k]; v[k] = s; }
        int incl = s;
#pragma unroll
        for (int o = 1; o < 64; o <<= 1) { const int t = __shfl_up(incl, o); if (tid >= o) incl += t; }
        const int base = incl - s;
#pragma unroll
        for (int k = 0; k < 8; ++k) nch[tid * 8 + k] = v[k] + base; }
    __syncthreads();
    const int total = nch[511];
    for (int cid = bid; cid < total; cid += G) {
        int lo = 0, hi_ = 511; while (lo < hi_) { const int mid = (lo + hi_) >> 1; if (nch[mid] > cid) hi_ = mid; else lo = mid + 1; }
        const int pair = lo, c = cid - (pair ? nch[pair - 1] : 0);
        moba_kv_chunk(P, SELB, CNTQ, LISTG, kmax, pair >> 5, pair & 31, c, tid, lds);
    }
    __syncthreads();
}

constexpr int NSA_S4_OFF = PIPE_BYTES, NSA_L4_OFF = NSA_S4_OFF + 8 * 8 * 128 * 4, NSA_SM_OFF = NSA_L4_OFF + 8 * 8 * 128 * 4;
struct NsaCtx { const bf16* Pb; const bf16* Kcb; const bf16* Vcb; int b, jq, tid, lane, wid, r32, hi, tq; unsigned mk0, mk1, mk2, mk3; };

template <int MODE>
__device__ __forceinline__ void nsa_tiles(const NsaCtx& c, LAS unsigned char* lds, const bf16x8 (&qf)[4], int nt, f32x16& o0, f32x16& o1, float& m, float& l, float pre) {
    const int tid = c.tid, lane = c.lane, r32 = c.r32, hi = c.hi, tq = c.tq, jq = c.jq;
    const int nw = (jq < 8 ? jq : 8) + 1;
    auto tile_of = [&](int i) -> int { return MODE < 2 ? i : (i == 0 ? jq : (MODE == 2 ? i - 1 : jq - nw + i)); };
    auto src_of = [&](int t) -> TileSrc {
        if (MODE < 2) return TileSrc{c.Kcb + (size_t)t * 64 * 64, c.Vcb + (size_t)t * 64 * 64, 64};
        if (MODE == 2) return TileSrc{c.Pb + (size_t)t * 64 * DINP + C_NKS, c.Pb + (size_t)t * 64 * DINP + C_NVS, DINP};
        return TileSrc{c.Pb + (size_t)t * 64 * DINP + C_NKW, c.Pb + (size_t)t * 64 * DINP + C_NVW, DINP};
    };
    u32x4v kr, vr;
    { const TileSrc s = src_of(tile_of(0)); tile_load(kr, vr, s, tid); }
    tile_store(lds, kr, vr, tid);
    __syncthreads();
    const int ncv = (tq >= 31) ? ((tq - 31) >> 4) + 1 : 0;
    for (int i = 0; i < nt; ++i) {
        const int tile = tile_of(i);
        if (i + 1 < nt) { const TileSrc s = src_of(tile_of(i + 1)); tile_load(kr, vr, s, tid); }
        LAS const unsigned char* buf = lds + (i & 1) * STG;
        const int kbase = tile * 64;
        bool rowsel = true;
        if (MODE == 2 && tile != jq) { const unsigned w = (tile >> 5) == 0 ? c.mk0 : (tile >> 5) == 1 ? c.mk1 : (tile >> 5) == 2 ? c.mk2 : c.mk3; rowsel = (w >> (tile & 31)) & 1u; }
        if (MODE != 2 || __any(rowsel)) {
            f32x16 p0, p1;
            qk_tile(p0, p1, buf, qf, r32, hi, MODE < 2 ? 0.f : (rowsel ? -m : NEGBIG));
            if (MODE < 2) {
#pragma unroll
                for (int r = 0; r < 16; ++r) { const int k0 = kbase + crow(r, hi); p0[r] = (k0 < ncv) ? p0[r] : NEGBIG; p1[r] = (k0 + 32 < ncv) ? p1[r] : NEGBIG; }
            } else if (MODE == 2) {
                if (tile == jq) {
#pragma unroll
                    for (int r = 0; r < 16; ++r) { const int k0 = kbase + crow(r, hi); p0[r] = (k0 <= tq) ? p0[r] : NEGBIG; p1[r] = (k0 + 32 <= tq) ? p1[r] : NEGBIG; }
                }
            } else if (tile == jq || tile + 8 == jq) {
#pragma unroll
                for (int r = 0; r < 16; ++r) { const int k0 = kbase + crow(r, hi);
                    p0[r] = (k0 <= tq && k0 + 511 >= tq) ? p0[r] : NEGBIG; p1[r] = (k0 + 32 <= tq && k0 + 32 + 511 >= tq) ? p1[r] : NEGBIG; }
            }
            if (MODE == 0) {
                float tm = fmaxf(p0[0], p1[0]);
#pragma unroll
                for (int r = 1; r < 16; ++r) tm = fmaxf(tm, fmaxf(p0[r], p1[r]));
                tm = fmaxf(tm, shx<32>(tm));
                const float mn = fmaxf(m, tm); float s = 0.f;
#pragma unroll
                for (int r = 0; r < 16; ++r) { s += (p0[r] > -1e29f ? __builtin_amdgcn_exp2f(p0[r] - mn) : 0.f) + (p1[r] > -1e29f ? __builtin_amdgcn_exp2f(p1[r] - mn) : 0.f); }
                l = l * __builtin_amdgcn_exp2f(m - mn) + s; m = mn;
            } else if (MODE == 1) {
#pragma unroll
                for (int r = 0; r < 16; ++r) { p0[r] = (p0[r] > -1e29f) ? __builtin_amdgcn_exp2f(p0[r] - m) * pre : 0.f; p1[r] = (p1[r] > -1e29f) ? __builtin_amdgcn_exp2f(p1[r] - m) * pre : 0.f; }
                pv_tile(o0, o1, buf + KBUF, p0, p1, lane);
                LAS float* S4 = (LAS float*)(lds + NSA_S4_OFF) + (c.wid * 8 + (r32 & 7)) * 128; LAS float* L4 = (LAS float*)(lds + NSA_L4_OFF) + (c.wid * 8 + (r32 & 7)) * 128;
#pragma unroll
                for (int mbk = 0; mbk < 2; ++mbk)
#pragma unroll
                    for (int g = 0; g < 4; ++g) {
                        float s4 = mbk ? (p1[4 * g] + p1[4 * g + 1]) + (p1[4 * g + 2] + p1[4 * g + 3]) : (p0[4 * g] + p0[4 * g + 1]) + (p0[4 * g + 2] + p0[4 * g + 3]);
                        float la = mbk ? p1[4 * g + 3] : p0[4 * g + 3];
                        s4 += shx<8>(s4); s4 += shx<16>(s4); la += shx<8>(la); la += shx<16>(la);
                        const int gi = tile * 16 + 8 * mbk + 2 * g + hi;
                        if (r32 < 8) { S4[gi] = s4; L4[gi] = la; }
                    }
            } else {
                softmax_tile(p0, p1, o0, o1, m, l, i == 0);
                pv_tile(o0, o1, buf + KBUF, p0, p1, lane);
            }
        }
        if (i + 1 < nt) tile_store(lds + ((i + 1) & 1) * STG, kr, vr, tid);
        __syncthreads();
    }
}

struct NsaSelPol {
    int nt, nmask, stride, jq, tq, hi; unsigned long long mlo, mhi; const bf16* Pk; const bf16* Pv;
    __device__ __forceinline__ int tile_of(int i) const { return i == 0 ? jq : i - 1; }
    __device__ __forceinline__ const bf16* kptr(int i) const { return Pk + (size_t)tile_of(i) * 64 * DINP; }
    __device__ __forceinline__ const bf16* vptr(int i) const { return Pv + (size_t)tile_of(i) * 64 * DINP; }
    __device__ __forceinline__ bool rowsel(int i) const { if (i == 0) return true; const int tile = i - 1; const unsigned long long w = tile < 64 ? mlo : mhi; return (w >> (tile & 63)) & 1ull; }
    __device__ __forceinline__ void mask(int i, f32x16& p0, f32x16& p1) const {
        if (i == 0) { const int kbase = jq * 64;
#pragma unroll
            for (int r = 0; r < 16; ++r) { const int k0 = kbase + crow(r, hi); p0[r] = (k0 <= tq) ? p0[r] : NEGBIG; p1[r] = (k0 + 32 <= tq) ? p1[r] : NEGBIG; } }
    }
};
struct NsaWinPol {
    int nt, nmask, stride, jq, tq, hi; const bf16* Pk; const bf16* Pv;
    __device__ __forceinline__ int tile_of(int i) const { return i == 0 ? jq : jq - nt + i; }
    __device__ __forceinline__ const bf16* kptr(int i) const { return Pk + (size_t)tile_of(i) * 64 * DINP; }
    __device__ __forceinline__ const bf16* vptr(int i) const { return Pv + (size_t)tile_of(i) * 64 * DINP; }
    __device__ __forceinline__ bool rowsel(int) const { return true; }
    __device__ __forceinline__ void mask(int i, f32x16& p0, f32x16& p1) const {
        const int tile = tile_of(i);
        if (tile == jq || tile + 8 == jq) { const int kbase = tile * 64;
#pragma unroll
            for (int r = 0; r < 16; ++r) { const int k0 = kbase + crow(r, hi);
                p0[r] = (k0 <= tq && k0 + 511 >= tq) ? p0[r] : NEGBIG; p1[r] = (k0 + 32 <= tq && k0 + 32 + 511 >= tq) ? p1[r] : NEGBIG; } }
    }
};
__device__ __forceinline__ void nsa_unit(const bf16* __restrict__ P, const float* __restrict__ G, const float* __restrict__ tab, const bf16* __restrict__ KVcb, const float* __restrict__ kgain  , bf16* __restrict__ MIX,
                                         int b, int jq, int tid, LAS unsigned char* lds) {
    asm volatile("" : "+v"(tid));
    NsaCtx c; c.b = b; c.jq = jq; c.tid = tid; c.lane = tid & 63; c.wid = __builtin_amdgcn_readfirstlane(tid >> 6); c.r32 = c.lane & 31; c.hi = c.lane >> 5;
    const int qi = c.r32 & 7, hh = c.r32 >> 3, hi = c.hi, lane = c.lane;
    c.tq = jq * 64 + c.wid * 8 + qi;
    c.Pb = P + (size_t)b * SEQ * DINP; c.Kcb = KVcb + (size_t)b * 512 * 64; c.Vcb = KVcb + ((size_t)NB + b) * 512 * 64;
    c.mk0 = c.mk1 = c.mk2 = c.mk3 = 0u;
    const size_t rowq = (size_t)b * SEQ + c.tq;
    bf16x8 qf[4];
#pragma unroll
    for (int ks = 0; ks < 4; ++ks) qf[ks] = scale_frag(*(const bf16x8*)(P + rowq * DINP + C_NQ + hh * 64 + ks * 16 + hi * 8), SCL2);
    const float g0 = sigmoidf_(G[rowq * 32 + 8 + hh]);
    { LAS float* gl = (LAS float*)(lds + NSA_SM_OFF + 1024); gl[tid] = sigmoidf_(G[rowq * 32 + 12 + hh]); gl[512 + tid] = sigmoidf_(G[rowq * 32 + 16 + hh]); }
    f32x16 a0, a1;
    {
        const int ncvmax = min(4 * jq + 3, NCMP), nct = (ncvmax + 63) >> 6;
        f32x16 o0, o1;
#pragma unroll
        for (int r = 0; r < 16; ++r) { o0[r] = zf_(); o1[r] = o0[r]; }
        float m = NEGBIG, l = 0.f;
#ifdef PROBE_CMP
        { f32x16 t0 = o0, t1 = o1; float tm = m, tl = l; nsa_tiles<0>(c, lds, qf, nct, t0, t1, tm, tl, 0.f); tl += shx<32>(tl); nsa_tiles<1>(c, lds, qf, nct, t0, t1, tm, tl, tl > 0.f ? rcpf_(tl) : 0.f); asm volatile("" :: "v"(t0), "v"(t1)); }
#endif
        nsa_tiles<0>(c, lds, qf, nct, o0, o1, m, l, 0.f);
        l += shx<32>(l);
        const float pre = (l > 0.f) ? rcpf_(l) : 0.f;
        nsa_tiles<1>(c, lds, qf, nct, o0, o1, m, l, pre);
#pragma unroll
        for (int r = 0; r < 16; ++r) { a0[r] = g0 * o0[r]; a1[r] = g0 * o1[r]; }
    }
    {
        LAS unsigned* sm = (LAS unsigned*)(lds + NSA_SM_OFF);
        for (int q = 0; q < 8; ++q) {
            LAS const float* S4 = (LAS const float*)(lds + NSA_S4_OFF) + (c.wid * 8 + q) * 128; LAS const float* L4 = (LAS const float*)(lds + NSA_L4_OFF) + (c.wid * 8 + q) * 128;
            float v0, v1;
            { const int n = lane; const bool causal = n <= jq, forced = causal && (n == 0 || n >= jq - 1);
              float im = 0.f; if (causal) { im = S4[n]; if (n > 0) im += L4[n - 1]; }
              v0 = forced ? 1e9f : (causal ? im : -1e30f); }
            { const int n = lane + 64; const bool causal = n <= jq, forced = causal && (n >= jq - 1);
              float im = 0.f; if (causal) { im = S4[n] + L4[n - 1]; }
              v1 = forced ? 1e9f : (causal ? im : -1e30f); }
            const unsigned b0_ = __float_as_uint(v0), b1_ = __float_as_uint(v1);
            const unsigned u0 = b0_ ^ ((b0_ >> 31) ? 0xFFFFFFFFu : 0x80000000u), u1 = b1_ ^ ((b1_ >> 31) ? 0xFFFFFFFFu : 0x80000000u);
            unsigned T = 0u;
#pragma unroll
            for (int bit = 31; bit >= 0; --bit) { const unsigned cand = T | (1u << bit);
                const int cn = __popcll(__ballot(u0 >= cand)) + __popcll(__ballot(u1 >= cand));
                if (cn >= 16) T = cand; }
            const unsigned long long g0b = __ballot(u0 > T), g1b = __ballot(u1 > T), e0b = __ballot(u0 == T), e1b = __ballot(u1 == T);
            const int rem = 16 - (__popcll(g0b) + __popcll(g1b));
            const unsigned long long ltm = (1ull << lane) - 1ull;
            const unsigned long long sel0 = g0b | __ballot(u0 == T && __popcll(e0b & ltm) < rem);
            const unsigned long long sel1 = g1b | __ballot(u1 == T && __popcll(e0b) + __popcll(e1b & ltm) < rem);
            if (lane == 0) { sm[(c.wid * 8 + q) * 4 + 0] = (unsigned)sel0; sm[(c.wid * 8 + q) * 4 + 1] = (unsigned)(sel0 >> 32); sm[(c.wid * 8 + q) * 4 + 2] = (unsigned)sel1; sm[(c.wid * 8 + q) * 4 + 3] = (unsigned)(sel1 >> 32); }
        }
        __builtin_amdgcn_s_waitcnt(0xc07f); __builtin_amdgcn_wave_barrier();
        c.mk0 = sm[(c.wid * 8 + qi) * 4 + 0]; c.mk1 = sm[(c.wid * 8 + qi) * 4 + 1]; c.mk2 = sm[(c.wid * 8 + qi) * 4 + 2]; c.mk3 = sm[(c.wid * 8 + qi) * 4 + 3];
    }
    LAS float* stash = (LAS float*)(lds + NSA_S4_OFF) + c.wid * 1024 + lane;
    LAS float* stash2 = (LAS float*)(lds + NSA_L4_OFF) + c.wid * 1024 + lane;
#pragma unroll
    for (int r = 0; r < 16; ++r) { stash[r * 64] = a0[r]; stash2[r * 64] = a1[r]; }
    {
        const u32x4v qw = __builtin_bit_cast(u32x4v, qf[0]); u32x4v w;
#pragma unroll
        for (int e = 0; e < 4; ++e) {
            float y[2];
#pragma unroll
            for (int k = 0; k < 2; ++k) { const int j = 2 * e + k; const float x = k ? __builtin_bit_cast(float, qw[e] & 0xffff0000u) : __builtin_bit_cast(float, qw[e] << 16); const float other = shx<32>(x);
                const float cs = tab[c.tq * 16 + j], sn = tab[c.tq * 16 + 8 + j]; y[k] = hi ? (x * cs + other * sn) : (x * cs - other * sn); }
            w[e] = cvtpk(y[0], y[1]);
        }
        qf[0] = __builtin_bit_cast(bf16x8, w);
    }
    {
        f32x16 o0, o1;
#pragma unroll
        for (int r = 0; r < 16; ++r) { o0[r] = zf_(); o1[r] = o0[r]; }
        float l = 0.f;
        NsaSelPol pol; pol.nt = jq + 1; pol.nmask = 1; pol.stride = DINP; pol.jq = jq; pol.tq = c.tq; pol.hi = hi; pol.mlo = (unsigned long long)c.mk0 | ((unsigned long long)c.mk1 << 32); pol.mhi = (unsigned long long)c.mk2 | ((unsigned long long)c.mk3 << 32); pol.Pk = c.Pb + C_NKS; pol.Pv = c.Pb + C_NVS;
#ifdef PROBE_SEL
        { attn_pipe(pol, lds, qf, row_negm(qf, gain_kmax(kgain + 64, lane)), o0, o1, l, tid); asm volatile("" : "+v"(o0), "+v"(o1), "+v"(l));
#pragma unroll
          for (int r = 0; r < 16; ++r) { o0[r] = zf_(); o1[r] = o0[r]; } l = zf_(); }
#endif
        attn_pipe(pol, lds, qf, row_negm(qf, gain_kmax(kgain + 64, lane)), o0, o1, l, tid);
        l += shx<32>(l);
        int t2 = tid; asm volatile("" : "+v"(t2));
        const float sc = ((LAS const float*)(lds + NSA_SM_OFF + 1024))[t2] * rcpf_(l);
        LAS float* st1 = (LAS float*)(lds + NSA_S4_OFF) + (t2 >> 6) * 1024 + (t2 & 63); LAS float* st2 = (LAS float*)(lds + NSA_L4_OFF) + (t2 >> 6) * 1024 + (t2 & 63);
#pragma unroll
        for (int r = 0; r < 16; ++r) { st1[r * 64] = fmaf(sc, o0[r], st1[r * 64]); st2[r * 64] = fmaf(sc, o1[r], st2[r * 64]); }
    }
    {
        f32x16 o0, o1;
#pragma unroll
        for (int r = 0; r < 16; ++r) { o0[r] = zf_(); o1[r] = o0[r]; }
        float l = 0.f;
        NsaWinPol pol; pol.nt = (jq < 8 ? jq : 8) + 1; pol.nmask = 2; pol.stride = DINP; pol.jq = jq; pol.tq = c.tq; pol.hi = hi; pol.Pk = c.Pb + C_NKW; pol.Pv = c.Pb + C_NVW;
#ifdef PROBE_WIN
        { attn_pipe(pol, lds, qf, row_negm(qf, gain_kmax(kgain + 128, lane)), o0, o1, l, tid); asm volatile("" : "+v"(o0), "+v"(o1), "+v"(l));
#pragma unroll
          for (int r = 0; r < 16; ++r) { o0[r] = zf_(); o1[r] = o0[r]; } l = zf_(); }
#endif
        attn_pipe(pol, lds, qf, row_negm(qf, gain_kmax(kgain + 128, lane)), o0, o1, l, tid);
        l += shx<32>(l);
        int t2 = tid; asm volatile("" : "+v"(t2));
        const float sc = ((LAS const float*)(lds + NSA_SM_OFF + 1024))[512 + t2] * rcpf_(l);
        LAS const float* st1 = (LAS const float*)(lds + NSA_S4_OFF) + (t2 >> 6) * 1024 + (t2 & 63); LAS const float* st2 = (LAS const float*)(lds + NSA_L4_OFF) + (t2 >> 6) * 1024 + (t2 & 63);
#pragma unroll
        for (int r = 0; r < 16; ++r) { a0[r] = fmaf(sc, o0[r], st1[r * 64]); a1[r] = fmaf(sc, o1[r], st2[r * 64]); }
    }
    int t3 = tid; asm volatile("" : "+v"(t3));
    const int ln3 = t3 & 63, r3 = ln3 & 31;
    bf16* op = MIX + ((size_t)b * SEQ + jq * 64 + (t3 >> 6) * 8 + (r3 & 7)) * DM + 768 + (r3 >> 3) * 64 + 4 * (ln3 >> 5);
#pragma unroll
    for (int g = 0; g < 4; ++g) {
        uint2 w0, w1;
        w0.x = cvtpk(a0[4 * g], a0[4 * g + 1]); w0.y = cvtpk(a0[4 * g + 2], a0[4 * g + 3]);
        w1.x = cvtpk(a1[4 * g], a1[4 * g + 1]); w1.y = cvtpk(a1[4 * g + 2], a1[4 * g + 3]);
        *(uint2*)(op + 8 * g) = w0; *(uint2*)(op + 32 + 8 * g) = w1;
    }
}


constexpr int MQ_PITCH = 272, MV_PITCH = 320;
constexpr int ML_G_OFF = 0;
constexpr int ML_Q_OFF = 4096;
constexpr int ML_K_OFF = ML_Q_OFF + 64 * MQ_PITCH;
constexpr int ML_V_OFF = ML_K_OFF + 64 * MV_PITCH;
constexpr int ML_END = ML_V_OFF + 64 * MV_PITCH;
static_assert(ML_END <= 131072, "mlstm LDS");
constexpr float KSCALE = 0.08838834764831845f;

__device__ __forceinline__ void qk2_rows(const bf16* __restrict__ P, const float* __restrict__ cw, bf16* __restrict__ QK2, int bid, int G, int tid) {
    asm volatile("" : "+v"(tid));
    const int ch = tid & 127, c0 = ch * 8;
    float tp[4][8];
#pragma unroll
    for (int j = 0; j < 4; ++j) { const float4 a = *(const float4*)(cw + j * 1024 + c0), b4 = *(const float4*)(cw + j * 1024 + c0 + 4);
        tp[j][0] = a.x; tp[j][1] = a.y; tp[j][2] = a.z; tp[j][3] = a.w; tp[j][4] = b4.x; tp[j][5] = b4.y; tp[j][6] = b4.z; tp[j][7] = b4.w; }
    const float sc = (c0 >= 512) ? KSCALE : 1.f;
    for (int row0 = bid * 4 + (tid >> 7); row0 < T; row0 += G * 16) {
        u32x4v w[4][4];
#pragma unroll
        for (int q = 0; q < 4; ++q) { const int row = row0 + q * G * 4, t = row & (SEQ - 1);
#pragma unroll
            for (int j = 0; j < 4; ++j) { w[q][j] = u32x4v{0u, 0u, 0u, 0u}; if (row < T && t - 3 + j >= 0) w[q][j] = *(const u32x4v*)(P + (size_t)(row - 3 + j) * DINP + c0); } }
#pragma unroll
        for (int q = 0; q < 4; ++q) { const int row = row0 + q * G * 4;
            float y[8];
#pragma unroll
            for (int e = 0; e < 8; ++e) y[e] = 0.f;
#pragma unroll
            for (int j = 0; j < 4; ++j)
#pragma unroll
                for (int e = 0; e < 4; ++e) { y[2 * e] = fmaf(tp[j][2 * e], __builtin_bit_cast(float, w[q][j][e] << 16), y[2 * e]); y[2 * e + 1] = fmaf(tp[j][2 * e + 1], __builtin_bit_cast(float, w[q][j][e] & 0xffff0000u), y[2 * e + 1]); }
#pragma unroll
            for (int e = 0; e < 8; ++e) y[e] = y[e] * rcpf_(1.f + __expf(-y[e])) * sc;
            u32x4v o; o[0] = cvtpk(y[0], y[1]); o[1] = cvtpk(y[2], y[3]); o[2] = cvtpk(y[4], y[5]); o[3] = cvtpk(y[6], y[7]);
            if (row < T) *(u32x4v*)(QK2 + (size_t)row * 1024 + c0) = o; }
    }
}

struct MlRaw { u32x4v q[2], k[2], v[2]; float gf, gi; };
template <bool WITH_Q> __device__ __forceinline__ void ml_load(MlRaw& r, const bf16* __restrict__ P, const bf16* __restrict__ QK2, const float* __restrict__ G, const float* __restrict__ bif, int u, int tid) {
    const int c = u & 127, h = (u >> 7) & 3, b = u >> 9, row0 = b * SEQ + c * 64, s = tid >> 3;
#pragma unroll
    for (int pass = 0; pass < 2; ++pass) { const int ch = (tid & 7) + 8 * pass;
        if (WITH_Q) r.q[pass] = *(const u32x4v*)(QK2 + (size_t)(row0 + s) * 1024 + h * 128 + ch * 8);
        r.k[pass] = *(const u32x4v*)(QK2 + (size_t)(row0 + s) * 1024 + 512 + h * 128 + ch * 8);
        r.v[pass] = *(const u32x4v*)(P + (size_t)(row0 + s) * DINP + C_MV + h * 128 + ch * 8); }
    if (tid < 64) { r.gf = G[(size_t)(row0 + tid) * 32 + 4 + h] + bif[4 + h]; r.gi = G[(size_t)(row0 + tid) * 32 + h] + bif[h]; }
}
__device__ __forceinline__ void mlstm_gates(const MlRaw& r, int tid, LAS float* gs) {
    if (tid < 64) { gs[tid] = log_sigmoidf_(r.gf); gs[128 + tid] = r.gi; }
    __syncthreads();
    if (tid < 64) { float a = 0.f; for (int s = 0; s <= tid; ++s) a += gs[s]; gs[64 + tid] = a; }
    __syncthreads();
}

__device__ __forceinline__ void mlstm_m1_phase(const bf16* __restrict__ P, const bf16* __restrict__ QK2, const float* __restrict__ G, const float* __restrict__ bif,
                                               bf16* __restrict__ CT, float* __restrict__ nst, float* __restrict__ dec, int bid, int Gd, int tid, LAS unsigned char* lds) {
    asm volatile("" : "+v"(tid));
    const int lane = tid & 63, wid = __builtin_amdgcn_readfirstlane(tid >> 6), hi = lane >> 5;
    LAS float* gs = (LAS float*)(lds + ML_G_OFF);
    MlRaw raw;
    if (bid < 2048) ml_load<false>(raw, P, QK2, G, bif, bid, tid);
    for (int u = bid; u < 2048; u += Gd) {
        mlstm_gates(raw, tid, gs);
        if (tid == 0) dec[u] = __expf(gs[64 + 63]);
        {
            const int s = tid >> 3; const float ws = __expf(gs[64 + 63] - gs[64 + s] + gs[128 + s]);
#pragma unroll
            for (int pass = 0; pass < 2; ++pass) { const int ch = (tid & 7) + 8 * pass; u32x4v w;
#pragma unroll
                for (int e = 0; e < 4; ++e) w[e] = cvtpk(__builtin_bit_cast(float, raw.k[pass][e] << 16) * ws, __builtin_bit_cast(float, raw.k[pass][e] & 0xffff0000u) * ws);
                *(LAS u32x4v*)(lds + ML_K_OFF + s * MV_PITCH + ch * 16) = w;
                *(LAS u32x4v*)(lds + ML_V_OFF + s * MV_PITCH + ch * 16) = raw.v[pass]; }
        }
        if (u + Gd < 2048) ml_load<false>(raw, P, QK2, G, bif, u + Gd, tid);
        __syncthreads();
        const int g = lane >> 4, i = lane & 15;
        const int mb = wid >> 1, nb0 = 2 * (wid & 1);
        f32x16 acc0, acc1;
#pragma unroll
        for (int r = 0; r < 16; ++r) { acc0[r] = zf_(); acc1[r] = acc0[r]; }
        LAS const unsigned char* trb = lds + (4 * hi + (i >> 2)) * MV_PITCH + (16 * (g & 1) + 4 * (i & 3)) * 2;
#pragma unroll
        for (int ks = 0; ks < 4; ++ks) {
            const s16x4 alo = lds_tr(trb + ML_K_OFF + ks * 16 * MV_PITCH + mb * 64), ahi = lds_tr(trb + ML_K_OFF + ks * 16 * MV_PITCH + 8 * MV_PITCH + mb * 64);
            const bf16x8 af = {alo[0], alo[1], alo[2], alo[3], ahi[0], ahi[1], ahi[2], ahi[3]};
            const s16x4 b0lo = lds_tr(trb + ML_V_OFF + ks * 16 * MV_PITCH + nb0 * 64), b0hi = lds_tr(trb + ML_V_OFF + ks * 16 * MV_PITCH + 8 * MV_PITCH + nb0 * 64);
            const s16x4 b1lo = lds_tr(trb + ML_V_OFF + ks * 16 * MV_PITCH + (nb0 + 1) * 64), b1hi = lds_tr(trb + ML_V_OFF + ks * 16 * MV_PITCH + 8 * MV_PITCH + (nb0 + 1) * 64);
            const bf16x8 bf0 = {b0lo[0], b0lo[1], b0lo[2], b0lo[3], b0hi[0], b0hi[1], b0hi[2], b0hi[3]}, bf1 = {b1lo[0], b1lo[1], b1lo[2], b1lo[3], b1hi[0], b1hi[1], b1hi[2], b1hi[3]};
            acc0 = __builtin_amdgcn_mfma_f32_32x32x16_bf16(af, bf0, acc0, 0, 0, 0);
            acc1 = __builtin_amdgcn_mfma_f32_32x32x16_bf16(af, bf1, acc1, 0, 0, 0);
        }
        bf16* ct = CT + (size_t)u * 16384;
#pragma unroll
        for (int gq = 0; gq < 4; ++gq) { const int d0 = 32 * mb + 8 * gq + 4 * hi;
            uint2 w0, w1; w0.x = cvtpk(acc0[4 * gq], acc0[4 * gq + 1]); w0.y = cvtpk(acc0[4 * gq + 2], acc0[4 * gq + 3]); w1.x = cvtpk(acc1[4 * gq], acc1[4 * gq + 1]); w1.y = cvtpk(acc1[4 * gq + 2], acc1[4 * gq + 3]);
            *(uint2*)(ct + (size_t)(32 * nb0 + (lane & 31)) * 128 + d0) = w0; *(uint2*)(ct + (size_t)(32 * (nb0 + 1) + (lane & 31)) * 128 + d0) = w1; }
        if (tid < 128) { float a = 0.f; for (int s = 0; s < 64; ++s) a += bf2f(*(LAS const bf16*)(lds + ML_K_OFF + s * MV_PITCH + tid * 2)); nst[(size_t)u * 128 + tid] = a; }
        __syncthreads();
    }
}
__device__ __forceinline__ void mlstm_scan(bf16* __restrict__ CT, float* __restrict__ nst, const float* __restrict__ dec, int item, int tid) {
    asm volatile("" : "+v"(tid));
    const int bh = item / 9, part = item % 9;
    if (part < 8) {
        bf16* base = CT + (size_t)bh * 128 * 16384 + (part * 512 + tid) * 4;
        float C[4]; C[0] = zf_(); C[1] = C[0]; C[2] = C[0]; C[3] = C[0];
        for (int c0 = 0; c0 < 128; c0 += 16) {
            uint2 w[16];
#pragma unroll
            for (int k = 0; k < 16; ++k) w[k] = *(const uint2*)(base + (size_t)(c0 + k) * 16384);
#pragma unroll
            for (int k = 0; k < 16; ++k) { const float a = dec[bh * 128 + c0 + k];
                uint2 o; o.x = cvtpk(C[0], C[1]); o.y = cvtpk(C[2], C[3]); *(uint2*)(base + (size_t)(c0 + k) * 16384) = o;
                C[0] = fmaf(a, C[0], __builtin_bit_cast(float, w[k].x << 16)); C[1] = fmaf(a, C[1], __builtin_bit_cast(float, w[k].x & 0xffff0000u));
                C[2] = fmaf(a, C[2], __builtin_bit_cast(float, w[k].y << 16)); C[3] = fmaf(a, C[3], __builtin_bit_cast(float, w[k].y & 0xffff0000u)); }
        }
    } else if (tid < 128) {
        float* base = nst + (size_t)bh * 128 * 128 + tid; float C = 0.f;
        for (int c = 0; c < 128; ++c) { const float dC = base[(size_t)c * 128]; base[(size_t)c * 128] = C; C = dec[bh * 128 + c] * C + dC; }
    }
}

__device__ __forceinline__ void mlstm_m3_phase(const bf16* __restrict__ P, const bf16* __restrict__ QK2, const float* __restrict__ G, const float* __restrict__ bif,
                                               const bf16* __restrict__ CT, const float* __restrict__ nst, const float* __restrict__ mnorm, bf16* __restrict__ MIX, int bid, int Gd, int tid, LAS unsigned char* lds) {
    asm volatile("" : "+v"(tid));
    const int lane = tid & 63, wid = __builtin_amdgcn_readfirstlane(tid >> 6), hi = lane >> 5, r32 = lane & 31;
    LAS float* gs = (LAS float*)(lds + ML_G_OFF);
    MlRaw raw;
    if (bid < 2048) ml_load<true>(raw, P, QK2, G, bif, bid, tid);
    for (int u = bid; u < 2048; u += Gd) {
    const int c = u & 127, h = (u >> 7) & 3, b = u >> 9, t0 = c * 64;
    const int tb = wid & 1, eb = wid >> 1, t = 32 * tb + r32;
    bf16x8 cf[8]; uint2 opre[4]; float npv = 0.f;
    { const bf16* ctp = CT + (size_t)u * 16384 + (size_t)(32 * eb + r32) * 128 + hi * 8;
#pragma unroll
      for (int ks = 0; ks < 8; ++ks) cf[ks] = *(const bf16x8*)(ctp + ks * 16);
      const size_t row_ = (size_t)b * SEQ + t0 + t;
#pragma unroll
      for (int gq = 0; gq < 4; ++gq) opre[gq] = *(const uint2*)(P + row_ * DINP + C_MO + h * 128 + 32 * eb + 8 * gq + 4 * hi);
      if (tid >= 128 && tid < 256) npv = nst[(size_t)u * 128 + tid - 128]; }
    if (tid >= 128 && tid < 256) gs[256 + tid - 128] = npv;
    mlstm_gates(raw, tid, gs);
    {
        const int s = tid >> 3;
#pragma unroll
        for (int pass = 0; pass < 2; ++pass) { const int ch = (tid & 7) + 8 * pass;
            *(LAS u32x4v*)(lds + ML_Q_OFF + s * MQ_PITCH + ch * 16) = raw.q[pass];
            *(LAS u32x4v*)(lds + ML_K_OFF + s * MQ_PITCH + ch * 16) = raw.k[pass];
            *(LAS u32x4v*)(lds + ML_V_OFF + s * MV_PITCH + ch * 16) = raw.v[pass]; }
    }
    if (u + Gd < 2048) ml_load<true>(raw, P, QK2, G, bif, u + Gd, tid);
    __syncthreads();
    bf16x8 qf[8];
#pragma unroll
    for (int ks = 0; ks < 8; ++ks) qf[ks] = *(LAS const bf16x8*)(lds + ML_Q_OFF + t * MQ_PITCH + ks * 32 + hi * 16);
    f32x16 ni;
#pragma unroll
    for (int r = 0; r < 16; ++r) ni[r] = zf_();
#pragma unroll
    for (int ks = 0; ks < 8; ++ks) ni = __builtin_amdgcn_mfma_f32_32x32x16_bf16(cf[ks], qf[ks], ni, 0, 0, 0);
    f32x16 p0, p1;
#pragma unroll
    for (int r = 0; r < 16; ++r) { p0[r] = zf_(); p1[r] = p0[r]; }
    { LAS const unsigned char* ka = lds + ML_K_OFF + r32 * MQ_PITCH + hi * 16;
#pragma unroll
      for (int ks = 0; ks < 8; ++ks) { const bf16x8 a0 = *(LAS const bf16x8*)(ka + ks * 32); p0 = __builtin_amdgcn_mfma_f32_32x32x16_bf16(a0, qf[ks], p0, 0, 0, 0); }
      if (tb == 1) {
#pragma unroll
          for (int ks = 0; ks < 8; ++ks) { const bf16x8 a1 = *(LAS const bf16x8*)(ka + 32 * MQ_PITCH + ks * 32); p1 = __builtin_amdgcn_mfma_f32_32x32x16_bf16(a1, qf[ks], p1, 0, 0, 0); } } }
    const float bt = gs[64 + t], Ft = __expf(bt);
    float dsum = 0.f;
#pragma unroll
    for (int r = 0; r < 16; ++r) { const int s0 = crow(r, hi);
        { const float w = (s0 <= t) ? __expf(bt - gs[64 + s0] + gs[128 + s0]) : 0.f; p0[r] *= w; dsum += p0[r]; }
        { const int s1 = s0 + 32; const float w = (s1 <= t) ? __expf(bt - gs[64 + s1] + gs[128 + s1]) : 0.f; p1[r] *= w; dsum += p1[r]; } }
    float qn = 0.f;
#pragma unroll
    for (int ks = 0; ks < 8; ++ks)
#pragma unroll
        for (int j = 0; j < 8; ++j) qn = fmaf(bf2f((bf16)qf[ks][j]), gs[256 + ks * 16 + hi * 8 + j], qn);
    dsum += shx<32>(dsum); qn += shx<32>(qn);
    const float den = dsum + Ft * qn, inv = rcpf_(fmaxf(fabsf(den), 1.f));
    f32x16 na;
#pragma unroll
    for (int r = 0; r < 16; ++r) na[r] = zf_();
    { const int g = lane >> 4, i = lane & 15;
      LAS const unsigned char* trb = lds + ML_V_OFF + (4 * hi + (i >> 2)) * MV_PITCH + (16 * (g & 1) + 4 * (i & 3)) * 2 + eb * 64;
#pragma unroll
      for (int ss = 0; ss < 4; ++ss) { if (ss >= 2 && tb == 0) break;
          unsigned w[4];
#pragma unroll
          for (int e = 0; e < 4; ++e) { const int r = 8 * (ss & 1) + 2 * e; w[e] = (ss < 2) ? cvtpk(p0[r], p0[r + 1]) : cvtpk(p1[r], p1[r + 1]); }
          const u32x4v wv = {w[0], w[1], w[2], w[3]}; const bf16x8 pf = __builtin_bit_cast(bf16x8, wv);
          const s16x4 lo = lds_tr(trb + ss * 16 * MV_PITCH), hi4 = lds_tr(trb + ss * 16 * MV_PITCH + 8 * MV_PITCH);
          const bf16x8 vt = {lo[0], lo[1], lo[2], lo[3], hi4[0], hi4[1], hi4[2], hi4[3]};
          na = __builtin_amdgcn_mfma_f32_32x32x16_bf16(vt, pf, na, 0, 0, 0); } }
    float ssq = 0.f;
#pragma unroll
    for (int r = 0; r < 16; ++r) { na[r] = (na[r] + Ft * ni[r]) * inv; ssq += na[r] * na[r]; }
    ssq += shx<32>(ssq);
    if (hi == 0) gs[384 + eb * 64 + t] = ssq;
    __syncthreads();
    const float rstd = rsqrtf((gs[384 + t] + gs[384 + 64 + t] + gs[384 + 128 + t] + gs[384 + 192 + t]) * (1.f / 128.f) + EPS);
    const size_t row = (size_t)b * SEQ + t0 + t;
#pragma unroll
    for (int gq = 0; gq < 4; ++gq) { const int cc = h * 128 + 32 * eb + 8 * gq + 4 * hi;
        const uint2 ow = opre[gq]; const float4 mn = *(const float4*)(mnorm + cc);
        const float o0 = sigmoidf_(__builtin_bit_cast(float, ow.x << 16)), o1 = sigmoidf_(__builtin_bit_cast(float, ow.x & 0xffff0000u)), o2 = sigmoidf_(__builtin_bit_cast(float, ow.y << 16)), o3 = sigmoidf_(__builtin_bit_cast(float, ow.y & 0xffff0000u));
        uint2 w; w.x = cvtpk(na[4 * gq] * rstd * mn.x * o0, na[4 * gq + 1] * rstd * mn.y * o1); w.y = cvtpk(na[4 * gq + 2] * rstd * mn.z * o2, na[4 * gq + 3] * rstd * mn.w * o3);
        *(uint2*)(MIX + row * DM + cc) = w; }
    __syncthreads();
    }
}


typedef float f32x4v __attribute__((ext_vector_type(4)));
__device__ __forceinline__ void compress_item(const bf16* __restrict__ P, const bf16* __restrict__ w1t  , const float* __restrict__ c1  , const float* __restrict__ w2  ,
                                              const float* __restrict__ kg0, bf16* __restrict__ KVcb, int item, int tid, LAS unsigned char* lds) {
    asm volatile("" : "+v"(tid));
    const int lane = tid & 63, wid = __builtin_amdgcn_readfirstlane(tid >> 6), hi = lane >> 5, r32 = lane & 31;
    const int kv = item >> 6, b = (item >> 4) & 3, i0 = (item & 15) * 32;
    const int cb = wid & 3, kh = wid >> 2;
    const int irow = min(i0 + r32, NCMP - 1);
    const bf16* xa = P + ((size_t)b * SEQ + 16 * irow + 16 * kh) * DINP + (kv ? C_NVC : C_NKC) + hi * 8;
    const bf16* wb = w1t + ((size_t)kv * 128 + 32 * cb + r32) * 2048 + kh * 1024 + hi * 8;
    f32x16 acc;
#pragma unroll
    for (int r = 0; r < 16; ++r) acc[r] = zf_();
    for (int p0 = 0; p0 < 16; p0 += 4) {
        bf16x8 af[16], bfr[16];
#pragma unroll
        for (int q = 0; q < 16; ++q) { const int p = p0 + (q >> 2), dq = q & 3;
            af[q] = *(const bf16x8*)(xa + (size_t)p * DINP + dq * 16); bfr[q] = *(const bf16x8*)(wb + p * 64 + dq * 16); }
#pragma unroll
        for (int q = 0; q < 16; ++q) acc = __builtin_amdgcn_mfma_f32_32x32x16_bf16(af[q], bfr[q], acc, 0, 0, 0);
    }
    LAS float* hid = (LAS float*)lds + kh * 32 * 132;
    { LAS f32x4v* w2s = (LAS f32x4v*)(lds + 2 * 32 * 132 * 4); const f32x4v* w2g = (const f32x4v*)(w2 + (size_t)kv * 128 * 64);
#pragma unroll
      for (int q = 0; q < 4; ++q) w2s[tid + 512 * q] = w2g[tid + 512 * q]; }
#pragma unroll
    for (int r = 0; r < 16; ++r) hid[crow(r, hi) * 132 + 32 * cb + r32] = acc[r];
    __syncthreads();
    {
        const int il = tid >> 4, d0 = (tid & 15) * 4;
        float o[4] = {0.f, 0.f, 0.f, 0.f};
        LAS const float* ha = (LAS const float*)lds + il * 132; LAS const float* hb = ha + 32 * 132;
        LAS const float* wp = (LAS const float*)(lds + 2 * 32 * 132 * 4) + d0;
        const float* cj = c1 + kv * 128;
#pragma unroll 8
        for (int j = 0; j < 128; ++j) { const float a = ha[j] + hb[j] + cj[j]; const float hv = a * rcpf_(1.f + __expf(-a)); const f32x4v wa = *(LAS const f32x4v*)(wp + j * 64);
            o[0] = fmaf(hv, wa[0], o[0]); o[1] = fmaf(hv, wa[1], o[1]); o[2] = fmaf(hv, wa[2], o[2]); o[3] = fmaf(hv, wa[3], o[3]); }
        if (kv == 0) { float ss = o[0] * o[0] + o[1] * o[1] + o[2] * o[2] + o[3] * o[3];
            ss += shx<1>(ss); ss += shx<2>(ss); ss += shx<4>(ss); ss += shx<8>(ss);
            const float rstd = rsqrtf(ss * (1.f / 64.f) + EPS);
#pragma unroll
            for (int e = 0; e < 4; ++e) o[e] *= rstd * kg0[d0 + e]; }
        const int i = i0 + il;
        if (i >= NCMP) { o[0] = zf_(); o[1] = o[0]; o[2] = o[0]; o[3] = o[0]; }
        uint2 w; w.x = cvtpk(o[0], o[1]); w.y = cvtpk(o[2], o[3]);
        *(uint2*)(KVcb + (((size_t)kv * NB + b) * 512 + i) * 64 + d0) = w;
    }
    __syncthreads();
}
__device__ __forceinline__ void cmp_c1_item(const float* __restrict__ pe, const float* __restrict__ w1, float* __restrict__ c1, int item, int tid, LAS unsigned char* lds) {
    const int lk = item >> 4, j0 = (item & 15) * 8, jj = tid & 7, kk = tid >> 3;
    const float* pp = pe + (size_t)lk * 2048; const float* ww = w1 + (size_t)lk * 2048 * 128 + j0 + jj;
    float a = 0.f;
#pragma unroll 8
    for (int k = kk; k < 2048; k += 64) a = fmaf(pp[k], ww[(size_t)k * 128], a);
    LAS float* red = (LAS float*)lds;
    red[tid] = a;
    __syncthreads();
    if (tid < 8) { float s = 0.f; for (int q = 0; q < 64; ++q) s += red[q * 8 + tid]; c1[lk * 128 + j0 + tid] = s; }
    __syncthreads();
}

#define XB_TMO      128
#define XB_XCNT(j)  (256  + 64 * (j))
#define XB_XSUB(j)  (1280 + 64 * (j))
#define XB_XGEN(j)  (2304 + 64 * (j))
#define XB_TOP      3328
#define XB_TOPGEN   3392
#define XCD_BAR_WORDS 3456
#define XB_SPIN_CAP (1u << 22)

__device__ __forceinline__ unsigned xb_ld(unsigned* p)              { return __hip_atomic_load(p, __ATOMIC_RELAXED, __HIP_MEMORY_SCOPE_AGENT); }
__device__ __forceinline__ unsigned xb_add(unsigned* p, unsigned v) { return __hip_atomic_fetch_add(p, v, __ATOMIC_RELAXED, __HIP_MEMORY_SCOPE_AGENT); }
__device__ __forceinline__ unsigned xb_xcc_id() { return (unsigned)__builtin_amdgcn_s_getreg((3 << 11) | 20) & 0xFu; }
#define XB_SPIN(cond, bar) do { unsigned _sp = 0; while (cond) { __builtin_amdgcn_s_sleep(1); \
    if ((++_sp & 255u) == 0u) { if (xb_ld(&(bar)[XB_TMO])) break; if (_sp > XB_SPIN_CAP) { atomicAdd(&(bar)[XB_TMO], 1u); break; } } } } while (0)

struct XcdBarrier {
    unsigned* bar; unsigned x;
    volatile LAS unsigned* st;
};

__device__ __forceinline__ XcdBarrier xcd_barrier_post(unsigned* bar, volatile LAS unsigned* st) {
    XcdBarrier b; b.bar = bar; b.x = xb_xcc_id(); b.st = st;
    if (threadIdx.x == 0) (void)xb_add(&bar[XB_XCNT(b.x)], 1u);
    return b;
}
__device__ __forceinline__ void xcd_barrier_complete(unsigned* bar, unsigned x, unsigned& nloc, unsigned& nx) {
    const unsigned G = gridDim.x * gridDim.y * gridDim.z;
    unsigned sum, cnt, mine, sp = 0u;
    for (;;) {
        sum = 0u; cnt = 0u; mine = 0u;
#pragma unroll
        for (unsigned j = 0; j < 16; ++j) { const unsigned c = xb_ld(&bar[XB_XCNT(j)]); sum += c; cnt += (c > 0u) ? 1u : 0u; mine = (j == x) ? c : mine; }
        if (sum == G) break;
        __builtin_amdgcn_s_sleep(1);
        if ((++sp & 255u) == 0u) { if (xb_ld(&bar[XB_TMO])) break; if (sp > XB_SPIN_CAP) { atomicAdd(&bar[XB_TMO], 1u); break; } }
    }
    nloc = mine > 0u ? mine : 1u; nx = cnt > 0u ? cnt : 1u;
}

__device__ __forceinline__ void xcd_barrier(const XcdBarrier& b) {
    asm volatile("s_waitcnt vmcnt(0)" ::: "memory");
    __syncthreads();
    if (threadIdx.x == 0) {
        unsigned* bar = b.bar;
        __builtin_amdgcn_s_waitcnt(0);
        unsigned nloc = b.st[0], nx = b.st[1];
        if (nloc == 0u) { xcd_barrier_complete(bar, b.x, nloc, nx); b.st[0] = nloc; b.st[1] = nx; }
        const unsigned old = xb_add(&bar[XB_XSUB(b.x)], 1u);
        const unsigned gen = old / nloc;
        if (old + 1u == (gen + 1u) * nloc) {
            __builtin_amdgcn_fence(__ATOMIC_RELEASE, "agent");
            asm volatile("s_waitcnt vmcnt(0)" ::: "memory");
            const unsigned og = xb_add(&bar[XB_TOP], 1u);
            const unsigned tg = og / nx;
            if (og + 1u == (tg + 1u) * nx) xb_add(&bar[XB_TOPGEN], 1u);
            else XB_SPIN(xb_ld(&bar[XB_TOPGEN]) == tg, bar);
            __builtin_amdgcn_fence(__ATOMIC_ACQUIRE, "agent");
            xb_add(&bar[XB_XGEN(b.x)], 1u);
            asm volatile("s_waitcnt vmcnt(0)" ::: "memory");
        } else {
            XB_SPIN(xb_ld(&bar[XB_XGEN(b.x)]) == gen, bar);
            __builtin_amdgcn_fence(__ATOMIC_ACQUIRE, "agent");
            asm volatile("s_waitcnt vmcnt(0)" ::: "memory");
        }
    }
    __syncthreads();
}


constexpr int M2_G_OFF = 0, M2_STG_OFF = 4096, M2_KIMG = 64 * MQ_PITCH, M2_VIMG = 64 * MV_PITCH, M2_STG = M2_KIMG + M2_VIMG;
static_assert(M2_STG_OFF + 2 * M2_STG <= 131072, "mlstm256 LDS");
__device__ __forceinline__ void ml256_gates(const float* __restrict__ G, const float* __restrict__ bif, int row0, int h, int tid, LAS float* gs) {
    if (tid < 256) { gs[tid] = log_sigmoidf_(G[(size_t)(row0 + tid) * 32 + 4 + h] + bif[4 + h]); gs[512 + tid] = G[(size_t)(row0 + tid) * 32 + h] + bif[h]; }
    __syncthreads();
    if (tid < 256) { float a = 0.f;
#pragma unroll 8
        for (int s = 0; s <= tid; ++s) a += gs[s];
        gs[256 + tid] = a; }
    __syncthreads();
}
struct Ml2Raw { u32x4v k[2], v[2]; };
__device__ __forceinline__ void ml2_load(Ml2Raw& r, const bf16* __restrict__ P, const bf16* __restrict__ QK2, int row0, int h, int tid) {
    const int s = tid >> 3;
#pragma unroll
    for (int pass = 0; pass < 2; ++pass) { const int ch = (tid & 7) + 8 * pass;
        r.k[pass] = *(const u32x4v*)(QK2 + (size_t)(row0 + s) * 1024 + 512 + h * 128 + ch * 8);
        r.v[pass] = *(const u32x4v*)(P + (size_t)(row0 + s) * DINP + C_MV + h * 128 + ch * 8); }
}
__device__ __forceinline__ void ml256_m1_phase(const bf16* __restrict__ P, const bf16* __restrict__ QK2, const float* __restrict__ G, const float* __restrict__ bif,
                                               bf16* __restrict__ CT, float* __restrict__ nst, float* __restrict__ dec, int bid, int Gd, int tid, LAS unsigned char* lds) {
    asm volatile("" : "+v"(tid));
    const int lane = tid & 63, wid = __builtin_amdgcn_readfirstlane(tid >> 6), hi = lane >> 5;
    LAS float* gs = (LAS float*)(lds + M2_G_OFF);
    for (int u = bid; u < 512; u += Gd) {
        const int sc = u & 31, h = (u >> 5) & 3, b = u >> 7, row0 = b * SEQ + sc * 256;
        Ml2Raw raw; ml2_load(raw, P, QK2, row0, h, tid);
        ml256_gates(G, bif, row0, h, tid, gs);
        if (tid == 0) dec[u] = __expf(gs[256 + 255]);
        const int g = lane >> 4, i = lane & 15;
        const int mb = wid >> 1, nb0 = 2 * (wid & 1);
        f32x16 acc0, acc1;
#pragma unroll
        for (int r = 0; r < 16; ++r) { acc0[r] = zf_(); acc1[r] = acc0[r]; }
        float an = 0.f;
        for (int st = 0; st < 4; ++st) {
            LAS unsigned char* stg = lds + M2_STG_OFF + (st & 1) * (2 * M2_VIMG);
            { const int s = tid >> 3; const float ws = __expf(gs[256 + 255] - gs[256 + st * 64 + s] + gs[512 + st * 64 + s]);
#pragma unroll
              for (int pass = 0; pass < 2; ++pass) { const int ch = (tid & 7) + 8 * pass; u32x4v w;
#pragma unroll
                  for (int e = 0; e < 4; ++e) w[e] = cvtpk(__builtin_bit_cast(float, raw.k[pass][e] << 16) * ws, __builtin_bit_cast(float, raw.k[pass][e] & 0xffff0000u) * ws);
                  *(LAS u32x4v*)(stg + s * MV_PITCH + ch * 16) = w;
                  *(LAS u32x4v*)(stg + M2_VIMG + s * MV_PITCH + ch * 16) = raw.v[pass]; } }
            if (st + 1 < 4) ml2_load(raw, P, QK2, row0 + (st + 1) * 64, h, tid);
            __syncthreads();
            LAS const unsigned char* trb = stg + (4 * hi + (i >> 2)) * MV_PITCH + (16 * (g & 1) + 4 * (i & 3)) * 2;
#pragma unroll
            for (int ks = 0; ks < 4; ++ks) {
                const s16x4 alo = lds_tr(trb + ks * 16 * MV_PITCH + mb * 64), ahi = lds_tr(trb + ks * 16 * MV_PITCH + 8 * MV_PITCH + mb * 64);
                const bf16x8 af = {alo[0], alo[1], alo[2], alo[3], ahi[0], ahi[1], ahi[2], ahi[3]};
                const s16x4 b0lo = lds_tr(trb + M2_VIMG + ks * 16 * MV_PITCH + nb0 * 64), b0hi = lds_tr(trb + M2_VIMG + ks * 16 * MV_PITCH + 8 * MV_PITCH + nb0 * 64);
                const s16x4 b1lo = lds_tr(trb + M2_VIMG + ks * 16 * MV_PITCH + (nb0 + 1) * 64), b1hi = lds_tr(trb + M2_VIMG + ks * 16 * MV_PITCH + 8 * MV_PITCH + (nb0 + 1) * 64);
                const bf16x8 bf0 = {b0lo[0], b0lo[1], b0lo[2], b0lo[3], b0hi[0], b0hi[1], b0hi[2], b0hi[3]}, bf1 = {b1lo[0], b1lo[1], b1lo[2], b1lo[3], b1hi[0], b1hi[1], b1hi[2], b1hi[3]};
                acc0 = __builtin_amdgcn_mfma_f32_32x32x16_bf16(af, bf0, acc0, 0, 0, 0);
                acc1 = __builtin_amdgcn_mfma_f32_32x32x16_bf16(af, bf1, acc1, 0, 0, 0);
            }
            if (tid < 128) { for (int s = 0; s < 64; ++s) an += bf2f(*(LAS const bf16*)(stg + s * MV_PITCH + tid * 2)); }
        }
        bf16* ct = CT + (size_t)u * 16384;
#pragma unroll
        for (int gq = 0; gq < 4; ++gq) { const int d0 = 32 * mb + 8 * gq + 4 * hi;
            uint2 w0, w1; w0.x = cvtpk(acc0[4 * gq], acc0[4 * gq + 1]); w0.y = cvtpk(acc0[4 * gq + 2], acc0[4 * gq + 3]); w1.x = cvtpk(acc1[4 * gq], acc1[4 * gq + 1]); w1.y = cvtpk(acc1[4 * gq + 2], acc1[4 * gq + 3]);
            *(uint2*)(ct + (size_t)(32 * nb0 + (lane & 31)) * 128 + d0) = w0; *(uint2*)(ct + (size_t)(32 * (nb0 + 1) + (lane & 31)) * 128 + d0) = w1; }
        if (tid < 128) nst[(size_t)u * 128 + tid] = an;
        __syncthreads();
    }
}
__device__ __forceinline__ void ml256_scan(bf16* __restrict__ CT, float* __restrict__ nst, const float* __restrict__ dec, int item, int tid) {
    asm volatile("" : "+v"(tid));
    const int bh = item / 9, part = item % 9;
    if (part < 8) {
        bf16* base = CT + (size_t)bh * 32 * 16384 + (part * 512 + tid) * 4;
        float C[4]; C[0] = zf_(); C[1] = C[0]; C[2] = C[0]; C[3] = C[0];
        for (int c0 = 0; c0 < 32; c0 += 16) {
            uint2 w[16];
#pragma unroll
            for (int k = 0; k < 16; ++k) w[k] = *(const uint2*)(base + (size_t)(c0 + k) * 16384);
#pragma unroll
            for (int k = 0; k < 16; ++k) { const float a = dec[bh * 32 + c0 + k];
                uint2 o; o.x = cvtpk(C[0], C[1]); o.y = cvtpk(C[2], C[3]); *(uint2*)(base + (size_t)(c0 + k) * 16384) = o;
                C[0] = fmaf(a, C[0], __builtin_bit_cast(float, w[k].x << 16)); C[1] = fmaf(a, C[1], __builtin_bit_cast(float, w[k].x & 0xffff0000u));
                C[2] = fmaf(a, C[2], __builtin_bit_cast(float, w[k].y << 16)); C[3] = fmaf(a, C[3], __builtin_bit_cast(float, w[k].y & 0xffff0000u)); }
        }
    } else if (tid < 128) {
        float* base = nst + (size_t)bh * 32 * 128 + tid; float C = 0.f;
        for (int c = 0; c < 32; ++c) { const float dC = base[(size_t)c * 128]; base[(size_t)c * 128] = C; C = dec[bh * 32 + c] * C + dC; }
    }
}
__device__ __forceinline__ void ml256_m3_phase(const bf16* __restrict__ P, const bf16* __restrict__ QK2, const float* __restrict__ G, const float* __restrict__ bif,
                                               const bf16* __restrict__ CT, const float* __restrict__ nst, const float* __restrict__ mnorm, bf16* __restrict__ MIX, int bid, int Gd, int tid, LAS unsigned char* lds) {
    asm volatile("" : "+v"(tid));
    const int lane = tid & 63, wid = __builtin_amdgcn_readfirstlane(tid >> 6), hi = lane >> 5, r32 = lane & 31;
    LAS float* gs = (LAS float*)(lds + M2_G_OFF);
    for (int u = bid; u < 512; u += Gd) {
        const int sc = u & 31, h = (u >> 5) & 3, b = u >> 7, row0 = b * SEQ + sc * 256;
        const int t = 32 * wid + r32; const size_t rowt = (size_t)row0 + t;
        auto stage_load = [&](int kt, u32x4v (&kk)[2], u32x4v (&vv)[2]) { const int s = tid >> 3;
#pragma unroll
            for (int pass = 0; pass < 2; ++pass) { const int ch = (tid & 7) + 8 * pass;
                kk[pass] = *(const u32x4v*)(QK2 + (size_t)(row0 + kt * 64 + s) * 1024 + 512 + h * 128 + ch * 8);
                vv[pass] = *(const u32x4v*)(P + (size_t)(row0 + kt * 64 + s) * DINP + C_MV + h * 128 + ch * 8); } };
        auto stage_store = [&](int kt, const u32x4v (&kk)[2], const u32x4v (&vv)[2]) { LAS unsigned char* stg = lds + M2_STG_OFF + (kt & 1) * M2_STG; const int s = tid >> 3;
#pragma unroll
            for (int pass = 0; pass < 2; ++pass) { const int ch = (tid & 7) + 8 * pass;
                *(LAS u32x4v*)(stg + s * MQ_PITCH + ch * 16) = kk[pass]; *(LAS u32x4v*)(stg + M2_KIMG + s * MV_PITCH + ch * 16) = vv[pass]; } };
        u32x4v kk[2], vv[2]; stage_load(0, kk, vv);
        bf16x8 qf[8];
#pragma unroll
        for (int ks = 0; ks < 8; ++ks) qf[ks] = *(const bf16x8*)(QK2 + rowt * 1024 + h * 128 + ks * 16 + hi * 8);
        if (tid >= 256 && tid < 384) gs[768 + tid - 256] = nst[(size_t)u * 128 + tid - 256];
        ml256_gates(G, bif, row0, h, tid, gs);
        stage_store(0, kk, vv);
        __syncthreads();
        f32x16 N0, N1, N2, N3;
#pragma unroll
        for (int r = 0; r < 16; ++r) { N0[r] = zf_(); N1[r] = N0[r]; N2[r] = N0[r]; N3[r] = N0[r]; }
        const float bt = gs[256 + t], Ft = __expf(bt);
        float dsum = 0.f;
        const int ktmax = wid >> 1;
        for (int kt = 0; kt < 4; ++kt) {
            if (kt + 1 < 4) stage_load(kt + 1, kk, vv);
            if (kt <= ktmax) {
                LAS const unsigned char* stg = lds + M2_STG_OFF + (kt & 1) * M2_STG;
                f32x16 p0, p1;
#pragma unroll
                for (int r = 0; r < 16; ++r) { p0[r] = zf_(); p1[r] = p0[r]; }
                LAS const unsigned char* ka = stg + r32 * MQ_PITCH + hi * 16;
#pragma unroll
                for (int ks = 0; ks < 8; ++ks) { const bf16x8 a0 = *(LAS const bf16x8*)(ka + ks * 32), a1 = *(LAS const bf16x8*)(ka + 32 * MQ_PITCH + ks * 32);
                    p0 = __builtin_amdgcn_mfma_f32_32x32x16_bf16(a0, qf[ks], p0, 0, 0, 0); p1 = __builtin_amdgcn_mfma_f32_32x32x16_bf16(a1, qf[ks], p1, 0, 0, 0); }
#pragma unroll
                for (int r = 0; r < 16; ++r) { const int s0 = kt * 64 + crow(r, hi), s1 = s0 + 32;
                    { const float w = (s0 <= t) ? __expf(bt - gs[256 + s0] + gs[512 + s0]) : 0.f; p0[r] *= w; dsum += p0[r]; }
                    { const float w = (s1 <= t) ? __expf(bt - gs[256 + s1] + gs[512 + s1]) : 0.f; p1[r] *= w; dsum += p1[r]; } }
                bf16x8 pf[4];
#pragma unroll
                for (int s = 0; s < 4; ++s) { u32x4v w;
#pragma unroll
                    for (int e = 0; e < 4; ++e) { const int r = 8 * (s & 1) + 2 * e; w[e] = (s < 2) ? cvtpk(p0[r], p0[r + 1]) : cvtpk(p1[r], p1[r + 1]); }
                    pf[s] = __builtin_bit_cast(bf16x8, w); }
                const int g = lane >> 4, i = lane & 15;
                LAS const unsigned char* trb = stg + M2_KIMG + (4 * hi + (i >> 2)) * MV_PITCH + (16 * (g & 1) + 4 * (i & 3)) * 2;
#pragma unroll
                for (int s = 0; s < 4; ++s) {
#pragma unroll
                    for (int eb = 0; eb < 4; ++eb) {
                        const s16x4 lo = lds_tr(trb + s * 16 * MV_PITCH + eb * 64), hi4 = lds_tr(trb + s * 16 * MV_PITCH + 8 * MV_PITCH + eb * 64);
                        const bf16x8 vt = {lo[0], lo[1], lo[2], lo[3], hi4[0], hi4[1], hi4[2], hi4[3]};
                        if (eb == 0) N0 = __builtin_amdgcn_mfma_f32_32x32x16_bf16(vt, pf[s], N0, 0, 0, 0);
                        else if (eb == 1) N1 = __builtin_amdgcn_mfma_f32_32x32x16_bf16(vt, pf[s], N1, 0, 0, 0);
                        else if (eb == 2) N2 = __builtin_amdgcn_mfma_f32_32x32x16_bf16(vt, pf[s], N2, 0, 0, 0);
                        else N3 = __builtin_amdgcn_mfma_f32_32x32x16_bf16(vt, pf[s], N3, 0, 0, 0);
                    } }
            }
            if (kt + 1 < 4) stage_store(kt + 1, kk, vv);
            __syncthreads();
        }
        float qn = 0.f;
#pragma unroll
        for (int ks = 0; ks < 8; ++ks)
#pragma unroll
            for (int j = 0; j < 8; ++j) qn = fmaf(bf2f((bf16)qf[ks][j]), gs[768 + ks * 16 + hi * 8 + j], qn);
        dsum += shx<32>(dsum); qn += shx<32>(qn);
        const float den = dsum + Ft * qn, inv = rcpf_(fmaxf(fabsf(den), 1.f));
        float ssq = 0.f;
#pragma unroll
        for (int eb = 0; eb < 4; ++eb) {
            const bf16* ctp = CT + (size_t)u * 16384 + (size_t)(32 * eb + r32) * 128 + hi * 8;
            bf16x8 cf[8];
#pragma unroll
            for (int ks = 0; ks < 8; ++ks) cf[ks] = *(const bf16x8*)(ctp + ks * 16);
            f32x16 ni;
#pragma unroll
            for (int r = 0; r < 16; ++r) ni[r] = zf_();
#pragma unroll
            for (int ks = 0; ks < 8; ++ks) ni = __builtin_amdgcn_mfma_f32_32x32x16_bf16(cf[ks], qf[ks], ni, 0, 0, 0);
            f32x16& Nx = eb == 0 ? N0 : eb == 1 ? N1 : eb == 2 ? N2 : N3;
#pragma unroll
            for (int r = 0; r < 16; ++r) { Nx[r] = (Nx[r] + Ft * ni[r]) * inv; ssq += Nx[r] * Nx[r]; }
        }
        ssq += shx<32>(ssq);
        const float rstd = rsqrtf(ssq * (1.f / 128.f) + EPS);
#pragma unroll
        for (int eb = 0; eb < 4; ++eb) { const f32x16& Nx = eb == 0 ? N0 : eb == 1 ? N1 : eb == 2 ? N2 : N3;
#pragma unroll
            for (int gq = 0; gq < 4; ++gq) { const int cc = h * 128 + 32 * eb + 8 * gq + 4 * hi;
                const uint2 ow = *(const uint2*)(P + rowt * DINP + C_MO + cc); const float4 mn = *(const float4*)(mnorm + cc);
                const float o0 = sigmoidf_(__builtin_bit_cast(float, ow.x << 16)), o1 = sigmoidf_(__builtin_bit_cast(float, ow.x & 0xffff0000u)), o2 = sigmoidf_(__builtin_bit_cast(float, ow.y << 16)), o3 = sigmoidf_(__builtin_bit_cast(float, ow.y & 0xffff0000u));
                uint2 w; w.x = cvtpk(Nx[4 * gq] * rstd * mn.x * o0, Nx[4 * gq + 1] * rstd * mn.y * o1); w.y = cvtpk(Nx[4 * gq + 2] * rstd * mn.z * o2, Nx[4 * gq + 3] * rstd * mn.w * o3);
                *(uint2*)(MIX + rowt * DM + cc) = w; } }
        __syncthreads();
    }
}

constexpr size_t MiB = 1u << 20;
constexpr size_t W_LAYER = (size_t)(DINP + DM + DFF) * DM + (size_t)DM * DFF;
constexpr size_t WS_W = 0;
constexpr size_t WS_HM = 52 * MiB;
constexpr size_t WS_G = 116 * MiB;
constexpr size_t WS_SMALL = 120 * MiB;
constexpr size_t WS_TAB = WS_SMALL, WS_KMEAN = WS_SMALL + 512 * 1024, WS_KVC = WS_SMALL + 1 * MiB, WS_NST = WS_SMALL + 2 * MiB, WS_DEC = WS_SMALL + 3 * MiB, WS_KVCB = WS_SMALL + 3 * MiB + 512 * 1024;
constexpr size_t WS_SSP = 476 * MiB;
constexpr size_t WS_BAR = WS_SMALL + 3 * MiB + 64 * 1024;
constexpr size_t WS_W1T = 50 * MiB, WS_C1 = WS_SMALL + 3 * MiB + 16 * 1024;
constexpr size_t WS_P = 124 * MiB;
constexpr size_t WS_C = 348 * MiB;
constexpr size_t WS_U = WS_P;
constexpr size_t WS_SELB = 478 * MiB, WS_CNTQ = WS_SELB + 512 * 1024, WS_LISTG = WS_CNTQ + 64 * 1024;
constexpr size_t WS_END = 484 * MiB;
static_assert(W_LAYER * 2 * DEPTH <= 50 * MiB && WS_W1T + (size_t)DEPTH * 2 * 128 * 2048 * 2 <= 52 * MiB, "weights");
static_assert((size_t)T * DINP * 2 == 224 * MiB && (size_t)T * DFF * 2 == 256 * MiB, "sizes");

#ifndef DUP_PRO
#define DUP_PRO 1
#endif
#ifndef DUP_QK2
#define DUP_QK2 1
#endif
#ifndef DUP_GEMM
#define DUP_GEMM 1
#endif
#ifndef DUP_M1
#define DUP_M1 1
#endif
#ifndef DUP_MOBA
#define DUP_MOBA 1
#endif
#ifndef DUP_NSA
#define DUP_NSA 1
#endif
#ifndef DUP_M3
#define DUP_M3 1
#endif
#ifndef DUP_CMP
#define DUP_CMP 1
#endif
struct Params { const float* in[16]; float* out; unsigned char* ws; };
static_assert(sizeof(Params) == 18 * 8, "kernarg layout: in[k] at 8k, out at 128, ws at 136");
constexpr int LDS_BYTES = 147456;

__global__ void __launch_bounds__(512, 2) hybrid_fwd(Params prm) {
    extern __shared__ __attribute__((aligned(16))) unsigned char lds[];
    cg::grid_group grid = cg::this_grid();
    constexpr int NPH = 1 + DEPTH * 8;
    volatile LAS unsigned* xst = (volatile LAS unsigned*)((LAS unsigned char*)lds + 131072 + 1024);
    if (threadIdx.x < 2) xst[threadIdx.x] = 0u;
    __syncthreads();
    (void)xcd_barrier_post((unsigned*)(prm.ws + WS_BAR), xst);
    for (int ph = 0; ph < NPH; ++ph) {
        int tid = threadIdx.x; asm volatile("" : "+v"(tid));
        int G = gridDim.x, bid = blockIdx.x; asm volatile("" : "+s"(G), "+s"(bid));
#define PH_LOCALS const int half = tid >> 8, t256 = tid & 255, lane = tid & 63, wid = __builtin_amdgcn_readfirstlane(tid >> 6); unsigned char* smh = lds + half * 65536; \
        const int vb = bid * 2 + half, NVB = G * 2, gwv = bid * 8 + wid, NGW = G * 8; (void)lane; (void)smh; (void)vb; (void)NVB; (void)gwv; (void)NGW; (void)t256;
        const __attribute__((address_space(4))) unsigned char* ka = (const __attribute__((address_space(4))) unsigned char*)__builtin_amdgcn_kernarg_segment_ptr(); asm volatile("" : "+s"(ka));
#define KARG(T_, off) (*(T_ const __attribute__((address_space(4)))*)(ka + (off)))
#define IN(k) KARG(const float*, 8 * (k))
        unsigned char* ws = KARG(unsigned char*, 8 * 17); float* out = KARG(float*, 8 * 16);
        bf16* Wb = (bf16*)(ws + WS_W); bf16* HM = (bf16*)(ws + WS_HM); float* Gt = (float*)(ws + WS_G); float* tab = (float*)(ws + WS_TAB); float* kmean = (float*)(ws + WS_KMEAN);
        float* KVc = (float*)(ws + WS_KVC); float* nst = (float*)(ws + WS_NST); float* dec = (float*)(ws + WS_DEC); bf16* KVcb = (bf16*)(ws + WS_KVCB); bf16* W1t = (bf16*)(ws + WS_W1T); float* C1 = (float*)(ws + WS_C1); bf16* P = (bf16*)(ws + WS_P); bf16* CT = (bf16*)(ws + WS_C); unsigned* SELB = (unsigned*)(ws + WS_SELB); int* CNTQ = (int*)(ws + WS_CNTQ); unsigned char* LISTG = ws + WS_LISTG; bf16* QK2 = (bf16*)out  ; bf16* XB = (bf16*)(ws + WS_C + 64 * MiB)  ; unsigned long long* SSA = (unsigned long long*)(ws + WS_SSP); unsigned long long* SSB = SSA + T;     bf16* U = (bf16*)(ws + WS_U);
        const int l = ph == 0 ? 0 : (ph - 1) / 8, j = ph == 0 ? -1 : (ph - 1) % 8;
        const float* x = IN(0);
        const bf16* WinT = Wb + l * W_LAYER; const bf16* WoT = WinT + (size_t)DINP * DM; const bf16* W1T = WoT + (size_t)DM * DM; const bf16* W2T = W1T + (size_t)DFF * DM;
        if (ph == 0) {
            PH_LOCALS
            const float* w_in = IN(1); const float* w_out = IN(11); const float* w_ff1 = IN(14); const float* w_ff2 = IN(15);
            for (int rep = 0; rep < DUP_PRO; ++rep) {
            for (int ll = 0; ll < DEPTH; ++ll) {
                bf16* WinT_ = Wb + ll * W_LAYER; bf16* WoT_ = WinT_ + (size_t)DINP * DM; bf16* W1T_ = WoT_ + (size_t)DM * DM; bf16* W2T_ = W1T_ + (size_t)DFF * DM;
                for (int mt = 0; mt < 4; ++mt) {
                    const float* W; int K, N, NP, mode; bf16* WT;
                    const float* gk = nullptr;
                    if (mt == 0) { W = w_in + (size_t)ll * DM * DIN; K = DM; N = DIN; NP = DINP; WT = WinT_; mode = 1; gk = IN(12) + ll * DM; }
                    else if (mt == 1) { W = w_out + (size_t)ll * DM * DM; K = DM; N = DM; NP = DM; WT = WoT_; mode = 0; }
                    else if (mt == 2) { W = w_ff1 + (size_t)ll * DM * DFF; K = DM; N = DFF; NP = DFF; WT = W1T_; mode = 0; gk = IN(13) + ll * DM; }
                    else { W = w_ff2 + (size_t)ll * DFF * DM; K = DFF; N = DM; NP = DM; WT = W2T_; mode = 0; }
                    ph_convert_mat(W, K, N, NP, WT, mode, vb, NVB, t256, (float*)smh, gk);
                }
            }
            for (int lk = 0; lk < DEPTH * 2; ++lk) {
                ph_convert_mat(IN(9) + (size_t)lk * 2048 * 128, 2048, 128, 128, W1t + (size_t)lk * 128 * 2048, 0, vb, NVB, t256, (float*)smh);
            }
            for (int it = bid; it < 64; it += G) cmp_c1_item(IN(8), IN(9), C1, it, tid, (LAS unsigned char*)lds);
            for (int i = bid * 512 + tid; i < SEQ * 8; i += G * 512) { const int pos = i >> 3, f = i & 7;
                float c_, s_; rope_cs(pos, f, c_, s_);
                tab[pos * 16 + f] = c_; tab[pos * 16 + 8 + f] = s_; }
            for (int row = gwv; row < T; row += 2 * NGW) { ph_x_row(x, XB, SSA, row, lane); if (row + NGW < T) ph_x_row(x, XB, SSA, row + NGW, lane); }
            }
        } else if (j == 0 || j >= 5) {
            pg8::Gemm g; pg8::EpiAny E; int N; const bool last = (l + 1 == DEPTH);
            if (j == 0) { g = pg8::Gemm{XB, WinT, T, DINP, DM}; N = DINP; E = pg8::EpiAny{0, true, P, DINP, Gt, C_GATE, nullptr, nullptr, nullptr, SSA}; }
            else if (j == 5) { g = pg8::Gemm{HM, WoT, T, DM, DM}; N = DM; E = pg8::EpiAny{2, true, nullptr, DM, nullptr, 0, nullptr, nullptr, XB, SSB}; }
            else if (j == 6) { g = pg8::Gemm{XB, W1T, T, DFF, DM}; N = DFF; E = pg8::EpiAny{1, true, U, DFF, nullptr, 0, nullptr, nullptr, nullptr, SSB}; }
            else { g = pg8::Gemm{U, W2T, T, DM, DFF}; N = DM; E = pg8::EpiAny{2, true, nullptr, DM, nullptr, 0, nullptr, last ? out : nullptr, XB, SSA}; }
            pg8::StaticOrder S; S.init(T, N, G, bid);
            for (int rep = 0; rep < ((j == 0 || j == 6) ? DUP_GEMM : 1); ++rep) pg8::gemm_phase<pg8::EpiAny, pg8::StaticOrder, true, true>((PG8_LAS unsigned char*)lds, g, S, E, tid);
        } else if (j == 1) {
            PH_LOCALS
            for (int rep = 0; rep < DUP_CMP; ++rep) for (int it = bid; it < 128; it += G) compress_item(P, W1t + (size_t)l * 2 * 128 * 2048, C1 + l * 256, IN(10) + (size_t)l * 2 * 128 * 64, IN(7) + l * 192, KVcb, it, tid, (LAS unsigned char*)lds);
            for (int it0 = 0; it0 < 128 * 14; it0 += NVB) { const int it = it0 + vb; ph_prep(P, tab, IN(5) + l * 128, IN(6) + l * 64, IN(7) + l * 192, kmean, it, it < 128 * 14, t256, (float*)smh); }
            for (int rep = 0; rep < DUP_QK2; ++rep) qk2_rows(P, IN(3) + (size_t)l * 4 * 1024, QK2, bid, G, tid);
            { unsigned long long z64 = 0ull; asm volatile("" : "+v"(z64)); for (int i = bid * 512 + tid; i < 2 * T; i += G * 512) SSA[i] = z64; }
        } else if (j == 2) {
            for (int rep = 0; rep < DUP_M1; ++rep) ml256_m1_phase(P, QK2, Gt, IN(2) + l * 8, CT, nst, dec, bid, G, tid, (LAS unsigned char*)lds);
            for (int u = bid; u < 512; u += G) moba_gate_item(P, kmean, SELB, CNTQ, LISTG, u >> 7, (u >> 5) & 3, u & 31, tid, (LAS unsigned char*)lds);
        } else if (j == 3) {
            for (int it = bid; it < 16 * 9; it += G) ml256_scan(CT, nst, dec, it, tid);
            for (int rep = 0; rep < DUP_MOBA; ++rep) moba_kv_phase(P, SELB, CNTQ, LISTG, IN(5) + l * 128 + 64, bid, G, tid, (LAS unsigned char*)lds);
            for (int rep = 0; rep < DUP_NSA; ++rep) for (int pu = bid; pu < 256; pu += G) { const int b_ = pu >> 6, s = pu & 63;
                nsa_unit(P, Gt, tab, KVcb, IN(7) + l * 192, HM, b_, 127 - s, tid, (LAS unsigned char*)lds); nsa_unit(P, Gt, tab, KVcb, IN(7) + l * 192, HM, b_, s, tid, (LAS unsigned char*)lds); }
        } else {
            { const float kmx = gain_kmax(IN(5) + l * 128 + 64, tid & 63);
              for (int pu = bid; pu < 256; pu += G) { const int bh = pu >> 4, s = pu & 15;
                  moba_merge_unit(P, SELB, kmx, HM, bh >> 2, bh & 3, 31 - s, tid, (LAS unsigned char*)lds); moba_merge_unit(P, SELB, kmx, HM, bh >> 2, bh & 3, s, tid, (LAS unsigned char*)lds); } }
            for (int rep = 0; rep < DUP_M3; ++rep) ml256_m3_phase(P, QK2, Gt, IN(2) + l * 8, CT, nst, IN(4) + l * 512, HM, bid, G, tid, (LAS unsigned char*)lds);
        }
        if (ph + 1 < NPH) { if (ph == 0) grid.sync(); else { XcdBarrier xbar; xbar.bar = (unsigned*)(ws + WS_BAR); xbar.x = xb_xcc_id(); xbar.st = xst; xcd_barrier(xbar); } }
    }
#undef IN
#undef KARG
#undef PH_LOCALS
}

extern "C" void kernel_launch(void* const* d_in, const int* in_sizes, int n_in, void* d_out, int out_size, void* d_ws, size_t ws_size, hipStream_t stream) {
    static int grid = 0;
    if (grid == 0) {
        if (n_in != 16 || in_sizes[0] != T * DM || out_size != T * DM || ws_size < WS_END) { fprintf(stderr, "kernel_launch: unexpected shapes / workspace %zu < %zu\n", ws_size, (size_t)WS_END); grid = -1; return; }
        int dev = 0, cus = 0, per_cu = 0;
        if (hipGetDevice(&dev) != hipSuccess || hipDeviceGetAttribute(&cus, hipDeviceAttributeMultiprocessorCount, dev) != hipSuccess) { grid = -1; return; }
        if (hipFuncSetAttribute((const void*)hybrid_fwd, hipFuncAttributeMaxDynamicSharedMemorySize, LDS_BYTES) != hipSuccess) { fprintf(stderr, "kernel_launch: hipFuncSetAttribute failed\n"); grid = -1; return; }
        if (hipOccupancyMaxActiveBlocksPerMultiprocessor(&per_cu, (const void*)hybrid_fwd, 512, LDS_BYTES) != hipSuccess || per_cu < 1) { fprintf(stderr, "kernel_launch: occupancy query failed (%d)\n", per_cu); grid = -1; return; }
        grid = cus * per_cu;
        fprintf(stderr, "kernel_launch: grid %d (%d CUs x %d)\n", grid, cus, per_cu);
    }
    if (grid < 0) return;
    if (hipMemsetAsync((char*)d_ws + WS_BAR, 0, XCD_BAR_WORDS * 4, stream) != hipSuccess) { fprintf(stderr, "kernel_launch: memset failed\n"); return; }
    Params p{};
    for (int i = 0; i < 16; ++i) p.in[i] = (const float*)d_in[i];
    p.out = (float*)d_out; p.ws = (unsigned char*)d_ws;
    void* args[] = {&p};
    hipError_t e = hipLaunchCooperativeKernel((const void*)hybrid_fwd, dim3(grid), dim3(512), args, LDS_BYTES, stream);
    if (e != hipSuccess) fprintf(stderr, "kernel_launch: cooperative launch failed: %s (grid %d)\n", hipGetErrorString(e), grid);
}
```

```cpp
#include <hip/hip_runtime.h>
#include <hip/hip_cooperative_groups.h>
#include <cstdio>
#include <cstdint>
namespace cg = cooperative_groups;
namespace pg8 {
#define PG8_LAS __attribute__((address_space(3)))
typedef unsigned short bf16_t;
typedef short bf16x8 __attribute__((ext_vector_type(8)));
typedef float f32x4 __attribute__((ext_vector_type(4)));
typedef unsigned u32x4 __attribute__((ext_vector_type(4)));
constexpr int BM = 256, BK = 64, HALF = 128, HTB = HALF * BK * 2  , STAGE_BYTES = 8 * HTB, NXCD = 8, WGM = 8;

__host__ __device__ __forceinline__ int lds_byte(int r, int c) { const int st = (r >> 4) * 2 + (c >> 5), rr = r & 15, cc = c & 31, ob = rr * 64 + cc * 2; return st * 1024 + (ob ^ (((ob >> 9) & 1) << 5)); }
__host__ __device__ __forceinline__ void stage_rc(int b, int& R, int& C) { const int st = b / 1024, sb = b % 1024, swz = sb ^ (((sb >> 9) & 1) << 5); R = (st >> 1) * 16 + swz / 64; C = (st & 1) * 32 + (swz % 64) / 2; }
__host__ __device__ __forceinline__ int perm32(int rho) { const int n = rho >> 4, i = rho & 15; return 8 * (i >> 2) + 4 * n + (i & 3); }

struct Unit { int pm, pn; };
struct Gemm { const bf16_t* A; const bf16_t* Bt; int M, N, K; };

struct StaticOrder {
    int nM, nN, nwg, G, c;
    __host__ __device__ void init(int M, int N, int G_, int c_) { nM = M / BM; nN = N / BM; nwg = nM * nN; G = G_; c = c_; }
    __host__ __device__ bool next(int i, Unit& u) const {
        const long L = (long)i * G + c; if (L >= nwg) return false;
        int wgid = (int)L; { const int q = nwg / NXCD, r = nwg % NXCD, xcd = wgid % NXCD, off = wgid / NXCD; wgid = (xcd < r ? xcd * (q + 1) : r * (q + 1) + (xcd - r) * q) + off; }
        const int nig = WGM * nN, gid = wgid / nig, fm = gid * WGM, gsz = (nM - fm) < WGM ? (nM - fm) : WGM;
        u.pm = fm + ((wgid % nig) % gsz); u.pn = (wgid % nig) / gsz; return true;
    }
    __device__ __forceinline__ void a_ready(const Unit&) const {}
    __device__ __forceinline__ void done(const Unit&) const {}
};

__device__ __forceinline__ unsigned f2bf_u(float f) { unsigned u = __builtin_bit_cast(unsigned, f); return (u + 0x7fffu + ((u >> 16) & 1u)) >> 16; }
__device__ __forceinline__ unsigned pk2bf(float lo, float hi) { return f2bf_u(lo) | (f2bf_u(hi) << 16); }

__device__ __forceinline__ unsigned cvtpk_bf16(float lo, float hi) { typedef float f2_ __attribute__((ext_vector_type(2))); typedef __bf16 b2_ __attribute__((ext_vector_type(2)));
    f2_ v = {lo, hi}; b2_ b = __builtin_convertvector(v, b2_); return __builtin_bit_cast(unsigned, b); }
__device__ __forceinline__ float swz_xor16(float v) { return __uint_as_float((unsigned)__builtin_amdgcn_ds_swizzle((int)__float_as_uint(v), 0x1F | (16 << 10))); }
__device__ __forceinline__ float half_sum(float v) { auto rr = __builtin_amdgcn_permlane32_swap(__float_as_uint(v), __float_as_uint(v), false, false); return __uint_as_float(rr[0]) + __uint_as_float(rr[1]); }
__device__ __forceinline__ float row_rstd(const unsigned long long* ssq, int row) { return __builtin_amdgcn_rsqf((float)ssq[row] * (1.0f / (1048576.0f * 1024.0f)) + 1e-6f); }

struct EpiProj {
    static constexpr bool PERM = true, AFTER_DRAIN = false;
    bf16_t* O; int ldc; float* gates; int gate0; const PG8_LAS unsigned long long* rs_raw;
    __device__ __forceinline__ void operator()(const f32x4 (&acc)[2][2][4][2], const Unit& u, int wr, int wc, int fr, int fq) const {
        const int row0 = u.pm * BM + wr * 64 + fr; const int col0 = u.pn * BM + wc * 32 + 8 * fq;
        float rsv[2][4];
#pragma unroll
        for (int ai = 0; ai < 2; ++ai)
#pragma unroll
            for (int m = 0; m < 4; ++m) rsv[ai][m] = __builtin_amdgcn_rsqf((float)rs_raw[ai * HALF + wr * 64 + m * 16 + fr] * (1.0f / (1048576.0f * 1024.0f)) + 1e-6f);
#pragma unroll
        for (int ai = 0; ai < 2; ++ai)
#pragma unroll
            for (int m = 0; m < 4; ++m) { const int row = row0 + ai * HALF + m * 16; bf16_t* rowp = O + (size_t)row * ldc + col0; const float rs = rsv[ai][m];
#pragma unroll
                for (int bj = 0; bj < 2; ++bj) { const f32x4 v0 = acc[ai][bj][m][0] * rs, v1 = acc[ai][bj][m][1] * rs;
                    u32x4 w; w.x = cvtpk_bf16(v0[0], v0[1]); w.y = cvtpk_bf16(v0[2], v0[3]); w.z = cvtpk_bf16(v1[0], v1[1]); w.w = cvtpk_bf16(v1[2], v1[3]);
                    *(u32x4*)(rowp + bj * HALF) = w;
                    const int c = col0 + bj * HALF - gate0;
                    if (c >= 0 && c < 32) { float* g = gates + (size_t)row * 32 + c; *(f32x4*)g = v0; *(f32x4*)(g + 4) = v1; } } }
    }
};
struct EpiRelu2 {
    static constexpr bool PERM = true, AFTER_DRAIN = false;
    bf16_t* O; int ldc; const PG8_LAS unsigned long long* rs_raw;
    __device__ __forceinline__ void operator()(const f32x4 (&acc)[2][2][4][2], const Unit& u, int wr, int wc, int fr, int fq) const {
        const int row0 = u.pm * BM + wr * 64 + fr; const int col0 = u.pn * BM + wc * 32 + 8 * fq;
        float rsv[2][4];
#pragma unroll
        for (int ai = 0; ai < 2; ++ai)
#pragma unroll
            for (int m = 0; m < 4; ++m) rsv[ai][m] = __builtin_amdgcn_rsqf((float)rs_raw[ai * HALF + wr * 64 + m * 16 + fr] * (1.0f / (1048576.0f * 1024.0f)) + 1e-6f);
#pragma unroll
        for (int ai = 0; ai < 2; ++ai)
#pragma unroll
            for (int m = 0; m < 4; ++m) { const int row = row0 + ai * HALF + m * 16; bf16_t* rowp = O + (size_t)row * ldc + col0; const float rs = rsv[ai][m];
#pragma unroll
                for (int bj = 0; bj < 2; ++bj) { f32x4 v0 = acc[ai][bj][m][0] * rs, v1 = acc[ai][bj][m][1] * rs;
#pragma unroll
                    for (int e = 0; e < 4; ++e) { float a = v0[e] > 0.f ? v0[e] : 0.f; v0[e] = a * a; float b = v1[e] > 0.f ? v1[e] : 0.f; v1[e] = b * b; }
                    u32x4 w; w.x = cvtpk_bf16(v0[0], v0[1]); w.y = cvtpk_bf16(v0[2], v0[3]); w.z = cvtpk_bf16(v1[0], v1[1]); w.w = cvtpk_bf16(v1[2], v1[3]);
                    *(u32x4*)(rowp + bj * HALF) = w; } }
    }
};
struct EpiResid {
    static constexpr bool PERM = true, AFTER_DRAIN = false;
    float* out; int ldc; bf16_t* xb; unsigned long long* ssp;
    __device__ __forceinline__ void operator()(const f32x4 (&acc)[2][2][4][2], const Unit& u, int wr, int wc, int fr, int fq) const {
        const int row0 = u.pm * BM + wr * 64 + fr; const int col0 = u.pn * BM + wc * 32 + 8 * fq;
#pragma unroll
        for (int ai = 0; ai < 2; ++ai)
#pragma unroll
            for (int m = 0; m < 4; ++m) { const int row = row0 + ai * HALF + m * 16; const size_t off = (size_t)row * ldc + col0; float ss = 0.f;
#pragma unroll
                for (int bj = 0; bj < 2; ++bj) { const size_t o = off + bj * HALF; const u32x4 b = *(const u32x4*)(xb + o);
                    f32x4 v0, v1;
                    v0[0] = __uint_as_float(b.x << 16) + acc[ai][bj][m][0][0]; v0[1] = __uint_as_float(b.x & 0xffff0000u) + acc[ai][bj][m][0][1];
                    v0[2] = __uint_as_float(b.y << 16) + acc[ai][bj][m][0][2]; v0[3] = __uint_as_float(b.y & 0xffff0000u) + acc[ai][bj][m][0][3];
                    v1[0] = __uint_as_float(b.z << 16) + acc[ai][bj][m][1][0]; v1[1] = __uint_as_float(b.z & 0xffff0000u) + acc[ai][bj][m][1][1];
                    v1[2] = __uint_as_float(b.w << 16) + acc[ai][bj][m][1][2]; v1[3] = __uint_as_float(b.w & 0xffff0000u) + acc[ai][bj][m][1][3];
                    if (out) { *(f32x4*)(out + o) = v0; *(f32x4*)(out + o + 4) = v1; }
                    else { ss += ((v0[0] * v0[0] + v0[1] * v0[1]) + (v0[2] * v0[2] + v0[3] * v0[3])) + ((v1[0] * v1[0] + v1[1] * v1[1]) + (v1[2] * v1[2] + v1[3] * v1[3]));
                        u32x4 w; w.x = cvtpk_bf16(v0[0], v0[1]); w.y = cvtpk_bf16(v0[2], v0[3]); w.z = cvtpk_bf16(v1[0], v1[1]); w.w = cvtpk_bf16(v1[2], v1[3]); *(u32x4*)(xb + o) = w; } }
                if (!out) { ss += swz_xor16(ss); ss = half_sum(ss); if (fq == 0) atomicAdd(ssp + row, (unsigned long long)(ss * 1048576.0f + 0.5f)); } }
    }
};

struct EpiAny {
    static constexpr bool AFTER_DRAIN = false;
    int kind; bool perm;
    bf16_t* O; int ldc; float* gates; int gate0; const float* base; float* out; bf16_t* xb; unsigned long long* ssp;
    PG8_LAS unsigned long long* rs_raw;
    __device__ __forceinline__ void operator()(const f32x4 (&acc)[2][2][4][2], const Unit& u, int wr, int wc, int fr, int fq) const {
        if (kind == 0) { EpiProj e{O, ldc, gates, gate0, rs_raw}; e(acc, u, wr, wc, fr, fq); }
        else if (kind == 1) { EpiRelu2 e{O, ldc, rs_raw}; e(acc, u, wr, wc, fr, fq); }
        else { EpiResid e{out, ldc, xb, ssp}; e(acc, u, wr, wc, fr, fq); }
    }
};
template <class Epi, class Sched, bool ALIGN_EPI = false, bool SP2 = false>
__device__ __forceinline__ void gemm_phase(PG8_LAS unsigned char* lds, const Gemm g, const Sched& S, const Epi& E, const int tid) {
    const int wid = __builtin_amdgcn_readfirstlane(tid >> 6), lane = tid & 63, wr = wid >> 2, wc = wid & 3, fr = lane & 15, fq = lane >> 4;
    const int K = g.K, nt = K / BK;
    unsigned voffA[2], voffB[2];
#pragma unroll
    for (int i = 0; i < 2; ++i) { int R, C; stage_rc(tid * 16 + i * 8192, R, C); const int Rb = E.perm ? ((R & ~31) + perm32(R & 31)) : R;
        voffA[i] = (unsigned)(R * K + C) * 2u; voffB[i] = (unsigned)(Rb * K + C) * 2u; }
    const size_t kstep = (size_t)(BK * 2);
    const size_t hstep = (size_t)HALF * K * 2;
    const size_t tstep = 2 * hstep;
    const unsigned ldsw = (unsigned)wid * 1024u;
    const int aoff = lds_byte(wr * 64 + fr, fq * 8), boff = lds_byte(wc * 32 + fr, fq * 8);
#define PG8_SA(b, h) (((b) * 2 + (h)) * HTB)
#define PG8_SB(b, h) ((4 + (b) * 2 + (h)) * HTB)
#define PG8_STAGE(bufoff, gbase, voff) do { _Pragma("unroll") for (int _i = 0; _i < 2; ++_i) \
        __builtin_amdgcn_global_load_lds((const unsigned*)((const char*)(gbase) + (voff)[_i]), (PG8_LAS unsigned*)(lds + (bufoff) + ldsw + _i * 8192), 16, 0, 0); } while (0)
#define PG8_LDA(dst, b, h) do { _Pragma("unroll") for (int m = 0; m < 4; ++m) _Pragma("unroll") for (int k = 0; k < 2; ++k) dst[m][k] = *(const PG8_LAS bf16x8*)(lds + PG8_SA(b, h) + aoff + m * 2048 + k * 1024); } while (0)
#define PG8_LDB(dst, b, h) do { _Pragma("unroll") for (int n = 0; n < 2; ++n) _Pragma("unroll") for (int k = 0; k < 2; ++k) dst[n][k] = *(const PG8_LAS bf16x8*)(lds + PG8_SB(b, h) + boff + n * 2048 + k * 1024); } while (0)
#define PG8_MMA(ai, bj, At, Bt) do { __builtin_amdgcn_s_setprio(1); _Pragma("unroll") for (int m = 0; m < 4; ++m) _Pragma("unroll") for (int n = 0; n < 2; ++n) _Pragma("unroll") for (int k = 0; k < 2; ++k) \
        acc[ai][bj][m][n] = __builtin_amdgcn_mfma_f32_16x16x32_bf16(Bt[n][k], At[m][k], acc[ai][bj][m][n], 0, 0, 0); __builtin_amdgcn_s_setprio(0); } while (0)
#define PG8_WAIT_V(n) asm volatile("s_waitcnt vmcnt(" #n ")" ::: "memory")
#define PG8_WAIT_L(n) asm volatile("s_waitcnt lgkmcnt(" #n ")" ::: "memory")
#define PG8_BAR __builtin_amdgcn_s_barrier()
#define PG8_SCHED __builtin_amdgcn_sched_barrier(0)
    Unit cur, nxt; int ui = 0;
    if (!S.next(0, cur)) return;
    f32x4 acc[2][2][4][2];
#pragma unroll
    for (int a = 0; a < 2; ++a)
#pragma unroll
        for (int b = 0; b < 2; ++b)
#pragma unroll
            for (int m = 0; m < 4; ++m)
#pragma unroll
                for (int n = 0; n < 2; ++n) acc[a][b][m][n] = (f32x4){0.f, 0.f, 0.f, 0.f};
    bf16x8 At[4][2], B0[2][2], B1[2][2];
    const char* cA = (const char*)g.A + (size_t)cur.pm * tstep; const char* cB = (const char*)g.Bt + (size_t)cur.pn * tstep;
    S.a_ready(cur);
    if constexpr (SP2) {
        PG8_STAGE(PG8_SB(0, 0), cB, voffB); PG8_STAGE(PG8_SB(0, 1), cB + hstep, voffB); PG8_STAGE(PG8_SA(0, 0), cA, voffA); PG8_STAGE(PG8_SA(0, 1), cA + hstep, voffA);
        if (wr == 1) PG8_BAR;
        PG8_WAIT_V(2); PG8_BAR;
        PG8_STAGE(PG8_SB(1, 0), cB + kstep, voffB); PG8_STAGE(PG8_SA(1, 0), cA + kstep, voffA); PG8_STAGE(PG8_SB(1, 1), cB + hstep + kstep, voffB);
        PG8_WAIT_V(6); PG8_BAR;
    } else {
        PG8_STAGE(PG8_SB(0, 0), cB, voffB); PG8_STAGE(PG8_SA(0, 0), cA, voffA); PG8_STAGE(PG8_SB(0, 1), cB + hstep, voffB); PG8_STAGE(PG8_SA(0, 1), cA + hstep, voffA);
        if (wr == 1) PG8_BAR;
        PG8_WAIT_V(4); PG8_BAR;
        PG8_STAGE(PG8_SB(1, 0), cB + kstep, voffB); PG8_STAGE(PG8_SA(1, 0), cA + kstep, voffA); PG8_STAGE(PG8_SB(1, 1), cB + hstep + kstep, voffB);
        PG8_WAIT_V(6); PG8_BAR;
    }
    for (;;) {
        const bool has_next = S.next(ui + 1, nxt);
        const char* nA = has_next ? (const char*)g.A + (size_t)nxt.pm * tstep : cA; const char* nB = has_next ? (const char*)g.Bt + (size_t)nxt.pn * tstep : cB;
        for (int t = 0; t < nt; t += 2) {
            const bool last = (t == nt - 2);
            const char* a1 = cA + (size_t)(t + 1) * kstep;
            const char* a2 = last ? nA : cA + (size_t)(t + 2) * kstep; const char* b2 = last ? nB : cB + (size_t)(t + 2) * kstep;
            const char* a3 = a2 + kstep; const char* b3 = b2 + kstep;
            if (last && has_next) S.a_ready(nxt);
            if (last) __builtin_amdgcn_global_load_lds((const unsigned*)(E.ssp + (size_t)cur.pm * BM + 32 * wid) + lane, (PG8_LAS unsigned*)E.rs_raw + wid * 64, 4, 0, 0);
            if constexpr (SP2) {
            PG8_LDB(B0, 0, 0); PG8_LDB(B1, 0, 1); PG8_SCHED; PG8_LDA(At, 0, 0); PG8_STAGE(PG8_SA(1, 1), a1 + hstep, voffA);
            PG8_WAIT_V(8); PG8_WAIT_L(0); PG8_BAR; PG8_MMA(0, 0, At, B0); PG8_MMA(0, 1, At, B1); PG8_BAR; PG8_SCHED;
            PG8_LDA(At, 0, 1); PG8_STAGE(PG8_SB(0, 0), b2, voffB); PG8_STAGE(PG8_SB(0, 1), b2 + hstep, voffB); PG8_STAGE(PG8_SA(0, 0), a2, voffA);
            PG8_WAIT_V(8); PG8_WAIT_L(0); PG8_BAR; PG8_MMA(1, 0, At, B0); PG8_MMA(1, 1, At, B1); PG8_BAR; PG8_SCHED;
            PG8_LDB(B0, 1, 0); PG8_LDB(B1, 1, 1); PG8_SCHED; PG8_LDA(At, 1, 0); PG8_STAGE(PG8_SA(0, 1), a2 + hstep, voffA);
            PG8_WAIT_V(8); PG8_WAIT_L(0); PG8_BAR; PG8_MMA(0, 0, At, B0); PG8_MMA(0, 1, At, B1); PG8_BAR; PG8_SCHED;
            PG8_LDA(At, 1, 1); PG8_STAGE(PG8_SB(1, 0), b3, voffB); PG8_STAGE(PG8_SB(1, 1), b3 + hstep, voffB); PG8_STAGE(PG8_SA(1, 0), a3, voffA);
            PG8_WAIT_V(8); PG8_WAIT_L(0); PG8_BAR; PG8_MMA(1, 0, At, B0); PG8_MMA(1, 1, At, B1); PG8_BAR; PG8_SCHED;
            } else {
            PG8_LDB(B0, 0, 0); PG8_SCHED; PG8_LDA(At, 0, 0); PG8_STAGE(PG8_SA(1, 1), a1 + hstep, voffA);
            PG8_WAIT_L(8); PG8_BAR; PG8_WAIT_L(0); PG8_MMA(0, 0, At, B0); PG8_BAR; PG8_SCHED;
            PG8_LDB(B1, 0, 1); PG8_STAGE(PG8_SB(0, 0), b2, voffB);
            PG8_BAR; PG8_WAIT_L(0); PG8_MMA(0, 1, At, B1); PG8_BAR;
            PG8_LDA(At, 0, 1); PG8_STAGE(PG8_SA(0, 0), a2, voffA);
            PG8_BAR; PG8_WAIT_L(0); PG8_MMA(1, 0, At, B0); PG8_BAR; PG8_SCHED;
            PG8_STAGE(PG8_SB(0, 1), b2 + hstep, voffB);
            PG8_WAIT_V(6); PG8_BAR; PG8_MMA(1, 1, At, B1); PG8_BAR;
            PG8_LDB(B0, 1, 0); PG8_SCHED; PG8_LDA(At, 1, 0); PG8_STAGE(PG8_SA(0, 1), a2 + hstep, voffA);
            PG8_WAIT_L(8); PG8_BAR; PG8_WAIT_L(0); PG8_MMA(0, 0, At, B0); PG8_BAR; PG8_SCHED;
            PG8_LDB(B1, 1, 1); PG8_STAGE(PG8_SB(1, 0), b3, voffB);
            PG8_BAR; PG8_WAIT_L(0); PG8_MMA(0, 1, At, B1); PG8_BAR;
            PG8_LDA(At, 1, 1); PG8_STAGE(PG8_SA(1, 0), a3, voffA);
            PG8_BAR; PG8_WAIT_L(0); PG8_MMA(1, 0, At, B0); PG8_BAR; PG8_SCHED;
            PG8_STAGE(PG8_SB(1, 1), b3 + hstep, voffB);
            PG8_WAIT_V(6); PG8_BAR; PG8_MMA(1, 1, At, B1); PG8_BAR;
            }
        }
        if constexpr (ALIGN_EPI) { if (wr == 0) PG8_BAR; }
        if constexpr (!Epi::AFTER_DRAIN) { E(acc, cur, wr, wc, fr, fq); S.done(cur); }
        if (!has_next) break;
#pragma unroll
        for (int a = 0; a < 2; ++a)
#pragma unroll
            for (int b = 0; b < 2; ++b)
#pragma unroll
                for (int m = 0; m < 4; ++m)
#pragma unroll
                    for (int n = 0; n < 2; ++n) acc[a][b][m][n] = (f32x4){0.f, 0.f, 0.f, 0.f};
        cur = nxt; cA = nA; cB = nB; ++ui;
        if constexpr (ALIGN_EPI) { if (wr == 1) PG8_BAR; }
    }
    PG8_WAIT_V(0);
    if constexpr (!ALIGN_EPI) { if (wr == 0) PG8_BAR; }
    PG8_BAR;
    if constexpr (Epi::AFTER_DRAIN) { E.fused(acc, cur, wr, wc, fr, fq, lds, wid, lane); S.done(cur); }
#undef PG8_SA
#undef PG8_SB
#undef PG8_STAGE
#undef PG8_LDA
#undef PG8_LDB
#undef PG8_MMA
#undef PG8_WAIT_V
#undef PG8_WAIT_L
#undef PG8_BAR
#undef PG8_SCHED
}
}

typedef unsigned short bf16;
constexpr int NB = 4, SEQ = 8192, T = NB * SEQ, DM = 1024, DFF = 4096, DEPTH = 2;
constexpr int DIN = 3476, DINP = 3584;
constexpr int C_MQ = 0, C_MK = 512, C_MV = 1024, C_MO = 1536, C_BQ = 2048, C_BK = 2304, C_BV = 2560, C_NQ = 2816,
              C_NKC = 3072, C_NVC = 3136, C_NKS = 3200, C_NVS = 3264, C_NKW = 3328, C_NVW = 3392, C_GATE = 3456;
constexpr int NCMP = 511;
constexpr float EPS = 1e-6f;

__device__ __forceinline__ float bf2f(bf16 v) { return __builtin_bit_cast(float, (unsigned)v << 16); }
__device__ __forceinline__ bf16 f2bf(float f) { return (bf16)pg8::f2bf_u(f); }
template <int MASK> __device__ __forceinline__ float shx(float v) {
    if constexpr (MASK == 32) { auto rr = __builtin_amdgcn_permlane32_swap(__float_as_uint(v), __float_as_uint(v), false, false);
        return __uint_as_float(__builtin_amdgcn_mbcnt_lo(~0u, 0u) == 32u ? rr[0] : rr[1]); }
    else return __uint_as_float((unsigned)__builtin_amdgcn_ds_swizzle((int)__float_as_uint(v), 0x1F | (MASK << 10)));
}
__device__ __forceinline__ float xchg32(float v, int hi) { auto rr = __builtin_amdgcn_permlane32_swap(__float_as_uint(v), __float_as_uint(v), false, false); return __uint_as_float(hi ? rr[0] : rr[1]); }
__device__ __forceinline__ float hsum32(float v) { auto rr = __builtin_amdgcn_permlane32_swap(__float_as_uint(v), __float_as_uint(v), false, false); return __uint_as_float(rr[0]) + __uint_as_float(rr[1]); }
__device__ __forceinline__ float hmax32(float v) { auto rr = __builtin_amdgcn_permlane32_swap(__float_as_uint(v), __float_as_uint(v), false, false); return fmaxf(__uint_as_float(rr[0]), __uint_as_float(rr[1])); }
template <int MASK> __device__ __forceinline__ unsigned shxu(unsigned v) { return __float_as_uint(shx<MASK>(__uint_as_float(v))); }
__device__ __forceinline__ float wave_sum(float v) {
    v += shx<1>(v); v += shx<2>(v); v += shx<4>(v); v += shx<8>(v); v += shx<16>(v);
    auto rr = __builtin_amdgcn_permlane32_swap(__float_as_uint(v), __float_as_uint(v), false, false); return __uint_as_float(rr[0]) + __uint_as_float(rr[1]);
}
__device__ __forceinline__ float wave_max(float v) {
    v = fmaxf(v, shx<1>(v)); v = fmaxf(v, shx<2>(v)); v = fmaxf(v, shx<4>(v)); v = fmaxf(v, shx<8>(v)); v = fmaxf(v, shx<16>(v));
    auto rr = __builtin_amdgcn_permlane32_swap(__float_as_uint(v), __float_as_uint(v), false, false); return fmaxf(__uint_as_float(rr[0]), __uint_as_float(rr[1]));
}
__device__ __forceinline__ float sgprf(float c) { asm volatile("" : "+s"(c)); return c; }
#define nbg (sgprf(-1e30f))
__device__ __forceinline__ int mk_tid(int wave_s) { int t; asm volatile("v_mbcnt_lo_u32_b32 %0, -1, 0\n\tv_mbcnt_hi_u32_b32 %0, -1, %0" : "=v"(t)); return t + wave_s * 64; }
__device__ __forceinline__ float zf_() { float z = 0.f; asm volatile("" : "+v"(z)); return z; }
__device__ __forceinline__ float rcpf_(float x) { return __builtin_amdgcn_rcpf(x); }
__device__ __forceinline__ float sigmoidf_(float x) { return rcpf_(1.f + __expf(-x)); }
__device__ __forceinline__ float log_sigmoidf_(float x) { return fminf(x, 0.f) - __logf(1.f + __expf(-fabsf(x))); }
__device__ __forceinline__ void rope_cs(int pos, int f, float& c, float& s) {
    const float invf = f == 0 ? 1.0f : f == 1 ? 0.193922758102417f : f == 2 ? 0.03760603442788124f : f == 3 ? 0.007292666472494602f : f == 4 ? 0.0014142136787995696f
                     : f == 5 ? 0.00027424818836152554f : f == 6 ? 5.318298644851893e-05f : 1.031338433676865e-05f;
    const float ang = (float)pos * invf;
    const float k = rintf(ang * 0.15915493667125702f);
    float r = fmaf(-k, 6.2831854820251465f, ang); r = fmaf(-k, -1.7484555314695172e-07f, r);
    c = __cosf(r); s = __sinf(r);
}


__device__ __forceinline__ float dot64(const bf16* __restrict__ kp, const float* q) {
    const uint4* k4 = (const uint4*)kp; float a = 0.f;
#pragma unroll
    for (int j = 0; j < 8; ++j) { const uint4 w = k4[j]; const unsigned ww[4] = {w.x, w.y, w.z, w.w};
#pragma unroll
        for (int e = 0; e < 4; ++e) { a = fmaf(q[8 * j + 2 * e], __builtin_bit_cast(float, ww[e] << 16), a); a = fmaf(q[8 * j + 2 * e + 1], __builtin_bit_cast(float, ww[e] & 0xffff0000u), a); } }
    return a;
}
__device__ __forceinline__ void dot64x4(const bf16* __restrict__ kp, const float (*q)[64], float (&a)[4]) {
    const uint4* k4 = (const uint4*)kp; a[0] = a[1] = a[2] = a[3] = 0.f;
#pragma unroll
    for (int j = 0; j < 8; ++j) { const uint4 w = k4[j]; const unsigned ww[4] = {w.x, w.y, w.z, w.w};
#pragma unroll
        for (int e = 0; e < 4; ++e) { const float k0 = __builtin_bit_cast(float, ww[e] << 16), k1 = __builtin_bit_cast(float, ww[e] & 0xffff0000u);
#pragma unroll
            for (int h = 0; h < 4; ++h) { a[h] = fmaf(q[h][8 * j + 2 * e], k0, a[h]); a[h] = fmaf(q[h][8 * j + 2 * e + 1], k1, a[h]); } } }
}

__host__ __device__ __forceinline__ int win_src(int n) {
    if (n < 2048) return n;
    if (n < 3456) return n + 8;
    if (n < 3464) return n - 3456 + 2048;
    if (n < 3476) return n;
    return -1;
}


typedef unsigned u32x4p __attribute__((ext_vector_type(4)));
__device__ __forceinline__ void cw_load(float (&v)[16], const float* __restrict__ W, int N, int NP, int mode, int item, int t, const float* __restrict__ gk) {
    const int nbx = NP / 64; const int n0 = (item % nbx) * 64, k0 = (item / nbx) * 64, c = t & 63, r = t >> 6;
    const int src = mode ? win_src(n0 + c) : (n0 + c);
#pragma unroll
    for (int i = 0; i < 16; ++i) { const int k = r + 4 * i; v[i] = (src >= 0) ? W[(size_t)(k0 + k) * N + src] * (gk ? gk[k0 + k] : 1.f) : 0.f; }
}
__device__ __forceinline__ void ph_convert_mat(const float* __restrict__ W, int K, int N, int NP, bf16* __restrict__ WT, int mode, int vb, int NVB, int t, float* tile, const float* __restrict__ gk = nullptr) {
    const int nit = (NP / 64) * (K / 64), nbx = NP / 64, c = t & 63, r = t >> 6;
    float v[16];
    if (vb < nit) cw_load(v, W, N, NP, mode, vb, t, gk);
    for (int it0 = 0; it0 < nit; it0 += NVB) { const int it = it0 + vb; const bool act = it < nit;
        if (act) {
#pragma unroll
            for (int i = 0; i < 16; ++i) tile[(r + 4 * i) * 65 + c] = v[i]; }
        if (it + NVB < nit) cw_load(v, W, N, NP, mode, it + NVB, t, gk);
        __syncthreads();
        if (act) { const int n0 = (it % nbx) * 64, k0 = (it / nbx) * 64, n = t >> 2, kc = (t & 3) * 16;
            u32x4p w0, w1;
#pragma unroll
            for (int e = 0; e < 4; ++e) { w0[e] = pg8::cvtpk_bf16(tile[(kc + 2 * e) * 65 + n], tile[(kc + 2 * e + 1) * 65 + n]); w1[e] = pg8::cvtpk_bf16(tile[(kc + 8 + 2 * e) * 65 + n], tile[(kc + 8 + 2 * e + 1) * 65 + n]); }
            u32x4p* dst = (u32x4p*)(WT + (size_t)(n0 + n) * K + k0 + kc); dst[0] = w0; dst[1] = w1; }
        __syncthreads();
    }
}
__device__ __forceinline__ void ph_x_row(const float* __restrict__ x, bf16* __restrict__ XB, unsigned long long* __restrict__ ssq, int row, int lane) {
    const float4* xr = (const float4*)(x + (size_t)row * DM) + lane;
    float4 v[4]; float s = 0.f;
#pragma unroll
    for (int j = 0; j < 4; ++j) { v[j] = xr[64 * j]; s += v[j].x * v[j].x + v[j].y * v[j].y + v[j].z * v[j].z + v[j].w * v[j].w; }
    s = wave_sum(s);
    uint2* o = (uint2*)(XB + (size_t)row * DM) + lane;
#pragma unroll
    for (int j = 0; j < 4; ++j) { uint2 w; w.x = pg8::cvtpk_bf16(v[j].x, v[j].y); w.y = pg8::cvtpk_bf16(v[j].z, v[j].w); o[64 * j] = w; }
    if (lane == 0) ssq[row] = (unsigned long long)(s * 1048576.0f + 0.5f);
}
__device__ __forceinline__ void ph_prep(bf16* __restrict__ P, const float* __restrict__ tab, const float* __restrict__ moba_g, const float* __restrict__ nsa_qg, const float* __restrict__ nsa_kg,
                                        float* __restrict__ kmean, int item, bool act, int t, float* red  ) {
    const int lane = t & 63, wid = t >> 6, tb = item % 128, kind = item / 128, rg = lane >> 3, dch = lane & 7;
    if (act) {
        int col; const float* g; bool rope;
        if (kind < 4) { col = C_BQ + kind * 64; g = moba_g; rope = true; }
        else if (kind < 8) { col = C_BK + (kind - 4) * 64; g = moba_g + 64; rope = true; }
        else if (kind < 12) { col = C_NQ + (kind - 8) * 64; g = nsa_qg; rope = false; }
        else if (kind == 12) { col = C_NKS; g = nsa_kg + 64; rope = true; }
        else { col = C_NKW; g = nsa_kg + 128; rope = true; }
        float gd[8];
#pragma unroll
        for (int e = 0; e < 8; ++e) gd[e] = g[dch * 8 + e];
        const int row0 = tb * 256 + wid * 64 + rg;
        u32x4p raw[8];
#pragma unroll
        for (int it = 0; it < 8; ++it) raw[it] = *(const u32x4p*)(P + (size_t)(row0 + it * 8) * DINP + col + dch * 8);
        float ks[8];
#pragma unroll
        for (int e = 0; e < 8; ++e) ks[e] = 0.f;
#pragma unroll
        for (int it = 0; it < 8; ++it) {
            const int row = row0 + it * 8, pos = row & (SEQ - 1);
            float y[8]; float ss = 0.f;
#pragma unroll
            for (int e = 0; e < 4; ++e) { y[2 * e] = __builtin_bit_cast(float, raw[it][e] << 16); y[2 * e + 1] = __builtin_bit_cast(float, raw[it][e] & 0xffff0000u); ss += y[2 * e] * y[2 * e] + y[2 * e + 1] * y[2 * e + 1]; }
            ss += shx<1>(ss); ss += shx<2>(ss); ss += shx<4>(ss);
            const float rstd = rsqrtf(ss * (1.f / 64.f) + EPS);
#pragma unroll
            for (int e = 0; e < 8; ++e) y[e] *= rstd * gd[e];
            if (rope) {
                float o[8];
#pragma unroll
                for (int e = 0; e < 8; ++e) o[e] = shx<1>(y[e]);
                if (dch < 2) { const float4 c0 = *(const float4*)(tab + pos * 16), c1 = *(const float4*)(tab + pos * 16 + 4), s0 = *(const float4*)(tab + pos * 16 + 8), s1 = *(const float4*)(tab + pos * 16 + 12);
                    const float cs[8] = {c0.x, c0.y, c0.z, c0.w, c1.x, c1.y, c1.z, c1.w}, sn[8] = {s0.x, s0.y, s0.z, s0.w, s1.x, s1.y, s1.z, s1.w};
#pragma unroll
                    for (int e = 0; e < 8; ++e) y[e] = dch ? (y[e] * cs[e] + o[e] * sn[e]) : (y[e] * cs[e] - o[e] * sn[e]); }
            }
            u32x4p w; w[0] = pg8::pk2bf(y[0], y[1]); w[1] = pg8::pk2bf(y[2], y[3]); w[2] = pg8::pk2bf(y[4], y[5]); w[3] = pg8::pk2bf(y[6], y[7]);
            *(u32x4p*)(P + (size_t)row * DINP + col + dch * 8) = w;
#pragma unroll
            for (int e = 0; e < 8; ++e) ks[e] += y[e];
        }
        if (kind >= 4 && kind < 8) {
#pragma unroll
            for (int e = 0; e < 8; ++e) { ks[e] += shx<8>(ks[e]); ks[e] += shx<16>(ks[e]); ks[e] += shx<32>(ks[e]); }
            if (rg == 0) {
#pragma unroll
                for (int e = 0; e < 8; ++e) red[wid * 64 + dch * 8 + e] = ks[e]; }
        }
    }
    __syncthreads();
    if (act && kind >= 4 && kind < 8 && wid == 0) { const float s = red[lane] + red[64 + lane] + red[128 + lane] + red[192 + lane];
        const int b = tb >> 5, n = tb & 31; kmean[(((size_t)b * 4 + (kind - 4)) * 32 + n) * 64 + lane] = s * (1.f / 256.f); }
    __syncthreads();
}
__device__ __forceinline__ void ph_compress(const bf16* __restrict__ P, const float* __restrict__ pe, const float* __restrict__ w1, const float* __restrict__ w2, const float* __restrict__ kg0,
                                            float* __restrict__ KVc, bf16* __restrict__ KVcb, int item, bool act, int t, float* sm  ) {
    float* in = sm; float* hid = sm + 2048;
    const int i = item % NCMP, b = (item / NCMP) & 3, kv = item / (NCMP * 4);
    const int col = kv ? C_NVC : C_NKC;
    if (act) for (int e = t; e < 2048; e += 256) { const int p = e >> 6, d = e & 63; in[e] = bf2f(P[(size_t)(b * SEQ + 16 * i + p) * DINP + col + d]) + pe[(kv * 32 + p) * 64 + d]; }
    __syncthreads();
    if (act && t < 128) { const float* w = w1 + (size_t)kv * 2048 * 128 + t; float a = 0.f;
#pragma unroll 8
        for (int k = 0; k < 2048; ++k) a = fmaf(in[k], w[(size_t)k * 128], a);
        hid[t] = a * rcpf_(1.f + __expf(-a)); }
    __syncthreads();
    if (act && t < 64) { const float* ww = w2 + (size_t)kv * 128 * 64 + t; float o = 0.f;
#pragma unroll 8
        for (int j = 0; j < 128; ++j) o = fmaf(hid[j], ww[j * 64], o);
        if (kv == 0) { const float ss = wave_sum(o * o); o = o * rsqrtf(ss * (1.f / 64.f) + EPS) * kg0[t]; }
        KVc[(((size_t)kv * NB + b) * 512 + i) * 64 + t] = o; KVcb[(((size_t)kv * NB + b) * 512 + i) * 64 + t] = f2bf(o);
        if (i == NCMP - 1) KVcb[(((size_t)kv * NB + b) * 512 + NCMP) * 64 + t] = 0; }
    __syncthreads();
}
__device__ __forceinline__ float conv_silu(const bf16* __restrict__ P, const float* __restrict__ cw  , int rowbase, int t, int c) {
    float a = 0.f;
#pragma unroll
    for (int j = 0; j < 4; ++j) { const int tt = t - 3 + j; if (tt >= 0) a = fmaf(cw[j * 1024 + c], bf2f(P[(size_t)(rowbase + tt) * DINP + c]), a); }
    return a * rcpf_(1.f + __expf(-a));
}
__device__ __forceinline__ void ph_mlstm_local(const bf16* __restrict__ P, const float* __restrict__ G, const float* __restrict__ cw, const float* __restrict__ bif,
                                               float* __restrict__ Cst, float* __restrict__ nst, float* __restrict__ dec, int u, bool act, int tid, unsigned char* sm) {
    bf16 (*ks)[128] = (bf16 (*)[128])sm; bf16 (*vs)[128] = (bf16 (*)[128])(sm + 16384); float* wS = (float*)(sm + 32768); float* lf = wS + 64;
    const int c = u & 127, h = (u >> 7) & 3, b = u >> 9;
    const int rowbase = b * SEQ, t0 = c * 64;
    if (act) {
        for (int e = tid; e < 64 * 128; e += 256) { const int s = e >> 7, d = e & 127;
            ks[s][d] = f2bf(conv_silu(P, cw, rowbase, t0 + s, 512 + h * 128 + d) * 0.08838834764831845f);
            vs[s][d] = P[(size_t)(rowbase + t0 + s) * DINP + C_MV + h * 128 + d]; }
        if (tid < 64) lf[tid] = log_sigmoidf_(G[(size_t)(rowbase + t0 + tid) * 32 + 4 + h] + bif[4 + h]);
    }
    __syncthreads();
    if (act && tid == 0) { float acc = 0.f;
        for (int s = 0; s < 64; ++s) { acc += lf[s]; lf[s] = acc; }
        dec[u] = __expf(acc); }
    __syncthreads();
    if (act && tid < 64) wS[tid] = __expf(lf[63] - lf[tid] + G[(size_t)(rowbase + t0 + tid) * 32 + h] + bif[h]);
    __syncthreads();
    if (act) {
        const int d = tid >> 1, e0 = (tid & 1) * 64;
        float acc[64];
#pragma unroll
        for (int e = 0; e < 64; ++e) acc[e] = 0.f;
        float an = 0.f;
        for (int s = 0; s < 64; ++s) { const float kw = wS[s] * bf2f(ks[s][d]); an += kw;
#pragma unroll
            for (int e = 0; e < 64; ++e) acc[e] = fmaf(kw, bf2f(vs[s][e0 + e]), acc[e]); }
        float* o = Cst + ((size_t)u * 128 + d) * 128 + e0;
#pragma unroll
        for (int e = 0; e < 64; ++e) o[e] = acc[e];
        if ((tid & 1) == 0) nst[(size_t)u * 128 + d] = an;
    }
    __syncthreads();
}
__device__ __forceinline__ void ph_mlstm_scan(float* __restrict__ Cst, float* __restrict__ nst, const float* __restrict__ dec, int item, int tid) {
    const int bh = item / 65, part = item % 65;
    float* base; int stride;
    if (part < 64) { base = Cst + (size_t)bh * 128 * 16384 + part * 256 + tid; stride = 16384; }
    else { if (tid >= 128) return; base = nst + (size_t)bh * 128 * 128 + tid; stride = 128; }
    float C = 0.f;
    for (int c = 0; c < 128; ++c) { const float dC = base[(size_t)c * stride]; base[(size_t)c * stride] = C; C = dec[bh * 128 + c] * C + dC; }
}
__device__ __forceinline__ void ph_mlstm_out(const bf16* __restrict__ P, const float* __restrict__ G, const float* __restrict__ cw, const float* __restrict__ bif,
                                             const float* __restrict__ Cst, const float* __restrict__ nst, const float* __restrict__ mnorm, bf16* __restrict__ MIX, int u, bool act, int tid, unsigned char* sm) {
    bf16 (*qs)[128] = (bf16 (*)[128])sm; float* ksS = (float*)(sm + 16384); bf16 (*ks)[128] = (bf16 (*)[128])ksS; bf16 (*vs)[128] = (bf16 (*)[128])(sm + 32768);
    float* bb = (float*)(sm + 49152); float* li = bb + 64;
    const int c = u & 127, h = (u >> 7) & 3, b = u >> 9;
    const int rowbase = b * SEQ, t0 = c * 64;
    if (act) {
        for (int e = tid; e < 64 * 128; e += 256) { const int s = e >> 7, d = e & 127;
            qs[s][d] = f2bf(conv_silu(P, cw, rowbase, t0 + s, h * 128 + d));
            ks[s][d] = f2bf(conv_silu(P, cw, rowbase, t0 + s, 512 + h * 128 + d) * 0.08838834764831845f);
            vs[s][d] = P[(size_t)(rowbase + t0 + s) * DINP + C_MV + h * 128 + d]; }
        if (tid < 64) { bb[tid] = log_sigmoidf_(G[(size_t)(rowbase + t0 + tid) * 32 + 4 + h] + bif[4 + h]); li[tid] = G[(size_t)(rowbase + t0 + tid) * 32 + h] + bif[h]; }
    }
    __syncthreads();
    if (act && tid == 0) { float acc = 0.f; for (int s = 0; s < 64; ++s) { acc += bb[s]; bb[s] = acc; } }
    __syncthreads();
    const int t = tid >> 2, part = tid & 3;
    float sreg[16];
    if (act) {
        const int s0 = part * 16;
#pragma unroll
        for (int j = 0; j < 16; ++j) { const int s = s0 + j; float a = 0.f;
            if (s <= t) { for (int d = 0; d < 128; ++d) a = fmaf(bf2f(qs[t][d]), bf2f(ks[s][d]), a); a *= __expf(bb[t] - bb[s] + li[s]); }
            sreg[j] = a; }
    }
    __syncthreads();
    float* S = ksS;
    if (act) {
#pragma unroll
        for (int j = 0; j < 16; ++j) S[t * 64 + part * 16 + j] = sreg[j];
    }
    __syncthreads();
    if (act) {
        const float Ft = __expf(bb[t]);
        float den = 0.f;
        for (int s = 0; s <= t; ++s) den += S[t * 64 + s];
        { const float* np = nst + (size_t)u * 128; float a = 0.f; for (int d = 0; d < 128; ++d) a = fmaf(bf2f(qs[t][d]), np[d], a); den += Ft * a; }
        const int e0 = part * 32;
        float acc[32];
#pragma unroll
        for (int e = 0; e < 32; ++e) acc[e] = 0.f;
        { const float* Cp = Cst + (size_t)u * 16384 + e0;
          for (int d = 0; d < 128; ++d) { const float qd = bf2f(qs[t][d]);
#pragma unroll
              for (int e = 0; e < 32; ++e) acc[e] = fmaf(qd, Cp[d * 128 + e], acc[e]); } }
#pragma unroll
        for (int e = 0; e < 32; ++e) acc[e] *= Ft;
        for (int s = 0; s <= t; ++s) { const float w = S[t * 64 + s];
#pragma unroll
            for (int e = 0; e < 32; ++e) acc[e] = fmaf(w, bf2f(vs[s][e0 + e]), acc[e]); }
        const float inv = rcpf_(fmaxf(fabsf(den), 1.f));
        float ss = 0.f;
#pragma unroll
        for (int e = 0; e < 32; ++e) { acc[e] *= inv; ss += acc[e] * acc[e]; }
        ss += shx<1>(ss); ss += shx<2>(ss);
        const float rstd = rsqrtf(ss * (1.f / 128.f) + EPS);
        const size_t row = (size_t)(rowbase + t0 + t);
#pragma unroll
        for (int e = 0; e < 32; ++e) { const int cc = h * 128 + e0 + e;
            const float o = sigmoidf_(bf2f(P[row * DINP + C_MO + cc]));
            MIX[row * DM + cc] = f2bf(acc[e] * rstd * mnorm[cc] * o); }
    }
    __syncthreads();
}

__device__ __forceinline__ void ph_moba(const bf16* __restrict__ P, const float* __restrict__ kmean, bf16* __restrict__ MIX, int gw, int lane, float* q) {
    const int bh = gw >> 13, tq = gw & (SEQ - 1), b = bh >> 2, h = bh & 3, own = tq >> 8;
    const size_t row = (size_t)b * SEQ + tq;
    __builtin_amdgcn_s_waitcnt(0); __builtin_amdgcn_wave_barrier();
    q[lane] = bf2f(P[row * DINP + C_BQ + h * 64 + lane]);
    __builtin_amdgcn_s_waitcnt(0); __builtin_amdgcn_wave_barrier();
    float gs = -3.0e38f;
    if (lane < 32) { if (lane < own) { const float* km = kmean + (((size_t)b * 4 + h) * 32 + lane) * 64; float a = 0.f; for (int d = 0; d < 64; ++d) a = fmaf(q[d], km[d], a); gs = a; } else gs = -1e30f; }
    int blk[4]; bool val[4];
#pragma unroll
    for (int r = 0; r < 3; ++r) { const float m = wave_max(gs); const unsigned long long bal = __ballot(gs == m); const int idx = __ffsll((long long)bal) - 1;
        blk[r] = idx; val[r] = (r < own); if (lane == idx) gs = -3.0e38f; }
    blk[3] = own; val[3] = true;
    float s[4][4]; float mx = -1e30f;
#pragma unroll
    for (int g = 0; g < 4; ++g)
#pragma unroll
        for (int i = 0; i < 4; ++i) { float a = -1e30f;
            if (val[g]) { const int pos = blk[g] * 256 + i * 64 + lane;
                if (g < 3 || pos <= tq) { const bf16* kp = P + ((size_t)b * SEQ + pos) * DINP + C_BK + h * 64; a = dot64(kp, q) * 0.125f; } }
            s[g][i] = a; mx = fmaxf(mx, a); }
    mx = wave_max(mx);
    float l = 0.f;
#pragma unroll
    for (int g = 0; g < 4; ++g)
#pragma unroll
        for (int i = 0; i < 4; ++i) { const float p = (s[g][i] > -1e29f) ? __expf(s[g][i] - mx) : 0.f; s[g][i] = p; l += p; }
    l = wave_sum(l);
    float o = 0.f;
#pragma unroll
    for (int g = 0; g < 4; ++g) { if (!val[g]) continue;
#pragma unroll
        for (int i = 0; i < 4; ++i) { const bf16* vp = P + ((size_t)b * SEQ + blk[g] * 256 + i * 64) * DINP + C_BV + h * 64 + lane;
            for (int src = 0; src < 64; ++src) { const float p = __shfl(s[g][i], src); o = fmaf(p, bf2f(vp[(size_t)src * DINP]), o); } } }
    MIX[row * DM + 512 + h * 64 + lane] = f2bf(o * rcpf_(l));
}

__device__ __forceinline__ void ph_nsa(const bf16* __restrict__ P, const float* __restrict__ G, const float* __restrict__ tab, const float* __restrict__ KVc, bf16* __restrict__ MIX, int gw, int lane, float* sm) {
    float (*qn)[64] = (float (*)[64])sm; float (*qr)[64] = (float (*)[64])(sm + 256); float* ps = sm + 512;
    const int b = gw >> 13, tq = gw & (SEQ - 1), blkq = tq >> 6;
    const size_t row = (size_t)b * SEQ + tq;
    __builtin_amdgcn_s_waitcnt(0); __builtin_amdgcn_wave_barrier();
#pragma unroll
    for (int h = 0; h < 4; ++h) { const float x = bf2f(P[row * DINP + C_NQ + h * 64 + lane]); qn[h][lane] = x;
        float y = x; const float other = shx<8>(x);
        if (lane < 16) { const int f = lane & 7; const float c = tab[tq * 16 + f], s = tab[tq * 16 + 8 + f]; y = (lane < 8) ? (x * c - other * s) : (x * c + other * s); }
        qr[h][lane] = y; }
    __builtin_amdgcn_s_waitcnt(0); __builtin_amdgcn_wave_barrier();
    const float* Kc = KVc + (size_t)b * 512 * 64; const float* Vc = KVc + ((size_t)NB + b) * 512 * 64;
    float out[4] = {0.f, 0.f, 0.f, 0.f};
    float gate[3][4];
#pragma unroll
    for (int br = 0; br < 3; ++br)
#pragma unroll
        for (int h = 0; h < 4; ++h) gate[br][h] = sigmoidf_(G[row * 32 + 8 + br * 4 + h]);
    const int ncv = (tq >= 31) ? ((tq - 31) >> 4) + 1 : 0;
    {
        float sc[8][4]; float mx[4] = {-1e30f, -1e30f, -1e30f, -1e30f};
#pragma unroll
        for (int i = 0; i < 8; ++i) { const int c = i * 64 + lane;
            float a[4] = {-1e30f, -1e30f, -1e30f, -1e30f};
            if (c < ncv) { const float* kp = Kc + (size_t)c * 64; a[0] = a[1] = a[2] = a[3] = 0.f;
                for (int d = 0; d < 64; ++d) { const float kd = kp[d]; a[0] = fmaf(qn[0][d], kd, a[0]); a[1] = fmaf(qn[1][d], kd, a[1]); a[2] = fmaf(qn[2][d], kd, a[2]); a[3] = fmaf(qn[3][d], kd, a[3]); }
#pragma unroll
                for (int h = 0; h < 4; ++h) a[h] *= 0.125f; }
#pragma unroll
            for (int h = 0; h < 4; ++h) { sc[i][h] = a[h]; mx[h] = fmaxf(mx[h], a[h]); } }
        float l[4];
#pragma unroll
        for (int h = 0; h < 4; ++h) { mx[h] = wave_max(mx[h]); l[h] = 0.f; }
#pragma unroll
        for (int i = 0; i < 8; ++i) { const int c = i * 64 + lane;
#pragma unroll
            for (int h = 0; h < 4; ++h) { const float p = (c < ncv) ? __expf(sc[i][h] - mx[h]) : 0.f; sc[i][h] = p; l[h] += p; } }
#pragma unroll
        for (int h = 0; h < 4; ++h) { l[h] = wave_sum(l[h]); l[h] = (l[h] > 0.f) ? rcpf_(l[h]) : 0.f; }
#pragma unroll
        for (int i = 0; i < 8; ++i) { float su = 0.f;
#pragma unroll
            for (int h = 0; h < 4; ++h) { sc[i][h] *= l[h]; su += sc[i][h]; }
            ps[i * 64 + lane] = su; }
        if (lane < 4) ps[512 + lane] = 0.f;
        float oc[4] = {0.f, 0.f, 0.f, 0.f};
#pragma unroll
        for (int i = 0; i < 8; ++i) { if (i * 64 >= ncv) break; const int nn = min(64, ncv - i * 64);
            for (int src = 0; src < nn; ++src) { const float v = Vc[(size_t)(i * 64 + src) * 64 + lane];
                oc[0] = fmaf(__shfl(sc[i][0], src), v, oc[0]); oc[1] = fmaf(__shfl(sc[i][1], src), v, oc[1]);
                oc[2] = fmaf(__shfl(sc[i][2], src), v, oc[2]); oc[3] = fmaf(__shfl(sc[i][3], src), v, oc[3]); } }
#pragma unroll
        for (int h = 0; h < 4; ++h) out[h] = gate[0][h] * oc[h];
    }
    __builtin_amdgcn_s_waitcnt(0); __builtin_amdgcn_wave_barrier();
    int sidx[16];
    {
        float v0, v1;
        { const int n = lane; float im = 0.f;
#pragma unroll
          for (int j = -1; j < 4; ++j) { const int c = 4 * n + j; if (c >= 0 && c < NCMP) im += ps[c]; }
          const bool causal = n <= blkq, forced = causal && (n == 0 || n >= blkq - 1);
          v0 = forced ? 1e9f : (causal ? im : -1e30f); }
        { const int n = lane + 64; float im = 0.f;
#pragma unroll
          for (int j = -1; j < 4; ++j) { const int c = 4 * n + j; if (c >= 0 && c < NCMP) im += ps[c]; }
          const bool causal = n <= blkq, forced = causal && (n == 0 || n >= blkq - 1);
          v1 = forced ? 1e9f : (causal ? im : -1e30f); }
#pragma unroll
        for (int k = 0; k < 16; ++k) { const float m = wave_max(fmaxf(v0, v1));
            const unsigned long long b0 = __ballot(v0 == m); int idx;
            if (b0) { idx = __ffsll((long long)b0) - 1; if (lane == idx) v0 = -3.0e38f; }
            else { const unsigned long long b1 = __ballot(v1 == m); idx = __ffsll((long long)b1) - 1; if (lane == idx) v1 = -3.0e38f; idx += 64; }
            sidx[k] = idx; }
    }
    {
        float sc[16][4]; float mx[4] = {-1e30f, -1e30f, -1e30f, -1e30f};
#pragma unroll
        for (int k = 0; k < 16; ++k) { const int n = sidx[k], pos = n * 64 + lane;
            float a[4] = {-1e30f, -1e30f, -1e30f, -1e30f};
            if (n <= blkq && pos <= tq) { const bf16* kp = P + ((size_t)b * SEQ + pos) * DINP + C_NKS; dot64x4(kp, qr, a);
#pragma unroll
                for (int h = 0; h < 4; ++h) a[h] *= 0.125f; }
#pragma unroll
            for (int h = 0; h < 4; ++h) { sc[k][h] = a[h]; mx[h] = fmaxf(mx[h], a[h]); } }
        float l[4];
#pragma unroll
        for (int h = 0; h < 4; ++h) { mx[h] = wave_max(mx[h]); l[h] = 0.f; }
#pragma unroll
        for (int k = 0; k < 16; ++k)
#pragma unroll
            for (int h = 0; h < 4; ++h) { const float p = (sc[k][h] > -1e29f) ? __expf(sc[k][h] - mx[h]) : 0.f; sc[k][h] = p; l[h] += p; }
#pragma unroll
        for (int h = 0; h < 4; ++h) l[h] = rcpf_(wave_sum(l[h]));
        float os[4] = {0.f, 0.f, 0.f, 0.f};
#pragma unroll
        for (int k = 0; k < 16; ++k) { const int n = sidx[k]; if (n > blkq) continue;
            const bf16* vp = P + ((size_t)b * SEQ + n * 64) * DINP + C_NVS + lane;
            for (int src = 0; src < 64; ++src) { const float v = bf2f(vp[(size_t)src * DINP]);
                os[0] = fmaf(__shfl(sc[k][0], src), v, os[0]); os[1] = fmaf(__shfl(sc[k][1], src), v, os[1]);
                os[2] = fmaf(__shfl(sc[k][2], src), v, os[2]); os[3] = fmaf(__shfl(sc[k][3], src), v, os[3]); } }
#pragma unroll
        for (int h = 0; h < 4; ++h) out[h] += gate[1][h] * os[h] * l[h];
    }
    {
        float sc[8][4]; float mx[4] = {-1e30f, -1e30f, -1e30f, -1e30f};
#pragma unroll
        for (int i = 0; i < 8; ++i) { const int pos = tq - 511 + i * 64 + lane;
            float a[4] = {-1e30f, -1e30f, -1e30f, -1e30f};
            if (pos >= 0) { const bf16* kp = P + ((size_t)b * SEQ + pos) * DINP + C_NKW; dot64x4(kp, qr, a);
#pragma unroll
                for (int h = 0; h < 4; ++h) a[h] *= 0.125f; }
#pragma unroll
            for (int h = 0; h < 4; ++h) { sc[i][h] = a[h]; mx[h] = fmaxf(mx[h], a[h]); } }
        float l[4];
#pragma unroll
        for (int h = 0; h < 4; ++h) { mx[h] = wave_max(mx[h]); l[h] = 0.f; }
#pragma unroll
        for (int i = 0; i < 8; ++i)
#pragma unroll
            for (int h = 0; h < 4; ++h) { const float p = (sc[i][h] > -1e29f) ? __expf(sc[i][h] - mx[h]) : 0.f; sc[i][h] = p; l[h] += p; }
#pragma unroll
        for (int h = 0; h < 4; ++h) l[h] = rcpf_(wave_sum(l[h]));
        float ow[4] = {0.f, 0.f, 0.f, 0.f};
#pragma unroll
        for (int i = 0; i < 8; ++i) { const int p0 = tq - 511 + i * 64; if (p0 + 63 < 0) continue;
            const int s0 = p0 < 0 ? -p0 : 0;
            for (int src = s0; src < 64; ++src) { const float v = bf2f(P[((size_t)b * SEQ + p0 + src) * DINP + C_NVW + lane]);
                ow[0] = fmaf(__shfl(sc[i][0], src), v, ow[0]); ow[1] = fmaf(__shfl(sc[i][1], src), v, ow[1]);
                ow[2] = fmaf(__shfl(sc[i][2], src), v, ow[2]); ow[3] = fmaf(__shfl(sc[i][3], src), v, ow[3]); } }
#pragma unroll
        for (int h = 0; h < 4; ++h) out[h] += gate[2][h] * ow[h] * l[h];
    }
#pragma unroll
    for (int h = 0; h < 4; ++h) MIX[row * DM + 768 + h * 64 + lane] = f2bf(out[h]);
}


#define LAS __attribute__((address_space(3)))
typedef short bf16x8 __attribute__((ext_vector_type(8)));
typedef float f32x16 __attribute__((ext_vector_type(16)));
typedef short s16x4 __attribute__((ext_vector_type(4)));
typedef unsigned u32x4v __attribute__((ext_vector_type(4)));
typedef float f32x2_t __attribute__((ext_vector_type(2)));
typedef __bf16 bf16x2_t __attribute__((ext_vector_type(2)));
constexpr int KROW = 144, VROW = 192;
constexpr int KBUF = 64 * KROW, VBUF = 64 * VROW, STG = KBUF + VBUF;
constexpr float SCL2 = 0.125f * 1.4426950408889634f;
constexpr float NEGBIG = -1e30f;

__device__ __forceinline__ unsigned cvtpk(float lo, float hi) { f32x2_t v = {lo, hi}; bf16x2_t b = __builtin_convertvector(v, bf16x2_t); return __builtin_bit_cast(unsigned, b); }
__device__ __forceinline__ int crow(int r, int hi) { return (r & 3) + 8 * (r >> 2) + 4 * hi; }
__device__ __forceinline__ s16x4 lds_tr(LAS const unsigned char* p) { return __builtin_bit_cast(s16x4, __builtin_amdgcn_ds_read_tr16_b64_v4i16((LAS s16x4*)p)); }

__device__ __forceinline__ bf16x8 scale_frag(bf16x8 v, float s) {
    const u32x4v w = __builtin_bit_cast(u32x4v, v); u32x4v o;
#pragma unroll
    for (int e = 0; e < 4; ++e) o[e] = cvtpk(__builtin_bit_cast(float, w[e] << 16) * s, __builtin_bit_cast(float, w[e] & 0xffff0000u) * s);
    return __builtin_bit_cast(bf16x8, o);
}
struct TileSrc { const bf16* k; const bf16* v; int stride; };
__device__ __forceinline__ void tile_load(u32x4v& kr, u32x4v& vr, const TileSrc& s, int t) {
    const int key = t >> 3, ch = t & 7;
    kr = *(const u32x4v*)(s.k + (size_t)key * s.stride + ch * 8); vr = *(const u32x4v*)(s.v + (size_t)key * s.stride + ch * 8);
}
__device__ __forceinline__ void tile_store(LAS unsigned char* buf, const u32x4v& kr, const u32x4v& vr, int t) {
    const int key = t >> 3, ch = t & 7;
    *(LAS u32x4v*)(buf + key * KROW + ch * 16) = kr; *(LAS u32x4v*)(buf + KBUF + key * VROW + ch * 16) = vr;
}
__device__ __forceinline__ void qk_tile(f32x16& p0, f32x16& p1, LAS const unsigned char* kb, const bf16x8 (&qf)[4], int r32, int hi, float cinit) {
    float ci = cinit; asm volatile("" : "+v"(ci));
#pragma unroll
    for (int r = 0; r < 16; ++r) { p0[r] = ci; p1[r] = ci; }
    LAS const unsigned char* a = kb + r32 * KROW + hi * 16;
#pragma unroll
    for (int ks = 0; ks < 4; ++ks) {
        const bf16x8 a0 = *(LAS const bf16x8*)(a + ks * 32), a1 = *(LAS const bf16x8*)(a + 32 * KROW + ks * 32);
        p0 = __builtin_amdgcn_mfma_f32_32x32x16_bf16(a0, qf[ks], p0, 0, 0, 0);
        p1 = __builtin_amdgcn_mfma_f32_32x32x16_bf16(a1, qf[ks], p1, 0, 0, 0);
    }
}
__device__ __forceinline__ void pv_tile(f32x16& o0, f32x16& o1, LAS const unsigned char* vb, const f32x16& p0, const f32x16& p1, int lane) {
    const int g = lane >> 4, i = lane & 15, hi = lane >> 5;
    LAS const unsigned char* base = vb + (4 * hi + (i >> 2)) * VROW + (16 * (g & 1) + 4 * (i & 3)) * 2;
#pragma unroll
    for (int s = 0; s < 4; ++s) {
        unsigned w[4];
#pragma unroll
        for (int e = 0; e < 4; ++e) { const int r = 8 * (s & 1) + 2 * e; w[e] = (s < 2) ? cvtpk(p0[r], p0[r + 1]) : cvtpk(p1[r], p1[r + 1]); }
        const u32x4v wv = {w[0], w[1], w[2], w[3]};
        const bf16x8 pf = __builtin_bit_cast(bf16x8, wv);
#pragma unroll
        for (int mb = 0; mb < 2; ++mb) {
            const s16x4 lo = lds_tr(base + s * 16 * VROW + mb * 64), hi4 = lds_tr(base + s * 16 * VROW + 8 * VROW + mb * 64);
            const bf16x8 vt = {lo[0], lo[1], lo[2], lo[3], hi4[0], hi4[1], hi4[2], hi4[3]};
            if (mb == 0) o0 = __builtin_amdgcn_mfma_f32_32x32x16_bf16(vt, pf, o0, 0, 0, 0);
            else o1 = __builtin_amdgcn_mfma_f32_32x32x16_bf16(vt, pf, o1, 0, 0, 0);
        }
    }
}
constexpr float SM_THR = 8.0f;
__device__ __forceinline__ void softmax_tile(f32x16& p0, f32x16& p1, f32x16& o0, f32x16& o1, float& mref, float& l, bool first) {
    float a = __builtin_fmaxf(__builtin_fmaxf(p0[0], p0[1]), p1[0]), b = __builtin_fmaxf(__builtin_fmaxf(p0[2], p0[3]), p1[1]);
    a = __builtin_fmaxf(__builtin_fmaxf(a, p1[2]), p1[3]);
#pragma unroll
    for (int r = 4; r < 16; r += 4) { a = __builtin_fmaxf(__builtin_fmaxf(a, p0[r]), p0[r + 1]); b = __builtin_fmaxf(__builtin_fmaxf(b, p0[r + 2]), p0[r + 3]);
        a = __builtin_fmaxf(__builtin_fmaxf(a, p1[r]), p1[r + 1]); b = __builtin_fmaxf(__builtin_fmaxf(b, p1[r + 2]), p1[r + 3]); }
    float rm = __builtin_fmaxf(a, b);
    { auto rr = __builtin_amdgcn_permlane32_swap(__float_as_uint(rm), __float_as_uint(rm), false, false); rm = __builtin_fmaxf(__uint_as_float(rr[0]), __uint_as_float(rr[1])); }
    if (first || __any(rm > SM_THR)) {
        const float dl = first ? rm : __builtin_fmaxf(rm, 0.f);
        mref += dl;
        const float f = __builtin_amdgcn_exp2f(-dl);
        l *= f;
#pragma unroll
        for (int r = 0; r < 16; ++r) { p0[r] -= dl; p1[r] -= dl; o0[r] *= f; o1[r] *= f; }
    }
    float s0 = 0.f, s1 = 0.f;
#pragma unroll
    for (int r = 0; r < 16; ++r) { p0[r] = __builtin_amdgcn_exp2f(p0[r]); p1[r] = __builtin_amdgcn_exp2f(p1[r]); s0 += p0[r]; s1 += p1[r]; }
    l += s0 + s1;
}


constexpr int PV_OFF = 2 * KBUF, PIPE_BYTES = 2 * KBUF + 2 * VBUF;
__device__ __forceinline__ void k_store(LAS unsigned char* lds, int slot, const u32x4v& kr, int t) { *(LAS u32x4v*)(lds + slot * KBUF + (t >> 3) * KROW + (t & 7) * 16) = kr; }
__device__ __forceinline__ void v_store(LAS unsigned char* lds, int voff, const u32x4v& vr, int t) { *(LAS u32x4v*)(lds + PV_OFF + voff + (t >> 3) * VROW + (t & 7) * 16) = vr; }
__device__ __forceinline__ u32x4v kv_load(const bf16* base, int stride, int t) { return *(const u32x4v*)(base + (size_t)(t >> 3) * stride + (t & 7) * 8); }
__device__ __forceinline__ void pv_frag(f32x16& o0, f32x16& o1, LAS const unsigned char* vb, const bf16x8 (&pf)[4], int lane) {
    const int g = lane >> 4, i = lane & 15, hi = lane >> 5;
    LAS const unsigned char* base = vb + (4 * hi + (i >> 2)) * VROW + (16 * (g & 1) + 4 * (i & 3)) * 2;
#pragma unroll
    for (int s = 0; s < 4; ++s)
#pragma unroll
        for (int mb = 0; mb < 2; ++mb) {
            const s16x4 lo = lds_tr(base + s * 16 * VROW + mb * 64), hi4 = lds_tr(base + s * 16 * VROW + 8 * VROW + mb * 64);
            const bf16x8 vt = {lo[0], lo[1], lo[2], lo[3], hi4[0], hi4[1], hi4[2], hi4[3]};
            if (mb == 0) o0 = __builtin_amdgcn_mfma_f32_32x32x16_bf16(vt, pf[s], o0, 0, 0, 0);
            else o1 = __builtin_amdgcn_mfma_f32_32x32x16_bf16(vt, pf[s], o1, 0, 0, 0);
        }
}
__device__ __forceinline__ void exp_pack(f32x16& p0, f32x16& p1, float& l, bf16x8 (&pf)[4]) {
    float s0 = 0.f, s1 = 0.f;
#pragma unroll
    for (int r = 0; r < 16; ++r) { p0[r] = __builtin_amdgcn_exp2f(p0[r]); p1[r] = __builtin_amdgcn_exp2f(p1[r]); s0 += p0[r]; s1 += p1[r]; }
    l += s0 + s1;
#pragma unroll
    for (int s = 0; s < 4; ++s) { u32x4v w;
#pragma unroll
        for (int e = 0; e < 4; ++e) { const int r = 8 * (s & 1) + 2 * e; w[e] = (s < 2) ? cvtpk(p0[r], p0[r + 1]) : cvtpk(p1[r], p1[r + 1]); }
        pf[s] = __builtin_bit_cast(bf16x8, w); }
}
template <class Pol>
__device__ __forceinline__ void attn_step_gen(const Pol& pol, int t, bool doqk, LAS unsigned char* lds, const bf16x8 (&qf)[4], float negm, f32x16& pc0, f32x16& pc1,
                                              f32x16& o0, f32x16& o1, float& l, int tid, int lane, int r32, int hi) {
    const int nt = pol.nt;
    u32x4v kr, vr;
    const bool ldk = (t + 2 < nt), ldv = (t + 1 < nt);
    if (ldk) kr = kv_load(pol.kptr(t + 2), pol.stride, tid);
    if (ldv) vr = kv_load(pol.vptr(t + 1), pol.stride, tid);
    f32x16 pn0, pn1; bf16x8 pf[4];
    if (doqk) { qk_tile(pn0, pn1, lds + ((t + 1) & 1) * KBUF, qf, r32, hi, pol.rowsel(t + 1) ? negm : NEGBIG); pol.mask(t + 1, pn0, pn1); }
    exp_pack(pc0, pc1, l, pf);
    pv_frag(o0, o1, lds + PV_OFF + (t & 1) * VBUF, pf, lane);
    if (ldk) k_store(lds, t & 1, kr, tid);
    if (ldv) v_store(lds, ((t + 1) & 1) * VBUF, vr, tid);
    __syncthreads();
    if (doqk) { pc0 = pn0; pc1 = pn1; }
}
template <class Pol>
__device__ __forceinline__ void attn_step_fast(const Pol& pol, int t, LAS unsigned char* lds, const bf16x8 (&qf)[4], float negm, f32x16& pc0, f32x16& pc1, f32x16& pn0, f32x16& pn1,
                                               f32x16& o0, f32x16& o1, float& l, u32x4v& kld, u32x4v& vld, const u32x4v& kst, const u32x4v& vst,
                                               int tid, int lane, int r32, int hi) {
    const int nt = pol.nt, tk = (t + 3 < nt) ? t + 3 : nt - 1, tv = (t + 2 < nt) ? t + 2 : nt - 1;
    kld = kv_load(pol.kptr(tk), pol.stride, tid); vld = kv_load(pol.vptr(tv), pol.stride, tid);
    bf16x8 pf[4];
    qk_tile(pn0, pn1, lds + ((t + 1) & 1) * KBUF, qf, r32, hi, pol.rowsel(t + 1) ? negm : NEGBIG);
    exp_pack(pc0, pc1, l, pf);
    pv_frag(o0, o1, lds + PV_OFF + (t & 1) * VBUF, pf, lane);
    k_store(lds, t & 1, kst, tid);
    v_store(lds, ((t + 1) & 1) * VBUF, vst, tid);
    __syncthreads();
}
template <class Pol>
__device__ __forceinline__ void attn_pipe(const Pol& pol, LAS unsigned char* lds, const bf16x8 (&qf)[4], float negm, f32x16& o0, f32x16& o1, float& l, int tid) {
    const int lane = tid & 63, r32 = lane & 31, hi = lane >> 5, nt = pol.nt;
    {
        const u32x4v k0 = kv_load(pol.kptr(0), pol.stride, tid), v0 = kv_load(pol.vptr(0), pol.stride, tid);
        u32x4v k1 = k0; if (nt > 1) k1 = kv_load(pol.kptr(1), pol.stride, tid);
        k_store(lds, 0, k0, tid); v_store(lds, 0, v0, tid); if (nt > 1) k_store(lds, 1, k1, tid);
    }
    __syncthreads();
    f32x16 pc0, pc1;
    qk_tile(pc0, pc1, lds, qf, r32, hi, pol.rowsel(0) ? negm : NEGBIG); pol.mask(0, pc0, pc1);
    int t = 0;
    for (; t < nt - 1 && t + 1 < pol.nmask; ++t)
        attn_step_gen(pol, t, true, lds, qf, negm, pc0, pc1, o0, o1, l, tid, lane, r32, hi);
    if (t < nt - 1) {
        const int tk0 = (t + 2 < nt) ? t + 2 : nt - 1;
        u32x4v ka = kv_load(pol.kptr(tk0), pol.stride, tid), va = kv_load(pol.vptr(t + 1), pol.stride, tid), kb, vb;
        f32x16 pd0, pd1;
        for (; t + 1 < nt - 1; t += 2) {
            attn_step_fast(pol, t, lds, qf, negm, pc0, pc1, pd0, pd1, o0, o1, l, kb, vb, ka, va, tid, lane, r32, hi);
            attn_step_fast(pol, t + 1, lds, qf, negm, pd0, pd1, pc0, pc1, o0, o1, l, ka, va, kb, vb, tid, lane, r32, hi);
        }
        if (t < nt - 1) {
            attn_step_fast(pol, t, lds, qf, negm, pc0, pc1, pd0, pd1, o0, o1, l, kb, vb, ka, va, tid, lane, r32, hi);
            pc0 = pd0; pc1 = pd1; ++t;
        }
    }
    attn_step_gen(pol, nt - 1, false, lds, qf, negm, pc0, pc1, o0, o1, l, tid, lane, r32, hi);
}
__device__ __forceinline__ float row_negm(const bf16x8 (&qf)[4], float kmax) {
    float ss = 0.f;
#pragma unroll
    for (int ks = 0; ks < 4; ++ks) { const u32x4v w = __builtin_bit_cast(u32x4v, qf[ks]);
#pragma unroll
        for (int e = 0; e < 4; ++e) { const float a = __builtin_bit_cast(float, w[e] << 16), b = __builtin_bit_cast(float, w[e] & 0xffff0000u); ss += a * a + b * b; } }
    ss += shx<32>(ss);
    return -(__builtin_sqrtf(ss) * kmax);
}
__device__ __forceinline__ float gain_kmax(const float* g, int lane) { return wave_max(fabsf(g[lane])) * (8.0f * 1.02f); }


constexpr int MK_KM_OFF = 0, MK_MSK_OFF = 8192, MK_CNT_OFF = MK_MSK_OFF + 1024, MK_END = MK_CNT_OFF + 512;
__device__ __forceinline__ void moba_gate_item(const bf16* __restrict__ P, const float* __restrict__ kmean, unsigned* __restrict__ SELB, int* __restrict__ CNTQ, unsigned char* __restrict__ LISTG,
                                               int b, int h, int qb, int tid, LAS unsigned char* lds) {
    asm volatile("" : "+v"(tid));
    const int lane = tid & 63, wid = __builtin_amdgcn_readfirstlane(tid >> 6), r32 = lane & 31, hi = lane >> 5, bh = b * 4 + h;
    LAS float* km = (LAS float*)(lds + MK_KM_OFF); LAS unsigned* msk = (LAS unsigned*)(lds + MK_MSK_OFF); LAS int* cnts = (LAS int*)(lds + MK_CNT_OFF);
    const int own = qb;
    const size_t rowq = (size_t)b * SEQ + qb * 256 + wid * 32 + r32;
    bf16x8 qg[4];
#pragma unroll
    for (int ks = 0; ks < 4; ++ks) qg[ks] = *(const bf16x8*)(P + rowq * DINP + C_BQ + h * 64 + ks * 16 + hi * 8);
    for (int e = tid; e < own * 64; e += 512) km[e] = kmean[((size_t)bh * 32) * 64 + e];
    __syncthreads();
    {
        unsigned mask = 0u; float qv[32];
#pragma unroll
        for (int ks = 0; ks < 4; ++ks)
#pragma unroll
            for (int j = 0; j < 8; ++j) qv[ks * 8 + j] = bf2f((bf16)qg[ks][j]);
        float b0 = -3e38f, b1 = -3e38f, b2 = -3e38f; int i0 = -1, i1 = -1, i2 = -1;
        for (int n = 0; n < own; ++n) {
            LAS const float* kp = km + n * 64 + hi * 8; float a = 0.f;
#pragma unroll
            for (int ks = 0; ks < 4; ++ks)
#pragma unroll
                for (int j = 0; j < 8; ++j) a = fmaf(qv[ks * 8 + j], kp[ks * 16 + j], a);
            a += shx<32>(a);
            if (a > b0) { b2 = b1; i2 = i1; b1 = b0; i1 = i0; b0 = a; i0 = n; }
            else if (a > b1) { b2 = b1; i2 = i1; b1 = a; i1 = n; }
            else if (a > b2) { b2 = a; i2 = n; }
        }
        if (i0 >= 0) mask |= 1u << i0; if (i1 >= 0) mask |= 1u << i1; if (i2 >= 0) mask |= 1u << i2;
        if (hi == 0) { msk[wid * 32 + r32] = mask; SELB[(size_t)bh * SEQ + qb * 256 + wid * 32 + r32] = mask; }
    }
    __syncthreads();
    unsigned mym = 0u;
    if (wid < 4) { mym = msk[wid * 64 + lane];
        for (int n = 0; n < own; ++n) { const unsigned long long bal = __ballot((mym >> n) & 1u); if (lane == 0) cnts[n * 4 + wid] = __popcll(bal); } }
    __syncthreads();
    if (wid < 4) {
        unsigned char* lg = LISTG + ((size_t)bh * 32 + qb) * 32 * 256;
        for (int n = 0; n < own; ++n) { const unsigned long long bal = __ballot((mym >> n) & 1u);
            int off = 0; for (int w = 0; w < wid; ++w) off += cnts[n * 4 + w];
            if ((mym >> n) & 1u) lg[n * 256 + off + __popcll(bal & ((1ull << lane) - 1ull))] = (unsigned char)(wid * 64 + lane); }
    } else if (wid == 4) {
        if (lane < 32) CNTQ[((size_t)bh * 32 + qb) * 32 + lane] = (lane < own) ? (cnts[lane * 4] + cnts[lane * 4 + 1] + cnts[lane * 4 + 2] + cnts[lane * 4 + 3]) : 0;
    }
    __syncthreads();
}
__device__ __forceinline__ unsigned char* moba_part(bf16* P, size_t token, int h, int slot) { return (unsigned char*)(P + token * DINP) + h * 512 + slot * 136; }
constexpr int MK_TAB_OFF = 4 * STG;
__device__ __forceinline__ void moba_kv_chunk(bf16* __restrict__ P, const unsigned* __restrict__ SELB, const int* __restrict__ CNTQ, const unsigned char* __restrict__ LISTG, float kmax,
                                              int bh, int n, int c, int tid, LAS unsigned char* lds) {
    asm volatile("" : "+v"(tid));
    const int lane = tid & 63, wid = __builtin_amdgcn_readfirstlane(tid >> 6), r32 = lane & 31, hi = lane >> 5, b = bh >> 2, h = bh & 3;
    bf16* Pb = P + (size_t)b * SEQ * DINP;
    LAS int* tab = (LAS int*)(lds + MK_TAB_OFF);
    {
        const bf16* ksrc = Pb + (size_t)(n * 256) * DINP + C_BK + h * 64; const bf16* vsrc = Pb + (size_t)(n * 256) * DINP + C_BV + h * 64;
        u32x4v kr[4], vr[4];
#pragma unroll
        for (int s = 0; s < 4; ++s) { kr[s] = kv_load(ksrc + (size_t)s * 64 * DINP, DINP, tid); vr[s] = kv_load(vsrc + (size_t)s * 64 * DINP, DINP, tid); }
        if (tid < 32) { const int cq = (tid > n) ? CNTQ[((size_t)bh * 32 + tid) * 32 + n] : 0; tab[tid] = (cq + 31) >> 5; tab[32 + tid] = cq; }
#pragma unroll
        for (int s = 0; s < 4; ++s) { *(LAS u32x4v*)(lds + s * STG + (tid >> 3) * KROW + (tid & 7) * 16) = kr[s]; *(LAS u32x4v*)(lds + s * STG + KBUF + (tid >> 3) * VROW + (tid & 7) * 16) = vr[s]; }
    }
    __syncthreads();
    if (tid < 16) { const int ord = 16 * c + tid; int qb = -1, j = 0, acc = 0;
        for (int q = n + 1; q < 32; ++q) { const int t = tab[q]; if (qb < 0 && ord < acc + t) { qb = q; j = ord - acc; } acc += t; }
        tab[64 + tid] = qb < 0 ? -1 : ((qb << 8) | j); }
    __syncthreads();
    for (int r = 0; r < 2; ++r) {
        const int ord = 16 * c + 8 * r + wid;
        const int code = tab[64 + 8 * r + wid];
        if (code < 0) continue;
        const int qb = code >> 8, j = code & 255; (void)ord;
        const int cnt = tab[32 + qb], idx = j * 32 + r32; const bool valid = idx < cnt;
        const int row = LISTG[(((size_t)bh * 32 + qb) * 32 + n) * 256 + (valid ? idx : cnt - 1)];
        const size_t token = (size_t)b * SEQ + qb * 256 + row;
        bf16x8 qf[4];
#pragma unroll
        for (int ks = 0; ks < 4; ++ks) qf[ks] = scale_frag(*(const bf16x8*)(P + token * DINP + C_BQ + h * 64 + ks * 16 + hi * 8), SCL2);
        const unsigned mrow = SELB[(size_t)bh * SEQ + qb * 256 + row];
        const float negm = row_negm(qf, kmax);
        f32x16 o0, o1; float l = 0.f;
#pragma unroll
        for (int q = 0; q < 16; ++q) { o0[q] = zf_(); o1[q] = o0[q]; }
#pragma unroll
        for (int s = 0; s < 4; ++s) { f32x16 p0, p1; bf16x8 pf[4];
            qk_tile(p0, p1, lds + s * STG, qf, r32, hi, negm);
            exp_pack(p0, p1, l, pf);
            pv_frag(o0, o1, lds + s * STG + KBUF, pf, lane); }
        l += shx<32>(l);
        if (valid) { unsigned char* pp = moba_part(P, token, h, __popc(mrow & ((1u << n) - 1u)));
#pragma unroll
            for (int g = 0; g < 4; ++g) { uint2 w0, w1;
                w0.x = cvtpk(o0[4 * g], o0[4 * g + 1]); w0.y = cvtpk(o0[4 * g + 2], o0[4 * g + 3]); w1.x = cvtpk(o1[4 * g], o1[4 * g + 1]); w1.y = cvtpk(o1[4 * g + 2], o1[4 * g + 3]);
                *(uint2*)(pp + (8 * g + 4 * hi) * 2) = w0; *(uint2*)(pp + (32 + 8 * g + 4 * hi) * 2) = w1; }
            if (hi == 0) *(float*)(pp + 128) = l; }
    }
    __syncthreads();
}
struct MobaOwnPol {
    int nt, nmask, stride, own, tq, hi; const bf16* Pk; const bf16* Pv;
    __device__ __forceinline__ const bf16* kptr(int i) const { return Pk + (size_t)(own * 4 + i) * 64 * DINP; }
    __device__ __forceinline__ const bf16* vptr(int i) const { return Pv + (size_t)(own * 4 + i) * 64 * DINP; }
    __device__ __forceinline__ bool rowsel(int) const { return true; }
    __device__ __forceinline__ void mask(int i, f32x16& p0, f32x16& p1) const { const int kbase = (own * 4 + i) * 64;
#pragma unroll
        for (int r = 0; r < 16; ++r) { const int k0 = kbase + crow(r, hi); p0[r] = (k0 <= tq) ? p0[r] : nbg; p1[r] = (k0 + 32 <= tq) ? p1[r] : nbg; } }
};
__device__ __forceinline__ void moba_merge_unit(bf16* __restrict__ P, const unsigned* __restrict__ SELB, float kmax, bf16* __restrict__ MIX, int b, int h, int qb, int tid, LAS unsigned char* lds) {
    asm volatile("" : "+v"(tid));
    const int lane = tid & 63, wid = __builtin_amdgcn_readfirstlane(tid >> 6), r32 = lane & 31, hi = lane >> 5, bh = b * 4 + h;
    const int tq = qb * 256 + wid * 32 + r32;
    const size_t rowq = (size_t)b * SEQ + tq;
    const bf16* Pb = P + (size_t)b * SEQ * DINP;
    bf16x8 qf[4];
#pragma unroll
    for (int ks = 0; ks < 4; ++ks) qf[ks] = scale_frag(*(const bf16x8*)(P + rowq * DINP + C_BQ + h * 64 + ks * 16 + hi * 8), SCL2);
    f32x16 o0, o1;
#pragma unroll
    for (int r = 0; r < 16; ++r) { o0[r] = zf_(); o1[r] = o0[r]; }
    float l = 0.f;
    { MobaOwnPol pol; pol.nt = 4; pol.nmask = 4; pol.stride = DINP; pol.own = qb; pol.tq = tq; pol.hi = hi; pol.Pk = Pb + C_BK + h * 64; pol.Pv = Pb + C_BV + h * 64;
      attn_pipe(pol, lds, qf, row_negm(qf, kmax), o0, o1, l, tid); }
    l += shx<32>(l);
    int t2 = tid; asm volatile("" : "+v"(t2));
    const int l2 = t2 & 63, r2 = l2 & 31, h2 = l2 >> 5, w2 = t2 >> 6;
    const size_t token = (size_t)b * SEQ + qb * 256 + w2 * 32 + r2;
    const int ns = __popc(SELB[(size_t)bh * SEQ + qb * 256 + w2 * 32 + r2]);
    {
        uint2 w0[3][4], w1[3][4]; float lp[3];
#pragma unroll
        for (int s = 0; s < 3; ++s) { const unsigned char* pp = moba_part(P, token, h, s < ns ? s : 0);
#pragma unroll
            for (int g = 0; g < 4; ++g) { w0[s][g] = *(const uint2*)(pp + (8 * g + 4 * h2) * 2); w1[s][g] = *(const uint2*)(pp + (32 + 8 * g + 4 * h2) * 2); }
            lp[s] = *(const float*)(pp + 128); }
#pragma unroll
        for (int s = 0; s < 3; ++s) { const unsigned km = s < ns ? 0xffffffffu : 0u;
#pragma unroll
            for (int g = 0; g < 4; ++g) { const unsigned ax = w0[s][g].x & km, ay = w0[s][g].y & km, bx = w1[s][g].x & km, by = w1[s][g].y & km;
                o0[4 * g] += __builtin_bit_cast(float, ax << 16); o0[4 * g + 1] += __builtin_bit_cast(float, ax & 0xffff0000u); o0[4 * g + 2] += __builtin_bit_cast(float, ay << 16); o0[4 * g + 3] += __builtin_bit_cast(float, ay & 0xffff0000u);
                o1[4 * g] += __builtin_bit_cast(float, bx << 16); o1[4 * g + 1] += __builtin_bit_cast(float, bx & 0xffff0000u); o1[4 * g + 2] += __builtin_bit_cast(float, by << 16); o1[4 * g + 3] += __builtin_bit_cast(float, by & 0xffff0000u); }
            l += s < ns ? lp[s] : 0.f; }
    }
    const float inv = rcpf_(l);
    bf16* op = MIX + token * DM + 512 + h * 64 + 4 * h2;
#pragma unroll
    for (int g = 0; g < 4; ++g) {
        uint2 w0, w1;
        w0.x = cvtpk(o0[4 * g] * inv, o0[4 * g + 1] * inv); w0.y = cvtpk(o0[4 * g + 2] * inv, o0[4 * g + 3] * inv);
        w1.x = cvtpk(o1[4 * g] * inv, o1[4 * g + 1] * inv); w1.y = cvtpk(o1[4 * g + 2] * inv, o1[4 * g + 3] * inv);
        *(uint2*)(op + 8 * g) = w0; *(uint2*)(op + 32 + 8 * g) = w1;
    }
}
constexpr int MK_ENUM_OFF = 4 * STG + 512;
__device__ __forceinline__ void moba_kv_phase(bf16* __restrict__ P, const unsigned* __restrict__ SELB, const int* __restrict__ CNTQ, const unsigned char* __restrict__ LISTG, const float* __restrict__ kgain,
                                              int bid, int G, int tid, LAS unsigned char* lds) {
    asm volatile("" : "+v"(tid));
    LAS int* nch = (LAS int*)(lds + MK_ENUM_OFF);
    const float kmax = gain_kmax(kgain, tid & 63);
    { const int bh = tid >> 5, n = tid & 31; int T = 0;
      for (int q = n + 1; q < 32; ++q) T += (CNTQ[((size_t)bh * 32 + q) * 32 + n] + 31) >> 5;
      nch[tid] = (T + 15) >> 4; }
    __syncthreads();
    if (tid < 64) {
        int v[8], s = 0;
#pragma unroll
        for (int k = 0; k < 8; ++k) { s += nch[tid * 8 + k]; v[k] = s; }
        int incl = s;
#pragma unroll
        for (int o = 1; o < 64; o <<= 1) { const int t = __shfl_up(incl, o); if (tid >= o) incl += t; }
        const int base = incl - s;
#pragma unroll
        for (int k = 0; k < 8; ++k) nch[tid * 8 + k] = v[k] + base; }
    __syncthreads();
    const int total = nch[511];
    for (int cid = bid; cid < total; cid += G) {
        int lo = 0, hi_ = 511; while (lo < hi_) { const int mid = (lo + hi_) >> 1; if (nch[mid] > cid) hi_ = mid; else lo = mid + 1; }
        const int pair = lo, c = cid - (pair ? nch[pair - 1] : 0);
        moba_kv_chunk(P, SELB, CNTQ, LISTG, kmax, pair >> 5, pair & 31, c, tid, lds);
    }
    __syncthreads();
}

constexpr int NSA_S4_OFF = PIPE_BYTES, NSA_L4_OFF = NSA_S4_OFF + 8 * 8 * 128 * 4, NSA_SM_OFF = NSA_L4_OFF + 8 * 8 * 128 * 4;
struct NsaCtx { const bf16* Pb; const bf16* Kcb; const bf16* Vcb; int b, jq, tid, lane, wid, r32, hi, tq; unsigned mk0, mk1, mk2, mk3; };

template <int MODE>
__device__ __forceinline__ void nsa_tiles(const NsaCtx& c, LAS unsigned char* lds, const bf16x8 (&qf)[4], int nt, f32x16& o0, f32x16& o1, float& m, float& l, float pre) {
    const int tid = c.tid, lane = c.lane, r32 = c.r32, hi = c.hi, tq = c.tq, jq = c.jq;
    const int nw = (jq < 8 ? jq : 8) + 1;
    auto tile_of = [&](int i) -> int { return MODE < 2 ? i : (i == 0 ? jq : (MODE == 2 ? i - 1 : jq - nw + i)); };
    auto src_of = [&](int t) -> TileSrc {
        if (MODE < 2) return TileSrc{c.Kcb + (size_t)t * 64 * 64, c.Vcb + (size_t)t * 64 * 64, 64};
        if (MODE == 2) return TileSrc{c.Pb + (size_t)t * 64 * DINP + C_NKS, c.Pb + (size_t)t * 64 * DINP + C_NVS, DINP};
        return TileSrc{c.Pb + (size_t)t * 64 * DINP + C_NKW, c.Pb + (size_t)t * 64 * DINP + C_NVW, DINP};
    };
    u32x4v kr, vr;
    { const TileSrc s = src_of(tile_of(0)); tile_load(kr, vr, s, tid); }
    tile_store(lds, kr, vr, tid);
    __syncthreads();
    const int ncv = (tq >= 31) ? ((tq - 31) >> 4) + 1 : 0;
    for (int i = 0; i < nt; ++i) {
        const int tile = tile_of(i);
        if (i + 1 < nt) { const TileSrc s = src_of(tile_of(i + 1)); tile_load(kr, vr, s, tid); }
        LAS const unsigned char* buf = lds + (i & 1) * STG;
        const int kbase = tile * 64;
        bool rowsel = true;
        if (MODE == 2 && tile != jq) { const unsigned w = (tile >> 5) == 0 ? c.mk0 : (tile >> 5) == 1 ? c.mk1 : (tile >> 5) == 2 ? c.mk2 : c.mk3; rowsel = (w >> (tile & 31)) & 1u; }
        if (MODE != 2 || __any(rowsel)) {
            f32x16 p0, p1;
            qk_tile(p0, p1, buf, qf, r32, hi, MODE < 2 ? 0.f : (rowsel ? -m : NEGBIG));
            if (MODE < 2) {
#pragma unroll
                for (int r = 0; r < 16; ++r) { const int k0 = kbase + crow(r, hi); p0[r] = (k0 < ncv) ? p0[r] : NEGBIG; p1[r] = (k0 + 32 < ncv) ? p1[r] : NEGBIG; }
            } else if (MODE == 2) {
                if (tile == jq) {
#pragma unroll
                    for (int r = 0; r < 16; ++r) { const int k0 = kbase + crow(r, hi); p0[r] = (k0 <= tq) ? p0[r] : NEGBIG; p1[r] = (k0 + 32 <= tq) ? p1[r] : NEGBIG; }
                }
            } else if (tile == jq || tile + 8 == jq) {
#pragma unroll
                for (int r = 0; r < 16; ++r) { const int k0 = kbase + crow(r, hi);
                    p0[r] = (k0 <= tq && k0 + 511 >= tq) ? p0[r] : NEGBIG; p1[r] = (k0 + 32 <= tq && k0 + 32 + 511 >= tq) ? p1[r] : NEGBIG; }
            }
            if (MODE == 0) {
                float tm = fmaxf(p0[0], p1[0]);
#pragma unroll
                for (int r = 1; r < 16; ++r) tm = fmaxf(tm, fmaxf(p0[r], p1[r]));
                tm = fmaxf(tm, shx<32>(tm));
                const float mn = fmaxf(m, tm); float s = 0.f;
#pragma unroll
                for (int r = 0; r < 16; ++r) { s += (p0[r] > -1e29f ? __builtin_amdgcn_exp2f(p0[r] - mn) : 0.f) + (p1[r] > -1e29f ? __builtin_amdgcn_exp2f(p1[r] - mn) : 0.f); }
                l = l * __builtin_amdgcn_exp2f(m - mn) + s; m = mn;
            } else if (MODE == 1) {
#pragma unroll
                for (int r = 0; r < 16; ++r) { p0[r] = (p0[r] > -1e29f) ? __builtin_amdgcn_exp2f(p0[r] - m) * pre : 0.f; p1[r] = (p1[r] > -1e29f) ? __builtin_amdgcn_exp2f(p1[r] - m) * pre : 0.f; }
                pv_tile(o0, o1, buf + KBUF, p0, p1, lane);
                LAS float* S4 = (LAS float*)(lds + NSA_S4_OFF) + (c.wid * 8 + (r32 & 7)) * 128; LAS float* L4 = (LAS float*)(lds + NSA_L4_OFF) + (c.wid * 8 + (r32 & 7)) * 128;
#pragma unroll
                for (int mbk = 0; mbk < 2; ++mbk)
#pragma unroll
                    for (int g = 0; g < 4; ++g) {
                        float s4 = mbk ? (p1[4 * g] + p1[4 * g + 1]) + (p1[4 * g + 2] + p1[4 * g + 3]) : (p0[4 * g] + p0[4 * g + 1]) + (p0[4 * g + 2] + p0[4 * g + 3]);
                        float la = mbk ? p1[4 * g + 3] : p0[4 * g + 3];
                        s4 += shx<8>(s4); s4 += shx<16>(s4); la += shx<8>(la); la += shx<16>(la);
                        const int gi = tile * 16 + 8 * mbk + 2 * g + hi;
                        if (r32 < 8) { S4[gi] = s4; L4[gi] = la; }
                    }
            } else {
                softmax_tile(p0, p1, o0, o1, m, l, i == 0);
                pv_tile(o0, o1, buf + KBUF, p0, p1, lane);
            }
        }
        if (i + 1 < nt) tile_store(lds + ((i + 1) & 1) * STG, kr, vr, tid);
        __syncthreads();
    }
}

struct NsaSelPol {
    int nt, nmask, stride, jq, tq, hi; unsigned long long mlo, mhi; const bf16* Pk; const bf16* Pv;
    __device__ __forceinline__ int tile_of(int i) const { return i == 0 ? jq : i - 1; }
    __device__ __forceinline__ const bf16* kptr(int i) const { return Pk + (size_t)tile_of(i) * 64 * DINP; }
    __device__ __forceinline__ const bf16* vptr(int i) const { return Pv + (size_t)tile_of(i) * 64 * DINP; }
    __device__ __forceinline__ bool rowsel(int i) const { if (i == 0) return true; const int tile = i - 1; const unsigned long long w = tile < 64 ? mlo : mhi; return (w >> (tile & 63)) & 1ull; }
    __device__ __forceinline__ void mask(int i, f32x16& p0, f32x16& p1) const {
        if (i == 0) { const int kbase = jq * 64;
#pragma unroll
            for (int r = 0; r < 16; ++r) { const int k0 = kbase + crow(r, hi); p0[r] = (k0 <= tq) ? p0[r] : NEGBIG; p1[r] = (k0 + 32 <= tq) ? p1[r] : NEGBIG; } }
    }
};
struct NsaWinPol {
    int nt, nmask, stride, jq, tq, hi; const bf16* Pk; const bf16* Pv;
    __device__ __forceinline__ int tile_of(int i) const { return i == 0 ? jq : jq - nt + i; }
    __device__ __forceinline__ const bf16* kptr(int i) const { return Pk + (size_t)tile_of(i) * 64 * DINP; }
    __device__ __forceinline__ const bf16* vptr(int i) const { return Pv + (size_t)tile_of(i) * 64 * DINP; }
    __device__ __forceinline__ bool rowsel(int) const { return true; }
    __device__ __forceinline__ void mask(int i, f32x16& p0, f32x16& p1) const {
        const int tile = tile_of(i);
        if (tile == jq || tile + 8 == jq) { const int kbase = tile * 64;
#pragma unroll
            for (int r = 0; r < 16; ++r) { const int k0 = kbase + crow(r, hi);
                p0[r] = (k0 <= tq && k0 + 511 >= tq) ? p0[r] : NEGBIG; p1[r] = (k0 + 32 <= tq && k0 + 32 + 511 >= tq) ? p1[r] : NEGBIG; } }
    }
};
__device__ __forceinline__ void nsa_unit(const bf16* __restrict__ P, const float* __restrict__ G, const float* __restrict__ tab, const bf16* __restrict__ KVcb, const float* __restrict__ kgain  , bf16* __restrict__ MIX,
                                         int b, int jq, int tid, LAS unsigned char* lds) {
    asm volatile("" : "+v"(tid));
    NsaCtx c; c.b = b; c.jq = jq; c.tid = tid; c.lane = tid & 63; c.wid = __builtin_amdgcn_readfirstlane(tid >> 6); c.r32 = c.lane & 31; c.hi = c.lane >> 5;
    const int qi = c.r32 & 7, hh = c.r32 >> 3, hi = c.hi, lane = c.lane;
    c.tq = jq * 64 + c.wid * 8 + qi;
    c.Pb = P + (size_t)b * SEQ * DINP; c.Kcb = KVcb + (size_t)b * 512 * 64; c.Vcb = KVcb + ((size_t)NB + b) * 512 * 64;
    c.mk0 = c.mk1 = c.mk2 = c.mk3 = 0u;
    const size_t rowq = (size_t)b * SEQ + c.tq;
    bf16x8 qf[4];
#pragma unroll
    for (int ks = 0; ks < 4; ++ks) qf[ks] = scale_frag(*(const bf16x8*)(P + rowq * DINP + C_NQ + hh * 64 + ks * 16 + hi * 8), SCL2);
    const float g0 = sigmoidf_(G[rowq * 32 + 8 + hh]);
    { LAS float* gl = (LAS float*)(lds + NSA_SM_OFF + 1024); gl[tid] = sigmoidf_(G[rowq * 32 + 12 + hh]); gl[512 + tid] = sigmoidf_(G[rowq * 32 + 16 + hh]); }
    f32x16 a0, a1;
    {
        const int ncvmax = min(4 * jq + 3, NCMP), nct = (ncvmax + 63) >> 6;
        f32x16 o0, o1;
#pragma unroll
        for (int r = 0; r < 16; ++r) { o0[r] = zf_(); o1[r] = o0[r]; }
        float m = NEGBIG, l = 0.f;
#ifdef PROBE_CMP
        { f32x16 t0 = o0, t1 = o1; float tm = m, tl = l; nsa_tiles<0>(c, lds, qf, nct, t0, t1, tm, tl, 0.f); tl += shx<32>(tl); nsa_tiles<1>(c, lds, qf, nct, t0, t1, tm, tl, tl > 0.f ? rcpf_(tl) : 0.f); asm volatile("" :: "v"(t0), "v"(t1)); }
#endif
        nsa_tiles<0>(c, lds, qf, nct, o0, o1, m, l, 0.f);
        l += shx<32>(l);
        const float pre = (l > 0.f) ? rcpf_(l) : 0.f;
        nsa_tiles<1>(c, lds, qf, nct, o0, o1, m, l, pre);
#pragma unroll
        for (int r = 0; r < 16; ++r) { a0[r] = g0 * o0[r]; a1[r] = g0 * o1[r]; }
    }
    {
        LAS unsigned* sm = (LAS unsigned*)(lds + NSA_SM_OFF);
        for (int q = 0; q < 8; ++q) {
            LAS const float* S4 = (LAS const float*)(lds + NSA_S4_OFF) + (c.wid * 8 + q) * 128; LAS const float* L4 = (LAS const float*)(lds + NSA_L4_OFF) + (c.wid * 8 + q) * 128;
            float v0, v1;
            { const int n = lane; const bool causal = n <= jq, forced = causal && (n == 0 || n >= jq - 1);
              float im = 0.f; if (causal) { im = S4[n]; if (n > 0) im += L4[n - 1]; }
              v0 = forced ? 1e9f : (causal ? im : -1e30f); }
            { const int n = lane + 64; const bool causal = n <= jq, forced = causal && (n >= jq - 1);
              float im = 0.f; if (causal) { im = S4[n] + L4[n - 1]; }
              v1 = forced ? 1e9f : (causal ? im : -1e30f); }
            const unsigned b0_ = __float_as_uint(v0), b1_ = __float_as_uint(v1);
            const unsigned u0 = b0_ ^ ((b0_ >> 31) ? 0xFFFFFFFFu : 0x80000000u), u1 = b1_ ^ ((b1_ >> 31) ? 0xFFFFFFFFu : 0x80000000u);
            unsigned T = 0u;
#pragma unroll
            for (int bit = 31; bit >= 0; --bit) { const unsigned cand = T | (1u << bit);
                const int cn = __popcll(__ballot(u0 >= cand)) + __popcll(__ballot(u1 >= cand));
                if (cn >= 16) T = cand; }
            const unsigned long long g0b = __ballot(u0 > T), g1b = __ballot(u1 > T), e0b = __ballot(u0 == T), e1b = __ballot(u1 == T);
            const int rem = 16 - (__popcll(g0b) + __popcll(g1b));
            const unsigned long long ltm = (1ull << lane) - 1ull;
            const unsigned long long sel0 = g0b | __ballot(u0 == T && __popcll(e0b & ltm) < rem);
            const unsigned long long sel1 = g1b | __ballot(u1 == T && __popcll(e0b) + __popcll(e1b & ltm) < rem);
            if (lane == 0) { sm[(c.wid * 8 + q) * 4 + 0] = (unsigned)sel0; sm[(c.wid * 8 + q) * 4 + 1] = (unsigned)(sel0 >> 32); sm[(c.wid * 8 + q) * 4 + 2] = (unsigned)sel1; sm[(c.wid * 8 + q) * 4 + 3] = (unsigned)(sel1 >> 32); }
        }
        __builtin_amdgcn_s_waitcnt(0xc07f); __builtin_amdgcn_wave_barrier();
        c.mk0 = sm[(c.wid * 8 + qi) * 4 + 0]; c.mk1 = sm[(c.wid * 8 + qi) * 4 + 1]; c.mk2 = sm[(c.wid * 8 + qi) * 4 + 2]; c.mk3 = sm[(c.wid * 8 + qi) * 4 + 3];
    }
    LAS float* stash = (LAS float*)(lds + NSA_S4_OFF) + c.wid * 1024 + lane;
    LAS float* stash2 = (LAS float*)(lds + NSA_L4_OFF) + c.wid * 1024 + lane;
#pragma unroll
    for (int r = 0; r < 16; ++r) { stash[r * 64] = a0[r]; stash2[r * 64] = a1[r]; }
    {
        const u32x4v qw = __builtin_bit_cast(u32x4v, qf[0]); u32x4v w;
#pragma unroll
        for (int e = 0; e < 4; ++e) {
            float y[2];
#pragma unroll
            for (int k = 0; k < 2; ++k) { const int j = 2 * e + k; const float x = k ? __builtin_bit_cast(float, qw[e] & 0xffff0000u) : __builtin_bit_cast(float, qw[e] << 16); const float other = shx<32>(x);
                const float cs = tab[c.tq * 16 + j], sn = tab[c.tq * 16 + 8 + j]; y[k] = hi ? (x * cs + other * sn) : (x * cs - other * sn); }
            w[e] = cvtpk(y[0], y[1]);
        }
        qf[0] = __builtin_bit_cast(bf16x8, w);
    }
    {
        f32x16 o0, o1;
#pragma unroll
        for (int r = 0; r < 16; ++r) { o0[r] = zf_(); o1[r] = o0[r]; }
        float l = 0.f;
        NsaSelPol pol; pol.nt = jq + 1; pol.nmask = 1; pol.stride = DINP; pol.jq = jq; pol.tq = c.tq; pol.hi = hi; pol.mlo = (unsigned long long)c.mk0 | ((unsigned long long)c.mk1 << 32); pol.mhi = (unsigned long long)c.mk2 | ((unsigned long long)c.mk3 << 32); pol.Pk = c.Pb + C_NKS; pol.Pv = c.Pb + C_NVS;
#ifdef PROBE_SEL
        { attn_pipe(pol, lds, qf, row_negm(qf, gain_kmax(kgain + 64, lane)), o0, o1, l, tid); asm volatile("" : "+v"(o0), "+v"(o1), "+v"(l));
#pragma unroll
          for (int r = 0; r < 16; ++r) { o0[r] = zf_(); o1[r] = o0[r]; } l = zf_(); }
#endif
        attn_pipe(pol, lds, qf, row_negm(qf, gain_kmax(kgain + 64, lane)), o0, o1, l, tid);
        l += shx<32>(l);
        int t2 = tid; asm volatile("" : "+v"(t2));
        const float sc = ((LAS const float*)(lds + NSA_SM_OFF + 1024))[t2] * rcpf_(l);
        LAS float* st1 = (LAS float*)(lds + NSA_S4_OFF) + (t2 >> 6) * 1024 + (t2 & 63); LAS float* st2 = (LAS float*)(lds + NSA_L4_OFF) + (t2 >> 6) * 1024 + (t2 & 63);
#pragma unroll
        for (int r = 0; r < 16; ++r) { st1[r * 64] = fmaf(sc, o0[r], st1[r * 64]); st2[r * 64] = fmaf(sc, o1[r], st2[r * 64]); }
    }
    {
        f32x16 o0, o1;
#pragma unroll
        for (int r = 0; r < 16; ++r) { o0[r] = zf_(); o1[r] = o0[r]; }
        float l = 0.f;
        NsaWinPol pol; pol.nt = (jq < 8 ? jq : 8) + 1; pol.nmask = 2; pol.stride = DINP; pol.jq = jq; pol.tq = c.tq; pol.hi = hi; pol.Pk = c.Pb + C_NKW; pol.Pv = c.Pb + C_NVW;
#ifdef PROBE_WIN
        { attn_pipe(pol, lds, qf, row_negm(qf, gain_kmax(kgain + 128, lane)), o0, o1, l, tid); asm volatile("" : "+v"(o0), "+v"(o1), "+v"(l));
#pragma unroll
          for (int r = 0; r < 16; ++r) { o0[r] = zf_(); o1[r] = o0[r]; } l = zf_(); }
#endif
        attn_pipe(pol, lds, qf, row_negm(qf, gain_kmax(kgain + 128, lane)), o0, o1, l, tid);
        l += shx<32>(l);
        int t2 = tid; asm volatile("" : "+v"(t2));
        const float sc = ((LAS const float*)(lds + NSA_SM_OFF + 1024))[512 + t2] * rcpf_(l);
        LAS const float* st1 = (LAS const float*)(lds + NSA_S4_OFF) + (t2 >> 6) * 1024 + (t2 & 63); LAS const float* st2 = (LAS const float*)(lds + NSA_L4_OFF) + (t2 >> 6) * 1024 + (t2 & 63);
#pragma unroll
        for (int r = 0; r < 16; ++r) { a0[r] = fmaf(sc, o0[r], st1[r * 64]); a1[r] = fmaf(sc, o1[r], st2[r * 64]); }
    }
    int t3 = tid; asm volatile("" : "+v"(t3));
    const int ln3 = t3 & 63, r3 = ln3 & 31;
    bf16* op = MIX + ((size_t)b * SEQ + jq * 64 + (t3 >> 6) * 8 + (r3 & 7)) * DM + 768 + (r3 >> 3) * 64 + 4 * (ln3 >> 5);
#pragma unroll
    for (int g = 0; g < 4; ++g) {
        uint2 w0, w1;
        w0.x = cvtpk(a0[4 * g], a0[4 * g + 1]); w0.y = cvtpk(a0[4 * g + 2], a0[4 * g + 3]);
        w1.x = cvtpk(a1[4 * g], a1[4 * g + 1]); w1.y = cvtpk(a1[4 * g + 2], a1[4 * g + 3]);
        *(uint2*)(op + 8 * g) = w0; *(uint2*)(op + 32 + 8 * g) = w1;
    }
}


constexpr int MQ_PITCH = 272, MV_PITCH = 320;
constexpr int ML_G_OFF = 0;
constexpr int ML_Q_OFF = 4096;
constexpr int ML_K_OFF = ML_Q_OFF + 64 * MQ_PITCH;
constexpr int ML_V_OFF = ML_K_OFF + 64 * MV_PITCH;
constexpr int ML_END = ML_V_OFF + 64 * MV_PITCH;
static_assert(ML_END <= 131072, "mlstm LDS");
constexpr float KSCALE = 0.08838834764831845f;

__device__ __forceinline__ void qk2_rows(const bf16* __restrict__ P, const float* __restrict__ cw, bf16* __restrict__ QK2, int bid, int G, int tid) {
    asm volatile("" : "+v"(tid));
    const int ch = tid & 127, c0 = ch * 8;
    float tp[4][8];
#pragma unroll
    for (int j = 0; j < 4; ++j) { const float4 a = *(const float4*)(cw + j * 1024 + c0), b4 = *(const float4*)(cw + j * 1024 + c0 + 4);
        tp[j][0] = a.x; tp[j][1] = a.y; tp[j][2] = a.z; tp[j][3] = a.w; tp[j][4] = b4.x; tp[j][5] = b4.y; tp[j][6] = b4.z; tp[j][7] = b4.w; }
    const float sc = (c0 >= 512) ? KSCALE : 1.f;
    for (int row0 = bid * 4 + (tid >> 7); row0 < T; row0 += G * 16) {
        u32x4v w[4][4];
#pragma unroll
        for (int q = 0; q < 4; ++q) { const int row = row0 + q * G * 4, t = row & (SEQ - 1);
#pragma unroll
            for (int j = 0; j < 4; ++j) { w[q][j] = u32x4v{0u, 0u, 0u, 0u}; if (row < T && t - 3 + j >= 0) w[q][j] = *(const u32x4v*)(P + (size_t)(row - 3 + j) * DINP + c0); } }
#pragma unroll
        for (int q = 0; q < 4; ++q) { const int row = row0 + q * G * 4;
            float y[8];
#pragma unroll
            for (int e = 0; e < 8; ++e) y[e] = 0.f;
#pragma unroll
            for (int j = 0; j < 4; ++j)
#pragma unroll
                for (int e = 0; e < 4; ++e) { y[2 * e] = fmaf(tp[j][2 * e], __builtin_bit_cast(float, w[q][j][e] << 16), y[2 * e]); y[2 * e + 1] = fmaf(tp[j][2 * e + 1], __builtin_bit_cast(float, w[q][j][e] & 0xffff0000u), y[2 * e + 1]); }
#pragma unroll
            for (int e = 0; e < 8; ++e) y[e] = y[e] * rcpf_(1.f + __expf(-y[e])) * sc;
            u32x4v o; o[0] = cvtpk(y[0], y[1]); o[1] = cvtpk(y[2], y[3]); o[2] = cvtpk(y[4], y[5]); o[3] = cvtpk(y[6], y[7]);
            if (row < T) *(u32x4v*)(QK2 + (size_t)row * 1024 + c0) = o; }
    }
}

struct MlRaw { u32x4v q[2], k[2], v[2]; float gf, gi; };
template <bool WITH_Q> __device__ __forceinline__ void ml_load(MlRaw& r, const bf16* __restrict__ P, const bf16* __restrict__ QK2, const float* __restrict__ G, const float* __restrict__ bif, int u, int tid) {
    const int c = u & 127, h = (u >> 7) & 3, b = u >> 9, row0 = b * SEQ + c * 64, s = tid >> 3;
#pragma unroll
    for (int pass = 0; pass < 2; ++pass) { const int ch = (tid & 7) + 8 * pass;
        if (WITH_Q) r.q[pass] = *(const u32x4v*)(QK2 + (size_t)(row0 + s) * 1024 + h * 128 + ch * 8);
        r.k[pass] = *(const u32x4v*)(QK2 + (size_t)(row0 + s) * 1024 + 512 + h * 128 + ch * 8);
        r.v[pass] = *(const u32x4v*)(P + (size_t)(row0 + s) * DINP + C_MV + h * 128 + ch * 8); }
    if (tid < 64) { r.gf = G[(size_t)(row0 + tid) * 32 + 4 + h] + bif[4 + h]; r.gi = G[(size_t)(row0 + tid) * 32 + h] + bif[h]; }
}
__device__ __forceinline__ void mlstm_gates(const MlRaw& r, int tid, LAS float* gs) {
    if (tid < 64) { gs[tid] = log_sigmoidf_(r.gf); gs[128 + tid] = r.gi; }
    __syncthreads();
    if (tid < 64) { float a = 0.f; for (int s = 0; s <= tid; ++s) a += gs[s]; gs[64 + tid] = a; }
    __syncthreads();
}

__device__ __forceinline__ void mlstm_m1_phase(const bf16* __restrict__ P, const bf16* __restrict__ QK2, const float* __restrict__ G, const float* __restrict__ bif,
                                               bf16* __restrict__ CT, float* __restrict__ nst, float* __restrict__ dec, int bid, int Gd, int tid, LAS unsigned char* lds) {
    asm volatile("" : "+v"(tid));
    const int lane = tid & 63, wid = __builtin_amdgcn_readfirstlane(tid >> 6), hi = lane >> 5;
    LAS float* gs = (LAS float*)(lds + ML_G_OFF);
    MlRaw raw;
    if (bid < 2048) ml_load<false>(raw, P, QK2, G, bif, bid, tid);
    for (int u = bid; u < 2048; u += Gd) {
        mlstm_gates(raw, tid, gs);
        if (tid == 0) dec[u] = __expf(gs[64 + 63]);
        {
            const int s = tid >> 3; const float ws = __expf(gs[64 + 63] - gs[64 + s] + gs[128 + s]);
#pragma unroll
            for (int pass = 0; pass < 2; ++pass) { const int ch = (tid & 7) + 8 * pass; u32x4v w;
#pragma unroll
                for (int e = 0; e < 4; ++e) w[e] = cvtpk(__builtin_bit_cast(float, raw.k[pass][e] << 16) * ws, __builtin_bit_cast(float, raw.k[pass][e] & 0xffff0000u) * ws);
                *(LAS u32x4v*)(lds + ML_K_OFF + s * MV_PITCH + ch * 16) = w;
                *(LAS u32x4v*)(lds + ML_V_OFF + s * MV_PITCH + ch * 16) = raw.v[pass]; }
        }
        if (u + Gd < 2048) ml_load<false>(raw, P, QK2, G, bif, u + Gd, tid);
        __syncthreads();
        const int g = lane >> 4, i = lane & 15;
        const int mb = wid >> 1, nb0 = 2 * (wid & 1);
        f32x16 acc0, acc1;
#pragma unroll
        for (int r = 0; r < 16; ++r) { acc0[r] = zf_(); acc1[r] = acc0[r]; }
        LAS const unsigned char* trb = lds + (4 * hi + (i >> 2)) * MV_PITCH + (16 * (g & 1) + 4 * (i & 3)) * 2;
#pragma unroll
        for (int ks = 0; ks < 4; ++ks) {
            const s16x4 alo = lds_tr(trb + ML_K_OFF + ks * 16 * MV_PITCH + mb * 64), ahi = lds_tr(trb + ML_K_OFF + ks * 16 * MV_PITCH + 8 * MV_PITCH + mb * 64);
            const bf16x8 af = {alo[0], alo[1], alo[2], alo[3], ahi[0], ahi[1], ahi[2], ahi[3]};
            const s16x4 b0lo = lds_tr(trb + ML_V_OFF + ks * 16 * MV_PITCH + nb0 * 64), b0hi = lds_tr(trb + ML_V_OFF + ks * 16 * MV_PITCH + 8 * MV_PITCH + nb0 * 64);
            const s16x4 b1lo = lds_tr(trb + ML_V_OFF + ks * 16 * MV_PITCH + (nb0 + 1) * 64), b1hi = lds_tr(trb + ML_V_OFF + ks * 16 * MV_PITCH + 8 * MV_PITCH + (nb0 + 1) * 64);
            const bf16x8 bf0 = {b0lo[0], b0lo[1], b0lo[2], b0lo[3], b0hi[0], b0hi[1], b0hi[2], b0hi[3]}, bf1 = {b1lo[0], b1lo[1], b1lo[2], b1lo[3], b1hi[0], b1hi[1], b1hi[2], b1hi[3]};
            acc0 = __builtin_amdgcn_mfma_f32_32x32x16_bf16(af, bf0, acc0, 0, 0, 0);
            acc1 = __builtin_amdgcn_mfma_f32_32x32x16_bf16(af, bf1, acc1, 0, 0, 0);
        }
        bf16* ct = CT + (size_t)u * 16384;
#pragma unroll
        for (int gq = 0; gq < 4; ++gq) { const int d0 = 32 * mb + 8 * gq + 4 * hi;
            uint2 w0, w1; w0.x = cvtpk(acc0[4 * gq], acc0[4 * gq + 1]); w0.y = cvtpk(acc0[4 * gq + 2], acc0[4 * gq + 3]); w1.x = cvtpk(acc1[4 * gq], acc1[4 * gq + 1]); w1.y = cvtpk(acc1[4 * gq + 2], acc1[4 * gq + 3]);
            *(uint2*)(ct + (size_t)(32 * nb0 + (lane & 31)) * 128 + d0) = w0; *(uint2*)(ct + (size_t)(32 * (nb0 + 1) + (lane & 31)) * 128 + d0) = w1; }
        if (tid < 128) { float a = 0.f; for (int s = 0; s < 64; ++s) a += bf2f(*(LAS const bf16*)(lds + ML_K_OFF + s * MV_PITCH + tid * 2)); nst[(size_t)u * 128 + tid] = a; }
        __syncthreads();
    }
}
__device__ __forceinline__ void mlstm_scan(bf16* __restrict__ CT, float* __restrict__ nst, const float* __restrict__ dec, int item, int tid) {
    asm volatile("" : "+v"(tid));
    const int bh = item / 9, part = item % 9;
    if (part < 8) {
        bf16* base = CT + (size_t)bh * 128 * 16384 + (part * 512 + tid) * 4;
        float C[4]; C[0] = zf_(); C[1] = C[0]; C[2] = C[0]; C[3] = C[0];
        for (int c0 = 0; c0 < 128; c0 += 16) {
            uint2 w[16];
#pragma unroll
            for (int k = 0; k < 16; ++k) w[k] = *(const uint2*)(base + (size_t)(c0 + k) * 16384);
#pragma unroll
            for (int k = 0; k < 16; ++k) { const float a = dec[bh * 128 + c0 + k];
                uint2 o; o.x = cvtpk(C[0], C[1]); o.y = cvtpk(C[2], C[3]); *(uint2*)(base + (size_t)(c0 + k) * 16384) = o;
                C[0] = fmaf(a, C[0], __builtin_bit_cast(float, w[k].x << 16)); C[1] = fmaf(a, C[1], __builtin_bit_cast(float, w[k].x & 0xffff0000u));
                C[2] = fmaf(a, C[2], __builtin_bit_cast(float, w[k].y << 16)); C[3] = fmaf(a, C[3], __builtin_bit_cast(float, w[k].y & 0xffff0000u)); }
        }
    } else if (tid < 128) {
        float* base = nst + (size_t)bh * 128 * 128 + tid; float C = 0.f;
        for (int c = 0; c < 128; ++c) { const float dC = base[(size_t)c * 128]; base[(size_t)c * 128] = C; C = dec[bh * 128 + c] * C + dC; }
    }
}

__device__ __forceinline__ void mlstm_m3_phase(const bf16* __restrict__ P, const bf16* __restrict__ QK2, const float* __restrict__ G, const float* __restrict__ bif,
                                               const bf16* __restrict__ CT, const float* __restrict__ nst, const float* __restrict__ mnorm, bf16* __restrict__ MIX, int bid, int Gd, int tid, LAS unsigned char* lds) {
    asm volatile("" : "+v"(tid));
    const int lane = tid & 63, wid = __builtin_amdgcn_readfirstlane(tid >> 6), hi = lane >> 5, r32 = lane & 31;
    LAS float* gs = (LAS float*)(lds + ML_G_OFF);
    MlRaw raw;
    if (bid < 2048) ml_load<true>(raw, P, QK2, G, bif, bid, tid);
    for (int u = bid; u < 2048; u += Gd) {
    const int c = u & 127, h = (u >> 7) & 3, b = u >> 9, t0 = c * 64;
    const int tb = wid & 1, eb = wid >> 1, t = 32 * tb + r32;
    bf16x8 cf[8]; uint2 opre[4]; float npv = 0.f;
    { const bf16* ctp = CT + (size_t)u * 16384 + (size_t)(32 * eb + r32) * 128 + hi * 8;
#pragma unroll
      for (int ks = 0; ks < 8; ++ks) cf[ks] = *(const bf16x8*)(ctp + ks * 16);
      const size_t row_ = (size_t)b * SEQ + t0 + t;
#pragma unroll
      for (int gq = 0; gq < 4; ++gq) opre[gq] = *(const uint2*)(P + row_ * DINP + C_MO + h * 128 + 32 * eb + 8 * gq + 4 * hi);
      if (tid >= 128 && tid < 256) npv = nst[(size_t)u * 128 + tid - 128]; }
    if (tid >= 128 && tid < 256) gs[256 + tid - 128] = npv;
    mlstm_gates(raw, tid, gs);
    {
        const int s = tid >> 3;
#pragma unroll
        for (int pass = 0; pass < 2; ++pass) { const int ch = (tid & 7) + 8 * pass;
            *(LAS u32x4v*)(lds + ML_Q_OFF + s * MQ_PITCH + ch * 16) = raw.q[pass];
            *(LAS u32x4v*)(lds + ML_K_OFF + s * MQ_PITCH + ch * 16) = raw.k[pass];
            *(LAS u32x4v*)(lds + ML_V_OFF + s * MV_PITCH + ch * 16) = raw.v[pass]; }
    }
    if (u + Gd < 2048) ml_load<true>(raw, P, QK2, G, bif, u + Gd, tid);
    __syncthreads();
    bf16x8 qf[8];
#pragma unroll
    for (int ks = 0; ks < 8; ++ks) qf[ks] = *(LAS const bf16x8*)(lds + ML_Q_OFF + t * MQ_PITCH + ks * 32 + hi * 16);
    f32x16 ni;
#pragma unroll
    for (int r = 0; r < 16; ++r) ni[r] = zf_();
#pragma unroll
    for (int ks = 0; ks < 8; ++ks) ni = __builtin_amdgcn_mfma_f32_32x32x16_bf16(cf[ks], qf[ks], ni, 0, 0, 0);
    f32x16 p0, p1;
#pragma unroll
    for (int r = 0; r < 16; ++r) { p0[r] = zf_(); p1[r] = p0[r]; }
    { LAS const unsigned char* ka = lds + ML_K_OFF + r32 * MQ_PITCH + hi * 16;
#pragma unroll
      for (int ks = 0; ks < 8; ++ks) { const bf16x8 a0 = *(LAS const bf16x8*)(ka + ks * 32); p0 = __builtin_amdgcn_mfma_f32_32x32x16_bf16(a0, qf[ks], p0, 0, 0, 0); }
      if (tb == 1) {
#pragma unroll
          for (int ks = 0; ks < 8; ++ks) { const bf16x8 a1 = *(LAS const bf16x8*)(ka + 32 * MQ_PITCH + ks * 32); p1 = __builtin_amdgcn_mfma_f32_32x32x16_bf16(a1, qf[ks], p1, 0, 0, 0); } } }
    const float bt = gs[64 + t], Ft = __expf(bt);
    float dsum = 0.f;
#pragma unroll
    for (int r = 0; r < 16; ++r) { const int s0 = crow(r, hi);
        { const float w = (s0 <= t) ? __expf(bt - gs[64 + s0] + gs[128 + s0]) : 0.f; p0[r] *= w; dsum += p0[r]; }
        { const int s1 = s0 + 32; const float w = (s1 <= t) ? __expf(bt - gs[64 + s1] + gs[128 + s1]) : 0.f; p1[r] *= w; dsum += p1[r]; } }
    float qn = 0.f;
#pragma unroll
    for (int ks = 0; ks < 8; ++ks)
#pragma unroll
        for (int j = 0; j < 8; ++j) qn = fmaf(bf2f((bf16)qf[ks][j]), gs[256 + ks * 16 + hi * 8 + j], qn);
    dsum += shx<32>(dsum); qn += shx<32>(qn);
    const float den = dsum + Ft * qn, inv = rcpf_(fmaxf(fabsf(den), 1.f));
    f32x16 na;
#pragma unroll
    for (int r = 0; r < 16; ++r) na[r] = zf_();
    { const int g = lane >> 4, i = lane & 15;
      LAS const unsigned char* trb = lds + ML_V_OFF + (4 * hi + (i >> 2)) * MV_PITCH + (16 * (g & 1) + 4 * (i & 3)) * 2 + eb * 64;
#pragma unroll
      for (int ss = 0; ss < 4; ++ss) { if (ss >= 2 && tb == 0) break;
          unsigned w[4];
#pragma unroll
          for (int e = 0; e < 4; ++e) { const int r = 8 * (ss & 1) + 2 * e; w[e] = (ss < 2) ? cvtpk(p0[r], p0[r + 1]) : cvtpk(p1[r], p1[r + 1]); }
          const u32x4v wv = {w[0], w[1], w[2], w[3]}; const bf16x8 pf = __builtin_bit_cast(bf16x8, wv);
          const s16x4 lo = lds_tr(trb + ss * 16 * MV_PITCH), hi4 = lds_tr(trb + ss * 16 * MV_PITCH + 8 * MV_PITCH);
          const bf16x8 vt = {lo[0], lo[1], lo[2], lo[3], hi4[0], hi4[1], hi4[2], hi4[3]};
          na = __builtin_amdgcn_mfma_f32_32x32x16_bf16(vt, pf, na, 0, 0, 0); } }
    float ssq = 0.f;
#pragma unroll
    for (int r = 0; r < 16; ++r) { na[r] = (na[r] + Ft * ni[r]) * inv; ssq += na[r] * na[r]; }
    ssq += shx<32>(ssq);
    if (hi == 0) gs[384 + eb * 64 + t] = ssq;
    __syncthreads();
    const float rstd = rsqrtf((gs[384 + t] + gs[384 + 64 + t] + gs[384 + 128 + t] + gs[384 + 192 + t]) * (1.f / 128.f) + EPS);
    const size_t row = (size_t)b * SEQ + t0 + t;
#pragma unroll
    for (int gq = 0; gq < 4; ++gq) { const int cc = h * 128 + 32 * eb + 8 * gq + 4 * hi;
        const uint2 ow = opre[gq]; const float4 mn = *(const float4*)(mnorm + cc);
        const float o0 = sigmoidf_(__builtin_bit_cast(float, ow.x << 16)), o1 = sigmoidf_(__builtin_bit_cast(float, ow.x & 0xffff0000u)), o2 = sigmoidf_(__builtin_bit_cast(float, ow.y << 16)), o3 = sigmoidf_(__builtin_bit_cast(float, ow.y & 0xffff0000u));
        uint2 w; w.x = cvtpk(na[4 * gq] * rstd * mn.x * o0, na[4 * gq + 1] * rstd * mn.y * o1); w.y = cvtpk(na[4 * gq + 2] * rstd * mn.z * o2, na[4 * gq + 3] * rstd * mn.w * o3);
        *(uint2*)(MIX + row * DM + cc) = w; }
    __syncthreads();
    }
}


typedef float f32x4v __attribute__((ext_vector_type(4)));
typedef float f32x2v __attribute__((ext_vector_type(2)));
constexpr int CI_W2_OFF = 8 * 16 * 132 * 4, CI_HS_OFF = CI_W2_OFF + 128 * 64 * 4;
static_assert(CI_HS_OFF + 16 * 128 * 4 <= 131072, "compress LDS");
__device__ __forceinline__ void compress_item(const bf16* __restrict__ P, const bf16* __restrict__ w1t  , const float* __restrict__ c1  , const float* __restrict__ w2  ,
                                              const float* __restrict__ kg0, bf16* __restrict__ KVcb, int item, int tid, LAS unsigned char* lds) {
    asm volatile("" : "+v"(tid));
    const int lane = tid & 63, wid = __builtin_amdgcn_readfirstlane(tid >> 6), r16 = lane & 15, g = lane >> 4;
    const int kv = item >> 7, b = (item >> 5) & 3, i0 = (item & 31) * 16;
    const int irow = min(i0 + r16, NCMP - 1);
    const bf16* xa = P + ((size_t)b * SEQ + 16 * irow + 4 * wid) * DINP + (kv ? C_NVC : C_NKC) + g * 8;
    const bf16* wb = w1t + ((size_t)kv * 128 + r16) * 2048 + wid * 256 + g * 8;
    pg8::f32x4 acc[8];
#pragma unroll
    for (int cb = 0; cb < 8; ++cb) { acc[cb][0] = zf_(); acc[cb][1] = acc[cb][0]; acc[cb][2] = acc[cb][0]; acc[cb][3] = acc[cb][0]; }
    bf16x8 af[2][2], bfr[2][16];
#define CI_LOAD(sp, bu) do { _Pragma("unroll") for (int e = 0; e < 2; ++e) { af[bu][e] = *(const bf16x8*)(xa + (size_t)(sp) * DINP + 32 * e); \
        _Pragma("unroll") for (int cb = 0; cb < 8; ++cb) bfr[bu][cb * 2 + e] = *(const bf16x8*)(wb + (size_t)cb * 16 * 2048 + 64 * (sp) + 32 * e); } } while (0)
    CI_LOAD(0, 0);
    f32x4v w2r[4];
    { const f32x4v* w2g = (const f32x4v*)(w2 + (size_t)kv * 128 * 64);
#pragma unroll
      for (int q = 0; q < 4; ++q) w2r[q] = w2g[tid + 512 * q]; }
#pragma unroll
    for (int sp = 0; sp < 4; ++sp) {
        if (sp + 1 < 4) { if (sp & 1) CI_LOAD(sp + 1, 0); else CI_LOAD(sp + 1, 1); }
#pragma unroll
        for (int e = 0; e < 2; ++e)
#pragma unroll
            for (int cb = 0; cb < 8; ++cb) acc[cb] = __builtin_amdgcn_mfma_f32_16x16x32_bf16(af[sp & 1][e], bfr[sp & 1][cb * 2 + e], acc[cb], 0, 0, 0);
    }
#undef CI_LOAD
    LAS float* part = (LAS float*)lds;
#pragma unroll
    for (int cb = 0; cb < 8; ++cb)
#pragma unroll
        for (int i = 0; i < 4; ++i) part[(wid * 16 + 4 * g + i) * 132 + 16 * cb + r16] = acc[cb][i];
    { LAS f32x4v* w2s = (LAS f32x4v*)(lds + CI_W2_OFF);
#pragma unroll
      for (int q = 0; q < 4; ++q) w2s[tid + 512 * q] = w2r[q]; }
    __syncthreads();
    const int il = tid >> 5;
    {
        const int j4 = (tid & 31) * 4;
        f32x4v a = *(const f32x4v*)(c1 + kv * 128 + j4);
#pragma unroll
        for (int w = 0; w < 8; ++w) a += *(LAS const f32x4v*)(part + (w * 16 + il) * 132 + j4);
#pragma unroll
        for (int e = 0; e < 4; ++e) a[e] = a[e] * rcpf_(1.f + __expf(-a[e]));
        *(LAS f32x4v*)(lds + CI_HS_OFF + (il * 128 + j4) * 4) = a;
    }
    __syncthreads();
    {
        const int d0 = (tid & 31) * 2;
        float o0 = 0.f, o1 = 0.f;
        LAS const float* hs = (LAS const float*)(lds + CI_HS_OFF) + il * 128;
        LAS const float* wp = (LAS const float*)(lds + CI_W2_OFF) + d0;
#pragma unroll 8
        for (int j = 0; j < 128; j += 4) { const f32x4v hv = *(LAS const f32x4v*)(hs + j);
#pragma unroll
            for (int e = 0; e < 4; ++e) { const f32x2v wa = *(LAS const f32x2v*)(wp + (j + e) * 64); o0 = fmaf(hv[e], wa[0], o0); o1 = fmaf(hv[e], wa[1], o1); } }
        if (kv == 0) { float ss = o0 * o0 + o1 * o1;
            ss += shx<1>(ss); ss += shx<2>(ss); ss += shx<4>(ss); ss += shx<8>(ss); ss += shx<16>(ss);
            const float rstd = rsqrtf(ss * (1.f / 64.f) + EPS);
            o0 *= rstd * kg0[d0]; o1 *= rstd * kg0[d0 + 1]; }
        const int i = i0 + il;
        if (i >= NCMP) { o0 = zf_(); o1 = o0; }
        *(unsigned*)(KVcb + (((size_t)kv * NB + b) * 512 + i) * 64 + d0) = cvtpk(o0, o1);
    }
    __syncthreads();
}
__device__ __forceinline__ void cmp_c1_item(const float* __restrict__ pe, const float* __restrict__ w1, float* __restrict__ c1, int item, int tid, LAS unsigned char* lds) {
    const int lk = item >> 4, j0 = (item & 15) * 8, jj = tid & 7, kk = tid >> 3;
    const float* pp = pe + (size_t)lk * 2048; const float* ww = w1 + (size_t)lk * 2048 * 128 + j0 + jj;
    float a = 0.f;
#pragma unroll 8
    for (int k = kk; k < 2048; k += 64) a = fmaf(pp[k], ww[(size_t)k * 128], a);
    LAS float* red = (LAS float*)lds;
    red[tid] = a;
    __syncthreads();
    if (tid < 8) { float s = 0.f; for (int q = 0; q < 64; ++q) s += red[q * 8 + tid]; c1[lk * 128 + j0 + tid] = s; }
    __syncthreads();
}

#define XB_TMO      128
#define XB_XCNT(j)  (256  + 64 * (j))
#define XB_XSUB(j)  (1280 + 64 * (j))
#define XB_XGEN(j)  (2304 + 64 * (j))
#define XB_TOP      3328
#define XB_TOPGEN   3392
#define XCD_BAR_WORDS 3456
#define XB_SPIN_CAP (1u << 22)

__device__ __forceinline__ unsigned xb_ld(unsigned* p)              { return __hip_atomic_load(p, __ATOMIC_RELAXED, __HIP_MEMORY_SCOPE_AGENT); }
__device__ __forceinline__ unsigned xb_add(unsigned* p, unsigned v) { return __hip_atomic_fetch_add(p, v, __ATOMIC_RELAXED, __HIP_MEMORY_SCOPE_AGENT); }
__device__ __forceinline__ unsigned xb_xcc_id() { return (unsigned)__builtin_amdgcn_s_getreg((3 << 11) | 20) & 0xFu; }
#define XB_SPIN(cond, bar) do { unsigned _sp = 0; while (cond) { __builtin_amdgcn_s_sleep(1); \
    if ((++_sp & 255u) == 0u) { if (xb_ld(&(bar)[XB_TMO])) break; if (_sp > XB_SPIN_CAP) { atomicAdd(&(bar)[XB_TMO], 1u); break; } } } } while (0)

struct XcdBarrier {
    unsigned* bar; unsigned x;
    volatile LAS unsigned* st;
};

__device__ __forceinline__ XcdBarrier xcd_barrier_post(unsigned* bar, volatile LAS unsigned* st) {
    XcdBarrier b; b.bar = bar; b.x = xb_xcc_id(); b.st = st;
    if (threadIdx.x == 0) (void)xb_add(&bar[XB_XCNT(b.x)], 1u);
    return b;
}
__device__ __forceinline__ void xcd_barrier_complete(unsigned* bar, unsigned x, unsigned& nloc, unsigned& nx) {
    const unsigned G = gridDim.x * gridDim.y * gridDim.z;
    unsigned sum, cnt, mine, sp = 0u;
    for (;;) {
        sum = 0u; cnt = 0u; mine = 0u;
#pragma unroll
        for (unsigned j = 0; j < 16; ++j) { const unsigned c = xb_ld(&bar[XB_XCNT(j)]); sum += c; cnt += (c > 0u) ? 1u : 0u; mine = (j == x) ? c : mine; }
        if (sum == G) break;
        __builtin_amdgcn_s_sleep(1);
        if ((++sp & 255u) == 0u) { if (xb_ld(&bar[XB_TMO])) break; if (sp > XB_SPIN_CAP) { atomicAdd(&bar[XB_TMO], 1u); break; } }
    }
    nloc = mine > 0u ? mine : 1u; nx = cnt > 0u ? cnt : 1u;
}

__device__ __forceinline__ void xcd_barrier(const XcdBarrier& b) {
    asm volatile("s_waitcnt vmcnt(0)" ::: "memory");
    __syncthreads();
    if (threadIdx.x == 0) {
        unsigned* bar = b.bar;
        __builtin_amdgcn_s_waitcnt(0);
        unsigned nloc = b.st[0], nx = b.st[1];
        if (nloc == 0u) { xcd_barrier_complete(bar, b.x, nloc, nx); b.st[0] = nloc; b.st[1] = nx; }
        const unsigned old = xb_add(&bar[XB_XSUB(b.x)], 1u);
        const unsigned gen = old / nloc;
        if (old + 1u == (gen + 1u) * nloc) {
            __builtin_amdgcn_fence(__ATOMIC_RELEASE, "agent");
            asm volatile("s_waitcnt vmcnt(0)" ::: "memory");
            const unsigned og = xb_add(&bar[XB_TOP], 1u);
            const unsigned tg = og / nx;
            if (og + 1u == (tg + 1u) * nx) xb_add(&bar[XB_TOPGEN], 1u);
            else XB_SPIN(xb_ld(&bar[XB_TOPGEN]) == tg, bar);
            __builtin_amdgcn_fence(__ATOMIC_ACQUIRE, "agent");
            xb_add(&bar[XB_XGEN(b.x)], 1u);
            asm volatile("s_waitcnt vmcnt(0)" ::: "memory");
        } else {
            XB_SPIN(xb_ld(&bar[XB_XGEN(b.x)]) == gen, bar);
            __builtin_amdgcn_fence(__ATOMIC_ACQUIRE, "agent");
            asm volatile("s_waitcnt vmcnt(0)" ::: "memory");
        }
    }
    __syncthreads();
}


constexpr int M2_G_OFF = 0, M2_STG_OFF = 4096, M2_KIMG = 64 * MQ_PITCH, M2_VIMG = 64 * MV_PITCH, M2_STG = M2_KIMG + M2_VIMG;
static_assert(M2_STG_OFF + 2 * M2_STG <= 131072, "mlstm256 LDS");
__device__ __forceinline__ void ml256_gates(const float* __restrict__ G, const float* __restrict__ bif, int row0, int h, int tid, LAS float* gs) {
    if (tid < 256) { gs[tid] = log_sigmoidf_(G[(size_t)(row0 + tid) * 32 + 4 + h] + bif[4 + h]); gs[512 + tid] = G[(size_t)(row0 + tid) * 32 + h] + bif[h]; }
    __syncthreads();
    if (tid < 256) { float a = 0.f;
#pragma unroll 8
        for (int s = 0; s <= tid; ++s) a += gs[s];
        gs[256 + tid] = a; }
    __syncthreads();
}
struct Ml2Raw { u32x4v k[2], v[2]; };
__device__ __forceinline__ void ml2_load(Ml2Raw& r, const bf16* __restrict__ P, const bf16* __restrict__ QK2, int row0, int h, int tid) {
    const int s = tid >> 3;
#pragma unroll
    for (int pass = 0; pass < 2; ++pass) { const int ch = (tid & 7) + 8 * pass;
        r.k[pass] = *(const u32x4v*)(QK2 + (size_t)(row0 + s) * 1024 + 512 + h * 128 + ch * 8);
        r.v[pass] = *(const u32x4v*)(P + (size_t)(row0 + s) * DINP + C_MV + h * 128 + ch * 8); }
}
__device__ __forceinline__ void ml256_m1_phase(const bf16* __restrict__ P, const bf16* __restrict__ QK2, const float* __restrict__ G, const float* __restrict__ bif,
                                               bf16* __restrict__ CT, float* __restrict__ nst, float* __restrict__ dec, int bid, int Gd, int tid, LAS unsigned char* lds) {
    asm volatile("" : "+v"(tid));
    const int lane = tid & 63, wid = __builtin_amdgcn_readfirstlane(tid >> 6), hi = lane >> 5;
    LAS float* gs = (LAS float*)(lds + M2_G_OFF);
    for (int u = bid; u < 512; u += Gd) {
        const int sc = u & 31, h = (u >> 5) & 3, b = u >> 7, row0 = b * SEQ + sc * 256;
        Ml2Raw raw; ml2_load(raw, P, QK2, row0, h, tid);
        ml256_gates(G, bif, row0, h, tid, gs);
        if (tid == 0) dec[u] = __expf(gs[256 + 255]);
        const int g = lane >> 4, i = lane & 15;
        const int mb = wid >> 1, nb0 = 2 * (wid & 1);
        f32x16 acc0, acc1;
#pragma unroll
        for (int r = 0; r < 16; ++r) { acc0[r] = zf_(); acc1[r] = acc0[r]; }
        float an = 0.f;
        for (int st = 0; st < 4; ++st) {
            LAS unsigned char* stg = lds + M2_STG_OFF + (st & 1) * (2 * M2_VIMG);
            { const int s = tid >> 3; const float ws = __expf(gs[256 + 255] - gs[256 + st * 64 + s] + gs[512 + st * 64 + s]);
#pragma unroll
              for (int pass = 0; pass < 2; ++pass) { const int ch = (tid & 7) + 8 * pass; u32x4v w;
#pragma unroll
                  for (int e = 0; e < 4; ++e) w[e] = cvtpk(__builtin_bit_cast(float, raw.k[pass][e] << 16) * ws, __builtin_bit_cast(float, raw.k[pass][e] & 0xffff0000u) * ws);
                  *(LAS u32x4v*)(stg + s * MV_PITCH + ch * 16) = w;
                  *(LAS u32x4v*)(stg + M2_VIMG + s * MV_PITCH + ch * 16) = raw.v[pass]; } }
            if (st + 1 < 4) ml2_load(raw, P, QK2, row0 + (st + 1) * 64, h, tid);
            __syncthreads();
            LAS const unsigned char* trb = stg + (4 * hi + (i >> 2)) * MV_PITCH + (16 * (g & 1) + 4 * (i & 3)) * 2;
#pragma unroll
            for (int ks = 0; ks < 4; ++ks) {
                const s16x4 alo = lds_tr(trb + ks * 16 * MV_PITCH + mb * 64), ahi = lds_tr(trb + ks * 16 * MV_PITCH + 8 * MV_PITCH + mb * 64);
                const bf16x8 af = {alo[0], alo[1], alo[2], alo[3], ahi[0], ahi[1], ahi[2], ahi[3]};
                const s16x4 b0lo = lds_tr(trb + M2_VIMG + ks * 16 * MV_PITCH + nb0 * 64), b0hi = lds_tr(trb + M2_VIMG + ks * 16 * MV_PITCH + 8 * MV_PITCH + nb0 * 64);
                const s16x4 b1lo = lds_tr(trb + M2_VIMG + ks * 16 * MV_PITCH + (nb0 + 1) * 64), b1hi = lds_tr(trb + M2_VIMG + ks * 16 * MV_PITCH + 8 * MV_PITCH + (nb0 + 1) * 64);
                const bf16x8 bf0 = {b0lo[0], b0lo[1], b0lo[2], b0lo[3], b0hi[0], b0hi[1], b0hi[2], b0hi[3]}, bf1 = {b1lo[0], b1lo[1], b1lo[2], b1lo[3], b1hi[0], b1hi[1], b1hi[2], b1hi[3]};
                acc0 = __builtin_amdgcn_mfma_f32_32x32x16_bf16(af, bf0, acc0, 0, 0, 0);
                acc1 = __builtin_amdgcn_mfma_f32_32x32x16_bf16(af, bf1, acc1, 0, 0, 0);
            }
            if (tid < 128) { for (int s = 0; s < 64; ++s) an += bf2f(*(LAS const bf16*)(stg + s * MV_PITCH + tid * 2)); }
        }
        bf16* ct = CT + (size_t)u * 16384;
#pragma unroll
        for (int gq = 0; gq < 4; ++gq) { const int d0 = 32 * mb + 8 * gq + 4 * hi;
            uint2 w0, w1; w0.x = cvtpk(acc0[4 * gq], acc0[4 * gq + 1]); w0.y = cvtpk(acc0[4 * gq + 2], acc0[4 * gq + 3]); w1.x = cvtpk(acc1[4 * gq], acc1[4 * gq + 1]); w1.y = cvtpk(acc1[4 * gq + 2], acc1[4 * gq + 3]);
            *(uint2*)(ct + (size_t)(32 * nb0 + (lane & 31)) * 128 + d0) = w0; *(uint2*)(ct + (size_t)(32 * (nb0 + 1) + (lane & 31)) * 128 + d0) = w1; }
        if (tid < 128) nst[(size_t)u * 128 + tid] = an;
        __syncthreads();
    }
}
__device__ __forceinline__ void ml256_scan(bf16* __restrict__ CT, float* __restrict__ nst, const float* __restrict__ dec, int item, int tid) {
    asm volatile("" : "+v"(tid));
    const int bh = item / 9, part = item % 9;
    if (part < 8) {
        bf16* base = CT + (size_t)bh * 32 * 16384 + (part * 512 + tid) * 4;
        float C[4]; C[0] = zf_(); C[1] = C[0]; C[2] = C[0]; C[3] = C[0];
        for (int c0 = 0; c0 < 32; c0 += 16) {
            uint2 w[16];
#pragma unroll
            for (int k = 0; k < 16; ++k) w[k] = *(const uint2*)(base + (size_t)(c0 + k) * 16384);
#pragma unroll
            for (int k = 0; k < 16; ++k) { const float a = dec[bh * 32 + c0 + k];
                uint2 o; o.x = cvtpk(C[0], C[1]); o.y = cvtpk(C[2], C[3]); *(uint2*)(base + (size_t)(c0 + k) * 16384) = o;
                C[0] = fmaf(a, C[0], __builtin_bit_cast(float, w[k].x << 16)); C[1] = fmaf(a, C[1], __builtin_bit_cast(float, w[k].x & 0xffff0000u));
                C[2] = fmaf(a, C[2], __builtin_bit_cast(float, w[k].y << 16)); C[3] = fmaf(a, C[3], __builtin_bit_cast(float, w[k].y & 0xffff0000u)); }
        }
    } else if (tid < 128) {
        float* base = nst + (size_t)bh * 32 * 128 + tid; float C = 0.f;
        for (int c = 0; c < 32; ++c) { const float dC = base[(size_t)c * 128]; base[(size_t)c * 128] = C; C = dec[bh * 32 + c] * C + dC; }
    }
}
__device__ __forceinline__ void ml256_m3_phase(const bf16* __restrict__ P, const bf16* __restrict__ QK2, const float* __restrict__ G, const float* __restrict__ bif,
                                               const bf16* __restrict__ CT, const float* __restrict__ nst, const float* __restrict__ mnorm, bf16* __restrict__ MIX, int bid, int Gd, int tid, LAS unsigned char* lds) {
    asm volatile("" : "+v"(tid));
    const int lane = tid & 63, wid = __builtin_amdgcn_readfirstlane(tid >> 6), hi = lane >> 5, r32 = lane & 31;
    LAS float* gs = (LAS float*)(lds + M2_G_OFF);
    for (int u = bid; u < 512; u += Gd) {
        const int sc = u & 31, h = (u >> 5) & 3, b = u >> 7, row0 = b * SEQ + sc * 256;
        const int t = 32 * wid + r32; const size_t rowt = (size_t)row0 + t;
        auto stage_load = [&](int kt, u32x4v (&kk)[2], u32x4v (&vv)[2]) { const int s = tid >> 3;
#pragma unroll
            for (int pass = 0; pass < 2; ++pass) { const int ch = (tid & 7) + 8 * pass;
                kk[pass] = *(const u32x4v*)(QK2 + (size_t)(row0 + kt * 64 + s) * 1024 + 512 + h * 128 + ch * 8);
                vv[pass] = *(const u32x4v*)(P + (size_t)(row0 + kt * 64 + s) * DINP + C_MV + h * 128 + ch * 8); } };
        auto stage_store = [&](int kt, const u32x4v (&kk)[2], const u32x4v (&vv)[2]) { LAS unsigned char* stg = lds + M2_STG_OFF + (kt & 1) * M2_STG; const int s = tid >> 3;
#pragma unroll
            for (int pass = 0; pass < 2; ++pass) { const int ch = (tid & 7) + 8 * pass;
                *(LAS u32x4v*)(stg + s * MQ_PITCH + ch * 16) = kk[pass]; *(LAS u32x4v*)(stg + M2_KIMG + s * MV_PITCH + ch * 16) = vv[pass]; } };
        u32x4v kk[2], vv[2]; stage_load(0, kk, vv);
        bf16x8 qf[8];
#pragma unroll
        for (int ks = 0; ks < 8; ++ks) qf[ks] = *(const bf16x8*)(QK2 + rowt * 1024 + h * 128 + ks * 16 + hi * 8);
        if (tid >= 256 && tid < 384) gs[768 + tid - 256] = nst[(size_t)u * 128 + tid - 256];
        ml256_gates(G, bif, row0, h, tid, gs);
        stage_store(0, kk, vv);
        __syncthreads();
        f32x16 N0, N1, N2, N3;
#pragma unroll
        for (int r = 0; r < 16; ++r) { N0[r] = zf_(); N1[r] = N0[r]; N2[r] = N0[r]; N3[r] = N0[r]; }
        const float bt = gs[256 + t], Ft = __expf(bt);
        float dsum = 0.f;
        const int ktmax = wid >> 1;
        for (int kt = 0; kt < 4; ++kt) {
            if (kt + 1 < 4) stage_load(kt + 1, kk, vv);
            if (kt <= ktmax) {
                LAS const unsigned char* stg = lds + M2_STG_OFF + (kt & 1) * M2_STG;
                f32x16 p0, p1;
#pragma unroll
                for (int r = 0; r < 16; ++r) { p0[r] = zf_(); p1[r] = p0[r]; }
                LAS const unsigned char* ka = stg + r32 * MQ_PITCH + hi * 16;
#pragma unroll
                for (int ks = 0; ks < 8; ++ks) { const bf16x8 a0 = *(LAS const bf16x8*)(ka + ks * 32), a1 = *(LAS const bf16x8*)(ka + 32 * MQ_PITCH + ks * 32);
                    p0 = __builtin_amdgcn_mfma_f32_32x32x16_bf16(a0, qf[ks], p0, 0, 0, 0); p1 = __builtin_amdgcn_mfma_f32_32x32x16_bf16(a1, qf[ks], p1, 0, 0, 0); }
#pragma unroll
                for (int r = 0; r < 16; ++r) { const int s0 = kt * 64 + crow(r, hi), s1 = s0 + 32;
                    { const float w = (s0 <= t) ? __expf(bt - gs[256 + s0] + gs[512 + s0]) : 0.f; p0[r] *= w; dsum += p0[r]; }
                    { const float w = (s1 <= t) ? __expf(bt - gs[256 + s1] + gs[512 + s1]) : 0.f; p1[r] *= w; dsum += p1[r]; } }
                bf16x8 pf[4];
#pragma unroll
                for (int s = 0; s < 4; ++s) { u32x4v w;
#pragma unroll
                    for (int e = 0; e < 4; ++e) { const int r = 8 * (s & 1) + 2 * e; w[e] = (s < 2) ? cvtpk(p0[r], p0[r + 1]) : cvtpk(p1[r], p1[r + 1]); }
                    pf[s] = __builtin_bit_cast(bf16x8, w); }
                const int g = lane >> 4, i = lane & 15;
                LAS const unsigned char* trb = stg + M2_KIMG + (4 * hi + (i >> 2)) * MV_PITCH + (16 * (g & 1) + 4 * (i & 3)) * 2;
#pragma unroll
                for (int s = 0; s < 4; ++s) {
#pragma unroll
                    for (int eb = 0; eb < 4; ++eb) {
                        const s16x4 lo = lds_tr(trb + s * 16 * MV_PITCH + eb * 64), hi4 = lds_tr(trb + s * 16 * MV_PITCH + 8 * MV_PITCH + eb * 64);
                        const bf16x8 vt = {lo[0], lo[1], lo[2], lo[3], hi4[0], hi4[1], hi4[2], hi4[3]};
                        if (eb == 0) N0 = __builtin_amdgcn_mfma_f32_32x32x16_bf16(vt, pf[s], N0, 0, 0, 0);
                        else if (eb == 1) N1 = __builtin_amdgcn_mfma_f32_32x32x16_bf16(vt, pf[s], N1, 0, 0, 0);
                        else if (eb == 2) N2 = __builtin_amdgcn_mfma_f32_32x32x16_bf16(vt, pf[s], N2, 0, 0, 0);
                        else N3 = __builtin_amdgcn_mfma_f32_32x32x16_bf16(vt, pf[s], N3, 0, 0, 0);
                    } }
            }
            if (kt + 1 < 4) stage_store(kt + 1, kk, vv);
            __syncthreads();
        }
        float qn = 0.f;
#pragma unroll
        for (int ks = 0; ks < 8; ++ks)
#pragma unroll
            for (int j = 0; j < 8; ++j) qn = fmaf(bf2f((bf16)qf[ks][j]), gs[768 + ks * 16 + hi * 8 + j], qn);
        dsum += shx<32>(dsum); qn += shx<32>(qn);
        const float den = dsum + Ft * qn, inv = rcpf_(fmaxf(fabsf(den), 1.f));
        float ssq = 0.f;
#pragma unroll
        for (int eb = 0; eb < 4; ++eb) {
            const bf16* ctp = CT + (size_t)u * 16384 + (size_t)(32 * eb + r32) * 128 + hi * 8;
            bf16x8 cf[8];
#pragma unroll
            for (int ks = 0; ks < 8; ++ks) cf[ks] = *(const bf16x8*)(ctp + ks * 16);
            f32x16 ni;
#pragma unroll
            for (int r = 0; r < 16; ++r) ni[r] = zf_();
#pragma unroll
            for (int ks = 0; ks < 8; ++ks) ni = __builtin_amdgcn_mfma_f32_32x32x16_bf16(cf[ks], qf[ks], ni, 0, 0, 0);
            f32x16& Nx = eb == 0 ? N0 : eb == 1 ? N1 : eb == 2 ? N2 : N3;
#pragma unroll
            for (int r = 0; r < 16; ++r) { Nx[r] = (Nx[r] + Ft * ni[r]) * inv; ssq += Nx[r] * Nx[r]; }
        }
        ssq += shx<32>(ssq);
        const float rstd = rsqrtf(ssq * (1.f / 128.f) + EPS);
#pragma unroll
        for (int eb = 0; eb < 4; ++eb) { const f32x16& Nx = eb == 0 ? N0 : eb == 1 ? N1 : eb == 2 ? N2 : N3;
#pragma unroll
            for (int gq = 0; gq < 4; ++gq) { const int cc = h * 128 + 32 * eb + 8 * gq + 4 * hi;
                const uint2 ow = *(const uint2*)(P + rowt * DINP + C_MO + cc); const float4 mn = *(const float4*)(mnorm + cc);
                const float o0 = sigmoidf_(__builtin_bit_cast(float, ow.x << 16)), o1 = sigmoidf_(__builtin_bit_cast(float, ow.x & 0xffff0000u)), o2 = sigmoidf_(__builtin_bit_cast(float, ow.y << 16)), o3 = sigmoidf_(__builtin_bit_cast(float, ow.y & 0xffff0000u));
                uint2 w; w.x = cvtpk(Nx[4 * gq] * rstd * mn.x * o0, Nx[4 * gq + 1] * rstd * mn.y * o1); w.y = cvtpk(Nx[4 * gq + 2] * rstd * mn.z * o2, Nx[4 * gq + 3] * rstd * mn.w * o3);
                *(uint2*)(MIX + rowt * DM + cc) = w; } }
        __syncthreads();
    }
}

constexpr size_t MiB = 1u << 20;
constexpr size_t W_LAYER = (size_t)(DINP + DM + DFF) * DM + (size_t)DM * DFF;
constexpr size_t WS_W = 0;
constexpr size_t WS_HM = 52 * MiB;
constexpr size_t WS_G = 116 * MiB;
constexpr size_t WS_SMALL = 120 * MiB;
constexpr size_t WS_TAB = WS_SMALL, WS_KMEAN = WS_SMALL + 512 * 1024, WS_KVC = WS_SMALL + 1 * MiB, WS_NST = WS_SMALL + 2 * MiB, WS_DEC = WS_SMALL + 3 * MiB, WS_KVCB = WS_SMALL + 3 * MiB + 512 * 1024;
constexpr size_t WS_SSP = 476 * MiB;
constexpr size_t WS_BAR = WS_SMALL + 3 * MiB + 64 * 1024;
constexpr size_t WS_W1T = 50 * MiB, WS_C1 = WS_SMALL + 3 * MiB + 16 * 1024;
constexpr size_t WS_P = 124 * MiB;
constexpr size_t WS_C = 348 * MiB;
constexpr size_t WS_U = WS_P;
constexpr size_t WS_SELB = 478 * MiB, WS_CNTQ = WS_SELB + 512 * 1024, WS_LISTG = WS_CNTQ + 64 * 1024;
constexpr size_t WS_END = 484 * MiB;
static_assert(W_LAYER * 2 * DEPTH <= 50 * MiB && WS_W1T + (size_t)DEPTH * 2 * 128 * 2048 * 2 <= 52 * MiB, "weights");
static_assert((size_t)T * DINP * 2 == 224 * MiB && (size_t)T * DFF * 2 == 256 * MiB, "sizes");

#ifndef DUP_PRO
#define DUP_PRO 1
#endif
#ifndef DUP_QK2
#define DUP_QK2 1
#endif
#ifndef DUP_GEMM
#define DUP_GEMM 1
#endif
#ifndef DUP_M1
#define DUP_M1 1
#endif
#ifndef DUP_MOBA
#define DUP_MOBA 1
#endif
#ifndef DUP_NSA
#define DUP_NSA 1
#endif
#ifndef DUP_M3
#define DUP_M3 1
#endif
#ifndef DUP_MRG
#define DUP_MRG 1
#endif
#ifndef DUP_CMP
#define DUP_CMP 1
#endif
struct Params { const float* in[16]; float* out; unsigned char* ws; };
static_assert(sizeof(Params) == 18 * 8, "kernarg layout: in[k] at 8k, out at 128, ws at 136");
constexpr int LDS_BYTES = 147456;

__global__ void __launch_bounds__(512, 2) hybrid_fwd(Params prm) {
    extern __shared__ __attribute__((aligned(16))) unsigned char lds[];
    cg::grid_group grid = cg::this_grid();
    constexpr int NPH = 1 + DEPTH * 8;
    volatile LAS unsigned* xst = (volatile LAS unsigned*)((LAS unsigned char*)lds + 131072 + 1024);
    if (threadIdx.x < 2) xst[threadIdx.x] = 0u;
    __syncthreads();
    (void)xcd_barrier_post((unsigned*)(prm.ws + WS_BAR), xst);
    for (int ph = 0; ph < NPH; ++ph) {
        int tid = threadIdx.x; asm volatile("" : "+v"(tid));
        int G = gridDim.x, bid = blockIdx.x; asm volatile("" : "+s"(G), "+s"(bid));
#define PH_LOCALS const int half = tid >> 8, t256 = tid & 255, lane = tid & 63, wid = __builtin_amdgcn_readfirstlane(tid >> 6); unsigned char* smh = lds + half * 65536; \
        const int vb = bid * 2 + half, NVB = G * 2, gwv = bid * 8 + wid, NGW = G * 8; (void)lane; (void)smh; (void)vb; (void)NVB; (void)gwv; (void)NGW; (void)t256;
        const __attribute__((address_space(4))) unsigned char* ka = (const __attribute__((address_space(4))) unsigned char*)__builtin_amdgcn_kernarg_segment_ptr(); asm volatile("" : "+s"(ka));
#define KARG(T_, off) (*(T_ const __attribute__((address_space(4)))*)(ka + (off)))
#define IN(k) KARG(const float*, 8 * (k))
        unsigned char* ws = KARG(unsigned char*, 8 * 17); float* out = KARG(float*, 8 * 16);
        bf16* Wb = (bf16*)(ws + WS_W); bf16* HM = (bf16*)(ws + WS_HM); float* Gt = (float*)(ws + WS_G); float* tab = (float*)(ws + WS_TAB); float* kmean = (float*)(ws + WS_KMEAN);
        float* KVc = (float*)(ws + WS_KVC); float* nst = (float*)(ws + WS_NST); float* dec = (float*)(ws + WS_DEC); bf16* KVcb = (bf16*)(ws + WS_KVCB); bf16* W1t = (bf16*)(ws + WS_W1T); float* C1 = (float*)(ws + WS_C1); bf16* P = (bf16*)(ws + WS_P); bf16* CT = (bf16*)(ws + WS_C); unsigned* SELB = (unsigned*)(ws + WS_SELB); int* CNTQ = (int*)(ws + WS_CNTQ); unsigned char* LISTG = ws + WS_LISTG; bf16* QK2 = (bf16*)out  ; bf16* XB = (bf16*)(ws + WS_C + 64 * MiB)  ; unsigned long long* SSA = (unsigned long long*)(ws + WS_SSP); unsigned long long* SSB = SSA + T;     bf16* U = (bf16*)(ws + WS_U);
        const int l = ph == 0 ? 0 : (ph - 1) / 8, j = ph == 0 ? -1 : (ph - 1) % 8;
        const float* x = IN(0);
        const bf16* WinT = Wb + l * W_LAYER; const bf16* WoT = WinT + (size_t)DINP * DM; const bf16* W1T = WoT + (size_t)DM * DM; const bf16* W2T = W1T + (size_t)DFF * DM;
        if (ph == 0) {
            PH_LOCALS
            const float* w_in = IN(1); const float* w_out = IN(11); const float* w_ff1 = IN(14); const float* w_ff2 = IN(15);
            for (int rep = 0; rep < DUP_PRO; ++rep) {
            for (int ll = 0; ll < DEPTH; ++ll) {
                bf16* WinT_ = Wb + ll * W_LAYER; bf16* WoT_ = WinT_ + (size_t)DINP * DM; bf16* W1T_ = WoT_ + (size_t)DM * DM; bf16* W2T_ = W1T_ + (size_t)DFF * DM;
                for (int mt = 0; mt < 4; ++mt) {
                    const float* W; int K, N, NP, mode; bf16* WT;
                    const float* gk = nullptr;
                    if (mt == 0) { W = w_in + (size_t)ll * DM * DIN; K = DM; N = DIN; NP = DINP; WT = WinT_; mode = 1; gk = IN(12) + ll * DM; }
                    else if (mt == 1) { W = w_out + (size_t)ll * DM * DM; K = DM; N = DM; NP = DM; WT = WoT_; mode = 0; }
                    else if (mt == 2) { W = w_ff1 + (size_t)ll * DM * DFF; K = DM; N = DFF; NP = DFF; WT = W1T_; mode = 0; gk = IN(13) + ll * DM; }
                    else { W = w_ff2 + (size_t)ll * DFF * DM; K = DFF; N = DM; NP = DM; WT = W2T_; mode = 0; }
                    ph_convert_mat(W, K, N, NP, WT, mode, vb, NVB, t256, (float*)smh, gk);
                }
            }
            for (int lk = 0; lk < DEPTH * 2; ++lk) {
                ph_convert_mat(IN(9) + (size_t)lk * 2048 * 128, 2048, 128, 128, W1t + (size_t)lk * 128 * 2048, 0, vb, NVB, t256, (float*)smh);
            }
            for (int it = bid; it < 64; it += G) cmp_c1_item(IN(8), IN(9), C1, it, tid, (LAS unsigned char*)lds);
            for (int i = bid * 512 + tid; i < SEQ * 8; i += G * 512) { const int pos = i >> 3, f = i & 7;
                float c_, s_; rope_cs(pos, f, c_, s_);
                tab[pos * 16 + f] = c_; tab[pos * 16 + 8 + f] = s_; }
            for (int row = gwv; row < T; row += 2 * NGW) { ph_x_row(x, XB, SSA, row, lane); if (row + NGW < T) ph_x_row(x, XB, SSA, row + NGW, lane); }
            }
        } else if (j == 0 || j >= 5) {
            pg8::Gemm g; pg8::EpiAny E; int N; const bool last = (l + 1 == DEPTH);
            PG8_LAS unsigned long long* RS_LDS = (PG8_LAS unsigned long long*)((PG8_LAS unsigned char*)lds + 131072 + 2048);
            if (j == 0) { g = pg8::Gemm{XB, WinT, T, DINP, DM}; N = DINP; E = pg8::EpiAny{0, true, P, DINP, Gt, C_GATE, nullptr, nullptr, nullptr, SSA, RS_LDS}; }
            else if (j == 5) { g = pg8::Gemm{HM, WoT, T, DM, DM}; N = DM; E = pg8::EpiAny{2, true, nullptr, DM, nullptr, 0, nullptr, nullptr, XB, SSB, RS_LDS}; }
            else if (j == 6) { g = pg8::Gemm{XB, W1T, T, DFF, DM}; N = DFF; E = pg8::EpiAny{1, true, U, DFF, nullptr, 0, nullptr, nullptr, nullptr, SSB, RS_LDS}; }
            else { g = pg8::Gemm{U, W2T, T, DM, DFF}; N = DM; E = pg8::EpiAny{2, true, nullptr, DM, nullptr, 0, nullptr, last ? out : nullptr, XB, SSA, RS_LDS}; }
            pg8::StaticOrder S; S.init(T, N, G, bid);
#ifdef STAGGER_T
            if (STAGGER_PH) { const unsigned long long dl = (unsigned long long)((bid >> 3) & (STAGGER_G - 1)) * STAGGER_T; const unsigned long long t0 = __builtin_amdgcn_s_memrealtime(); while (__builtin_amdgcn_s_memrealtime() - t0 < dl) __builtin_amdgcn_s_sleep(4); }
#endif
            for (int rep = 0; rep < ((j == 0 || j == 6) ? DUP_GEMM : 1); ++rep) pg8::gemm_phase<pg8::EpiAny, pg8::StaticOrder, true, true>((PG8_LAS unsigned char*)lds, g, S, E, tid);
        } else if (j == 1) {
            PH_LOCALS
            for (int rep = 0; rep < DUP_CMP; ++rep) for (int it = bid; it < 256; it += G) compress_item(P, W1t + (size_t)l * 2 * 128 * 2048, C1 + l * 256, IN(10) + (size_t)l * 2 * 128 * 64, IN(7) + l * 192, KVcb, it, tid, (LAS unsigned char*)lds);
            for (int it0 = 0; it0 < 128 * 14; it0 += NVB) { const int it = it0 + vb; ph_prep(P, tab, IN(5) + l * 128, IN(6) + l * 64, IN(7) + l * 192, kmean, it, it < 128 * 14, t256, (float*)smh); }
            for (int rep = 0; rep < DUP_QK2; ++rep) qk2_rows(P, IN(3) + (size_t)l * 4 * 1024, QK2, bid, G, tid);
            { unsigned long long z64 = 0ull; asm volatile("" : "+v"(z64)); for (int i = bid * 512 + tid; i < 2 * T; i += G * 512) SSA[i] = z64; }
        } else if (j == 2) {
            for (int rep = 0; rep < DUP_M1; ++rep) ml256_m1_phase(P, QK2, Gt, IN(2) + l * 8, CT, nst, dec, bid, G, tid, (LAS unsigned char*)lds);
            for (int u = bid; u < 512; u += G) moba_gate_item(P, kmean, SELB, CNTQ, LISTG, u >> 7, (u >> 5) & 3, u & 31, tid, (LAS unsigned char*)lds);
        } else if (j == 3) {
            for (int it = bid; it < 16 * 9; it += G) ml256_scan(CT, nst, dec, it, tid);
            for (int rep = 0; rep < DUP_MOBA; ++rep) moba_kv_phase(P, SELB, CNTQ, LISTG, IN(5) + l * 128 + 64, bid, G, tid, (LAS unsigned char*)lds);
            for (int rep = 0; rep < DUP_NSA; ++rep) for (int pu = bid; pu < 256; pu += G) { const int b_ = pu >> 6, s = pu & 63;
                nsa_unit(P, Gt, tab, KVcb, IN(7) + l * 192, HM, b_, 127 - s, tid, (LAS unsigned char*)lds); nsa_unit(P, Gt, tab, KVcb, IN(7) + l * 192, HM, b_, s, tid, (LAS unsigned char*)lds); }
        } else {
            { const float kmx = gain_kmax(IN(5) + l * 128 + 64, tid & 63);
              for (int rep = 0; rep < DUP_MRG; ++rep) for (int pu = bid; pu < 256; pu += G) { const int bh = pu >> 4, s = pu & 15;
                  moba_merge_unit(P, SELB, kmx, HM, bh >> 2, bh & 3, 31 - s, tid, (LAS unsigned char*)lds); moba_merge_unit(P, SELB, kmx, HM, bh >> 2, bh & 3, s, tid, (LAS unsigned char*)lds); } }
            for (int rep = 0; rep < DUP_M3; ++rep) ml256_m3_phase(P, QK2, Gt, IN(2) + l * 8, CT, nst, IN(4) + l * 512, HM, bid, G, tid, (LAS unsigned char*)lds);
        }
        if (ph + 1 < NPH) { if (ws == nullptr) grid.sync(); else { XcdBarrier xbar; xbar.bar = (unsigned*)(ws + WS_BAR); xbar.x = xb_xcc_id(); xbar.st = xst; xcd_barrier(xbar); } }
    }
#undef IN
#undef KARG
#undef PH_LOCALS
}

extern "C" void kernel_launch(void* const* d_in, const int* in_sizes, int n_in, void* d_out, int out_size, void* d_ws, size_t ws_size, hipStream_t stream) {
    static int grid = 0;
    if (grid == 0) {
        if (n_in != 16 || in_sizes[0] != T * DM || out_size != T * DM || ws_size < WS_END) { fprintf(stderr, "kernel_launch: unexpected shapes / workspace %zu < %zu\n", ws_size, (size_t)WS_END); grid = -1; return; }
        int dev = 0, cus = 0, per_cu = 0;
        if (hipGetDevice(&dev) != hipSuccess || hipDeviceGetAttribute(&cus, hipDeviceAttributeMultiprocessorCount, dev) != hipSuccess) { grid = -1; return; }
        if (hipFuncSetAttribute((const void*)hybrid_fwd, hipFuncAttributeMaxDynamicSharedMemorySize, LDS_BYTES) != hipSuccess) { fprintf(stderr, "kernel_launch: hipFuncSetAttribute failed\n"); grid = -1; return; }
        if (hipOccupancyMaxActiveBlocksPerMultiprocessor(&per_cu, (const void*)hybrid_fwd, 512, LDS_BYTES) != hipSuccess || per_cu < 1) { fprintf(stderr, "kernel_launch: occupancy query failed (%d)\n", per_cu); grid = -1; return; }
        grid = cus * per_cu;
        fprintf(stderr, "kernel_launch: grid %d (%d CUs x %d)\n", grid, cus, per_cu);
    }
    if (grid < 0) return;
    if (hipMemsetAsync((char*)d_ws + WS_BAR, 0, XCD_BAR_WORDS * 4, stream) != hipSuccess) { fprintf(stderr, "kernel_launch: memset failed\n"); return; }
    Params p{};
    for (int i = 0; i < 16; ++i) p.in[i] = (const float*)d_in[i];
    p.out = (float*)d_out; p.ws = (unsigned char*)d_ws;
    void* args[] = {&p};
    hipError_t e = hipLaunchCooperativeKernel((const void*)hybrid_fwd, dim3(grid), dim3(512), args, LDS_BYTES, stream);
    if (e != hipSuccess) fprintf(stderr, "kernel_launch: cooperative launch failed: %s (grid %d)\n", hipGetErrorString(e), grid);
}
```

```cpp
#include <hip/hip_runtime.h>
#include <hip/hip_cooperative_groups.h>
#include <cstdio>
#include <cstdint>
namespace cg = cooperative_groups;
namespace pg8 {
#define PG8_LAS __attribute__((address_space(3)))
typedef unsigned short bf16_t;
typedef short bf16x8 __attribute__((ext_vector_type(8)));
typedef float f32x4 __attribute__((ext_vector_type(4)));
typedef unsigned u32x4 __attribute__((ext_vector_type(4)));
constexpr int BM = 256, BK = 64, HALF = 128, HTB = HALF * BK * 2  , STAGE_BYTES = 8 * HTB, NXCD = 8, WGM = 8;

__host__ __device__ __forceinline__ int lds_byte(int r, int c) { const int st = (r >> 4) * 2 + (c >> 5), rr = r & 15, cc = c & 31, ob = rr * 64 + cc * 2; return st * 1024 + (ob ^ (((ob >> 9) & 1) << 5)); }
__host__ __device__ __forceinline__ void stage_rc(int b, int& R, int& C) { const int st = b / 1024, sb = b % 1024, swz = sb ^ (((sb >> 9) & 1) << 5); R = (st >> 1) * 16 + swz / 64; C = (st & 1) * 32 + (swz % 64) / 2; }
__host__ __device__ __forceinline__ int perm32(int rho) { const int n = rho >> 4, i = rho & 15; return 8 * (i >> 2) + 4 * n + (i & 3); }

struct Unit { int pm, pn; };
struct Gemm { const bf16_t* A; const bf16_t* Bt; int M, N, K; };

struct StaticOrder {
    int nM, nN, nwg, G, c;
    __host__ __device__ void init(int M, int N, int G_, int c_) { nM = M / BM; nN = N / BM; nwg = nM * nN; G = G_; c = c_; }
    __host__ __device__ bool next(int i, Unit& u) const {
        const long L = (long)i * G + c; if (L >= nwg) return false;
        int wgid = (int)L; { const int q = nwg / NXCD, r = nwg % NXCD, xcd = wgid % NXCD, off = wgid / NXCD; wgid = (xcd < r ? xcd * (q + 1) : r * (q + 1) + (xcd - r) * q) + off; }
        const int nig = WGM * nN, gid = wgid / nig, fm = gid * WGM, gsz = (nM - fm) < WGM ? (nM - fm) : WGM;
        u.pm = fm + ((wgid % nig) % gsz); u.pn = (wgid % nig) / gsz; return true;
    }
    __device__ __forceinline__ void a_ready(const Unit&) const {}
    __device__ __forceinline__ void done(const Unit&) const {}
};

__device__ __forceinline__ unsigned f2bf_u(float f) { unsigned u = __builtin_bit_cast(unsigned, f); return (u + 0x7fffu + ((u >> 16) & 1u)) >> 16; }
__device__ __forceinline__ unsigned pk2bf(float lo, float hi) { return f2bf_u(lo) | (f2bf_u(hi) << 16); }

__device__ __forceinline__ unsigned cvtpk_bf16(float lo, float hi) { typedef float f2_ __attribute__((ext_vector_type(2))); typedef __bf16 b2_ __attribute__((ext_vector_type(2)));
    f2_ v = {lo, hi}; b2_ b = __builtin_convertvector(v, b2_); return __builtin_bit_cast(unsigned, b); }
__device__ __forceinline__ float swz_xor16(float v) { return __uint_as_float((unsigned)__builtin_amdgcn_ds_swizzle((int)__float_as_uint(v), 0x1F | (16 << 10))); }
__device__ __forceinline__ float half_sum(float v) { auto rr = __builtin_amdgcn_permlane32_swap(__float_as_uint(v), __float_as_uint(v), false, false); return __uint_as_float(rr[0]) + __uint_as_float(rr[1]); }
__device__ __forceinline__ float row_rstd(const unsigned long long* ssq, int row) { return __builtin_amdgcn_rsqf((float)ssq[row] * (1.0f / (1048576.0f * 1024.0f)) + 1e-6f); }

struct EpiProj {
    static constexpr bool PERM = true, AFTER_DRAIN = false;
    bf16_t* O; int ldc; float* gates; int gate0; const PG8_LAS unsigned long long* rs_raw;
    __device__ __forceinline__ void operator()(const f32x4 (&acc)[2][2][4][2], const Unit& u, int wr, int wc, int fr, int fq) const {
        const int row0 = u.pm * BM + wr * 64 + fr; const int col0 = u.pn * BM + wc * 32 + 8 * fq;
        float rsv[2][4];
#pragma unroll
        for (int ai = 0; ai < 2; ++ai)
#pragma unroll
            for (int m = 0; m < 4; ++m) rsv[ai][m] = __builtin_amdgcn_rsqf((float)rs_raw[ai * HALF + wr * 64 + m * 16 + fr] * (1.0f / (1048576.0f * 1024.0f)) + 1e-6f);
#pragma unroll
        for (int ai = 0; ai < 2; ++ai)
#pragma unroll
            for (int m = 0; m < 4; ++m) { const int row = row0 + ai * HALF + m * 16; bf16_t* rowp = O + (size_t)row * ldc + col0; const float rs = rsv[ai][m];
#pragma unroll
                for (int bj = 0; bj < 2; ++bj) { const f32x4 v0 = acc[ai][bj][m][0] * rs, v1 = acc[ai][bj][m][1] * rs;
                    u32x4 w; w.x = cvtpk_bf16(v0[0], v0[1]); w.y = cvtpk_bf16(v0[2], v0[3]); w.z = cvtpk_bf16(v1[0], v1[1]); w.w = cvtpk_bf16(v1[2], v1[3]);
                    *(u32x4*)(rowp + bj * HALF) = w;
                    const int c = col0 + bj * HALF - gate0;
                    if (c >= 0 && c < 32) { float* g = gates + (size_t)row * 32 + c; *(f32x4*)g = v0; *(f32x4*)(g + 4) = v1; } } }
    }
};
struct EpiRelu2 {
    static constexpr bool PERM = true, AFTER_DRAIN = false;
    bf16_t* O; int ldc; const PG8_LAS unsigned long long* rs_raw;
    __device__ __forceinline__ void operator()(const f32x4 (&acc)[2][2][4][2], const Unit& u, int wr, int wc, int fr, int fq) const {
        const int row0 = u.pm * BM + wr * 64 + fr; const int col0 = u.pn * BM + wc * 32 + 8 * fq;
        float rsv[2][4];
#pragma unroll
        for (int ai = 0; ai < 2; ++ai)
#pragma unroll
            for (int m = 0; m < 4; ++m) rsv[ai][m] = __builtin_amdgcn_rsqf((float)rs_raw[ai * HALF + wr * 64 + m * 16 + fr] * (1.0f / (1048576.0f * 1024.0f)) + 1e-6f);
#pragma unroll
        for (int ai = 0; ai < 2; ++ai)
#pragma unroll
            for (int m = 0; m < 4; ++m) { const int row = row0 + ai * HALF + m * 16; bf16_t* rowp = O + (size_t)row * ldc + col0; const float rs = rsv[ai][m];
#pragma unroll
                for (int bj = 0; bj < 2; ++bj) { f32x4 v0 = acc[ai][bj][m][0] * rs, v1 = acc[ai][bj][m][1] * rs;
#pragma unroll
                    for (int e = 0; e < 4; ++e) { float a = v0[e] > 0.f ? v0[e] : 0.f; v0[e] = a * a; float b = v1[e] > 0.f ? v1[e] : 0.f; v1[e] = b * b; }
                    u32x4 w; w.x = cvtpk_bf16(v0[0], v0[1]); w.y = cvtpk_bf16(v0[2], v0[3]); w.z = cvtpk_bf16(v1[0], v1[1]); w.w = cvtpk_bf16(v1[2], v1[3]);
                    *(u32x4*)(rowp + bj * HALF) = w; } }
    }
};
struct EpiResid {
    static constexpr bool PERM = true, AFTER_DRAIN = false;
    float* out; int ldc; bf16_t* xb; unsigned long long* ssp;
    __device__ __forceinline__ void operator()(const f32x4 (&acc)[2][2][4][2], const Unit& u, int wr, int wc, int fr, int fq) const {
        const int row0 = u.pm * BM + wr * 64 + fr; const int col0 = u.pn * BM + wc * 32 + 8 * fq;
#pragma unroll
        for (int ai = 0; ai < 2; ++ai) {
        u32x4 bv[1][4][2];
#pragma unroll
            for (int m = 0; m < 4; ++m)
#pragma unroll
                for (int bj = 0; bj < 2; ++bj) bv[0][m][bj] = *(const u32x4*)(xb + (size_t)(row0 + ai * HALF + m * 16) * ldc + col0 + bj * HALF);
        __builtin_amdgcn_sched_barrier(0);
#pragma unroll
            for (int m = 0; m < 4; ++m) { const int row = row0 + ai * HALF + m * 16; const size_t off = (size_t)row * ldc + col0; float ss = 0.f;
#pragma unroll
                for (int bj = 0; bj < 2; ++bj) { const size_t o = off + bj * HALF; const u32x4 b = bv[0][m][bj];
                    f32x4 v0, v1;
                    v0[0] = __uint_as_float(b.x << 16) + acc[ai][bj][m][0][0]; v0[1] = __uint_as_float(b.x & 0xffff0000u) + acc[ai][bj][m][0][1];
                    v0[2] = __uint_as_float(b.y << 16) + acc[ai][bj][m][0][2]; v0[3] = __uint_as_float(b.y & 0xffff0000u) + acc[ai][bj][m][0][3];
                    v1[0] = __uint_as_float(b.z << 16) + acc[ai][bj][m][1][0]; v1[1] = __uint_as_float(b.z & 0xffff0000u) + acc[ai][bj][m][1][1];
                    v1[2] = __uint_as_float(b.w << 16) + acc[ai][bj][m][1][2]; v1[3] = __uint_as_float(b.w & 0xffff0000u) + acc[ai][bj][m][1][3];
                    if (out) { *(f32x4*)(out + o) = v0; *(f32x4*)(out + o + 4) = v1; }
                    else { ss += ((v0[0] * v0[0] + v0[1] * v0[1]) + (v0[2] * v0[2] + v0[3] * v0[3])) + ((v1[0] * v1[0] + v1[1] * v1[1]) + (v1[2] * v1[2] + v1[3] * v1[3]));
                        u32x4 w; w.x = cvtpk_bf16(v0[0], v0[1]); w.y = cvtpk_bf16(v0[2], v0[3]); w.z = cvtpk_bf16(v1[0], v1[1]); w.w = cvtpk_bf16(v1[2], v1[3]); *(u32x4*)(xb + o) = w; } }
                if (!out) { ss += swz_xor16(ss); ss = half_sum(ss); if (fq == 0) atomicAdd(ssp + row, (unsigned long long)(ss * 1048576.0f + 0.5f)); } }
        __builtin_amdgcn_sched_barrier(0);
        }
    }
};

struct EpiAny {
    static constexpr bool AFTER_DRAIN = false;
    int kind; bool perm;
    bf16_t* O; int ldc; float* gates; int gate0; const float* base; float* out; bf16_t* xb; unsigned long long* ssp;
    PG8_LAS unsigned long long* rs_raw;
    __device__ __forceinline__ void operator()(const f32x4 (&acc)[2][2][4][2], const Unit& u, int wr, int wc, int fr, int fq) const {
        if (kind == 0) { EpiProj e{O, ldc, gates, gate0, rs_raw}; e(acc, u, wr, wc, fr, fq); }
        else if (kind == 1) { EpiRelu2 e{O, ldc, rs_raw}; e(acc, u, wr, wc, fr, fq); }
        else { EpiResid e{out, ldc, xb, ssp}; e(acc, u, wr, wc, fr, fq); }
    }
};
template <class Epi, class Sched, bool ALIGN_EPI = false, bool SP2 = false>
__device__ __forceinline__ void gemm_phase(PG8_LAS unsigned char* lds, const Gemm g, const Sched& S, const Epi& E, const int tid) {
    const int wid = __builtin_amdgcn_readfirstlane(tid >> 6), lane = tid & 63, wr = wid >> 2, wc = wid & 3, fr = lane & 15, fq = lane >> 4;
    const int K = g.K, nt = K / BK;
    unsigned voffA[2], voffB[2];
#pragma unroll
    for (int i = 0; i < 2; ++i) { int R, C; stage_rc(tid * 16 + i * 8192, R, C); const int Rb = E.perm ? ((R & ~31) + perm32(R & 31)) : R;
        voffA[i] = (unsigned)(R * K + C) * 2u; voffB[i] = (unsigned)(Rb * K + C) * 2u; }
    const size_t kstep = (size_t)(BK * 2);
    const size_t hstep = (size_t)HALF * K * 2;
    const size_t tstep = 2 * hstep;
    const unsigned ldsw = (unsigned)wid * 1024u;
    const int aoff = lds_byte(wr * 64 + fr, fq * 8), boff = lds_byte(wc * 32 + fr, fq * 8);
#define PG8_SA(b, h) (((b) * 2 + (h)) * HTB)
#define PG8_SB(b, h) ((4 + (b) * 2 + (h)) * HTB)
#define PG8_STAGE(bufoff, gbase, voff) do { _Pragma("unroll") for (int _i = 0; _i < 2; ++_i) \
        __builtin_amdgcn_global_load_lds((const unsigned*)((const char*)(gbase) + (voff)[_i]), (PG8_LAS unsigned*)(lds + (bufoff) + ldsw + _i * 8192), 16, 0, 0); } while (0)
#define PG8_LDA(dst, b, h) do { _Pragma("unroll") for (int m = 0; m < 4; ++m) _Pragma("unroll") for (int k = 0; k < 2; ++k) dst[m][k] = *(const PG8_LAS bf16x8*)(lds + PG8_SA(b, h) + aoff + m * 2048 + k * 1024); } while (0)
#define PG8_LDB(dst, b, h) do { _Pragma("unroll") for (int n = 0; n < 2; ++n) _Pragma("unroll") for (int k = 0; k < 2; ++k) dst[n][k] = *(const PG8_LAS bf16x8*)(lds + PG8_SB(b, h) + boff + n * 2048 + k * 1024); } while (0)
#define PG8_MMA(ai, bj, At, Bt) do { __builtin_amdgcn_s_setprio(1); _Pragma("unroll") for (int m = 0; m < 4; ++m) _Pragma("unroll") for (int n = 0; n < 2; ++n) _Pragma("unroll") for (int k = 0; k < 2; ++k) \
        acc[ai][bj][m][n] = __builtin_amdgcn_mfma_f32_16x16x32_bf16(Bt[n][k], At[m][k], acc[ai][bj][m][n], 0, 0, 0); __builtin_amdgcn_s_setprio(0); } while (0)
#define PG8_WAIT_V(n) asm volatile("s_waitcnt vmcnt(" #n ")" ::: "memory")
#define PG8_WAIT_L(n) asm volatile("s_waitcnt lgkmcnt(" #n ")" ::: "memory")
#define PG8_BAR __builtin_amdgcn_s_barrier()
#define PG8_SCHED __builtin_amdgcn_sched_barrier(0)
    Unit cur, nxt; int ui = 0;
    if (!S.next(0, cur)) return;
    f32x4 acc[2][2][4][2];
#pragma unroll
    for (int a = 0; a < 2; ++a)
#pragma unroll
        for (int b = 0; b < 2; ++b)
#pragma unroll
            for (int m = 0; m < 4; ++m)
#pragma unroll
                for (int n = 0; n < 2; ++n) acc[a][b][m][n] = (f32x4){0.f, 0.f, 0.f, 0.f};
    bf16x8 At[4][2], B0[2][2], B1[2][2];
    const char* cA = (const char*)g.A + (size_t)cur.pm * tstep; const char* cB = (const char*)g.Bt + (size_t)cur.pn * tstep;
    S.a_ready(cur);
    if constexpr (SP2) {
        PG8_STAGE(PG8_SB(0, 0), cB, voffB); PG8_STAGE(PG8_SB(0, 1), cB + hstep, voffB); PG8_STAGE(PG8_SA(0, 0), cA, voffA); PG8_STAGE(PG8_SA(0, 1), cA + hstep, voffA);
        if (wr == 1) PG8_BAR;
        PG8_WAIT_V(2); PG8_BAR;
        PG8_STAGE(PG8_SB(1, 0), cB + kstep, voffB); PG8_STAGE(PG8_SA(1, 0), cA + kstep, voffA); PG8_STAGE(PG8_SB(1, 1), cB + hstep + kstep, voffB);
        PG8_WAIT_V(6); PG8_BAR;
    } else {
        PG8_STAGE(PG8_SB(0, 0), cB, voffB); PG8_STAGE(PG8_SA(0, 0), cA, voffA); PG8_STAGE(PG8_SB(0, 1), cB + hstep, voffB); PG8_STAGE(PG8_SA(0, 1), cA + hstep, voffA);
        if (wr == 1) PG8_BAR;
        PG8_WAIT_V(4); PG8_BAR;
        PG8_STAGE(PG8_SB(1, 0), cB + kstep, voffB); PG8_STAGE(PG8_SA(1, 0), cA + kstep, voffA); PG8_STAGE(PG8_SB(1, 1), cB + hstep + kstep, voffB);
        PG8_WAIT_V(6); PG8_BAR;
    }
    for (;;) {
        const bool has_next = S.next(ui + 1, nxt);
        const char* nA = has_next ? (const char*)g.A + (size_t)nxt.pm * tstep : cA; const char* nB = has_next ? (const char*)g.Bt + (size_t)nxt.pn * tstep : cB;
        for (int t = 0; t < nt; t += 2) {
            const bool last = (t == nt - 2);
            const char* a1 = cA + (size_t)(t + 1) * kstep;
            const char* a2 = last ? nA : cA + (size_t)(t + 2) * kstep; const char* b2 = last ? nB : cB + (size_t)(t + 2) * kstep;
            const char* a3 = a2 + kstep; const char* b3 = b2 + kstep;
            if (last && has_next) S.a_ready(nxt);
            if (last) __builtin_amdgcn_global_load_lds((const unsigned*)(E.ssp + (size_t)cur.pm * BM + 32 * wid) + lane, (PG8_LAS unsigned*)E.rs_raw + wid * 64, 4, 0, 0);
            if constexpr (SP2) {
            PG8_LDB(B0, 0, 0); PG8_LDB(B1, 0, 1); PG8_SCHED; PG8_LDA(At, 0, 0); PG8_STAGE(PG8_SA(1, 1), a1 + hstep, voffA);
            PG8_WAIT_V(8); PG8_WAIT_L(0); PG8_BAR; PG8_MMA(0, 0, At, B0); PG8_MMA(0, 1, At, B1); PG8_BAR; PG8_SCHED;
            PG8_LDA(At, 0, 1); PG8_STAGE(PG8_SB(0, 0), b2, voffB); PG8_STAGE(PG8_SB(0, 1), b2 + hstep, voffB); PG8_STAGE(PG8_SA(0, 0), a2, voffA);
            PG8_WAIT_V(8); PG8_WAIT_L(0); PG8_BAR; PG8_MMA(1, 0, At, B0); PG8_MMA(1, 1, At, B1); PG8_BAR; PG8_SCHED;
            PG8_LDB(B0, 1, 0); PG8_LDB(B1, 1, 1); PG8_SCHED; PG8_LDA(At, 1, 0); PG8_STAGE(PG8_SA(0, 1), a2 + hstep, voffA);
            PG8_WAIT_V(8); PG8_WAIT_L(0); PG8_BAR; PG8_MMA(0, 0, At, B0); PG8_MMA(0, 1, At, B1); PG8_BAR; PG8_SCHED;
            PG8_LDA(At, 1, 1); PG8_STAGE(PG8_SB(1, 0), b3, voffB); PG8_STAGE(PG8_SB(1, 1), b3 + hstep, voffB); PG8_STAGE(PG8_SA(1, 0), a3, voffA);
            PG8_WAIT_V(8); PG8_WAIT_L(0); PG8_BAR; PG8_MMA(1, 0, At, B0); PG8_MMA(1, 1, At, B1); PG8_BAR; PG8_SCHED;
            } else {
            PG8_LDB(B0, 0, 0); PG8_SCHED; PG8_LDA(At, 0, 0); PG8_STAGE(PG8_SA(1, 1), a1 + hstep, voffA);
            PG8_WAIT_L(8); PG8_BAR; PG8_WAIT_L(0); PG8_MMA(0, 0, At, B0); PG8_BAR; PG8_SCHED;
            PG8_LDB(B1, 0, 1); PG8_STAGE(PG8_SB(0, 0), b2, voffB);
            PG8_BAR; PG8_WAIT_L(0); PG8_MMA(0, 1, At, B1); PG8_BAR;
            PG8_LDA(At, 0, 1); PG8_STAGE(PG8_SA(0, 0), a2, voffA);
            PG8_BAR; PG8_WAIT_L(0); PG8_MMA(1, 0, At, B0); PG8_BAR; PG8_SCHED;
            PG8_STAGE(PG8_SB(0, 1), b2 + hstep, voffB);
            PG8_WAIT_V(6); PG8_BAR; PG8_MMA(1, 1, At, B1); PG8_BAR;
            PG8_LDB(B0, 1, 0); PG8_SCHED; PG8_LDA(At, 1, 0); PG8_STAGE(PG8_SA(0, 1), a2 + hstep, voffA);
            PG8_WAIT_L(8); PG8_BAR; PG8_WAIT_L(0); PG8_MMA(0, 0, At, B0); PG8_BAR; PG8_SCHED;
            PG8_LDB(B1, 1, 1); PG8_STAGE(PG8_SB(1, 0), b3, voffB);
            PG8_BAR; PG8_WAIT_L(0); PG8_MMA(0, 1, At, B1); PG8_BAR;
            PG8_LDA(At, 1, 1); PG8_STAGE(PG8_SA(1, 0), a3, voffA);
            PG8_BAR; PG8_WAIT_L(0); PG8_MMA(1, 0, At, B0); PG8_BAR; PG8_SCHED;
            PG8_STAGE(PG8_SB(1, 1), b3 + hstep, voffB);
            PG8_WAIT_V(6); PG8_BAR; PG8_MMA(1, 1, At, B1); PG8_BAR;
            }
        }
        if constexpr (ALIGN_EPI) { if (wr == 0) PG8_BAR; }
        if constexpr (!Epi::AFTER_DRAIN) { E(acc, cur, wr, wc, fr, fq); S.done(cur); }
        if (!has_next) break;
#pragma unroll
        for (int a = 0; a < 2; ++a)
#pragma unroll
            for (int b = 0; b < 2; ++b)
#pragma unroll
                for (int m = 0; m < 4; ++m)
#pragma unroll
                    for (int n = 0; n < 2; ++n) acc[a][b][m][n] = (f32x4){0.f, 0.f, 0.f, 0.f};
        cur = nxt; cA = nA; cB = nB; ++ui;
        if constexpr (ALIGN_EPI) { if (wr == 1) PG8_BAR; }
    }
    PG8_WAIT_V(0);
    if constexpr (!ALIGN_EPI) { if (wr == 0) PG8_BAR; }
    PG8_BAR;
    if constexpr (Epi::AFTER_DRAIN) { E.fused(acc, cur, wr, wc, fr, fq, lds, wid, lane); S.done(cur); }
#undef PG8_SA
#undef PG8_SB
#undef PG8_STAGE
#undef PG8_LDA
#undef PG8_LDB
#undef PG8_MMA
#undef PG8_WAIT_V
#undef PG8_WAIT_L
#undef PG8_BAR
#undef PG8_SCHED
}
}

typedef unsigned short bf16;
constexpr int NB = 4, SEQ = 8192, T = NB * SEQ, DM = 1024, DFF = 4096, DEPTH = 2;
constexpr int DIN = 3476, DINP = 3584;
constexpr int C_MQ = 0, C_MK = 512, C_MV = 1024, C_MO = 1536, C_BQ = 2048, C_BK = 2304, C_BV = 2560, C_NQ = 2816,
              C_NKC = 3072, C_NVC = 3136, C_NKS = 3200, C_NVS = 3264, C_NKW = 3328, C_NVW = 3392, C_GATE = 3456;
constexpr int NCMP = 511;
constexpr float EPS = 1e-6f;

__device__ __forceinline__ float bf2f(bf16 v) { return __builtin_bit_cast(float, (unsigned)v << 16); }
__device__ __forceinline__ bf16 f2bf(float f) { return (bf16)pg8::f2bf_u(f); }
template <int MASK> __device__ __forceinline__ float shx(float v) {
    if constexpr (MASK == 32) { auto rr = __builtin_amdgcn_permlane32_swap(__float_as_uint(v), __float_as_uint(v), false, false);
        return __uint_as_float(__builtin_amdgcn_mbcnt_lo(~0u, 0u) == 32u ? rr[0] : rr[1]); }
    else return __uint_as_float((unsigned)__builtin_amdgcn_ds_swizzle((int)__float_as_uint(v), 0x1F | (MASK << 10)));
}
__device__ __forceinline__ float xchg32(float v, int hi) { auto rr = __builtin_amdgcn_permlane32_swap(__float_as_uint(v), __float_as_uint(v), false, false); return __uint_as_float(hi ? rr[0] : rr[1]); }
__device__ __forceinline__ float hsum32(float v) { auto rr = __builtin_amdgcn_permlane32_swap(__float_as_uint(v), __float_as_uint(v), false, false); return __uint_as_float(rr[0]) + __uint_as_float(rr[1]); }
__device__ __forceinline__ float hmax32(float v) { auto rr = __builtin_amdgcn_permlane32_swap(__float_as_uint(v), __float_as_uint(v), false, false); return fmaxf(__uint_as_float(rr[0]), __uint_as_float(rr[1])); }
template <int MASK> __device__ __forceinline__ unsigned shxu(unsigned v) { return __float_as_uint(shx<MASK>(__uint_as_float(v))); }
__device__ __forceinline__ float wave_sum(float v) {
    v += shx<1>(v); v += shx<2>(v); v += shx<4>(v); v += shx<8>(v); v += shx<16>(v);
    auto rr = __builtin_amdgcn_permlane32_swap(__float_as_uint(v), __float_as_uint(v), false, false); return __uint_as_float(rr[0]) + __uint_as_float(rr[1]);
}
__device__ __forceinline__ float wave_max(float v) {
    v = fmaxf(v, shx<1>(v)); v = fmaxf(v, shx<2>(v)); v = fmaxf(v, shx<4>(v)); v = fmaxf(v, shx<8>(v)); v = fmaxf(v, shx<16>(v));
    auto rr = __builtin_amdgcn_permlane32_swap(__float_as_uint(v), __float_as_uint(v), false, false); return fmaxf(__uint_as_float(rr[0]), __uint_as_float(rr[1]));
}
__device__ __forceinline__ float sgprf(float c) { asm volatile("" : "+s"(c)); return c; }
#define nbg (sgprf(-1e30f))
__device__ __forceinline__ int mk_tid(int wave_s) { int t; asm volatile("v_mbcnt_lo_u32_b32 %0, -1, 0\n\tv_mbcnt_hi_u32_b32 %0, -1, %0" : "=v"(t)); return t + wave_s * 64; }
__device__ __forceinline__ float zf_() { float z = 0.f; asm volatile("" : "+v"(z)); return z; }
__device__ __forceinline__ float rcpf_(float x) { return __builtin_amdgcn_rcpf(x); }
__device__ __forceinline__ float sigmoidf_(float x) { return rcpf_(1.f + __expf(-x)); }
__device__ __forceinline__ float log_sigmoidf_(float x) { return fminf(x, 0.f) - __logf(1.f + __expf(-fabsf(x))); }
__device__ __forceinline__ void rope_cs(int pos, int f, float& c, float& s) {
    const float invf = f == 0 ? 1.0f : f == 1 ? 0.193922758102417f : f == 2 ? 0.03760603442788124f : f == 3 ? 0.007292666472494602f : f == 4 ? 0.0014142136787995696f
                     : f == 5 ? 0.00027424818836152554f : f == 6 ? 5.318298644851893e-05f : 1.031338433676865e-05f;
    const float ang = (float)pos * invf;
    const float k = rintf(ang * 0.15915493667125702f);
    float r = fmaf(-k, 6.2831854820251465f, ang); r = fmaf(-k, -1.7484555314695172e-07f, r);
    c = __cosf(r); s = __sinf(r);
}


__device__ __forceinline__ float dot64(const bf16* __restrict__ kp, const float* q) {
    const uint4* k4 = (const uint4*)kp; float a = 0.f;
#pragma unroll
    for (int j = 0; j < 8; ++j) { const uint4 w = k4[j]; const unsigned ww[4] = {w.x, w.y, w.z, w.w};
#pragma unroll
        for (int e = 0; e < 4; ++e) { a = fmaf(q[8 * j + 2 * e], __builtin_bit_cast(float, ww[e] << 16), a); a = fmaf(q[8 * j + 2 * e + 1], __builtin_bit_cast(float, ww[e] & 0xffff0000u), a); } }
    return a;
}
__device__ __forceinline__ void dot64x4(const bf16* __restrict__ kp, const float (*q)[64], float (&a)[4]) {
    const uint4* k4 = (const uint4*)kp; a[0] = a[1] = a[2] = a[3] = 0.f;
#pragma unroll
    for (int j = 0; j < 8; ++j) { const uint4 w = k4[j]; const unsigned ww[4] = {w.x, w.y, w.z, w.w};
#pragma unroll
        for (int e = 0; e < 4; ++e) { const float k0 = __builtin_bit_cast(float, ww[e] << 16), k1 = __builtin_bit_cast(float, ww[e] & 0xffff0000u);
#pragma unroll
            for (int h = 0; h < 4; ++h) { a[h] = fmaf(q[h][8 * j + 2 * e], k0, a[h]); a[h] = fmaf(q[h][8 * j + 2 * e + 1], k1, a[h]); } } }
}

__host__ __device__ __forceinline__ int win_src(int n) {
    if (n < 2048) return n;
    if (n < 3456) return n + 8;
    if (n < 3464) return n - 3456 + 2048;
    if (n < 3476) return n;
    return -1;
}


typedef unsigned u32x4p __attribute__((ext_vector_type(4)));
__device__ __forceinline__ void cw_load(float (&v)[16], const float* __restrict__ W, int N, int NP, int mode, int item, int t, const float* __restrict__ gk) {
    const int nbx = NP / 64; const int n0 = (item % nbx) * 64, k0 = (item / nbx) * 64, c = t & 63, r = t >> 6;
    const int src = mode ? win_src(n0 + c) : (n0 + c);
    const int srcc = src >= 0 ? src : 0; const float msk = src >= 0 ? 1.f : 0.f;
#pragma unroll
    for (int i = 0; i < 16; ++i) v[i] = W[(size_t)(k0 + r + 4 * i) * N + srcc];
    if (gk) { float gv[16];
#pragma unroll
        for (int i = 0; i < 16; ++i) gv[i] = gk[k0 + r + 4 * i];
#pragma unroll
        for (int i = 0; i < 16; ++i) v[i] *= gv[i]; }
#pragma unroll
    for (int i = 0; i < 16; ++i) v[i] *= msk;
}
__device__ __forceinline__ void ph_convert_mat(const float* __restrict__ W, int K, int N, int NP, bf16* __restrict__ WT, int mode, int vb, int NVB, int t, float* tile, const float* __restrict__ gk = nullptr) {
    const int nit = (NP / 64) * (K / 64), nbx = NP / 64, c = t & 63, r = t >> 6;
    float v[16];
    if (vb < nit) cw_load(v, W, N, NP, mode, vb, t, gk);
    for (int it0 = 0; it0 < nit; it0 += NVB) { const int it = it0 + vb; const bool act = it < nit;
        if (act) {
#pragma unroll
            for (int i = 0; i < 16; ++i) tile[(r + 4 * i) * 65 + c] = v[i]; }
        if (it + NVB < nit) cw_load(v, W, N, NP, mode, it + NVB, t, gk);
        __syncthreads();
        if (act) { const int n0 = (it % nbx) * 64, k0 = (it / nbx) * 64, n = t >> 2, kc = (t & 3) * 16;
            u32x4p w0, w1;
#pragma unroll
            for (int e = 0; e < 4; ++e) { w0[e] = pg8::cvtpk_bf16(tile[(kc + 2 * e) * 65 + n], tile[(kc + 2 * e + 1) * 65 + n]); w1[e] = pg8::cvtpk_bf16(tile[(kc + 8 + 2 * e) * 65 + n], tile[(kc + 8 + 2 * e + 1) * 65 + n]); }
            u32x4p* dst = (u32x4p*)(WT + (size_t)(n0 + n) * K + k0 + kc); dst[0] = w0; dst[1] = w1; }
        __syncthreads();
    }
}
__device__ __forceinline__ void ph_x_row(const float* __restrict__ x, bf16* __restrict__ XB, unsigned long long* __restrict__ ssq, int row, int lane) {
    const float4* xr = (const float4*)(x + (size_t)row * DM) + lane;
    float4 v[4]; float s = 0.f;
#pragma unroll
    for (int j = 0; j < 4; ++j) { v[j] = xr[64 * j]; s += v[j].x * v[j].x + v[j].y * v[j].y + v[j].z * v[j].z + v[j].w * v[j].w; }
    s = wave_sum(s);
    uint2* o = (uint2*)(XB + (size_t)row * DM) + lane;
#pragma unroll
    for (int j = 0; j < 4; ++j) { uint2 w; w.x = pg8::cvtpk_bf16(v[j].x, v[j].y); w.y = pg8::cvtpk_bf16(v[j].z, v[j].w); o[64 * j] = w; }
    if (lane == 0) ssq[row] = (unsigned long long)(s * 1048576.0f + 0.5f);
}
__device__ __forceinline__ void ph_prep(bf16* __restrict__ P, const float* __restrict__ tab, const float* __restrict__ moba_g, const float* __restrict__ nsa_qg, const float* __restrict__ nsa_kg,
                                        float* __restrict__ kmean, int item, bool act, int t, float* red  ) {
    const int lane = t & 63, wid = t >> 6, tb = item % 128, kind = item / 128, rg = lane >> 3, dch = lane & 7;
    if (act) {
        int col; const float* g; bool rope;
        if (kind < 4) { col = C_BQ + kind * 64; g = moba_g; rope = true; }
        else if (kind < 8) { col = C_BK + (kind - 4) * 64; g = moba_g + 64; rope = true; }
        else if (kind < 12) { col = C_NQ + (kind - 8) * 64; g = nsa_qg; rope = false; }
        else if (kind == 12) { col = C_NKS; g = nsa_kg + 64; rope = true; }
        else { col = C_NKW; g = nsa_kg + 128; rope = true; }
        float gd[8];
#pragma unroll
        for (int e = 0; e < 8; ++e) gd[e] = g[dch * 8 + e];
        const int row0 = tb * 256 + wid * 64 + rg;
        u32x4p raw[8];
#pragma unroll
        for (int it = 0; it < 8; ++it) raw[it] = *(const u32x4p*)(P + (size_t)(row0 + it * 8) * DINP + col + dch * 8);
        float ks[8];
#pragma unroll
        for (int e = 0; e < 8; ++e) ks[e] = 0.f;
#pragma unroll
        for (int it = 0; it < 8; ++it) {
            const int row = row0 + it * 8, pos = row & (SEQ - 1);
            float y[8]; float ss = 0.f;
#pragma unroll
            for (int e = 0; e < 4; ++e) { y[2 * e] = __builtin_bit_cast(float, raw[it][e] << 16); y[2 * e + 1] = __builtin_bit_cast(float, raw[it][e] & 0xffff0000u); ss += y[2 * e] * y[2 * e] + y[2 * e + 1] * y[2 * e + 1]; }
            ss += shx<1>(ss); ss += shx<2>(ss); ss += shx<4>(ss);
            const float rstd = rsqrtf(ss * (1.f / 64.f) + EPS);
#pragma unroll
            for (int e = 0; e < 8; ++e) y[e] *= rstd * gd[e];
            if (rope) {
                float o[8];
#pragma unroll
                for (int e = 0; e < 8; ++e) o[e] = shx<1>(y[e]);
                if (dch < 2) { const float4 c0 = *(const float4*)(tab + pos * 16), c1 = *(const float4*)(tab + pos * 16 + 4), s0 = *(const float4*)(tab + pos * 16 + 8), s1 = *(const float4*)(tab + pos * 16 + 12);
                    const float cs[8] = {c0.x, c0.y, c0.z, c0.w, c1.x, c1.y, c1.z, c1.w}, sn[8] = {s0.x, s0.y, s0.z, s0.w, s1.x, s1.y, s1.z, s1.w};
#pragma unroll
                    for (int e = 0; e < 8; ++e) y[e] = dch ? (y[e] * cs[e] + o[e] * sn[e]) : (y[e] * cs[e] - o[e] * sn[e]); }
            }
            u32x4p w; w[0] = pg8::pk2bf(y[0], y[1]); w[1] = pg8::pk2bf(y[2], y[3]); w[2] = pg8::pk2bf(y[4], y[5]); w[3] = pg8::pk2bf(y[6], y[7]);
            *(u32x4p*)(P + (size_t)row * DINP + col + dch * 8) = w;
#pragma unroll
            for (int e = 0; e < 8; ++e) ks[e] += y[e];
        }
        if (kind >= 4 && kind < 8) {
#pragma unroll
            for (int e = 0; e < 8; ++e) { ks[e] += shx<8>(ks[e]); ks[e] += shx<16>(ks[e]); ks[e] += shx<32>(ks[e]); }
            if (rg == 0) {
#pragma unroll
                for (int e = 0; e < 8; ++e) red[wid * 64 + dch * 8 + e] = ks[e]; }
        }
    }
    __syncthreads();
    if (act && kind >= 4 && kind < 8 && wid == 0) { const float s = red[lane] + red[64 + lane] + red[128 + lane] + red[192 + lane];
        const int b = tb >> 5, n = tb & 31; kmean[(((size_t)b * 4 + (kind - 4)) * 32 + n) * 64 + lane] = s * (1.f / 256.f); }
    __syncthreads();
}
__device__ __forceinline__ void ph_compress(const bf16* __restrict__ P, const float* __restrict__ pe, const float* __restrict__ w1, const float* __restrict__ w2, const float* __restrict__ kg0,
                                            float* __restrict__ KVc, bf16* __restrict__ KVcb, int item, bool act, int t, float* sm  ) {
    float* in = sm; float* hid = sm + 2048;
    const int i = item % NCMP, b = (item / NCMP) & 3, kv = item / (NCMP * 4);
    const int col = kv ? C_NVC : C_NKC;
    if (act) for (int e = t; e < 2048; e += 256) { const int p = e >> 6, d = e & 63; in[e] = bf2f(P[(size_t)(b * SEQ + 16 * i + p) * DINP + col + d]) + pe[(kv * 32 + p) * 64 + d]; }
    __syncthreads();
    if (act && t < 128) { const float* w = w1 + (size_t)kv * 2048 * 128 + t; float a = 0.f;
#pragma unroll 8
        for (int k = 0; k < 2048; ++k) a = fmaf(in[k], w[(size_t)k * 128], a);
        hid[t] = a * rcpf_(1.f + __expf(-a)); }
    __syncthreads();
    if (act && t < 64) { const float* ww = w2 + (size_t)kv * 128 * 64 + t; float o = 0.f;
#pragma unroll 8
        for (int j = 0; j < 128; ++j) o = fmaf(hid[j], ww[j * 64], o);
        if (kv == 0) { const float ss = wave_sum(o * o); o = o * rsqrtf(ss * (1.f / 64.f) + EPS) * kg0[t]; }
        KVc[(((size_t)kv * NB + b) * 512 + i) * 64 + t] = o; KVcb[(((size_t)kv * NB + b) * 512 + i) * 64 + t] = f2bf(o);
        if (i == NCMP - 1) KVcb[(((size_t)kv * NB + b) * 512 + NCMP) * 64 + t] = 0; }
    __syncthreads();
}
__device__ __forceinline__ float conv_silu(const bf16* __restrict__ P, const float* __restrict__ cw  , int rowbase, int t, int c) {
    float a = 0.f;
#pragma unroll
    for (int j = 0; j < 4; ++j) { const int tt = t - 3 + j; if (tt >= 0) a = fmaf(cw[j * 1024 + c], bf2f(P[(size_t)(rowbase + tt) * DINP + c]), a); }
    return a * rcpf_(1.f + __expf(-a));
}
__device__ __forceinline__ void ph_mlstm_local(const bf16* __restrict__ P, const float* __restrict__ G, const float* __restrict__ cw, const float* __restrict__ bif,
                                               float* __restrict__ Cst, float* __restrict__ nst, float* __restrict__ dec, int u, bool act, int tid, unsigned char* sm) {
    bf16 (*ks)[128] = (bf16 (*)[128])sm; bf16 (*vs)[128] = (bf16 (*)[128])(sm + 16384); float* wS = (float*)(sm + 32768); float* lf = wS + 64;
    const int c = u & 127, h = (u >> 7) & 3, b = u >> 9;
    const int rowbase = b * SEQ, t0 = c * 64;
    if (act) {
        for (int e = tid; e < 64 * 128; e += 256) { const int s = e >> 7, d = e & 127;
            ks[s][d] = f2bf(conv_silu(P, cw, rowbase, t0 + s, 512 + h * 128 + d) * 0.08838834764831845f);
            vs[s][d] = P[(size_t)(rowbase + t0 + s) * DINP + C_MV + h * 128 + d]; }
        if (tid < 64) lf[tid] = log_sigmoidf_(G[(size_t)(rowbase + t0 + tid) * 32 + 4 + h] + bif[4 + h]);
    }
    __syncthreads();
    if (act && tid == 0) { float acc = 0.f;
        for (int s = 0; s < 64; ++s) { acc += lf[s]; lf[s] = acc; }
        dec[u] = __expf(acc); }
    __syncthreads();
    if (act && tid < 64) wS[tid] = __expf(lf[63] - lf[tid] + G[(size_t)(rowbase + t0 + tid) * 32 + h] + bif[h]);
    __syncthreads();
    if (act) {
        const int d = tid >> 1, e0 = (tid & 1) * 64;
        float acc[64];
#pragma unroll
        for (int e = 0; e < 64; ++e) acc[e] = 0.f;
        float an = 0.f;
        for (int s = 0; s < 64; ++s) { const float kw = wS[s] * bf2f(ks[s][d]); an += kw;
#pragma unroll
            for (int e = 0; e < 64; ++e) acc[e] = fmaf(kw, bf2f(vs[s][e0 + e]), acc[e]); }
        float* o = Cst + ((size_t)u * 128 + d) * 128 + e0;
#pragma unroll
        for (int e = 0; e < 64; ++e) o[e] = acc[e];
        if ((tid & 1) == 0) nst[(size_t)u * 128 + d] = an;
    }
    __syncthreads();
}
__device__ __forceinline__ void ph_mlstm_scan(float* __restrict__ Cst, float* __restrict__ nst, const float* __restrict__ dec, int item, int tid) {
    const int bh = item / 65, part = item % 65;
    float* base; int stride;
    if (part < 64) { base = Cst + (size_t)bh * 128 * 16384 + part * 256 + tid; stride = 16384; }
    else { if (tid >= 128) return; base = nst + (size_t)bh * 128 * 128 + tid; stride = 128; }
    float C = 0.f;
    for (int c = 0; c < 128; ++c) { const float dC = base[(size_t)c * stride]; base[(size_t)c * stride] = C; C = dec[bh * 128 + c] * C + dC; }
}
__device__ __forceinline__ void ph_mlstm_out(const bf16* __restrict__ P, const float* __restrict__ G, const float* __restrict__ cw, const float* __restrict__ bif,
                                             const float* __restrict__ Cst, const float* __restrict__ nst, const float* __restrict__ mnorm, bf16* __restrict__ MIX, int u, bool act, int tid, unsigned char* sm) {
    bf16 (*qs)[128] = (bf16 (*)[128])sm; float* ksS = (float*)(sm + 16384); bf16 (*ks)[128] = (bf16 (*)[128])ksS; bf16 (*vs)[128] = (bf16 (*)[128])(sm + 32768);
    float* bb = (float*)(sm + 49152); float* li = bb + 64;
    const int c = u & 127, h = (u >> 7) & 3, b = u >> 9;
    const int rowbase = b * SEQ, t0 = c * 64;
    if (act) {
        for (int e = tid; e < 64 * 128; e += 256) { const int s = e >> 7, d = e & 127;
            qs[s][d] = f2bf(conv_silu(P, cw, rowbase, t0 + s, h * 128 + d));
            ks[s][d] = f2bf(conv_silu(P, cw, rowbase, t0 + s, 512 + h * 128 + d) * 0.08838834764831845f);
            vs[s][d] = P[(size_t)(rowbase + t0 + s) * DINP + C_MV + h * 128 + d]; }
        if (tid < 64) { bb[tid] = log_sigmoidf_(G[(size_t)(rowbase + t0 + tid) * 32 + 4 + h] + bif[4 + h]); li[tid] = G[(size_t)(rowbase + t0 + tid) * 32 + h] + bif[h]; }
    }
    __syncthreads();
    if (act && tid == 0) { float acc = 0.f; for (int s = 0; s < 64; ++s) { acc += bb[s]; bb[s] = acc; } }
    __syncthreads();
    const int t = tid >> 2, part = tid & 3;
    float sreg[16];
    if (act) {
        const int s0 = part * 16;
#pragma unroll
        for (int j = 0; j < 16; ++j) { const int s = s0 + j; float a = 0.f;
            if (s <= t) { for (int d = 0; d < 128; ++d) a = fmaf(bf2f(qs[t][d]), bf2f(ks[s][d]), a); a *= __expf(bb[t] - bb[s] + li[s]); }
            sreg[j] = a; }
    }
    __syncthreads();
    float* S = ksS;
    if (act) {
#pragma unroll
        for (int j = 0; j < 16; ++j) S[t * 64 + part * 16 + j] = sreg[j];
    }
    __syncthreads();
    if (act) {
        const float Ft = __expf(bb[t]);
        float den = 0.f;
        for (int s = 0; s <= t; ++s) den += S[t * 64 + s];
        { const float* np = nst + (size_t)u * 128; float a = 0.f; for (int d = 0; d < 128; ++d) a = fmaf(bf2f(qs[t][d]), np[d], a); den += Ft * a; }
        const int e0 = part * 32;
        float acc[32];
#pragma unroll
        for (int e = 0; e < 32; ++e) acc[e] = 0.f;
        { const float* Cp = Cst + (size_t)u * 16384 + e0;
          for (int d = 0; d < 128; ++d) { const float qd = bf2f(qs[t][d]);
#pragma unroll
              for (int e = 0; e < 32; ++e) acc[e] = fmaf(qd, Cp[d * 128 + e], acc[e]); } }
#pragma unroll
        for (int e = 0; e < 32; ++e) acc[e] *= Ft;
        for (int s = 0; s <= t; ++s) { const float w = S[t * 64 + s];
#pragma unroll
            for (int e = 0; e < 32; ++e) acc[e] = fmaf(w, bf2f(vs[s][e0 + e]), acc[e]); }
        const float inv = rcpf_(fmaxf(fabsf(den), 1.f));
        float ss = 0.f;
#pragma unroll
        for (int e = 0; e < 32; ++e) { acc[e] *= inv; ss += acc[e] * acc[e]; }
        ss += shx<1>(ss); ss += shx<2>(ss);
        const float rstd = rsqrtf(ss * (1.f / 128.f) + EPS);
        const size_t row = (size_t)(rowbase + t0 + t);
#pragma unroll
        for (int e = 0; e < 32; ++e) { const int cc = h * 128 + e0 + e;
            const float o = sigmoidf_(bf2f(P[row * DINP + C_MO + cc]));
            MIX[row * DM + cc] = f2bf(acc[e] * rstd * mnorm[cc] * o); }
    }
    __syncthreads();
}

__device__ __forceinline__ void ph_moba(const bf16* __restrict__ P, const float* __restrict__ kmean, bf16* __restrict__ MIX, int gw, int lane, float* q) {
    const int bh = gw >> 13, tq = gw & (SEQ - 1), b = bh >> 2, h = bh & 3, own = tq >> 8;
    const size_t row = (size_t)b * SEQ + tq;
    __builtin_amdgcn_s_waitcnt(0); __builtin_amdgcn_wave_barrier();
    q[lane] = bf2f(P[row * DINP + C_BQ + h * 64 + lane]);
    __builtin_amdgcn_s_waitcnt(0); __builtin_amdgcn_wave_barrier();
    float gs = -3.0e38f;
    if (lane < 32) { if (lane < own) { const float* km = kmean + (((size_t)b * 4 + h) * 32 + lane) * 64; float a = 0.f; for (int d = 0; d < 64; ++d) a = fmaf(q[d], km[d], a); gs = a; } else gs = -1e30f; }
    int blk[4]; bool val[4];
#pragma unroll
    for (int r = 0; r < 3; ++r) { const float m = wave_max(gs); const unsigned long long bal = __ballot(gs == m); const int idx = __ffsll((long long)bal) - 1;
        blk[r] = idx; val[r] = (r < own); if (lane == idx) gs = -3.0e38f; }
    blk[3] = own; val[3] = true;
    float s[4][4]; float mx = -1e30f;
#pragma unroll
    for (int g = 0; g < 4; ++g)
#pragma unroll
        for (int i = 0; i < 4; ++i) { float a = -1e30f;
            if (val[g]) { const int pos = blk[g] * 256 + i * 64 + lane;
                if (g < 3 || pos <= tq) { const bf16* kp = P + ((size_t)b * SEQ + pos) * DINP + C_BK + h * 64; a = dot64(kp, q) * 0.125f; } }
            s[g][i] = a; mx = fmaxf(mx, a); }
    mx = wave_max(mx);
    float l = 0.f;
#pragma unroll
    for (int g = 0; g < 4; ++g)
#pragma unroll
        for (int i = 0; i < 4; ++i) { const float p = (s[g][i] > -1e29f) ? __expf(s[g][i] - mx) : 0.f; s[g][i] = p; l += p; }
    l = wave_sum(l);
    float o = 0.f;
#pragma unroll
    for (int g = 0; g < 4; ++g) { if (!val[g]) continue;
#pragma unroll
        for (int i = 0; i < 4; ++i) { const bf16* vp = P + ((size_t)b * SEQ + blk[g] * 256 + i * 64) * DINP + C_BV + h * 64 + lane;
            for (int src = 0; src < 64; ++src) { const float p = __shfl(s[g][i], src); o = fmaf(p, bf2f(vp[(size_t)src * DINP]), o); } } }
    MIX[row * DM + 512 + h * 64 + lane] = f2bf(o * rcpf_(l));
}

__device__ __forceinline__ void ph_nsa(const bf16* __restrict__ P, const float* __restrict__ G, const float* __restrict__ tab, const float* __restrict__ KVc, bf16* __restrict__ MIX, int gw, int lane, float* sm) {
    float (*qn)[64] = (float (*)[64])sm; float (*qr)[64] = (float (*)[64])(sm + 256); float* ps = sm + 512;
    const int b = gw >> 13, tq = gw & (SEQ - 1), blkq = tq >> 6;
    const size_t row = (size_t)b * SEQ + tq;
    __builtin_amdgcn_s_waitcnt(0); __builtin_amdgcn_wave_barrier();
#pragma unroll
    for (int h = 0; h < 4; ++h) { const float x = bf2f(P[row * DINP + C_NQ + h * 64 + lane]); qn[h][lane] = x;
        float y = x; const float other = shx<8>(x);
        if (lane < 16) { const int f = lane & 7; const float c = tab[tq * 16 + f], s = tab[tq * 16 + 8 + f]; y = (lane < 8) ? (x * c - other * s) : (x * c + other * s); }
        qr[h][lane] = y; }
    __builtin_amdgcn_s_waitcnt(0); __builtin_amdgcn_wave_barrier();
    const float* Kc = KVc + (size_t)b * 512 * 64; const float* Vc = KVc + ((size_t)NB + b) * 512 * 64;
    float out[4] = {0.f, 0.f, 0.f, 0.f};
    float gate[3][4];
#pragma unroll
    for (int br = 0; br < 3; ++br)
#pragma unroll
        for (int h = 0; h < 4; ++h) gate[br][h] = sigmoidf_(G[row * 32 + 8 + br * 4 + h]);
    const int ncv = (tq >= 31) ? ((tq - 31) >> 4) + 1 : 0;
    {
        float sc[8][4]; float mx[4] = {-1e30f, -1e30f, -1e30f, -1e30f};
#pragma unroll
        for (int i = 0; i < 8; ++i) { const int c = i * 64 + lane;
            float a[4] = {-1e30f, -1e30f, -1e30f, -1e30f};
            if (c < ncv) { const float* kp = Kc + (size_t)c * 64; a[0] = a[1] = a[2] = a[3] = 0.f;
                for (int d = 0; d < 64; ++d) { const float kd = kp[d]; a[0] = fmaf(qn[0][d], kd, a[0]); a[1] = fmaf(qn[1][d], kd, a[1]); a[2] = fmaf(qn[2][d], kd, a[2]); a[3] = fmaf(qn[3][d], kd, a[3]); }
#pragma unroll
                for (int h = 0; h < 4; ++h) a[h] *= 0.125f; }
#pragma unroll
            for (int h = 0; h < 4; ++h) { sc[i][h] = a[h]; mx[h] = fmaxf(mx[h], a[h]); } }
        float l[4];
#pragma unroll
        for (int h = 0; h < 4; ++h) { mx[h] = wave_max(mx[h]); l[h] = 0.f; }
#pragma unroll
        for (int i = 0; i < 8; ++i) { const int c = i * 64 + lane;
#pragma unroll
            for (int h = 0; h < 4; ++h) { const float p = (c < ncv) ? __expf(sc[i][h] - mx[h]) : 0.f; sc[i][h] = p; l[h] += p; } }
#pragma unroll
        for (int h = 0; h < 4; ++h) { l[h] = wave_sum(l[h]); l[h] = (l[h] > 0.f) ? rcpf_(l[h]) : 0.f; }
#pragma unroll
        for (int i = 0; i < 8; ++i) { float su = 0.f;
#pragma unroll
            for (int h = 0; h < 4; ++h) { sc[i][h] *= l[h]; su += sc[i][h]; }
            ps[i * 64 + lane] = su; }
        if (lane < 4) ps[512 + lane] = 0.f;
        float oc[4] = {0.f, 0.f, 0.f, 0.f};
#pragma unroll
        for (int i = 0; i < 8; ++i) { if (i * 64 >= ncv) break; const int nn = min(64, ncv - i * 64);
            for (int src = 0; src < nn; ++src) { const float v = Vc[(size_t)(i * 64 + src) * 64 + lane];
                oc[0] = fmaf(__shfl(sc[i][0], src), v, oc[0]); oc[1] = fmaf(__shfl(sc[i][1], src), v, oc[1]);
                oc[2] = fmaf(__shfl(sc[i][2], src), v, oc[2]); oc[3] = fmaf(__shfl(sc[i][3], src), v, oc[3]); } }
#pragma unroll
        for (int h = 0; h < 4; ++h) out[h] = gate[0][h] * oc[h];
    }
    __builtin_amdgcn_s_waitcnt(0); __builtin_amdgcn_wave_barrier();
    int sidx[16];
    {
        float v0, v1;
        { const int n = lane; float im = 0.f;
#pragma unroll
          for (int j = -1; j < 4; ++j) { const int c = 4 * n + j; if (c >= 0 && c < NCMP) im += ps[c]; }
          const bool causal = n <= blkq, forced = causal && (n == 0 || n >= blkq - 1);
          v0 = forced ? 1e9f : (causal ? im : -1e30f); }
        { const int n = lane + 64; float im = 0.f;
#pragma unroll
          for (int j = -1; j < 4; ++j) { const int c = 4 * n + j; if (c >= 0 && c < NCMP) im += ps[c]; }
          const bool causal = n <= blkq, forced = causal && (n == 0 || n >= blkq - 1);
          v1 = forced ? 1e9f : (causal ? im : -1e30f); }
#pragma unroll
        for (int k = 0; k < 16; ++k) { const float m = wave_max(fmaxf(v0, v1));
            const unsigned long long b0 = __ballot(v0 == m); int idx;
            if (b0) { idx = __ffsll((long long)b0) - 1; if (lane == idx) v0 = -3.0e38f; }
            else { const unsigned long long b1 = __ballot(v1 == m); idx = __ffsll((long long)b1) - 1; if (lane == idx) v1 = -3.0e38f; idx += 64; }
            sidx[k] = idx; }
    }
    {
        float sc[16][4]; float mx[4] = {-1e30f, -1e30f, -1e30f, -1e30f};
#pragma unroll
        for (int k = 0; k < 16; ++k) { const int n = sidx[k], pos = n * 64 + lane;
            float a[4] = {-1e30f, -1e30f, -1e30f, -1e30f};
            if (n <= blkq && pos <= tq) { const bf16* kp = P + ((size_t)b * SEQ + pos) * DINP + C_NKS; dot64x4(kp, qr, a);
#pragma unroll
                for (int h = 0; h < 4; ++h) a[h] *= 0.125f; }
#pragma unroll
            for (int h = 0; h < 4; ++h) { sc[k][h] = a[h]; mx[h] = fmaxf(mx[h], a[h]); } }
        float l[4];
#pragma unroll
        for (int h = 0; h < 4; ++h) { mx[h] = wave_max(mx[h]); l[h] = 0.f; }
#pragma unroll
        for (int k = 0; k < 16; ++k)
#pragma unroll
            for (int h = 0; h < 4; ++h) { const float p = (sc[k][h] > -1e29f) ? __expf(sc[k][h] - mx[h]) : 0.f; sc[k][h] = p; l[h] += p; }
#pragma unroll
        for (int h = 0; h < 4; ++h) l[h] = rcpf_(wave_sum(l[h]));
        float os[4] = {0.f, 0.f, 0.f, 0.f};
#pragma unroll
        for (int k = 0; k < 16; ++k) { const int n = sidx[k]; if (n > blkq) continue;
            const bf16* vp = P + ((size_t)b * SEQ + n * 64) * DINP + C_NVS + lane;
            for (int src = 0; src < 64; ++src) { const float v = bf2f(vp[(size_t)src * DINP]);
                os[0] = fmaf(__shfl(sc[k][0], src), v, os[0]); os[1] = fmaf(__shfl(sc[k][1], src), v, os[1]);
                os[2] = fmaf(__shfl(sc[k][2], src), v, os[2]); os[3] = fmaf(__shfl(sc[k][3], src), v, os[3]); } }
#pragma unroll
        for (int h = 0; h < 4; ++h) out[h] += gate[1][h] * os[h] * l[h];
    }
    {
        float sc[8][4]; float mx[4] = {-1e30f, -1e30f, -1e30f, -1e30f};
#pragma unroll
        for (int i = 0; i < 8; ++i) { const int pos = tq - 511 + i * 64 + lane;
            float a[4] = {-1e30f, -1e30f, -1e30f, -1e30f};
            if (pos >= 0) { const bf16* kp = P + ((size_t)b * SEQ + pos) * DINP + C_NKW; dot64x4(kp, qr, a);
#pragma unroll
                for (int h = 0; h < 4; ++h) a[h] *= 0.125f; }
#pragma unroll
            for (int h = 0; h < 4; ++h) { sc[i][h] = a[h]; mx[h] = fmaxf(mx[h], a[h]); } }
        float l[4];
#pragma unroll
        for (int h = 0; h < 4; ++h) { mx[h] = wave_max(mx[h]); l[h] = 0.f; }
#pragma unroll
        for (int i = 0; i < 8; ++i)
#pragma unroll
            for (int h = 0; h < 4; ++h) { const float p = (sc[i][h] > -1e29f) ? __expf(sc[i][h] - mx[h]) : 0.f; sc[i][h] = p; l[h] += p; }
#pragma unroll
        for (int h = 0; h < 4; ++h) l[h] = rcpf_(wave_sum(l[h]));
        float ow[4] = {0.f, 0.f, 0.f, 0.f};
#pragma unroll
        for (int i = 0; i < 8; ++i) { const int p0 = tq - 511 + i * 64; if (p0 + 63 < 0) continue;
            const int s0 = p0 < 0 ? -p0 : 0;
            for (int src = s0; src < 64; ++src) { const float v = bf2f(P[((size_t)b * SEQ + p0 + src) * DINP + C_NVW + lane]);
                ow[0] = fmaf(__shfl(sc[i][0], src), v, ow[0]); ow[1] = fmaf(__shfl(sc[i][1], src), v, ow[1]);
                ow[2] = fmaf(__shfl(sc[i][2], src), v, ow[2]); ow[3] = fmaf(__shfl(sc[i][3], src), v, ow[3]); } }
#pragma unroll
        for (int h = 0; h < 4; ++h) out[h] += gate[2][h] * ow[h] * l[h];
    }
#pragma unroll
    for (int h = 0; h < 4; ++h) MIX[row * DM + 768 + h * 64 + lane] = f2bf(out[h]);
}


#define LAS __attribute__((address_space(3)))
typedef short bf16x8 __attribute__((ext_vector_type(8)));
typedef float f32x16 __attribute__((ext_vector_type(16)));
typedef short s16x4 __attribute__((ext_vector_type(4)));
typedef unsigned u32x4v __attribute__((ext_vector_type(4)));
typedef float f32x2_t __attribute__((ext_vector_type(2)));
typedef __bf16 bf16x2_t __attribute__((ext_vector_type(2)));
constexpr int KROW = 144, VROW = 192;
constexpr int KBUF = 64 * KROW, VBUF = 64 * VROW, STG = KBUF + VBUF;
constexpr float SCL2 = 0.125f * 1.4426950408889634f;
constexpr float NEGBIG = -1e30f;

__device__ __forceinline__ unsigned cvtpk(float lo, float hi) { f32x2_t v = {lo, hi}; bf16x2_t b = __builtin_convertvector(v, bf16x2_t); return __builtin_bit_cast(unsigned, b); }
__device__ __forceinline__ int crow(int r, int hi) { return (r & 3) + 8 * (r >> 2) + 4 * hi; }
__device__ __forceinline__ s16x4 lds_tr(LAS const unsigned char* p) { return __builtin_bit_cast(s16x4, __builtin_amdgcn_ds_read_tr16_b64_v4i16((LAS s16x4*)p)); }

__device__ __forceinline__ bf16x8 scale_frag(bf16x8 v, float s) {
    const u32x4v w = __builtin_bit_cast(u32x4v, v); u32x4v o;
#pragma unroll
    for (int e = 0; e < 4; ++e) o[e] = cvtpk(__builtin_bit_cast(float, w[e] << 16) * s, __builtin_bit_cast(float, w[e] & 0xffff0000u) * s);
    return __builtin_bit_cast(bf16x8, o);
}
struct TileSrc { const bf16* k; const bf16* v; int stride; };
__device__ __forceinline__ void tile_load(u32x4v& kr, u32x4v& vr, const TileSrc& s, int t) {
    const unsigned off = (unsigned)(t >> 3) * (unsigned)(s.stride * 2) + (unsigned)(t & 7) * 16u;
    kr = *(const u32x4v*)((const unsigned char*)s.k + off); vr = *(const u32x4v*)((const unsigned char*)s.v + off);
}
__device__ __forceinline__ void tile_store(LAS unsigned char* buf, const u32x4v& kr, const u32x4v& vr, int t) {
    const int key = t >> 3, ch = t & 7;
    *(LAS u32x4v*)(buf + key * KROW + ch * 16) = kr; *(LAS u32x4v*)(buf + KBUF + key * VROW + ch * 16) = vr;
}
__device__ __forceinline__ void qk_tile(f32x16& p0, f32x16& p1, LAS const unsigned char* kb, const bf16x8 (&qf)[4], int r32, int hi, float cinit) {
    float ci = cinit; asm volatile("" : "+v"(ci));
#pragma unroll
    for (int r = 0; r < 16; ++r) { p0[r] = ci; p1[r] = ci; }
    LAS const unsigned char* a = kb + r32 * KROW + hi * 16;
    bf16x8 kf[8];
#pragma unroll
    for (int ks = 0; ks < 4; ++ks) { kf[2 * ks] = *(LAS const bf16x8*)(a + ks * 32); kf[2 * ks + 1] = *(LAS const bf16x8*)(a + 32 * KROW + ks * 32); }
    __builtin_amdgcn_sched_barrier(0);
#pragma unroll
    for (int ks = 0; ks < 4; ++ks) {
        p0 = __builtin_amdgcn_mfma_f32_32x32x16_bf16(kf[2 * ks], qf[ks], p0, 0, 0, 0);
        p1 = __builtin_amdgcn_mfma_f32_32x32x16_bf16(kf[2 * ks + 1], qf[ks], p1, 0, 0, 0);
    }
}
__device__ __forceinline__ void pv_tile(f32x16& o0, f32x16& o1, LAS const unsigned char* vb, const f32x16& p0, const f32x16& p1, int lane) {
    const int g = lane >> 4, i = lane & 15, hi = lane >> 5;
    LAS const unsigned char* base = vb + (4 * hi + (i >> 2)) * VROW + (16 * (g & 1) + 4 * (i & 3)) * 2;
    s16x4 vlo[8], vhi[8];
#pragma unroll
    for (int s = 0; s < 4; ++s)
#pragma unroll
        for (int mb = 0; mb < 2; ++mb) { vlo[2 * s + mb] = lds_tr(base + s * 16 * VROW + mb * 64); vhi[2 * s + mb] = lds_tr(base + s * 16 * VROW + 8 * VROW + mb * 64); }
    __builtin_amdgcn_sched_barrier(0);
#pragma unroll
    for (int s = 0; s < 4; ++s) {
        unsigned w[4];
#pragma unroll
        for (int e = 0; e < 4; ++e) { const int r = 8 * (s & 1) + 2 * e; w[e] = (s < 2) ? cvtpk(p0[r], p0[r + 1]) : cvtpk(p1[r], p1[r + 1]); }
        const u32x4v wv = {w[0], w[1], w[2], w[3]};
        const bf16x8 pf = __builtin_bit_cast(bf16x8, wv);
#pragma unroll
        for (int mb = 0; mb < 2; ++mb) {
            const s16x4 lo = vlo[2 * s + mb], hi4 = vhi[2 * s + mb];
            const bf16x8 vt = {lo[0], lo[1], lo[2], lo[3], hi4[0], hi4[1], hi4[2], hi4[3]};
            if (mb == 0) o0 = __builtin_amdgcn_mfma_f32_32x32x16_bf16(vt, pf, o0, 0, 0, 0);
            else o1 = __builtin_amdgcn_mfma_f32_32x32x16_bf16(vt, pf, o1, 0, 0, 0);
        }
    }
}
constexpr float SM_THR = 8.0f;
__device__ __forceinline__ void softmax_tile(f32x16& p0, f32x16& p1, f32x16& o0, f32x16& o1, float& mref, float& l, bool first) {
    float a = __builtin_fmaxf(__builtin_fmaxf(p0[0], p0[1]), p1[0]), b = __builtin_fmaxf(__builtin_fmaxf(p0[2], p0[3]), p1[1]);
    a = __builtin_fmaxf(__builtin_fmaxf(a, p1[2]), p1[3]);
#pragma unroll
    for (int r = 4; r < 16; r += 4) { a = __builtin_fmaxf(__builtin_fmaxf(a, p0[r]), p0[r + 1]); b = __builtin_fmaxf(__builtin_fmaxf(b, p0[r + 2]), p0[r + 3]);
        a = __builtin_fmaxf(__builtin_fmaxf(a, p1[r]), p1[r + 1]); b = __builtin_fmaxf(__builtin_fmaxf(b, p1[r + 2]), p1[r + 3]); }
    float rm = __builtin_fmaxf(a, b);
    { auto rr = __builtin_amdgcn_permlane32_swap(__float_as_uint(rm), __float_as_uint(rm), false, false); rm = __builtin_fmaxf(__uint_as_float(rr[0]), __uint_as_float(rr[1])); }
    if (first || __any(rm > SM_THR)) {
        const float dl = first ? rm : __builtin_fmaxf(rm, 0.f);
        mref += dl;
        const float f = __builtin_amdgcn_exp2f(-dl);
        l *= f;
#pragma unroll
        for (int r = 0; r < 16; ++r) { p0[r] -= dl; p1[r] -= dl; o0[r] *= f; o1[r] *= f; }
    }
    float s0 = 0.f, s1 = 0.f;
#pragma unroll
    for (int r = 0; r < 16; ++r) { p0[r] = __builtin_amdgcn_exp2f(p0[r]); p1[r] = __builtin_amdgcn_exp2f(p1[r]); s0 += p0[r]; s1 += p1[r]; }
    l += s0 + s1;
}


constexpr int PV_OFF = 2 * KBUF, PIPE_BYTES = 2 * KBUF + 2 * VBUF;
__device__ __forceinline__ void k_store(LAS unsigned char* lds, int slot, const u32x4v& kr, int t) { *(LAS u32x4v*)(lds + slot * KBUF + (t >> 3) * KROW + (t & 7) * 16) = kr; }
__device__ __forceinline__ void v_store(LAS unsigned char* lds, int voff, const u32x4v& vr, int t) { *(LAS u32x4v*)(lds + PV_OFF + voff + (t >> 3) * VROW + (t & 7) * 16) = vr; }
__device__ __forceinline__ u32x4v kv_load(const bf16* base, int stride, int t) { const unsigned off = (unsigned)(t >> 3) * (unsigned)(stride * 2) + (unsigned)(t & 7) * 16u;
    return *(const u32x4v*)((const unsigned char*)base + off); }
__device__ __forceinline__ void pv_frag(f32x16& o0, f32x16& o1, LAS const unsigned char* vb, const bf16x8 (&pf)[4], int lane) {
    const int g = lane >> 4, i = lane & 15, hi = lane >> 5;
    LAS const unsigned char* base = vb + (4 * hi + (i >> 2)) * VROW + (16 * (g & 1) + 4 * (i & 3)) * 2;
#pragma unroll
    for (int s = 0; s < 4; ++s)
#pragma unroll
        for (int mb = 0; mb < 2; ++mb) {
            const s16x4 lo = lds_tr(base + s * 16 * VROW + mb * 64), hi4 = lds_tr(base + s * 16 * VROW + 8 * VROW + mb * 64);
            const bf16x8 vt = {lo[0], lo[1], lo[2], lo[3], hi4[0], hi4[1], hi4[2], hi4[3]};
            if (mb == 0) o0 = __builtin_amdgcn_mfma_f32_32x32x16_bf16(vt, pf[s], o0, 0, 0, 0);
            else o1 = __builtin_amdgcn_mfma_f32_32x32x16_bf16(vt, pf[s], o1, 0, 0, 0);
        }
}
__device__ __forceinline__ void exp_pack(f32x16& p0, f32x16& p1, float& l, bf16x8 (&pf)[4]) {
    float s0 = 0.f, s1 = 0.f;
#pragma unroll
    for (int r = 0; r < 16; ++r) { p0[r] = __builtin_amdgcn_exp2f(p0[r]); p1[r] = __builtin_amdgcn_exp2f(p1[r]); s0 += p0[r]; s1 += p1[r]; }
    l += s0 + s1;
#pragma unroll
    for (int s = 0; s < 4; ++s) { u32x4v w;
#pragma unroll
        for (int e = 0; e < 4; ++e) { const int r = 8 * (s & 1) + 2 * e; w[e] = (s < 2) ? cvtpk(p0[r], p0[r + 1]) : cvtpk(p1[r], p1[r + 1]); }
        pf[s] = __builtin_bit_cast(bf16x8, w); }
}
template <bool DOQK>
__device__ __forceinline__ void attn_slices(LAS const unsigned char* kn, LAS const unsigned char* vc, const bf16x8 (&qf)[4], float ci_, f32x16& pc0, f32x16& pc1, f32x16& pn0, f32x16& pn1,
                                            f32x16& o0, f32x16& o1, float& l, int lane, int r32, int hi) {
    LAS const unsigned char* ka = kn + r32 * KROW + hi * 16;
    bf16x8 kf[8];
    if (DOQK) {
#pragma unroll
        for (int j = 0; j < 4; ++j) kf[j] = *(LAS const bf16x8*)(ka + (j & 1) * 32 * KROW + (j >> 1) * 32);
        float ci = ci_; asm volatile("" : "+v"(ci));
#pragma unroll
        for (int r = 0; r < 16; ++r) { pn0[r] = ci; pn1[r] = ci; }
    }
    const int g = lane >> 4, i16 = lane & 15;
    LAS const unsigned char* vbase = vc + (4 * hi + (i16 >> 2)) * VROW + (16 * (g & 1) + 4 * (i16 & 3)) * 2;
    float s0 = 0.f, s1 = 0.f;
    bf16x8 pf[4]; s16x4 vlo, vhi;
    __builtin_amdgcn_sched_barrier(0);
#pragma unroll
    for (int i = 0; i < 10; ++i) {
        if (DOQK && i < 8) { if (i & 1) pn1 = __builtin_amdgcn_mfma_f32_32x32x16_bf16(kf[i], qf[i >> 1], pn1, 0, 0, 0); else pn0 = __builtin_amdgcn_mfma_f32_32x32x16_bf16(kf[i], qf[i >> 1], pn0, 0, 0, 0); }
        if (i >= 2) {
            const int s = (i - 2) >> 1, mb = (i - 2) & 1;
            const bf16x8 vt = {vlo[0], vlo[1], vlo[2], vlo[3], vhi[0], vhi[1], vhi[2], vhi[3]};
            if (mb == 0) o0 = __builtin_amdgcn_mfma_f32_32x32x16_bf16(vt, pf[s], o0, 0, 0, 0); else o1 = __builtin_amdgcn_mfma_f32_32x32x16_bf16(vt, pf[s], o1, 0, 0, 0);
        }
        if (DOQK && i + 4 < 8) kf[i + 4] = *(LAS const bf16x8*)(ka + ((i + 4) & 1) * 32 * KROW + ((i + 4) >> 1) * 32);
        if (i >= 1 && i < 9) { const int s = (i - 1) >> 1, mb = (i - 1) & 1;
            vlo = lds_tr(vbase + s * 16 * VROW + mb * 64); vhi = lds_tr(vbase + s * 16 * VROW + 8 * VROW + mb * 64); }
        if (i < 8) {
#pragma unroll
            for (int e = 0; e < 4; ++e) { const int r = 4 * (i & 3) + e;
                if (i < 4) { pc0[r] = __builtin_amdgcn_exp2f(pc0[r]); s0 += pc0[r]; } else { pc1[r] = __builtin_amdgcn_exp2f(pc1[r]); s1 += pc1[r]; } }
            if (i & 1) { const int s = i >> 1; u32x4v w;
#pragma unroll
                for (int e = 0; e < 4; ++e) { const int r = 8 * (s & 1) + 2 * e; w[e] = (s < 2) ? cvtpk(pc0[r], pc0[r + 1]) : cvtpk(pc1[r], pc1[r + 1]); }
                pf[s] = __builtin_bit_cast(bf16x8, w); }
        }
        __builtin_amdgcn_sched_barrier(0);
    }
    l += s0 + s1;
}
template <class Pol>
__device__ __forceinline__ void attn_step_gen(const Pol& pol, int t, bool doqk, LAS unsigned char* lds, const bf16x8 (&qf)[4], float negm, f32x16& pc0, f32x16& pc1,
                                              f32x16& o0, f32x16& o1, float& l, int tid_, int lane_, int r32_, int hi_) {
    const int tid = mk_tid(pol.ws), lane = tid & 63, r32 = lane & 31, hi = lane >> 5; (void)tid_; (void)lane_; (void)r32_; (void)hi_;
    const int nt = pol.nt;
    u32x4v kr, vr;
    const bool ldk = (t + 2 < nt), ldv = (t + 1 < nt);
    if (ldk) kr = kv_load(pol.kptr(t + 2), pol.stride, tid);
    if (ldv) vr = kv_load(pol.vptr(t + 1), pol.stride, tid);
    f32x16 pn0, pn1;
    const bool qa = doqk && pol.active(t + 1), ca = pol.active(t);
    if (qa) { attn_slices<true>(lds + ((t + 1) & 1) * KBUF, lds + PV_OFF + (t & 1) * VBUF, qf, pol.rowsel(t + 1) ? negm : NEGBIG, pc0, pc1, pn0, pn1, o0, o1, l, lane, r32, hi); pol.mask(t + 1, pn0, pn1); }
    else if (ca) attn_slices<false>(lds, lds + PV_OFF + (t & 1) * VBUF, qf, 0.f, pc0, pc1, pn0, pn1, o0, o1, l, lane, r32, hi);
    if (ldk) k_store(lds, t & 1, kr, tid);
    if (ldv) v_store(lds, ((t + 1) & 1) * VBUF, vr, tid);
    __syncthreads();
    if (qa) { pc0 = pn0; pc1 = pn1; }
}
template <class Pol>
__device__ __forceinline__ void attn_step_fast(const Pol& pol, int t, LAS unsigned char* lds, const bf16x8 (&qf)[4], float negm, f32x16& pc0, f32x16& pc1, f32x16& pn0, f32x16& pn1,
                                               f32x16& o0, f32x16& o1, float& l, u32x4v& kld, u32x4v& vld, const u32x4v& kst, const u32x4v& vst,
                                               int tid_, int lane_, int r32_, int hi_) {
    const int tid = mk_tid(pol.ws), lane = tid & 63, r32 = lane & 31, hi = lane >> 5; (void)tid_; (void)lane_; (void)r32_; (void)hi_;
    const int nt = pol.nt, tk = (t + 3 < nt) ? t + 3 : nt - 1, tv = (t + 2 < nt) ? t + 2 : nt - 1;
    kld = kv_load(pol.kptr(tk), pol.stride, tid); vld = kv_load(pol.vptr(tv), pol.stride, tid);
    attn_slices<true>(lds + ((t + 1) & 1) * KBUF, lds + PV_OFF + (t & 1) * VBUF, qf, pol.rowsel(t + 1) ? negm : NEGBIG, pc0, pc1, pn0, pn1, o0, o1, l, lane, r32, hi);
    k_store(lds, t & 1, kst, tid);
    v_store(lds, ((t + 1) & 1) * VBUF, vst, tid);
    __syncthreads();
}
template <class Pol>
__device__ __forceinline__ void attn_pipe(const Pol& pol, LAS unsigned char* lds, const bf16x8 (&qf)[4], float negm, f32x16& o0, f32x16& o1, float& l, int tid) {
    const int lane = tid & 63, r32 = lane & 31, hi = lane >> 5, nt = pol.nt;
    {
        const u32x4v k0 = kv_load(pol.kptr(0), pol.stride, tid), v0 = kv_load(pol.vptr(0), pol.stride, tid);
        u32x4v k1 = k0; if (nt > 1) k1 = kv_load(pol.kptr(1), pol.stride, tid);
        k_store(lds, 0, k0, tid); v_store(lds, 0, v0, tid); if (nt > 1) k_store(lds, 1, k1, tid);
    }
    __syncthreads();
    f32x16 pc0, pc1;
    qk_tile(pc0, pc1, lds, qf, r32, hi, pol.rowsel(0) ? negm : NEGBIG); pol.mask(0, pc0, pc1);
    int t = 0;
    for (; t < nt - 1 && t + 1 < pol.nmask; ++t)
        attn_step_gen(pol, t, true, lds, qf, negm, pc0, pc1, o0, o1, l, tid, lane, r32, hi);
    if (t < nt - 1) {
        const int tk0 = (t + 2 < nt) ? t + 2 : nt - 1;
        u32x4v ka = kv_load(pol.kptr(tk0), pol.stride, tid), va = kv_load(pol.vptr(t + 1), pol.stride, tid), kb, vb;
        f32x16 pd0, pd1;
        for (; t + 1 < nt - 1; t += 2) {
            attn_step_fast(pol, t, lds, qf, negm, pc0, pc1, pd0, pd1, o0, o1, l, kb, vb, ka, va, tid, lane, r32, hi);
            attn_step_fast(pol, t + 1, lds, qf, negm, pd0, pd1, pc0, pc1, o0, o1, l, ka, va, kb, vb, tid, lane, r32, hi);
        }
        if (t < nt - 1) {
            attn_step_fast(pol, t, lds, qf, negm, pc0, pc1, pd0, pd1, o0, o1, l, kb, vb, ka, va, tid, lane, r32, hi);
            pc0 = pd0; pc1 = pd1; ++t;
        }
    }
    attn_step_gen(pol, nt - 1, false, lds, qf, negm, pc0, pc1, o0, o1, l, tid, lane, r32, hi);
}
__device__ __forceinline__ float row_negm(const bf16x8 (&qf)[4], float kmax) {
    float ss = 0.f;
#pragma unroll
    for (int ks = 0; ks < 4; ++ks) { const u32x4v w = __builtin_bit_cast(u32x4v, qf[ks]);
#pragma unroll
        for (int e = 0; e < 4; ++e) { const float a = __builtin_bit_cast(float, w[e] << 16), b = __builtin_bit_cast(float, w[e] & 0xffff0000u); ss += a * a + b * b; } }
    ss += shx<32>(ss);
    return -(__builtin_sqrtf(ss) * kmax);
}
__device__ __forceinline__ float gain_kmax(const float* g, int lane) { return wave_max(fabsf(g[lane])) * (8.0f * 1.02f); }


constexpr int MK_KM_OFF = 0, MK_MSK_OFF = 8192, MK_CNT_OFF = MK_MSK_OFF + 1024, MK_END = MK_CNT_OFF + 512;
__device__ __forceinline__ void moba_gate_item(const bf16* __restrict__ P, const float* __restrict__ kmean, unsigned* __restrict__ SELB, int* __restrict__ CNTQ, unsigned char* __restrict__ LISTG,
                                               int b, int h, int qb, int tid, LAS unsigned char* lds) {
    asm volatile("" : "+v"(tid));
    const int lane = tid & 63, wid = __builtin_amdgcn_readfirstlane(tid >> 6), r32 = lane & 31, hi = lane >> 5, bh = b * 4 + h;
    constexpr int G_LO = 32 * KROW, G_LIST = 2 * 32 * KROW, G_CNT = G_LIST + 32 * 256;
    const int own = qb;
    const size_t rowq = (size_t)b * SEQ + qb * 256 + wid * 32 + r32;
    bf16x8 qg[4];
#pragma unroll
    for (int ks = 0; ks < 4; ++ks) qg[ks] = *(const bf16x8*)(P + rowq * DINP + C_BQ + h * 64 + ks * 16 + hi * 8);
    {
        const int n = tid >> 4, d0 = (tid & 15) * 4;
        pg8::f32x4 v = {0.f, 0.f, 0.f, 0.f};
        if (n < own) v = *(const pg8::f32x4*)(kmean + ((size_t)bh * 32 + n) * 64 + d0);
        unsigned hw[2], lw[2];
#pragma unroll
        for (int e = 0; e < 2; ++e) { const unsigned hp = cvtpk(v[2 * e], v[2 * e + 1]);
            const float r0 = v[2 * e] - __builtin_bit_cast(float, hp << 16), r1 = v[2 * e + 1] - __builtin_bit_cast(float, hp & 0xffff0000u);
            hw[e] = hp; lw[e] = cvtpk(r0, r1); }
        typedef unsigned u32x2g __attribute__((ext_vector_type(2)));
        *(LAS u32x2g*)(lds + n * KROW + d0 * 2) = u32x2g{hw[0], hw[1]}; *(LAS u32x2g*)(lds + G_LO + n * KROW + d0 * 2) = u32x2g{lw[0], lw[1]};
        if (tid < 32) ((LAS int*)(lds + G_CNT))[tid] = 0;
    }
    __syncthreads();
    f32x16 p;
#pragma unroll
    for (int r = 0; r < 16; ++r) p[r] = zf_();
    { LAS const unsigned char* a = lds + r32 * KROW + hi * 16;
#pragma unroll
      for (int ks = 0; ks < 4; ++ks) { p = __builtin_amdgcn_mfma_f32_32x32x16_bf16(*(LAS const bf16x8*)(a + ks * 32), qg[ks], p, 0, 0, 0);
          p = __builtin_amdgcn_mfma_f32_32x32x16_bf16(*(LAS const bf16x8*)(a + G_LO + ks * 32), qg[ks], p, 0, 0, 0); } }
    float b0 = -3e38f, b1 = -3e38f, b2 = -3e38f; int i0 = -1, i1 = -1, i2 = -1;
#pragma unroll
    for (int r = 0; r < 16; ++r) { const int n = crow(r, hi); const bool valid = n < own; const float a = p[r];
        const bool g0 = valid && (a > b0 || (a == b0 && n < i0)), g1 = valid && (a > b1 || (a == b1 && n < i1)), g2 = valid && (a > b2 || (a == b2 && n < i2));
        b2 = g1 ? b1 : (g2 ? a : b2); i2 = g1 ? i1 : (g2 ? n : i2);
        b1 = g0 ? b0 : (g1 ? a : b1); i1 = g0 ? i0 : (g1 ? n : i1);
        b0 = g0 ? a : b0; i0 = g0 ? n : i0; }
    {
        float pb[3]; int pi[3];
        pb[0] = shx<32>(b0); pb[1] = shx<32>(b1); pb[2] = shx<32>(b2);
        pi[0] = __builtin_bit_cast(int, shx<32>(__builtin_bit_cast(float, i0))); pi[1] = __builtin_bit_cast(int, shx<32>(__builtin_bit_cast(float, i1))); pi[2] = __builtin_bit_cast(int, shx<32>(__builtin_bit_cast(float, i2)));
#pragma unroll
        for (int k = 0; k < 3; ++k) { const float a = pb[k]; const int n = pi[k];
            const bool valid = n >= 0;
            const bool g0 = valid && (a > b0 || (a == b0 && n < i0)), g1 = valid && (a > b1 || (a == b1 && n < i1)), g2 = valid && (a > b2 || (a == b2 && n < i2));
            b2 = g1 ? b1 : (g2 ? a : b2); i2 = g1 ? i1 : (g2 ? n : i2);
            b1 = g0 ? b0 : (g1 ? a : b1); i1 = g0 ? i0 : (g1 ? n : i1);
            b0 = g0 ? a : b0; i0 = g0 ? n : i0; }
    }
    unsigned mask = 0u;
    if (i0 >= 0) mask |= 1u << i0;
    if (i1 >= 0) mask |= 1u << i1;
    if (i2 >= 0) mask |= 1u << i2;
    if (hi == 0) {
        SELB[(size_t)bh * SEQ + qb * 256 + wid * 32 + r32] = mask;
        LAS int* cn = (LAS int*)(lds + G_CNT); LAS unsigned char* ls = lds + G_LIST; const unsigned char me = (unsigned char)(wid * 32 + r32);
        if (i0 >= 0) { const int pos = __hip_atomic_fetch_add(cn + i0, 1, __ATOMIC_RELAXED, __HIP_MEMORY_SCOPE_WORKGROUP); ls[i0 * 256 + pos] = me; }
        if (i1 >= 0) { const int pos = __hip_atomic_fetch_add(cn + i1, 1, __ATOMIC_RELAXED, __HIP_MEMORY_SCOPE_WORKGROUP); ls[i1 * 256 + pos] = me; }
        if (i2 >= 0) { const int pos = __hip_atomic_fetch_add(cn + i2, 1, __ATOMIC_RELAXED, __HIP_MEMORY_SCOPE_WORKGROUP); ls[i2 * 256 + pos] = me; }
    }
    __syncthreads();
    {
        unsigned char* lg = LISTG + ((size_t)bh * 32 + qb) * 32 * 256;
        *(u32x4v*)(lg + tid * 16) = *(LAS const u32x4v*)(lds + G_LIST + tid * 16);
        if (tid < 32) CNTQ[((size_t)bh * 32 + qb) * 32 + tid] = ((LAS const int*)(lds + G_CNT))[tid];
    }
    __syncthreads();
}
__device__ __forceinline__ unsigned char* moba_part(bf16* P, size_t token, int h, int slot) { return (unsigned char*)(P + token * DINP) + h * 512 + slot * 136; }
constexpr int MK_TAB_OFF = 4 * STG;
__device__ __forceinline__ void moba_kv_chunk(bf16* __restrict__ P, const unsigned* __restrict__ SELB, const int* __restrict__ CNTQ, const unsigned char* __restrict__ LISTG, float kmax,
                                              int bh, int n, int c, int tid, LAS unsigned char* lds) {
    asm volatile("" : "+v"(tid));
    const int lane = tid & 63, wid = __builtin_amdgcn_readfirstlane(tid >> 6), r32 = lane & 31, hi = lane >> 5, b = bh >> 2, h = bh & 3;
    bf16* Pb = P + (size_t)b * SEQ * DINP;
    LAS int* tab = (LAS int*)(lds + MK_TAB_OFF);
    {
        const bf16* ksrc = Pb + (size_t)(n * 256) * DINP + C_BK + h * 64; const bf16* vsrc = Pb + (size_t)(n * 256) * DINP + C_BV + h * 64;
        u32x4v kr[4], vr[4];
#pragma unroll
        for (int s = 0; s < 4; ++s) { kr[s] = kv_load(ksrc + (size_t)s * 64 * DINP, DINP, tid); vr[s] = kv_load(vsrc + (size_t)s * 64 * DINP, DINP, tid); }
        if (tid < 32) { const int cq = (tid > n) ? CNTQ[((size_t)bh * 32 + tid) * 32 + n] : 0; tab[tid] = (cq + 31) >> 5; tab[32 + tid] = cq; }
#pragma unroll
        for (int s = 0; s < 4; ++s) { *(LAS u32x4v*)(lds + s * STG + (tid >> 3) * KROW + (tid & 7) * 16) = kr[s]; *(LAS u32x4v*)(lds + s * STG + KBUF + (tid >> 3) * VROW + (tid & 7) * 16) = vr[s]; }
    }
    __syncthreads();
    if (tid < 16) { const int ord = 16 * c + tid; int qb = -1, j = 0, acc = 0;
        for (int q = n + 1; q < 32; ++q) { const int t = tab[q]; if (qb < 0 && ord < acc + t) { qb = q; j = ord - acc; } acc += t; }
        tab[64 + tid] = qb < 0 ? -1 : ((qb << 8) | j); }
    __syncthreads();
    int codeR[2], cntR[2]; bool validR[2]; size_t tokR[2]; bf16x8 qraw[2][4]; unsigned mrowR[2];
#pragma unroll
    for (int r = 0; r < 2; ++r) { const int code = tab[64 + 8 * r + wid]; codeR[r] = code;
        const int qb = code < 0 ? n + 1 : (code >> 8), j = code < 0 ? 0 : (code & 255);
        const int cnt = code < 0 ? 1 : tab[32 + (qb & 31)], idx = j * 32 + r32; cntR[r] = cnt; validR[r] = (code >= 0) && (idx < cnt);
        const int li = validR[r] ? idx : (cnt - 1);
        const int row = LISTG[(((size_t)bh * 32 + (qb & 31)) * 32 + n) * 256 + li];
        tokR[r] = (size_t)b * SEQ + (qb & 31) * 256 + row; }
#pragma unroll
    for (int r = 0; r < 2; ++r) {
#pragma unroll
        for (int ks = 0; ks < 4; ++ks) qraw[r][ks] = *(const bf16x8*)(P + tokR[r] * DINP + C_BQ + h * 64 + ks * 16 + hi * 8);
        mrowR[r] = SELB[(size_t)bh * SEQ + (tokR[r] - (size_t)b * SEQ)]; }
#pragma unroll
    for (int r = 0; r < 2; ++r) {
        if (codeR[r] < 0) continue;
        const bool valid = validR[r]; const size_t token = tokR[r]; const unsigned mrow = mrowR[r];
        bf16x8 qf[4];
#pragma unroll
        for (int ks = 0; ks < 4; ++ks) qf[ks] = scale_frag(qraw[r][ks], SCL2);
        const float negm = row_negm(qf, kmax);
        f32x16 o0, o1; float l = 0.f;
#pragma unroll
        for (int q = 0; q < 16; ++q) { o0[q] = zf_(); o1[q] = o0[q]; }
        {
            f32x16 pa0, pa1, pb0, pb1;
            qk_tile(pa0, pa1, lds, qf, r32, hi, negm);
            attn_slices<true>(lds + 1 * STG, lds + 0 * STG + KBUF, qf, negm, pa0, pa1, pb0, pb1, o0, o1, l, lane, r32, hi);
            attn_slices<true>(lds + 2 * STG, lds + 1 * STG + KBUF, qf, negm, pb0, pb1, pa0, pa1, o0, o1, l, lane, r32, hi);
            attn_slices<true>(lds + 3 * STG, lds + 2 * STG + KBUF, qf, negm, pa0, pa1, pb0, pb1, o0, o1, l, lane, r32, hi);
            attn_slices<false>(lds, lds + 3 * STG + KBUF, qf, 0.f, pb0, pb1, pa0, pa1, o0, o1, l, lane, r32, hi);
        }
        l += shx<32>(l);
        if (valid) { unsigned char* pp = moba_part(P, token, h, __popc(mrow & ((1u << n) - 1u)));
#pragma unroll
            for (int g = 0; g < 4; ++g) { uint2 w0, w1;
                w0.x = cvtpk(o0[4 * g], o0[4 * g + 1]); w0.y = cvtpk(o0[4 * g + 2], o0[4 * g + 3]); w1.x = cvtpk(o1[4 * g], o1[4 * g + 1]); w1.y = cvtpk(o1[4 * g + 2], o1[4 * g + 3]);
                *(uint2*)(pp + (8 * g + 4 * hi) * 2) = w0; *(uint2*)(pp + (32 + 8 * g + 4 * hi) * 2) = w1; }
            if (hi == 0) *(float*)(pp + 128) = l; }
    }
    __syncthreads();
}
struct MobaOwnPol {
    int ws, wmax, nt, nmask, stride, own, tq, hi; const bf16* Pk; const bf16* Pv;
    __device__ __forceinline__ const bf16* kptr(int i) const { return Pk + (size_t)(own * 4 + i) * 64 * DINP; }
    __device__ __forceinline__ const bf16* vptr(int i) const { return Pv + (size_t)(own * 4 + i) * 64 * DINP; }
    __device__ __forceinline__ bool active(int i) const { return i <= wmax; }
    __device__ __forceinline__ bool rowsel(int) const { return true; }
    __device__ __forceinline__ void mask(int i, f32x16& p0, f32x16& p1) const { const int kbase = (own * 4 + i) * 64;
        const float ng = nbg;
#pragma unroll
        for (int r = 0; r < 16; ++r) { const int k0 = kbase + crow(r, hi); p0[r] = (k0 <= tq) ? p0[r] : ng; p1[r] = (k0 + 32 <= tq) ? p1[r] : ng; } }
};
__device__ __forceinline__ void moba_merge_unit(bf16* __restrict__ P, const unsigned* __restrict__ SELB, float kmax, bf16* __restrict__ MIX, int b, int h, int qb, int tid, LAS unsigned char* lds, int wave_s) {
    asm volatile("" : "+v"(tid));
    const int lane = tid & 63, wid = __builtin_amdgcn_readfirstlane(tid >> 6), r32 = lane & 31, hi = lane >> 5, bh = b * 4 + h;
    const int tq = qb * 256 + wid * 32 + r32;
    const size_t rowq = (size_t)b * SEQ + tq;
    const bf16* Pb = P + (size_t)b * SEQ * DINP;
    bf16x8 qf[4];
#pragma unroll
    for (int ks = 0; ks < 4; ++ks) qf[ks] = scale_frag(*(const bf16x8*)(P + rowq * DINP + C_BQ + h * 64 + ks * 16 + hi * 8), SCL2);
    f32x16 o0, o1;
#pragma unroll
    for (int r = 0; r < 16; ++r) { o0[r] = zf_(); o1[r] = o0[r]; }
    float l = 0.f;
    { MobaOwnPol pol; pol.ws = wave_s; pol.wmax = wid >> 1; pol.nt = 4; pol.nmask = 4; pol.stride = DINP; pol.own = qb; pol.tq = tq; pol.hi = hi; pol.Pk = Pb + C_BK + h * 64; pol.Pv = Pb + C_BV + h * 64;
      attn_pipe(pol, lds, qf, row_negm(qf, kmax), o0, o1, l, tid); }
    l += shx<32>(l);
    int t2 = mk_tid(wave_s);
    const int l2 = t2 & 63, r2 = l2 & 31, h2 = l2 >> 5, w2 = t2 >> 6;
    const size_t token = (size_t)b * SEQ + qb * 256 + w2 * 32 + r2;
    const int ns = __popc(SELB[(size_t)bh * SEQ + qb * 256 + w2 * 32 + r2]);
    {
        uint2 w0[3][4], w1[3][4]; float lp[3];
#pragma unroll
        for (int s = 0; s < 3; ++s) { const unsigned char* pp = moba_part(P, token, h, s < ns ? s : 0);
#pragma unroll
            for (int g = 0; g < 4; ++g) { w0[s][g] = *(const uint2*)(pp + (8 * g + 4 * h2) * 2); w1[s][g] = *(const uint2*)(pp + (32 + 8 * g + 4 * h2) * 2); }
            lp[s] = *(const float*)(pp + 128); }
#pragma unroll
        for (int s = 0; s < 3; ++s) { const unsigned km = s < ns ? 0xffffffffu : 0u;
#pragma unroll
            for (int g = 0; g < 4; ++g) { const unsigned ax = w0[s][g].x & km, ay = w0[s][g].y & km, bx = w1[s][g].x & km, by = w1[s][g].y & km;
                o0[4 * g] += __builtin_bit_cast(float, ax << 16); o0[4 * g + 1] += __builtin_bit_cast(float, ax & 0xffff0000u); o0[4 * g + 2] += __builtin_bit_cast(float, ay << 16); o0[4 * g + 3] += __builtin_bit_cast(float, ay & 0xffff0000u);
                o1[4 * g] += __builtin_bit_cast(float, bx << 16); o1[4 * g + 1] += __builtin_bit_cast(float, bx & 0xffff0000u); o1[4 * g + 2] += __builtin_bit_cast(float, by << 16); o1[4 * g + 3] += __builtin_bit_cast(float, by & 0xffff0000u); }
            l += s < ns ? lp[s] : 0.f; }
    }
    const float inv = rcpf_(l);
    bf16* op = MIX + token * DM + 512 + h * 64 + 4 * h2;
#pragma unroll
    for (int g = 0; g < 4; ++g) {
        uint2 w0, w1;
        w0.x = cvtpk(o0[4 * g] * inv, o0[4 * g + 1] * inv); w0.y = cvtpk(o0[4 * g + 2] * inv, o0[4 * g + 3] * inv);
        w1.x = cvtpk(o1[4 * g] * inv, o1[4 * g + 1] * inv); w1.y = cvtpk(o1[4 * g + 2] * inv, o1[4 * g + 3] * inv);
        *(uint2*)(op + 8 * g) = w0; *(uint2*)(op + 32 + 8 * g) = w1;
    }
}
constexpr int MK_ENUM_OFF = 4 * STG + 512;
__device__ __forceinline__ void moba_kv_phase(bf16* __restrict__ P, const unsigned* __restrict__ SELB, const int* __restrict__ CNTQ, const unsigned char* __restrict__ LISTG, const float* __restrict__ kgain,
                                              unsigned* __restrict__ queue, int tid, LAS unsigned char* lds) {
    asm volatile("" : "+v"(tid));
    LAS int* nch = (LAS int*)(lds + MK_ENUM_OFF);
    const float kmax = gain_kmax(kgain, tid & 63);
    { const int bh = tid >> 5, n = tid & 31; int T = 0;
      int cq[31];
#pragma unroll
      for (int q = 1; q < 32; ++q) cq[q - 1] = CNTQ[((size_t)bh * 32 + q) * 32 + n];
#pragma unroll
      for (int q = 1; q < 32; ++q) T += (q > n) ? ((cq[q - 1] + 31) >> 5) : 0;
      nch[tid] = (T + 15) >> 4; }
    __syncthreads();
    if (tid < 64) {
        int v[8], s = 0;
#pragma unroll
        for (int k = 0; k < 8; ++k) { s += nch[tid * 8 + k]; v[k] = s; }
        int incl = s;
#pragma unroll
        for (int o = 1; o < 64; o <<= 1) { const int t = __shfl_up(incl, o); if (tid >= o) incl += t; }
        const int base = incl - s;
#pragma unroll
        for (int k = 0; k < 8; ++k) nch[tid * 8 + k] = v[k] + base; }
    __syncthreads();
    const int total = nch[511];
    LAS int* qs = (LAS int*)(lds + MK_ENUM_OFF + 2048);
    int nxt = 0;
    if (tid == 0) nxt = (int)__hip_atomic_fetch_add(queue, 1u, __ATOMIC_RELAXED, __HIP_MEMORY_SCOPE_AGENT);
    for (int it = 0;; ++it) {
        if (tid == 0) { qs[it & 1] = nxt; nxt = (int)__hip_atomic_fetch_add(queue, 1u, __ATOMIC_RELAXED, __HIP_MEMORY_SCOPE_AGENT); }
        __syncthreads();
        const int cid = __builtin_amdgcn_readfirstlane(qs[it & 1]);
        if (cid >= total) break;
        int lo = 0, hi_ = 511; while (lo < hi_) { const int mid = (lo + hi_) >> 1; if (nch[mid] > cid) hi_ = mid; else lo = mid + 1; }
        const int pair = lo, c = cid - (pair ? nch[pair - 1] : 0);
        moba_kv_chunk(P, SELB, CNTQ, LISTG, kmax, pair >> 5, pair & 31, c, tid, lds);
    }
    __syncthreads();
}

constexpr int NSA_S4_OFF = PIPE_BYTES, NSA_L4_OFF = NSA_S4_OFF + 8 * 8 * 128 * 4, NSA_SM_OFF = NSA_L4_OFF + 8 * 8 * 128 * 4;
struct NsaCtx { const bf16* Pb; const bf16* Kcb; const bf16* Vcb; int b, jq, tid, lane, wid, r32, hi, tq; unsigned mk0, mk1, mk2, mk3; };

template <int MODE>
__device__ __forceinline__ void nsa_tiles(const NsaCtx& c, LAS unsigned char* lds, const bf16x8 (&qf)[4], int nt, f32x16& o0, f32x16& o1, float& m, float& l, float pre) {
    const int tid = c.tid, lane = c.lane, r32 = c.r32, hi = c.hi, tq = c.tq, jq = c.jq;
    const int nw = (jq < 8 ? jq : 8) + 1;
    auto tile_of = [&](int i) -> int { return MODE < 2 ? i : (i == 0 ? jq : (MODE == 2 ? i - 1 : jq - nw + i)); };
    auto src_of = [&](int t) -> TileSrc {
        if (MODE < 2) return TileSrc{c.Kcb + (size_t)t * 64 * 64, c.Vcb + (size_t)t * 64 * 64, 64};
        if (MODE == 2) return TileSrc{c.Pb + (size_t)t * 64 * DINP + C_NKS, c.Pb + (size_t)t * 64 * DINP + C_NVS, DINP};
        return TileSrc{c.Pb + (size_t)t * 64 * DINP + C_NKW, c.Pb + (size_t)t * 64 * DINP + C_NVW, DINP};
    };
    u32x4v kA, vA, kB, vB;
    if (MODE == 1) {
        kA = u32x4v{0u, 0u, 0u, 0u}; vA = kA; kB = kA; vB = kA;
        if (nt >= 3) { const TileSrc s = src_of(nt - 3); tile_load(kA, vA, s, tid); }
        if (nt >= 4) { const TileSrc s = src_of(nt - 4); tile_load(kB, vB, s, tid); }
    } else {
    { const TileSrc s = src_of(tile_of(0)); tile_load(kA, vA, s, tid); }
    kB = kA; vB = vA;
    if (1 < nt) { const TileSrc s = src_of(tile_of(1)); tile_load(kB, vB, s, tid); }
    tile_store(lds, kA, vA, tid);
    if (2 < nt) { const TileSrc s = src_of(tile_of(2)); tile_load(kA, vA, s, tid); }
    __syncthreads();
    }
    const int ncv = (tq >= 31) ? ((tq - 31) >> 4) + 1 : 0;
    const int tq0 = jq * 64 + c.wid * 8, ncvmin = (tq0 >= 31) ? ((tq0 - 31) >> 4) + 1 : 0;
    auto compute = [&](const int i) {
        const int tile = tile_of(i);
        LAS const unsigned char* buf = lds + (i & 1) * STG;
        const int kbase = tile * 64;
        bool rowsel = true;
        if (MODE == 2 && tile != jq) { const unsigned w = (tile >> 5) == 0 ? c.mk0 : (tile >> 5) == 1 ? c.mk1 : (tile >> 5) == 2 ? c.mk2 : c.mk3; rowsel = (w >> (tile & 31)) & 1u; }
        if (MODE != 2 || __any(rowsel)) {
            f32x16 p0, p1;
            qk_tile(p0, p1, buf, qf, r32, hi, MODE < 2 ? m : (rowsel ? -m : NEGBIG));
            if (MODE < 2) {
                if (kbase + 64 > ncvmin) {
#pragma unroll
                for (int r = 0; r < 16; ++r) { const int k0 = kbase + crow(r, hi); p0[r] = (k0 < ncv) ? p0[r] : NEGBIG; p1[r] = (k0 + 32 < ncv) ? p1[r] : NEGBIG; } }
            } else if (MODE == 2) {
                if (tile == jq) {
#pragma unroll
                    for (int r = 0; r < 16; ++r) { const int k0 = kbase + crow(r, hi); p0[r] = (k0 <= tq) ? p0[r] : NEGBIG; p1[r] = (k0 + 32 <= tq) ? p1[r] : NEGBIG; }
                }
            } else if (tile == jq || tile + 8 == jq) {
#pragma unroll
                for (int r = 0; r < 16; ++r) { const int k0 = kbase + crow(r, hi);
                    p0[r] = (k0 <= tq && k0 + 511 >= tq) ? p0[r] : NEGBIG; p1[r] = (k0 + 32 <= tq && k0 + 32 + 511 >= tq) ? p1[r] : NEGBIG; }
            }
            if (MODE == 0) {
                float s0 = 0.f, s1 = 0.f;
#pragma unroll
                for (int r = 0; r < 16; ++r) { s0 += __builtin_amdgcn_exp2f(p0[r]); s1 += __builtin_amdgcn_exp2f(p1[r]); }
                l += s0 + s1;
            } else if (MODE == 1) {
#pragma unroll
                for (int r = 0; r < 16; ++r) { p0[r] = __builtin_amdgcn_exp2f(p0[r]) * pre; p1[r] = __builtin_amdgcn_exp2f(p1[r]) * pre; }
                pv_tile(o0, o1, buf + KBUF, p0, p1, lane);
                LAS float* S4 = (LAS float*)(lds + NSA_S4_OFF) + (c.wid * 8 + (r32 & 7)) * 128; LAS float* L4 = (LAS float*)(lds + NSA_L4_OFF) + (c.wid * 8 + (r32 & 7)) * 128;
                float s4v[8], lav[8];
#pragma unroll
                for (int mbk = 0; mbk < 2; ++mbk)
#pragma unroll
                    for (int g = 0; g < 4; ++g) {
                        s4v[mbk * 4 + g] = mbk ? (p1[4 * g] + p1[4 * g + 1]) + (p1[4 * g + 2] + p1[4 * g + 3]) : (p0[4 * g] + p0[4 * g + 1]) + (p0[4 * g + 2] + p0[4 * g + 3]);
                        lav[mbk * 4 + g] = mbk ? p1[4 * g + 3] : p0[4 * g + 3]; }
#pragma unroll
                for (int q = 0; q < 8; ++q) { s4v[q] += shx<8>(s4v[q]); lav[q] += shx<8>(lav[q]); }
#pragma unroll
                for (int q = 0; q < 8; ++q) { s4v[q] += shx<16>(s4v[q]); lav[q] += shx<16>(lav[q]); }
                if (r32 < 8) {
#pragma unroll
                    for (int q = 0; q < 8; ++q) { const int gi = tile * 16 + 8 * (q >> 2) + 2 * (q & 3) + hi; S4[gi] = s4v[q]; L4[gi] = lav[q]; } }
            } else {
                softmax_tile(p0, p1, o0, o1, m, l, i == 0);
                pv_tile(o0, o1, buf + KBUF, p0, p1, lane);
            }
        }
    };
    if (MODE == 1) {
        for (int i = 0; i < nt; i += 2) {
            const int t = nt - 1 - i;
            compute(t);
            __syncthreads();
            if (t >= 2) { tile_store(lds + (t & 1) * STG, kA, vA, tid); if (t >= 4) { const TileSrc s = src_of(t - 4); tile_load(kA, vA, s, tid); } }
            if (i + 1 < nt) { const int t2 = t - 1;
                compute(t2);
                __syncthreads();
                if (t2 >= 2) { tile_store(lds + (t2 & 1) * STG, kB, vB, tid); if (t2 >= 4) { const TileSrc s = src_of(t2 - 4); tile_load(kB, vB, s, tid); } } }
        }
        return;
    }
    for (int i = 0; i < nt; i += 2) {
        compute(i);
        if (i + 1 < nt) tile_store(lds + STG, kB, vB, tid);
        if (i + 3 < nt) { const TileSrc s = src_of(tile_of(i + 3)); tile_load(kB, vB, s, tid); }
        __syncthreads();
        if (i + 1 < nt) {
            compute(i + 1);
            if (i + 2 < nt) tile_store(lds, kA, vA, tid);
            if (i + 4 < nt) { const TileSrc s = src_of(tile_of(i + 4)); tile_load(kA, vA, s, tid); }
            __syncthreads();
        }
    }
}

struct NsaSelPol {
    int ws, nt, nmask, stride, jq, tq, hi; unsigned long long mlo, mhi; const bf16* Pk; const bf16* Pv;
    __device__ __forceinline__ int tile_of(int i) const { return i == 0 ? jq : i - 1; }
    __device__ __forceinline__ const bf16* kptr(int i) const { return Pk + (size_t)tile_of(i) * 64 * DINP; }
    __device__ __forceinline__ const bf16* vptr(int i) const { return Pv + (size_t)tile_of(i) * 64 * DINP; }
    __device__ __forceinline__ bool active(int) const { return true; }
    __device__ __forceinline__ bool rowsel(int i) const { if (i == 0) return true; const int tile = i - 1; const unsigned long long w = tile < 64 ? mlo : mhi; return (w >> (tile & 63)) & 1ull; }
    __device__ __forceinline__ void mask(int i, f32x16& p0, f32x16& p1) const {
        if (i == 0) { const int kbase = jq * 64;
#pragma unroll
            for (int r = 0; r < 16; ++r) { const int k0 = kbase + crow(r, hi); p0[r] = (k0 <= tq) ? p0[r] : NEGBIG; p1[r] = (k0 + 32 <= tq) ? p1[r] : NEGBIG; } }
    }
};
struct NsaWinPol {
    int ws, nt, nmask, stride, jq, tq, hi; const bf16* Pk; const bf16* Pv;
    __device__ __forceinline__ int tile_of(int i) const { return i == 0 ? jq : jq - nt + i; }
    __device__ __forceinline__ const bf16* kptr(int i) const { return Pk + (size_t)tile_of(i) * 64 * DINP; }
    __device__ __forceinline__ const bf16* vptr(int i) const { return Pv + (size_t)tile_of(i) * 64 * DINP; }
    __device__ __forceinline__ bool active(int) const { return true; }
    __device__ __forceinline__ bool rowsel(int) const { return true; }
    __device__ __forceinline__ void mask(int i, f32x16& p0, f32x16& p1) const {
        const int tile = tile_of(i);
        if (tile == jq || tile + 8 == jq) { const int kbase = tile * 64;
#pragma unroll
            for (int r = 0; r < 16; ++r) { const int k0 = kbase + crow(r, hi);
                p0[r] = (k0 <= tq && k0 + 511 >= tq) ? p0[r] : NEGBIG; p1[r] = (k0 + 32 <= tq && k0 + 32 + 511 >= tq) ? p1[r] : NEGBIG; } }
    }
};
__device__ __forceinline__ void nsa_unit(const bf16* __restrict__ P, const float* __restrict__ G, const float* __restrict__ tab, const bf16* __restrict__ KVcb, const float* __restrict__ kgain  , bf16* __restrict__ MIX,
                                         int b, int jq, int tid, LAS unsigned char* lds, int wave_s) {
    asm volatile("" : "+v"(tid));
    NsaCtx c; c.b = b; c.jq = jq; c.tid = tid; c.lane = tid & 63; c.wid = __builtin_amdgcn_readfirstlane(tid >> 6); c.r32 = c.lane & 31; c.hi = c.lane >> 5;
    const int qi = c.r32 & 7, hh = c.r32 >> 3, hi = c.hi, lane = c.lane;
    c.tq = jq * 64 + c.wid * 8 + qi;
    c.Pb = P + (size_t)b * SEQ * DINP; c.Kcb = KVcb + (size_t)b * 512 * 64; c.Vcb = KVcb + ((size_t)NB + b) * 512 * 64;
    c.mk0 = c.mk1 = c.mk2 = c.mk3 = 0u;
    const size_t rowq = (size_t)b * SEQ + c.tq;
    bf16x8 qf[4];
#pragma unroll
    for (int ks = 0; ks < 4; ++ks) qf[ks] = scale_frag(*(const bf16x8*)(P + rowq * DINP + C_NQ + hh * 64 + ks * 16 + hi * 8), SCL2);
    const float g0 = sigmoidf_(G[rowq * 32 + 8 + hh]);
    { LAS float* gl = (LAS float*)(lds + NSA_SM_OFF + 1024); gl[tid] = sigmoidf_(G[rowq * 32 + 12 + hh]); gl[512 + tid] = sigmoidf_(G[rowq * 32 + 16 + hh]); }
    f32x16 a0, a1;
    {
        const int ncvmax = min(4 * jq + 3, NCMP), nct = (ncvmax + 63) >> 6;
        f32x16 o0, o1;
#pragma unroll
        for (int r = 0; r < 16; ++r) { o0[r] = zf_(); o1[r] = o0[r]; }
        float m = row_negm(qf, gain_kmax(kgain, lane)), l = 0.f;
#ifdef PROBE_CMP
        { f32x16 t0 = o0, t1 = o1; float tm = m, tl = l; nsa_tiles<0>(c, lds, qf, nct, t0, t1, tm, tl, 0.f); tl += shx<32>(tl); nsa_tiles<1>(c, lds, qf, nct, t0, t1, tm, tl, tl > 0.f ? rcpf_(tl) : 0.f); asm volatile("" :: "v"(t0), "v"(t1)); }
#endif
        nsa_tiles<0>(c, lds, qf, nct, o0, o1, m, l, 0.f);
        l += shx<32>(l);
        const float pre = (l > 0.f) ? rcpf_(l) : 0.f;
        nsa_tiles<1>(c, lds, qf, nct, o0, o1, m, l, pre);
#pragma unroll
        for (int r = 0; r < 16; ++r) { a0[r] = g0 * o0[r]; a1[r] = g0 * o1[r]; }
    }
    {
        LAS unsigned* sm = (LAS unsigned*)(lds + NSA_SM_OFF);
        unsigned u0[8], u1[8];
#pragma unroll
        for (int q = 0; q < 8; ++q) {
            LAS const float* S4 = (LAS const float*)(lds + NSA_S4_OFF) + (c.wid * 8 + q) * 128; LAS const float* L4 = (LAS const float*)(lds + NSA_L4_OFF) + (c.wid * 8 + q) * 128;
            const int n0 = lane, n1 = lane + 64;
            const float s0 = S4[n0], l0 = L4[n0 > 0 ? n0 - 1 : 0], s1 = S4[n1], l1 = L4[n1 - 1];
            const bool causal0 = n0 <= jq, forced0 = causal0 && (n0 == 0 || n0 >= jq - 1), causal1 = n1 <= jq, forced1 = causal1 && (n1 >= jq - 1);
            const float v0 = forced0 ? 1e9f : (causal0 ? s0 + (n0 > 0 ? l0 : 0.f) : -1e30f), v1 = forced1 ? 1e9f : (causal1 ? s1 + l1 : -1e30f);
            const unsigned b0_ = __float_as_uint(v0), b1_ = __float_as_uint(v1);
            u0[q] = b0_ ^ ((b0_ >> 31) ? 0xFFFFFFFFu : 0x80000000u); u1[q] = b1_ ^ ((b1_ >> 31) ? 0xFFFFFFFFu : 0x80000000u);
        }
        unsigned T[8];
#pragma unroll
        for (int q = 0; q < 8; ++q) T[q] = 0u;
#pragma unroll
        for (int bit = 31; bit >= 0; --bit) {
#pragma unroll
            for (int q = 0; q < 8; ++q) { const unsigned cand = T[q] | (1u << bit);
                const int cn = __popcll(__ballot(u0[q] >= cand)) + __popcll(__ballot(u1[q] >= cand));
                if (cn >= 16) T[q] = cand; } }
#pragma unroll
        for (int q = 0; q < 8; ++q) {
            const unsigned long long g0b = __ballot(u0[q] > T[q]), g1b = __ballot(u1[q] > T[q]), e0b = __ballot(u0[q] == T[q]), e1b = __ballot(u1[q] == T[q]);
            const int rem = 16 - (__popcll(g0b) + __popcll(g1b));
            const unsigned long long ltm = (1ull << lane) - 1ull;
            const unsigned long long sel0 = g0b | __ballot(u0[q] == T[q] && __popcll(e0b & ltm) < rem);
            const unsigned long long sel1 = g1b | __ballot(u1[q] == T[q] && __popcll(e0b) + __popcll(e1b & ltm) < rem);
            if (lane == 0) { sm[(c.wid * 8 + q) * 4 + 0] = (unsigned)sel0; sm[(c.wid * 8 + q) * 4 + 1] = (unsigned)(sel0 >> 32); sm[(c.wid * 8 + q) * 4 + 2] = (unsigned)sel1; sm[(c.wid * 8 + q) * 4 + 3] = (unsigned)(sel1 >> 32); }
        }
        __builtin_amdgcn_s_waitcnt(0xc07f); __builtin_amdgcn_wave_barrier();
        c.mk0 = sm[(c.wid * 8 + qi) * 4 + 0]; c.mk1 = sm[(c.wid * 8 + qi) * 4 + 1]; c.mk2 = sm[(c.wid * 8 + qi) * 4 + 2]; c.mk3 = sm[(c.wid * 8 + qi) * 4 + 3];
    }
    LAS float* stash = (LAS float*)(lds + NSA_S4_OFF) + c.wid * 1024 + lane;
    LAS float* stash2 = (LAS float*)(lds + NSA_L4_OFF) + c.wid * 1024 + lane;
#pragma unroll
    for (int r = 0; r < 16; ++r) { stash[r * 64] = a0[r]; stash2[r * 64] = a1[r]; }
    {
        const u32x4v qw = __builtin_bit_cast(u32x4v, qf[0]); u32x4v w;
#pragma unroll
        for (int e = 0; e < 4; ++e) {
            float y[2];
#pragma unroll
            for (int k = 0; k < 2; ++k) { const int j = 2 * e + k; const float x = k ? __builtin_bit_cast(float, qw[e] & 0xffff0000u) : __builtin_bit_cast(float, qw[e] << 16); const float other = shx<32>(x);
                const float cs = tab[c.tq * 16 + j], sn = tab[c.tq * 16 + 8 + j]; y[k] = hi ? (x * cs + other * sn) : (x * cs - other * sn); }
            w[e] = cvtpk(y[0], y[1]);
        }
        qf[0] = __builtin_bit_cast(bf16x8, w);
    }
    {
        f32x16 o0, o1;
#pragma unroll
        for (int r = 0; r < 16; ++r) { o0[r] = zf_(); o1[r] = o0[r]; }
        float l = 0.f;
        NsaSelPol pol; pol.ws = wave_s; pol.nt = jq + 1; pol.nmask = 1; pol.stride = DINP; pol.jq = jq; pol.tq = c.tq; pol.hi = hi; pol.mlo = (unsigned long long)c.mk0 | ((unsigned long long)c.mk1 << 32); pol.mhi = (unsigned long long)c.mk2 | ((unsigned long long)c.mk3 << 32); pol.Pk = c.Pb + C_NKS; pol.Pv = c.Pb + C_NVS;
#ifdef PROBE_SEL
        { attn_pipe(pol, lds, qf, row_negm(qf, gain_kmax(kgain + 64, lane)), o0, o1, l, tid); asm volatile("" : "+v"(o0), "+v"(o1), "+v"(l));
#pragma unroll
          for (int r = 0; r < 16; ++r) { o0[r] = zf_(); o1[r] = o0[r]; } l = zf_(); }
#endif
        attn_pipe(pol, lds, qf, row_negm(qf, gain_kmax(kgain + 64, lane)), o0, o1, l, tid);
        l += shx<32>(l);
        int t2 = mk_tid(wave_s);
        const float sc = ((LAS const float*)(lds + NSA_SM_OFF + 1024))[t2] * rcpf_(l);
        LAS float* st1 = (LAS float*)(lds + NSA_S4_OFF) + (t2 >> 6) * 1024 + (t2 & 63); LAS float* st2 = (LAS float*)(lds + NSA_L4_OFF) + (t2 >> 6) * 1024 + (t2 & 63);
#pragma unroll
        for (int r = 0; r < 16; ++r) { st1[r * 64] = fmaf(sc, o0[r], st1[r * 64]); st2[r * 64] = fmaf(sc, o1[r], st2[r * 64]); }
    }
    {
        f32x16 o0, o1;
#pragma unroll
        for (int r = 0; r < 16; ++r) { o0[r] = zf_(); o1[r] = o0[r]; }
        float l = 0.f;
        NsaWinPol pol; pol.ws = wave_s; pol.nt = (jq < 8 ? jq : 8) + 1; pol.nmask = 2; pol.stride = DINP; pol.jq = jq; pol.tq = c.tq; pol.hi = hi; pol.Pk = c.Pb + C_NKW; pol.Pv = c.Pb + C_NVW;
#ifdef PROBE_WIN
        { attn_pipe(pol, lds, qf, row_negm(qf, gain_kmax(kgain + 128, lane)), o0, o1, l, tid); asm volatile("" : "+v"(o0), "+v"(o1), "+v"(l));
#pragma unroll
          for (int r = 0; r < 16; ++r) { o0[r] = zf_(); o1[r] = o0[r]; } l = zf_(); }
#endif
        attn_pipe(pol, lds, qf, row_negm(qf, gain_kmax(kgain + 128, lane)), o0, o1, l, tid);
        l += shx<32>(l);
        int t2 = mk_tid(wave_s);
        const float sc = ((LAS const float*)(lds + NSA_SM_OFF + 1024))[512 + t2] * rcpf_(l);
        LAS const float* st1 = (LAS const float*)(lds + NSA_S4_OFF) + (t2 >> 6) * 1024 + (t2 & 63); LAS const float* st2 = (LAS const float*)(lds + NSA_L4_OFF) + (t2 >> 6) * 1024 + (t2 & 63);
#pragma unroll
        for (int r = 0; r < 16; ++r) { a0[r] = fmaf(sc, o0[r], st1[r * 64]); a1[r] = fmaf(sc, o1[r], st2[r * 64]); }
    }
    int t3 = mk_tid(wave_s);
    const int ln3 = t3 & 63, r3 = ln3 & 31;
    bf16* op = MIX + ((size_t)b * SEQ + jq * 64 + (t3 >> 6) * 8 + (r3 & 7)) * DM + 768 + (r3 >> 3) * 64 + 4 * (ln3 >> 5);
#pragma unroll
    for (int g = 0; g < 4; ++g) {
        uint2 w0, w1;
        w0.x = cvtpk(a0[4 * g], a0[4 * g + 1]); w0.y = cvtpk(a0[4 * g + 2], a0[4 * g + 3]);
        w1.x = cvtpk(a1[4 * g], a1[4 * g + 1]); w1.y = cvtpk(a1[4 * g + 2], a1[4 * g + 3]);
        *(uint2*)(op + 8 * g) = w0; *(uint2*)(op + 32 + 8 * g) = w1;
    }
}


constexpr int MQ_PITCH = 272, MV_PITCH = 320;
constexpr int ML_G_OFF = 0;
constexpr int ML_Q_OFF = 4096;
constexpr int ML_K_OFF = ML_Q_OFF + 64 * MQ_PITCH;
constexpr int ML_V_OFF = ML_K_OFF + 64 * MV_PITCH;
constexpr int ML_END = ML_V_OFF + 64 * MV_PITCH;
static_assert(ML_END <= 131072, "mlstm LDS");
constexpr float KSCALE = 0.08838834764831845f;

__device__ __forceinline__ void qk2_rows(const bf16* __restrict__ P, const float* __restrict__ cw, bf16* __restrict__ QK2, int bid, int G, int tid) {
    asm volatile("" : "+v"(tid));
    const int ch = tid & 127, c0 = ch * 8;
    float tp[4][8];
#pragma unroll
    for (int j = 0; j < 4; ++j) { const float4 a = *(const float4*)(cw + j * 1024 + c0), b4 = *(const float4*)(cw + j * 1024 + c0 + 4);
        tp[j][0] = a.x; tp[j][1] = a.y; tp[j][2] = a.z; tp[j][3] = a.w; tp[j][4] = b4.x; tp[j][5] = b4.y; tp[j][6] = b4.z; tp[j][7] = b4.w; }
    const float sc = (c0 >= 512) ? KSCALE : 1.f;
    for (int row0 = bid * 4 + (tid >> 7); row0 < T; row0 += G * 16) {
        u32x4v w[4][4];
#pragma unroll
        for (int q = 0; q < 4; ++q) { const int row = row0 + q * G * 4, t = row & (SEQ - 1);
#pragma unroll
            for (int j = 0; j < 4; ++j) { w[q][j] = u32x4v{0u, 0u, 0u, 0u}; if (row < T && t - 3 + j >= 0) w[q][j] = *(const u32x4v*)(P + (size_t)(row - 3 + j) * DINP + c0); } }
#pragma unroll
        for (int q = 0; q < 4; ++q) { const int row = row0 + q * G * 4;
            float y[8];
#pragma unroll
            for (int e = 0; e < 8; ++e) y[e] = 0.f;
#pragma unroll
            for (int j = 0; j < 4; ++j)
#pragma unroll
                for (int e = 0; e < 4; ++e) { y[2 * e] = fmaf(tp[j][2 * e], __builtin_bit_cast(float, w[q][j][e] << 16), y[2 * e]); y[2 * e + 1] = fmaf(tp[j][2 * e + 1], __builtin_bit_cast(float, w[q][j][e] & 0xffff0000u), y[2 * e + 1]); }
#pragma unroll
            for (int e = 0; e < 8; ++e) y[e] = y[e] * rcpf_(1.f + __expf(-y[e])) * sc;
            u32x4v o; o[0] = cvtpk(y[0], y[1]); o[1] = cvtpk(y[2], y[3]); o[2] = cvtpk(y[4], y[5]); o[3] = cvtpk(y[6], y[7]);
            if (row < T) *(u32x4v*)(QK2 + (size_t)row * 1024 + c0) = o; }
    }
}

struct MlRaw { u32x4v q[2], k[2], v[2]; float gf, gi; };
template <bool WITH_Q> __device__ __forceinline__ void ml_load(MlRaw& r, const bf16* __restrict__ P, const bf16* __restrict__ QK2, const float* __restrict__ G, const float* __restrict__ bif, int u, int tid) {
    const int c = u & 127, h = (u >> 7) & 3, b = u >> 9, row0 = b * SEQ + c * 64, s = tid >> 3;
#pragma unroll
    for (int pass = 0; pass < 2; ++pass) { const int ch = (tid & 7) + 8 * pass;
        if (WITH_Q) r.q[pass] = *(const u32x4v*)(QK2 + (size_t)(row0 + s) * 1024 + h * 128 + ch * 8);
        r.k[pass] = *(const u32x4v*)(QK2 + (size_t)(row0 + s) * 1024 + 512 + h * 128 + ch * 8);
        r.v[pass] = *(const u32x4v*)(P + (size_t)(row0 + s) * DINP + C_MV + h * 128 + ch * 8); }
    if (tid < 64) { r.gf = G[(size_t)(row0 + tid) * 32 + 4 + h] + bif[4 + h]; r.gi = G[(size_t)(row0 + tid) * 32 + h] + bif[h]; }
}
__device__ __forceinline__ void mlstm_gates(const MlRaw& r, int tid, LAS float* gs) {
    if (tid < 64) { gs[tid] = log_sigmoidf_(r.gf); gs[128 + tid] = r.gi; }
    __syncthreads();
    if (tid < 64) { float a = 0.f; for (int s = 0; s <= tid; ++s) a += gs[s]; gs[64 + tid] = a; }
    __syncthreads();
}

__device__ __forceinline__ void mlstm_m1_phase(const bf16* __restrict__ P, const bf16* __restrict__ QK2, const float* __restrict__ G, const float* __restrict__ bif,
                                               bf16* __restrict__ CT, float* __restrict__ nst, float* __restrict__ dec, int bid, int Gd, int tid, LAS unsigned char* lds) {
    asm volatile("" : "+v"(tid));
    const int lane = tid & 63, wid = __builtin_amdgcn_readfirstlane(tid >> 6), hi = lane >> 5;
    LAS float* gs = (LAS float*)(lds + ML_G_OFF);
    MlRaw raw;
    if (bid < 2048) ml_load<false>(raw, P, QK2, G, bif, bid, tid);
    for (int u = bid; u < 2048; u += Gd) {
        mlstm_gates(raw, tid, gs);
        if (tid == 0) dec[u] = __expf(gs[64 + 63]);
        {
            const int s = tid >> 3; const float ws = __expf(gs[64 + 63] - gs[64 + s] + gs[128 + s]);
#pragma unroll
            for (int pass = 0; pass < 2; ++pass) { const int ch = (tid & 7) + 8 * pass; u32x4v w;
#pragma unroll
                for (int e = 0; e < 4; ++e) w[e] = cvtpk(__builtin_bit_cast(float, raw.k[pass][e] << 16) * ws, __builtin_bit_cast(float, raw.k[pass][e] & 0xffff0000u) * ws);
                *(LAS u32x4v*)(lds + ML_K_OFF + s * MV_PITCH + ch * 16) = w;
                *(LAS u32x4v*)(lds + ML_V_OFF + s * MV_PITCH + ch * 16) = raw.v[pass]; }
        }
        if (u + Gd < 2048) ml_load<false>(raw, P, QK2, G, bif, u + Gd, tid);
        __syncthreads();
        const int g = lane >> 4, i = lane & 15;
        const int mb = wid >> 1, nb0 = 2 * (wid & 1);
        f32x16 acc0, acc1;
#pragma unroll
        for (int r = 0; r < 16; ++r) { acc0[r] = zf_(); acc1[r] = acc0[r]; }
        LAS const unsigned char* trb = lds + (4 * hi + (i >> 2)) * MV_PITCH + (16 * (g & 1) + 4 * (i & 3)) * 2;
#pragma unroll
        for (int ks = 0; ks < 4; ++ks) {
            const s16x4 alo = lds_tr(trb + ML_K_OFF + ks * 16 * MV_PITCH + mb * 64), ahi = lds_tr(trb + ML_K_OFF + ks * 16 * MV_PITCH + 8 * MV_PITCH + mb * 64);
            const bf16x8 af = {alo[0], alo[1], alo[2], alo[3], ahi[0], ahi[1], ahi[2], ahi[3]};
            const s16x4 b0lo = lds_tr(trb + ML_V_OFF + ks * 16 * MV_PITCH + nb0 * 64), b0hi = lds_tr(trb + ML_V_OFF + ks * 16 * MV_PITCH + 8 * MV_PITCH + nb0 * 64);
            const s16x4 b1lo = lds_tr(trb + ML_V_OFF + ks * 16 * MV_PITCH + (nb0 + 1) * 64), b1hi = lds_tr(trb + ML_V_OFF + ks * 16 * MV_PITCH + 8 * MV_PITCH + (nb0 + 1) * 64);
            const bf16x8 bf0 = {b0lo[0], b0lo[1], b0lo[2], b0lo[3], b0hi[0], b0hi[1], b0hi[2], b0hi[3]}, bf1 = {b1lo[0], b1lo[1], b1lo[2], b1lo[3], b1hi[0], b1hi[1], b1hi[2], b1hi[3]};
            acc0 = __builtin_amdgcn_mfma_f32_32x32x16_bf16(af, bf0, acc0, 0, 0, 0);
            acc1 = __builtin_amdgcn_mfma_f32_32x32x16_bf16(af, bf1, acc1, 0, 0, 0);
        }
        bf16* ct = CT + (size_t)u * 16384;
#pragma unroll
        for (int gq = 0; gq < 4; ++gq) { const int d0 = 32 * mb + 8 * gq + 4 * hi;
            uint2 w0, w1; w0.x = cvtpk(acc0[4 * gq], acc0[4 * gq + 1]); w0.y = cvtpk(acc0[4 * gq + 2], acc0[4 * gq + 3]); w1.x = cvtpk(acc1[4 * gq], acc1[4 * gq + 1]); w1.y = cvtpk(acc1[4 * gq + 2], acc1[4 * gq + 3]);
            *(uint2*)(ct + (size_t)(32 * nb0 + (lane & 31)) * 128 + d0) = w0; *(uint2*)(ct + (size_t)(32 * (nb0 + 1) + (lane & 31)) * 128 + d0) = w1; }
        if (tid < 128) { float a = 0.f; for (int s = 0; s < 64; ++s) a += bf2f(*(LAS const bf16*)(lds + ML_K_OFF + s * MV_PITCH + tid * 2)); nst[(size_t)u * 128 + tid] = a; }
        __syncthreads();
    }
}
__device__ __forceinline__ void mlstm_scan(bf16* __restrict__ CT, float* __restrict__ nst, const float* __restrict__ dec, int item, int tid) {
    asm volatile("" : "+v"(tid));
    const int bh = item / 9, part = item % 9;
    if (part < 8) {
        bf16* base = CT + (size_t)bh * 128 * 16384 + (part * 512 + tid) * 4;
        float C[4]; C[0] = zf_(); C[1] = C[0]; C[2] = C[0]; C[3] = C[0];
        for (int c0 = 0; c0 < 128; c0 += 16) {
            uint2 w[16];
#pragma unroll
            for (int k = 0; k < 16; ++k) w[k] = *(const uint2*)(base + (size_t)(c0 + k) * 16384);
#pragma unroll
            for (int k = 0; k < 16; ++k) { const float a = dec[bh * 128 + c0 + k];
                uint2 o; o.x = cvtpk(C[0], C[1]); o.y = cvtpk(C[2], C[3]); *(uint2*)(base + (size_t)(c0 + k) * 16384) = o;
                C[0] = fmaf(a, C[0], __builtin_bit_cast(float, w[k].x << 16)); C[1] = fmaf(a, C[1], __builtin_bit_cast(float, w[k].x & 0xffff0000u));
                C[2] = fmaf(a, C[2], __builtin_bit_cast(float, w[k].y << 16)); C[3] = fmaf(a, C[3], __builtin_bit_cast(float, w[k].y & 0xffff0000u)); }
        }
    } else if (tid < 128) {
        float* base = nst + (size_t)bh * 128 * 128 + tid; float C = 0.f;
        for (int c = 0; c < 128; ++c) { const float dC = base[(size_t)c * 128]; base[(size_t)c * 128] = C; C = dec[bh * 128 + c] * C + dC; }
    }
}

__device__ __forceinline__ void mlstm_m3_phase(const bf16* __restrict__ P, const bf16* __restrict__ QK2, const float* __restrict__ G, const float* __restrict__ bif,
                                               const bf16* __restrict__ CT, const float* __restrict__ nst, const float* __restrict__ mnorm, bf16* __restrict__ MIX, int bid, int Gd, int tid, LAS unsigned char* lds) {
    asm volatile("" : "+v"(tid));
    const int lane = tid & 63, wid = __builtin_amdgcn_readfirstlane(tid >> 6), hi = lane >> 5, r32 = lane & 31;
    LAS float* gs = (LAS float*)(lds + ML_G_OFF);
    MlRaw raw;
    if (bid < 2048) ml_load<true>(raw, P, QK2, G, bif, bid, tid);
    for (int u = bid; u < 2048; u += Gd) {
    const int c = u & 127, h = (u >> 7) & 3, b = u >> 9, t0 = c * 64;
    const int tb = wid & 1, eb = wid >> 1, t = 32 * tb + r32;
    bf16x8 cf[8]; uint2 opre[4]; float npv = 0.f;
    { const bf16* ctp = CT + (size_t)u * 16384 + (size_t)(32 * eb + r32) * 128 + hi * 8;
#pragma unroll
      for (int ks = 0; ks < 8; ++ks) cf[ks] = *(const bf16x8*)(ctp + ks * 16);
      const size_t row_ = (size_t)b * SEQ + t0 + t;
#pragma unroll
      for (int gq = 0; gq < 4; ++gq) opre[gq] = *(const uint2*)(P + row_ * DINP + C_MO + h * 128 + 32 * eb + 8 * gq + 4 * hi);
      if (tid >= 128 && tid < 256) npv = nst[(size_t)u * 128 + tid - 128]; }
    if (tid >= 128 && tid < 256) gs[256 + tid - 128] = npv;
    mlstm_gates(raw, tid, gs);
    {
        const int s = tid >> 3;
#pragma unroll
        for (int pass = 0; pass < 2; ++pass) { const int ch = (tid & 7) + 8 * pass;
            *(LAS u32x4v*)(lds + ML_Q_OFF + s * MQ_PITCH + ch * 16) = raw.q[pass];
            *(LAS u32x4v*)(lds + ML_K_OFF + s * MQ_PITCH + ch * 16) = raw.k[pass];
            *(LAS u32x4v*)(lds + ML_V_OFF + s * MV_PITCH + ch * 16) = raw.v[pass]; }
    }
    if (u + Gd < 2048) ml_load<true>(raw, P, QK2, G, bif, u + Gd, tid);
    __syncthreads();
    bf16x8 qf[8];
#pragma unroll
    for (int ks = 0; ks < 8; ++ks) qf[ks] = *(LAS const bf16x8*)(lds + ML_Q_OFF + t * MQ_PITCH + ks * 32 + hi * 16);
    f32x16 ni;
#pragma unroll
    for (int r = 0; r < 16; ++r) ni[r] = zf_();
#pragma unroll
    for (int ks = 0; ks < 8; ++ks) ni = __builtin_amdgcn_mfma_f32_32x32x16_bf16(cf[ks], qf[ks], ni, 0, 0, 0);
    f32x16 p0, p1;
#pragma unroll
    for (int r = 0; r < 16; ++r) { p0[r] = zf_(); p1[r] = p0[r]; }
    { LAS const unsigned char* ka = lds + ML_K_OFF + r32 * MQ_PITCH + hi * 16;
#pragma unroll
      for (int ks = 0; ks < 8; ++ks) { const bf16x8 a0 = *(LAS const bf16x8*)(ka + ks * 32); p0 = __builtin_amdgcn_mfma_f32_32x32x16_bf16(a0, qf[ks], p0, 0, 0, 0); }
      if (tb == 1) {
#pragma unroll
          for (int ks = 0; ks < 8; ++ks) { const bf16x8 a1 = *(LAS const bf16x8*)(ka + 32 * MQ_PITCH + ks * 32); p1 = __builtin_amdgcn_mfma_f32_32x32x16_bf16(a1, qf[ks], p1, 0, 0, 0); } } }
    const float bt = gs[64 + t], Ft = __expf(bt);
    float dsum = 0.f;
#pragma unroll
    for (int r = 0; r < 16; ++r) { const int s0 = crow(r, hi);
        { const float w = (s0 <= t) ? __expf(bt - gs[64 + s0] + gs[128 + s0]) : 0.f; p0[r] *= w; dsum += p0[r]; }
        { const int s1 = s0 + 32; const float w = (s1 <= t) ? __expf(bt - gs[64 + s1] + gs[128 + s1]) : 0.f; p1[r] *= w; dsum += p1[r]; } }
    float qn = 0.f;
#pragma unroll
    for (int ks = 0; ks < 8; ++ks)
#pragma unroll
        for (int j = 0; j < 8; ++j) qn = fmaf(bf2f((bf16)qf[ks][j]), gs[256 + ks * 16 + hi * 8 + j], qn);
    dsum += shx<32>(dsum); qn += shx<32>(qn);
    const float den = dsum + Ft * qn, inv = rcpf_(fmaxf(fabsf(den), 1.f));
    f32x16 na;
#pragma unroll
    for (int r = 0; r < 16; ++r) na[r] = zf_();
    { const int g = lane >> 4, i = lane & 15;
      LAS const unsigned char* trb = lds + ML_V_OFF + (4 * hi + (i >> 2)) * MV_PITCH + (16 * (g & 1) + 4 * (i & 3)) * 2 + eb * 64;
#pragma unroll
      for (int ss = 0; ss < 4; ++ss) { if (ss >= 2 && tb == 0) break;
          unsigned w[4];
#pragma unroll
          for (int e = 0; e < 4; ++e) { const int r = 8 * (ss & 1) + 2 * e; w[e] = (ss < 2) ? cvtpk(p0[r], p0[r + 1]) : cvtpk(p1[r], p1[r + 1]); }
          const u32x4v wv = {w[0], w[1], w[2], w[3]}; const bf16x8 pf = __builtin_bit_cast(bf16x8, wv);
          const s16x4 lo = lds_tr(trb + ss * 16 * MV_PITCH), hi4 = lds_tr(trb + ss * 16 * MV_PITCH + 8 * MV_PITCH);
          const bf16x8 vt = {lo[0], lo[1], lo[2], lo[3], hi4[0], hi4[1], hi4[2], hi4[3]};
          na = __builtin_amdgcn_mfma_f32_32x32x16_bf16(vt, pf, na, 0, 0, 0); } }
    float ssq = 0.f;
#pragma unroll
    for (int r = 0; r < 16; ++r) { na[r] = (na[r] + Ft * ni[r]) * inv; ssq += na[r] * na[r]; }
    ssq += shx<32>(ssq);
    if (hi == 0) gs[384 + eb * 64 + t] = ssq;
    __syncthreads();
    const float rstd = rsqrtf((gs[384 + t] + gs[384 + 64 + t] + gs[384 + 128 + t] + gs[384 + 192 + t]) * (1.f / 128.f) + EPS);
    const size_t row = (size_t)b * SEQ + t0 + t;
#pragma unroll
    for (int gq = 0; gq < 4; ++gq) { const int cc = h * 128 + 32 * eb + 8 * gq + 4 * hi;
        const uint2 ow = opre[gq]; const float4 mn = *(const float4*)(mnorm + cc);
        const float o0 = sigmoidf_(__builtin_bit_cast(float, ow.x << 16)), o1 = sigmoidf_(__builtin_bit_cast(float, ow.x & 0xffff0000u)), o2 = sigmoidf_(__builtin_bit_cast(float, ow.y << 16)), o3 = sigmoidf_(__builtin_bit_cast(float, ow.y & 0xffff0000u));
        uint2 w; w.x = cvtpk(na[4 * gq] * rstd * mn.x * o0, na[4 * gq + 1] * rstd * mn.y * o1); w.y = cvtpk(na[4 * gq + 2] * rstd * mn.z * o2, na[4 * gq + 3] * rstd * mn.w * o3);
        *(uint2*)(MIX + row * DM + cc) = w; }
    __syncthreads();
    }
}


typedef float f32x4v __attribute__((ext_vector_type(4)));
typedef float f32x2v __attribute__((ext_vector_type(2)));
constexpr int CI_W2_OFF = 8 * 16 * 132 * 4, CI_HS_OFF = CI_W2_OFF + 128 * 64 * 4;
static_assert(CI_HS_OFF + 16 * 128 * 4 <= 131072, "compress LDS");
__device__ __forceinline__ void compress_item(const bf16* __restrict__ P, const bf16* __restrict__ w1t  , const float* __restrict__ c1  , const float* __restrict__ w2  ,
                                              const float* __restrict__ kg0, bf16* __restrict__ KVcb, int item, int tid, LAS unsigned char* lds) {
    asm volatile("" : "+v"(tid));
    const int lane = tid & 63, wid = __builtin_amdgcn_readfirstlane(tid >> 6), r16 = lane & 15, g = lane >> 4;
    const int kv = item >> 7, b = (item >> 5) & 3, i0 = (item & 31) * 16;
    const int irow = min(i0 + r16, NCMP - 1);
    const bf16* xa = P + ((size_t)b * SEQ + 16 * irow + 4 * wid) * DINP + (kv ? C_NVC : C_NKC) + g * 8;
    const bf16* wb = w1t + ((size_t)kv * 128 + r16) * 2048 + wid * 256 + g * 8;
    pg8::f32x4 acc[8];
#pragma unroll
    for (int cb = 0; cb < 8; ++cb) { acc[cb][0] = zf_(); acc[cb][1] = acc[cb][0]; acc[cb][2] = acc[cb][0]; acc[cb][3] = acc[cb][0]; }
    bf16x8 af[2][2], bfr[2][16];
#define CI_LOAD(sp, bu) do { _Pragma("unroll") for (int e = 0; e < 2; ++e) { af[bu][e] = *(const bf16x8*)(xa + (size_t)(sp) * DINP + 32 * e); \
        _Pragma("unroll") for (int cb = 0; cb < 8; ++cb) bfr[bu][cb * 2 + e] = *(const bf16x8*)(wb + (size_t)cb * 16 * 2048 + 64 * (sp) + 32 * e); } } while (0)
    CI_LOAD(0, 0);
    f32x4v w2r[4];
    { const f32x4v* w2g = (const f32x4v*)(w2 + (size_t)kv * 128 * 64);
#pragma unroll
      for (int q = 0; q < 4; ++q) w2r[q] = w2g[tid + 512 * q]; }
#pragma unroll
    for (int sp = 0; sp < 4; ++sp) {
        if (sp + 1 < 4) { if (sp & 1) CI_LOAD(sp + 1, 0); else CI_LOAD(sp + 1, 1); }
#pragma unroll
        for (int e = 0; e < 2; ++e)
#pragma unroll
            for (int cb = 0; cb < 8; ++cb) acc[cb] = __builtin_amdgcn_mfma_f32_16x16x32_bf16(af[sp & 1][e], bfr[sp & 1][cb * 2 + e], acc[cb], 0, 0, 0);
    }
#undef CI_LOAD
    LAS float* part = (LAS float*)lds;
#pragma unroll
    for (int cb = 0; cb < 8; ++cb)
#pragma unroll
        for (int i = 0; i < 4; ++i) part[(wid * 16 + 4 * g + i) * 132 + 16 * cb + r16] = acc[cb][i];
    { LAS f32x4v* w2s = (LAS f32x4v*)(lds + CI_W2_OFF);
#pragma unroll
      for (int q = 0; q < 4; ++q) w2s[tid + 512 * q] = w2r[q]; }
    __syncthreads();
    const int il = tid >> 5;
    {
        const int j4 = (tid & 31) * 4;
        f32x4v a = *(const f32x4v*)(c1 + kv * 128 + j4);
#pragma unroll
        for (int w = 0; w < 8; ++w) a += *(LAS const f32x4v*)(part + (w * 16 + il) * 132 + j4);
#pragma unroll
        for (int e = 0; e < 4; ++e) a[e] = a[e] * rcpf_(1.f + __expf(-a[e]));
        *(LAS f32x4v*)(lds + CI_HS_OFF + (il * 128 + j4) * 4) = a;
    }
    __syncthreads();
    {
        const int d0 = (tid & 31) * 2;
        float o0 = 0.f, o1 = 0.f;
        LAS const float* hs = (LAS const float*)(lds + CI_HS_OFF) + il * 128;
        LAS const float* wp = (LAS const float*)(lds + CI_W2_OFF) + d0;
#pragma unroll 8
        for (int j = 0; j < 128; j += 4) { const f32x4v hv = *(LAS const f32x4v*)(hs + j);
#pragma unroll
            for (int e = 0; e < 4; ++e) { const f32x2v wa = *(LAS const f32x2v*)(wp + (j + e) * 64); o0 = fmaf(hv[e], wa[0], o0); o1 = fmaf(hv[e], wa[1], o1); } }
        if (kv == 0) { float ss = o0 * o0 + o1 * o1;
            ss += shx<1>(ss); ss += shx<2>(ss); ss += shx<4>(ss); ss += shx<8>(ss); ss += shx<16>(ss);
            const float rstd = rsqrtf(ss * (1.f / 64.f) + EPS);
            o0 *= rstd * kg0[d0]; o1 *= rstd * kg0[d0 + 1]; }
        const int i = i0 + il;
        if (i >= NCMP) { o0 = zf_(); o1 = o0; }
        *(unsigned*)(KVcb + (((size_t)kv * NB + b) * 512 + i) * 64 + d0) = cvtpk(o0, o1);
    }
    __syncthreads();
}
__device__ __forceinline__ void cmp_c1_item(const float* __restrict__ pe, const float* __restrict__ w1, float* __restrict__ c1, int item, int tid, LAS unsigned char* lds) {
    const int lk = item >> 6, j0 = (item & 63) * 2, jj = tid & 1, kk = tid >> 1;
    const float* pp = pe + (size_t)lk * 2048; const float* ww = w1 + (size_t)lk * 2048 * 128 + j0 + jj;
    float a = 0.f;
#pragma unroll 8
    for (int k = kk; k < 2048; k += 256) a = fmaf(pp[k], ww[(size_t)k * 128], a);
    LAS float* red = (LAS float*)lds;
    red[tid] = a;
    __syncthreads();
    if (tid < 2) { float s = 0.f; for (int q = 0; q < 256; ++q) s += red[q * 2 + tid]; c1[lk * 128 + j0 + tid] = s; }
    __syncthreads();
}

#define XB_TMO      128
#define XB_XCNT(j)  (256  + 64 * (j))
#define XB_XSUB(j)  (1280 + 64 * (j))
#define XB_XGEN(j)  (2304 + 64 * (j))
#define XB_TOP      3328
#define XB_TOPGEN   3392
#define XB_QUEUE(k) (3456 + 64 * (k))
#define XCD_BAR_WORDS (3456 + 64 * 8)
#define XB_SPIN_CAP (1u << 22)

__device__ __forceinline__ unsigned xb_ld(unsigned* p)              { return __hip_atomic_load(p, __ATOMIC_RELAXED, __HIP_MEMORY_SCOPE_AGENT); }
__device__ __forceinline__ unsigned xb_add(unsigned* p, unsigned v) { return __hip_atomic_fetch_add(p, v, __ATOMIC_RELAXED, __HIP_MEMORY_SCOPE_AGENT); }
__device__ __forceinline__ unsigned xb_xcc_id() { return (unsigned)__builtin_amdgcn_s_getreg((3 << 11) | 20) & 0xFu; }
#define XB_SPIN(cond, bar) do { unsigned _sp = 0; while (cond) { __builtin_amdgcn_s_sleep(1); \
    if ((++_sp & 255u) == 0u) { if (xb_ld(&(bar)[XB_TMO])) break; if (_sp > XB_SPIN_CAP) { atomicAdd(&(bar)[XB_TMO], 1u); break; } } } } while (0)

struct XcdBarrier {
    unsigned* bar; unsigned x;
    volatile LAS unsigned* st;
};

__device__ __forceinline__ XcdBarrier xcd_barrier_post(unsigned* bar, volatile LAS unsigned* st) {
    XcdBarrier b; b.bar = bar; b.x = xb_xcc_id(); b.st = st;
    if (threadIdx.x == 0) (void)xb_add(&bar[XB_XCNT(b.x)], 1u);
    return b;
}
__device__ __forceinline__ void xcd_barrier_complete(unsigned* bar, unsigned x, unsigned& nloc, unsigned& nx) {
    const unsigned G = gridDim.x * gridDim.y * gridDim.z;
    unsigned sum, cnt, mine, sp = 0u;
    for (;;) {
        sum = 0u; cnt = 0u; mine = 0u;
#pragma unroll
        for (unsigned j = 0; j < 16; ++j) { const unsigned c = xb_ld(&bar[XB_XCNT(j)]); sum += c; cnt += (c > 0u) ? 1u : 0u; mine = (j == x) ? c : mine; }
        if (sum == G) break;
        __builtin_amdgcn_s_sleep(1);
        if ((++sp & 255u) == 0u) { if (xb_ld(&bar[XB_TMO])) break; if (sp > XB_SPIN_CAP) { atomicAdd(&bar[XB_TMO], 1u); break; } }
    }
    nloc = mine > 0u ? mine : 1u; nx = cnt > 0u ? cnt : 1u;
}

__device__ __forceinline__ void xcd_barrier(const XcdBarrier& b) {
    asm volatile("s_waitcnt vmcnt(0)" ::: "memory");
    __syncthreads();
    if (threadIdx.x == 0) {
        unsigned* bar = b.bar;
        __builtin_amdgcn_s_waitcnt(0);
        unsigned nloc = b.st[0], nx = b.st[1];
        if (nloc == 0u) { xcd_barrier_complete(bar, b.x, nloc, nx); b.st[0] = nloc; b.st[1] = nx; }
        const unsigned old = xb_add(&bar[XB_XSUB(b.x)], 1u);
        const unsigned gen = old / nloc;
        if (old + 1u == (gen + 1u) * nloc) {
            __builtin_amdgcn_fence(__ATOMIC_RELEASE, "agent");
            asm volatile("s_waitcnt vmcnt(0)" ::: "memory");
            const unsigned og = xb_add(&bar[XB_TOP], 1u);
            const unsigned tg = og / nx;
            if (og + 1u == (tg + 1u) * nx) xb_add(&bar[XB_TOPGEN], 1u);
            else XB_SPIN(xb_ld(&bar[XB_TOPGEN]) == tg, bar);
            __builtin_amdgcn_fence(__ATOMIC_ACQUIRE, "agent");
            xb_add(&bar[XB_XGEN(b.x)], 1u);
            asm volatile("s_waitcnt vmcnt(0)" ::: "memory");
        } else {
            XB_SPIN(xb_ld(&bar[XB_XGEN(b.x)]) == gen, bar);
            __builtin_amdgcn_fence(__ATOMIC_ACQUIRE, "agent");
            asm volatile("s_waitcnt vmcnt(0)" ::: "memory");
        }
    }
    __syncthreads();
}


constexpr int M2_G_OFF = 0, M2_STG_OFF = 4096, M2_KIMG = 64 * MQ_PITCH, M2_VIMG = 64 * MV_PITCH, M2_STG = M2_KIMG + M2_VIMG;
static_assert(M2_STG_OFF + 2 * M2_STG <= 131072, "mlstm256 LDS");
constexpr int M2_CT_OFF = M2_STG_OFF + 2 * M2_STG + 512, M2_CT_PITCH = 272;
static_assert(M2_CT_OFF + 128 * M2_CT_PITCH <= 131072, "mlstm256 LDS (C^T image)");
__device__ __forceinline__ void ml256_gates(const float* __restrict__ G, const float* __restrict__ bif, int row0, int h, int tid, LAS float* gs) {
    if (tid < 256) { gs[tid] = log_sigmoidf_(G[(size_t)(row0 + tid) * 32 + 4 + h] + bif[4 + h]); gs[512 + tid] = G[(size_t)(row0 + tid) * 32 + h] + bif[h]; }
    __syncthreads();
    if (tid < 256) {
        float a = gs[tid]; const int ln = tid & 63;
#pragma unroll
        for (int o = 1; o < 64; o <<= 1) { const float t = __shfl_up(a, o); if (ln >= o) a += t; }
        if (ln == 63) gs[896 + (tid >> 6)] = a;
        gs[256 + tid] = a; }
    __syncthreads();
    if (tid >= 64 && tid < 256) { float a = gs[256 + tid]; const int w = tid >> 6;
        a += gs[896]; if (w >= 2) a += gs[897]; if (w >= 3) a += gs[898];
        gs[256 + tid] = a; }
    __syncthreads();
}
__device__ __forceinline__ void ml256_gates_load(const float* __restrict__ G, int row0, int h, int tid, float& gf, float& gi) {
    const size_t r = (size_t)(row0 + (tid & 255)) * 32; gf = G[r + 4 + h]; gi = G[r + h];
}
template <bool WITHE>
__device__ __forceinline__ void ml256_gates_finish(float gf, float gi, const float* __restrict__ bif, int h, int tid, LAS float* gs) {
    if (tid < 256) {
        const float ig = gi + bif[h]; float a = log_sigmoidf_(gf + bif[4 + h]); const int ln = tid & 63;
#pragma unroll
        for (int o = 1; o < 64; o <<= 1) { const float t = __shfl_up(a, o); if (ln >= o) a += t; }
        if (ln == 63) gs[896 + (tid >> 6)] = a;
        gs[256 + tid] = a; gs[512 + tid] = ig;
        if (WITHE) gs[tid] = __expf(fminf(ig - a + __builtin_bit_cast(float, __builtin_amdgcn_readfirstlane(__builtin_bit_cast(int, a))), 80.f)); }
    __syncthreads();
    if (tid >= 64 && tid < 256) { float a = gs[256 + tid]; const int w = tid >> 6;
        a += gs[896]; if (w >= 2) a += gs[897]; if (w >= 3) a += gs[898];
        gs[256 + tid] = a; }
    __syncthreads();
}
struct Ml2Raw { u32x4v k[2], v[2]; };
__device__ __forceinline__ void ml2_load(Ml2Raw& r, const bf16* __restrict__ P, const bf16* __restrict__ QK2, int row0, int h, int tid) {
    const int s = tid >> 3;
#pragma unroll
    for (int pass = 0; pass < 2; ++pass) { const int ch = (tid & 7) + 8 * pass;
        r.k[pass] = *(const u32x4v*)(QK2 + (size_t)(row0 + s) * 1024 + 512 + h * 128 + ch * 8);
        r.v[pass] = *(const u32x4v*)(P + (size_t)(row0 + s) * DINP + C_MV + h * 128 + ch * 8); }
}
__device__ __forceinline__ void ml256_m1_phase(const bf16* __restrict__ P, const bf16* __restrict__ QK2, const float* __restrict__ G, const float* __restrict__ bif,
                                               bf16* __restrict__ CT, float* __restrict__ nst, float* __restrict__ dec, int bid, int Gd, int tid, LAS unsigned char* lds) {
    asm volatile("" : "+v"(tid));
    const int lane = tid & 63, wid = __builtin_amdgcn_readfirstlane(tid >> 6), hi = lane >> 5;
    LAS float* gs = (LAS float*)(lds + M2_G_OFF);
    for (int u = bid; u < 512; u += Gd) {
        const int sc = u & 31, h = (u >> 5) & 3, b = u >> 7, row0 = b * SEQ + sc * 256;
        Ml2Raw raw; ml2_load(raw, P, QK2, row0, h, tid);
        ml256_gates(G, bif, row0, h, tid, gs);
        if (tid == 0) dec[u] = __expf(gs[256 + 255]);
        const int g = lane >> 4, i = lane & 15;
        const int mb = wid >> 1, nb0 = 2 * (wid & 1);
        f32x16 acc0, acc1;
#pragma unroll
        for (int r = 0; r < 16; ++r) { acc0[r] = zf_(); acc1[r] = acc0[r]; }
        float an = 0.f;
        for (int st = 0; st < 4; ++st) {
            LAS unsigned char* stg = lds + M2_STG_OFF + (st & 1) * (2 * M2_VIMG);
            { const int s = tid >> 3; const float ws = __expf(gs[256 + 255] - gs[256 + st * 64 + s] + gs[512 + st * 64 + s]);
#pragma unroll
              for (int pass = 0; pass < 2; ++pass) { const int ch = (tid & 7) + 8 * pass; u32x4v w;
#pragma unroll
                  for (int e = 0; e < 4; ++e) w[e] = cvtpk(__builtin_bit_cast(float, raw.k[pass][e] << 16) * ws, __builtin_bit_cast(float, raw.k[pass][e] & 0xffff0000u) * ws);
                  *(LAS u32x4v*)(stg + s * MV_PITCH + ch * 16) = w;
                  *(LAS u32x4v*)(stg + M2_VIMG + s * MV_PITCH + ch * 16) = raw.v[pass]; } }
            if (st + 1 < 4) ml2_load(raw, P, QK2, row0 + (st + 1) * 64, h, tid);
            __syncthreads();
            LAS const unsigned char* trb = stg + (4 * hi + (i >> 2)) * MV_PITCH + (16 * (g & 1) + 4 * (i & 3)) * 2;
#pragma unroll
            for (int ks = 0; ks < 4; ++ks) {
                const s16x4 alo = lds_tr(trb + ks * 16 * MV_PITCH + mb * 64), ahi = lds_tr(trb + ks * 16 * MV_PITCH + 8 * MV_PITCH + mb * 64);
                const bf16x8 af = {alo[0], alo[1], alo[2], alo[3], ahi[0], ahi[1], ahi[2], ahi[3]};
                const s16x4 b0lo = lds_tr(trb + M2_VIMG + ks * 16 * MV_PITCH + nb0 * 64), b0hi = lds_tr(trb + M2_VIMG + ks * 16 * MV_PITCH + 8 * MV_PITCH + nb0 * 64);
                const s16x4 b1lo = lds_tr(trb + M2_VIMG + ks * 16 * MV_PITCH + (nb0 + 1) * 64), b1hi = lds_tr(trb + M2_VIMG + ks * 16 * MV_PITCH + 8 * MV_PITCH + (nb0 + 1) * 64);
                const bf16x8 bf0 = {b0lo[0], b0lo[1], b0lo[2], b0lo[3], b0hi[0], b0hi[1], b0hi[2], b0hi[3]}, bf1 = {b1lo[0], b1lo[1], b1lo[2], b1lo[3], b1hi[0], b1hi[1], b1hi[2], b1hi[3]};
                acc0 = __builtin_amdgcn_mfma_f32_32x32x16_bf16(af, bf0, acc0, 0, 0, 0);
                acc1 = __builtin_amdgcn_mfma_f32_32x32x16_bf16(af, bf1, acc1, 0, 0, 0);
            }
            if (tid < 128) {
#pragma unroll
                for (int s0 = 0; s0 < 64; s0 += 8) { float kv[8];
#pragma unroll
                    for (int q = 0; q < 8; ++q) kv[q] = bf2f(*(LAS const bf16*)(stg + (s0 + q) * MV_PITCH + tid * 2));
#pragma unroll
                    for (int q = 0; q < 4; ++q) kv[q] += kv[q + 4];
                    an += (kv[0] + kv[2]) + (kv[1] + kv[3]);
                    __builtin_amdgcn_sched_barrier(0); } }
        }
        bf16* ct = CT + (size_t)u * 16384;
#pragma unroll
        for (int gq = 0; gq < 4; ++gq) { const int d0 = 32 * mb + 8 * gq + 4 * hi;
            uint2 w0, w1; w0.x = cvtpk(acc0[4 * gq], acc0[4 * gq + 1]); w0.y = cvtpk(acc0[4 * gq + 2], acc0[4 * gq + 3]); w1.x = cvtpk(acc1[4 * gq], acc1[4 * gq + 1]); w1.y = cvtpk(acc1[4 * gq + 2], acc1[4 * gq + 3]);
            *(uint2*)(ct + (size_t)(32 * nb0 + (lane & 31)) * 128 + d0) = w0; *(uint2*)(ct + (size_t)(32 * (nb0 + 1) + (lane & 31)) * 128 + d0) = w1; }
        if (tid < 128) nst[(size_t)u * 128 + tid] = an;
        __syncthreads();
    }
}
__device__ __forceinline__ void ml256_scan(bf16* __restrict__ CT, float* __restrict__ nst, const float* __restrict__ dec, int item, int tid) {
    asm volatile("" : "+v"(tid));
    const int bh = item / 9, part = item % 9;
    if (part < 8) {
        bf16* base = CT + (size_t)bh * 32 * 16384 + (part * 512 + tid) * 4;
        float C[4]; C[0] = zf_(); C[1] = C[0]; C[2] = C[0]; C[3] = C[0];
        for (int c0 = 0; c0 < 32; c0 += 16) {
            uint2 w[16];
#pragma unroll
            for (int k = 0; k < 16; ++k) w[k] = *(const uint2*)(base + (size_t)(c0 + k) * 16384);
#pragma unroll
            for (int k = 0; k < 16; ++k) { const float a = dec[bh * 32 + c0 + k];
                uint2 o; o.x = cvtpk(C[0], C[1]); o.y = cvtpk(C[2], C[3]); *(uint2*)(base + (size_t)(c0 + k) * 16384) = o;
                C[0] = fmaf(a, C[0], __builtin_bit_cast(float, w[k].x << 16)); C[1] = fmaf(a, C[1], __builtin_bit_cast(float, w[k].x & 0xffff0000u));
                C[2] = fmaf(a, C[2], __builtin_bit_cast(float, w[k].y << 16)); C[3] = fmaf(a, C[3], __builtin_bit_cast(float, w[k].y & 0xffff0000u)); }
        }
    } else if (tid < 128) {
        float* base = nst + (size_t)bh * 32 * 128 + tid; float C = 0.f;
        float dC[32], dk[32];
#pragma unroll
        for (int c = 0; c < 32; ++c) { dC[c] = base[(size_t)c * 128]; dk[c] = dec[bh * 32 + c]; }
        __builtin_amdgcn_sched_barrier(0);
#pragma unroll
        for (int c = 0; c < 32; ++c) { base[(size_t)c * 128] = C; C = dk[c] * C + dC[c]; }
    }
}
__device__ __forceinline__ void ml256_m3_phase(const bf16* __restrict__ P, const bf16* __restrict__ QK2, const float* __restrict__ G, const float* __restrict__ bif,
                                               const bf16* __restrict__ CT, const float* __restrict__ nst, const float* __restrict__ mnorm, bf16* __restrict__ MIX, int bid, int Gd, int tid, LAS unsigned char* lds) {
    asm volatile("" : "+v"(tid));
    const int lane = tid & 63, wid = __builtin_amdgcn_readfirstlane(tid >> 6), hi = lane >> 5, r32 = lane & 31;
    LAS float* gs = (LAS float*)(lds + M2_G_OFF);
    for (int u = bid; u < 512; u += Gd) {
        asm volatile("" : "+v"(tid));
        const int sc = u & 31, h = (u >> 5) & 3, b = u >> 7, row0 = b * SEQ + sc * 256;
        const int t = 32 * wid + r32; const size_t rowt = (size_t)row0 + t;
        auto stage_load = [&](int kt, u32x4v (&kk)[2], u32x4v (&vv)[2]) { const int s = tid >> 3;
#pragma unroll
            for (int pass = 0; pass < 2; ++pass) { const int ch = (tid & 7) + 8 * pass;
                kk[pass] = *(const u32x4v*)(QK2 + (size_t)(row0 + kt * 64 + s) * 1024 + 512 + h * 128 + ch * 8);
                vv[pass] = *(const u32x4v*)(P + (size_t)(row0 + kt * 64 + s) * DINP + C_MV + h * 128 + ch * 8); } };
        auto stage_store = [&](int kt, const u32x4v (&kk)[2], const u32x4v (&vv)[2]) { LAS unsigned char* stg = lds + M2_STG_OFF + (kt & 1) * M2_STG; const int s = tid >> 3;
#pragma unroll
            for (int pass = 0; pass < 2; ++pass) { const int ch = (tid & 7) + 8 * pass;
                *(LAS u32x4v*)(stg + s * MQ_PITCH + ch * 16) = kk[pass]; *(LAS u32x4v*)(stg + M2_KIMG + s * MV_PITCH + ch * 16) = vv[pass]; } };
        float gf, gi; ml256_gates_load(G, row0, h, tid, gf, gi);
        u32x4v kA[2], vA[2], kB[2], vB[2]; stage_load(0, kA, vA); stage_load(1, kB, vB);
        bf16x8 qf[8];
#pragma unroll
        for (int ks = 0; ks < 8; ++ks) qf[ks] = *(const bf16x8*)(QK2 + rowt * 1024 + h * 128 + ks * 16 + hi * 8);
        if (tid >= 256 && tid < 384) gs[768 + tid - 256] = nst[(size_t)u * 128 + tid - 256];
        if (tid >= 384) ((LAS float*)(lds + M2_STG_OFF + 2 * M2_STG))[tid - 384] = mnorm[h * 128 + tid - 384];
        ml256_gates_finish<true>(gf, gi, bif, h, tid, gs);
        stage_store(0, kA, vA); stage_store(1, kB, vB);
        stage_load(2, kA, vA); stage_load(3, kB, vB);
        __syncthreads();
        f32x16 N0, N1, N2, N3;
#pragma unroll
        for (int r = 0; r < 16; ++r) { N0[r] = zf_(); N1[r] = N0[r]; N2[r] = N0[r]; N3[r] = N0[r]; }
        const float bt = gs[256 + t], Ft = __expf(bt);
        float dsum = 0.f;
        const int ktmax = wid >> 1;
        for (int kt = 0; kt < 4; ++kt) {
            if (kt <= ktmax) {
                LAS const unsigned char* stg = lds + M2_STG_OFF + (kt & 1) * M2_STG;
                f32x16 p0, p1;
#pragma unroll
                for (int r = 0; r < 16; ++r) { p0[r] = zf_(); p1[r] = p0[r]; }
                LAS const unsigned char* ka = stg + r32 * MQ_PITCH + hi * 16;
#pragma unroll
                for (int ks = 0; ks < 8; ++ks) { const bf16x8 a0 = *(LAS const bf16x8*)(ka + ks * 32), a1 = *(LAS const bf16x8*)(ka + 32 * MQ_PITCH + ks * 32);
                    p0 = __builtin_amdgcn_mfma_f32_32x32x16_bf16(a0, qf[ks], p0, 0, 0, 0); p1 = __builtin_amdgcn_mfma_f32_32x32x16_bf16(a1, qf[ks], p1, 0, 0, 0); }
                __builtin_amdgcn_sched_barrier(0);
                const float Fk = __expf(bt - gs[256 + kt * 64]);
#pragma unroll
                for (int rb = 0; rb < 16; rb += 4) {
                    float e0v[4], e1v[4];
#pragma unroll
                    for (int q = 0; q < 4; ++q) { const int s0 = kt * 64 + crow(rb + q, hi); e0v[q] = gs[s0]; e1v[q] = gs[s0 + 32]; }
#pragma unroll
                    for (int q = 0; q < 4; ++q) { const int r = rb + q, s0 = kt * 64 + crow(r, hi), s1 = s0 + 32;
                        const float w0 = (s0 <= t) ? e0v[q] * Fk : 0.f, w1 = (s1 <= t) ? e1v[q] * Fk : 0.f;
                        p0[r] *= w0; dsum += p0[r]; p1[r] *= w1; dsum += p1[r]; } }
                __builtin_amdgcn_sched_barrier(0);
                bf16x8 pf[4];
#pragma unroll
                for (int s = 0; s < 4; ++s) { u32x4v w;
#pragma unroll
                    for (int e = 0; e < 4; ++e) { const int r = 8 * (s & 1) + 2 * e; w[e] = (s < 2) ? cvtpk(p0[r], p0[r + 1]) : cvtpk(p1[r], p1[r + 1]); }
                    pf[s] = __builtin_bit_cast(bf16x8, w); }
                const int g = lane >> 4, i = lane & 15;
                LAS const unsigned char* trb = stg + M2_KIMG + (4 * hi + (i >> 2)) * MV_PITCH + (16 * (g & 1) + 4 * (i & 3)) * 2;
#pragma unroll
                for (int s = 0; s < 4; ++s) {
#pragma unroll
                    for (int eb = 0; eb < 4; ++eb) {
                        const s16x4 lo = lds_tr(trb + s * 16 * MV_PITCH + eb * 64), hi4 = lds_tr(trb + s * 16 * MV_PITCH + 8 * MV_PITCH + eb * 64);
                        const bf16x8 vt = {lo[0], lo[1], lo[2], lo[3], hi4[0], hi4[1], hi4[2], hi4[3]};
                        if (eb == 0) N0 = __builtin_amdgcn_mfma_f32_32x32x16_bf16(vt, pf[s], N0, 0, 0, 0);
                        else if (eb == 1) N1 = __builtin_amdgcn_mfma_f32_32x32x16_bf16(vt, pf[s], N1, 0, 0, 0);
                        else if (eb == 2) N2 = __builtin_amdgcn_mfma_f32_32x32x16_bf16(vt, pf[s], N2, 0, 0, 0);
                        else N3 = __builtin_amdgcn_mfma_f32_32x32x16_bf16(vt, pf[s], N3, 0, 0, 0);
                    } }
            }
            if (kt < 3) __syncthreads();
            if (kt == 0) stage_store(2, kA, vA);
            if (kt == 1) stage_store(3, kB, vB);
        }
        u32x4v ctr[4];
        { const bf16* cg_ = CT + (size_t)u * 16384 + (size_t)(tid >> 2) * 128 + (tid & 3) * 32;
#pragma unroll
          for (int q = 0; q < 4; ++q) ctr[q] = *(const u32x4v*)(cg_ + q * 8); }
        float qn = 0.f;
#pragma unroll
        for (int ks = 0; ks < 8; ++ks)
#pragma unroll
            for (int j = 0; j < 8; ++j) qn = fmaf(bf2f((bf16)qf[ks][j]), gs[768 + ks * 16 + hi * 8 + j], qn);
        dsum += shx<32>(dsum); qn += shx<32>(qn);
        const float den = dsum + Ft * qn, inv = rcpf_(fmaxf(fabsf(den), 1.f));
        float ssq = 0.f;
        int t3 = tid; asm volatile("" : "+v"(t3));
        const int hi3 = (t3 >> 5) & 1; const size_t rowt3 = (size_t)row0 + 32 * (t3 >> 6) + (t3 & 31);
        uint2 owv[16];
#pragma unroll
        for (int q = 0; q < 16; ++q) owv[q] = *(const uint2*)(P + rowt3 * DINP + C_MO + h * 128 + 32 * (q >> 2) + 8 * (q & 3) + 4 * hi3);
        {   LAS unsigned char* cl = lds + M2_CT_OFF + (tid >> 2) * M2_CT_PITCH + (tid & 3) * 64;
#pragma unroll
            for (int q = 0; q < 4; ++q) *(LAS u32x4v*)(cl + q * 16) = ctr[q]; }
        __syncthreads();
#pragma unroll
        for (int eb = 0; eb < 4; ++eb) {
            LAS const unsigned char* ca = lds + M2_CT_OFF + (32 * eb + r32) * M2_CT_PITCH + hi * 16;
            f32x16 ni;
#pragma unroll
            for (int r = 0; r < 16; ++r) ni[r] = zf_();
#pragma unroll
            for (int ks = 0; ks < 8; ++ks) ni = __builtin_amdgcn_mfma_f32_32x32x16_bf16(*(LAS const bf16x8*)(ca + ks * 32), qf[ks], ni, 0, 0, 0);
            f32x16& Nx = eb == 0 ? N0 : eb == 1 ? N1 : eb == 2 ? N2 : N3;
#pragma unroll
            for (int r = 0; r < 16; ++r) { Nx[r] = (Nx[r] + Ft * ni[r]) * inv; ssq += Nx[r] * Nx[r]; }
        }
        ssq += shx<32>(ssq);
        const float rstd = rsqrtf(ssq * (1.f / 128.f) + EPS);
        f32x4v mnv[16];
#pragma unroll
        for (int q = 0; q < 16; ++q) mnv[q] = *(LAS const f32x4v*)(lds + M2_STG_OFF + 2 * M2_STG + (32 * (q >> 2) + 8 * (q & 3) + 4 * hi3) * 4);
#pragma unroll
        for (int eb = 0; eb < 4; ++eb) { const f32x16& Nx = eb == 0 ? N0 : eb == 1 ? N1 : eb == 2 ? N2 : N3;
#pragma unroll
            for (int gq = 0; gq < 4; ++gq) { const int cc = h * 128 + 32 * eb + 8 * gq + 4 * hi3;
                const uint2 ow = owv[eb * 4 + gq]; const f32x4v mnq = mnv[eb * 4 + gq]; float4 mn; mn.x = mnq[0]; mn.y = mnq[1]; mn.z = mnq[2]; mn.w = mnq[3];
                const float o0 = sigmoidf_(__builtin_bit_cast(float, ow.x << 16)), o1 = sigmoidf_(__builtin_bit_cast(float, ow.x & 0xffff0000u)), o2 = sigmoidf_(__builtin_bit_cast(float, ow.y << 16)), o3 = sigmoidf_(__builtin_bit_cast(float, ow.y & 0xffff0000u));
                uint2 w; w.x = cvtpk(Nx[4 * gq] * rstd * mn.x * o0, Nx[4 * gq + 1] * rstd * mn.y * o1); w.y = cvtpk(Nx[4 * gq + 2] * rstd * mn.z * o2, Nx[4 * gq + 3] * rstd * mn.w * o3);
                *(uint2*)(MIX + rowt3 * DM + cc) = w; } }
        __syncthreads();
    }
}

constexpr size_t MiB = 1u << 20;
constexpr size_t W_LAYER = (size_t)(DINP + DM + DFF) * DM + (size_t)DM * DFF;
constexpr size_t WS_W = 0;
constexpr size_t WS_HM = 52 * MiB;
constexpr size_t WS_G = 116 * MiB;
constexpr size_t WS_SMALL = 120 * MiB;
constexpr size_t WS_TAB = WS_SMALL, WS_KMEAN = WS_SMALL + 512 * 1024, WS_KVC = WS_SMALL + 1 * MiB, WS_NST = WS_SMALL + 2 * MiB, WS_DEC = WS_SMALL + 3 * MiB, WS_KVCB = WS_SMALL + 3 * MiB + 512 * 1024;
constexpr size_t WS_SSP = 476 * MiB;
constexpr size_t WS_BAR = WS_SMALL + 3 * MiB + 64 * 1024;
constexpr size_t WS_W1T = 50 * MiB, WS_C1 = WS_SMALL + 3 * MiB + 16 * 1024;
constexpr size_t WS_P = 124 * MiB;
constexpr size_t WS_C = 348 * MiB;
constexpr size_t WS_U = WS_P;
constexpr size_t WS_SELB = 478 * MiB, WS_CNTQ = WS_SELB + 512 * 1024, WS_LISTG = WS_CNTQ + 64 * 1024;
constexpr size_t WS_END = 484 * MiB;
static_assert(W_LAYER * 2 * DEPTH <= 50 * MiB && WS_W1T + (size_t)DEPTH * 2 * 128 * 2048 * 2 <= 52 * MiB, "weights");
static_assert((size_t)T * DINP * 2 == 224 * MiB && (size_t)T * DFF * 2 == 256 * MiB, "sizes");

#ifndef DUP_PRO
#define DUP_PRO 1
#endif
#ifndef DUP_QK2
#define DUP_QK2 1
#endif
#ifndef DUP_GEMM
#define DUP_GEMM 1
#endif
#ifndef DUP_M1
#define DUP_M1 1
#endif
#ifndef DUP_MOBA
#define DUP_MOBA 1
#endif
#ifndef DUP_NSA
#define DUP_NSA 1
#endif
#ifndef DUP_M3
#define DUP_M3 1
#endif
#ifndef DUP_MRG
#define DUP_MRG 1
#endif
#ifndef DUP_CMP
#define DUP_CMP 1
#endif
struct Params { const float* in[16]; float* out; unsigned char* ws; };
static_assert(sizeof(Params) == 18 * 8, "kernarg layout: in[k] at 8k, out at 128, ws at 136");
constexpr int LDS_BYTES = 147456;

__global__ void __launch_bounds__(512, 2) hybrid_fwd(Params prm) {
    extern __shared__ __attribute__((aligned(16))) unsigned char lds[];
    cg::grid_group grid = cg::this_grid();
    constexpr int NPH = 1 + DEPTH * 8;
    volatile LAS unsigned* xst = (volatile LAS unsigned*)((LAS unsigned char*)lds + 131072 + 1024);
    if (threadIdx.x < 2) xst[threadIdx.x] = 0u;
    __syncthreads();
    (void)xcd_barrier_post((unsigned*)(prm.ws + WS_BAR), xst);
    int wave_s = __builtin_amdgcn_readfirstlane((int)threadIdx.x >> 6); asm volatile("" : "+s"(wave_s));
    for (int ph = 0; ph < NPH; ++ph) {
        int tid = threadIdx.x; asm volatile("" : "+v"(tid));
        int G = gridDim.x, bid = blockIdx.x; asm volatile("" : "+s"(G), "+s"(bid));
#define PH_LOCALS const int half = tid >> 8, t256 = tid & 255, lane = tid & 63, wid = __builtin_amdgcn_readfirstlane(tid >> 6); unsigned char* smh = lds + half * 65536; \
        const int vb = bid * 2 + half, NVB = G * 2, gwv = bid * 8 + wid, NGW = G * 8; (void)lane; (void)smh; (void)vb; (void)NVB; (void)gwv; (void)NGW; (void)t256;
        const __attribute__((address_space(4))) unsigned char* ka = (const __attribute__((address_space(4))) unsigned char*)__builtin_amdgcn_kernarg_segment_ptr(); asm volatile("" : "+s"(ka));
#define KARG(T_, off) (*(T_ const __attribute__((address_space(4)))*)(ka + (off)))
#define IN(k) KARG(const float*, 8 * (k))
        unsigned char* ws = KARG(unsigned char*, 8 * 17); float* out = KARG(float*, 8 * 16);
        bf16* Wb = (bf16*)(ws + WS_W); bf16* HM = (bf16*)(ws + WS_HM); float* Gt = (float*)(ws + WS_G); float* tab = (float*)(ws + WS_TAB); float* kmean = (float*)(ws + WS_KMEAN);
        float* KVc = (float*)(ws + WS_KVC); float* nst = (float*)(ws + WS_NST); float* dec = (float*)(ws + WS_DEC); bf16* KVcb = (bf16*)(ws + WS_KVCB); bf16* W1t = (bf16*)(ws + WS_W1T); float* C1 = (float*)(ws + WS_C1); bf16* P = (bf16*)(ws + WS_P); bf16* CT = (bf16*)(ws + WS_C); unsigned* SELB = (unsigned*)(ws + WS_SELB); int* CNTQ = (int*)(ws + WS_CNTQ); unsigned char* LISTG = ws + WS_LISTG; bf16* QK2 = (bf16*)out  ; bf16* XB = (bf16*)(ws + WS_C + 64 * MiB)  ; unsigned long long* SSA = (unsigned long long*)(ws + WS_SSP); unsigned long long* SSB = SSA + T;     bf16* U = (bf16*)(ws + WS_U);
        const int l = ph == 0 ? 0 : (ph - 1) / 8, j = ph == 0 ? -1 : (ph - 1) % 8;
        const float* x = IN(0);
        const bf16* WinT = Wb + l * W_LAYER; const bf16* WoT = WinT + (size_t)DINP * DM; const bf16* W1T = WoT + (size_t)DM * DM; const bf16* W2T = W1T + (size_t)DFF * DM;
        if (ph == 0) {
            PH_LOCALS
            const float* w_in = IN(1); const float* w_out = IN(11); const float* w_ff1 = IN(14); const float* w_ff2 = IN(15);
            for (int rep = 0; rep < DUP_PRO; ++rep) {
            for (int ll = 0; ll < DEPTH; ++ll) {
                bf16* WinT_ = Wb + ll * W_LAYER; bf16* WoT_ = WinT_ + (size_t)DINP * DM; bf16* W1T_ = WoT_ + (size_t)DM * DM; bf16* W2T_ = W1T_ + (size_t)DFF * DM;
                for (int mt = 0; mt < 4; ++mt) {
                    const float* W; int K, N, NP, mode; bf16* WT;
                    const float* gk = nullptr;
                    if (mt == 0) { W = w_in + (size_t)ll * DM * DIN; K = DM; N = DIN; NP = DINP; WT = WinT_; mode = 1; gk = IN(12) + ll * DM; }
                    else if (mt == 1) { W = w_out + (size_t)ll * DM * DM; K = DM; N = DM; NP = DM; WT = WoT_; mode = 0; }
                    else if (mt == 2) { W = w_ff1 + (size_t)ll * DM * DFF; K = DM; N = DFF; NP = DFF; WT = W1T_; mode = 0; gk = IN(13) + ll * DM; }
                    else { W = w_ff2 + (size_t)ll * DFF * DM; K = DFF; N = DM; NP = DM; WT = W2T_; mode = 0; }
                    ph_convert_mat(W, K, N, NP, WT, mode, vb, NVB, t256, (float*)smh, gk);
                }
            }
            for (int lk = 0; lk < DEPTH * 2; ++lk) {
                ph_convert_mat(IN(9) + (size_t)lk * 2048 * 128, 2048, 128, 128, W1t + (size_t)lk * 128 * 2048, 0, vb, NVB, t256, (float*)smh);
            }
            for (int it = bid; it < 256; it += G) cmp_c1_item(IN(8), IN(9), C1, it, tid, (LAS unsigned char*)lds);
            for (int i = bid * 512 + tid; i < SEQ * 8; i += G * 512) { const int pos = i >> 3, f = i & 7;
                float c_, s_; rope_cs(pos, f, c_, s_);
                tab[pos * 16 + f] = c_; tab[pos * 16 + 8 + f] = s_; }
            for (int row = gwv; row < T; row += 2 * NGW) { ph_x_row(x, XB, SSA, row, lane); if (row + NGW < T) ph_x_row(x, XB, SSA, row + NGW, lane); }
            }
        } else if (j == 0 || j >= 5) {
            pg8::Gemm g; pg8::EpiAny E; int N; const bool last = (l + 1 == DEPTH);
            PG8_LAS unsigned long long* RS_LDS = (PG8_LAS unsigned long long*)((PG8_LAS unsigned char*)lds + 131072 + 2048);
            if (j == 0) { g = pg8::Gemm{XB, WinT, T, DINP, DM}; N = DINP; E = pg8::EpiAny{0, true, P, DINP, Gt, C_GATE, nullptr, nullptr, nullptr, SSA, RS_LDS}; }
            else if (j == 5) { g = pg8::Gemm{HM, WoT, T, DM, DM}; N = DM; E = pg8::EpiAny{2, true, nullptr, DM, nullptr, 0, nullptr, nullptr, XB, SSB, RS_LDS}; }
            else if (j == 6) { g = pg8::Gemm{XB, W1T, T, DFF, DM}; N = DFF; E = pg8::EpiAny{1, true, U, DFF, nullptr, 0, nullptr, nullptr, nullptr, SSB, RS_LDS}; }
            else { g = pg8::Gemm{U, W2T, T, DM, DFF}; N = DM; E = pg8::EpiAny{2, true, nullptr, DM, nullptr, 0, nullptr, last ? out : nullptr, XB, SSA, RS_LDS}; }
            pg8::StaticOrder S; S.init(T, N, G, bid);
#ifdef STAGGER_T
            if (STAGGER_PH) { const unsigned long long dl = (unsigned long long)((bid >> 3) & (STAGGER_G - 1)) * STAGGER_T; const unsigned long long t0 = __builtin_amdgcn_s_memrealtime(); while (__builtin_amdgcn_s_memrealtime() - t0 < dl) __builtin_amdgcn_s_sleep(4); }
#endif
            for (int rep = 0; rep < ((j == 0 || j == 6) ? DUP_GEMM : 1); ++rep) pg8::gemm_phase<pg8::EpiAny, pg8::StaticOrder, true, true>((PG8_LAS unsigned char*)lds, g, S, E, tid);
        } else if (j == 1) {
            PH_LOCALS
            for (int rep = 0; rep < DUP_CMP; ++rep) for (int it = bid; it < 256; it += G) compress_item(P, W1t + (size_t)l * 2 * 128 * 2048, C1 + l * 256, IN(10) + (size_t)l * 2 * 128 * 64, IN(7) + l * 192, KVcb, it, tid, (LAS unsigned char*)lds);
            for (int it0 = 0; it0 < 128 * 14; it0 += NVB) { const int it = it0 + vb; ph_prep(P, tab, IN(5) + l * 128, IN(6) + l * 64, IN(7) + l * 192, kmean, it, it < 128 * 14, t256, (float*)smh); }
            for (int rep = 0; rep < DUP_QK2; ++rep) qk2_rows(P, IN(3) + (size_t)l * 4 * 1024, QK2, bid, G, tid);
            { unsigned long long z64 = 0ull; asm volatile("" : "+v"(z64)); for (int i = bid * 512 + tid; i < 2 * T; i += G * 512) SSA[i] = z64; }
        } else if (j == 2) {
            for (int rep = 0; rep < DUP_M1; ++rep) ml256_m1_phase(P, QK2, Gt, IN(2) + l * 8, CT, nst, dec, bid, G, tid, (LAS unsigned char*)lds);
            for (int u = bid; u < 512; u += G) moba_gate_item(P, kmean, SELB, CNTQ, LISTG, u >> 7, (u >> 5) & 3, u & 31, tid, (LAS unsigned char*)lds);
        } else if (j == 3) {
            for (int it = bid; it < 16 * 9; it += G) ml256_scan(CT, nst, dec, it, tid);
            for (int rep = 0; rep < DUP_NSA; ++rep) for (int pu = bid; pu < 256; pu += G) { const int b_ = pu >> 6, s = pu & 63;
                nsa_unit(P, Gt, tab, KVcb, IN(7) + l * 192, HM, b_, 127 - s, tid, (LAS unsigned char*)lds, wave_s); nsa_unit(P, Gt, tab, KVcb, IN(7) + l * 192, HM, b_, s, tid, (LAS unsigned char*)lds, wave_s); }
            __syncthreads();
            moba_kv_phase(P, SELB, CNTQ, LISTG, IN(5) + l * 128 + 64, (unsigned*)(ws + WS_BAR) + XB_QUEUE(l), tid, (LAS unsigned char*)lds);
        } else {
            { const float kmx = gain_kmax(IN(5) + l * 128 + 64, tid & 63);
              for (int rep = 0; rep < DUP_MRG; ++rep) for (int pu = bid; pu < 256; pu += G) { const int bh = pu >> 4, s = pu & 15;
                  moba_merge_unit(P, SELB, kmx, HM, bh >> 2, bh & 3, 31 - s, tid, (LAS unsigned char*)lds, wave_s); moba_merge_unit(P, SELB, kmx, HM, bh >> 2, bh & 3, s, tid, (LAS unsigned char*)lds, wave_s); } }
            for (int rep = 0; rep < DUP_M3; ++rep) ml256_m3_phase(P, QK2, Gt, IN(2) + l * 8, CT, nst, IN(4) + l * 512, HM, bid, G, tid, (LAS unsigned char*)lds);
        }
        if (ph + 1 < NPH) { if (ph == 0) grid.sync(); else { XcdBarrier xbar; xbar.bar = (unsigned*)(ws + WS_BAR); xbar.x = xb_xcc_id(); xbar.st = xst; xcd_barrier(xbar); } }
    }
#undef IN
#undef KARG
#undef PH_LOCALS
}

extern "C" void kernel_launch(void* const* d_in, const int* in_sizes, int n_in, void* d_out, int out_size, void* d_ws, size_t ws_size, hipStream_t stream) {
    static int grid = 0;
    if (grid == 0) {
        if (n_in != 16 || in_sizes[0] != T * DM || out_size != T * DM || ws_size < WS_END) { fprintf(stderr, "kernel_launch: unexpected shapes / workspace %zu < %zu\n", ws_size, (size_t)WS_END); grid = -1; return; }
        int dev = 0, cus = 0, per_cu = 0;
        if (hipGetDevice(&dev) != hipSuccess || hipDeviceGetAttribute(&cus, hipDeviceAttributeMultiprocessorCount, dev) != hipSuccess) { grid = -1; return; }
        if (hipFuncSetAttribute((const void*)hybrid_fwd, hipFuncAttributeMaxDynamicSharedMemorySize, LDS_BYTES) != hipSuccess) { fprintf(stderr, "kernel_launch: hipFuncSetAttribute failed\n"); grid = -1; return; }
        if (hipOccupancyMaxActiveBlocksPerMultiprocessor(&per_cu, (const void*)hybrid_fwd, 512, LDS_BYTES) != hipSuccess || per_cu < 1) { fprintf(stderr, "kernel_launch: occupancy query failed (%d)\n", per_cu); grid = -1; return; }
        grid = cus * per_cu;
        fprintf(stderr, "kernel_launch: grid %d (%d CUs x %d)\n", grid, cus, per_cu);
    }
    if (grid < 0) return;
    if (hipMemsetAsync((char*)d_ws + WS_BAR, 0, XCD_BAR_WORDS * 4, stream) != hipSuccess) { fprintf(stderr, "kernel_launch: memset failed\n"); return; }
    Params p{};
    for (int i = 0; i < 16; ++i) p.in[i] = (const float*)d_in[i];
    p.out = (float*)d_out; p.ws = (unsigned char*)d_ws;
    void* args[] = {&p};
    hipError_t e = hipLaunchCooperativeKernel((const void*)hybrid_fwd, dim3(grid), dim3(512), args, LDS_BYTES, stream);
    if (e != hipSuccess) fprintf(stderr, "kernel_launch: cooperative launch failed: %s (grid %d)\n", hipGetErrorString(e), grid);
}
```

```cpp
#include <hip/hip_runtime.h>
#include <hip/hip_cooperative_groups.h>
#include <cstdio>
#include <cstdint>
namespace cg = cooperative_groups;
namespace pg8 {
#define PG8_LAS __attribute__((address_space(3)))
typedef unsigned short bf16_t;
typedef short bf16x8 __attribute__((ext_vector_type(8)));
typedef float f32x4 __attribute__((ext_vector_type(4)));
typedef unsigned u32x4 __attribute__((ext_vector_type(4)));
constexpr int BM = 256, BK = 64, HALF = 128, HTB = HALF * BK * 2  , STAGE_BYTES = 8 * HTB, NXCD = 8, WGM = 4;

__host__ __device__ __forceinline__ int lds_byte(int r, int c) { const int st = (r >> 4) * 2 + (c >> 5), rr = r & 15, cc = c & 31, ob = rr * 64 + cc * 2; return st * 1024 + (ob ^ (((ob >> 9) & 1) << 5)); }
__host__ __device__ __forceinline__ void stage_rc(int b, int& R, int& C) { const int st = b / 1024, sb = b % 1024, swz = sb ^ (((sb >> 9) & 1) << 5); R = (st >> 1) * 16 + swz / 64; C = (st & 1) * 32 + (swz % 64) / 2; }
__host__ __device__ __forceinline__ int perm32(int rho) { const int n = rho >> 4, i = rho & 15; return 8 * (i >> 2) + 4 * n + (i & 3); }

struct Unit { int pm, pn; };
struct Gemm { const bf16_t* A; const bf16_t* Bt; int M, N, K; };

struct StaticOrder {
    int nM, nN, nwg, G, c;
    __host__ __device__ void init(int M, int N, int G_, int c_) { nM = M / BM; nN = N / BM; nwg = nM * nN; G = G_; c = c_; }
    __host__ __device__ bool next(int i, Unit& u) const {
        const long L = (long)i * G + c; if (L >= nwg) return false;
        int wgid = (int)L; { const int q = nwg / NXCD, r = nwg % NXCD, xcd = wgid % NXCD, off = wgid / NXCD; wgid = (xcd < r ? xcd * (q + 1) : r * (q + 1) + (xcd - r) * q) + off; }
        const int nig = WGM * nN, gid = wgid / nig, fm = gid * WGM, gsz = (nM - fm) < WGM ? (nM - fm) : WGM;
        u.pm = fm + ((wgid % nig) % gsz); u.pn = (wgid % nig) / gsz; return true;
    }
    __device__ __forceinline__ void a_ready(const Unit&) const {}
    __device__ __forceinline__ void done(const Unit&) const {}
};

__device__ __forceinline__ unsigned f2bf_u(float f) { unsigned u = __builtin_bit_cast(unsigned, f); return (u + 0x7fffu + ((u >> 16) & 1u)) >> 16; }
__device__ __forceinline__ unsigned pk2bf(float lo, float hi) { return f2bf_u(lo) | (f2bf_u(hi) << 16); }

__device__ __forceinline__ unsigned cvtpk_bf16(float lo, float hi) { typedef float f2_ __attribute__((ext_vector_type(2))); typedef __bf16 b2_ __attribute__((ext_vector_type(2)));
    f2_ v = {lo, hi}; b2_ b = __builtin_convertvector(v, b2_); return __builtin_bit_cast(unsigned, b); }
__device__ __forceinline__ float swz_xor16(float v) { return __uint_as_float((unsigned)__builtin_amdgcn_ds_swizzle((int)__float_as_uint(v), 0x1F | (16 << 10))); }
__device__ __forceinline__ float half_sum(float v) { auto rr = __builtin_amdgcn_permlane32_swap(__float_as_uint(v), __float_as_uint(v), false, false); return __uint_as_float(rr[0]) + __uint_as_float(rr[1]); }
__device__ __forceinline__ float row_rstd(const unsigned long long* ssq, int row) { return __builtin_amdgcn_rsqf((float)ssq[row] * (1.0f / (1048576.0f * 1024.0f)) + 1e-6f); }

struct EpiProj {
    static constexpr bool PERM = true, AFTER_DRAIN = false;
    bf16_t* O; int ldc; float* gates; int gate0; const PG8_LAS unsigned long long* rs_raw;
    __device__ __forceinline__ void operator()(const f32x4 (&acc)[2][2][4][2], const Unit& u, int wr, int wc, int fr, int fq) const {
        const bool gtile = (u.pn * BM < gate0 + 32) && (u.pn * BM + BM > gate0);
        const int row0 = u.pm * BM + wr * 64 + fr; const int col0 = u.pn * BM + wc * 32 + 8 * fq;
        float rsv[2][4];
#pragma unroll
        for (int ai = 0; ai < 2; ++ai)
#pragma unroll
            for (int m = 0; m < 4; ++m) rsv[ai][m] = __builtin_amdgcn_rsqf((float)rs_raw[ai * HALF + wr * 64 + m * 16 + fr] * (1.0f / (1048576.0f * 1024.0f)) + 1e-6f);
#pragma unroll
        for (int ai = 0; ai < 2; ++ai)
#pragma unroll
            for (int m = 0; m < 4; ++m) { const int row = row0 + ai * HALF + m * 16; bf16_t* rowp = O + (size_t)row * ldc + col0; const float rs = rsv[ai][m];
#pragma unroll
                for (int bj = 0; bj < 2; ++bj) { const f32x4 v0 = acc[ai][bj][m][0] * rs, v1 = acc[ai][bj][m][1] * rs;
                    u32x4 w; w.x = cvtpk_bf16(v0[0], v0[1]); w.y = cvtpk_bf16(v0[2], v0[3]); w.z = cvtpk_bf16(v1[0], v1[1]); w.w = cvtpk_bf16(v1[2], v1[3]);
                    *(u32x4*)(rowp + bj * HALF) = w;
                    const int c = col0 + bj * HALF - gate0;
                    if (gtile && c >= 0 && c < 32) { float* g = gates + (size_t)row * 32 + c; *(f32x4*)g = v0; *(f32x4*)(g + 4) = v1; } } }
    }
};
struct EpiRelu2 {
    static constexpr bool PERM = true, AFTER_DRAIN = false;
    bf16_t* O; int ldc; const PG8_LAS unsigned long long* rs_raw;
    __device__ __forceinline__ void operator()(const f32x4 (&acc)[2][2][4][2], const Unit& u, int wr, int wc, int fr, int fq) const {
        const int row0 = u.pm * BM + wr * 64 + fr; const int col0 = u.pn * BM + wc * 32 + 8 * fq;
        float rsv[2][4];
#pragma unroll
        for (int ai = 0; ai < 2; ++ai)
#pragma unroll
            for (int m = 0; m < 4; ++m) rsv[ai][m] = __builtin_amdgcn_rsqf((float)rs_raw[ai * HALF + wr * 64 + m * 16 + fr] * (1.0f / (1048576.0f * 1024.0f)) + 1e-6f);
#pragma unroll
        for (int ai = 0; ai < 2; ++ai)
#pragma unroll
            for (int m = 0; m < 4; ++m) { const int row = row0 + ai * HALF + m * 16; bf16_t* rowp = O + (size_t)row * ldc + col0; const float rs = rsv[ai][m];
#pragma unroll
                for (int bj = 0; bj < 2; ++bj) { f32x4 v0 = acc[ai][bj][m][0] * rs, v1 = acc[ai][bj][m][1] * rs;
#pragma unroll
                    for (int e = 0; e < 4; ++e) { float a = v0[e] > 0.f ? v0[e] : 0.f; v0[e] = a * a; float b = v1[e] > 0.f ? v1[e] : 0.f; v1[e] = b * b; }
                    u32x4 w; w.x = cvtpk_bf16(v0[0], v0[1]); w.y = cvtpk_bf16(v0[2], v0[3]); w.z = cvtpk_bf16(v1[0], v1[1]); w.w = cvtpk_bf16(v1[2], v1[3]);
                    *(u32x4*)(rowp + bj * HALF) = w; } }
    }
};
struct EpiResid {
    static constexpr bool PERM = true, AFTER_DRAIN = false;
    float* out; int ldc; bf16_t* xb; unsigned long long* ssp;
    __device__ __forceinline__ void operator()(const f32x4 (&acc)[2][2][4][2], const Unit& u, int wr, int wc, int fr, int fq) const {
        const int row0 = u.pm * BM + wr * 64 + fr; const int col0 = u.pn * BM + wc * 32 + 8 * fq;
#pragma unroll
        for (int ai = 0; ai < 2; ++ai) {
        u32x4 bv[1][4][2];
#pragma unroll
            for (int m = 0; m < 4; ++m)
#pragma unroll
                for (int bj = 0; bj < 2; ++bj) bv[0][m][bj] = *(const u32x4*)(xb + (size_t)(row0 + ai * HALF + m * 16) * ldc + col0 + bj * HALF);
        __builtin_amdgcn_sched_barrier(0);
#pragma unroll
            for (int m = 0; m < 4; ++m) { const int row = row0 + ai * HALF + m * 16; const size_t off = (size_t)row * ldc + col0; float ss = 0.f;
#pragma unroll
                for (int bj = 0; bj < 2; ++bj) { const size_t o = off + bj * HALF; const u32x4 b = bv[0][m][bj];
                    f32x4 v0, v1;
                    v0[0] = __uint_as_float(b.x << 16) + acc[ai][bj][m][0][0]; v0[1] = __uint_as_float(b.x & 0xffff0000u) + acc[ai][bj][m][0][1];
                    v0[2] = __uint_as_float(b.y << 16) + acc[ai][bj][m][0][2]; v0[3] = __uint_as_float(b.y & 0xffff0000u) + acc[ai][bj][m][0][3];
                    v1[0] = __uint_as_float(b.z << 16) + acc[ai][bj][m][1][0]; v1[1] = __uint_as_float(b.z & 0xffff0000u) + acc[ai][bj][m][1][1];
                    v1[2] = __uint_as_float(b.w << 16) + acc[ai][bj][m][1][2]; v1[3] = __uint_as_float(b.w & 0xffff0000u) + acc[ai][bj][m][1][3];
                    if (out) { *(f32x4*)(out + o) = v0; *(f32x4*)(out + o + 4) = v1; }
                    else { ss += ((v0[0] * v0[0] + v0[1] * v0[1]) + (v0[2] * v0[2] + v0[3] * v0[3])) + ((v1[0] * v1[0] + v1[1] * v1[1]) + (v1[2] * v1[2] + v1[3] * v1[3]));
                        u32x4 w; w.x = cvtpk_bf16(v0[0], v0[1]); w.y = cvtpk_bf16(v0[2], v0[3]); w.z = cvtpk_bf16(v1[0], v1[1]); w.w = cvtpk_bf16(v1[2], v1[3]); *(u32x4*)(xb + o) = w; } }
                if (!out) { ss += swz_xor16(ss); ss = half_sum(ss); if (fq == 0) atomicAdd(ssp + row, (unsigned long long)(ss * 1048576.0f + 0.5f)); } }
        __builtin_amdgcn_sched_barrier(0);
        }
    }
};

struct EpiAny {
    static constexpr bool AFTER_DRAIN = false;
    int kind; bool perm;
    bf16_t* O; int ldc; float* gates; int gate0; const float* base; float* out; bf16_t* xb; unsigned long long* ssp;
    PG8_LAS unsigned long long* rs_raw;
    unsigned* war = nullptr; unsigned war_target = 0u;
    __device__ __forceinline__ void operator()(const f32x4 (&acc)[2][2][4][2], const Unit& u, int wr, int wc, int fr, int fq) const {
        if (kind == 0) { EpiProj e{O, ldc, gates, gate0, rs_raw}; e(acc, u, wr, wc, fr, fq); }
        else if (kind == 1) { EpiRelu2 e{O, ldc, rs_raw}; e(acc, u, wr, wc, fr, fq); }
        else { EpiResid e{out, ldc, xb, ssp}; e(acc, u, wr, wc, fr, fq); }
    }
};
template <class Epi, class Sched, bool ALIGN_EPI = false, bool SP2 = false>
__device__ __forceinline__ void gemm_phase(PG8_LAS unsigned char* lds, const Gemm g, const Sched& S, const Epi& E, const int tid) {
    const int wid = __builtin_amdgcn_readfirstlane(tid >> 6), lane = tid & 63, wr = wid >> 2, wc = wid & 3, fr = lane & 15, fq = lane >> 4;
    const int K = g.K, nt = K / BK;
    unsigned voffA[2], voffB[2];
#pragma unroll
    for (int i = 0; i < 2; ++i) { int R, C; stage_rc(tid * 16 + i * 8192, R, C); const int Rb = E.perm ? ((R & ~31) + perm32(R & 31)) : R;
        voffA[i] = (unsigned)(R * K + C) * 2u; voffB[i] = (unsigned)(Rb * K + C) * 2u; }
    const size_t kstep = (size_t)(BK * 2);
    const size_t hstep = (size_t)HALF * K * 2;
    const size_t tstep = 2 * hstep;
    const unsigned ldsw = (unsigned)wid * 1024u;
    const int aoff = lds_byte(wr * 64 + fr, fq * 8), boff = lds_byte(wc * 32 + fr, fq * 8);
#define PG8_SA(b, h) (((b) * 2 + (h)) * HTB)
#define PG8_SB(b, h) ((4 + (b) * 2 + (h)) * HTB)
#define PG8_STAGE(bufoff, gbase, voff) do { _Pragma("unroll") for (int _i = 0; _i < 2; ++_i) \
        __builtin_amdgcn_global_load_lds((const unsigned*)((const char*)(gbase) + (voff)[_i]), (PG8_LAS unsigned*)(lds + (bufoff) + ldsw + _i * 8192), 16, 0, 0); } while (0)
#define PG8_LDA(dst, b, h) do { _Pragma("unroll") for (int m = 0; m < 4; ++m) _Pragma("unroll") for (int k = 0; k < 2; ++k) dst[m][k] = *(const PG8_LAS bf16x8*)(lds + PG8_SA(b, h) + aoff + m * 2048 + k * 1024); } while (0)
#define PG8_LDB(dst, b, h) do { _Pragma("unroll") for (int n = 0; n < 2; ++n) _Pragma("unroll") for (int k = 0; k < 2; ++k) dst[n][k] = *(const PG8_LAS bf16x8*)(lds + PG8_SB(b, h) + boff + n * 2048 + k * 1024); } while (0)
#define PG8_MMA(ai, bj, At, Bt) do { __builtin_amdgcn_s_setprio(1); _Pragma("unroll") for (int m = 0; m < 4; ++m) _Pragma("unroll") for (int n = 0; n < 2; ++n) _Pragma("unroll") for (int k = 0; k < 2; ++k) \
        acc[ai][bj][m][n] = __builtin_amdgcn_mfma_f32_16x16x32_bf16(Bt[n][k], At[m][k], acc[ai][bj][m][n], 0, 0, 0); __builtin_amdgcn_s_setprio(0); } while (0)
#define PG8_WAIT_V(n) asm volatile("s_waitcnt vmcnt(" #n ")" ::: "memory")
#define PG8_WAIT_L(n) asm volatile("s_waitcnt lgkmcnt(" #n ")" ::: "memory")
#define PG8_BAR __builtin_amdgcn_s_barrier()
#define PG8_SCHED __builtin_amdgcn_sched_barrier(0)
    Unit cur, nxt; int ui = 0;
    if (!S.next(0, cur)) return;
    f32x4 acc[2][2][4][2];
#pragma unroll
    for (int a = 0; a < 2; ++a)
#pragma unroll
        for (int b = 0; b < 2; ++b)
#pragma unroll
            for (int m = 0; m < 4; ++m)
#pragma unroll
                for (int n = 0; n < 2; ++n) acc[a][b][m][n] = (f32x4){0.f, 0.f, 0.f, 0.f};
    bf16x8 At[4][2], B0[2][2], B1[2][2];
    const char* cA = (const char*)g.A + (size_t)cur.pm * tstep; const char* cB = (const char*)g.Bt + (size_t)cur.pn * tstep;
    S.a_ready(cur);
    if constexpr (SP2) {
        PG8_STAGE(PG8_SB(0, 0), cB, voffB); PG8_STAGE(PG8_SB(0, 1), cB + hstep, voffB); PG8_STAGE(PG8_SA(0, 0), cA, voffA); PG8_STAGE(PG8_SA(0, 1), cA + hstep, voffA);
        if (wr == 1) PG8_BAR;
        PG8_WAIT_V(2); PG8_BAR;
        PG8_STAGE(PG8_SB(1, 0), cB + kstep, voffB); PG8_STAGE(PG8_SA(1, 0), cA + kstep, voffA); PG8_STAGE(PG8_SB(1, 1), cB + hstep + kstep, voffB);
        PG8_WAIT_V(6); PG8_BAR;
    } else {
        PG8_STAGE(PG8_SB(0, 0), cB, voffB); PG8_STAGE(PG8_SA(0, 0), cA, voffA); PG8_STAGE(PG8_SB(0, 1), cB + hstep, voffB); PG8_STAGE(PG8_SA(0, 1), cA + hstep, voffA);
        if (wr == 1) PG8_BAR;
        PG8_WAIT_V(4); PG8_BAR;
        PG8_STAGE(PG8_SB(1, 0), cB + kstep, voffB); PG8_STAGE(PG8_SA(1, 0), cA + kstep, voffA); PG8_STAGE(PG8_SB(1, 1), cB + hstep + kstep, voffB);
        PG8_WAIT_V(6); PG8_BAR;
    }
    for (;;) {
        const bool has_next = S.next(ui + 1, nxt);
        const char* nA = has_next ? (const char*)g.A + (size_t)nxt.pm * tstep : cA; const char* nB = has_next ? (const char*)g.Bt + (size_t)nxt.pn * tstep : cB;
        for (int t = 0; t < nt; t += 2) {
            const bool last = (t == nt - 2);
            const char* a1 = cA + (size_t)(t + 1) * kstep;
            const char* a2 = last ? nA : cA + (size_t)(t + 2) * kstep; const char* b2 = last ? nB : cB + (size_t)(t + 2) * kstep;
            const char* a3 = a2 + kstep; const char* b3 = b2 + kstep;
            if (last && has_next) S.a_ready(nxt);
            if (last) __builtin_amdgcn_global_load_lds((const unsigned*)(E.ssp + (size_t)cur.pm * BM + 32 * wid) + lane, (PG8_LAS unsigned*)E.rs_raw + wid * 64, 4, 0, 0);
            if constexpr (SP2) {
            PG8_LDB(B0, 0, 0); PG8_LDB(B1, 0, 1); PG8_SCHED; PG8_LDA(At, 0, 0); PG8_STAGE(PG8_SA(1, 1), a1 + hstep, voffA);
            PG8_WAIT_V(8); PG8_WAIT_L(0); PG8_BAR; PG8_MMA(0, 0, At, B0); PG8_MMA(0, 1, At, B1); PG8_BAR; PG8_SCHED;
            PG8_LDA(At, 0, 1); PG8_STAGE(PG8_SB(0, 0), b2, voffB); PG8_STAGE(PG8_SB(0, 1), b2 + hstep, voffB); PG8_STAGE(PG8_SA(0, 0), a2, voffA);
            PG8_WAIT_V(8); PG8_WAIT_L(0); PG8_BAR; PG8_MMA(1, 0, At, B0); PG8_MMA(1, 1, At, B1); PG8_BAR; PG8_SCHED;
            PG8_LDB(B0, 1, 0); PG8_LDB(B1, 1, 1); PG8_SCHED; PG8_LDA(At, 1, 0); PG8_STAGE(PG8_SA(0, 1), a2 + hstep, voffA);
            PG8_WAIT_V(8); PG8_WAIT_L(0); PG8_BAR; PG8_MMA(0, 0, At, B0); PG8_MMA(0, 1, At, B1); PG8_BAR; PG8_SCHED;
            PG8_LDA(At, 1, 1); PG8_STAGE(PG8_SB(1, 0), b3, voffB); PG8_STAGE(PG8_SB(1, 1), b3 + hstep, voffB); PG8_STAGE(PG8_SA(1, 0), a3, voffA);
            PG8_WAIT_V(8); PG8_WAIT_L(0); PG8_BAR; PG8_MMA(1, 0, At, B0); PG8_MMA(1, 1, At, B1); PG8_BAR; PG8_SCHED;
            } else {
            PG8_LDB(B0, 0, 0); PG8_SCHED; PG8_LDA(At, 0, 0); PG8_STAGE(PG8_SA(1, 1), a1 + hstep, voffA);
            PG8_WAIT_L(8); PG8_BAR; PG8_WAIT_L(0); PG8_MMA(0, 0, At, B0); PG8_BAR; PG8_SCHED;
            PG8_LDB(B1, 0, 1); PG8_STAGE(PG8_SB(0, 0), b2, voffB);
            PG8_BAR; PG8_WAIT_L(0); PG8_MMA(0, 1, At, B1); PG8_BAR;
            PG8_LDA(At, 0, 1); PG8_STAGE(PG8_SA(0, 0), a2, voffA);
            PG8_BAR; PG8_WAIT_L(0); PG8_MMA(1, 0, At, B0); PG8_BAR; PG8_SCHED;
            PG8_STAGE(PG8_SB(0, 1), b2 + hstep, voffB);
            PG8_WAIT_V(6); PG8_BAR; PG8_MMA(1, 1, At, B1); PG8_BAR;
            PG8_LDB(B0, 1, 0); PG8_SCHED; PG8_LDA(At, 1, 0); PG8_STAGE(PG8_SA(0, 1), a2 + hstep, voffA);
            PG8_WAIT_L(8); PG8_BAR; PG8_WAIT_L(0); PG8_MMA(0, 0, At, B0); PG8_BAR; PG8_SCHED;
            PG8_LDB(B1, 1, 1); PG8_STAGE(PG8_SB(1, 0), b3, voffB);
            PG8_BAR; PG8_WAIT_L(0); PG8_MMA(0, 1, At, B1); PG8_BAR;
            PG8_LDA(At, 1, 1); PG8_STAGE(PG8_SA(1, 0), a3, voffA);
            PG8_BAR; PG8_WAIT_L(0); PG8_MMA(1, 0, At, B0); PG8_BAR; PG8_SCHED;
            PG8_STAGE(PG8_SB(1, 1), b3 + hstep, voffB);
            PG8_WAIT_V(6); PG8_BAR; PG8_MMA(1, 1, At, B1); PG8_BAR;
            }
        }
        if constexpr (ALIGN_EPI) { if (wr == 0) PG8_BAR; }
        if constexpr (!Epi::AFTER_DRAIN) {
            if (ui == 0 && E.war != nullptr) {
                if (wid == 0 && lane == 0) { unsigned sp = 0u; while (__hip_atomic_load(E.war, __ATOMIC_RELAXED, __HIP_MEMORY_SCOPE_AGENT) < E.war_target && ++sp < (1u << 22)) __builtin_amdgcn_s_sleep(1); }
                PG8_BAR; }
            E(acc, cur, wr, wc, fr, fq); S.done(cur); }
        if (!has_next) break;
#pragma unroll
        for (int a = 0; a < 2; ++a)
#pragma unroll
            for (int b = 0; b < 2; ++b)
#pragma unroll
                for (int m = 0; m < 4; ++m)
#pragma unroll
                    for (int n = 0; n < 2; ++n) acc[a][b][m][n] = (f32x4){0.f, 0.f, 0.f, 0.f};
        cur = nxt; cA = nA; cB = nB; ++ui;
        if constexpr (ALIGN_EPI) { if (wr == 1) PG8_BAR; }
    }
    PG8_WAIT_V(0);
    if constexpr (!ALIGN_EPI) { if (wr == 0) PG8_BAR; }
    PG8_BAR;
    if constexpr (Epi::AFTER_DRAIN) { E.fused(acc, cur, wr, wc, fr, fq, lds, wid, lane); S.done(cur); }
#undef PG8_SA
#undef PG8_SB
#undef PG8_STAGE
#undef PG8_LDA
#undef PG8_LDB
#undef PG8_MMA
#undef PG8_WAIT_V
#undef PG8_WAIT_L
#undef PG8_BAR
#undef PG8_SCHED
}
}

typedef unsigned short bf16;
constexpr int NB = 4, SEQ = 8192, T = NB * SEQ, DM = 1024, DFF = 4096, DEPTH = 2;
constexpr int DIN = 3476, DINP = 3584;
constexpr int C_MQ = 0, C_MK = 512, C_MV = 1024, C_MO = 1536, C_BQ = 2048, C_BK = 2304, C_BV = 2560, C_NQ = 2816,
              C_NKC = 3072, C_NVC = 3136, C_NKS = 3200, C_NVS = 3264, C_NKW = 3328, C_NVW = 3392, C_GATE = 3456;
constexpr int NCMP = 511;
constexpr float EPS = 1e-6f;

__device__ __forceinline__ float bf2f(bf16 v) { return __builtin_bit_cast(float, (unsigned)v << 16); }
__device__ __forceinline__ bf16 f2bf(float f) { return (bf16)pg8::f2bf_u(f); }
template <int MASK> __device__ __forceinline__ float shx(float v) {
    if constexpr (MASK == 32) { auto rr = __builtin_amdgcn_permlane32_swap(__float_as_uint(v), __float_as_uint(v), false, false);
        return __uint_as_float(__builtin_amdgcn_mbcnt_lo(~0u, 0u) == 32u ? rr[0] : rr[1]); }
    else return __uint_as_float((unsigned)__builtin_amdgcn_ds_swizzle((int)__float_as_uint(v), 0x1F | (MASK << 10)));
}
__device__ __forceinline__ float xchg32(float v, int hi) { auto rr = __builtin_amdgcn_permlane32_swap(__float_as_uint(v), __float_as_uint(v), false, false); return __uint_as_float(hi ? rr[0] : rr[1]); }
__device__ __forceinline__ float hsum32(float v) { auto rr = __builtin_amdgcn_permlane32_swap(__float_as_uint(v), __float_as_uint(v), false, false); return __uint_as_float(rr[0]) + __uint_as_float(rr[1]); }
__device__ __forceinline__ float hmax32(float v) { auto rr = __builtin_amdgcn_permlane32_swap(__float_as_uint(v), __float_as_uint(v), false, false); return fmaxf(__uint_as_float(rr[0]), __uint_as_float(rr[1])); }
template <int MASK> __device__ __forceinline__ unsigned shxu(unsigned v) { return __float_as_uint(shx<MASK>(__uint_as_float(v))); }
__device__ __forceinline__ float wave_sum(float v) {
    v += shx<1>(v); v += shx<2>(v); v += shx<4>(v); v += shx<8>(v); v += shx<16>(v);
    auto rr = __builtin_amdgcn_permlane32_swap(__float_as_uint(v), __float_as_uint(v), false, false); return __uint_as_float(rr[0]) + __uint_as_float(rr[1]);
}
__device__ __forceinline__ float wave_max(float v) {
    v = fmaxf(v, shx<1>(v)); v = fmaxf(v, shx<2>(v)); v = fmaxf(v, shx<4>(v)); v = fmaxf(v, shx<8>(v)); v = fmaxf(v, shx<16>(v));
    auto rr = __builtin_amdgcn_permlane32_swap(__float_as_uint(v), __float_as_uint(v), false, false); return fmaxf(__uint_as_float(rr[0]), __uint_as_float(rr[1]));
}
__device__ __forceinline__ float sgprf(float c) { asm volatile("" : "+s"(c)); return c; }
#define nbg (sgprf(-1e30f))
__device__ __forceinline__ int mk_tid(int wave_s) { int t; asm volatile("v_mbcnt_lo_u32_b32 %0, -1, 0\n\tv_mbcnt_hi_u32_b32 %0, -1, %0" : "=v"(t)); return t + wave_s * 64; }
__device__ __forceinline__ float zf_() { float z = 0.f; asm volatile("" : "+v"(z)); return z; }
__device__ __forceinline__ float rcpf_(float x) { return __builtin_amdgcn_rcpf(x); }
__device__ __forceinline__ float sigmoidf_(float x) { return rcpf_(1.f + __expf(-x)); }
__device__ __forceinline__ float log_sigmoidf_(float x) { return fminf(x, 0.f) - __logf(1.f + __expf(-fabsf(x))); }
__device__ __forceinline__ void rope_cs(int pos, int f, float& c, float& s) {
    const float invf = f == 0 ? 1.0f : f == 1 ? 0.193922758102417f : f == 2 ? 0.03760603442788124f : f == 3 ? 0.007292666472494602f : f == 4 ? 0.0014142136787995696f
                     : f == 5 ? 0.00027424818836152554f : f == 6 ? 5.318298644851893e-05f : 1.031338433676865e-05f;
    const float ang = (float)pos * invf;
    const float k = rintf(ang * 0.15915493667125702f);
    float r = fmaf(-k, 6.2831854820251465f, ang); r = fmaf(-k, -1.7484555314695172e-07f, r);
    c = __cosf(r); s = __sinf(r);
}


__device__ __forceinline__ float dot64(const bf16* __restrict__ kp, const float* q) {
    const uint4* k4 = (const uint4*)kp; float a = 0.f;
#pragma unroll
    for (int j = 0; j < 8; ++j) { const uint4 w = k4[j]; const unsigned ww[4] = {w.x, w.y, w.z, w.w};
#pragma unroll
        for (int e = 0; e < 4; ++e) { a = fmaf(q[8 * j + 2 * e], __builtin_bit_cast(float, ww[e] << 16), a); a = fmaf(q[8 * j + 2 * e + 1], __builtin_bit_cast(float, ww[e] & 0xffff0000u), a); } }
    return a;
}
__device__ __forceinline__ void dot64x4(const bf16* __restrict__ kp, const float (*q)[64], float (&a)[4]) {
    const uint4* k4 = (const uint4*)kp; a[0] = a[1] = a[2] = a[3] = 0.f;
#pragma unroll
    for (int j = 0; j < 8; ++j) { const uint4 w = k4[j]; const unsigned ww[4] = {w.x, w.y, w.z, w.w};
#pragma unroll
        for (int e = 0; e < 4; ++e) { const float k0 = __builtin_bit_cast(float, ww[e] << 16), k1 = __builtin_bit_cast(float, ww[e] & 0xffff0000u);
#pragma unroll
            for (int h = 0; h < 4; ++h) { a[h] = fmaf(q[h][8 * j + 2 * e], k0, a[h]); a[h] = fmaf(q[h][8 * j + 2 * e + 1], k1, a[h]); } } }
}

__host__ __device__ __forceinline__ int win_src(int n) {
    if (n < 2048) return n;
    if (n < 3456) return n + 8;
    if (n < 3464) return n - 3456 + 2048;
    if (n < 3476) return n;
    return -1;
}


typedef unsigned u32x4p __attribute__((ext_vector_type(4)));
__device__ __forceinline__ void cw_load(float (&v)[16], const float* __restrict__ W, int N, int NP, int mode, int item, int t, const float* __restrict__ gk) {
    const int nbx = NP / 64; const int n0 = (item % nbx) * 64, k0 = (item / nbx) * 64, c = t & 63, r = t >> 6;
    const int src = mode ? win_src(n0 + c) : (n0 + c);
    const int srcc = src >= 0 ? src : 0; const float msk = src >= 0 ? 1.f : 0.f;
#pragma unroll
    for (int i = 0; i < 16; ++i) v[i] = W[(size_t)(k0 + r + 4 * i) * N + srcc];
    if (gk) { float gv[16];
#pragma unroll
        for (int i = 0; i < 16; ++i) gv[i] = gk[k0 + r + 4 * i];
#pragma unroll
        for (int i = 0; i < 16; ++i) v[i] *= gv[i]; }
#pragma unroll
    for (int i = 0; i < 16; ++i) v[i] *= msk;
}
__device__ __forceinline__ void ph_convert_mat(const float* __restrict__ W, int K, int N, int NP, bf16* __restrict__ WT, int mode, int vb, int NVB, int t, float* tile, const float* __restrict__ gk = nullptr) {
    const int nit = (NP / 64) * (K / 64), nbx = NP / 64, c = t & 63, r = t >> 6;
    float v[16];
    if (vb < nit) cw_load(v, W, N, NP, mode, vb, t, gk);
    for (int it0 = 0; it0 < nit; it0 += NVB) { const int it = it0 + vb; const bool act = it < nit;
        if (act) {
#pragma unroll
            for (int i = 0; i < 16; ++i) tile[(r + 4 * i) * 65 + c] = v[i]; }
        if (it + NVB < nit) cw_load(v, W, N, NP, mode, it + NVB, t, gk);
        __syncthreads();
        if (act) { const int n0 = (it % nbx) * 64, k0 = (it / nbx) * 64, n = t >> 2, kc = (t & 3) * 16;
            u32x4p w0, w1;
#pragma unroll
            for (int e = 0; e < 4; ++e) { w0[e] = pg8::cvtpk_bf16(tile[(kc + 2 * e) * 65 + n], tile[(kc + 2 * e + 1) * 65 + n]); w1[e] = pg8::cvtpk_bf16(tile[(kc + 8 + 2 * e) * 65 + n], tile[(kc + 8 + 2 * e + 1) * 65 + n]); }
            u32x4p* dst = (u32x4p*)(WT + (size_t)(n0 + n) * K + k0 + kc); dst[0] = w0; dst[1] = w1; }
        __syncthreads();
    }
}
__device__ __forceinline__ void ph_x_row(const float* __restrict__ x, bf16* __restrict__ XB, unsigned long long* __restrict__ ssq, int row, int lane) {
    const float4* xr = (const float4*)(x + (size_t)row * DM) + lane;
    float4 v[4]; float s = 0.f;
#pragma unroll
    for (int j = 0; j < 4; ++j) { v[j] = xr[64 * j]; s += v[j].x * v[j].x + v[j].y * v[j].y + v[j].z * v[j].z + v[j].w * v[j].w; }
    s = wave_sum(s);
    uint2* o = (uint2*)(XB + (size_t)row * DM) + lane;
#pragma unroll
    for (int j = 0; j < 4; ++j) { uint2 w; w.x = pg8::cvtpk_bf16(v[j].x, v[j].y); w.y = pg8::cvtpk_bf16(v[j].z, v[j].w); o[64 * j] = w; }
    if (lane == 0) ssq[row] = (unsigned long long)(s * 1048576.0f + 0.5f);
}
__device__ __forceinline__ void ph_prep(bf16* __restrict__ P, const float* __restrict__ tab, const float* __restrict__ moba_g, const float* __restrict__ nsa_qg, const float* __restrict__ nsa_kg,
                                        float* __restrict__ kmean, int item, bool act, int t, float* red  ) {
    const int lane = t & 63, wid = t >> 6, tb = item % 128, kind = item / 128, rg = lane >> 3, dch = lane & 7;
    if (act) {
        int col; const float* g; bool rope;
        if (kind < 4) { col = C_BQ + kind * 64; g = moba_g; rope = true; }
        else if (kind < 8) { col = C_BK + (kind - 4) * 64; g = moba_g + 64; rope = true; }
        else if (kind < 12) { col = C_NQ + (kind - 8) * 64; g = nsa_qg; rope = false; }
        else if (kind == 12) { col = C_NKS; g = nsa_kg + 64; rope = true; }
        else { col = C_NKW; g = nsa_kg + 128; rope = true; }
        float gd[8];
#pragma unroll
        for (int e = 0; e < 8; ++e) gd[e] = g[dch * 8 + e];
        const int row0 = tb * 256 + wid * 64 + rg;
        u32x4p raw[8];
#pragma unroll
        for (int it = 0; it < 8; ++it) raw[it] = *(const u32x4p*)(P + (size_t)(row0 + it * 8) * DINP + col + dch * 8);
        float ks[8];
#pragma unroll
        for (int e = 0; e < 8; ++e) ks[e] = 0.f;
#pragma unroll
        for (int it = 0; it < 8; ++it) {
            const int row = row0 + it * 8, pos = row & (SEQ - 1);
            float y[8]; float ss = 0.f;
#pragma unroll
            for (int e = 0; e < 4; ++e) { y[2 * e] = __builtin_bit_cast(float, raw[it][e] << 16); y[2 * e + 1] = __builtin_bit_cast(float, raw[it][e] & 0xffff0000u); ss += y[2 * e] * y[2 * e] + y[2 * e + 1] * y[2 * e + 1]; }
            ss += shx<1>(ss); ss += shx<2>(ss); ss += shx<4>(ss);
            const float rstd = rsqrtf(ss * (1.f / 64.f) + EPS);
#pragma unroll
            for (int e = 0; e < 8; ++e) y[e] *= rstd * gd[e];
            if (rope) {
                float o[8];
#pragma unroll
                for (int e = 0; e < 8; ++e) o[e] = shx<1>(y[e]);
                if (dch < 2) { const float4 c0 = *(const float4*)(tab + pos * 16), c1 = *(const float4*)(tab + pos * 16 + 4), s0 = *(const float4*)(tab + pos * 16 + 8), s1 = *(const float4*)(tab + pos * 16 + 12);
                    const float cs[8] = {c0.x, c0.y, c0.z, c0.w, c1.x, c1.y, c1.z, c1.w}, sn[8] = {s0.x, s0.y, s0.z, s0.w, s1.x, s1.y, s1.z, s1.w};
#pragma unroll
                    for (int e = 0; e < 8; ++e) y[e] = dch ? (y[e] * cs[e] + o[e] * sn[e]) : (y[e] * cs[e] - o[e] * sn[e]); }
            }
            u32x4p w; w[0] = pg8::pk2bf(y[0], y[1]); w[1] = pg8::pk2bf(y[2], y[3]); w[2] = pg8::pk2bf(y[4], y[5]); w[3] = pg8::pk2bf(y[6], y[7]);
            *(u32x4p*)(P + (size_t)row * DINP + col + dch * 8) = w;
#pragma unroll
            for (int e = 0; e < 8; ++e) ks[e] += y[e];
        }
        if (kind >= 4 && kind < 8) {
#pragma unroll
            for (int e = 0; e < 8; ++e) { ks[e] += shx<8>(ks[e]); ks[e] += shx<16>(ks[e]); ks[e] += shx<32>(ks[e]); }
            if (rg == 0) {
#pragma unroll
                for (int e = 0; e < 8; ++e) red[wid * 64 + dch * 8 + e] = ks[e]; }
        }
    }
    __syncthreads();
    if (act && kind >= 4 && kind < 8 && wid == 0) { const float s = red[lane] + red[64 + lane] + red[128 + lane] + red[192 + lane];
        const int b = tb >> 5, n = tb & 31; kmean[(((size_t)b * 4 + (kind - 4)) * 32 + n) * 64 + lane] = s * (1.f / 256.f); }
    __syncthreads();
}
__device__ __forceinline__ void ph_compress(const bf16* __restrict__ P, const float* __restrict__ pe, const float* __restrict__ w1, const float* __restrict__ w2, const float* __restrict__ kg0,
                                            float* __restrict__ KVc, bf16* __restrict__ KVcb, int item, bool act, int t, float* sm  ) {
    float* in = sm; float* hid = sm + 2048;
    const int i = item % NCMP, b = (item / NCMP) & 3, kv = item / (NCMP * 4);
    const int col = kv ? C_NVC : C_NKC;
    if (act) for (int e = t; e < 2048; e += 256) { const int p = e >> 6, d = e & 63; in[e] = bf2f(P[(size_t)(b * SEQ + 16 * i + p) * DINP + col + d]) + pe[(kv * 32 + p) * 64 + d]; }
    __syncthreads();
    if (act && t < 128) { const float* w = w1 + (size_t)kv * 2048 * 128 + t; float a = 0.f;
#pragma unroll 8
        for (int k = 0; k < 2048; ++k) a = fmaf(in[k], w[(size_t)k * 128], a);
        hid[t] = a * rcpf_(1.f + __expf(-a)); }
    __syncthreads();
    if (act && t < 64) { const float* ww = w2 + (size_t)kv * 128 * 64 + t; float o = 0.f;
#pragma unroll 8
        for (int j = 0; j < 128; ++j) o = fmaf(hid[j], ww[j * 64], o);
        if (kv == 0) { const float ss = wave_sum(o * o); o = o * rsqrtf(ss * (1.f / 64.f) + EPS) * kg0[t]; }
        KVc[(((size_t)kv * NB + b) * 512 + i) * 64 + t] = o; KVcb[(((size_t)kv * NB + b) * 512 + i) * 64 + t] = f2bf(o);
        if (i == NCMP - 1) KVcb[(((size_t)kv * NB + b) * 512 + NCMP) * 64 + t] = 0; }
    __syncthreads();
}
__device__ __forceinline__ float conv_silu(const bf16* __restrict__ P, const float* __restrict__ cw  , int rowbase, int t, int c) {
    float a = 0.f;
#pragma unroll
    for (int j = 0; j < 4; ++j) { const int tt = t - 3 + j; if (tt >= 0) a = fmaf(cw[j * 1024 + c], bf2f(P[(size_t)(rowbase + tt) * DINP + c]), a); }
    return a * rcpf_(1.f + __expf(-a));
}
__device__ __forceinline__ void ph_mlstm_local(const bf16* __restrict__ P, const float* __restrict__ G, const float* __restrict__ cw, const float* __restrict__ bif,
                                               float* __restrict__ Cst, float* __restrict__ nst, float* __restrict__ dec, int u, bool act, int tid, unsigned char* sm) {
    bf16 (*ks)[128] = (bf16 (*)[128])sm; bf16 (*vs)[128] = (bf16 (*)[128])(sm + 16384); float* wS = (float*)(sm + 32768); float* lf = wS + 64;
    const int c = u & 127, h = (u >> 7) & 3, b = u >> 9;
    const int rowbase = b * SEQ, t0 = c * 64;
    if (act) {
        for (int e = tid; e < 64 * 128; e += 256) { const int s = e >> 7, d = e & 127;
            ks[s][d] = f2bf(conv_silu(P, cw, rowbase, t0 + s, 512 + h * 128 + d) * 0.08838834764831845f);
            vs[s][d] = P[(size_t)(rowbase + t0 + s) * DINP + C_MV + h * 128 + d]; }
        if (tid < 64) lf[tid] = log_sigmoidf_(G[(size_t)(rowbase + t0 + tid) * 32 + 4 + h] + bif[4 + h]);
    }
    __syncthreads();
    if (act && tid == 0) { float acc = 0.f;
        for (int s = 0; s < 64; ++s) { acc += lf[s]; lf[s] = acc; }
        dec[u] = __expf(acc); }
    __syncthreads();
    if (act && tid < 64) wS[tid] = __expf(lf[63] - lf[tid] + G[(size_t)(rowbase + t0 + tid) * 32 + h] + bif[h]);
    __syncthreads();
    if (act) {
        const int d = tid >> 1, e0 = (tid & 1) * 64;
        float acc[64];
#pragma unroll
        for (int e = 0; e < 64; ++e) acc[e] = 0.f;
        float an = 0.f;
        for (int s = 0; s < 64; ++s) { const float kw = wS[s] * bf2f(ks[s][d]); an += kw;
#pragma unroll
            for (int e = 0; e < 64; ++e) acc[e] = fmaf(kw, bf2f(vs[s][e0 + e]), acc[e]); }
        float* o = Cst + ((size_t)u * 128 + d) * 128 + e0;
#pragma unroll
        for (int e = 0; e < 64; ++e) o[e] = acc[e];
        if ((tid & 1) == 0) nst[(size_t)u * 128 + d] = an;
    }
    __syncthreads();
}
__device__ __forceinline__ void ph_mlstm_scan(float* __restrict__ Cst, float* __restrict__ nst, const float* __restrict__ dec, int item, int tid) {
    const int bh = item / 65, part = item % 65;
    float* base; int stride;
    if (part < 64) { base = Cst + (size_t)bh * 128 * 16384 + part * 256 + tid; stride = 16384; }
    else { if (tid >= 128) return; base = nst + (size_t)bh * 128 * 128 + tid; stride = 128; }
    float C = 0.f;
    for (int c = 0; c < 128; ++c) { const float dC = base[(size_t)c * stride]; base[(size_t)c * stride] = C; C = dec[bh * 128 + c] * C + dC; }
}
__device__ __forceinline__ void ph_mlstm_out(const bf16* __restrict__ P, const float* __restrict__ G, const float* __restrict__ cw, const float* __restrict__ bif,
                                             const float* __restrict__ Cst, const float* __restrict__ nst, const float* __restrict__ mnorm, bf16* __restrict__ MIX, int u, bool act, int tid, unsigned char* sm) {
    bf16 (*qs)[128] = (bf16 (*)[128])sm; float* ksS = (float*)(sm + 16384); bf16 (*ks)[128] = (bf16 (*)[128])ksS; bf16 (*vs)[128] = (bf16 (*)[128])(sm + 32768);
    float* bb = (float*)(sm + 49152); float* li = bb + 64;
    const int c = u & 127, h = (u >> 7) & 3, b = u >> 9;
    const int rowbase = b * SEQ, t0 = c * 64;
    if (act) {
        for (int e = tid; e < 64 * 128; e += 256) { const int s = e >> 7, d = e & 127;
            qs[s][d] = f2bf(conv_silu(P, cw, rowbase, t0 + s, h * 128 + d));
            ks[s][d] = f2bf(conv_silu(P, cw, rowbase, t0 + s, 512 + h * 128 + d) * 0.08838834764831845f);
            vs[s][d] = P[(size_t)(rowbase + t0 + s) * DINP + C_MV + h * 128 + d]; }
        if (tid < 64) { bb[tid] = log_sigmoidf_(G[(size_t)(rowbase + t0 + tid) * 32 + 4 + h] + bif[4 + h]); li[tid] = G[(size_t)(rowbase + t0 + tid) * 32 + h] + bif[h]; }
    }
    __syncthreads();
    if (act && tid == 0) { float acc = 0.f; for (int s = 0; s < 64; ++s) { acc += bb[s]; bb[s] = acc; } }
    __syncthreads();
    const int t = tid >> 2, part = tid & 3;
    float sreg[16];
    if (act) {
        const int s0 = part * 16;
#pragma unroll
        for (int j = 0; j < 16; ++j) { const int s = s0 + j; float a = 0.f;
            if (s <= t) { for (int d = 0; d < 128; ++d) a = fmaf(bf2f(qs[t][d]), bf2f(ks[s][d]), a); a *= __expf(bb[t] - bb[s] + li[s]); }
            sreg[j] = a; }
    }
    __syncthreads();
    float* S = ksS;
    if (act) {
#pragma unroll
        for (int j = 0; j < 16; ++j) S[t * 64 + part * 16 + j] = sreg[j];
    }
    __syncthreads();
    if (act) {
        const float Ft = __expf(bb[t]);
        float den = 0.f;
        for (int s = 0; s <= t; ++s) den += S[t * 64 + s];
        { const float* np = nst + (size_t)u * 128; float a = 0.f; for (int d = 0; d < 128; ++d) a = fmaf(bf2f(qs[t][d]), np[d], a); den += Ft * a; }
        const int e0 = part * 32;
        float acc[32];
#pragma unroll
        for (int e = 0; e < 32; ++e) acc[e] = 0.f;
        { const float* Cp = Cst + (size_t)u * 16384 + e0;
          for (int d = 0; d < 128; ++d) { const float qd = bf2f(qs[t][d]);
#pragma unroll
              for (int e = 0; e < 32; ++e) acc[e] = fmaf(qd, Cp[d * 128 + e], acc[e]); } }
#pragma unroll
        for (int e = 0; e < 32; ++e) acc[e] *= Ft;
        for (int s = 0; s <= t; ++s) { const float w = S[t * 64 + s];
#pragma unroll
            for (int e = 0; e < 32; ++e) acc[e] = fmaf(w, bf2f(vs[s][e0 + e]), acc[e]); }
        const float inv = rcpf_(fmaxf(fabsf(den), 1.f));
        float ss = 0.f;
#pragma unroll
        for (int e = 0; e < 32; ++e) { acc[e] *= inv; ss += acc[e] * acc[e]; }
        ss += shx<1>(ss); ss += shx<2>(ss);
        const float rstd = rsqrtf(ss * (1.f / 128.f) + EPS);
        const size_t row = (size_t)(rowbase + t0 + t);
#pragma unroll
        for (int e = 0; e < 32; ++e) { const int cc = h * 128 + e0 + e;
            const float o = sigmoidf_(bf2f(P[row * DINP + C_MO + cc]));
            MIX[row * DM + cc] = f2bf(acc[e] * rstd * mnorm[cc] * o); }
    }
    __syncthreads();
}

__device__ __forceinline__ void ph_moba(const bf16* __restrict__ P, const float* __restrict__ kmean, bf16* __restrict__ MIX, int gw, int lane, float* q) {
    const int bh = gw >> 13, tq = gw & (SEQ - 1), b = bh >> 2, h = bh & 3, own = tq >> 8;
    const size_t row = (size_t)b * SEQ + tq;
    __builtin_amdgcn_s_waitcnt(0); __builtin_amdgcn_wave_barrier();
    q[lane] = bf2f(P[row * DINP + C_BQ + h * 64 + lane]);
    __builtin_amdgcn_s_waitcnt(0); __builtin_amdgcn_wave_barrier();
    float gs = -3.0e38f;
    if (lane < 32) { if (lane < own) { const float* km = kmean + (((size_t)b * 4 + h) * 32 + lane) * 64; float a = 0.f; for (int d = 0; d < 64; ++d) a = fmaf(q[d], km[d], a); gs = a; } else gs = -1e30f; }
    int blk[4]; bool val[4];
#pragma unroll
    for (int r = 0; r < 3; ++r) { const float m = wave_max(gs); const unsigned long long bal = __ballot(gs == m); const int idx = __ffsll((long long)bal) - 1;
        blk[r] = idx; val[r] = (r < own); if (lane == idx) gs = -3.0e38f; }
    blk[3] = own; val[3] = true;
    float s[4][4]; float mx = -1e30f;
#pragma unroll
    for (int g = 0; g < 4; ++g)
#pragma unroll
        for (int i = 0; i < 4; ++i) { float a = -1e30f;
            if (val[g]) { const int pos = blk[g] * 256 + i * 64 + lane;
                if (g < 3 || pos <= tq) { const bf16* kp = P + ((size_t)b * SEQ + pos) * DINP + C_BK + h * 64; a = dot64(kp, q) * 0.125f; } }
            s[g][i] = a; mx = fmaxf(mx, a); }
    mx = wave_max(mx);
    float l = 0.f;
#pragma unroll
    for (int g = 0; g < 4; ++g)
#pragma unroll
        for (int i = 0; i < 4; ++i) { const float p = (s[g][i] > -1e29f) ? __expf(s[g][i] - mx) : 0.f; s[g][i] = p; l += p; }
    l = wave_sum(l);
    float o = 0.f;
#pragma unroll
    for (int g = 0; g < 4; ++g) { if (!val[g]) continue;
#pragma unroll
        for (int i = 0; i < 4; ++i) { const bf16* vp = P + ((size_t)b * SEQ + blk[g] * 256 + i * 64) * DINP + C_BV + h * 64 + lane;
            for (int src = 0; src < 64; ++src) { const float p = __shfl(s[g][i], src); o = fmaf(p, bf2f(vp[(size_t)src * DINP]), o); } } }
    MIX[row * DM + 512 + h * 64 + lane] = f2bf(o * rcpf_(l));
}

__device__ __forceinline__ void ph_nsa(const bf16* __restrict__ P, const float* __restrict__ G, const float* __restrict__ tab, const float* __restrict__ KVc, bf16* __restrict__ MIX, int gw, int lane, float* sm) {
    float (*qn)[64] = (float (*)[64])sm; float (*qr)[64] = (float (*)[64])(sm + 256); float* ps = sm + 512;
    const int b = gw >> 13, tq = gw & (SEQ - 1), blkq = tq >> 6;
    const size_t row = (size_t)b * SEQ + tq;
    __builtin_amdgcn_s_waitcnt(0); __builtin_amdgcn_wave_barrier();
#pragma unroll
    for (int h = 0; h < 4; ++h) { const float x = bf2f(P[row * DINP + C_NQ + h * 64 + lane]); qn[h][lane] = x;
        float y = x; const float other = shx<8>(x);
        if (lane < 16) { const int f = lane & 7; const float c = tab[tq * 16 + f], s = tab[tq * 16 + 8 + f]; y = (lane < 8) ? (x * c - other * s) : (x * c + other * s); }
        qr[h][lane] = y; }
    __builtin_amdgcn_s_waitcnt(0); __builtin_amdgcn_wave_barrier();
    const float* Kc = KVc + (size_t)b * 512 * 64; const float* Vc = KVc + ((size_t)NB + b) * 512 * 64;
    float out[4] = {0.f, 0.f, 0.f, 0.f};
    float gate[3][4];
#pragma unroll
    for (int br = 0; br < 3; ++br)
#pragma unroll
        for (int h = 0; h < 4; ++h) gate[br][h] = sigmoidf_(G[row * 32 + 8 + br * 4 + h]);
    const int ncv = (tq >= 31) ? ((tq - 31) >> 4) + 1 : 0;
    {
        float sc[8][4]; float mx[4] = {-1e30f, -1e30f, -1e30f, -1e30f};
#pragma unroll
        for (int i = 0; i < 8; ++i) { const int c = i * 64 + lane;
            float a[4] = {-1e30f, -1e30f, -1e30f, -1e30f};
            if (c < ncv) { const float* kp = Kc + (size_t)c * 64; a[0] = a[1] = a[2] = a[3] = 0.f;
                for (int d = 0; d < 64; ++d) { const float kd = kp[d]; a[0] = fmaf(qn[0][d], kd, a[0]); a[1] = fmaf(qn[1][d], kd, a[1]); a[2] = fmaf(qn[2][d], kd, a[2]); a[3] = fmaf(qn[3][d], kd, a[3]); }
#pragma unroll
                for (int h = 0; h < 4; ++h) a[h] *= 0.125f; }
#pragma unroll
            for (int h = 0; h < 4; ++h) { sc[i][h] = a[h]; mx[h] = fmaxf(mx[h], a[h]); } }
        float l[4];
#pragma unroll
        for (int h = 0; h < 4; ++h) { mx[h] = wave_max(mx[h]); l[h] = 0.f; }
#pragma unroll
        for (int i = 0; i < 8; ++i) { const int c = i * 64 + lane;
#pragma unroll
            for (int h = 0; h < 4; ++h) { const float p = (c < ncv) ? __expf(sc[i][h] - mx[h]) : 0.f; sc[i][h] = p; l[h] += p; } }
#pragma unroll
        for (int h = 0; h < 4; ++h) { l[h] = wave_sum(l[h]); l[h] = (l[h] > 0.f) ? rcpf_(l[h]) : 0.f; }
#pragma unroll
        for (int i = 0; i < 8; ++i) { float su = 0.f;
#pragma unroll
            for (int h = 0; h < 4; ++h) { sc[i][h] *= l[h]; su += sc[i][h]; }
            ps[i * 64 + lane] = su; }
        if (lane < 4) ps[512 + lane] = 0.f;
        float oc[4] = {0.f, 0.f, 0.f, 0.f};
#pragma unroll
        for (int i = 0; i < 8; ++i) { if (i * 64 >= ncv) break; const int nn = min(64, ncv - i * 64);
            for (int src = 0; src < nn; ++src) { const float v = Vc[(size_t)(i * 64 + src) * 64 + lane];
                oc[0] = fmaf(__shfl(sc[i][0], src), v, oc[0]); oc[1] = fmaf(__shfl(sc[i][1], src), v, oc[1]);
                oc[2] = fmaf(__shfl(sc[i][2], src), v, oc[2]); oc[3] = fmaf(__shfl(sc[i][3], src), v, oc[3]); } }
#pragma unroll
        for (int h = 0; h < 4; ++h) out[h] = gate[0][h] * oc[h];
    }
    __builtin_amdgcn_s_waitcnt(0); __builtin_amdgcn_wave_barrier();
    int sidx[16];
    {
        float v0, v1;
        { const int n = lane; float im = 0.f;
#pragma unroll
          for (int j = -1; j < 4; ++j) { const int c = 4 * n + j; if (c >= 0 && c < NCMP) im += ps[c]; }
          const bool causal = n <= blkq, forced = causal && (n == 0 || n >= blkq - 1);
          v0 = forced ? 1e9f : (causal ? im : -1e30f); }
        { const int n = lane + 64; float im = 0.f;
#pragma unroll
          for (int j = -1; j < 4; ++j) { const int c = 4 * n + j; if (c >= 0 && c < NCMP) im += ps[c]; }
          const bool causal = n <= blkq, forced = causal && (n == 0 || n >= blkq - 1);
          v1 = forced ? 1e9f : (causal ? im : -1e30f); }
#pragma unroll
        for (int k = 0; k < 16; ++k) { const float m = wave_max(fmaxf(v0, v1));
            const unsigned long long b0 = __ballot(v0 == m); int idx;
            if (b0) { idx = __ffsll((long long)b0) - 1; if (lane == idx) v0 = -3.0e38f; }
            else { const unsigned long long b1 = __ballot(v1 == m); idx = __ffsll((long long)b1) - 1; if (lane == idx) v1 = -3.0e38f; idx += 64; }
            sidx[k] = idx; }
    }
    {
        float sc[16][4]; float mx[4] = {-1e30f, -1e30f, -1e30f, -1e30f};
#pragma unroll
        for (int k = 0; k < 16; ++k) { const int n = sidx[k], pos = n * 64 + lane;
            float a[4] = {-1e30f, -1e30f, -1e30f, -1e30f};
            if (n <= blkq && pos <= tq) { const bf16* kp = P + ((size_t)b * SEQ + pos) * DINP + C_NKS; dot64x4(kp, qr, a);
#pragma unroll
                for (int h = 0; h < 4; ++h) a[h] *= 0.125f; }
#pragma unroll
            for (int h = 0; h < 4; ++h) { sc[k][h] = a[h]; mx[h] = fmaxf(mx[h], a[h]); } }
        float l[4];
#pragma unroll
        for (int h = 0; h < 4; ++h) { mx[h] = wave_max(mx[h]); l[h] = 0.f; }
#pragma unroll
        for (int k = 0; k < 16; ++k)
#pragma unroll
            for (int h = 0; h < 4; ++h) { const float p = (sc[k][h] > -1e29f) ? __expf(sc[k][h] - mx[h]) : 0.f; sc[k][h] = p; l[h] += p; }
#pragma unroll
        for (int h = 0; h < 4; ++h) l[h] = rcpf_(wave_sum(l[h]));
        float os[4] = {0.f, 0.f, 0.f, 0.f};
#pragma unroll
        for (int k = 0; k < 16; ++k) { const int n = sidx[k]; if (n > blkq) continue;
            const bf16* vp = P + ((size_t)b * SEQ + n * 64) * DINP + C_NVS + lane;
            for (int src = 0; src < 64; ++src) { const float v = bf2f(vp[(size_t)src * DINP]);
                os[0] = fmaf(__shfl(sc[k][0], src), v, os[0]); os[1] = fmaf(__shfl(sc[k][1], src), v, os[1]);
                os[2] = fmaf(__shfl(sc[k][2], src), v, os[2]); os[3] = fmaf(__shfl(sc[k][3], src), v, os[3]); } }
#pragma unroll
        for (int h = 0; h < 4; ++h) out[h] += gate[1][h] * os[h] * l[h];
    }
    {
        float sc[8][4]; float mx[4] = {-1e30f, -1e30f, -1e30f, -1e30f};
#pragma unroll
        for (int i = 0; i < 8; ++i) { const int pos = tq - 511 + i * 64 + lane;
            float a[4] = {-1e30f, -1e30f, -1e30f, -1e30f};
            if (pos >= 0) { const bf16* kp = P + ((size_t)b * SEQ + pos) * DINP + C_NKW; dot64x4(kp, qr, a);
#pragma unroll
                for (int h = 0; h < 4; ++h) a[h] *= 0.125f; }
#pragma unroll
            for (int h = 0; h < 4; ++h) { sc[i][h] = a[h]; mx[h] = fmaxf(mx[h], a[h]); } }
        float l[4];
#pragma unroll
        for (int h = 0; h < 4; ++h) { mx[h] = wave_max(mx[h]); l[h] = 0.f; }
#pragma unroll
        for (int i = 0; i < 8; ++i)
#pragma unroll
            for (int h = 0; h < 4; ++h) { const float p = (sc[i][h] > -1e29f) ? __expf(sc[i][h] - mx[h]) : 0.f; sc[i][h] = p; l[h] += p; }
#pragma unroll
        for (int h = 0; h < 4; ++h) l[h] = rcpf_(wave_sum(l[h]));
        float ow[4] = {0.f, 0.f, 0.f, 0.f};
#pragma unroll
        for (int i = 0; i < 8; ++i) { const int p0 = tq - 511 + i * 64; if (p0 + 63 < 0) continue;
            const int s0 = p0 < 0 ? -p0 : 0;
            for (int src = s0; src < 64; ++src) { const float v = bf2f(P[((size_t)b * SEQ + p0 + src) * DINP + C_NVW + lane]);
                ow[0] = fmaf(__shfl(sc[i][0], src), v, ow[0]); ow[1] = fmaf(__shfl(sc[i][1], src), v, ow[1]);
                ow[2] = fmaf(__shfl(sc[i][2], src), v, ow[2]); ow[3] = fmaf(__shfl(sc[i][3], src), v, ow[3]); } }
#pragma unroll
        for (int h = 0; h < 4; ++h) out[h] += gate[2][h] * ow[h] * l[h];
    }
#pragma unroll
    for (int h = 0; h < 4; ++h) MIX[row * DM + 768 + h * 64 + lane] = f2bf(out[h]);
}


#define LAS __attribute__((address_space(3)))
typedef short bf16x8 __attribute__((ext_vector_type(8)));
typedef float f32x16 __attribute__((ext_vector_type(16)));
typedef short s16x4 __attribute__((ext_vector_type(4)));
typedef unsigned u32x4v __attribute__((ext_vector_type(4)));
typedef float f32x2_t __attribute__((ext_vector_type(2)));
typedef __bf16 bf16x2_t __attribute__((ext_vector_type(2)));
constexpr int KROW = 144, VROW = 192;
constexpr int KBUF = 64 * KROW, VBUF = 64 * VROW, STG = KBUF + VBUF;
constexpr float SCL2 = 0.125f * 1.4426950408889634f;
constexpr float NEGBIG = -1e30f;

__device__ __forceinline__ unsigned cvtpk(float lo, float hi) { f32x2_t v = {lo, hi}; bf16x2_t b = __builtin_convertvector(v, bf16x2_t); return __builtin_bit_cast(unsigned, b); }
__device__ __forceinline__ int crow(int r, int hi) { return (r & 3) + 8 * (r >> 2) + 4 * hi; }
__device__ __forceinline__ s16x4 lds_tr(LAS const unsigned char* p) { return __builtin_bit_cast(s16x4, __builtin_amdgcn_ds_read_tr16_b64_v4i16((LAS s16x4*)p)); }

__device__ __forceinline__ bf16x8 scale_frag(bf16x8 v, float s) {
    const u32x4v w = __builtin_bit_cast(u32x4v, v); u32x4v o;
#pragma unroll
    for (int e = 0; e < 4; ++e) o[e] = cvtpk(__builtin_bit_cast(float, w[e] << 16) * s, __builtin_bit_cast(float, w[e] & 0xffff0000u) * s);
    return __builtin_bit_cast(bf16x8, o);
}
struct TileSrc { const bf16* k; const bf16* v; int stride; };
__device__ __forceinline__ void tile_load(u32x4v& kr, u32x4v& vr, const TileSrc& s, int t) {
    const unsigned off = (unsigned)(t >> 3) * (unsigned)(s.stride * 2) + (unsigned)(t & 7) * 16u;
    kr = *(const u32x4v*)((const unsigned char*)s.k + off); vr = *(const u32x4v*)((const unsigned char*)s.v + off);
}
__device__ __forceinline__ void tile_store(LAS unsigned char* buf, const u32x4v& kr, const u32x4v& vr, int t) {
    const int key = t >> 3, ch = t & 7;
    *(LAS u32x4v*)(buf + key * KROW + ch * 16) = kr; *(LAS u32x4v*)(buf + KBUF + key * VROW + ch * 16) = vr;
}
__device__ __forceinline__ void qk_tile(f32x16& p0, f32x16& p1, LAS const unsigned char* kb, const bf16x8 (&qf)[4], int r32, int hi, float cinit) {
    float ci = cinit; asm volatile("" : "+v"(ci));
#pragma unroll
    for (int r = 0; r < 16; ++r) { p0[r] = ci; p1[r] = ci; }
    LAS const unsigned char* a = kb + r32 * KROW + hi * 16;
    bf16x8 kf[8];
#pragma unroll
    for (int ks = 0; ks < 4; ++ks) { kf[2 * ks] = *(LAS const bf16x8*)(a + ks * 32); kf[2 * ks + 1] = *(LAS const bf16x8*)(a + 32 * KROW + ks * 32); }
    __builtin_amdgcn_sched_barrier(0);
#pragma unroll
    for (int ks = 0; ks < 4; ++ks) {
        p0 = __builtin_amdgcn_mfma_f32_32x32x16_bf16(kf[2 * ks], qf[ks], p0, 0, 0, 0);
        p1 = __builtin_amdgcn_mfma_f32_32x32x16_bf16(kf[2 * ks + 1], qf[ks], p1, 0, 0, 0);
    }
}
__device__ __forceinline__ void pv_tile(f32x16& o0, f32x16& o1, LAS const unsigned char* vb, const f32x16& p0, const f32x16& p1, int lane) {
    const int g = lane >> 4, i = lane & 15, hi = lane >> 5;
    LAS const unsigned char* base = vb + (4 * hi + (i >> 2)) * VROW + (16 * (g & 1) + 4 * (i & 3)) * 2;
    s16x4 vlo[8], vhi[8];
#pragma unroll
    for (int s = 0; s < 4; ++s)
#pragma unroll
        for (int mb = 0; mb < 2; ++mb) { vlo[2 * s + mb] = lds_tr(base + s * 16 * VROW + mb * 64); vhi[2 * s + mb] = lds_tr(base + s * 16 * VROW + 8 * VROW + mb * 64); }
    __builtin_amdgcn_sched_barrier(0);
#pragma unroll
    for (int s = 0; s < 4; ++s) {
        unsigned w[4];
#pragma unroll
        for (int e = 0; e < 4; ++e) { const int r = 8 * (s & 1) + 2 * e; w[e] = (s < 2) ? cvtpk(p0[r], p0[r + 1]) : cvtpk(p1[r], p1[r + 1]); }
        const u32x4v wv = {w[0], w[1], w[2], w[3]};
        const bf16x8 pf = __builtin_bit_cast(bf16x8, wv);
#pragma unroll
        for (int mb = 0; mb < 2; ++mb) {
            const s16x4 lo = vlo[2 * s + mb], hi4 = vhi[2 * s + mb];
            const bf16x8 vt = {lo[0], lo[1], lo[2], lo[3], hi4[0], hi4[1], hi4[2], hi4[3]};
            if (mb == 0) o0 = __builtin_amdgcn_mfma_f32_32x32x16_bf16(vt, pf, o0, 0, 0, 0);
            else o1 = __builtin_amdgcn_mfma_f32_32x32x16_bf16(vt, pf, o1, 0, 0, 0);
        }
    }
}
constexpr float SM_THR = 8.0f;
__device__ __forceinline__ void softmax_tile(f32x16& p0, f32x16& p1, f32x16& o0, f32x16& o1, float& mref, float& l, bool first) {
    float a = __builtin_fmaxf(__builtin_fmaxf(p0[0], p0[1]), p1[0]), b = __builtin_fmaxf(__builtin_fmaxf(p0[2], p0[3]), p1[1]);
    a = __builtin_fmaxf(__builtin_fmaxf(a, p1[2]), p1[3]);
#pragma unroll
    for (int r = 4; r < 16; r += 4) { a = __builtin_fmaxf(__builtin_fmaxf(a, p0[r]), p0[r + 1]); b = __builtin_fmaxf(__builtin_fmaxf(b, p0[r + 2]), p0[r + 3]);
        a = __builtin_fmaxf(__builtin_fmaxf(a, p1[r]), p1[r + 1]); b = __builtin_fmaxf(__builtin_fmaxf(b, p1[r + 2]), p1[r + 3]); }
    float rm = __builtin_fmaxf(a, b);
    { auto rr = __builtin_amdgcn_permlane32_swap(__float_as_uint(rm), __float_as_uint(rm), false, false); rm = __builtin_fmaxf(__uint_as_float(rr[0]), __uint_as_float(rr[1])); }
    if (first || __any(rm > SM_THR)) {
        const float dl = first ? rm : __builtin_fmaxf(rm, 0.f);
        mref += dl;
        const float f = __builtin_amdgcn_exp2f(-dl);
        l *= f;
#pragma unroll
        for (int r = 0; r < 16; ++r) { p0[r] -= dl; p1[r] -= dl; o0[r] *= f; o1[r] *= f; }
    }
    float s0 = 0.f, s1 = 0.f;
#pragma unroll
    for (int r = 0; r < 16; ++r) { p0[r] = __builtin_amdgcn_exp2f(p0[r]); p1[r] = __builtin_amdgcn_exp2f(p1[r]); s0 += p0[r]; s1 += p1[r]; }
    l += s0 + s1;
}


constexpr int PV_OFF = 2 * KBUF, PIPE_BYTES = 2 * KBUF + 2 * VBUF;
__device__ __forceinline__ void k_store(LAS unsigned char* lds, int slot, const u32x4v& kr, int t) { *(LAS u32x4v*)(lds + slot * KBUF + (t >> 3) * KROW + (t & 7) * 16) = kr; }
__device__ __forceinline__ void v_store(LAS unsigned char* lds, int voff, const u32x4v& vr, int t) { *(LAS u32x4v*)(lds + PV_OFF + voff + (t >> 3) * VROW + (t & 7) * 16) = vr; }
__device__ __forceinline__ u32x4v kv_load(const bf16* base, int stride, int t) { const unsigned off = (unsigned)(t >> 3) * (unsigned)(stride * 2) + (unsigned)(t & 7) * 16u;
    return *(const u32x4v*)((const unsigned char*)base + off); }
__device__ __forceinline__ void pv_frag(f32x16& o0, f32x16& o1, LAS const unsigned char* vb, const bf16x8 (&pf)[4], int lane) {
    const int g = lane >> 4, i = lane & 15, hi = lane >> 5;
    LAS const unsigned char* base = vb + (4 * hi + (i >> 2)) * VROW + (16 * (g & 1) + 4 * (i & 3)) * 2;
#pragma unroll
    for (int s = 0; s < 4; ++s)
#pragma unroll
        for (int mb = 0; mb < 2; ++mb) {
            const s16x4 lo = lds_tr(base + s * 16 * VROW + mb * 64), hi4 = lds_tr(base + s * 16 * VROW + 8 * VROW + mb * 64);
            const bf16x8 vt = {lo[0], lo[1], lo[2], lo[3], hi4[0], hi4[1], hi4[2], hi4[3]};
            if (mb == 0) o0 = __builtin_amdgcn_mfma_f32_32x32x16_bf16(vt, pf[s], o0, 0, 0, 0);
            else o1 = __builtin_amdgcn_mfma_f32_32x32x16_bf16(vt, pf[s], o1, 0, 0, 0);
        }
}
__device__ __forceinline__ void exp_pack(f32x16& p0, f32x16& p1, float& l, bf16x8 (&pf)[4]) {
    float s0 = 0.f, s1 = 0.f;
#pragma unroll
    for (int r = 0; r < 16; ++r) { p0[r] = __builtin_amdgcn_exp2f(p0[r]); p1[r] = __builtin_amdgcn_exp2f(p1[r]); s0 += p0[r]; s1 += p1[r]; }
    l += s0 + s1;
#pragma unroll
    for (int s = 0; s < 4; ++s) { u32x4v w;
#pragma unroll
        for (int e = 0; e < 4; ++e) { const int r = 8 * (s & 1) + 2 * e; w[e] = (s < 2) ? cvtpk(p0[r], p0[r + 1]) : cvtpk(p1[r], p1[r + 1]); }
        pf[s] = __builtin_bit_cast(bf16x8, w); }
}
template <bool DOQK>
__device__ __forceinline__ void attn_slices(LAS const unsigned char* kn, LAS const unsigned char* vc, const bf16x8 (&qf)[4], float ci_, f32x16& pc0, f32x16& pc1, f32x16& pn0, f32x16& pn1,
                                            f32x16& o0, f32x16& o1, float& l, int lane, int r32, int hi) {
    LAS const unsigned char* ka = kn + r32 * KROW + hi * 16;
    bf16x8 kf[8];
    if (DOQK) {
#pragma unroll
        for (int j = 0; j < 4; ++j) kf[j] = *(LAS const bf16x8*)(ka + (j & 1) * 32 * KROW + (j >> 1) * 32);
        float ci = ci_; asm volatile("" : "+v"(ci));
#pragma unroll
        for (int r = 0; r < 16; ++r) { pn0[r] = ci; pn1[r] = ci; }
    }
    const int g = lane >> 4, i16 = lane & 15;
    LAS const unsigned char* vbase = vc + (4 * hi + (i16 >> 2)) * VROW + (16 * (g & 1) + 4 * (i16 & 3)) * 2;
    float s0 = 0.f, s1 = 0.f;
    bf16x8 pf[4]; s16x4 vlo, vhi;
    __builtin_amdgcn_sched_barrier(0);
#pragma unroll
    for (int i = 0; i < 10; ++i) {
        if (DOQK && i < 8) { if (i & 1) pn1 = __builtin_amdgcn_mfma_f32_32x32x16_bf16(kf[i], qf[i >> 1], pn1, 0, 0, 0); else pn0 = __builtin_amdgcn_mfma_f32_32x32x16_bf16(kf[i], qf[i >> 1], pn0, 0, 0, 0); }
        if (i >= 2) {
            const int s = (i - 2) >> 1, mb = (i - 2) & 1;
            const bf16x8 vt = {vlo[0], vlo[1], vlo[2], vlo[3], vhi[0], vhi[1], vhi[2], vhi[3]};
            if (mb == 0) o0 = __builtin_amdgcn_mfma_f32_32x32x16_bf16(vt, pf[s], o0, 0, 0, 0); else o1 = __builtin_amdgcn_mfma_f32_32x32x16_bf16(vt, pf[s], o1, 0, 0, 0);
        }
        if (DOQK && i + 4 < 8) kf[i + 4] = *(LAS const bf16x8*)(ka + ((i + 4) & 1) * 32 * KROW + ((i + 4) >> 1) * 32);
        if (i >= 1 && i < 9) { const int s = (i - 1) >> 1, mb = (i - 1) & 1;
            vlo = lds_tr(vbase + s * 16 * VROW + mb * 64); vhi = lds_tr(vbase + s * 16 * VROW + 8 * VROW + mb * 64); }
        if (i < 8) {
#pragma unroll
            for (int e = 0; e < 4; ++e) { const int r = 4 * (i & 3) + e;
                if (i < 4) { pc0[r] = __builtin_amdgcn_exp2f(pc0[r]); s0 += pc0[r]; } else { pc1[r] = __builtin_amdgcn_exp2f(pc1[r]); s1 += pc1[r]; } }
            if (i & 1) { const int s = i >> 1; u32x4v w;
#pragma unroll
                for (int e = 0; e < 4; ++e) { const int r = 8 * (s & 1) + 2 * e; w[e] = (s < 2) ? cvtpk(pc0[r], pc0[r + 1]) : cvtpk(pc1[r], pc1[r + 1]); }
                pf[s] = __builtin_bit_cast(bf16x8, w); }
        }
        __builtin_amdgcn_sched_barrier(0);
    }
    l += s0 + s1;
}
template <class Pol>
__device__ __forceinline__ void attn_step_gen(const Pol& pol, int t, bool doqk, LAS unsigned char* lds, const bf16x8 (&qf)[4], float negm, f32x16& pc0, f32x16& pc1,
                                              f32x16& o0, f32x16& o1, float& l, int tid_, int lane_, int r32_, int hi_) {
    const int tid = mk_tid(pol.ws), lane = tid & 63, r32 = lane & 31, hi = lane >> 5; (void)tid_; (void)lane_; (void)r32_; (void)hi_;
    const int nt = pol.nt;
    u32x4v kr, vr;
    const bool ldk = (t + 2 < nt), ldv = (t + 1 < nt);
    if (ldk) kr = kv_load(pol.kptr(t + 2), pol.stride, tid);
    if (ldv) vr = kv_load(pol.vptr(t + 1), pol.stride, tid);
    f32x16 pn0, pn1;
    const bool qa = doqk && pol.active(t + 1), ca = pol.active(t);
    if (qa) { attn_slices<true>(lds + ((t + 1) & 1) * KBUF, lds + PV_OFF + (t & 1) * VBUF, qf, pol.rowsel(t + 1) ? negm : NEGBIG, pc0, pc1, pn0, pn1, o0, o1, l, lane, r32, hi); pol.mask(t + 1, pn0, pn1); }
    else if (ca) attn_slices<false>(lds, lds + PV_OFF + (t & 1) * VBUF, qf, 0.f, pc0, pc1, pn0, pn1, o0, o1, l, lane, r32, hi);
    if (ldk) k_store(lds, t & 1, kr, tid);
    if (ldv) v_store(lds, ((t + 1) & 1) * VBUF, vr, tid);
    __syncthreads();
    if (qa) { pc0 = pn0; pc1 = pn1; }
}
template <class Pol>
__device__ __forceinline__ void attn_step_fast(const Pol& pol, int t, LAS unsigned char* lds, const bf16x8 (&qf)[4], float negm, f32x16& pc0, f32x16& pc1, f32x16& pn0, f32x16& pn1,
                                               f32x16& o0, f32x16& o1, float& l, u32x4v& kld, u32x4v& vld, const u32x4v& kst, const u32x4v& vst,
                                               int tid_, int lane_, int r32_, int hi_) {
    const int tid = mk_tid(pol.ws), lane = tid & 63, r32 = lane & 31, hi = lane >> 5; (void)tid_; (void)lane_; (void)r32_; (void)hi_;
    const int nt = pol.nt, tk = (t + 3 < nt) ? t + 3 : nt - 1, tv = (t + 2 < nt) ? t + 2 : nt - 1;
    kld = kv_load(pol.kptr(tk), pol.stride, tid); vld = kv_load(pol.vptr(tv), pol.stride, tid);
    attn_slices<true>(lds + ((t + 1) & 1) * KBUF, lds + PV_OFF + (t & 1) * VBUF, qf, pol.rowsel(t + 1) ? negm : NEGBIG, pc0, pc1, pn0, pn1, o0, o1, l, lane, r32, hi);
    k_store(lds, t & 1, kst, tid);
    v_store(lds, ((t + 1) & 1) * VBUF, vst, tid);
    __syncthreads();
}
template <class Pol>
__device__ __forceinline__ void attn_pipe(const Pol& pol, LAS unsigned char* lds, const bf16x8 (&qf)[4], float negm, f32x16& o0, f32x16& o1, float& l, int tid, const u32x4v* pre = nullptr) {
    const int lane = tid & 63, r32 = lane & 31, hi = lane >> 5, nt = pol.nt;
    if (pre) { k_store(lds, 0, pre[0], tid); v_store(lds, 0, pre[1], tid); if (nt > 1) k_store(lds, 1, pre[2], tid); }
    else {
        const u32x4v k0 = kv_load(pol.kptr(0), pol.stride, tid), v0 = kv_load(pol.vptr(0), pol.stride, tid);
        u32x4v k1 = k0; if (nt > 1) k1 = kv_load(pol.kptr(1), pol.stride, tid);
        k_store(lds, 0, k0, tid); v_store(lds, 0, v0, tid); if (nt > 1) k_store(lds, 1, k1, tid);
    }
    __syncthreads();
    f32x16 pc0, pc1;
    qk_tile(pc0, pc1, lds, qf, r32, hi, pol.rowsel(0) ? negm : NEGBIG); pol.mask(0, pc0, pc1);
    int t = 0;
    for (; t < nt - 1 && t + 1 < pol.nmask; ++t)
        attn_step_gen(pol, t, true, lds, qf, negm, pc0, pc1, o0, o1, l, tid, lane, r32, hi);
    if (t < nt - 1) {
        const int tk0 = (t + 2 < nt) ? t + 2 : nt - 1;
        u32x4v ka = kv_load(pol.kptr(tk0), pol.stride, tid), va = kv_load(pol.vptr(t + 1), pol.stride, tid), kb, vb;
        f32x16 pd0, pd1;
        for (; t + 1 < nt - 1; t += 2) {
            attn_step_fast(pol, t, lds, qf, negm, pc0, pc1, pd0, pd1, o0, o1, l, kb, vb, ka, va, tid, lane, r32, hi);
            attn_step_fast(pol, t + 1, lds, qf, negm, pd0, pd1, pc0, pc1, o0, o1, l, ka, va, kb, vb, tid, lane, r32, hi);
        }
        if (t < nt - 1) {
            attn_step_fast(pol, t, lds, qf, negm, pc0, pc1, pd0, pd1, o0, o1, l, kb, vb, ka, va, tid, lane, r32, hi);
            pc0 = pd0; pc1 = pd1; ++t;
        }
    }
    attn_step_gen(pol, nt - 1, false, lds, qf, negm, pc0, pc1, o0, o1, l, tid, lane, r32, hi);
}
__device__ __forceinline__ float row_negm(const bf16x8 (&qf)[4], float kmax) {
    float ss = 0.f;
#pragma unroll
    for (int ks = 0; ks < 4; ++ks) { const u32x4v w = __builtin_bit_cast(u32x4v, qf[ks]);
#pragma unroll
        for (int e = 0; e < 4; ++e) { const float a = __builtin_bit_cast(float, w[e] << 16), b = __builtin_bit_cast(float, w[e] & 0xffff0000u); ss += a * a + b * b; } }
    ss += shx<32>(ss);
    return -(__builtin_sqrtf(ss) * kmax);
}
__device__ __forceinline__ float gain_kmax(const float* g, int lane) { return wave_max(fabsf(g[lane])) * (8.0f * 1.02f); }


constexpr int MK_KM_OFF = 0, MK_MSK_OFF = 8192, MK_CNT_OFF = MK_MSK_OFF + 1024, MK_END = MK_CNT_OFF + 512;
__device__ __forceinline__ void moba_gate_item(const bf16* __restrict__ P, const float* __restrict__ kmean, unsigned* __restrict__ SELB, int* __restrict__ CNTQ, unsigned char* __restrict__ LISTG,
                                               int b, int h, int qb, int tid, LAS unsigned char* lds) {
    asm volatile("" : "+v"(tid));
    const int lane = tid & 63, wid = __builtin_amdgcn_readfirstlane(tid >> 6), r32 = lane & 31, hi = lane >> 5, bh = b * 4 + h;
    constexpr int G_LO = 32 * KROW, G_LIST = 2 * 32 * KROW, G_CNT = G_LIST + 32 * 256;
    const int own = qb;
    const size_t rowq = (size_t)b * SEQ + qb * 256 + wid * 32 + r32;
    bf16x8 qg[4];
#pragma unroll
    for (int ks = 0; ks < 4; ++ks) qg[ks] = *(const bf16x8*)(P + rowq * DINP + C_BQ + h * 64 + ks * 16 + hi * 8);
    {
        const int n = tid >> 4, d0 = (tid & 15) * 4;
        pg8::f32x4 v = {0.f, 0.f, 0.f, 0.f};
        if (n < own) v = *(const pg8::f32x4*)(kmean + ((size_t)bh * 32 + n) * 64 + d0);
        unsigned hw[2], lw[2];
#pragma unroll
        for (int e = 0; e < 2; ++e) { const unsigned hp = cvtpk(v[2 * e], v[2 * e + 1]);
            const float r0 = v[2 * e] - __builtin_bit_cast(float, hp << 16), r1 = v[2 * e + 1] - __builtin_bit_cast(float, hp & 0xffff0000u);
            hw[e] = hp; lw[e] = cvtpk(r0, r1); }
        typedef unsigned u32x2g __attribute__((ext_vector_type(2)));
        *(LAS u32x2g*)(lds + n * KROW + d0 * 2) = u32x2g{hw[0], hw[1]}; *(LAS u32x2g*)(lds + G_LO + n * KROW + d0 * 2) = u32x2g{lw[0], lw[1]};
        if (tid < 32) ((LAS int*)(lds + G_CNT))[tid] = 0;
    }
    __syncthreads();
    f32x16 p;
#pragma unroll
    for (int r = 0; r < 16; ++r) p[r] = zf_();
    { LAS const unsigned char* a = lds + r32 * KROW + hi * 16;
#pragma unroll
      for (int ks = 0; ks < 4; ++ks) { p = __builtin_amdgcn_mfma_f32_32x32x16_bf16(*(LAS const bf16x8*)(a + ks * 32), qg[ks], p, 0, 0, 0);
          p = __builtin_amdgcn_mfma_f32_32x32x16_bf16(*(LAS const bf16x8*)(a + G_LO + ks * 32), qg[ks], p, 0, 0, 0); } }
    float b0 = -3e38f, b1 = -3e38f, b2 = -3e38f; int i0 = -1, i1 = -1, i2 = -1;
#pragma unroll
    for (int r = 0; r < 16; ++r) { const int n = crow(r, hi); const bool valid = n < own; const float a = p[r];
        const bool g0 = valid && (a > b0 || (a == b0 && n < i0)), g1 = valid && (a > b1 || (a == b1 && n < i1)), g2 = valid && (a > b2 || (a == b2 && n < i2));
        b2 = g1 ? b1 : (g2 ? a : b2); i2 = g1 ? i1 : (g2 ? n : i2);
        b1 = g0 ? b0 : (g1 ? a : b1); i1 = g0 ? i0 : (g1 ? n : i1);
        b0 = g0 ? a : b0; i0 = g0 ? n : i0; }
    {
        float pb[3]; int pi[3];
        pb[0] = shx<32>(b0); pb[1] = shx<32>(b1); pb[2] = shx<32>(b2);
        pi[0] = __builtin_bit_cast(int, shx<32>(__builtin_bit_cast(float, i0))); pi[1] = __builtin_bit_cast(int, shx<32>(__builtin_bit_cast(float, i1))); pi[2] = __builtin_bit_cast(int, shx<32>(__builtin_bit_cast(float, i2)));
#pragma unroll
        for (int k = 0; k < 3; ++k) { const float a = pb[k]; const int n = pi[k];
            const bool valid = n >= 0;
            const bool g0 = valid && (a > b0 || (a == b0 && n < i0)), g1 = valid && (a > b1 || (a == b1 && n < i1)), g2 = valid && (a > b2 || (a == b2 && n < i2));
            b2 = g1 ? b1 : (g2 ? a : b2); i2 = g1 ? i1 : (g2 ? n : i2);
            b1 = g0 ? b0 : (g1 ? a : b1); i1 = g0 ? i0 : (g1 ? n : i1);
            b0 = g0 ? a : b0; i0 = g0 ? n : i0; }
    }
    unsigned mask = 0u;
    if (i0 >= 0) mask |= 1u << i0;
    if (i1 >= 0) mask |= 1u << i1;
    if (i2 >= 0) mask |= 1u << i2;
    if (hi == 0) {
        SELB[(size_t)bh * SEQ + qb * 256 + wid * 32 + r32] = mask;
        LAS int* cn = (LAS int*)(lds + G_CNT); LAS unsigned char* ls = lds + G_LIST; const unsigned char me = (unsigned char)(wid * 32 + r32);
        if (i0 >= 0) { const int pos = __hip_atomic_fetch_add(cn + i0, 1, __ATOMIC_RELAXED, __HIP_MEMORY_SCOPE_WORKGROUP); ls[i0 * 256 + pos] = me; }
        if (i1 >= 0) { const int pos = __hip_atomic_fetch_add(cn + i1, 1, __ATOMIC_RELAXED, __HIP_MEMORY_SCOPE_WORKGROUP); ls[i1 * 256 + pos] = me; }
        if (i2 >= 0) { const int pos = __hip_atomic_fetch_add(cn + i2, 1, __ATOMIC_RELAXED, __HIP_MEMORY_SCOPE_WORKGROUP); ls[i2 * 256 + pos] = me; }
    }
    __syncthreads();
    {
        unsigned char* lg = LISTG + ((size_t)bh * 32 + qb) * 32 * 256;
        *(u32x4v*)(lg + tid * 16) = *(LAS const u32x4v*)(lds + G_LIST + tid * 16);
        if (tid < 32) CNTQ[((size_t)bh * 32 + qb) * 32 + tid] = ((LAS const int*)(lds + G_CNT))[tid];
    }
    __syncthreads();
}
__device__ __forceinline__ unsigned char* moba_part(bf16* P, size_t token, int h, int slot) { return (unsigned char*)(P + token * DINP) + h * 512 + slot * 136; }
constexpr int MK_TAB_OFF = 4 * STG;
__device__ __forceinline__ void moba_kv_chunk(bf16* __restrict__ P, const unsigned* __restrict__ SELB, const int* __restrict__ CNTQ, const unsigned char* __restrict__ LISTG, float kmax,
                                              int bh, int n, int c, int tid, LAS unsigned char* lds) {
    asm volatile("" : "+v"(tid));
    const int lane = tid & 63, wid = __builtin_amdgcn_readfirstlane(tid >> 6), r32 = lane & 31, hi = lane >> 5, b = bh >> 2, h = bh & 3;
    bf16* Pb = P + (size_t)b * SEQ * DINP;
    LAS int* tab = (LAS int*)(lds + MK_TAB_OFF);
    {
        const bf16* ksrc = Pb + (size_t)(n * 256) * DINP + C_BK + h * 64; const bf16* vsrc = Pb + (size_t)(n * 256) * DINP + C_BV + h * 64;
        u32x4v kr[4], vr[4];
#pragma unroll
        for (int s = 0; s < 4; ++s) { kr[s] = kv_load(ksrc + (size_t)s * 64 * DINP, DINP, tid); vr[s] = kv_load(vsrc + (size_t)s * 64 * DINP, DINP, tid); }
        if (tid < 32) { const int cq = (tid > n) ? CNTQ[((size_t)bh * 32 + tid) * 32 + n] : 0; tab[tid] = (cq + 31) >> 5; tab[32 + tid] = cq; }
#pragma unroll
        for (int s = 0; s < 4; ++s) { *(LAS u32x4v*)(lds + s * STG + (tid >> 3) * KROW + (tid & 7) * 16) = kr[s]; *(LAS u32x4v*)(lds + s * STG + KBUF + (tid >> 3) * VROW + (tid & 7) * 16) = vr[s]; }
    }
    __syncthreads();
    if (tid < 16) { const int ord = 16 * c + tid; int qb = -1, j = 0, acc = 0;
        for (int q = n + 1; q < 32; ++q) { const int t = tab[q]; if (qb < 0 && ord < acc + t) { qb = q; j = ord - acc; } acc += t; }
        tab[64 + tid] = qb < 0 ? -1 : ((qb << 8) | j); }
    __syncthreads();
    int codeR[2], cntR[2]; bool validR[2]; size_t tokR[2]; bf16x8 qraw[2][4]; unsigned mrowR[2];
#pragma unroll
    for (int r = 0; r < 2; ++r) { const int code = tab[64 + 8 * r + wid]; codeR[r] = code;
        const int qb = code < 0 ? n + 1 : (code >> 8), j = code < 0 ? 0 : (code & 255);
        const int cnt = code < 0 ? 1 : tab[32 + (qb & 31)], idx = j * 32 + r32; cntR[r] = cnt; validR[r] = (code >= 0) && (idx < cnt);
        const int li = validR[r] ? idx : (cnt - 1);
        const int row = LISTG[(((size_t)bh * 32 + (qb & 31)) * 32 + n) * 256 + li];
        tokR[r] = (size_t)b * SEQ + (qb & 31) * 256 + row; }
#pragma unroll
    for (int r = 0; r < 2; ++r) {
#pragma unroll
        for (int ks = 0; ks < 4; ++ks) qraw[r][ks] = *(const bf16x8*)(P + tokR[r] * DINP + C_BQ + h * 64 + ks * 16 + hi * 8);
        mrowR[r] = SELB[(size_t)bh * SEQ + (tokR[r] - (size_t)b * SEQ)]; }
#pragma unroll
    for (int r = 0; r < 2; ++r) {
        if (codeR[r] < 0) continue;
        const bool valid = validR[r]; const size_t token = tokR[r]; const unsigned mrow = mrowR[r];
        bf16x8 qf[4];
#pragma unroll
        for (int ks = 0; ks < 4; ++ks) qf[ks] = scale_frag(qraw[r][ks], SCL2);
        const float negm = row_negm(qf, kmax);
        f32x16 o0, o1; float l = 0.f;
#pragma unroll
        for (int q = 0; q < 16; ++q) { o0[q] = zf_(); o1[q] = o0[q]; }
        {
            f32x16 pa0, pa1, pb0, pb1;
            qk_tile(pa0, pa1, lds, qf, r32, hi, negm);
            attn_slices<true>(lds + 1 * STG, lds + 0 * STG + KBUF, qf, negm, pa0, pa1, pb0, pb1, o0, o1, l, lane, r32, hi);
            attn_slices<true>(lds + 2 * STG, lds + 1 * STG + KBUF, qf, negm, pb0, pb1, pa0, pa1, o0, o1, l, lane, r32, hi);
            attn_slices<true>(lds + 3 * STG, lds + 2 * STG + KBUF, qf, negm, pa0, pa1, pb0, pb1, o0, o1, l, lane, r32, hi);
            attn_slices<false>(lds, lds + 3 * STG + KBUF, qf, 0.f, pb0, pb1, pa0, pa1, o0, o1, l, lane, r32, hi);
        }
        l += shx<32>(l);
        if (valid) { unsigned char* pp = moba_part(P, token, h, __popc(mrow & ((1u << n) - 1u)));
#pragma unroll
            for (int g = 0; g < 4; ++g) { uint2 w0, w1;
                w0.x = cvtpk(o0[4 * g], o0[4 * g + 1]); w0.y = cvtpk(o0[4 * g + 2], o0[4 * g + 3]); w1.x = cvtpk(o1[4 * g], o1[4 * g + 1]); w1.y = cvtpk(o1[4 * g + 2], o1[4 * g + 3]);
                *(uint2*)(pp + (8 * g + 4 * hi) * 2) = w0; *(uint2*)(pp + (32 + 8 * g + 4 * hi) * 2) = w1; }
            if (hi == 0) *(float*)(pp + 128) = l; }
    }
    __syncthreads();
}
struct MobaOwnPol {
    int ws, wmax, nt, nmask, stride, own, tq, hi; const bf16* Pk; const bf16* Pv;
    __device__ __forceinline__ const bf16* kptr(int i) const { return Pk + (size_t)(own * 4 + i) * 64 * DINP; }
    __device__ __forceinline__ const bf16* vptr(int i) const { return Pv + (size_t)(own * 4 + i) * 64 * DINP; }
    __device__ __forceinline__ bool active(int i) const { return i <= wmax; }
    __device__ __forceinline__ bool rowsel(int) const { return true; }
    __device__ __forceinline__ void mask(int i, f32x16& p0, f32x16& p1) const { const int kbase = (own * 4 + i) * 64;
        const float ng = nbg;
#pragma unroll
        for (int r = 0; r < 16; ++r) { const int k0 = kbase + crow(r, hi); p0[r] = (k0 <= tq) ? p0[r] : ng; p1[r] = (k0 + 32 <= tq) ? p1[r] : ng; } }
};
__device__ __forceinline__ void xcd_split_wait(unsigned* bar, unsigned round, const int tid_, const unsigned co = 0u);
__device__ __forceinline__ void moba_merge_unit(bf16* __restrict__ P, const unsigned* __restrict__ SELB, float kmax, bf16* __restrict__ MIX, int b, int h, int qb, int tid, LAS unsigned char* lds, int wave_s, unsigned* wbar = nullptr, unsigned wround = 0u) {
    asm volatile("" : "+v"(tid));
    const int lane = tid & 63, wid = __builtin_amdgcn_readfirstlane(tid >> 6), r32 = lane & 31, hi = lane >> 5, bh = b * 4 + h;
    const int tq = qb * 256 + wid * 32 + r32;
    const size_t rowq = (size_t)b * SEQ + tq;
    const bf16* Pb = P + (size_t)b * SEQ * DINP;
    bf16x8 qf[4];
#pragma unroll
    for (int ks = 0; ks < 4; ++ks) qf[ks] = scale_frag(*(const bf16x8*)(P + rowq * DINP + C_BQ + h * 64 + ks * 16 + hi * 8), SCL2);
    f32x16 o0, o1;
#pragma unroll
    for (int r = 0; r < 16; ++r) { o0[r] = zf_(); o1[r] = o0[r]; }
    float l = 0.f;
    { MobaOwnPol pol; pol.ws = wave_s; pol.wmax = wid >> 1; pol.nt = 4; pol.nmask = 4; pol.stride = DINP; pol.own = qb; pol.tq = tq; pol.hi = hi; pol.Pk = Pb + C_BK + h * 64; pol.Pv = Pb + C_BV + h * 64;
      attn_pipe(pol, lds, qf, row_negm(qf, kmax), o0, o1, l, tid); }
    l += shx<32>(l);
    if (wbar) xcd_split_wait(wbar, wround, mk_tid(wave_s), 1152u  );
    int t2 = mk_tid(wave_s);
    const int l2 = t2 & 63, r2 = l2 & 31, h2 = l2 >> 5, w2 = t2 >> 6;
    const size_t token = (size_t)b * SEQ + qb * 256 + w2 * 32 + r2;
    const int ns = __popc(SELB[(size_t)bh * SEQ + qb * 256 + w2 * 32 + r2]);
    {
        uint2 w0[3][4], w1[3][4]; float lp[3];
#pragma unroll
        for (int s = 0; s < 3; ++s) { const unsigned char* pp = moba_part(P, token, h, s < ns ? s : 0);
#pragma unroll
            for (int g = 0; g < 4; ++g) { w0[s][g] = *(const uint2*)(pp + (8 * g + 4 * h2) * 2); w1[s][g] = *(const uint2*)(pp + (32 + 8 * g + 4 * h2) * 2); }
            lp[s] = *(const float*)(pp + 128); }
#pragma unroll
        for (int s = 0; s < 3; ++s) { const unsigned km = s < ns ? 0xffffffffu : 0u;
#pragma unroll
            for (int g = 0; g < 4; ++g) { const unsigned ax = w0[s][g].x & km, ay = w0[s][g].y & km, bx = w1[s][g].x & km, by = w1[s][g].y & km;
                o0[4 * g] += __builtin_bit_cast(float, ax << 16); o0[4 * g + 1] += __builtin_bit_cast(float, ax & 0xffff0000u); o0[4 * g + 2] += __builtin_bit_cast(float, ay << 16); o0[4 * g + 3] += __builtin_bit_cast(float, ay & 0xffff0000u);
                o1[4 * g] += __builtin_bit_cast(float, bx << 16); o1[4 * g + 1] += __builtin_bit_cast(float, bx & 0xffff0000u); o1[4 * g + 2] += __builtin_bit_cast(float, by << 16); o1[4 * g + 3] += __builtin_bit_cast(float, by & 0xffff0000u); }
            l += s < ns ? lp[s] : 0.f; }
    }
    const float inv = rcpf_(l);
    bf16* op = MIX + token * DM + 512 + h * 64 + 4 * h2;
#pragma unroll
    for (int g = 0; g < 4; ++g) {
        uint2 w0, w1;
        w0.x = cvtpk(o0[4 * g] * inv, o0[4 * g + 1] * inv); w0.y = cvtpk(o0[4 * g + 2] * inv, o0[4 * g + 3] * inv);
        w1.x = cvtpk(o1[4 * g] * inv, o1[4 * g + 1] * inv); w1.y = cvtpk(o1[4 * g + 2] * inv, o1[4 * g + 3] * inv);
        *(uint2*)(op + 8 * g) = w0; *(uint2*)(op + 32 + 8 * g) = w1;
    }
}
constexpr int MK_ENUM_OFF = 4 * STG + 512;
__device__ __forceinline__ void moba_kv_phase(bf16* __restrict__ P, const unsigned* __restrict__ SELB, const int* __restrict__ CNTQ, const unsigned char* __restrict__ LISTG, const float* __restrict__ kgain,
                                              unsigned* __restrict__ queue, int tid, LAS unsigned char* lds) {
    asm volatile("" : "+v"(tid));
    LAS int* nch = (LAS int*)(lds + MK_ENUM_OFF);
    const float kmax = gain_kmax(kgain, tid & 63);
    { const int bh = tid >> 5, n = tid & 31; int T = 0;
      int cq[31];
#pragma unroll
      for (int q = 1; q < 32; ++q) cq[q - 1] = CNTQ[((size_t)bh * 32 + q) * 32 + n];
#pragma unroll
      for (int q = 1; q < 32; ++q) T += (q > n) ? ((cq[q - 1] + 31) >> 5) : 0;
      nch[tid] = (T + 15) >> 4; }
    __syncthreads();
    if (tid < 64) {
        int v[8], s = 0;
#pragma unroll
        for (int k = 0; k < 8; ++k) { s += nch[tid * 8 + k]; v[k] = s; }
        int incl = s;
#pragma unroll
        for (int o = 1; o < 64; o <<= 1) { const int t = __shfl_up(incl, o); if (tid >= o) incl += t; }
        const int base = incl - s;
#pragma unroll
        for (int k = 0; k < 8; ++k) nch[tid * 8 + k] = v[k] + base; }
    __syncthreads();
    const int total = nch[511];
    LAS int* qs = (LAS int*)(lds + MK_ENUM_OFF + 2048);
    int nxt = 0;
    if (tid == 0) nxt = (int)__hip_atomic_fetch_add(queue, 1u, __ATOMIC_RELAXED, __HIP_MEMORY_SCOPE_AGENT);
    for (int it = 0;; ++it) {
        if (tid == 0) { qs[it & 1] = nxt; nxt = (int)__hip_atomic_fetch_add(queue, 1u, __ATOMIC_RELAXED, __HIP_MEMORY_SCOPE_AGENT); }
        __syncthreads();
        const int cid = __builtin_amdgcn_readfirstlane(qs[it & 1]);
        if (cid >= total) break;
        int lo = 0, hi_ = 511; while (lo < hi_) { const int mid = (lo + hi_) >> 1; if (nch[mid] > cid) hi_ = mid; else lo = mid + 1; }
        const int pair = lo, c = cid - (pair ? nch[pair - 1] : 0);
        moba_kv_chunk(P, SELB, CNTQ, LISTG, kmax, pair >> 5, pair & 31, c, tid, lds);
    }
    __syncthreads();
}

constexpr int NSA_S4_OFF = PIPE_BYTES, NSA_L4_OFF = NSA_S4_OFF + 8 * 8 * 128 * 4, NSA_SM_OFF = NSA_L4_OFF + 8 * 8 * 128 * 4;
struct NsaCtx { const bf16* Pb; const bf16* Kcb; const bf16* Vcb; int b, jq, tid, lane, wid, r32, hi, tq; unsigned mk0, mk1, mk2, mk3; };

template <int MODE>
__device__ __forceinline__ void nsa_tiles(const NsaCtx& c, LAS unsigned char* lds, const bf16x8 (&qf)[4], int nt, f32x16& o0, f32x16& o1, float& m, float& l, float pre) {
    const int tid = c.tid, lane = c.lane, r32 = c.r32, hi = c.hi, tq = c.tq, jq = c.jq;
    const int nw = (jq < 8 ? jq : 8) + 1;
    auto tile_of = [&](int i) -> int { return MODE < 2 ? i : (i == 0 ? jq : (MODE == 2 ? i - 1 : jq - nw + i)); };
    auto src_of = [&](int t) -> TileSrc {
        if (MODE < 2) return TileSrc{c.Kcb + (size_t)t * 64 * 64, c.Vcb + (size_t)t * 64 * 64, 64};
        if (MODE == 2) return TileSrc{c.Pb + (size_t)t * 64 * DINP + C_NKS, c.Pb + (size_t)t * 64 * DINP + C_NVS, DINP};
        return TileSrc{c.Pb + (size_t)t * 64 * DINP + C_NKW, c.Pb + (size_t)t * 64 * DINP + C_NVW, DINP};
    };
    u32x4v kA, vA, kB, vB;
    if (MODE == 1) {
        kA = u32x4v{0u, 0u, 0u, 0u}; vA = kA; kB = kA; vB = kA;
        if (nt >= 3) { const TileSrc s = src_of(nt - 3); tile_load(kA, vA, s, tid); }
        if (nt >= 4) { const TileSrc s = src_of(nt - 4); tile_load(kB, vB, s, tid); }
    } else {
    { const TileSrc s = src_of(tile_of(0)); tile_load(kA, vA, s, tid); }
    kB = kA; vB = vA;
    if (1 < nt) { const TileSrc s = src_of(tile_of(1)); tile_load(kB, vB, s, tid); }
    tile_store(lds, kA, vA, tid);
    if (2 < nt) { const TileSrc s = src_of(tile_of(2)); tile_load(kA, vA, s, tid); }
    __syncthreads();
    }
    const int ncv = (tq >= 31) ? ((tq - 31) >> 4) + 1 : 0;
    const int tq0 = jq * 64 + c.wid * 8, ncvmin = (tq0 >= 31) ? ((tq0 - 31) >> 4) + 1 : 0;
    auto compute = [&](const int i) {
        const int tile = tile_of(i);
        LAS const unsigned char* buf = lds + (i & 1) * STG;
        const int kbase = tile * 64;
        bool rowsel = true;
        if (MODE == 2 && tile != jq) { const unsigned w = (tile >> 5) == 0 ? c.mk0 : (tile >> 5) == 1 ? c.mk1 : (tile >> 5) == 2 ? c.mk2 : c.mk3; rowsel = (w >> (tile & 31)) & 1u; }
        if (MODE != 2 || __any(rowsel)) {
            f32x16 p0, p1;
            qk_tile(p0, p1, buf, qf, r32, hi, MODE < 2 ? m : (rowsel ? -m : NEGBIG));
            if (MODE < 2) {
                if (kbase + 64 > ncvmin) {
#pragma unroll
                for (int r = 0; r < 16; ++r) { const int k0 = kbase + crow(r, hi); p0[r] = (k0 < ncv) ? p0[r] : NEGBIG; p1[r] = (k0 + 32 < ncv) ? p1[r] : NEGBIG; } }
            } else if (MODE == 2) {
                if (tile == jq) {
#pragma unroll
                    for (int r = 0; r < 16; ++r) { const int k0 = kbase + crow(r, hi); p0[r] = (k0 <= tq) ? p0[r] : NEGBIG; p1[r] = (k0 + 32 <= tq) ? p1[r] : NEGBIG; }
                }
            } else if (tile == jq || tile + 8 == jq) {
#pragma unroll
                for (int r = 0; r < 16; ++r) { const int k0 = kbase + crow(r, hi);
                    p0[r] = (k0 <= tq && k0 + 511 >= tq) ? p0[r] : NEGBIG; p1[r] = (k0 + 32 <= tq && k0 + 32 + 511 >= tq) ? p1[r] : NEGBIG; }
            }
            if (MODE == 0) {
                float s0 = 0.f, s1 = 0.f;
#pragma unroll
                for (int r = 0; r < 16; ++r) { s0 += __builtin_amdgcn_exp2f(p0[r]); s1 += __builtin_amdgcn_exp2f(p1[r]); }
                l += s0 + s1;
            } else if (MODE == 1) {
#pragma unroll
                for (int r = 0; r < 16; ++r) { p0[r] = __builtin_amdgcn_exp2f(p0[r]) * pre; p1[r] = __builtin_amdgcn_exp2f(p1[r]) * pre; }
                pv_tile(o0, o1, buf + KBUF, p0, p1, lane);
                LAS float* S4 = (LAS float*)(lds + NSA_S4_OFF) + (c.wid * 8 + (r32 & 7)) * 128; LAS float* L4 = (LAS float*)(lds + NSA_L4_OFF) + (c.wid * 8 + (r32 & 7)) * 128;
                float s4v[8], lav[8];
#pragma unroll
                for (int mbk = 0; mbk < 2; ++mbk)
#pragma unroll
                    for (int g = 0; g < 4; ++g) {
                        s4v[mbk * 4 + g] = mbk ? (p1[4 * g] + p1[4 * g + 1]) + (p1[4 * g + 2] + p1[4 * g + 3]) : (p0[4 * g] + p0[4 * g + 1]) + (p0[4 * g + 2] + p0[4 * g + 3]);
                        lav[mbk * 4 + g] = mbk ? p1[4 * g + 3] : p0[4 * g + 3]; }
#pragma unroll
                for (int q = 0; q < 8; ++q) { s4v[q] += shx<8>(s4v[q]); lav[q] += shx<8>(lav[q]); }
#pragma unroll
                for (int q = 0; q < 8; ++q) { s4v[q] += shx<16>(s4v[q]); lav[q] += shx<16>(lav[q]); }
                if (r32 < 8) {
#pragma unroll
                    for (int q = 0; q < 8; ++q) { const int gi = tile * 16 + 8 * (q >> 2) + 2 * (q & 3) + hi; S4[gi] = s4v[q]; L4[gi] = lav[q]; } }
            } else {
                softmax_tile(p0, p1, o0, o1, m, l, i == 0);
                pv_tile(o0, o1, buf + KBUF, p0, p1, lane);
            }
        }
    };
    if (MODE == 1) {
        for (int i = 0; i < nt; i += 2) {
            const int t = nt - 1 - i;
            compute(t);
            __syncthreads();
            if (t >= 2) { tile_store(lds + (t & 1) * STG, kA, vA, tid); if (t >= 4) { const TileSrc s = src_of(t - 4); tile_load(kA, vA, s, tid); } }
            if (i + 1 < nt) { const int t2 = t - 1;
                compute(t2);
                __syncthreads();
                if (t2 >= 2) { tile_store(lds + (t2 & 1) * STG, kB, vB, tid); if (t2 >= 4) { const TileSrc s = src_of(t2 - 4); tile_load(kB, vB, s, tid); } } }
        }
        return;
    }
    for (int i = 0; i < nt; i += 2) {
        compute(i);
        if (i + 1 < nt) tile_store(lds + STG, kB, vB, tid);
        if (i + 3 < nt) { const TileSrc s = src_of(tile_of(i + 3)); tile_load(kB, vB, s, tid); }
        __syncthreads();
        if (i + 1 < nt) {
            compute(i + 1);
            if (i + 2 < nt) tile_store(lds, kA, vA, tid);
            if (i + 4 < nt) { const TileSrc s = src_of(tile_of(i + 4)); tile_load(kA, vA, s, tid); }
            __syncthreads();
        }
    }
}

struct NsaSelPol {
    int ws, nt, nmask, stride, jq, tq, hi; unsigned long long mlo, mhi; const bf16* Pk; const bf16* Pv;
    __device__ __forceinline__ int tile_of(int i) const { return i == 0 ? jq : i - 1; }
    __device__ __forceinline__ const bf16* kptr(int i) const { return Pk + (size_t)tile_of(i) * 64 * DINP; }
    __device__ __forceinline__ const bf16* vptr(int i) const { return Pv + (size_t)tile_of(i) * 64 * DINP; }
    __device__ __forceinline__ bool active(int) const { return true; }
    __device__ __forceinline__ bool rowsel(int i) const { if (i == 0) return true; const int tile = i - 1; const unsigned long long w = tile < 64 ? mlo : mhi; return (w >> (tile & 63)) & 1ull; }
    __device__ __forceinline__ void mask(int i, f32x16& p0, f32x16& p1) const {
        if (i == 0) { const int kbase = jq * 64;
#pragma unroll
            for (int r = 0; r < 16; ++r) { const int k0 = kbase + crow(r, hi); p0[r] = (k0 <= tq) ? p0[r] : NEGBIG; p1[r] = (k0 + 32 <= tq) ? p1[r] : NEGBIG; } }
    }
};
struct NsaWinPol {
    int ws, nt, nmask, stride, jq, tq, hi; const bf16* Pk; const bf16* Pv;
    __device__ __forceinline__ int tile_of(int i) const { return i == 0 ? jq : jq - nt + i; }
    __device__ __forceinline__ const bf16* kptr(int i) const { return Pk + (size_t)tile_of(i) * 64 * DINP; }
    __device__ __forceinline__ const bf16* vptr(int i) const { return Pv + (size_t)tile_of(i) * 64 * DINP; }
    __device__ __forceinline__ bool active(int) const { return true; }
    __device__ __forceinline__ bool rowsel(int) const { return true; }
    __device__ __forceinline__ void mask(int i, f32x16& p0, f32x16& p1) const {
        const int tile = tile_of(i);
        if (tile == jq || tile + 8 == jq) { const int kbase = tile * 64;
#pragma unroll
            for (int r = 0; r < 16; ++r) { const int k0 = kbase + crow(r, hi);
                p0[r] = (k0 <= tq && k0 + 511 >= tq) ? p0[r] : NEGBIG; p1[r] = (k0 + 32 <= tq && k0 + 32 + 511 >= tq) ? p1[r] : NEGBIG; } }
    }
};
__device__ __forceinline__ void nsa_unit(const bf16* __restrict__ P, const float* __restrict__ G, const float* __restrict__ tab, const bf16* __restrict__ KVcb, const float* __restrict__ kgain  , bf16* __restrict__ MIX,
                                         int b, int jq, int tid, LAS unsigned char* lds, int wave_s) {
    asm volatile("" : "+v"(tid));
    NsaCtx c; c.b = b; c.jq = jq; c.tid = tid; c.lane = tid & 63; c.wid = __builtin_amdgcn_readfirstlane(tid >> 6); c.r32 = c.lane & 31; c.hi = c.lane >> 5;
    const int qi = c.r32 & 7, hh = c.r32 >> 3, hi = c.hi, lane = c.lane;
    c.tq = jq * 64 + c.wid * 8 + qi;
    c.Pb = P + (size_t)b * SEQ * DINP; c.Kcb = KVcb + (size_t)b * 512 * 64; c.Vcb = KVcb + ((size_t)NB + b) * 512 * 64;
    c.mk0 = c.mk1 = c.mk2 = c.mk3 = 0u;
    const size_t rowq = (size_t)b * SEQ + c.tq;
    bf16x8 qf[4];
#pragma unroll
    for (int ks = 0; ks < 4; ++ks) qf[ks] = scale_frag(*(const bf16x8*)(P + rowq * DINP + C_NQ + hh * 64 + ks * 16 + hi * 8), SCL2);
    const float g0 = sigmoidf_(G[rowq * 32 + 8 + hh]);
    { LAS float* gl = (LAS float*)(lds + NSA_SM_OFF + 1024); gl[tid] = sigmoidf_(G[rowq * 32 + 12 + hh]); gl[512 + tid] = sigmoidf_(G[rowq * 32 + 16 + hh]); }
    f32x16 a0, a1;
    {
        const int ncvmax = min(4 * jq + 3, NCMP), nct = (ncvmax + 63) >> 6;
        f32x16 o0, o1;
#pragma unroll
        for (int r = 0; r < 16; ++r) { o0[r] = zf_(); o1[r] = o0[r]; }
        float m = row_negm(qf, gain_kmax(kgain, lane)), l = 0.f;
#ifdef PROBE_CMP
        { f32x16 t0 = o0, t1 = o1; float tm = m, tl = l; nsa_tiles<0>(c, lds, qf, nct, t0, t1, tm, tl, 0.f); tl += shx<32>(tl); nsa_tiles<1>(c, lds, qf, nct, t0, t1, tm, tl, tl > 0.f ? rcpf_(tl) : 0.f); asm volatile("" :: "v"(t0), "v"(t1)); }
#endif
        nsa_tiles<0>(c, lds, qf, nct, o0, o1, m, l, 0.f);
        l += shx<32>(l);
        const float pre = (l > 0.f) ? rcpf_(l) : 0.f;
        nsa_tiles<1>(c, lds, qf, nct, o0, o1, m, l, pre);
#pragma unroll
        for (int r = 0; r < 16; ++r) { a0[r] = g0 * o0[r]; a1[r] = g0 * o1[r]; }
    }
    u32x4v selpre[3];
    { const bf16* pk_ = c.Pb + C_NKS; const bf16* pv_ = c.Pb + C_NVS;
      selpre[0] = kv_load(pk_ + (size_t)jq * 64 * DINP, DINP, tid); selpre[1] = kv_load(pv_ + (size_t)jq * 64 * DINP, DINP, tid); selpre[2] = kv_load(pk_, DINP, tid); }
    {
        LAS unsigned* sm = (LAS unsigned*)(lds + NSA_SM_OFF);
        unsigned u0[8], u1[8];
#pragma unroll
        for (int q = 0; q < 8; ++q) {
            LAS const float* S4 = (LAS const float*)(lds + NSA_S4_OFF) + (c.wid * 8 + q) * 128; LAS const float* L4 = (LAS const float*)(lds + NSA_L4_OFF) + (c.wid * 8 + q) * 128;
            const int n0 = lane, n1 = lane + 64;
            const float s0 = S4[n0], l0 = L4[n0 > 0 ? n0 - 1 : 0], s1 = S4[n1], l1 = L4[n1 - 1];
            const bool causal0 = n0 <= jq, forced0 = causal0 && (n0 == 0 || n0 >= jq - 1), causal1 = n1 <= jq, forced1 = causal1 && (n1 >= jq - 1);
            const float v0 = forced0 ? 1e9f : (causal0 ? s0 + (n0 > 0 ? l0 : 0.f) : -1e30f), v1 = forced1 ? 1e9f : (causal1 ? s1 + l1 : -1e30f);
            const unsigned b0_ = __float_as_uint(v0), b1_ = __float_as_uint(v1);
            u0[q] = b0_ ^ ((b0_ >> 31) ? 0xFFFFFFFFu : 0x80000000u); u1[q] = b1_ ^ ((b1_ >> 31) ? 0xFFFFFFFFu : 0x80000000u);
        }
        unsigned T[8];
#pragma unroll
        for (int q = 0; q < 8; ++q) T[q] = 0u;
#pragma unroll
        for (int bit = 31; bit >= 0; --bit) {
#pragma unroll
            for (int q = 0; q < 8; ++q) { const unsigned cand = T[q] | (1u << bit);
                const int cn = __popcll(__ballot(u0[q] >= cand)) + __popcll(__ballot(u1[q] >= cand));
                if (cn >= 16) T[q] = cand; } }
#pragma unroll
        for (int q = 0; q < 8; ++q) {
            const unsigned long long g0b = __ballot(u0[q] > T[q]), g1b = __ballot(u1[q] > T[q]), e0b = __ballot(u0[q] == T[q]), e1b = __ballot(u1[q] == T[q]);
            const int rem = 16 - (__popcll(g0b) + __popcll(g1b));
            const unsigned long long ltm = (1ull << lane) - 1ull;
            const unsigned long long sel0 = g0b | __ballot(u0[q] == T[q] && __popcll(e0b & ltm) < rem);
            const unsigned long long sel1 = g1b | __ballot(u1[q] == T[q] && __popcll(e0b) + __popcll(e1b & ltm) < rem);
            if (lane == 0) { sm[(c.wid * 8 + q) * 4 + 0] = (unsigned)sel0; sm[(c.wid * 8 + q) * 4 + 1] = (unsigned)(sel0 >> 32); sm[(c.wid * 8 + q) * 4 + 2] = (unsigned)sel1; sm[(c.wid * 8 + q) * 4 + 3] = (unsigned)(sel1 >> 32); }
        }
        __builtin_amdgcn_s_waitcnt(0xc07f); __builtin_amdgcn_wave_barrier();
        c.mk0 = sm[(c.wid * 8 + qi) * 4 + 0]; c.mk1 = sm[(c.wid * 8 + qi) * 4 + 1]; c.mk2 = sm[(c.wid * 8 + qi) * 4 + 2]; c.mk3 = sm[(c.wid * 8 + qi) * 4 + 3];
    }
    LAS float* stash = (LAS float*)(lds + NSA_S4_OFF) + c.wid * 1024 + lane;
    LAS float* stash2 = (LAS float*)(lds + NSA_L4_OFF) + c.wid * 1024 + lane;
#pragma unroll
    for (int r = 0; r < 16; ++r) { stash[r * 64] = a0[r]; stash2[r * 64] = a1[r]; }
    {
        const u32x4v qw = __builtin_bit_cast(u32x4v, qf[0]); u32x4v w;
#pragma unroll
        for (int e = 0; e < 4; ++e) {
            float y[2];
#pragma unroll
            for (int k = 0; k < 2; ++k) { const int j = 2 * e + k; const float x = k ? __builtin_bit_cast(float, qw[e] & 0xffff0000u) : __builtin_bit_cast(float, qw[e] << 16); const float other = shx<32>(x);
                const float cs = tab[c.tq * 16 + j], sn = tab[c.tq * 16 + 8 + j]; y[k] = hi ? (x * cs + other * sn) : (x * cs - other * sn); }
            w[e] = cvtpk(y[0], y[1]);
        }
        qf[0] = __builtin_bit_cast(bf16x8, w);
    }
    {
        f32x16 o0, o1;
#pragma unroll
        for (int r = 0; r < 16; ++r) { o0[r] = zf_(); o1[r] = o0[r]; }
        float l = 0.f;
        NsaSelPol pol; pol.ws = wave_s; pol.nt = jq + 1; pol.nmask = 1; pol.stride = DINP; pol.jq = jq; pol.tq = c.tq; pol.hi = hi; pol.mlo = (unsigned long long)c.mk0 | ((unsigned long long)c.mk1 << 32); pol.mhi = (unsigned long long)c.mk2 | ((unsigned long long)c.mk3 << 32); pol.Pk = c.Pb + C_NKS; pol.Pv = c.Pb + C_NVS;
#ifdef PROBE_SEL
        { attn_pipe(pol, lds, qf, row_negm(qf, gain_kmax(kgain + 64, lane)), o0, o1, l, tid); asm volatile("" : "+v"(o0), "+v"(o1), "+v"(l));
#pragma unroll
          for (int r = 0; r < 16; ++r) { o0[r] = zf_(); o1[r] = o0[r]; } l = zf_(); }
#endif
        attn_pipe(pol, lds, qf, row_negm(qf, gain_kmax(kgain + 64, lane)), o0, o1, l, tid, selpre);
        l += shx<32>(l);
        int t2 = mk_tid(wave_s);
        const float sc = ((LAS const float*)(lds + NSA_SM_OFF + 1024))[t2] * rcpf_(l);
        LAS float* st1 = (LAS float*)(lds + NSA_S4_OFF) + (t2 >> 6) * 1024 + (t2 & 63); LAS float* st2 = (LAS float*)(lds + NSA_L4_OFF) + (t2 >> 6) * 1024 + (t2 & 63);
#pragma unroll
        for (int r = 0; r < 16; ++r) { st1[r * 64] = fmaf(sc, o0[r], st1[r * 64]); st2[r * 64] = fmaf(sc, o1[r], st2[r * 64]); }
    }
    {
        f32x16 o0, o1;
#pragma unroll
        for (int r = 0; r < 16; ++r) { o0[r] = zf_(); o1[r] = o0[r]; }
        float l = 0.f;
        NsaWinPol pol; pol.ws = wave_s; pol.nt = (jq < 8 ? jq : 8) + 1; pol.nmask = 2; pol.stride = DINP; pol.jq = jq; pol.tq = c.tq; pol.hi = hi; pol.Pk = c.Pb + C_NKW; pol.Pv = c.Pb + C_NVW;
#ifdef PROBE_WIN
        { attn_pipe(pol, lds, qf, row_negm(qf, gain_kmax(kgain + 128, lane)), o0, o1, l, tid); asm volatile("" : "+v"(o0), "+v"(o1), "+v"(l));
#pragma unroll
          for (int r = 0; r < 16; ++r) { o0[r] = zf_(); o1[r] = o0[r]; } l = zf_(); }
#endif
        attn_pipe(pol, lds, qf, row_negm(qf, gain_kmax(kgain + 128, lane)), o0, o1, l, tid);
        l += shx<32>(l);
        int t2 = mk_tid(wave_s);
        const float sc = ((LAS const float*)(lds + NSA_SM_OFF + 1024))[512 + t2] * rcpf_(l);
        LAS const float* st1 = (LAS const float*)(lds + NSA_S4_OFF) + (t2 >> 6) * 1024 + (t2 & 63); LAS const float* st2 = (LAS const float*)(lds + NSA_L4_OFF) + (t2 >> 6) * 1024 + (t2 & 63);
#pragma unroll
        for (int r = 0; r < 16; ++r) { a0[r] = fmaf(sc, o0[r], st1[r * 64]); a1[r] = fmaf(sc, o1[r], st2[r * 64]); }
    }
    int t3 = mk_tid(wave_s);
    const int ln3 = t3 & 63, r3 = ln3 & 31;
    bf16* op = MIX + ((size_t)b * SEQ + jq * 64 + (t3 >> 6) * 8 + (r3 & 7)) * DM + 768 + (r3 >> 3) * 64 + 4 * (ln3 >> 5);
#pragma unroll
    for (int g = 0; g < 4; ++g) {
        uint2 w0, w1;
        w0.x = cvtpk(a0[4 * g], a0[4 * g + 1]); w0.y = cvtpk(a0[4 * g + 2], a0[4 * g + 3]);
        w1.x = cvtpk(a1[4 * g], a1[4 * g + 1]); w1.y = cvtpk(a1[4 * g + 2], a1[4 * g + 3]);
        *(uint2*)(op + 8 * g) = w0; *(uint2*)(op + 32 + 8 * g) = w1;
    }
}


constexpr int MQ_PITCH = 272, MV_PITCH = 320;
constexpr int ML_G_OFF = 0;
constexpr int ML_Q_OFF = 4096;
constexpr int ML_K_OFF = ML_Q_OFF + 64 * MQ_PITCH;
constexpr int ML_V_OFF = ML_K_OFF + 64 * MV_PITCH;
constexpr int ML_END = ML_V_OFF + 64 * MV_PITCH;
static_assert(ML_END <= 131072, "mlstm LDS");
constexpr float KSCALE = 0.08838834764831845f;

__device__ __forceinline__ void qk2_rows(const bf16* __restrict__ P, const float* __restrict__ cw, bf16* __restrict__ QK2, int bid, int G, int tid) {
    asm volatile("" : "+v"(tid));
    const int ch = tid & 127, c0 = ch * 8, rg = tid >> 7;
    float tp[4][8];
#pragma unroll
    for (int j = 0; j < 4; ++j) { const float4 a = *(const float4*)(cw + j * 1024 + c0), b4 = *(const float4*)(cw + j * 1024 + c0 + 4);
        tp[j][0] = a.x; tp[j][1] = a.y; tp[j][2] = a.z; tp[j][3] = a.w; tp[j][4] = b4.x; tp[j][5] = b4.y; tp[j][6] = b4.z; tp[j][7] = b4.w; }
    const float sc = (c0 >= 512) ? KSCALE : 1.f;
    constexpr int sub = 32;
    for (int ck = bid * 4 + rg; ck < T / sub; ck += G * 4) { const int r0 = ck * sub;
        u32x4v h0, h1, h2;
        u32x4v wa[8], wb[8];
        { const bool hv = (r0 & (SEQ - 1)) != 0; const u32x4v z = {0u, 0u, 0u, 0u};
          const size_t rb = (size_t)(hv ? r0 - 3 : r0);
          const u32x4v a = *(const u32x4v*)(P + rb * DINP + c0), b = *(const u32x4v*)(P + (rb + 1) * DINP + c0), c = *(const u32x4v*)(P + (rb + 2) * DINP + c0);
#pragma unroll
          for (int q = 0; q < 8; ++q) wa[q] = *(const u32x4v*)(P + (size_t)(r0 + q) * DINP + c0);
          h0 = hv ? a : z; h1 = hv ? b : z; h2 = hv ? c : z; }
#pragma unroll
        for (int rr = 0; rr < sub; rr += 8) {
            u32x4v (&w)[8] = ((rr >> 3) & 1) ? wb : wa; u32x4v (&wn)[8] = ((rr >> 3) & 1) ? wa : wb;
            if (rr + 8 < sub) {
#pragma unroll
                for (int q = 0; q < 8; ++q) wn[q] = *(const u32x4v*)(P + (size_t)(r0 + rr + 8 + q) * DINP + c0); }
#pragma unroll
            for (int q = 0; q < 8; ++q) {
                const u32x4v x0 = q >= 3 ? w[q - 3] : (q == 2 ? h2 : (q == 1 ? h1 : h0)), x1 = q >= 2 ? w[q - 2] : (q == 1 ? h2 : h1), x2 = q >= 1 ? w[q - 1] : h2, x3 = w[q];
                float y[8];
#pragma unroll
                for (int e = 0; e < 4; ++e) {
                    y[2 * e] = fmaf(tp[3][2 * e], __builtin_bit_cast(float, x3[e] << 16), fmaf(tp[2][2 * e], __builtin_bit_cast(float, x2[e] << 16), fmaf(tp[1][2 * e], __builtin_bit_cast(float, x1[e] << 16), tp[0][2 * e] * __builtin_bit_cast(float, x0[e] << 16))));
                    y[2 * e + 1] = fmaf(tp[3][2 * e + 1], __builtin_bit_cast(float, x3[e] & 0xffff0000u), fmaf(tp[2][2 * e + 1], __builtin_bit_cast(float, x2[e] & 0xffff0000u), fmaf(tp[1][2 * e + 1], __builtin_bit_cast(float, x1[e] & 0xffff0000u), tp[0][2 * e + 1] * __builtin_bit_cast(float, x0[e] & 0xffff0000u)))); }
#pragma unroll
                for (int e = 0; e < 8; ++e) y[e] = y[e] * rcpf_(1.f + __expf(-y[e])) * sc;
                u32x4v o; o[0] = cvtpk(y[0], y[1]); o[1] = cvtpk(y[2], y[3]); o[2] = cvtpk(y[4], y[5]); o[3] = cvtpk(y[6], y[7]);
                *(u32x4v*)(QK2 + (size_t)(r0 + rr + q) * 1024 + c0) = o; }
            h0 = w[5]; h1 = w[6]; h2 = w[7];
        }
    }
}

struct MlRaw { u32x4v q[2], k[2], v[2]; float gf, gi; };
template <bool WITH_Q> __device__ __forceinline__ void ml_load(MlRaw& r, const bf16* __restrict__ P, const bf16* __restrict__ QK2, const float* __restrict__ G, const float* __restrict__ bif, int u, int tid) {
    const int c = u & 127, h = (u >> 7) & 3, b = u >> 9, row0 = b * SEQ + c * 64, s = tid >> 3;
#pragma unroll
    for (int pass = 0; pass < 2; ++pass) { const int ch = (tid & 7) + 8 * pass;
        if (WITH_Q) r.q[pass] = *(const u32x4v*)(QK2 + (size_t)(row0 + s) * 1024 + h * 128 + ch * 8);
        r.k[pass] = *(const u32x4v*)(QK2 + (size_t)(row0 + s) * 1024 + 512 + h * 128 + ch * 8);
        r.v[pass] = *(const u32x4v*)(P + (size_t)(row0 + s) * DINP + C_MV + h * 128 + ch * 8); }
    if (tid < 64) { r.gf = G[(size_t)(row0 + tid) * 32 + 4 + h] + bif[4 + h]; r.gi = G[(size_t)(row0 + tid) * 32 + h] + bif[h]; }
}
__device__ __forceinline__ void mlstm_gates(const MlRaw& r, int tid, LAS float* gs) {
    if (tid < 64) { gs[tid] = log_sigmoidf_(r.gf); gs[128 + tid] = r.gi; }
    __syncthreads();
    if (tid < 64) { float a = 0.f; for (int s = 0; s <= tid; ++s) a += gs[s]; gs[64 + tid] = a; }
    __syncthreads();
}

__device__ __forceinline__ void mlstm_m1_phase(const bf16* __restrict__ P, const bf16* __restrict__ QK2, const float* __restrict__ G, const float* __restrict__ bif,
                                               bf16* __restrict__ CT, float* __restrict__ nst, float* __restrict__ dec, int bid, int Gd, int tid, LAS unsigned char* lds) {
    asm volatile("" : "+v"(tid));
    const int lane = tid & 63, wid = __builtin_amdgcn_readfirstlane(tid >> 6), hi = lane >> 5;
    LAS float* gs = (LAS float*)(lds + ML_G_OFF);
    MlRaw raw;
    if (bid < 2048) ml_load<false>(raw, P, QK2, G, bif, bid, tid);
    for (int u = bid; u < 2048; u += Gd) {
        mlstm_gates(raw, tid, gs);
        if (tid == 0) dec[u] = __expf(gs[64 + 63]);
        {
            const int s = tid >> 3; const float ws = __expf(gs[64 + 63] - gs[64 + s] + gs[128 + s]);
#pragma unroll
            for (int pass = 0; pass < 2; ++pass) { const int ch = (tid & 7) + 8 * pass; u32x4v w;
#pragma unroll
                for (int e = 0; e < 4; ++e) w[e] = cvtpk(__builtin_bit_cast(float, raw.k[pass][e] << 16) * ws, __builtin_bit_cast(float, raw.k[pass][e] & 0xffff0000u) * ws);
                *(LAS u32x4v*)(lds + ML_K_OFF + s * MV_PITCH + ch * 16) = w;
                *(LAS u32x4v*)(lds + ML_V_OFF + s * MV_PITCH + ch * 16) = raw.v[pass]; }
        }
        if (u + Gd < 2048) ml_load<false>(raw, P, QK2, G, bif, u + Gd, tid);
        __syncthreads();
        const int g = lane >> 4, i = lane & 15;
        const int mb = wid >> 1, nb0 = 2 * (wid & 1);
        f32x16 acc0, acc1;
#pragma unroll
        for (int r = 0; r < 16; ++r) { acc0[r] = zf_(); acc1[r] = acc0[r]; }
        LAS const unsigned char* trb = lds + (4 * hi + (i >> 2)) * MV_PITCH + (16 * (g & 1) + 4 * (i & 3)) * 2;
#pragma unroll
        for (int ks = 0; ks < 4; ++ks) {
            const s16x4 alo = lds_tr(trb + ML_K_OFF + ks * 16 * MV_PITCH + mb * 64), ahi = lds_tr(trb + ML_K_OFF + ks * 16 * MV_PITCH + 8 * MV_PITCH + mb * 64);
            const bf16x8 af = {alo[0], alo[1], alo[2], alo[3], ahi[0], ahi[1], ahi[2], ahi[3]};
            const s16x4 b0lo = lds_tr(trb + ML_V_OFF + ks * 16 * MV_PITCH + nb0 * 64), b0hi = lds_tr(trb + ML_V_OFF + ks * 16 * MV_PITCH + 8 * MV_PITCH + nb0 * 64);
            const s16x4 b1lo = lds_tr(trb + ML_V_OFF + ks * 16 * MV_PITCH + (nb0 + 1) * 64), b1hi = lds_tr(trb + ML_V_OFF + ks * 16 * MV_PITCH + 8 * MV_PITCH + (nb0 + 1) * 64);
            const bf16x8 bf0 = {b0lo[0], b0lo[1], b0lo[2], b0lo[3], b0hi[0], b0hi[1], b0hi[2], b0hi[3]}, bf1 = {b1lo[0], b1lo[1], b1lo[2], b1lo[3], b1hi[0], b1hi[1], b1hi[2], b1hi[3]};
            acc0 = __builtin_amdgcn_mfma_f32_32x32x16_bf16(af, bf0, acc0, 0, 0, 0);
            acc1 = __builtin_amdgcn_mfma_f32_32x32x16_bf16(af, bf1, acc1, 0, 0, 0);
        }
        bf16* ct = CT + (size_t)u * 16384;
#pragma unroll
        for (int gq = 0; gq < 4; ++gq) { const int d0 = 32 * mb + 8 * gq + 4 * hi;
            uint2 w0, w1; w0.x = cvtpk(acc0[4 * gq], acc0[4 * gq + 1]); w0.y = cvtpk(acc0[4 * gq + 2], acc0[4 * gq + 3]); w1.x = cvtpk(acc1[4 * gq], acc1[4 * gq + 1]); w1.y = cvtpk(acc1[4 * gq + 2], acc1[4 * gq + 3]);
            *(uint2*)(ct + (size_t)(32 * nb0 + (lane & 31)) * 128 + d0) = w0; *(uint2*)(ct + (size_t)(32 * (nb0 + 1) + (lane & 31)) * 128 + d0) = w1; }
        if (tid < 128) { float a = 0.f; for (int s = 0; s < 64; ++s) a += bf2f(*(LAS const bf16*)(lds + ML_K_OFF + s * MV_PITCH + tid * 2)); nst[(size_t)u * 128 + tid] = a; }
        __syncthreads();
    }
}
__device__ __forceinline__ void mlstm_scan(bf16* __restrict__ CT, float* __restrict__ nst, const float* __restrict__ dec, int item, int tid) {
    asm volatile("" : "+v"(tid));
    const int bh = item / 9, part = item % 9;
    if (part < 8) {
        bf16* base = CT + (size_t)bh * 128 * 16384 + (part * 512 + tid) * 4;
        float C[4]; C[0] = zf_(); C[1] = C[0]; C[2] = C[0]; C[3] = C[0];
        for (int c0 = 0; c0 < 128; c0 += 16) {
            uint2 w[16];
#pragma unroll
            for (int k = 0; k < 16; ++k) w[k] = *(const uint2*)(base + (size_t)(c0 + k) * 16384);
#pragma unroll
            for (int k = 0; k < 16; ++k) { const float a = dec[bh * 128 + c0 + k];
                uint2 o; o.x = cvtpk(C[0], C[1]); o.y = cvtpk(C[2], C[3]); *(uint2*)(base + (size_t)(c0 + k) * 16384) = o;
                C[0] = fmaf(a, C[0], __builtin_bit_cast(float, w[k].x << 16)); C[1] = fmaf(a, C[1], __builtin_bit_cast(float, w[k].x & 0xffff0000u));
                C[2] = fmaf(a, C[2], __builtin_bit_cast(float, w[k].y << 16)); C[3] = fmaf(a, C[3], __builtin_bit_cast(float, w[k].y & 0xffff0000u)); }
        }
    } else if (tid < 128) {
        float* base = nst + (size_t)bh * 128 * 128 + tid; float C = 0.f;
        for (int c = 0; c < 128; ++c) { const float dC = base[(size_t)c * 128]; base[(size_t)c * 128] = C; C = dec[bh * 128 + c] * C + dC; }
    }
}

__device__ __forceinline__ void mlstm_m3_phase(const bf16* __restrict__ P, const bf16* __restrict__ QK2, const float* __restrict__ G, const float* __restrict__ bif,
                                               const bf16* __restrict__ CT, const float* __restrict__ nst, const float* __restrict__ mnorm, bf16* __restrict__ MIX, int bid, int Gd, int tid, LAS unsigned char* lds) {
    asm volatile("" : "+v"(tid));
    const int lane = tid & 63, wid = __builtin_amdgcn_readfirstlane(tid >> 6), hi = lane >> 5, r32 = lane & 31;
    LAS float* gs = (LAS float*)(lds + ML_G_OFF);
    MlRaw raw;
    if (bid < 2048) ml_load<true>(raw, P, QK2, G, bif, bid, tid);
    for (int u = bid; u < 2048; u += Gd) {
    const int c = u & 127, h = (u >> 7) & 3, b = u >> 9, t0 = c * 64;
    const int tb = wid & 1, eb = wid >> 1, t = 32 * tb + r32;
    bf16x8 cf[8]; uint2 opre[4]; float npv = 0.f;
    { const bf16* ctp = CT + (size_t)u * 16384 + (size_t)(32 * eb + r32) * 128 + hi * 8;
#pragma unroll
      for (int ks = 0; ks < 8; ++ks) cf[ks] = *(const bf16x8*)(ctp + ks * 16);
      const size_t row_ = (size_t)b * SEQ + t0 + t;
#pragma unroll
      for (int gq = 0; gq < 4; ++gq) opre[gq] = *(const uint2*)(P + row_ * DINP + C_MO + h * 128 + 32 * eb + 8 * gq + 4 * hi);
      if (tid >= 128 && tid < 256) npv = nst[(size_t)u * 128 + tid - 128]; }
    if (tid >= 128 && tid < 256) gs[256 + tid - 128] = npv;
    mlstm_gates(raw, tid, gs);
    {
        const int s = tid >> 3;
#pragma unroll
        for (int pass = 0; pass < 2; ++pass) { const int ch = (tid & 7) + 8 * pass;
            *(LAS u32x4v*)(lds + ML_Q_OFF + s * MQ_PITCH + ch * 16) = raw.q[pass];
            *(LAS u32x4v*)(lds + ML_K_OFF + s * MQ_PITCH + ch * 16) = raw.k[pass];
            *(LAS u32x4v*)(lds + ML_V_OFF + s * MV_PITCH + ch * 16) = raw.v[pass]; }
    }
    if (u + Gd < 2048) ml_load<true>(raw, P, QK2, G, bif, u + Gd, tid);
    __syncthreads();
    bf16x8 qf[8];
#pragma unroll
    for (int ks = 0; ks < 8; ++ks) qf[ks] = *(LAS const bf16x8*)(lds + ML_Q_OFF + t * MQ_PITCH + ks * 32 + hi * 16);
    f32x16 ni;
#pragma unroll
    for (int r = 0; r < 16; ++r) ni[r] = zf_();
#pragma unroll
    for (int ks = 0; ks < 8; ++ks) ni = __builtin_amdgcn_mfma_f32_32x32x16_bf16(cf[ks], qf[ks], ni, 0, 0, 0);
    f32x16 p0, p1;
#pragma unroll
    for (int r = 0; r < 16; ++r) { p0[r] = zf_(); p1[r] = p0[r]; }
    { LAS const unsigned char* ka = lds + ML_K_OFF + r32 * MQ_PITCH + hi * 16;
#pragma unroll
      for (int ks = 0; ks < 8; ++ks) { const bf16x8 a0 = *(LAS const bf16x8*)(ka + ks * 32); p0 = __builtin_amdgcn_mfma_f32_32x32x16_bf16(a0, qf[ks], p0, 0, 0, 0); }
      if (tb == 1) {
#pragma unroll
          for (int ks = 0; ks < 8; ++ks) { const bf16x8 a1 = *(LAS const bf16x8*)(ka + 32 * MQ_PITCH + ks * 32); p1 = __builtin_amdgcn_mfma_f32_32x32x16_bf16(a1, qf[ks], p1, 0, 0, 0); } } }
    const float bt = gs[64 + t], Ft = __expf(bt);
    float dsum = 0.f;
#pragma unroll
    for (int r = 0; r < 16; ++r) { const int s0 = crow(r, hi);
        { const float w = (s0 <= t) ? __expf(bt - gs[64 + s0] + gs[128 + s0]) : 0.f; p0[r] *= w; dsum += p0[r]; }
        { const int s1 = s0 + 32; const float w = (s1 <= t) ? __expf(bt - gs[64 + s1] + gs[128 + s1]) : 0.f; p1[r] *= w; dsum += p1[r]; } }
    float qn = 0.f;
#pragma unroll
    for (int ks = 0; ks < 8; ++ks)
#pragma unroll
        for (int j = 0; j < 8; ++j) qn = fmaf(bf2f((bf16)qf[ks][j]), gs[256 + ks * 16 + hi * 8 + j], qn);
    dsum += shx<32>(dsum); qn += shx<32>(qn);
    const float den = dsum + Ft * qn, inv = rcpf_(fmaxf(fabsf(den), 1.f));
    f32x16 na;
#pragma unroll
    for (int r = 0; r < 16; ++r) na[r] = zf_();
    { const int g = lane >> 4, i = lane & 15;
      LAS const unsigned char* trb = lds + ML_V_OFF + (4 * hi + (i >> 2)) * MV_PITCH + (16 * (g & 1) + 4 * (i & 3)) * 2 + eb * 64;
#pragma unroll
      for (int ss = 0; ss < 4; ++ss) { if (ss >= 2 && tb == 0) break;
          unsigned w[4];
#pragma unroll
          for (int e = 0; e < 4; ++e) { const int r = 8 * (ss & 1) + 2 * e; w[e] = (ss < 2) ? cvtpk(p0[r], p0[r + 1]) : cvtpk(p1[r], p1[r + 1]); }
          const u32x4v wv = {w[0], w[1], w[2], w[3]}; const bf16x8 pf = __builtin_bit_cast(bf16x8, wv);
          const s16x4 lo = lds_tr(trb + ss * 16 * MV_PITCH), hi4 = lds_tr(trb + ss * 16 * MV_PITCH + 8 * MV_PITCH);
          const bf16x8 vt = {lo[0], lo[1], lo[2], lo[3], hi4[0], hi4[1], hi4[2], hi4[3]};
          na = __builtin_amdgcn_mfma_f32_32x32x16_bf16(vt, pf, na, 0, 0, 0); } }
    float ssq = 0.f;
#pragma unroll
    for (int r = 0; r < 16; ++r) { na[r] = (na[r] + Ft * ni[r]) * inv; ssq += na[r] * na[r]; }
    ssq += shx<32>(ssq);
    if (hi == 0) gs[384 + eb * 64 + t] = ssq;
    __syncthreads();
    const float rstd = rsqrtf((gs[384 + t] + gs[384 + 64 + t] + gs[384 + 128 + t] + gs[384 + 192 + t]) * (1.f / 128.f) + EPS);
    const size_t row = (size_t)b * SEQ + t0 + t;
#pragma unroll
    for (int gq = 0; gq < 4; ++gq) { const int cc = h * 128 + 32 * eb + 8 * gq + 4 * hi;
        const uint2 ow = opre[gq]; const float4 mn = *(const float4*)(mnorm + cc);
        const float o0 = sigmoidf_(__builtin_bit_cast(float, ow.x << 16)), o1 = sigmoidf_(__builtin_bit_cast(float, ow.x & 0xffff0000u)), o2 = sigmoidf_(__builtin_bit_cast(float, ow.y << 16)), o3 = sigmoidf_(__builtin_bit_cast(float, ow.y & 0xffff0000u));
        uint2 w; w.x = cvtpk(na[4 * gq] * rstd * mn.x * o0, na[4 * gq + 1] * rstd * mn.y * o1); w.y = cvtpk(na[4 * gq + 2] * rstd * mn.z * o2, na[4 * gq + 3] * rstd * mn.w * o3);
        *(uint2*)(MIX + row * DM + cc) = w; }
    __syncthreads();
    }
}


typedef float f32x4v __attribute__((ext_vector_type(4)));
typedef float f32x2v __attribute__((ext_vector_type(2)));
constexpr int CI_W2_OFF = 8 * 16 * 132 * 4, CI_HS_OFF = CI_W2_OFF + 128 * 64 * 4;
static_assert(CI_HS_OFF + 16 * 128 * 4 <= 131072, "compress LDS");
__device__ __forceinline__ void compress_item(const bf16* __restrict__ P, const bf16* __restrict__ w1t  , const float* __restrict__ c1  , const float* __restrict__ w2  ,
                                              const float* __restrict__ kg0, bf16* __restrict__ KVcb, int item, int tid, LAS unsigned char* lds) {
    asm volatile("" : "+v"(tid));
    const int lane = tid & 63, wid = __builtin_amdgcn_readfirstlane(tid >> 6), r16 = lane & 15, g = lane >> 4;
    const int kv = item >> 7, b = (item >> 5) & 3, i0 = (item & 31) * 16;
    const int irow = min(i0 + r16, NCMP - 1);
    const bf16* xa = P + ((size_t)b * SEQ + 16 * irow + 4 * wid) * DINP + (kv ? C_NVC : C_NKC) + g * 8;
    const bf16* wb = w1t + ((size_t)kv * 128 + r16) * 2048 + wid * 256 + g * 8;
    pg8::f32x4 acc[8];
#pragma unroll
    for (int cb = 0; cb < 8; ++cb) { acc[cb][0] = zf_(); acc[cb][1] = acc[cb][0]; acc[cb][2] = acc[cb][0]; acc[cb][3] = acc[cb][0]; }
    bf16x8 af[2][2], bfr[2][16];
#define CI_LOAD(sp, bu) do { _Pragma("unroll") for (int e = 0; e < 2; ++e) { af[bu][e] = *(const bf16x8*)(xa + (size_t)(sp) * DINP + 32 * e); \
        _Pragma("unroll") for (int cb = 0; cb < 8; ++cb) bfr[bu][cb * 2 + e] = *(const bf16x8*)(wb + (size_t)cb * 16 * 2048 + 64 * (sp) + 32 * e); } } while (0)
    CI_LOAD(0, 0);
    f32x4v w2r[4];
    { const f32x4v* w2g = (const f32x4v*)(w2 + (size_t)kv * 128 * 64);
#pragma unroll
      for (int q = 0; q < 4; ++q) w2r[q] = w2g[tid + 512 * q]; }
#pragma unroll
    for (int sp = 0; sp < 4; ++sp) {
        if (sp + 1 < 4) { if (sp & 1) CI_LOAD(sp + 1, 0); else CI_LOAD(sp + 1, 1); }
#pragma unroll
        for (int e = 0; e < 2; ++e)
#pragma unroll
            for (int cb = 0; cb < 8; ++cb) acc[cb] = __builtin_amdgcn_mfma_f32_16x16x32_bf16(af[sp & 1][e], bfr[sp & 1][cb * 2 + e], acc[cb], 0, 0, 0);
    }
#undef CI_LOAD
    LAS float* part = (LAS float*)lds;
#pragma unroll
    for (int cb = 0; cb < 8; ++cb)
#pragma unroll
        for (int i = 0; i < 4; ++i) part[(wid * 16 + 4 * g + i) * 132 + 16 * cb + r16] = acc[cb][i];
    { LAS f32x4v* w2s = (LAS f32x4v*)(lds + CI_W2_OFF);
#pragma unroll
      for (int q = 0; q < 4; ++q) w2s[tid + 512 * q] = w2r[q]; }
    __syncthreads();
    const int il = tid >> 5;
    {
        const int j4 = (tid & 31) * 4;
        f32x4v a = *(const f32x4v*)(c1 + kv * 128 + j4);
#pragma unroll
        for (int w = 0; w < 8; ++w) a += *(LAS const f32x4v*)(part + (w * 16 + il) * 132 + j4);
#pragma unroll
        for (int e = 0; e < 4; ++e) a[e] = a[e] * rcpf_(1.f + __expf(-a[e]));
        *(LAS f32x4v*)(lds + CI_HS_OFF + (il * 128 + j4) * 4) = a;
    }
    __syncthreads();
    {
        const int d0 = (tid & 31) * 2;
        float o0 = 0.f, o1 = 0.f;
        LAS const float* hs = (LAS const float*)(lds + CI_HS_OFF) + il * 128;
        LAS const float* wp = (LAS const float*)(lds + CI_W2_OFF) + d0;
#pragma unroll 8
        for (int j = 0; j < 128; j += 4) { const f32x4v hv = *(LAS const f32x4v*)(hs + j);
#pragma unroll
            for (int e = 0; e < 4; ++e) { const f32x2v wa = *(LAS const f32x2v*)(wp + (j + e) * 64); o0 = fmaf(hv[e], wa[0], o0); o1 = fmaf(hv[e], wa[1], o1); } }
        if (kv == 0) { float ss = o0 * o0 + o1 * o1;
            ss += shx<1>(ss); ss += shx<2>(ss); ss += shx<4>(ss); ss += shx<8>(ss); ss += shx<16>(ss);
            const float rstd = rsqrtf(ss * (1.f / 64.f) + EPS);
            o0 *= rstd * kg0[d0]; o1 *= rstd * kg0[d0 + 1]; }
        const int i = i0 + il;
        if (i >= NCMP) { o0 = zf_(); o1 = o0; }
        *(unsigned*)(KVcb + (((size_t)kv * NB + b) * 512 + i) * 64 + d0) = cvtpk(o0, o1);
    }
    __syncthreads();
}
__device__ __forceinline__ void cmp_c1_item(const float* __restrict__ pe, const float* __restrict__ w1, float* __restrict__ c1, int item, int tid, LAS unsigned char* lds) {
    const int lk = item >> 6, j0 = (item & 63) * 2, jj = tid & 1, kk = tid >> 1;
    const float* pp = pe + (size_t)lk * 2048; const float* ww = w1 + (size_t)lk * 2048 * 128 + j0 + jj;
    float a = 0.f;
#pragma unroll 8
    for (int k = kk; k < 2048; k += 256) a = fmaf(pp[k], ww[(size_t)k * 128], a);
    LAS float* red = (LAS float*)lds;
    red[tid] = a;
    __syncthreads();
    if (tid < 2) { float s = 0.f; for (int q = 0; q < 256; ++q) s += red[q * 2 + tid]; c1[lk * 128 + j0 + tid] = s; }
    __syncthreads();
}

#define XB_TMO      128
#define XB_XCNT(j)  (256  + 64 * (j))
#define XB_XSUB(j)  (1280 + 64 * (j))
#define XB_XGEN(j)  (2304 + 64 * (j))
#define XB_TOP      3328
#define XB_TOPGEN   3392
#define XB_QUEUE(k) (3456 + 64 * (k))
#define XB_LSUB(j)  (3968 + 64 * (j))
#define XB_SSUB(j)  (4992 + 64 * (j))
#define XB_STOP     6016
#define XB_SGEN     6080
#define XB_CH1      1152
#define XB_RD4      7296
#define XB_RD7      7360
#define XCD_BAR_WORDS 7424
#define XB_SPIN_CAP (1u << 22)

__device__ __forceinline__ unsigned xb_ld(unsigned* p)              { return __hip_atomic_load(p, __ATOMIC_RELAXED, __HIP_MEMORY_SCOPE_AGENT); }
__device__ __forceinline__ unsigned xb_add(unsigned* p, unsigned v) { return __hip_atomic_fetch_add(p, v, __ATOMIC_RELAXED, __HIP_MEMORY_SCOPE_AGENT); }
__device__ __forceinline__ unsigned xb_xcc_id() { return (unsigned)__builtin_amdgcn_s_getreg((3 << 11) | 20) & 0xFu; }
#define XB_SPIN(cond, bar) do { unsigned _sp = 0; while (cond) { __builtin_amdgcn_s_sleep(1); \
    if ((++_sp & 255u) == 0u) { if (xb_ld(&(bar)[XB_TMO])) break; if (_sp > XB_SPIN_CAP) { atomicAdd(&(bar)[XB_TMO], 1u); break; } } } } while (0)

struct XcdBarrier {
    unsigned* bar; unsigned x;
    volatile LAS unsigned* st;
};

__device__ __forceinline__ XcdBarrier xcd_barrier_post(unsigned* bar, volatile LAS unsigned* st, const int tid_) {
    XcdBarrier b; b.bar = bar; b.x = xb_xcc_id(); b.st = st;
    if (tid_ == 0) st[2] = xb_add(&bar[XB_XCNT(b.x)], 1u);
    return b;
}
__device__ __forceinline__ void xcd_barrier_complete(unsigned* bar, unsigned x, unsigned& nloc, unsigned& nx) {
    const unsigned G = gridDim.x * gridDim.y * gridDim.z;
    unsigned sum, cnt, mine, sp = 0u;
    for (;;) {
        sum = 0u; cnt = 0u; mine = 0u;
#pragma unroll
        for (unsigned j = 0; j < 16; ++j) { const unsigned c = xb_ld(&bar[XB_XCNT(j)]); sum += c; cnt += (c > 0u) ? 1u : 0u; mine = (j == x) ? c : mine; }
        if (sum == G) break;
        __builtin_amdgcn_s_sleep(1);
        if ((++sp & 255u) == 0u) { if (xb_ld(&bar[XB_TMO])) break; if (sp > XB_SPIN_CAP) { atomicAdd(&bar[XB_TMO], 1u); break; } }
    }
    nloc = mine > 0u ? mine : 1u; nx = cnt > 0u ? cnt : 1u;
}
__device__ __forceinline__ unsigned xcd_chain_code(unsigned* bar, unsigned x) {
    unsigned ok = 1u, cnt = 0u, idx = 0u;
#pragma unroll
    for (unsigned j = 0; j < 16; ++j) { const unsigned c = xb_ld(&bar[XB_XCNT(j)]); if (c != 0u && c != 32u) ok = 0u; cnt += (c > 0u) ? 1u : 0u; idx += (c > 0u && j < x) ? 1u : 0u; }
    return (ok && cnt == 8u && gridDim.x == 256u) ? idx + 1u : 0u;
}
__device__ __forceinline__ void xcd_local_barrier(unsigned* bar, unsigned x, const int tid_) {
    asm volatile("s_waitcnt vmcnt(0)" ::: "memory");
    __syncthreads();
    if (tid_ == 0) {
        __builtin_amdgcn_s_waitcnt(0);
        const unsigned old = xb_add(&bar[XB_LSUB(x)], 1u);
        const unsigned target = (old / 32u + 1u) * 32u;
        __builtin_amdgcn_fence(__ATOMIC_ACQUIRE, "agent");
        XB_SPIN(xb_ld(&bar[XB_LSUB(x)]) < target, bar);
        asm volatile("s_waitcnt vmcnt(0)" ::: "memory");
    }
    __syncthreads();
}

__device__ __forceinline__ void xcd_split_arrive(unsigned* bar, unsigned x, unsigned nloc, unsigned nx, const int tid_, const unsigned co = 0u) {
    asm volatile("s_waitcnt vmcnt(0)" ::: "memory");
    __syncthreads();
    if (tid_ == 0) {
        __builtin_amdgcn_s_waitcnt(0);
        const unsigned old = xb_add(&bar[XB_SSUB(x) + co], 1u);
        const unsigned gen = old / nloc;
        if (old + 1u == (gen + 1u) * nloc) {
            __builtin_amdgcn_fence(__ATOMIC_RELEASE, "agent");
            asm volatile("s_waitcnt vmcnt(0)" ::: "memory");
            const unsigned og = xb_add(&bar[XB_STOP + co], 1u);
            const unsigned tg = og / nx;
            if (og + 1u == (tg + 1u) * nx) xb_add(&bar[XB_SGEN + co], 1u);
        }
    }
}
__device__ __forceinline__ void xcd_split_wait(unsigned* bar, unsigned round, const int tid_, const unsigned co) {
    asm volatile("s_waitcnt vmcnt(0)" ::: "memory");
    __syncthreads();
    if (tid_ == 0) {
        __builtin_amdgcn_fence(__ATOMIC_ACQUIRE, "agent");
        XB_SPIN(xb_ld(&bar[XB_SGEN + co]) <= round, bar);
        asm volatile("s_waitcnt vmcnt(0)" ::: "memory");
    }
    __syncthreads();
}
__device__ __forceinline__ void xcd_reads_done(unsigned* bar, const unsigned word, const int tid_) {
    asm volatile("s_waitcnt vmcnt(0)" ::: "memory");
    __syncthreads();
    if (tid_ == 0) (void)xb_add(&bar[word], 1u);
}
__device__ __forceinline__ void xcd_reads_wait(unsigned* bar, const unsigned word, const unsigned target, const int tid_) {
    if (tid_ == 0) { XB_SPIN(xb_ld(&bar[word]) < target, bar); }
    __syncthreads();
}
__device__ __forceinline__ void xcd_barrier(const XcdBarrier& b, const int tid_) {
    asm volatile("s_waitcnt vmcnt(0)" ::: "memory");
    __syncthreads();
    if (tid_ == 0) {
        unsigned* bar = b.bar;
        __builtin_amdgcn_s_waitcnt(0);
        unsigned nloc = b.st[0], nx = b.st[1];
        if (nloc == 0u) { xcd_barrier_complete(bar, b.x, nloc, nx); b.st[0] = nloc; b.st[1] = nx; b.st[3] = xcd_chain_code(bar, b.x); }
        const unsigned old = xb_add(&bar[XB_XSUB(b.x)], 1u);
        const unsigned gen = old / nloc;
        if (old == gen * nloc && nloc > 1u) {
            __builtin_amdgcn_fence(__ATOMIC_RELEASE, "agent");
            asm volatile("s_waitcnt vmcnt(0)" ::: "memory"); }
        if (old + 1u == (gen + 1u) * nloc) {
            __builtin_amdgcn_fence(__ATOMIC_RELEASE, "agent");
            asm volatile("s_waitcnt vmcnt(0)" ::: "memory");
            const unsigned og = xb_add(&bar[XB_TOP], 1u);
            const unsigned tg = og / nx;
            __builtin_amdgcn_fence(__ATOMIC_ACQUIRE, "agent");
            if (og + 1u == (tg + 1u) * nx) xb_add(&bar[XB_TOPGEN], 1u);
            else XB_SPIN(xb_ld(&bar[XB_TOPGEN]) == tg, bar);
            xb_add(&bar[XB_XGEN(b.x)], 1u);
            asm volatile("s_waitcnt vmcnt(0)" ::: "memory");
        } else {
            __builtin_amdgcn_fence(__ATOMIC_ACQUIRE, "agent");
            XB_SPIN(xb_ld(&bar[XB_XGEN(b.x)]) == gen, bar);
            asm volatile("s_waitcnt vmcnt(0)" ::: "memory");
        }
    }
    __syncthreads();
}


constexpr int M2_G_OFF = 0, M2_STG_OFF = 4096, M2_KIMG = 64 * MQ_PITCH, M2_VIMG = 64 * MV_PITCH, M2_STG = M2_KIMG + M2_VIMG;
static_assert(M2_STG_OFF + 2 * M2_STG <= 131072, "mlstm256 LDS");
constexpr int M2_CT_OFF = M2_STG_OFF + 2 * M2_STG + 512, M2_CT_PITCH = 272;
static_assert(M2_CT_OFF + 128 * M2_CT_PITCH <= 131072, "mlstm256 LDS (C^T image)");
__device__ __forceinline__ void ml256_gates(const float* __restrict__ G, const float* __restrict__ bif, int row0, int h, int tid, LAS float* gs) {
    if (tid < 256) { gs[tid] = log_sigmoidf_(G[(size_t)(row0 + tid) * 32 + 4 + h] + bif[4 + h]); gs[512 + tid] = G[(size_t)(row0 + tid) * 32 + h] + bif[h]; }
    __syncthreads();
    if (tid < 256) {
        float a = gs[tid]; const int ln = tid & 63;
#pragma unroll
        for (int o = 1; o < 64; o <<= 1) { const float t = __shfl_up(a, o); if (ln >= o) a += t; }
        if (ln == 63) gs[896 + (tid >> 6)] = a;
        gs[256 + tid] = a; }
    __syncthreads();
    if (tid >= 64 && tid < 256) { float a = gs[256 + tid]; const int w = tid >> 6;
        a += gs[896]; if (w >= 2) a += gs[897]; if (w >= 3) a += gs[898];
        gs[256 + tid] = a; }
    __syncthreads();
}
__device__ __forceinline__ void ml256_gates_load(const float* __restrict__ G, int row0, int h, int tid, float& gf, float& gi) {
    const size_t r = (size_t)(row0 + (tid & 255)) * 32; gf = G[r + 4 + h]; gi = G[r + h];
}
template <bool WITHE>
__device__ __forceinline__ void ml256_gates_finish(float gf, float gi, const float* __restrict__ bif, int h, int tid, LAS float* gs) {
    if (tid < 256) {
        const float ig = gi + bif[h]; float a = log_sigmoidf_(gf + bif[4 + h]); const int ln = tid & 63;
#pragma unroll
        for (int o = 1; o < 64; o <<= 1) { const float t = __shfl_up(a, o); if (ln >= o) a += t; }
        if (ln == 63) gs[896 + (tid >> 6)] = a;
        gs[256 + tid] = a; gs[512 + tid] = ig;
        if (WITHE) gs[tid] = __expf(fminf(ig - a + __builtin_bit_cast(float, __builtin_amdgcn_readfirstlane(__builtin_bit_cast(int, a))), 80.f)); }
    __syncthreads();
    if (tid >= 64 && tid < 256) { float a = gs[256 + tid]; const int w = tid >> 6;
        a += gs[896]; if (w >= 2) a += gs[897]; if (w >= 3) a += gs[898];
        gs[256 + tid] = a; }
    __syncthreads();
}
struct Ml2Raw { u32x4v k[2], v[2]; };
__device__ __forceinline__ void ml2_load(Ml2Raw& r, const bf16* __restrict__ P, const bf16* __restrict__ QK2, int row0, int h, int tid) {
    const int s = tid >> 3;
#pragma unroll
    for (int pass = 0; pass < 2; ++pass) { const int ch = (tid & 7) + 8 * pass;
        r.k[pass] = *(const u32x4v*)(QK2 + (size_t)(row0 + s) * 1024 + 512 + h * 128 + ch * 8);
        r.v[pass] = *(const u32x4v*)(P + (size_t)(row0 + s) * DINP + C_MV + h * 128 + ch * 8); }
}
__device__ __forceinline__ void ml256_m1_phase(const bf16* __restrict__ P, const bf16* __restrict__ QK2, const float* __restrict__ G, const float* __restrict__ bif,
                                               bf16* __restrict__ CT, float* __restrict__ nst, float* __restrict__ dec, int bid, int Gd, int tid, LAS unsigned char* lds) {
    asm volatile("" : "+v"(tid));
    const int lane = tid & 63, wid = __builtin_amdgcn_readfirstlane(tid >> 6), hi = lane >> 5;
    LAS float* gs = (LAS float*)(lds + M2_G_OFF);
    for (int u = bid; u < 512; u += Gd) {
        const int sc = u & 31, h = (u >> 5) & 3, b = u >> 7, row0 = b * SEQ + sc * 256;
        Ml2Raw raw; ml2_load(raw, P, QK2, row0, h, tid);
        ml256_gates(G, bif, row0, h, tid, gs);
        if (tid == 0) dec[u] = __expf(gs[256 + 255]);
        const int g = lane >> 4, i = lane & 15;
        const int mb = wid >> 1, nb0 = 2 * (wid & 1);
        f32x16 acc0, acc1;
#pragma unroll
        for (int r = 0; r < 16; ++r) { acc0[r] = zf_(); acc1[r] = acc0[r]; }
        float an = 0.f;
        for (int st = 0; st < 4; ++st) {
            LAS unsigned char* stg = lds + M2_STG_OFF + (st & 1) * (2 * M2_VIMG);
            { const int s = tid >> 3; const float ws = __expf(gs[256 + 255] - gs[256 + st * 64 + s] + gs[512 + st * 64 + s]);
#pragma unroll
              for (int pass = 0; pass < 2; ++pass) { const int ch = (tid & 7) + 8 * pass; u32x4v w;
#pragma unroll
                  for (int e = 0; e < 4; ++e) w[e] = cvtpk(__builtin_bit_cast(float, raw.k[pass][e] << 16) * ws, __builtin_bit_cast(float, raw.k[pass][e] & 0xffff0000u) * ws);
                  *(LAS u32x4v*)(stg + s * MV_PITCH + ch * 16) = w;
                  *(LAS u32x4v*)(stg + M2_VIMG + s * MV_PITCH + ch * 16) = raw.v[pass]; } }
            if (st + 1 < 4) ml2_load(raw, P, QK2, row0 + (st + 1) * 64, h, tid);
            __syncthreads();
            LAS const unsigned char* trb = stg + (4 * hi + (i >> 2)) * MV_PITCH + (16 * (g & 1) + 4 * (i & 3)) * 2;
#pragma unroll
            for (int ks = 0; ks < 4; ++ks) {
                const s16x4 alo = lds_tr(trb + ks * 16 * MV_PITCH + mb * 64), ahi = lds_tr(trb + ks * 16 * MV_PITCH + 8 * MV_PITCH + mb * 64);
                const bf16x8 af = {alo[0], alo[1], alo[2], alo[3], ahi[0], ahi[1], ahi[2], ahi[3]};
                const s16x4 b0lo = lds_tr(trb + M2_VIMG + ks * 16 * MV_PITCH + nb0 * 64), b0hi = lds_tr(trb + M2_VIMG + ks * 16 * MV_PITCH + 8 * MV_PITCH + nb0 * 64);
                const s16x4 b1lo = lds_tr(trb + M2_VIMG + ks * 16 * MV_PITCH + (nb0 + 1) * 64), b1hi = lds_tr(trb + M2_VIMG + ks * 16 * MV_PITCH + 8 * MV_PITCH + (nb0 + 1) * 64);
                const bf16x8 bf0 = {b0lo[0], b0lo[1], b0lo[2], b0lo[3], b0hi[0], b0hi[1], b0hi[2], b0hi[3]}, bf1 = {b1lo[0], b1lo[1], b1lo[2], b1lo[3], b1hi[0], b1hi[1], b1hi[2], b1hi[3]};
                acc0 = __builtin_amdgcn_mfma_f32_32x32x16_bf16(af, bf0, acc0, 0, 0, 0);
                acc1 = __builtin_amdgcn_mfma_f32_32x32x16_bf16(af, bf1, acc1, 0, 0, 0);
            }
            if (tid < 128) {
#pragma unroll
                for (int s0 = 0; s0 < 64; s0 += 8) { float kv[8];
#pragma unroll
                    for (int q = 0; q < 8; ++q) kv[q] = bf2f(*(LAS const bf16*)(stg + (s0 + q) * MV_PITCH + tid * 2));
#pragma unroll
                    for (int q = 0; q < 4; ++q) kv[q] += kv[q + 4];
                    an += (kv[0] + kv[2]) + (kv[1] + kv[3]);
                    __builtin_amdgcn_sched_barrier(0); } }
        }
        bf16* ct = CT + (size_t)u * 16384;
#pragma unroll
        for (int gq = 0; gq < 4; ++gq) { const int d0 = 32 * mb + 8 * gq + 4 * hi;
            uint2 w0, w1; w0.x = cvtpk(acc0[4 * gq], acc0[4 * gq + 1]); w0.y = cvtpk(acc0[4 * gq + 2], acc0[4 * gq + 3]); w1.x = cvtpk(acc1[4 * gq], acc1[4 * gq + 1]); w1.y = cvtpk(acc1[4 * gq + 2], acc1[4 * gq + 3]);
            *(uint2*)(ct + (size_t)(32 * nb0 + (lane & 31)) * 128 + d0) = w0; *(uint2*)(ct + (size_t)(32 * (nb0 + 1) + (lane & 31)) * 128 + d0) = w1; }
        if (tid < 128) nst[(size_t)u * 128 + tid] = an;
        __syncthreads();
    }
}
__device__ __forceinline__ void ml256_scan(bf16* __restrict__ CT, float* __restrict__ nst, const float* __restrict__ dec, int item, int tid) {
    asm volatile("" : "+v"(tid));
    const int bh = item / 9, part = item % 9;
    if (part < 8) {
        bf16* base = CT + (size_t)bh * 32 * 16384 + (part * 512 + tid) * 4;
        float C[4]; C[0] = zf_(); C[1] = C[0]; C[2] = C[0]; C[3] = C[0];
        for (int c0 = 0; c0 < 32; c0 += 16) {
            uint2 w[16];
#pragma unroll
            for (int k = 0; k < 16; ++k) w[k] = *(const uint2*)(base + (size_t)(c0 + k) * 16384);
#pragma unroll
            for (int k = 0; k < 16; ++k) { const float a = dec[bh * 32 + c0 + k];
                uint2 o; o.x = cvtpk(C[0], C[1]); o.y = cvtpk(C[2], C[3]); *(uint2*)(base + (size_t)(c0 + k) * 16384) = o;
                C[0] = fmaf(a, C[0], __builtin_bit_cast(float, w[k].x << 16)); C[1] = fmaf(a, C[1], __builtin_bit_cast(float, w[k].x & 0xffff0000u));
                C[2] = fmaf(a, C[2], __builtin_bit_cast(float, w[k].y << 16)); C[3] = fmaf(a, C[3], __builtin_bit_cast(float, w[k].y & 0xffff0000u)); }
        }
    } else if (tid < 128) {
        float* base = nst + (size_t)bh * 32 * 128 + tid; float C = 0.f;
        float dC[32], dk[32];
#pragma unroll
        for (int c = 0; c < 32; ++c) { dC[c] = base[(size_t)c * 128]; dk[c] = dec[bh * 32 + c]; }
        __builtin_amdgcn_sched_barrier(0);
#pragma unroll
        for (int c = 0; c < 32; ++c) { base[(size_t)c * 128] = C; C = dk[c] * C + dC[c]; }
    }
}
__device__ __forceinline__ void ml256_m3_phase(const bf16* __restrict__ P, const bf16* __restrict__ QK2, const float* __restrict__ G, const float* __restrict__ bif,
                                               const bf16* __restrict__ CT, const float* __restrict__ nst, const float* __restrict__ mnorm, bf16* __restrict__ MIX, int ustart, int ustep, int ulimit, int tid, LAS unsigned char* lds) {
    asm volatile("" : "+v"(tid));
    const int lane = tid & 63, wid = __builtin_amdgcn_readfirstlane(tid >> 6), hi = lane >> 5, r32 = lane & 31;
    LAS float* gs = (LAS float*)(lds + M2_G_OFF);
    for (int u = ustart; u < ulimit; u += ustep) {
        asm volatile("" : "+v"(tid));
        const int sc = u & 31, h = (u >> 5) & 3, b = u >> 7, row0 = b * SEQ + sc * 256;
        const int t = 32 * wid + r32; const size_t rowt = (size_t)row0 + t;
        auto stage_load = [&](int kt, u32x4v (&kk)[2], u32x4v (&vv)[2]) { const int s = tid >> 3;
#pragma unroll
            for (int pass = 0; pass < 2; ++pass) { const int ch = (tid & 7) + 8 * pass;
                kk[pass] = *(const u32x4v*)(QK2 + (size_t)(row0 + kt * 64 + s) * 1024 + 512 + h * 128 + ch * 8);
                vv[pass] = *(const u32x4v*)(P + (size_t)(row0 + kt * 64 + s) * DINP + C_MV + h * 128 + ch * 8); } };
        auto stage_store = [&](int kt, const u32x4v (&kk)[2], const u32x4v (&vv)[2]) { LAS unsigned char* stg = lds + M2_STG_OFF + (kt & 1) * M2_STG; const int s = tid >> 3;
#pragma unroll
            for (int pass = 0; pass < 2; ++pass) { const int ch = (tid & 7) + 8 * pass;
                *(LAS u32x4v*)(stg + s * MQ_PITCH + ch * 16) = kk[pass]; *(LAS u32x4v*)(stg + M2_KIMG + s * MV_PITCH + ch * 16) = vv[pass]; } };
        float gf, gi; ml256_gates_load(G, row0, h, tid, gf, gi);
        u32x4v kA[2], vA[2], kB[2], vB[2]; stage_load(0, kA, vA); stage_load(1, kB, vB);
        bf16x8 qf[8];
#pragma unroll
        for (int ks = 0; ks < 8; ++ks) qf[ks] = *(const bf16x8*)(QK2 + rowt * 1024 + h * 128 + ks * 16 + hi * 8);
        if (tid >= 256 && tid < 384) gs[768 + tid - 256] = nst[(size_t)u * 128 + tid - 256];
        if (tid >= 384) ((LAS float*)(lds + M2_STG_OFF + 2 * M2_STG))[tid - 384] = mnorm[h * 128 + tid - 384];
        ml256_gates_finish<true>(gf, gi, bif, h, tid, gs);
        stage_store(0, kA, vA); stage_store(1, kB, vB);
        stage_load(2, kA, vA); stage_load(3, kB, vB);
        __syncthreads();
        f32x16 N0, N1, N2, N3;
#pragma unroll
        for (int r = 0; r < 16; ++r) { N0[r] = zf_(); N1[r] = N0[r]; N2[r] = N0[r]; N3[r] = N0[r]; }
        const float bt = gs[256 + t], Ft = __expf(bt);
        float dsum = 0.f;
        const int ktmax = wid >> 1;
        for (int kt = 0; kt < 4; ++kt) {
            if (kt <= ktmax) {
                LAS const unsigned char* stg = lds + M2_STG_OFF + (kt & 1) * M2_STG;
                f32x16 p0, p1;
#pragma unroll
                for (int r = 0; r < 16; ++r) { p0[r] = zf_(); p1[r] = p0[r]; }
                LAS const unsigned char* ka = stg + r32 * MQ_PITCH + hi * 16;
#pragma unroll
                for (int ks = 0; ks < 8; ++ks) { const bf16x8 a0 = *(LAS const bf16x8*)(ka + ks * 32), a1 = *(LAS const bf16x8*)(ka + 32 * MQ_PITCH + ks * 32);
                    p0 = __builtin_amdgcn_mfma_f32_32x32x16_bf16(a0, qf[ks], p0, 0, 0, 0); p1 = __builtin_amdgcn_mfma_f32_32x32x16_bf16(a1, qf[ks], p1, 0, 0, 0); }
                __builtin_amdgcn_sched_barrier(0);
                const float Fk = __expf(bt - gs[256 + kt * 64]);
#pragma unroll
                for (int rb = 0; rb < 16; rb += 4) {
                    float e0v[4], e1v[4];
#pragma unroll
                    for (int q = 0; q < 4; ++q) { const int s0 = kt * 64 + crow(rb + q, hi); e0v[q] = gs[s0]; e1v[q] = gs[s0 + 32]; }
#pragma unroll
                    for (int q = 0; q < 4; ++q) { const int r = rb + q, s0 = kt * 64 + crow(r, hi), s1 = s0 + 32;
                        const float w0 = (s0 <= t) ? e0v[q] * Fk : 0.f, w1 = (s1 <= t) ? e1v[q] * Fk : 0.f;
                        p0[r] *= w0; dsum += p0[r]; p1[r] *= w1; dsum += p1[r]; } }
                __builtin_amdgcn_sched_barrier(0);
                bf16x8 pf[4];
#pragma unroll
                for (int s = 0; s < 4; ++s) { u32x4v w;
#pragma unroll
                    for (int e = 0; e < 4; ++e) { const int r = 8 * (s & 1) + 2 * e; w[e] = (s < 2) ? cvtpk(p0[r], p0[r + 1]) : cvtpk(p1[r], p1[r + 1]); }
                    pf[s] = __builtin_bit_cast(bf16x8, w); }
                const int g = lane >> 4, i = lane & 15;
                LAS const unsigned char* trb = stg + M2_KIMG + (4 * hi + (i >> 2)) * MV_PITCH + (16 * (g & 1) + 4 * (i & 3)) * 2;
#pragma unroll
                for (int s = 0; s < 4; ++s) {
#pragma unroll
                    for (int eb = 0; eb < 4; ++eb) {
                        const s16x4 lo = lds_tr(trb + s * 16 * MV_PITCH + eb * 64), hi4 = lds_tr(trb + s * 16 * MV_PITCH + 8 * MV_PITCH + eb * 64);
                        const bf16x8 vt = {lo[0], lo[1], lo[2], lo[3], hi4[0], hi4[1], hi4[2], hi4[3]};
                        if (eb == 0) N0 = __builtin_amdgcn_mfma_f32_32x32x16_bf16(vt, pf[s], N0, 0, 0, 0);
                        else if (eb == 1) N1 = __builtin_amdgcn_mfma_f32_32x32x16_bf16(vt, pf[s], N1, 0, 0, 0);
                        else if (eb == 2) N2 = __builtin_amdgcn_mfma_f32_32x32x16_bf16(vt, pf[s], N2, 0, 0, 0);
                        else N3 = __builtin_amdgcn_mfma_f32_32x32x16_bf16(vt, pf[s], N3, 0, 0, 0);
                    } }
            }
            if (kt < 3) __syncthreads();
            if (kt == 0) stage_store(2, kA, vA);
            if (kt == 1) stage_store(3, kB, vB);
        }
        u32x4v ctr[4];
        { const bf16* cg_ = CT + (size_t)u * 16384 + (size_t)(tid >> 2) * 128 + (tid & 3) * 32;
#pragma unroll
          for (int q = 0; q < 4; ++q) ctr[q] = *(const u32x4v*)(cg_ + q * 8); }
        float qn = 0.f;
#pragma unroll
        for (int ks = 0; ks < 8; ++ks)
#pragma unroll
            for (int j = 0; j < 8; ++j) qn = fmaf(bf2f((bf16)qf[ks][j]), gs[768 + ks * 16 + hi * 8 + j], qn);
        dsum += shx<32>(dsum); qn += shx<32>(qn);
        const float den = dsum + Ft * qn, inv = rcpf_(fmaxf(fabsf(den), 1.f));
        float ssq = 0.f;
        int t3 = tid; asm volatile("" : "+v"(t3));
        const int hi3 = (t3 >> 5) & 1; const size_t rowt3 = (size_t)row0 + 32 * (t3 >> 6) + (t3 & 31);
        uint2 owv[16];
#pragma unroll
        for (int q = 0; q < 16; ++q) owv[q] = *(const uint2*)(P + rowt3 * DINP + C_MO + h * 128 + 32 * (q >> 2) + 8 * (q & 3) + 4 * hi3);
        {   LAS unsigned char* cl = lds + M2_CT_OFF + (tid >> 2) * M2_CT_PITCH + (tid & 3) * 64;
#pragma unroll
            for (int q = 0; q < 4; ++q) *(LAS u32x4v*)(cl + q * 16) = ctr[q]; }
        __syncthreads();
#pragma unroll
        for (int eb = 0; eb < 4; ++eb) {
            LAS const unsigned char* ca = lds + M2_CT_OFF + (32 * eb + r32) * M2_CT_PITCH + hi * 16;
            f32x16 ni;
#pragma unroll
            for (int r = 0; r < 16; ++r) ni[r] = zf_();
#pragma unroll
            for (int ks = 0; ks < 8; ++ks) ni = __builtin_amdgcn_mfma_f32_32x32x16_bf16(*(LAS const bf16x8*)(ca + ks * 32), qf[ks], ni, 0, 0, 0);
            f32x16& Nx = eb == 0 ? N0 : eb == 1 ? N1 : eb == 2 ? N2 : N3;
#pragma unroll
            for (int r = 0; r < 16; ++r) { Nx[r] = (Nx[r] + Ft * ni[r]) * inv; ssq += Nx[r] * Nx[r]; }
        }
        ssq += shx<32>(ssq);
        const float rstd = rsqrtf(ssq * (1.f / 128.f) + EPS);
        f32x4v mnv[16];
#pragma unroll
        for (int q = 0; q < 16; ++q) mnv[q] = *(LAS const f32x4v*)(lds + M2_STG_OFF + 2 * M2_STG + (32 * (q >> 2) + 8 * (q & 3) + 4 * hi3) * 4);
#pragma unroll
        for (int eb = 0; eb < 4; ++eb) { const f32x16& Nx = eb == 0 ? N0 : eb == 1 ? N1 : eb == 2 ? N2 : N3;
#pragma unroll
            for (int gq = 0; gq < 4; ++gq) { const int cc = h * 128 + 32 * eb + 8 * gq + 4 * hi3;
                const uint2 ow = owv[eb * 4 + gq]; const f32x4v mnq = mnv[eb * 4 + gq]; float4 mn; mn.x = mnq[0]; mn.y = mnq[1]; mn.z = mnq[2]; mn.w = mnq[3];
                const float o0 = sigmoidf_(__builtin_bit_cast(float, ow.x << 16)), o1 = sigmoidf_(__builtin_bit_cast(float, ow.x & 0xffff0000u)), o2 = sigmoidf_(__builtin_bit_cast(float, ow.y << 16)), o3 = sigmoidf_(__builtin_bit_cast(float, ow.y & 0xffff0000u));
                uint2 w; w.x = cvtpk(Nx[4 * gq] * rstd * mn.x * o0, Nx[4 * gq + 1] * rstd * mn.y * o1); w.y = cvtpk(Nx[4 * gq + 2] * rstd * mn.z * o2, Nx[4 * gq + 3] * rstd * mn.w * o3);
                *(uint2*)(MIX + rowt3 * DM + cc) = w; } }
        __syncthreads();
    }
}

constexpr size_t MiB = 1u << 20;
constexpr size_t W_LAYER = (size_t)(DINP + DM + DFF) * DM + (size_t)DM * DFF;
constexpr size_t WS_W = 0;
constexpr size_t WS_HM = 52 * MiB;
constexpr size_t WS_G = 116 * MiB;
constexpr size_t WS_SMALL = 120 * MiB;
constexpr size_t WS_TAB = WS_SMALL, WS_KMEAN = WS_SMALL + 512 * 1024, WS_KVC = WS_SMALL + 1 * MiB, WS_NST = WS_SMALL + 2 * MiB, WS_DEC = WS_SMALL + 3 * MiB, WS_KVCB = WS_SMALL + 3 * MiB + 512 * 1024;
constexpr size_t WS_SSP = 476 * MiB;
constexpr size_t WS_BAR = WS_SMALL + 3 * MiB + 64 * 1024;
constexpr size_t WS_W1T = 50 * MiB, WS_C1 = WS_SMALL + 3 * MiB + 16 * 1024;
constexpr size_t WS_P = 124 * MiB;
constexpr size_t WS_C = 348 * MiB;
constexpr size_t WS_U = WS_P;
constexpr size_t WS_SELB = 478 * MiB, WS_CNTQ = WS_SELB + 512 * 1024, WS_LISTG = WS_CNTQ + 64 * 1024;
constexpr size_t WS_END = 484 * MiB;
static_assert(W_LAYER * 2 * DEPTH <= 50 * MiB && WS_W1T + (size_t)DEPTH * 2 * 128 * 2048 * 2 <= 52 * MiB, "weights");
static_assert((size_t)T * DINP * 2 == 224 * MiB && (size_t)T * DFF * 2 == 256 * MiB, "sizes");

#ifndef DUP_PRO
#define DUP_PRO 1
#endif
#ifndef DUP_QK2
#define DUP_QK2 1
#endif
#ifndef DUP_GEMM
#define DUP_GEMM 1
#endif
#ifndef DUP_M1
#define DUP_M1 1
#endif
#ifndef DUP_MOBA
#define DUP_MOBA 1
#endif
#ifndef DUP_NSA
#define DUP_NSA 1
#endif
#ifndef DUP_M3
#define DUP_M3 1
#endif
#ifndef DUP_MRG
#define DUP_MRG 1
#endif
#ifndef DUP_CMP
#define DUP_CMP 1
#endif
struct Params { const float* in[16]; float* out; unsigned char* ws; };
static_assert(sizeof(Params) == 18 * 8, "kernarg layout: in[k] at 8k, out at 128, ws at 136");
constexpr int LDS_BYTES = 147456;

__global__ void __launch_bounds__(512, 2) hybrid_fwd(Params prm) {
    extern __shared__ __attribute__((aligned(16))) unsigned char lds[];
    cg::grid_group grid = cg::this_grid();
    constexpr int NPH = 1 + DEPTH * 7;
    volatile LAS unsigned* xst = (volatile LAS unsigned*)((LAS unsigned char*)lds + 131072 + 1024);
    if (threadIdx.x < 8) xst[threadIdx.x] = 0u;
    __syncthreads();
    if (blockIdx.x == 0) { unsigned* bz = (unsigned*)(prm.ws + WS_BAR); for (int i = threadIdx.x; i < XCD_BAR_WORDS; i += 512) bz[i] = 0u; }
    int wave_s = __builtin_amdgcn_readfirstlane((int)threadIdx.x >> 6); asm volatile("" : "+s"(wave_s));
    grid.sync();
    (void)xcd_barrier_post((unsigned*)(prm.ws + WS_BAR), xst, mk_tid(wave_s));
    if (mk_tid(wave_s) == 0) { unsigned* bar = (unsigned*)(prm.ws + WS_BAR); const unsigned xc = xb_xcc_id(); unsigned nloc, nx; xcd_barrier_complete(bar, xc, nloc, nx); xst[0] = nloc; xst[1] = nx; xst[3] = xcd_chain_code(bar, xc); }
    __syncthreads();
    for (int ph = 0; ph < NPH; ++ph) {
        int tid = mk_tid(wave_s);
        int G = gridDim.x, bid = blockIdx.x; asm volatile("" : "+s"(G), "+s"(bid));
#define PH_LOCALS const int half = tid >> 8, t256 = tid & 255, lane = tid & 63, wid = __builtin_amdgcn_readfirstlane(tid >> 6); unsigned char* smh = lds + half * 65536; \
        const int vb = bid * 2 + half, NVB = G * 2, gwv = bid * 8 + wid, NGW = G * 8; (void)lane; (void)smh; (void)vb; (void)NVB; (void)gwv; (void)NGW; (void)t256;
        const __attribute__((address_space(4))) unsigned char* ka = (const __attribute__((address_space(4))) unsigned char*)__builtin_amdgcn_kernarg_segment_ptr(); asm volatile("" : "+s"(ka));
#define KARG(T_, off) (*(T_ const __attribute__((address_space(4)))*)(ka + (off)))
#define IN(k) KARG(const float*, 8 * (k))
        unsigned char* ws = KARG(unsigned char*, 8 * 17); float* out = KARG(float*, 8 * 16);
        bf16* Wb = (bf16*)(ws + WS_W); bf16* HM = (bf16*)(ws + WS_HM); float* Gt = (float*)(ws + WS_G); float* tab = (float*)(ws + WS_TAB); float* kmean = (float*)(ws + WS_KMEAN);
        float* KVc = (float*)(ws + WS_KVC); float* nst = (float*)(ws + WS_NST); float* dec = (float*)(ws + WS_DEC); bf16* KVcb = (bf16*)(ws + WS_KVCB); bf16* W1t = (bf16*)(ws + WS_W1T); float* C1 = (float*)(ws + WS_C1); bf16* P = (bf16*)(ws + WS_P); bf16* CT = (bf16*)(ws + WS_C); unsigned* SELB = (unsigned*)(ws + WS_SELB); int* CNTQ = (int*)(ws + WS_CNTQ); unsigned char* LISTG = ws + WS_LISTG; bf16* QK2 = (bf16*)out  ; bf16* XB = (bf16*)(ws + WS_C + 64 * MiB)  ; unsigned long long* SSA = (unsigned long long*)(ws + WS_SSP); unsigned long long* SSB = SSA + T;     bf16* U = (bf16*)(ws + WS_U);
        const int l = ph == 0 ? 0 : (ph - 1) / 7, jj_ = ph == 0 ? -1 : (ph - 1) % 7, j = jj_ < 2 ? jj_ : jj_ + 1;
        const float* x = IN(0);
        const bf16* WinT = Wb + l * W_LAYER; const bf16* WoT = WinT + (size_t)DINP * DM; const bf16* W1T = WoT + (size_t)DM * DM; const bf16* W2T = W1T + (size_t)DFF * DM;
        if (ph == 0) {
            PH_LOCALS
            const float* w_in = IN(1); const float* w_out = IN(11); const float* w_ff1 = IN(14); const float* w_ff2 = IN(15);
            for (int rep = 0; rep < DUP_PRO; ++rep) {
            for (int i = bid * 512 + tid; i < SEQ * 8; i += G * 512) { const int pos = i >> 3, f = i & 7;
                float c_, s_; rope_cs(pos, f, c_, s_);
                tab[pos * 16 + f] = c_; tab[pos * 16 + 8 + f] = s_; }
            for (int row = gwv; row < T; row += 2 * NGW) { ph_x_row(x, XB, SSA, row, lane); if (row + NGW < T) ph_x_row(x, XB, SSA, row + NGW, lane); }
            for (int ll = 0; ll < DEPTH; ++ll) {
                bf16* WinT_ = Wb + ll * W_LAYER; bf16* WoT_ = WinT_ + (size_t)DINP * DM; bf16* W1T_ = WoT_ + (size_t)DM * DM; bf16* W2T_ = W1T_ + (size_t)DFF * DM;
                for (int mt = 0; mt < 4; ++mt) {
                    const float* W; int K, N, NP, mode; bf16* WT;
                    const float* gk = nullptr;
                    if (mt == 0) { W = w_in + (size_t)ll * DM * DIN; K = DM; N = DIN; NP = DINP; WT = WinT_; mode = 1; gk = IN(12) + ll * DM; }
                    else if (mt == 1) { W = w_out + (size_t)ll * DM * DM; K = DM; N = DM; NP = DM; WT = WoT_; mode = 0; }
                    else if (mt == 2) { W = w_ff1 + (size_t)ll * DM * DFF; K = DM; N = DFF; NP = DFF; WT = W1T_; mode = 0; gk = IN(13) + ll * DM; }
                    else { W = w_ff2 + (size_t)ll * DFF * DM; K = DFF; N = DM; NP = DM; WT = W2T_; mode = 0; }
                    ph_convert_mat(W, K, N, NP, WT, mode, vb, NVB, t256, (float*)smh, gk);
                    if (ll == 0 && mt == 0) xcd_split_arrive((unsigned*)(ws + WS_BAR), xb_xcc_id(), xst[0], xst[1], mk_tid(wave_s), 0u);
                }
            }
            for (int lk = 0; lk < DEPTH * 2; ++lk) {
                ph_convert_mat(IN(9) + (size_t)lk * 2048 * 128, 2048, 128, 128, W1t + (size_t)lk * 128 * 2048, 0, vb, NVB, t256, (float*)smh);
            }
            for (int it = bid; it < 256; it += G) cmp_c1_item(IN(8), IN(9), C1, it, tid, (LAS unsigned char*)lds);
            }
        } else if (j == 0 || j >= 5) {
            pg8::Gemm g; pg8::EpiAny E; int N; const bool last = (l + 1 == DEPTH);
            PG8_LAS unsigned long long* RS_LDS = (PG8_LAS unsigned long long*)((PG8_LAS unsigned char*)lds + 131072 + 2048);
            if (j == 0) { g = pg8::Gemm{XB, WinT, T, DINP, DM}; N = DINP; E = pg8::EpiAny{0, true, P, DINP, Gt, C_GATE, nullptr, nullptr, nullptr, SSA, RS_LDS}; }
            else if (j == 5) { g = pg8::Gemm{HM, WoT, T, DM, DM}; N = DM; E = pg8::EpiAny{2, true, nullptr, DM, nullptr, 0, nullptr, nullptr, XB, SSB, RS_LDS}; }
            else if (j == 6) { g = pg8::Gemm{XB, W1T, T, DFF, DM}; N = DFF; E = pg8::EpiAny{1, true, U, DFF, nullptr, 0, nullptr, nullptr, nullptr, SSB, RS_LDS}; }
            else { g = pg8::Gemm{U, W2T, T, DM, DFF}; N = DM; E = pg8::EpiAny{2, true, nullptr, DM, nullptr, 0, nullptr, last ? out : nullptr, XB, SSA, RS_LDS}; }
            const unsigned chain = xst[3]; const bool chained = chain != 0u;
            pg8::StaticOrder S; S.init(T, N, G, chained ? (int)(xst[2] * 8u + (chain - 1u)) : bid);
#ifdef STAGGER_T
            if (STAGGER_PH) { const unsigned long long dl = (unsigned long long)((bid >> 3) & (STAGGER_G - 1)) * STAGGER_T; const unsigned long long t0 = __builtin_amdgcn_s_memrealtime(); while (__builtin_amdgcn_s_memrealtime() - t0 < dl) __builtin_amdgcn_s_sleep(4); }
#endif
            if (j == 6) { E.war = (unsigned*)(ws + WS_BAR) + XB_RD4; E.war_target = (unsigned)G * (unsigned)(l + 1); }
            else if (j == 0 && l > 0) { E.war = (unsigned*)(ws + WS_BAR) + XB_RD7; E.war_target = (unsigned)G * (unsigned)l; }
            for (int rep = 0; rep < ((j == 0 || j == 6) ? DUP_GEMM : 1); ++rep) pg8::gemm_phase<pg8::EpiAny, pg8::StaticOrder, true, true>((PG8_LAS unsigned char*)lds, g, S, E, tid);
        } else if (j == 1) {
            PH_LOCALS
            const unsigned chain = xst[3];
            if (chain == 0u) xcd_split_wait((unsigned*)(ws + WS_BAR), 3u * (unsigned)l + 1u, mk_tid(wave_s), 0u);
            { const int nr = chain != 0u ? 4 : (128 * 14 + NVB - 1) / NVB, lh = (int)xst[2] * 2 + half;
              for (int r = 0; r < nr; ++r) { int it; bool act;
                  if (chain != 0u) { const int q = lh + 64 * r; act = q < 224; it = (q >> 4) * 128 + 16 * (int)(chain - 1u) + (q & 15); }
                  else { it = r * NVB + vb; act = it < 128 * 14; }
                  ph_prep(P, tab, IN(5) + l * 128, IN(6) + l * 64, IN(7) + l * 192, kmean, it, act, t256, (float*)smh); } }
            if (chain != 0u) xcd_split_wait((unsigned*)(ws + WS_BAR), 3u * (unsigned)l + 1u, mk_tid(wave_s), 0u);
            tid = mk_tid(wave_s);
            for (int rep = 0; rep < DUP_CMP; ++rep) for (int it = bid; it < 256; it += G) compress_item(P, W1t + (size_t)l * 2 * 128 * 2048, C1 + l * 256, IN(10) + (size_t)l * 2 * 128 * 64, IN(7) + l * 192, KVcb, it, tid, (LAS unsigned char*)lds);
            { unsigned long long z64 = 0ull; asm volatile("" : "+v"(z64)); for (int i = bid * 512 + tid; i < 2 * T; i += G * 512) SSA[i] = z64; }
        } else if (j == 3) {
            for (int rep = 0; rep < DUP_QK2; ++rep) qk2_rows(P, IN(3) + (size_t)l * 4 * 1024, QK2, bid, G, tid);
            xcd_split_arrive((unsigned*)(ws + WS_BAR), xb_xcc_id(), xst[0], xst[1], mk_tid(wave_s), XB_CH1);
            xcd_split_wait((unsigned*)(ws + WS_BAR), 3u * (unsigned)l + 2u, mk_tid(wave_s), 0u);
            for (int rep = 0; rep < DUP_NSA; ++rep) for (int pu = bid; pu < 256; pu += G) { const int b_ = pu >> 6, s = pu & 63;
                nsa_unit(P, Gt, tab, KVcb, IN(7) + l * 192, HM, b_, 127 - s, tid, (LAS unsigned char*)lds, wave_s); }
            xcd_split_wait((unsigned*)(ws + WS_BAR), 2u * (unsigned)l, mk_tid(wave_s), XB_CH1);
            tid = mk_tid(wave_s);
            for (int rep = 0; rep < DUP_M1; ++rep) ml256_m1_phase(P, QK2, Gt, IN(2) + l * 8, CT, nst, dec, bid, G, tid, (LAS unsigned char*)lds);
            for (int u = bid; u < 512; u += G) moba_gate_item(P, kmean, SELB, CNTQ, LISTG, u >> 7, (u >> 5) & 3, u & 31, tid, (LAS unsigned char*)lds);
            xcd_split_arrive((unsigned*)(ws + WS_BAR), xb_xcc_id(), xst[0], xst[1], mk_tid(wave_s), 0u);
            for (int rep = 0; rep < DUP_NSA; ++rep) for (int pu = bid; pu < 256; pu += G) { const int b_ = pu >> 6, s = pu & 63;
                nsa_unit(P, Gt, tab, KVcb, IN(7) + l * 192, HM, b_, s, tid, (LAS unsigned char*)lds, wave_s); }
            xcd_split_wait((unsigned*)(ws + WS_BAR), 3u * (unsigned)l + 3u, mk_tid(wave_s), 0u);
            tid = mk_tid(wave_s);
            for (int it = bid; it < 16 * 9; it += G) ml256_scan(CT, nst, dec, it, tid);
            __syncthreads();
            moba_kv_phase(P, SELB, CNTQ, LISTG, IN(5) + l * 128 + 64, (unsigned*)(ws + WS_BAR) + XB_QUEUE(l), tid, (LAS unsigned char*)lds);
        } else {
            const unsigned chain = xst[3];
            { const float kmx = gain_kmax(IN(5) + l * 128 + 64, tid & 63);
              const int pu0 = chain != 0u ? 0 : bid, pul = chain != 0u ? 1 : 256;
              for (int pu = pu0; pu < pul; pu += G) { int b_, h_, qa, qb;
                  if (chain != 0u) { const int lu = (int)xst[2], p0 = 16 * (int)(chain - 1u) + (lu >> 2); b_ = p0 >> 5; h_ = lu & 3; qa = p0 & 31; qb = (p0 + 8) & 31; }
                  else { const int bh = pu >> 4, s = pu & 15; b_ = bh >> 2; h_ = bh & 3; qa = 31 - s; qb = s; }
                  for (int q2 = 0; q2 < 2; ++q2) moba_merge_unit(P, SELB, kmx, HM, b_, h_, q2 ? qb : qa, tid, (LAS unsigned char*)lds, wave_s, (q2 == 0 && pu == pu0) ? (unsigned*)(ws + WS_BAR) : nullptr, 2u * (unsigned)l + 1u); } }
            { int us = bid, ust = G, ul = 512;
              if (chain != 0u) { const int lu = (int)xst[2], p0 = 16 * (int)(chain - 1u) + (lu >> 2); us = (p0 >> 5) * 128 + (lu & 3) * 32 + (p0 & 31); ust = 8; ul = us + 16; }
              ml256_m3_phase(P, QK2, Gt, IN(2) + l * 8, CT, nst, IN(4) + l * 512, HM, us, ust, ul, tid, (LAS unsigned char*)lds); }
        }
        if (ph + 1 < NPH) { if (ph == 0) xcd_split_wait((unsigned*)(ws + WS_BAR), 0u, mk_tid(wave_s), 0u);
            else if (j == 0) { if (xst[3] != 0u) xcd_local_barrier((unsigned*)(ws + WS_BAR), xb_xcc_id(), mk_tid(wave_s));
                xcd_split_arrive((unsigned*)(ws + WS_BAR), xb_xcc_id(), xst[0], xst[1], mk_tid(wave_s), 0u); }
            else if (j == 1) xcd_split_arrive((unsigned*)(ws + WS_BAR), xb_xcc_id(), xst[0], xst[1], mk_tid(wave_s), 0u);
            else if (j == 3) xcd_split_arrive((unsigned*)(ws + WS_BAR), xb_xcc_id(), xst[0], xst[1], mk_tid(wave_s), XB_CH1);
            else { if (j == 4) xcd_reads_done((unsigned*)(ws + WS_BAR), XB_RD4, mk_tid(wave_s)); else if (j == 7) xcd_reads_done((unsigned*)(ws + WS_BAR), XB_RD7, mk_tid(wave_s));
                if (xst[3] != 0u) xcd_local_barrier((unsigned*)(ws + WS_BAR), xb_xcc_id(), mk_tid(wave_s));
                else { XcdBarrier xbar; xbar.bar = (unsigned*)(ws + WS_BAR); xbar.x = xb_xcc_id(); xbar.st = xst; xcd_barrier(xbar, mk_tid(wave_s)); } } }
    }
#undef IN
#undef KARG
#undef PH_LOCALS
}

extern "C" void kernel_launch(void* const* d_in, const int* in_sizes, int n_in, void* d_out, int out_size, void* d_ws, size_t ws_size, hipStream_t stream) {
    static int grid = 0;
    if (grid == 0) {
        if (n_in != 16 || in_sizes[0] != T * DM || out_size != T * DM || ws_size < WS_END) { fprintf(stderr, "kernel_launch: unexpected shapes / workspace %zu < %zu\n", ws_size, (size_t)WS_END); grid = -1; return; }
        int dev = 0, cus = 0, per_cu = 0;
        if (hipGetDevice(&dev) != hipSuccess || hipDeviceGetAttribute(&cus, hipDeviceAttributeMultiprocessorCount, dev) != hipSuccess) { grid = -1; return; }
        if (hipFuncSetAttribute((const void*)hybrid_fwd, hipFuncAttributeMaxDynamicSharedMemorySize, LDS_BYTES) != hipSuccess) { fprintf(stderr, "kernel_launch: hipFuncSetAttribute failed\n"); grid = -1; return; }
        if (hipOccupancyMaxActiveBlocksPerMultiprocessor(&per_cu, (const void*)hybrid_fwd, 512, LDS_BYTES) != hipSuccess || per_cu < 1) { fprintf(stderr, "kernel_launch: occupancy query failed (%d)\n", per_cu); grid = -1; return; }
        grid = cus * per_cu;
        fprintf(stderr, "kernel_launch: grid %d (%d CUs x %d)\n", grid, cus, per_cu);
    }
    if (grid < 0) return;
    Params p{};
    for (int i = 0; i < 16; ++i) p.in[i] = (const float*)d_in[i];
    p.out = (float*)d_out; p.ws = (unsigned char*)d_ws;
    void* args[] = {&p};
    hipError_t e = hipLaunchCooperativeKernel((const void*)hybrid_fwd, dim3(grid), dim3(512), args, LDS_BYTES, stream);
    if (e != hipSuccess) fprintf(stderr, "kernel_launch: cooperative launch failed: %s (grid %d)\n", hipGetErrorString(e), grid);
}
```
